# Optimizing an MI355X kernel written in HIP

```python
import math
import jax, jax.numpy as jnp
from jax import lax
import numpy as np

D_MODEL = 1024
BATCH = 4
SEQ = 4096
DEPTH = 2

N_BRANCH = 4
D_MIX = D_MODEL // N_BRANCH
HEAD_A = 64
H_A = D_MIX // HEAD_A
LORA_W = 32
LORA_A = 32
LORA_V = 32
LORA_G = 64
LNX_EPS = 64e-5
CHUNK = 128
GROUP_B = 64
G_B = D_MIX // GROUP_B
CONV_K = 3
GROUP_D = 16
G_D = D_MIX // GROUP_D
N_STATE = 64
D_FF = 4 * D_MODEL
EPS = 1e-6
LN_EPS = 1e-5

A_COLS = 3 * D_MIX + LORA_W + LORA_A + LORA_G
B_COLS = 2 * D_MIX
C_COLS = 3 * D_MIX
D_COLS = D_MIX
GATE_COLS = N_BRANCH * D_MODEL
OFF_B = A_COLS
OFF_C = OFF_B + B_COLS
OFF_D = OFF_C + C_COLS
OFF_G = OFF_D + D_COLS
N_IN = OFF_G + GATE_COLS

kernel_name = "hybrid_rwkv7_sgu_conv_s5_block"


def rms_norm(x, g):
    xf = x.astype(jnp.float32)
    return xf * lax.rsqrt(jnp.mean(xf * xf, axis=-1, keepdims=True) + EPS) * g.astype(jnp.float32)


def layer_norm(x, w, b, eps):
    xf = x.astype(jnp.float32)
    mu = jnp.mean(xf, axis=-1, keepdims=True)
    var = jnp.mean(jnp.square(xf - mu), axis=-1, keepdims=True)
    return (xf - mu) * lax.rsqrt(var + eps) * w.astype(jnp.float32) + b.astype(jnp.float32)


def shift_prev(p):
    return jnp.pad(p, ((0, 0), (1, 0), (0, 0)))[:, :-1]


def wkv7(r, w, k, v, a, b):
    bsz, _, nh, n = r.shape

    def step(state, inp):
        r_t, w_t, k_t, v_t, a_t, b_t = inp
        sa = jnp.einsum('bhij,bhj->bhi', state, a_t)
        state = (state * w_t[:, :, None, :] + sa[..., None] * b_t[:, :, None, :]
                 + v_t[..., None] * k_t[:, :, None, :])
        return state, jnp.einsum('bhij,bhj->bhi', state, r_t)

    xs = tuple(jnp.moveaxis(t, 1, 0) for t in (r, w, k, v, a, b))
    s0 = jnp.zeros((bsz, nh, n, n), jnp.float32)
    _, out = lax.scan(step, s0, xs)
    return jnp.moveaxis(out, 0, 1)


def rwkv7_mixer(p, v_first, v_mix, mu, w0, w2, a0, a2, g2, k_k, k_a, r_k, lnx_w, lnx_b, w_out):
    bsz, seq, _ = p.shape
    p = p + (shift_prev(p) - p) * mu
    r = p[..., :D_MIX]
    k = p[..., D_MIX:2 * D_MIX]
    v = p[..., 2 * D_MIX:3 * D_MIX]
    wd = p[..., 3 * D_MIX:3 * D_MIX + LORA_W]
    ad = p[..., 3 * D_MIX + LORA_W:3 * D_MIX + LORA_W + LORA_A]
    gd = p[..., 3 * D_MIX + LORA_W + LORA_A:]
    log_w = -jax.nn.softplus(-(w0 + jnp.tanh(wd) @ w2)) - 0.5
    decay = jnp.exp(-jnp.exp(log_w))
    if v_mix is None:
        v_first = v
    else:
        v0, v1, v2 = v_mix
        v = v + (v_first - v) * jax.nn.sigmoid(v0 + (v @ v1) @ v2)
    a = jax.nn.sigmoid(a0 + ad @ a2)
    g = jax.nn.sigmoid(gd) @ g2

    def heads(t):
        return t.reshape(bsz, seq, H_A, HEAD_A).astype(jnp.float32)

    kk = heads(k * k_k)
    kk = kk / jnp.maximum(jnp.sqrt(jnp.sum(kk * kk, axis=-1, keepdims=True)), 1e-12)
    k = k * (1.0 + (a - 1.0) * k_a)
    rh, kh, vh, ah = heads(r), heads(k), heads(v), heads(a)
    o = wkv7(rh, heads(decay), kh, vh, -kk, kk * ah)
    o = layer_norm(o, lnx_w.reshape(H_A, HEAD_A), lnx_b.reshape(H_A, HEAD_A), LNX_EPS)
    o = o + jnp.sum(rh * kh * r_k, axis=-1, keepdims=True) * vh
    return (o.reshape(bsz, seq, D_MIX) * g) @ w_out, v_first


def spatial_gating_mixer(p, ln_w, ln_b, w_s, b_s, w_out):
    bsz, seq, _ = p.shape
    z = jax.nn.gelu(p)
    u = z[..., :D_MIX]
    v = layer_norm(z[..., D_MIX:], ln_w, ln_b, LN_EPS)
    v = v.reshape(bsz, seq // CHUNK, CHUNK, G_B, GROUP_B)
    mask = jnp.tril(jnp.ones((CHUNK, CHUNK), jnp.float32))
    mixed = jnp.einsum('gts,bnsgc->bntgc', w_s * mask, v) + b_s.T[None, None, :, :, None]
    return (u * mixed.reshape(bsz, seq, D_MIX)) @ w_out


def short_conv_mixer(p, conv_w, w_out):
    seq = p.shape[1]
    bg = p[..., :D_MIX]
    cg = p[..., D_MIX:2 * D_MIX]
    xin = p[..., 2 * D_MIX:]
    zp = jnp.pad(cg * xin, ((0, 0), (CONV_K - 1, 0), (0, 0)))
    y = sum(conv_w[j] * zp[:, j:j + seq] for j in range(CONV_K))
    return (bg * y) @ w_out


def _complex_affine_combine(e1, e2):
    a1r, a1i, b1r, b1i = e1
    a2r, a2i, b2r, b2i = e2
    return (a2r * a1r - a2i * a1i,
            a2r * a1i + a2i * a1r,
            a2r * b1r - a2i * b1i + b2r,
            a2r * b1i + a2i * b1r + b2i)


def s5_mixer(u, a_re, a_im, b_re, b_im, c_re, c_im, d, log_dt, glu_w):
    f32 = jnp.float32
    bsz, seq, _ = u.shape
    u32 = u.astype(f32)
    ug = u32.reshape(bsz, seq, G_D, GROUP_D)
    lam_re = jnp.minimum(a_re.astype(f32), -1e-4)
    lam_im = a_im.astype(f32)
    dt = jnp.exp(log_dt.astype(f32))[:, None]
    mag = jnp.exp(lam_re * dt)
    ab_re = mag * jnp.cos(lam_im * dt)
    ab_im = mag * jnp.sin(lam_im * dt)
    den = lam_re * lam_re + lam_im * lam_im
    q_re = ((ab_re - 1.0) * lam_re + ab_im * lam_im) / den
    q_im = (ab_im * lam_re - (ab_re - 1.0) * lam_im) / den
    bb_re = q_re[..., None] * b_re - q_im[..., None] * b_im
    bb_im = q_re[..., None] * b_im + q_im[..., None] * b_re
    bu_re = jnp.einsum('gnc,bsgc->bsgn', bb_re, ug)
    bu_im = jnp.einsum('gnc,bsgc->bsgn', bb_im, ug)
    ar = jnp.broadcast_to(ab_re, bu_re.shape)
    ai = jnp.broadcast_to(ab_im, bu_im.shape)
    _, _, x_re, x_im = lax.associative_scan(_complex_affine_combine, (ar, ai, bu_re, bu_im), axis=1)
    y = (jnp.einsum('gcn,bsgn->bsgc', c_re, x_re) - jnp.einsum('gcn,bsgn->bsgc', c_im, x_im))
    y = y.reshape(bsz, seq, D_MIX) + d * u32
    h = jax.nn.gelu(y) @ glu_w
    return h[..., :D_MODEL] * jax.nn.sigmoid(h[..., D_MODEL:])


def setup_inputs(seed: int = 0) -> dict:
    key = jax.random.key(seed)
    ks = iter(jax.random.split(key, 64))
    f32 = jnp.float32
    L = DEPTH

    def nrm(shape, scale):
        return scale * jax.random.normal(next(ks), shape, f32)

    def uni(shape, lo, hi):
        return jax.random.uniform(next(ks), shape, f32, lo, hi)

    return {
        'x': nrm((BATCH, SEQ, D_MODEL), 1.0),
        'c': nrm((BATCH, D_MODEL), 1.0),
        'ada_w': nrm((L, D_MODEL, 6 * D_MODEL), 0.5 * D_MODEL ** -0.5),
        'ada_b': nrm((L, 6 * D_MODEL), 0.02),
        'norm_mix_g': 1.0 + nrm((L, D_MODEL), 0.1),
        'w_in': nrm((L, D_MODEL, N_IN), D_MODEL ** -0.5),
        'rwkv_mu': uni((L, A_COLS), 0.0, 1.0),
        'rwkv_w0': uni((L, D_MIX), -6.0, -1.0),
        'rwkv_w2': nrm((L, LORA_W, D_MIX), 0.1),
        'rwkv_a0': nrm((L, D_MIX), 0.1),
        'rwkv_a2': nrm((L, LORA_A, D_MIX), 0.1),
        'rwkv_g2': nrm((L, LORA_G, D_MIX), LORA_G ** -0.5),
        'rwkv_v0': 1.0 + nrm((L - 1, D_MIX), 0.1),
        'rwkv_v1': nrm((L - 1, D_MIX, LORA_V), D_MIX ** -0.5),
        'rwkv_v2': nrm((L - 1, LORA_V, D_MIX), 0.1),
        'rwkv_kk': 0.85 + nrm((L, D_MIX), 0.1),
        'rwkv_ka': 1.0 + nrm((L, D_MIX), 0.1),
        'rwkv_rk': nrm((L, H_A, HEAD_A), 0.1),
        'rwkv_lnx_w': 1.0 + nrm((L, D_MIX), 0.1),
        'rwkv_lnx_b': nrm((L, D_MIX), 0.02),
        'rwkv_out': nrm((L, D_MIX, D_MODEL), D_MIX ** -0.5),
        'sg_ln_w': 1.0 + nrm((L, D_MIX), 0.1),
        'sg_ln_b': nrm((L, D_MIX), 0.02),
        'sg_ws': nrm((L, G_B, CHUNK, CHUNK), CHUNK ** -0.5),
        'sg_bs': 1.0 + nrm((L, G_B, CHUNK), 0.1),
        'sg_out': nrm((L, D_MIX, D_MODEL), D_MIX ** -0.5),
        'conv_w': nrm((L, CONV_K, D_MIX), CONV_K ** -0.5),
        'conv_out': nrm((L, D_MIX, D_MODEL), D_MIX ** -0.5),
        's5_a_re': -0.5 + nrm((L, G_D, N_STATE), 0.01),
        's5_a_im': jnp.pi * jnp.arange(N_STATE, dtype=f32)[None, None, :] + nrm((L, G_D, N_STATE), 0.01),
        's5_b_re': nrm((L, G_D, N_STATE, GROUP_D), (2 * GROUP_D) ** -0.5),
        's5_b_im': nrm((L, G_D, N_STATE, GROUP_D), (2 * GROUP_D) ** -0.5),
        's5_c_re': nrm((L, G_D, GROUP_D, N_STATE), (2 * N_STATE) ** -0.5),
        's5_c_im': nrm((L, G_D, GROUP_D, N_STATE), (2 * N_STATE) ** -0.5),
        's5_d': nrm((L, D_MIX), 1.0),
        's5_log_dt': uni((L, G_D), math.log(1e-3), math.log(1e-1)),
        's5_glu_w': nrm((L, D_MIX, 2 * D_MODEL), D_MIX ** -0.5),
        'w_o': nrm((L, D_MODEL, D_MODEL), D_MODEL ** -0.5),
        'norm_ffn_g': 1.0 + nrm((L, D_MODEL), 0.1),
        'ffn_w1': nrm((L, D_MODEL, D_FF), D_MODEL ** -0.5),
        'ffn_w2': nrm((L, D_FF, D_MODEL), D_FF ** -0.5),
        'final_g': 1.0 + nrm((D_MODEL,), 0.1),
    }


def reference(x, c, ada_w, ada_b, norm_mix_g, w_in, rwkv_mu, rwkv_w0, rwkv_w2, rwkv_a0, rwkv_a2,
              rwkv_g2, rwkv_v0, rwkv_v1, rwkv_v2, rwkv_kk, rwkv_ka, rwkv_rk, rwkv_lnx_w, rwkv_lnx_b,
              rwkv_out, sg_ln_w, sg_ln_b, sg_ws, sg_bs, sg_out, conv_w, conv_out, s5_a_re, s5_a_im,
              s5_b_re, s5_b_im, s5_c_re, s5_c_im, s5_d, s5_log_dt, s5_glu_w, w_o, norm_ffn_g,
              ffn_w1, ffn_w2, final_g):
    in_dtype = x.dtype
    bsz, seq, _ = x.shape
    c_act = jax.nn.silu(c.astype(jnp.float32))
    v_first = None
    for l in range(DEPTH):
        mod = (c_act @ ada_w[l] + ada_b[l])[:, None, :]
        sh1, sc1, gt1, sh2, sc2, gt2 = jnp.split(mod, 6, axis=-1)

        h = rms_norm(x, norm_mix_g[l]) * (1.0 + sc1) + sh1
        p = h @ w_in[l]
        v_mix = None if l == 0 else (rwkv_v0[l - 1], rwkv_v1[l - 1], rwkv_v2[l - 1])
        y_a, v_first = rwkv7_mixer(p[..., :OFF_B], v_first, v_mix, rwkv_mu[l], rwkv_w0[l], rwkv_w2[l],
                                   rwkv_a0[l], rwkv_a2[l], rwkv_g2[l], rwkv_kk[l], rwkv_ka[l],
                                   rwkv_rk[l], rwkv_lnx_w[l], rwkv_lnx_b[l], rwkv_out[l])
        y_b = spatial_gating_mixer(p[..., OFF_B:OFF_C], sg_ln_w[l], sg_ln_b[l], sg_ws[l], sg_bs[l], sg_out[l])
        y_c = short_conv_mixer(p[..., OFF_C:OFF_D], conv_w[l], conv_out[l])
        y_d = s5_mixer(p[..., OFF_D:OFF_G], s5_a_re[l], s5_a_im[l], s5_b_re[l], s5_b_im[l],
                       s5_c_re[l], s5_c_im[l], s5_d[l], s5_log_dt[l], s5_glu_w[l])
        gates = jax.nn.sigmoid(p[..., OFF_G:]).reshape(bsz, seq, N_BRANCH, D_MODEL)
        merged = (gates[:, :, 0] * y_a + gates[:, :, 1] * y_b
                  + gates[:, :, 2] * y_c + gates[:, :, 3] * y_d)
        x = x + gt1 * (merged @ w_o[l])

        h = rms_norm(x, norm_ffn_g[l]) * (1.0 + sc2) + sh2
        x = x + gt2 * (jnp.square(jax.nn.relu(h @ ffn_w1[l])) @ ffn_w2[l])
    return rms_norm(x, final_g).astype(in_dtype)
```

```cpp
#include <hip/hip_runtime.h>
#include <hip/hip_cooperative_groups.h>
#include <cstdio>
namespace cg = cooperative_groups;

typedef unsigned short u16;
using bf16x8 = __attribute__((ext_vector_type(8))) short;
using f32x4 = __attribute__((ext_vector_type(4))) float;
using u32x4 = __attribute__((ext_vector_type(4))) unsigned int;
using u32x2 = __attribute__((ext_vector_type(2))) unsigned int;

#define T_TOK 16384
#define SEQ 4096
#define DM 1024
#define NTHR 256

static constexpr size_t SZ_WIN = (size_t)6528 * 1024 * 2;
static constexpr size_t OFF_WIN = 0;
static constexpr size_t OFF_RO = OFF_WIN + SZ_WIN;
static constexpr size_t OFF_SO = OFF_RO + 1024 * 256 * 2;
static constexpr size_t OFF_CO = OFF_SO + 1024 * 256 * 2;
static constexpr size_t OFF_GLU = OFF_CO + 1024 * 256 * 2;
static constexpr size_t OFF_WO = OFF_GLU + 2048 * 256 * 2;
static constexpr size_t OFF_W1 = OFF_WO + 1024 * 1024 * 2;
static constexpr size_t OFF_W2 = OFF_W1 + (size_t)4096 * 1024 * 2;
static constexpr size_t OFF_H = OFF_W2 + (size_t)4096 * 1024 * 2;
static constexpr size_t SZ_T256B = (size_t)T_TOK * 256 * 2;
static constexpr size_t OFF_VF = OFF_H + (size_t)T_TOK * 1024 * 2;
static constexpr size_t OFF_PD = OFF_VF + SZ_T256B;
static constexpr size_t OFF_G = OFF_PD + SZ_T256B;
static constexpr size_t OFF_UB = OFF_G + SZ_T256B;
static constexpr size_t OFF_CB = OFF_UB + SZ_T256B;
static constexpr size_t OFF_SR = OFF_CB + SZ_T256B;
static constexpr size_t OFF_SK = OFF_SR + SZ_T256B;
static constexpr size_t OFF_SV = OFF_SK + SZ_T256B;
static constexpr size_t OFF_SKK = OFF_SV + SZ_T256B;
static constexpr size_t OFF_SA = OFF_SKK + SZ_T256B;
static constexpr size_t OFF_SW = OFF_SA + SZ_T256B;
static constexpr size_t OFF_PABC = OFF_SW + 2 * SZ_T256B;
static constexpr size_t OFF_O = OFF_PABC;
static constexpr size_t OFF_YD = OFF_O + 2 * SZ_T256B;
static constexpr size_t OFF_OG = OFF_YD + SZ_T256B;
static constexpr size_t OFF_MRG = OFF_OG + SZ_T256B;
static constexpr size_t OFF_F = OFF_UB;
static constexpr size_t OFF_SMALL = OFF_PABC + (size_t)T_TOK * 2176 * 2;
static constexpr size_t OFF_MOD = OFF_SMALL;
static constexpr size_t OFF_S5AB = OFF_MOD + 2 * 4 * 6144 * 4;
static constexpr size_t OFF_S5BB = OFF_S5AB + 2 * 16 * 64 * 2 * 4;
static constexpr size_t OFF_S5E = OFF_S5BB + 2 * 16 * 64 * 32 * 4;
static constexpr size_t WS_END = OFF_S5E + (size_t)4 * 64 * 16 * 64 * 2 * 4;
static_assert(OFF_F + (size_t)T_TOK * 4096 * 2 <= OFF_SMALL, "F overlaps small region");
static_assert(OFF_MRG + (size_t)T_TOK * 1024 * 2 <= OFF_SMALL, "MRG overlaps");

struct Params {
  const float* in[42];
  float* out;
  unsigned char* ws;
};

__device__ __forceinline__ u16 f2bf(float f) {
  unsigned u = __float_as_uint(f);
  u += 0x7fffu + ((u >> 16) & 1u);
  return (u16)(u >> 16);
}
__device__ __forceinline__ float bf2f(u16 h) { return __uint_as_float(((unsigned)h) << 16); }
__device__ __forceinline__ float bflo(unsigned u) { return __uint_as_float(u << 16); }
__device__ __forceinline__ float bfhi(unsigned u) { return __uint_as_float(u & 0xffff0000u); }
__device__ __forceinline__ unsigned pack2(float a, float b) { return (unsigned)f2bf(a) | ((unsigned)f2bf(b) << 16); }
__device__ __forceinline__ float sigmoidf_(float x) { return 1.f / (1.f + __expf(-x)); }
__device__ __forceinline__ float tanhf_(float y) { return 1.f - 2.f / (1.f + __expf(2.f * y)); }
__device__ __forceinline__ float geluf_(float x) {
  float y = 0.7978845608028654f * (x + 0.044715f * x * x * x);
  return 0.5f * x * (1.f + tanhf_(y));
}
__device__ __forceinline__ float wave_sum(float v) {
#pragma unroll
  for (int o = 32; o > 0; o >>= 1) v += __shfl_xor(v, o, 64);
  return v;
}
template <int CTRL>
__device__ __forceinline__ float dppf(float x) {
  return __int_as_float(__builtin_amdgcn_update_dpp(0, __float_as_int(x), CTRL, 0xF, 0xF, false));
}
__device__ __forceinline__ float row_sum16(float x) {
  x += dppf<0x128>(x);
  x += dppf<0x124>(x);
  x += dppf<0x122>(x);
  x += dppf<0x121>(x);
  return x;
}

__device__ void phase_mod(const Params& p, unsigned char* smem) {
  const int tid = threadIdx.x;
  float* cact = (float*)smem;
  float* red = cact + 4096;
  float* mod = (float*)(p.ws + OFF_MOD);
  for (int i = tid; i < 4096; i += NTHR) { float c = p.in[1][i]; cact[i] = c / (1.f + __expf(-c)); }
  __syncthreads();
  for (int item = blockIdx.x; item < 192; item += gridDim.x) {
    int l = item / 96, nb = item % 96;
    int cl = tid & 63, kq = tid >> 6;
    int col = nb * 64 + cl;
    const float* W = p.in[2] + (size_t)l * 1024 * 6144;
    float a0 = 0, a1 = 0, a2 = 0, a3 = 0;
    for (int k = kq * 256; k < kq * 256 + 256; ++k) {
      float w = W[(size_t)k * 6144 + col];
      a0 += cact[k] * w; a1 += cact[1024 + k] * w; a2 += cact[2048 + k] * w; a3 += cact[3072 + k] * w;
    }
    red[(kq * 4 + 0) * 64 + cl] = a0; red[(kq * 4 + 1) * 64 + cl] = a1;
    red[(kq * 4 + 2) * 64 + cl] = a2; red[(kq * 4 + 3) * 64 + cl] = a3;
    __syncthreads();
    {
      int b = tid >> 6;
      float s = red[(0 * 4 + b) * 64 + cl] + red[(1 * 4 + b) * 64 + cl] + red[(2 * 4 + b) * 64 + cl] + red[(3 * 4 + b) * 64 + cl];
      mod[((size_t)l * 4 + b) * 6144 + col] = s + p.in[3][l * 6144 + col];
    }
    __syncthreads();
  }
  float* s5ab = (float*)(p.ws + OFF_S5AB);
  float* s5bb = (float*)(p.ws + OFF_S5BB);
  for (int idx = blockIdx.x * NTHR + tid; idx < 2048; idx += gridDim.x * NTHR) {
    int l = idx >> 10, g = (idx >> 6) & 15, n = idx & 63;
    double lre = fmin((double)p.in[28][idx], -1e-4);
    double lim = (double)p.in[29][idx];
    double dt = exp((double)p.in[35][l * 16 + g]);
    double mag = exp(lre * dt);
    double abr = mag * cos(lim * dt), abi = mag * sin(lim * dt);
    double den = lre * lre + lim * lim;
    double qr = ((abr - 1.0) * lre + abi * lim) / den;
    double qi = (abi * lre - (abr - 1.0) * lim) / den;
    s5ab[idx * 2 + 0] = (float)abr; s5ab[idx * 2 + 1] = (float)abi;
    for (int c = 0; c < 16; ++c) {
      double br = p.in[30][(size_t)idx * 16 + c], bi = p.in[31][(size_t)idx * 16 + c];
      s5bb[(size_t)idx * 32 + c] = (float)(qr * br - qi * bi);
      s5bb[(size_t)idx * 32 + 16 + c] = (float)(qr * bi + qi * br);
    }
  }
}

__device__ void convert_tile(const float* __restrict__ src, int K, int N, u16* __restrict__ dst, int tk, int tn, u16* sm) {
  const int tid = threadIdx.x;
  int r = tid >> 4, c4 = (tid & 15) * 4;
#pragma unroll
  for (int i = 0; i < 4; ++i) {
    int kk = r + 16 * i;
    float4 v = *(const float4*)(src + (size_t)(tk * 64 + kk) * N + tn * 64 + c4);
    sm[(c4 + 0) * 72 + kk] = f2bf(v.x);
    sm[(c4 + 1) * 72 + kk] = f2bf(v.y);
    sm[(c4 + 2) * 72 + kk] = f2bf(v.z);
    sm[(c4 + 3) * 72 + kk] = f2bf(v.w);
  }
  __syncthreads();
#pragma unroll
  for (int j = 0; j < 2; ++j) {
    int n = (tid >> 3) + 32 * j, ch = tid & 7;
    u32x4 v = *(const u32x4*)(sm + n * 72 + ch * 8);
    *(u32x4*)(dst + (size_t)(tn * 64 + n) * K + tk * 64 + ch * 8) = v;
  }
  __syncthreads();
}

__device__ void phase_convert(const Params& p, int l, unsigned char* smem) {
  u16* sm = (u16*)smem;
  const int total = 1632 + 192 + 128 + 256 + 1024 + 1024;
  for (int item = blockIdx.x; item < total; item += gridDim.x) {
    int t = item;
    const float* src; int K, N; size_t off;
    if (t < 1632) { src = p.in[5] + (size_t)l * 1024 * 6528; K = 1024; N = 6528; off = OFF_WIN; }
    else if ((t -= 1632) < 64) { src = p.in[20] + (size_t)l * 256 * 1024; K = 256; N = 1024; off = OFF_RO; }
    else if ((t -= 64) < 64) { src = p.in[25] + (size_t)l * 256 * 1024; K = 256; N = 1024; off = OFF_SO; }
    else if ((t -= 64) < 64) { src = p.in[27] + (size_t)l * 256 * 1024; K = 256; N = 1024; off = OFF_CO; }
    else if ((t -= 64) < 128) { src = p.in[36] + (size_t)l * 256 * 2048; K = 256; N = 2048; off = OFF_GLU; }
    else if ((t -= 128) < 256) { src = p.in[37] + (size_t)l * 1024 * 1024; K = 1024; N = 1024; off = OFF_WO; }
    else if ((t -= 256) < 1024) { src = p.in[39] + (size_t)l * 1024 * 4096; K = 1024; N = 4096; off = OFF_W1; }
    else { t -= 1024; src = p.in[40] + (size_t)l * 4096 * 1024; K = 4096; N = 1024; off = OFF_W2; }
    int ntn = N / 64;
    convert_tile(src, K, N, (u16*)(p.ws + off), t / ntn, t % ntn, sm);
  }
}

__device__ void phase_norm(const float* __restrict__ X, const float* __restrict__ g, const float* __restrict__ modl,
                           int sh_off, int sc_off, u16* __restrict__ H) {
  const int lane = threadIdx.x & 63, wv = threadIdx.x >> 6;
  for (int item = blockIdx.x; item < T_TOK / 4; item += gridDim.x) {
    int row = item * 4 + wv;
    int b = row >> 12;
    const float* xr = X + (size_t)row * 1024;
    float4 v[4];
    float ss = 0;
#pragma unroll
    for (int i = 0; i < 4; ++i) {
      v[i] = *(const float4*)(xr + lane * 4 + 256 * i);
      ss += v[i].x * v[i].x + v[i].y * v[i].y + v[i].z * v[i].z + v[i].w * v[i].w;
    }
    ss = wave_sum(ss);
    float rstd = rsqrtf(ss * (1.f / 1024.f) + 1e-6f);
    const float* sh = modl + (size_t)b * 6144 + sh_off;
    const float* sc = modl + (size_t)b * 6144 + sc_off;
#pragma unroll
    for (int i = 0; i < 4; ++i) {
      int c = lane * 4 + 256 * i;
      float4 gg = *(const float4*)(g + c);
      float4 s1 = *(const float4*)(sc + c);
      float4 s0 = *(const float4*)(sh + c);
      float h0 = v[i].x * rstd * gg.x * (1.f + s1.x) + s0.x;
      float h1 = v[i].y * rstd * gg.y * (1.f + s1.y) + s0.y;
      float h2 = v[i].z * rstd * gg.z * (1.f + s1.z) + s0.z;
      float h3 = v[i].w * rstd * gg.w * (1.f + s1.w) + s0.w;
      u32x2 o; o.x = pack2(h0, h1); o.y = pack2(h2, h3);
      *(u32x2*)(H + (size_t)row * 1024 + c) = o;
    }
  }
}

__device__ void phase_final(float* __restrict__ X, const float* __restrict__ g) {
  const int lane = threadIdx.x & 63, wv = threadIdx.x >> 6;
  for (int item = blockIdx.x; item < T_TOK / 4; item += gridDim.x) {
    int row = item * 4 + wv;
    float* xr = X + (size_t)row * 1024;
    float4 v[4];
    float ss = 0;
#pragma unroll
    for (int i = 0; i < 4; ++i) {
      v[i] = *(const float4*)(xr + lane * 4 + 256 * i);
      ss += v[i].x * v[i].x + v[i].y * v[i].y + v[i].z * v[i].z + v[i].w * v[i].w;
    }
    ss = wave_sum(ss);
    float rstd = rsqrtf(ss * (1.f / 1024.f) + 1e-6f);
#pragma unroll
    for (int i = 0; i < 4; ++i) {
      int c = lane * 4 + 256 * i;
      float4 gg = *(const float4*)(g + c);
      float4 o;
      o.x = v[i].x * rstd * gg.x; o.y = v[i].y * rstd * gg.y; o.z = v[i].z * rstd * gg.z; o.w = v[i].w * rstd * gg.w;
      *(float4*)(xr + c) = o;
    }
  }
}

template <int NF>
__device__ __forceinline__ void gemm_mainloop(const u16* __restrict__ A, int lda, const u16* __restrict__ B, int ldb,
                                              int K, f32x4 (&acc)[4][NF], u16* smem) {
  constexpr int BN = 32 * NF;
  constexpr int NB = BN / 32;
  u16* sA = smem;
  u16* sB = smem + 2 * 128 * 64;
  const int tid = threadIdx.x, lane = tid & 63, wv = tid >> 6;
  const int wm = wv >> 1, wn = wv & 1;
  u32x4 ra[4], rb[NB];
  const int lrow = tid >> 3, lch = tid & 7;
  const u16* Ap = A + (size_t)lrow * lda + lch * 8;
  const u16* Bp = B + (size_t)lrow * ldb + lch * 8;
  const int wofs = lrow * 64 + ((lch ^ ((lrow >> 1) & 7)) << 3);
  const int nk = K >> 6;
#pragma unroll
  for (int i = 0; i < 4; ++i) ra[i] = *(const u32x4*)(Ap + (size_t)(32 * i) * lda);
#pragma unroll
  for (int i = 0; i < NB; ++i) rb[i] = *(const u32x4*)(Bp + (size_t)(32 * i) * ldb);
  __syncthreads();
#pragma unroll
  for (int i = 0; i < 4; ++i) *(u32x4*)(sA + wofs + 32 * i * 64) = ra[i];
#pragma unroll
  for (int i = 0; i < NB; ++i) *(u32x4*)(sB + wofs + 32 * i * 64) = rb[i];
  __syncthreads();
  const int fr = lane & 15, fq = lane >> 4;
  const int sw = (fr >> 1) & 7;
  for (int kt = 0; kt < nk; ++kt) {
    const int cur = kt & 1;
    if (kt + 1 < nk) {
      const int ko = (kt + 1) << 6;
#pragma unroll
      for (int i = 0; i < 4; ++i) ra[i] = *(const u32x4*)(Ap + (size_t)(32 * i) * lda + ko);
#pragma unroll
      for (int i = 0; i < NB; ++i) rb[i] = *(const u32x4*)(Bp + (size_t)(32 * i) * ldb + ko);
    }
    const u16* cA = sA + cur * (128 * 64) + (wm * 64 + fr) * 64;
    const u16* cB = sB + cur * (BN * 64) + (wn * 16 * NF + fr) * 64;
#pragma unroll
    for (int ks = 0; ks < 2; ++ks) {
      const int pc = ((fq + 4 * ks) ^ sw) << 3;
      bf16x8 fa[4], fb[NF];
#pragma unroll
      for (int i = 0; i < 4; ++i) fa[i] = *(const bf16x8*)(cA + i * 16 * 64 + pc);
#pragma unroll
      for (int j = 0; j < NF; ++j) fb[j] = *(const bf16x8*)(cB + j * 16 * 64 + pc);
#pragma unroll
      for (int i = 0; i < 4; ++i)
#pragma unroll
        for (int j = 0; j < NF; ++j)
          acc[i][j] = __builtin_amdgcn_mfma_f32_16x16x32_bf16(fb[j], fa[i], acc[i][j], 0, 0, 0);
    }
    if (kt + 1 < nk) {
      const int nx = cur ^ 1;
#pragma unroll
      for (int i = 0; i < 4; ++i) *(u32x4*)(sA + nx * (128 * 64) + wofs + 32 * i * 64) = ra[i];
#pragma unroll
      for (int i = 0; i < NB; ++i) *(u32x4*)(sB + nx * (BN * 64) + wofs + 32 * i * 64) = rb[i];
    }
    __syncthreads();
  }
}

template <int NF>
__device__ __forceinline__ void zero_acc(f32x4 (&acc)[4][NF]) {
#pragma unroll
  for (int i = 0; i < 4; ++i)
#pragma unroll
    for (int j = 0; j < NF; ++j) acc[i][j] = f32x4{0.f, 0.f, 0.f, 0.f};
}

template <int EPI>
__device__ void phase_gemm(const Params& p, int l, unsigned char* smem_raw) {
  u16* smem = (u16*)smem_raw;
  const int lane = threadIdx.x & 63, wv = threadIdx.x >> 6;
  const int wm = wv >> 1, wn = wv & 1;
  const int fr = lane & 15, fq = lane >> 4;
  const u16* A; const u16* B; int lda, ldb, K, ntiles_n;
  if (EPI == 0) { A = (const u16*)(p.ws + OFF_H); lda = 1024; B = (const u16*)(p.ws + OFF_WIN); ldb = 1024; K = 1024; ntiles_n = 19; }
  if (EPI == 1) { A = (const u16*)(p.ws + OFF_MRG); lda = 1024; B = (const u16*)(p.ws + OFF_WO); ldb = 1024; K = 1024; ntiles_n = 8; }
  if (EPI == 2) { A = (const u16*)(p.ws + OFF_H); lda = 1024; B = (const u16*)(p.ws + OFF_W1); ldb = 1024; K = 1024; ntiles_n = 32; }
  if (EPI == 3) { A = (const u16*)(p.ws + OFF_F); lda = 4096; B = (const u16*)(p.ws + OFF_W2); ldb = 4096; K = 4096; ntiles_n = 8; }
  const float* modl = (const float*)(p.ws + OFF_MOD) + (size_t)l * 4 * 6144;
  const int total = 128 * ntiles_n;
  for (int item = blockIdx.x; item < total; item += gridDim.x) {
    const int mt = item & 127, nt = item >> 7;
    const int m0 = mt * 128, n0 = nt * 128;
    f32x4 acc[4][4];
    zero_acc<4>(acc);
    gemm_mainloop<4>(A + (size_t)m0 * lda, lda, B + (size_t)n0 * ldb, ldb, K, acc, smem);
#pragma unroll
    for (int i = 0; i < 4; ++i) {
      const int m = m0 + wm * 64 + i * 16 + fr;
#pragma unroll
      for (int j = 0; j < 4; ++j) {
        const int n = n0 + wn * 64 + j * 16 + fq * 4;
        f32x4 v = acc[i][j];
        if (EPI == 0) {
          u32x2 o; o.x = pack2(v[0], v[1]); o.y = pack2(v[2], v[3]);
          if (n < 2176) *(u32x2*)((u16*)(p.ws + OFF_PABC) + (size_t)m * 2176 + n) = o;
          else *(u32x2*)((u16*)(p.ws + OFF_PD) + (size_t)m * 256 + (n - 2176)) = o;
        } else if (EPI == 1 || EPI == 3) {
          const int b = m >> 12;
          const float* gt = modl + (size_t)b * 6144 + (EPI == 1 ? 2048 : 5120) + n;
          const float* xin = ((EPI == 1 && l == 0) ? p.in[0] : p.out) + (size_t)m * 1024 + n;
          float4 x = *(const float4*)xin;
          float4 gg = *(const float4*)gt;
          float4 o;
          o.x = x.x + gg.x * v[0]; o.y = x.y + gg.y * v[1]; o.z = x.z + gg.z * v[2]; o.w = x.w + gg.w * v[3];
          *(float4*)(p.out + (size_t)m * 1024 + n) = o;
        } else {
          float r0 = fmaxf(v[0], 0.f), r1 = fmaxf(v[1], 0.f), r2 = fmaxf(v[2], 0.f), r3 = fmaxf(v[3], 0.f);
          u32x2 o; o.x = pack2(r0 * r0, r1 * r1); o.y = pack2(r2 * r2, r3 * r3);
          *(u32x2*)((u16*)(p.ws + OFF_F) + (size_t)m * 4096 + n) = o;
        }
      }
    }
  }
}

__device__ void phase_merge(const Params& p, unsigned char* smem_raw) {
  u16* smem = (u16*)smem_raw;
  const int lane = threadIdx.x & 63, wv = threadIdx.x >> 6;
  const int wm = wv >> 1, wn = wv & 1;
  const int fr = lane & 15, fq = lane >> 4;
  const u16* H = (const u16*)(p.ws + OFF_H);
  const u16* WIN = (const u16*)(p.ws + OFF_WIN);
  for (int item = blockIdx.x; item < 128 * 16; item += gridDim.x) {
    const int mt = item & 127, nt = item >> 7;
    const int m0 = mt * 128, n0 = nt * 64;
    f32x4 macc[4][2], bacc[4][2], gacc[4][2];
    zero_acc<2>(macc);
#pragma unroll 1
    for (int br = 0; br < 4; ++br) {
      zero_acc<2>(bacc);
      const u16* Ab; const u16* Wb;
      if (br == 0) { Ab = (const u16*)(p.ws + OFF_OG); Wb = (const u16*)(p.ws + OFF_RO); }
      else if (br == 1) { Ab = (const u16*)(p.ws + OFF_UB); Wb = (const u16*)(p.ws + OFF_SO); }
      else if (br == 2) { Ab = (const u16*)(p.ws + OFF_CB); Wb = (const u16*)(p.ws + OFF_CO); }
      else { Ab = (const u16*)(p.ws + OFF_YD); Wb = (const u16*)(p.ws + OFF_GLU); }
      gemm_mainloop<2>(Ab + (size_t)m0 * 256, 256, Wb + (size_t)n0 * 256, 256, 256, bacc, smem);
      if (br == 3) {
        zero_acc<2>(gacc);
        gemm_mainloop<2>(Ab + (size_t)m0 * 256, 256, Wb + (size_t)(1024 + n0) * 256, 256, 256, gacc, smem);
#pragma unroll
        for (int i = 0; i < 4; ++i)
#pragma unroll
          for (int j = 0; j < 2; ++j)
#pragma unroll
            for (int e = 0; e < 4; ++e) bacc[i][j][e] *= sigmoidf_(gacc[i][j][e]);
      }
      zero_acc<2>(gacc);
      gemm_mainloop<2>(H + (size_t)m0 * 1024, 1024, WIN + (size_t)(2432 + br * 1024 + n0) * 1024, 1024, 1024, gacc, smem);
#pragma unroll
      for (int i = 0; i < 4; ++i)
#pragma unroll
        for (int j = 0; j < 2; ++j)
#pragma unroll
          for (int e = 0; e < 4; ++e) macc[i][j][e] += sigmoidf_(gacc[i][j][e]) * bacc[i][j][e];
    }
    u16* MRG = (u16*)(p.ws + OFF_MRG);
#pragma unroll
    for (int i = 0; i < 4; ++i) {
      const int m = m0 + wm * 64 + i * 16 + fr;
#pragma unroll
      for (int j = 0; j < 2; ++j) {
        const int n = n0 + wn * 32 + j * 16 + fq * 4;
        u32x2 o; o.x = pack2(macc[i][j][0], macc[i][j][1]); o.y = pack2(macc[i][j][2], macc[i][j][3]);
        *(u32x2*)(MRG + (size_t)m * 1024 + n) = o;
      }
    }
  }
}

__device__ __forceinline__ float shifted(const u16* __restrict__ P, int tok, int col, float mu) {
  float pv = bf2f(P[(size_t)tok * 2176 + col]);
  float pr = (tok & (SEQ - 1)) ? bf2f(P[(size_t)(tok - 1) * 2176 + col]) : 0.f;
  return pv + (pr - pv) * mu;
}

__device__ void rwkv_prep_item(const Params& p, int l, int item, unsigned char* smem) {
  const int tid = threadIdx.x;
  float* sl = (float*)smem;
  float* sv = sl + 32 * 128;
  float* svl = sv + 32 * 256;
  const u16* P = (const u16*)(p.ws + OFF_PABC);
  const float* mu = p.in[6] + l * 896;
  const int tok0 = item * 32;
  for (int idx = tid; idx < 32 * 128; idx += NTHR) {
    int t = idx >> 7, ci = idx & 127;
    float v = shifted(P, tok0 + t, 768 + ci, mu[768 + ci]);
    if (ci < 32) v = tanhf_(v);
    else if (ci >= 64) v = sigmoidf_(v);
    sl[idx] = v;
  }
  if (l > 0) {
    float m = mu[512 + tid];
    for (int t = 0; t < 32; ++t) sv[t * 256 + tid] = shifted(P, tok0 + t, 512 + tid, m);
  }
  __syncthreads();
  if (l > 0) {
    const float* v1 = p.in[13];
    int t = tid >> 3, o4 = (tid & 7) * 4;
    float a0 = 0, a1 = 0, a2 = 0, a3 = 0;
    for (int k = 0; k < 256; ++k) {
      float s = sv[t * 256 + k];
      float4 w = *(const float4*)(v1 + k * 32 + o4);
      a0 += s * w.x; a1 += s * w.y; a2 += s * w.z; a3 += s * w.w;
    }
    svl[t * 32 + o4 + 0] = a0; svl[t * 32 + o4 + 1] = a1; svl[t * 32 + o4 + 2] = a2; svl[t * 32 + o4 + 3] = a3;
    __syncthreads();
  }
  const int j = tid;
  const float* w2 = p.in[8] + l * 32 * 256;
  const float* a2w = p.in[10] + l * 32 * 256;
  const float* g2 = p.in[11] + l * 64 * 256;
  const float* v2 = p.in[14];
  const float w0 = p.in[7][l * 256 + j], a0c = p.in[9][l * 256 + j];
  const float v0 = (l > 0) ? p.in[12][j] : 0.f;
  const float kkc = p.in[15][l * 256 + j], kac = p.in[16][l * 256 + j];
  const float mur = mu[j], muk = mu[256 + j], muv = mu[512 + j];
  u16* SR = (u16*)(p.ws + OFF_SR); u16* SK = (u16*)(p.ws + OFF_SK); u16* SV = (u16*)(p.ws + OFF_SV);
  u16* SKK = (u16*)(p.ws + OFF_SKK); u16* SA = (u16*)(p.ws + OFF_SA); float* SW = (float*)(p.ws + OFF_SW);
  u16* G = (u16*)(p.ws + OFF_G); u16* VF = (u16*)(p.ws + OFF_VF);
#pragma unroll 1
  for (int tg = 0; tg < 4; ++tg) {
    float accw[8], acca[8], accg[8], accv[8];
#pragma unroll
    for (int tt = 0; tt < 8; ++tt) { accw[tt] = 0; acca[tt] = 0; accg[tt] = 0; accv[tt] = 0; }
#pragma unroll 2
    for (int k4 = 0; k4 < 8; ++k4) {
      float ww[4], wa[4];
#pragma unroll
      for (int e = 0; e < 4; ++e) { ww[e] = w2[(k4 * 4 + e) * 256 + j]; wa[e] = a2w[(k4 * 4 + e) * 256 + j]; }
#pragma unroll
      for (int tt = 0; tt < 8; ++tt) {
        float4 s = *(const float4*)(sl + (tg * 8 + tt) * 128 + k4 * 4);
        float4 s2 = *(const float4*)(sl + (tg * 8 + tt) * 128 + 32 + k4 * 4);
        accw[tt] += s.x * ww[0] + s.y * ww[1] + s.z * ww[2] + s.w * ww[3];
        acca[tt] += s2.x * wa[0] + s2.y * wa[1] + s2.z * wa[2] + s2.w * wa[3];
      }
    }
#pragma unroll 2
    for (int k4 = 0; k4 < 16; ++k4) {
      float wg[4];
#pragma unroll
      for (int e = 0; e < 4; ++e) wg[e] = g2[(k4 * 4 + e) * 256 + j];
#pragma unroll
      for (int tt = 0; tt < 8; ++tt) {
        float4 s = *(const float4*)(sl + (tg * 8 + tt) * 128 + 64 + k4 * 4);
        accg[tt] += s.x * wg[0] + s.y * wg[1] + s.z * wg[2] + s.w * wg[3];
      }
    }
    if (l > 0) {
#pragma unroll 2
      for (int k4 = 0; k4 < 8; ++k4) {
        float wvv[4];
#pragma unroll
        for (int e = 0; e < 4; ++e) wvv[e] = v2[(k4 * 4 + e) * 256 + j];
#pragma unroll
        for (int tt = 0; tt < 8; ++tt) {
          float4 s = *(const float4*)(svl + (tg * 8 + tt) * 32 + k4 * 4);
          accv[tt] += s.x * wvv[0] + s.y * wvv[1] + s.z * wvv[2] + s.w * wvv[3];
        }
      }
    }
#pragma unroll
    for (int tt = 0; tt < 8; ++tt) {
      const int tok = tok0 + tg * 8 + tt;
      float r = shifted(P, tok, j, mur);
      float k = shifted(P, tok, 256 + j, muk);
      float v = shifted(P, tok, 512 + j, muv);
      float wl = w0 + accw[tt];
      float z = -wl;
      float sp = (z > 15.f) ? z : log1pf(__expf(z));
      float lw = -sp - 0.5f;
      float decay = __expf(-__expf(lw));
      float a = sigmoidf_(a0c + acca[tt]);
      float g = accg[tt];
      const size_t o = (size_t)tok * 256 + j;
      if (l == 0) {
        VF[o] = f2bf(v);
      } else {
        float vf = bf2f(VF[o]);
        v = v + (vf - v) * sigmoidf_(v0 + accv[tt]);
      }
      float kk = k * kkc;
      float ss = wave_sum(kk * kk);
      kk = kk / fmaxf(sqrtf(ss), 1e-12f);
      float km = k * (1.f + (a - 1.f) * kac);
      SR[o] = f2bf(r); SK[o] = f2bf(km); SV[o] = f2bf(v); SKK[o] = f2bf(kk); SA[o] = f2bf(a);
      SW[o] = decay; G[o] = f2bf(g);
    }
  }
  __syncthreads();
}

__device__ void sg_item(const Params& p, int l, int item, unsigned char* smem) {
  const int tid = threadIdx.x, lane = tid & 63, wv = tid >> 6;
  float* vs = (float*)smem;
  float* smu = vs + 128 * 64;
  float* srs = smu + 128;
  const u16* P = (const u16*)(p.ws + OFF_PABC);
  const int g = item & 3, chn = item >> 2;
  const int tok0 = chn * 128;
  for (int i = 0; i < 32; ++i) {
    int t = wv * 32 + i;
    u32x2 raw = *(const u32x2*)(P + (size_t)(tok0 + t) * 2176 + 896 + 256 + lane * 4);
    float z0 = geluf_(bflo(raw.x)), z1 = geluf_(bfhi(raw.x)), z2 = geluf_(bflo(raw.y)), z3 = geluf_(bfhi(raw.y));
    float s = wave_sum(z0 + z1 + z2 + z3);
    float mean = s * (1.f / 256.f);
    float d0 = z0 - mean, d1 = z1 - mean, d2 = z2 - mean, d3 = z3 - mean;
    float var = wave_sum(d0 * d0 + d1 * d1 + d2 * d2 + d3 * d3) * (1.f / 256.f);
    if (lane == 0) { smu[t] = mean; srs[t] = rsqrtf(var + 1e-5f); }
  }
  __syncthreads();
  {
    const int c = tid & 63, tq = tid >> 6;
    const float lw = p.in[21][l * 256 + g * 64 + c], lb = p.in[22][l * 256 + g * 64 + c];
    for (int i = 0; i < 32; ++i) {
      int t = tq + 4 * i;
      float z = geluf_(bf2f(P[(size_t)(tok0 + t) * 2176 + 896 + 256 + g * 64 + c]));
      vs[t * 64 + c] = (z - smu[t]) * srs[t] * lw + lb;
    }
  }
  __syncthreads();
  {
    const int c = tid & 63;
    const int tq = __builtin_amdgcn_readfirstlane(tid >> 6);
    const float* Wg = p.in[23] + ((size_t)l * 4 + g) * 128 * 128;
    const float* bs = p.in[24] + ((size_t)l * 4 + g) * 128;
    u16* UB = (u16*)(p.ws + OFF_UB);
    for (int i = 0; i < 32; ++i) {
      const int t = tq + 4 * i;
      const float* Wrow = Wg + (size_t)t * 128;
      float acc = bs[t];
      const int n4 = (t >> 2) + 1;
      for (int s4 = 0; s4 < n4; ++s4) {
        float4 w = *(const float4*)(Wrow + s4 * 4);
        int s = s4 * 4;
        acc += w.x * vs[s * 64 + c];
        if (s + 1 <= t) acc += w.y * vs[(s + 1) * 64 + c];
        if (s + 2 <= t) acc += w.z * vs[(s + 2) * 64 + c];
        if (s + 3 <= t) acc += w.w * vs[(s + 3) * 64 + c];
      }
      float u = geluf_(bf2f(P[(size_t)(tok0 + t) * 2176 + 896 + g * 64 + c]));
      UB[(size_t)(tok0 + t) * 256 + g * 64 + c] = f2bf(u * acc);
    }
  }
  __syncthreads();
}

__device__ void conv_item(const Params& p, int l, int item) {
  const int j = threadIdx.x;
  const u16* P = (const u16*)(p.ws + OFF_PABC);
  u16* CB = (u16*)(p.ws + OFF_CB);
  const float c0 = p.in[26][(l * 3 + 0) * 256 + j], c1 = p.in[26][(l * 3 + 1) * 256 + j], c2 = p.in[26][(l * 3 + 2) * 256 + j];
  const int tok0 = item * 64;
  float z2 = 0.f, z1 = 0.f;
  if (tok0 & (SEQ - 1)) {
    const u16* q2 = P + (size_t)(tok0 - 2) * 2176 + 1408;
    const u16* q1 = P + (size_t)(tok0 - 1) * 2176 + 1408;
    z2 = bf2f(q2[256 + j]) * bf2f(q2[512 + j]);
    z1 = bf2f(q1[256 + j]) * bf2f(q1[512 + j]);
  }
  for (int t = 0; t < 64; ++t) {
    const u16* q = P + (size_t)(tok0 + t) * 2176 + 1408;
    float bg = bf2f(q[j]);
    float z = bf2f(q[256 + j]) * bf2f(q[512 + j]);
    float y = c0 * z2 + c1 * z1 + c2 * z;
    CB[(size_t)(tok0 + t) * 256 + j] = f2bf(bg * y);
    z2 = z1; z1 = z;
  }
}

__device__ __forceinline__ void s5_load_u(const u16* __restrict__ PD, int tok, int g, float (&u)[16]) {
  const u32x4* q = (const u32x4*)(PD + (size_t)tok * 256 + g * 16);
  u32x4 a = q[0], b = q[1];
  u[0] = bflo(a.x); u[1] = bfhi(a.x); u[2] = bflo(a.y); u[3] = bfhi(a.y);
  u[4] = bflo(a.z); u[5] = bfhi(a.z); u[6] = bflo(a.w); u[7] = bfhi(a.w);
  u[8] = bflo(b.x); u[9] = bfhi(b.x); u[10] = bflo(b.y); u[11] = bfhi(b.y);
  u[12] = bflo(b.z); u[13] = bfhi(b.z); u[14] = bflo(b.w); u[15] = bfhi(b.w);
}

__device__ void s5a_item(const Params& p, int l, int item) {
  const int lane = threadIdx.x & 63, wv = threadIdx.x >> 6;
  const int gq = item & 3, bc = item >> 2;
  const int g = gq * 4 + wv;
  const int tok0 = bc * 64;
  const u16* PD = (const u16*)(p.ws + OFF_PD);
  const float* ab = (const float*)(p.ws + OFF_S5AB) + ((size_t)(l * 16 + g) * 64 + lane) * 2;
  const float* bb = (const float*)(p.ws + OFF_S5BB) + ((size_t)(l * 16 + g) * 64 + lane) * 32;
  float bbr[16], bbi[16];
#pragma unroll
  for (int c = 0; c < 16; ++c) { bbr[c] = bb[c]; bbi[c] = bb[16 + c]; }
  const float abr = ab[0], abi = ab[1];
  float xr = 0.f, xi = 0.f;
  for (int t = 0; t < 64; ++t) {
    float u[16];
    s5_load_u(PD, tok0 + t, g, u);
    float bur = 0.f, bui = 0.f;
#pragma unroll
    for (int c = 0; c < 16; ++c) { bur += bbr[c] * u[c]; bui += bbi[c] * u[c]; }
    float nr = abr * xr - abi * xi + bur;
    float ni = abr * xi + abi * xr + bui;
    xr = nr; xi = ni;
  }
  float2* E = (float2*)(p.ws + OFF_S5E);
  E[((size_t)bc * 16 + g) * 64 + lane] = make_float2(xr, xi);
}

__device__ void s5b_item(const Params& p, int l, int item, unsigned char* smem) {
  const int lane = threadIdx.x & 63, wv = threadIdx.x >> 6;
  const int gq = item & 3, bc = item >> 2;
  const int b = bc >> 6, ch = bc & 63;
  const int g = gq * 4 + wv;
  const int tok0 = bc * 64;
  float* base = (float*)smem + wv * 4096;
  float* csr = base, *csi = base + 1024, *xsr = base + 2048, *xsi = base + 3072;
  const u16* PD = (const u16*)(p.ws + OFF_PD);
  const float* ab = (const float*)(p.ws + OFF_S5AB) + ((size_t)(l * 16 + g) * 64 + lane) * 2;
  const float* bb = (const float*)(p.ws + OFF_S5BB) + ((size_t)(l * 16 + g) * 64 + lane) * 32;
  const float* cre = p.in[32] + ((size_t)(l * 16 + g) * 16) * 64;
  const float* cim = p.in[33] + ((size_t)(l * 16 + g) * 16) * 64;
  for (int c = 0; c < 16; ++c) {
    csr[(lane >> 2) * 64 + c * 4 + (lane & 3)] = cre[c * 64 + lane];
    csi[(lane >> 2) * 64 + c * 4 + (lane & 3)] = cim[c * 64 + lane];
  }
  float bbr[16], bbi[16];
#pragma unroll
  for (int c = 0; c < 16; ++c) { bbr[c] = bb[c]; bbi[c] = bb[16 + c]; }
  const float abr = ab[0], abi = ab[1];
  float pr = abr, pi = abi;
#pragma unroll
  for (int s = 0; s < 6; ++s) { float nr = pr * pr - pi * pi, ni = 2.f * pr * pi; pr = nr; pi = ni; }
  float xr = 0.f, xi = 0.f;
  const float2* E = (const float2*)(p.ws + OFF_S5E);
  for (int c = 0; c < ch; ++c) {
    float2 e = E[((size_t)(b * 64 + c) * 16 + g) * 64 + lane];
    float nr = pr * xr - pi * xi + e.x;
    float ni = pr * xi + pi * xr + e.y;
    xr = nr; xi = ni;
  }
  const int tt = lane & 15, cq = lane >> 4;
  const float* dvec = p.in[34] + l * 256 + g * 16 + cq * 4;
  const float d0 = dvec[0], d1 = dvec[1], d2 = dvec[2], d3 = dvec[3];
  u16* YD = (u16*)(p.ws + OFF_YD);
  const int n4w = lane >> 2, e4 = lane & 3;
#pragma unroll 1
  for (int sc = 0; sc < 4; ++sc) {
    for (int t = 0; t < 16; ++t) {
      float u[16];
      s5_load_u(PD, tok0 + sc * 16 + t, g, u);
      float bur = 0.f, bui = 0.f;
#pragma unroll
      for (int c = 0; c < 16; ++c) { bur += bbr[c] * u[c]; bui += bbi[c] * u[c]; }
      float nr = abr * xr - abi * xi + bur;
      float ni = abr * xi + abi * xr + bui;
      xr = nr; xi = ni;
      int a = n4w * 64 + ((t ^ (n4w & 7)) << 2) + e4;
      xsr[a] = xr; xsi[a] = xi;
    }
    __syncthreads();
    float acc0 = 0.f, acc1 = 0.f, acc2 = 0.f, acc3 = 0.f;
#pragma unroll 2
    for (int n4 = 0; n4 < 16; ++n4) {
      int xa = n4 * 64 + ((tt ^ (n4 & 7)) << 2);
      float4 xr4 = *(const float4*)(xsr + xa);
      float4 xi4 = *(const float4*)(xsi + xa);
      const float* cr = csr + n4 * 64 + cq * 16;
      const float* ci = csi + n4 * 64 + cq * 16;
      float4 r0 = *(const float4*)(cr), r1 = *(const float4*)(cr + 4), r2 = *(const float4*)(cr + 8), r3 = *(const float4*)(cr + 12);
      float4 i0 = *(const float4*)(ci), i1 = *(const float4*)(ci + 4), i2 = *(const float4*)(ci + 8), i3 = *(const float4*)(ci + 12);
      acc0 += r0.x * xr4.x + r0.y * xr4.y + r0.z * xr4.z + r0.w * xr4.w - (i0.x * xi4.x + i0.y * xi4.y + i0.z * xi4.z + i0.w * xi4.w);
      acc1 += r1.x * xr4.x + r1.y * xr4.y + r1.z * xr4.z + r1.w * xr4.w - (i1.x * xi4.x + i1.y * xi4.y + i1.z * xi4.z + i1.w * xi4.w);
      acc2 += r2.x * xr4.x + r2.y * xr4.y + r2.z * xr4.z + r2.w * xr4.w - (i2.x * xi4.x + i2.y * xi4.y + i2.z * xi4.z + i2.w * xi4.w);
      acc3 += r3.x * xr4.x + r3.y * xr4.y + r3.z * xr4.z + r3.w * xr4.w - (i3.x * xi4.x + i3.y * xi4.y + i3.z * xi4.z + i3.w * xi4.w);
    }
    {
      const int tok = tok0 + sc * 16 + tt;
      u32x2 ur = *(const u32x2*)(PD + (size_t)tok * 256 + g * 16 + cq * 4);
      float y0 = acc0 + d0 * bflo(ur.x), y1 = acc1 + d1 * bfhi(ur.x), y2 = acc2 + d2 * bflo(ur.y), y3 = acc3 + d3 * bfhi(ur.y);
      u32x2 o; o.x = pack2(geluf_(y0), geluf_(y1)); o.y = pack2(geluf_(y2), geluf_(y3));
      *(u32x2*)(YD + (size_t)tok * 256 + g * 16 + cq * 4) = o;
    }
    __syncthreads();
  }
}

__device__ void scan_item(const Params& p, int item, unsigned char* smem) {
  const int tid = threadIdx.x, lane = tid & 63, wv = tid >> 6;
  const int b = item >> 4, h = (item >> 2) & 3, q = item & 3;
  const int rl = lane >> 4, cl = lane & 15;
  const int rloc = wv * 4 + rl;
  const int rowi = q * 16 + rloc;
  const size_t tokb = (size_t)b * SEQ;
  const int chan0 = h * 64;
  const u16* SR = (const u16*)(p.ws + OFF_SR); const u16* SK = (const u16*)(p.ws + OFF_SK);
  const u16* SV = (const u16*)(p.ws + OFF_SV); const u16* SKK = (const u16*)(p.ws + OFF_SKK);
  const u16* SA = (const u16*)(p.ws + OFF_SA); const float* SW = (const float*)(p.ws + OFF_SW);
  float* O = (float*)(p.ws + OFF_O);
  constexpr int BUFB = 25600;
  const int st = tid >> 3, part = tid & 7;
  u32x4 gr, gk, gkk, ga, gw0, gw1, gv;
  auto gload = [&](int c) {
    size_t o = (tokb + (size_t)c * 32 + st) * 256 + chan0 + part * 8;
    gr = *(const u32x4*)(SR + o); gk = *(const u32x4*)(SK + o); gkk = *(const u32x4*)(SKK + o); ga = *(const u32x4*)(SA + o);
    {
      int i0 = tid, i1 = tid + 256;
      gw0 = *(const u32x4*)(SW + (tokb + (size_t)c * 32 + (i0 >> 4)) * 256 + chan0 + (i0 & 15) * 4);
      gw1 = *(const u32x4*)(SW + (tokb + (size_t)c * 32 + (i1 >> 4)) * 256 + chan0 + (i1 & 15) * 4);
    }
    if (tid < 64) gv = *(const u32x4*)(SV + (tokb + (size_t)c * 32 + (tid >> 1)) * 256 + chan0 + q * 16 + (tid & 1) * 8);
  };
  auto lwrite = [&](int buf) {
    unsigned char* bp = smem + buf * BUFB;
    *(u32x4*)(bp + 0 * 4096 + tid * 16) = gr;
    *(u32x4*)(bp + 1 * 4096 + tid * 16) = gk;
    *(u32x4*)(bp + 2 * 4096 + tid * 16) = gkk;
    *(u32x4*)(bp + 3 * 4096 + tid * 16) = ga;
    *(u32x4*)(bp + 16384 + tid * 16) = gw0;
    *(u32x4*)(bp + 16384 + (tid + 256) * 16) = gw1;
    if (tid < 64) *(u32x4*)(bp + 24576 + tid * 16) = gv;
  };
  gload(0);
  __syncthreads();
  lwrite(0);
  __syncthreads();
  float S0 = 0.f, S1 = 0.f, S2 = 0.f, S3 = 0.f;
#pragma unroll 1
  for (int c = 0; c < SEQ / 32; ++c) {
    if (c + 1 < SEQ / 32) gload(c + 1);
    const unsigned char* bp = smem + (c & 1) * BUFB;
    float* optr = O + (tokb + (size_t)c * 32) * 256 + chan0 + rowi;
#pragma unroll 4
    for (int s = 0; s < 32; ++s) {
      u32x2 r2 = *(const u32x2*)(bp + 0 * 4096 + s * 128 + cl * 8);
      u32x2 k2 = *(const u32x2*)(bp + 1 * 4096 + s * 128 + cl * 8);
      u32x2 q2 = *(const u32x2*)(bp + 2 * 4096 + s * 128 + cl * 8);
      u32x2 a2 = *(const u32x2*)(bp + 3 * 4096 + s * 128 + cl * 8);
      float4 w4 = *(const float4*)(bp + 16384 + s * 256 + cl * 16);
      float v = bf2f(*(const u16*)(bp + 24576 + s * 32 + rloc * 2));
      float kk0 = bflo(q2.x), kk1 = bfhi(q2.x), kk2 = bflo(q2.y), kk3 = bfhi(q2.y);
      float sa = S0 * kk0 + S1 * kk1 + S2 * kk2 + S3 * kk3;
      sa = row_sum16(sa);
      float b0 = kk0 * bflo(a2.x), b1 = kk1 * bfhi(a2.x), b2 = kk2 * bflo(a2.y), b3 = kk3 * bfhi(a2.y);
      float u0 = v * bflo(k2.x) - sa * b0, u1 = v * bfhi(k2.x) - sa * b1, u2 = v * bflo(k2.y) - sa * b2, u3 = v * bfhi(k2.y) - sa * b3;
      S0 = S0 * w4.x + u0; S1 = S1 * w4.y + u1; S2 = S2 * w4.z + u2; S3 = S3 * w4.w + u3;
      float os = S0 * bflo(r2.x) + S1 * bfhi(r2.x) + S2 * bflo(r2.y) + S3 * bfhi(r2.y);
      os = row_sum16(os);
      if (cl == 0) optr[(size_t)s * 256] = os;
    }
    if (c + 1 < SEQ / 32) lwrite((c + 1) & 1);
    __syncthreads();
  }
}

__device__ void rwkv_post_item(const Params& p, int l, int item) {
  const int j = threadIdx.x;
  const float* O = (const float*)(p.ws + OFF_O);
  const u16* SR = (const u16*)(p.ws + OFF_SR); const u16* SK = (const u16*)(p.ws + OFF_SK);
  const u16* SV = (const u16*)(p.ws + OFF_SV); const u16* G = (const u16*)(p.ws + OFF_G);
  u16* OG = (u16*)(p.ws + OFF_OG);
  const float lw = p.in[18][l * 256 + j], lb = p.in[19][l * 256 + j], rk = p.in[17][l * 256 + j];
  const int tok0 = item * 64;
  for (int t = 0; t < 64; ++t) {
    const size_t o = (size_t)(tok0 + t) * 256 + j;
    float ov = O[o];
    float mean = wave_sum(ov) * (1.f / 64.f);
    float d = ov - mean;
    float var = wave_sum(d * d) * (1.f / 64.f);
    float on = d * rsqrtf(var + 64e-5f) * lw + lb;
    float r = bf2f(SR[o]), k = bf2f(SK[o]), v = bf2f(SV[o]), g = bf2f(G[o]);
    float bonus = wave_sum(r * k * rk);
    OG[o] = f2bf((on + bonus * v) * g);
  }
}

#define N_PHASES 22
#ifndef PH_MASK
#define PH_MASK 0xFFFFF
#endif
#define PHON(s) (PH_MASK & (1 << (s)))
#define PHASE_BEGIN(k) if (ph_lo <= (k) && (k) < ph_hi) { if ((k) > ph_lo) grid.sync();
#define PHASE_END }

template <int L>
__device__ __forceinline__ void run_layer(const Params& p, int ph_lo, int ph_hi, unsigned char* smem, cg::grid_group& grid) {
  constexpr int l = L;
  constexpr int base = 1 + 10 * L;
  const float* modl = (const float*)(p.ws + OFF_MOD) + (size_t)l * 4 * 6144;
  PHASE_BEGIN(base + 0)
    if (PHON(0)) {
      phase_convert(p, l, smem);
      phase_norm(l == 0 ? p.in[0] : p.out, p.in[4] + l * 1024, modl, 0, 1024, (u16*)(p.ws + OFF_H));
    }
  PHASE_END
  PHASE_BEGIN(base + 1)
    if (PHON(1)) phase_gemm<0>(p, l, smem);
  PHASE_END
  PHASE_BEGIN(base + 2)
    if (PHON(2)) {
      for (int item = blockIdx.x; item < 2304; item += gridDim.x) {
        if (item < 512) sg_item(p, l, item, smem);
        else if (item < 1024) rwkv_prep_item(p, l, item - 512, smem);
        else if (item < 2048) s5a_item(p, l, item - 1024);
        else conv_item(p, l, item - 2048);
      }
    }
  PHASE_END
  PHASE_BEGIN(base + 3)
    if (PHON(3)) {
      if ((int)blockIdx.x < 64) scan_item(p, blockIdx.x, smem);
      else for (int item = blockIdx.x - 64; item < 1024; item += gridDim.x - 64) s5b_item(p, l, item, smem);
    }
  PHASE_END
  PHASE_BEGIN(base + 4)
    if (PHON(4)) for (int item = blockIdx.x; item < 256; item += gridDim.x) rwkv_post_item(p, l, item);
  PHASE_END
  PHASE_BEGIN(base + 5)
    if (PHON(5)) phase_merge(p, smem);
  PHASE_END
  PHASE_BEGIN(base + 6)
    if (PHON(6)) phase_gemm<1>(p, l, smem);
  PHASE_END
  PHASE_BEGIN(base + 7)
    if (PHON(7)) phase_norm(p.out, p.in[38] + l * 1024, modl, 3072, 4096, (u16*)(p.ws + OFF_H));
  PHASE_END
  PHASE_BEGIN(base + 8)
    if (PHON(8)) phase_gemm<2>(p, l, smem);
  PHASE_END
  PHASE_BEGIN(base + 9)
    if (PHON(9)) phase_gemm<3>(p, l, smem);
  PHASE_END
}

__global__ void __launch_bounds__(NTHR, 2) mega_fwd(Params p, int ph_lo, int ph_hi) {
  __shared__ __attribute__((aligned(16))) unsigned char smem[65536];
  cg::grid_group grid = cg::this_grid();
  PHASE_BEGIN(0)
    if (PHON(10)) phase_mod(p, smem);
  PHASE_END
  run_layer<0>(p, ph_lo, ph_hi, smem, grid);
  run_layer<1>(p, ph_lo, ph_hi, smem, grid);
  PHASE_BEGIN(21)
    if (PHON(11)) phase_final(p.out, p.in[41]);
  PHASE_END
}

extern "C" void kernel_launch(void* const* d_in, const int* in_sizes, int n_in, void* d_out, int out_size, void* d_ws,
                              size_t ws_size, hipStream_t stream) {
  static int grid_blocks = 0;
  if (!grid_blocks) {
    int dev = 0, cus = 0, per_cu = 0;
    hipGetDevice(&dev);
    hipDeviceGetAttribute(&cus, hipDeviceAttributeMultiprocessorCount, dev);
    hipOccupancyMaxActiveBlocksPerMultiprocessor(&per_cu, mega_fwd, NTHR, 0);
    if (per_cu > 2) per_cu = 2;
    if (per_cu < 1) per_cu = 1;
    grid_blocks = cus * per_cu;
    if (ws_size < WS_END) fprintf(stderr, "workspace too small: %zu < %zu\n", ws_size, (size_t)WS_END);
  }
  Params p{};
  for (int i = 0; i < 42; ++i) p.in[i] = (const float*)d_in[i];
  p.out = (float*)d_out;
  p.ws = (unsigned char*)d_ws;
  int lo = 0, hi = N_PHASES;
  void* args[] = {&p, &lo, &hi};
  hipError_t e = hipLaunchCooperativeKernel((void*)mega_fwd, dim3(grid_blocks), dim3(NTHR), args, 0, stream);
  if (e != hipSuccess) fprintf(stderr, "cooperative launch failed: %s (grid %d)\n", hipGetErrorString(e), grid_blocks);
}
```

```cpp
#include <hip/hip_runtime.h>
#include <hip/hip_cooperative_groups.h>
#include <cstdio>
namespace cg = cooperative_groups;

typedef unsigned short u16;
using bf16x8 = __attribute__((ext_vector_type(8))) short;
using f32x4 = __attribute__((ext_vector_type(4))) float;
using u32x4 = __attribute__((ext_vector_type(4))) unsigned int;
using u32x2 = __attribute__((ext_vector_type(2))) unsigned int;

#define T_TOK 16384
#define SEQ 4096
#define DM 1024
#define NTHR 256

static constexpr size_t SZ_WIN = (size_t)6528 * 1024 * 2;
static constexpr size_t OFF_WIN = 0;
static constexpr size_t OFF_RO = OFF_WIN + SZ_WIN;
static constexpr size_t OFF_SO = OFF_RO + 1024 * 256 * 2;
static constexpr size_t OFF_CO = OFF_SO + 1024 * 256 * 2;
static constexpr size_t OFF_GLU = OFF_CO + 1024 * 256 * 2;
static constexpr size_t OFF_WO = OFF_GLU + 2048 * 256 * 2;
static constexpr size_t OFF_W1 = OFF_WO + 1024 * 1024 * 2;
static constexpr size_t OFF_W2 = OFF_W1 + (size_t)4096 * 1024 * 2;
static constexpr size_t OFF_H = OFF_W2 + (size_t)4096 * 1024 * 2;
static constexpr size_t SZ_T256B = (size_t)T_TOK * 256 * 2;
static constexpr size_t OFF_VF = OFF_H + (size_t)T_TOK * 1024 * 2;
static constexpr size_t OFF_PD = OFF_VF + SZ_T256B;
static constexpr size_t OFF_G = OFF_PD + SZ_T256B;
static constexpr size_t OFF_UB = OFF_G + SZ_T256B;
static constexpr size_t OFF_CB = OFF_UB + SZ_T256B;
static constexpr size_t OFF_SR = OFF_CB + SZ_T256B;
static constexpr size_t OFF_SK = OFF_SR + SZ_T256B;
static constexpr size_t OFF_SV = OFF_SK + SZ_T256B;
static constexpr size_t OFF_SKK = OFF_SV + SZ_T256B;
static constexpr size_t OFF_SA = OFF_SKK + SZ_T256B;
static constexpr size_t OFF_SW = OFF_SA + SZ_T256B;
static constexpr size_t OFF_PABC = OFF_SW + 2 * SZ_T256B;
static constexpr size_t OFF_O = OFF_PABC;
static constexpr size_t OFF_YD = OFF_O + 2 * SZ_T256B;
static constexpr size_t OFF_OG = OFF_YD + SZ_T256B;
static constexpr size_t OFF_MRG = OFF_OG + SZ_T256B;
static constexpr size_t OFF_F = OFF_UB;
static constexpr size_t OFF_SMALL = OFF_PABC + (size_t)T_TOK * 2176 * 2;
static constexpr size_t OFF_MOD = OFF_SMALL;
static constexpr size_t OFF_S5AB = OFF_MOD + 2 * 4 * 6144 * 4;
static constexpr size_t OFF_S5BB = OFF_S5AB + 2 * 16 * 64 * 2 * 4;
static constexpr size_t OFF_S5E = OFF_S5BB + 2 * 16 * 64 * 32 * 4;
static constexpr size_t OFF_BAR = OFF_S5E + (size_t)4 * 64 * 16 * 64 * 2 * 4;
static constexpr size_t WS_END = OFF_BAR + 16384;
static_assert(OFF_F + (size_t)T_TOK * 4096 * 2 <= OFF_SMALL, "F overlaps small region");
static_assert(OFF_MRG + (size_t)T_TOK * 1024 * 2 <= OFF_SMALL, "MRG overlaps");

struct Params {
  const float* in[42];
  float* out;
  unsigned char* ws;
};

__device__ __forceinline__ u16 f2bf(float f) {
  unsigned u = __float_as_uint(f);
  u += 0x7fffu + ((u >> 16) & 1u);
  return (u16)(u >> 16);
}
__device__ __forceinline__ float bf2f(u16 h) { return __uint_as_float(((unsigned)h) << 16); }
__device__ __forceinline__ float bflo(unsigned u) { return __uint_as_float(u << 16); }
__device__ __forceinline__ float bfhi(unsigned u) { return __uint_as_float(u & 0xffff0000u); }
__device__ __forceinline__ unsigned pack2(float a, float b) { return (unsigned)f2bf(a) | ((unsigned)f2bf(b) << 16); }
__device__ __forceinline__ float sigmoidf_(float x) { return 1.f / (1.f + __expf(-x)); }
__device__ __forceinline__ float tanhf_(float y) { return 1.f - 2.f / (1.f + __expf(2.f * y)); }
__device__ __forceinline__ float geluf_(float x) {
  float y = 0.7978845608028654f * (x + 0.044715f * x * x * x);
  return 0.5f * x * (1.f + tanhf_(y));
}
__device__ __forceinline__ float wave_sum(float v) {
#pragma unroll
  for (int o = 32; o > 0; o >>= 1) v += __shfl_xor(v, o, 64);
  return v;
}
template <int CTRL>
__device__ __forceinline__ float dppf(float x) {
  return __int_as_float(__builtin_amdgcn_update_dpp(0, __float_as_int(x), CTRL, 0xF, 0xF, false));
}
__device__ __forceinline__ float row_sum16(float x) {
  x += dppf<0x128>(x);
  x += dppf<0x124>(x);
  x += dppf<0x122>(x);
  x += dppf<0x121>(x);
  return x;
}

__device__ __forceinline__ void phase_mod(const Params& p, unsigned char* smem) {
  const int tid = threadIdx.x;
  float* cact = (float*)smem;
  float* red = cact + 4096;
  float* mod = (float*)(p.ws + OFF_MOD);
  for (int i = tid; i < 4096; i += NTHR) { float c = p.in[1][i]; cact[i] = c / (1.f + __expf(-c)); }
  __syncthreads();
  for (int item = blockIdx.x; item < 192; item += gridDim.x) {
    int l = item / 96, nb = item % 96;
    int cl = tid & 63, kq = tid >> 6;
    int col = nb * 64 + cl;
    const float* W = p.in[2] + (size_t)l * 1024 * 6144;
    float a0 = 0, a1 = 0, a2 = 0, a3 = 0;
    for (int k = kq * 256; k < kq * 256 + 256; ++k) {
      float w = W[(size_t)k * 6144 + col];
      a0 += cact[k] * w; a1 += cact[1024 + k] * w; a2 += cact[2048 + k] * w; a3 += cact[3072 + k] * w;
    }
    red[(kq * 4 + 0) * 64 + cl] = a0; red[(kq * 4 + 1) * 64 + cl] = a1;
    red[(kq * 4 + 2) * 64 + cl] = a2; red[(kq * 4 + 3) * 64 + cl] = a3;
    __syncthreads();
    {
      int b = tid >> 6;
      float s = red[(0 * 4 + b) * 64 + cl] + red[(1 * 4 + b) * 64 + cl] + red[(2 * 4 + b) * 64 + cl] + red[(3 * 4 + b) * 64 + cl];
      mod[((size_t)l * 4 + b) * 6144 + col] = s + p.in[3][l * 6144 + col];
    }
    __syncthreads();
  }
  float* s5ab = (float*)(p.ws + OFF_S5AB);
  float* s5bb = (float*)(p.ws + OFF_S5BB);
  for (int idx = blockIdx.x * NTHR + tid; idx < 2048; idx += gridDim.x * NTHR) {
    int l = idx >> 10, g = (idx >> 6) & 15, n = idx & 63;
    double lre = fmin((double)p.in[28][idx], -1e-4);
    double lim = (double)p.in[29][idx];
    double dt = exp((double)p.in[35][l * 16 + g]);
    double mag = exp(lre * dt);
    double abr = mag * cos(lim * dt), abi = mag * sin(lim * dt);
    double den = lre * lre + lim * lim;
    double qr = ((abr - 1.0) * lre + abi * lim) / den;
    double qi = (abi * lre - (abr - 1.0) * lim) / den;
    s5ab[idx * 2 + 0] = (float)abr; s5ab[idx * 2 + 1] = (float)abi;
    for (int c = 0; c < 16; ++c) {
      double br = p.in[30][(size_t)idx * 16 + c], bi = p.in[31][(size_t)idx * 16 + c];
      s5bb[(size_t)idx * 32 + c] = (float)(qr * br - qi * bi);
      s5bb[(size_t)idx * 32 + 16 + c] = (float)(qr * bi + qi * br);
    }
  }
}

__device__ __forceinline__ void convert_tile(const float* __restrict__ src, int K, int N, u16* __restrict__ dst, int tk, int tn, u16* sm) {
  const int tid = threadIdx.x;
  int r = tid >> 4, c4 = (tid & 15) * 4;
#pragma unroll
  for (int i = 0; i < 4; ++i) {
    int kk = r + 16 * i;
    float4 v = *(const float4*)(src + (size_t)(tk * 64 + kk) * N + tn * 64 + c4);
    sm[(c4 + 0) * 72 + kk] = f2bf(v.x);
    sm[(c4 + 1) * 72 + kk] = f2bf(v.y);
    sm[(c4 + 2) * 72 + kk] = f2bf(v.z);
    sm[(c4 + 3) * 72 + kk] = f2bf(v.w);
  }
  __syncthreads();
#pragma unroll
  for (int j = 0; j < 2; ++j) {
    int n = (tid >> 3) + 32 * j, ch = tid & 7;
    u32x4 v = *(const u32x4*)(sm + n * 72 + ch * 8);
    *(u32x4*)(dst + (size_t)(tn * 64 + n) * K + tk * 64 + ch * 8) = v;
  }
  __syncthreads();
}

__device__ __forceinline__ void phase_convert(const Params& p, int l, unsigned char* smem) {
  u16* sm = (u16*)smem;
  const int total = 1632 + 192 + 128 + 256 + 1024 + 1024;
  for (int item = blockIdx.x; item < total; item += gridDim.x) {
    int t = item;
    const float* src; int K, N; size_t off;
    if (t < 1632) { src = p.in[5] + (size_t)l * 1024 * 6528; K = 1024; N = 6528; off = OFF_WIN; }
    else if ((t -= 1632) < 64) { src = p.in[20] + (size_t)l * 256 * 1024; K = 256; N = 1024; off = OFF_RO; }
    else if ((t -= 64) < 64) { src = p.in[25] + (size_t)l * 256 * 1024; K = 256; N = 1024; off = OFF_SO; }
    else if ((t -= 64) < 64) { src = p.in[27] + (size_t)l * 256 * 1024; K = 256; N = 1024; off = OFF_CO; }
    else if ((t -= 64) < 128) { src = p.in[36] + (size_t)l * 256 * 2048; K = 256; N = 2048; off = OFF_GLU; }
    else if ((t -= 128) < 256) { src = p.in[37] + (size_t)l * 1024 * 1024; K = 1024; N = 1024; off = OFF_WO; }
    else if ((t -= 256) < 1024) { src = p.in[39] + (size_t)l * 1024 * 4096; K = 1024; N = 4096; off = OFF_W1; }
    else { t -= 1024; src = p.in[40] + (size_t)l * 4096 * 1024; K = 4096; N = 1024; off = OFF_W2; }
    int ntn = N / 64;
    convert_tile(src, K, N, (u16*)(p.ws + off), t / ntn, t % ntn, sm);
  }
}

__device__ __forceinline__ void phase_norm(const float* __restrict__ X, const float* __restrict__ g, const float* __restrict__ modl,
                           int sh_off, int sc_off, u16* __restrict__ H) {
  const int lane = threadIdx.x & 63, wv = threadIdx.x >> 6;
  for (int item = blockIdx.x; item < T_TOK / 4; item += gridDim.x) {
    int row = item * 4 + wv;
    int b = row >> 12;
    const float* xr = X + (size_t)row * 1024;
    float4 v[4];
    float ss = 0;
#pragma unroll
    for (int i = 0; i < 4; ++i) {
      v[i] = *(const float4*)(xr + lane * 4 + 256 * i);
      ss += v[i].x * v[i].x + v[i].y * v[i].y + v[i].z * v[i].z + v[i].w * v[i].w;
    }
    ss = wave_sum(ss);
    float rstd = rsqrtf(ss * (1.f / 1024.f) + 1e-6f);
    const float* sh = modl + (size_t)b * 6144 + sh_off;
    const float* sc = modl + (size_t)b * 6144 + sc_off;
#pragma unroll
    for (int i = 0; i < 4; ++i) {
      int c = lane * 4 + 256 * i;
      float4 gg = *(const float4*)(g + c);
      float4 s1 = *(const float4*)(sc + c);
      float4 s0 = *(const float4*)(sh + c);
      float h0 = v[i].x * rstd * gg.x * (1.f + s1.x) + s0.x;
      float h1 = v[i].y * rstd * gg.y * (1.f + s1.y) + s0.y;
      float h2 = v[i].z * rstd * gg.z * (1.f + s1.z) + s0.z;
      float h3 = v[i].w * rstd * gg.w * (1.f + s1.w) + s0.w;
      u32x2 o; o.x = pack2(h0, h1); o.y = pack2(h2, h3);
      *(u32x2*)(H + (size_t)row * 1024 + c) = o;
    }
  }
}

__device__ __forceinline__ void phase_final(float* __restrict__ X, const float* __restrict__ g) {
  const int lane = threadIdx.x & 63, wv = threadIdx.x >> 6;
  for (int item = blockIdx.x; item < T_TOK / 4; item += gridDim.x) {
    int row = item * 4 + wv;
    float* xr = X + (size_t)row * 1024;
    float4 v[4];
    float ss = 0;
#pragma unroll
    for (int i = 0; i < 4; ++i) {
      v[i] = *(const float4*)(xr + lane * 4 + 256 * i);
      ss += v[i].x * v[i].x + v[i].y * v[i].y + v[i].z * v[i].z + v[i].w * v[i].w;
    }
    ss = wave_sum(ss);
    float rstd = rsqrtf(ss * (1.f / 1024.f) + 1e-6f);
#pragma unroll
    for (int i = 0; i < 4; ++i) {
      int c = lane * 4 + 256 * i;
      float4 gg = *(const float4*)(g + c);
      float4 o;
      o.x = v[i].x * rstd * gg.x; o.y = v[i].y * rstd * gg.y; o.z = v[i].z * rstd * gg.z; o.w = v[i].w * rstd * gg.w;
      *(float4*)(xr + c) = o;
    }
  }
}

template <int NF>
__device__ __forceinline__ void gemm_mainloop(const u16* __restrict__ A, int lda, const u16* __restrict__ B, int ldb,
                                              int K, f32x4 (&acc)[4][NF], u16* smem) {
  constexpr int BN = 32 * NF;
  constexpr int NB = BN / 32;
  u16* sA = smem;
  u16* sB = smem + 2 * 128 * 64;
  const int tid = threadIdx.x, lane = tid & 63, wv = tid >> 6;
  const int wm = wv >> 1, wn = wv & 1;
  u32x4 ra[4], rb[NB];
  const int lrow = tid >> 3, lch = tid & 7;
  const u16* Ap = A + (size_t)lrow * lda + lch * 8;
  const u16* Bp = B + (size_t)lrow * ldb + lch * 8;
  const int wofs = lrow * 64 + ((lch ^ ((lrow >> 1) & 7)) << 3);
  const int nk = K >> 6;
#pragma unroll
  for (int i = 0; i < 4; ++i) ra[i] = *(const u32x4*)(Ap + (size_t)(32 * i) * lda);
#pragma unroll
  for (int i = 0; i < NB; ++i) rb[i] = *(const u32x4*)(Bp + (size_t)(32 * i) * ldb);
  __syncthreads();
#pragma unroll
  for (int i = 0; i < 4; ++i) *(u32x4*)(sA + wofs + 32 * i * 64) = ra[i];
#pragma unroll
  for (int i = 0; i < NB; ++i) *(u32x4*)(sB + wofs + 32 * i * 64) = rb[i];
  __syncthreads();
  const int fr = lane & 15, fq = lane >> 4;
  const int sw = (fr >> 1) & 7;
  for (int kt = 0; kt < nk; ++kt) {
    const int cur = kt & 1;
    if (kt + 1 < nk) {
      const int ko = (kt + 1) << 6;
#pragma unroll
      for (int i = 0; i < 4; ++i) ra[i] = *(const u32x4*)(Ap + (size_t)(32 * i) * lda + ko);
#pragma unroll
      for (int i = 0; i < NB; ++i) rb[i] = *(const u32x4*)(Bp + (size_t)(32 * i) * ldb + ko);
    }
    const u16* cA = sA + cur * (128 * 64) + (wm * 64 + fr) * 64;
    const u16* cB = sB + cur * (BN * 64) + (wn * 16 * NF + fr) * 64;
#pragma unroll
    for (int ks = 0; ks < 2; ++ks) {
      const int pc = ((fq + 4 * ks) ^ sw) << 3;
      bf16x8 fa[4], fb[NF];
#pragma unroll
      for (int i = 0; i < 4; ++i) fa[i] = *(const bf16x8*)(cA + i * 16 * 64 + pc);
#pragma unroll
      for (int j = 0; j < NF; ++j) fb[j] = *(const bf16x8*)(cB + j * 16 * 64 + pc);
#pragma unroll
      for (int i = 0; i < 4; ++i)
#pragma unroll
        for (int j = 0; j < NF; ++j)
          acc[i][j] = __builtin_amdgcn_mfma_f32_16x16x32_bf16(fb[j], fa[i], acc[i][j], 0, 0, 0);
    }
    if (kt + 1 < nk) {
      const int nx = cur ^ 1;
#pragma unroll
      for (int i = 0; i < 4; ++i) *(u32x4*)(sA + nx * (128 * 64) + wofs + 32 * i * 64) = ra[i];
#pragma unroll
      for (int i = 0; i < NB; ++i) *(u32x4*)(sB + nx * (BN * 64) + wofs + 32 * i * 64) = rb[i];
    }
    __syncthreads();
  }
}

template <int NF>
__device__ __forceinline__ void zero_acc(f32x4 (&acc)[4][NF]) {
#pragma unroll
  for (int i = 0; i < 4; ++i)
#pragma unroll
    for (int j = 0; j < NF; ++j) acc[i][j] = f32x4{0.f, 0.f, 0.f, 0.f};
}

template <int EPI>
__device__ __forceinline__ void phase_gemm(const Params& p, int l, unsigned char* smem_raw) {
  u16* smem = (u16*)smem_raw;
  const int lane = threadIdx.x & 63, wv = threadIdx.x >> 6;
  const int wm = wv >> 1, wn = wv & 1;
  const int fr = lane & 15, fq = lane >> 4;
  const u16* A; const u16* B; int lda, ldb, K, ntiles_n;
  if (EPI == 0) { A = (const u16*)(p.ws + OFF_H); lda = 1024; B = (const u16*)(p.ws + OFF_WIN); ldb = 1024; K = 1024; ntiles_n = 19; }
  if (EPI == 1) { A = (const u16*)(p.ws + OFF_MRG); lda = 1024; B = (const u16*)(p.ws + OFF_WO); ldb = 1024; K = 1024; ntiles_n = 8; }
  if (EPI == 2) { A = (const u16*)(p.ws + OFF_H); lda = 1024; B = (const u16*)(p.ws + OFF_W1); ldb = 1024; K = 1024; ntiles_n = 32; }
  if (EPI == 3) { A = (const u16*)(p.ws + OFF_F); lda = 4096; B = (const u16*)(p.ws + OFF_W2); ldb = 4096; K = 4096; ntiles_n = 8; }
  const float* modl = (const float*)(p.ws + OFF_MOD) + (size_t)l * 4 * 6144;
  const int total = 128 * ntiles_n;
  for (int item = blockIdx.x; item < total; item += gridDim.x) {
    const int mt = item & 127, nt = item >> 7;
    const int m0 = mt * 128, n0 = nt * 128;
    f32x4 acc[4][4];
    zero_acc<4>(acc);
    gemm_mainloop<4>(A + (size_t)m0 * lda, lda, B + (size_t)n0 * ldb, ldb, K, acc, smem);
#pragma unroll
    for (int i = 0; i < 4; ++i) {
      const int m = m0 + wm * 64 + i * 16 + fr;
#pragma unroll
      for (int j = 0; j < 4; ++j) {
        const int n = n0 + wn * 64 + j * 16 + fq * 4;
        f32x4 v = acc[i][j];
        if (EPI == 0) {
          u32x2 o; o.x = pack2(v[0], v[1]); o.y = pack2(v[2], v[3]);
          if (n < 2176) *(u32x2*)((u16*)(p.ws + OFF_PABC) + (size_t)m * 2176 + n) = o;
          else *(u32x2*)((u16*)(p.ws + OFF_PD) + (size_t)m * 256 + (n - 2176)) = o;
        } else if (EPI == 1 || EPI == 3) {
          const int b = m >> 12;
          const float* gt = modl + (size_t)b * 6144 + (EPI == 1 ? 2048 : 5120) + n;
          const float* xin = ((EPI == 1 && l == 0) ? p.in[0] : p.out) + (size_t)m * 1024 + n;
          float4 x = *(const float4*)xin;
          float4 gg = *(const float4*)gt;
          float4 o;
          o.x = x.x + gg.x * v[0]; o.y = x.y + gg.y * v[1]; o.z = x.z + gg.z * v[2]; o.w = x.w + gg.w * v[3];
          *(float4*)(p.out + (size_t)m * 1024 + n) = o;
        } else {
          float r0 = fmaxf(v[0], 0.f), r1 = fmaxf(v[1], 0.f), r2 = fmaxf(v[2], 0.f), r3 = fmaxf(v[3], 0.f);
          u32x2 o; o.x = pack2(r0 * r0, r1 * r1); o.y = pack2(r2 * r2, r3 * r3);
          *(u32x2*)((u16*)(p.ws + OFF_F) + (size_t)m * 4096 + n) = o;
        }
      }
    }
  }
}

__device__ __forceinline__ void phase_merge(const Params& p, unsigned char* smem_raw) {
  u16* smem = (u16*)smem_raw;
  const int lane = threadIdx.x & 63, wv = threadIdx.x >> 6;
  const int wm = wv >> 1, wn = wv & 1;
  const int fr = lane & 15, fq = lane >> 4;
  const u16* H = (const u16*)(p.ws + OFF_H);
  const u16* WIN = (const u16*)(p.ws + OFF_WIN);
  for (int item = blockIdx.x; item < 128 * 16; item += gridDim.x) {
    const int mt = item & 127, nt = item >> 7;
    const int m0 = mt * 128, n0 = nt * 64;
    f32x4 macc[4][2], bacc[4][2], gacc[4][2];
    zero_acc<2>(macc);
#pragma unroll 1
    for (int br = 0; br < 4; ++br) {
      zero_acc<2>(bacc);
      const u16* Ab; const u16* Wb;
      if (br == 0) { Ab = (const u16*)(p.ws + OFF_OG); Wb = (const u16*)(p.ws + OFF_RO); }
      else if (br == 1) { Ab = (const u16*)(p.ws + OFF_UB); Wb = (const u16*)(p.ws + OFF_SO); }
      else if (br == 2) { Ab = (const u16*)(p.ws + OFF_CB); Wb = (const u16*)(p.ws + OFF_CO); }
      else { Ab = (const u16*)(p.ws + OFF_YD); Wb = (const u16*)(p.ws + OFF_GLU); }
      gemm_mainloop<2>(Ab + (size_t)m0 * 256, 256, Wb + (size_t)n0 * 256, 256, 256, bacc, smem);
      if (br == 3) {
        zero_acc<2>(gacc);
        gemm_mainloop<2>(Ab + (size_t)m0 * 256, 256, Wb + (size_t)(1024 + n0) * 256, 256, 256, gacc, smem);
#pragma unroll
        for (int i = 0; i < 4; ++i)
#pragma unroll
          for (int j = 0; j < 2; ++j)
#pragma unroll
            for (int e = 0; e < 4; ++e) bacc[i][j][e] *= sigmoidf_(gacc[i][j][e]);
      }
      zero_acc<2>(gacc);
      gemm_mainloop<2>(H + (size_t)m0 * 1024, 1024, WIN + (size_t)(2432 + br * 1024 + n0) * 1024, 1024, 1024, gacc, smem);
#pragma unroll
      for (int i = 0; i < 4; ++i)
#pragma unroll
        for (int j = 0; j < 2; ++j)
#pragma unroll
          for (int e = 0; e < 4; ++e) macc[i][j][e] += sigmoidf_(gacc[i][j][e]) * bacc[i][j][e];
    }
    u16* MRG = (u16*)(p.ws + OFF_MRG);
#pragma unroll
    for (int i = 0; i < 4; ++i) {
      const int m = m0 + wm * 64 + i * 16 + fr;
#pragma unroll
      for (int j = 0; j < 2; ++j) {
        const int n = n0 + wn * 32 + j * 16 + fq * 4;
        u32x2 o; o.x = pack2(macc[i][j][0], macc[i][j][1]); o.y = pack2(macc[i][j][2], macc[i][j][3]);
        *(u32x2*)(MRG + (size_t)m * 1024 + n) = o;
      }
    }
  }
}

__device__ __forceinline__ float shifted(const u16* __restrict__ P, int tok, int col, float mu) {
  float pv = bf2f(P[(size_t)tok * 2176 + col]);
  float pr = (tok & (SEQ - 1)) ? bf2f(P[(size_t)(tok - 1) * 2176 + col]) : 0.f;
  return pv + (pr - pv) * mu;
}

__device__ __forceinline__ void rwkv_prep_item(const Params& p, int l, int item, unsigned char* smem) {
  const int tid = threadIdx.x;
  float* sl = (float*)smem;
  float* sv = sl + 32 * 128;
  float* svl = sv + 32 * 256;
  const u16* P = (const u16*)(p.ws + OFF_PABC);
  const float* mu = p.in[6] + l * 896;
  const int tok0 = item * 32;
  for (int idx = tid; idx < 32 * 128; idx += NTHR) {
    int t = idx >> 7, ci = idx & 127;
    float v = shifted(P, tok0 + t, 768 + ci, mu[768 + ci]);
    if (ci < 32) v = tanhf_(v);
    else if (ci >= 64) v = sigmoidf_(v);
    sl[idx] = v;
  }
  if (l > 0) {
    float m = mu[512 + tid];
    for (int t = 0; t < 32; ++t) sv[t * 256 + tid] = shifted(P, tok0 + t, 512 + tid, m);
  }
  __syncthreads();
  if (l > 0) {
    const float* v1 = p.in[13];
    int t = tid >> 3, o4 = (tid & 7) * 4;
    float a0 = 0, a1 = 0, a2 = 0, a3 = 0;
    for (int k = 0; k < 256; ++k) {
      float s = sv[t * 256 + k];
      float4 w = *(const float4*)(v1 + k * 32 + o4);
      a0 += s * w.x; a1 += s * w.y; a2 += s * w.z; a3 += s * w.w;
    }
    svl[t * 32 + o4 + 0] = a0; svl[t * 32 + o4 + 1] = a1; svl[t * 32 + o4 + 2] = a2; svl[t * 32 + o4 + 3] = a3;
    __syncthreads();
  }
  const int j = tid;
  const float* w2 = p.in[8] + l * 32 * 256;
  const float* a2w = p.in[10] + l * 32 * 256;
  const float* g2 = p.in[11] + l * 64 * 256;
  const float* v2 = p.in[14];
  const float w0 = p.in[7][l * 256 + j], a0c = p.in[9][l * 256 + j];
  const float v0 = (l > 0) ? p.in[12][j] : 0.f;
  const float kkc = p.in[15][l * 256 + j], kac = p.in[16][l * 256 + j];
  const float mur = mu[j], muk = mu[256 + j], muv = mu[512 + j];
  u16* SR = (u16*)(p.ws + OFF_SR); u16* SK = (u16*)(p.ws + OFF_SK); u16* SV = (u16*)(p.ws + OFF_SV);
  u16* SKK = (u16*)(p.ws + OFF_SKK); u16* SA = (u16*)(p.ws + OFF_SA); float* SW = (float*)(p.ws + OFF_SW);
  u16* G = (u16*)(p.ws + OFF_G); u16* VF = (u16*)(p.ws + OFF_VF);
#pragma unroll 1
  for (int tg = 0; tg < 4; ++tg) {
    float accw[8], acca[8], accg[8], accv[8];
#pragma unroll
    for (int tt = 0; tt < 8; ++tt) { accw[tt] = 0; acca[tt] = 0; accg[tt] = 0; accv[tt] = 0; }
#pragma unroll 2
    for (int k4 = 0; k4 < 8; ++k4) {
      float ww[4], wa[4];
#pragma unroll
      for (int e = 0; e < 4; ++e) { ww[e] = w2[(k4 * 4 + e) * 256 + j]; wa[e] = a2w[(k4 * 4 + e) * 256 + j]; }
#pragma unroll
      for (int tt = 0; tt < 8; ++tt) {
        float4 s = *(const float4*)(sl + (tg * 8 + tt) * 128 + k4 * 4);
        float4 s2 = *(const float4*)(sl + (tg * 8 + tt) * 128 + 32 + k4 * 4);
        accw[tt] += s.x * ww[0] + s.y * ww[1] + s.z * ww[2] + s.w * ww[3];
        acca[tt] += s2.x * wa[0] + s2.y * wa[1] + s2.z * wa[2] + s2.w * wa[3];
      }
    }
#pragma unroll 2
    for (int k4 = 0; k4 < 16; ++k4) {
      float wg[4];
#pragma unroll
      for (int e = 0; e < 4; ++e) wg[e] = g2[(k4 * 4 + e) * 256 + j];
#pragma unroll
      for (int tt = 0; tt < 8; ++tt) {
        float4 s = *(const float4*)(sl + (tg * 8 + tt) * 128 + 64 + k4 * 4);
        accg[tt] += s.x * wg[0] + s.y * wg[1] + s.z * wg[2] + s.w * wg[3];
      }
    }
    if (l > 0) {
#pragma unroll 2
      for (int k4 = 0; k4 < 8; ++k4) {
        float wvv[4];
#pragma unroll
        for (int e = 0; e < 4; ++e) wvv[e] = v2[(k4 * 4 + e) * 256 + j];
#pragma unroll
        for (int tt = 0; tt < 8; ++tt) {
          float4 s = *(const float4*)(svl + (tg * 8 + tt) * 32 + k4 * 4);
          accv[tt] += s.x * wvv[0] + s.y * wvv[1] + s.z * wvv[2] + s.w * wvv[3];
        }
      }
    }
#pragma unroll
    for (int tt = 0; tt < 8; ++tt) {
      const int tok = tok0 + tg * 8 + tt;
      float r = shifted(P, tok, j, mur);
      float k = shifted(P, tok, 256 + j, muk);
      float v = shifted(P, tok, 512 + j, muv);
      float wl = w0 + accw[tt];
      float z = -wl;
      float sp = (z > 15.f) ? z : log1pf(__expf(z));
      float lw = -sp - 0.5f;
      float decay = __expf(-__expf(lw));
      float a = sigmoidf_(a0c + acca[tt]);
      float g = accg[tt];
      const size_t o = (size_t)tok * 256 + j;
      if (l == 0) {
        VF[o] = f2bf(v);
      } else {
        float vf = bf2f(VF[o]);
        v = v + (vf - v) * sigmoidf_(v0 + accv[tt]);
      }
      float kk = k * kkc;
      float ss = wave_sum(kk * kk);
      kk = kk / fmaxf(sqrtf(ss), 1e-12f);
      float km = k * (1.f + (a - 1.f) * kac);
      SR[o] = f2bf(r); SK[o] = f2bf(km); SV[o] = f2bf(v); SKK[o] = f2bf(kk); SA[o] = f2bf(a);
      SW[o] = decay; G[o] = f2bf(g);
    }
  }
  __syncthreads();
}

__device__ __forceinline__ void sg_item(const Params& p, int l, int item, unsigned char* smem) {
  const int tid = threadIdx.x, lane = tid & 63, wv = tid >> 6;
  float* vs = (float*)smem;
  float* smu = vs + 128 * 64;
  float* srs = smu + 128;
  const u16* P = (const u16*)(p.ws + OFF_PABC);
  const int g = item & 3, chn = item >> 2;
  const int tok0 = chn * 128;
  for (int i = 0; i < 32; ++i) {
    int t = wv * 32 + i;
    u32x2 raw = *(const u32x2*)(P + (size_t)(tok0 + t) * 2176 + 896 + 256 + lane * 4);
    float z0 = geluf_(bflo(raw.x)), z1 = geluf_(bfhi(raw.x)), z2 = geluf_(bflo(raw.y)), z3 = geluf_(bfhi(raw.y));
    float s = wave_sum(z0 + z1 + z2 + z3);
    float mean = s * (1.f / 256.f);
    float d0 = z0 - mean, d1 = z1 - mean, d2 = z2 - mean, d3 = z3 - mean;
    float var = wave_sum(d0 * d0 + d1 * d1 + d2 * d2 + d3 * d3) * (1.f / 256.f);
    if (lane == 0) { smu[t] = mean; srs[t] = rsqrtf(var + 1e-5f); }
  }
  __syncthreads();
  {
    const int c = tid & 63, tq = tid >> 6;
    const float lw = p.in[21][l * 256 + g * 64 + c], lb = p.in[22][l * 256 + g * 64 + c];
    for (int i = 0; i < 32; ++i) {
      int t = tq + 4 * i;
      float z = geluf_(bf2f(P[(size_t)(tok0 + t) * 2176 + 896 + 256 + g * 64 + c]));
      vs[t * 64 + c] = (z - smu[t]) * srs[t] * lw + lb;
    }
  }
  __syncthreads();
  {
    const int c = tid & 63;
    const int tq = __builtin_amdgcn_readfirstlane(tid >> 6);
    const float* Wg = p.in[23] + ((size_t)l * 4 + g) * 128 * 128;
    const float* bs = p.in[24] + ((size_t)l * 4 + g) * 128;
    u16* UB = (u16*)(p.ws + OFF_UB);
    for (int i = 0; i < 32; ++i) {
      const int t = tq + 4 * i;
      const float* Wrow = Wg + (size_t)t * 128;
      float acc = bs[t];
      const int n4 = (t >> 2) + 1;
      for (int s4 = 0; s4 < n4; ++s4) {
        float4 w = *(const float4*)(Wrow + s4 * 4);
        int s = s4 * 4;
        acc += w.x * vs[s * 64 + c];
        if (s + 1 <= t) acc += w.y * vs[(s + 1) * 64 + c];
        if (s + 2 <= t) acc += w.z * vs[(s + 2) * 64 + c];
        if (s + 3 <= t) acc += w.w * vs[(s + 3) * 64 + c];
      }
      float u = geluf_(bf2f(P[(size_t)(tok0 + t) * 2176 + 896 + g * 64 + c]));
      UB[(size_t)(tok0 + t) * 256 + g * 64 + c] = f2bf(u * acc);
    }
  }
  __syncthreads();
}

__device__ __forceinline__ void conv_item(const Params& p, int l, int item) {
  const int j = threadIdx.x;
  const u16* P = (const u16*)(p.ws + OFF_PABC);
  u16* CB = (u16*)(p.ws + OFF_CB);
  const float c0 = p.in[26][(l * 3 + 0) * 256 + j], c1 = p.in[26][(l * 3 + 1) * 256 + j], c2 = p.in[26][(l * 3 + 2) * 256 + j];
  const int tok0 = item * 64;
  float z2 = 0.f, z1 = 0.f;
  if (tok0 & (SEQ - 1)) {
    const u16* q2 = P + (size_t)(tok0 - 2) * 2176 + 1408;
    const u16* q1 = P + (size_t)(tok0 - 1) * 2176 + 1408;
    z2 = bf2f(q2[256 + j]) * bf2f(q2[512 + j]);
    z1 = bf2f(q1[256 + j]) * bf2f(q1[512 + j]);
  }
  for (int t = 0; t < 64; ++t) {
    const u16* q = P + (size_t)(tok0 + t) * 2176 + 1408;
    float bg = bf2f(q[j]);
    float z = bf2f(q[256 + j]) * bf2f(q[512 + j]);
    float y = c0 * z2 + c1 * z1 + c2 * z;
    CB[(size_t)(tok0 + t) * 256 + j] = f2bf(bg * y);
    z2 = z1; z1 = z;
  }
}

__device__ __forceinline__ void s5_load_u(const u16* __restrict__ PD, int tok, int g, float (&u)[16]) {
  const u32x4* q = (const u32x4*)(PD + (size_t)tok * 256 + g * 16);
  u32x4 a = q[0], b = q[1];
  u[0] = bflo(a.x); u[1] = bfhi(a.x); u[2] = bflo(a.y); u[3] = bfhi(a.y);
  u[4] = bflo(a.z); u[5] = bfhi(a.z); u[6] = bflo(a.w); u[7] = bfhi(a.w);
  u[8] = bflo(b.x); u[9] = bfhi(b.x); u[10] = bflo(b.y); u[11] = bfhi(b.y);
  u[12] = bflo(b.z); u[13] = bfhi(b.z); u[14] = bflo(b.w); u[15] = bfhi(b.w);
}

__device__ __forceinline__ void s5a_item(const Params& p, int l, int item) {
  const int lane = threadIdx.x & 63, wv = threadIdx.x >> 6;
  const int gq = item & 3, bc = item >> 2;
  const int g = gq * 4 + wv;
  const int tok0 = bc * 64;
  const u16* PD = (const u16*)(p.ws + OFF_PD);
  const float* ab = (const float*)(p.ws + OFF_S5AB) + ((size_t)(l * 16 + g) * 64 + lane) * 2;
  const float* bb = (const float*)(p.ws + OFF_S5BB) + ((size_t)(l * 16 + g) * 64 + lane) * 32;
  float bbr[16], bbi[16];
#pragma unroll
  for (int c = 0; c < 16; ++c) { bbr[c] = bb[c]; bbi[c] = bb[16 + c]; }
  const float abr = ab[0], abi = ab[1];
  float xr = 0.f, xi = 0.f;
  for (int t = 0; t < 64; ++t) {
    float u[16];
    s5_load_u(PD, tok0 + t, g, u);
    float bur = 0.f, bui = 0.f;
#pragma unroll
    for (int c = 0; c < 16; ++c) { bur += bbr[c] * u[c]; bui += bbi[c] * u[c]; }
    float nr = abr * xr - abi * xi + bur;
    float ni = abr * xi + abi * xr + bui;
    xr = nr; xi = ni;
  }
  float2* E = (float2*)(p.ws + OFF_S5E);
  E[((size_t)bc * 16 + g) * 64 + lane] = make_float2(xr, xi);
}

__device__ __forceinline__ void s5b_item(const Params& p, int l, int item, unsigned char* smem) {
  const int lane = threadIdx.x & 63, wv = threadIdx.x >> 6;
  const int gq = item & 3, bc = item >> 2;
  const int b = bc >> 6, ch = bc & 63;
  const int g = gq * 4 + wv;
  const int tok0 = bc * 64;
  float* base = (float*)smem + wv * 4096;
  float* csr = base, *csi = base + 1024, *xsr = base + 2048, *xsi = base + 3072;
  const u16* PD = (const u16*)(p.ws + OFF_PD);
  const float* ab = (const float*)(p.ws + OFF_S5AB) + ((size_t)(l * 16 + g) * 64 + lane) * 2;
  const float* bb = (const float*)(p.ws + OFF_S5BB) + ((size_t)(l * 16 + g) * 64 + lane) * 32;
  const float* cre = p.in[32] + ((size_t)(l * 16 + g) * 16) * 64;
  const float* cim = p.in[33] + ((size_t)(l * 16 + g) * 16) * 64;
  for (int c = 0; c < 16; ++c) {
    csr[(lane >> 2) * 64 + c * 4 + (lane & 3)] = cre[c * 64 + lane];
    csi[(lane >> 2) * 64 + c * 4 + (lane & 3)] = cim[c * 64 + lane];
  }
  float bbr[16], bbi[16];
#pragma unroll
  for (int c = 0; c < 16; ++c) { bbr[c] = bb[c]; bbi[c] = bb[16 + c]; }
  const float abr = ab[0], abi = ab[1];
  float pr = abr, pi = abi;
#pragma unroll
  for (int s = 0; s < 6; ++s) { float nr = pr * pr - pi * pi, ni = 2.f * pr * pi; pr = nr; pi = ni; }
  float xr = 0.f, xi = 0.f;
  const float2* E = (const float2*)(p.ws + OFF_S5E);
  for (int c = 0; c < ch; ++c) {
    float2 e = E[((size_t)(b * 64 + c) * 16 + g) * 64 + lane];
    float nr = pr * xr - pi * xi + e.x;
    float ni = pr * xi + pi * xr + e.y;
    xr = nr; xi = ni;
  }
  const int tt = lane & 15, cq = lane >> 4;
  const float* dvec = p.in[34] + l * 256 + g * 16 + cq * 4;
  const float d0 = dvec[0], d1 = dvec[1], d2 = dvec[2], d3 = dvec[3];
  u16* YD = (u16*)(p.ws + OFF_YD);
  const int n4w = lane >> 2, e4 = lane & 3;
#pragma unroll 1
  for (int sc = 0; sc < 4; ++sc) {
    for (int t = 0; t < 16; ++t) {
      float u[16];
      s5_load_u(PD, tok0 + sc * 16 + t, g, u);
      float bur = 0.f, bui = 0.f;
#pragma unroll
      for (int c = 0; c < 16; ++c) { bur += bbr[c] * u[c]; bui += bbi[c] * u[c]; }
      float nr = abr * xr - abi * xi + bur;
      float ni = abr * xi + abi * xr + bui;
      xr = nr; xi = ni;
      int a = n4w * 64 + ((t ^ (n4w & 7)) << 2) + e4;
      xsr[a] = xr; xsi[a] = xi;
    }
    __syncthreads();
    float acc0 = 0.f, acc1 = 0.f, acc2 = 0.f, acc3 = 0.f;
#pragma unroll 2
    for (int n4 = 0; n4 < 16; ++n4) {
      int xa = n4 * 64 + ((tt ^ (n4 & 7)) << 2);
      float4 xr4 = *(const float4*)(xsr + xa);
      float4 xi4 = *(const float4*)(xsi + xa);
      const float* cr = csr + n4 * 64 + cq * 16;
      const float* ci = csi + n4 * 64 + cq * 16;
      float4 r0 = *(const float4*)(cr), r1 = *(const float4*)(cr + 4), r2 = *(const float4*)(cr + 8), r3 = *(const float4*)(cr + 12);
      float4 i0 = *(const float4*)(ci), i1 = *(const float4*)(ci + 4), i2 = *(const float4*)(ci + 8), i3 = *(const float4*)(ci + 12);
      acc0 += r0.x * xr4.x + r0.y * xr4.y + r0.z * xr4.z + r0.w * xr4.w - (i0.x * xi4.x + i0.y * xi4.y + i0.z * xi4.z + i0.w * xi4.w);
      acc1 += r1.x * xr4.x + r1.y * xr4.y + r1.z * xr4.z + r1.w * xr4.w - (i1.x * xi4.x + i1.y * xi4.y + i1.z * xi4.z + i1.w * xi4.w);
      acc2 += r2.x * xr4.x + r2.y * xr4.y + r2.z * xr4.z + r2.w * xr4.w - (i2.x * xi4.x + i2.y * xi4.y + i2.z * xi4.z + i2.w * xi4.w);
      acc3 += r3.x * xr4.x + r3.y * xr4.y + r3.z * xr4.z + r3.w * xr4.w - (i3.x * xi4.x + i3.y * xi4.y + i3.z * xi4.z + i3.w * xi4.w);
    }
    {
      const int tok = tok0 + sc * 16 + tt;
      u32x2 ur = *(const u32x2*)(PD + (size_t)tok * 256 + g * 16 + cq * 4);
      float y0 = acc0 + d0 * bflo(ur.x), y1 = acc1 + d1 * bfhi(ur.x), y2 = acc2 + d2 * bflo(ur.y), y3 = acc3 + d3 * bfhi(ur.y);
      u32x2 o; o.x = pack2(geluf_(y0), geluf_(y1)); o.y = pack2(geluf_(y2), geluf_(y3));
      *(u32x2*)(YD + (size_t)tok * 256 + g * 16 + cq * 4) = o;
    }
    __syncthreads();
  }
}

__device__ __forceinline__ void scan_item(const Params& p, int item, unsigned char* smem) {
  const int tid = threadIdx.x, lane = tid & 63, wv = tid >> 6;
  const int b = item >> 4, h = (item >> 2) & 3, q = item & 3;
  const int rl = lane >> 4, cl = lane & 15;
  const int rloc = wv * 4 + rl;
  const int rowi = q * 16 + rloc;
  const size_t tokb = (size_t)b * SEQ;
  const int chan0 = h * 64;
  const u16* SR = (const u16*)(p.ws + OFF_SR); const u16* SK = (const u16*)(p.ws + OFF_SK);
  const u16* SV = (const u16*)(p.ws + OFF_SV); const u16* SKK = (const u16*)(p.ws + OFF_SKK);
  const u16* SA = (const u16*)(p.ws + OFF_SA); const float* SW = (const float*)(p.ws + OFF_SW);
  float* O = (float*)(p.ws + OFF_O);
  constexpr int BUFB = 25600;
  const int st = tid >> 3, part = tid & 7;
  u32x4 gr, gk, gkk, ga, gw0, gw1, gv;
  auto gload = [&](int c) {
    size_t o = (tokb + (size_t)c * 32 + st) * 256 + chan0 + part * 8;
    gr = *(const u32x4*)(SR + o); gk = *(const u32x4*)(SK + o); gkk = *(const u32x4*)(SKK + o); ga = *(const u32x4*)(SA + o);
    {
      int i0 = tid, i1 = tid + 256;
      gw0 = *(const u32x4*)(SW + (tokb + (size_t)c * 32 + (i0 >> 4)) * 256 + chan0 + (i0 & 15) * 4);
      gw1 = *(const u32x4*)(SW + (tokb + (size_t)c * 32 + (i1 >> 4)) * 256 + chan0 + (i1 & 15) * 4);
    }
    if (tid < 64) gv = *(const u32x4*)(SV + (tokb + (size_t)c * 32 + (tid >> 1)) * 256 + chan0 + q * 16 + (tid & 1) * 8);
  };
  auto lwrite = [&](int buf) {
    unsigned char* bp = smem + buf * BUFB;
    *(u32x4*)(bp + 0 * 4096 + tid * 16) = gr;
    *(u32x4*)(bp + 1 * 4096 + tid * 16) = gk;
    *(u32x4*)(bp + 2 * 4096 + tid * 16) = gkk;
    *(u32x4*)(bp + 3 * 4096 + tid * 16) = ga;
    *(u32x4*)(bp + 16384 + tid * 16) = gw0;
    *(u32x4*)(bp + 16384 + (tid + 256) * 16) = gw1;
    if (tid < 64) *(u32x4*)(bp + 24576 + tid * 16) = gv;
  };
  gload(0);
  __syncthreads();
  lwrite(0);
  __syncthreads();
  float S0 = 0.f, S1 = 0.f, S2 = 0.f, S3 = 0.f;
#pragma unroll 1
  for (int c = 0; c < SEQ / 32; ++c) {
    if (c + 1 < SEQ / 32) gload(c + 1);
    const unsigned char* bp = smem + (c & 1) * BUFB;
    float* optr = O + (tokb + (size_t)c * 32) * 256 + chan0 + rowi;
#pragma unroll 4
    for (int s = 0; s < 32; ++s) {
      u32x2 r2 = *(const u32x2*)(bp + 0 * 4096 + s * 128 + cl * 8);
      u32x2 k2 = *(const u32x2*)(bp + 1 * 4096 + s * 128 + cl * 8);
      u32x2 q2 = *(const u32x2*)(bp + 2 * 4096 + s * 128 + cl * 8);
      u32x2 a2 = *(const u32x2*)(bp + 3 * 4096 + s * 128 + cl * 8);
      float4 w4 = *(const float4*)(bp + 16384 + s * 256 + cl * 16);
      float v = bf2f(*(const u16*)(bp + 24576 + s * 32 + rloc * 2));
      float kk0 = bflo(q2.x), kk1 = bfhi(q2.x), kk2 = bflo(q2.y), kk3 = bfhi(q2.y);
      float sa = S0 * kk0 + S1 * kk1 + S2 * kk2 + S3 * kk3;
      sa = row_sum16(sa);
      float b0 = kk0 * bflo(a2.x), b1 = kk1 * bfhi(a2.x), b2 = kk2 * bflo(a2.y), b3 = kk3 * bfhi(a2.y);
      float u0 = v * bflo(k2.x) - sa * b0, u1 = v * bfhi(k2.x) - sa * b1, u2 = v * bflo(k2.y) - sa * b2, u3 = v * bfhi(k2.y) - sa * b3;
      S0 = S0 * w4.x + u0; S1 = S1 * w4.y + u1; S2 = S2 * w4.z + u2; S3 = S3 * w4.w + u3;
      float os = S0 * bflo(r2.x) + S1 * bfhi(r2.x) + S2 * bflo(r2.y) + S3 * bfhi(r2.y);
      os = row_sum16(os);
      if (cl == 0) optr[(size_t)s * 256] = os;
    }
    if (c + 1 < SEQ / 32) lwrite((c + 1) & 1);
    __syncthreads();
  }
}

__device__ __forceinline__ void rwkv_post_item(const Params& p, int l, int item) {
  const int j = threadIdx.x;
  const float* O = (const float*)(p.ws + OFF_O);
  const u16* SR = (const u16*)(p.ws + OFF_SR); const u16* SK = (const u16*)(p.ws + OFF_SK);
  const u16* SV = (const u16*)(p.ws + OFF_SV); const u16* G = (const u16*)(p.ws + OFF_G);
  u16* OG = (u16*)(p.ws + OFF_OG);
  const float lw = p.in[18][l * 256 + j], lb = p.in[19][l * 256 + j], rk = p.in[17][l * 256 + j];
  const int tok0 = item * 64;
  for (int t = 0; t < 64; ++t) {
    const size_t o = (size_t)(tok0 + t) * 256 + j;
    float ov = O[o];
    float mean = wave_sum(ov) * (1.f / 64.f);
    float d = ov - mean;
    float var = wave_sum(d * d) * (1.f / 64.f);
    float on = d * rsqrtf(var + 64e-5f) * lw + lb;
    float r = bf2f(SR[o]), k = bf2f(SK[o]), v = bf2f(SV[o]), g = bf2f(G[o]);
    float bonus = wave_sum(r * k * rk);
    OG[o] = f2bf((on + bonus * v) * g);
  }
}


#define XB_TMO      128
#define XB_XCNT(j)  (256  + 64 * (j))
#define XB_XSUB(j)  (1280 + 64 * (j))
#define XB_XGEN(j)  (2304 + 64 * (j))
#define XB_TOP      3328
#define XB_TOPGEN   3392
#define XCD_BAR_WORDS 3456
#define XB_SPIN_CAP (1u << 22)
#define LAS __attribute__((address_space(3)))
__device__ __forceinline__ unsigned xb_ld(unsigned* p) { return __hip_atomic_load(p, __ATOMIC_RELAXED, __HIP_MEMORY_SCOPE_AGENT); }
__device__ __forceinline__ unsigned xb_add(unsigned* p, unsigned v) { return __hip_atomic_fetch_add(p, v, __ATOMIC_RELAXED, __HIP_MEMORY_SCOPE_AGENT); }
__device__ __forceinline__ unsigned xb_xcc_id() { return (unsigned)__builtin_amdgcn_s_getreg((3 << 11) | 20) & 0xFu; }
#define XB_SPIN(cond, bar) do { unsigned _sp = 0; while (cond) { __builtin_amdgcn_s_sleep(1); \
    if ((++_sp & 255u) == 0u) { if (xb_ld(&(bar)[XB_TMO])) break; if (_sp > XB_SPIN_CAP) { atomicAdd(&(bar)[XB_TMO], 1u); break; } } } } while (0)
struct XcdBarrier { unsigned* bar; unsigned x; volatile LAS unsigned* st; };
__device__ __forceinline__ XcdBarrier xcd_barrier_post(unsigned* bar, volatile LAS unsigned* st) {
  XcdBarrier b; b.bar = bar; b.x = xb_xcc_id(); b.st = st;
  if (threadIdx.x == 0) (void)xb_add(&bar[XB_XCNT(b.x)], 1u);
  return b;
}
__device__ __forceinline__ void xcd_barrier_complete(unsigned* bar, unsigned x, unsigned& nloc, unsigned& nx) {
  const unsigned G = gridDim.x * gridDim.y * gridDim.z;
  unsigned sum, cnt, mine, sp = 0u;
  for (;;) {
    sum = 0u; cnt = 0u; mine = 0u;
#pragma unroll
    for (unsigned j = 0; j < 16; ++j) { const unsigned c = xb_ld(&bar[XB_XCNT(j)]); sum += c; cnt += (c > 0u) ? 1u : 0u; mine = (j == x) ? c : mine; }
    if (sum == G) break;
    __builtin_amdgcn_s_sleep(1);
    if ((++sp & 255u) == 0u) { if (xb_ld(&bar[XB_TMO])) break; if (sp > XB_SPIN_CAP) { atomicAdd(&bar[XB_TMO], 1u); break; } }
  }
  nloc = mine > 0u ? mine : 1u; nx = cnt > 0u ? cnt : 1u;
}
__device__ __forceinline__ void xcd_barrier(const XcdBarrier& b) {
  asm volatile("s_waitcnt vmcnt(0)" ::: "memory");
  __syncthreads();
  if (threadIdx.x == 0) {
    unsigned* bar = b.bar;
    __builtin_amdgcn_s_waitcnt(0);
    unsigned nloc = b.st[0], nx = b.st[1];
    if (nloc == 0u) { xcd_barrier_complete(bar, b.x, nloc, nx); b.st[0] = nloc; b.st[1] = nx; }
    const unsigned old = xb_add(&bar[XB_XSUB(b.x)], 1u);
    const unsigned gen = old / nloc;
    if (old + 1u == (gen + 1u) * nloc) {
      __builtin_amdgcn_fence(__ATOMIC_RELEASE, "agent");
      asm volatile("s_waitcnt vmcnt(0)" ::: "memory");
      const unsigned og = xb_add(&bar[XB_TOP], 1u);
      const unsigned tg = og / nx;
      if (og + 1u == (tg + 1u) * nx) xb_add(&bar[XB_TOPGEN], 1u);
      else XB_SPIN(xb_ld(&bar[XB_TOPGEN]) == tg, bar);
      __builtin_amdgcn_fence(__ATOMIC_ACQUIRE, "agent");
      xb_add(&bar[XB_XGEN(b.x)], 1u);
      asm volatile("s_waitcnt vmcnt(0)" ::: "memory");
    } else {
      XB_SPIN(xb_ld(&bar[XB_XGEN(b.x)]) == gen, bar);
      __builtin_amdgcn_fence(__ATOMIC_ACQUIRE, "agent");
      asm volatile("s_waitcnt vmcnt(0)" ::: "memory");
    }
  }
  __syncthreads();
}

#define N_PHASES 22
#ifndef PH_MASK
#define PH_MASK 0xFFFFF
#endif
#define PHON(s) (PH_MASK & (1 << (s)))
#define PHASE_BEGIN(k) if (ph_lo <= (k) && (k) < ph_hi) { if ((k) > ph_lo) xcd_barrier(xb);
#define PHASE_END }

template <int L>
__device__ __forceinline__ void run_layer(const Params& p, int ph_lo, int ph_hi, unsigned char* smem, const XcdBarrier& xb) {
  constexpr int l = L;
  constexpr int base = 1 + 10 * L;
  const float* modl = (const float*)(p.ws + OFF_MOD) + (size_t)l * 4 * 6144;
  PHASE_BEGIN(base + 0)
    if (PHON(0)) {
      phase_convert(p, l, smem);
      phase_norm(l == 0 ? p.in[0] : p.out, p.in[4] + l * 1024, modl, 0, 1024, (u16*)(p.ws + OFF_H));
    }
  PHASE_END
  PHASE_BEGIN(base + 1)
    if (PHON(1)) phase_gemm<0>(p, l, smem);
  PHASE_END
  PHASE_BEGIN(base + 2)
    if (PHON(2)) {
      for (int item = blockIdx.x; item < 2304; item += gridDim.x) {
        if (item < 512) sg_item(p, l, item, smem);
        else if (item < 1024) rwkv_prep_item(p, l, item - 512, smem);
        else if (item < 2048) s5a_item(p, l, item - 1024);
        else conv_item(p, l, item - 2048);
      }
    }
  PHASE_END
  PHASE_BEGIN(base + 3)
    if (PHON(3)) {
      if ((int)blockIdx.x < 64) scan_item(p, blockIdx.x, smem);
      else for (int item = blockIdx.x - 64; item < 1024; item += gridDim.x - 64) s5b_item(p, l, item, smem);
    }
  PHASE_END
  PHASE_BEGIN(base + 4)
    if (PHON(4)) for (int item = blockIdx.x; item < 256; item += gridDim.x) rwkv_post_item(p, l, item);
  PHASE_END
  PHASE_BEGIN(base + 5)
    if (PHON(5)) phase_merge(p, smem);
  PHASE_END
  PHASE_BEGIN(base + 6)
    if (PHON(6)) phase_gemm<1>(p, l, smem);
  PHASE_END
  PHASE_BEGIN(base + 7)
    if (PHON(7)) phase_norm(p.out, p.in[38] + l * 1024, modl, 3072, 4096, (u16*)(p.ws + OFF_H));
  PHASE_END
  PHASE_BEGIN(base + 8)
    if (PHON(8)) phase_gemm<2>(p, l, smem);
  PHASE_END
  PHASE_BEGIN(base + 9)
    if (PHON(9)) phase_gemm<3>(p, l, smem);
  PHASE_END
}

__global__ void __launch_bounds__(NTHR, 2) mega_fwd(Params p, int ph_lo, int ph_hi) {
  __shared__ __attribute__((aligned(16))) unsigned char smem[65536 + 16];
  cg::grid_group grid = cg::this_grid();
  if (ph_hi < 0) grid.sync();
  volatile LAS unsigned* st = (volatile LAS unsigned*)(smem + 65536);
  if (threadIdx.x == 0) { st[0] = 0u; st[1] = 0u; }
  __syncthreads();
  const XcdBarrier xb = xcd_barrier_post((unsigned*)(p.ws + OFF_BAR), st);
  PHASE_BEGIN(0)
    if (PHON(10)) phase_mod(p, smem);
  PHASE_END
  run_layer<0>(p, ph_lo, ph_hi, smem, xb);
  run_layer<1>(p, ph_lo, ph_hi, smem, xb);
  PHASE_BEGIN(21)
    if (PHON(11)) phase_final(p.out, p.in[41]);
  PHASE_END
}

extern "C" void kernel_launch(void* const* d_in, const int* in_sizes, int n_in, void* d_out, int out_size, void* d_ws,
                              size_t ws_size, hipStream_t stream) {
  static int grid_blocks = 0;
  if (!grid_blocks) {
    int dev = 0, cus = 0, per_cu = 0;
    hipGetDevice(&dev);
    hipDeviceGetAttribute(&cus, hipDeviceAttributeMultiprocessorCount, dev);
    hipOccupancyMaxActiveBlocksPerMultiprocessor(&per_cu, mega_fwd, NTHR, 0);
    if (per_cu > 2) per_cu = 2;
    if (per_cu < 1) per_cu = 1;
    grid_blocks = cus * per_cu;
    if (ws_size < WS_END) fprintf(stderr, "workspace too small: %zu < %zu\n", ws_size, (size_t)WS_END);
  }
  Params p{};
  for (int i = 0; i < 42; ++i) p.in[i] = (const float*)d_in[i];
  p.out = (float*)d_out;
  p.ws = (unsigned char*)d_ws;
  hipMemsetAsync((unsigned char*)d_ws + OFF_BAR, 0, 16384, stream);
  int lo = 0, hi = N_PHASES;
  void* args[] = {&p, &lo, &hi};
  hipError_t e = hipLaunchCooperativeKernel((void*)mega_fwd, dim3(grid_blocks), dim3(NTHR), args, 0, stream);
  if (e != hipSuccess) fprintf(stderr, "cooperative launch failed: %s (grid %d)\n", hipGetErrorString(e), grid_blocks);
}
```

```cpp
#include <hip/hip_runtime.h>
#include <hip/hip_cooperative_groups.h>
#include <cstdio>
namespace cg = cooperative_groups;

typedef unsigned short u16;
using bf16x8 = __attribute__((ext_vector_type(8))) short;
using f32x4 = __attribute__((ext_vector_type(4))) float;
using u32x4 = __attribute__((ext_vector_type(4))) unsigned int;
using u32x2 = __attribute__((ext_vector_type(2))) unsigned int;

#define T_TOK 16384
#define SEQ 4096
#define DM 1024
#define NTHR 256

static constexpr size_t SZ_WIN = (size_t)6528 * 1024 * 2;
static constexpr size_t OFF_WIN = 0;
static constexpr size_t OFF_RO = OFF_WIN + SZ_WIN;
static constexpr size_t OFF_SO = OFF_RO + 1024 * 256 * 2;
static constexpr size_t OFF_CO = OFF_SO + 1024 * 256 * 2;
static constexpr size_t OFF_GLU = OFF_CO + 1024 * 256 * 2;
static constexpr size_t OFF_WO = OFF_GLU + 2048 * 256 * 2;
static constexpr size_t OFF_W1 = OFF_WO + 1024 * 1024 * 2;
static constexpr size_t OFF_W2 = OFF_W1 + (size_t)4096 * 1024 * 2;
static constexpr size_t OFF_H = OFF_W2 + (size_t)4096 * 1024 * 2;
static constexpr size_t SZ_T256B = (size_t)T_TOK * 256 * 2;
static constexpr size_t OFF_VF = OFF_H + (size_t)T_TOK * 1024 * 2;
static constexpr size_t OFF_PD = OFF_VF + SZ_T256B;
static constexpr size_t OFF_G = OFF_PD + SZ_T256B;
static constexpr size_t OFF_UB = OFF_G + SZ_T256B;
static constexpr size_t OFF_CB = OFF_UB + SZ_T256B;
static constexpr size_t OFF_SR = OFF_CB + SZ_T256B;
static constexpr size_t OFF_SK = OFF_SR + SZ_T256B;
static constexpr size_t OFF_SV = OFF_SK + SZ_T256B;
static constexpr size_t OFF_SKK = OFF_SV + SZ_T256B;
static constexpr size_t OFF_SA = OFF_SKK + SZ_T256B;
static constexpr size_t OFF_SW = OFF_SA + SZ_T256B;
static constexpr size_t OFF_PABC = OFF_SW + 2 * SZ_T256B;
static constexpr size_t OFF_O = OFF_PABC;
static constexpr size_t OFF_YD = OFF_O + 2 * SZ_T256B;
static constexpr size_t OFF_OG = OFF_YD + SZ_T256B;
static constexpr size_t OFF_MRG = OFF_OG + SZ_T256B;
static constexpr size_t OFF_F = OFF_UB;
static constexpr size_t OFF_SMALL = OFF_PABC + (size_t)T_TOK * 2176 * 2;
static constexpr size_t OFF_MOD = OFF_SMALL;
static constexpr size_t OFF_S5AB = OFF_MOD + 2 * 4 * 6144 * 4;
static constexpr size_t OFF_S5BB = OFF_S5AB + 2 * 16 * 64 * 2 * 4;
static constexpr size_t OFF_S5E = OFF_S5BB + 2 * 16 * 64 * 32 * 4;
static constexpr size_t OFF_BAR = OFF_S5E + (size_t)4 * 64 * 16 * 64 * 2 * 4;
static constexpr size_t WS_END = OFF_BAR + 16384;
static_assert(OFF_F + (size_t)T_TOK * 4096 * 2 <= OFF_SMALL, "F overlaps small region");
static_assert(OFF_MRG + (size_t)T_TOK * 1024 * 2 <= OFF_SMALL, "MRG overlaps");

struct Params {
  const float* in[42];
  float* out;
  unsigned char* ws;
};

__device__ __forceinline__ u16 f2bf(float f) {
  unsigned u = __float_as_uint(f);
  u += 0x7fffu + ((u >> 16) & 1u);
  return (u16)(u >> 16);
}
__device__ __forceinline__ float bf2f(u16 h) { return __uint_as_float(((unsigned)h) << 16); }
__device__ __forceinline__ float bflo(unsigned u) { return __uint_as_float(u << 16); }
__device__ __forceinline__ float bfhi(unsigned u) { return __uint_as_float(u & 0xffff0000u); }
__device__ __forceinline__ unsigned pack2(float a, float b) { return (unsigned)f2bf(a) | ((unsigned)f2bf(b) << 16); }
__device__ __forceinline__ float sigmoidf_(float x) { return 1.f / (1.f + __expf(-x)); }
__device__ __forceinline__ float tanhf_(float y) { return 1.f - 2.f / (1.f + __expf(2.f * y)); }
__device__ __forceinline__ float geluf_(float x) {
  float y = 0.7978845608028654f * (x + 0.044715f * x * x * x);
  return 0.5f * x * (1.f + tanhf_(y));
}
__device__ __forceinline__ float wave_sum(float v) {
#pragma unroll
  for (int o = 32; o > 0; o >>= 1) v += __shfl_xor(v, o, 64);
  return v;
}
template <int CTRL>
__device__ __forceinline__ float dppf(float x) {
  return __int_as_float(__builtin_amdgcn_update_dpp(__float_as_int(x), __float_as_int(x), CTRL, 0xF, 0xF, true));
}
__device__ __forceinline__ float row_sum16(float x) {
  x += dppf<0x128>(x);
  x += dppf<0x124>(x);
  x += dppf<0x122>(x);
  x += dppf<0x121>(x);
  return x;
}

__device__ __forceinline__ void phase_mod(const Params& p, unsigned char* smem) {
  const int tid = threadIdx.x;
  float* cact = (float*)smem;
  float* red = cact + 4096;
  float* mod = (float*)(p.ws + OFF_MOD);
  for (int i = tid; i < 4096; i += NTHR) { float c = p.in[1][i]; cact[i] = c / (1.f + __expf(-c)); }
  __syncthreads();
  for (int item = blockIdx.x; item < 192; item += gridDim.x) {
    int l = item / 96, nb = item % 96;
    int cl = tid & 63, kq = tid >> 6;
    int col = nb * 64 + cl;
    const float* W = p.in[2] + (size_t)l * 1024 * 6144;
    float a0 = 0, a1 = 0, a2 = 0, a3 = 0;
    for (int k = kq * 256; k < kq * 256 + 256; ++k) {
      float w = W[(size_t)k * 6144 + col];
      a0 += cact[k] * w; a1 += cact[1024 + k] * w; a2 += cact[2048 + k] * w; a3 += cact[3072 + k] * w;
    }
    red[(kq * 4 + 0) * 64 + cl] = a0; red[(kq * 4 + 1) * 64 + cl] = a1;
    red[(kq * 4 + 2) * 64 + cl] = a2; red[(kq * 4 + 3) * 64 + cl] = a3;
    __syncthreads();
    {
      int b = tid >> 6;
      float s = red[(0 * 4 + b) * 64 + cl] + red[(1 * 4 + b) * 64 + cl] + red[(2 * 4 + b) * 64 + cl] + red[(3 * 4 + b) * 64 + cl];
      mod[((size_t)l * 4 + b) * 6144 + col] = s + p.in[3][l * 6144 + col];
    }
    __syncthreads();
  }
  float* s5ab = (float*)(p.ws + OFF_S5AB);
  float* s5bb = (float*)(p.ws + OFF_S5BB);
  for (int idx = blockIdx.x * NTHR + tid; idx < 2048; idx += gridDim.x * NTHR) {
    int l = idx >> 10, g = (idx >> 6) & 15, n = idx & 63;
    double lre = fmin((double)p.in[28][idx], -1e-4);
    double lim = (double)p.in[29][idx];
    double dt = exp((double)p.in[35][l * 16 + g]);
    double mag = exp(lre * dt);
    double abr = mag * cos(lim * dt), abi = mag * sin(lim * dt);
    double den = lre * lre + lim * lim;
    double qr = ((abr - 1.0) * lre + abi * lim) / den;
    double qi = (abi * lre - (abr - 1.0) * lim) / den;
    s5ab[idx * 2 + 0] = (float)abr; s5ab[idx * 2 + 1] = (float)abi;
    for (int c = 0; c < 16; ++c) {
      double br = p.in[30][(size_t)idx * 16 + c], bi = p.in[31][(size_t)idx * 16 + c];
      s5bb[(size_t)idx * 32 + c] = (float)(qr * br - qi * bi);
      s5bb[(size_t)idx * 32 + 16 + c] = (float)(qr * bi + qi * br);
    }
  }
}

__device__ __forceinline__ void convert_tile(const float* __restrict__ src, int K, int N, u16* __restrict__ dst, int tk, int tn, u16* sm) {
  const int tid = threadIdx.x;
  int r = tid >> 4, c4 = (tid & 15) * 4;
#pragma unroll
  for (int i = 0; i < 4; ++i) {
    int kk = r + 16 * i;
    float4 v = *(const float4*)(src + (size_t)(tk * 64 + kk) * N + tn * 64 + c4);
    sm[(c4 + 0) * 72 + kk] = f2bf(v.x);
    sm[(c4 + 1) * 72 + kk] = f2bf(v.y);
    sm[(c4 + 2) * 72 + kk] = f2bf(v.z);
    sm[(c4 + 3) * 72 + kk] = f2bf(v.w);
  }
  __syncthreads();
#pragma unroll
  for (int j = 0; j < 2; ++j) {
    int n = (tid >> 3) + 32 * j, ch = tid & 7;
    u32x4 v = *(const u32x4*)(sm + n * 72 + ch * 8);
    *(u32x4*)(dst + (size_t)(tn * 64 + n) * K + tk * 64 + ch * 8) = v;
  }
  __syncthreads();
}

__device__ __forceinline__ void phase_convert(const Params& p, int l, unsigned char* smem) {
  u16* sm = (u16*)smem;
  const int total = 1632 + 192 + 128 + 256 + 1024 + 1024;
  for (int item = blockIdx.x; item < total; item += gridDim.x) {
    int t = item;
    const float* src; int K, N; size_t off;
    if (t < 1632) { src = p.in[5] + (size_t)l * 1024 * 6528; K = 1024; N = 6528; off = OFF_WIN; }
    else if ((t -= 1632) < 64) { src = p.in[20] + (size_t)l * 256 * 1024; K = 256; N = 1024; off = OFF_RO; }
    else if ((t -= 64) < 64) { src = p.in[25] + (size_t)l * 256 * 1024; K = 256; N = 1024; off = OFF_SO; }
    else if ((t -= 64) < 64) { src = p.in[27] + (size_t)l * 256 * 1024; K = 256; N = 1024; off = OFF_CO; }
    else if ((t -= 64) < 128) { src = p.in[36] + (size_t)l * 256 * 2048; K = 256; N = 2048; off = OFF_GLU; }
    else if ((t -= 128) < 256) { src = p.in[37] + (size_t)l * 1024 * 1024; K = 1024; N = 1024; off = OFF_WO; }
    else if ((t -= 256) < 1024) { src = p.in[39] + (size_t)l * 1024 * 4096; K = 1024; N = 4096; off = OFF_W1; }
    else { t -= 1024; src = p.in[40] + (size_t)l * 4096 * 1024; K = 4096; N = 1024; off = OFF_W2; }
    int ntn = N / 64;
    convert_tile(src, K, N, (u16*)(p.ws + off), t / ntn, t % ntn, sm);
  }
}

__device__ __forceinline__ void phase_norm(const float* __restrict__ X, const float* __restrict__ g, const float* __restrict__ modl,
                           int sh_off, int sc_off, u16* __restrict__ H) {
  const int lane = threadIdx.x & 63, wv = threadIdx.x >> 6;
  for (int item = blockIdx.x; item < T_TOK / 4; item += gridDim.x) {
    int row = item * 4 + wv;
    int b = row >> 12;
    const float* xr = X + (size_t)row * 1024;
    float4 v[4];
    float ss = 0;
#pragma unroll
    for (int i = 0; i < 4; ++i) {
      v[i] = *(const float4*)(xr + lane * 4 + 256 * i);
      ss += v[i].x * v[i].x + v[i].y * v[i].y + v[i].z * v[i].z + v[i].w * v[i].w;
    }
    ss = wave_sum(ss);
    float rstd = rsqrtf(ss * (1.f / 1024.f) + 1e-6f);
    const float* sh = modl + (size_t)b * 6144 + sh_off;
    const float* sc = modl + (size_t)b * 6144 + sc_off;
#pragma unroll
    for (int i = 0; i < 4; ++i) {
      int c = lane * 4 + 256 * i;
      float4 gg = *(const float4*)(g + c);
      float4 s1 = *(const float4*)(sc + c);
      float4 s0 = *(const float4*)(sh + c);
      float h0 = v[i].x * rstd * gg.x * (1.f + s1.x) + s0.x;
      float h1 = v[i].y * rstd * gg.y * (1.f + s1.y) + s0.y;
      float h2 = v[i].z * rstd * gg.z * (1.f + s1.z) + s0.z;
      float h3 = v[i].w * rstd * gg.w * (1.f + s1.w) + s0.w;
      u32x2 o; o.x = pack2(h0, h1); o.y = pack2(h2, h3);
      *(u32x2*)(H + (size_t)row * 1024 + c) = o;
    }
  }
}

__device__ __forceinline__ void phase_final(float* __restrict__ X, const float* __restrict__ g) {
  const int lane = threadIdx.x & 63, wv = threadIdx.x >> 6;
  for (int item = blockIdx.x; item < T_TOK / 4; item += gridDim.x) {
    int row = item * 4 + wv;
    float* xr = X + (size_t)row * 1024;
    float4 v[4];
    float ss = 0;
#pragma unroll
    for (int i = 0; i < 4; ++i) {
      v[i] = *(const float4*)(xr + lane * 4 + 256 * i);
      ss += v[i].x * v[i].x + v[i].y * v[i].y + v[i].z * v[i].z + v[i].w * v[i].w;
    }
    ss = wave_sum(ss);
    float rstd = rsqrtf(ss * (1.f / 1024.f) + 1e-6f);
#pragma unroll
    for (int i = 0; i < 4; ++i) {
      int c = lane * 4 + 256 * i;
      float4 gg = *(const float4*)(g + c);
      float4 o;
      o.x = v[i].x * rstd * gg.x; o.y = v[i].y * rstd * gg.y; o.z = v[i].z * rstd * gg.z; o.w = v[i].w * rstd * gg.w;
      *(float4*)(xr + c) = o;
    }
  }
}

template <int NF>
__device__ __forceinline__ void gemm_mainloop(const u16* __restrict__ A, int lda, const u16* __restrict__ B, int ldb,
                                              int K, f32x4 (&acc)[4][NF], u16* smem) {
  constexpr int BN = 32 * NF;
  constexpr int NB = BN / 32;
  u16* sA = smem;
  u16* sB = smem + 2 * 128 * 64;
  const int tid = threadIdx.x, lane = tid & 63, wv = tid >> 6;
  const int wm = wv >> 1, wn = wv & 1;
  u32x4 ra[4], rb[NB];
  const int lrow = tid >> 3, lch = tid & 7;
  const u16* Ap = A + (size_t)lrow * lda + lch * 8;
  const u16* Bp = B + (size_t)lrow * ldb + lch * 8;
  const int wofs = lrow * 64 + ((lch ^ ((lrow >> 1) & 7)) << 3);
  const int nk = K >> 6;
#pragma unroll
  for (int i = 0; i < 4; ++i) ra[i] = *(const u32x4*)(Ap + (size_t)(32 * i) * lda);
#pragma unroll
  for (int i = 0; i < NB; ++i) rb[i] = *(const u32x4*)(Bp + (size_t)(32 * i) * ldb);
  __syncthreads();
#pragma unroll
  for (int i = 0; i < 4; ++i) *(u32x4*)(sA + wofs + 32 * i * 64) = ra[i];
#pragma unroll
  for (int i = 0; i < NB; ++i) *(u32x4*)(sB + wofs + 32 * i * 64) = rb[i];
  __syncthreads();
  const int fr = lane & 15, fq = lane >> 4;
  const int sw = (fr >> 1) & 7;
  for (int kt = 0; kt < nk; ++kt) {
    const int cur = kt & 1;
    if (kt + 1 < nk) {
      const int ko = (kt + 1) << 6;
#pragma unroll
      for (int i = 0; i < 4; ++i) ra[i] = *(const u32x4*)(Ap + (size_t)(32 * i) * lda + ko);
#pragma unroll
      for (int i = 0; i < NB; ++i) rb[i] = *(const u32x4*)(Bp + (size_t)(32 * i) * ldb + ko);
    }
    const u16* cA = sA + cur * (128 * 64) + (wm * 64 + fr) * 64;
    const u16* cB = sB + cur * (BN * 64) + (wn * 16 * NF + fr) * 64;
#pragma unroll
    for (int ks = 0; ks < 2; ++ks) {
      const int pc = ((fq + 4 * ks) ^ sw) << 3;
      bf16x8 fa[4], fb[NF];
#pragma unroll
      for (int i = 0; i < 4; ++i) fa[i] = *(const bf16x8*)(cA + i * 16 * 64 + pc);
#pragma unroll
      for (int j = 0; j < NF; ++j) fb[j] = *(const bf16x8*)(cB + j * 16 * 64 + pc);
#pragma unroll
      for (int i = 0; i < 4; ++i)
#pragma unroll
        for (int j = 0; j < NF; ++j)
          acc[i][j] = __builtin_amdgcn_mfma_f32_16x16x32_bf16(fb[j], fa[i], acc[i][j], 0, 0, 0);
    }
    if (kt + 1 < nk) {
      const int nx = cur ^ 1;
#pragma unroll
      for (int i = 0; i < 4; ++i) *(u32x4*)(sA + nx * (128 * 64) + wofs + 32 * i * 64) = ra[i];
#pragma unroll
      for (int i = 0; i < NB; ++i) *(u32x4*)(sB + nx * (BN * 64) + wofs + 32 * i * 64) = rb[i];
    }
    __syncthreads();
  }
}

template <int NF>
__device__ __forceinline__ void zero_acc(f32x4 (&acc)[4][NF]) {
#pragma unroll
  for (int i = 0; i < 4; ++i)
#pragma unroll
    for (int j = 0; j < NF; ++j) acc[i][j] = f32x4{0.f, 0.f, 0.f, 0.f};
}

template <int EPI>
__device__ __forceinline__ void phase_gemm(const Params& p, int l, unsigned char* smem_raw) {
  u16* smem = (u16*)smem_raw;
  const int lane = threadIdx.x & 63, wv = threadIdx.x >> 6;
  const int wm = wv >> 1, wn = wv & 1;
  const int fr = lane & 15, fq = lane >> 4;
  const u16* A; const u16* B; int lda, ldb, K, ntiles_n;
  if (EPI == 0) { A = (const u16*)(p.ws + OFF_H); lda = 1024; B = (const u16*)(p.ws + OFF_WIN); ldb = 1024; K = 1024; ntiles_n = 19; }
  if (EPI == 1) { A = (const u16*)(p.ws + OFF_MRG); lda = 1024; B = (const u16*)(p.ws + OFF_WO); ldb = 1024; K = 1024; ntiles_n = 8; }
  if (EPI == 2) { A = (const u16*)(p.ws + OFF_H); lda = 1024; B = (const u16*)(p.ws + OFF_W1); ldb = 1024; K = 1024; ntiles_n = 32; }
  if (EPI == 3) { A = (const u16*)(p.ws + OFF_F); lda = 4096; B = (const u16*)(p.ws + OFF_W2); ldb = 4096; K = 4096; ntiles_n = 8; }
  const float* modl = (const float*)(p.ws + OFF_MOD) + (size_t)l * 4 * 6144;
  const int total = 128 * ntiles_n;
  for (int item = blockIdx.x; item < total; item += gridDim.x) {
    const int mt = item & 127, nt = item >> 7;
    const int m0 = mt * 128, n0 = nt * 128;
    f32x4 acc[4][4];
    zero_acc<4>(acc);
    gemm_mainloop<4>(A + (size_t)m0 * lda, lda, B + (size_t)n0 * ldb, ldb, K, acc, smem);
#pragma unroll
    for (int i = 0; i < 4; ++i) {
      const int m = m0 + wm * 64 + i * 16 + fr;
#pragma unroll
      for (int j = 0; j < 4; ++j) {
        const int n = n0 + wn * 64 + j * 16 + fq * 4;
        f32x4 v = acc[i][j];
        if (EPI == 0) {
          u32x2 o; o.x = pack2(v[0], v[1]); o.y = pack2(v[2], v[3]);
          if (n < 2176) *(u32x2*)((u16*)(p.ws + OFF_PABC) + (size_t)m * 2176 + n) = o;
          else *(u32x2*)((u16*)(p.ws + OFF_PD) + (size_t)m * 256 + (n - 2176)) = o;
        } else if (EPI == 1 || EPI == 3) {
          const int b = m >> 12;
          const float* gt = modl + (size_t)b * 6144 + (EPI == 1 ? 2048 : 5120) + n;
          const float* xin = ((EPI == 1 && l == 0) ? p.in[0] : p.out) + (size_t)m * 1024 + n;
          float4 x = *(const float4*)xin;
          float4 gg = *(const float4*)gt;
          float4 o;
          o.x = x.x + gg.x * v[0]; o.y = x.y + gg.y * v[1]; o.z = x.z + gg.z * v[2]; o.w = x.w + gg.w * v[3];
          *(float4*)(p.out + (size_t)m * 1024 + n) = o;
        } else {
          float r0 = fmaxf(v[0], 0.f), r1 = fmaxf(v[1], 0.f), r2 = fmaxf(v[2], 0.f), r3 = fmaxf(v[3], 0.f);
          u32x2 o; o.x = pack2(r0 * r0, r1 * r1); o.y = pack2(r2 * r2, r3 * r3);
          *(u32x2*)((u16*)(p.ws + OFF_F) + (size_t)m * 4096 + n) = o;
        }
      }
    }
  }
}

template <int MODE>
__device__ __forceinline__ void merge_tile(const Params& p, int item, unsigned char* smem_raw) {
  u16* smem = (u16*)smem_raw;
  const int lane = threadIdx.x & 63, wv = threadIdx.x >> 6;
  const int wm = wv >> 1, wn = wv & 1;
  const int fr = lane & 15, fq = lane >> 4;
  const u16* H = (const u16*)(p.ws + OFF_H);
  const u16* WIN = (const u16*)(p.ws + OFF_WIN);
  const int mt = item & 127, nt = item >> 7;
  const int m0 = mt * 128, n0 = nt * 64;
  f32x4 macc[4][2], bacc[4][2], gacc[4][2];
  zero_acc<2>(macc);
#pragma unroll 1
  for (int br = (MODE == 0 ? 1 : 0); br < (MODE == 0 ? 4 : 1); ++br) {
    zero_acc<2>(bacc);
    const u16* Ab; const u16* Wb;
    if (br == 0) { Ab = (const u16*)(p.ws + OFF_OG); Wb = (const u16*)(p.ws + OFF_RO); }
    else if (br == 1) { Ab = (const u16*)(p.ws + OFF_UB); Wb = (const u16*)(p.ws + OFF_SO); }
    else if (br == 2) { Ab = (const u16*)(p.ws + OFF_CB); Wb = (const u16*)(p.ws + OFF_CO); }
    else { Ab = (const u16*)(p.ws + OFF_YD); Wb = (const u16*)(p.ws + OFF_GLU); }
    gemm_mainloop<2>(Ab + (size_t)m0 * 256, 256, Wb + (size_t)n0 * 256, 256, 256, bacc, smem);
    if (MODE == 0 && br == 3) {
      zero_acc<2>(gacc);
      gemm_mainloop<2>(Ab + (size_t)m0 * 256, 256, Wb + (size_t)(1024 + n0) * 256, 256, 256, gacc, smem);
#pragma unroll
      for (int i = 0; i < 4; ++i)
#pragma unroll
        for (int j = 0; j < 2; ++j)
#pragma unroll
          for (int e = 0; e < 4; ++e) bacc[i][j][e] *= sigmoidf_(gacc[i][j][e]);
    }
    zero_acc<2>(gacc);
    gemm_mainloop<2>(H + (size_t)m0 * 1024, 1024, WIN + (size_t)(2432 + br * 1024 + n0) * 1024, 1024, 1024, gacc, smem);
#pragma unroll
    for (int i = 0; i < 4; ++i)
#pragma unroll
      for (int j = 0; j < 2; ++j)
#pragma unroll
        for (int e = 0; e < 4; ++e) macc[i][j][e] += sigmoidf_(gacc[i][j][e]) * bacc[i][j][e];
  }
  u16* MRG = (u16*)(p.ws + OFF_MRG);
#pragma unroll
  for (int i = 0; i < 4; ++i) {
    const int m = m0 + wm * 64 + i * 16 + fr;
#pragma unroll
    for (int j = 0; j < 2; ++j) {
      const int n = n0 + wn * 32 + j * 16 + fq * 4;
      f32x4 v = macc[i][j];
      if (MODE == 1) {
        u32x2 pr = *(const u32x2*)(MRG + (size_t)m * 1024 + n);
        v[0] += bflo(pr.x); v[1] += bfhi(pr.x); v[2] += bflo(pr.y); v[3] += bfhi(pr.y);
      }
      u32x2 o; o.x = pack2(v[0], v[1]); o.y = pack2(v[2], v[3]);
      *(u32x2*)(MRG + (size_t)m * 1024 + n) = o;
    }
  }
}

__device__ __forceinline__ float shifted(const u16* __restrict__ P, int tok, int col, float mu) {
  float pv = bf2f(P[(size_t)tok * 2176 + col]);
  float pr = (tok & (SEQ - 1)) ? bf2f(P[(size_t)(tok - 1) * 2176 + col]) : 0.f;
  return pv + (pr - pv) * mu;
}

__device__ __forceinline__ void rwkv_prep_item(const Params& p, int l, int item, unsigned char* smem) {
  const int tid = threadIdx.x;
  float* sl = (float*)smem;
  float* sv = sl + 32 * 128;
  float* svl = sv + 32 * 256;
  const u16* P = (const u16*)(p.ws + OFF_PABC);
  const float* mu = p.in[6] + l * 896;
  const int tok0 = item * 32;
  for (int idx = tid; idx < 32 * 128; idx += NTHR) {
    int t = idx >> 7, ci = idx & 127;
    float v = shifted(P, tok0 + t, 768 + ci, mu[768 + ci]);
    if (ci < 32) v = tanhf_(v);
    else if (ci >= 64) v = sigmoidf_(v);
    sl[idx] = v;
  }
  if (l > 0) {
    float m = mu[512 + tid];
    for (int t = 0; t < 32; ++t) sv[t * 256 + tid] = shifted(P, tok0 + t, 512 + tid, m);
  }
  __syncthreads();
  if (l > 0) {
    const float* v1 = p.in[13];
    int t = tid >> 3, o4 = (tid & 7) * 4;
    float a0 = 0, a1 = 0, a2 = 0, a3 = 0;
    for (int k = 0; k < 256; ++k) {
      float s = sv[t * 256 + k];
      float4 w = *(const float4*)(v1 + k * 32 + o4);
      a0 += s * w.x; a1 += s * w.y; a2 += s * w.z; a3 += s * w.w;
    }
    svl[t * 32 + o4 + 0] = a0; svl[t * 32 + o4 + 1] = a1; svl[t * 32 + o4 + 2] = a2; svl[t * 32 + o4 + 3] = a3;
    __syncthreads();
  }
  const int j = tid;
  const float* w2 = p.in[8] + l * 32 * 256;
  const float* a2w = p.in[10] + l * 32 * 256;
  const float* g2 = p.in[11] + l * 64 * 256;
  const float* v2 = p.in[14];
  const float w0 = p.in[7][l * 256 + j], a0c = p.in[9][l * 256 + j];
  const float v0 = (l > 0) ? p.in[12][j] : 0.f;
  const float kkc = p.in[15][l * 256 + j], kac = p.in[16][l * 256 + j];
  const float mur = mu[j], muk = mu[256 + j], muv = mu[512 + j];
  u16* SR = (u16*)(p.ws + OFF_SR); u16* SK = (u16*)(p.ws + OFF_SK); u16* SV = (u16*)(p.ws + OFF_SV);
  u16* SKK = (u16*)(p.ws + OFF_SKK); u16* SA = (u16*)(p.ws + OFF_SA); float* SW = (float*)(p.ws + OFF_SW);
  u16* G = (u16*)(p.ws + OFF_G); u16* VF = (u16*)(p.ws + OFF_VF);
#pragma unroll 1
  for (int tg = 0; tg < 4; ++tg) {
    float accw[8], acca[8], accg[8], accv[8];
#pragma unroll
    for (int tt = 0; tt < 8; ++tt) { accw[tt] = 0; acca[tt] = 0; accg[tt] = 0; accv[tt] = 0; }
#pragma unroll 2
    for (int k4 = 0; k4 < 8; ++k4) {
      float ww[4], wa[4];
#pragma unroll
      for (int e = 0; e < 4; ++e) { ww[e] = w2[(k4 * 4 + e) * 256 + j]; wa[e] = a2w[(k4 * 4 + e) * 256 + j]; }
#pragma unroll
      for (int tt = 0; tt < 8; ++tt) {
        float4 s = *(const float4*)(sl + (tg * 8 + tt) * 128 + k4 * 4);
        float4 s2 = *(const float4*)(sl + (tg * 8 + tt) * 128 + 32 + k4 * 4);
        accw[tt] += s.x * ww[0] + s.y * ww[1] + s.z * ww[2] + s.w * ww[3];
        acca[tt] += s2.x * wa[0] + s2.y * wa[1] + s2.z * wa[2] + s2.w * wa[3];
      }
    }
#pragma unroll 2
    for (int k4 = 0; k4 < 16; ++k4) {
      float wg[4];
#pragma unroll
      for (int e = 0; e < 4; ++e) wg[e] = g2[(k4 * 4 + e) * 256 + j];
#pragma unroll
      for (int tt = 0; tt < 8; ++tt) {
        float4 s = *(const float4*)(sl + (tg * 8 + tt) * 128 + 64 + k4 * 4);
        accg[tt] += s.x * wg[0] + s.y * wg[1] + s.z * wg[2] + s.w * wg[3];
      }
    }
    if (l > 0) {
#pragma unroll 2
      for (int k4 = 0; k4 < 8; ++k4) {
        float wvv[4];
#pragma unroll
        for (int e = 0; e < 4; ++e) wvv[e] = v2[(k4 * 4 + e) * 256 + j];
#pragma unroll
        for (int tt = 0; tt < 8; ++tt) {
          float4 s = *(const float4*)(svl + (tg * 8 + tt) * 32 + k4 * 4);
          accv[tt] += s.x * wvv[0] + s.y * wvv[1] + s.z * wvv[2] + s.w * wvv[3];
        }
      }
    }
#pragma unroll
    for (int tt = 0; tt < 8; ++tt) {
      const int tok = tok0 + tg * 8 + tt;
      float r = shifted(P, tok, j, mur);
      float k = shifted(P, tok, 256 + j, muk);
      float v = shifted(P, tok, 512 + j, muv);
      float wl = w0 + accw[tt];
      float z = -wl;
      float sp = (z > 15.f) ? z : log1pf(__expf(z));
      float lw = -sp - 0.5f;
      float decay = __expf(-__expf(lw));
      float a = sigmoidf_(a0c + acca[tt]);
      float g = accg[tt];
      const size_t o = (size_t)tok * 256 + j;
      if (l == 0) {
        VF[o] = f2bf(v);
      } else {
        float vf = bf2f(VF[o]);
        v = v + (vf - v) * sigmoidf_(v0 + accv[tt]);
      }
      float kk = k * kkc;
      float ss = wave_sum(kk * kk);
      kk = kk / fmaxf(sqrtf(ss), 1e-12f);
      float km = k * (1.f + (a - 1.f) * kac);
      SR[o] = f2bf(r); SK[o] = f2bf(km); SV[o] = f2bf(v); SKK[o] = f2bf(kk); SA[o] = f2bf(a);
      SW[o] = decay; G[o] = f2bf(g);
    }
  }
  __syncthreads();
}

__device__ __forceinline__ void sg_item(const Params& p, int l, int item, unsigned char* smem) {
  const int tid = threadIdx.x, lane = tid & 63, wv = tid >> 6;
  float* vs = (float*)smem;
  float* smu = vs + 128 * 64;
  float* srs = smu + 128;
  const u16* P = (const u16*)(p.ws + OFF_PABC);
  const int g = item & 3, chn = item >> 2;
  const int tok0 = chn * 128;
  for (int i = 0; i < 32; ++i) {
    int t = wv * 32 + i;
    u32x2 raw = *(const u32x2*)(P + (size_t)(tok0 + t) * 2176 + 896 + 256 + lane * 4);
    float z0 = geluf_(bflo(raw.x)), z1 = geluf_(bfhi(raw.x)), z2 = geluf_(bflo(raw.y)), z3 = geluf_(bfhi(raw.y));
    float s = wave_sum(z0 + z1 + z2 + z3);
    float mean = s * (1.f / 256.f);
    float d0 = z0 - mean, d1 = z1 - mean, d2 = z2 - mean, d3 = z3 - mean;
    float var = wave_sum(d0 * d0 + d1 * d1 + d2 * d2 + d3 * d3) * (1.f / 256.f);
    if (lane == 0) { smu[t] = mean; srs[t] = rsqrtf(var + 1e-5f); }
  }
  __syncthreads();
  {
    const int c = tid & 63, tq = tid >> 6;
    const float lw = p.in[21][l * 256 + g * 64 + c], lb = p.in[22][l * 256 + g * 64 + c];
    for (int i = 0; i < 32; ++i) {
      int t = tq + 4 * i;
      float z = geluf_(bf2f(P[(size_t)(tok0 + t) * 2176 + 896 + 256 + g * 64 + c]));
      vs[t * 64 + c] = (z - smu[t]) * srs[t] * lw + lb;
    }
  }
  __syncthreads();
  {
    const int c = tid & 63;
    const int tq = __builtin_amdgcn_readfirstlane(tid >> 6);
    const float* Wg = p.in[23] + ((size_t)l * 4 + g) * 128 * 128;
    const float* bs = p.in[24] + ((size_t)l * 4 + g) * 128;
    u16* UB = (u16*)(p.ws + OFF_UB);
    for (int i = 0; i < 32; ++i) {
      const int t = tq + 4 * i;
      const float* Wrow = Wg + (size_t)t * 128;
      float acc = bs[t];
      const int n4 = (t >> 2) + 1;
      for (int s4 = 0; s4 < n4; ++s4) {
        float4 w = *(const float4*)(Wrow + s4 * 4);
        int s = s4 * 4;
        acc += w.x * vs[s * 64 + c];
        if (s + 1 <= t) acc += w.y * vs[(s + 1) * 64 + c];
        if (s + 2 <= t) acc += w.z * vs[(s + 2) * 64 + c];
        if (s + 3 <= t) acc += w.w * vs[(s + 3) * 64 + c];
      }
      float u = geluf_(bf2f(P[(size_t)(tok0 + t) * 2176 + 896 + g * 64 + c]));
      UB[(size_t)(tok0 + t) * 256 + g * 64 + c] = f2bf(u * acc);
    }
  }
  __syncthreads();
}

__device__ __forceinline__ void conv_item(const Params& p, int l, int item) {
  const int j = threadIdx.x;
  const u16* P = (const u16*)(p.ws + OFF_PABC);
  u16* CB = (u16*)(p.ws + OFF_CB);
  const float c0 = p.in[26][(l * 3 + 0) * 256 + j], c1 = p.in[26][(l * 3 + 1) * 256 + j], c2 = p.in[26][(l * 3 + 2) * 256 + j];
  const int tok0 = item * 64;
  float z2 = 0.f, z1 = 0.f;
  if (tok0 & (SEQ - 1)) {
    const u16* q2 = P + (size_t)(tok0 - 2) * 2176 + 1408;
    const u16* q1 = P + (size_t)(tok0 - 1) * 2176 + 1408;
    z2 = bf2f(q2[256 + j]) * bf2f(q2[512 + j]);
    z1 = bf2f(q1[256 + j]) * bf2f(q1[512 + j]);
  }
  for (int t = 0; t < 64; ++t) {
    const u16* q = P + (size_t)(tok0 + t) * 2176 + 1408;
    float bg = bf2f(q[j]);
    float z = bf2f(q[256 + j]) * bf2f(q[512 + j]);
    float y = c0 * z2 + c1 * z1 + c2 * z;
    CB[(size_t)(tok0 + t) * 256 + j] = f2bf(bg * y);
    z2 = z1; z1 = z;
  }
}

__device__ __forceinline__ void s5_load_u(const u16* __restrict__ PD, int tok, int g, float (&u)[16]) {
  const u32x4* q = (const u32x4*)(PD + (size_t)tok * 256 + g * 16);
  u32x4 a = q[0], b = q[1];
  u[0] = bflo(a.x); u[1] = bfhi(a.x); u[2] = bflo(a.y); u[3] = bfhi(a.y);
  u[4] = bflo(a.z); u[5] = bfhi(a.z); u[6] = bflo(a.w); u[7] = bfhi(a.w);
  u[8] = bflo(b.x); u[9] = bfhi(b.x); u[10] = bflo(b.y); u[11] = bfhi(b.y);
  u[12] = bflo(b.z); u[13] = bfhi(b.z); u[14] = bflo(b.w); u[15] = bfhi(b.w);
}

__device__ __forceinline__ void s5a_item(const Params& p, int l, int item) {
  const int lane = threadIdx.x & 63, wv = threadIdx.x >> 6;
  const int gq = item & 3, bc = item >> 2;
  const int g = gq * 4 + wv;
  const int tok0 = bc * 64;
  const u16* PD = (const u16*)(p.ws + OFF_PD);
  const float* ab = (const float*)(p.ws + OFF_S5AB) + ((size_t)(l * 16 + g) * 64 + lane) * 2;
  const float* bb = (const float*)(p.ws + OFF_S5BB) + ((size_t)(l * 16 + g) * 64 + lane) * 32;
  float bbr[16], bbi[16];
#pragma unroll
  for (int c = 0; c < 16; ++c) { bbr[c] = bb[c]; bbi[c] = bb[16 + c]; }
  const float abr = ab[0], abi = ab[1];
  float xr = 0.f, xi = 0.f;
  for (int t = 0; t < 64; ++t) {
    float u[16];
    s5_load_u(PD, tok0 + t, g, u);
    float bur = 0.f, bui = 0.f;
#pragma unroll
    for (int c = 0; c < 16; ++c) { bur += bbr[c] * u[c]; bui += bbi[c] * u[c]; }
    float nr = abr * xr - abi * xi + bur;
    float ni = abr * xi + abi * xr + bui;
    xr = nr; xi = ni;
  }
  float2* E = (float2*)(p.ws + OFF_S5E);
  E[((size_t)bc * 16 + g) * 64 + lane] = make_float2(xr, xi);
}

__device__ __forceinline__ void s5b_item(const Params& p, int l, int item, unsigned char* smem) {
  const int lane = threadIdx.x & 63, wv = threadIdx.x >> 6;
  const int gq = item & 3, bc = item >> 2;
  const int b = bc >> 6, ch = bc & 63;
  const int g = gq * 4 + wv;
  const int tok0 = bc * 64;
  float* base = (float*)smem + wv * 4096;
  float* csr = base, *csi = base + 1024, *xsr = base + 2048, *xsi = base + 3072;
  const u16* PD = (const u16*)(p.ws + OFF_PD);
  const float* ab = (const float*)(p.ws + OFF_S5AB) + ((size_t)(l * 16 + g) * 64 + lane) * 2;
  const float* bb = (const float*)(p.ws + OFF_S5BB) + ((size_t)(l * 16 + g) * 64 + lane) * 32;
  const float* cre = p.in[32] + ((size_t)(l * 16 + g) * 16) * 64;
  const float* cim = p.in[33] + ((size_t)(l * 16 + g) * 16) * 64;
  for (int c = 0; c < 16; ++c) {
    csr[(lane >> 2) * 64 + c * 4 + (lane & 3)] = cre[c * 64 + lane];
    csi[(lane >> 2) * 64 + c * 4 + (lane & 3)] = cim[c * 64 + lane];
  }
  float bbr[16], bbi[16];
#pragma unroll
  for (int c = 0; c < 16; ++c) { bbr[c] = bb[c]; bbi[c] = bb[16 + c]; }
  const float abr = ab[0], abi = ab[1];
  float pr = abr, pi = abi;
#pragma unroll
  for (int s = 0; s < 6; ++s) { float nr = pr * pr - pi * pi, ni = 2.f * pr * pi; pr = nr; pi = ni; }
  float xr = 0.f, xi = 0.f;
  const float2* E = (const float2*)(p.ws + OFF_S5E);
  for (int c = 0; c < ch; ++c) {
    float2 e = E[((size_t)(b * 64 + c) * 16 + g) * 64 + lane];
    float nr = pr * xr - pi * xi + e.x;
    float ni = pr * xi + pi * xr + e.y;
    xr = nr; xi = ni;
  }
  const int tt = lane & 15, cq = lane >> 4;
  const float* dvec = p.in[34] + l * 256 + g * 16 + cq * 4;
  const float d0 = dvec[0], d1 = dvec[1], d2 = dvec[2], d3 = dvec[3];
  u16* YD = (u16*)(p.ws + OFF_YD);
  const int n4w = lane >> 2, e4 = lane & 3;
#pragma unroll 1
  for (int sc = 0; sc < 4; ++sc) {
    for (int t = 0; t < 16; ++t) {
      float u[16];
      s5_load_u(PD, tok0 + sc * 16 + t, g, u);
      float bur = 0.f, bui = 0.f;
#pragma unroll
      for (int c = 0; c < 16; ++c) { bur += bbr[c] * u[c]; bui += bbi[c] * u[c]; }
      float nr = abr * xr - abi * xi + bur;
      float ni = abr * xi + abi * xr + bui;
      xr = nr; xi = ni;
      int a = n4w * 64 + ((t ^ (n4w & 7)) << 2) + e4;
      xsr[a] = xr; xsi[a] = xi;
    }
    __syncthreads();
    float acc0 = 0.f, acc1 = 0.f, acc2 = 0.f, acc3 = 0.f;
#pragma unroll 2
    for (int n4 = 0; n4 < 16; ++n4) {
      int xa = n4 * 64 + ((tt ^ (n4 & 7)) << 2);
      float4 xr4 = *(const float4*)(xsr + xa);
      float4 xi4 = *(const float4*)(xsi + xa);
      const float* cr = csr + n4 * 64 + cq * 16;
      const float* ci = csi + n4 * 64 + cq * 16;
      float4 r0 = *(const float4*)(cr), r1 = *(const float4*)(cr + 4), r2 = *(const float4*)(cr + 8), r3 = *(const float4*)(cr + 12);
      float4 i0 = *(const float4*)(ci), i1 = *(const float4*)(ci + 4), i2 = *(const float4*)(ci + 8), i3 = *(const float4*)(ci + 12);
      acc0 += r0.x * xr4.x + r0.y * xr4.y + r0.z * xr4.z + r0.w * xr4.w - (i0.x * xi4.x + i0.y * xi4.y + i0.z * xi4.z + i0.w * xi4.w);
      acc1 += r1.x * xr4.x + r1.y * xr4.y + r1.z * xr4.z + r1.w * xr4.w - (i1.x * xi4.x + i1.y * xi4.y + i1.z * xi4.z + i1.w * xi4.w);
      acc2 += r2.x * xr4.x + r2.y * xr4.y + r2.z * xr4.z + r2.w * xr4.w - (i2.x * xi4.x + i2.y * xi4.y + i2.z * xi4.z + i2.w * xi4.w);
      acc3 += r3.x * xr4.x + r3.y * xr4.y + r3.z * xr4.z + r3.w * xr4.w - (i3.x * xi4.x + i3.y * xi4.y + i3.z * xi4.z + i3.w * xi4.w);
    }
    {
      const int tok = tok0 + sc * 16 + tt;
      u32x2 ur = *(const u32x2*)(PD + (size_t)tok * 256 + g * 16 + cq * 4);
      float y0 = acc0 + d0 * bflo(ur.x), y1 = acc1 + d1 * bfhi(ur.x), y2 = acc2 + d2 * bflo(ur.y), y3 = acc3 + d3 * bfhi(ur.y);
      u32x2 o; o.x = pack2(geluf_(y0), geluf_(y1)); o.y = pack2(geluf_(y2), geluf_(y3));
      *(u32x2*)(YD + (size_t)tok * 256 + g * 16 + cq * 4) = o;
    }
    __syncthreads();
  }
}

__device__ __forceinline__ void lds_barrier() {
  asm volatile("s_waitcnt lgkmcnt(0)" ::: "memory");
  __builtin_amdgcn_s_barrier();
  asm volatile("" ::: "memory");
}
using f32x2 = __attribute__((ext_vector_type(2))) float;
__device__ __forceinline__ void scan_item(const Params& p, int item, unsigned char* smem) {
  const int tid = threadIdx.x, lane = tid & 63, wv = tid >> 6;
  const int b = item >> 4, h = (item >> 2) & 3, q = item & 3;
  const int rl = lane >> 4, cl = lane & 15;
  const int rloc = wv * 4 + rl;
  const size_t tokb = (size_t)b * SEQ;
  const int chan0 = h * 64;
  const u16* SR = (const u16*)(p.ws + OFF_SR); const u16* SK = (const u16*)(p.ws + OFF_SK);
  const u16* SV = (const u16*)(p.ws + OFF_SV); const u16* SKK = (const u16*)(p.ws + OFF_SKK);
  const u16* SA = (const u16*)(p.ws + OFF_SA); const float* SW = (const float*)(p.ws + OFF_SW);
  float* O = (float*)(p.ws + OFF_O);
  constexpr int BUFF = 5376;
  float* lbase = (float*)smem;
  float* pp = lbase + 2 * BUFF + wv * 1024;
  const int st = tid >> 4, cg4 = tid & 15;
  struct Stg { u32x2 r, k, kk, a; f32x4 w; u16 v; };
  auto gload = [&](Stg& g, int c) {
    const size_t o = (tokb + (size_t)c * 16 + st) * 256 + chan0;
    g.r = *(const u32x2*)(SR + o + cg4 * 4); g.k = *(const u32x2*)(SK + o + cg4 * 4);
    g.kk = *(const u32x2*)(SKK + o + cg4 * 4); g.a = *(const u32x2*)(SA + o + cg4 * 4);
    g.w = *(const f32x4*)(SW + o + cg4 * 4);
    g.v = SV[o + q * 16 + cg4];
  };
  auto lwrite = [&](const Stg& g, int buf) {
    float* bp = lbase + buf * BUFF;
    const int o = st * 64 + cg4 * 4;
    f32x4 kk = {bflo(g.kk.x), bfhi(g.kk.x), bflo(g.kk.y), bfhi(g.kk.y)};
    f32x4 a = {bflo(g.a.x), bfhi(g.a.x), bflo(g.a.y), bfhi(g.a.y)};
    f32x4 k = {bflo(g.k.x), bfhi(g.k.x), bflo(g.k.y), bfhi(g.k.y)};
    f32x4 r = {bflo(g.r.x), bfhi(g.r.x), bflo(g.r.y), bfhi(g.r.y)};
    *(f32x4*)(bp + o) = kk;
    *(f32x4*)(bp + 1024 + o) = kk * a;
    *(f32x4*)(bp + 2048 + o) = k;
    *(f32x4*)(bp + 3072 + o) = g.w;
    *(f32x4*)(bp + 4096 + o) = r;
    bp[5120 + st * 16 + cg4] = bf2f(g.v);
  };
  constexpr int NCH = SEQ / 16;
  Stg R0, R1, R2, R3;
  gload(R0, 0); gload(R1, 1); gload(R2, 2); gload(R3, 3);
  __syncthreads();
  lwrite(R0, 0);
  __syncthreads();
  __builtin_amdgcn_s_setprio(3);
  float S0 = 0.f, S1 = 0.f, S2 = 0.f, S3 = 0.f;
  const int rrow = lane & 3, rstep = lane >> 2;
  struct Ops { f32x4 kk, bb, k4, w4, r4; float v; };
  auto chunk = [&](int c) {
    const float* bp = lbase + (c & 1) * BUFF;
    auto ldops = [&](Ops& o, int s) {
      o.kk = *(const f32x4*)(bp + s * 64 + cl * 4);
      o.bb = *(const f32x4*)(bp + 1024 + s * 64 + cl * 4);
      o.k4 = *(const f32x4*)(bp + 2048 + s * 64 + cl * 4);
      o.w4 = *(const f32x4*)(bp + 3072 + s * 64 + cl * 4);
      o.r4 = *(const f32x4*)(bp + 4096 + s * 64 + cl * 4);
      o.v = bp[5120 + s * 16 + rloc];
    };
    auto step = [&](const Ops& o, int s) {
      const float sa = row_sum16(__builtin_fmaf(S3, o.kk.w, __builtin_fmaf(S2, o.kk.z, __builtin_fmaf(S1, o.kk.y, S0 * o.kk.x))));
      S0 = __builtin_fmaf(S0, o.w4.x, __builtin_fmaf(o.v, o.k4.x, -(sa * o.bb.x)));
      S1 = __builtin_fmaf(S1, o.w4.y, __builtin_fmaf(o.v, o.k4.y, -(sa * o.bb.y)));
      S2 = __builtin_fmaf(S2, o.w4.z, __builtin_fmaf(o.v, o.k4.z, -(sa * o.bb.z)));
      S3 = __builtin_fmaf(S3, o.w4.w, __builtin_fmaf(o.v, o.k4.w, -(sa * o.bb.w)));
      pp[(s * 4 + rl) * 16 + cl] = __builtin_fmaf(S3, o.r4.w, __builtin_fmaf(S2, o.r4.z, __builtin_fmaf(S1, o.r4.y, S0 * o.r4.x)));
    };
    Ops a0, a1, b0, b1;
    ldops(a0, 0); ldops(a1, 1);
#pragma unroll
    for (int j = 0; j < 4; ++j) {
      ldops(b0, 4 * j + 2); ldops(b1, 4 * j + 3);
      __builtin_amdgcn_sched_barrier(0);
      step(a0, 4 * j); step(a1, 4 * j + 1);
      __builtin_amdgcn_sched_barrier(0);
      if (j < 3) { ldops(a0, 4 * j + 4); ldops(a1, 4 * j + 5); }
      __builtin_amdgcn_sched_barrier(0);
      step(b0, 4 * j + 2); step(b1, 4 * j + 3);
      __builtin_amdgcn_sched_barrier(0);
    }
    asm volatile("" ::: "memory");
    {
      const float* q0 = pp + (rstep * 4 + rrow) * 16;
      f32x4 a0 = *(const f32x4*)(q0), a1 = *(const f32x4*)(q0 + 4), a2 = *(const f32x4*)(q0 + 8), a3 = *(const f32x4*)(q0 + 12);
      f32x4 sm4 = (a0 + a1) + (a2 + a3);
      O[(tokb + (size_t)c * 16 + rstep) * 256 + chan0 + q * 16 + wv * 4 + rrow] = (sm4.x + sm4.y) + (sm4.z + sm4.w);
    }
    asm volatile("" ::: "memory");
  };
#pragma unroll 1
  for (int g = 0; g < NCH / 4; ++g) {
    const int c0 = g * 4;
    if (c0 + 4 < NCH) gload(R0, c0 + 4);
    chunk(c0);
    lwrite(R1, (c0 + 1) & 1);
    lds_barrier();
    if (c0 + 5 < NCH) gload(R1, c0 + 5);
    chunk(c0 + 1);
    lwrite(R2, (c0 + 2) & 1);
    lds_barrier();
    if (c0 + 6 < NCH) gload(R2, c0 + 6);
    chunk(c0 + 2);
    lwrite(R3, (c0 + 3) & 1);
    lds_barrier();
    if (c0 + 7 < NCH) gload(R3, c0 + 7);
    chunk(c0 + 3);
    if (c0 + 4 < NCH) lwrite(R0, (c0 + 4) & 1);
    lds_barrier();
  }
  __builtin_amdgcn_s_setprio(0);
}

__device__ __forceinline__ void rwkv_post_item(const Params& p, int l, int item) {
  const int j = threadIdx.x;
  const float* O = (const float*)(p.ws + OFF_O);
  const u16* SR = (const u16*)(p.ws + OFF_SR); const u16* SK = (const u16*)(p.ws + OFF_SK);
  const u16* SV = (const u16*)(p.ws + OFF_SV); const u16* G = (const u16*)(p.ws + OFF_G);
  u16* OG = (u16*)(p.ws + OFF_OG);
  const float lw = p.in[18][l * 256 + j], lb = p.in[19][l * 256 + j], rk = p.in[17][l * 256 + j];
  const int tok0 = item * 64;
  for (int t = 0; t < 64; ++t) {
    const size_t o = (size_t)(tok0 + t) * 256 + j;
    float ov = O[o];
    float mean = wave_sum(ov) * (1.f / 64.f);
    float d = ov - mean;
    float var = wave_sum(d * d) * (1.f / 64.f);
    float on = d * rsqrtf(var + 64e-5f) * lw + lb;
    float r = bf2f(SR[o]), k = bf2f(SK[o]), v = bf2f(SV[o]), g = bf2f(G[o]);
    float bonus = wave_sum(r * k * rk);
    OG[o] = f2bf((on + bonus * v) * g);
  }
}


#define XB_TMO      128
#define XB_XCNT(j)  (256  + 64 * (j))
#define XB_XSUB(j)  (1280 + 64 * (j))
#define XB_XGEN(j)  (2304 + 64 * (j))
#define XB_TOP      3328
#define XB_TOPGEN   3392
#define XCD_BAR_WORDS 3456
#define XB_SPIN_CAP (1u << 22)
#define LAS __attribute__((address_space(3)))
__device__ __forceinline__ unsigned xb_ld(unsigned* p) { return __hip_atomic_load(p, __ATOMIC_RELAXED, __HIP_MEMORY_SCOPE_AGENT); }
__device__ __forceinline__ unsigned xb_add(unsigned* p, unsigned v) { return __hip_atomic_fetch_add(p, v, __ATOMIC_RELAXED, __HIP_MEMORY_SCOPE_AGENT); }
__device__ __forceinline__ unsigned xb_xcc_id() { return (unsigned)__builtin_amdgcn_s_getreg((3 << 11) | 20) & 0xFu; }
#define XB_SPIN(cond, bar) do { unsigned _sp = 0; while (cond) { __builtin_amdgcn_s_sleep(1); \
    if ((++_sp & 255u) == 0u) { if (xb_ld(&(bar)[XB_TMO])) break; if (_sp > XB_SPIN_CAP) { atomicAdd(&(bar)[XB_TMO], 1u); break; } } } } while (0)
struct XcdBarrier { unsigned* bar; unsigned x; volatile LAS unsigned* st; };
__device__ __forceinline__ XcdBarrier xcd_barrier_post(unsigned* bar, volatile LAS unsigned* st) {
  XcdBarrier b; b.bar = bar; b.x = xb_xcc_id(); b.st = st;
  if (threadIdx.x == 0) (void)xb_add(&bar[XB_XCNT(b.x)], 1u);
  return b;
}
__device__ __forceinline__ void xcd_barrier_complete(unsigned* bar, unsigned x, unsigned& nloc, unsigned& nx) {
  const unsigned G = gridDim.x * gridDim.y * gridDim.z;
  unsigned sum, cnt, mine, sp = 0u;
  for (;;) {
    sum = 0u; cnt = 0u; mine = 0u;
#pragma unroll
    for (unsigned j = 0; j < 16; ++j) { const unsigned c = xb_ld(&bar[XB_XCNT(j)]); sum += c; cnt += (c > 0u) ? 1u : 0u; mine = (j == x) ? c : mine; }
    if (sum == G) break;
    __builtin_amdgcn_s_sleep(1);
    if ((++sp & 255u) == 0u) { if (xb_ld(&bar[XB_TMO])) break; if (sp > XB_SPIN_CAP) { atomicAdd(&bar[XB_TMO], 1u); break; } }
  }
  nloc = mine > 0u ? mine : 1u; nx = cnt > 0u ? cnt : 1u;
}
__device__ __forceinline__ void xcd_barrier(const XcdBarrier& b) {
  asm volatile("s_waitcnt vmcnt(0)" ::: "memory");
  __syncthreads();
  if (threadIdx.x == 0) {
    unsigned* bar = b.bar;
    __builtin_amdgcn_s_waitcnt(0);
    unsigned nloc = b.st[0], nx = b.st[1];
    if (nloc == 0u) { xcd_barrier_complete(bar, b.x, nloc, nx); b.st[0] = nloc; b.st[1] = nx; }
    const unsigned old = xb_add(&bar[XB_XSUB(b.x)], 1u);
    const unsigned gen = old / nloc;
    if (old + 1u == (gen + 1u) * nloc) {
      __builtin_amdgcn_fence(__ATOMIC_RELEASE, "agent");
      asm volatile("s_waitcnt vmcnt(0)" ::: "memory");
      const unsigned og = xb_add(&bar[XB_TOP], 1u);
      const unsigned tg = og / nx;
      if (og + 1u == (tg + 1u) * nx) xb_add(&bar[XB_TOPGEN], 1u);
      else XB_SPIN(xb_ld(&bar[XB_TOPGEN]) == tg, bar);
      __builtin_amdgcn_fence(__ATOMIC_ACQUIRE, "agent");
      xb_add(&bar[XB_XGEN(b.x)], 1u);
      asm volatile("s_waitcnt vmcnt(0)" ::: "memory");
    } else {
      XB_SPIN(xb_ld(&bar[XB_XGEN(b.x)]) == gen, bar);
      __builtin_amdgcn_fence(__ATOMIC_ACQUIRE, "agent");
      asm volatile("s_waitcnt vmcnt(0)" ::: "memory");
    }
  }
  __syncthreads();
}

__device__ __forceinline__ void sub_barrier(unsigned* cnt, unsigned target) {
  asm volatile("s_waitcnt vmcnt(0)" ::: "memory");
  __syncthreads();
  if (threadIdx.x == 0) {
    __builtin_amdgcn_fence(__ATOMIC_RELEASE, "agent");
    asm volatile("s_waitcnt vmcnt(0)" ::: "memory");
    xb_add(cnt, 1u);
    unsigned sp = 0;
    while (xb_ld(cnt) < target) { __builtin_amdgcn_s_sleep(2); if (++sp > (1u << 24)) break; }
    __builtin_amdgcn_fence(__ATOMIC_ACQUIRE, "agent");
    asm volatile("s_waitcnt vmcnt(0)" ::: "memory");
  }
  __syncthreads();
}

#define N_PHASES 22
#ifndef PROBE_SCAN_REPS
#define PROBE_SCAN_REPS 1
#endif
#ifndef PROBE_FFN1_REPS
#define PROBE_FFN1_REPS 1
#endif
#ifndef PH_MASK
#define PH_MASK 0xFFFFF
#endif
#define PHON(s) (PH_MASK & (1 << (s)))
#define PHASE_BEGIN(k) if (ph_lo <= (k) && (k) < ph_hi) { if ((k) > ph_lo) xcd_barrier(xb);
#define PHASE_END }

template <int L>
__device__ __forceinline__ void run_layer(const Params& p, int ph_lo, int ph_hi, unsigned char* smem, const XcdBarrier& xb) {
  constexpr int l = L;
  constexpr int base = 1 + 10 * L;
  const float* modl = (const float*)(p.ws + OFF_MOD) + (size_t)l * 4 * 6144;
  PHASE_BEGIN(base + 0)
    if (PHON(0)) {
      phase_convert(p, l, smem);
      phase_norm(l == 0 ? p.in[0] : p.out, p.in[4] + l * 1024, modl, 0, 1024, (u16*)(p.ws + OFF_H));
    }
  PHASE_END
  PHASE_BEGIN(base + 1)
    if (PHON(1)) phase_gemm<0>(p, l, smem);
  PHASE_END
  PHASE_BEGIN(base + 2)
    if (PHON(2)) {
      for (int item = blockIdx.x; item < 2304; item += gridDim.x) {
        if (item < 512) sg_item(p, l, item, smem);
        else if (item < 1024) rwkv_prep_item(p, l, item - 512, smem);
        else if (item < 2048) s5a_item(p, l, item - 1024);
        else conv_item(p, l, item - 2048);
      }
    }
  PHASE_END
  PHASE_BEGIN(base + 3)
    if ((int)blockIdx.x < 64) scan_item(p, blockIdx.x, smem);
    else {
      for (int item = blockIdx.x - 64; item < 1024; item += gridDim.x - 64) s5b_item(p, l, item, smem);
      sub_barrier((unsigned*)(p.ws + OFF_BAR) + 3520 + 64 * l, gridDim.x - 64);
      for (int item = blockIdx.x - 64; item < 2048; item += gridDim.x - 64) merge_tile<0>(p, item, smem);
    }
  PHASE_END
  PHASE_BEGIN(base + 4)
    if (PHON(4)) for (int item = blockIdx.x; item < 256; item += gridDim.x) rwkv_post_item(p, l, item);
  PHASE_END
  PHASE_BEGIN(base + 5)
    for (int item = blockIdx.x; item < 2048; item += gridDim.x) merge_tile<1>(p, item, smem);
  PHASE_END
  PHASE_BEGIN(base + 6)
    if (PHON(6)) phase_gemm<1>(p, l, smem);
  PHASE_END
  PHASE_BEGIN(base + 7)
    if (PHON(7)) phase_norm(p.out, p.in[38] + l * 1024, modl, 3072, 4096, (u16*)(p.ws + OFF_H));
  PHASE_END
  PHASE_BEGIN(base + 8)
    for (int rep = 0; rep < PROBE_FFN1_REPS; ++rep) { if (rep) xcd_barrier(xb); phase_gemm<2>(p, l, smem); }
  PHASE_END
  PHASE_BEGIN(base + 9)
    if (PHON(9)) phase_gemm<3>(p, l, smem);
  PHASE_END
}

__global__ void __launch_bounds__(NTHR, 2) mega_fwd(Params p, int ph_lo, int ph_hi) {
  __shared__ __attribute__((aligned(16))) unsigned char smem[65536 + 16];
  cg::grid_group grid = cg::this_grid();
  if (ph_hi < 0) grid.sync();
  volatile LAS unsigned* st = (volatile LAS unsigned*)(smem + 65536);
  if (threadIdx.x == 0) { st[0] = 0u; st[1] = 0u; }
  __syncthreads();
  const XcdBarrier xb = xcd_barrier_post((unsigned*)(p.ws + OFF_BAR), st);
  PHASE_BEGIN(0)
    if (PHON(10)) phase_mod(p, smem);
  PHASE_END
  run_layer<0>(p, ph_lo, ph_hi, smem, xb);
  run_layer<1>(p, ph_lo, ph_hi, smem, xb);
  PHASE_BEGIN(21)
    if (PHON(11)) phase_final(p.out, p.in[41]);
  PHASE_END
}

extern "C" void kernel_launch(void* const* d_in, const int* in_sizes, int n_in, void* d_out, int out_size, void* d_ws,
                              size_t ws_size, hipStream_t stream) {
  static int grid_blocks = 0;
  if (!grid_blocks) {
    int dev = 0, cus = 0, per_cu = 0;
    hipGetDevice(&dev);
    hipDeviceGetAttribute(&cus, hipDeviceAttributeMultiprocessorCount, dev);
    hipOccupancyMaxActiveBlocksPerMultiprocessor(&per_cu, mega_fwd, NTHR, 0);
    if (per_cu > 2) per_cu = 2;
    if (per_cu < 1) per_cu = 1;
    grid_blocks = cus * per_cu;
    if (ws_size < WS_END) fprintf(stderr, "workspace too small: %zu < %zu\n", ws_size, (size_t)WS_END);
  }
  Params p{};
  for (int i = 0; i < 42; ++i) p.in[i] = (const float*)d_in[i];
  p.out = (float*)d_out;
  p.ws = (unsigned char*)d_ws;
  hipMemsetAsync((unsigned char*)d_ws + OFF_BAR, 0, 16384, stream);
  int lo = 0, hi = N_PHASES;
  void* args[] = {&p, &lo, &hi};
  hipError_t e = hipLaunchCooperativeKernel((void*)mega_fwd, dim3(grid_blocks), dim3(NTHR), args, 0, stream);
  if (e != hipSuccess) fprintf(stderr, "cooperative launch failed: %s (grid %d)\n", hipGetErrorString(e), grid_blocks);
}
```

```cpp
#include <hip/hip_runtime.h>
#include <hip/hip_cooperative_groups.h>
#include <cstdio>
namespace cg = cooperative_groups;

typedef unsigned short u16;
using bf16x8 = __attribute__((ext_vector_type(8))) short;
using f32x4 = __attribute__((ext_vector_type(4))) float;
using u32x4 = __attribute__((ext_vector_type(4))) unsigned int;
using u32x2 = __attribute__((ext_vector_type(2))) unsigned int;

#define T_TOK 16384
#define SEQ 4096
#define DM 1024
#define NTHR 256

static constexpr size_t SZ_WIN = (size_t)6528 * 1024 * 2;
static constexpr size_t OFF_WIN = 0;
static constexpr size_t OFF_RO = OFF_WIN + SZ_WIN;
static constexpr size_t OFF_SO = OFF_RO + 1024 * 256 * 2;
static constexpr size_t OFF_CO = OFF_SO + 1024 * 256 * 2;
static constexpr size_t OFF_GLU = OFF_CO + 1024 * 256 * 2;
static constexpr size_t OFF_WO = OFF_GLU + 2048 * 256 * 2;
static constexpr size_t OFF_W1 = OFF_WO + 1024 * 1024 * 2;
static constexpr size_t OFF_W2 = OFF_W1 + (size_t)4096 * 1024 * 2;
static constexpr size_t OFF_H = OFF_W2 + (size_t)4096 * 1024 * 2;
static constexpr size_t SZ_T256B = (size_t)T_TOK * 256 * 2;
static constexpr size_t OFF_VF = OFF_H + (size_t)T_TOK * 1024 * 2;
static constexpr size_t OFF_PD = OFF_VF + SZ_T256B;
static constexpr size_t OFF_G = OFF_PD + SZ_T256B;
static constexpr size_t OFF_UB = OFF_G + SZ_T256B;
static constexpr size_t OFF_CB = OFF_UB + SZ_T256B;
static constexpr size_t OFF_SR = OFF_CB + SZ_T256B;
static constexpr size_t OFF_SK = OFF_SR + SZ_T256B;
static constexpr size_t OFF_SV = OFF_SK + SZ_T256B;
static constexpr size_t OFF_SKK = OFF_SV + SZ_T256B;
static constexpr size_t OFF_SA = OFF_SKK + SZ_T256B;
static constexpr size_t OFF_SW = OFF_SA + SZ_T256B;
static constexpr size_t OFF_PABC = OFF_SW + 2 * SZ_T256B;
static constexpr size_t OFF_O = OFF_PABC;
static constexpr size_t OFF_YD = OFF_O + 2 * SZ_T256B;
static constexpr size_t OFF_OG = OFF_YD + SZ_T256B;
static constexpr size_t OFF_MRG = OFF_OG + SZ_T256B;
static constexpr size_t OFF_F = OFF_UB;
static constexpr size_t OFF_SMALL = OFF_PABC + (size_t)T_TOK * 2176 * 2;
static constexpr size_t OFF_MOD = OFF_SMALL;
static constexpr size_t OFF_S5AB = OFF_MOD + 2 * 4 * 6144 * 4;
static constexpr size_t OFF_S5BB = OFF_S5AB + 2 * 16 * 64 * 2 * 4;
static constexpr size_t OFF_S5E = OFF_S5BB + 2 * 16 * 64 * 32 * 4;
static constexpr size_t OFF_BAR = OFF_S5E + (size_t)4 * 64 * 16 * 64 * 2 * 4;
static constexpr size_t OFF_SGW = OFF_BAR + 16384;
static constexpr size_t WS_END = OFF_SGW + 4 * 128 * 128 * 2;
static_assert(OFF_F + (size_t)T_TOK * 4096 * 2 <= OFF_SMALL, "F overlaps small region");
static_assert(OFF_MRG + (size_t)T_TOK * 1024 * 2 <= OFF_SMALL, "MRG overlaps");

struct Params {
  const float* in[42];
  float* out;
  unsigned char* ws;
};

__device__ __forceinline__ u16 f2bf(float f) {
  unsigned u = __float_as_uint(f);
  u += 0x7fffu + ((u >> 16) & 1u);
  return (u16)(u >> 16);
}
__device__ __forceinline__ float bf2f(u16 h) { return __uint_as_float(((unsigned)h) << 16); }
__device__ __forceinline__ float bflo(unsigned u) { return __uint_as_float(u << 16); }
__device__ __forceinline__ float bfhi(unsigned u) { return __uint_as_float(u & 0xffff0000u); }
__device__ __forceinline__ unsigned pack2(float a, float b) { return (unsigned)f2bf(a) | ((unsigned)f2bf(b) << 16); }
__device__ __forceinline__ float sigmoidf_(float x) { return 1.f / (1.f + __expf(-x)); }
__device__ __forceinline__ float tanhf_(float y) { return 1.f - 2.f / (1.f + __expf(2.f * y)); }
__device__ __forceinline__ float geluf_(float x) {
  float y = 0.7978845608028654f * (x + 0.044715f * x * x * x);
  return 0.5f * x * (1.f + tanhf_(y));
}
__device__ __forceinline__ float wave_sum(float v) {
#pragma unroll
  for (int o = 32; o > 0; o >>= 1) v += __shfl_xor(v, o, 64);
  return v;
}
template <int CTRL>
__device__ __forceinline__ float dppf(float x) {
  return __int_as_float(__builtin_amdgcn_update_dpp(__float_as_int(x), __float_as_int(x), CTRL, 0xF, 0xF, true));
}
__device__ __forceinline__ float row_sum16(float x) {
  x += dppf<0x128>(x);
  x += dppf<0x124>(x);
  x += dppf<0x122>(x);
  x += dppf<0x121>(x);
  return x;
}

__device__ __forceinline__ void phase_mod(const Params& p, unsigned char* smem) {
  const int tid = threadIdx.x;
  float* cact = (float*)smem;
  float* red = cact + 4096;
  float* mod = (float*)(p.ws + OFF_MOD);
  for (int i = tid; i < 4096; i += NTHR) { float c = p.in[1][i]; cact[i] = c / (1.f + __expf(-c)); }
  __syncthreads();
  for (int item = blockIdx.x; item < 192; item += gridDim.x) {
    int l = item / 96, nb = item % 96;
    int cl = tid & 63, kq = tid >> 6;
    int col = nb * 64 + cl;
    const float* W = p.in[2] + (size_t)l * 1024 * 6144;
    float a0 = 0, a1 = 0, a2 = 0, a3 = 0;
    for (int k = kq * 256; k < kq * 256 + 256; ++k) {
      float w = W[(size_t)k * 6144 + col];
      a0 += cact[k] * w; a1 += cact[1024 + k] * w; a2 += cact[2048 + k] * w; a3 += cact[3072 + k] * w;
    }
    red[(kq * 4 + 0) * 64 + cl] = a0; red[(kq * 4 + 1) * 64 + cl] = a1;
    red[(kq * 4 + 2) * 64 + cl] = a2; red[(kq * 4 + 3) * 64 + cl] = a3;
    __syncthreads();
    {
      int b = tid >> 6;
      float s = red[(0 * 4 + b) * 64 + cl] + red[(1 * 4 + b) * 64 + cl] + red[(2 * 4 + b) * 64 + cl] + red[(3 * 4 + b) * 64 + cl];
      mod[((size_t)l * 4 + b) * 6144 + col] = s + p.in[3][l * 6144 + col];
    }
    __syncthreads();
  }
  float* s5ab = (float*)(p.ws + OFF_S5AB);
  float* s5bb = (float*)(p.ws + OFF_S5BB);
  for (int idx = blockIdx.x * NTHR + tid; idx < 2048; idx += gridDim.x * NTHR) {
    int l = idx >> 10, g = (idx >> 6) & 15, n = idx & 63;
    double lre = fmin((double)p.in[28][idx], -1e-4);
    double lim = (double)p.in[29][idx];
    double dt = exp((double)p.in[35][l * 16 + g]);
    double mag = exp(lre * dt);
    double abr = mag * cos(lim * dt), abi = mag * sin(lim * dt);
    double den = lre * lre + lim * lim;
    double qr = ((abr - 1.0) * lre + abi * lim) / den;
    double qi = (abi * lre - (abr - 1.0) * lim) / den;
    s5ab[idx * 2 + 0] = (float)abr; s5ab[idx * 2 + 1] = (float)abi;
    for (int c = 0; c < 16; ++c) {
      double br = p.in[30][(size_t)idx * 16 + c], bi = p.in[31][(size_t)idx * 16 + c];
      s5bb[(size_t)idx * 32 + c] = (float)(qr * br - qi * bi);
      s5bb[(size_t)idx * 32 + 16 + c] = (float)(qr * bi + qi * br);
    }
  }
}

__device__ __forceinline__ void convert_tile(const float* __restrict__ src, int K, int N, u16* __restrict__ dst, int tk, int tn, u16* sm) {
  const int tid = threadIdx.x;
  int r = tid >> 4, c4 = (tid & 15) * 4;
#pragma unroll
  for (int i = 0; i < 4; ++i) {
    int kk = r + 16 * i;
    float4 v = *(const float4*)(src + (size_t)(tk * 64 + kk) * N + tn * 64 + c4);
    sm[(c4 + 0) * 72 + kk] = f2bf(v.x);
    sm[(c4 + 1) * 72 + kk] = f2bf(v.y);
    sm[(c4 + 2) * 72 + kk] = f2bf(v.z);
    sm[(c4 + 3) * 72 + kk] = f2bf(v.w);
  }
  __syncthreads();
#pragma unroll
  for (int j = 0; j < 2; ++j) {
    int n = (tid >> 3) + 32 * j, ch = tid & 7;
    u32x4 v = *(const u32x4*)(sm + n * 72 + ch * 8);
    *(u32x4*)(dst + (size_t)(tn * 64 + n) * K + tk * 64 + ch * 8) = v;
  }
  __syncthreads();
}

__device__ __forceinline__ void phase_convert(const Params& p, int l, unsigned char* smem) {
  u16* sm = (u16*)smem;
  const int total = 1632 + 192 + 128 + 256 + 1024 + 1024;
  for (int item = blockIdx.x; item < total + 16; item += gridDim.x) {
    int t = item;
    if (t >= total) {
      const int idx = t - total, g = idx >> 2, rq = idx & 3;
      const int tr = rq * 32 + (threadIdx.x >> 3), s0 = (threadIdx.x & 7) * 16;
      const float* src = p.in[23] + (((size_t)l * 4 + g) * 128 + tr) * 128 + s0;
      u16* dst = (u16*)(p.ws + OFF_SGW) + ((size_t)g * 128 + tr) * 128 + s0;
      unsigned pk[8];
#pragma unroll
      for (int e = 0; e < 4; ++e) {
        f32x4 v = *(const f32x4*)(src + e * 4);
        const int sb = s0 + e * 4;
        pk[e * 2 + 0] = pack2(sb + 0 <= tr ? v.x : 0.f, sb + 1 <= tr ? v.y : 0.f);
        pk[e * 2 + 1] = pack2(sb + 2 <= tr ? v.z : 0.f, sb + 3 <= tr ? v.w : 0.f);
      }
      *(u32x4*)(dst) = u32x4{pk[0], pk[1], pk[2], pk[3]};
      *(u32x4*)(dst + 8) = u32x4{pk[4], pk[5], pk[6], pk[7]};
      continue;
    }
    const float* src; int K, N; size_t off;
    if (t < 1632) { src = p.in[5] + (size_t)l * 1024 * 6528; K = 1024; N = 6528; off = OFF_WIN; }
    else if ((t -= 1632) < 64) { src = p.in[20] + (size_t)l * 256 * 1024; K = 256; N = 1024; off = OFF_RO; }
    else if ((t -= 64) < 64) { src = p.in[25] + (size_t)l * 256 * 1024; K = 256; N = 1024; off = OFF_SO; }
    else if ((t -= 64) < 64) { src = p.in[27] + (size_t)l * 256 * 1024; K = 256; N = 1024; off = OFF_CO; }
    else if ((t -= 64) < 128) { src = p.in[36] + (size_t)l * 256 * 2048; K = 256; N = 2048; off = OFF_GLU; }
    else if ((t -= 128) < 256) { src = p.in[37] + (size_t)l * 1024 * 1024; K = 1024; N = 1024; off = OFF_WO; }
    else if ((t -= 256) < 1024) { src = p.in[39] + (size_t)l * 1024 * 4096; K = 1024; N = 4096; off = OFF_W1; }
    else { t -= 1024; src = p.in[40] + (size_t)l * 4096 * 1024; K = 4096; N = 1024; off = OFF_W2; }
    int ntn = N / 64;
    convert_tile(src, K, N, (u16*)(p.ws + off), t / ntn, t % ntn, sm);
  }
}

__device__ __forceinline__ void phase_norm(const float* __restrict__ X, const float* __restrict__ g, const float* __restrict__ modl,
                           int sh_off, int sc_off, u16* __restrict__ H) {
  const int lane = threadIdx.x & 63, wv = threadIdx.x >> 6;
  for (int item = blockIdx.x; item < T_TOK / 4; item += gridDim.x) {
    int row = item * 4 + wv;
    int b = row >> 12;
    const float* xr = X + (size_t)row * 1024;
    float4 v[4];
    float ss = 0;
#pragma unroll
    for (int i = 0; i < 4; ++i) {
      v[i] = *(const float4*)(xr + lane * 4 + 256 * i);
      ss += v[i].x * v[i].x + v[i].y * v[i].y + v[i].z * v[i].z + v[i].w * v[i].w;
    }
    ss = wave_sum(ss);
    float rstd = rsqrtf(ss * (1.f / 1024.f) + 1e-6f);
    const float* sh = modl + (size_t)b * 6144 + sh_off;
    const float* sc = modl + (size_t)b * 6144 + sc_off;
#pragma unroll
    for (int i = 0; i < 4; ++i) {
      int c = lane * 4 + 256 * i;
      float4 gg = *(const float4*)(g + c);
      float4 s1 = *(const float4*)(sc + c);
      float4 s0 = *(const float4*)(sh + c);
      float h0 = v[i].x * rstd * gg.x * (1.f + s1.x) + s0.x;
      float h1 = v[i].y * rstd * gg.y * (1.f + s1.y) + s0.y;
      float h2 = v[i].z * rstd * gg.z * (1.f + s1.z) + s0.z;
      float h3 = v[i].w * rstd * gg.w * (1.f + s1.w) + s0.w;
      u32x2 o; o.x = pack2(h0, h1); o.y = pack2(h2, h3);
      *(u32x2*)(H + (size_t)row * 1024 + c) = o;
    }
  }
}

__device__ __forceinline__ void phase_final(float* __restrict__ X, const float* __restrict__ g) {
  const int lane = threadIdx.x & 63, wv = threadIdx.x >> 6;
  for (int item = blockIdx.x; item < T_TOK / 4; item += gridDim.x) {
    int row = item * 4 + wv;
    float* xr = X + (size_t)row * 1024;
    float4 v[4];
    float ss = 0;
#pragma unroll
    for (int i = 0; i < 4; ++i) {
      v[i] = *(const float4*)(xr + lane * 4 + 256 * i);
      ss += v[i].x * v[i].x + v[i].y * v[i].y + v[i].z * v[i].z + v[i].w * v[i].w;
    }
    ss = wave_sum(ss);
    float rstd = rsqrtf(ss * (1.f / 1024.f) + 1e-6f);
#pragma unroll
    for (int i = 0; i < 4; ++i) {
      int c = lane * 4 + 256 * i;
      float4 gg = *(const float4*)(g + c);
      float4 o;
      o.x = v[i].x * rstd * gg.x; o.y = v[i].y * rstd * gg.y; o.z = v[i].z * rstd * gg.z; o.w = v[i].w * rstd * gg.w;
      *(float4*)(xr + c) = o;
    }
  }
}

template <int NF>
__device__ __forceinline__ void gemm_mainloop(const u16* __restrict__ A, int lda, const u16* __restrict__ B, int ldb,
                                              int K, f32x4 (&acc)[4][NF], u16* smem) {
  constexpr int BN = 32 * NF;
  constexpr int NB = BN / 32;
  u16* sA = smem;
  u16* sB = smem + 2 * 128 * 64;
  const int tid = threadIdx.x, lane = tid & 63, wv = tid >> 6;
  const int wm = wv >> 1, wn = wv & 1;
  u32x4 ra[4], rb[NB];
  const int lrow = tid >> 3, lch = tid & 7;
  const u16* Ap = A + (size_t)lrow * lda + lch * 8;
  const u16* Bp = B + (size_t)lrow * ldb + lch * 8;
  const int wofs = lrow * 64 + ((lch ^ ((lrow >> 1) & 7)) << 3);
  const int nk = K >> 6;
#pragma unroll
  for (int i = 0; i < 4; ++i) ra[i] = *(const u32x4*)(Ap + (size_t)(32 * i) * lda);
#pragma unroll
  for (int i = 0; i < NB; ++i) rb[i] = *(const u32x4*)(Bp + (size_t)(32 * i) * ldb);
  __syncthreads();
#pragma unroll
  for (int i = 0; i < 4; ++i) *(u32x4*)(sA + wofs + 32 * i * 64) = ra[i];
#pragma unroll
  for (int i = 0; i < NB; ++i) *(u32x4*)(sB + wofs + 32 * i * 64) = rb[i];
  __syncthreads();
  const int fr = lane & 15, fq = lane >> 4;
  const int sw = (fr >> 1) & 7;
  for (int kt = 0; kt < nk; ++kt) {
    const int cur = kt & 1;
    if (kt + 1 < nk) {
      const int ko = (kt + 1) << 6;
#pragma unroll
      for (int i = 0; i < 4; ++i) ra[i] = *(const u32x4*)(Ap + (size_t)(32 * i) * lda + ko);
#pragma unroll
      for (int i = 0; i < NB; ++i) rb[i] = *(const u32x4*)(Bp + (size_t)(32 * i) * ldb + ko);
    }
    const u16* cA = sA + cur * (128 * 64) + (wm * 64 + fr) * 64;
    const u16* cB = sB + cur * (BN * 64) + (wn * 16 * NF + fr) * 64;
#pragma unroll
    for (int ks = 0; ks < 2; ++ks) {
      const int pc = ((fq + 4 * ks) ^ sw) << 3;
      bf16x8 fa[4], fb[NF];
#pragma unroll
      for (int i = 0; i < 4; ++i) fa[i] = *(const bf16x8*)(cA + i * 16 * 64 + pc);
#pragma unroll
      for (int j = 0; j < NF; ++j) fb[j] = *(const bf16x8*)(cB + j * 16 * 64 + pc);
#pragma unroll
      for (int i = 0; i < 4; ++i)
#pragma unroll
        for (int j = 0; j < NF; ++j)
          acc[i][j] = __builtin_amdgcn_mfma_f32_16x16x32_bf16(fb[j], fa[i], acc[i][j], 0, 0, 0);
    }
    if (kt + 1 < nk) {
      const int nx = cur ^ 1;
#pragma unroll
      for (int i = 0; i < 4; ++i) *(u32x4*)(sA + nx * (128 * 64) + wofs + 32 * i * 64) = ra[i];
#pragma unroll
      for (int i = 0; i < NB; ++i) *(u32x4*)(sB + nx * (BN * 64) + wofs + 32 * i * 64) = rb[i];
    }
    __syncthreads();
  }
}

template <int NF>
__device__ __forceinline__ void zero_acc(f32x4 (&acc)[4][NF]) {
#pragma unroll
  for (int i = 0; i < 4; ++i)
#pragma unroll
    for (int j = 0; j < NF; ++j) acc[i][j] = f32x4{0.f, 0.f, 0.f, 0.f};
}

template <int EPI>
__device__ __forceinline__ void phase_gemm(const Params& p, int l, unsigned char* smem_raw) {
  u16* smem = (u16*)smem_raw;
  const int lane = threadIdx.x & 63, wv = threadIdx.x >> 6;
  const int wm = wv >> 1, wn = wv & 1;
  const int fr = lane & 15, fq = lane >> 4;
  const u16* A; const u16* B; int lda, ldb, K, ntiles_n;
  if (EPI == 0) { A = (const u16*)(p.ws + OFF_H); lda = 1024; B = (const u16*)(p.ws + OFF_WIN); ldb = 1024; K = 1024; ntiles_n = 19; }
  if (EPI == 1) { A = (const u16*)(p.ws + OFF_MRG); lda = 1024; B = (const u16*)(p.ws + OFF_WO); ldb = 1024; K = 1024; ntiles_n = 8; }
  if (EPI == 2) { A = (const u16*)(p.ws + OFF_H); lda = 1024; B = (const u16*)(p.ws + OFF_W1); ldb = 1024; K = 1024; ntiles_n = 32; }
  if (EPI == 3) { A = (const u16*)(p.ws + OFF_F); lda = 4096; B = (const u16*)(p.ws + OFF_W2); ldb = 4096; K = 4096; ntiles_n = 8; }
  const float* modl = (const float*)(p.ws + OFF_MOD) + (size_t)l * 4 * 6144;
  const int total = 128 * ntiles_n;
  for (int item = blockIdx.x; item < total; item += gridDim.x) {
    const int mt = item & 127, nt = item >> 7;
    const int m0 = mt * 128, n0 = nt * 128;
    f32x4 acc[4][4];
    zero_acc<4>(acc);
    gemm_mainloop<4>(A + (size_t)m0 * lda, lda, B + (size_t)n0 * ldb, ldb, K, acc, smem);
#pragma unroll
    for (int i = 0; i < 4; ++i) {
      const int m = m0 + wm * 64 + i * 16 + fr;
#pragma unroll
      for (int j = 0; j < 4; ++j) {
        const int n = n0 + wn * 64 + j * 16 + fq * 4;
        f32x4 v = acc[i][j];
        if (EPI == 0) {
          u32x2 o; o.x = pack2(v[0], v[1]); o.y = pack2(v[2], v[3]);
          if (n < 2176) *(u32x2*)((u16*)(p.ws + OFF_PABC) + (size_t)m * 2176 + n) = o;
          else *(u32x2*)((u16*)(p.ws + OFF_PD) + (size_t)m * 256 + (n - 2176)) = o;
        } else if (EPI == 1 || EPI == 3) {
          const int b = m >> 12;
          const float* gt = modl + (size_t)b * 6144 + (EPI == 1 ? 2048 : 5120) + n;
          const float* xin = ((EPI == 1 && l == 0) ? p.in[0] : p.out) + (size_t)m * 1024 + n;
          float4 x = *(const float4*)xin;
          float4 gg = *(const float4*)gt;
          float4 o;
          o.x = x.x + gg.x * v[0]; o.y = x.y + gg.y * v[1]; o.z = x.z + gg.z * v[2]; o.w = x.w + gg.w * v[3];
          *(float4*)(p.out + (size_t)m * 1024 + n) = o;
        } else {
          float r0 = fmaxf(v[0], 0.f), r1 = fmaxf(v[1], 0.f), r2 = fmaxf(v[2], 0.f), r3 = fmaxf(v[3], 0.f);
          u32x2 o; o.x = pack2(r0 * r0, r1 * r1); o.y = pack2(r2 * r2, r3 * r3);
          *(u32x2*)((u16*)(p.ws + OFF_F) + (size_t)m * 4096 + n) = o;
        }
      }
    }
  }
}

template <int MODE>
__device__ __forceinline__ void merge_tile(const Params& p, int item, unsigned char* smem_raw) {
  u16* smem = (u16*)smem_raw;
  const int lane = threadIdx.x & 63, wv = threadIdx.x >> 6;
  const int wm = wv >> 1, wn = wv & 1;
  const int fr = lane & 15, fq = lane >> 4;
  const u16* H = (const u16*)(p.ws + OFF_H);
  const u16* WIN = (const u16*)(p.ws + OFF_WIN);
  const int mt = item & 127, nt = item >> 7;
  const int m0 = mt * 128, n0 = nt * 64;
  f32x4 macc[4][2], bacc[4][2], gacc[4][2];
  zero_acc<2>(macc);
#pragma unroll 1
  for (int br = (MODE == 0 ? 1 : 0); br < (MODE == 0 ? 4 : 1); ++br) {
    zero_acc<2>(bacc);
    const u16* Ab; const u16* Wb;
    if (br == 0) { Ab = (const u16*)(p.ws + OFF_OG); Wb = (const u16*)(p.ws + OFF_RO); }
    else if (br == 1) { Ab = (const u16*)(p.ws + OFF_UB); Wb = (const u16*)(p.ws + OFF_SO); }
    else if (br == 2) { Ab = (const u16*)(p.ws + OFF_CB); Wb = (const u16*)(p.ws + OFF_CO); }
    else { Ab = (const u16*)(p.ws + OFF_YD); Wb = (const u16*)(p.ws + OFF_GLU); }
    gemm_mainloop<2>(Ab + (size_t)m0 * 256, 256, Wb + (size_t)n0 * 256, 256, 256, bacc, smem);
    if (MODE == 0 && br == 3) {
      zero_acc<2>(gacc);
      gemm_mainloop<2>(Ab + (size_t)m0 * 256, 256, Wb + (size_t)(1024 + n0) * 256, 256, 256, gacc, smem);
#pragma unroll
      for (int i = 0; i < 4; ++i)
#pragma unroll
        for (int j = 0; j < 2; ++j)
#pragma unroll
          for (int e = 0; e < 4; ++e) bacc[i][j][e] *= sigmoidf_(gacc[i][j][e]);
    }
    zero_acc<2>(gacc);
    gemm_mainloop<2>(H + (size_t)m0 * 1024, 1024, WIN + (size_t)(2432 + br * 1024 + n0) * 1024, 1024, 1024, gacc, smem);
#pragma unroll
    for (int i = 0; i < 4; ++i)
#pragma unroll
      for (int j = 0; j < 2; ++j)
#pragma unroll
        for (int e = 0; e < 4; ++e) macc[i][j][e] += sigmoidf_(gacc[i][j][e]) * bacc[i][j][e];
  }
  u16* MRG = (u16*)(p.ws + OFF_MRG);
#pragma unroll
  for (int i = 0; i < 4; ++i) {
    const int m = m0 + wm * 64 + i * 16 + fr;
#pragma unroll
    for (int j = 0; j < 2; ++j) {
      const int n = n0 + wn * 32 + j * 16 + fq * 4;
      f32x4 v = macc[i][j];
      if (MODE == 1) {
        u32x2 pr = *(const u32x2*)(MRG + (size_t)m * 1024 + n);
        v[0] += bflo(pr.x); v[1] += bfhi(pr.x); v[2] += bflo(pr.y); v[3] += bfhi(pr.y);
      }
      u32x2 o; o.x = pack2(v[0], v[1]); o.y = pack2(v[2], v[3]);
      *(u32x2*)(MRG + (size_t)m * 1024 + n) = o;
    }
  }
}

__device__ __forceinline__ float shifted(const u16* __restrict__ P, int tok, int col, float mu) {
  float pv = bf2f(P[(size_t)tok * 2176 + col]);
  float pr = (tok & (SEQ - 1)) ? bf2f(P[(size_t)(tok - 1) * 2176 + col]) : 0.f;
  return pv + (pr - pv) * mu;
}

__device__ __forceinline__ void rwkv_prep_item(const Params& p, int l, int item, unsigned char* smem) {
  const int tid = threadIdx.x;
  float* sl = (float*)smem;
  float* sv = sl + 32 * 128;
  float* svl = sv + 32 * 256;
  const u16* P = (const u16*)(p.ws + OFF_PABC);
  const float* mu = p.in[6] + l * 896;
  const int tok0 = item * 32;
  for (int idx = tid; idx < 32 * 128; idx += NTHR) {
    int t = idx >> 7, ci = idx & 127;
    float v = shifted(P, tok0 + t, 768 + ci, mu[768 + ci]);
    if (ci < 32) v = tanhf_(v);
    else if (ci >= 64) v = sigmoidf_(v);
    sl[idx] = v;
  }
  if (l > 0) {
    float m = mu[512 + tid];
    for (int t = 0; t < 32; ++t) sv[t * 256 + tid] = shifted(P, tok0 + t, 512 + tid, m);
  }
  __syncthreads();
  if (l > 0) {
    const float* v1 = p.in[13];
    int t = tid >> 3, o4 = (tid & 7) * 4;
    float a0 = 0, a1 = 0, a2 = 0, a3 = 0;
    for (int k = 0; k < 256; ++k) {
      float s = sv[t * 256 + k];
      float4 w = *(const float4*)(v1 + k * 32 + o4);
      a0 += s * w.x; a1 += s * w.y; a2 += s * w.z; a3 += s * w.w;
    }
    svl[t * 32 + o4 + 0] = a0; svl[t * 32 + o4 + 1] = a1; svl[t * 32 + o4 + 2] = a2; svl[t * 32 + o4 + 3] = a3;
    __syncthreads();
  }
  const int j = tid;
  const float* w2 = p.in[8] + l * 32 * 256;
  const float* a2w = p.in[10] + l * 32 * 256;
  const float* g2 = p.in[11] + l * 64 * 256;
  const float* v2 = p.in[14];
  const float w0 = p.in[7][l * 256 + j], a0c = p.in[9][l * 256 + j];
  const float v0 = (l > 0) ? p.in[12][j] : 0.f;
  const float kkc = p.in[15][l * 256 + j], kac = p.in[16][l * 256 + j];
  const float mur = mu[j], muk = mu[256 + j], muv = mu[512 + j];
  u16* SR = (u16*)(p.ws + OFF_SR); u16* SK = (u16*)(p.ws + OFF_SK); u16* SV = (u16*)(p.ws + OFF_SV);
  u16* SKK = (u16*)(p.ws + OFF_SKK); u16* SA = (u16*)(p.ws + OFF_SA); float* SW = (float*)(p.ws + OFF_SW);
  u16* G = (u16*)(p.ws + OFF_G); u16* VF = (u16*)(p.ws + OFF_VF);
#pragma unroll 1
  for (int tg = 0; tg < 4; ++tg) {
    float accw[8], acca[8], accg[8], accv[8];
#pragma unroll
    for (int tt = 0; tt < 8; ++tt) { accw[tt] = 0; acca[tt] = 0; accg[tt] = 0; accv[tt] = 0; }
#pragma unroll 2
    for (int k4 = 0; k4 < 8; ++k4) {
      float ww[4], wa[4];
#pragma unroll
      for (int e = 0; e < 4; ++e) { ww[e] = w2[(k4 * 4 + e) * 256 + j]; wa[e] = a2w[(k4 * 4 + e) * 256 + j]; }
#pragma unroll
      for (int tt = 0; tt < 8; ++tt) {
        float4 s = *(const float4*)(sl + (tg * 8 + tt) * 128 + k4 * 4);
        float4 s2 = *(const float4*)(sl + (tg * 8 + tt) * 128 + 32 + k4 * 4);
        accw[tt] += s.x * ww[0] + s.y * ww[1] + s.z * ww[2] + s.w * ww[3];
        acca[tt] += s2.x * wa[0] + s2.y * wa[1] + s2.z * wa[2] + s2.w * wa[3];
      }
    }
#pragma unroll 2
    for (int k4 = 0; k4 < 16; ++k4) {
      float wg[4];
#pragma unroll
      for (int e = 0; e < 4; ++e) wg[e] = g2[(k4 * 4 + e) * 256 + j];
#pragma unroll
      for (int tt = 0; tt < 8; ++tt) {
        float4 s = *(const float4*)(sl + (tg * 8 + tt) * 128 + 64 + k4 * 4);
        accg[tt] += s.x * wg[0] + s.y * wg[1] + s.z * wg[2] + s.w * wg[3];
      }
    }
    if (l > 0) {
#pragma unroll 2
      for (int k4 = 0; k4 < 8; ++k4) {
        float wvv[4];
#pragma unroll
        for (int e = 0; e < 4; ++e) wvv[e] = v2[(k4 * 4 + e) * 256 + j];
#pragma unroll
        for (int tt = 0; tt < 8; ++tt) {
          float4 s = *(const float4*)(svl + (tg * 8 + tt) * 32 + k4 * 4);
          accv[tt] += s.x * wvv[0] + s.y * wvv[1] + s.z * wvv[2] + s.w * wvv[3];
        }
      }
    }
#pragma unroll
    for (int tt = 0; tt < 8; ++tt) {
      const int tok = tok0 + tg * 8 + tt;
      float r = shifted(P, tok, j, mur);
      float k = shifted(P, tok, 256 + j, muk);
      float v = shifted(P, tok, 512 + j, muv);
      float wl = w0 + accw[tt];
      float z = -wl;
      float sp = (z > 15.f) ? z : log1pf(__expf(z));
      float lw = -sp - 0.5f;
      float decay = __expf(-__expf(lw));
      float a = sigmoidf_(a0c + acca[tt]);
      float g = accg[tt];
      const size_t o = (size_t)tok * 256 + j;
      if (l == 0) {
        VF[o] = f2bf(v);
      } else {
        float vf = bf2f(VF[o]);
        v = v + (vf - v) * sigmoidf_(v0 + accv[tt]);
      }
      float kk = k * kkc;
      float ss = wave_sum(kk * kk);
      kk = kk / fmaxf(sqrtf(ss), 1e-12f);
      float km = k * (1.f + (a - 1.f) * kac);
      SR[o] = f2bf(r); SK[o] = f2bf(km); SV[o] = f2bf(v); SKK[o] = f2bf(kk); SA[o] = f2bf(a);
      SW[o] = decay; G[o] = f2bf(g);
    }
  }
  __syncthreads();
}

__device__ __forceinline__ void sg_item(const Params& p, int l, int item, unsigned char* smem) {
  const int tid = threadIdx.x, lane = tid & 63, wv = tid >> 6;
  u16* vsT = (u16*)smem;
  float* smu = (float*)(smem + 16384);
  float* srs = smu + 128;
  const u16* P = (const u16*)(p.ws + OFF_PABC);
  const int g = item & 3, chn = item >> 2;
  const int tok0 = chn * 128;
  {
    const int t = tid >> 1, hf = tid & 1;
    const u16* src = P + (size_t)(tok0 + t) * 2176 + 896 + 256 + hf * 128;
    float sm = 0.f, ss = 0.f;
#pragma unroll 4
    for (int i = 0; i < 16; ++i) {
      u32x4 raw = *(const u32x4*)(src + i * 8);
      float z;
      z = geluf_(bflo(raw.x)); sm += z; ss += z * z;  z = geluf_(bfhi(raw.x)); sm += z; ss += z * z;
      z = geluf_(bflo(raw.y)); sm += z; ss += z * z;  z = geluf_(bfhi(raw.y)); sm += z; ss += z * z;
      z = geluf_(bflo(raw.z)); sm += z; ss += z * z;  z = geluf_(bfhi(raw.z)); sm += z; ss += z * z;
      z = geluf_(bflo(raw.w)); sm += z; ss += z * z;  z = geluf_(bfhi(raw.w)); sm += z; ss += z * z;
    }
    sm += __shfl_xor(sm, 1, 64); ss += __shfl_xor(ss, 1, 64);
    const float mean = sm * (1.f / 256.f);
    const float var = fmaxf(ss * (1.f / 256.f) - mean * mean, 0.f);
    if (hf == 0) { smu[t] = mean; srs[t] = rsqrtf(var + 1e-5f); }
  }
  __syncthreads();
  {
    const int c = tid & 63, tb = tid >> 6;
    const float lw = p.in[21][l * 256 + g * 64 + c], lb = p.in[22][l * 256 + g * 64 + c];
#pragma unroll
    for (int j = 0; j < 4; ++j) {
      u16 raw[8];
#pragma unroll
      for (int e = 0; e < 8; ++e) raw[e] = P[(size_t)(tok0 + tb * 32 + j * 8 + e) * 2176 + 896 + 256 + g * 64 + c];
      float vv[8];
#pragma unroll
      for (int e = 0; e < 8; ++e) {
        const int t = tb * 32 + j * 8 + e;
        vv[e] = (geluf_(bf2f(raw[e])) - smu[t]) * srs[t] * lw + lb;
      }
      const int phys = (tb * 4 + j) ^ (c & 15);
      *(u32x4*)(vsT + c * 128 + phys * 8) = u32x4{pack2(vv[0], vv[1]), pack2(vv[2], vv[3]), pack2(vv[4], vv[5]), pack2(vv[6], vv[7])};
    }
  }
  __syncthreads();
  {
    const int fr = lane & 15, fq = lane >> 4;
    const u16* Wm = (const u16*)(p.ws + OFF_SGW) + (size_t)g * 128 * 128;
    f32x4 acc[2][4];
#pragma unroll
    for (int i = 0; i < 2; ++i)
#pragma unroll
      for (int j = 0; j < 4; ++j) acc[i][j] = f32x4{0.f, 0.f, 0.f, 0.f};
    for (int ks = 0; ks <= wv; ++ks) {
      bf16x8 fa[2], fb[4];
#pragma unroll
      for (int i = 0; i < 2; ++i) fa[i] = *(const bf16x8*)(Wm + (size_t)(32 * wv + 16 * i + fr) * 128 + ks * 32 + fq * 8);
#pragma unroll
      for (int j = 0; j < 4; ++j) fb[j] = *(const bf16x8*)(vsT + (j * 16 + fr) * 128 + (((ks * 4 + fq) ^ fr) << 3));
#pragma unroll
      for (int i = 0; i < 2; ++i)
#pragma unroll
        for (int j = 0; j < 4; ++j) acc[i][j] = __builtin_amdgcn_mfma_f32_16x16x32_bf16(fb[j], fa[i], acc[i][j], 0, 0, 0);
    }
    const float* bs = p.in[24] + ((size_t)l * 4 + g) * 128;
    u16* UB = (u16*)(p.ws + OFF_UB);
#pragma unroll
    for (int i = 0; i < 2; ++i) {
      const int t = 32 * wv + 16 * i + fr;
      const float bsv = bs[t];
#pragma unroll
      for (int j = 0; j < 4; ++j) {
        const int cc = j * 16 + fq * 4;
        u32x2 ur = *(const u32x2*)(P + (size_t)(tok0 + t) * 2176 + 896 + g * 64 + cc);
        float o0 = geluf_(bflo(ur.x)) * (acc[i][j][0] + bsv), o1 = geluf_(bfhi(ur.x)) * (acc[i][j][1] + bsv);
        float o2 = geluf_(bflo(ur.y)) * (acc[i][j][2] + bsv), o3 = geluf_(bfhi(ur.y)) * (acc[i][j][3] + bsv);
        *(u32x2*)(UB + (size_t)(tok0 + t) * 256 + g * 64 + cc) = u32x2{pack2(o0, o1), pack2(o2, o3)};
      }
    }
  }
  __syncthreads();
}

__device__ __forceinline__ void conv_item(const Params& p, int l, int item) {
  const int j = threadIdx.x;
  const u16* P = (const u16*)(p.ws + OFF_PABC);
  u16* CB = (u16*)(p.ws + OFF_CB);
  const float c0 = p.in[26][(l * 3 + 0) * 256 + j], c1 = p.in[26][(l * 3 + 1) * 256 + j], c2 = p.in[26][(l * 3 + 2) * 256 + j];
  const int tok0 = item * 8;
  u16 rc[10], rx[10], rb[8];
  const bool first = (tok0 & (SEQ - 1)) == 0;
#pragma unroll
  for (int t = 0; t < 10; ++t) {
    const int tok = (first && t < 2) ? tok0 : tok0 + t - 2;
    const u16* q = P + (size_t)tok * 2176 + 1408;
    rc[t] = q[256 + j]; rx[t] = q[512 + j];
    if (t >= 2) rb[t - 2] = q[j];
  }
  float z[10];
#pragma unroll
  for (int t = 0; t < 10; ++t) z[t] = bf2f(rc[t]) * bf2f(rx[t]);
  if (first) { z[0] = 0.f; z[1] = 0.f; }
#pragma unroll
  for (int t = 0; t < 8; ++t) {
    float y = c0 * z[t] + c1 * z[t + 1] + c2 * z[t + 2];
    CB[(size_t)(tok0 + t) * 256 + j] = f2bf(bf2f(rb[t]) * y);
  }
}

__device__ __forceinline__ void s5_load_u(const u16* us, int t, int wv, float (&u)[16]) {
  const u32x4* q = (const u32x4*)(us + t * 64 + wv * 16);
  u32x4 a = q[0], b = q[1];
  u[0] = bflo(a.x); u[1] = bfhi(a.x); u[2] = bflo(a.y); u[3] = bfhi(a.y);
  u[4] = bflo(a.z); u[5] = bfhi(a.z); u[6] = bflo(a.w); u[7] = bfhi(a.w);
  u[8] = bflo(b.x); u[9] = bfhi(b.x); u[10] = bflo(b.y); u[11] = bfhi(b.y);
  u[12] = bflo(b.z); u[13] = bfhi(b.z); u[14] = bflo(b.w); u[15] = bfhi(b.w);
}
__device__ __forceinline__ void s5_stage_u(const u16* __restrict__ PD, int tok0, int gq, u16* us) {
#pragma unroll
  for (int i = 0; i < 2; ++i) {
    const int ch = threadIdx.x + 256 * i;
    const int t = ch >> 3, part = ch & 7;
    *(u32x4*)(us + t * 64 + part * 8) = *(const u32x4*)(PD + (size_t)(tok0 + t) * 256 + gq * 64 + part * 8);
  }
}

__device__ __forceinline__ void s5a_item(const Params& p, int l, int item, unsigned char* smem) {
  const int lane = threadIdx.x & 63, wv = threadIdx.x >> 6;
  const int gq = item & 3, bc = item >> 2;
  const int g = gq * 4 + wv;
  const int tok0 = bc * 64;
  const u16* PD = (const u16*)(p.ws + OFF_PD);
  const float* ab = (const float*)(p.ws + OFF_S5AB) + ((size_t)(l * 16 + g) * 64 + lane) * 2;
  const float* bb = (const float*)(p.ws + OFF_S5BB) + ((size_t)(l * 16 + g) * 64 + lane) * 32;
  float bbr[16], bbi[16];
#pragma unroll
  for (int c = 0; c < 16; ++c) { bbr[c] = bb[c]; bbi[c] = bb[16 + c]; }
  const float abr = ab[0], abi = ab[1];
  float xr = 0.f, xi = 0.f;
  u16* us = (u16*)smem;
  s5_stage_u(PD, tok0, gq, us);
  __syncthreads();
#pragma unroll 4
  for (int t = 0; t < 64; ++t) {
    float u[16];
    s5_load_u(us, t, wv, u);
    float bur = 0.f, bui = 0.f;
#pragma unroll
    for (int c = 0; c < 16; ++c) { bur += bbr[c] * u[c]; bui += bbi[c] * u[c]; }
    float nr = abr * xr - abi * xi + bur;
    float ni = abr * xi + abi * xr + bui;
    xr = nr; xi = ni;
  }
  float2* E = (float2*)(p.ws + OFF_S5E);
  E[((size_t)bc * 16 + g) * 64 + lane] = make_float2(xr, xi);
  __syncthreads();
}

__device__ __forceinline__ void s5b_item(const Params& p, int l, int item, unsigned char* smem) {
  const int lane = threadIdx.x & 63, wv = threadIdx.x >> 6;
  const int gq = item & 3, bc = item >> 2;
  const int b = bc >> 6, ch = bc & 63;
  const int g = gq * 4 + wv;
  const int tok0 = bc * 64;
  u16* us = (u16*)(smem + 65536);
  s5_stage_u((const u16*)(p.ws + OFF_PD), tok0, gq, us);
  float* base = (float*)smem + wv * 4096;
  float* csr = base, *csi = base + 1024, *xsr = base + 2048, *xsi = base + 3072;
  const u16* PD = (const u16*)(p.ws + OFF_PD);
  const float* ab = (const float*)(p.ws + OFF_S5AB) + ((size_t)(l * 16 + g) * 64 + lane) * 2;
  const float* bb = (const float*)(p.ws + OFF_S5BB) + ((size_t)(l * 16 + g) * 64 + lane) * 32;
  const float* cre = p.in[32] + ((size_t)(l * 16 + g) * 16) * 64;
  const float* cim = p.in[33] + ((size_t)(l * 16 + g) * 16) * 64;
  for (int c = 0; c < 16; ++c) {
    csr[(lane >> 2) * 64 + c * 4 + (lane & 3)] = cre[c * 64 + lane];
    csi[(lane >> 2) * 64 + c * 4 + (lane & 3)] = cim[c * 64 + lane];
  }
  float bbr[16], bbi[16];
#pragma unroll
  for (int c = 0; c < 16; ++c) { bbr[c] = bb[c]; bbi[c] = bb[16 + c]; }
  const float abr = ab[0], abi = ab[1];
  float pr = abr, pi = abi;
#pragma unroll
  for (int s = 0; s < 6; ++s) { float nr = pr * pr - pi * pi, ni = 2.f * pr * pi; pr = nr; pi = ni; }
  float xr = 0.f, xi = 0.f;
  const float2* E = (const float2*)(p.ws + OFF_S5E);
  for (int c = 0; c < ch; ++c) {
    float2 e = E[((size_t)(b * 64 + c) * 16 + g) * 64 + lane];
    float nr = pr * xr - pi * xi + e.x;
    float ni = pr * xi + pi * xr + e.y;
    xr = nr; xi = ni;
  }
  const int tt = lane & 15, cq = lane >> 4;
  const float* dvec = p.in[34] + l * 256 + g * 16 + cq * 4;
  const float d0 = dvec[0], d1 = dvec[1], d2 = dvec[2], d3 = dvec[3];
  u16* YD = (u16*)(p.ws + OFF_YD);
  const int n4w = lane >> 2, e4 = lane & 3;
  __syncthreads();
#pragma unroll 1
  for (int sc = 0; sc < 4; ++sc) {
    for (int t = 0; t < 16; ++t) {
      float u[16];
      s5_load_u(us, sc * 16 + t, wv, u);
      float bur = 0.f, bui = 0.f;
#pragma unroll
      for (int c = 0; c < 16; ++c) { bur += bbr[c] * u[c]; bui += bbi[c] * u[c]; }
      float nr = abr * xr - abi * xi + bur;
      float ni = abr * xi + abi * xr + bui;
      xr = nr; xi = ni;
      int a = n4w * 64 + ((t ^ (n4w & 7)) << 2) + e4;
      xsr[a] = xr; xsi[a] = xi;
    }
    __syncthreads();
    float acc0 = 0.f, acc1 = 0.f, acc2 = 0.f, acc3 = 0.f;
#pragma unroll 2
    for (int n4 = 0; n4 < 16; ++n4) {
      int xa = n4 * 64 + ((tt ^ (n4 & 7)) << 2);
      float4 xr4 = *(const float4*)(xsr + xa);
      float4 xi4 = *(const float4*)(xsi + xa);
      const float* cr = csr + n4 * 64 + cq * 16;
      const float* ci = csi + n4 * 64 + cq * 16;
      float4 r0 = *(const float4*)(cr), r1 = *(const float4*)(cr + 4), r2 = *(const float4*)(cr + 8), r3 = *(const float4*)(cr + 12);
      float4 i0 = *(const float4*)(ci), i1 = *(const float4*)(ci + 4), i2 = *(const float4*)(ci + 8), i3 = *(const float4*)(ci + 12);
      acc0 += r0.x * xr4.x + r0.y * xr4.y + r0.z * xr4.z + r0.w * xr4.w - (i0.x * xi4.x + i0.y * xi4.y + i0.z * xi4.z + i0.w * xi4.w);
      acc1 += r1.x * xr4.x + r1.y * xr4.y + r1.z * xr4.z + r1.w * xr4.w - (i1.x * xi4.x + i1.y * xi4.y + i1.z * xi4.z + i1.w * xi4.w);
      acc2 += r2.x * xr4.x + r2.y * xr4.y + r2.z * xr4.z + r2.w * xr4.w - (i2.x * xi4.x + i2.y * xi4.y + i2.z * xi4.z + i2.w * xi4.w);
      acc3 += r3.x * xr4.x + r3.y * xr4.y + r3.z * xr4.z + r3.w * xr4.w - (i3.x * xi4.x + i3.y * xi4.y + i3.z * xi4.z + i3.w * xi4.w);
    }
    {
      const int tok = tok0 + sc * 16 + tt;
      u32x2 ur = *(const u32x2*)(us + (sc * 16 + tt) * 64 + wv * 16 + cq * 4);
      float y0 = acc0 + d0 * bflo(ur.x), y1 = acc1 + d1 * bfhi(ur.x), y2 = acc2 + d2 * bflo(ur.y), y3 = acc3 + d3 * bfhi(ur.y);
      u32x2 o; o.x = pack2(geluf_(y0), geluf_(y1)); o.y = pack2(geluf_(y2), geluf_(y3));
      *(u32x2*)(YD + (size_t)tok * 256 + g * 16 + cq * 4) = o;
    }
    __syncthreads();
  }
}

__device__ __forceinline__ void lds_barrier() {
  asm volatile("s_waitcnt lgkmcnt(0)" ::: "memory");
  __builtin_amdgcn_s_barrier();
  asm volatile("" ::: "memory");
}
using f32x2 = __attribute__((ext_vector_type(2))) float;
__device__ __forceinline__ void scan_item(const Params& p, int item, unsigned char* smem) {
  const int tid = threadIdx.x, lane = tid & 63, wv = tid >> 6;
  const int b = item >> 4, h = (item >> 2) & 3, q = item & 3;
  const int rl = lane >> 4, cl = lane & 15;
  const int rloc = wv * 4 + rl;
  const size_t tokb = (size_t)b * SEQ;
  const int chan0 = h * 64;
  const u16* SR = (const u16*)(p.ws + OFF_SR); const u16* SK = (const u16*)(p.ws + OFF_SK);
  const u16* SV = (const u16*)(p.ws + OFF_SV); const u16* SKK = (const u16*)(p.ws + OFF_SKK);
  const u16* SA = (const u16*)(p.ws + OFF_SA); const float* SW = (const float*)(p.ws + OFF_SW);
  float* O = (float*)(p.ws + OFF_O);
  constexpr int BUFF = 5376;
  float* lbase = (float*)smem;
  float* pp = lbase + 2 * BUFF + wv * 1024;
  const int st = tid >> 4, cg4 = tid & 15;
  struct Stg { u32x2 r, k, kk, a; f32x4 w; u16 v; };
  auto gload = [&](Stg& g, int c) {
    const size_t o = (tokb + (size_t)c * 16 + st) * 256 + chan0;
    g.r = *(const u32x2*)(SR + o + cg4 * 4); g.k = *(const u32x2*)(SK + o + cg4 * 4);
    g.kk = *(const u32x2*)(SKK + o + cg4 * 4); g.a = *(const u32x2*)(SA + o + cg4 * 4);
    g.w = *(const f32x4*)(SW + o + cg4 * 4);
    g.v = SV[o + q * 16 + cg4];
  };
  auto lwrite = [&](const Stg& g, int buf) {
    float* bp = lbase + buf * BUFF;
    const int o = st * 64 + cg4 * 4;
    f32x4 kk = {bflo(g.kk.x), bfhi(g.kk.x), bflo(g.kk.y), bfhi(g.kk.y)};
    f32x4 a = {bflo(g.a.x), bfhi(g.a.x), bflo(g.a.y), bfhi(g.a.y)};
    f32x4 k = {bflo(g.k.x), bfhi(g.k.x), bflo(g.k.y), bfhi(g.k.y)};
    f32x4 r = {bflo(g.r.x), bfhi(g.r.x), bflo(g.r.y), bfhi(g.r.y)};
    *(f32x4*)(bp + o) = kk;
    *(f32x4*)(bp + 1024 + o) = kk * a;
    *(f32x4*)(bp + 2048 + o) = k;
    *(f32x4*)(bp + 3072 + o) = g.w;
    *(f32x4*)(bp + 4096 + o) = r;
    bp[5120 + st * 16 + cg4] = bf2f(g.v);
  };
  constexpr int NCH = SEQ / 16;
  Stg R0, R1, R2, R3;
  gload(R0, 0); gload(R1, 1); gload(R2, 2); gload(R3, 3);
  __syncthreads();
  lwrite(R0, 0);
  __syncthreads();
  __builtin_amdgcn_s_setprio(3);
  float S0 = 0.f, S1 = 0.f, S2 = 0.f, S3 = 0.f;
  const int rrow = lane & 3, rstep = lane >> 2;
  struct Ops { f32x4 kk, bb, k4, w4, r4; float v; };
  auto chunk = [&](int c) {
    const float* bp = lbase + (c & 1) * BUFF;
    auto ldops = [&](Ops& o, int s) {
      o.kk = *(const f32x4*)(bp + s * 64 + cl * 4);
      o.bb = *(const f32x4*)(bp + 1024 + s * 64 + cl * 4);
      o.k4 = *(const f32x4*)(bp + 2048 + s * 64 + cl * 4);
      o.w4 = *(const f32x4*)(bp + 3072 + s * 64 + cl * 4);
      o.r4 = *(const f32x4*)(bp + 4096 + s * 64 + cl * 4);
      o.v = bp[5120 + s * 16 + rloc];
    };
    auto step = [&](const Ops& o, int s) {
      const float sa = row_sum16(__builtin_fmaf(S3, o.kk.w, __builtin_fmaf(S2, o.kk.z, __builtin_fmaf(S1, o.kk.y, S0 * o.kk.x))));
      S0 = __builtin_fmaf(S0, o.w4.x, __builtin_fmaf(o.v, o.k4.x, -(sa * o.bb.x)));
      S1 = __builtin_fmaf(S1, o.w4.y, __builtin_fmaf(o.v, o.k4.y, -(sa * o.bb.y)));
      S2 = __builtin_fmaf(S2, o.w4.z, __builtin_fmaf(o.v, o.k4.z, -(sa * o.bb.z)));
      S3 = __builtin_fmaf(S3, o.w4.w, __builtin_fmaf(o.v, o.k4.w, -(sa * o.bb.w)));
      pp[(s * 4 + rl) * 16 + cl] = __builtin_fmaf(S3, o.r4.w, __builtin_fmaf(S2, o.r4.z, __builtin_fmaf(S1, o.r4.y, S0 * o.r4.x)));
    };
    Ops a0, a1, b0, b1;
    ldops(a0, 0); ldops(a1, 1);
#pragma unroll
    for (int j = 0; j < 4; ++j) {
      ldops(b0, 4 * j + 2); ldops(b1, 4 * j + 3);
      __builtin_amdgcn_sched_barrier(0);
      step(a0, 4 * j); step(a1, 4 * j + 1);
      __builtin_amdgcn_sched_barrier(0);
      if (j < 3) { ldops(a0, 4 * j + 4); ldops(a1, 4 * j + 5); }
      __builtin_amdgcn_sched_barrier(0);
      step(b0, 4 * j + 2); step(b1, 4 * j + 3);
      __builtin_amdgcn_sched_barrier(0);
    }
    asm volatile("" ::: "memory");
    {
      const float* q0 = pp + (rstep * 4 + rrow) * 16;
      f32x4 a0 = *(const f32x4*)(q0), a1 = *(const f32x4*)(q0 + 4), a2 = *(const f32x4*)(q0 + 8), a3 = *(const f32x4*)(q0 + 12);
      f32x4 sm4 = (a0 + a1) + (a2 + a3);
      O[(tokb + (size_t)c * 16 + rstep) * 256 + chan0 + q * 16 + wv * 4 + rrow] = (sm4.x + sm4.y) + (sm4.z + sm4.w);
    }
    asm volatile("" ::: "memory");
  };
#pragma unroll 1
  for (int g = 0; g < NCH / 4; ++g) {
    const int c0 = g * 4;
    if (c0 + 4 < NCH) gload(R0, c0 + 4);
    chunk(c0);
    lwrite(R1, (c0 + 1) & 1);
    lds_barrier();
    if (c0 + 5 < NCH) gload(R1, c0 + 5);
    chunk(c0 + 1);
    lwrite(R2, (c0 + 2) & 1);
    lds_barrier();
    if (c0 + 6 < NCH) gload(R2, c0 + 6);
    chunk(c0 + 2);
    lwrite(R3, (c0 + 3) & 1);
    lds_barrier();
    if (c0 + 7 < NCH) gload(R3, c0 + 7);
    chunk(c0 + 3);
    if (c0 + 4 < NCH) lwrite(R0, (c0 + 4) & 1);
    lds_barrier();
  }
  __builtin_amdgcn_s_setprio(0);
}

__device__ __forceinline__ void rwkv_post_item(const Params& p, int l, int item) {
  const int j = threadIdx.x;
  const float* O = (const float*)(p.ws + OFF_O);
  const u16* SR = (const u16*)(p.ws + OFF_SR); const u16* SK = (const u16*)(p.ws + OFF_SK);
  const u16* SV = (const u16*)(p.ws + OFF_SV); const u16* G = (const u16*)(p.ws + OFF_G);
  u16* OG = (u16*)(p.ws + OFF_OG);
  const float lw = p.in[18][l * 256 + j], lb = p.in[19][l * 256 + j], rk = p.in[17][l * 256 + j];
  const int tok0 = item * 8;
  float ov[8]; u16 rr[8], rkk[8], rv[8], rg[8];
#pragma unroll
  for (int t = 0; t < 8; ++t) {
    const size_t o = (size_t)(tok0 + t) * 256 + j;
    ov[t] = O[o]; rr[t] = SR[o]; rkk[t] = SK[o]; rv[t] = SV[o]; rg[t] = G[o];
  }
#pragma unroll
  for (int t = 0; t < 8; ++t) {
    const size_t o = (size_t)(tok0 + t) * 256 + j;
    float mean = wave_sum(ov[t]) * (1.f / 64.f);
    float d = ov[t] - mean;
    float var = wave_sum(d * d) * (1.f / 64.f);
    float on = d * rsqrtf(var + 64e-5f) * lw + lb;
    float bonus = wave_sum(bf2f(rr[t]) * bf2f(rkk[t]) * rk);
    OG[o] = f2bf((on + bonus * bf2f(rv[t])) * bf2f(rg[t]));
  }
}

#define XB_TMO      128
#define XB_XCNT(j)  (256  + 64 * (j))
#define XB_XSUB(j)  (1280 + 64 * (j))
#define XB_XGEN(j)  (2304 + 64 * (j))
#define XB_TOP      3328
#define XB_TOPGEN   3392
#define XCD_BAR_WORDS 3456
#define XB_SPIN_CAP (1u << 22)
#define LAS __attribute__((address_space(3)))
__device__ __forceinline__ unsigned xb_ld(unsigned* p) { return __hip_atomic_load(p, __ATOMIC_RELAXED, __HIP_MEMORY_SCOPE_AGENT); }
__device__ __forceinline__ unsigned xb_add(unsigned* p, unsigned v) { return __hip_atomic_fetch_add(p, v, __ATOMIC_RELAXED, __HIP_MEMORY_SCOPE_AGENT); }
__device__ __forceinline__ unsigned xb_xcc_id() { return (unsigned)__builtin_amdgcn_s_getreg((3 << 11) | 20) & 0xFu; }
#define XB_SPIN(cond, bar) do { unsigned _sp = 0; while (cond) { __builtin_amdgcn_s_sleep(1); \
    if ((++_sp & 255u) == 0u) { if (xb_ld(&(bar)[XB_TMO])) break; if (_sp > XB_SPIN_CAP) { atomicAdd(&(bar)[XB_TMO], 1u); break; } } } } while (0)
struct XcdBarrier { unsigned* bar; unsigned x; volatile LAS unsigned* st; };
__device__ __forceinline__ XcdBarrier xcd_barrier_post(unsigned* bar, volatile LAS unsigned* st) {
  XcdBarrier b; b.bar = bar; b.x = xb_xcc_id(); b.st = st;
  if (threadIdx.x == 0) (void)xb_add(&bar[XB_XCNT(b.x)], 1u);
  return b;
}
__device__ __forceinline__ void xcd_barrier_complete(unsigned* bar, unsigned x, unsigned& nloc, unsigned& nx) {
  const unsigned G = gridDim.x * gridDim.y * gridDim.z;
  unsigned sum, cnt, mine, sp = 0u;
  for (;;) {
    sum = 0u; cnt = 0u; mine = 0u;
#pragma unroll
    for (unsigned j = 0; j < 16; ++j) { const unsigned c = xb_ld(&bar[XB_XCNT(j)]); sum += c; cnt += (c > 0u) ? 1u : 0u; mine = (j == x) ? c : mine; }
    if (sum == G) break;
    __builtin_amdgcn_s_sleep(1);
    if ((++sp & 255u) == 0u) { if (xb_ld(&bar[XB_TMO])) break; if (sp > XB_SPIN_CAP) { atomicAdd(&bar[XB_TMO], 1u); break; } }
  }
  nloc = mine > 0u ? mine : 1u; nx = cnt > 0u ? cnt : 1u;
}
__device__ __forceinline__ void xcd_barrier(const XcdBarrier& b) {
  asm volatile("s_waitcnt vmcnt(0)" ::: "memory");
  __syncthreads();
  if (threadIdx.x == 0) {
    unsigned* bar = b.bar;
    __builtin_amdgcn_s_waitcnt(0);
    unsigned nloc = b.st[0], nx = b.st[1];
    if (nloc == 0u) { xcd_barrier_complete(bar, b.x, nloc, nx); b.st[0] = nloc; b.st[1] = nx; }
    const unsigned old = xb_add(&bar[XB_XSUB(b.x)], 1u);
    const unsigned gen = old / nloc;
    if (old + 1u == (gen + 1u) * nloc) {
      __builtin_amdgcn_fence(__ATOMIC_RELEASE, "agent");
      asm volatile("s_waitcnt vmcnt(0)" ::: "memory");
      const unsigned og = xb_add(&bar[XB_TOP], 1u);
      const unsigned tg = og / nx;
      if (og + 1u == (tg + 1u) * nx) xb_add(&bar[XB_TOPGEN], 1u);
      else XB_SPIN(xb_ld(&bar[XB_TOPGEN]) == tg, bar);
      __builtin_amdgcn_fence(__ATOMIC_ACQUIRE, "agent");
      xb_add(&bar[XB_XGEN(b.x)], 1u);
      asm volatile("s_waitcnt vmcnt(0)" ::: "memory");
    } else {
      XB_SPIN(xb_ld(&bar[XB_XGEN(b.x)]) == gen, bar);
      __builtin_amdgcn_fence(__ATOMIC_ACQUIRE, "agent");
      asm volatile("s_waitcnt vmcnt(0)" ::: "memory");
    }
  }
  __syncthreads();
}

__device__ __forceinline__ void sub_barrier(unsigned* cnt, unsigned target) {
  asm volatile("s_waitcnt vmcnt(0)" ::: "memory");
  __syncthreads();
  if (threadIdx.x == 0) {
    __builtin_amdgcn_fence(__ATOMIC_RELEASE, "agent");
    asm volatile("s_waitcnt vmcnt(0)" ::: "memory");
    xb_add(cnt, 1u);
    unsigned sp = 0;
    while (xb_ld(cnt) < target) { __builtin_amdgcn_s_sleep(2); if (++sp > (1u << 24)) break; }
    __builtin_amdgcn_fence(__ATOMIC_ACQUIRE, "agent");
    asm volatile("s_waitcnt vmcnt(0)" ::: "memory");
  }
  __syncthreads();
}

#define N_PHASES 22
#ifndef PROBE_CONV_REPS
#define PROBE_CONV_REPS 1
#endif
#ifndef PROBE_PREP_REPS
#define PROBE_PREP_REPS 1
#endif
#ifndef PROBE_POST_REPS
#define PROBE_POST_REPS 1
#endif
#ifndef PROBE_SCAN_REPS
#define PROBE_SCAN_REPS 1
#endif
#ifndef PROBE_FFN1_REPS
#define PROBE_FFN1_REPS 1
#endif
#ifndef PH_MASK
#define PH_MASK 0xFFFFF
#endif
#define PHON(s) (PH_MASK & (1 << (s)))
#define PHASE_BEGIN(k) if (ph_lo <= (k) && (k) < ph_hi) { if ((k) > ph_lo) xcd_barrier(xb);
#define PHASE_END }

template <int L>
__device__ __forceinline__ void run_layer(const Params& p, int ph_lo, int ph_hi, unsigned char* smem, const XcdBarrier& xb) {
  constexpr int l = L;
  constexpr int base = 1 + 10 * L;
  const float* modl = (const float*)(p.ws + OFF_MOD) + (size_t)l * 4 * 6144;
  PHASE_BEGIN(base + 0)
    for (int rep = 0; rep < PROBE_CONV_REPS; ++rep) {
      if (rep) xcd_barrier(xb);
      phase_convert(p, l, smem);
      phase_norm(l == 0 ? p.in[0] : p.out, p.in[4] + l * 1024, modl, 0, 1024, (u16*)(p.ws + OFF_H));
    }
  PHASE_END
  PHASE_BEGIN(base + 1)
    if (PHON(1)) phase_gemm<0>(p, l, smem);
  PHASE_END
  PHASE_BEGIN(base + 2)
    for (int rep = 0; rep < PROBE_PREP_REPS; ++rep) {
      if (rep) xcd_barrier(xb);
      for (int item = blockIdx.x; item < 4096; item += gridDim.x) {
        if (item < 512) sg_item(p, l, item, smem);
        else if (item < 1024) rwkv_prep_item(p, l, item - 512, smem);
        else if (item < 2048) s5a_item(p, l, item - 1024, smem);
        else conv_item(p, l, item - 2048);
      }
    }
  PHASE_END
  PHASE_BEGIN(base + 3)
    if ((int)blockIdx.x < 64) scan_item(p, blockIdx.x, smem);
    else {
      for (int item = blockIdx.x - 64; item < 1024; item += gridDim.x - 64) s5b_item(p, l, item, smem);
      sub_barrier((unsigned*)(p.ws + OFF_BAR) + 3520 + 64 * l, gridDim.x - 64);
      for (int item = blockIdx.x - 64; item < 2048; item += gridDim.x - 64) merge_tile<0>(p, item, smem);
    }
  PHASE_END
  PHASE_BEGIN(base + 4)
    for (int rep = 0; rep < PROBE_POST_REPS; ++rep) { if (rep) xcd_barrier(xb); for (int item = blockIdx.x; item < 2048; item += gridDim.x) rwkv_post_item(p, l, item); }
  PHASE_END
  PHASE_BEGIN(base + 5)
    for (int item = blockIdx.x; item < 2048; item += gridDim.x) merge_tile<1>(p, item, smem);
  PHASE_END
  PHASE_BEGIN(base + 6)
    if (PHON(6)) phase_gemm<1>(p, l, smem);
  PHASE_END
  PHASE_BEGIN(base + 7)
    if (PHON(7)) phase_norm(p.out, p.in[38] + l * 1024, modl, 3072, 4096, (u16*)(p.ws + OFF_H));
  PHASE_END
  PHASE_BEGIN(base + 8)
    for (int rep = 0; rep < PROBE_FFN1_REPS; ++rep) { if (rep) xcd_barrier(xb); phase_gemm<2>(p, l, smem); }
  PHASE_END
  PHASE_BEGIN(base + 9)
    if (PHON(9)) phase_gemm<3>(p, l, smem);
  PHASE_END
}

__global__ void __launch_bounds__(NTHR, 2) mega_fwd(Params p, int ph_lo, int ph_hi) {
  __shared__ __attribute__((aligned(16))) unsigned char smem[73728 + 16];
  cg::grid_group grid = cg::this_grid();
  if (ph_hi < 0) grid.sync();
  volatile LAS unsigned* st = (volatile LAS unsigned*)(smem + 73728);
  if (threadIdx.x == 0) { st[0] = 0u; st[1] = 0u; }
  __syncthreads();
  const XcdBarrier xb = xcd_barrier_post((unsigned*)(p.ws + OFF_BAR), st);
  PHASE_BEGIN(0)
    if (PHON(10)) phase_mod(p, smem);
  PHASE_END
  run_layer<0>(p, ph_lo, ph_hi, smem, xb);
  run_layer<1>(p, ph_lo, ph_hi, smem, xb);
  PHASE_BEGIN(21)
    if (PHON(11)) phase_final(p.out, p.in[41]);
  PHASE_END
}

extern "C" void kernel_launch(void* const* d_in, const int* in_sizes, int n_in, void* d_out, int out_size, void* d_ws,
                              size_t ws_size, hipStream_t stream) {
  static int grid_blocks = 0;
  if (!grid_blocks) {
    int dev = 0, cus = 0, per_cu = 0;
    hipGetDevice(&dev);
    hipDeviceGetAttribute(&cus, hipDeviceAttributeMultiprocessorCount, dev);
    hipOccupancyMaxActiveBlocksPerMultiprocessor(&per_cu, mega_fwd, NTHR, 0);
    if (per_cu > 2) per_cu = 2;
    if (per_cu < 1) per_cu = 1;
    grid_blocks = cus * per_cu;
    if (ws_size < WS_END) fprintf(stderr, "workspace too small: %zu < %zu\n", ws_size, (size_t)WS_END);
  }
  Params p{};
  for (int i = 0; i < 42; ++i) p.in[i] = (const float*)d_in[i];
  p.out = (float*)d_out;
  p.ws = (unsigned char*)d_ws;
  hipMemsetAsync((unsigned char*)d_ws + OFF_BAR, 0, 16384, stream);
  int lo = 0, hi = N_PHASES;
  void* args[] = {&p, &lo, &hi};
  hipError_t e = hipLaunchCooperativeKernel((void*)mega_fwd, dim3(grid_blocks), dim3(NTHR), args, 0, stream);
  if (e != hipSuccess) fprintf(stderr, "cooperative launch failed: %s (grid %d)\n", hipGetErrorString(e), grid_blocks);
}
```

```cpp
#include <hip/hip_runtime.h>
#include <hip/hip_cooperative_groups.h>
#include <cstdio>
namespace cg = cooperative_groups;

typedef unsigned short u16;
using bf16x8 = __attribute__((ext_vector_type(8))) short;
using f32x4 = __attribute__((ext_vector_type(4))) float;
using u32x4 = __attribute__((ext_vector_type(4))) unsigned int;
using u32x2 = __attribute__((ext_vector_type(2))) unsigned int;

#define T_TOK 16384
#define SEQ 4096
#define DM 1024
#define NTHR 256

static constexpr size_t SZ_WIN = (size_t)6528 * 1024 * 2;
static constexpr size_t OFF_WIN = 0;
static constexpr size_t OFF_RO = OFF_WIN + SZ_WIN;
static constexpr size_t OFF_SO = OFF_RO + 1024 * 256 * 2;
static constexpr size_t OFF_CO = OFF_SO + 1024 * 256 * 2;
static constexpr size_t OFF_GLU = OFF_CO + 1024 * 256 * 2;
static constexpr size_t OFF_WO = OFF_GLU + 2048 * 256 * 2;
static constexpr size_t OFF_W1 = OFF_WO + 1024 * 1024 * 2;
static constexpr size_t OFF_W2 = OFF_W1 + (size_t)4096 * 1024 * 2;
static constexpr size_t OFF_H = OFF_W2 + (size_t)4096 * 1024 * 2;
static constexpr size_t SZ_T256B = (size_t)T_TOK * 256 * 2;
static constexpr size_t OFF_VF = OFF_H + (size_t)T_TOK * 1024 * 2;
static constexpr size_t OFF_PD = OFF_VF + SZ_T256B;
static constexpr size_t OFF_G = OFF_PD + SZ_T256B;
static constexpr size_t OFF_UB = OFF_G + SZ_T256B;
static constexpr size_t OFF_CB = OFF_UB + SZ_T256B;
static constexpr size_t OFF_SR = OFF_CB + SZ_T256B;
static constexpr size_t OFF_SK = OFF_SR + SZ_T256B;
static constexpr size_t OFF_SV = OFF_SK + SZ_T256B;
static constexpr size_t OFF_SKK = OFF_SV + SZ_T256B;
static constexpr size_t OFF_SA = OFF_SKK + SZ_T256B;
static constexpr size_t OFF_SW = OFF_SA + SZ_T256B;
static constexpr size_t OFF_PABC = OFF_SW + 2 * SZ_T256B;
static constexpr size_t OFF_YD = OFF_PABC;
static constexpr size_t OFF_OG = OFF_YD + SZ_T256B;
static constexpr size_t OFF_MRG = OFF_OG + SZ_T256B;
static constexpr size_t OFF_F = OFF_UB;
static constexpr size_t OFF_SMALL = OFF_PABC + (size_t)T_TOK * 2176 * 2;
static constexpr size_t OFF_MOD = OFF_SMALL;
static constexpr size_t OFF_S5AB = OFF_MOD + 2 * 4 * 6144 * 4;
static constexpr size_t OFF_S5BB = OFF_S5AB + 2 * 16 * 64 * 2 * 4;
static constexpr size_t OFF_S5E = OFF_S5BB + 2 * 16 * 64 * 32 * 4;
static constexpr size_t OFF_BAR = OFF_S5E + (size_t)4 * 64 * 16 * 64 * 2 * 4;
static constexpr size_t OFF_SGW = OFF_BAR + 16384;
static constexpr size_t OFF_O = OFF_SGW + 4 * 128 * 128 * 2;
static constexpr size_t WS_END = OFF_O + 2 * SZ_T256B;
static_assert(OFF_F + (size_t)T_TOK * 4096 * 2 <= OFF_SMALL, "F overlaps small region");
static_assert(OFF_MRG + (size_t)T_TOK * 1024 * 2 <= OFF_SMALL, "MRG overlaps");

struct Params {
  const float* in[42];
  float* out;
  unsigned char* ws;
};

__device__ __forceinline__ u16 f2bf(float f) {
  unsigned u = __float_as_uint(f);
  u += 0x7fffu + ((u >> 16) & 1u);
  return (u16)(u >> 16);
}
__device__ __forceinline__ float bf2f(u16 h) { return __uint_as_float(((unsigned)h) << 16); }
__device__ __forceinline__ float bflo(unsigned u) { return __uint_as_float(u << 16); }
__device__ __forceinline__ float bfhi(unsigned u) { return __uint_as_float(u & 0xffff0000u); }
__device__ __forceinline__ unsigned pack2(float a, float b) { return (unsigned)f2bf(a) | ((unsigned)f2bf(b) << 16); }
__device__ __forceinline__ float sigmoidf_(float x) { return 1.f / (1.f + __expf(-x)); }
__device__ __forceinline__ float tanhf_(float y) { return 1.f - 2.f / (1.f + __expf(2.f * y)); }
__device__ __forceinline__ float geluf_(float x) {
  float y = 0.7978845608028654f * (x + 0.044715f * x * x * x);
  return 0.5f * x * (1.f + tanhf_(y));
}
__device__ __forceinline__ float wave_sum(float v) {
#pragma unroll
  for (int o = 32; o > 0; o >>= 1) v += __shfl_xor(v, o, 64);
  return v;
}
template <int CTRL>
__device__ __forceinline__ float dppf(float x) {
  return __int_as_float(__builtin_amdgcn_update_dpp(__float_as_int(x), __float_as_int(x), CTRL, 0xF, 0xF, true));
}
__device__ __forceinline__ float row_sum16(float x) {
  x += dppf<0x128>(x);
  x += dppf<0x124>(x);
  x += dppf<0x122>(x);
  x += dppf<0x121>(x);
  return x;
}

__device__ __forceinline__ void phase_mod(const Params& p, unsigned char* smem) {
  const int tid = threadIdx.x;
  float* cact = (float*)smem;
  float* red = cact + 4096;
  float* mod = (float*)(p.ws + OFF_MOD);
  for (int i = tid; i < 4096; i += NTHR) { float c = p.in[1][i]; cact[i] = c / (1.f + __expf(-c)); }
  __syncthreads();
  for (int item = blockIdx.x; item < 192; item += gridDim.x) {
    int l = item / 96, nb = item % 96;
    int cl = tid & 63, kq = tid >> 6;
    int col = nb * 64 + cl;
    const float* W = p.in[2] + (size_t)l * 1024 * 6144;
    float a0 = 0, a1 = 0, a2 = 0, a3 = 0;
    for (int k = kq * 256; k < kq * 256 + 256; ++k) {
      float w = W[(size_t)k * 6144 + col];
      a0 += cact[k] * w; a1 += cact[1024 + k] * w; a2 += cact[2048 + k] * w; a3 += cact[3072 + k] * w;
    }
    red[(kq * 4 + 0) * 64 + cl] = a0; red[(kq * 4 + 1) * 64 + cl] = a1;
    red[(kq * 4 + 2) * 64 + cl] = a2; red[(kq * 4 + 3) * 64 + cl] = a3;
    __syncthreads();
    {
      int b = tid >> 6;
      float s = red[(0 * 4 + b) * 64 + cl] + red[(1 * 4 + b) * 64 + cl] + red[(2 * 4 + b) * 64 + cl] + red[(3 * 4 + b) * 64 + cl];
      mod[((size_t)l * 4 + b) * 6144 + col] = s + p.in[3][l * 6144 + col];
    }
    __syncthreads();
  }
  float* s5ab = (float*)(p.ws + OFF_S5AB);
  float* s5bb = (float*)(p.ws + OFF_S5BB);
  for (int idx = blockIdx.x * NTHR + tid; idx < 2048; idx += gridDim.x * NTHR) {
    int l = idx >> 10, g = (idx >> 6) & 15, n = idx & 63;
    double lre = fmin((double)p.in[28][idx], -1e-4);
    double lim = (double)p.in[29][idx];
    double dt = exp((double)p.in[35][l * 16 + g]);
    double mag = exp(lre * dt);
    double abr = mag * cos(lim * dt), abi = mag * sin(lim * dt);
    double den = lre * lre + lim * lim;
    double qr = ((abr - 1.0) * lre + abi * lim) / den;
    double qi = (abi * lre - (abr - 1.0) * lim) / den;
    s5ab[idx * 2 + 0] = (float)abr; s5ab[idx * 2 + 1] = (float)abi;
    for (int c = 0; c < 16; ++c) {
      double br = p.in[30][(size_t)idx * 16 + c], bi = p.in[31][(size_t)idx * 16 + c];
      s5bb[(size_t)idx * 32 + c] = (float)(qr * br - qi * bi);
      s5bb[(size_t)idx * 32 + 16 + c] = (float)(qr * bi + qi * br);
    }
  }
}

__device__ __forceinline__ void convert_tile(const float* __restrict__ src, int K, int N, u16* __restrict__ dst, int tk, int tn, u16* sm) {
  const int tid = threadIdx.x;
  int r = tid >> 4, c4 = (tid & 15) * 4;
#pragma unroll
  for (int i = 0; i < 4; ++i) {
    int kk = r + 16 * i;
    float4 v = *(const float4*)(src + (size_t)(tk * 64 + kk) * N + tn * 64 + c4);
    sm[(c4 + 0) * 72 + kk] = f2bf(v.x);
    sm[(c4 + 1) * 72 + kk] = f2bf(v.y);
    sm[(c4 + 2) * 72 + kk] = f2bf(v.z);
    sm[(c4 + 3) * 72 + kk] = f2bf(v.w);
  }
  __syncthreads();
#pragma unroll
  for (int j = 0; j < 2; ++j) {
    int n = (tid >> 3) + 32 * j, ch = tid & 7;
    u32x4 v = *(const u32x4*)(sm + n * 72 + ch * 8);
    *(u32x4*)(dst + (size_t)(tn * 64 + n) * K + tk * 64 + ch * 8) = v;
  }
  __syncthreads();
}

__device__ __forceinline__ void phase_convert(const Params& p, int l, unsigned char* smem) {
  u16* sm = (u16*)smem;
  const int total = 1632 + 192 + 128 + 256 + 1024 + 1024;
  for (int item = blockIdx.x; item < total + 16; item += gridDim.x) {
    int t = item;
    if (t >= total) {
      const int idx = t - total, g = idx >> 2, rq = idx & 3;
      const int tr = rq * 32 + (threadIdx.x >> 3), s0 = (threadIdx.x & 7) * 16;
      const float* src = p.in[23] + (((size_t)l * 4 + g) * 128 + tr) * 128 + s0;
      u16* dst = (u16*)(p.ws + OFF_SGW) + ((size_t)g * 128 + tr) * 128 + s0;
      unsigned pk[8];
#pragma unroll
      for (int e = 0; e < 4; ++e) {
        f32x4 v = *(const f32x4*)(src + e * 4);
        const int sb = s0 + e * 4;
        pk[e * 2 + 0] = pack2(sb + 0 <= tr ? v.x : 0.f, sb + 1 <= tr ? v.y : 0.f);
        pk[e * 2 + 1] = pack2(sb + 2 <= tr ? v.z : 0.f, sb + 3 <= tr ? v.w : 0.f);
      }
      *(u32x4*)(dst) = u32x4{pk[0], pk[1], pk[2], pk[3]};
      *(u32x4*)(dst + 8) = u32x4{pk[4], pk[5], pk[6], pk[7]};
      continue;
    }
    const float* src; int K, N; size_t off;
    if (t < 1632) { src = p.in[5] + (size_t)l * 1024 * 6528; K = 1024; N = 6528; off = OFF_WIN; }
    else if ((t -= 1632) < 64) { src = p.in[20] + (size_t)l * 256 * 1024; K = 256; N = 1024; off = OFF_RO; }
    else if ((t -= 64) < 64) { src = p.in[25] + (size_t)l * 256 * 1024; K = 256; N = 1024; off = OFF_SO; }
    else if ((t -= 64) < 64) { src = p.in[27] + (size_t)l * 256 * 1024; K = 256; N = 1024; off = OFF_CO; }
    else if ((t -= 64) < 128) { src = p.in[36] + (size_t)l * 256 * 2048; K = 256; N = 2048; off = OFF_GLU; }
    else if ((t -= 128) < 256) { src = p.in[37] + (size_t)l * 1024 * 1024; K = 1024; N = 1024; off = OFF_WO; }
    else if ((t -= 256) < 1024) { src = p.in[39] + (size_t)l * 1024 * 4096; K = 1024; N = 4096; off = OFF_W1; }
    else { t -= 1024; src = p.in[40] + (size_t)l * 4096 * 1024; K = 4096; N = 1024; off = OFF_W2; }
    int ntn = N / 64;
    convert_tile(src, K, N, (u16*)(p.ws + off), t / ntn, t % ntn, sm);
  }
}

__device__ __forceinline__ void phase_norm(const float* __restrict__ X, const float* __restrict__ g, const float* __restrict__ modl,
                           int sh_off, int sc_off, u16* __restrict__ H) {
  const int lane = threadIdx.x & 63, wv = threadIdx.x >> 6;
  for (int item = blockIdx.x; item < T_TOK / 4; item += gridDim.x) {
    int row = item * 4 + wv;
    int b = row >> 12;
    const float* xr = X + (size_t)row * 1024;
    float4 v[4];
    float ss = 0;
#pragma unroll
    for (int i = 0; i < 4; ++i) {
      v[i] = *(const float4*)(xr + lane * 4 + 256 * i);
      ss += v[i].x * v[i].x + v[i].y * v[i].y + v[i].z * v[i].z + v[i].w * v[i].w;
    }
    ss = wave_sum(ss);
    float rstd = rsqrtf(ss * (1.f / 1024.f) + 1e-6f);
    const float* sh = modl + (size_t)b * 6144 + sh_off;
    const float* sc = modl + (size_t)b * 6144 + sc_off;
#pragma unroll
    for (int i = 0; i < 4; ++i) {
      int c = lane * 4 + 256 * i;
      float4 gg = *(const float4*)(g + c);
      float4 s1 = *(const float4*)(sc + c);
      float4 s0 = *(const float4*)(sh + c);
      float h0 = v[i].x * rstd * gg.x * (1.f + s1.x) + s0.x;
      float h1 = v[i].y * rstd * gg.y * (1.f + s1.y) + s0.y;
      float h2 = v[i].z * rstd * gg.z * (1.f + s1.z) + s0.z;
      float h3 = v[i].w * rstd * gg.w * (1.f + s1.w) + s0.w;
      u32x2 o; o.x = pack2(h0, h1); o.y = pack2(h2, h3);
      *(u32x2*)(H + (size_t)row * 1024 + c) = o;
    }
  }
}

__device__ __forceinline__ void phase_final(float* __restrict__ X, const float* __restrict__ g) {
  const int lane = threadIdx.x & 63, wv = threadIdx.x >> 6;
  for (int item = blockIdx.x; item < T_TOK / 4; item += gridDim.x) {
    int row = item * 4 + wv;
    float* xr = X + (size_t)row * 1024;
    float4 v[4];
    float ss = 0;
#pragma unroll
    for (int i = 0; i < 4; ++i) {
      v[i] = *(const float4*)(xr + lane * 4 + 256 * i);
      ss += v[i].x * v[i].x + v[i].y * v[i].y + v[i].z * v[i].z + v[i].w * v[i].w;
    }
    ss = wave_sum(ss);
    float rstd = rsqrtf(ss * (1.f / 1024.f) + 1e-6f);
#pragma unroll
    for (int i = 0; i < 4; ++i) {
      int c = lane * 4 + 256 * i;
      float4 gg = *(const float4*)(g + c);
      float4 o;
      o.x = v[i].x * rstd * gg.x; o.y = v[i].y * rstd * gg.y; o.z = v[i].z * rstd * gg.z; o.w = v[i].w * rstd * gg.w;
      *(float4*)(xr + c) = o;
    }
  }
}

template <int NF>
__device__ __forceinline__ void gemm_mainloop(const u16* __restrict__ A, int lda, const u16* __restrict__ B, int ldb,
                                              int K, f32x4 (&acc)[4][NF], u16* smem) {
  constexpr int BN = 32 * NF;
  constexpr int NB = BN / 32;
  u16* sA = smem;
  u16* sB = smem + 2 * 128 * 64;
  const int tid = threadIdx.x, lane = tid & 63, wv = tid >> 6;
  const int wm = wv >> 1, wn = wv & 1;
  const int lrow = tid >> 3;
  const int lchs = (tid & 7) ^ ((lrow >> 1) & 7);
  const u16* Ap = A + (size_t)lrow * lda + lchs * 8;
  const u16* Bp = B + (size_t)lrow * ldb + lchs * 8;
  const int nk = K >> 6;
  auto stage = [&](int kt, int buf) {
    const int ko = kt << 6;
#pragma unroll
    for (int i = 0; i < 4; ++i)
      __builtin_amdgcn_global_load_lds((const unsigned*)(Ap + (size_t)(32 * i) * lda + ko),
                                       (__attribute__((address_space(3))) unsigned*)(sA + buf * (128 * 64) + (tid + 256 * i) * 8), 16, 0, 0);
#pragma unroll
    for (int i = 0; i < NB; ++i)
      __builtin_amdgcn_global_load_lds((const unsigned*)(Bp + (size_t)(32 * i) * ldb + ko),
                                       (__attribute__((address_space(3))) unsigned*)(sB + buf * (BN * 64) + (tid + 256 * i) * 8), 16, 0, 0);
  };
  __syncthreads();
  stage(0, 0);
  const int fr = lane & 15, fq = lane >> 4;
  const int sw = (fr >> 1) & 7;
  for (int kt = 0; kt < nk; ++kt) {
    const int cur = kt & 1;
    asm volatile("s_waitcnt vmcnt(0)" ::: "memory");
    __syncthreads();
    if (kt + 1 < nk) stage(kt + 1, cur ^ 1);
    const u16* cA = sA + cur * (128 * 64) + (wm * 64 + fr) * 64;
    const u16* cB = sB + cur * (BN * 64) + (wn * 16 * NF + fr) * 64;
#pragma unroll
    for (int ks = 0; ks < 2; ++ks) {
      const int pc = ((fq + 4 * ks) ^ sw) << 3;
      bf16x8 fa[4], fb[NF];
#pragma unroll
      for (int i = 0; i < 4; ++i) fa[i] = *(const bf16x8*)(cA + i * 16 * 64 + pc);
#pragma unroll
      for (int j = 0; j < NF; ++j) fb[j] = *(const bf16x8*)(cB + j * 16 * 64 + pc);
#pragma unroll
      for (int i = 0; i < 4; ++i)
#pragma unroll
        for (int j = 0; j < NF; ++j)
          acc[i][j] = __builtin_amdgcn_mfma_f32_16x16x32_bf16(fb[j], fa[i], acc[i][j], 0, 0, 0);
    }
  }
}

template <int NF>
__device__ __forceinline__ void zero_acc(f32x4 (&acc)[4][NF]) {
#pragma unroll
  for (int i = 0; i < 4; ++i)
#pragma unroll
    for (int j = 0; j < NF; ++j) acc[i][j] = f32x4{0.f, 0.f, 0.f, 0.f};
}

template <int EPI>
__device__ __forceinline__ void phase_gemm(const Params& p, int l, unsigned char* smem_raw) {
  u16* smem = (u16*)smem_raw;
  const int lane = threadIdx.x & 63, wv = threadIdx.x >> 6;
  const int wm = wv >> 1, wn = wv & 1;
  const int fr = lane & 15, fq = lane >> 4;
  const u16* A; const u16* B; int lda, ldb, K, ntiles_n;
  if (EPI == 0) { A = (const u16*)(p.ws + OFF_H); lda = 1024; B = (const u16*)(p.ws + OFF_WIN); ldb = 1024; K = 1024; ntiles_n = 19; }
  if (EPI == 1) { A = (const u16*)(p.ws + OFF_MRG); lda = 1024; B = (const u16*)(p.ws + OFF_WO); ldb = 1024; K = 1024; ntiles_n = 8; }
  if (EPI == 2) { A = (const u16*)(p.ws + OFF_H); lda = 1024; B = (const u16*)(p.ws + OFF_W1); ldb = 1024; K = 1024; ntiles_n = 32; }
  if (EPI == 3) { A = (const u16*)(p.ws + OFF_F); lda = 4096; B = (const u16*)(p.ws + OFF_W2); ldb = 4096; K = 4096; ntiles_n = 8; }
  const float* modl = (const float*)(p.ws + OFF_MOD) + (size_t)l * 4 * 6144;
  const int total = 128 * ntiles_n;
  for (int item = blockIdx.x; item < total; item += gridDim.x) {
    const int mt = item & 127, nt = item >> 7;
    const int m0 = mt * 128, n0 = nt * 128;
    f32x4 acc[4][4];
    zero_acc<4>(acc);
    gemm_mainloop<4>(A + (size_t)m0 * lda, lda, B + (size_t)n0 * ldb, ldb, K, acc, smem);
#pragma unroll
    for (int i = 0; i < 4; ++i) {
      const int m = m0 + wm * 64 + i * 16 + fr;
#pragma unroll
      for (int j = 0; j < 4; ++j) {
        const int n = n0 + wn * 64 + j * 16 + fq * 4;
        f32x4 v = acc[i][j];
        if (EPI == 0) {
          u32x2 o; o.x = pack2(v[0], v[1]); o.y = pack2(v[2], v[3]);
          if (n < 2176) *(u32x2*)((u16*)(p.ws + OFF_PABC) + (size_t)m * 2176 + n) = o;
          else *(u32x2*)((u16*)(p.ws + OFF_PD) + (size_t)m * 256 + (n - 2176)) = o;
        } else if (EPI == 1 || EPI == 3) {
          const int b = m >> 12;
          const float* gt = modl + (size_t)b * 6144 + (EPI == 1 ? 2048 : 5120) + n;
          const float* xin = ((EPI == 1 && l == 0) ? p.in[0] : p.out) + (size_t)m * 1024 + n;
          float4 x = *(const float4*)xin;
          float4 gg = *(const float4*)gt;
          float4 o;
          o.x = x.x + gg.x * v[0]; o.y = x.y + gg.y * v[1]; o.z = x.z + gg.z * v[2]; o.w = x.w + gg.w * v[3];
          *(float4*)(p.out + (size_t)m * 1024 + n) = o;
        } else {
          float r0 = fmaxf(v[0], 0.f), r1 = fmaxf(v[1], 0.f), r2 = fmaxf(v[2], 0.f), r3 = fmaxf(v[3], 0.f);
          u32x2 o; o.x = pack2(r0 * r0, r1 * r1); o.y = pack2(r2 * r2, r3 * r3);
          *(u32x2*)((u16*)(p.ws + OFF_F) + (size_t)m * 4096 + n) = o;
        }
      }
    }
  }
}

template <int MODE>
__device__ __forceinline__ void merge_tile(const Params& p, int item, unsigned char* smem_raw) {
  u16* smem = (u16*)smem_raw;
  const int lane = threadIdx.x & 63, wv = threadIdx.x >> 6;
  const int wm = wv >> 1, wn = wv & 1;
  const int fr = lane & 15, fq = lane >> 4;
  const u16* H = (const u16*)(p.ws + OFF_H);
  const u16* WIN = (const u16*)(p.ws + OFF_WIN);
  const int mt = item & 127, nt = item >> 7;
  const int m0 = mt * 128, n0 = nt * 64;
  f32x4 macc[4][2], bacc[4][2], gacc[4][2];
  zero_acc<2>(macc);
#pragma unroll 1
  for (int br = (MODE == 0 ? 1 : 0); br < (MODE == 0 ? 4 : 1); ++br) {
    zero_acc<2>(bacc);
    const u16* Ab; const u16* Wb;
    if (br == 0) { Ab = (const u16*)(p.ws + OFF_OG); Wb = (const u16*)(p.ws + OFF_RO); }
    else if (br == 1) { Ab = (const u16*)(p.ws + OFF_UB); Wb = (const u16*)(p.ws + OFF_SO); }
    else if (br == 2) { Ab = (const u16*)(p.ws + OFF_CB); Wb = (const u16*)(p.ws + OFF_CO); }
    else { Ab = (const u16*)(p.ws + OFF_YD); Wb = (const u16*)(p.ws + OFF_GLU); }
    gemm_mainloop<2>(Ab + (size_t)m0 * 256, 256, Wb + (size_t)n0 * 256, 256, 256, bacc, smem);
    if (MODE == 0 && br == 3) {
      zero_acc<2>(gacc);
      gemm_mainloop<2>(Ab + (size_t)m0 * 256, 256, Wb + (size_t)(1024 + n0) * 256, 256, 256, gacc, smem);
#pragma unroll
      for (int i = 0; i < 4; ++i)
#pragma unroll
        for (int j = 0; j < 2; ++j)
#pragma unroll
          for (int e = 0; e < 4; ++e) bacc[i][j][e] *= sigmoidf_(gacc[i][j][e]);
    }
    zero_acc<2>(gacc);
    gemm_mainloop<2>(H + (size_t)m0 * 1024, 1024, WIN + (size_t)(2432 + br * 1024 + n0) * 1024, 1024, 1024, gacc, smem);
#pragma unroll
    for (int i = 0; i < 4; ++i)
#pragma unroll
      for (int j = 0; j < 2; ++j)
#pragma unroll
        for (int e = 0; e < 4; ++e) macc[i][j][e] += sigmoidf_(gacc[i][j][e]) * bacc[i][j][e];
  }
  u16* MRG = (u16*)(p.ws + OFF_MRG);
#pragma unroll
  for (int i = 0; i < 4; ++i) {
    const int m = m0 + wm * 64 + i * 16 + fr;
#pragma unroll
    for (int j = 0; j < 2; ++j) {
      const int n = n0 + wn * 32 + j * 16 + fq * 4;
      f32x4 v = macc[i][j];
      if (MODE == 1) {
        u32x2 pr = *(const u32x2*)(MRG + (size_t)m * 1024 + n);
        v[0] += bflo(pr.x); v[1] += bfhi(pr.x); v[2] += bflo(pr.y); v[3] += bfhi(pr.y);
      }
      u32x2 o; o.x = pack2(v[0], v[1]); o.y = pack2(v[2], v[3]);
      *(u32x2*)(MRG + (size_t)m * 1024 + n) = o;
    }
  }
}

__device__ __forceinline__ float shifted(const u16* __restrict__ P, int tok, int col, float mu) {
  float pv = bf2f(P[(size_t)tok * 2176 + col]);
  float pr = (tok & (SEQ - 1)) ? bf2f(P[(size_t)(tok - 1) * 2176 + col]) : 0.f;
  return pv + (pr - pv) * mu;
}

__device__ __forceinline__ void rwkv_prep_item(const Params& p, int l, int item, unsigned char* smem) {
  const int tid = threadIdx.x;
  float* sl = (float*)smem;
  float* sv = sl + 32 * 128;
  float* svl = sv + 32 * 256;
  const u16* P = (const u16*)(p.ws + OFF_PABC);
  const float* mu = p.in[6] + l * 896;
  const int tok0 = item * 32;
  for (int idx = tid; idx < 32 * 128; idx += NTHR) {
    int t = idx >> 7, ci = idx & 127;
    float v = shifted(P, tok0 + t, 768 + ci, mu[768 + ci]);
    if (ci < 32) v = tanhf_(v);
    else if (ci >= 64) v = sigmoidf_(v);
    sl[idx] = v;
  }
  if (l > 0) {
    float m = mu[512 + tid];
    for (int t = 0; t < 32; ++t) sv[t * 256 + tid] = shifted(P, tok0 + t, 512 + tid, m);
  }
  __syncthreads();
  if (l > 0) {
    const float* v1 = p.in[13];
    int t = tid >> 3, o4 = (tid & 7) * 4;
    float a0 = 0, a1 = 0, a2 = 0, a3 = 0;
    for (int k = 0; k < 256; ++k) {
      float s = sv[t * 256 + k];
      float4 w = *(const float4*)(v1 + k * 32 + o4);
      a0 += s * w.x; a1 += s * w.y; a2 += s * w.z; a3 += s * w.w;
    }
    svl[t * 32 + o4 + 0] = a0; svl[t * 32 + o4 + 1] = a1; svl[t * 32 + o4 + 2] = a2; svl[t * 32 + o4 + 3] = a3;
    __syncthreads();
  }
  const int j = tid;
  const float* w2 = p.in[8] + l * 32 * 256;
  const float* a2w = p.in[10] + l * 32 * 256;
  const float* g2 = p.in[11] + l * 64 * 256;
  const float* v2 = p.in[14];
  const float w0 = p.in[7][l * 256 + j], a0c = p.in[9][l * 256 + j];
  const float v0 = (l > 0) ? p.in[12][j] : 0.f;
  const float kkc = p.in[15][l * 256 + j], kac = p.in[16][l * 256 + j];
  const float mur = mu[j], muk = mu[256 + j], muv = mu[512 + j];
  u16* SR = (u16*)(p.ws + OFF_SR); u16* SK = (u16*)(p.ws + OFF_SK); u16* SV = (u16*)(p.ws + OFF_SV);
  u16* SKK = (u16*)(p.ws + OFF_SKK); u16* SA = (u16*)(p.ws + OFF_SA); float* SW = (float*)(p.ws + OFF_SW);
  u16* G = (u16*)(p.ws + OFF_G); u16* VF = (u16*)(p.ws + OFF_VF);
#pragma unroll 1
  for (int tg = 0; tg < 4; ++tg) {
    float accw[8], acca[8], accg[8], accv[8];
#pragma unroll
    for (int tt = 0; tt < 8; ++tt) { accw[tt] = 0; acca[tt] = 0; accg[tt] = 0; accv[tt] = 0; }
#pragma unroll 1
    for (int k4 = 0; k4 < 8; ++k4) {
      float ww[4], wa[4];
#pragma unroll
      for (int e = 0; e < 4; ++e) { ww[e] = w2[(k4 * 4 + e) * 256 + j]; wa[e] = a2w[(k4 * 4 + e) * 256 + j]; }
#pragma unroll
      for (int tt = 0; tt < 8; ++tt) {
        float4 s = *(const float4*)(sl + (tg * 8 + tt) * 128 + k4 * 4);
        float4 s2 = *(const float4*)(sl + (tg * 8 + tt) * 128 + 32 + k4 * 4);
        accw[tt] += s.x * ww[0] + s.y * ww[1] + s.z * ww[2] + s.w * ww[3];
        acca[tt] += s2.x * wa[0] + s2.y * wa[1] + s2.z * wa[2] + s2.w * wa[3];
      }
    }
#pragma unroll 1
    for (int k4 = 0; k4 < 16; ++k4) {
      float wg[4];
#pragma unroll
      for (int e = 0; e < 4; ++e) wg[e] = g2[(k4 * 4 + e) * 256 + j];
#pragma unroll
      for (int tt = 0; tt < 8; ++tt) {
        float4 s = *(const float4*)(sl + (tg * 8 + tt) * 128 + 64 + k4 * 4);
        accg[tt] += s.x * wg[0] + s.y * wg[1] + s.z * wg[2] + s.w * wg[3];
      }
    }
    if (l > 0) {
#pragma unroll 1
      for (int k4 = 0; k4 < 8; ++k4) {
        float wvv[4];
#pragma unroll
        for (int e = 0; e < 4; ++e) wvv[e] = v2[(k4 * 4 + e) * 256 + j];
#pragma unroll
        for (int tt = 0; tt < 8; ++tt) {
          float4 s = *(const float4*)(svl + (tg * 8 + tt) * 32 + k4 * 4);
          accv[tt] += s.x * wvv[0] + s.y * wvv[1] + s.z * wvv[2] + s.w * wvv[3];
        }
      }
    }
#pragma unroll
    for (int tt = 0; tt < 8; ++tt) {
      const int tok = tok0 + tg * 8 + tt;
      float r = shifted(P, tok, j, mur);
      float k = shifted(P, tok, 256 + j, muk);
      float v = shifted(P, tok, 512 + j, muv);
      float wl = w0 + accw[tt];
      float z = -wl;
      float sp = (z > 15.f) ? z : __logf(1.f + __expf(z));
      float lw = -sp - 0.5f;
      float decay = __expf(-__expf(lw));
      float a = sigmoidf_(a0c + acca[tt]);
      float g = accg[tt];
      const size_t o = (size_t)tok * 256 + j;
      if (l == 0) {
        VF[o] = f2bf(v);
      } else {
        float vf = bf2f(VF[o]);
        v = v + (vf - v) * sigmoidf_(v0 + accv[tt]);
      }
      float kk = k * kkc;
      float ss = wave_sum(kk * kk);
      kk = kk / fmaxf(sqrtf(ss), 1e-12f);
      float km = k * (1.f + (a - 1.f) * kac);
      SR[o] = f2bf(r); SK[o] = f2bf(km); SV[o] = f2bf(v); SKK[o] = f2bf(kk); SA[o] = f2bf(a);
      SW[o] = decay; G[o] = f2bf(g);
    }
  }
  __syncthreads();
}

__device__ __forceinline__ void sg_item(const Params& p, int l, int item, unsigned char* smem) {
  const int tid = threadIdx.x, lane = tid & 63, wv = tid >> 6;
  u16* vsT = (u16*)smem;
  float* smu = (float*)(smem + 16384);
  float* srs = smu + 128;
  const u16* P = (const u16*)(p.ws + OFF_PABC);
  const int g = item & 3, chn = item >> 2;
  const int tok0 = chn * 128;
  {
    const int t = tid >> 1, hf = tid & 1;
    const u16* src = P + (size_t)(tok0 + t) * 2176 + 896 + 256 + hf * 128;
    float sm = 0.f, ss = 0.f;
#pragma unroll 4
    for (int i = 0; i < 16; ++i) {
      u32x4 raw = *(const u32x4*)(src + i * 8);
      float z;
      z = geluf_(bflo(raw.x)); sm += z; ss += z * z;  z = geluf_(bfhi(raw.x)); sm += z; ss += z * z;
      z = geluf_(bflo(raw.y)); sm += z; ss += z * z;  z = geluf_(bfhi(raw.y)); sm += z; ss += z * z;
      z = geluf_(bflo(raw.z)); sm += z; ss += z * z;  z = geluf_(bfhi(raw.z)); sm += z; ss += z * z;
      z = geluf_(bflo(raw.w)); sm += z; ss += z * z;  z = geluf_(bfhi(raw.w)); sm += z; ss += z * z;
    }
    sm += __shfl_xor(sm, 1, 64); ss += __shfl_xor(ss, 1, 64);
    const float mean = sm * (1.f / 256.f);
    const float var = fmaxf(ss * (1.f / 256.f) - mean * mean, 0.f);
    if (hf == 0) { smu[t] = mean; srs[t] = rsqrtf(var + 1e-5f); }
  }
  __syncthreads();
  {
    const int c = tid & 63, tb = tid >> 6;
    const float lw = p.in[21][l * 256 + g * 64 + c], lb = p.in[22][l * 256 + g * 64 + c];
#pragma unroll
    for (int j = 0; j < 4; ++j) {
      u16 raw[8];
#pragma unroll
      for (int e = 0; e < 8; ++e) raw[e] = P[(size_t)(tok0 + tb * 32 + j * 8 + e) * 2176 + 896 + 256 + g * 64 + c];
      float vv[8];
#pragma unroll
      for (int e = 0; e < 8; ++e) {
        const int t = tb * 32 + j * 8 + e;
        vv[e] = (geluf_(bf2f(raw[e])) - smu[t]) * srs[t] * lw + lb;
      }
      const int phys = (tb * 4 + j) ^ (c & 15);
      *(u32x4*)(vsT + c * 128 + phys * 8) = u32x4{pack2(vv[0], vv[1]), pack2(vv[2], vv[3]), pack2(vv[4], vv[5]), pack2(vv[6], vv[7])};
    }
  }
  __syncthreads();
  {
    const int fr = lane & 15, fq = lane >> 4;
    const u16* Wm = (const u16*)(p.ws + OFF_SGW) + (size_t)g * 128 * 128;
    f32x4 acc[2][4];
#pragma unroll
    for (int i = 0; i < 2; ++i)
#pragma unroll
      for (int j = 0; j < 4; ++j) acc[i][j] = f32x4{0.f, 0.f, 0.f, 0.f};
    for (int ks = 0; ks <= wv; ++ks) {
      bf16x8 fa[2], fb[4];
#pragma unroll
      for (int i = 0; i < 2; ++i) fa[i] = *(const bf16x8*)(Wm + (size_t)(32 * wv + 16 * i + fr) * 128 + ks * 32 + fq * 8);
#pragma unroll
      for (int j = 0; j < 4; ++j) fb[j] = *(const bf16x8*)(vsT + (j * 16 + fr) * 128 + (((ks * 4 + fq) ^ fr) << 3));
#pragma unroll
      for (int i = 0; i < 2; ++i)
#pragma unroll
        for (int j = 0; j < 4; ++j) acc[i][j] = __builtin_amdgcn_mfma_f32_16x16x32_bf16(fb[j], fa[i], acc[i][j], 0, 0, 0);
    }
    const float* bs = p.in[24] + ((size_t)l * 4 + g) * 128;
    u16* UB = (u16*)(p.ws + OFF_UB);
#pragma unroll
    for (int i = 0; i < 2; ++i) {
      const int t = 32 * wv + 16 * i + fr;
      const float bsv = bs[t];
#pragma unroll
      for (int j = 0; j < 4; ++j) {
        const int cc = j * 16 + fq * 4;
        u32x2 ur = *(const u32x2*)(P + (size_t)(tok0 + t) * 2176 + 896 + g * 64 + cc);
        float o0 = geluf_(bflo(ur.x)) * (acc[i][j][0] + bsv), o1 = geluf_(bfhi(ur.x)) * (acc[i][j][1] + bsv);
        float o2 = geluf_(bflo(ur.y)) * (acc[i][j][2] + bsv), o3 = geluf_(bfhi(ur.y)) * (acc[i][j][3] + bsv);
        *(u32x2*)(UB + (size_t)(tok0 + t) * 256 + g * 64 + cc) = u32x2{pack2(o0, o1), pack2(o2, o3)};
      }
    }
  }
  __syncthreads();
}

__device__ __forceinline__ void conv_item(const Params& p, int l, int item) {
  const int j = threadIdx.x;
  const u16* P = (const u16*)(p.ws + OFF_PABC);
  u16* CB = (u16*)(p.ws + OFF_CB);
  const float c0 = p.in[26][(l * 3 + 0) * 256 + j], c1 = p.in[26][(l * 3 + 1) * 256 + j], c2 = p.in[26][(l * 3 + 2) * 256 + j];
  const int tok0 = item * 8;
  u16 rc[10], rx[10], rb[8];
  const bool first = (tok0 & (SEQ - 1)) == 0;
#pragma unroll
  for (int t = 0; t < 10; ++t) {
    const int tok = (first && t < 2) ? tok0 : tok0 + t - 2;
    const u16* q = P + (size_t)tok * 2176 + 1408;
    rc[t] = q[256 + j]; rx[t] = q[512 + j];
    if (t >= 2) rb[t - 2] = q[j];
  }
  float z[10];
#pragma unroll
  for (int t = 0; t < 10; ++t) z[t] = bf2f(rc[t]) * bf2f(rx[t]);
  if (first) { z[0] = 0.f; z[1] = 0.f; }
#pragma unroll
  for (int t = 0; t < 8; ++t) {
    float y = c0 * z[t] + c1 * z[t + 1] + c2 * z[t + 2];
    CB[(size_t)(tok0 + t) * 256 + j] = f2bf(bf2f(rb[t]) * y);
  }
}

__device__ __forceinline__ void s5_load_u(const u16* us, int t, int wv, float (&u)[16]) {
  const u32x4* q = (const u32x4*)(us + t * 64 + wv * 16);
  u32x4 a = q[0], b = q[1];
  u[0] = bflo(a.x); u[1] = bfhi(a.x); u[2] = bflo(a.y); u[3] = bfhi(a.y);
  u[4] = bflo(a.z); u[5] = bfhi(a.z); u[6] = bflo(a.w); u[7] = bfhi(a.w);
  u[8] = bflo(b.x); u[9] = bfhi(b.x); u[10] = bflo(b.y); u[11] = bfhi(b.y);
  u[12] = bflo(b.z); u[13] = bfhi(b.z); u[14] = bflo(b.w); u[15] = bfhi(b.w);
}
__device__ __forceinline__ void s5_stage_u(const u16* __restrict__ PD, int tok0, int gq, u16* us) {
#pragma unroll
  for (int i = 0; i < 2; ++i) {
    const int ch = threadIdx.x + 256 * i;
    const int t = ch >> 3, part = ch & 7;
    *(u32x4*)(us + t * 64 + part * 8) = *(const u32x4*)(PD + (size_t)(tok0 + t) * 256 + gq * 64 + part * 8);
  }
}

__device__ __forceinline__ void s5a_item(const Params& p, int l, int item, unsigned char* smem) {
  const int lane = threadIdx.x & 63, wv = threadIdx.x >> 6;
  const int gq = item & 3, bc = item >> 2;
  const int g = gq * 4 + wv;
  const int tok0 = bc * 64;
  const u16* PD = (const u16*)(p.ws + OFF_PD);
  const float* ab = (const float*)(p.ws + OFF_S5AB) + ((size_t)(l * 16 + g) * 64 + lane) * 2;
  const float* bb = (const float*)(p.ws + OFF_S5BB) + ((size_t)(l * 16 + g) * 64 + lane) * 32;
  float bbr[16], bbi[16];
#pragma unroll
  for (int c = 0; c < 16; ++c) { bbr[c] = bb[c]; bbi[c] = bb[16 + c]; }
  const float abr = ab[0], abi = ab[1];
  float xr = 0.f, xi = 0.f;
  u16* us = (u16*)smem;
  s5_stage_u(PD, tok0, gq, us);
  __syncthreads();
#pragma unroll 4
  for (int t = 0; t < 64; ++t) {
    float u[16];
    s5_load_u(us, t, wv, u);
    float bur = 0.f, bui = 0.f;
#pragma unroll
    for (int c = 0; c < 16; ++c) { bur += bbr[c] * u[c]; bui += bbi[c] * u[c]; }
    float nr = abr * xr - abi * xi + bur;
    float ni = abr * xi + abi * xr + bui;
    xr = nr; xi = ni;
  }
  float2* E = (float2*)(p.ws + OFF_S5E);
  E[((size_t)bc * 16 + g) * 64 + lane] = make_float2(xr, xi);
  __syncthreads();
}

__device__ __forceinline__ void s5b_item(const Params& p, int l, int item, unsigned char* smem) {
  const int lane = threadIdx.x & 63, wv = threadIdx.x >> 6;
  const int gq = item & 3, bc = item >> 2;
  const int b = bc >> 6, ch = bc & 63;
  const int g = gq * 4 + wv;
  const int tok0 = bc * 64;
  u16* us = (u16*)(smem + 65536);
  s5_stage_u((const u16*)(p.ws + OFF_PD), tok0, gq, us);
  float* base = (float*)smem + wv * 4096;
  float* csr = base, *csi = base + 1024, *xsr = base + 2048, *xsi = base + 3072;
  const u16* PD = (const u16*)(p.ws + OFF_PD);
  const float* ab = (const float*)(p.ws + OFF_S5AB) + ((size_t)(l * 16 + g) * 64 + lane) * 2;
  const float* bb = (const float*)(p.ws + OFF_S5BB) + ((size_t)(l * 16 + g) * 64 + lane) * 32;
  const float* cre = p.in[32] + ((size_t)(l * 16 + g) * 16) * 64;
  const float* cim = p.in[33] + ((size_t)(l * 16 + g) * 16) * 64;
  for (int c = 0; c < 16; ++c) {
    csr[(lane >> 2) * 64 + c * 4 + (lane & 3)] = cre[c * 64 + lane];
    csi[(lane >> 2) * 64 + c * 4 + (lane & 3)] = cim[c * 64 + lane];
  }
  float bbr[16], bbi[16];
#pragma unroll
  for (int c = 0; c < 16; ++c) { bbr[c] = bb[c]; bbi[c] = bb[16 + c]; }
  const float abr = ab[0], abi = ab[1];
  float pr = abr, pi = abi;
#pragma unroll
  for (int s = 0; s < 6; ++s) { float nr = pr * pr - pi * pi, ni = 2.f * pr * pi; pr = nr; pi = ni; }
  float xr = 0.f, xi = 0.f;
  const float2* E = (const float2*)(p.ws + OFF_S5E);
  for (int c = 0; c < ch; ++c) {
    float2 e = E[((size_t)(b * 64 + c) * 16 + g) * 64 + lane];
    float nr = pr * xr - pi * xi + e.x;
    float ni = pr * xi + pi * xr + e.y;
    xr = nr; xi = ni;
  }
  const int tt = lane & 15, cq = lane >> 4;
  const float* dvec = p.in[34] + l * 256 + g * 16 + cq * 4;
  const float d0 = dvec[0], d1 = dvec[1], d2 = dvec[2], d3 = dvec[3];
  u16* YD = (u16*)(p.ws + OFF_YD);
  const int n4w = lane >> 2, e4 = lane & 3;
  __syncthreads();
#pragma unroll 1
  for (int sc = 0; sc < 4; ++sc) {
    for (int t = 0; t < 16; ++t) {
      float u[16];
      s5_load_u(us, sc * 16 + t, wv, u);
      float bur = 0.f, bui = 0.f;
#pragma unroll
      for (int c = 0; c < 16; ++c) { bur += bbr[c] * u[c]; bui += bbi[c] * u[c]; }
      float nr = abr * xr - abi * xi + bur;
      float ni = abr * xi + abi * xr + bui;
      xr = nr; xi = ni;
      int a = n4w * 64 + ((t ^ (n4w & 7)) << 2) + e4;
      xsr[a] = xr; xsi[a] = xi;
    }
    __syncthreads();
    float acc0 = 0.f, acc1 = 0.f, acc2 = 0.f, acc3 = 0.f;
#pragma unroll 2
    for (int n4 = 0; n4 < 16; ++n4) {
      int xa = n4 * 64 + ((tt ^ (n4 & 7)) << 2);
      float4 xr4 = *(const float4*)(xsr + xa);
      float4 xi4 = *(const float4*)(xsi + xa);
      const float* cr = csr + n4 * 64 + cq * 16;
      const float* ci = csi + n4 * 64 + cq * 16;
      float4 r0 = *(const float4*)(cr), r1 = *(const float4*)(cr + 4), r2 = *(const float4*)(cr + 8), r3 = *(const float4*)(cr + 12);
      float4 i0 = *(const float4*)(ci), i1 = *(const float4*)(ci + 4), i2 = *(const float4*)(ci + 8), i3 = *(const float4*)(ci + 12);
      acc0 += r0.x * xr4.x + r0.y * xr4.y + r0.z * xr4.z + r0.w * xr4.w - (i0.x * xi4.x + i0.y * xi4.y + i0.z * xi4.z + i0.w * xi4.w);
      acc1 += r1.x * xr4.x + r1.y * xr4.y + r1.z * xr4.z + r1.w * xr4.w - (i1.x * xi4.x + i1.y * xi4.y + i1.z * xi4.z + i1.w * xi4.w);
      acc2 += r2.x * xr4.x + r2.y * xr4.y + r2.z * xr4.z + r2.w * xr4.w - (i2.x * xi4.x + i2.y * xi4.y + i2.z * xi4.z + i2.w * xi4.w);
      acc3 += r3.x * xr4.x + r3.y * xr4.y + r3.z * xr4.z + r3.w * xr4.w - (i3.x * xi4.x + i3.y * xi4.y + i3.z * xi4.z + i3.w * xi4.w);
    }
    {
      const int tok = tok0 + sc * 16 + tt;
      u32x2 ur = *(const u32x2*)(us + (sc * 16 + tt) * 64 + wv * 16 + cq * 4);
      float y0 = acc0 + d0 * bflo(ur.x), y1 = acc1 + d1 * bfhi(ur.x), y2 = acc2 + d2 * bflo(ur.y), y3 = acc3 + d3 * bfhi(ur.y);
      u32x2 o; o.x = pack2(geluf_(y0), geluf_(y1)); o.y = pack2(geluf_(y2), geluf_(y3));
      *(u32x2*)(YD + (size_t)tok * 256 + g * 16 + cq * 4) = o;
    }
    __syncthreads();
  }
}

__device__ __forceinline__ void lds_barrier() {
  asm volatile("s_waitcnt lgkmcnt(0)" ::: "memory");
  __builtin_amdgcn_s_barrier();
  asm volatile("" ::: "memory");
}
using f32x2 = __attribute__((ext_vector_type(2))) float;
__device__ __forceinline__ void scan_item(const Params& p, int item, unsigned char* smem) {
  const int tid = threadIdx.x, lane = tid & 63, wv = tid >> 6;
  const int b = item >> 4, h = (item >> 2) & 3, q = item & 3;
  const int rl = lane >> 4, cl = lane & 15;
  const int rloc = wv * 4 + rl;
  const size_t tokb = (size_t)b * SEQ;
  const int chan0 = h * 64;
  const u16* SR = (const u16*)(p.ws + OFF_SR); const u16* SK = (const u16*)(p.ws + OFF_SK);
  const u16* SV = (const u16*)(p.ws + OFF_SV); const u16* SKK = (const u16*)(p.ws + OFF_SKK);
  const u16* SA = (const u16*)(p.ws + OFF_SA); const float* SW = (const float*)(p.ws + OFF_SW);
  float* O = (float*)(p.ws + OFF_O);
  constexpr int BUFF = 5376;
  float* lbase = (float*)smem;
  float* pp = lbase + 2 * BUFF + wv * 1024;
  const int st = tid >> 4, cg4 = tid & 15;
  struct Stg { u32x2 r, k, kk, a; f32x4 w; u16 v; };
  auto gload = [&](Stg& g, int c) {
    const size_t o = (tokb + (size_t)c * 16 + st) * 256 + chan0;
    g.r = *(const u32x2*)(SR + o + cg4 * 4); g.k = *(const u32x2*)(SK + o + cg4 * 4);
    g.kk = *(const u32x2*)(SKK + o + cg4 * 4); g.a = *(const u32x2*)(SA + o + cg4 * 4);
    g.w = *(const f32x4*)(SW + o + cg4 * 4);
    g.v = SV[o + q * 16 + cg4];
  };
  auto lwrite = [&](const Stg& g, int buf) {
    float* bp = lbase + buf * BUFF;
    const int o = st * 64 + cg4 * 4;
    f32x4 kk = {bflo(g.kk.x), bfhi(g.kk.x), bflo(g.kk.y), bfhi(g.kk.y)};
    f32x4 a = {bflo(g.a.x), bfhi(g.a.x), bflo(g.a.y), bfhi(g.a.y)};
    f32x4 k = {bflo(g.k.x), bfhi(g.k.x), bflo(g.k.y), bfhi(g.k.y)};
    f32x4 r = {bflo(g.r.x), bfhi(g.r.x), bflo(g.r.y), bfhi(g.r.y)};
    *(f32x4*)(bp + o) = kk;
    *(f32x4*)(bp + 1024 + o) = kk * a;
    *(f32x4*)(bp + 2048 + o) = k;
    *(f32x4*)(bp + 3072 + o) = g.w;
    *(f32x4*)(bp + 4096 + o) = r;
    bp[5120 + st * 16 + cg4] = bf2f(g.v);
  };
  constexpr int NCH = SEQ / 16;
  Stg R0, R1, R2, R3;
  gload(R0, 0); gload(R1, 1); gload(R2, 2); gload(R3, 3);
  __syncthreads();
  lwrite(R0, 0);
  __syncthreads();
  __builtin_amdgcn_s_setprio(3);
  float S0 = 0.f, S1 = 0.f, S2 = 0.f, S3 = 0.f;
  const int rrow = lane & 3, rstep = lane >> 2;
  struct Ops { f32x4 kk, bb, k4, w4, r4; float v; };
  auto chunk = [&](int c) {
    const float* bp = lbase + (c & 1) * BUFF;
    auto ldops = [&](Ops& o, int s) {
      o.kk = *(const f32x4*)(bp + s * 64 + cl * 4);
      o.bb = *(const f32x4*)(bp + 1024 + s * 64 + cl * 4);
      o.k4 = *(const f32x4*)(bp + 2048 + s * 64 + cl * 4);
      o.w4 = *(const f32x4*)(bp + 3072 + s * 64 + cl * 4);
      o.r4 = *(const f32x4*)(bp + 4096 + s * 64 + cl * 4);
      o.v = bp[5120 + s * 16 + rloc];
    };
    auto step = [&](const Ops& o, int s) {
      const float sa = row_sum16(__builtin_fmaf(S3, o.kk.w, __builtin_fmaf(S2, o.kk.z, __builtin_fmaf(S1, o.kk.y, S0 * o.kk.x))));
      S0 = __builtin_fmaf(S0, o.w4.x, __builtin_fmaf(o.v, o.k4.x, -(sa * o.bb.x)));
      S1 = __builtin_fmaf(S1, o.w4.y, __builtin_fmaf(o.v, o.k4.y, -(sa * o.bb.y)));
      S2 = __builtin_fmaf(S2, o.w4.z, __builtin_fmaf(o.v, o.k4.z, -(sa * o.bb.z)));
      S3 = __builtin_fmaf(S3, o.w4.w, __builtin_fmaf(o.v, o.k4.w, -(sa * o.bb.w)));
      pp[(s * 4 + rl) * 16 + cl] = __builtin_fmaf(S3, o.r4.w, __builtin_fmaf(S2, o.r4.z, __builtin_fmaf(S1, o.r4.y, S0 * o.r4.x)));
    };
    Ops a0, a1, b0, b1;
    ldops(a0, 0); ldops(a1, 1);
#pragma unroll
    for (int j = 0; j < 4; ++j) {
      ldops(b0, 4 * j + 2); ldops(b1, 4 * j + 3);
      __builtin_amdgcn_sched_barrier(0);
      step(a0, 4 * j); step(a1, 4 * j + 1);
      __builtin_amdgcn_sched_barrier(0);
      if (j < 3) { ldops(a0, 4 * j + 4); ldops(a1, 4 * j + 5); }
      __builtin_amdgcn_sched_barrier(0);
      step(b0, 4 * j + 2); step(b1, 4 * j + 3);
      __builtin_amdgcn_sched_barrier(0);
    }
    asm volatile("" ::: "memory");
    {
      const float* q0 = pp + (rstep * 4 + rrow) * 16;
      f32x4 a0 = *(const f32x4*)(q0), a1 = *(const f32x4*)(q0 + 4), a2 = *(const f32x4*)(q0 + 8), a3 = *(const f32x4*)(q0 + 12);
      f32x4 sm4 = (a0 + a1) + (a2 + a3);
      O[(tokb + (size_t)c * 16 + rstep) * 256 + chan0 + q * 16 + wv * 4 + rrow] = (sm4.x + sm4.y) + (sm4.z + sm4.w);
    }
    asm volatile("" ::: "memory");
  };
#pragma unroll 1
  for (int g = 0; g < NCH / 4; ++g) {
    const int c0 = g * 4;
    if (c0 + 4 < NCH) gload(R0, c0 + 4);
    chunk(c0);
    lwrite(R1, (c0 + 1) & 1);
    lds_barrier();
    if (c0 + 5 < NCH) gload(R1, c0 + 5);
    chunk(c0 + 1);
    lwrite(R2, (c0 + 2) & 1);
    lds_barrier();
    if (c0 + 6 < NCH) gload(R2, c0 + 6);
    chunk(c0 + 2);
    lwrite(R3, (c0 + 3) & 1);
    lds_barrier();
    if (c0 + 7 < NCH) gload(R3, c0 + 7);
    chunk(c0 + 3);
    if (c0 + 4 < NCH) lwrite(R0, (c0 + 4) & 1);
    lds_barrier();
  }
  __builtin_amdgcn_s_setprio(0);
}

__device__ __forceinline__ void rwkv_post_item(const Params& p, int l, int item) {
  const int j = threadIdx.x;
  const float* O = (const float*)(p.ws + OFF_O);
  const u16* SR = (const u16*)(p.ws + OFF_SR); const u16* SK = (const u16*)(p.ws + OFF_SK);
  const u16* SV = (const u16*)(p.ws + OFF_SV); const u16* G = (const u16*)(p.ws + OFF_G);
  u16* OG = (u16*)(p.ws + OFF_OG);
  const float lw = p.in[18][l * 256 + j], lb = p.in[19][l * 256 + j], rk = p.in[17][l * 256 + j];
  const int tok0 = item * 8;
  float ov[8]; u16 rr[8], rkk[8], rv[8], rg[8];
#pragma unroll
  for (int t = 0; t < 8; ++t) {
    const size_t o = (size_t)(tok0 + t) * 256 + j;
    ov[t] = O[o]; rr[t] = SR[o]; rkk[t] = SK[o]; rv[t] = SV[o]; rg[t] = G[o];
  }
#pragma unroll
  for (int t = 0; t < 8; ++t) {
    const size_t o = (size_t)(tok0 + t) * 256 + j;
    float mean = wave_sum(ov[t]) * (1.f / 64.f);
    float d = ov[t] - mean;
    float var = wave_sum(d * d) * (1.f / 64.f);
    float on = d * rsqrtf(var + 64e-5f) * lw + lb;
    float bonus = wave_sum(bf2f(rr[t]) * bf2f(rkk[t]) * rk);
    OG[o] = f2bf((on + bonus * bf2f(rv[t])) * bf2f(rg[t]));
  }
}

#define XB_TMO      128
#define XB_XCNT(j)  (256  + 64 * (j))
#define XB_XSUB(j)  (1280 + 64 * (j))
#define XB_XGEN(j)  (2304 + 64 * (j))
#define XB_TOP      3328
#define XB_TOPGEN   3392
#define XCD_BAR_WORDS 3456
#define XB_SPIN_CAP (1u << 22)
#define LAS __attribute__((address_space(3)))
__device__ __forceinline__ unsigned xb_ld(unsigned* p) { return __hip_atomic_load(p, __ATOMIC_RELAXED, __HIP_MEMORY_SCOPE_AGENT); }
__device__ __forceinline__ unsigned xb_add(unsigned* p, unsigned v) { return __hip_atomic_fetch_add(p, v, __ATOMIC_RELAXED, __HIP_MEMORY_SCOPE_AGENT); }
__device__ __forceinline__ unsigned xb_xcc_id() { return (unsigned)__builtin_amdgcn_s_getreg((3 << 11) | 20) & 0xFu; }
#define XB_SPIN(cond, bar) do { unsigned _sp = 0; while (cond) { __builtin_amdgcn_s_sleep(1); \
    if ((++_sp & 255u) == 0u) { if (xb_ld(&(bar)[XB_TMO])) break; if (_sp > XB_SPIN_CAP) { atomicAdd(&(bar)[XB_TMO], 1u); break; } } } } while (0)
struct XcdBarrier { unsigned* bar; unsigned x; volatile LAS unsigned* st; };
__device__ __forceinline__ XcdBarrier xcd_barrier_post(unsigned* bar, volatile LAS unsigned* st) {
  XcdBarrier b; b.bar = bar; b.x = xb_xcc_id(); b.st = st;
  if (threadIdx.x == 0) (void)xb_add(&bar[XB_XCNT(b.x)], 1u);
  return b;
}
__device__ __forceinline__ void xcd_barrier_complete(unsigned* bar, unsigned x, unsigned& nloc, unsigned& nx) {
  const unsigned G = gridDim.x * gridDim.y * gridDim.z;
  unsigned sum, cnt, mine, sp = 0u;
  for (;;) {
    sum = 0u; cnt = 0u; mine = 0u;
#pragma unroll
    for (unsigned j = 0; j < 16; ++j) { const unsigned c = xb_ld(&bar[XB_XCNT(j)]); sum += c; cnt += (c > 0u) ? 1u : 0u; mine = (j == x) ? c : mine; }
    if (sum == G) break;
    __builtin_amdgcn_s_sleep(1);
    if ((++sp & 255u) == 0u) { if (xb_ld(&bar[XB_TMO])) break; if (sp > XB_SPIN_CAP) { atomicAdd(&bar[XB_TMO], 1u); break; } }
  }
  nloc = mine > 0u ? mine : 1u; nx = cnt > 0u ? cnt : 1u;
}
__device__ __forceinline__ void xcd_barrier(const XcdBarrier& b) {
  asm volatile("s_waitcnt vmcnt(0)" ::: "memory");
  __syncthreads();
  if (threadIdx.x == 0) {
    unsigned* bar = b.bar;
    __builtin_amdgcn_s_waitcnt(0);
    unsigned nloc = b.st[0], nx = b.st[1];
    if (nloc == 0u) { xcd_barrier_complete(bar, b.x, nloc, nx); b.st[0] = nloc; b.st[1] = nx; }
    const unsigned old = xb_add(&bar[XB_XSUB(b.x)], 1u);
    const unsigned gen = old / nloc;
    if (old + 1u == (gen + 1u) * nloc) {
      __builtin_amdgcn_fence(__ATOMIC_RELEASE, "agent");
      asm volatile("s_waitcnt vmcnt(0)" ::: "memory");
      const unsigned og = xb_add(&bar[XB_TOP], 1u);
      const unsigned tg = og / nx;
      if (og + 1u == (tg + 1u) * nx) xb_add(&bar[XB_TOPGEN], 1u);
      else XB_SPIN(xb_ld(&bar[XB_TOPGEN]) == tg, bar);
      __builtin_amdgcn_fence(__ATOMIC_ACQUIRE, "agent");
      xb_add(&bar[XB_XGEN(b.x)], 1u);
      asm volatile("s_waitcnt vmcnt(0)" ::: "memory");
    } else {
      XB_SPIN(xb_ld(&bar[XB_XGEN(b.x)]) == gen, bar);
      __builtin_amdgcn_fence(__ATOMIC_ACQUIRE, "agent");
      asm volatile("s_waitcnt vmcnt(0)" ::: "memory");
    }
  }
  __syncthreads();
}

__device__ __forceinline__ void sub_barrier(unsigned* cnt, unsigned target) {
  asm volatile("s_waitcnt vmcnt(0)" ::: "memory");
  __syncthreads();
  if (threadIdx.x == 0) {
    __builtin_amdgcn_fence(__ATOMIC_RELEASE, "agent");
    asm volatile("s_waitcnt vmcnt(0)" ::: "memory");
    xb_add(cnt, 1u);
    unsigned sp = 0;
    while (xb_ld(cnt) < target) { __builtin_amdgcn_s_sleep(2); if (++sp > (1u << 24)) break; }
    __builtin_amdgcn_fence(__ATOMIC_ACQUIRE, "agent");
    asm volatile("s_waitcnt vmcnt(0)" ::: "memory");
  }
  __syncthreads();
}

#define N_PHASES 22
#ifndef PROBE_CONV_REPS
#define PROBE_CONV_REPS 1
#endif
#ifndef PROBE_PREP_REPS
#define PROBE_PREP_REPS 1
#endif
#ifndef PROBE_POST_REPS
#define PROBE_POST_REPS 1
#endif
#ifndef PROBE_SCAN_REPS
#define PROBE_SCAN_REPS 1
#endif
#ifndef PROBE_FFN1_REPS
#define PROBE_FFN1_REPS 1
#endif
#ifndef PH_MASK
#define PH_MASK 0xFFFFF
#endif
#define PHON(s) (PH_MASK & (1 << (s)))
#define PHASE_BEGIN(k) if (ph_lo <= (k) && (k) < ph_hi) { if ((k) > ph_lo) xcd_barrier(xb);
#define PHASE_END }

template <int L>
__device__ __forceinline__ void run_layer(const Params& p, int ph_lo, int ph_hi, unsigned char* smem, const XcdBarrier& xb) {
  constexpr int l = L;
  constexpr int base = 1 + 10 * L;
  const float* modl = (const float*)(p.ws + OFF_MOD) + (size_t)l * 4 * 6144;
  PHASE_BEGIN(base + 0)
    for (int rep = 0; rep < PROBE_CONV_REPS; ++rep) {
      if (rep) xcd_barrier(xb);
      phase_convert(p, l, smem);
      phase_norm(l == 0 ? p.in[0] : p.out, p.in[4] + l * 1024, modl, 0, 1024, (u16*)(p.ws + OFF_H));
    }
  PHASE_END
  PHASE_BEGIN(base + 1)
    if (PHON(1)) phase_gemm<0>(p, l, smem);
  PHASE_END
  PHASE_BEGIN(base + 2)
    for (int rep = 0; rep < PROBE_PREP_REPS; ++rep) {
      if (rep) xcd_barrier(xb);
      for (int item = blockIdx.x; item < 512; item += gridDim.x) rwkv_prep_item(p, l, item, smem);
    }
  PHASE_END
  PHASE_BEGIN(base + 3)
    if ((int)blockIdx.x < 64) scan_item(p, blockIdx.x, smem);
    else {
      const int nb = gridDim.x - 64, bi = blockIdx.x - 64;
      for (int item = bi; item < 512; item += nb) sg_item(p, l, item, smem);
      for (int item = (bi + 64) % nb; item < 1024; item += nb) s5a_item(p, l, item, smem);
      for (int item = bi; item < 2048; item += nb) conv_item(p, l, item);
      sub_barrier((unsigned*)(p.ws + OFF_BAR) + 3520 + 64 * (2 * l), gridDim.x - 64);
      for (int item = blockIdx.x - 64; item < 1024; item += gridDim.x - 64) s5b_item(p, l, item, smem);
      sub_barrier((unsigned*)(p.ws + OFF_BAR) + 3520 + 64 * (2 * l + 1), gridDim.x - 64);
      for (int item = blockIdx.x - 64; item < 2048; item += gridDim.x - 64) merge_tile<0>(p, item, smem);
    }
  PHASE_END
  PHASE_BEGIN(base + 4)
    for (int rep = 0; rep < PROBE_POST_REPS; ++rep) { if (rep) xcd_barrier(xb); for (int item = blockIdx.x; item < 2048; item += gridDim.x) rwkv_post_item(p, l, item); }
  PHASE_END
  PHASE_BEGIN(base + 5)
    for (int item = blockIdx.x; item < 2048; item += gridDim.x) merge_tile<1>(p, item, smem);
  PHASE_END
  PHASE_BEGIN(base + 6)
    if (PHON(6)) phase_gemm<1>(p, l, smem);
  PHASE_END
  PHASE_BEGIN(base + 7)
    if (PHON(7)) phase_norm(p.out, p.in[38] + l * 1024, modl, 3072, 4096, (u16*)(p.ws + OFF_H));
  PHASE_END
  PHASE_BEGIN(base + 8)
    for (int rep = 0; rep < PROBE_FFN1_REPS; ++rep) { if (rep) xcd_barrier(xb); phase_gemm<2>(p, l, smem); }
  PHASE_END
  PHASE_BEGIN(base + 9)
    if (PHON(9)) phase_gemm<3>(p, l, smem);
  PHASE_END
}

__global__ void __launch_bounds__(NTHR, 2) mega_fwd(Params p, int ph_lo, int ph_hi) {
  __shared__ __attribute__((aligned(16))) unsigned char smem[73728 + 16];
  cg::grid_group grid = cg::this_grid();
  if (ph_hi < 0) grid.sync();
  volatile LAS unsigned* st = (volatile LAS unsigned*)(smem + 73728);
  if (threadIdx.x == 0) { st[0] = 0u; st[1] = 0u; }
  __syncthreads();
  const XcdBarrier xb = xcd_barrier_post((unsigned*)(p.ws + OFF_BAR), st);
  PHASE_BEGIN(0)
    if (PHON(10)) phase_mod(p, smem);
  PHASE_END
  run_layer<0>(p, ph_lo, ph_hi, smem, xb);
  run_layer<1>(p, ph_lo, ph_hi, smem, xb);
  PHASE_BEGIN(21)
    if (PHON(11)) phase_final(p.out, p.in[41]);
  PHASE_END
}

extern "C" void kernel_launch(void* const* d_in, const int* in_sizes, int n_in, void* d_out, int out_size, void* d_ws,
                              size_t ws_size, hipStream_t stream) {
  static int grid_blocks = 0;
  if (!grid_blocks) {
    int dev = 0, cus = 0, per_cu = 0;
    hipGetDevice(&dev);
    hipDeviceGetAttribute(&cus, hipDeviceAttributeMultiprocessorCount, dev);
    hipOccupancyMaxActiveBlocksPerMultiprocessor(&per_cu, mega_fwd, NTHR, 0);
    if (per_cu > 2) per_cu = 2;
    if (per_cu < 1) per_cu = 1;
    grid_blocks = cus * per_cu;
    if (ws_size < WS_END) fprintf(stderr, "workspace too small: %zu < %zu\n", ws_size, (size_t)WS_END);
  }
  Params p{};
  for (int i = 0; i < 42; ++i) p.in[i] = (const float*)d_in[i];
  p.out = (float*)d_out;
  p.ws = (unsigned char*)d_ws;
  hipMemsetAsync((unsigned char*)d_ws + OFF_BAR, 0, 16384, stream);
  int lo = 0, hi = N_PHASES;
  void* args[] = {&p, &lo, &hi};
  hipError_t e = hipLaunchCooperativeKernel((void*)mega_fwd, dim3(grid_blocks), dim3(NTHR), args, 0, stream);
  if (e != hipSuccess) fprintf(stderr, "cooperative launch failed: %s (grid %d)\n", hipGetErrorString(e), grid_blocks);
}
```

```cpp
#include <hip/hip_runtime.h>
#include <hip/hip_cooperative_groups.h>
#include <cstdio>
namespace cg = cooperative_groups;

typedef unsigned short u16;
using bf16x8 = __attribute__((ext_vector_type(8))) short;
using f32x4 = __attribute__((ext_vector_type(4))) float;
using u32x4 = __attribute__((ext_vector_type(4))) unsigned int;
using u32x2 = __attribute__((ext_vector_type(2))) unsigned int;

#define T_TOK 16384
#define SEQ 4096
#define DM 1024
#define NTHR 256

static constexpr size_t SZ_WIN = (size_t)6528 * 1024 * 2;
static constexpr size_t OFF_WIN = 0;
static constexpr size_t OFF_RO = OFF_WIN + SZ_WIN;
static constexpr size_t OFF_SO = OFF_RO + 1024 * 256 * 2;
static constexpr size_t OFF_CO = OFF_SO + 1024 * 256 * 2;
static constexpr size_t OFF_GLU = OFF_CO + 1024 * 256 * 2;
static constexpr size_t OFF_WO = OFF_GLU + 2048 * 256 * 2;
static constexpr size_t OFF_W1 = OFF_WO + 1024 * 1024 * 2;
static constexpr size_t OFF_W2 = OFF_W1 + (size_t)4096 * 1024 * 2;
static constexpr size_t OFF_H = OFF_W2 + (size_t)4096 * 1024 * 2;
static constexpr size_t SZ_T256B = (size_t)T_TOK * 256 * 2;
static constexpr size_t OFF_VF = OFF_H + (size_t)T_TOK * 1024 * 2;
static constexpr size_t OFF_PD = OFF_VF + SZ_T256B;
static constexpr size_t OFF_G = OFF_PD + SZ_T256B;
static constexpr size_t OFF_UB = OFF_G + SZ_T256B;
static constexpr size_t OFF_CB = OFF_UB + SZ_T256B;
static constexpr size_t OFF_SR = OFF_CB + SZ_T256B;
static constexpr size_t OFF_SK = OFF_SR + SZ_T256B;
static constexpr size_t OFF_SV = OFF_SK + SZ_T256B;
static constexpr size_t OFF_SKK = OFF_SV + SZ_T256B;
static constexpr size_t OFF_SA = OFF_SKK + SZ_T256B;
static constexpr size_t OFF_SW = OFF_SA + SZ_T256B;
static constexpr size_t OFF_PABC = OFF_SW + 2 * SZ_T256B;
static constexpr size_t OFF_YD = OFF_PABC;
static constexpr size_t OFF_OG = OFF_YD + SZ_T256B;
static constexpr size_t OFF_MRG = OFF_OG + SZ_T256B;
static constexpr size_t OFF_F = OFF_UB;
static constexpr size_t OFF_SMALL = OFF_PABC + (size_t)T_TOK * 2176 * 2;
static constexpr size_t OFF_MOD = OFF_SMALL;
static constexpr size_t OFF_S5AB = OFF_MOD + 2 * 4 * 6144 * 4;
static constexpr size_t OFF_S5BB = OFF_S5AB + 2 * 16 * 64 * 2 * 4;
static constexpr size_t OFF_S5E = OFF_S5BB + 2 * 16 * 64 * 32 * 4;
static constexpr size_t OFF_BAR = OFF_S5E + (size_t)4 * 64 * 16 * 64 * 2 * 4;
static constexpr size_t OFF_SGW = OFF_BAR + 16384;
static constexpr size_t OFF_O = OFF_SGW + 4 * 128 * 128 * 2;
static constexpr size_t WS_END = OFF_O + 2 * SZ_T256B;
static_assert(OFF_F + (size_t)T_TOK * 4096 * 2 <= OFF_SMALL, "F overlaps small region");
static_assert(OFF_MRG + (size_t)T_TOK * 1024 * 2 <= OFF_SMALL, "MRG overlaps");

struct Params {
  const float* in[42];
  float* out;
  unsigned char* ws;
};

__device__ __forceinline__ u16 f2bf(float f) {
  unsigned u = __float_as_uint(f);
  u += 0x7fffu + ((u >> 16) & 1u);
  return (u16)(u >> 16);
}
__device__ __forceinline__ float bf2f(u16 h) { return __uint_as_float(((unsigned)h) << 16); }
__device__ __forceinline__ float bflo(unsigned u) { return __uint_as_float(u << 16); }
__device__ __forceinline__ float bfhi(unsigned u) { return __uint_as_float(u & 0xffff0000u); }
__device__ __forceinline__ unsigned pack2(float a, float b) { return (unsigned)f2bf(a) | ((unsigned)f2bf(b) << 16); }
__device__ __forceinline__ float sigmoidf_(float x) { return 1.f / (1.f + __expf(-x)); }
__device__ __forceinline__ float tanhf_(float y) { return 1.f - 2.f / (1.f + __expf(2.f * y)); }
__device__ __forceinline__ float geluf_(float x) {
  float y = 0.7978845608028654f * (x + 0.044715f * x * x * x);
  return 0.5f * x * (1.f + tanhf_(y));
}
__device__ __forceinline__ float wave_sum(float v) {
#pragma unroll
  for (int o = 32; o > 0; o >>= 1) v += __shfl_xor(v, o, 64);
  return v;
}
template <int CTRL>
__device__ __forceinline__ float dppf(float x) {
  return __int_as_float(__builtin_amdgcn_update_dpp(__float_as_int(x), __float_as_int(x), CTRL, 0xF, 0xF, true));
}
__device__ __forceinline__ float row_sum16(float x) {
  x += dppf<0x128>(x);
  x += dppf<0x124>(x);
  x += dppf<0x122>(x);
  x += dppf<0x121>(x);
  return x;
}

__device__ __forceinline__ void phase_mod(const Params& p, unsigned char* smem) {
  const int tid = threadIdx.x;
  float* cact = (float*)smem;
  float* red = cact + 4096;
  float* mod = (float*)(p.ws + OFF_MOD);
  for (int i = tid; i < 4096; i += NTHR) { float c = p.in[1][i]; cact[i] = c / (1.f + __expf(-c)); }
  __syncthreads();
  for (int item = blockIdx.x; item < 192; item += gridDim.x) {
    int l = item / 96, nb = item % 96;
    int cl = tid & 63, kq = tid >> 6;
    int col = nb * 64 + cl;
    const float* W = p.in[2] + (size_t)l * 1024 * 6144;
    float a0 = 0, a1 = 0, a2 = 0, a3 = 0;
    for (int k = kq * 256; k < kq * 256 + 256; ++k) {
      float w = W[(size_t)k * 6144 + col];
      a0 += cact[k] * w; a1 += cact[1024 + k] * w; a2 += cact[2048 + k] * w; a3 += cact[3072 + k] * w;
    }
    red[(kq * 4 + 0) * 64 + cl] = a0; red[(kq * 4 + 1) * 64 + cl] = a1;
    red[(kq * 4 + 2) * 64 + cl] = a2; red[(kq * 4 + 3) * 64 + cl] = a3;
    __syncthreads();
    {
      int b = tid >> 6;
      float s = red[(0 * 4 + b) * 64 + cl] + red[(1 * 4 + b) * 64 + cl] + red[(2 * 4 + b) * 64 + cl] + red[(3 * 4 + b) * 64 + cl];
      mod[((size_t)l * 4 + b) * 6144 + col] = s + p.in[3][l * 6144 + col];
    }
    __syncthreads();
  }
  float* s5ab = (float*)(p.ws + OFF_S5AB);
  float* s5bb = (float*)(p.ws + OFF_S5BB);
  for (int idx = blockIdx.x * NTHR + tid; idx < 2048; idx += gridDim.x * NTHR) {
    int l = idx >> 10, g = (idx >> 6) & 15, n = idx & 63;
    double lre = fmin((double)p.in[28][idx], -1e-4);
    double lim = (double)p.in[29][idx];
    double dt = exp((double)p.in[35][l * 16 + g]);
    double mag = exp(lre * dt);
    double abr = mag * cos(lim * dt), abi = mag * sin(lim * dt);
    double den = lre * lre + lim * lim;
    double qr = ((abr - 1.0) * lre + abi * lim) / den;
    double qi = (abi * lre - (abr - 1.0) * lim) / den;
    s5ab[idx * 2 + 0] = (float)abr; s5ab[idx * 2 + 1] = (float)abi;
    for (int c = 0; c < 16; ++c) {
      double br = p.in[30][(size_t)idx * 16 + c], bi = p.in[31][(size_t)idx * 16 + c];
      s5bb[(size_t)idx * 32 + c] = (float)(qr * br - qi * bi);
      s5bb[(size_t)idx * 32 + 16 + c] = (float)(qr * bi + qi * br);
    }
  }
}

__device__ __forceinline__ void convert_tile(const float* __restrict__ src, int K, int N, u16* __restrict__ dst, int tk, int tn, u16* sm) {
  const int tid = threadIdx.x;
  int r = tid >> 4, c4 = (tid & 15) * 4;
#pragma unroll
  for (int i = 0; i < 4; ++i) {
    int kk = r + 16 * i;
    float4 v = *(const float4*)(src + (size_t)(tk * 64 + kk) * N + tn * 64 + c4);
    sm[(c4 + 0) * 72 + kk] = f2bf(v.x);
    sm[(c4 + 1) * 72 + kk] = f2bf(v.y);
    sm[(c4 + 2) * 72 + kk] = f2bf(v.z);
    sm[(c4 + 3) * 72 + kk] = f2bf(v.w);
  }
  __syncthreads();
#pragma unroll
  for (int j = 0; j < 2; ++j) {
    int n = (tid >> 3) + 32 * j, ch = tid & 7;
    u32x4 v = *(const u32x4*)(sm + n * 72 + ch * 8);
    *(u32x4*)(dst + (size_t)(tn * 64 + n) * K + tk * 64 + ch * 8) = v;
  }
  __syncthreads();
}

__device__ __forceinline__ void phase_convert(const Params& p, int l, unsigned char* smem) {
  u16* sm = (u16*)smem;
  const int total = 1632 + 192 + 128 + 256 + 1024 + 1024;
  for (int item = blockIdx.x; item < total + 16; item += gridDim.x) {
    int t = item;
    if (t >= total) {
      const int idx = t - total, g = idx >> 2, rq = idx & 3;
      const int tr = rq * 32 + (threadIdx.x >> 3), s0 = (threadIdx.x & 7) * 16;
      const float* src = p.in[23] + (((size_t)l * 4 + g) * 128 + tr) * 128 + s0;
      u16* dst = (u16*)(p.ws + OFF_SGW) + ((size_t)g * 128 + tr) * 128 + s0;
      unsigned pk[8];
#pragma unroll
      for (int e = 0; e < 4; ++e) {
        f32x4 v = *(const f32x4*)(src + e * 4);
        const int sb = s0 + e * 4;
        pk[e * 2 + 0] = pack2(sb + 0 <= tr ? v.x : 0.f, sb + 1 <= tr ? v.y : 0.f);
        pk[e * 2 + 1] = pack2(sb + 2 <= tr ? v.z : 0.f, sb + 3 <= tr ? v.w : 0.f);
      }
      *(u32x4*)(dst) = u32x4{pk[0], pk[1], pk[2], pk[3]};
      *(u32x4*)(dst + 8) = u32x4{pk[4], pk[5], pk[6], pk[7]};
      continue;
    }
    const float* src; int K, N; size_t off;
    if (t < 1632) { src = p.in[5] + (size_t)l * 1024 * 6528; K = 1024; N = 6528; off = OFF_WIN; }
    else if ((t -= 1632) < 64) { src = p.in[20] + (size_t)l * 256 * 1024; K = 256; N = 1024; off = OFF_RO; }
    else if ((t -= 64) < 64) { src = p.in[25] + (size_t)l * 256 * 1024; K = 256; N = 1024; off = OFF_SO; }
    else if ((t -= 64) < 64) { src = p.in[27] + (size_t)l * 256 * 1024; K = 256; N = 1024; off = OFF_CO; }
    else if ((t -= 64) < 128) { src = p.in[36] + (size_t)l * 256 * 2048; K = 256; N = 2048; off = OFF_GLU; }
    else if ((t -= 128) < 256) { src = p.in[37] + (size_t)l * 1024 * 1024; K = 1024; N = 1024; off = OFF_WO; }
    else if ((t -= 256) < 1024) { src = p.in[39] + (size_t)l * 1024 * 4096; K = 1024; N = 4096; off = OFF_W1; }
    else { t -= 1024; src = p.in[40] + (size_t)l * 4096 * 1024; K = 4096; N = 1024; off = OFF_W2; }
    int ntn = N / 64;
    convert_tile(src, K, N, (u16*)(p.ws + off), t / ntn, t % ntn, sm);
  }
}

__device__ __forceinline__ void phase_norm(const float* __restrict__ X, const float* __restrict__ g, const float* __restrict__ modl,
                           int sh_off, int sc_off, u16* __restrict__ H) {
  const int lane = threadIdx.x & 63, wv = threadIdx.x >> 6;
  for (int item = blockIdx.x; item < T_TOK / 4; item += gridDim.x) {
    int row = item * 4 + wv;
    int b = row >> 12;
    const float* xr = X + (size_t)row * 1024;
    float4 v[4];
    float ss = 0;
#pragma unroll
    for (int i = 0; i < 4; ++i) {
      v[i] = *(const float4*)(xr + lane * 4 + 256 * i);
      ss += v[i].x * v[i].x + v[i].y * v[i].y + v[i].z * v[i].z + v[i].w * v[i].w;
    }
    ss = wave_sum(ss);
    float rstd = rsqrtf(ss * (1.f / 1024.f) + 1e-6f);
    const float* sh = modl + (size_t)b * 6144 + sh_off;
    const float* sc = modl + (size_t)b * 6144 + sc_off;
#pragma unroll
    for (int i = 0; i < 4; ++i) {
      int c = lane * 4 + 256 * i;
      float4 gg = *(const float4*)(g + c);
      float4 s1 = *(const float4*)(sc + c);
      float4 s0 = *(const float4*)(sh + c);
      float h0 = v[i].x * rstd * gg.x * (1.f + s1.x) + s0.x;
      float h1 = v[i].y * rstd * gg.y * (1.f + s1.y) + s0.y;
      float h2 = v[i].z * rstd * gg.z * (1.f + s1.z) + s0.z;
      float h3 = v[i].w * rstd * gg.w * (1.f + s1.w) + s0.w;
      u32x2 o; o.x = pack2(h0, h1); o.y = pack2(h2, h3);
      *(u32x2*)(H + (size_t)row * 1024 + c) = o;
    }
  }
}

__device__ __forceinline__ void phase_final(float* __restrict__ X, const float* __restrict__ g) {
  const int lane = threadIdx.x & 63, wv = threadIdx.x >> 6;
  for (int item = blockIdx.x; item < T_TOK / 4; item += gridDim.x) {
    int row = item * 4 + wv;
    float* xr = X + (size_t)row * 1024;
    float4 v[4];
    float ss = 0;
#pragma unroll
    for (int i = 0; i < 4; ++i) {
      v[i] = *(const float4*)(xr + lane * 4 + 256 * i);
      ss += v[i].x * v[i].x + v[i].y * v[i].y + v[i].z * v[i].z + v[i].w * v[i].w;
    }
    ss = wave_sum(ss);
    float rstd = rsqrtf(ss * (1.f / 1024.f) + 1e-6f);
#pragma unroll
    for (int i = 0; i < 4; ++i) {
      int c = lane * 4 + 256 * i;
      float4 gg = *(const float4*)(g + c);
      float4 o;
      o.x = v[i].x * rstd * gg.x; o.y = v[i].y * rstd * gg.y; o.z = v[i].z * rstd * gg.z; o.w = v[i].w * rstd * gg.w;
      *(float4*)(xr + c) = o;
    }
  }
}

template <int NF, bool LEAN = false>
__device__ __forceinline__ void gemm_mainloop(const u16* __restrict__ A, int lda, const u16* __restrict__ B, int ldb,
                                              int K, f32x4 (&acc)[4][NF], u16* smem) {
  constexpr int BN = 32 * NF;
  constexpr int NB = BN / 32;
  u16* sA = smem;
  u16* sB = smem + 2 * 128 * 64;
  int tz = 0;
  if (LEAN) asm volatile("" : "+v"(tz));
  const int tid = threadIdx.x + tz, lane = tid & 63, wv = tid >> 6;
  const int wm = wv >> 1, wn = wv & 1;
  const int lrow = tid >> 3;
  const int lchs = (tid & 7) ^ ((lrow >> 1) & 7);
  const u16* Ap = A + (size_t)lrow * lda + lchs * 8;
  const u16* Bp = B + (size_t)lrow * ldb + lchs * 8;
  const int nk = K >> 6;
  auto stage = [&](int kt, int buf) {
    const int ko = kt << 6;
#pragma unroll
    for (int i = 0; i < 4; ++i)
      __builtin_amdgcn_global_load_lds((const unsigned*)(Ap + (size_t)(32 * i) * lda + ko),
                                       (__attribute__((address_space(3))) unsigned*)(sA + buf * (128 * 64) + (tid + 256 * i) * 8), 16, 0, 0);
#pragma unroll
    for (int i = 0; i < NB; ++i)
      __builtin_amdgcn_global_load_lds((const unsigned*)(Bp + (size_t)(32 * i) * ldb + ko),
                                       (__attribute__((address_space(3))) unsigned*)(sB + buf * (BN * 64) + (tid + 256 * i) * 8), 16, 0, 0);
  };
  __syncthreads();
  stage(0, 0);
  const int fr = lane & 15, fq = lane >> 4;
  const int sw = (fr >> 1) & 7;
  for (int kt = 0; kt < nk; ++kt) {
    const int cur = kt & 1;
    asm volatile("s_waitcnt vmcnt(0)" ::: "memory");
    __syncthreads();
    if (kt + 1 < nk) stage(kt + 1, cur ^ 1);
    const u16* cA = sA + cur * (128 * 64) + (wm * 64 + fr) * 64;
    const u16* cB = sB + cur * (BN * 64) + (wn * 16 * NF + fr) * 64;
#pragma unroll
    for (int ks = 0; ks < 2; ++ks) {
      if (LEAN) __builtin_amdgcn_sched_barrier(0);
      const int pc = ((fq + 4 * ks) ^ sw) << 3;
      bf16x8 fa[4], fb[NF];
#pragma unroll
      for (int i = 0; i < 4; ++i) fa[i] = *(const bf16x8*)(cA + i * 16 * 64 + pc);
#pragma unroll
      for (int j = 0; j < NF; ++j) fb[j] = *(const bf16x8*)(cB + j * 16 * 64 + pc);
#pragma unroll
      for (int i = 0; i < 4; ++i)
#pragma unroll
        for (int j = 0; j < NF; ++j)
          acc[i][j] = __builtin_amdgcn_mfma_f32_16x16x32_bf16(fb[j], fa[i], acc[i][j], 0, 0, 0);
    }
  }
}

template <int NF>
__device__ __forceinline__ void zero_acc(f32x4 (&acc)[4][NF]) {
#pragma unroll
  for (int i = 0; i < 4; ++i)
#pragma unroll
    for (int j = 0; j < NF; ++j) acc[i][j] = f32x4{0.f, 0.f, 0.f, 0.f};
}

__device__ __forceinline__ int swz4(int row) { return (0x78 >> (((row >> 2) & 3) * 2)) & 3; }
__device__ __forceinline__ void gemm_mainloop_big(const u16* __restrict__ A, int lda, const u16* __restrict__ B, int ldb,
                                                  int K, f32x4 (&acc)[8][4], u16* smem) {
  constexpr int STG = 12288;
  const int tid = threadIdx.x, lane = tid & 63, wv = tid >> 6;
  const int wm = wv >> 1, wn = wv & 1;
  const int lrow = tid >> 2;
  const int lchs = (tid & 3) ^ swz4(lrow);
  const u16* Ap = A + (size_t)lrow * lda + lchs * 8;
  const u16* Bp = B + (size_t)lrow * ldb + lchs * 8;
  const int nk = K >> 5;
  auto stage = [&](int kt, int buf) {
    const int ko = kt << 5;
    u16* sa = smem + buf * STG;
#pragma unroll
    for (int i = 0; i < 4; ++i)
      __builtin_amdgcn_global_load_lds((const unsigned*)(Ap + (size_t)(64 * i) * lda + ko),
                                       (__attribute__((address_space(3))) unsigned*)(sa + (tid + 256 * i) * 8), 16, 0, 0);
#pragma unroll
    for (int i = 0; i < 2; ++i)
      __builtin_amdgcn_global_load_lds((const unsigned*)(Bp + (size_t)(64 * i) * ldb + ko),
                                       (__attribute__((address_space(3))) unsigned*)(sa + 8192 + (tid + 256 * i) * 8), 16, 0, 0);
  };
  __syncthreads();
  stage(0, 0);
  stage(1, 1);
  const int fr = lane & 15, fq = lane >> 4;
  const int pc = (fq ^ swz4(fr)) << 3;
  int cur = 0;
  for (int kt = 0; kt < nk; ++kt) {
    asm volatile("s_waitcnt vmcnt(6)" ::: "memory");
    __builtin_amdgcn_s_barrier();
    asm volatile("" ::: "memory");
    {
      int nx = cur + 2; if (nx >= 3) nx -= 3;
      int ktn = kt + 2; if (ktn >= nk) ktn = nk - 1;
      stage(ktn, nx);
    }
    const u16* cA = smem + cur * STG + (wm * 128 + fr) * 32 + pc;
    const u16* cB = smem + cur * STG + 8192 + (wn * 64 + fr) * 32 + pc;
    bf16x8 fa[8], fb[4];
#pragma unroll
    for (int i = 0; i < 8; ++i) fa[i] = *(const bf16x8*)(cA + i * 16 * 32);
#pragma unroll
    for (int j = 0; j < 4; ++j) fb[j] = *(const bf16x8*)(cB + j * 16 * 32);
#pragma unroll
    for (int i = 0; i < 8; ++i)
#pragma unroll
      for (int j = 0; j < 4; ++j)
        acc[i][j] = __builtin_amdgcn_mfma_f32_16x16x32_bf16(fb[j], fa[i], acc[i][j], 0, 0, 0);
    cur = cur + 1; if (cur >= 3) cur = 0;
  }
  asm volatile("s_waitcnt vmcnt(0)" ::: "memory");
}

template <int EPI>
__device__ __forceinline__ void phase_gemm_big(const Params& p, int l, int vb, unsigned char* smem_raw) {
  u16* smem = (u16*)smem_raw;
  const int lane = threadIdx.x & 63, wv = threadIdx.x >> 6;
  const int wm = wv >> 1, wn = wv & 1;
  const int fr = lane & 15, fq = lane >> 4;
  const u16* A; const u16* B; int lda, ldb, K, ntiles_n;
  if (EPI == 1) { A = (const u16*)(p.ws + OFF_MRG); lda = 1024; B = (const u16*)(p.ws + OFF_WO); ldb = 1024; K = 1024; ntiles_n = 8; }
  if (EPI == 2) { A = (const u16*)(p.ws + OFF_H); lda = 1024; B = (const u16*)(p.ws + OFF_W1); ldb = 1024; K = 1024; ntiles_n = 32; }
  if (EPI == 3) { A = (const u16*)(p.ws + OFF_F); lda = 4096; B = (const u16*)(p.ws + OFF_W2); ldb = 4096; K = 4096; ntiles_n = 8; }
  const float* modl = (const float*)(p.ws + OFF_MOD) + (size_t)l * 4 * 6144;
  const int total = 64 * ntiles_n;
  const int G = gridDim.x;
  const bool swz = (G == 512);
  for (int item = vb; item < total; item += G) {
    int mt = item & 63, nt = item >> 6;
    if (swz) { const int r = item >> 9, w = vb & 63; mt = (vb >> 6) * 8 + (w & 7); nt = r * 8 + (w >> 3); }
    const int m0 = mt * 256, n0 = nt * 128;
    f32x4 acc[8][4];
#pragma unroll
    for (int i = 0; i < 8; ++i)
#pragma unroll
      for (int j = 0; j < 4; ++j) acc[i][j] = f32x4{0.f, 0.f, 0.f, 0.f};
    gemm_mainloop_big(A + (size_t)m0 * lda, lda, B + (size_t)n0 * ldb, ldb, K, acc, smem);
#pragma unroll
    for (int i = 0; i < 8; ++i) {
      const int m = m0 + wm * 128 + i * 16 + fr;
#pragma unroll
      for (int j = 0; j < 4; ++j) {
        const int n = n0 + wn * 64 + j * 16 + fq * 4;
        f32x4 v = acc[i][j];
        if (EPI == 1 || EPI == 3) {
          const int b = m >> 12;
          const float* gt = modl + (size_t)b * 6144 + (EPI == 1 ? 2048 : 5120) + n;
          const float* xin = ((EPI == 1 && l == 0) ? p.in[0] : p.out) + (size_t)m * 1024 + n;
          f32x4 x = *(const f32x4*)xin;
          f32x4 gg = *(const f32x4*)gt;
          *(f32x4*)(p.out + (size_t)m * 1024 + n) = x + gg * v;
        } else {
          float r0 = fmaxf(v[0], 0.f), r1 = fmaxf(v[1], 0.f), r2 = fmaxf(v[2], 0.f), r3 = fmaxf(v[3], 0.f);
          *(u32x2*)((u16*)(p.ws + OFF_F) + (size_t)m * 4096 + n) = u32x2{pack2(r0 * r0, r1 * r1), pack2(r2 * r2, r3 * r3)};
        }
      }
    }
  }
}

template <int EPI>
__device__ __forceinline__ void phase_gemm(const Params& p, int l, int vb, unsigned char* smem_raw) {
  u16* smem = (u16*)smem_raw;
  const int lane = threadIdx.x & 63, wv = threadIdx.x >> 6;
  const int wm = wv >> 1, wn = wv & 1;
  const int fr = lane & 15, fq = lane >> 4;
  const u16* A; const u16* B; int lda, ldb, K, ntiles_n;
  if (EPI == 0) { A = (const u16*)(p.ws + OFF_H); lda = 1024; B = (const u16*)(p.ws + OFF_WIN); ldb = 1024; K = 1024; ntiles_n = 19; }
  if (EPI == 1) { A = (const u16*)(p.ws + OFF_MRG); lda = 1024; B = (const u16*)(p.ws + OFF_WO); ldb = 1024; K = 1024; ntiles_n = 8; }
  if (EPI == 2) { A = (const u16*)(p.ws + OFF_H); lda = 1024; B = (const u16*)(p.ws + OFF_W1); ldb = 1024; K = 1024; ntiles_n = 32; }
  if (EPI == 3) { A = (const u16*)(p.ws + OFF_F); lda = 4096; B = (const u16*)(p.ws + OFF_W2); ldb = 4096; K = 4096; ntiles_n = 8; }
  const float* modl = (const float*)(p.ws + OFF_MOD) + (size_t)l * 4 * 6144;
  const int G = gridDim.x;
  const bool swz = (G == 512);
  const int total = swz ? 128 * ((ntiles_n + 3) & ~3) : 128 * ntiles_n;
  for (int item = vb; item < total; item += G) {
    int mt = item & 127, nt = item >> 7;
    if (swz) { const int r = item >> 9, w = vb & 63; mt = (vb >> 6) * 16 + (w & 15); nt = r * 4 + (w >> 4); if (nt >= ntiles_n) continue; }
    const int m0 = mt * 128, n0 = nt * 128;
    f32x4 acc[4][4];
    zero_acc<4>(acc);
    gemm_mainloop<4>(A + (size_t)m0 * lda, lda, B + (size_t)n0 * ldb, ldb, K, acc, smem);
#pragma unroll
    for (int i = 0; i < 4; ++i) {
      const int m = m0 + wm * 64 + i * 16 + fr;
#pragma unroll
      for (int j = 0; j < 4; ++j) {
        const int n = n0 + wn * 64 + j * 16 + fq * 4;
        f32x4 v = acc[i][j];
        if (EPI == 0) {
          u32x2 o; o.x = pack2(v[0], v[1]); o.y = pack2(v[2], v[3]);
          if (n < 2176) *(u32x2*)((u16*)(p.ws + OFF_PABC) + (size_t)m * 2176 + n) = o;
          else *(u32x2*)((u16*)(p.ws + OFF_PD) + (size_t)m * 256 + (n - 2176)) = o;
        } else if (EPI == 1 || EPI == 3) {
          const int b = m >> 12;
          const float* gt = modl + (size_t)b * 6144 + (EPI == 1 ? 2048 : 5120) + n;
          const float* xin = ((EPI == 1 && l == 0) ? p.in[0] : p.out) + (size_t)m * 1024 + n;
          float4 x = *(const float4*)xin;
          float4 gg = *(const float4*)gt;
          float4 o;
          o.x = x.x + gg.x * v[0]; o.y = x.y + gg.y * v[1]; o.z = x.z + gg.z * v[2]; o.w = x.w + gg.w * v[3];
          *(float4*)(p.out + (size_t)m * 1024 + n) = o;
        } else {
          float r0 = fmaxf(v[0], 0.f), r1 = fmaxf(v[1], 0.f), r2 = fmaxf(v[2], 0.f), r3 = fmaxf(v[3], 0.f);
          u32x2 o; o.x = pack2(r0 * r0, r1 * r1); o.y = pack2(r2 * r2, r3 * r3);
          *(u32x2*)((u16*)(p.ws + OFF_F) + (size_t)m * 4096 + n) = o;
        }
      }
    }
  }
}

template <int MODE>
__device__ __forceinline__ void merge_tile(const Params& p, int item, unsigned char* smem_raw) {
  u16* smem = (u16*)smem_raw;
  const int lane = threadIdx.x & 63, wv = threadIdx.x >> 6;
  const int wm = wv >> 1, wn = wv & 1;
  const int fr = lane & 15, fq = lane >> 4;
  const u16* H = (const u16*)(p.ws + OFF_H);
  const u16* WIN = (const u16*)(p.ws + OFF_WIN);
  const int mt = item & 127, nt = item >> 7;
  const int m0 = mt * 128, n0 = nt * 128;
  f32x4 bacc[4][4];
  u32x2 gpk[4][4];
  u16* MRG = (u16*)(p.ws + OFF_MRG);
#pragma unroll 1
  for (int br = (MODE == 0 ? 1 : 0); br < (MODE == 0 ? 4 : 1); ++br) {
    zero_acc<4>(bacc);
    gemm_mainloop<4, true>(H + (size_t)m0 * 1024, 1024, WIN + (size_t)(2432 + br * 1024 + n0) * 1024, 1024, 1024, bacc, smem);
#pragma unroll
    for (int i = 0; i < 4; ++i)
#pragma unroll
      for (int j = 0; j < 4; ++j)
        gpk[i][j] = u32x2{pack2(sigmoidf_(bacc[i][j][0]), sigmoidf_(bacc[i][j][1])), pack2(sigmoidf_(bacc[i][j][2]), sigmoidf_(bacc[i][j][3]))};
    const u16* Ab; const u16* Wb;
    if (br == 0) { Ab = (const u16*)(p.ws + OFF_OG); Wb = (const u16*)(p.ws + OFF_RO); }
    else if (br == 1) { Ab = (const u16*)(p.ws + OFF_UB); Wb = (const u16*)(p.ws + OFF_SO); }
    else if (br == 2) { Ab = (const u16*)(p.ws + OFF_CB); Wb = (const u16*)(p.ws + OFF_CO); }
    else { Ab = (const u16*)(p.ws + OFF_YD); Wb = (const u16*)(p.ws + OFF_GLU); }
    if (MODE == 0 && br == 3) {
      zero_acc<4>(bacc);
      gemm_mainloop<4, true>(Ab + (size_t)m0 * 256, 256, Wb + (size_t)(1024 + n0) * 256, 256, 256, bacc, smem);
#pragma unroll
      for (int i = 0; i < 4; ++i)
#pragma unroll
        for (int j = 0; j < 4; ++j) {
          const float g0 = bflo(gpk[i][j].x) * sigmoidf_(bacc[i][j][0]), g1 = bfhi(gpk[i][j].x) * sigmoidf_(bacc[i][j][1]);
          const float g2 = bflo(gpk[i][j].y) * sigmoidf_(bacc[i][j][2]), g3 = bfhi(gpk[i][j].y) * sigmoidf_(bacc[i][j][3]);
          gpk[i][j] = u32x2{pack2(g0, g1), pack2(g2, g3)};
        }
    }
    zero_acc<4>(bacc);
    gemm_mainloop<4, true>(Ab + (size_t)m0 * 256, 256, Wb + (size_t)n0 * 256, 256, 256, bacc, smem);
#pragma unroll
    for (int i = 0; i < 4; ++i)
#pragma unroll
      for (int j = 0; j < 4; ++j) {
        u32x2* mp = (u32x2*)(MRG + (size_t)(m0 + wm * 64 + i * 16 + fr) * 1024 + n0 + wn * 64 + j * 16 + fq * 4);
        u32x2 cm = u32x2{0u, 0u};
        if (MODE == 1 || br > 1) cm = *mp;
        const float v0 = bflo(cm.x) + bflo(gpk[i][j].x) * bacc[i][j][0];
        const float v1 = bfhi(cm.x) + bfhi(gpk[i][j].x) * bacc[i][j][1];
        const float v2 = bflo(cm.y) + bflo(gpk[i][j].y) * bacc[i][j][2];
        const float v3 = bfhi(cm.y) + bfhi(gpk[i][j].y) * bacc[i][j][3];
        *mp = u32x2{pack2(v0, v1), pack2(v2, v3)};
      }
  }
}

__device__ __forceinline__ float shifted(const u16* __restrict__ P, int tok, int col, float mu) {
  float pv = bf2f(P[(size_t)tok * 2176 + col]);
  float pr = (tok & (SEQ - 1)) ? bf2f(P[(size_t)(tok - 1) * 2176 + col]) : 0.f;
  return pv + (pr - pv) * mu;
}

__device__ __forceinline__ void rwkv_prep_item(const Params& p, int l, int item, unsigned char* smem) {
  const int tid = threadIdx.x;
  float* sl = (float*)smem;
  float* sv = sl + 32 * 128;
  float* svl = sv + 32 * 256;
  const u16* P = (const u16*)(p.ws + OFF_PABC);
  const float* mu = p.in[6] + l * 896;
  const int tok0 = item * 32;
  for (int idx = tid; idx < 32 * 128; idx += NTHR) {
    int t = idx >> 7, ci = idx & 127;
    float v = shifted(P, tok0 + t, 768 + ci, mu[768 + ci]);
    if (ci < 32) v = tanhf_(v);
    else if (ci >= 64) v = sigmoidf_(v);
    sl[idx] = v;
  }
  if (l > 0) {
    float m = mu[512 + tid];
    for (int t = 0; t < 32; ++t) sv[t * 256 + tid] = shifted(P, tok0 + t, 512 + tid, m);
  }
  __syncthreads();
  if (l > 0) {
    const float* v1 = p.in[13];
    int t = tid >> 3, o4 = (tid & 7) * 4;
    float a0 = 0, a1 = 0, a2 = 0, a3 = 0;
    for (int k = 0; k < 256; ++k) {
      float s = sv[t * 256 + k];
      float4 w = *(const float4*)(v1 + k * 32 + o4);
      a0 += s * w.x; a1 += s * w.y; a2 += s * w.z; a3 += s * w.w;
    }
    svl[t * 32 + o4 + 0] = a0; svl[t * 32 + o4 + 1] = a1; svl[t * 32 + o4 + 2] = a2; svl[t * 32 + o4 + 3] = a3;
    __syncthreads();
  }
  const int j = tid;
  const float* w2 = p.in[8] + l * 32 * 256;
  const float* a2w = p.in[10] + l * 32 * 256;
  const float* g2 = p.in[11] + l * 64 * 256;
  const float* v2 = p.in[14];
  const float w0 = p.in[7][l * 256 + j], a0c = p.in[9][l * 256 + j];
  const float v0 = (l > 0) ? p.in[12][j] : 0.f;
  const float kkc = p.in[15][l * 256 + j], kac = p.in[16][l * 256 + j];
  const float mur = mu[j], muk = mu[256 + j], muv = mu[512 + j];
  u16* SR = (u16*)(p.ws + OFF_SR); u16* SK = (u16*)(p.ws + OFF_SK); u16* SV = (u16*)(p.ws + OFF_SV);
  u16* SKK = (u16*)(p.ws + OFF_SKK); u16* SA = (u16*)(p.ws + OFF_SA); float* SW = (float*)(p.ws + OFF_SW);
  u16* G = (u16*)(p.ws + OFF_G); u16* VF = (u16*)(p.ws + OFF_VF);
#pragma unroll 1
  for (int tg = 0; tg < 4; ++tg) {
    float accw[8], acca[8], accg[8], accv[8];
#pragma unroll
    for (int tt = 0; tt < 8; ++tt) { accw[tt] = 0; acca[tt] = 0; accg[tt] = 0; accv[tt] = 0; }
#pragma unroll 1
    for (int k4 = 0; k4 < 8; ++k4) {
      float ww[4], wa[4];
#pragma unroll
      for (int e = 0; e < 4; ++e) { ww[e] = w2[(k4 * 4 + e) * 256 + j]; wa[e] = a2w[(k4 * 4 + e) * 256 + j]; }
#pragma unroll
      for (int tt = 0; tt < 8; ++tt) {
        float4 s = *(const float4*)(sl + (tg * 8 + tt) * 128 + k4 * 4);
        float4 s2 = *(const float4*)(sl + (tg * 8 + tt) * 128 + 32 + k4 * 4);
        accw[tt] += s.x * ww[0] + s.y * ww[1] + s.z * ww[2] + s.w * ww[3];
        acca[tt] += s2.x * wa[0] + s2.y * wa[1] + s2.z * wa[2] + s2.w * wa[3];
      }
    }
#pragma unroll 1
    for (int k4 = 0; k4 < 16; ++k4) {
      float wg[4];
#pragma unroll
      for (int e = 0; e < 4; ++e) wg[e] = g2[(k4 * 4 + e) * 256 + j];
#pragma unroll
      for (int tt = 0; tt < 8; ++tt) {
        float4 s = *(const float4*)(sl + (tg * 8 + tt) * 128 + 64 + k4 * 4);
        accg[tt] += s.x * wg[0] + s.y * wg[1] + s.z * wg[2] + s.w * wg[3];
      }
    }
    if (l > 0) {
#pragma unroll 1
      for (int k4 = 0; k4 < 8; ++k4) {
        float wvv[4];
#pragma unroll
        for (int e = 0; e < 4; ++e) wvv[e] = v2[(k4 * 4 + e) * 256 + j];
#pragma unroll
        for (int tt = 0; tt < 8; ++tt) {
          float4 s = *(const float4*)(svl + (tg * 8 + tt) * 32 + k4 * 4);
          accv[tt] += s.x * wvv[0] + s.y * wvv[1] + s.z * wvv[2] + s.w * wvv[3];
        }
      }
    }
#pragma unroll
    for (int tt = 0; tt < 8; ++tt) {
      const int tok = tok0 + tg * 8 + tt;
      float r = shifted(P, tok, j, mur);
      float k = shifted(P, tok, 256 + j, muk);
      float v = shifted(P, tok, 512 + j, muv);
      float wl = w0 + accw[tt];
      float z = -wl;
      float sp = (z > 15.f) ? z : __logf(1.f + __expf(z));
      float lw = -sp - 0.5f;
      float decay = __expf(-__expf(lw));
      float a = sigmoidf_(a0c + acca[tt]);
      float g = accg[tt];
      const size_t o = (size_t)tok * 256 + j;
      if (l == 0) {
        VF[o] = f2bf(v);
      } else {
        float vf = bf2f(VF[o]);
        v = v + (vf - v) * sigmoidf_(v0 + accv[tt]);
      }
      float kk = k * kkc;
      float ss = wave_sum(kk * kk);
      kk = kk / fmaxf(sqrtf(ss), 1e-12f);
      float km = k * (1.f + (a - 1.f) * kac);
      SR[o] = f2bf(r); SK[o] = f2bf(km); SV[o] = f2bf(v); SKK[o] = f2bf(kk); SA[o] = f2bf(a);
      SW[o] = decay; G[o] = f2bf(g);
    }
  }
  __syncthreads();
}

__device__ __forceinline__ void sg_item(const Params& p, int l, int item, unsigned char* smem) {
  const int tid = threadIdx.x, lane = tid & 63, wv = tid >> 6;
  u16* vsT = (u16*)smem;
  float* smu = (float*)(smem + 16384);
  float* srs = smu + 128;
  const u16* P = (const u16*)(p.ws + OFF_PABC);
  const int g = item & 3, chn = item >> 2;
  const int tok0 = chn * 128;
  {
    const int t = tid >> 1, hf = tid & 1;
    const u16* src = P + (size_t)(tok0 + t) * 2176 + 896 + 256 + hf * 128;
    float sm = 0.f, ss = 0.f;
#pragma unroll 4
    for (int i = 0; i < 16; ++i) {
      u32x4 raw = *(const u32x4*)(src + i * 8);
      float z;
      z = geluf_(bflo(raw.x)); sm += z; ss += z * z;  z = geluf_(bfhi(raw.x)); sm += z; ss += z * z;
      z = geluf_(bflo(raw.y)); sm += z; ss += z * z;  z = geluf_(bfhi(raw.y)); sm += z; ss += z * z;
      z = geluf_(bflo(raw.z)); sm += z; ss += z * z;  z = geluf_(bfhi(raw.z)); sm += z; ss += z * z;
      z = geluf_(bflo(raw.w)); sm += z; ss += z * z;  z = geluf_(bfhi(raw.w)); sm += z; ss += z * z;
    }
    sm += __shfl_xor(sm, 1, 64); ss += __shfl_xor(ss, 1, 64);
    const float mean = sm * (1.f / 256.f);
    const float var = fmaxf(ss * (1.f / 256.f) - mean * mean, 0.f);
    if (hf == 0) { smu[t] = mean; srs[t] = rsqrtf(var + 1e-5f); }
  }
  __syncthreads();
  {
    const int c = tid & 63, tb = tid >> 6;
    const float lw = p.in[21][l * 256 + g * 64 + c], lb = p.in[22][l * 256 + g * 64 + c];
#pragma unroll
    for (int j = 0; j < 4; ++j) {
      u16 raw[8];
#pragma unroll
      for (int e = 0; e < 8; ++e) raw[e] = P[(size_t)(tok0 + tb * 32 + j * 8 + e) * 2176 + 896 + 256 + g * 64 + c];
      float vv[8];
#pragma unroll
      for (int e = 0; e < 8; ++e) {
        const int t = tb * 32 + j * 8 + e;
        vv[e] = (geluf_(bf2f(raw[e])) - smu[t]) * srs[t] * lw + lb;
      }
      const int phys = (tb * 4 + j) ^ (c & 15);
      *(u32x4*)(vsT + c * 128 + phys * 8) = u32x4{pack2(vv[0], vv[1]), pack2(vv[2], vv[3]), pack2(vv[4], vv[5]), pack2(vv[6], vv[7])};
    }
  }
  __syncthreads();
  {
    const int fr = lane & 15, fq = lane >> 4;
    const u16* Wm = (const u16*)(p.ws + OFF_SGW) + (size_t)g * 128 * 128;
    f32x4 acc[2][4];
#pragma unroll
    for (int i = 0; i < 2; ++i)
#pragma unroll
      for (int j = 0; j < 4; ++j) acc[i][j] = f32x4{0.f, 0.f, 0.f, 0.f};
    for (int ks = 0; ks <= wv; ++ks) {
      bf16x8 fa[2], fb[4];
#pragma unroll
      for (int i = 0; i < 2; ++i) fa[i] = *(const bf16x8*)(Wm + (size_t)(32 * wv + 16 * i + fr) * 128 + ks * 32 + fq * 8);
#pragma unroll
      for (int j = 0; j < 4; ++j) fb[j] = *(const bf16x8*)(vsT + (j * 16 + fr) * 128 + (((ks * 4 + fq) ^ fr) << 3));
#pragma unroll
      for (int i = 0; i < 2; ++i)
#pragma unroll
        for (int j = 0; j < 4; ++j) acc[i][j] = __builtin_amdgcn_mfma_f32_16x16x32_bf16(fb[j], fa[i], acc[i][j], 0, 0, 0);
    }
    const float* bs = p.in[24] + ((size_t)l * 4 + g) * 128;
    u16* UB = (u16*)(p.ws + OFF_UB);
#pragma unroll
    for (int i = 0; i < 2; ++i) {
      const int t = 32 * wv + 16 * i + fr;
      const float bsv = bs[t];
#pragma unroll
      for (int j = 0; j < 4; ++j) {
        const int cc = j * 16 + fq * 4;
        u32x2 ur = *(const u32x2*)(P + (size_t)(tok0 + t) * 2176 + 896 + g * 64 + cc);
        float o0 = geluf_(bflo(ur.x)) * (acc[i][j][0] + bsv), o1 = geluf_(bfhi(ur.x)) * (acc[i][j][1] + bsv);
        float o2 = geluf_(bflo(ur.y)) * (acc[i][j][2] + bsv), o3 = geluf_(bfhi(ur.y)) * (acc[i][j][3] + bsv);
        *(u32x2*)(UB + (size_t)(tok0 + t) * 256 + g * 64 + cc) = u32x2{pack2(o0, o1), pack2(o2, o3)};
      }
    }
  }
  __syncthreads();
}

__device__ __forceinline__ void conv_item(const Params& p, int l, int item) {
  const int j = threadIdx.x;
  const u16* P = (const u16*)(p.ws + OFF_PABC);
  u16* CB = (u16*)(p.ws + OFF_CB);
  const float c0 = p.in[26][(l * 3 + 0) * 256 + j], c1 = p.in[26][(l * 3 + 1) * 256 + j], c2 = p.in[26][(l * 3 + 2) * 256 + j];
  const int tok0 = item * 8;
  u16 rc[10], rx[10], rb[8];
  const bool first = (tok0 & (SEQ - 1)) == 0;
#pragma unroll
  for (int t = 0; t < 10; ++t) {
    const int tok = (first && t < 2) ? tok0 : tok0 + t - 2;
    const u16* q = P + (size_t)tok * 2176 + 1408;
    rc[t] = q[256 + j]; rx[t] = q[512 + j];
    if (t >= 2) rb[t - 2] = q[j];
  }
  float z[10];
#pragma unroll
  for (int t = 0; t < 10; ++t) z[t] = bf2f(rc[t]) * bf2f(rx[t]);
  if (first) { z[0] = 0.f; z[1] = 0.f; }
#pragma unroll
  for (int t = 0; t < 8; ++t) {
    float y = c0 * z[t] + c1 * z[t + 1] + c2 * z[t + 2];
    CB[(size_t)(tok0 + t) * 256 + j] = f2bf(bf2f(rb[t]) * y);
  }
}

__device__ __forceinline__ void s5_load_u(const u16* us, int t, int wv, float (&u)[16]) {
  const u32x4* q = (const u32x4*)(us + t * 64 + wv * 16);
  u32x4 a = q[0], b = q[1];
  u[0] = bflo(a.x); u[1] = bfhi(a.x); u[2] = bflo(a.y); u[3] = bfhi(a.y);
  u[4] = bflo(a.z); u[5] = bfhi(a.z); u[6] = bflo(a.w); u[7] = bfhi(a.w);
  u[8] = bflo(b.x); u[9] = bfhi(b.x); u[10] = bflo(b.y); u[11] = bfhi(b.y);
  u[12] = bflo(b.z); u[13] = bfhi(b.z); u[14] = bflo(b.w); u[15] = bfhi(b.w);
}
__device__ __forceinline__ void s5_stage_u(const u16* __restrict__ PD, int tok0, int gq, u16* us) {
#pragma unroll
  for (int i = 0; i < 2; ++i) {
    const int ch = threadIdx.x + 256 * i;
    const int t = ch >> 3, part = ch & 7;
    *(u32x4*)(us + t * 64 + part * 8) = *(const u32x4*)(PD + (size_t)(tok0 + t) * 256 + gq * 64 + part * 8);
  }
}

__device__ __forceinline__ void s5a_item(const Params& p, int l, int item, unsigned char* smem) {
  const int lane = threadIdx.x & 63, wv = threadIdx.x >> 6;
  const int gq = item & 3, bc = item >> 2;
  const int g = gq * 4 + wv;
  const int tok0 = bc * 64;
  const u16* PD = (const u16*)(p.ws + OFF_PD);
  const float* ab = (const float*)(p.ws + OFF_S5AB) + ((size_t)(l * 16 + g) * 64 + lane) * 2;
  const float* bb = (const float*)(p.ws + OFF_S5BB) + ((size_t)(l * 16 + g) * 64 + lane) * 32;
  float bbr[16], bbi[16];
#pragma unroll
  for (int c = 0; c < 16; ++c) { bbr[c] = bb[c]; bbi[c] = bb[16 + c]; }
  const float abr = ab[0], abi = ab[1];
  float xr = 0.f, xi = 0.f;
  u16* us = (u16*)smem;
  s5_stage_u(PD, tok0, gq, us);
  __syncthreads();
#pragma unroll 4
  for (int t = 0; t < 64; ++t) {
    float u[16];
    s5_load_u(us, t, wv, u);
    float bur = 0.f, bui = 0.f;
#pragma unroll
    for (int c = 0; c < 16; ++c) { bur += bbr[c] * u[c]; bui += bbi[c] * u[c]; }
    float nr = abr * xr - abi * xi + bur;
    float ni = abr * xi + abi * xr + bui;
    xr = nr; xi = ni;
  }
  float2* E = (float2*)(p.ws + OFF_S5E);
  E[((size_t)bc * 16 + g) * 64 + lane] = make_float2(xr, xi);
  __syncthreads();
}

__device__ __forceinline__ void s5b_item(const Params& p, int l, int item, unsigned char* smem) {
  const int lane = threadIdx.x & 63, wv = threadIdx.x >> 6;
  const int gq = item & 3, bc = item >> 2;
  const int b = bc >> 6, ch = bc & 63;
  const int g = gq * 4 + wv;
  const int tok0 = bc * 64;
  u16* us = (u16*)(smem + 65536);
  s5_stage_u((const u16*)(p.ws + OFF_PD), tok0, gq, us);
  float* base = (float*)smem + wv * 4096;
  float* csr = base, *csi = base + 1024, *xsr = base + 2048, *xsi = base + 3072;
  const u16* PD = (const u16*)(p.ws + OFF_PD);
  const float* ab = (const float*)(p.ws + OFF_S5AB) + ((size_t)(l * 16 + g) * 64 + lane) * 2;
  const float* bb = (const float*)(p.ws + OFF_S5BB) + ((size_t)(l * 16 + g) * 64 + lane) * 32;
  const float* cre = p.in[32] + ((size_t)(l * 16 + g) * 16) * 64;
  const float* cim = p.in[33] + ((size_t)(l * 16 + g) * 16) * 64;
  for (int c = 0; c < 16; ++c) {
    csr[(lane >> 2) * 64 + c * 4 + (lane & 3)] = cre[c * 64 + lane];
    csi[(lane >> 2) * 64 + c * 4 + (lane & 3)] = cim[c * 64 + lane];
  }
  float bbr[16], bbi[16];
#pragma unroll
  for (int c = 0; c < 16; ++c) { bbr[c] = bb[c]; bbi[c] = bb[16 + c]; }
  const float abr = ab[0], abi = ab[1];
  float pr = abr, pi = abi;
#pragma unroll
  for (int s = 0; s < 6; ++s) { float nr = pr * pr - pi * pi, ni = 2.f * pr * pi; pr = nr; pi = ni; }
  float xr = 0.f, xi = 0.f;
  const float2* E = (const float2*)(p.ws + OFF_S5E);
  for (int c = 0; c < ch; ++c) {
    float2 e = E[((size_t)(b * 64 + c) * 16 + g) * 64 + lane];
    float nr = pr * xr - pi * xi + e.x;
    float ni = pr * xi + pi * xr + e.y;
    xr = nr; xi = ni;
  }
  const int tt = lane & 15, cq = lane >> 4;
  const float* dvec = p.in[34] + l * 256 + g * 16 + cq * 4;
  const float d0 = dvec[0], d1 = dvec[1], d2 = dvec[2], d3 = dvec[3];
  u16* YD = (u16*)(p.ws + OFF_YD);
  const int n4w = lane >> 2, e4 = lane & 3;
  __syncthreads();
#pragma unroll 1
  for (int sc = 0; sc < 4; ++sc) {
    for (int t = 0; t < 16; ++t) {
      float u[16];
      s5_load_u(us, sc * 16 + t, wv, u);
      float bur = 0.f, bui = 0.f;
#pragma unroll
      for (int c = 0; c < 16; ++c) { bur += bbr[c] * u[c]; bui += bbi[c] * u[c]; }
      float nr = abr * xr - abi * xi + bur;
      float ni = abr * xi + abi * xr + bui;
      xr = nr; xi = ni;
      int a = n4w * 64 + ((t ^ (n4w & 7)) << 2) + e4;
      xsr[a] = xr; xsi[a] = xi;
    }
    __syncthreads();
    float acc0 = 0.f, acc1 = 0.f, acc2 = 0.f, acc3 = 0.f;
#pragma unroll 2
    for (int n4 = 0; n4 < 16; ++n4) {
      int xa = n4 * 64 + ((tt ^ (n4 & 7)) << 2);
      float4 xr4 = *(const float4*)(xsr + xa);
      float4 xi4 = *(const float4*)(xsi + xa);
      const float* cr = csr + n4 * 64 + cq * 16;
      const float* ci = csi + n4 * 64 + cq * 16;
      float4 r0 = *(const float4*)(cr), r1 = *(const float4*)(cr + 4), r2 = *(const float4*)(cr + 8), r3 = *(const float4*)(cr + 12);
      float4 i0 = *(const float4*)(ci), i1 = *(const float4*)(ci + 4), i2 = *(const float4*)(ci + 8), i3 = *(const float4*)(ci + 12);
      acc0 += r0.x * xr4.x + r0.y * xr4.y + r0.z * xr4.z + r0.w * xr4.w - (i0.x * xi4.x + i0.y * xi4.y + i0.z * xi4.z + i0.w * xi4.w);
      acc1 += r1.x * xr4.x + r1.y * xr4.y + r1.z * xr4.z + r1.w * xr4.w - (i1.x * xi4.x + i1.y * xi4.y + i1.z * xi4.z + i1.w * xi4.w);
      acc2 += r2.x * xr4.x + r2.y * xr4.y + r2.z * xr4.z + r2.w * xr4.w - (i2.x * xi4.x + i2.y * xi4.y + i2.z * xi4.z + i2.w * xi4.w);
      acc3 += r3.x * xr4.x + r3.y * xr4.y + r3.z * xr4.z + r3.w * xr4.w - (i3.x * xi4.x + i3.y * xi4.y + i3.z * xi4.z + i3.w * xi4.w);
    }
    {
      const int tok = tok0 + sc * 16 + tt;
      u32x2 ur = *(const u32x2*)(us + (sc * 16 + tt) * 64 + wv * 16 + cq * 4);
      float y0 = acc0 + d0 * bflo(ur.x), y1 = acc1 + d1 * bfhi(ur.x), y2 = acc2 + d2 * bflo(ur.y), y3 = acc3 + d3 * bfhi(ur.y);
      u32x2 o; o.x = pack2(geluf_(y0), geluf_(y1)); o.y = pack2(geluf_(y2), geluf_(y3));
      *(u32x2*)(YD + (size_t)tok * 256 + g * 16 + cq * 4) = o;
    }
    __syncthreads();
  }
}

__device__ __forceinline__ void lds_barrier() {
  asm volatile("s_waitcnt lgkmcnt(0)" ::: "memory");
  __builtin_amdgcn_s_barrier();
  asm volatile("" ::: "memory");
}
using f32x2 = __attribute__((ext_vector_type(2))) float;
__device__ __forceinline__ void scan_item(const Params& p, int item, unsigned char* smem) {
  const int tid = threadIdx.x, lane = tid & 63, wv = tid >> 6;
  const int b = item >> 4, h = (item >> 2) & 3, q = item & 3;
  const int rl = lane >> 4, cl = lane & 15;
  const int rloc = wv * 4 + rl;
  const size_t tokb = (size_t)b * SEQ;
  const int chan0 = h * 64;
  const u16* SR = (const u16*)(p.ws + OFF_SR); const u16* SK = (const u16*)(p.ws + OFF_SK);
  const u16* SV = (const u16*)(p.ws + OFF_SV); const u16* SKK = (const u16*)(p.ws + OFF_SKK);
  const u16* SA = (const u16*)(p.ws + OFF_SA); const float* SW = (const float*)(p.ws + OFF_SW);
  float* O = (float*)(p.ws + OFF_O);
  constexpr int BUFF = 5376;
  float* lbase = (float*)smem;
  float* pp = lbase + 2 * BUFF + wv * 1024;
  const int st = tid >> 4, cg4 = tid & 15;
  struct Stg { u32x2 r, k, kk, a; f32x4 w; u16 v; };
  auto gload = [&](Stg& g, int c) {
    const size_t o = (tokb + (size_t)c * 16 + st) * 256 + chan0;
    g.r = *(const u32x2*)(SR + o + cg4 * 4); g.k = *(const u32x2*)(SK + o + cg4 * 4);
    g.kk = *(const u32x2*)(SKK + o + cg4 * 4); g.a = *(const u32x2*)(SA + o + cg4 * 4);
    g.w = *(const f32x4*)(SW + o + cg4 * 4);
    g.v = SV[o + q * 16 + cg4];
  };
  auto lwrite = [&](const Stg& g, int buf) {
    float* bp = lbase + buf * BUFF;
    const int o = st * 64 + cg4 * 4;
    f32x4 kk = {bflo(g.kk.x), bfhi(g.kk.x), bflo(g.kk.y), bfhi(g.kk.y)};
    f32x4 a = {bflo(g.a.x), bfhi(g.a.x), bflo(g.a.y), bfhi(g.a.y)};
    f32x4 k = {bflo(g.k.x), bfhi(g.k.x), bflo(g.k.y), bfhi(g.k.y)};
    f32x4 r = {bflo(g.r.x), bfhi(g.r.x), bflo(g.r.y), bfhi(g.r.y)};
    *(f32x4*)(bp + o) = kk;
    *(f32x4*)(bp + 1024 + o) = kk * a;
    *(f32x4*)(bp + 2048 + o) = k;
    *(f32x4*)(bp + 3072 + o) = g.w;
    *(f32x4*)(bp + 4096 + o) = r;
    bp[5120 + st * 16 + cg4] = bf2f(g.v);
  };
  constexpr int NCH = SEQ / 16;
  Stg R0, R1, R2, R3;
  gload(R0, 0); gload(R1, 1); gload(R2, 2); gload(R3, 3);
  __syncthreads();
  lwrite(R0, 0);
  __syncthreads();
  __builtin_amdgcn_s_setprio(3);
  float S0 = 0.f, S1 = 0.f, S2 = 0.f, S3 = 0.f;
  const int rrow = lane & 3, rstep = lane >> 2;
  struct Ops { f32x4 kk, bb, k4, w4, r4; float v; };
  auto chunk = [&](int c) {
    const float* bp = lbase + (c & 1) * BUFF;
    auto ldops = [&](Ops& o, int s) {
      o.kk = *(const f32x4*)(bp + s * 64 + cl * 4);
      o.bb = *(const f32x4*)(bp + 1024 + s * 64 + cl * 4);
      o.k4 = *(const f32x4*)(bp + 2048 + s * 64 + cl * 4);
      o.w4 = *(const f32x4*)(bp + 3072 + s * 64 + cl * 4);
      o.r4 = *(const f32x4*)(bp + 4096 + s * 64 + cl * 4);
      o.v = bp[5120 + s * 16 + rloc];
    };
    auto step = [&](const Ops& o, int s) {
      const float sa = row_sum16(__builtin_fmaf(S3, o.kk.w, __builtin_fmaf(S2, o.kk.z, __builtin_fmaf(S1, o.kk.y, S0 * o.kk.x))));
      S0 = __builtin_fmaf(S0, o.w4.x, __builtin_fmaf(o.v, o.k4.x, -(sa * o.bb.x)));
      S1 = __builtin_fmaf(S1, o.w4.y, __builtin_fmaf(o.v, o.k4.y, -(sa * o.bb.y)));
      S2 = __builtin_fmaf(S2, o.w4.z, __builtin_fmaf(o.v, o.k4.z, -(sa * o.bb.z)));
      S3 = __builtin_fmaf(S3, o.w4.w, __builtin_fmaf(o.v, o.k4.w, -(sa * o.bb.w)));
      pp[(s * 4 + rl) * 16 + cl] = __builtin_fmaf(S3, o.r4.w, __builtin_fmaf(S2, o.r4.z, __builtin_fmaf(S1, o.r4.y, S0 * o.r4.x)));
    };
    Ops a0, a1, b0, b1;
    ldops(a0, 0); ldops(a1, 1);
#pragma unroll
    for (int j = 0; j < 4; ++j) {
      ldops(b0, 4 * j + 2); ldops(b1, 4 * j + 3);
      __builtin_amdgcn_sched_barrier(0);
      step(a0, 4 * j); step(a1, 4 * j + 1);
      __builtin_amdgcn_sched_barrier(0);
      if (j < 3) { ldops(a0, 4 * j + 4); ldops(a1, 4 * j + 5); }
      __builtin_amdgcn_sched_barrier(0);
      step(b0, 4 * j + 2); step(b1, 4 * j + 3);
      __builtin_amdgcn_sched_barrier(0);
    }
    asm volatile("" ::: "memory");
    {
      const float* q0 = pp + (rstep * 4 + rrow) * 16;
      f32x4 a0 = *(const f32x4*)(q0), a1 = *(const f32x4*)(q0 + 4), a2 = *(const f32x4*)(q0 + 8), a3 = *(const f32x4*)(q0 + 12);
      f32x4 sm4 = (a0 + a1) + (a2 + a3);
      O[(tokb + (size_t)c * 16 + rstep) * 256 + chan0 + q * 16 + wv * 4 + rrow] = (sm4.x + sm4.y) + (sm4.z + sm4.w);
    }
    asm volatile("" ::: "memory");
  };
#pragma unroll 1
  for (int g = 0; g < NCH / 4; ++g) {
    const int c0 = g * 4;
    if (c0 + 4 < NCH) gload(R0, c0 + 4);
    chunk(c0);
    lwrite(R1, (c0 + 1) & 1);
    lds_barrier();
    if (c0 + 5 < NCH) gload(R1, c0 + 5);
    chunk(c0 + 1);
    lwrite(R2, (c0 + 2) & 1);
    lds_barrier();
    if (c0 + 6 < NCH) gload(R2, c0 + 6);
    chunk(c0 + 2);
    lwrite(R3, (c0 + 3) & 1);
    lds_barrier();
    if (c0 + 7 < NCH) gload(R3, c0 + 7);
    chunk(c0 + 3);
    if (c0 + 4 < NCH) lwrite(R0, (c0 + 4) & 1);
    lds_barrier();
  }
  __builtin_amdgcn_s_setprio(0);
}

__device__ __forceinline__ void rwkv_post_item(const Params& p, int l, int item) {
  const int j = threadIdx.x;
  const float* O = (const float*)(p.ws + OFF_O);
  const u16* SR = (const u16*)(p.ws + OFF_SR); const u16* SK = (const u16*)(p.ws + OFF_SK);
  const u16* SV = (const u16*)(p.ws + OFF_SV); const u16* G = (const u16*)(p.ws + OFF_G);
  u16* OG = (u16*)(p.ws + OFF_OG);
  const float lw = p.in[18][l * 256 + j], lb = p.in[19][l * 256 + j], rk = p.in[17][l * 256 + j];
  const int tok0 = item * 8;
  float ov[8]; u16 rr[8], rkk[8], rv[8], rg[8];
#pragma unroll
  for (int t = 0; t < 8; ++t) {
    const size_t o = (size_t)(tok0 + t) * 256 + j;
    ov[t] = O[o]; rr[t] = SR[o]; rkk[t] = SK[o]; rv[t] = SV[o]; rg[t] = G[o];
  }
#pragma unroll
  for (int t = 0; t < 8; ++t) {
    const size_t o = (size_t)(tok0 + t) * 256 + j;
    float mean = wave_sum(ov[t]) * (1.f / 64.f);
    float d = ov[t] - mean;
    float var = wave_sum(d * d) * (1.f / 64.f);
    float on = d * rsqrtf(var + 64e-5f) * lw + lb;
    float bonus = wave_sum(bf2f(rr[t]) * bf2f(rkk[t]) * rk);
    OG[o] = f2bf((on + bonus * bf2f(rv[t])) * bf2f(rg[t]));
  }
}

#define XB_TMO      128
#define XB_XCNT(j)  (256  + 64 * (j))
#define XB_XSUB(j)  (1280 + 64 * (j))
#define XB_XGEN(j)  (2304 + 64 * (j))
#define XB_TOP      3328
#define XB_TOPGEN   3392
#define XCD_BAR_WORDS 3456
#define XB_SPIN_CAP (1u << 22)
#define LAS __attribute__((address_space(3)))
__device__ __forceinline__ unsigned xb_ld(unsigned* p) { return __hip_atomic_load(p, __ATOMIC_RELAXED, __HIP_MEMORY_SCOPE_AGENT); }
__device__ __forceinline__ unsigned xb_add(unsigned* p, unsigned v) { return __hip_atomic_fetch_add(p, v, __ATOMIC_RELAXED, __HIP_MEMORY_SCOPE_AGENT); }
__device__ __forceinline__ unsigned xb_xcc_id() { return (unsigned)__builtin_amdgcn_s_getreg((3 << 11) | 20) & 0xFu; }
#define XB_SPIN(cond, bar) do { unsigned _sp = 0; while (cond) { __builtin_amdgcn_s_sleep(1); \
    if ((++_sp & 255u) == 0u) { if (xb_ld(&(bar)[XB_TMO])) break; if (_sp > XB_SPIN_CAP) { atomicAdd(&(bar)[XB_TMO], 1u); break; } } } } while (0)
struct XcdBarrier { unsigned* bar; unsigned x; volatile LAS unsigned* st; };
__device__ __forceinline__ XcdBarrier xcd_barrier_post(unsigned* bar, volatile LAS unsigned* st) {
  XcdBarrier b; b.bar = bar; b.x = xb_xcc_id(); b.st = st;
  if (threadIdx.x == 0) st[2] = xb_add(&bar[XB_XCNT(b.x)], 1u);
  return b;
}
__device__ __forceinline__ void xcd_barrier_complete(unsigned* bar, unsigned x, unsigned& nloc, unsigned& nx) {
  const unsigned G = gridDim.x * gridDim.y * gridDim.z;
  unsigned sum, cnt, mine, sp = 0u;
  for (;;) {
    sum = 0u; cnt = 0u; mine = 0u;
#pragma unroll
    for (unsigned j = 0; j < 16; ++j) { const unsigned c = xb_ld(&bar[XB_XCNT(j)]); sum += c; cnt += (c > 0u) ? 1u : 0u; mine = (j == x) ? c : mine; }
    if (sum == G) break;
    __builtin_amdgcn_s_sleep(1);
    if ((++sp & 255u) == 0u) { if (xb_ld(&bar[XB_TMO])) break; if (sp > XB_SPIN_CAP) { atomicAdd(&bar[XB_TMO], 1u); break; } }
  }
  nloc = mine > 0u ? mine : 1u; nx = cnt > 0u ? cnt : 1u;
}
__device__ __forceinline__ void xcd_barrier(const XcdBarrier& b) {
  asm volatile("s_waitcnt vmcnt(0)" ::: "memory");
  __syncthreads();
  if (threadIdx.x == 0) {
    unsigned* bar = b.bar;
    __builtin_amdgcn_s_waitcnt(0);
    unsigned nloc = b.st[0], nx = b.st[1];
    if (nloc == 0u) { xcd_barrier_complete(bar, b.x, nloc, nx); b.st[0] = nloc; b.st[1] = nx; }
    const unsigned old = xb_add(&bar[XB_XSUB(b.x)], 1u);
    const unsigned gen = old / nloc;
    if (old + 1u == (gen + 1u) * nloc) {
      __builtin_amdgcn_fence(__ATOMIC_RELEASE, "agent");
      asm volatile("s_waitcnt vmcnt(0)" ::: "memory");
      const unsigned og = xb_add(&bar[XB_TOP], 1u);
      const unsigned tg = og / nx;
      if (og + 1u == (tg + 1u) * nx) xb_add(&bar[XB_TOPGEN], 1u);
      else XB_SPIN(xb_ld(&bar[XB_TOPGEN]) == tg, bar);
      __builtin_amdgcn_fence(__ATOMIC_ACQUIRE, "agent");
      xb_add(&bar[XB_XGEN(b.x)], 1u);
      asm volatile("s_waitcnt vmcnt(0)" ::: "memory");
    } else {
      XB_SPIN(xb_ld(&bar[XB_XGEN(b.x)]) == gen, bar);
      __builtin_amdgcn_fence(__ATOMIC_ACQUIRE, "agent");
      asm volatile("s_waitcnt vmcnt(0)" ::: "memory");
    }
  }
  __syncthreads();
}

__device__ __forceinline__ int xcd_virtual_id(const XcdBarrier& b) {
  if (threadIdx.x == 0) {
    unsigned base = 0u;
#pragma unroll
    for (unsigned j = 0; j < 16; ++j) { const unsigned c = xb_ld(&b.bar[XB_XCNT(j)]); base += (j < b.x) ? c : 0u; }
    b.st[3] = base + b.st[2];
  }
  __syncthreads();
  const int vb = __builtin_amdgcn_readfirstlane((int)b.st[3]);
  __syncthreads();
  return vb;
}

__device__ __forceinline__ void sub_barrier(unsigned* cnt, unsigned target) {
  asm volatile("s_waitcnt vmcnt(0)" ::: "memory");
  __syncthreads();
  if (threadIdx.x == 0) {
    __builtin_amdgcn_fence(__ATOMIC_RELEASE, "agent");
    asm volatile("s_waitcnt vmcnt(0)" ::: "memory");
    xb_add(cnt, 1u);
    unsigned sp = 0;
    while (xb_ld(cnt) < target) { __builtin_amdgcn_s_sleep(2); if (++sp > (1u << 24)) break; }
    __builtin_amdgcn_fence(__ATOMIC_ACQUIRE, "agent");
    asm volatile("s_waitcnt vmcnt(0)" ::: "memory");
  }
  __syncthreads();
}

#define N_PHASES 22
#ifndef PROBE_CONV_REPS
#define PROBE_CONV_REPS 1
#endif
#ifndef PROBE_PREP_REPS
#define PROBE_PREP_REPS 1
#endif
#ifndef PROBE_POST_REPS
#define PROBE_POST_REPS 1
#endif
#ifndef PROBE_SCAN_REPS
#define PROBE_SCAN_REPS 1
#endif
#ifndef PROBE_FFN1_REPS
#define PROBE_FFN1_REPS 1
#endif
#ifndef PH_MASK
#define PH_MASK 0xFFFFF
#endif
#define PHON(s) (PH_MASK & (1 << (s)))
#define PHASE_BEGIN(k) if (ph_hi > (k)) { if ((k) > 1) xcd_barrier(xb);
#define PHASE_END }

template <int L>
__device__ __forceinline__ void run_layer(const Params& p, int vb, int ph_hi, unsigned char* smem, const XcdBarrier& xb) {
  constexpr int l = L;
  constexpr int base = 1 + 10 * L;
  const float* modl = (const float*)(p.ws + OFF_MOD) + (size_t)l * 4 * 6144;
  PHASE_BEGIN(base + 0)
    for (int rep = 0; rep < PROBE_CONV_REPS; ++rep) {
      if (rep) xcd_barrier(xb);
      phase_convert(p, l, smem);
      phase_norm(l == 0 ? p.in[0] : p.out, p.in[4] + l * 1024, modl, 0, 1024, (u16*)(p.ws + OFF_H));
    }
  PHASE_END
  PHASE_BEGIN(base + 1)
    phase_gemm<0>(p, l, vb, smem);
  PHASE_END
  PHASE_BEGIN(base + 2)
    for (int rep = 0; rep < PROBE_PREP_REPS; ++rep) {
      if (rep) xcd_barrier(xb);
      for (int item = blockIdx.x; item < 512; item += gridDim.x) rwkv_prep_item(p, l, item, smem);
    }
  PHASE_END
  PHASE_BEGIN(base + 3)
    if ((int)blockIdx.x < 64) scan_item(p, blockIdx.x, smem);
    else {
      const int nb = gridDim.x - 64, bi = blockIdx.x - 64;
      for (int item = bi; item < 512; item += nb) sg_item(p, l, item, smem);
      for (int item = (bi + 64) % nb; item < 1024; item += nb) s5a_item(p, l, item, smem);
      for (int item = bi; item < 2048; item += nb) conv_item(p, l, item);
      sub_barrier((unsigned*)(p.ws + OFF_BAR) + 3520 + 64 * (2 * l), gridDim.x - 64);
      for (int item = blockIdx.x - 64; item < 1024; item += gridDim.x - 64) s5b_item(p, l, item, smem);
      sub_barrier((unsigned*)(p.ws + OFF_BAR) + 3520 + 64 * (2 * l + 1), gridDim.x - 64);
      for (int item = blockIdx.x - 64; item < 1024; item += gridDim.x - 64) merge_tile<0>(p, item, smem);
    }
  PHASE_END
  PHASE_BEGIN(base + 4)
    for (int rep = 0; rep < PROBE_POST_REPS; ++rep) { if (rep) xcd_barrier(xb); for (int item = blockIdx.x; item < 2048; item += gridDim.x) rwkv_post_item(p, l, item); }
  PHASE_END
  PHASE_BEGIN(base + 5)
    for (int item = vb; item < 1024; item += gridDim.x) {
      int it2 = item;
      if (gridDim.x == 512) { const int r = item >> 9, w = vb & 63; it2 = ((r * 4 + (w >> 4)) << 7) | ((vb >> 6) * 16 + (w & 15)); }
      merge_tile<1>(p, it2, smem);
    }
  PHASE_END
  PHASE_BEGIN(base + 6)
    phase_gemm_big<1>(p, l, vb, smem);
  PHASE_END
  PHASE_BEGIN(base + 7)
    if (PHON(7)) phase_norm(p.out, p.in[38] + l * 1024, modl, 3072, 4096, (u16*)(p.ws + OFF_H));
  PHASE_END
  PHASE_BEGIN(base + 8)
    for (int rep = 0; rep < PROBE_FFN1_REPS; ++rep) { if (rep) xcd_barrier(xb); phase_gemm_big<2>(p, l, vb, smem); }
  PHASE_END
  PHASE_BEGIN(base + 9)
    phase_gemm_big<3>(p, l, vb, smem);
  PHASE_END
}

__global__ void __launch_bounds__(NTHR, 2) mega_fwd(Params p, int ph_lo, int ph_hi) {
  __shared__ __attribute__((aligned(16))) unsigned char smem[73728 + 16];
  cg::grid_group grid = cg::this_grid();
  if (ph_hi < 0) grid.sync();
  volatile LAS unsigned* st = (volatile LAS unsigned*)(smem + 73728);
  if (threadIdx.x == 0) { st[0] = 0u; st[1] = 0u; st[2] = 0u; st[3] = 0u; }
  __syncthreads();
  const XcdBarrier xb = xcd_barrier_post((unsigned*)(p.ws + OFF_BAR), st);
  if (ph_hi > 0) phase_mod(p, smem);
  xcd_barrier(xb);
  const int vb = xcd_virtual_id(xb);
  run_layer<0>(p, vb, ph_hi, smem, xb);
  run_layer<1>(p, vb, ph_hi, smem, xb);
  PHASE_BEGIN(21)
    if (PHON(11)) phase_final(p.out, p.in[41]);
  PHASE_END
}

extern "C" void kernel_launch(void* const* d_in, const int* in_sizes, int n_in, void* d_out, int out_size, void* d_ws,
                              size_t ws_size, hipStream_t stream) {
  static int grid_blocks = 0;
  if (!grid_blocks) {
    int dev = 0, cus = 0, per_cu = 0;
    hipGetDevice(&dev);
    hipDeviceGetAttribute(&cus, hipDeviceAttributeMultiprocessorCount, dev);
    hipOccupancyMaxActiveBlocksPerMultiprocessor(&per_cu, mega_fwd, NTHR, 0);
    if (per_cu > 2) per_cu = 2;
    if (per_cu < 1) per_cu = 1;
    grid_blocks = cus * per_cu;
    if (ws_size < WS_END) fprintf(stderr, "workspace too small: %zu < %zu\n", ws_size, (size_t)WS_END);
  }
  Params p{};
  for (int i = 0; i < 42; ++i) p.in[i] = (const float*)d_in[i];
  p.out = (float*)d_out;
  p.ws = (unsigned char*)d_ws;
  hipMemsetAsync((unsigned char*)d_ws + OFF_BAR, 0, 16384, stream);
  int lo = 0, hi = N_PHASES;
  void* args[] = {&p, &lo, &hi};
  hipError_t e = hipLaunchCooperativeKernel((void*)mega_fwd, dim3(grid_blocks), dim3(NTHR), args, 0, stream);
  if (e != hipSuccess) fprintf(stderr, "cooperative launch failed: %s (grid %d)\n", hipGetErrorString(e), grid_blocks);
}
```

```cpp
#include <hip/hip_runtime.h>
#include <hip/hip_cooperative_groups.h>
#include <cstdio>
namespace cg = cooperative_groups;

typedef unsigned short u16;
using bf16x8 = __attribute__((ext_vector_type(8))) short;
using f32x4 = __attribute__((ext_vector_type(4))) float;
using u32x4 = __attribute__((ext_vector_type(4))) unsigned int;
using u32x2 = __attribute__((ext_vector_type(2))) unsigned int;

#define T_TOK 16384
#define SEQ 4096
#define DM 1024
#define NTHR 256
#define TIDX ((int)(threadIdx.x & 255))
#define SUBB ((int)(threadIdx.x >> 8))
#define VBLK ((int)(blockIdx.x * 2 + (threadIdx.x >> 8)))
#define VGRID ((int)(gridDim.x * 2))

static constexpr size_t SZ_WIN = (size_t)6528 * 1024 * 2;
static constexpr size_t OFF_WIN = 0;
static constexpr size_t OFF_RO = OFF_WIN + SZ_WIN;
static constexpr size_t OFF_SO = OFF_RO + 1024 * 256 * 2;
static constexpr size_t OFF_CO = OFF_SO + 1024 * 256 * 2;
static constexpr size_t OFF_GLU = OFF_CO + 1024 * 256 * 2;
static constexpr size_t OFF_WO = OFF_GLU + 2048 * 256 * 2;
static constexpr size_t OFF_W1 = OFF_WO + 1024 * 1024 * 2;
static constexpr size_t OFF_W2 = OFF_W1 + (size_t)4096 * 1024 * 2;
static constexpr size_t OFF_H = OFF_W2 + (size_t)4096 * 1024 * 2;
static constexpr size_t SZ_T256B = (size_t)T_TOK * 256 * 2;
static constexpr size_t OFF_VF = OFF_H + (size_t)T_TOK * 1024 * 2;
static constexpr size_t OFF_PD = OFF_VF + SZ_T256B;
static constexpr size_t OFF_G = OFF_PD + SZ_T256B;
static constexpr size_t OFF_UB = OFF_G + SZ_T256B;
static constexpr size_t OFF_CB = OFF_UB + SZ_T256B;
static constexpr size_t OFF_SR = OFF_CB + SZ_T256B;
static constexpr size_t OFF_SK = OFF_SR + SZ_T256B;
static constexpr size_t OFF_SV = OFF_SK + SZ_T256B;
static constexpr size_t OFF_SKK = OFF_SV + SZ_T256B;
static constexpr size_t OFF_SA = OFF_SKK + SZ_T256B;
static constexpr size_t OFF_SW = OFF_SA + SZ_T256B;
static constexpr size_t OFF_PABC = OFF_SW + 2 * SZ_T256B;
static constexpr size_t OFF_YD = OFF_PABC;
static constexpr size_t OFF_OG = OFF_YD + SZ_T256B;
static constexpr size_t OFF_MRG = OFF_OG + SZ_T256B;
static constexpr size_t OFF_F = OFF_UB;
static constexpr size_t OFF_SMALL = OFF_PABC + (size_t)T_TOK * 2176 * 2;
static constexpr size_t OFF_MOD = OFF_SMALL;
static constexpr size_t OFF_S5AB = OFF_MOD + 2 * 4 * 6144 * 4;
static constexpr size_t OFF_S5BB = OFF_S5AB + 2 * 16 * 64 * 2 * 4;
static constexpr size_t OFF_S5E = OFF_S5BB + 2 * 16 * 64 * 32 * 4;
static constexpr size_t OFF_BAR = OFF_S5E + (size_t)4 * 64 * 16 * 64 * 2 * 4;
static constexpr size_t OFF_SGW = OFF_BAR + 16384;
static constexpr size_t OFF_O = OFF_SGW + 4 * 128 * 128 * 2;
static constexpr size_t WS_END = OFF_O + 2 * SZ_T256B;
static_assert(OFF_F + (size_t)T_TOK * 4096 * 2 <= OFF_SMALL, "F overlaps small region");
static_assert(OFF_MRG + (size_t)T_TOK * 1024 * 2 <= OFF_SMALL, "MRG overlaps");

struct Params {
  const float* in[42];
  float* out;
  unsigned char* ws;
};

__device__ __forceinline__ u16 f2bf(float f) {
  unsigned u = __float_as_uint(f);
  u += 0x7fffu + ((u >> 16) & 1u);
  return (u16)(u >> 16);
}
__device__ __forceinline__ float bf2f(u16 h) { return __uint_as_float(((unsigned)h) << 16); }
__device__ __forceinline__ float bflo(unsigned u) { return __uint_as_float(u << 16); }
__device__ __forceinline__ float bfhi(unsigned u) { return __uint_as_float(u & 0xffff0000u); }
__device__ __forceinline__ unsigned pack2(float a, float b) { return (unsigned)f2bf(a) | ((unsigned)f2bf(b) << 16); }
__device__ __forceinline__ float sigmoidf_(float x) { return 1.f / (1.f + __expf(-x)); }
__device__ __forceinline__ float tanhf_(float y) { return 1.f - 2.f / (1.f + __expf(2.f * y)); }
__device__ __forceinline__ float geluf_(float x) {
  float y = 0.7978845608028654f * (x + 0.044715f * x * x * x);
  return 0.5f * x * (1.f + tanhf_(y));
}
__device__ __forceinline__ float wave_sum(float v) {
#pragma unroll
  for (int o = 32; o > 0; o >>= 1) v += __shfl_xor(v, o, 64);
  return v;
}
template <int CTRL>
__device__ __forceinline__ float dppf(float x) {
  return __int_as_float(__builtin_amdgcn_update_dpp(__float_as_int(x), __float_as_int(x), CTRL, 0xF, 0xF, true));
}
__device__ __forceinline__ float row_sum16(float x) {
  x += dppf<0x128>(x);
  x += dppf<0x124>(x);
  x += dppf<0x122>(x);
  x += dppf<0x121>(x);
  return x;
}

__device__ __forceinline__ void phase_mod(const Params& p, unsigned char* smem) {
  const int tid = TIDX;
  float* cact = (float*)smem;
  float* red = cact + 4096;
  float* mod = (float*)(p.ws + OFF_MOD);
  for (int i = tid; i < 4096; i += NTHR) { float c = p.in[1][i]; cact[i] = c / (1.f + __expf(-c)); }
  __syncthreads();
  for (int item = VBLK; item < 192; item += VGRID) {
    int l = item / 96, nb = item % 96;
    int cl = tid & 63, kq = tid >> 6;
    int col = nb * 64 + cl;
    const float* W = p.in[2] + (size_t)l * 1024 * 6144;
    float a0 = 0, a1 = 0, a2 = 0, a3 = 0;
    for (int k = kq * 256; k < kq * 256 + 256; ++k) {
      float w = W[(size_t)k * 6144 + col];
      a0 += cact[k] * w; a1 += cact[1024 + k] * w; a2 += cact[2048 + k] * w; a3 += cact[3072 + k] * w;
    }
    red[(kq * 4 + 0) * 64 + cl] = a0; red[(kq * 4 + 1) * 64 + cl] = a1;
    red[(kq * 4 + 2) * 64 + cl] = a2; red[(kq * 4 + 3) * 64 + cl] = a3;
    __syncthreads();
    {
      int b = tid >> 6;
      float s = red[(0 * 4 + b) * 64 + cl] + red[(1 * 4 + b) * 64 + cl] + red[(2 * 4 + b) * 64 + cl] + red[(3 * 4 + b) * 64 + cl];
      mod[((size_t)l * 4 + b) * 6144 + col] = s + p.in[3][l * 6144 + col];
    }
    __syncthreads();
  }
  float* s5ab = (float*)(p.ws + OFF_S5AB);
  float* s5bb = (float*)(p.ws + OFF_S5BB);
  for (int idx = VBLK * NTHR + tid; idx < 2048; idx += VGRID * NTHR) {
    int l = idx >> 10, g = (idx >> 6) & 15, n = idx & 63;
    double lre = fmin((double)p.in[28][idx], -1e-4);
    double lim = (double)p.in[29][idx];
    double dt = exp((double)p.in[35][l * 16 + g]);
    double mag = exp(lre * dt);
    double abr = mag * cos(lim * dt), abi = mag * sin(lim * dt);
    double den = lre * lre + lim * lim;
    double qr = ((abr - 1.0) * lre + abi * lim) / den;
    double qi = (abi * lre - (abr - 1.0) * lim) / den;
    s5ab[idx * 2 + 0] = (float)abr; s5ab[idx * 2 + 1] = (float)abi;
    for (int c = 0; c < 16; ++c) {
      double br = p.in[30][(size_t)idx * 16 + c], bi = p.in[31][(size_t)idx * 16 + c];
      s5bb[(size_t)idx * 32 + c] = (float)(qr * br - qi * bi);
      s5bb[(size_t)idx * 32 + 16 + c] = (float)(qr * bi + qi * br);
    }
  }
}

__device__ __forceinline__ void convert_tile(const float* __restrict__ src, int K, int N, u16* __restrict__ dst, int tk, int tn, u16* sm) {
  const int tid = TIDX;
  int r = tid >> 4, c4 = (tid & 15) * 4;
#pragma unroll
  for (int i = 0; i < 4; ++i) {
    int kk = r + 16 * i;
    float4 v = *(const float4*)(src + (size_t)(tk * 64 + kk) * N + tn * 64 + c4);
    sm[(c4 + 0) * 72 + kk] = f2bf(v.x);
    sm[(c4 + 1) * 72 + kk] = f2bf(v.y);
    sm[(c4 + 2) * 72 + kk] = f2bf(v.z);
    sm[(c4 + 3) * 72 + kk] = f2bf(v.w);
  }
  __syncthreads();
#pragma unroll
  for (int j = 0; j < 2; ++j) {
    int n = (tid >> 3) + 32 * j, ch = tid & 7;
    u32x4 v = *(const u32x4*)(sm + n * 72 + ch * 8);
    *(u32x4*)(dst + (size_t)(tn * 64 + n) * K + tk * 64 + ch * 8) = v;
  }
  __syncthreads();
}

__device__ __forceinline__ void phase_convert(const Params& p, int l, unsigned char* smem) {
  u16* sm = (u16*)smem;
  const int total = 1632 + 192 + 128 + 256 + 1024 + 1024;
  for (int item = VBLK; item < total + 16; item += VGRID) {
    int t = item;
    if (t >= total) {
      const int idx = t - total, g = idx >> 2, rq = idx & 3;
      const int tr = rq * 32 + (TIDX >> 3), s0 = (TIDX & 7) * 16;
      const float* src = p.in[23] + (((size_t)l * 4 + g) * 128 + tr) * 128 + s0;
      u16* dst = (u16*)(p.ws + OFF_SGW) + ((size_t)g * 128 + tr) * 128 + s0;
      unsigned pk[8];
#pragma unroll
      for (int e = 0; e < 4; ++e) {
        f32x4 v = *(const f32x4*)(src + e * 4);
        const int sb = s0 + e * 4;
        pk[e * 2 + 0] = pack2(sb + 0 <= tr ? v.x : 0.f, sb + 1 <= tr ? v.y : 0.f);
        pk[e * 2 + 1] = pack2(sb + 2 <= tr ? v.z : 0.f, sb + 3 <= tr ? v.w : 0.f);
      }
      *(u32x4*)(dst) = u32x4{pk[0], pk[1], pk[2], pk[3]};
      *(u32x4*)(dst + 8) = u32x4{pk[4], pk[5], pk[6], pk[7]};
      continue;
    }
    const float* src; int K, N; size_t off;
    if (t < 1632) { src = p.in[5] + (size_t)l * 1024 * 6528; K = 1024; N = 6528; off = OFF_WIN; }
    else if ((t -= 1632) < 64) { src = p.in[20] + (size_t)l * 256 * 1024; K = 256; N = 1024; off = OFF_RO; }
    else if ((t -= 64) < 64) { src = p.in[25] + (size_t)l * 256 * 1024; K = 256; N = 1024; off = OFF_SO; }
    else if ((t -= 64) < 64) { src = p.in[27] + (size_t)l * 256 * 1024; K = 256; N = 1024; off = OFF_CO; }
    else if ((t -= 64) < 128) { src = p.in[36] + (size_t)l * 256 * 2048; K = 256; N = 2048; off = OFF_GLU; }
    else if ((t -= 128) < 256) { src = p.in[37] + (size_t)l * 1024 * 1024; K = 1024; N = 1024; off = OFF_WO; }
    else if ((t -= 256) < 1024) { src = p.in[39] + (size_t)l * 1024 * 4096; K = 1024; N = 4096; off = OFF_W1; }
    else { t -= 1024; src = p.in[40] + (size_t)l * 4096 * 1024; K = 4096; N = 1024; off = OFF_W2; }
    int ntn = N / 64;
    convert_tile(src, K, N, (u16*)(p.ws + off), t / ntn, t % ntn, sm);
  }
}

__device__ __forceinline__ void phase_norm(const float* __restrict__ X, const float* __restrict__ g, const float* __restrict__ modl,
                           int sh_off, int sc_off, u16* __restrict__ H) {
  const int lane = TIDX & 63, wv = TIDX >> 6;
  for (int item = VBLK; item < T_TOK / 4; item += VGRID) {
    int row = item * 4 + wv;
    int b = row >> 12;
    const float* xr = X + (size_t)row * 1024;
    float4 v[4];
    float ss = 0;
#pragma unroll
    for (int i = 0; i < 4; ++i) {
      v[i] = *(const float4*)(xr + lane * 4 + 256 * i);
      ss += v[i].x * v[i].x + v[i].y * v[i].y + v[i].z * v[i].z + v[i].w * v[i].w;
    }
    ss = wave_sum(ss);
    float rstd = rsqrtf(ss * (1.f / 1024.f) + 1e-6f);
    const float* sh = modl + (size_t)b * 6144 + sh_off;
    const float* sc = modl + (size_t)b * 6144 + sc_off;
#pragma unroll
    for (int i = 0; i < 4; ++i) {
      int c = lane * 4 + 256 * i;
      float4 gg = *(const float4*)(g + c);
      float4 s1 = *(const float4*)(sc + c);
      float4 s0 = *(const float4*)(sh + c);
      float h0 = v[i].x * rstd * gg.x * (1.f + s1.x) + s0.x;
      float h1 = v[i].y * rstd * gg.y * (1.f + s1.y) + s0.y;
      float h2 = v[i].z * rstd * gg.z * (1.f + s1.z) + s0.z;
      float h3 = v[i].w * rstd * gg.w * (1.f + s1.w) + s0.w;
      u32x2 o; o.x = pack2(h0, h1); o.y = pack2(h2, h3);
      *(u32x2*)(H + (size_t)row * 1024 + c) = o;
    }
  }
}

__device__ __forceinline__ void phase_final(float* __restrict__ X, const float* __restrict__ g) {
  const int lane = TIDX & 63, wv = TIDX >> 6;
  for (int item = VBLK; item < T_TOK / 4; item += VGRID) {
    int row = item * 4 + wv;
    float* xr = X + (size_t)row * 1024;
    float4 v[4];
    float ss = 0;
#pragma unroll
    for (int i = 0; i < 4; ++i) {
      v[i] = *(const float4*)(xr + lane * 4 + 256 * i);
      ss += v[i].x * v[i].x + v[i].y * v[i].y + v[i].z * v[i].z + v[i].w * v[i].w;
    }
    ss = wave_sum(ss);
    float rstd = rsqrtf(ss * (1.f / 1024.f) + 1e-6f);
#pragma unroll
    for (int i = 0; i < 4; ++i) {
      int c = lane * 4 + 256 * i;
      float4 gg = *(const float4*)(g + c);
      float4 o;
      o.x = v[i].x * rstd * gg.x; o.y = v[i].y * rstd * gg.y; o.z = v[i].z * rstd * gg.z; o.w = v[i].w * rstd * gg.w;
      *(float4*)(xr + c) = o;
    }
  }
}

template <int NF, bool LEAN = false>
__device__ __forceinline__ void gemm_mainloop(const u16* __restrict__ A, int lda, const u16* __restrict__ B, int ldb,
                                              int K, f32x4 (&acc)[4][NF], u16* smem) {
  constexpr int BN = 32 * NF;
  constexpr int NB = BN / 32;
  u16* sA = smem;
  u16* sB = smem + 2 * 128 * 64;
  int tz = 0;
  if (LEAN) asm volatile("" : "+v"(tz));
  const int tid = TIDX + tz, lane = tid & 63, wv = tid >> 6;
  const int wm = wv >> 1, wn = wv & 1;
  const int lrow = tid >> 3;
  const int lchs = (tid & 7) ^ ((lrow >> 1) & 7);
  const u16* Ap = A + (size_t)lrow * lda + lchs * 8;
  const u16* Bp = B + (size_t)lrow * ldb + lchs * 8;
  const int nk = K >> 6;
  auto stage = [&](int kt, int buf) {
    const int ko = kt << 6;
#pragma unroll
    for (int i = 0; i < 4; ++i)
      __builtin_amdgcn_global_load_lds((const unsigned*)(Ap + (size_t)(32 * i) * lda + ko),
                                       (__attribute__((address_space(3))) unsigned*)(sA + buf * (128 * 64) + (tid + 256 * i) * 8), 16, 0, 0);
#pragma unroll
    for (int i = 0; i < NB; ++i)
      __builtin_amdgcn_global_load_lds((const unsigned*)(Bp + (size_t)(32 * i) * ldb + ko),
                                       (__attribute__((address_space(3))) unsigned*)(sB + buf * (BN * 64) + (tid + 256 * i) * 8), 16, 0, 0);
  };
  __syncthreads();
  stage(0, 0);
  const int fr = lane & 15, fq = lane >> 4;
  const int sw = (fr >> 1) & 7;
  for (int kt = 0; kt < nk; ++kt) {
    const int cur = kt & 1;
    asm volatile("s_waitcnt vmcnt(0)" ::: "memory");
    __syncthreads();
    if (kt + 1 < nk) stage(kt + 1, cur ^ 1);
    const u16* cA = sA + cur * (128 * 64) + (wm * 64 + fr) * 64;
    const u16* cB = sB + cur * (BN * 64) + (wn * 16 * NF + fr) * 64;
#pragma unroll
    for (int ks = 0; ks < 2; ++ks) {
      if (LEAN) __builtin_amdgcn_sched_barrier(0);
      const int pc = ((fq + 4 * ks) ^ sw) << 3;
      bf16x8 fa[4], fb[NF];
#pragma unroll
      for (int i = 0; i < 4; ++i) fa[i] = *(const bf16x8*)(cA + i * 16 * 64 + pc);
#pragma unroll
      for (int j = 0; j < NF; ++j) fb[j] = *(const bf16x8*)(cB + j * 16 * 64 + pc);
#pragma unroll
      for (int i = 0; i < 4; ++i)
#pragma unroll
        for (int j = 0; j < NF; ++j)
          acc[i][j] = __builtin_amdgcn_mfma_f32_16x16x32_bf16(fb[j], fa[i], acc[i][j], 0, 0, 0);
    }
  }
}

template <int NF>
__device__ __forceinline__ void zero_acc(f32x4 (&acc)[4][NF]) {
#pragma unroll
  for (int i = 0; i < 4; ++i)
#pragma unroll
    for (int j = 0; j < NF; ++j) acc[i][j] = f32x4{0.f, 0.f, 0.f, 0.f};
}

__device__ __forceinline__ void gemm_mainloop_8w(const u16* __restrict__ A, int lda, const u16* __restrict__ B, int ldb,
                                                 int K, f32x4 (&acc)[8][4], u16* smem) {
  constexpr int STG = 32768;
  const int tid = threadIdx.x, lane = tid & 63, wv = tid >> 6;
  const int wm = wv >> 2, wn = wv & 3;
  const int lrow = tid >> 3;
  const int lchs = (tid & 7) ^ ((lrow >> 1) & 7);
  const u16* Ap = A + (size_t)lrow * lda + lchs * 8;
  const u16* Bp = B + (size_t)lrow * ldb + lchs * 8;
  const int nk = K >> 6;
  auto stage = [&](int kt, int buf) {
    const int ko = kt << 6;
    u16* sa = smem + buf * STG;
#pragma unroll
    for (int i = 0; i < 4; ++i)
      __builtin_amdgcn_global_load_lds((const unsigned*)(Ap + (size_t)(64 * i) * lda + ko),
                                       (__attribute__((address_space(3))) unsigned*)(sa + (tid + 512 * i) * 8), 16, 0, 0);
#pragma unroll
    for (int i = 0; i < 4; ++i)
      __builtin_amdgcn_global_load_lds((const unsigned*)(Bp + (size_t)(64 * i) * ldb + ko),
                                       (__attribute__((address_space(3))) unsigned*)(sa + 16384 + (tid + 512 * i) * 8), 16, 0, 0);
  };
  __syncthreads();
  stage(0, 0);
  const int fr = lane & 15, fq = lane >> 4;
  const int sw = (fr >> 1) & 7;
  for (int kt = 0; kt < nk; ++kt) {
    const int cur = kt & 1;
    asm volatile("s_waitcnt vmcnt(0)" ::: "memory");
    __syncthreads();
    if (kt + 1 < nk) stage(kt + 1, cur ^ 1);
    const u16* cA = smem + cur * STG + (wm * 128 + fr) * 64;
    const u16* cB = smem + cur * STG + 16384 + (wn * 64 + fr) * 64;
#pragma unroll
    for (int ks = 0; ks < 2; ++ks) {
      __builtin_amdgcn_sched_barrier(0);
      const int pc = ((fq + 4 * ks) ^ sw) << 3;
      bf16x8 fa[8], fb[4];
#pragma unroll
      for (int i = 0; i < 8; ++i) fa[i] = *(const bf16x8*)(cA + i * 16 * 64 + pc);
#pragma unroll
      for (int j = 0; j < 4; ++j) fb[j] = *(const bf16x8*)(cB + j * 16 * 64 + pc);
#pragma unroll
      for (int i = 0; i < 8; ++i)
#pragma unroll
        for (int j = 0; j < 4; ++j)
          acc[i][j] = __builtin_amdgcn_mfma_f32_16x16x32_bf16(fb[j], fa[i], acc[i][j], 0, 0, 0);
    }
  }
}

template <int EPI>
__device__ __forceinline__ void phase_gemm_8w(const Params& p, int l, int vb, unsigned char* smem_raw) {
  u16* smem = (u16*)smem_raw;
  const int lane = threadIdx.x & 63, wv = threadIdx.x >> 6;
  const int wm = wv >> 2, wn = wv & 3;
  const int fr = lane & 15, fq = lane >> 4;
  const u16* A; const u16* B; int lda, ldb, K, ntiles_n;
  if (EPI == 1) { A = (const u16*)(p.ws + OFF_MRG); lda = 1024; B = (const u16*)(p.ws + OFF_WO); ldb = 1024; K = 1024; ntiles_n = 4; }
  if (EPI == 2) { A = (const u16*)(p.ws + OFF_H); lda = 1024; B = (const u16*)(p.ws + OFF_W1); ldb = 1024; K = 1024; ntiles_n = 16; }
  if (EPI == 3) { A = (const u16*)(p.ws + OFF_F); lda = 4096; B = (const u16*)(p.ws + OFF_W2); ldb = 4096; K = 4096; ntiles_n = 4; }
  const float* modl = (const float*)(p.ws + OFF_MOD) + (size_t)l * 4 * 6144;
  const int total = 64 * ntiles_n;
  const int G = gridDim.x;
  const bool swz = (G == 256);
  for (int item = vb; item < total; item += G) {
    int mt = item & 63, nt = item >> 6;
    if (swz) { const int r = item >> 8, w = vb & 31; mt = (vb >> 5) * 8 + (w & 7); nt = r * 4 + (w >> 3); }
    const int m0 = mt * 256, n0 = nt * 256;
    f32x4 acc[8][4];
#pragma unroll
    for (int i = 0; i < 8; ++i)
#pragma unroll
      for (int j = 0; j < 4; ++j) acc[i][j] = f32x4{0.f, 0.f, 0.f, 0.f};
    gemm_mainloop_8w(A + (size_t)m0 * lda, lda, B + (size_t)n0 * ldb, ldb, K, acc, smem);
#pragma unroll
    for (int i = 0; i < 8; ++i) {
      const int m = m0 + wm * 128 + i * 16 + fr;
#pragma unroll
      for (int j = 0; j < 4; ++j) {
        const int n = n0 + wn * 64 + j * 16 + fq * 4;
        f32x4 v = acc[i][j];
        if (EPI == 1 || EPI == 3) {
          const int b = m >> 12;
          const float* gt = modl + (size_t)b * 6144 + (EPI == 1 ? 2048 : 5120) + n;
          const float* xin = ((EPI == 1 && l == 0) ? p.in[0] : p.out) + (size_t)m * 1024 + n;
          f32x4 x = *(const f32x4*)xin;
          f32x4 gg = *(const f32x4*)gt;
          *(f32x4*)(p.out + (size_t)m * 1024 + n) = x + gg * v;
        } else {
          float r0 = fmaxf(v[0], 0.f), r1 = fmaxf(v[1], 0.f), r2 = fmaxf(v[2], 0.f), r3 = fmaxf(v[3], 0.f);
          *(u32x2*)((u16*)(p.ws + OFF_F) + (size_t)m * 4096 + n) = u32x2{pack2(r0 * r0, r1 * r1), pack2(r2 * r2, r3 * r3)};
        }
      }
    }
  }
}

template <int EPI>
__device__ __forceinline__ void phase_gemm(const Params& p, int l, int vb, unsigned char* smem_raw) {
  u16* smem = (u16*)smem_raw;
  const int lane = TIDX & 63, wv = TIDX >> 6;
  const int wm = wv >> 1, wn = wv & 1;
  const int fr = lane & 15, fq = lane >> 4;
  const u16* A; const u16* B; int lda, ldb, K, ntiles_n;
  if (EPI == 0) { A = (const u16*)(p.ws + OFF_H); lda = 1024; B = (const u16*)(p.ws + OFF_WIN); ldb = 1024; K = 1024; ntiles_n = 19; }
  if (EPI == 1) { A = (const u16*)(p.ws + OFF_MRG); lda = 1024; B = (const u16*)(p.ws + OFF_WO); ldb = 1024; K = 1024; ntiles_n = 8; }
  if (EPI == 2) { A = (const u16*)(p.ws + OFF_H); lda = 1024; B = (const u16*)(p.ws + OFF_W1); ldb = 1024; K = 1024; ntiles_n = 32; }
  if (EPI == 3) { A = (const u16*)(p.ws + OFF_F); lda = 4096; B = (const u16*)(p.ws + OFF_W2); ldb = 4096; K = 4096; ntiles_n = 8; }
  const float* modl = (const float*)(p.ws + OFF_MOD) + (size_t)l * 4 * 6144;
  const int G = VGRID;
  const bool swz = (G == 512);
  const int total = swz ? 128 * ((ntiles_n + 3) & ~3) : 128 * ntiles_n;
  for (int item = vb; item < total; item += G) {
    int mt = item & 127, nt = item >> 7;
    if (swz) { const int r = item >> 9, w = vb & 63; mt = (vb >> 6) * 16 + (w & 15); nt = r * 4 + (w >> 4); if (nt >= ntiles_n) continue; }
    const int m0 = mt * 128, n0 = nt * 128;
    f32x4 acc[4][4];
    zero_acc<4>(acc);
    gemm_mainloop<4>(A + (size_t)m0 * lda, lda, B + (size_t)n0 * ldb, ldb, K, acc, smem);
#pragma unroll
    for (int i = 0; i < 4; ++i) {
      const int m = m0 + wm * 64 + i * 16 + fr;
#pragma unroll
      for (int j = 0; j < 4; ++j) {
        const int n = n0 + wn * 64 + j * 16 + fq * 4;
        f32x4 v = acc[i][j];
        if (EPI == 0) {
          u32x2 o; o.x = pack2(v[0], v[1]); o.y = pack2(v[2], v[3]);
          if (n < 2176) *(u32x2*)((u16*)(p.ws + OFF_PABC) + (size_t)m * 2176 + n) = o;
          else *(u32x2*)((u16*)(p.ws + OFF_PD) + (size_t)m * 256 + (n - 2176)) = o;
        } else if (EPI == 1 || EPI == 3) {
          const int b = m >> 12;
          const float* gt = modl + (size_t)b * 6144 + (EPI == 1 ? 2048 : 5120) + n;
          const float* xin = ((EPI == 1 && l == 0) ? p.in[0] : p.out) + (size_t)m * 1024 + n;
          float4 x = *(const float4*)xin;
          float4 gg = *(const float4*)gt;
          float4 o;
          o.x = x.x + gg.x * v[0]; o.y = x.y + gg.y * v[1]; o.z = x.z + gg.z * v[2]; o.w = x.w + gg.w * v[3];
          *(float4*)(p.out + (size_t)m * 1024 + n) = o;
        } else {
          float r0 = fmaxf(v[0], 0.f), r1 = fmaxf(v[1], 0.f), r2 = fmaxf(v[2], 0.f), r3 = fmaxf(v[3], 0.f);
          u32x2 o; o.x = pack2(r0 * r0, r1 * r1); o.y = pack2(r2 * r2, r3 * r3);
          *(u32x2*)((u16*)(p.ws + OFF_F) + (size_t)m * 4096 + n) = o;
        }
      }
    }
  }
}

template <int MODE>
__device__ __forceinline__ void merge_tile(const Params& p, int item, unsigned char* smem_raw) {
  u16* smem = (u16*)smem_raw;
  const int lane = TIDX & 63, wv = TIDX >> 6;
  const int wm = wv >> 1, wn = wv & 1;
  const int fr = lane & 15, fq = lane >> 4;
  const u16* H = (const u16*)(p.ws + OFF_H);
  const u16* WIN = (const u16*)(p.ws + OFF_WIN);
  const int mt = item & 127, nt = item >> 7;
  const int m0 = mt * 128, n0 = nt * 128;
  f32x4 bacc[4][4];
  u32x2 gpk[4][4];
  u16* MRG = (u16*)(p.ws + OFF_MRG);
#pragma unroll 1
  for (int br = (MODE == 0 ? 1 : 0); br < (MODE == 0 ? 4 : 1); ++br) {
    zero_acc<4>(bacc);
    gemm_mainloop<4, true>(H + (size_t)m0 * 1024, 1024, WIN + (size_t)(2432 + br * 1024 + n0) * 1024, 1024, 1024, bacc, smem);
#pragma unroll
    for (int i = 0; i < 4; ++i)
#pragma unroll
      for (int j = 0; j < 4; ++j)
        gpk[i][j] = u32x2{pack2(sigmoidf_(bacc[i][j][0]), sigmoidf_(bacc[i][j][1])), pack2(sigmoidf_(bacc[i][j][2]), sigmoidf_(bacc[i][j][3]))};
    const u16* Ab; const u16* Wb;
    if (br == 0) { Ab = (const u16*)(p.ws + OFF_OG); Wb = (const u16*)(p.ws + OFF_RO); }
    else if (br == 1) { Ab = (const u16*)(p.ws + OFF_UB); Wb = (const u16*)(p.ws + OFF_SO); }
    else if (br == 2) { Ab = (const u16*)(p.ws + OFF_CB); Wb = (const u16*)(p.ws + OFF_CO); }
    else { Ab = (const u16*)(p.ws + OFF_YD); Wb = (const u16*)(p.ws + OFF_GLU); }
    if (MODE == 0 && br == 3) {
      zero_acc<4>(bacc);
      gemm_mainloop<4, true>(Ab + (size_t)m0 * 256, 256, Wb + (size_t)(1024 + n0) * 256, 256, 256, bacc, smem);
#pragma unroll
      for (int i = 0; i < 4; ++i)
#pragma unroll
        for (int j = 0; j < 4; ++j) {
          const float g0 = bflo(gpk[i][j].x) * sigmoidf_(bacc[i][j][0]), g1 = bfhi(gpk[i][j].x) * sigmoidf_(bacc[i][j][1]);
          const float g2 = bflo(gpk[i][j].y) * sigmoidf_(bacc[i][j][2]), g3 = bfhi(gpk[i][j].y) * sigmoidf_(bacc[i][j][3]);
          gpk[i][j] = u32x2{pack2(g0, g1), pack2(g2, g3)};
        }
    }
    zero_acc<4>(bacc);
    gemm_mainloop<4, true>(Ab + (size_t)m0 * 256, 256, Wb + (size_t)n0 * 256, 256, 256, bacc, smem);
#pragma unroll
    for (int i = 0; i < 4; ++i)
#pragma unroll
      for (int j = 0; j < 4; ++j) {
        u32x2* mp = (u32x2*)(MRG + (size_t)(m0 + wm * 64 + i * 16 + fr) * 1024 + n0 + wn * 64 + j * 16 + fq * 4);
        u32x2 cm = u32x2{0u, 0u};
        if (MODE == 1 || br > 1) cm = *mp;
        const float v0 = bflo(cm.x) + bflo(gpk[i][j].x) * bacc[i][j][0];
        const float v1 = bfhi(cm.x) + bfhi(gpk[i][j].x) * bacc[i][j][1];
        const float v2 = bflo(cm.y) + bflo(gpk[i][j].y) * bacc[i][j][2];
        const float v3 = bfhi(cm.y) + bfhi(gpk[i][j].y) * bacc[i][j][3];
        *mp = u32x2{pack2(v0, v1), pack2(v2, v3)};
      }
  }
}

__device__ __forceinline__ float shifted(const u16* __restrict__ P, int tok, int col, float mu) {
  float pv = bf2f(P[(size_t)tok * 2176 + col]);
  float pr = (tok & (SEQ - 1)) ? bf2f(P[(size_t)(tok - 1) * 2176 + col]) : 0.f;
  return pv + (pr - pv) * mu;
}

__device__ __forceinline__ void rwkv_prep_item(const Params& p, int l, int item, unsigned char* smem) {
  const int tid = TIDX;
  float* sl = (float*)smem;
  float* sv = sl + 32 * 128;
  float* svl = sv + 32 * 256;
  const u16* P = (const u16*)(p.ws + OFF_PABC);
  const float* mu = p.in[6] + l * 896;
  const int tok0 = item * 32;
  for (int idx = tid; idx < 32 * 128; idx += NTHR) {
    int t = idx >> 7, ci = idx & 127;
    float v = shifted(P, tok0 + t, 768 + ci, mu[768 + ci]);
    if (ci < 32) v = tanhf_(v);
    else if (ci >= 64) v = sigmoidf_(v);
    sl[idx] = v;
  }
  if (l > 0) {
    float m = mu[512 + tid];
    for (int t = 0; t < 32; ++t) sv[t * 256 + tid] = shifted(P, tok0 + t, 512 + tid, m);
  }
  __syncthreads();
  if (l > 0) {
    const float* v1 = p.in[13];
    int t = tid >> 3, o4 = (tid & 7) * 4;
    float a0 = 0, a1 = 0, a2 = 0, a3 = 0;
    for (int k = 0; k < 256; ++k) {
      float s = sv[t * 256 + k];
      float4 w = *(const float4*)(v1 + k * 32 + o4);
      a0 += s * w.x; a1 += s * w.y; a2 += s * w.z; a3 += s * w.w;
    }
    svl[t * 32 + o4 + 0] = a0; svl[t * 32 + o4 + 1] = a1; svl[t * 32 + o4 + 2] = a2; svl[t * 32 + o4 + 3] = a3;
    __syncthreads();
  }
  const int j = tid;
  const float* w2 = p.in[8] + l * 32 * 256;
  const float* a2w = p.in[10] + l * 32 * 256;
  const float* g2 = p.in[11] + l * 64 * 256;
  const float* v2 = p.in[14];
  const float w0 = p.in[7][l * 256 + j], a0c = p.in[9][l * 256 + j];
  const float v0 = (l > 0) ? p.in[12][j] : 0.f;
  const float kkc = p.in[15][l * 256 + j], kac = p.in[16][l * 256 + j];
  const float mur = mu[j], muk = mu[256 + j], muv = mu[512 + j];
  u16* SR = (u16*)(p.ws + OFF_SR); u16* SK = (u16*)(p.ws + OFF_SK); u16* SV = (u16*)(p.ws + OFF_SV);
  u16* SKK = (u16*)(p.ws + OFF_SKK); u16* SA = (u16*)(p.ws + OFF_SA); float* SW = (float*)(p.ws + OFF_SW);
  u16* G = (u16*)(p.ws + OFF_G); u16* VF = (u16*)(p.ws + OFF_VF);
#pragma unroll 1
  for (int tg = 0; tg < 4; ++tg) {
    float accw[8], acca[8], accg[8], accv[8];
#pragma unroll
    for (int tt = 0; tt < 8; ++tt) { accw[tt] = 0; acca[tt] = 0; accg[tt] = 0; accv[tt] = 0; }
#pragma unroll 1
    for (int k4 = 0; k4 < 8; ++k4) {
      float ww[4], wa[4];
#pragma unroll
      for (int e = 0; e < 4; ++e) { ww[e] = w2[(k4 * 4 + e) * 256 + j]; wa[e] = a2w[(k4 * 4 + e) * 256 + j]; }
#pragma unroll
      for (int tt = 0; tt < 8; ++tt) {
        float4 s = *(const float4*)(sl + (tg * 8 + tt) * 128 + k4 * 4);
        float4 s2 = *(const float4*)(sl + (tg * 8 + tt) * 128 + 32 + k4 * 4);
        accw[tt] += s.x * ww[0] + s.y * ww[1] + s.z * ww[2] + s.w * ww[3];
        acca[tt] += s2.x * wa[0] + s2.y * wa[1] + s2.z * wa[2] + s2.w * wa[3];
      }
    }
#pragma unroll 1
    for (int k4 = 0; k4 < 16; ++k4) {
      float wg[4];
#pragma unroll
      for (int e = 0; e < 4; ++e) wg[e] = g2[(k4 * 4 + e) * 256 + j];
#pragma unroll
      for (int tt = 0; tt < 8; ++tt) {
        float4 s = *(const float4*)(sl + (tg * 8 + tt) * 128 + 64 + k4 * 4);
        accg[tt] += s.x * wg[0] + s.y * wg[1] + s.z * wg[2] + s.w * wg[3];
      }
    }
    if (l > 0) {
#pragma unroll 1
      for (int k4 = 0; k4 < 8; ++k4) {
        float wvv[4];
#pragma unroll
        for (int e = 0; e < 4; ++e) wvv[e] = v2[(k4 * 4 + e) * 256 + j];
#pragma unroll
        for (int tt = 0; tt < 8; ++tt) {
          float4 s = *(const float4*)(svl + (tg * 8 + tt) * 32 + k4 * 4);
          accv[tt] += s.x * wvv[0] + s.y * wvv[1] + s.z * wvv[2] + s.w * wvv[3];
        }
      }
    }
#pragma unroll
    for (int tt = 0; tt < 8; ++tt) {
      const int tok = tok0 + tg * 8 + tt;
      float r = shifted(P, tok, j, mur);
      float k = shifted(P, tok, 256 + j, muk);
      float v = shifted(P, tok, 512 + j, muv);
      float wl = w0 + accw[tt];
      float z = -wl;
      float sp = (z > 15.f) ? z : __logf(1.f + __expf(z));
      float lw = -sp - 0.5f;
      float decay = __expf(-__expf(lw));
      float a = sigmoidf_(a0c + acca[tt]);
      float g = accg[tt];
      const size_t o = (size_t)tok * 256 + j;
      if (l == 0) {
        VF[o] = f2bf(v);
      } else {
        float vf = bf2f(VF[o]);
        v = v + (vf - v) * sigmoidf_(v0 + accv[tt]);
      }
      float kk = k * kkc;
      float ss = wave_sum(kk * kk);
      kk = kk / fmaxf(sqrtf(ss), 1e-12f);
      float km = k * (1.f + (a - 1.f) * kac);
      SR[o] = f2bf(r); SK[o] = f2bf(km); SV[o] = f2bf(v); SKK[o] = f2bf(kk); SA[o] = f2bf(a);
      SW[o] = decay; G[o] = f2bf(g);
    }
  }
  __syncthreads();
}

__device__ __forceinline__ void sg_item(const Params& p, int l, int item, unsigned char* smem) {
  const int tid = TIDX, lane = tid & 63, wv = tid >> 6;
  u16* vsT = (u16*)smem;
  float* smu = (float*)(smem + 16384);
  float* srs = smu + 128;
  const u16* P = (const u16*)(p.ws + OFF_PABC);
  const int g = item & 3, chn = item >> 2;
  const int tok0 = chn * 128;
  {
    const int t = tid >> 1, hf = tid & 1;
    const u16* src = P + (size_t)(tok0 + t) * 2176 + 896 + 256 + hf * 128;
    float sm = 0.f, ss = 0.f;
#pragma unroll 4
    for (int i = 0; i < 16; ++i) {
      u32x4 raw = *(const u32x4*)(src + i * 8);
      float z;
      z = geluf_(bflo(raw.x)); sm += z; ss += z * z;  z = geluf_(bfhi(raw.x)); sm += z; ss += z * z;
      z = geluf_(bflo(raw.y)); sm += z; ss += z * z;  z = geluf_(bfhi(raw.y)); sm += z; ss += z * z;
      z = geluf_(bflo(raw.z)); sm += z; ss += z * z;  z = geluf_(bfhi(raw.z)); sm += z; ss += z * z;
      z = geluf_(bflo(raw.w)); sm += z; ss += z * z;  z = geluf_(bfhi(raw.w)); sm += z; ss += z * z;
    }
    sm += __shfl_xor(sm, 1, 64); ss += __shfl_xor(ss, 1, 64);
    const float mean = sm * (1.f / 256.f);
    const float var = fmaxf(ss * (1.f / 256.f) - mean * mean, 0.f);
    if (hf == 0) { smu[t] = mean; srs[t] = rsqrtf(var + 1e-5f); }
  }
  __syncthreads();
  {
    const int c = tid & 63, tb = tid >> 6;
    const float lw = p.in[21][l * 256 + g * 64 + c], lb = p.in[22][l * 256 + g * 64 + c];
#pragma unroll
    for (int j = 0; j < 4; ++j) {
      u16 raw[8];
#pragma unroll
      for (int e = 0; e < 8; ++e) raw[e] = P[(size_t)(tok0 + tb * 32 + j * 8 + e) * 2176 + 896 + 256 + g * 64 + c];
      float vv[8];
#pragma unroll
      for (int e = 0; e < 8; ++e) {
        const int t = tb * 32 + j * 8 + e;
        vv[e] = (geluf_(bf2f(raw[e])) - smu[t]) * srs[t] * lw + lb;
      }
      const int phys = (tb * 4 + j) ^ (c & 15);
      *(u32x4*)(vsT + c * 128 + phys * 8) = u32x4{pack2(vv[0], vv[1]), pack2(vv[2], vv[3]), pack2(vv[4], vv[5]), pack2(vv[6], vv[7])};
    }
  }
  __syncthreads();
  {
    const int fr = lane & 15, fq = lane >> 4;
    const u16* Wm = (const u16*)(p.ws + OFF_SGW) + (size_t)g * 128 * 128;
    f32x4 acc[2][4];
#pragma unroll
    for (int i = 0; i < 2; ++i)
#pragma unroll
      for (int j = 0; j < 4; ++j) acc[i][j] = f32x4{0.f, 0.f, 0.f, 0.f};
    for (int ks = 0; ks <= wv; ++ks) {
      bf16x8 fa[2], fb[4];
#pragma unroll
      for (int i = 0; i < 2; ++i) fa[i] = *(const bf16x8*)(Wm + (size_t)(32 * wv + 16 * i + fr) * 128 + ks * 32 + fq * 8);
#pragma unroll
      for (int j = 0; j < 4; ++j) fb[j] = *(const bf16x8*)(vsT + (j * 16 + fr) * 128 + (((ks * 4 + fq) ^ fr) << 3));
#pragma unroll
      for (int i = 0; i < 2; ++i)
#pragma unroll
        for (int j = 0; j < 4; ++j) acc[i][j] = __builtin_amdgcn_mfma_f32_16x16x32_bf16(fb[j], fa[i], acc[i][j], 0, 0, 0);
    }
    const float* bs = p.in[24] + ((size_t)l * 4 + g) * 128;
    u16* UB = (u16*)(p.ws + OFF_UB);
#pragma unroll
    for (int i = 0; i < 2; ++i) {
      const int t = 32 * wv + 16 * i + fr;
      const float bsv = bs[t];
#pragma unroll
      for (int j = 0; j < 4; ++j) {
        const int cc = j * 16 + fq * 4;
        u32x2 ur = *(const u32x2*)(P + (size_t)(tok0 + t) * 2176 + 896 + g * 64 + cc);
        float o0 = geluf_(bflo(ur.x)) * (acc[i][j][0] + bsv), o1 = geluf_(bfhi(ur.x)) * (acc[i][j][1] + bsv);
        float o2 = geluf_(bflo(ur.y)) * (acc[i][j][2] + bsv), o3 = geluf_(bfhi(ur.y)) * (acc[i][j][3] + bsv);
        *(u32x2*)(UB + (size_t)(tok0 + t) * 256 + g * 64 + cc) = u32x2{pack2(o0, o1), pack2(o2, o3)};
      }
    }
  }
  __syncthreads();
}

__device__ __forceinline__ void conv_item(const Params& p, int l, int item) {
  const int j = TIDX;
  const u16* P = (const u16*)(p.ws + OFF_PABC);
  u16* CB = (u16*)(p.ws + OFF_CB);
  const float c0 = p.in[26][(l * 3 + 0) * 256 + j], c1 = p.in[26][(l * 3 + 1) * 256 + j], c2 = p.in[26][(l * 3 + 2) * 256 + j];
  const int tok0 = item * 8;
  u16 rc[10], rx[10], rb[8];
  const bool first = (tok0 & (SEQ - 1)) == 0;
#pragma unroll
  for (int t = 0; t < 10; ++t) {
    const int tok = (first && t < 2) ? tok0 : tok0 + t - 2;
    const u16* q = P + (size_t)tok * 2176 + 1408;
    rc[t] = q[256 + j]; rx[t] = q[512 + j];
    if (t >= 2) rb[t - 2] = q[j];
  }
  float z[10];
#pragma unroll
  for (int t = 0; t < 10; ++t) z[t] = bf2f(rc[t]) * bf2f(rx[t]);
  if (first) { z[0] = 0.f; z[1] = 0.f; }
#pragma unroll
  for (int t = 0; t < 8; ++t) {
    float y = c0 * z[t] + c1 * z[t + 1] + c2 * z[t + 2];
    CB[(size_t)(tok0 + t) * 256 + j] = f2bf(bf2f(rb[t]) * y);
  }
}

__device__ __forceinline__ void s5_load_u(const u16* us, int t, int wv, float (&u)[16]) {
  const u32x4* q = (const u32x4*)(us + t * 64 + wv * 16);
  u32x4 a = q[0], b = q[1];
  u[0] = bflo(a.x); u[1] = bfhi(a.x); u[2] = bflo(a.y); u[3] = bfhi(a.y);
  u[4] = bflo(a.z); u[5] = bfhi(a.z); u[6] = bflo(a.w); u[7] = bfhi(a.w);
  u[8] = bflo(b.x); u[9] = bfhi(b.x); u[10] = bflo(b.y); u[11] = bfhi(b.y);
  u[12] = bflo(b.z); u[13] = bfhi(b.z); u[14] = bflo(b.w); u[15] = bfhi(b.w);
}
__device__ __forceinline__ void s5_stage_u(const u16* __restrict__ PD, int tok0, int gq, u16* us) {
#pragma unroll
  for (int i = 0; i < 2; ++i) {
    const int ch = TIDX + 256 * i;
    const int t = ch >> 3, part = ch & 7;
    *(u32x4*)(us + t * 64 + part * 8) = *(const u32x4*)(PD + (size_t)(tok0 + t) * 256 + gq * 64 + part * 8);
  }
}

__device__ __forceinline__ void s5a_item(const Params& p, int l, int item, unsigned char* smem) {
  const int lane = TIDX & 63, wv = TIDX >> 6;
  const int gq = item & 3, bc = item >> 2;
  const int g = gq * 4 + wv;
  const int tok0 = bc * 64;
  const u16* PD = (const u16*)(p.ws + OFF_PD);
  const float* ab = (const float*)(p.ws + OFF_S5AB) + ((size_t)(l * 16 + g) * 64 + lane) * 2;
  const float* bb = (const float*)(p.ws + OFF_S5BB) + ((size_t)(l * 16 + g) * 64 + lane) * 32;
  float bbr[16], bbi[16];
#pragma unroll
  for (int c = 0; c < 16; ++c) { bbr[c] = bb[c]; bbi[c] = bb[16 + c]; }
  const float abr = ab[0], abi = ab[1];
  float xr = 0.f, xi = 0.f;
  u16* us = (u16*)smem;
  s5_stage_u(PD, tok0, gq, us);
  __syncthreads();
#pragma unroll 4
  for (int t = 0; t < 64; ++t) {
    float u[16];
    s5_load_u(us, t, wv, u);
    float bur = 0.f, bui = 0.f;
#pragma unroll
    for (int c = 0; c < 16; ++c) { bur += bbr[c] * u[c]; bui += bbi[c] * u[c]; }
    float nr = abr * xr - abi * xi + bur;
    float ni = abr * xi + abi * xr + bui;
    xr = nr; xi = ni;
  }
  float2* E = (float2*)(p.ws + OFF_S5E);
  E[((size_t)bc * 16 + g) * 64 + lane] = make_float2(xr, xi);
  __syncthreads();
}

__device__ __forceinline__ void s5b_item(const Params& p, int l, int item, unsigned char* smem) {
  const int lane = TIDX & 63, wv = TIDX >> 6;
  const int gq = item & 3, bc = item >> 2;
  const int b = bc >> 6, ch = bc & 63;
  const int g = gq * 4 + wv;
  const int tok0 = bc * 64;
  u16* us = (u16*)(smem + 65536);
  s5_stage_u((const u16*)(p.ws + OFF_PD), tok0, gq, us);
  float* base = (float*)smem + wv * 4096;
  float* csr = base, *csi = base + 1024, *xsr = base + 2048, *xsi = base + 3072;
  const u16* PD = (const u16*)(p.ws + OFF_PD);
  const float* ab = (const float*)(p.ws + OFF_S5AB) + ((size_t)(l * 16 + g) * 64 + lane) * 2;
  const float* bb = (const float*)(p.ws + OFF_S5BB) + ((size_t)(l * 16 + g) * 64 + lane) * 32;
  const float* cre = p.in[32] + ((size_t)(l * 16 + g) * 16) * 64;
  const float* cim = p.in[33] + ((size_t)(l * 16 + g) * 16) * 64;
  for (int c = 0; c < 16; ++c) {
    csr[(lane >> 2) * 64 + c * 4 + (lane & 3)] = cre[c * 64 + lane];
    csi[(lane >> 2) * 64 + c * 4 + (lane & 3)] = cim[c * 64 + lane];
  }
  float bbr[16], bbi[16];
#pragma unroll
  for (int c = 0; c < 16; ++c) { bbr[c] = bb[c]; bbi[c] = bb[16 + c]; }
  const float abr = ab[0], abi = ab[1];
  float pr = abr, pi = abi;
#pragma unroll
  for (int s = 0; s < 6; ++s) { float nr = pr * pr - pi * pi, ni = 2.f * pr * pi; pr = nr; pi = ni; }
  float xr = 0.f, xi = 0.f;
  const float2* E = (const float2*)(p.ws + OFF_S5E);
  for (int c = 0; c < ch; ++c) {
    float2 e = E[((size_t)(b * 64 + c) * 16 + g) * 64 + lane];
    float nr = pr * xr - pi * xi + e.x;
    float ni = pr * xi + pi * xr + e.y;
    xr = nr; xi = ni;
  }
  const int tt = lane & 15, cq = lane >> 4;
  const float* dvec = p.in[34] + l * 256 + g * 16 + cq * 4;
  const float d0 = dvec[0], d1 = dvec[1], d2 = dvec[2], d3 = dvec[3];
  u16* YD = (u16*)(p.ws + OFF_YD);
  const int n4w = lane >> 2, e4 = lane & 3;
  __syncthreads();
#pragma unroll 1
  for (int sc = 0; sc < 4; ++sc) {
    for (int t = 0; t < 16; ++t) {
      float u[16];
      s5_load_u(us, sc * 16 + t, wv, u);
      float bur = 0.f, bui = 0.f;
#pragma unroll
      for (int c = 0; c < 16; ++c) { bur += bbr[c] * u[c]; bui += bbi[c] * u[c]; }
      float nr = abr * xr - abi * xi + bur;
      float ni = abr * xi + abi * xr + bui;
      xr = nr; xi = ni;
      int a = n4w * 64 + ((t ^ (n4w & 7)) << 2) + e4;
      xsr[a] = xr; xsi[a] = xi;
    }
    __syncthreads();
    float acc0 = 0.f, acc1 = 0.f, acc2 = 0.f, acc3 = 0.f;
#pragma unroll 2
    for (int n4 = 0; n4 < 16; ++n4) {
      int xa = n4 * 64 + ((tt ^ (n4 & 7)) << 2);
      float4 xr4 = *(const float4*)(xsr + xa);
      float4 xi4 = *(const float4*)(xsi + xa);
      const float* cr = csr + n4 * 64 + cq * 16;
      const float* ci = csi + n4 * 64 + cq * 16;
      float4 r0 = *(const float4*)(cr), r1 = *(const float4*)(cr + 4), r2 = *(const float4*)(cr + 8), r3 = *(const float4*)(cr + 12);
      float4 i0 = *(const float4*)(ci), i1 = *(const float4*)(ci + 4), i2 = *(const float4*)(ci + 8), i3 = *(const float4*)(ci + 12);
      acc0 += r0.x * xr4.x + r0.y * xr4.y + r0.z * xr4.z + r0.w * xr4.w - (i0.x * xi4.x + i0.y * xi4.y + i0.z * xi4.z + i0.w * xi4.w);
      acc1 += r1.x * xr4.x + r1.y * xr4.y + r1.z * xr4.z + r1.w * xr4.w - (i1.x * xi4.x + i1.y * xi4.y + i1.z * xi4.z + i1.w * xi4.w);
      acc2 += r2.x * xr4.x + r2.y * xr4.y + r2.z * xr4.z + r2.w * xr4.w - (i2.x * xi4.x + i2.y * xi4.y + i2.z * xi4.z + i2.w * xi4.w);
      acc3 += r3.x * xr4.x + r3.y * xr4.y + r3.z * xr4.z + r3.w * xr4.w - (i3.x * xi4.x + i3.y * xi4.y + i3.z * xi4.z + i3.w * xi4.w);
    }
    {
      const int tok = tok0 + sc * 16 + tt;
      u32x2 ur = *(const u32x2*)(us + (sc * 16 + tt) * 64 + wv * 16 + cq * 4);
      float y0 = acc0 + d0 * bflo(ur.x), y1 = acc1 + d1 * bfhi(ur.x), y2 = acc2 + d2 * bflo(ur.y), y3 = acc3 + d3 * bfhi(ur.y);
      u32x2 o; o.x = pack2(geluf_(y0), geluf_(y1)); o.y = pack2(geluf_(y2), geluf_(y3));
      *(u32x2*)(YD + (size_t)tok * 256 + g * 16 + cq * 4) = o;
    }
    __syncthreads();
  }
}

__device__ __forceinline__ void lds_barrier() {
  asm volatile("s_waitcnt lgkmcnt(0)" ::: "memory");
  __builtin_amdgcn_s_barrier();
  asm volatile("" ::: "memory");
}
using f32x2 = __attribute__((ext_vector_type(2))) float;
__device__ __forceinline__ void scan_item(const Params& p, int item, unsigned char* smem) {
  const int tid = TIDX, lane = tid & 63, wv = tid >> 6;
  const int b = item >> 4, h = (item >> 2) & 3, q = item & 3;
  const int rl = lane >> 4, cl = lane & 15;
  const int rloc = wv * 4 + rl;
  const size_t tokb = (size_t)b * SEQ;
  const int chan0 = h * 64;
  const u16* SR = (const u16*)(p.ws + OFF_SR); const u16* SK = (const u16*)(p.ws + OFF_SK);
  const u16* SV = (const u16*)(p.ws + OFF_SV); const u16* SKK = (const u16*)(p.ws + OFF_SKK);
  const u16* SA = (const u16*)(p.ws + OFF_SA); const float* SW = (const float*)(p.ws + OFF_SW);
  float* O = (float*)(p.ws + OFF_O);
  constexpr int BUFF = 5376;
  float* lbase = (float*)smem;
  float* pp = lbase + 2 * BUFF + wv * 1024;
  const int st = tid >> 4, cg4 = tid & 15;
  struct Stg { u32x2 r, k, kk, a; f32x4 w; u16 v; };
  auto gload = [&](Stg& g, int c) {
    const size_t o = (tokb + (size_t)c * 16 + st) * 256 + chan0;
    g.r = *(const u32x2*)(SR + o + cg4 * 4); g.k = *(const u32x2*)(SK + o + cg4 * 4);
    g.kk = *(const u32x2*)(SKK + o + cg4 * 4); g.a = *(const u32x2*)(SA + o + cg4 * 4);
    g.w = *(const f32x4*)(SW + o + cg4 * 4);
    g.v = SV[o + q * 16 + cg4];
  };
  auto lwrite = [&](const Stg& g, int buf) {
    float* bp = lbase + buf * BUFF;
    const int o = st * 64 + cg4 * 4;
    f32x4 kk = {bflo(g.kk.x), bfhi(g.kk.x), bflo(g.kk.y), bfhi(g.kk.y)};
    f32x4 a = {bflo(g.a.x), bfhi(g.a.x), bflo(g.a.y), bfhi(g.a.y)};
    f32x4 k = {bflo(g.k.x), bfhi(g.k.x), bflo(g.k.y), bfhi(g.k.y)};
    f32x4 r = {bflo(g.r.x), bfhi(g.r.x), bflo(g.r.y), bfhi(g.r.y)};
    *(f32x4*)(bp + o) = kk;
    *(f32x4*)(bp + 1024 + o) = kk * a;
    *(f32x4*)(bp + 2048 + o) = k;
    *(f32x4*)(bp + 3072 + o) = g.w;
    *(f32x4*)(bp + 4096 + o) = r;
    bp[5120 + st * 16 + cg4] = bf2f(g.v);
  };
  constexpr int NCH = SEQ / 16;
  Stg R0, R1, R2, R3;
  gload(R0, 0); gload(R1, 1); gload(R2, 2); gload(R3, 3);
  __syncthreads();
  lwrite(R0, 0);
  __syncthreads();
  __builtin_amdgcn_s_setprio(3);
  float S0 = 0.f, S1 = 0.f, S2 = 0.f, S3 = 0.f;
  const int rrow = lane & 3, rstep = lane >> 2;
  struct Ops { f32x4 kk, bb, k4, w4, r4; float v; };
  auto chunk = [&](int c) {
    const float* bp = lbase + (c & 1) * BUFF;
    auto ldops = [&](Ops& o, int s) {
      o.kk = *(const f32x4*)(bp + s * 64 + cl * 4);
      o.bb = *(const f32x4*)(bp + 1024 + s * 64 + cl * 4);
      o.k4 = *(const f32x4*)(bp + 2048 + s * 64 + cl * 4);
      o.w4 = *(const f32x4*)(bp + 3072 + s * 64 + cl * 4);
      o.r4 = *(const f32x4*)(bp + 4096 + s * 64 + cl * 4);
      o.v = bp[5120 + s * 16 + rloc];
    };
    auto step = [&](const Ops& o, int s) {
      const float sa = row_sum16(__builtin_fmaf(S3, o.kk.w, __builtin_fmaf(S2, o.kk.z, __builtin_fmaf(S1, o.kk.y, S0 * o.kk.x))));
      S0 = __builtin_fmaf(S0, o.w4.x, __builtin_fmaf(o.v, o.k4.x, -(sa * o.bb.x)));
      S1 = __builtin_fmaf(S1, o.w4.y, __builtin_fmaf(o.v, o.k4.y, -(sa * o.bb.y)));
      S2 = __builtin_fmaf(S2, o.w4.z, __builtin_fmaf(o.v, o.k4.z, -(sa * o.bb.z)));
      S3 = __builtin_fmaf(S3, o.w4.w, __builtin_fmaf(o.v, o.k4.w, -(sa * o.bb.w)));
      pp[(s * 4 + rl) * 16 + cl] = __builtin_fmaf(S3, o.r4.w, __builtin_fmaf(S2, o.r4.z, __builtin_fmaf(S1, o.r4.y, S0 * o.r4.x)));
    };
    Ops a0, a1, b0, b1;
    ldops(a0, 0); ldops(a1, 1);
#pragma unroll
    for (int j = 0; j < 4; ++j) {
      ldops(b0, 4 * j + 2); ldops(b1, 4 * j + 3);
      __builtin_amdgcn_sched_barrier(0);
      step(a0, 4 * j); step(a1, 4 * j + 1);
      __builtin_amdgcn_sched_barrier(0);
      if (j < 3) { ldops(a0, 4 * j + 4); ldops(a1, 4 * j + 5); }
      __builtin_amdgcn_sched_barrier(0);
      step(b0, 4 * j + 2); step(b1, 4 * j + 3);
      __builtin_amdgcn_sched_barrier(0);
    }
    asm volatile("" ::: "memory");
    {
      const float* q0 = pp + (rstep * 4 + rrow) * 16;
      f32x4 a0 = *(const f32x4*)(q0), a1 = *(const f32x4*)(q0 + 4), a2 = *(const f32x4*)(q0 + 8), a3 = *(const f32x4*)(q0 + 12);
      f32x4 sm4 = (a0 + a1) + (a2 + a3);
      O[(tokb + (size_t)c * 16 + rstep) * 256 + chan0 + q * 16 + wv * 4 + rrow] = (sm4.x + sm4.y) + (sm4.z + sm4.w);
    }
    asm volatile("" ::: "memory");
  };
#pragma unroll 1
  for (int g = 0; g < NCH / 4; ++g) {
    const int c0 = g * 4;
    if (c0 + 4 < NCH) gload(R0, c0 + 4);
    chunk(c0);
    lwrite(R1, (c0 + 1) & 1);
    lds_barrier();
    if (c0 + 5 < NCH) gload(R1, c0 + 5);
    chunk(c0 + 1);
    lwrite(R2, (c0 + 2) & 1);
    lds_barrier();
    if (c0 + 6 < NCH) gload(R2, c0 + 6);
    chunk(c0 + 2);
    lwrite(R3, (c0 + 3) & 1);
    lds_barrier();
    if (c0 + 7 < NCH) gload(R3, c0 + 7);
    chunk(c0 + 3);
    if (c0 + 4 < NCH) lwrite(R0, (c0 + 4) & 1);
    lds_barrier();
  }
  __builtin_amdgcn_s_setprio(0);
}

__device__ __forceinline__ void rwkv_post_item(const Params& p, int l, int item) {
  const int j = TIDX;
  const float* O = (const float*)(p.ws + OFF_O);
  const u16* SR = (const u16*)(p.ws + OFF_SR); const u16* SK = (const u16*)(p.ws + OFF_SK);
  const u16* SV = (const u16*)(p.ws + OFF_SV); const u16* G = (const u16*)(p.ws + OFF_G);
  u16* OG = (u16*)(p.ws + OFF_OG);
  const float lw = p.in[18][l * 256 + j], lb = p.in[19][l * 256 + j], rk = p.in[17][l * 256 + j];
  const int tok0 = item * 8;
  float ov[8]; u16 rr[8], rkk[8], rv[8], rg[8];
#pragma unroll
  for (int t = 0; t < 8; ++t) {
    const size_t o = (size_t)(tok0 + t) * 256 + j;
    ov[t] = O[o]; rr[t] = SR[o]; rkk[t] = SK[o]; rv[t] = SV[o]; rg[t] = G[o];
  }
#pragma unroll
  for (int t = 0; t < 8; ++t) {
    const size_t o = (size_t)(tok0 + t) * 256 + j;
    float mean = wave_sum(ov[t]) * (1.f / 64.f);
    float d = ov[t] - mean;
    float var = wave_sum(d * d) * (1.f / 64.f);
    float on = d * rsqrtf(var + 64e-5f) * lw + lb;
    float bonus = wave_sum(bf2f(rr[t]) * bf2f(rkk[t]) * rk);
    OG[o] = f2bf((on + bonus * bf2f(rv[t])) * bf2f(rg[t]));
  }
}

#define XB_TMO      128
#define XB_XCNT(j)  (256  + 64 * (j))
#define XB_XSUB(j)  (1280 + 64 * (j))
#define XB_XGEN(j)  (2304 + 64 * (j))
#define XB_TOP      3328
#define XB_TOPGEN   3392
#define XCD_BAR_WORDS 3456
#define XB_SPIN_CAP (1u << 22)
#define LAS __attribute__((address_space(3)))
__device__ __forceinline__ unsigned xb_ld(unsigned* p) { return __hip_atomic_load(p, __ATOMIC_RELAXED, __HIP_MEMORY_SCOPE_AGENT); }
__device__ __forceinline__ unsigned xb_add(unsigned* p, unsigned v) { return __hip_atomic_fetch_add(p, v, __ATOMIC_RELAXED, __HIP_MEMORY_SCOPE_AGENT); }
__device__ __forceinline__ unsigned xb_xcc_id() { return (unsigned)__builtin_amdgcn_s_getreg((3 << 11) | 20) & 0xFu; }
#define XB_SPIN(cond, bar) do { unsigned _sp = 0; while (cond) { __builtin_amdgcn_s_sleep(1); \
    if ((++_sp & 255u) == 0u) { if (xb_ld(&(bar)[XB_TMO])) break; if (_sp > XB_SPIN_CAP) { atomicAdd(&(bar)[XB_TMO], 1u); break; } } } } while (0)
struct XcdBarrier { unsigned* bar; unsigned x; volatile LAS unsigned* st; };
__device__ __forceinline__ XcdBarrier xcd_barrier_post(unsigned* bar, volatile LAS unsigned* st) {
  XcdBarrier b; b.bar = bar; b.x = xb_xcc_id(); b.st = st;
  if (threadIdx.x == 0) st[2] = xb_add(&bar[XB_XCNT(b.x)], 1u);
  return b;
}
__device__ __forceinline__ void xcd_barrier_complete(unsigned* bar, unsigned x, unsigned& nloc, unsigned& nx) {
  const unsigned G = gridDim.x * gridDim.y * gridDim.z;
  unsigned sum, cnt, mine, sp = 0u;
  for (;;) {
    sum = 0u; cnt = 0u; mine = 0u;
#pragma unroll
    for (unsigned j = 0; j < 16; ++j) { const unsigned c = xb_ld(&bar[XB_XCNT(j)]); sum += c; cnt += (c > 0u) ? 1u : 0u; mine = (j == x) ? c : mine; }
    if (sum == G) break;
    __builtin_amdgcn_s_sleep(1);
    if ((++sp & 255u) == 0u) { if (xb_ld(&bar[XB_TMO])) break; if (sp > XB_SPIN_CAP) { atomicAdd(&bar[XB_TMO], 1u); break; } }
  }
  nloc = mine > 0u ? mine : 1u; nx = cnt > 0u ? cnt : 1u;
}
__device__ __forceinline__ void xcd_barrier(const XcdBarrier& b) {
  asm volatile("s_waitcnt vmcnt(0)" ::: "memory");
  __syncthreads();
  if (threadIdx.x == 0) {
    unsigned* bar = b.bar;
    __builtin_amdgcn_s_waitcnt(0);
    unsigned nloc = b.st[0], nx = b.st[1];
    if (nloc == 0u) { xcd_barrier_complete(bar, b.x, nloc, nx); b.st[0] = nloc; b.st[1] = nx; }
    const unsigned old = xb_add(&bar[XB_XSUB(b.x)], 1u);
    const unsigned gen = old / nloc;
    if (old + 1u == (gen + 1u) * nloc) {
      __builtin_amdgcn_fence(__ATOMIC_RELEASE, "agent");
      asm volatile("s_waitcnt vmcnt(0)" ::: "memory");
      const unsigned og = xb_add(&bar[XB_TOP], 1u);
      const unsigned tg = og / nx;
      if (og + 1u == (tg + 1u) * nx) xb_add(&bar[XB_TOPGEN], 1u);
      else XB_SPIN(xb_ld(&bar[XB_TOPGEN]) == tg, bar);
      __builtin_amdgcn_fence(__ATOMIC_ACQUIRE, "agent");
      xb_add(&bar[XB_XGEN(b.x)], 1u);
      asm volatile("s_waitcnt vmcnt(0)" ::: "memory");
    } else {
      XB_SPIN(xb_ld(&bar[XB_XGEN(b.x)]) == gen, bar);
      __builtin_amdgcn_fence(__ATOMIC_ACQUIRE, "agent");
      asm volatile("s_waitcnt vmcnt(0)" ::: "memory");
    }
  }
  __syncthreads();
}

__device__ __forceinline__ int xcd_virtual_id(const XcdBarrier& b) {
  if (threadIdx.x == 0) {
    unsigned base = 0u;
#pragma unroll
    for (unsigned j = 0; j < 16; ++j) { const unsigned c = xb_ld(&b.bar[XB_XCNT(j)]); base += (j < b.x) ? c : 0u; }
    b.st[3] = base + b.st[2];
  }
  __syncthreads();
  const int vb = __builtin_amdgcn_readfirstlane((int)b.st[3]);
  __syncthreads();
  return vb;
}

__device__ __forceinline__ void sub_barrier(unsigned* cnt, unsigned target) {
  asm volatile("s_waitcnt vmcnt(0)" ::: "memory");
  __syncthreads();
  if (threadIdx.x == 0) {
    __builtin_amdgcn_fence(__ATOMIC_RELEASE, "agent");
    asm volatile("s_waitcnt vmcnt(0)" ::: "memory");
    xb_add(cnt, 1u);
    unsigned sp = 0;
    while (xb_ld(cnt) < target) { __builtin_amdgcn_s_sleep(2); if (++sp > (1u << 24)) break; }
    __builtin_amdgcn_fence(__ATOMIC_ACQUIRE, "agent");
    asm volatile("s_waitcnt vmcnt(0)" ::: "memory");
  }
  __syncthreads();
}

#define N_PHASES 22
#ifndef PROBE_CONV_REPS
#define PROBE_CONV_REPS 1
#endif
#ifndef PROBE_PREP_REPS
#define PROBE_PREP_REPS 1
#endif
#ifndef PROBE_POST_REPS
#define PROBE_POST_REPS 1
#endif
#ifndef PROBE_SCAN_REPS
#define PROBE_SCAN_REPS 1
#endif
#ifndef PROBE_FFN1_REPS
#define PROBE_FFN1_REPS 1
#endif
#ifndef PH_MASK
#define PH_MASK 0xFFFFF
#endif
#define PHON(s) (PH_MASK & (1 << (s)))
#define PHASE_BEGIN(k) if (ph_hi > (k)) { if ((k) > 1) xcd_barrier(xb);
#define PHASE_END }

template <int L>
__device__ __forceinline__ void run_layer(const Params& p, int vbr, int ph_hi, unsigned char* smem_all, const XcdBarrier& xb) {
  unsigned char* smem = smem_all + SUBB * 73728;
  const int vb = vbr * 2 + SUBB;
  constexpr int l = L;
  constexpr int base = 1 + 10 * L;
  const float* modl = (const float*)(p.ws + OFF_MOD) + (size_t)l * 4 * 6144;
  PHASE_BEGIN(base + 0)
    for (int rep = 0; rep < PROBE_CONV_REPS; ++rep) {
      if (rep) xcd_barrier(xb);
      phase_convert(p, l, smem);
      phase_norm(l == 0 ? p.in[0] : p.out, p.in[4] + l * 1024, modl, 0, 1024, (u16*)(p.ws + OFF_H));
    }
  PHASE_END
  PHASE_BEGIN(base + 1)
    phase_gemm<0>(p, l, vb, smem);
  PHASE_END
  PHASE_BEGIN(base + 2)
    for (int rep = 0; rep < PROBE_PREP_REPS; ++rep) {
      if (rep) xcd_barrier(xb);
      for (int item = VBLK; item < 512; item += VGRID) rwkv_prep_item(p, l, item, smem);
    }
  PHASE_END
  PHASE_BEGIN(base + 3)
    if ((int)blockIdx.x < 64) {
      if (SUBB == 0) scan_item(p, blockIdx.x, smem);
      else { __syncthreads(); __syncthreads(); for (int c = 0; c < SEQ / 16; ++c) lds_barrier(); }
    }
    else {
      const int nb = VGRID - 128, bi = VBLK - 128;
      for (int item = bi; item < 512; item += nb) sg_item(p, l, item, smem);
      for (int item = (bi + 64) % nb; item < 1024; item += nb) s5a_item(p, l, item, smem);
      for (int item = bi; item < 2048; item += nb) conv_item(p, l, item);
      sub_barrier((unsigned*)(p.ws + OFF_BAR) + 3520 + 64 * (2 * l), gridDim.x - 64);
      for (int item = bi; item < 1024; item += nb) s5b_item(p, l, item, smem);
      sub_barrier((unsigned*)(p.ws + OFF_BAR) + 3520 + 64 * (2 * l + 1), gridDim.x - 64);
      for (int item = bi; item < 1024; item += nb) merge_tile<0>(p, item, smem);
    }
  PHASE_END
  PHASE_BEGIN(base + 4)
    for (int rep = 0; rep < PROBE_POST_REPS; ++rep) { if (rep) xcd_barrier(xb); for (int item = VBLK; item < 2048; item += VGRID) rwkv_post_item(p, l, item); }
  PHASE_END
  PHASE_BEGIN(base + 5)
    for (int item = vb; item < 1024; item += VGRID) {
      int it2 = item;
      if (VGRID == 512) { const int r = item >> 9, w = vb & 63; it2 = ((r * 4 + (w >> 4)) << 7) | ((vb >> 6) * 16 + (w & 15)); }
      merge_tile<1>(p, it2, smem);
    }
  PHASE_END
  PHASE_BEGIN(base + 6)
    phase_gemm_8w<1>(p, l, vbr, smem_all);
  PHASE_END
  PHASE_BEGIN(base + 7)
    if (PHON(7)) phase_norm(p.out, p.in[38] + l * 1024, modl, 3072, 4096, (u16*)(p.ws + OFF_H));
  PHASE_END
  PHASE_BEGIN(base + 8)
    phase_gemm_8w<2>(p, l, vbr, smem_all);
  PHASE_END
#ifdef PROBE_DUP_FFN1
  PHASE_BEGIN(base + 8)
    phase_gemm_8w<2>(p, l, vbr, smem_all);
  PHASE_END
#endif
  PHASE_BEGIN(base + 9)
    phase_gemm_8w<3>(p, l, vbr, smem_all);
  PHASE_END
}

__global__ void __launch_bounds__(512, 2) mega_fwd(Params p, int ph_lo, int ph_hi) {
  __shared__ __attribute__((aligned(16))) unsigned char smem[2 * 73728 + 16];
  cg::grid_group grid = cg::this_grid();
  if (ph_hi < 0) grid.sync();
  volatile LAS unsigned* st = (volatile LAS unsigned*)(smem + 2 * 73728);
  if (threadIdx.x == 0) { st[0] = 0u; st[1] = 0u; st[2] = 0u; st[3] = 0u; }
  __syncthreads();
  const XcdBarrier xb = xcd_barrier_post((unsigned*)(p.ws + OFF_BAR), st);
  if (ph_hi > 0) phase_mod(p, smem + SUBB * 73728);
  xcd_barrier(xb);
  const int vb = xcd_virtual_id(xb);
  run_layer<0>(p, vb, ph_hi, smem, xb);
  run_layer<1>(p, vb, ph_hi, smem, xb);
  PHASE_BEGIN(21)
    if (PHON(11)) phase_final(p.out, p.in[41]);
  PHASE_END
}

extern "C" void kernel_launch(void* const* d_in, const int* in_sizes, int n_in, void* d_out, int out_size, void* d_ws,
                              size_t ws_size, hipStream_t stream) {
  static int grid_blocks = 0;
  if (!grid_blocks) {
    int dev = 0, cus = 0, per_cu = 0;
    hipGetDevice(&dev);
    hipDeviceGetAttribute(&cus, hipDeviceAttributeMultiprocessorCount, dev);
    hipOccupancyMaxActiveBlocksPerMultiprocessor(&per_cu, mega_fwd, 512, 0);
    if (per_cu > 1) per_cu = 1;
    if (per_cu < 1) per_cu = 1;
    grid_blocks = cus * per_cu;
    if (ws_size < WS_END) fprintf(stderr, "workspace too small: %zu < %zu\n", ws_size, (size_t)WS_END);
  }
  Params p{};
  for (int i = 0; i < 42; ++i) p.in[i] = (const float*)d_in[i];
  p.out = (float*)d_out;
  p.ws = (unsigned char*)d_ws;
  hipMemsetAsync((unsigned char*)d_ws + OFF_BAR, 0, 16384, stream);
  int lo = 0, hi = N_PHASES;
  void* args[] = {&p, &lo, &hi};
  hipError_t e = hipLaunchCooperativeKernel((void*)mega_fwd, dim3(grid_blocks), dim3(512), args, 0, stream);
  if (e != hipSuccess) fprintf(stderr, "cooperative launch failed: %s (grid %d)\n", hipGetErrorString(e), grid_blocks);
}
```

```cpp
#include <hip/hip_runtime.h>
#include <hip/hip_cooperative_groups.h>
#include <cstdio>
namespace cg = cooperative_groups;

typedef unsigned short u16;
using bf16x8 = __attribute__((ext_vector_type(8))) short;
using f32x4 = __attribute__((ext_vector_type(4))) float;
using u32x4 = __attribute__((ext_vector_type(4))) unsigned int;
using u32x2 = __attribute__((ext_vector_type(2))) unsigned int;

#define T_TOK 16384
#define SEQ 4096
#define DM 1024
#define NTHR 256
#define TIDX ((int)(threadIdx.x & 255))
#define SUBB ((int)(threadIdx.x >> 8))
#define VBLK ((int)(blockIdx.x * 2 + (threadIdx.x >> 8)))
#define VGRID ((int)(gridDim.x * 2))

static constexpr size_t SZ_WIN = (size_t)6528 * 1024 * 2;
static constexpr size_t OFF_WIN = 0;
static constexpr size_t OFF_RO = OFF_WIN + SZ_WIN;
static constexpr size_t OFF_SO = OFF_RO + 1024 * 256 * 2;
static constexpr size_t OFF_CO = OFF_SO + 1024 * 256 * 2;
static constexpr size_t OFF_GLU = OFF_CO + 1024 * 256 * 2;
static constexpr size_t OFF_WO = OFF_GLU + 2048 * 256 * 2;
static constexpr size_t OFF_W1 = OFF_WO + 1024 * 1024 * 2;
static constexpr size_t OFF_W2 = OFF_W1 + (size_t)4096 * 1024 * 2;
static constexpr size_t OFF_H = OFF_W2 + (size_t)4096 * 1024 * 2;
static constexpr size_t SZ_T256B = (size_t)T_TOK * 256 * 2;
static constexpr size_t OFF_VF = OFF_H + (size_t)T_TOK * 1024 * 2;
static constexpr size_t OFF_PD = OFF_VF + SZ_T256B;
static constexpr size_t OFF_G = OFF_PD + SZ_T256B;
static constexpr size_t OFF_UB = OFF_G + SZ_T256B;
static constexpr size_t OFF_CB = OFF_UB + SZ_T256B;
static constexpr size_t OFF_SR = OFF_CB + SZ_T256B;
static constexpr size_t OFF_SK = OFF_SR + SZ_T256B;
static constexpr size_t OFF_SV = OFF_SK + SZ_T256B;
static constexpr size_t OFF_SKK = OFF_SV + SZ_T256B;
static constexpr size_t OFF_SA = OFF_SKK + SZ_T256B;
static constexpr size_t OFF_SW = OFF_SA + SZ_T256B;
static constexpr size_t OFF_PABC = OFF_SW + 2 * SZ_T256B;
static constexpr size_t OFF_YD = OFF_PABC;
static constexpr size_t OFF_OG = OFF_YD + SZ_T256B;
static constexpr size_t OFF_MRG = OFF_OG + SZ_T256B;
static constexpr size_t OFF_F = OFF_UB;
static constexpr size_t OFF_SMALL = OFF_PABC + (size_t)T_TOK * 2176 * 2;
static constexpr size_t OFF_MOD = OFF_SMALL;
static constexpr size_t OFF_S5AB = OFF_MOD + 2 * 4 * 6144 * 4;
static constexpr size_t OFF_S5BB = OFF_S5AB + 2 * 16 * 64 * 2 * 4;
static constexpr size_t OFF_S5E = OFF_S5BB + 2 * 16 * 64 * 32 * 4;
static constexpr size_t OFF_BAR = OFF_S5E + (size_t)4 * 64 * 16 * 64 * 2 * 4;
static constexpr size_t OFF_SGW = OFF_BAR + 16384;
static constexpr size_t OFF_O = OFF_SGW + 4 * 128 * 128 * 2;
static constexpr size_t OFF_LW2 = OFF_O + 2 * SZ_T256B;
static constexpr size_t OFF_LA2 = OFF_LW2 + 256 * 32 * 2;
static constexpr size_t OFF_LG2 = OFF_LA2 + 256 * 32 * 2;
static constexpr size_t OFF_LV2 = OFF_LG2 + 256 * 64 * 2;
static constexpr size_t OFF_LV1 = OFF_LV2 + 256 * 32 * 2;
static constexpr size_t WS_END = OFF_LV1 + 32 * 256 * 2;
static_assert(OFF_F + (size_t)T_TOK * 4096 * 2 <= OFF_SMALL, "F overlaps small region");
static_assert(OFF_MRG + (size_t)T_TOK * 1024 * 2 <= OFF_SMALL, "MRG overlaps");

struct Params {
  const float* in[42];
  float* out;
  unsigned char* ws;
};

__device__ __forceinline__ u16 f2bf(float f) {
  unsigned u = __float_as_uint(f);
  u += 0x7fffu + ((u >> 16) & 1u);
  return (u16)(u >> 16);
}
__device__ __forceinline__ float bf2f(u16 h) { return __uint_as_float(((unsigned)h) << 16); }
__device__ __forceinline__ float bflo(unsigned u) { return __uint_as_float(u << 16); }
__device__ __forceinline__ float bfhi(unsigned u) { return __uint_as_float(u & 0xffff0000u); }
__device__ __forceinline__ unsigned pack2(float a, float b) { return (unsigned)f2bf(a) | ((unsigned)f2bf(b) << 16); }
__device__ __forceinline__ float sigmoidf_(float x) { return 1.f / (1.f + __expf(-x)); }
__device__ __forceinline__ float tanhf_(float y) { return 1.f - 2.f / (1.f + __expf(2.f * y)); }
__device__ __forceinline__ float geluf_(float x) {
  float y = 0.7978845608028654f * (x + 0.044715f * x * x * x);
  return 0.5f * x * (1.f + tanhf_(y));
}
__device__ __forceinline__ float wave_sum(float v) {
#pragma unroll
  for (int o = 32; o > 0; o >>= 1) v += __shfl_xor(v, o, 64);
  return v;
}
template <int CTRL>
__device__ __forceinline__ float dppf(float x) {
  return __int_as_float(__builtin_amdgcn_update_dpp(__float_as_int(x), __float_as_int(x), CTRL, 0xF, 0xF, true));
}
__device__ __forceinline__ float row_sum16(float x) {
  x += dppf<0x128>(x);
  x += dppf<0x124>(x);
  x += dppf<0x122>(x);
  x += dppf<0x121>(x);
  return x;
}

__device__ __forceinline__ void phase_mod(const Params& p, unsigned char* smem) {
  const int tid = TIDX;
  float* cact = (float*)smem;
  float* red = cact + 4096;
  float* mod = (float*)(p.ws + OFF_MOD);
  for (int i = tid; i < 4096; i += NTHR) { float c = p.in[1][i]; cact[i] = c / (1.f + __expf(-c)); }
  __syncthreads();
  for (int item = VBLK; item < 192; item += VGRID) {
    int l = item / 96, nb = item % 96;
    int cl = tid & 63, kq = tid >> 6;
    int col = nb * 64 + cl;
    const float* W = p.in[2] + (size_t)l * 1024 * 6144;
    float a0 = 0, a1 = 0, a2 = 0, a3 = 0;
    for (int k = kq * 256; k < kq * 256 + 256; ++k) {
      float w = W[(size_t)k * 6144 + col];
      a0 += cact[k] * w; a1 += cact[1024 + k] * w; a2 += cact[2048 + k] * w; a3 += cact[3072 + k] * w;
    }
    red[(kq * 4 + 0) * 64 + cl] = a0; red[(kq * 4 + 1) * 64 + cl] = a1;
    red[(kq * 4 + 2) * 64 + cl] = a2; red[(kq * 4 + 3) * 64 + cl] = a3;
    __syncthreads();
    {
      int b = tid >> 6;
      float s = red[(0 * 4 + b) * 64 + cl] + red[(1 * 4 + b) * 64 + cl] + red[(2 * 4 + b) * 64 + cl] + red[(3 * 4 + b) * 64 + cl];
      mod[((size_t)l * 4 + b) * 6144 + col] = s + p.in[3][l * 6144 + col];
    }
    __syncthreads();
  }
  float* s5ab = (float*)(p.ws + OFF_S5AB);
  float* s5bb = (float*)(p.ws + OFF_S5BB);
  for (int idx = VBLK * NTHR + tid; idx < 2048; idx += VGRID * NTHR) {
    int l = idx >> 10, g = (idx >> 6) & 15, n = idx & 63;
    double lre = fmin((double)p.in[28][idx], -1e-4);
    double lim = (double)p.in[29][idx];
    double dt = exp((double)p.in[35][l * 16 + g]);
    double mag = exp(lre * dt);
    double abr = mag * cos(lim * dt), abi = mag * sin(lim * dt);
    double den = lre * lre + lim * lim;
    double qr = ((abr - 1.0) * lre + abi * lim) / den;
    double qi = (abi * lre - (abr - 1.0) * lim) / den;
    s5ab[idx * 2 + 0] = (float)abr; s5ab[idx * 2 + 1] = (float)abi;
    for (int c = 0; c < 16; ++c) {
      double br = p.in[30][(size_t)idx * 16 + c], bi = p.in[31][(size_t)idx * 16 + c];
      s5bb[(size_t)idx * 32 + c] = (float)(qr * br - qi * bi);
      s5bb[(size_t)idx * 32 + 16 + c] = (float)(qr * bi + qi * br);
    }
  }
}

__device__ __forceinline__ void convert_tile(const float* __restrict__ src, int K, int N, u16* __restrict__ dst, int tk, int tn, u16* sm) {
  const int tid = TIDX;
  int r = tid >> 4, c4 = (tid & 15) * 4;
#pragma unroll
  for (int i = 0; i < 4; ++i) {
    int kk = r + 16 * i;
    float4 v = *(const float4*)(src + (size_t)(tk * 64 + kk) * N + tn * 64 + c4);
    sm[(c4 + 0) * 72 + kk] = f2bf(v.x);
    sm[(c4 + 1) * 72 + kk] = f2bf(v.y);
    sm[(c4 + 2) * 72 + kk] = f2bf(v.z);
    sm[(c4 + 3) * 72 + kk] = f2bf(v.w);
  }
  __syncthreads();
#pragma unroll
  for (int j = 0; j < 2; ++j) {
    int n = (tid >> 3) + 32 * j, ch = tid & 7;
    u32x4 v = *(const u32x4*)(sm + n * 72 + ch * 8);
    *(u32x4*)(dst + (size_t)(tn * 64 + n) * K + tk * 64 + ch * 8) = v;
  }
  __syncthreads();
}

__device__ __forceinline__ void phase_convert(const Params& p, int l, unsigned char* smem) {
  u16* sm = (u16*)smem;
  const int total = 1632 + 192 + 128 + 256 + 1024 + 1024;
  for (int item = VBLK; item < total + 16 + 192; item += VGRID) {
    int t = item;
    if (t >= total + 16) {
      const int e = (t - total - 16) * 256 + TIDX;
      if (e < 8192) { const int n = e >> 5, k = e & 31; ((u16*)(p.ws + OFF_LW2))[e] = f2bf(p.in[8][(size_t)l * 8192 + k * 256 + n]); }
      else if (e < 16384) { const int q = e - 8192, n = q >> 5, k = q & 31; ((u16*)(p.ws + OFF_LA2))[q] = f2bf(p.in[10][(size_t)l * 8192 + k * 256 + n]); }
      else if (e < 32768) { const int q = e - 16384, n = q >> 6, k = q & 63; ((u16*)(p.ws + OFF_LG2))[q] = f2bf(p.in[11][(size_t)l * 16384 + k * 256 + n]); }
      else if (e < 40960) { const int q = e - 32768, n = q >> 5, k = q & 31; ((u16*)(p.ws + OFF_LV2))[q] = (l > 0) ? f2bf(p.in[14][k * 256 + n]) : (u16)0; }
      else { const int q = e - 40960, n = q >> 8, k = q & 255; ((u16*)(p.ws + OFF_LV1))[q] = (l > 0) ? f2bf(p.in[13][k * 32 + n]) : (u16)0; }
      continue;
    }
    if (t >= total) {
      const int idx = t - total, g = idx >> 2, rq = idx & 3;
      const int tr = rq * 32 + (TIDX >> 3), s0 = (TIDX & 7) * 16;
      const float* src = p.in[23] + (((size_t)l * 4 + g) * 128 + tr) * 128 + s0;
      u16* dst = (u16*)(p.ws + OFF_SGW) + ((size_t)g * 128 + tr) * 128 + s0;
      unsigned pk[8];
#pragma unroll
      for (int e = 0; e < 4; ++e) {
        f32x4 v = *(const f32x4*)(src + e * 4);
        const int sb = s0 + e * 4;
        pk[e * 2 + 0] = pack2(sb + 0 <= tr ? v.x : 0.f, sb + 1 <= tr ? v.y : 0.f);
        pk[e * 2 + 1] = pack2(sb + 2 <= tr ? v.z : 0.f, sb + 3 <= tr ? v.w : 0.f);
      }
      *(u32x4*)(dst) = u32x4{pk[0], pk[1], pk[2], pk[3]};
      *(u32x4*)(dst + 8) = u32x4{pk[4], pk[5], pk[6], pk[7]};
      continue;
    }
    const float* src; int K, N; size_t off;
    if (t < 1632) { src = p.in[5] + (size_t)l * 1024 * 6528; K = 1024; N = 6528; off = OFF_WIN; }
    else if ((t -= 1632) < 64) { src = p.in[20] + (size_t)l * 256 * 1024; K = 256; N = 1024; off = OFF_RO; }
    else if ((t -= 64) < 64) { src = p.in[25] + (size_t)l * 256 * 1024; K = 256; N = 1024; off = OFF_SO; }
    else if ((t -= 64) < 64) { src = p.in[27] + (size_t)l * 256 * 1024; K = 256; N = 1024; off = OFF_CO; }
    else if ((t -= 64) < 128) { src = p.in[36] + (size_t)l * 256 * 2048; K = 256; N = 2048; off = OFF_GLU; }
    else if ((t -= 128) < 256) { src = p.in[37] + (size_t)l * 1024 * 1024; K = 1024; N = 1024; off = OFF_WO; }
    else if ((t -= 256) < 1024) { src = p.in[39] + (size_t)l * 1024 * 4096; K = 1024; N = 4096; off = OFF_W1; }
    else { t -= 1024; src = p.in[40] + (size_t)l * 4096 * 1024; K = 4096; N = 1024; off = OFF_W2; }
    int ntn = N / 64;
    convert_tile(src, K, N, (u16*)(p.ws + off), t / ntn, t % ntn, sm);
  }
}

__device__ __forceinline__ void phase_norm(const float* __restrict__ X, const float* __restrict__ g, const float* __restrict__ modl,
                           int sh_off, int sc_off, u16* __restrict__ H) {
  const int lane = TIDX & 63, wv = TIDX >> 6;
  for (int item = VBLK; item < T_TOK / 4; item += VGRID) {
    int row = item * 4 + wv;
    int b = row >> 12;
    const float* xr = X + (size_t)row * 1024;
    float4 v[4];
    float ss = 0;
#pragma unroll
    for (int i = 0; i < 4; ++i) {
      v[i] = *(const float4*)(xr + lane * 4 + 256 * i);
      ss += v[i].x * v[i].x + v[i].y * v[i].y + v[i].z * v[i].z + v[i].w * v[i].w;
    }
    ss = wave_sum(ss);
    float rstd = rsqrtf(ss * (1.f / 1024.f) + 1e-6f);
    const float* sh = modl + (size_t)b * 6144 + sh_off;
    const float* sc = modl + (size_t)b * 6144 + sc_off;
#pragma unroll
    for (int i = 0; i < 4; ++i) {
      int c = lane * 4 + 256 * i;
      float4 gg = *(const float4*)(g + c);
      float4 s1 = *(const float4*)(sc + c);
      float4 s0 = *(const float4*)(sh + c);
      float h0 = v[i].x * rstd * gg.x * (1.f + s1.x) + s0.x;
      float h1 = v[i].y * rstd * gg.y * (1.f + s1.y) + s0.y;
      float h2 = v[i].z * rstd * gg.z * (1.f + s1.z) + s0.z;
      float h3 = v[i].w * rstd * gg.w * (1.f + s1.w) + s0.w;
      u32x2 o; o.x = pack2(h0, h1); o.y = pack2(h2, h3);
      *(u32x2*)(H + (size_t)row * 1024 + c) = o;
    }
  }
}

__device__ __forceinline__ void phase_final(float* __restrict__ X, const float* __restrict__ g) {
  const int lane = TIDX & 63, wv = TIDX >> 6;
  for (int item = VBLK; item < T_TOK / 4; item += VGRID) {
    int row = item * 4 + wv;
    float* xr = X + (size_t)row * 1024;
    float4 v[4];
    float ss = 0;
#pragma unroll
    for (int i = 0; i < 4; ++i) {
      v[i] = *(const float4*)(xr + lane * 4 + 256 * i);
      ss += v[i].x * v[i].x + v[i].y * v[i].y + v[i].z * v[i].z + v[i].w * v[i].w;
    }
    ss = wave_sum(ss);
    float rstd = rsqrtf(ss * (1.f / 1024.f) + 1e-6f);
#pragma unroll
    for (int i = 0; i < 4; ++i) {
      int c = lane * 4 + 256 * i;
      float4 gg = *(const float4*)(g + c);
      float4 o;
      o.x = v[i].x * rstd * gg.x; o.y = v[i].y * rstd * gg.y; o.z = v[i].z * rstd * gg.z; o.w = v[i].w * rstd * gg.w;
      *(float4*)(xr + c) = o;
    }
  }
}

template <int NF, bool LEAN = false>
__device__ __forceinline__ void gemm_mainloop(const u16* __restrict__ A, int lda, const u16* __restrict__ B, int ldb,
                                              int K, f32x4 (&acc)[4][NF], u16* smem) {
  constexpr int BN = 32 * NF;
  constexpr int NB = BN / 32;
  u16* sA = smem;
  u16* sB = smem + 2 * 128 * 64;
  int tz = 0;
  if (LEAN) asm volatile("" : "+v"(tz));
  const int tid = TIDX + tz, lane = tid & 63, wv = tid >> 6;
  const int wm = wv >> 1, wn = wv & 1;
  const int lrow = tid >> 3;
  const int lchs = (tid & 7) ^ ((lrow >> 1) & 7);
  const u16* Ap = A + (size_t)lrow * lda + lchs * 8;
  const u16* Bp = B + (size_t)lrow * ldb + lchs * 8;
  const int nk = K >> 6;
  auto stage = [&](int kt, int buf) {
    const int ko = kt << 6;
#pragma unroll
    for (int i = 0; i < 4; ++i)
      __builtin_amdgcn_global_load_lds((const unsigned*)(Ap + (size_t)(32 * i) * lda + ko),
                                       (__attribute__((address_space(3))) unsigned*)(sA + buf * (128 * 64) + (tid + 256 * i) * 8), 16, 0, 0);
#pragma unroll
    for (int i = 0; i < NB; ++i)
      __builtin_amdgcn_global_load_lds((const unsigned*)(Bp + (size_t)(32 * i) * ldb + ko),
                                       (__attribute__((address_space(3))) unsigned*)(sB + buf * (BN * 64) + (tid + 256 * i) * 8), 16, 0, 0);
  };
  __syncthreads();
  stage(0, 0);
  const int fr = lane & 15, fq = lane >> 4;
  const int sw = (fr >> 1) & 7;
  for (int kt = 0; kt < nk; ++kt) {
    const int cur = kt & 1;
    asm volatile("s_waitcnt vmcnt(0)" ::: "memory");
    __syncthreads();
    if (kt + 1 < nk) stage(kt + 1, cur ^ 1);
    const u16* cA = sA + cur * (128 * 64) + (wm * 64 + fr) * 64;
    const u16* cB = sB + cur * (BN * 64) + (wn * 16 * NF + fr) * 64;
#pragma unroll
    for (int ks = 0; ks < 2; ++ks) {
      if (LEAN) __builtin_amdgcn_sched_barrier(0);
      const int pc = ((fq + 4 * ks) ^ sw) << 3;
      bf16x8 fa[4], fb[NF];
#pragma unroll
      for (int i = 0; i < 4; ++i) fa[i] = *(const bf16x8*)(cA + i * 16 * 64 + pc);
#pragma unroll
      for (int j = 0; j < NF; ++j) fb[j] = *(const bf16x8*)(cB + j * 16 * 64 + pc);
#pragma unroll
      for (int i = 0; i < 4; ++i)
#pragma unroll
        for (int j = 0; j < NF; ++j)
          acc[i][j] = __builtin_amdgcn_mfma_f32_16x16x32_bf16(fb[j], fa[i], acc[i][j], 0, 0, 0);
    }
  }
}

template <int NF>
__device__ __forceinline__ void zero_acc(f32x4 (&acc)[4][NF]) {
#pragma unroll
  for (int i = 0; i < 4; ++i)
#pragma unroll
    for (int j = 0; j < NF; ++j) acc[i][j] = f32x4{0.f, 0.f, 0.f, 0.f};
}

__device__ __forceinline__ void gemm_mainloop_8w(const u16* __restrict__ A, int lda, const u16* __restrict__ B, int ldb,
                                                 int K, f32x4 (&acc)[8][4], u16* smem) {
  constexpr int STG = 32768;
  const int tid = threadIdx.x, lane = tid & 63, wv = tid >> 6;
  const int wm = wv >> 2, wn = wv & 3;
  const int lrow = tid >> 3;
  const int lchs = (tid & 7) ^ ((lrow >> 1) & 7);
  const u16* Ap = A + (size_t)lrow * lda + lchs * 8;
  const u16* Bp = B + (size_t)lrow * ldb + lchs * 8;
  const int nk = K >> 6;
  auto stage = [&](int kt, int buf) {
    const int ko = kt << 6;
    u16* sa = smem + buf * STG;
#pragma unroll
    for (int i = 0; i < 4; ++i)
      __builtin_amdgcn_global_load_lds((const unsigned*)(Ap + (size_t)(64 * i) * lda + ko),
                                       (__attribute__((address_space(3))) unsigned*)(sa + (tid + 512 * i) * 8), 16, 0, 0);
#pragma unroll
    for (int i = 0; i < 4; ++i)
      __builtin_amdgcn_global_load_lds((const unsigned*)(Bp + (size_t)(64 * i) * ldb + ko),
                                       (__attribute__((address_space(3))) unsigned*)(sa + 16384 + (tid + 512 * i) * 8), 16, 0, 0);
  };
  __syncthreads();
  stage(0, 0);
  const int fr = lane & 15, fq = lane >> 4;
  const int sw = (fr >> 1) & 7;
  for (int kt = 0; kt < nk; ++kt) {
    const int cur = kt & 1;
    asm volatile("s_waitcnt vmcnt(0)" ::: "memory");
    __syncthreads();
    if (kt + 1 < nk) stage(kt + 1, cur ^ 1);
    const u16* cA = smem + cur * STG + (wm * 128 + fr) * 64;
    const u16* cB = smem + cur * STG + 16384 + (wn * 64 + fr) * 64;
#pragma unroll
    for (int ks = 0; ks < 2; ++ks) {
      __builtin_amdgcn_sched_barrier(0);
      const int pc = ((fq + 4 * ks) ^ sw) << 3;
      bf16x8 fa[8], fb[4];
#pragma unroll
      for (int i = 0; i < 8; ++i) fa[i] = *(const bf16x8*)(cA + i * 16 * 64 + pc);
#pragma unroll
      for (int j = 0; j < 4; ++j) fb[j] = *(const bf16x8*)(cB + j * 16 * 64 + pc);
#pragma unroll
      for (int i = 0; i < 8; ++i)
#pragma unroll
        for (int j = 0; j < 4; ++j)
          acc[i][j] = __builtin_amdgcn_mfma_f32_16x16x32_bf16(fb[j], fa[i], acc[i][j], 0, 0, 0);
    }
  }
}

template <int EPI>
__device__ __forceinline__ void phase_gemm_8w(const Params& p, int l, int vb, unsigned char* smem_raw) {
  u16* smem = (u16*)smem_raw;
  const int lane = threadIdx.x & 63, wv = threadIdx.x >> 6;
  const int wm = wv >> 2, wn = wv & 3;
  const int fr = lane & 15, fq = lane >> 4;
  const u16* A; const u16* B; int lda, ldb, K, ntiles_n;
  if (EPI == 1) { A = (const u16*)(p.ws + OFF_MRG); lda = 1024; B = (const u16*)(p.ws + OFF_WO); ldb = 1024; K = 1024; ntiles_n = 4; }
  if (EPI == 2) { A = (const u16*)(p.ws + OFF_H); lda = 1024; B = (const u16*)(p.ws + OFF_W1); ldb = 1024; K = 1024; ntiles_n = 16; }
  if (EPI == 3) { A = (const u16*)(p.ws + OFF_F); lda = 4096; B = (const u16*)(p.ws + OFF_W2); ldb = 4096; K = 4096; ntiles_n = 4; }
  const float* modl = (const float*)(p.ws + OFF_MOD) + (size_t)l * 4 * 6144;
  const int total = 64 * ntiles_n;
  const int G = gridDim.x;
  const bool swz = (G == 256);
  for (int item = vb; item < total; item += G) {
    int mt = item & 63, nt = item >> 6;
    if (swz) { const int r = item >> 8, w = vb & 31; mt = (vb >> 5) * 8 + (w & 7); nt = r * 4 + (w >> 3); }
    const int m0 = mt * 256, n0 = nt * 256;
    f32x4 acc[8][4];
#pragma unroll
    for (int i = 0; i < 8; ++i)
#pragma unroll
      for (int j = 0; j < 4; ++j) acc[i][j] = f32x4{0.f, 0.f, 0.f, 0.f};
    gemm_mainloop_8w(A + (size_t)m0 * lda, lda, B + (size_t)n0 * ldb, ldb, K, acc, smem);
#pragma unroll
    for (int i = 0; i < 8; ++i) {
      const int m = m0 + wm * 128 + i * 16 + fr;
#pragma unroll
      for (int j = 0; j < 4; ++j) {
        const int n = n0 + wn * 64 + j * 16 + fq * 4;
        f32x4 v = acc[i][j];
        if (EPI == 1 || EPI == 3) {
          const int b = m >> 12;
          const float* gt = modl + (size_t)b * 6144 + (EPI == 1 ? 2048 : 5120) + n;
          const float* xin = ((EPI == 1 && l == 0) ? p.in[0] : p.out) + (size_t)m * 1024 + n;
          f32x4 x = *(const f32x4*)xin;
          f32x4 gg = *(const f32x4*)gt;
          *(f32x4*)(p.out + (size_t)m * 1024 + n) = x + gg * v;
        } else {
          float r0 = fmaxf(v[0], 0.f), r1 = fmaxf(v[1], 0.f), r2 = fmaxf(v[2], 0.f), r3 = fmaxf(v[3], 0.f);
          *(u32x2*)((u16*)(p.ws + OFF_F) + (size_t)m * 4096 + n) = u32x2{pack2(r0 * r0, r1 * r1), pack2(r2 * r2, r3 * r3)};
        }
      }
    }
  }
}

template <int EPI>
__device__ __forceinline__ void phase_gemm(const Params& p, int l, int vb, unsigned char* smem_raw) {
  u16* smem = (u16*)smem_raw;
  const int lane = TIDX & 63, wv = TIDX >> 6;
  const int wm = wv >> 1, wn = wv & 1;
  const int fr = lane & 15, fq = lane >> 4;
  const u16* A; const u16* B; int lda, ldb, K, ntiles_n;
  if (EPI == 0) { A = (const u16*)(p.ws + OFF_H); lda = 1024; B = (const u16*)(p.ws + OFF_WIN); ldb = 1024; K = 1024; ntiles_n = 19; }
  if (EPI == 1) { A = (const u16*)(p.ws + OFF_MRG); lda = 1024; B = (const u16*)(p.ws + OFF_WO); ldb = 1024; K = 1024; ntiles_n = 8; }
  if (EPI == 2) { A = (const u16*)(p.ws + OFF_H); lda = 1024; B = (const u16*)(p.ws + OFF_W1); ldb = 1024; K = 1024; ntiles_n = 32; }
  if (EPI == 3) { A = (const u16*)(p.ws + OFF_F); lda = 4096; B = (const u16*)(p.ws + OFF_W2); ldb = 4096; K = 4096; ntiles_n = 8; }
  const float* modl = (const float*)(p.ws + OFF_MOD) + (size_t)l * 4 * 6144;
  const int G = VGRID;
  const bool swz = (G == 512);
  const int total = swz ? 128 * ((ntiles_n + 3) & ~3) : 128 * ntiles_n;
  for (int item = vb; item < total; item += G) {
    int mt = item & 127, nt = item >> 7;
    if (swz) { const int r = item >> 9, w = vb & 63; mt = (vb >> 6) * 16 + (w & 15); nt = r * 4 + (w >> 4); if (nt >= ntiles_n) continue; }
    const int m0 = mt * 128, n0 = nt * 128;
    f32x4 acc[4][4];
    zero_acc<4>(acc);
    gemm_mainloop<4>(A + (size_t)m0 * lda, lda, B + (size_t)n0 * ldb, ldb, K, acc, smem);
#pragma unroll
    for (int i = 0; i < 4; ++i) {
      const int m = m0 + wm * 64 + i * 16 + fr;
#pragma unroll
      for (int j = 0; j < 4; ++j) {
        const int n = n0 + wn * 64 + j * 16 + fq * 4;
        f32x4 v = acc[i][j];
        if (EPI == 0) {
          u32x2 o; o.x = pack2(v[0], v[1]); o.y = pack2(v[2], v[3]);
          if (n < 2176) *(u32x2*)((u16*)(p.ws + OFF_PABC) + (size_t)m * 2176 + n) = o;
          else *(u32x2*)((u16*)(p.ws + OFF_PD) + (size_t)m * 256 + (n - 2176)) = o;
        } else if (EPI == 1 || EPI == 3) {
          const int b = m >> 12;
          const float* gt = modl + (size_t)b * 6144 + (EPI == 1 ? 2048 : 5120) + n;
          const float* xin = ((EPI == 1 && l == 0) ? p.in[0] : p.out) + (size_t)m * 1024 + n;
          float4 x = *(const float4*)xin;
          float4 gg = *(const float4*)gt;
          float4 o;
          o.x = x.x + gg.x * v[0]; o.y = x.y + gg.y * v[1]; o.z = x.z + gg.z * v[2]; o.w = x.w + gg.w * v[3];
          *(float4*)(p.out + (size_t)m * 1024 + n) = o;
        } else {
          float r0 = fmaxf(v[0], 0.f), r1 = fmaxf(v[1], 0.f), r2 = fmaxf(v[2], 0.f), r3 = fmaxf(v[3], 0.f);
          u32x2 o; o.x = pack2(r0 * r0, r1 * r1); o.y = pack2(r2 * r2, r3 * r3);
          *(u32x2*)((u16*)(p.ws + OFF_F) + (size_t)m * 4096 + n) = o;
        }
      }
    }
  }
}

template <int MODE>
__device__ __forceinline__ void merge_tile(const Params& p, int item, unsigned char* smem_raw) {
  u16* smem = (u16*)smem_raw;
  const int lane = TIDX & 63, wv = TIDX >> 6;
  const int wm = wv >> 1, wn = wv & 1;
  const int fr = lane & 15, fq = lane >> 4;
  const u16* H = (const u16*)(p.ws + OFF_H);
  const u16* WIN = (const u16*)(p.ws + OFF_WIN);
  const int mt = item & 127, nt = item >> 7;
  const int m0 = mt * 128, n0 = nt * 128;
  f32x4 bacc[4][4];
  u32x2 gpk[4][4];
  u16* MRG = (u16*)(p.ws + OFF_MRG);
#pragma unroll 1
  for (int br = (MODE == 0 ? 1 : 0); br < (MODE == 0 ? 4 : 1); ++br) {
    zero_acc<4>(bacc);
    gemm_mainloop<4, true>(H + (size_t)m0 * 1024, 1024, WIN + (size_t)(2432 + br * 1024 + n0) * 1024, 1024, 1024, bacc, smem);
#pragma unroll
    for (int i = 0; i < 4; ++i)
#pragma unroll
      for (int j = 0; j < 4; ++j)
        gpk[i][j] = u32x2{pack2(sigmoidf_(bacc[i][j][0]), sigmoidf_(bacc[i][j][1])), pack2(sigmoidf_(bacc[i][j][2]), sigmoidf_(bacc[i][j][3]))};
    const u16* Ab; const u16* Wb;
    if (br == 0) { Ab = (const u16*)(p.ws + OFF_OG); Wb = (const u16*)(p.ws + OFF_RO); }
    else if (br == 1) { Ab = (const u16*)(p.ws + OFF_UB); Wb = (const u16*)(p.ws + OFF_SO); }
    else if (br == 2) { Ab = (const u16*)(p.ws + OFF_CB); Wb = (const u16*)(p.ws + OFF_CO); }
    else { Ab = (const u16*)(p.ws + OFF_YD); Wb = (const u16*)(p.ws + OFF_GLU); }
    if (MODE == 0 && br == 3) {
      zero_acc<4>(bacc);
      gemm_mainloop<4, true>(Ab + (size_t)m0 * 256, 256, Wb + (size_t)(1024 + n0) * 256, 256, 256, bacc, smem);
#pragma unroll
      for (int i = 0; i < 4; ++i)
#pragma unroll
        for (int j = 0; j < 4; ++j) {
          const float g0 = bflo(gpk[i][j].x) * sigmoidf_(bacc[i][j][0]), g1 = bfhi(gpk[i][j].x) * sigmoidf_(bacc[i][j][1]);
          const float g2 = bflo(gpk[i][j].y) * sigmoidf_(bacc[i][j][2]), g3 = bfhi(gpk[i][j].y) * sigmoidf_(bacc[i][j][3]);
          gpk[i][j] = u32x2{pack2(g0, g1), pack2(g2, g3)};
        }
    }
    zero_acc<4>(bacc);
    gemm_mainloop<4, true>(Ab + (size_t)m0 * 256, 256, Wb + (size_t)n0 * 256, 256, 256, bacc, smem);
#pragma unroll
    for (int i = 0; i < 4; ++i)
#pragma unroll
      for (int j = 0; j < 4; ++j) {
        u32x2* mp = (u32x2*)(MRG + (size_t)(m0 + wm * 64 + i * 16 + fr) * 1024 + n0 + wn * 64 + j * 16 + fq * 4);
        u32x2 cm = u32x2{0u, 0u};
        if (MODE == 1 || br > 1) cm = *mp;
        const float v0 = bflo(cm.x) + bflo(gpk[i][j].x) * bacc[i][j][0];
        const float v1 = bfhi(cm.x) + bfhi(gpk[i][j].x) * bacc[i][j][1];
        const float v2 = bflo(cm.y) + bflo(gpk[i][j].y) * bacc[i][j][2];
        const float v3 = bfhi(cm.y) + bfhi(gpk[i][j].y) * bacc[i][j][3];
        *mp = u32x2{pack2(v0, v1), pack2(v2, v3)};
      }
  }
}

__device__ __forceinline__ float shifted(const u16* __restrict__ P, int tok, int col, float mu) {
  float pv = bf2f(P[(size_t)tok * 2176 + col]);
  float pr = (tok & (SEQ - 1)) ? bf2f(P[(size_t)(tok - 1) * 2176 + col]) : 0.f;
  return pv + (pr - pv) * mu;
}

__device__ __forceinline__ void rwkv_prep_item(const Params& p, int l, int item, unsigned char* smem) {
  const int tid = TIDX, lane = tid & 63, wv = tid >> 6;
  const int fr = lane & 15, fq = lane >> 4;
  u16* sl = (u16*)smem;
  u16* sv = sl + 32 * 168;
  constexpr int SLS = 168, SVS = 264;
  const u16* P = (const u16*)(p.ws + OFF_PABC);
  const float* mu = p.in[6] + l * 896;
  const int tok0 = item * 32;
  for (int idx = tid; idx < 32 * 128; idx += NTHR) {
    const int t = idx >> 7, ci = idx & 127;
    float v = shifted(P, tok0 + t, 768 + ci, mu[768 + ci]);
    if (ci < 32) v = tanhf_(v);
    else if (ci >= 64) v = sigmoidf_(v);
    sl[t * SLS + ci] = f2bf(v);
  }
  if (l > 0) {
    const int t = tid >> 3, c0 = (tid & 7) * 32;
    const int tok = tok0 + t;
    const bool hasp = (tok & (SEQ - 1)) != 0;
#pragma unroll
    for (int q = 0; q < 4; ++q) {
      const int c = c0 + q * 8;
      const u32x4 cur = *(const u32x4*)(P + (size_t)tok * 2176 + 512 + c);
      u32x4 prv = u32x4{0u, 0u, 0u, 0u};
      if (hasp) prv = *(const u32x4*)(P + (size_t)(tok - 1) * 2176 + 512 + c);
      const f32x4 m0 = *(const f32x4*)(mu + 512 + c), m1 = *(const f32x4*)(mu + 512 + c + 4);
      float o[8];
      o[0] = bflo(cur.x) + (bflo(prv.x) - bflo(cur.x)) * m0.x; o[1] = bfhi(cur.x) + (bfhi(prv.x) - bfhi(cur.x)) * m0.y;
      o[2] = bflo(cur.y) + (bflo(prv.y) - bflo(cur.y)) * m0.z; o[3] = bfhi(cur.y) + (bfhi(prv.y) - bfhi(cur.y)) * m0.w;
      o[4] = bflo(cur.z) + (bflo(prv.z) - bflo(cur.z)) * m1.x; o[5] = bfhi(cur.z) + (bfhi(prv.z) - bfhi(cur.z)) * m1.y;
      o[6] = bflo(cur.w) + (bflo(prv.w) - bflo(cur.w)) * m1.z; o[7] = bfhi(cur.w) + (bfhi(prv.w) - bfhi(cur.w)) * m1.w;
      *(u32x4*)(sv + t * SVS + c) = u32x4{pack2(o[0], o[1]), pack2(o[2], o[3]), pack2(o[4], o[5]), pack2(o[6], o[7])};
    }
  }
  __syncthreads();
  if (l > 0) {
    const int mf = wv >> 1, nf = wv & 1;
    const u16* v1t = (const u16*)(p.ws + OFF_LV1);
    f32x4 acc = f32x4{0.f, 0.f, 0.f, 0.f};
#pragma unroll
    for (int ks = 0; ks < 8; ++ks) {
      const bf16x8 fa = *(const bf16x8*)(sv + (mf * 16 + fr) * SVS + ks * 32 + fq * 8);
      const bf16x8 fb = *(const bf16x8*)(v1t + (size_t)(nf * 16 + fr) * 256 + ks * 32 + fq * 8);
      acc = __builtin_amdgcn_mfma_f32_16x16x32_bf16(fb, fa, acc, 0, 0, 0);
    }
    *(u32x2*)(sl + (mf * 16 + fr) * SLS + 128 + nf * 16 + fq * 4) = u32x2{pack2(acc[0], acc[1]), pack2(acc[2], acc[3])};
    __syncthreads();
  }
  const u16* w2t = (const u16*)(p.ws + OFF_LW2); const u16* a2t = (const u16*)(p.ws + OFF_LA2);
  const u16* g2t = (const u16*)(p.ws + OFF_LG2); const u16* v2t = (const u16*)(p.ws + OFF_LV2);
  u16* SR = (u16*)(p.ws + OFF_SR); u16* SK = (u16*)(p.ws + OFF_SK); u16* SV = (u16*)(p.ws + OFF_SV);
  u16* SKK = (u16*)(p.ws + OFF_SKK); u16* SA = (u16*)(p.ws + OFF_SA); float* SW = (float*)(p.ws + OFF_SW);
  u16* G = (u16*)(p.ws + OFF_G); u16* VF = (u16*)(p.ws + OFF_VF);
#pragma unroll 1
  for (int mf = 0; mf < 2; ++mf) {
    const u16* arow = sl + (mf * 16 + fr) * SLS + fq * 8;
    const bf16x8 aw = *(const bf16x8*)(arow), aa = *(const bf16x8*)(arow + 32);
    const bf16x8 ag0 = *(const bf16x8*)(arow + 64), ag1 = *(const bf16x8*)(arow + 96), av = *(const bf16x8*)(arow + 128);
    f32x4 cw[4], ca[4], cg[4], cv[4];
#pragma unroll
    for (int nf = 0; nf < 4; ++nf) {
      const int n = wv * 64 + nf * 16 + fr;
      const f32x4 z = f32x4{0.f, 0.f, 0.f, 0.f};
      cw[nf] = __builtin_amdgcn_mfma_f32_16x16x32_bf16(*(const bf16x8*)(w2t + n * 32 + fq * 8), aw, z, 0, 0, 0);
      ca[nf] = __builtin_amdgcn_mfma_f32_16x16x32_bf16(*(const bf16x8*)(a2t + n * 32 + fq * 8), aa, z, 0, 0, 0);
      cg[nf] = __builtin_amdgcn_mfma_f32_16x16x32_bf16(*(const bf16x8*)(g2t + n * 64 + fq * 8), ag0, z, 0, 0, 0);
      cg[nf] = __builtin_amdgcn_mfma_f32_16x16x32_bf16(*(const bf16x8*)(g2t + n * 64 + 32 + fq * 8), ag1, cg[nf], 0, 0, 0);
      cv[nf] = z;
      if (l > 0) cv[nf] = __builtin_amdgcn_mfma_f32_16x16x32_bf16(*(const bf16x8*)(v2t + n * 32 + fq * 8), av, z, 0, 0, 0);
    }
    const int tok = tok0 + mf * 16 + fr;
    const bool hasp = (tok & (SEQ - 1)) != 0;
    float kkv[4][4], kmv[4][4], av4[4][4];
    float ss = 0.f;
#pragma unroll
    for (int nf = 0; nf < 4; ++nf) {
      const int c = wv * 64 + nf * 16 + fq * 4;
      const size_t o = (size_t)tok * 256 + c;
      const u16* pc = P + (size_t)tok * 2176 + c;
      const u32x2 r_c = *(const u32x2*)(pc), k_c = *(const u32x2*)(pc + 256), v_c = *(const u32x2*)(pc + 512);
      u32x2 r_p = u32x2{0u, 0u}, k_p = u32x2{0u, 0u}, v_p = u32x2{0u, 0u};
      if (hasp) { r_p = *(const u32x2*)(pc - 2176); k_p = *(const u32x2*)(pc - 2176 + 256); v_p = *(const u32x2*)(pc - 2176 + 512); }
      const f32x4 mur = *(const f32x4*)(mu + c), muk = *(const f32x4*)(mu + 256 + c), muv = *(const f32x4*)(mu + 512 + c);
      const f32x4 w0 = *(const f32x4*)(p.in[7] + l * 256 + c), a0 = *(const f32x4*)(p.in[9] + l * 256 + c);
      const f32x4 kkc = *(const f32x4*)(p.in[15] + l * 256 + c), kac = *(const f32x4*)(p.in[16] + l * 256 + c);
      f32x4 v0 = f32x4{0.f, 0.f, 0.f, 0.f};
      if (l > 0) v0 = *(const f32x4*)(p.in[12] + c);
      u32x2 vfraw = u32x2{0u, 0u};
      if (l > 0) vfraw = *(const u32x2*)(VF + o);
      float rr[4], kk_[4], vv[4], dec[4], gg[4];
#pragma unroll
      for (int e = 0; e < 4; ++e) {
        const unsigned rc = e < 2 ? r_c.x : r_c.y, rp = e < 2 ? r_p.x : r_p.y;
        const unsigned kc = e < 2 ? k_c.x : k_c.y, kp = e < 2 ? k_p.x : k_p.y;
        const unsigned vc = e < 2 ? v_c.x : v_c.y, vp = e < 2 ? v_p.x : v_p.y;
        const unsigned vfr = e < 2 ? vfraw.x : vfraw.y;
        const float rcf = (e & 1) ? bfhi(rc) : bflo(rc), rpf = (e & 1) ? bfhi(rp) : bflo(rp);
        const float kcf = (e & 1) ? bfhi(kc) : bflo(kc), kpf = (e & 1) ? bfhi(kp) : bflo(kp);
        const float vcf = (e & 1) ? bfhi(vc) : bflo(vc), vpf = (e & 1) ? bfhi(vp) : bflo(vp);
        const float r = rcf + (rpf - rcf) * mur[e];
        const float k = kcf + (kpf - kcf) * muk[e];
        float v = vcf + (vpf - vcf) * muv[e];
        const float wl = w0[e] + cw[nf][e];
        const float z = -wl;
        const float sp = (z > 15.f) ? z : __logf(1.f + __expf(z));
        dec[e] = __expf(-__expf(-sp - 0.5f));
        const float a = sigmoidf_(a0[e] + ca[nf][e]);
        gg[e] = cg[nf][e];
        if (l > 0) { const float vf = (e & 1) ? bfhi(vfr) : bflo(vfr); v = v + (vf - v) * sigmoidf_(v0[e] + cv[nf][e]); }
        const float kk = k * kkc[e];
        ss += kk * kk;
        rr[e] = r; vv[e] = v; kk_[e] = kk; kkv[nf][e] = kk;
        kmv[nf][e] = k * (1.f + (a - 1.f) * kac[e]); av4[nf][e] = a;
      }
      *(u32x2*)(SR + o) = u32x2{pack2(rr[0], rr[1]), pack2(rr[2], rr[3])};
      *(u32x2*)(SV + o) = u32x2{pack2(vv[0], vv[1]), pack2(vv[2], vv[3])};
      if (l == 0) *(u32x2*)(VF + o) = u32x2{pack2(vv[0], vv[1]), pack2(vv[2], vv[3])};
      *(u32x2*)(G + o) = u32x2{pack2(gg[0], gg[1]), pack2(gg[2], gg[3])};
      *(f32x4*)(SW + o) = f32x4{dec[0], dec[1], dec[2], dec[3]};
    }
    ss += __shfl_xor(ss, 16, 64);
    ss += __shfl_xor(ss, 32, 64);
    const float inv = 1.f / fmaxf(sqrtf(ss), 1e-12f);
#pragma unroll
    for (int nf = 0; nf < 4; ++nf) {
      const size_t o = (size_t)tok * 256 + wv * 64 + nf * 16 + fq * 4;
      *(u32x2*)(SKK + o) = u32x2{pack2(kkv[nf][0] * inv, kkv[nf][1] * inv), pack2(kkv[nf][2] * inv, kkv[nf][3] * inv)};
      *(u32x2*)(SK + o) = u32x2{pack2(kmv[nf][0], kmv[nf][1]), pack2(kmv[nf][2], kmv[nf][3])};
      *(u32x2*)(SA + o) = u32x2{pack2(av4[nf][0], av4[nf][1]), pack2(av4[nf][2], av4[nf][3])};
    }
  }
  __syncthreads();
}

__device__ __forceinline__ void sg_item(const Params& p, int l, int item, unsigned char* smem) {
  const int tid = TIDX, lane = tid & 63, wv = tid >> 6;
  u16* vsT = (u16*)smem;
  float* smu = (float*)(smem + 16384);
  float* srs = smu + 128;
  const u16* P = (const u16*)(p.ws + OFF_PABC);
  const int g = item & 3, chn = item >> 2;
  const int tok0 = chn * 128;
  {
    const int t = tid >> 1, hf = tid & 1;
    const u16* src = P + (size_t)(tok0 + t) * 2176 + 896 + 256 + hf * 128;
    float sm = 0.f, ss = 0.f;
#pragma unroll 4
    for (int i = 0; i < 16; ++i) {
      u32x4 raw = *(const u32x4*)(src + i * 8);
      float z;
      z = geluf_(bflo(raw.x)); sm += z; ss += z * z;  z = geluf_(bfhi(raw.x)); sm += z; ss += z * z;
      z = geluf_(bflo(raw.y)); sm += z; ss += z * z;  z = geluf_(bfhi(raw.y)); sm += z; ss += z * z;
      z = geluf_(bflo(raw.z)); sm += z; ss += z * z;  z = geluf_(bfhi(raw.z)); sm += z; ss += z * z;
      z = geluf_(bflo(raw.w)); sm += z; ss += z * z;  z = geluf_(bfhi(raw.w)); sm += z; ss += z * z;
    }
    sm += __shfl_xor(sm, 1, 64); ss += __shfl_xor(ss, 1, 64);
    const float mean = sm * (1.f / 256.f);
    const float var = fmaxf(ss * (1.f / 256.f) - mean * mean, 0.f);
    if (hf == 0) { smu[t] = mean; srs[t] = rsqrtf(var + 1e-5f); }
  }
  __syncthreads();
  {
    const int c = tid & 63, tb = tid >> 6;
    const float lw = p.in[21][l * 256 + g * 64 + c], lb = p.in[22][l * 256 + g * 64 + c];
#pragma unroll
    for (int j = 0; j < 4; ++j) {
      u16 raw[8];
#pragma unroll
      for (int e = 0; e < 8; ++e) raw[e] = P[(size_t)(tok0 + tb * 32 + j * 8 + e) * 2176 + 896 + 256 + g * 64 + c];
      float vv[8];
#pragma unroll
      for (int e = 0; e < 8; ++e) {
        const int t = tb * 32 + j * 8 + e;
        vv[e] = (geluf_(bf2f(raw[e])) - smu[t]) * srs[t] * lw + lb;
      }
      const int phys = (tb * 4 + j) ^ (c & 15);
      *(u32x4*)(vsT + c * 128 + phys * 8) = u32x4{pack2(vv[0], vv[1]), pack2(vv[2], vv[3]), pack2(vv[4], vv[5]), pack2(vv[6], vv[7])};
    }
  }
  __syncthreads();
  {
    const int fr = lane & 15, fq = lane >> 4;
    const u16* Wm = (const u16*)(p.ws + OFF_SGW) + (size_t)g * 128 * 128;
    f32x4 acc[2][4];
#pragma unroll
    for (int i = 0; i < 2; ++i)
#pragma unroll
      for (int j = 0; j < 4; ++j) acc[i][j] = f32x4{0.f, 0.f, 0.f, 0.f};
    for (int ks = 0; ks <= wv; ++ks) {
      bf16x8 fa[2], fb[4];
#pragma unroll
      for (int i = 0; i < 2; ++i) fa[i] = *(const bf16x8*)(Wm + (size_t)(32 * wv + 16 * i + fr) * 128 + ks * 32 + fq * 8);
#pragma unroll
      for (int j = 0; j < 4; ++j) fb[j] = *(const bf16x8*)(vsT + (j * 16 + fr) * 128 + (((ks * 4 + fq) ^ fr) << 3));
#pragma unroll
      for (int i = 0; i < 2; ++i)
#pragma unroll
        for (int j = 0; j < 4; ++j) acc[i][j] = __builtin_amdgcn_mfma_f32_16x16x32_bf16(fb[j], fa[i], acc[i][j], 0, 0, 0);
    }
    const float* bs = p.in[24] + ((size_t)l * 4 + g) * 128;
    u16* UB = (u16*)(p.ws + OFF_UB);
#pragma unroll
    for (int i = 0; i < 2; ++i) {
      const int t = 32 * wv + 16 * i + fr;
      const float bsv = bs[t];
#pragma unroll
      for (int j = 0; j < 4; ++j) {
        const int cc = j * 16 + fq * 4;
        u32x2 ur = *(const u32x2*)(P + (size_t)(tok0 + t) * 2176 + 896 + g * 64 + cc);
        float o0 = geluf_(bflo(ur.x)) * (acc[i][j][0] + bsv), o1 = geluf_(bfhi(ur.x)) * (acc[i][j][1] + bsv);
        float o2 = geluf_(bflo(ur.y)) * (acc[i][j][2] + bsv), o3 = geluf_(bfhi(ur.y)) * (acc[i][j][3] + bsv);
        *(u32x2*)(UB + (size_t)(tok0 + t) * 256 + g * 64 + cc) = u32x2{pack2(o0, o1), pack2(o2, o3)};
      }
    }
  }
  __syncthreads();
}

__device__ __forceinline__ void conv_item(const Params& p, int l, int item) {
  const int j = TIDX;
  const u16* P = (const u16*)(p.ws + OFF_PABC);
  u16* CB = (u16*)(p.ws + OFF_CB);
  const float c0 = p.in[26][(l * 3 + 0) * 256 + j], c1 = p.in[26][(l * 3 + 1) * 256 + j], c2 = p.in[26][(l * 3 + 2) * 256 + j];
  const int tok0 = item * 8;
  u16 rc[10], rx[10], rb[8];
  const bool first = (tok0 & (SEQ - 1)) == 0;
#pragma unroll
  for (int t = 0; t < 10; ++t) {
    const int tok = (first && t < 2) ? tok0 : tok0 + t - 2;
    const u16* q = P + (size_t)tok * 2176 + 1408;
    rc[t] = q[256 + j]; rx[t] = q[512 + j];
    if (t >= 2) rb[t - 2] = q[j];
  }
  float z[10];
#pragma unroll
  for (int t = 0; t < 10; ++t) z[t] = bf2f(rc[t]) * bf2f(rx[t]);
  if (first) { z[0] = 0.f; z[1] = 0.f; }
#pragma unroll
  for (int t = 0; t < 8; ++t) {
    float y = c0 * z[t] + c1 * z[t + 1] + c2 * z[t + 2];
    CB[(size_t)(tok0 + t) * 256 + j] = f2bf(bf2f(rb[t]) * y);
  }
}

__device__ __forceinline__ void s5_load_u(const u16* us, int t, int wv, float (&u)[16]) {
  const u32x4* q = (const u32x4*)(us + t * 64 + wv * 16);
  u32x4 a = q[0], b = q[1];
  u[0] = bflo(a.x); u[1] = bfhi(a.x); u[2] = bflo(a.y); u[3] = bfhi(a.y);
  u[4] = bflo(a.z); u[5] = bfhi(a.z); u[6] = bflo(a.w); u[7] = bfhi(a.w);
  u[8] = bflo(b.x); u[9] = bfhi(b.x); u[10] = bflo(b.y); u[11] = bfhi(b.y);
  u[12] = bflo(b.z); u[13] = bfhi(b.z); u[14] = bflo(b.w); u[15] = bfhi(b.w);
}
__device__ __forceinline__ void s5_stage_u(const u16* __restrict__ PD, int tok0, int gq, u16* us) {
#pragma unroll
  for (int i = 0; i < 2; ++i) {
    const int ch = TIDX + 256 * i;
    const int t = ch >> 3, part = ch & 7;
    *(u32x4*)(us + t * 64 + part * 8) = *(const u32x4*)(PD + (size_t)(tok0 + t) * 256 + gq * 64 + part * 8);
  }
}

__device__ __forceinline__ void s5a_item(const Params& p, int l, int item, unsigned char* smem) {
  const int lane = TIDX & 63, wv = TIDX >> 6;
  const int gq = item & 3, bc = item >> 2;
  const int g = gq * 4 + wv;
  const int tok0 = bc * 64;
  const u16* PD = (const u16*)(p.ws + OFF_PD);
  const float* ab = (const float*)(p.ws + OFF_S5AB) + ((size_t)(l * 16 + g) * 64 + lane) * 2;
  const float* bb = (const float*)(p.ws + OFF_S5BB) + ((size_t)(l * 16 + g) * 64 + lane) * 32;
  float bbr[16], bbi[16];
#pragma unroll
  for (int c = 0; c < 16; ++c) { bbr[c] = bb[c]; bbi[c] = bb[16 + c]; }
  const float abr = ab[0], abi = ab[1];
  float xr = 0.f, xi = 0.f;
  u16* us = (u16*)smem;
  s5_stage_u(PD, tok0, gq, us);
  __syncthreads();
#pragma unroll 4
  for (int t = 0; t < 64; ++t) {
    float u[16];
    s5_load_u(us, t, wv, u);
    float bur = 0.f, bui = 0.f;
#pragma unroll
    for (int c = 0; c < 16; ++c) { bur += bbr[c] * u[c]; bui += bbi[c] * u[c]; }
    float nr = abr * xr - abi * xi + bur;
    float ni = abr * xi + abi * xr + bui;
    xr = nr; xi = ni;
  }
  float2* E = (float2*)(p.ws + OFF_S5E);
  E[((size_t)bc * 16 + g) * 64 + lane] = make_float2(xr, xi);
  __syncthreads();
}

__device__ __forceinline__ void s5b_item(const Params& p, int l, int item, unsigned char* smem) {
  const int lane = TIDX & 63, wv = TIDX >> 6;
  const int gq = item & 3, bc = item >> 2;
  const int b = bc >> 6, ch = bc & 63;
  const int g = gq * 4 + wv;
  const int tok0 = bc * 64;
  u16* us = (u16*)(smem + 65536);
  s5_stage_u((const u16*)(p.ws + OFF_PD), tok0, gq, us);
  float* base = (float*)smem + wv * 4096;
  float* csr = base, *csi = base + 1024, *xsr = base + 2048, *xsi = base + 3072;
  const u16* PD = (const u16*)(p.ws + OFF_PD);
  const float* ab = (const float*)(p.ws + OFF_S5AB) + ((size_t)(l * 16 + g) * 64 + lane) * 2;
  const float* bb = (const float*)(p.ws + OFF_S5BB) + ((size_t)(l * 16 + g) * 64 + lane) * 32;
  const float* cre = p.in[32] + ((size_t)(l * 16 + g) * 16) * 64;
  const float* cim = p.in[33] + ((size_t)(l * 16 + g) * 16) * 64;
  for (int c = 0; c < 16; ++c) {
    csr[(lane >> 2) * 64 + c * 4 + (lane & 3)] = cre[c * 64 + lane];
    csi[(lane >> 2) * 64 + c * 4 + (lane & 3)] = cim[c * 64 + lane];
  }
  float bbr[16], bbi[16];
#pragma unroll
  for (int c = 0; c < 16; ++c) { bbr[c] = bb[c]; bbi[c] = bb[16 + c]; }
  const float abr = ab[0], abi = ab[1];
  float pr = abr, pi = abi;
#pragma unroll
  for (int s = 0; s < 6; ++s) { float nr = pr * pr - pi * pi, ni = 2.f * pr * pi; pr = nr; pi = ni; }
  float xr = 0.f, xi = 0.f;
  const float2* E = (const float2*)(p.ws + OFF_S5E);
  for (int c = 0; c < ch; ++c) {
    float2 e = E[((size_t)(b * 64 + c) * 16 + g) * 64 + lane];
    float nr = pr * xr - pi * xi + e.x;
    float ni = pr * xi + pi * xr + e.y;
    xr = nr; xi = ni;
  }
  const int tt = lane & 15, cq = lane >> 4;
  const float* dvec = p.in[34] + l * 256 + g * 16 + cq * 4;
  const float d0 = dvec[0], d1 = dvec[1], d2 = dvec[2], d3 = dvec[3];
  u16* YD = (u16*)(p.ws + OFF_YD);
  const int n4w = lane >> 2, e4 = lane & 3;
  __syncthreads();
#pragma unroll 1
  for (int sc = 0; sc < 4; ++sc) {
    for (int t = 0; t < 16; ++t) {
      float u[16];
      s5_load_u(us, sc * 16 + t, wv, u);
      float bur = 0.f, bui = 0.f;
#pragma unroll
      for (int c = 0; c < 16; ++c) { bur += bbr[c] * u[c]; bui += bbi[c] * u[c]; }
      float nr = abr * xr - abi * xi + bur;
      float ni = abr * xi + abi * xr + bui;
      xr = nr; xi = ni;
      int a = n4w * 64 + ((t ^ (n4w & 7)) << 2) + e4;
      xsr[a] = xr; xsi[a] = xi;
    }
    __syncthreads();
    float acc0 = 0.f, acc1 = 0.f, acc2 = 0.f, acc3 = 0.f;
#pragma unroll 2
    for (int n4 = 0; n4 < 16; ++n4) {
      int xa = n4 * 64 + ((tt ^ (n4 & 7)) << 2);
      float4 xr4 = *(const float4*)(xsr + xa);
      float4 xi4 = *(const float4*)(xsi + xa);
      const float* cr = csr + n4 * 64 + cq * 16;
      const float* ci = csi + n4 * 64 + cq * 16;
      float4 r0 = *(const float4*)(cr), r1 = *(const float4*)(cr + 4), r2 = *(const float4*)(cr + 8), r3 = *(const float4*)(cr + 12);
      float4 i0 = *(const float4*)(ci), i1 = *(const float4*)(ci + 4), i2 = *(const float4*)(ci + 8), i3 = *(const float4*)(ci + 12);
      acc0 += r0.x * xr4.x + r0.y * xr4.y + r0.z * xr4.z + r0.w * xr4.w - (i0.x * xi4.x + i0.y * xi4.y + i0.z * xi4.z + i0.w * xi4.w);
      acc1 += r1.x * xr4.x + r1.y * xr4.y + r1.z * xr4.z + r1.w * xr4.w - (i1.x * xi4.x + i1.y * xi4.y + i1.z * xi4.z + i1.w * xi4.w);
      acc2 += r2.x * xr4.x + r2.y * xr4.y + r2.z * xr4.z + r2.w * xr4.w - (i2.x * xi4.x + i2.y * xi4.y + i2.z * xi4.z + i2.w * xi4.w);
      acc3 += r3.x * xr4.x + r3.y * xr4.y + r3.z * xr4.z + r3.w * xr4.w - (i3.x * xi4.x + i3.y * xi4.y + i3.z * xi4.z + i3.w * xi4.w);
    }
    {
      const int tok = tok0 + sc * 16 + tt;
      u32x2 ur = *(const u32x2*)(us + (sc * 16 + tt) * 64 + wv * 16 + cq * 4);
      float y0 = acc0 + d0 * bflo(ur.x), y1 = acc1 + d1 * bfhi(ur.x), y2 = acc2 + d2 * bflo(ur.y), y3 = acc3 + d3 * bfhi(ur.y);
      u32x2 o; o.x = pack2(geluf_(y0), geluf_(y1)); o.y = pack2(geluf_(y2), geluf_(y3));
      *(u32x2*)(YD + (size_t)tok * 256 + g * 16 + cq * 4) = o;
    }
    __syncthreads();
  }
}

__device__ __forceinline__ void lds_barrier() {
  asm volatile("s_waitcnt lgkmcnt(0)" ::: "memory");
  __builtin_amdgcn_s_barrier();
  asm volatile("" ::: "memory");
}
using f32x2 = __attribute__((ext_vector_type(2))) float;
__device__ __forceinline__ void scan_item(const Params& p, int item, unsigned char* smem) {
  const int tid = TIDX, lane = tid & 63, wv = tid >> 6;
  const int b = item >> 4, h = (item >> 2) & 3, q = item & 3;
  const int rl = lane >> 4, cl = lane & 15;
  const int rloc = wv * 4 + rl;
  const size_t tokb = (size_t)b * SEQ;
  const int chan0 = h * 64;
  const u16* SR = (const u16*)(p.ws + OFF_SR); const u16* SK = (const u16*)(p.ws + OFF_SK);
  const u16* SV = (const u16*)(p.ws + OFF_SV); const u16* SKK = (const u16*)(p.ws + OFF_SKK);
  const u16* SA = (const u16*)(p.ws + OFF_SA); const float* SW = (const float*)(p.ws + OFF_SW);
  float* O = (float*)(p.ws + OFF_O);
  constexpr int BUFF = 5376;
  float* lbase = (float*)smem;
  float* pp = lbase + 2 * BUFF + wv * 1024;
  const int st = tid >> 4, cg4 = tid & 15;
  struct Stg { u32x2 r, k, kk, a; f32x4 w; u16 v; };
  auto gload = [&](Stg& g, int c) {
    const size_t o = (tokb + (size_t)c * 16 + st) * 256 + chan0;
    g.r = *(const u32x2*)(SR + o + cg4 * 4); g.k = *(const u32x2*)(SK + o + cg4 * 4);
    g.kk = *(const u32x2*)(SKK + o + cg4 * 4); g.a = *(const u32x2*)(SA + o + cg4 * 4);
    g.w = *(const f32x4*)(SW + o + cg4 * 4);
    g.v = SV[o + q * 16 + cg4];
  };
  auto lwrite = [&](const Stg& g, int buf) {
    float* bp = lbase + buf * BUFF;
    const int o = st * 64 + cg4 * 4;
    f32x4 kk = {bflo(g.kk.x), bfhi(g.kk.x), bflo(g.kk.y), bfhi(g.kk.y)};
    f32x4 a = {bflo(g.a.x), bfhi(g.a.x), bflo(g.a.y), bfhi(g.a.y)};
    f32x4 k = {bflo(g.k.x), bfhi(g.k.x), bflo(g.k.y), bfhi(g.k.y)};
    f32x4 r = {bflo(g.r.x), bfhi(g.r.x), bflo(g.r.y), bfhi(g.r.y)};
    *(f32x4*)(bp + o) = kk;
    *(f32x4*)(bp + 1024 + o) = kk * a;
    *(f32x4*)(bp + 2048 + o) = k;
    *(f32x4*)(bp + 3072 + o) = g.w;
    *(f32x4*)(bp + 4096 + o) = r;
    bp[5120 + st * 16 + cg4] = bf2f(g.v);
  };
  constexpr int NCH = SEQ / 16;
  Stg R0, R1, R2, R3;
  gload(R0, 0); gload(R1, 1); gload(R2, 2); gload(R3, 3);
  __syncthreads();
  lwrite(R0, 0);
  __syncthreads();
  __builtin_amdgcn_s_setprio(3);
  float S0 = 0.f, S1 = 0.f, S2 = 0.f, S3 = 0.f;
  const int rrow = lane & 3, rstep = lane >> 2;
  struct Ops { f32x4 kk, bb, k4, w4, r4; float v; };
  auto chunk = [&](int c) {
    const float* bp = lbase + (c & 1) * BUFF;
    auto ldops = [&](Ops& o, int s) {
      o.kk = *(const f32x4*)(bp + s * 64 + cl * 4);
      o.bb = *(const f32x4*)(bp + 1024 + s * 64 + cl * 4);
      o.k4 = *(const f32x4*)(bp + 2048 + s * 64 + cl * 4);
      o.w4 = *(const f32x4*)(bp + 3072 + s * 64 + cl * 4);
      o.r4 = *(const f32x4*)(bp + 4096 + s * 64 + cl * 4);
      o.v = bp[5120 + s * 16 + rloc];
    };
    auto step = [&](const Ops& o, int s) {
      const float sa = row_sum16(__builtin_fmaf(S3, o.kk.w, __builtin_fmaf(S2, o.kk.z, __builtin_fmaf(S1, o.kk.y, S0 * o.kk.x))));
      S0 = __builtin_fmaf(S0, o.w4.x, __builtin_fmaf(o.v, o.k4.x, -(sa * o.bb.x)));
      S1 = __builtin_fmaf(S1, o.w4.y, __builtin_fmaf(o.v, o.k4.y, -(sa * o.bb.y)));
      S2 = __builtin_fmaf(S2, o.w4.z, __builtin_fmaf(o.v, o.k4.z, -(sa * o.bb.z)));
      S3 = __builtin_fmaf(S3, o.w4.w, __builtin_fmaf(o.v, o.k4.w, -(sa * o.bb.w)));
      pp[(s * 4 + rl) * 16 + cl] = __builtin_fmaf(S3, o.r4.w, __builtin_fmaf(S2, o.r4.z, __builtin_fmaf(S1, o.r4.y, S0 * o.r4.x)));
    };
    Ops a0, a1, b0, b1;
    ldops(a0, 0); ldops(a1, 1);
#pragma unroll
    for (int j = 0; j < 4; ++j) {
      ldops(b0, 4 * j + 2); ldops(b1, 4 * j + 3);
      __builtin_amdgcn_sched_barrier(0);
      step(a0, 4 * j); step(a1, 4 * j + 1);
      __builtin_amdgcn_sched_barrier(0);
      if (j < 3) { ldops(a0, 4 * j + 4); ldops(a1, 4 * j + 5); }
      __builtin_amdgcn_sched_barrier(0);
      step(b0, 4 * j + 2); step(b1, 4 * j + 3);
      __builtin_amdgcn_sched_barrier(0);
    }
    asm volatile("" ::: "memory");
    {
      const float* q0 = pp + (rstep * 4 + rrow) * 16;
      f32x4 a0 = *(const f32x4*)(q0), a1 = *(const f32x4*)(q0 + 4), a2 = *(const f32x4*)(q0 + 8), a3 = *(const f32x4*)(q0 + 12);
      f32x4 sm4 = (a0 + a1) + (a2 + a3);
      O[(tokb + (size_t)c * 16 + rstep) * 256 + chan0 + q * 16 + wv * 4 + rrow] = (sm4.x + sm4.y) + (sm4.z + sm4.w);
    }
    asm volatile("" ::: "memory");
  };
#pragma unroll 1
  for (int g = 0; g < NCH / 4; ++g) {
    const int c0 = g * 4;
    if (c0 + 4 < NCH) gload(R0, c0 + 4);
    chunk(c0);
    lwrite(R1, (c0 + 1) & 1);
    lds_barrier();
    if (c0 + 5 < NCH) gload(R1, c0 + 5);
    chunk(c0 + 1);
    lwrite(R2, (c0 + 2) & 1);
    lds_barrier();
    if (c0 + 6 < NCH) gload(R2, c0 + 6);
    chunk(c0 + 2);
    lwrite(R3, (c0 + 3) & 1);
    lds_barrier();
    if (c0 + 7 < NCH) gload(R3, c0 + 7);
    chunk(c0 + 3);
    if (c0 + 4 < NCH) lwrite(R0, (c0 + 4) & 1);
    lds_barrier();
  }
  __builtin_amdgcn_s_setprio(0);
}

__device__ __forceinline__ void rwkv_post_item(const Params& p, int l, int item) {
  const int j = TIDX;
  const float* O = (const float*)(p.ws + OFF_O);
  const u16* SR = (const u16*)(p.ws + OFF_SR); const u16* SK = (const u16*)(p.ws + OFF_SK);
  const u16* SV = (const u16*)(p.ws + OFF_SV); const u16* G = (const u16*)(p.ws + OFF_G);
  u16* OG = (u16*)(p.ws + OFF_OG);
  const float lw = p.in[18][l * 256 + j], lb = p.in[19][l * 256 + j], rk = p.in[17][l * 256 + j];
  const int tok0 = item * 8;
  float ov[8]; u16 rr[8], rkk[8], rv[8], rg[8];
#pragma unroll
  for (int t = 0; t < 8; ++t) {
    const size_t o = (size_t)(tok0 + t) * 256 + j;
    ov[t] = O[o]; rr[t] = SR[o]; rkk[t] = SK[o]; rv[t] = SV[o]; rg[t] = G[o];
  }
#pragma unroll
  for (int t = 0; t < 8; ++t) {
    const size_t o = (size_t)(tok0 + t) * 256 + j;
    float mean = wave_sum(ov[t]) * (1.f / 64.f);
    float d = ov[t] - mean;
    float var = wave_sum(d * d) * (1.f / 64.f);
    float on = d * rsqrtf(var + 64e-5f) * lw + lb;
    float bonus = wave_sum(bf2f(rr[t]) * bf2f(rkk[t]) * rk);
    OG[o] = f2bf((on + bonus * bf2f(rv[t])) * bf2f(rg[t]));
  }
}

#define XB_TMO      128
#define XB_XCNT(j)  (256  + 64 * (j))
#define XB_XSUB(j)  (1280 + 64 * (j))
#define XB_XGEN(j)  (2304 + 64 * (j))
#define XB_TOP      3328
#define XB_TOPGEN   3392
#define XCD_BAR_WORDS 3456
#define XB_SPIN_CAP (1u << 22)
#define LAS __attribute__((address_space(3)))
__device__ __forceinline__ unsigned xb_ld(unsigned* p) { return __hip_atomic_load(p, __ATOMIC_RELAXED, __HIP_MEMORY_SCOPE_AGENT); }
__device__ __forceinline__ unsigned xb_add(unsigned* p, unsigned v) { return __hip_atomic_fetch_add(p, v, __ATOMIC_RELAXED, __HIP_MEMORY_SCOPE_AGENT); }
__device__ __forceinline__ unsigned xb_xcc_id() { return (unsigned)__builtin_amdgcn_s_getreg((3 << 11) | 20) & 0xFu; }
#define XB_SPIN(cond, bar) do { unsigned _sp = 0; while (cond) { __builtin_amdgcn_s_sleep(1); \
    if ((++_sp & 255u) == 0u) { if (xb_ld(&(bar)[XB_TMO])) break; if (_sp > XB_SPIN_CAP) { atomicAdd(&(bar)[XB_TMO], 1u); break; } } } } while (0)
struct XcdBarrier { unsigned* bar; unsigned x; volatile LAS unsigned* st; };
__device__ __forceinline__ XcdBarrier xcd_barrier_post(unsigned* bar, volatile LAS unsigned* st) {
  XcdBarrier b; b.bar = bar; b.x = xb_xcc_id(); b.st = st;
  if (threadIdx.x == 0) st[2] = xb_add(&bar[XB_XCNT(b.x)], 1u);
  return b;
}
__device__ __forceinline__ void xcd_barrier_complete(unsigned* bar, unsigned x, unsigned& nloc, unsigned& nx) {
  const unsigned G = gridDim.x * gridDim.y * gridDim.z;
  unsigned sum, cnt, mine, sp = 0u;
  for (;;) {
    sum = 0u; cnt = 0u; mine = 0u;
#pragma unroll
    for (unsigned j = 0; j < 16; ++j) { const unsigned c = xb_ld(&bar[XB_XCNT(j)]); sum += c; cnt += (c > 0u) ? 1u : 0u; mine = (j == x) ? c : mine; }
    if (sum == G) break;
    __builtin_amdgcn_s_sleep(1);
    if ((++sp & 255u) == 0u) { if (xb_ld(&bar[XB_TMO])) break; if (sp > XB_SPIN_CAP) { atomicAdd(&bar[XB_TMO], 1u); break; } }
  }
  nloc = mine > 0u ? mine : 1u; nx = cnt > 0u ? cnt : 1u;
}
__device__ __forceinline__ void xcd_barrier(const XcdBarrier& b) {
  asm volatile("s_waitcnt vmcnt(0)" ::: "memory");
  __syncthreads();
  if (threadIdx.x == 0) {
    unsigned* bar = b.bar;
    __builtin_amdgcn_s_waitcnt(0);
    unsigned nloc = b.st[0], nx = b.st[1];
    if (nloc == 0u) { xcd_barrier_complete(bar, b.x, nloc, nx); b.st[0] = nloc; b.st[1] = nx; }
    const unsigned old = xb_add(&bar[XB_XSUB(b.x)], 1u);
    const unsigned gen = old / nloc;
    if (old + 1u == (gen + 1u) * nloc) {
      __builtin_amdgcn_fence(__ATOMIC_RELEASE, "agent");
      asm volatile("s_waitcnt vmcnt(0)" ::: "memory");
      const unsigned og = xb_add(&bar[XB_TOP], 1u);
      const unsigned tg = og / nx;
      if (og + 1u == (tg + 1u) * nx) xb_add(&bar[XB_TOPGEN], 1u);
      else XB_SPIN(xb_ld(&bar[XB_TOPGEN]) == tg, bar);
      __builtin_amdgcn_fence(__ATOMIC_ACQUIRE, "agent");
      xb_add(&bar[XB_XGEN(b.x)], 1u);
      asm volatile("s_waitcnt vmcnt(0)" ::: "memory");
    } else {
      XB_SPIN(xb_ld(&bar[XB_XGEN(b.x)]) == gen, bar);
      __builtin_amdgcn_fence(__ATOMIC_ACQUIRE, "agent");
      asm volatile("s_waitcnt vmcnt(0)" ::: "memory");
    }
  }
  __syncthreads();
}

__device__ __forceinline__ int xcd_virtual_id(const XcdBarrier& b) {
  if (threadIdx.x == 0) {
    unsigned base = 0u;
#pragma unroll
    for (unsigned j = 0; j < 16; ++j) { const unsigned c = xb_ld(&b.bar[XB_XCNT(j)]); base += (j < b.x) ? c : 0u; }
    b.st[3] = base + b.st[2];
  }
  __syncthreads();
  const int vb = __builtin_amdgcn_readfirstlane((int)b.st[3]);
  __syncthreads();
  return vb;
}

__device__ __forceinline__ void sub_barrier(unsigned* cnt, unsigned target) {
  asm volatile("s_waitcnt vmcnt(0)" ::: "memory");
  __syncthreads();
  if (threadIdx.x == 0) {
    __builtin_amdgcn_fence(__ATOMIC_RELEASE, "agent");
    asm volatile("s_waitcnt vmcnt(0)" ::: "memory");
    xb_add(cnt, 1u);
    unsigned sp = 0;
    while (xb_ld(cnt) < target) { __builtin_amdgcn_s_sleep(2); if (++sp > (1u << 24)) break; }
    __builtin_amdgcn_fence(__ATOMIC_ACQUIRE, "agent");
    asm volatile("s_waitcnt vmcnt(0)" ::: "memory");
  }
  __syncthreads();
}

#define N_PHASES 22
#ifndef PROBE_CONV_REPS
#define PROBE_CONV_REPS 1
#endif
#ifndef PROBE_PREP_REPS
#define PROBE_PREP_REPS 1
#endif
#ifndef PROBE_POST_REPS
#define PROBE_POST_REPS 1
#endif
#ifndef PROBE_SCAN_REPS
#define PROBE_SCAN_REPS 1
#endif
#ifndef PROBE_FFN1_REPS
#define PROBE_FFN1_REPS 1
#endif
#ifndef PH_MASK
#define PH_MASK 0xFFFFF
#endif
#define PHON(s) (PH_MASK & (1 << (s)))
#define PHASE_BEGIN(k) if (ph_hi > (k)) { if ((k) > 1) xcd_barrier(xb);
#define PHASE_END }

template <int L>
__device__ __forceinline__ void run_layer(const Params& p, int vbr, int ph_hi, unsigned char* smem_all, const XcdBarrier& xb) {
  unsigned char* smem = smem_all + SUBB * 73728;
  const int vb = vbr * 2 + SUBB;
  constexpr int l = L;
  constexpr int base = 1 + 10 * L;
  const float* modl = (const float*)(p.ws + OFF_MOD) + (size_t)l * 4 * 6144;
  PHASE_BEGIN(base + 0)
    for (int rep = 0; rep < PROBE_CONV_REPS; ++rep) {
      if (rep) xcd_barrier(xb);
      phase_convert(p, l, smem);
      phase_norm(l == 0 ? p.in[0] : p.out, p.in[4] + l * 1024, modl, 0, 1024, (u16*)(p.ws + OFF_H));
    }
  PHASE_END
  PHASE_BEGIN(base + 1)
    phase_gemm<0>(p, l, vb, smem);
  PHASE_END
  PHASE_BEGIN(base + 2)
    for (int rep = 0; rep < PROBE_PREP_REPS; ++rep) {
      if (rep) xcd_barrier(xb);
      for (int item = VBLK; item < 512; item += VGRID) rwkv_prep_item(p, l, item, smem);
    }
  PHASE_END
  PHASE_BEGIN(base + 3)
    if ((int)blockIdx.x < 64) {
      if (SUBB == 0) scan_item(p, blockIdx.x, smem);
      else { __syncthreads(); __syncthreads(); for (int c = 0; c < SEQ / 16; ++c) lds_barrier(); }
    }
    else {
      const int nb = VGRID - 128, bi = VBLK - 128;
      for (int item = bi; item < 512; item += nb) sg_item(p, l, item, smem);
      for (int item = (bi + 64) % nb; item < 1024; item += nb) s5a_item(p, l, item, smem);
      for (int item = bi; item < 2048; item += nb) conv_item(p, l, item);
      sub_barrier((unsigned*)(p.ws + OFF_BAR) + 3520 + 64 * (2 * l), gridDim.x - 64);
      for (int item = bi; item < 1024; item += nb) s5b_item(p, l, item, smem);
      sub_barrier((unsigned*)(p.ws + OFF_BAR) + 3520 + 64 * (2 * l + 1), gridDim.x - 64);
      for (int item = bi; item < 1024; item += nb) merge_tile<0>(p, item, smem);
    }
  PHASE_END
  PHASE_BEGIN(base + 4)
    for (int rep = 0; rep < PROBE_POST_REPS; ++rep) { if (rep) xcd_barrier(xb); for (int item = VBLK; item < 2048; item += VGRID) rwkv_post_item(p, l, item); }
  PHASE_END
  PHASE_BEGIN(base + 5)
    for (int item = vb; item < 1024; item += VGRID) {
      int it2 = item;
      if (VGRID == 512) { const int r = item >> 9, w = vb & 63; it2 = ((r * 4 + (w >> 4)) << 7) | ((vb >> 6) * 16 + (w & 15)); }
      merge_tile<1>(p, it2, smem);
    }
  PHASE_END
  PHASE_BEGIN(base + 6)
    phase_gemm_8w<1>(p, l, vbr, smem_all);
  PHASE_END
  PHASE_BEGIN(base + 7)
    if (PHON(7)) phase_norm(p.out, p.in[38] + l * 1024, modl, 3072, 4096, (u16*)(p.ws + OFF_H));
  PHASE_END
  PHASE_BEGIN(base + 8)
    phase_gemm_8w<2>(p, l, vbr, smem_all);
  PHASE_END
#ifdef PROBE_DUP_FFN1
  PHASE_BEGIN(base + 8)
    phase_gemm_8w<2>(p, l, vbr, smem_all);
  PHASE_END
#endif
  PHASE_BEGIN(base + 9)
    phase_gemm_8w<3>(p, l, vbr, smem_all);
  PHASE_END
}

__global__ void __launch_bounds__(512, 2) mega_fwd(Params p, int ph_lo, int ph_hi) {
  __shared__ __attribute__((aligned(16))) unsigned char smem[2 * 73728 + 16];
  cg::grid_group grid = cg::this_grid();
  if (ph_hi < 0) grid.sync();
  volatile LAS unsigned* st = (volatile LAS unsigned*)(smem + 2 * 73728);
  if (threadIdx.x == 0) { st[0] = 0u; st[1] = 0u; st[2] = 0u; st[3] = 0u; }
  __syncthreads();
  const XcdBarrier xb = xcd_barrier_post((unsigned*)(p.ws + OFF_BAR), st);
  if (ph_hi > 0) phase_mod(p, smem + SUBB * 73728);
  xcd_barrier(xb);
  const int vb = xcd_virtual_id(xb);
  run_layer<0>(p, vb, ph_hi, smem, xb);
  run_layer<1>(p, vb, ph_hi, smem, xb);
  PHASE_BEGIN(21)
    if (PHON(11)) phase_final(p.out, p.in[41]);
  PHASE_END
}

extern "C" void kernel_launch(void* const* d_in, const int* in_sizes, int n_in, void* d_out, int out_size, void* d_ws,
                              size_t ws_size, hipStream_t stream) {
  static int grid_blocks = 0;
  if (!grid_blocks) {
    int dev = 0, cus = 0, per_cu = 0;
    hipGetDevice(&dev);
    hipDeviceGetAttribute(&cus, hipDeviceAttributeMultiprocessorCount, dev);
    hipOccupancyMaxActiveBlocksPerMultiprocessor(&per_cu, mega_fwd, 512, 0);
    if (per_cu > 1) per_cu = 1;
    if (per_cu < 1) per_cu = 1;
    grid_blocks = cus * per_cu;
    if (ws_size < WS_END) fprintf(stderr, "workspace too small: %zu < %zu\n", ws_size, (size_t)WS_END);
  }
  Params p{};
  for (int i = 0; i < 42; ++i) p.in[i] = (const float*)d_in[i];
  p.out = (float*)d_out;
  p.ws = (unsigned char*)d_ws;
  hipMemsetAsync((unsigned char*)d_ws + OFF_BAR, 0, 16384, stream);
  int lo = 0, hi = N_PHASES;
  void* args[] = {&p, &lo, &hi};
  hipError_t e = hipLaunchCooperativeKernel((void*)mega_fwd, dim3(grid_blocks), dim3(512), args, 0, stream);
  if (e != hipSuccess) fprintf(stderr, "cooperative launch failed: %s (grid %d)\n", hipGetErrorString(e), grid_blocks);
}
```

```cpp
#include <hip/hip_runtime.h>
#include <hip/hip_cooperative_groups.h>
#include <cstdio>
namespace cg = cooperative_groups;

typedef unsigned short u16;
using bf16x8 = __attribute__((ext_vector_type(8))) short;
using f32x4 = __attribute__((ext_vector_type(4))) float;
using u32x4 = __attribute__((ext_vector_type(4))) unsigned int;
using u32x2 = __attribute__((ext_vector_type(2))) unsigned int;

#define T_TOK 16384
#define SEQ 4096
#define DM 1024
#define NTHR 256
#define TIDX ((int)(threadIdx.x & 255))
#define SUBB ((int)(threadIdx.x >> 8))
#define VBLK ((int)(blockIdx.x * 2 + (threadIdx.x >> 8)))
#define VGRID ((int)(gridDim.x * 2))

static constexpr size_t SZ_WIN = (size_t)6528 * 1024 * 2;
static constexpr size_t OFF_WIN = 0;
static constexpr size_t OFF_RO = OFF_WIN + SZ_WIN;
static constexpr size_t OFF_SO = OFF_RO + 1024 * 256 * 2;
static constexpr size_t OFF_CO = OFF_SO + 1024 * 256 * 2;
static constexpr size_t OFF_GLU = OFF_CO + 1024 * 256 * 2;
static constexpr size_t OFF_WO = OFF_GLU + 2048 * 256 * 2;
static constexpr size_t OFF_W1 = OFF_WO + 1024 * 1024 * 2;
static constexpr size_t OFF_W2 = OFF_W1 + (size_t)4096 * 1024 * 2;
static constexpr size_t OFF_H = OFF_W2 + (size_t)4096 * 1024 * 2;
static constexpr size_t SZ_T256B = (size_t)T_TOK * 256 * 2;
static constexpr size_t OFF_VF = OFF_H + (size_t)T_TOK * 1024 * 2;
static constexpr size_t OFF_PD = OFF_VF + SZ_T256B;
static constexpr size_t OFF_G = OFF_PD + SZ_T256B;
static constexpr size_t OFF_UB = OFF_G + SZ_T256B;
static constexpr size_t OFF_CB = OFF_UB + SZ_T256B;
static constexpr size_t OFF_SR = OFF_CB + SZ_T256B;
static constexpr size_t OFF_SK = OFF_SR + SZ_T256B;
static constexpr size_t OFF_SV = OFF_SK + SZ_T256B;
static constexpr size_t OFF_SKK = OFF_SV + SZ_T256B;
static constexpr size_t OFF_SA = OFF_SKK + SZ_T256B;
static constexpr size_t OFF_SW = OFF_SA + SZ_T256B;
static constexpr size_t OFF_PABC = OFF_SW + 2 * SZ_T256B;
static constexpr size_t OFF_YD = OFF_PABC;
static constexpr size_t OFF_OG = OFF_YD + SZ_T256B;
static constexpr size_t OFF_MRG = OFF_OG + SZ_T256B;
static constexpr size_t OFF_F = OFF_UB;
static constexpr size_t OFF_SMALL = OFF_PABC + (size_t)T_TOK * 2176 * 2;
static constexpr size_t OFF_MOD = OFF_SMALL;
static constexpr size_t OFF_S5AB = OFF_MOD + 2 * 4 * 6144 * 4;
static constexpr size_t OFF_S5BB = OFF_S5AB + 2 * 16 * 64 * 2 * 4;
static constexpr size_t OFF_S5E = OFF_S5BB + 2 * 16 * 64 * 32 * 4;
static constexpr size_t OFF_BAR = OFF_S5E + (size_t)4 * 64 * 16 * 64 * 2 * 4;
static constexpr size_t OFF_SGW = OFF_BAR + 16384;
static constexpr size_t OFF_O = OFF_SGW + 4 * 128 * 128 * 2;
static constexpr size_t OFF_LW2 = OFF_O + 2 * SZ_T256B;
static constexpr size_t OFF_LA2 = OFF_LW2 + 256 * 32 * 2;
static constexpr size_t OFF_LG2 = OFF_LA2 + 256 * 32 * 2;
static constexpr size_t OFF_LV2 = OFF_LG2 + 256 * 64 * 2;
static constexpr size_t OFF_LV1 = OFF_LV2 + 256 * 32 * 2;
static constexpr size_t WS_END = OFF_LV1 + 32 * 256 * 2;
static_assert(OFF_F + (size_t)T_TOK * 4096 * 2 <= OFF_SMALL, "F overlaps small region");
static_assert(OFF_MRG + (size_t)T_TOK * 1024 * 2 <= OFF_SMALL, "MRG overlaps");

struct Params {
  const float* in[42];
  float* out;
  unsigned char* ws;
};

__device__ __forceinline__ u16 f2bf(float f) {
  unsigned u = __float_as_uint(f);
  u += 0x7fffu + ((u >> 16) & 1u);
  return (u16)(u >> 16);
}
__device__ __forceinline__ float bf2f(u16 h) { return __uint_as_float(((unsigned)h) << 16); }
__device__ __forceinline__ float bflo(unsigned u) { return __uint_as_float(u << 16); }
__device__ __forceinline__ float bfhi(unsigned u) { return __uint_as_float(u & 0xffff0000u); }
__device__ __forceinline__ unsigned pack2(float a, float b) { return (unsigned)f2bf(a) | ((unsigned)f2bf(b) << 16); }
__device__ __forceinline__ float sigmoidf_(float x) { return 1.f / (1.f + __expf(-x)); }
__device__ __forceinline__ float tanhf_(float y) { return 1.f - 2.f / (1.f + __expf(2.f * y)); }
__device__ __forceinline__ float geluf_(float x) {
  float y = 0.7978845608028654f * (x + 0.044715f * x * x * x);
  return 0.5f * x * (1.f + tanhf_(y));
}
__device__ __forceinline__ float wave_sum(float v) {
#pragma unroll
  for (int o = 32; o > 0; o >>= 1) v += __shfl_xor(v, o, 64);
  return v;
}
template <int CTRL>
__device__ __forceinline__ float dppf(float x) {
  return __int_as_float(__builtin_amdgcn_update_dpp(__float_as_int(x), __float_as_int(x), CTRL, 0xF, 0xF, true));
}
__device__ __forceinline__ float row_sum16(float x) {
  x += dppf<0x128>(x);
  x += dppf<0x124>(x);
  x += dppf<0x122>(x);
  x += dppf<0x121>(x);
  return x;
}

__device__ __forceinline__ void phase_mod(const Params& p, unsigned char* smem) {
  const int tid = TIDX;
  float* cact = (float*)smem;
  float* red = cact + 4096;
  float* mod = (float*)(p.ws + OFF_MOD);
  for (int i = tid; i < 4096; i += NTHR) { float c = p.in[1][i]; cact[i] = c / (1.f + __expf(-c)); }
  __syncthreads();
  for (int item = VBLK; item < 192; item += VGRID) {
    int l = item / 96, nb = item % 96;
    int cl = tid & 63, kq = tid >> 6;
    int col = nb * 64 + cl;
    const float* W = p.in[2] + (size_t)l * 1024 * 6144;
    float a0 = 0, a1 = 0, a2 = 0, a3 = 0;
    for (int k = kq * 256; k < kq * 256 + 256; ++k) {
      float w = W[(size_t)k * 6144 + col];
      a0 += cact[k] * w; a1 += cact[1024 + k] * w; a2 += cact[2048 + k] * w; a3 += cact[3072 + k] * w;
    }
    red[(kq * 4 + 0) * 64 + cl] = a0; red[(kq * 4 + 1) * 64 + cl] = a1;
    red[(kq * 4 + 2) * 64 + cl] = a2; red[(kq * 4 + 3) * 64 + cl] = a3;
    __syncthreads();
    {
      int b = tid >> 6;
      float s = red[(0 * 4 + b) * 64 + cl] + red[(1 * 4 + b) * 64 + cl] + red[(2 * 4 + b) * 64 + cl] + red[(3 * 4 + b) * 64 + cl];
      mod[((size_t)l * 4 + b) * 6144 + col] = s + p.in[3][l * 6144 + col];
    }
    __syncthreads();
  }
  float* s5ab = (float*)(p.ws + OFF_S5AB);
  float* s5bb = (float*)(p.ws + OFF_S5BB);
  for (int idx = VBLK * NTHR + tid; idx < 2048; idx += VGRID * NTHR) {
    int l = idx >> 10, g = (idx >> 6) & 15, n = idx & 63;
    double lre = fmin((double)p.in[28][idx], -1e-4);
    double lim = (double)p.in[29][idx];
    double dt = exp((double)p.in[35][l * 16 + g]);
    double mag = exp(lre * dt);
    double abr = mag * cos(lim * dt), abi = mag * sin(lim * dt);
    double den = lre * lre + lim * lim;
    double qr = ((abr - 1.0) * lre + abi * lim) / den;
    double qi = (abi * lre - (abr - 1.0) * lim) / den;
    s5ab[idx * 2 + 0] = (float)abr; s5ab[idx * 2 + 1] = (float)abi;
    for (int c = 0; c < 16; ++c) {
      double br = p.in[30][(size_t)idx * 16 + c], bi = p.in[31][(size_t)idx * 16 + c];
      s5bb[(size_t)idx * 32 + c] = (float)(qr * br - qi * bi);
      s5bb[(size_t)idx * 32 + 16 + c] = (float)(qr * bi + qi * br);
    }
  }
}

__device__ __forceinline__ void convert_tile(const float* __restrict__ src, int K, int N, u16* __restrict__ dst, int tk, int tn, u16* sm) {
  const int tid = TIDX;
  int r = tid >> 4, c4 = (tid & 15) * 4;
#pragma unroll
  for (int i = 0; i < 4; ++i) {
    int kk = r + 16 * i;
    float4 v = *(const float4*)(src + (size_t)(tk * 64 + kk) * N + tn * 64 + c4);
    sm[(c4 + 0) * 72 + kk] = f2bf(v.x);
    sm[(c4 + 1) * 72 + kk] = f2bf(v.y);
    sm[(c4 + 2) * 72 + kk] = f2bf(v.z);
    sm[(c4 + 3) * 72 + kk] = f2bf(v.w);
  }
  __syncthreads();
#pragma unroll
  for (int j = 0; j < 2; ++j) {
    int n = (tid >> 3) + 32 * j, ch = tid & 7;
    u32x4 v = *(const u32x4*)(sm + n * 72 + ch * 8);
    *(u32x4*)(dst + (size_t)(tn * 64 + n) * K + tk * 64 + ch * 8) = v;
  }
  __syncthreads();
}

__device__ __forceinline__ void phase_convert(const Params& p, int l, unsigned char* smem) {
  u16* sm = (u16*)smem;
  const int total = 1632 + 192 + 128 + 256 + 1024 + 1024;
  for (int item = VBLK; item < total + 16 + 192; item += VGRID) {
    int t = item;
    if (t >= total + 16) {
      const int e = (t - total - 16) * 256 + TIDX;
      if (e < 8192) { const int n = e >> 5, k = e & 31; ((u16*)(p.ws + OFF_LW2))[e] = f2bf(p.in[8][(size_t)l * 8192 + k * 256 + n]); }
      else if (e < 16384) { const int q = e - 8192, n = q >> 5, k = q & 31; ((u16*)(p.ws + OFF_LA2))[q] = f2bf(p.in[10][(size_t)l * 8192 + k * 256 + n]); }
      else if (e < 32768) { const int q = e - 16384, n = q >> 6, k = q & 63; ((u16*)(p.ws + OFF_LG2))[q] = f2bf(p.in[11][(size_t)l * 16384 + k * 256 + n]); }
      else if (e < 40960) { const int q = e - 32768, n = q >> 5, k = q & 31; ((u16*)(p.ws + OFF_LV2))[q] = (l > 0) ? f2bf(p.in[14][k * 256 + n]) : (u16)0; }
      else { const int q = e - 40960, n = q >> 8, k = q & 255; ((u16*)(p.ws + OFF_LV1))[q] = (l > 0) ? f2bf(p.in[13][k * 32 + n]) : (u16)0; }
      continue;
    }
    if (t >= total) {
      const int idx = t - total, g = idx >> 2, rq = idx & 3;
      const int tr = rq * 32 + (TIDX >> 3), s0 = (TIDX & 7) * 16;
      const float* src = p.in[23] + (((size_t)l * 4 + g) * 128 + tr) * 128 + s0;
      u16* dst = (u16*)(p.ws + OFF_SGW) + ((size_t)g * 128 + tr) * 128 + s0;
      unsigned pk[8];
#pragma unroll
      for (int e = 0; e < 4; ++e) {
        f32x4 v = *(const f32x4*)(src + e * 4);
        const int sb = s0 + e * 4;
        pk[e * 2 + 0] = pack2(sb + 0 <= tr ? v.x : 0.f, sb + 1 <= tr ? v.y : 0.f);
        pk[e * 2 + 1] = pack2(sb + 2 <= tr ? v.z : 0.f, sb + 3 <= tr ? v.w : 0.f);
      }
      *(u32x4*)(dst) = u32x4{pk[0], pk[1], pk[2], pk[3]};
      *(u32x4*)(dst + 8) = u32x4{pk[4], pk[5], pk[6], pk[7]};
      continue;
    }
    const float* src; int K, N; size_t off;
    if (t < 1632) { src = p.in[5] + (size_t)l * 1024 * 6528; K = 1024; N = 6528; off = OFF_WIN; }
    else if ((t -= 1632) < 64) { src = p.in[20] + (size_t)l * 256 * 1024; K = 256; N = 1024; off = OFF_RO; }
    else if ((t -= 64) < 64) { src = p.in[25] + (size_t)l * 256 * 1024; K = 256; N = 1024; off = OFF_SO; }
    else if ((t -= 64) < 64) { src = p.in[27] + (size_t)l * 256 * 1024; K = 256; N = 1024; off = OFF_CO; }
    else if ((t -= 64) < 128) { src = p.in[36] + (size_t)l * 256 * 2048; K = 256; N = 2048; off = OFF_GLU; }
    else if ((t -= 128) < 256) { src = p.in[37] + (size_t)l * 1024 * 1024; K = 1024; N = 1024; off = OFF_WO; }
    else if ((t -= 256) < 1024) { src = p.in[39] + (size_t)l * 1024 * 4096; K = 1024; N = 4096; off = OFF_W1; }
    else { t -= 1024; src = p.in[40] + (size_t)l * 4096 * 1024; K = 4096; N = 1024; off = OFF_W2; }
    int ntn = N / 64;
    convert_tile(src, K, N, (u16*)(p.ws + off), t / ntn, t % ntn, sm);
  }
}

__device__ __forceinline__ void phase_norm(const float* __restrict__ X, const float* __restrict__ g, const float* __restrict__ modl,
                           int sh_off, int sc_off, u16* __restrict__ H) {
  const int lane = TIDX & 63, wv = TIDX >> 6;
  for (int item = VBLK; item < T_TOK / 4; item += VGRID) {
    int row = item * 4 + wv;
    int b = row >> 12;
    const float* xr = X + (size_t)row * 1024;
    float4 v[4];
    float ss = 0;
#pragma unroll
    for (int i = 0; i < 4; ++i) {
      v[i] = *(const float4*)(xr + lane * 4 + 256 * i);
      ss += v[i].x * v[i].x + v[i].y * v[i].y + v[i].z * v[i].z + v[i].w * v[i].w;
    }
    ss = wave_sum(ss);
    float rstd = rsqrtf(ss * (1.f / 1024.f) + 1e-6f);
    const float* sh = modl + (size_t)b * 6144 + sh_off;
    const float* sc = modl + (size_t)b * 6144 + sc_off;
#pragma unroll
    for (int i = 0; i < 4; ++i) {
      int c = lane * 4 + 256 * i;
      float4 gg = *(const float4*)(g + c);
      float4 s1 = *(const float4*)(sc + c);
      float4 s0 = *(const float4*)(sh + c);
      float h0 = v[i].x * rstd * gg.x * (1.f + s1.x) + s0.x;
      float h1 = v[i].y * rstd * gg.y * (1.f + s1.y) + s0.y;
      float h2 = v[i].z * rstd * gg.z * (1.f + s1.z) + s0.z;
      float h3 = v[i].w * rstd * gg.w * (1.f + s1.w) + s0.w;
      u32x2 o; o.x = pack2(h0, h1); o.y = pack2(h2, h3);
      *(u32x2*)(H + (size_t)row * 1024 + c) = o;
    }
  }
}

__device__ __forceinline__ void phase_final(float* __restrict__ X, const float* __restrict__ g) {
  const int lane = TIDX & 63, wv = TIDX >> 6;
  for (int item = VBLK; item < T_TOK / 4; item += VGRID) {
    int row = item * 4 + wv;
    float* xr = X + (size_t)row * 1024;
    float4 v[4];
    float ss = 0;
#pragma unroll
    for (int i = 0; i < 4; ++i) {
      v[i] = *(const float4*)(xr + lane * 4 + 256 * i);
      ss += v[i].x * v[i].x + v[i].y * v[i].y + v[i].z * v[i].z + v[i].w * v[i].w;
    }
    ss = wave_sum(ss);
    float rstd = rsqrtf(ss * (1.f / 1024.f) + 1e-6f);
#pragma unroll
    for (int i = 0; i < 4; ++i) {
      int c = lane * 4 + 256 * i;
      float4 gg = *(const float4*)(g + c);
      float4 o;
      o.x = v[i].x * rstd * gg.x; o.y = v[i].y * rstd * gg.y; o.z = v[i].z * rstd * gg.z; o.w = v[i].w * rstd * gg.w;
      *(float4*)(xr + c) = o;
    }
  }
}

template <int NF, bool LEAN = false>
__device__ __forceinline__ void gemm_mainloop(const u16* __restrict__ A, int lda, const u16* __restrict__ B, int ldb,
                                              int K, f32x4 (&acc)[4][NF], u16* smem) {
  constexpr int BN = 32 * NF;
  constexpr int NB = BN / 32;
  u16* sA = smem;
  u16* sB = smem + 2 * 128 * 64;
  int tz = 0;
  if (LEAN) asm volatile("" : "+v"(tz));
  const int tid = TIDX + tz, lane = tid & 63, wv = tid >> 6;
  const int wm = wv >> 1, wn = wv & 1;
  const int lrow = tid >> 3;
  const int lchs = (tid & 7) ^ ((lrow >> 1) & 7);
  const u16* Ap = A + (size_t)lrow * lda + lchs * 8;
  const u16* Bp = B + (size_t)lrow * ldb + lchs * 8;
  const int nk = K >> 6;
  auto stage = [&](int kt, int buf) {
    const int ko = kt << 6;
#pragma unroll
    for (int i = 0; i < 4; ++i)
      __builtin_amdgcn_global_load_lds((const unsigned*)(Ap + (size_t)(32 * i) * lda + ko),
                                       (__attribute__((address_space(3))) unsigned*)(sA + buf * (128 * 64) + (tid + 256 * i) * 8), 16, 0, 0);
#pragma unroll
    for (int i = 0; i < NB; ++i)
      __builtin_amdgcn_global_load_lds((const unsigned*)(Bp + (size_t)(32 * i) * ldb + ko),
                                       (__attribute__((address_space(3))) unsigned*)(sB + buf * (BN * 64) + (tid + 256 * i) * 8), 16, 0, 0);
  };
  __syncthreads();
  stage(0, 0);
  const int fr = lane & 15, fq = lane >> 4;
  const int sw = (fr >> 1) & 7;
  for (int kt = 0; kt < nk; ++kt) {
    const int cur = kt & 1;
    asm volatile("s_waitcnt vmcnt(0)" ::: "memory");
    __syncthreads();
    if (kt + 1 < nk) stage(kt + 1, cur ^ 1);
    const u16* cA = sA + cur * (128 * 64) + (wm * 64 + fr) * 64;
    const u16* cB = sB + cur * (BN * 64) + (wn * 16 * NF + fr) * 64;
#pragma unroll
    for (int ks = 0; ks < 2; ++ks) {
      if (LEAN) __builtin_amdgcn_sched_barrier(0);
      const int pc = ((fq + 4 * ks) ^ sw) << 3;
      bf16x8 fa[4], fb[NF];
#pragma unroll
      for (int i = 0; i < 4; ++i) fa[i] = *(const bf16x8*)(cA + i * 16 * 64 + pc);
#pragma unroll
      for (int j = 0; j < NF; ++j) fb[j] = *(const bf16x8*)(cB + j * 16 * 64 + pc);
#pragma unroll
      for (int i = 0; i < 4; ++i)
#pragma unroll
        for (int j = 0; j < NF; ++j)
          acc[i][j] = __builtin_amdgcn_mfma_f32_16x16x32_bf16(fb[j], fa[i], acc[i][j], 0, 0, 0);
    }
  }
}

template <int NF>
__device__ __forceinline__ void zero_acc(f32x4 (&acc)[4][NF]) {
#pragma unroll
  for (int i = 0; i < 4; ++i)
#pragma unroll
    for (int j = 0; j < NF; ++j) acc[i][j] = f32x4{0.f, 0.f, 0.f, 0.f};
}

__device__ __forceinline__ void gemm_mainloop_8w(const u16* __restrict__ A, int lda, const u16* __restrict__ B, int ldb,
                                                 int K, f32x4 (&acc)[8][4], u16* smem) {
  constexpr int STG = 32768;
  const int tid = threadIdx.x, lane = tid & 63, wv = tid >> 6;
  const int wm = wv >> 2, wn = wv & 3;
  const int lrow = tid >> 3;
  const int lchs = (tid & 7) ^ ((lrow >> 1) & 7);
  const u16* Ap = A + (size_t)lrow * lda + lchs * 8;
  const u16* Bp = B + (size_t)lrow * ldb + lchs * 8;
  const int nk = K >> 6;
  auto stage = [&](int kt, int buf) {
    const int ko = kt << 6;
    u16* sa = smem + buf * STG;
#pragma unroll
    for (int i = 0; i < 4; ++i)
      __builtin_amdgcn_global_load_lds((const unsigned*)(Ap + (size_t)(64 * i) * lda + ko),
                                       (__attribute__((address_space(3))) unsigned*)(sa + (tid + 512 * i) * 8), 16, 0, 0);
#pragma unroll
    for (int i = 0; i < 4; ++i)
      __builtin_amdgcn_global_load_lds((const unsigned*)(Bp + (size_t)(64 * i) * ldb + ko),
                                       (__attribute__((address_space(3))) unsigned*)(sa + 16384 + (tid + 512 * i) * 8), 16, 0, 0);
  };
  __syncthreads();
  stage(0, 0);
  const int fr = lane & 15, fq = lane >> 4;
  const int sw = (fr >> 1) & 7;
  for (int kt = 0; kt < nk; ++kt) {
    const int cur = kt & 1;
    asm volatile("s_waitcnt vmcnt(0)" ::: "memory");
    __syncthreads();
    if (kt + 1 < nk) stage(kt + 1, cur ^ 1);
    const u16* cA = smem + cur * STG + (wm * 128 + fr) * 64;
    const u16* cB = smem + cur * STG + 16384 + (wn * 64 + fr) * 64;
#pragma unroll
    for (int ks = 0; ks < 2; ++ks) {
      __builtin_amdgcn_sched_barrier(0);
      const int pc = ((fq + 4 * ks) ^ sw) << 3;
      bf16x8 fa[8], fb[4];
#pragma unroll
      for (int i = 0; i < 8; ++i) fa[i] = *(const bf16x8*)(cA + i * 16 * 64 + pc);
#pragma unroll
      for (int j = 0; j < 4; ++j) fb[j] = *(const bf16x8*)(cB + j * 16 * 64 + pc);
#pragma unroll
      for (int i = 0; i < 8; ++i)
#pragma unroll
        for (int j = 0; j < 4; ++j)
          acc[i][j] = __builtin_amdgcn_mfma_f32_16x16x32_bf16(fb[j], fa[i], acc[i][j], 0, 0, 0);
    }
  }
}

template <int EPI>
__device__ __forceinline__ void phase_gemm_8w(const Params& p, int l, int vb, unsigned char* smem_raw) {
  u16* smem = (u16*)smem_raw;
  const int lane = threadIdx.x & 63, wv = threadIdx.x >> 6;
  const int wm = wv >> 2, wn = wv & 3;
  const int fr = lane & 15, fq = lane >> 4;
  const u16* A; const u16* B; int lda, ldb, K, ntiles_n;
  if (EPI == 1) { A = (const u16*)(p.ws + OFF_MRG); lda = 1024; B = (const u16*)(p.ws + OFF_WO); ldb = 1024; K = 1024; ntiles_n = 4; }
  if (EPI == 2) { A = (const u16*)(p.ws + OFF_H); lda = 1024; B = (const u16*)(p.ws + OFF_W1); ldb = 1024; K = 1024; ntiles_n = 16; }
  if (EPI == 3) { A = (const u16*)(p.ws + OFF_F); lda = 4096; B = (const u16*)(p.ws + OFF_W2); ldb = 4096; K = 4096; ntiles_n = 4; }
  const float* modl = (const float*)(p.ws + OFF_MOD) + (size_t)l * 4 * 6144;
  const int total = 64 * ntiles_n;
  const int G = gridDim.x;
  const bool swz = (G == 256);
  for (int item = vb; item < total; item += G) {
    int mt = item & 63, nt = item >> 6;
    if (swz) { const int r = item >> 8, w = vb & 31; mt = (vb >> 5) * 8 + (w & 7); nt = r * 4 + (w >> 3); }
    const int m0 = mt * 256, n0 = nt * 256;
    f32x4 acc[8][4];
#pragma unroll
    for (int i = 0; i < 8; ++i)
#pragma unroll
      for (int j = 0; j < 4; ++j) acc[i][j] = f32x4{0.f, 0.f, 0.f, 0.f};
    gemm_mainloop_8w(A + (size_t)m0 * lda, lda, B + (size_t)n0 * ldb, ldb, K, acc, smem);
#pragma unroll
    for (int i = 0; i < 8; ++i) {
      const int m = m0 + wm * 128 + i * 16 + fr;
#pragma unroll
      for (int j = 0; j < 4; ++j) {
        const int n = n0 + wn * 64 + j * 16 + fq * 4;
        f32x4 v = acc[i][j];
        if (EPI == 1 || EPI == 3) {
          const int b = m >> 12;
          const float* gt = modl + (size_t)b * 6144 + (EPI == 1 ? 2048 : 5120) + n;
          const float* xin = ((EPI == 1 && l == 0) ? p.in[0] : p.out) + (size_t)m * 1024 + n;
          f32x4 x = *(const f32x4*)xin;
          f32x4 gg = *(const f32x4*)gt;
          *(f32x4*)(p.out + (size_t)m * 1024 + n) = x + gg * v;
        } else {
          float r0 = fmaxf(v[0], 0.f), r1 = fmaxf(v[1], 0.f), r2 = fmaxf(v[2], 0.f), r3 = fmaxf(v[3], 0.f);
          *(u32x2*)((u16*)(p.ws + OFF_F) + (size_t)m * 4096 + n) = u32x2{pack2(r0 * r0, r1 * r1), pack2(r2 * r2, r3 * r3)};
        }
      }
    }
  }
}

template <int EPI>
__device__ __forceinline__ void phase_gemm(const Params& p, int l, int vb, unsigned char* smem_raw) {
  u16* smem = (u16*)smem_raw;
  const int lane = TIDX & 63, wv = TIDX >> 6;
  const int wm = wv >> 1, wn = wv & 1;
  const int fr = lane & 15, fq = lane >> 4;
  const u16* A; const u16* B; int lda, ldb, K, ntiles_n;
  if (EPI == 0) { A = (const u16*)(p.ws + OFF_H); lda = 1024; B = (const u16*)(p.ws + OFF_WIN); ldb = 1024; K = 1024; ntiles_n = 19; }
  if (EPI == 1) { A = (const u16*)(p.ws + OFF_MRG); lda = 1024; B = (const u16*)(p.ws + OFF_WO); ldb = 1024; K = 1024; ntiles_n = 8; }
  if (EPI == 2) { A = (const u16*)(p.ws + OFF_H); lda = 1024; B = (const u16*)(p.ws + OFF_W1); ldb = 1024; K = 1024; ntiles_n = 32; }
  if (EPI == 3) { A = (const u16*)(p.ws + OFF_F); lda = 4096; B = (const u16*)(p.ws + OFF_W2); ldb = 4096; K = 4096; ntiles_n = 8; }
  const float* modl = (const float*)(p.ws + OFF_MOD) + (size_t)l * 4 * 6144;
  const int G = VGRID;
  const bool swz = (G == 512);
  const int total = swz ? 128 * ((ntiles_n + 3) & ~3) : 128 * ntiles_n;
  for (int item = vb; item < total; item += G) {
    int mt = item & 127, nt = item >> 7;
    if (swz) { const int r = item >> 9, w = vb & 63; mt = (vb >> 6) * 16 + (w & 15); nt = r * 4 + (w >> 4); if (nt >= ntiles_n) continue; }
    const int m0 = mt * 128, n0 = nt * 128;
    f32x4 acc[4][4];
    zero_acc<4>(acc);
    gemm_mainloop<4>(A + (size_t)m0 * lda, lda, B + (size_t)n0 * ldb, ldb, K, acc, smem);
#pragma unroll
    for (int i = 0; i < 4; ++i) {
      const int m = m0 + wm * 64 + i * 16 + fr;
#pragma unroll
      for (int j = 0; j < 4; ++j) {
        const int n = n0 + wn * 64 + j * 16 + fq * 4;
        f32x4 v = acc[i][j];
        if (EPI == 0) {
          u32x2 o; o.x = pack2(v[0], v[1]); o.y = pack2(v[2], v[3]);
          if (n < 2176) *(u32x2*)((u16*)(p.ws + OFF_PABC) + (size_t)m * 2176 + n) = o;
          else *(u32x2*)((u16*)(p.ws + OFF_PD) + (size_t)m * 256 + (n - 2176)) = o;
        } else if (EPI == 1 || EPI == 3) {
          const int b = m >> 12;
          const float* gt = modl + (size_t)b * 6144 + (EPI == 1 ? 2048 : 5120) + n;
          const float* xin = ((EPI == 1 && l == 0) ? p.in[0] : p.out) + (size_t)m * 1024 + n;
          float4 x = *(const float4*)xin;
          float4 gg = *(const float4*)gt;
          float4 o;
          o.x = x.x + gg.x * v[0]; o.y = x.y + gg.y * v[1]; o.z = x.z + gg.z * v[2]; o.w = x.w + gg.w * v[3];
          *(float4*)(p.out + (size_t)m * 1024 + n) = o;
        } else {
          float r0 = fmaxf(v[0], 0.f), r1 = fmaxf(v[1], 0.f), r2 = fmaxf(v[2], 0.f), r3 = fmaxf(v[3], 0.f);
          u32x2 o; o.x = pack2(r0 * r0, r1 * r1); o.y = pack2(r2 * r2, r3 * r3);
          *(u32x2*)((u16*)(p.ws + OFF_F) + (size_t)m * 4096 + n) = o;
        }
      }
    }
  }
}

template <int MODE>
__device__ __forceinline__ void merge_tile(const Params& p, int item, unsigned char* smem_raw) {
  u16* smem = (u16*)smem_raw;
  const int lane = TIDX & 63, wv = TIDX >> 6;
  const int wm = wv >> 1, wn = wv & 1;
  const int fr = lane & 15, fq = lane >> 4;
  const u16* H = (const u16*)(p.ws + OFF_H);
  const u16* WIN = (const u16*)(p.ws + OFF_WIN);
  const int mt = item & 127, nt = item >> 7;
  const int m0 = mt * 128, n0 = nt * 128;
  f32x4 bacc[4][4];
  u32x2 gpk[4][4];
  u16* MRG = (u16*)(p.ws + OFF_MRG);
#pragma unroll 1
  for (int br = (MODE == 0 ? 1 : 0); br < (MODE == 0 ? 4 : 1); ++br) {
    zero_acc<4>(bacc);
    gemm_mainloop<4, true>(H + (size_t)m0 * 1024, 1024, WIN + (size_t)(2432 + br * 1024 + n0) * 1024, 1024, 1024, bacc, smem);
#pragma unroll
    for (int i = 0; i < 4; ++i)
#pragma unroll
      for (int j = 0; j < 4; ++j)
        gpk[i][j] = u32x2{pack2(sigmoidf_(bacc[i][j][0]), sigmoidf_(bacc[i][j][1])), pack2(sigmoidf_(bacc[i][j][2]), sigmoidf_(bacc[i][j][3]))};
    const u16* Ab; const u16* Wb;
    if (br == 0) { Ab = (const u16*)(p.ws + OFF_OG); Wb = (const u16*)(p.ws + OFF_RO); }
    else if (br == 1) { Ab = (const u16*)(p.ws + OFF_UB); Wb = (const u16*)(p.ws + OFF_SO); }
    else if (br == 2) { Ab = (const u16*)(p.ws + OFF_CB); Wb = (const u16*)(p.ws + OFF_CO); }
    else { Ab = (const u16*)(p.ws + OFF_YD); Wb = (const u16*)(p.ws + OFF_GLU); }
    if (MODE == 0 && br == 3) {
      zero_acc<4>(bacc);
      gemm_mainloop<4, true>(Ab + (size_t)m0 * 256, 256, Wb + (size_t)(1024 + n0) * 256, 256, 256, bacc, smem);
#pragma unroll
      for (int i = 0; i < 4; ++i)
#pragma unroll
        for (int j = 0; j < 4; ++j) {
          const float g0 = bflo(gpk[i][j].x) * sigmoidf_(bacc[i][j][0]), g1 = bfhi(gpk[i][j].x) * sigmoidf_(bacc[i][j][1]);
          const float g2 = bflo(gpk[i][j].y) * sigmoidf_(bacc[i][j][2]), g3 = bfhi(gpk[i][j].y) * sigmoidf_(bacc[i][j][3]);
          gpk[i][j] = u32x2{pack2(g0, g1), pack2(g2, g3)};
        }
    }
    zero_acc<4>(bacc);
    gemm_mainloop<4, true>(Ab + (size_t)m0 * 256, 256, Wb + (size_t)n0 * 256, 256, 256, bacc, smem);
#pragma unroll
    for (int i = 0; i < 4; ++i)
#pragma unroll
      for (int j = 0; j < 4; ++j) {
        u32x2* mp = (u32x2*)(MRG + (size_t)(m0 + wm * 64 + i * 16 + fr) * 1024 + n0 + wn * 64 + j * 16 + fq * 4);
        u32x2 cm = u32x2{0u, 0u};
        if (MODE == 1 || br > 1) cm = *mp;
        const float v0 = bflo(cm.x) + bflo(gpk[i][j].x) * bacc[i][j][0];
        const float v1 = bfhi(cm.x) + bfhi(gpk[i][j].x) * bacc[i][j][1];
        const float v2 = bflo(cm.y) + bflo(gpk[i][j].y) * bacc[i][j][2];
        const float v3 = bfhi(cm.y) + bfhi(gpk[i][j].y) * bacc[i][j][3];
        *mp = u32x2{pack2(v0, v1), pack2(v2, v3)};
      }
  }
}

__device__ __forceinline__ void gemm_mainloop_8n(const u16* __restrict__ A, int lda, const u16* __restrict__ B, int ldb,
                                                 int K, f32x4 (&acc)[4][4], u16* smem) {
  constexpr int STG = 24576;
  int tz = 0;
  asm volatile("" : "+v"(tz));
  const int tid = threadIdx.x + tz, lane = tid & 63, wv = tid >> 6;
  const int wm = wv >> 1, wn = wv & 1;
  const int lrow = tid >> 3;
  const int lchs = (tid & 7) ^ ((lrow >> 1) & 7);
  const u16* Ap = A + (size_t)lrow * lda + lchs * 8;
  const u16* Bp = B + (size_t)lrow * ldb + lchs * 8;
  const int nk = K >> 6;
  auto stage = [&](int kt, int buf) {
    const int ko = kt << 6;
    u16* sa = smem + buf * STG;
#pragma unroll
    for (int i = 0; i < 4; ++i)
      __builtin_amdgcn_global_load_lds((const unsigned*)(Ap + (size_t)(64 * i) * lda + ko),
                                       (__attribute__((address_space(3))) unsigned*)(sa + (tid + 512 * i) * 8), 16, 0, 0);
#pragma unroll
    for (int i = 0; i < 2; ++i)
      __builtin_amdgcn_global_load_lds((const unsigned*)(Bp + (size_t)(64 * i) * ldb + ko),
                                       (__attribute__((address_space(3))) unsigned*)(sa + 16384 + (tid + 512 * i) * 8), 16, 0, 0);
  };
  __syncthreads();
  stage(0, 0);
  stage(nk > 1 ? 1 : 0, 1);
  const int fr = lane & 15, fq = lane >> 4;
  const int sw = (fr >> 1) & 7;
  int cur = 0;
  for (int kt = 0; kt < nk; ++kt) {
    asm volatile("s_waitcnt vmcnt(6)" ::: "memory");
    __builtin_amdgcn_s_barrier();
    asm volatile("" ::: "memory");
    {
      int nx = cur + 2; if (nx >= 3) nx -= 3;
      int ktn = kt + 2; if (ktn >= nk) ktn = nk - 1;
      stage(ktn, nx);
    }
    const u16* cA = smem + cur * STG + (wm * 64 + fr) * 64;
    const u16* cB = smem + cur * STG + 16384 + (wn * 64 + fr) * 64;
#pragma unroll
    for (int ks = 0; ks < 2; ++ks) {
      __builtin_amdgcn_sched_barrier(0);
      const int pc = ((fq + 4 * ks) ^ sw) << 3;
      bf16x8 fa[4], fb[4];
#pragma unroll
      for (int i = 0; i < 4; ++i) fa[i] = *(const bf16x8*)(cA + i * 16 * 64 + pc);
#pragma unroll
      for (int j = 0; j < 4; ++j) fb[j] = *(const bf16x8*)(cB + j * 16 * 64 + pc);
#pragma unroll
      for (int i = 0; i < 4; ++i)
#pragma unroll
        for (int j = 0; j < 4; ++j)
          acc[i][j] = __builtin_amdgcn_mfma_f32_16x16x32_bf16(fb[j], fa[i], acc[i][j], 0, 0, 0);
    }
    cur = cur + 1; if (cur >= 3) cur = 0;
  }
  asm volatile("s_waitcnt vmcnt(0)" ::: "memory");
}

template <int MODE>
__device__ __forceinline__ void merge_tile8(const Params& p, int item, unsigned char* smem_raw) {
  u16* smem = (u16*)smem_raw;
  const int lane = threadIdx.x & 63, wv = threadIdx.x >> 6;
  const int wm = wv >> 1, wn = wv & 1;
  const int fr = lane & 15, fq = lane >> 4;
  const u16* H = (const u16*)(p.ws + OFF_H);
  const u16* WIN = (const u16*)(p.ws + OFF_WIN);
  const int mt = item & 63, nt = item >> 6;
  const int m0 = mt * 256, n0 = nt * 128;
  f32x4 bacc[4][4];
  u32x2 gpk[4][4];
  u16* MRG = (u16*)(p.ws + OFF_MRG);
#pragma unroll 1
  for (int br = (MODE == 0 ? 1 : 0); br < (MODE == 0 ? 4 : 1); ++br) {
    zero_acc<4>(bacc);
    gemm_mainloop_8n(H + (size_t)m0 * 1024, 1024, WIN + (size_t)(2432 + br * 1024 + n0) * 1024, 1024, 1024, bacc, smem);
#pragma unroll
    for (int i = 0; i < 4; ++i)
#pragma unroll
      for (int j = 0; j < 4; ++j)
        gpk[i][j] = u32x2{pack2(sigmoidf_(bacc[i][j][0]), sigmoidf_(bacc[i][j][1])), pack2(sigmoidf_(bacc[i][j][2]), sigmoidf_(bacc[i][j][3]))};
    const u16* Ab; const u16* Wb;
    if (br == 0) { Ab = (const u16*)(p.ws + OFF_OG); Wb = (const u16*)(p.ws + OFF_RO); }
    else if (br == 1) { Ab = (const u16*)(p.ws + OFF_UB); Wb = (const u16*)(p.ws + OFF_SO); }
    else if (br == 2) { Ab = (const u16*)(p.ws + OFF_CB); Wb = (const u16*)(p.ws + OFF_CO); }
    else { Ab = (const u16*)(p.ws + OFF_YD); Wb = (const u16*)(p.ws + OFF_GLU); }
    if (MODE == 0 && br == 3) {
      zero_acc<4>(bacc);
      gemm_mainloop_8n(Ab + (size_t)m0 * 256, 256, Wb + (size_t)(1024 + n0) * 256, 256, 256, bacc, smem);
#pragma unroll
      for (int i = 0; i < 4; ++i)
#pragma unroll
        for (int j = 0; j < 4; ++j) {
          const float g0 = bflo(gpk[i][j].x) * sigmoidf_(bacc[i][j][0]), g1 = bfhi(gpk[i][j].x) * sigmoidf_(bacc[i][j][1]);
          const float g2 = bflo(gpk[i][j].y) * sigmoidf_(bacc[i][j][2]), g3 = bfhi(gpk[i][j].y) * sigmoidf_(bacc[i][j][3]);
          gpk[i][j] = u32x2{pack2(g0, g1), pack2(g2, g3)};
        }
    }
    zero_acc<4>(bacc);
    gemm_mainloop_8n(Ab + (size_t)m0 * 256, 256, Wb + (size_t)n0 * 256, 256, 256, bacc, smem);
#pragma unroll
    for (int i = 0; i < 4; ++i)
#pragma unroll
      for (int j = 0; j < 4; ++j) {
        u32x2* mp = (u32x2*)(MRG + (size_t)(m0 + wm * 64 + i * 16 + fr) * 1024 + n0 + wn * 64 + j * 16 + fq * 4);
        u32x2 cm = u32x2{0u, 0u};
        if (MODE == 1 || br > 1) cm = *mp;
        const float v0 = bflo(cm.x) + bflo(gpk[i][j].x) * bacc[i][j][0];
        const float v1 = bfhi(cm.x) + bfhi(gpk[i][j].x) * bacc[i][j][1];
        const float v2 = bflo(cm.y) + bflo(gpk[i][j].y) * bacc[i][j][2];
        const float v3 = bfhi(cm.y) + bfhi(gpk[i][j].y) * bacc[i][j][3];
        *mp = u32x2{pack2(v0, v1), pack2(v2, v3)};
      }
  }
}

__device__ __forceinline__ float shifted(const u16* __restrict__ P, int tok, int col, float mu) {
  float pv = bf2f(P[(size_t)tok * 2176 + col]);
  float pr = (tok & (SEQ - 1)) ? bf2f(P[(size_t)(tok - 1) * 2176 + col]) : 0.f;
  return pv + (pr - pv) * mu;
}

__device__ __forceinline__ void rwkv_prep_item(const Params& p, int l, int item, unsigned char* smem) {
  const int tid = TIDX, lane = tid & 63, wv = tid >> 6;
  const int fr = lane & 15, fq = lane >> 4;
  u16* sl = (u16*)smem;
  u16* sv = sl + 32 * 168;
  constexpr int SLS = 168, SVS = 264;
  const u16* P = (const u16*)(p.ws + OFF_PABC);
  const float* mu = p.in[6] + l * 896;
  const int tok0 = item * 32;
  for (int idx = tid; idx < 32 * 128; idx += NTHR) {
    const int t = idx >> 7, ci = idx & 127;
    float v = shifted(P, tok0 + t, 768 + ci, mu[768 + ci]);
    if (ci < 32) v = tanhf_(v);
    else if (ci >= 64) v = sigmoidf_(v);
    sl[t * SLS + ci] = f2bf(v);
  }
  if (l > 0) {
    const int t = tid >> 3, c0 = (tid & 7) * 32;
    const int tok = tok0 + t;
    const bool hasp = (tok & (SEQ - 1)) != 0;
#pragma unroll
    for (int q = 0; q < 4; ++q) {
      const int c = c0 + q * 8;
      const u32x4 cur = *(const u32x4*)(P + (size_t)tok * 2176 + 512 + c);
      u32x4 prv = u32x4{0u, 0u, 0u, 0u};
      if (hasp) prv = *(const u32x4*)(P + (size_t)(tok - 1) * 2176 + 512 + c);
      const f32x4 m0 = *(const f32x4*)(mu + 512 + c), m1 = *(const f32x4*)(mu + 512 + c + 4);
      float o[8];
      o[0] = bflo(cur.x) + (bflo(prv.x) - bflo(cur.x)) * m0.x; o[1] = bfhi(cur.x) + (bfhi(prv.x) - bfhi(cur.x)) * m0.y;
      o[2] = bflo(cur.y) + (bflo(prv.y) - bflo(cur.y)) * m0.z; o[3] = bfhi(cur.y) + (bfhi(prv.y) - bfhi(cur.y)) * m0.w;
      o[4] = bflo(cur.z) + (bflo(prv.z) - bflo(cur.z)) * m1.x; o[5] = bfhi(cur.z) + (bfhi(prv.z) - bfhi(cur.z)) * m1.y;
      o[6] = bflo(cur.w) + (bflo(prv.w) - bflo(cur.w)) * m1.z; o[7] = bfhi(cur.w) + (bfhi(prv.w) - bfhi(cur.w)) * m1.w;
      *(u32x4*)(sv + t * SVS + c) = u32x4{pack2(o[0], o[1]), pack2(o[2], o[3]), pack2(o[4], o[5]), pack2(o[6], o[7])};
    }
  }
  __syncthreads();
  if (l > 0) {
    const int mf = wv >> 1, nf = wv & 1;
    const u16* v1t = (const u16*)(p.ws + OFF_LV1);
    f32x4 acc = f32x4{0.f, 0.f, 0.f, 0.f};
#pragma unroll
    for (int ks = 0; ks < 8; ++ks) {
      const bf16x8 fa = *(const bf16x8*)(sv + (mf * 16 + fr) * SVS + ks * 32 + fq * 8);
      const bf16x8 fb = *(const bf16x8*)(v1t + (size_t)(nf * 16 + fr) * 256 + ks * 32 + fq * 8);
      acc = __builtin_amdgcn_mfma_f32_16x16x32_bf16(fb, fa, acc, 0, 0, 0);
    }
    *(u32x2*)(sl + (mf * 16 + fr) * SLS + 128 + nf * 16 + fq * 4) = u32x2{pack2(acc[0], acc[1]), pack2(acc[2], acc[3])};
    __syncthreads();
  }
  const u16* w2t = (const u16*)(p.ws + OFF_LW2); const u16* a2t = (const u16*)(p.ws + OFF_LA2);
  const u16* g2t = (const u16*)(p.ws + OFF_LG2); const u16* v2t = (const u16*)(p.ws + OFF_LV2);
  u16* SR = (u16*)(p.ws + OFF_SR); u16* SK = (u16*)(p.ws + OFF_SK); u16* SV = (u16*)(p.ws + OFF_SV);
  u16* SKK = (u16*)(p.ws + OFF_SKK); u16* SA = (u16*)(p.ws + OFF_SA); float* SW = (float*)(p.ws + OFF_SW);
  u16* G = (u16*)(p.ws + OFF_G); u16* VF = (u16*)(p.ws + OFF_VF);
#pragma unroll 1
  for (int mf = 0; mf < 2; ++mf) {
    const u16* arow = sl + (mf * 16 + fr) * SLS + fq * 8;
    const bf16x8 aw = *(const bf16x8*)(arow), aa = *(const bf16x8*)(arow + 32);
    const bf16x8 ag0 = *(const bf16x8*)(arow + 64), ag1 = *(const bf16x8*)(arow + 96), av = *(const bf16x8*)(arow + 128);
    f32x4 cw[4], ca[4], cg[4], cv[4];
#pragma unroll
    for (int nf = 0; nf < 4; ++nf) {
      const int n = wv * 64 + nf * 16 + fr;
      const f32x4 z = f32x4{0.f, 0.f, 0.f, 0.f};
      cw[nf] = __builtin_amdgcn_mfma_f32_16x16x32_bf16(*(const bf16x8*)(w2t + n * 32 + fq * 8), aw, z, 0, 0, 0);
      ca[nf] = __builtin_amdgcn_mfma_f32_16x16x32_bf16(*(const bf16x8*)(a2t + n * 32 + fq * 8), aa, z, 0, 0, 0);
      cg[nf] = __builtin_amdgcn_mfma_f32_16x16x32_bf16(*(const bf16x8*)(g2t + n * 64 + fq * 8), ag0, z, 0, 0, 0);
      cg[nf] = __builtin_amdgcn_mfma_f32_16x16x32_bf16(*(const bf16x8*)(g2t + n * 64 + 32 + fq * 8), ag1, cg[nf], 0, 0, 0);
      cv[nf] = z;
      if (l > 0) cv[nf] = __builtin_amdgcn_mfma_f32_16x16x32_bf16(*(const bf16x8*)(v2t + n * 32 + fq * 8), av, z, 0, 0, 0);
    }
    const int tok = tok0 + mf * 16 + fr;
    const bool hasp = (tok & (SEQ - 1)) != 0;
    float kkv[4][4], kmv[4][4], av4[4][4];
    float ss = 0.f;
#pragma unroll
    for (int nf = 0; nf < 4; ++nf) {
      const int c = wv * 64 + nf * 16 + fq * 4;
      const size_t o = (size_t)tok * 256 + c;
      const u16* pc = P + (size_t)tok * 2176 + c;
      const u32x2 r_c = *(const u32x2*)(pc), k_c = *(const u32x2*)(pc + 256), v_c = *(const u32x2*)(pc + 512);
      u32x2 r_p = u32x2{0u, 0u}, k_p = u32x2{0u, 0u}, v_p = u32x2{0u, 0u};
      if (hasp) { r_p = *(const u32x2*)(pc - 2176); k_p = *(const u32x2*)(pc - 2176 + 256); v_p = *(const u32x2*)(pc - 2176 + 512); }
      const f32x4 mur = *(const f32x4*)(mu + c), muk = *(const f32x4*)(mu + 256 + c), muv = *(const f32x4*)(mu + 512 + c);
      const f32x4 w0 = *(const f32x4*)(p.in[7] + l * 256 + c), a0 = *(const f32x4*)(p.in[9] + l * 256 + c);
      const f32x4 kkc = *(const f32x4*)(p.in[15] + l * 256 + c), kac = *(const f32x4*)(p.in[16] + l * 256 + c);
      f32x4 v0 = f32x4{0.f, 0.f, 0.f, 0.f};
      if (l > 0) v0 = *(const f32x4*)(p.in[12] + c);
      u32x2 vfraw = u32x2{0u, 0u};
      if (l > 0) vfraw = *(const u32x2*)(VF + o);
      float rr[4], kk_[4], vv[4], dec[4], gg[4];
#pragma unroll
      for (int e = 0; e < 4; ++e) {
        const unsigned rc = e < 2 ? r_c.x : r_c.y, rp = e < 2 ? r_p.x : r_p.y;
        const unsigned kc = e < 2 ? k_c.x : k_c.y, kp = e < 2 ? k_p.x : k_p.y;
        const unsigned vc = e < 2 ? v_c.x : v_c.y, vp = e < 2 ? v_p.x : v_p.y;
        const unsigned vfr = e < 2 ? vfraw.x : vfraw.y;
        const float rcf = (e & 1) ? bfhi(rc) : bflo(rc), rpf = (e & 1) ? bfhi(rp) : bflo(rp);
        const float kcf = (e & 1) ? bfhi(kc) : bflo(kc), kpf = (e & 1) ? bfhi(kp) : bflo(kp);
        const float vcf = (e & 1) ? bfhi(vc) : bflo(vc), vpf = (e & 1) ? bfhi(vp) : bflo(vp);
        const float r = rcf + (rpf - rcf) * mur[e];
        const float k = kcf + (kpf - kcf) * muk[e];
        float v = vcf + (vpf - vcf) * muv[e];
        const float wl = w0[e] + cw[nf][e];
        const float z = -wl;
        const float sp = (z > 15.f) ? z : __logf(1.f + __expf(z));
        dec[e] = __expf(-__expf(-sp - 0.5f));
        const float a = sigmoidf_(a0[e] + ca[nf][e]);
        gg[e] = cg[nf][e];
        if (l > 0) { const float vf = (e & 1) ? bfhi(vfr) : bflo(vfr); v = v + (vf - v) * sigmoidf_(v0[e] + cv[nf][e]); }
        const float kk = k * kkc[e];
        ss += kk * kk;
        rr[e] = r; vv[e] = v; kk_[e] = kk; kkv[nf][e] = kk;
        kmv[nf][e] = k * (1.f + (a - 1.f) * kac[e]); av4[nf][e] = a;
      }
      *(u32x2*)(SR + o) = u32x2{pack2(rr[0], rr[1]), pack2(rr[2], rr[3])};
      *(u32x2*)(SV + o) = u32x2{pack2(vv[0], vv[1]), pack2(vv[2], vv[3])};
      if (l == 0) *(u32x2*)(VF + o) = u32x2{pack2(vv[0], vv[1]), pack2(vv[2], vv[3])};
      *(u32x2*)(G + o) = u32x2{pack2(gg[0], gg[1]), pack2(gg[2], gg[3])};
      *(f32x4*)(SW + o) = f32x4{dec[0], dec[1], dec[2], dec[3]};
    }
    ss += __shfl_xor(ss, 16, 64);
    ss += __shfl_xor(ss, 32, 64);
    const float inv = 1.f / fmaxf(sqrtf(ss), 1e-12f);
#pragma unroll
    for (int nf = 0; nf < 4; ++nf) {
      const size_t o = (size_t)tok * 256 + wv * 64 + nf * 16 + fq * 4;
      *(u32x2*)(SKK + o) = u32x2{pack2(kkv[nf][0] * inv, kkv[nf][1] * inv), pack2(kkv[nf][2] * inv, kkv[nf][3] * inv)};
      *(u32x2*)(SK + o) = u32x2{pack2(kmv[nf][0], kmv[nf][1]), pack2(kmv[nf][2], kmv[nf][3])};
      *(u32x2*)(SA + o) = u32x2{pack2(av4[nf][0], av4[nf][1]), pack2(av4[nf][2], av4[nf][3])};
    }
  }
  __syncthreads();
}

__device__ __forceinline__ void sg_item(const Params& p, int l, int item, unsigned char* smem) {
  const int tid = TIDX, lane = tid & 63, wv = tid >> 6;
  u16* vsT = (u16*)smem;
  float* smu = (float*)(smem + 16384);
  float* srs = smu + 128;
  const u16* P = (const u16*)(p.ws + OFF_PABC);
  const int g = item & 3, chn = item >> 2;
  const int tok0 = chn * 128;
  {
    const int t = tid >> 1, hf = tid & 1;
    const u16* src = P + (size_t)(tok0 + t) * 2176 + 896 + 256 + hf * 128;
    float sm = 0.f, ss = 0.f;
#pragma unroll 4
    for (int i = 0; i < 16; ++i) {
      u32x4 raw = *(const u32x4*)(src + i * 8);
      float z;
      z = geluf_(bflo(raw.x)); sm += z; ss += z * z;  z = geluf_(bfhi(raw.x)); sm += z; ss += z * z;
      z = geluf_(bflo(raw.y)); sm += z; ss += z * z;  z = geluf_(bfhi(raw.y)); sm += z; ss += z * z;
      z = geluf_(bflo(raw.z)); sm += z; ss += z * z;  z = geluf_(bfhi(raw.z)); sm += z; ss += z * z;
      z = geluf_(bflo(raw.w)); sm += z; ss += z * z;  z = geluf_(bfhi(raw.w)); sm += z; ss += z * z;
    }
    sm += __shfl_xor(sm, 1, 64); ss += __shfl_xor(ss, 1, 64);
    const float mean = sm * (1.f / 256.f);
    const float var = fmaxf(ss * (1.f / 256.f) - mean * mean, 0.f);
    if (hf == 0) { smu[t] = mean; srs[t] = rsqrtf(var + 1e-5f); }
  }
  __syncthreads();
  {
    const int c = tid & 63, tb = tid >> 6;
    const float lw = p.in[21][l * 256 + g * 64 + c], lb = p.in[22][l * 256 + g * 64 + c];
#pragma unroll
    for (int j = 0; j < 4; ++j) {
      u16 raw[8];
#pragma unroll
      for (int e = 0; e < 8; ++e) raw[e] = P[(size_t)(tok0 + tb * 32 + j * 8 + e) * 2176 + 896 + 256 + g * 64 + c];
      float vv[8];
#pragma unroll
      for (int e = 0; e < 8; ++e) {
        const int t = tb * 32 + j * 8 + e;
        vv[e] = (geluf_(bf2f(raw[e])) - smu[t]) * srs[t] * lw + lb;
      }
      const int phys = (tb * 4 + j) ^ (c & 15);
      *(u32x4*)(vsT + c * 128 + phys * 8) = u32x4{pack2(vv[0], vv[1]), pack2(vv[2], vv[3]), pack2(vv[4], vv[5]), pack2(vv[6], vv[7])};
    }
  }
  __syncthreads();
  {
    const int fr = lane & 15, fq = lane >> 4;
    const u16* Wm = (const u16*)(p.ws + OFF_SGW) + (size_t)g * 128 * 128;
    f32x4 acc[2][4];
#pragma unroll
    for (int i = 0; i < 2; ++i)
#pragma unroll
      for (int j = 0; j < 4; ++j) acc[i][j] = f32x4{0.f, 0.f, 0.f, 0.f};
    for (int ks = 0; ks <= wv; ++ks) {
      bf16x8 fa[2], fb[4];
#pragma unroll
      for (int i = 0; i < 2; ++i) fa[i] = *(const bf16x8*)(Wm + (size_t)(32 * wv + 16 * i + fr) * 128 + ks * 32 + fq * 8);
#pragma unroll
      for (int j = 0; j < 4; ++j) fb[j] = *(const bf16x8*)(vsT + (j * 16 + fr) * 128 + (((ks * 4 + fq) ^ fr) << 3));
#pragma unroll
      for (int i = 0; i < 2; ++i)
#pragma unroll
        for (int j = 0; j < 4; ++j) acc[i][j] = __builtin_amdgcn_mfma_f32_16x16x32_bf16(fb[j], fa[i], acc[i][j], 0, 0, 0);
    }
    const float* bs = p.in[24] + ((size_t)l * 4 + g) * 128;
    u16* UB = (u16*)(p.ws + OFF_UB);
#pragma unroll
    for (int i = 0; i < 2; ++i) {
      const int t = 32 * wv + 16 * i + fr;
      const float bsv = bs[t];
#pragma unroll
      for (int j = 0; j < 4; ++j) {
        const int cc = j * 16 + fq * 4;
        u32x2 ur = *(const u32x2*)(P + (size_t)(tok0 + t) * 2176 + 896 + g * 64 + cc);
        float o0 = geluf_(bflo(ur.x)) * (acc[i][j][0] + bsv), o1 = geluf_(bfhi(ur.x)) * (acc[i][j][1] + bsv);
        float o2 = geluf_(bflo(ur.y)) * (acc[i][j][2] + bsv), o3 = geluf_(bfhi(ur.y)) * (acc[i][j][3] + bsv);
        *(u32x2*)(UB + (size_t)(tok0 + t) * 256 + g * 64 + cc) = u32x2{pack2(o0, o1), pack2(o2, o3)};
      }
    }
  }
  __syncthreads();
}

__device__ __forceinline__ void conv_item(const Params& p, int l, int item) {
  const int j = TIDX;
  const u16* P = (const u16*)(p.ws + OFF_PABC);
  u16* CB = (u16*)(p.ws + OFF_CB);
  const float c0 = p.in[26][(l * 3 + 0) * 256 + j], c1 = p.in[26][(l * 3 + 1) * 256 + j], c2 = p.in[26][(l * 3 + 2) * 256 + j];
  const int tok0 = item * 8;
  u16 rc[10], rx[10], rb[8];
  const bool first = (tok0 & (SEQ - 1)) == 0;
#pragma unroll
  for (int t = 0; t < 10; ++t) {
    const int tok = (first && t < 2) ? tok0 : tok0 + t - 2;
    const u16* q = P + (size_t)tok * 2176 + 1408;
    rc[t] = q[256 + j]; rx[t] = q[512 + j];
    if (t >= 2) rb[t - 2] = q[j];
  }
  float z[10];
#pragma unroll
  for (int t = 0; t < 10; ++t) z[t] = bf2f(rc[t]) * bf2f(rx[t]);
  if (first) { z[0] = 0.f; z[1] = 0.f; }
#pragma unroll
  for (int t = 0; t < 8; ++t) {
    float y = c0 * z[t] + c1 * z[t + 1] + c2 * z[t + 2];
    CB[(size_t)(tok0 + t) * 256 + j] = f2bf(bf2f(rb[t]) * y);
  }
}

__device__ __forceinline__ void s5_load_u(const u16* us, int t, int wv, float (&u)[16]) {
  const u32x4* q = (const u32x4*)(us + t * 64 + wv * 16);
  u32x4 a = q[0], b = q[1];
  u[0] = bflo(a.x); u[1] = bfhi(a.x); u[2] = bflo(a.y); u[3] = bfhi(a.y);
  u[4] = bflo(a.z); u[5] = bfhi(a.z); u[6] = bflo(a.w); u[7] = bfhi(a.w);
  u[8] = bflo(b.x); u[9] = bfhi(b.x); u[10] = bflo(b.y); u[11] = bfhi(b.y);
  u[12] = bflo(b.z); u[13] = bfhi(b.z); u[14] = bflo(b.w); u[15] = bfhi(b.w);
}
__device__ __forceinline__ void s5_stage_u(const u16* __restrict__ PD, int tok0, int gq, u16* us) {
#pragma unroll
  for (int i = 0; i < 2; ++i) {
    const int ch = TIDX + 256 * i;
    const int t = ch >> 3, part = ch & 7;
    *(u32x4*)(us + t * 64 + part * 8) = *(const u32x4*)(PD + (size_t)(tok0 + t) * 256 + gq * 64 + part * 8);
  }
}

__device__ __forceinline__ void s5a_item(const Params& p, int l, int item, unsigned char* smem) {
  const int lane = TIDX & 63, wv = TIDX >> 6;
  const int gq = item & 3, bc = item >> 2;
  const int g = gq * 4 + wv;
  const int tok0 = bc * 64;
  const u16* PD = (const u16*)(p.ws + OFF_PD);
  const float* ab = (const float*)(p.ws + OFF_S5AB) + ((size_t)(l * 16 + g) * 64 + lane) * 2;
  const float* bb = (const float*)(p.ws + OFF_S5BB) + ((size_t)(l * 16 + g) * 64 + lane) * 32;
  float bbr[16], bbi[16];
#pragma unroll
  for (int c = 0; c < 16; ++c) { bbr[c] = bb[c]; bbi[c] = bb[16 + c]; }
  const float abr = ab[0], abi = ab[1];
  float xr = 0.f, xi = 0.f;
  u16* us = (u16*)smem;
  s5_stage_u(PD, tok0, gq, us);
  __syncthreads();
#pragma unroll 4
  for (int t = 0; t < 64; ++t) {
    float u[16];
    s5_load_u(us, t, wv, u);
    float bur = 0.f, bui = 0.f;
#pragma unroll
    for (int c = 0; c < 16; ++c) { bur += bbr[c] * u[c]; bui += bbi[c] * u[c]; }
    float nr = abr * xr - abi * xi + bur;
    float ni = abr * xi + abi * xr + bui;
    xr = nr; xi = ni;
  }
  float2* E = (float2*)(p.ws + OFF_S5E);
  E[((size_t)bc * 16 + g) * 64 + lane] = make_float2(xr, xi);
  __syncthreads();
}

__device__ __forceinline__ void s5b_item(const Params& p, int l, int item, unsigned char* smem) {
  const int lane = TIDX & 63, wv = TIDX >> 6;
  const int gq = item & 3, bc = item >> 2;
  const int b = bc >> 6, ch = bc & 63;
  const int g = gq * 4 + wv;
  const int tok0 = bc * 64;
  u16* us = (u16*)(smem + 65536);
  s5_stage_u((const u16*)(p.ws + OFF_PD), tok0, gq, us);
  float* base = (float*)smem + wv * 4096;
  float* csr = base, *csi = base + 1024, *xsr = base + 2048, *xsi = base + 3072;
  const u16* PD = (const u16*)(p.ws + OFF_PD);
  const float* ab = (const float*)(p.ws + OFF_S5AB) + ((size_t)(l * 16 + g) * 64 + lane) * 2;
  const float* bb = (const float*)(p.ws + OFF_S5BB) + ((size_t)(l * 16 + g) * 64 + lane) * 32;
  const float* cre = p.in[32] + ((size_t)(l * 16 + g) * 16) * 64;
  const float* cim = p.in[33] + ((size_t)(l * 16 + g) * 16) * 64;
  for (int c = 0; c < 16; ++c) {
    csr[(lane >> 2) * 64 + c * 4 + (lane & 3)] = cre[c * 64 + lane];
    csi[(lane >> 2) * 64 + c * 4 + (lane & 3)] = cim[c * 64 + lane];
  }
  float bbr[16], bbi[16];
#pragma unroll
  for (int c = 0; c < 16; ++c) { bbr[c] = bb[c]; bbi[c] = bb[16 + c]; }
  const float abr = ab[0], abi = ab[1];
  float pr = abr, pi = abi;
#pragma unroll
  for (int s = 0; s < 6; ++s) { float nr = pr * pr - pi * pi, ni = 2.f * pr * pi; pr = nr; pi = ni; }
  float xr = 0.f, xi = 0.f;
  const float2* E = (const float2*)(p.ws + OFF_S5E);
  for (int c = 0; c < ch; ++c) {
    float2 e = E[((size_t)(b * 64 + c) * 16 + g) * 64 + lane];
    float nr = pr * xr - pi * xi + e.x;
    float ni = pr * xi + pi * xr + e.y;
    xr = nr; xi = ni;
  }
  const int tt = lane & 15, cq = lane >> 4;
  const float* dvec = p.in[34] + l * 256 + g * 16 + cq * 4;
  const float d0 = dvec[0], d1 = dvec[1], d2 = dvec[2], d3 = dvec[3];
  u16* YD = (u16*)(p.ws + OFF_YD);
  const int n4w = lane >> 2, e4 = lane & 3;
  __syncthreads();
#pragma unroll 1
  for (int sc = 0; sc < 4; ++sc) {
    for (int t = 0; t < 16; ++t) {
      float u[16];
      s5_load_u(us, sc * 16 + t, wv, u);
      float bur = 0.f, bui = 0.f;
#pragma unroll
      for (int c = 0; c < 16; ++c) { bur += bbr[c] * u[c]; bui += bbi[c] * u[c]; }
      float nr = abr * xr - abi * xi + bur;
      float ni = abr * xi + abi * xr + bui;
      xr = nr; xi = ni;
      int a = n4w * 64 + ((t ^ (n4w & 7)) << 2) + e4;
      xsr[a] = xr; xsi[a] = xi;
    }
    __syncthreads();
    float acc0 = 0.f, acc1 = 0.f, acc2 = 0.f, acc3 = 0.f;
#pragma unroll 2
    for (int n4 = 0; n4 < 16; ++n4) {
      int xa = n4 * 64 + ((tt ^ (n4 & 7)) << 2);
      float4 xr4 = *(const float4*)(xsr + xa);
      float4 xi4 = *(const float4*)(xsi + xa);
      const float* cr = csr + n4 * 64 + cq * 16;
      const float* ci = csi + n4 * 64 + cq * 16;
      float4 r0 = *(const float4*)(cr), r1 = *(const float4*)(cr + 4), r2 = *(const float4*)(cr + 8), r3 = *(const float4*)(cr + 12);
      float4 i0 = *(const float4*)(ci), i1 = *(const float4*)(ci + 4), i2 = *(const float4*)(ci + 8), i3 = *(const float4*)(ci + 12);
      acc0 += r0.x * xr4.x + r0.y * xr4.y + r0.z * xr4.z + r0.w * xr4.w - (i0.x * xi4.x + i0.y * xi4.y + i0.z * xi4.z + i0.w * xi4.w);
      acc1 += r1.x * xr4.x + r1.y * xr4.y + r1.z * xr4.z + r1.w * xr4.w - (i1.x * xi4.x + i1.y * xi4.y + i1.z * xi4.z + i1.w * xi4.w);
      acc2 += r2.x * xr4.x + r2.y * xr4.y + r2.z * xr4.z + r2.w * xr4.w - (i2.x * xi4.x + i2.y * xi4.y + i2.z * xi4.z + i2.w * xi4.w);
      acc3 += r3.x * xr4.x + r3.y * xr4.y + r3.z * xr4.z + r3.w * xr4.w - (i3.x * xi4.x + i3.y * xi4.y + i3.z * xi4.z + i3.w * xi4.w);
    }
    {
      const int tok = tok0 + sc * 16 + tt;
      u32x2 ur = *(const u32x2*)(us + (sc * 16 + tt) * 64 + wv * 16 + cq * 4);
      float y0 = acc0 + d0 * bflo(ur.x), y1 = acc1 + d1 * bfhi(ur.x), y2 = acc2 + d2 * bflo(ur.y), y3 = acc3 + d3 * bfhi(ur.y);
      u32x2 o; o.x = pack2(geluf_(y0), geluf_(y1)); o.y = pack2(geluf_(y2), geluf_(y3));
      *(u32x2*)(YD + (size_t)tok * 256 + g * 16 + cq * 4) = o;
    }
    __syncthreads();
  }
}

__device__ __forceinline__ void lds_barrier() {
  asm volatile("s_waitcnt lgkmcnt(0)" ::: "memory");
  __builtin_amdgcn_s_barrier();
  asm volatile("" ::: "memory");
}
using f32x2 = __attribute__((ext_vector_type(2))) float;
__device__ __forceinline__ void scan_item(const Params& p, int item, unsigned char* smem) {
  const int tid = TIDX, lane = tid & 63, wv = tid >> 6;
  const int b = item >> 4, h = (item >> 2) & 3, q = item & 3;
  const int rl = lane >> 4, cl = lane & 15;
  const int rloc = wv * 4 + rl;
  const size_t tokb = (size_t)b * SEQ;
  const int chan0 = h * 64;
  const u16* SR = (const u16*)(p.ws + OFF_SR); const u16* SK = (const u16*)(p.ws + OFF_SK);
  const u16* SV = (const u16*)(p.ws + OFF_SV); const u16* SKK = (const u16*)(p.ws + OFF_SKK);
  const u16* SA = (const u16*)(p.ws + OFF_SA); const float* SW = (const float*)(p.ws + OFF_SW);
  float* O = (float*)(p.ws + OFF_O);
  constexpr int BUFF = 6432;
  float* lbase = (float*)smem;
  float* pp = lbase + 2 * BUFF + wv * 1024;
  const int st = tid >> 4, cg4 = tid & 15;
  struct Stg { u32x2 r, k, kk, a, kk1; f32x4 w; u16 v; };
  auto gload = [&](Stg& g, int c) {
    const size_t o = (tokb + (size_t)c * 16 + st) * 256 + chan0;
    g.r = *(const u32x2*)(SR + o + cg4 * 4); g.k = *(const u32x2*)(SK + o + cg4 * 4);
    g.kk = *(const u32x2*)(SKK + o + cg4 * 4); g.a = *(const u32x2*)(SA + o + cg4 * 4);
    g.w = *(const f32x4*)(SW + o + cg4 * 4);
    g.v = SV[o + q * 16 + cg4];
    int t1 = c * 16 + st + 1; if (t1 >= SEQ) t1 = SEQ - 1;
    g.kk1 = *(const u32x2*)(SKK + (tokb + (size_t)t1) * 256 + chan0 + cg4 * 4);
  };
  auto lwrite = [&](const Stg& g, int buf) {
    float* bp = lbase + buf * BUFF;
    const int o = st * 64 + cg4 * 4;
    f32x4 kk = {bflo(g.kk.x), bfhi(g.kk.x), bflo(g.kk.y), bfhi(g.kk.y)};
    f32x4 a = {bflo(g.a.x), bfhi(g.a.x), bflo(g.a.y), bfhi(g.a.y)};
    f32x4 k = {bflo(g.k.x), bfhi(g.k.x), bflo(g.k.y), bfhi(g.k.y)};
    f32x4 r = {bflo(g.r.x), bfhi(g.r.x), bflo(g.r.y), bfhi(g.r.y)};
    *(f32x4*)(bp + o) = kk;
    *(f32x4*)(bp + 1024 + o) = kk * a;
    *(f32x4*)(bp + 2048 + o) = k;
    *(f32x4*)(bp + 3072 + o) = g.w;
    *(f32x4*)(bp + 4096 + o) = r;
    bp[5120 + st * 16 + cg4] = bf2f(g.v);
    const f32x4 kn = {bflo(g.kk1.x), bfhi(g.kk1.x), bflo(g.kk1.y), bfhi(g.kk1.y)};
    *(f32x4*)(bp + 5376 + o) = g.w * kn;
    const f32x4 bb = kk * a;
    const float c1 = row_sum16(k.x * kn.x + k.y * kn.y + k.z * kn.z + k.w * kn.w);
    const float c2 = row_sum16(bb.x * kn.x + bb.y * kn.y + bb.z * kn.z + bb.w * kn.w);
    if (cg4 == 0) *(f32x2*)(bp + 6400 + st * 2) = f32x2{c1, c2};
  };
  constexpr int NCH = SEQ / 16;
  Stg R0, R1, R2, R3;
  gload(R0, 0); gload(R1, 1); gload(R2, 2); gload(R3, 3);
  __syncthreads();
  lwrite(R0, 0);
  __syncthreads();
  __builtin_amdgcn_s_setprio(3);
  float S0 = 0.f, S1 = 0.f, S2 = 0.f, S3 = 0.f;
  const int rrow = lane & 3, rstep = lane >> 2;
  struct Pair { f32x4 kkA, bbA, kA, wA, rA, mA, bbB, kB, wB, rB; f32x2 cA; float vA, vB; };
  auto chunk = [&](int c) {
    const float* bp = lbase + (c & 1) * BUFF;
    auto ldpair = [&](Pair& o, int s) {
      o.kkA = *(const f32x4*)(bp + s * 64 + cl * 4);
      o.mA = *(const f32x4*)(bp + 5376 + s * 64 + cl * 4);
      o.bbA = *(const f32x4*)(bp + 1024 + s * 64 + cl * 4);
      o.kA = *(const f32x4*)(bp + 2048 + s * 64 + cl * 4);
      o.wA = *(const f32x4*)(bp + 3072 + s * 64 + cl * 4);
      o.rA = *(const f32x4*)(bp + 4096 + s * 64 + cl * 4);
      o.vA = bp[5120 + s * 16 + rloc];
      o.cA = *(const f32x2*)(bp + 6400 + s * 2);
      o.bbB = *(const f32x4*)(bp + 1024 + (s + 1) * 64 + cl * 4);
      o.kB = *(const f32x4*)(bp + 2048 + (s + 1) * 64 + cl * 4);
      o.wB = *(const f32x4*)(bp + 3072 + (s + 1) * 64 + cl * 4);
      o.rB = *(const f32x4*)(bp + 4096 + (s + 1) * 64 + cl * 4);
      o.vB = bp[5120 + (s + 1) * 16 + rloc];
    };
    auto pairstep = [&](const Pair& o, int s) {
      const float pa = __builtin_fmaf(S3, o.kkA.w, __builtin_fmaf(S2, o.kkA.z, __builtin_fmaf(S1, o.kkA.y, S0 * o.kkA.x)));
      const float pd = __builtin_fmaf(S3, o.mA.w, __builtin_fmaf(S2, o.mA.z, __builtin_fmaf(S1, o.mA.y, S0 * o.mA.x)));
      const float saA = row_sum16(pa);
      const float dd = row_sum16(pd);
      const float saB = __builtin_fmaf(-saA, o.cA.y, __builtin_fmaf(o.vA, o.cA.x, dd));
      S0 = __builtin_fmaf(S0, o.wA.x, __builtin_fmaf(o.vA, o.kA.x, -(saA * o.bbA.x)));
      S1 = __builtin_fmaf(S1, o.wA.y, __builtin_fmaf(o.vA, o.kA.y, -(saA * o.bbA.y)));
      S2 = __builtin_fmaf(S2, o.wA.z, __builtin_fmaf(o.vA, o.kA.z, -(saA * o.bbA.z)));
      S3 = __builtin_fmaf(S3, o.wA.w, __builtin_fmaf(o.vA, o.kA.w, -(saA * o.bbA.w)));
      pp[(s * 4 + rl) * 16 + cl] = __builtin_fmaf(S3, o.rA.w, __builtin_fmaf(S2, o.rA.z, __builtin_fmaf(S1, o.rA.y, S0 * o.rA.x)));
      S0 = __builtin_fmaf(S0, o.wB.x, __builtin_fmaf(o.vB, o.kB.x, -(saB * o.bbB.x)));
      S1 = __builtin_fmaf(S1, o.wB.y, __builtin_fmaf(o.vB, o.kB.y, -(saB * o.bbB.y)));
      S2 = __builtin_fmaf(S2, o.wB.z, __builtin_fmaf(o.vB, o.kB.z, -(saB * o.bbB.z)));
      S3 = __builtin_fmaf(S3, o.wB.w, __builtin_fmaf(o.vB, o.kB.w, -(saB * o.bbB.w)));
      pp[((s + 1) * 4 + rl) * 16 + cl] = __builtin_fmaf(S3, o.rB.w, __builtin_fmaf(S2, o.rB.z, __builtin_fmaf(S1, o.rB.y, S0 * o.rB.x)));
    };
    Pair p0, p1;
    ldpair(p0, 0);
#pragma unroll
    for (int j = 0; j < 4; ++j) {
      ldpair(p1, 4 * j + 2);
      __builtin_amdgcn_sched_barrier(0);
      pairstep(p0, 4 * j);
      __builtin_amdgcn_sched_barrier(0);
      if (j < 3) ldpair(p0, 4 * j + 4);
      __builtin_amdgcn_sched_barrier(0);
      pairstep(p1, 4 * j + 2);
      __builtin_amdgcn_sched_barrier(0);
    }
    asm volatile("" ::: "memory");
    {
      const float* q0 = pp + (rstep * 4 + rrow) * 16;
      f32x4 a0 = *(const f32x4*)(q0), a1 = *(const f32x4*)(q0 + 4), a2 = *(const f32x4*)(q0 + 8), a3 = *(const f32x4*)(q0 + 12);
      f32x4 sm4 = (a0 + a1) + (a2 + a3);
      O[(tokb + (size_t)c * 16 + rstep) * 256 + chan0 + q * 16 + wv * 4 + rrow] = (sm4.x + sm4.y) + (sm4.z + sm4.w);
    }
    asm volatile("" ::: "memory");
  };
#pragma unroll 1
  for (int g = 0; g < NCH / 4; ++g) {
    const int c0 = g * 4;
    if (c0 + 4 < NCH) gload(R0, c0 + 4);
    chunk(c0);
    lwrite(R1, (c0 + 1) & 1);
    lds_barrier();
    if (c0 + 5 < NCH) gload(R1, c0 + 5);
    chunk(c0 + 1);
    lwrite(R2, (c0 + 2) & 1);
    lds_barrier();
    if (c0 + 6 < NCH) gload(R2, c0 + 6);
    chunk(c0 + 2);
    lwrite(R3, (c0 + 3) & 1);
    lds_barrier();
    if (c0 + 7 < NCH) gload(R3, c0 + 7);
    chunk(c0 + 3);
    if (c0 + 4 < NCH) lwrite(R0, (c0 + 4) & 1);
    lds_barrier();
  }
  __builtin_amdgcn_s_setprio(0);
}

__device__ __forceinline__ void rwkv_post_item(const Params& p, int l, int item) {
  const int j = TIDX;
  const float* O = (const float*)(p.ws + OFF_O);
  const u16* SR = (const u16*)(p.ws + OFF_SR); const u16* SK = (const u16*)(p.ws + OFF_SK);
  const u16* SV = (const u16*)(p.ws + OFF_SV); const u16* G = (const u16*)(p.ws + OFF_G);
  u16* OG = (u16*)(p.ws + OFF_OG);
  const float lw = p.in[18][l * 256 + j], lb = p.in[19][l * 256 + j], rk = p.in[17][l * 256 + j];
  const int tok0 = item * 8;
  float ov[8]; u16 rr[8], rkk[8], rv[8], rg[8];
#pragma unroll
  for (int t = 0; t < 8; ++t) {
    const size_t o = (size_t)(tok0 + t) * 256 + j;
    ov[t] = O[o]; rr[t] = SR[o]; rkk[t] = SK[o]; rv[t] = SV[o]; rg[t] = G[o];
  }
#pragma unroll
  for (int t = 0; t < 8; ++t) {
    const size_t o = (size_t)(tok0 + t) * 256 + j;
    float mean = wave_sum(ov[t]) * (1.f / 64.f);
    float d = ov[t] - mean;
    float var = wave_sum(d * d) * (1.f / 64.f);
    float on = d * rsqrtf(var + 64e-5f) * lw + lb;
    float bonus = wave_sum(bf2f(rr[t]) * bf2f(rkk[t]) * rk);
    OG[o] = f2bf((on + bonus * bf2f(rv[t])) * bf2f(rg[t]));
  }
}

#define XB_TMO      128
#define XB_XCNT(j)  (256  + 64 * (j))
#define XB_XSUB(j)  (1280 + 64 * (j))
#define XB_XGEN(j)  (2304 + 64 * (j))
#define XB_TOP      3328
#define XB_TOPGEN   3392
#define XCD_BAR_WORDS 3456
#define XB_SPIN_CAP (1u << 22)
#define LAS __attribute__((address_space(3)))
__device__ __forceinline__ unsigned xb_ld(unsigned* p) { return __hip_atomic_load(p, __ATOMIC_RELAXED, __HIP_MEMORY_SCOPE_AGENT); }
__device__ __forceinline__ unsigned xb_add(unsigned* p, unsigned v) { return __hip_atomic_fetch_add(p, v, __ATOMIC_RELAXED, __HIP_MEMORY_SCOPE_AGENT); }
__device__ __forceinline__ unsigned xb_xcc_id() { return (unsigned)__builtin_amdgcn_s_getreg((3 << 11) | 20) & 0xFu; }
#define XB_SPIN(cond, bar) do { unsigned _sp = 0; while (cond) { __builtin_amdgcn_s_sleep(1); \
    if ((++_sp & 255u) == 0u) { if (xb_ld(&(bar)[XB_TMO])) break; if (_sp > XB_SPIN_CAP) { atomicAdd(&(bar)[XB_TMO], 1u); break; } } } } while (0)
struct XcdBarrier { unsigned* bar; unsigned x; volatile LAS unsigned* st; };
__device__ __forceinline__ XcdBarrier xcd_barrier_post(unsigned* bar, volatile LAS unsigned* st) {
  XcdBarrier b; b.bar = bar; b.x = xb_xcc_id(); b.st = st;
  if (threadIdx.x == 0) st[2] = xb_add(&bar[XB_XCNT(b.x)], 1u);
  return b;
}
__device__ __forceinline__ void xcd_barrier_complete(unsigned* bar, unsigned x, unsigned& nloc, unsigned& nx) {
  const unsigned G = gridDim.x * gridDim.y * gridDim.z;
  unsigned sum, cnt, mine, sp = 0u;
  for (;;) {
    sum = 0u; cnt = 0u; mine = 0u;
#pragma unroll
    for (unsigned j = 0; j < 16; ++j) { const unsigned c = xb_ld(&bar[XB_XCNT(j)]); sum += c; cnt += (c > 0u) ? 1u : 0u; mine = (j == x) ? c : mine; }
    if (sum == G) break;
    __builtin_amdgcn_s_sleep(1);
    if ((++sp & 255u) == 0u) { if (xb_ld(&bar[XB_TMO])) break; if (sp > XB_SPIN_CAP) { atomicAdd(&bar[XB_TMO], 1u); break; } }
  }
  nloc = mine > 0u ? mine : 1u; nx = cnt > 0u ? cnt : 1u;
}
__device__ __forceinline__ void xcd_barrier(const XcdBarrier& b) {
  asm volatile("s_waitcnt vmcnt(0)" ::: "memory");
  __syncthreads();
  if (threadIdx.x == 0) {
    unsigned* bar = b.bar;
    __builtin_amdgcn_s_waitcnt(0);
    unsigned nloc = b.st[0], nx = b.st[1];
    if (nloc == 0u) { xcd_barrier_complete(bar, b.x, nloc, nx); b.st[0] = nloc; b.st[1] = nx; }
    const unsigned old = xb_add(&bar[XB_XSUB(b.x)], 1u);
    const unsigned gen = old / nloc;
    if (old + 1u == (gen + 1u) * nloc) {
      __builtin_amdgcn_fence(__ATOMIC_RELEASE, "agent");
      asm volatile("s_waitcnt vmcnt(0)" ::: "memory");
      const unsigned og = xb_add(&bar[XB_TOP], 1u);
      const unsigned tg = og / nx;
      if (og + 1u == (tg + 1u) * nx) xb_add(&bar[XB_TOPGEN], 1u);
      else XB_SPIN(xb_ld(&bar[XB_TOPGEN]) == tg, bar);
      __builtin_amdgcn_fence(__ATOMIC_ACQUIRE, "agent");
      xb_add(&bar[XB_XGEN(b.x)], 1u);
      asm volatile("s_waitcnt vmcnt(0)" ::: "memory");
    } else {
      XB_SPIN(xb_ld(&bar[XB_XGEN(b.x)]) == gen, bar);
      __builtin_amdgcn_fence(__ATOMIC_ACQUIRE, "agent");
      asm volatile("s_waitcnt vmcnt(0)" ::: "memory");
    }
  }
  __syncthreads();
}

__device__ __forceinline__ int xcd_virtual_id(const XcdBarrier& b) {
  if (threadIdx.x == 0) {
    unsigned base = 0u;
#pragma unroll
    for (unsigned j = 0; j < 16; ++j) { const unsigned c = xb_ld(&b.bar[XB_XCNT(j)]); base += (j < b.x) ? c : 0u; }
    b.st[3] = base + b.st[2];
  }
  __syncthreads();
  const int vb = __builtin_amdgcn_readfirstlane((int)b.st[3]);
  __syncthreads();
  return vb;
}

__device__ __forceinline__ void sub_barrier(unsigned* cnt, unsigned target) {
  asm volatile("s_waitcnt vmcnt(0)" ::: "memory");
  __syncthreads();
  if (threadIdx.x == 0) {
    __builtin_amdgcn_fence(__ATOMIC_RELEASE, "agent");
    asm volatile("s_waitcnt vmcnt(0)" ::: "memory");
    xb_add(cnt, 1u);
    unsigned sp = 0;
    while (xb_ld(cnt) < target) { __builtin_amdgcn_s_sleep(2); if (++sp > (1u << 24)) break; }
    __builtin_amdgcn_fence(__ATOMIC_ACQUIRE, "agent");
    asm volatile("s_waitcnt vmcnt(0)" ::: "memory");
  }
  __syncthreads();
}

#define N_PHASES 22
#ifndef PROBE_CONV_REPS
#define PROBE_CONV_REPS 1
#endif
#ifndef PROBE_PREP_REPS
#define PROBE_PREP_REPS 1
#endif
#ifndef PROBE_POST_REPS
#define PROBE_POST_REPS 1
#endif
#ifndef PROBE_SCAN_REPS
#define PROBE_SCAN_REPS 1
#endif
#ifndef PROBE_FFN1_REPS
#define PROBE_FFN1_REPS 1
#endif
#ifndef PH_MASK
#define PH_MASK 0xFFFFF
#endif
#define PHON(s) (PH_MASK & (1 << (s)))
#define PHASE_BEGIN(k) if (ph_hi > (k)) { if ((k) > 1) xcd_barrier(xb);
#define PHASE_END }

template <int L>
__device__ __forceinline__ void run_layer(const Params& p, int vbr, int ph_hi, unsigned char* smem_all, const XcdBarrier& xb) {
  unsigned char* smem = smem_all + SUBB * 73728;
  const int vb = vbr * 2 + SUBB;
  constexpr int l = L;
  constexpr int base = 1 + 10 * L;
  const float* modl = (const float*)(p.ws + OFF_MOD) + (size_t)l * 4 * 6144;
  PHASE_BEGIN(base + 0)
    for (int rep = 0; rep < PROBE_CONV_REPS; ++rep) {
      if (rep) xcd_barrier(xb);
      phase_convert(p, l, smem);
      phase_norm(l == 0 ? p.in[0] : p.out, p.in[4] + l * 1024, modl, 0, 1024, (u16*)(p.ws + OFF_H));
    }
  PHASE_END
  PHASE_BEGIN(base + 1)
    phase_gemm<0>(p, l, vb, smem);
  PHASE_END
  PHASE_BEGIN(base + 2)
    for (int rep = 0; rep < PROBE_PREP_REPS; ++rep) {
      if (rep) xcd_barrier(xb);
      for (int item = VBLK; item < 512; item += VGRID) rwkv_prep_item(p, l, item, smem);
    }
  PHASE_END
  PHASE_BEGIN(base + 3)
    if ((int)blockIdx.x < 64) {
      if (SUBB == 0) scan_item(p, blockIdx.x, smem);
      else { __syncthreads(); __syncthreads(); for (int c = 0; c < SEQ / 16; ++c) lds_barrier(); }
    }
    else {
      const int nb = VGRID - 128, bi = VBLK - 128;
      for (int item = bi; item < 512; item += nb) sg_item(p, l, item, smem);
      for (int item = (bi + 64) % nb; item < 1024; item += nb) s5a_item(p, l, item, smem);
      for (int item = bi; item < 2048; item += nb) conv_item(p, l, item);
      sub_barrier((unsigned*)(p.ws + OFF_BAR) + 3520 + 64 * (2 * l), gridDim.x - 64);
      for (int item = bi; item < 1024; item += nb) s5b_item(p, l, item, smem);
      sub_barrier((unsigned*)(p.ws + OFF_BAR) + 3520 + 64 * (2 * l + 1), gridDim.x - 64);
      for (int item = (int)blockIdx.x - 64; item < 512; item += (int)gridDim.x - 64) merge_tile8<0>(p, item, smem_all);
    }
  PHASE_END
  PHASE_BEGIN(base + 4)
    for (int rep = 0; rep < PROBE_POST_REPS; ++rep) { if (rep) xcd_barrier(xb); for (int item = VBLK; item < 2048; item += VGRID) rwkv_post_item(p, l, item); }
  PHASE_END
  PHASE_BEGIN(base + 5)
    for (int item = vbr; item < 512; item += (int)gridDim.x) {
      int it2 = item;
      if (gridDim.x == 256) { const int r = item >> 8, w = vbr & 31; it2 = ((r * 4 + (w >> 3)) << 6) | ((vbr >> 5) * 8 + (w & 7)); }
      merge_tile8<1>(p, it2, smem_all);
    }
  PHASE_END
  PHASE_BEGIN(base + 6)
    phase_gemm_8w<1>(p, l, vbr, smem_all);
  PHASE_END
  PHASE_BEGIN(base + 7)
    if (PHON(7)) phase_norm(p.out, p.in[38] + l * 1024, modl, 3072, 4096, (u16*)(p.ws + OFF_H));
  PHASE_END
  PHASE_BEGIN(base + 8)
    phase_gemm_8w<2>(p, l, vbr, smem_all);
  PHASE_END
#ifdef PROBE_DUP_FFN1
  PHASE_BEGIN(base + 8)
    phase_gemm_8w<2>(p, l, vbr, smem_all);
  PHASE_END
#endif
  PHASE_BEGIN(base + 9)
    phase_gemm_8w<3>(p, l, vbr, smem_all);
  PHASE_END
}

__global__ void __launch_bounds__(512, 2) mega_fwd(Params p, int ph_lo, int ph_hi) {
  __shared__ __attribute__((aligned(16))) unsigned char smem[2 * 73728 + 16];
  cg::grid_group grid = cg::this_grid();
  if (ph_hi < 0) grid.sync();
  volatile LAS unsigned* st = (volatile LAS unsigned*)(smem + 2 * 73728);
  if (threadIdx.x == 0) { st[0] = 0u; st[1] = 0u; st[2] = 0u; st[3] = 0u; }
  __syncthreads();
  const XcdBarrier xb = xcd_barrier_post((unsigned*)(p.ws + OFF_BAR), st);
  if (ph_hi > 0) phase_mod(p, smem + SUBB * 73728);
  xcd_barrier(xb);
  const int vb = xcd_virtual_id(xb);
  run_layer<0>(p, vb, ph_hi, smem, xb);
  run_layer<1>(p, vb, ph_hi, smem, xb);
  PHASE_BEGIN(21)
    if (PHON(11)) phase_final(p.out, p.in[41]);
  PHASE_END
}

extern "C" void kernel_launch(void* const* d_in, const int* in_sizes, int n_in, void* d_out, int out_size, void* d_ws,
                              size_t ws_size, hipStream_t stream) {
  static int grid_blocks = 0;
  if (!grid_blocks) {
    int dev = 0, cus = 0, per_cu = 0;
    hipGetDevice(&dev);
    hipDeviceGetAttribute(&cus, hipDeviceAttributeMultiprocessorCount, dev);
    hipOccupancyMaxActiveBlocksPerMultiprocessor(&per_cu, mega_fwd, 512, 0);
    if (per_cu > 1) per_cu = 1;
    if (per_cu < 1) per_cu = 1;
    grid_blocks = cus * per_cu;
    if (ws_size < WS_END) fprintf(stderr, "workspace too small: %zu < %zu\n", ws_size, (size_t)WS_END);
  }
  Params p{};
  for (int i = 0; i < 42; ++i) p.in[i] = (const float*)d_in[i];
  p.out = (float*)d_out;
  p.ws = (unsigned char*)d_ws;
  hipMemsetAsync((unsigned char*)d_ws + OFF_BAR, 0, 16384, stream);
  int lo = 0, hi = N_PHASES;
  void* args[] = {&p, &lo, &hi};
  hipError_t e = hipLaunchCooperativeKernel((void*)mega_fwd, dim3(grid_blocks), dim3(512), args, 0, stream);
  if (e != hipSuccess) fprintf(stderr, "cooperative launch failed: %s (grid %d)\n", hipGetErrorString(e), grid_blocks);
}
```

```cpp
#include <hip/hip_runtime.h>
#include <hip/hip_cooperative_groups.h>
#include <cstdio>
namespace cg = cooperative_groups;

typedef unsigned short u16;
using bf16x8 = __attribute__((ext_vector_type(8))) short;
using f32x4 = __attribute__((ext_vector_type(4))) float;
using u32x4 = __attribute__((ext_vector_type(4))) unsigned int;
using u32x2 = __attribute__((ext_vector_type(2))) unsigned int;
using f32x2 = __attribute__((ext_vector_type(2))) float;

#define T_TOK 16384
#define SEQ 4096
#define DM 1024
#define NTHR 256
#define TIDX ((int)(threadIdx.x & 255))
#define SUBB ((int)(threadIdx.x >> 8))
#define VBLK ((int)(blockIdx.x * 2 + (threadIdx.x >> 8)))
#define VGRID ((int)(gridDim.x * 2))

static constexpr size_t SZ_WIN = (size_t)6528 * 1024 * 2;
static constexpr size_t OFF_WIN = 0;
static constexpr size_t OFF_RO = OFF_WIN + SZ_WIN;
static constexpr size_t OFF_SO = OFF_RO + 1024 * 256 * 2;
static constexpr size_t OFF_CO = OFF_SO + 1024 * 256 * 2;
static constexpr size_t OFF_GLU = OFF_CO + 1024 * 256 * 2;
static constexpr size_t OFF_WO = OFF_GLU + 2048 * 256 * 2;
static constexpr size_t OFF_W1 = OFF_WO + 1024 * 1024 * 2;
static constexpr size_t OFF_W2 = OFF_W1 + (size_t)4096 * 1024 * 2;
static constexpr size_t OFF_H = OFF_W2 + (size_t)4096 * 1024 * 2;
static constexpr size_t SZ_T256B = (size_t)T_TOK * 256 * 2;
static constexpr size_t OFF_VF = OFF_H + (size_t)T_TOK * 1024 * 2;
static constexpr size_t OFF_PD = OFF_VF + SZ_T256B;
static constexpr size_t OFF_G = OFF_PD + SZ_T256B;
static constexpr size_t OFF_UB = OFF_G + SZ_T256B;
static constexpr size_t OFF_CB = OFF_UB + SZ_T256B;
static constexpr size_t OFF_SR = OFF_CB + SZ_T256B;
static constexpr size_t OFF_SK = OFF_SR + SZ_T256B;
static constexpr size_t OFF_SV = OFF_SK + SZ_T256B;
static constexpr size_t OFF_SKK = OFF_SV + SZ_T256B;
static constexpr size_t OFF_SA = OFF_SKK + SZ_T256B;
static constexpr size_t OFF_SW = OFF_SA + SZ_T256B;
static constexpr size_t OFF_PABC = OFF_SW + 2 * SZ_T256B;
static constexpr size_t OFF_YD = OFF_PABC;
static constexpr size_t OFF_OG = OFF_YD + SZ_T256B;
static constexpr size_t OFF_MRG = OFF_OG + SZ_T256B;
static constexpr size_t OFF_F = OFF_UB;
static constexpr size_t OFF_SMALL = OFF_PABC + (size_t)T_TOK * 2176 * 2;
static constexpr size_t OFF_MOD = OFF_SMALL;
static constexpr size_t OFF_S5AB = OFF_MOD + 2 * 4 * 6144 * 4;
static constexpr size_t OFF_S5BB = OFF_S5AB + 2 * 16 * 64 * 2 * 4;
static constexpr size_t OFF_S5E = OFF_S5BB + 2 * 16 * 64 * 32 * 4;
static constexpr size_t OFF_BAR = OFF_S5E + (size_t)4 * 64 * 16 * 64 * 2 * 4;
static constexpr size_t OFF_SGW = OFF_BAR + 16384;
static constexpr size_t OFF_O = OFF_SGW + 4 * 128 * 128 * 2;
static constexpr size_t OFF_LW2 = OFF_O + 2 * SZ_T256B;
static constexpr size_t OFF_LA2 = OFF_LW2 + 256 * 32 * 2;
static constexpr size_t OFF_LG2 = OFF_LA2 + 256 * 32 * 2;
static constexpr size_t OFF_LV2 = OFF_LG2 + 256 * 64 * 2;
static constexpr size_t OFF_LV1 = OFF_LV2 + 256 * 32 * 2;
static constexpr size_t WS_END = OFF_LV1 + 32 * 256 * 2;
static_assert(OFF_F + (size_t)T_TOK * 4096 * 2 <= OFF_SMALL, "F overlaps small region");
static_assert(OFF_MRG + (size_t)T_TOK * 1024 * 2 <= OFF_SMALL, "MRG overlaps");

struct Params {
  const float* in[42];
  float* out;
  unsigned char* ws;
};

__device__ __forceinline__ u16 f2bf(float f) {
  unsigned u = __float_as_uint(f);
  u += 0x7fffu + ((u >> 16) & 1u);
  return (u16)(u >> 16);
}
__device__ __forceinline__ float bf2f(u16 h) { return __uint_as_float(((unsigned)h) << 16); }
__device__ __forceinline__ float bflo(unsigned u) { return __uint_as_float(u << 16); }
__device__ __forceinline__ float bfhi(unsigned u) { return __uint_as_float(u & 0xffff0000u); }
__device__ __forceinline__ unsigned pack2(float a, float b) { return (unsigned)f2bf(a) | ((unsigned)f2bf(b) << 16); }
__device__ __forceinline__ float sigmoidf_(float x) { return 1.f / (1.f + __expf(-x)); }
__device__ __forceinline__ float tanhf_(float y) { return 1.f - 2.f / (1.f + __expf(2.f * y)); }
__device__ __forceinline__ float geluf_(float x) {
  float y = 0.7978845608028654f * (x + 0.044715f * x * x * x);
  return 0.5f * x * (1.f + tanhf_(y));
}
__device__ __forceinline__ float wave_sum(float v) {
#pragma unroll
  for (int o = 32; o > 0; o >>= 1) v += __shfl_xor(v, o, 64);
  return v;
}
template <int CTRL>
__device__ __forceinline__ float dppf(float x) {
  return __int_as_float(__builtin_amdgcn_update_dpp(__float_as_int(x), __float_as_int(x), CTRL, 0xF, 0xF, true));
}
__device__ __forceinline__ float row_sum16(float x) {
  x += dppf<0x128>(x);
  x += dppf<0x124>(x);
  x += dppf<0x122>(x);
  x += dppf<0x121>(x);
  return x;
}

__device__ __forceinline__ void phase_mod(const Params& p, unsigned char* smem) {
  const int tid = TIDX;
  float* cact = (float*)smem;
  float* red = cact + 4096;
  float* mod = (float*)(p.ws + OFF_MOD);
  for (int i = tid; i < 4096; i += NTHR) { float c = p.in[1][i]; cact[i] = c / (1.f + __expf(-c)); }
  __syncthreads();
  for (int item = VBLK; item < 192; item += VGRID) {
    int l = item / 96, nb = item % 96;
    int cl = tid & 63, kq = tid >> 6;
    int col = nb * 64 + cl;
    const float* W = p.in[2] + (size_t)l * 1024 * 6144;
    float a0 = 0, a1 = 0, a2 = 0, a3 = 0;
    for (int k = kq * 256; k < kq * 256 + 256; ++k) {
      float w = W[(size_t)k * 6144 + col];
      a0 += cact[k] * w; a1 += cact[1024 + k] * w; a2 += cact[2048 + k] * w; a3 += cact[3072 + k] * w;
    }
    red[(kq * 4 + 0) * 64 + cl] = a0; red[(kq * 4 + 1) * 64 + cl] = a1;
    red[(kq * 4 + 2) * 64 + cl] = a2; red[(kq * 4 + 3) * 64 + cl] = a3;
    __syncthreads();
    {
      int b = tid >> 6;
      float s = red[(0 * 4 + b) * 64 + cl] + red[(1 * 4 + b) * 64 + cl] + red[(2 * 4 + b) * 64 + cl] + red[(3 * 4 + b) * 64 + cl];
      mod[((size_t)l * 4 + b) * 6144 + col] = s + p.in[3][l * 6144 + col];
    }
    __syncthreads();
  }
  float* s5ab = (float*)(p.ws + OFF_S5AB);
  float* s5bb = (float*)(p.ws + OFF_S5BB);
  for (int idx = VBLK * NTHR + tid; idx < 2048; idx += VGRID * NTHR) {
    int l = idx >> 10, g = (idx >> 6) & 15, n = idx & 63;
    double lre = fmin((double)p.in[28][idx], -1e-4);
    double lim = (double)p.in[29][idx];
    double dt = exp((double)p.in[35][l * 16 + g]);
    double mag = exp(lre * dt);
    double abr = mag * cos(lim * dt), abi = mag * sin(lim * dt);
    double den = lre * lre + lim * lim;
    double qr = ((abr - 1.0) * lre + abi * lim) / den;
    double qi = (abi * lre - (abr - 1.0) * lim) / den;
    s5ab[idx * 2 + 0] = (float)abr; s5ab[idx * 2 + 1] = (float)abi;
    for (int c = 0; c < 16; ++c) {
      double br = p.in[30][(size_t)idx * 16 + c], bi = p.in[31][(size_t)idx * 16 + c];
      s5bb[(size_t)idx * 32 + c] = (float)(qr * br - qi * bi);
      s5bb[(size_t)idx * 32 + 16 + c] = (float)(qr * bi + qi * br);
    }
  }
}

__device__ __forceinline__ void convert_tile(const float* __restrict__ src, int K, int N, u16* __restrict__ dst, int tk, int tn, u16* sm) {
  const int tid = TIDX;
  int r = tid >> 4, c4 = (tid & 15) * 4;
#pragma unroll
  for (int i = 0; i < 4; ++i) {
    int kk = r + 16 * i;
    float4 v = *(const float4*)(src + (size_t)(tk * 64 + kk) * N + tn * 64 + c4);
    sm[(c4 + 0) * 72 + kk] = f2bf(v.x);
    sm[(c4 + 1) * 72 + kk] = f2bf(v.y);
    sm[(c4 + 2) * 72 + kk] = f2bf(v.z);
    sm[(c4 + 3) * 72 + kk] = f2bf(v.w);
  }
  __syncthreads();
#pragma unroll
  for (int j = 0; j < 2; ++j) {
    int n = (tid >> 3) + 32 * j, ch = tid & 7;
    u32x4 v = *(const u32x4*)(sm + n * 72 + ch * 8);
    *(u32x4*)(dst + (size_t)(tn * 64 + n) * K + tk * 64 + ch * 8) = v;
  }
  __syncthreads();
}

__device__ __forceinline__ void phase_convert(const Params& p, int l, unsigned char* smem) {
  u16* sm = (u16*)smem;
  const int total = 1632 + 192 + 128 + 256 + 1024 + 1024;
  for (int item = VBLK; item < total + 16 + 192; item += VGRID) {
    int t = item;
    if (t >= total + 16) {
      const int e = (t - total - 16) * 256 + TIDX;
      if (e < 8192) { const int n = e >> 5, k = e & 31; ((u16*)(p.ws + OFF_LW2))[e] = f2bf(p.in[8][(size_t)l * 8192 + k * 256 + n]); }
      else if (e < 16384) { const int q = e - 8192, n = q >> 5, k = q & 31; ((u16*)(p.ws + OFF_LA2))[q] = f2bf(p.in[10][(size_t)l * 8192 + k * 256 + n]); }
      else if (e < 32768) { const int q = e - 16384, n = q >> 6, k = q & 63; ((u16*)(p.ws + OFF_LG2))[q] = f2bf(p.in[11][(size_t)l * 16384 + k * 256 + n]); }
      else if (e < 40960) { const int q = e - 32768, n = q >> 5, k = q & 31; ((u16*)(p.ws + OFF_LV2))[q] = (l > 0) ? f2bf(p.in[14][k * 256 + n]) : (u16)0; }
      else { const int q = e - 40960, n = q >> 8, k = q & 255; ((u16*)(p.ws + OFF_LV1))[q] = (l > 0) ? f2bf(p.in[13][k * 32 + n]) : (u16)0; }
      continue;
    }
    if (t >= total) {
      const int idx = t - total, g = idx >> 2, rq = idx & 3;
      const int tr = rq * 32 + (TIDX >> 3), s0 = (TIDX & 7) * 16;
      const float* src = p.in[23] + (((size_t)l * 4 + g) * 128 + tr) * 128 + s0;
      u16* dst = (u16*)(p.ws + OFF_SGW) + ((size_t)g * 128 + tr) * 128 + s0;
      unsigned pk[8];
#pragma unroll
      for (int e = 0; e < 4; ++e) {
        f32x4 v = *(const f32x4*)(src + e * 4);
        const int sb = s0 + e * 4;
        pk[e * 2 + 0] = pack2(sb + 0 <= tr ? v.x : 0.f, sb + 1 <= tr ? v.y : 0.f);
        pk[e * 2 + 1] = pack2(sb + 2 <= tr ? v.z : 0.f, sb + 3 <= tr ? v.w : 0.f);
      }
      *(u32x4*)(dst) = u32x4{pk[0], pk[1], pk[2], pk[3]};
      *(u32x4*)(dst + 8) = u32x4{pk[4], pk[5], pk[6], pk[7]};
      continue;
    }
    const float* src; int K, N; size_t off;
    if (t < 1632) { src = p.in[5] + (size_t)l * 1024 * 6528; K = 1024; N = 6528; off = OFF_WIN; }
    else if ((t -= 1632) < 64) { src = p.in[20] + (size_t)l * 256 * 1024; K = 256; N = 1024; off = OFF_RO; }
    else if ((t -= 64) < 64) { src = p.in[25] + (size_t)l * 256 * 1024; K = 256; N = 1024; off = OFF_SO; }
    else if ((t -= 64) < 64) { src = p.in[27] + (size_t)l * 256 * 1024; K = 256; N = 1024; off = OFF_CO; }
    else if ((t -= 64) < 128) { src = p.in[36] + (size_t)l * 256 * 2048; K = 256; N = 2048; off = OFF_GLU; }
    else if ((t -= 128) < 256) { src = p.in[37] + (size_t)l * 1024 * 1024; K = 1024; N = 1024; off = OFF_WO; }
    else if ((t -= 256) < 1024) { src = p.in[39] + (size_t)l * 1024 * 4096; K = 1024; N = 4096; off = OFF_W1; }
    else { t -= 1024; src = p.in[40] + (size_t)l * 4096 * 1024; K = 4096; N = 1024; off = OFF_W2; }
    int ntn = N / 64;
    convert_tile(src, K, N, (u16*)(p.ws + off), t / ntn, t % ntn, sm);
  }
}

__device__ __forceinline__ void phase_norm(const float* __restrict__ X, const float* __restrict__ g, const float* __restrict__ modl,
                           int sh_off, int sc_off, u16* __restrict__ H) {
  const int lane = TIDX & 63, wv = TIDX >> 6;
  for (int item = VBLK; item < T_TOK / 4; item += VGRID) {
    int row = item * 4 + wv;
    int b = row >> 12;
    const float* xr = X + (size_t)row * 1024;
    float4 v[4];
    float ss = 0;
#pragma unroll
    for (int i = 0; i < 4; ++i) {
      v[i] = *(const float4*)(xr + lane * 4 + 256 * i);
      ss += v[i].x * v[i].x + v[i].y * v[i].y + v[i].z * v[i].z + v[i].w * v[i].w;
    }
    ss = wave_sum(ss);
    float rstd = rsqrtf(ss * (1.f / 1024.f) + 1e-6f);
    const float* sh = modl + (size_t)b * 6144 + sh_off;
    const float* sc = modl + (size_t)b * 6144 + sc_off;
#pragma unroll
    for (int i = 0; i < 4; ++i) {
      int c = lane * 4 + 256 * i;
      float4 gg = *(const float4*)(g + c);
      float4 s1 = *(const float4*)(sc + c);
      float4 s0 = *(const float4*)(sh + c);
      float h0 = v[i].x * rstd * gg.x * (1.f + s1.x) + s0.x;
      float h1 = v[i].y * rstd * gg.y * (1.f + s1.y) + s0.y;
      float h2 = v[i].z * rstd * gg.z * (1.f + s1.z) + s0.z;
      float h3 = v[i].w * rstd * gg.w * (1.f + s1.w) + s0.w;
      u32x2 o; o.x = pack2(h0, h1); o.y = pack2(h2, h3);
      *(u32x2*)(H + (size_t)row * 1024 + c) = o;
    }
  }
}

__device__ __forceinline__ void phase_final(float* __restrict__ X, const float* __restrict__ g) {
  const int lane = TIDX & 63, wv = TIDX >> 6;
  for (int item = VBLK; item < T_TOK / 4; item += VGRID) {
    int row = item * 4 + wv;
    float* xr = X + (size_t)row * 1024;
    float4 v[4];
    float ss = 0;
#pragma unroll
    for (int i = 0; i < 4; ++i) {
      v[i] = *(const float4*)(xr + lane * 4 + 256 * i);
      ss += v[i].x * v[i].x + v[i].y * v[i].y + v[i].z * v[i].z + v[i].w * v[i].w;
    }
    ss = wave_sum(ss);
    float rstd = rsqrtf(ss * (1.f / 1024.f) + 1e-6f);
#pragma unroll
    for (int i = 0; i < 4; ++i) {
      int c = lane * 4 + 256 * i;
      float4 gg = *(const float4*)(g + c);
      float4 o;
      o.x = v[i].x * rstd * gg.x; o.y = v[i].y * rstd * gg.y; o.z = v[i].z * rstd * gg.z; o.w = v[i].w * rstd * gg.w;
      *(float4*)(xr + c) = o;
    }
  }
}

template <int NF, bool LEAN = false>
__device__ __forceinline__ void gemm_mainloop(const u16* __restrict__ A, int lda, const u16* __restrict__ B, int ldb,
                                              int K, f32x4 (&acc)[4][NF], u16* smem) {
  constexpr int BN = 32 * NF;
  constexpr int NB = BN / 32;
  u16* sA = smem;
  u16* sB = smem + 2 * 128 * 64;
  int tz = 0;
  if (LEAN) asm volatile("" : "+v"(tz));
  const int tid = TIDX + tz, lane = tid & 63, wv = tid >> 6;
  const int wm = wv >> 1, wn = wv & 1;
  const int lrow = tid >> 3;
  const int lchs = (tid & 7) ^ ((lrow >> 1) & 7);
  const u16* Ap = A + (size_t)lrow * lda + lchs * 8;
  const u16* Bp = B + (size_t)lrow * ldb + lchs * 8;
  const int nk = K >> 6;
  auto stage = [&](int kt, int buf) {
    const int ko = kt << 6;
#pragma unroll
    for (int i = 0; i < 4; ++i)
      __builtin_amdgcn_global_load_lds((const unsigned*)(Ap + (size_t)(32 * i) * lda + ko),
                                       (__attribute__((address_space(3))) unsigned*)(sA + buf * (128 * 64) + (tid + 256 * i) * 8), 16, 0, 0);
#pragma unroll
    for (int i = 0; i < NB; ++i)
      __builtin_amdgcn_global_load_lds((const unsigned*)(Bp + (size_t)(32 * i) * ldb + ko),
                                       (__attribute__((address_space(3))) unsigned*)(sB + buf * (BN * 64) + (tid + 256 * i) * 8), 16, 0, 0);
  };
  __syncthreads();
  stage(0, 0);
  const int fr = lane & 15, fq = lane >> 4;
  const int sw = (fr >> 1) & 7;
  for (int kt = 0; kt < nk; ++kt) {
    const int cur = kt & 1;
    asm volatile("s_waitcnt vmcnt(0)" ::: "memory");
    __syncthreads();
    if (kt + 1 < nk) stage(kt + 1, cur ^ 1);
    const u16* cA = sA + cur * (128 * 64) + (wm * 64 + fr) * 64;
    const u16* cB = sB + cur * (BN * 64) + (wn * 16 * NF + fr) * 64;
#pragma unroll
    for (int ks = 0; ks < 2; ++ks) {
      if (LEAN) __builtin_amdgcn_sched_barrier(0);
      const int pc = ((fq + 4 * ks) ^ sw) << 3;
      bf16x8 fa[4], fb[NF];
#pragma unroll
      for (int i = 0; i < 4; ++i) fa[i] = *(const bf16x8*)(cA + i * 16 * 64 + pc);
#pragma unroll
      for (int j = 0; j < NF; ++j) fb[j] = *(const bf16x8*)(cB + j * 16 * 64 + pc);
#pragma unroll
      for (int i = 0; i < 4; ++i)
#pragma unroll
        for (int j = 0; j < NF; ++j)
          acc[i][j] = __builtin_amdgcn_mfma_f32_16x16x32_bf16(fb[j], fa[i], acc[i][j], 0, 0, 0);
    }
  }
}

template <int NF>
__device__ __forceinline__ void zero_acc(f32x4 (&acc)[4][NF]) {
#pragma unroll
  for (int i = 0; i < 4; ++i)
#pragma unroll
    for (int j = 0; j < NF; ++j) acc[i][j] = f32x4{0.f, 0.f, 0.f, 0.f};
}

__device__ __forceinline__ void gemm_mainloop_8w(const u16* __restrict__ A, int lda, const u16* __restrict__ B, int ldb,
                                                 int K, f32x4 (&acc)[8][4], u16* smem) {
  constexpr int STG = 32768;
  const int tid = threadIdx.x, lane = tid & 63, wv = tid >> 6;
  const int wm = wv >> 2, wn = wv & 3;
  const int lrow = tid >> 3;
  const int lchs = (tid & 7) ^ ((lrow >> 1) & 7);
  const u16* Ap = A + (size_t)lrow * lda + lchs * 8;
  const u16* Bp = B + (size_t)lrow * ldb + lchs * 8;
  const int nk = K >> 6;
  auto stage = [&](int kt, int buf) {
    const int ko = kt << 6;
    u16* sa = smem + buf * STG;
#pragma unroll
    for (int i = 0; i < 4; ++i)
      __builtin_amdgcn_global_load_lds((const unsigned*)(Ap + (size_t)(64 * i) * lda + ko),
                                       (__attribute__((address_space(3))) unsigned*)(sa + (tid + 512 * i) * 8), 16, 0, 0);
#pragma unroll
    for (int i = 0; i < 4; ++i)
      __builtin_amdgcn_global_load_lds((const unsigned*)(Bp + (size_t)(64 * i) * ldb + ko),
                                       (__attribute__((address_space(3))) unsigned*)(sa + 16384 + (tid + 512 * i) * 8), 16, 0, 0);
  };
  __syncthreads();
  stage(0, 0);
  const int fr = lane & 15, fq = lane >> 4;
  const int sw = (fr >> 1) & 7;
  for (int kt = 0; kt < nk; ++kt) {
    const int cur = kt & 1;
    asm volatile("s_waitcnt vmcnt(0)" ::: "memory");
    __syncthreads();
    if (kt + 1 < nk) stage(kt + 1, cur ^ 1);
    const u16* cA = smem + cur * STG + (wm * 128 + fr) * 64;
    const u16* cB = smem + cur * STG + 16384 + (wn * 64 + fr) * 64;
#pragma unroll
    for (int ks = 0; ks < 2; ++ks) {
      __builtin_amdgcn_sched_barrier(0);
      const int pc = ((fq + 4 * ks) ^ sw) << 3;
      bf16x8 fa[8], fb[4];
#pragma unroll
      for (int i = 0; i < 8; ++i) fa[i] = *(const bf16x8*)(cA + i * 16 * 64 + pc);
#pragma unroll
      for (int j = 0; j < 4; ++j) fb[j] = *(const bf16x8*)(cB + j * 16 * 64 + pc);
#pragma unroll
      for (int i = 0; i < 8; ++i)
#pragma unroll
        for (int j = 0; j < 4; ++j)
          acc[i][j] = __builtin_amdgcn_mfma_f32_16x16x32_bf16(fb[j], fa[i], acc[i][j], 0, 0, 0);
    }
  }
}

template <int EPI>
__device__ __forceinline__ void phase_gemm_8w(const Params& p, int l, int vb, unsigned char* smem_raw) {
  u16* smem = (u16*)smem_raw;
  const int lane = threadIdx.x & 63, wv = threadIdx.x >> 6;
  const int wm = wv >> 2, wn = wv & 3;
  const int fr = lane & 15, fq = lane >> 4;
  const u16* A; const u16* B; int lda, ldb, K, ntiles_n;
  if (EPI == 1) { A = (const u16*)(p.ws + OFF_MRG); lda = 1024; B = (const u16*)(p.ws + OFF_WO); ldb = 1024; K = 1024; ntiles_n = 4; }
  if (EPI == 2) { A = (const u16*)(p.ws + OFF_H); lda = 1024; B = (const u16*)(p.ws + OFF_W1); ldb = 1024; K = 1024; ntiles_n = 16; }
  if (EPI == 3) { A = (const u16*)(p.ws + OFF_F); lda = 4096; B = (const u16*)(p.ws + OFF_W2); ldb = 4096; K = 4096; ntiles_n = 4; }
  const float* modl = (const float*)(p.ws + OFF_MOD) + (size_t)l * 4 * 6144;
  const int total = 64 * ntiles_n;
  const int G = gridDim.x;
  const bool swz = (G == 256);
  for (int item = vb; item < total; item += G) {
    int mt = item & 63, nt = item >> 6;
    if (swz) { const int r = item >> 8, w = vb & 31; mt = (vb >> 5) * 8 + (w & 7); nt = r * 4 + (w >> 3); }
    const int m0 = mt * 256, n0 = nt * 256;
    f32x4 acc[8][4];
#pragma unroll
    for (int i = 0; i < 8; ++i)
#pragma unroll
      for (int j = 0; j < 4; ++j) acc[i][j] = f32x4{0.f, 0.f, 0.f, 0.f};
    gemm_mainloop_8w(A + (size_t)m0 * lda, lda, B + (size_t)n0 * ldb, ldb, K, acc, smem);
#pragma unroll
    for (int i = 0; i < 8; ++i) {
      const int m = m0 + wm * 128 + i * 16 + fr;
#pragma unroll
      for (int j = 0; j < 4; ++j) {
        const int n = n0 + wn * 64 + j * 16 + fq * 4;
        f32x4 v = acc[i][j];
        if (EPI == 1 || EPI == 3) {
          const int b = m >> 12;
          const float* gt = modl + (size_t)b * 6144 + (EPI == 1 ? 2048 : 5120) + n;
          const float* xin = ((EPI == 1 && l == 0) ? p.in[0] : p.out) + (size_t)m * 1024 + n;
          f32x4 x = *(const f32x4*)xin;
          f32x4 gg = *(const f32x4*)gt;
          *(f32x4*)(p.out + (size_t)m * 1024 + n) = x + gg * v;
        } else {
          float r0 = fmaxf(v[0], 0.f), r1 = fmaxf(v[1], 0.f), r2 = fmaxf(v[2], 0.f), r3 = fmaxf(v[3], 0.f);
          *(u32x2*)((u16*)(p.ws + OFF_F) + (size_t)m * 4096 + n) = u32x2{pack2(r0 * r0, r1 * r1), pack2(r2 * r2, r3 * r3)};
        }
      }
    }
  }
}

template <int EPI>
__device__ __forceinline__ void phase_gemm(const Params& p, int l, int vb, unsigned char* smem_raw) {
  u16* smem = (u16*)smem_raw;
  const int lane = TIDX & 63, wv = TIDX >> 6;
  const int wm = wv >> 1, wn = wv & 1;
  const int fr = lane & 15, fq = lane >> 4;
  const u16* A; const u16* B; int lda, ldb, K, ntiles_n;
  if (EPI == 0) { A = (const u16*)(p.ws + OFF_H); lda = 1024; B = (const u16*)(p.ws + OFF_WIN); ldb = 1024; K = 1024; ntiles_n = 19; }
  if (EPI == 1) { A = (const u16*)(p.ws + OFF_MRG); lda = 1024; B = (const u16*)(p.ws + OFF_WO); ldb = 1024; K = 1024; ntiles_n = 8; }
  if (EPI == 2) { A = (const u16*)(p.ws + OFF_H); lda = 1024; B = (const u16*)(p.ws + OFF_W1); ldb = 1024; K = 1024; ntiles_n = 32; }
  if (EPI == 3) { A = (const u16*)(p.ws + OFF_F); lda = 4096; B = (const u16*)(p.ws + OFF_W2); ldb = 4096; K = 4096; ntiles_n = 8; }
  const float* modl = (const float*)(p.ws + OFF_MOD) + (size_t)l * 4 * 6144;
  const int G = VGRID;
  const bool swz = (G == 512);
  const int total = swz ? 128 * ((ntiles_n + 3) & ~3) : 128 * ntiles_n;
  for (int item = vb; item < total; item += G) {
    int mt = item & 127, nt = item >> 7;
    if (swz) { const int r = item >> 9, w = vb & 63; mt = (vb >> 6) * 16 + (w & 15); nt = r * 4 + (w >> 4); if (nt >= ntiles_n) continue; }
    const int m0 = mt * 128, n0 = nt * 128;
    f32x4 acc[4][4];
    zero_acc<4>(acc);
    gemm_mainloop<4>(A + (size_t)m0 * lda, lda, B + (size_t)n0 * ldb, ldb, K, acc, smem);
#pragma unroll
    for (int i = 0; i < 4; ++i) {
      const int m = m0 + wm * 64 + i * 16 + fr;
#pragma unroll
      for (int j = 0; j < 4; ++j) {
        const int n = n0 + wn * 64 + j * 16 + fq * 4;
        f32x4 v = acc[i][j];
        if (EPI == 0) {
          u32x2 o; o.x = pack2(v[0], v[1]); o.y = pack2(v[2], v[3]);
          if (n < 2176) *(u32x2*)((u16*)(p.ws + OFF_PABC) + (size_t)m * 2176 + n) = o;
          else *(u32x2*)((u16*)(p.ws + OFF_PD) + (size_t)m * 256 + (n - 2176)) = o;
        } else if (EPI == 1 || EPI == 3) {
          const int b = m >> 12;
          const float* gt = modl + (size_t)b * 6144 + (EPI == 1 ? 2048 : 5120) + n;
          const float* xin = ((EPI == 1 && l == 0) ? p.in[0] : p.out) + (size_t)m * 1024 + n;
          float4 x = *(const float4*)xin;
          float4 gg = *(const float4*)gt;
          float4 o;
          o.x = x.x + gg.x * v[0]; o.y = x.y + gg.y * v[1]; o.z = x.z + gg.z * v[2]; o.w = x.w + gg.w * v[3];
          *(float4*)(p.out + (size_t)m * 1024 + n) = o;
        } else {
          float r0 = fmaxf(v[0], 0.f), r1 = fmaxf(v[1], 0.f), r2 = fmaxf(v[2], 0.f), r3 = fmaxf(v[3], 0.f);
          u32x2 o; o.x = pack2(r0 * r0, r1 * r1); o.y = pack2(r2 * r2, r3 * r3);
          *(u32x2*)((u16*)(p.ws + OFF_F) + (size_t)m * 4096 + n) = o;
        }
      }
    }
  }
}

template <int MODE>
__device__ __forceinline__ void merge_tile(const Params& p, int item, unsigned char* smem_raw) {
  u16* smem = (u16*)smem_raw;
  const int lane = TIDX & 63, wv = TIDX >> 6;
  const int wm = wv >> 1, wn = wv & 1;
  const int fr = lane & 15, fq = lane >> 4;
  const u16* H = (const u16*)(p.ws + OFF_H);
  const u16* WIN = (const u16*)(p.ws + OFF_WIN);
  const int mt = item & 127, nt = item >> 7;
  const int m0 = mt * 128, n0 = nt * 128;
  f32x4 bacc[4][4];
  u32x2 gpk[4][4];
  u16* MRG = (u16*)(p.ws + OFF_MRG);
#pragma unroll 1
  for (int br = (MODE == 0 ? 1 : 0); br < (MODE == 0 ? 4 : 1); ++br) {
    zero_acc<4>(bacc);
    gemm_mainloop<4, true>(H + (size_t)m0 * 1024, 1024, WIN + (size_t)(2432 + br * 1024 + n0) * 1024, 1024, 1024, bacc, smem);
#pragma unroll
    for (int i = 0; i < 4; ++i)
#pragma unroll
      for (int j = 0; j < 4; ++j)
        gpk[i][j] = u32x2{pack2(sigmoidf_(bacc[i][j][0]), sigmoidf_(bacc[i][j][1])), pack2(sigmoidf_(bacc[i][j][2]), sigmoidf_(bacc[i][j][3]))};
    const u16* Ab; const u16* Wb;
    if (br == 0) { Ab = (const u16*)(p.ws + OFF_OG); Wb = (const u16*)(p.ws + OFF_RO); }
    else if (br == 1) { Ab = (const u16*)(p.ws + OFF_UB); Wb = (const u16*)(p.ws + OFF_SO); }
    else if (br == 2) { Ab = (const u16*)(p.ws + OFF_CB); Wb = (const u16*)(p.ws + OFF_CO); }
    else { Ab = (const u16*)(p.ws + OFF_YD); Wb = (const u16*)(p.ws + OFF_GLU); }
    if (MODE == 0 && br == 3) {
      zero_acc<4>(bacc);
      gemm_mainloop<4, true>(Ab + (size_t)m0 * 256, 256, Wb + (size_t)(1024 + n0) * 256, 256, 256, bacc, smem);
#pragma unroll
      for (int i = 0; i < 4; ++i)
#pragma unroll
        for (int j = 0; j < 4; ++j) {
          const float g0 = bflo(gpk[i][j].x) * sigmoidf_(bacc[i][j][0]), g1 = bfhi(gpk[i][j].x) * sigmoidf_(bacc[i][j][1]);
          const float g2 = bflo(gpk[i][j].y) * sigmoidf_(bacc[i][j][2]), g3 = bfhi(gpk[i][j].y) * sigmoidf_(bacc[i][j][3]);
          gpk[i][j] = u32x2{pack2(g0, g1), pack2(g2, g3)};
        }
    }
    zero_acc<4>(bacc);
    gemm_mainloop<4, true>(Ab + (size_t)m0 * 256, 256, Wb + (size_t)n0 * 256, 256, 256, bacc, smem);
#pragma unroll
    for (int i = 0; i < 4; ++i)
#pragma unroll
      for (int j = 0; j < 4; ++j) {
        u32x2* mp = (u32x2*)(MRG + (size_t)(m0 + wm * 64 + i * 16 + fr) * 1024 + n0 + wn * 64 + j * 16 + fq * 4);
        u32x2 cm = u32x2{0u, 0u};
        if (MODE == 1 || br > 1) cm = *mp;
        const float v0 = bflo(cm.x) + bflo(gpk[i][j].x) * bacc[i][j][0];
        const float v1 = bfhi(cm.x) + bfhi(gpk[i][j].x) * bacc[i][j][1];
        const float v2 = bflo(cm.y) + bflo(gpk[i][j].y) * bacc[i][j][2];
        const float v3 = bfhi(cm.y) + bfhi(gpk[i][j].y) * bacc[i][j][3];
        *mp = u32x2{pack2(v0, v1), pack2(v2, v3)};
      }
  }
}

__device__ __forceinline__ void gemm_mainloop_8n(const u16* __restrict__ A, int lda, const u16* __restrict__ B, int ldb,
                                                 int K, f32x4 (&acc)[4][4], u16* smem) {
  constexpr int STG = 24576;
  int tz = 0;
  asm volatile("" : "+v"(tz));
  const int tid = threadIdx.x + tz, lane = tid & 63, wv = tid >> 6;
  const int wm = wv >> 1, wn = wv & 1;
  const int lrow = tid >> 3;
  const int lchs = (tid & 7) ^ ((lrow >> 1) & 7);
  const u16* Ap = A + (size_t)lrow * lda + lchs * 8;
  const u16* Bp = B + (size_t)lrow * ldb + lchs * 8;
  const int nk = K >> 6;
  auto stage = [&](int kt, int buf) {
    const int ko = kt << 6;
    u16* sa = smem + buf * STG;
#pragma unroll
    for (int i = 0; i < 4; ++i)
      __builtin_amdgcn_global_load_lds((const unsigned*)(Ap + (size_t)(64 * i) * lda + ko),
                                       (__attribute__((address_space(3))) unsigned*)(sa + (tid + 512 * i) * 8), 16, 0, 0);
#pragma unroll
    for (int i = 0; i < 2; ++i)
      __builtin_amdgcn_global_load_lds((const unsigned*)(Bp + (size_t)(64 * i) * ldb + ko),
                                       (__attribute__((address_space(3))) unsigned*)(sa + 16384 + (tid + 512 * i) * 8), 16, 0, 0);
  };
  __syncthreads();
  stage(0, 0);
  stage(nk > 1 ? 1 : 0, 1);
  const int fr = lane & 15, fq = lane >> 4;
  const int sw = (fr >> 1) & 7;
  int cur = 0;
  for (int kt = 0; kt < nk; ++kt) {
    asm volatile("s_waitcnt vmcnt(6)" ::: "memory");
    __builtin_amdgcn_s_barrier();
    asm volatile("" ::: "memory");
    {
      int nx = cur + 2; if (nx >= 3) nx -= 3;
      int ktn = kt + 2; if (ktn >= nk) ktn = nk - 1;
      stage(ktn, nx);
    }
    const u16* cA = smem + cur * STG + (wm * 64 + fr) * 64;
    const u16* cB = smem + cur * STG + 16384 + (wn * 64 + fr) * 64;
#pragma unroll
    for (int ks = 0; ks < 2; ++ks) {
      __builtin_amdgcn_sched_barrier(0);
      const int pc = ((fq + 4 * ks) ^ sw) << 3;
      bf16x8 fa[4], fb[4];
#pragma unroll
      for (int i = 0; i < 4; ++i) fa[i] = *(const bf16x8*)(cA + i * 16 * 64 + pc);
#pragma unroll
      for (int j = 0; j < 4; ++j) fb[j] = *(const bf16x8*)(cB + j * 16 * 64 + pc);
#pragma unroll
      for (int i = 0; i < 4; ++i)
#pragma unroll
        for (int j = 0; j < 4; ++j)
          acc[i][j] = __builtin_amdgcn_mfma_f32_16x16x32_bf16(fb[j], fa[i], acc[i][j], 0, 0, 0);
    }
    cur = cur + 1; if (cur >= 3) cur = 0;
  }
  asm volatile("s_waitcnt vmcnt(0)" ::: "memory");
}

template <int MODE>
__device__ __forceinline__ void merge_tile8(const Params& p, int item, unsigned char* smem_raw) {
  u16* smem = (u16*)smem_raw;
  const int lane = threadIdx.x & 63, wv = threadIdx.x >> 6;
  const int wm = wv >> 1, wn = wv & 1;
  const int fr = lane & 15, fq = lane >> 4;
  const u16* H = (const u16*)(p.ws + OFF_H);
  const u16* WIN = (const u16*)(p.ws + OFF_WIN);
  const int mt = item & 63, nt = item >> 6;
  const int m0 = mt * 256, n0 = nt * 128;
  f32x4 bacc[4][4];
  u32x2 gpk[4][4];
  u16* MRG = (u16*)(p.ws + OFF_MRG);
#pragma unroll 1
  for (int br = (MODE == 0 ? 1 : 0); br < (MODE == 0 ? 4 : 1); ++br) {
    zero_acc<4>(bacc);
    gemm_mainloop_8n(H + (size_t)m0 * 1024, 1024, WIN + (size_t)(2432 + br * 1024 + n0) * 1024, 1024, 1024, bacc, smem);
#pragma unroll
    for (int i = 0; i < 4; ++i)
#pragma unroll
      for (int j = 0; j < 4; ++j)
        gpk[i][j] = u32x2{pack2(sigmoidf_(bacc[i][j][0]), sigmoidf_(bacc[i][j][1])), pack2(sigmoidf_(bacc[i][j][2]), sigmoidf_(bacc[i][j][3]))};
    const u16* Ab; const u16* Wb;
    if (br == 0) { Ab = (const u16*)(p.ws + OFF_OG); Wb = (const u16*)(p.ws + OFF_RO); }
    else if (br == 1) { Ab = (const u16*)(p.ws + OFF_UB); Wb = (const u16*)(p.ws + OFF_SO); }
    else if (br == 2) { Ab = (const u16*)(p.ws + OFF_CB); Wb = (const u16*)(p.ws + OFF_CO); }
    else { Ab = (const u16*)(p.ws + OFF_YD); Wb = (const u16*)(p.ws + OFF_GLU); }
    if (MODE == 0 && br == 3) {
      zero_acc<4>(bacc);
      gemm_mainloop_8n(Ab + (size_t)m0 * 256, 256, Wb + (size_t)(1024 + n0) * 256, 256, 256, bacc, smem);
#pragma unroll
      for (int i = 0; i < 4; ++i)
#pragma unroll
        for (int j = 0; j < 4; ++j) {
          const float g0 = bflo(gpk[i][j].x) * sigmoidf_(bacc[i][j][0]), g1 = bfhi(gpk[i][j].x) * sigmoidf_(bacc[i][j][1]);
          const float g2 = bflo(gpk[i][j].y) * sigmoidf_(bacc[i][j][2]), g3 = bfhi(gpk[i][j].y) * sigmoidf_(bacc[i][j][3]);
          gpk[i][j] = u32x2{pack2(g0, g1), pack2(g2, g3)};
        }
    }
    zero_acc<4>(bacc);
    gemm_mainloop_8n(Ab + (size_t)m0 * 256, 256, Wb + (size_t)n0 * 256, 256, 256, bacc, smem);
#pragma unroll
    for (int i = 0; i < 4; ++i)
#pragma unroll
      for (int j = 0; j < 4; ++j) {
        u32x2* mp = (u32x2*)(MRG + (size_t)(m0 + wm * 64 + i * 16 + fr) * 1024 + n0 + wn * 64 + j * 16 + fq * 4);
        u32x2 cm = u32x2{0u, 0u};
        if (MODE == 1 || br > 1) cm = *mp;
        const float v0 = bflo(cm.x) + bflo(gpk[i][j].x) * bacc[i][j][0];
        const float v1 = bfhi(cm.x) + bfhi(gpk[i][j].x) * bacc[i][j][1];
        const float v2 = bflo(cm.y) + bflo(gpk[i][j].y) * bacc[i][j][2];
        const float v3 = bfhi(cm.y) + bfhi(gpk[i][j].y) * bacc[i][j][3];
        *mp = u32x2{pack2(v0, v1), pack2(v2, v3)};
      }
  }
}

__device__ __forceinline__ float shifted(const u16* __restrict__ P, int tok, int col, float mu) {
  float pv = bf2f(P[(size_t)tok * 2176 + col]);
  float pr = (tok & (SEQ - 1)) ? bf2f(P[(size_t)(tok - 1) * 2176 + col]) : 0.f;
  return pv + (pr - pv) * mu;
}

__device__ __forceinline__ void rwkv_prep_item(const Params& p, int l, int item, unsigned char* smem) {
  const int tid = TIDX, lane = tid & 63, wv = tid >> 6;
  const int fr = lane & 15, fq = lane >> 4;
  u16* sl = (u16*)smem;
  u16* sv = sl + 32 * 168;
  constexpr int SLS = 168, SVS = 264;
  const u16* P = (const u16*)(p.ws + OFF_PABC);
  const float* mu = p.in[6] + l * 896;
  const int tok0 = item * 32;
  for (int idx = tid; idx < 32 * 128; idx += NTHR) {
    const int t = idx >> 7, ci = idx & 127;
    float v = shifted(P, tok0 + t, 768 + ci, mu[768 + ci]);
    if (ci < 32) v = tanhf_(v);
    else if (ci >= 64) v = sigmoidf_(v);
    sl[t * SLS + ci] = f2bf(v);
  }
  if (l > 0) {
    const int t = tid >> 3, c0 = (tid & 7) * 32;
    const int tok = tok0 + t;
    const bool hasp = (tok & (SEQ - 1)) != 0;
#pragma unroll
    for (int q = 0; q < 4; ++q) {
      const int c = c0 + q * 8;
      const u32x4 cur = *(const u32x4*)(P + (size_t)tok * 2176 + 512 + c);
      u32x4 prv = u32x4{0u, 0u, 0u, 0u};
      if (hasp) prv = *(const u32x4*)(P + (size_t)(tok - 1) * 2176 + 512 + c);
      const f32x4 m0 = *(const f32x4*)(mu + 512 + c), m1 = *(const f32x4*)(mu + 512 + c + 4);
      float o[8];
      o[0] = bflo(cur.x) + (bflo(prv.x) - bflo(cur.x)) * m0.x; o[1] = bfhi(cur.x) + (bfhi(prv.x) - bfhi(cur.x)) * m0.y;
      o[2] = bflo(cur.y) + (bflo(prv.y) - bflo(cur.y)) * m0.z; o[3] = bfhi(cur.y) + (bfhi(prv.y) - bfhi(cur.y)) * m0.w;
      o[4] = bflo(cur.z) + (bflo(prv.z) - bflo(cur.z)) * m1.x; o[5] = bfhi(cur.z) + (bfhi(prv.z) - bfhi(cur.z)) * m1.y;
      o[6] = bflo(cur.w) + (bflo(prv.w) - bflo(cur.w)) * m1.z; o[7] = bfhi(cur.w) + (bfhi(prv.w) - bfhi(cur.w)) * m1.w;
      *(u32x4*)(sv + t * SVS + c) = u32x4{pack2(o[0], o[1]), pack2(o[2], o[3]), pack2(o[4], o[5]), pack2(o[6], o[7])};
    }
  }
  __syncthreads();
  if (l > 0) {
    const int mf = wv >> 1, nf = wv & 1;
    const u16* v1t = (const u16*)(p.ws + OFF_LV1);
    f32x4 acc = f32x4{0.f, 0.f, 0.f, 0.f};
#pragma unroll
    for (int ks = 0; ks < 8; ++ks) {
      const bf16x8 fa = *(const bf16x8*)(sv + (mf * 16 + fr) * SVS + ks * 32 + fq * 8);
      const bf16x8 fb = *(const bf16x8*)(v1t + (size_t)(nf * 16 + fr) * 256 + ks * 32 + fq * 8);
      acc = __builtin_amdgcn_mfma_f32_16x16x32_bf16(fb, fa, acc, 0, 0, 0);
    }
    *(u32x2*)(sl + (mf * 16 + fr) * SLS + 128 + nf * 16 + fq * 4) = u32x2{pack2(acc[0], acc[1]), pack2(acc[2], acc[3])};
    __syncthreads();
  }
  const u16* w2t = (const u16*)(p.ws + OFF_LW2); const u16* a2t = (const u16*)(p.ws + OFF_LA2);
  const u16* g2t = (const u16*)(p.ws + OFF_LG2); const u16* v2t = (const u16*)(p.ws + OFF_LV2);
  u16* SR = (u16*)(p.ws + OFF_SR); u16* SK = (u16*)(p.ws + OFF_SK); u16* SV = (u16*)(p.ws + OFF_SV);
  u16* SKK = (u16*)(p.ws + OFF_SKK); u16* SA = (u16*)(p.ws + OFF_SA); float* SW = (float*)(p.ws + OFF_SW);
  u16* G = (u16*)(p.ws + OFF_G); u16* VF = (u16*)(p.ws + OFF_VF);
#pragma unroll 1
  for (int mf = 0; mf < 2; ++mf) {
    const u16* arow = sl + (mf * 16 + fr) * SLS + fq * 8;
    const bf16x8 aw = *(const bf16x8*)(arow), aa = *(const bf16x8*)(arow + 32);
    const bf16x8 ag0 = *(const bf16x8*)(arow + 64), ag1 = *(const bf16x8*)(arow + 96), av = *(const bf16x8*)(arow + 128);
    f32x4 cw[4], ca[4], cg[4], cv[4];
#pragma unroll
    for (int nf = 0; nf < 4; ++nf) {
      const int n = wv * 64 + nf * 16 + fr;
      const f32x4 z = f32x4{0.f, 0.f, 0.f, 0.f};
      cw[nf] = __builtin_amdgcn_mfma_f32_16x16x32_bf16(*(const bf16x8*)(w2t + n * 32 + fq * 8), aw, z, 0, 0, 0);
      ca[nf] = __builtin_amdgcn_mfma_f32_16x16x32_bf16(*(const bf16x8*)(a2t + n * 32 + fq * 8), aa, z, 0, 0, 0);
      cg[nf] = __builtin_amdgcn_mfma_f32_16x16x32_bf16(*(const bf16x8*)(g2t + n * 64 + fq * 8), ag0, z, 0, 0, 0);
      cg[nf] = __builtin_amdgcn_mfma_f32_16x16x32_bf16(*(const bf16x8*)(g2t + n * 64 + 32 + fq * 8), ag1, cg[nf], 0, 0, 0);
      cv[nf] = z;
      if (l > 0) cv[nf] = __builtin_amdgcn_mfma_f32_16x16x32_bf16(*(const bf16x8*)(v2t + n * 32 + fq * 8), av, z, 0, 0, 0);
    }
    const int tok = tok0 + mf * 16 + fr;
    const bool hasp = (tok & (SEQ - 1)) != 0;
    float kkv[4][4], kmv[4][4], av4[4][4];
    float ss = 0.f;
#pragma unroll
    for (int nf = 0; nf < 4; ++nf) {
      const int c = wv * 64 + nf * 16 + fq * 4;
      const size_t o = (size_t)tok * 256 + c;
      const u16* pc = P + (size_t)tok * 2176 + c;
      const u32x2 r_c = *(const u32x2*)(pc), k_c = *(const u32x2*)(pc + 256), v_c = *(const u32x2*)(pc + 512);
      u32x2 r_p = u32x2{0u, 0u}, k_p = u32x2{0u, 0u}, v_p = u32x2{0u, 0u};
      if (hasp) { r_p = *(const u32x2*)(pc - 2176); k_p = *(const u32x2*)(pc - 2176 + 256); v_p = *(const u32x2*)(pc - 2176 + 512); }
      const f32x4 mur = *(const f32x4*)(mu + c), muk = *(const f32x4*)(mu + 256 + c), muv = *(const f32x4*)(mu + 512 + c);
      const f32x4 w0 = *(const f32x4*)(p.in[7] + l * 256 + c), a0 = *(const f32x4*)(p.in[9] + l * 256 + c);
      const f32x4 kkc = *(const f32x4*)(p.in[15] + l * 256 + c), kac = *(const f32x4*)(p.in[16] + l * 256 + c);
      f32x4 v0 = f32x4{0.f, 0.f, 0.f, 0.f};
      if (l > 0) v0 = *(const f32x4*)(p.in[12] + c);
      u32x2 vfraw = u32x2{0u, 0u};
      if (l > 0) vfraw = *(const u32x2*)(VF + o);
      float rr[4], kk_[4], vv[4], dec[4], gg[4];
#pragma unroll
      for (int e = 0; e < 4; ++e) {
        const unsigned rc = e < 2 ? r_c.x : r_c.y, rp = e < 2 ? r_p.x : r_p.y;
        const unsigned kc = e < 2 ? k_c.x : k_c.y, kp = e < 2 ? k_p.x : k_p.y;
        const unsigned vc = e < 2 ? v_c.x : v_c.y, vp = e < 2 ? v_p.x : v_p.y;
        const unsigned vfr = e < 2 ? vfraw.x : vfraw.y;
        const float rcf = (e & 1) ? bfhi(rc) : bflo(rc), rpf = (e & 1) ? bfhi(rp) : bflo(rp);
        const float kcf = (e & 1) ? bfhi(kc) : bflo(kc), kpf = (e & 1) ? bfhi(kp) : bflo(kp);
        const float vcf = (e & 1) ? bfhi(vc) : bflo(vc), vpf = (e & 1) ? bfhi(vp) : bflo(vp);
        const float r = rcf + (rpf - rcf) * mur[e];
        const float k = kcf + (kpf - kcf) * muk[e];
        float v = vcf + (vpf - vcf) * muv[e];
        const float wl = w0[e] + cw[nf][e];
        const float z = -wl;
        const float sp = (z > 15.f) ? z : __logf(1.f + __expf(z));
        dec[e] = __expf(-__expf(-sp - 0.5f));
        const float a = sigmoidf_(a0[e] + ca[nf][e]);
        gg[e] = cg[nf][e];
        if (l > 0) { const float vf = (e & 1) ? bfhi(vfr) : bflo(vfr); v = v + (vf - v) * sigmoidf_(v0[e] + cv[nf][e]); }
        const float kk = k * kkc[e];
        ss += kk * kk;
        rr[e] = r; vv[e] = v; kk_[e] = kk; kkv[nf][e] = kk;
        kmv[nf][e] = k * (1.f + (a - 1.f) * kac[e]); av4[nf][e] = a;
      }
      *(u32x2*)(SR + o) = u32x2{pack2(rr[0], rr[1]), pack2(rr[2], rr[3])};
      *(u32x2*)(SV + o) = u32x2{pack2(vv[0], vv[1]), pack2(vv[2], vv[3])};
      if (l == 0) *(u32x2*)(VF + o) = u32x2{pack2(vv[0], vv[1]), pack2(vv[2], vv[3])};
      *(u32x2*)(G + o) = u32x2{pack2(gg[0], gg[1]), pack2(gg[2], gg[3])};
      *(f32x4*)(SW + o) = f32x4{dec[0], dec[1], dec[2], dec[3]};
    }
    ss += __shfl_xor(ss, 16, 64);
    ss += __shfl_xor(ss, 32, 64);
    const float inv = 1.f / fmaxf(sqrtf(ss), 1e-12f);
#pragma unroll
    for (int nf = 0; nf < 4; ++nf) {
      const size_t o = (size_t)tok * 256 + wv * 64 + nf * 16 + fq * 4;
      *(u32x2*)(SKK + o) = u32x2{pack2(kkv[nf][0] * inv, kkv[nf][1] * inv), pack2(kkv[nf][2] * inv, kkv[nf][3] * inv)};
      *(u32x2*)(SK + o) = u32x2{pack2(kmv[nf][0], kmv[nf][1]), pack2(kmv[nf][2], kmv[nf][3])};
      *(u32x2*)(SA + o) = u32x2{pack2(av4[nf][0], av4[nf][1]), pack2(av4[nf][2], av4[nf][3])};
    }
  }
  __syncthreads();
}

__device__ __forceinline__ void sg_item(const Params& p, int l, int item, unsigned char* smem) {
  const int tid = TIDX, lane = tid & 63, wv = tid >> 6;
  u16* vsT = (u16*)smem;
  float* smu = (float*)(smem + 16384);
  float* srs = smu + 128;
  const u16* P = (const u16*)(p.ws + OFF_PABC);
  const int g = item & 3, chn = item >> 2;
  const int tok0 = chn * 128;
  {
    const int t = tid >> 1, hf = tid & 1;
    const u16* src = P + (size_t)(tok0 + t) * 2176 + 896 + 256 + hf * 128;
    float sm = 0.f, ss = 0.f;
#pragma unroll 4
    for (int i = 0; i < 16; ++i) {
      u32x4 raw = *(const u32x4*)(src + i * 8);
      float z;
      z = geluf_(bflo(raw.x)); sm += z; ss += z * z;  z = geluf_(bfhi(raw.x)); sm += z; ss += z * z;
      z = geluf_(bflo(raw.y)); sm += z; ss += z * z;  z = geluf_(bfhi(raw.y)); sm += z; ss += z * z;
      z = geluf_(bflo(raw.z)); sm += z; ss += z * z;  z = geluf_(bfhi(raw.z)); sm += z; ss += z * z;
      z = geluf_(bflo(raw.w)); sm += z; ss += z * z;  z = geluf_(bfhi(raw.w)); sm += z; ss += z * z;
    }
    sm += __shfl_xor(sm, 1, 64); ss += __shfl_xor(ss, 1, 64);
    const float mean = sm * (1.f / 256.f);
    const float var = fmaxf(ss * (1.f / 256.f) - mean * mean, 0.f);
    if (hf == 0) { smu[t] = mean; srs[t] = rsqrtf(var + 1e-5f); }
  }
  __syncthreads();
  {
    const int c = tid & 63, tb = tid >> 6;
    const float lw = p.in[21][l * 256 + g * 64 + c], lb = p.in[22][l * 256 + g * 64 + c];
#pragma unroll
    for (int j = 0; j < 4; ++j) {
      u16 raw[8];
#pragma unroll
      for (int e = 0; e < 8; ++e) raw[e] = P[(size_t)(tok0 + tb * 32 + j * 8 + e) * 2176 + 896 + 256 + g * 64 + c];
      float vv[8];
#pragma unroll
      for (int e = 0; e < 8; ++e) {
        const int t = tb * 32 + j * 8 + e;
        vv[e] = (geluf_(bf2f(raw[e])) - smu[t]) * srs[t] * lw + lb;
      }
      const int phys = (tb * 4 + j) ^ (c & 15);
      *(u32x4*)(vsT + c * 128 + phys * 8) = u32x4{pack2(vv[0], vv[1]), pack2(vv[2], vv[3]), pack2(vv[4], vv[5]), pack2(vv[6], vv[7])};
    }
  }
  __syncthreads();
  {
    const int fr = lane & 15, fq = lane >> 4;
    const u16* Wm = (const u16*)(p.ws + OFF_SGW) + (size_t)g * 128 * 128;
    f32x4 acc[2][4];
#pragma unroll
    for (int i = 0; i < 2; ++i)
#pragma unroll
      for (int j = 0; j < 4; ++j) acc[i][j] = f32x4{0.f, 0.f, 0.f, 0.f};
    for (int ks = 0; ks <= wv; ++ks) {
      bf16x8 fa[2], fb[4];
#pragma unroll
      for (int i = 0; i < 2; ++i) fa[i] = *(const bf16x8*)(Wm + (size_t)(32 * wv + 16 * i + fr) * 128 + ks * 32 + fq * 8);
#pragma unroll
      for (int j = 0; j < 4; ++j) fb[j] = *(const bf16x8*)(vsT + (j * 16 + fr) * 128 + (((ks * 4 + fq) ^ fr) << 3));
#pragma unroll
      for (int i = 0; i < 2; ++i)
#pragma unroll
        for (int j = 0; j < 4; ++j) acc[i][j] = __builtin_amdgcn_mfma_f32_16x16x32_bf16(fb[j], fa[i], acc[i][j], 0, 0, 0);
    }
    const float* bs = p.in[24] + ((size_t)l * 4 + g) * 128;
    u16* UB = (u16*)(p.ws + OFF_UB);
#pragma unroll
    for (int i = 0; i < 2; ++i) {
      const int t = 32 * wv + 16 * i + fr;
      const float bsv = bs[t];
#pragma unroll
      for (int j = 0; j < 4; ++j) {
        const int cc = j * 16 + fq * 4;
        u32x2 ur = *(const u32x2*)(P + (size_t)(tok0 + t) * 2176 + 896 + g * 64 + cc);
        float o0 = geluf_(bflo(ur.x)) * (acc[i][j][0] + bsv), o1 = geluf_(bfhi(ur.x)) * (acc[i][j][1] + bsv);
        float o2 = geluf_(bflo(ur.y)) * (acc[i][j][2] + bsv), o3 = geluf_(bfhi(ur.y)) * (acc[i][j][3] + bsv);
        *(u32x2*)(UB + (size_t)(tok0 + t) * 256 + g * 64 + cc) = u32x2{pack2(o0, o1), pack2(o2, o3)};
      }
    }
  }
  __syncthreads();
}

__device__ __forceinline__ void conv_item(const Params& p, int l, int item) {
  const int j = TIDX;
  const u16* P = (const u16*)(p.ws + OFF_PABC);
  u16* CB = (u16*)(p.ws + OFF_CB);
  const float c0 = p.in[26][(l * 3 + 0) * 256 + j], c1 = p.in[26][(l * 3 + 1) * 256 + j], c2 = p.in[26][(l * 3 + 2) * 256 + j];
  const int tok0 = item * 8;
  u16 rc[10], rx[10], rb[8];
  const bool first = (tok0 & (SEQ - 1)) == 0;
#pragma unroll
  for (int t = 0; t < 10; ++t) {
    const int tok = (first && t < 2) ? tok0 : tok0 + t - 2;
    const u16* q = P + (size_t)tok * 2176 + 1408;
    rc[t] = q[256 + j]; rx[t] = q[512 + j];
    if (t >= 2) rb[t - 2] = q[j];
  }
  float z[10];
#pragma unroll
  for (int t = 0; t < 10; ++t) z[t] = bf2f(rc[t]) * bf2f(rx[t]);
  if (first) { z[0] = 0.f; z[1] = 0.f; }
#pragma unroll
  for (int t = 0; t < 8; ++t) {
    float y = c0 * z[t] + c1 * z[t + 1] + c2 * z[t + 2];
    CB[(size_t)(tok0 + t) * 256 + j] = f2bf(bf2f(rb[t]) * y);
  }
}

__device__ __forceinline__ void s5_load_u(const u16* us, int t, int wv, float (&u)[16]) {
  const u32x4* q = (const u32x4*)(us + t * 64 + wv * 16);
  u32x4 a = q[0], b = q[1];
  u[0] = bflo(a.x); u[1] = bfhi(a.x); u[2] = bflo(a.y); u[3] = bfhi(a.y);
  u[4] = bflo(a.z); u[5] = bfhi(a.z); u[6] = bflo(a.w); u[7] = bfhi(a.w);
  u[8] = bflo(b.x); u[9] = bfhi(b.x); u[10] = bflo(b.y); u[11] = bfhi(b.y);
  u[12] = bflo(b.z); u[13] = bfhi(b.z); u[14] = bflo(b.w); u[15] = bfhi(b.w);
}
__device__ __forceinline__ void s5_stage_u(const u16* __restrict__ PD, int tok0, int gq, u16* us) {
#pragma unroll
  for (int i = 0; i < 2; ++i) {
    const int ch = TIDX + 256 * i;
    const int t = ch >> 3, part = ch & 7;
    *(u32x4*)(us + t * 64 + part * 8) = *(const u32x4*)(PD + (size_t)(tok0 + t) * 256 + gq * 64 + part * 8);
  }
}

__device__ __forceinline__ void s5a_item(const Params& p, int l, int item, unsigned char* smem) {
  const int lane = TIDX & 63, wv = TIDX >> 6;
  const int gq = item & 3, bc = item >> 2;
  const int g = gq * 4 + wv;
  const int tok0 = bc * 64;
  const u16* PD = (const u16*)(p.ws + OFF_PD);
  const float* ab = (const float*)(p.ws + OFF_S5AB) + ((size_t)(l * 16 + g) * 64 + lane) * 2;
  const float* bb = (const float*)(p.ws + OFF_S5BB) + ((size_t)(l * 16 + g) * 64 + lane) * 32;
  float bbr[16], bbi[16];
#pragma unroll
  for (int c = 0; c < 16; ++c) { bbr[c] = bb[c]; bbi[c] = bb[16 + c]; }
  const float abr = ab[0], abi = ab[1];
  float xr = 0.f, xi = 0.f;
  u16* us = (u16*)smem;
  s5_stage_u(PD, tok0, gq, us);
  __syncthreads();
#pragma unroll 4
  for (int t = 0; t < 64; ++t) {
    float u[16];
    s5_load_u(us, t, wv, u);
    float bur = 0.f, bui = 0.f;
#pragma unroll
    for (int c = 0; c < 16; ++c) { bur += bbr[c] * u[c]; bui += bbi[c] * u[c]; }
    float nr = abr * xr - abi * xi + bur;
    float ni = abr * xi + abi * xr + bui;
    xr = nr; xi = ni;
  }
  float2* E = (float2*)(p.ws + OFF_S5E);
  E[((size_t)bc * 16 + g) * 64 + lane] = make_float2(xr, xi);
  __syncthreads();
}

__device__ __forceinline__ void s5b_item(const Params& p, int l, int item, unsigned char* smem) {
  const int lane = TIDX & 63, wv = TIDX >> 6;
  const int gq = item & 3, bc = item >> 2;
  const int b = bc >> 6, ch = bc & 63;
  const int g = gq * 4 + wv;
  const int tok0 = bc * 64;
  u16* us = (u16*)(smem + 65536);
  s5_stage_u((const u16*)(p.ws + OFF_PD), tok0, gq, us);
  float* base = (float*)smem + wv * 4096;
  float* csr = base, *csi = base + 1024, *xsr = base + 2048, *xsi = base + 3072;
  const u16* PD = (const u16*)(p.ws + OFF_PD);
  const float* ab = (const float*)(p.ws + OFF_S5AB) + ((size_t)(l * 16 + g) * 64 + lane) * 2;
  const float* bb = (const float*)(p.ws + OFF_S5BB) + ((size_t)(l * 16 + g) * 64 + lane) * 32;
  const float* cre = p.in[32] + ((size_t)(l * 16 + g) * 16) * 64;
  const float* cim = p.in[33] + ((size_t)(l * 16 + g) * 16) * 64;
  for (int c = 0; c < 16; ++c) {
    csr[(lane >> 2) * 64 + c * 4 + (lane & 3)] = cre[c * 64 + lane];
    csi[(lane >> 2) * 64 + c * 4 + (lane & 3)] = cim[c * 64 + lane];
  }
  float bbr[16], bbi[16];
#pragma unroll
  for (int c = 0; c < 16; ++c) { bbr[c] = bb[c]; bbi[c] = bb[16 + c]; }
  const float abr = ab[0], abi = ab[1];
  float pr = abr, pi = abi;
#pragma unroll
  for (int s = 0; s < 6; ++s) { float nr = pr * pr - pi * pi, ni = 2.f * pr * pi; pr = nr; pi = ni; }
  float xr = 0.f, xi = 0.f;
  const float2* E = (const float2*)(p.ws + OFF_S5E);
  {
    const f32x2* Ev = (const f32x2*)E + ((size_t)(b * 64) * 16 + g) * 64 + lane;
    int c = 0;
    for (; c + 8 <= ch; c += 8) {
      f32x2 e[8];
#pragma unroll
      for (int k = 0; k < 8; ++k) e[k] = Ev[(size_t)(c + k) * 1024];
#pragma unroll
      for (int k = 0; k < 8; ++k) {
        const float nr = pr * xr - pi * xi + e[k].x;
        const float ni = pr * xi + pi * xr + e[k].y;
        xr = nr; xi = ni;
      }
    }
    for (; c < ch; ++c) {
      const f32x2 e = Ev[(size_t)c * 1024];
      const float nr = pr * xr - pi * xi + e.x;
      const float ni = pr * xi + pi * xr + e.y;
      xr = nr; xi = ni;
    }
  }
  const int tt = lane & 15, cq = lane >> 4;
  const float* dvec = p.in[34] + l * 256 + g * 16 + cq * 4;
  const float d0 = dvec[0], d1 = dvec[1], d2 = dvec[2], d3 = dvec[3];
  u16* YD = (u16*)(p.ws + OFF_YD);
  const int n4w = lane >> 2, e4 = lane & 3;
  __syncthreads();
#pragma unroll 1
  for (int sc = 0; sc < 4; ++sc) {
    for (int t = 0; t < 16; ++t) {
      float u[16];
      s5_load_u(us, sc * 16 + t, wv, u);
      float bur = 0.f, bui = 0.f;
#pragma unroll
      for (int c = 0; c < 16; ++c) { bur += bbr[c] * u[c]; bui += bbi[c] * u[c]; }
      float nr = abr * xr - abi * xi + bur;
      float ni = abr * xi + abi * xr + bui;
      xr = nr; xi = ni;
      int a = n4w * 64 + ((t ^ (n4w & 7)) << 2) + e4;
      xsr[a] = xr; xsi[a] = xi;
    }
    __syncthreads();
    float acc0 = 0.f, acc1 = 0.f, acc2 = 0.f, acc3 = 0.f;
#pragma unroll 2
    for (int n4 = 0; n4 < 16; ++n4) {
      int xa = n4 * 64 + ((tt ^ (n4 & 7)) << 2);
      float4 xr4 = *(const float4*)(xsr + xa);
      float4 xi4 = *(const float4*)(xsi + xa);
      const float* cr = csr + n4 * 64 + cq * 16;
      const float* ci = csi + n4 * 64 + cq * 16;
      float4 r0 = *(const float4*)(cr), r1 = *(const float4*)(cr + 4), r2 = *(const float4*)(cr + 8), r3 = *(const float4*)(cr + 12);
      float4 i0 = *(const float4*)(ci), i1 = *(const float4*)(ci + 4), i2 = *(const float4*)(ci + 8), i3 = *(const float4*)(ci + 12);
      acc0 += r0.x * xr4.x + r0.y * xr4.y + r0.z * xr4.z + r0.w * xr4.w - (i0.x * xi4.x + i0.y * xi4.y + i0.z * xi4.z + i0.w * xi4.w);
      acc1 += r1.x * xr4.x + r1.y * xr4.y + r1.z * xr4.z + r1.w * xr4.w - (i1.x * xi4.x + i1.y * xi4.y + i1.z * xi4.z + i1.w * xi4.w);
      acc2 += r2.x * xr4.x + r2.y * xr4.y + r2.z * xr4.z + r2.w * xr4.w - (i2.x * xi4.x + i2.y * xi4.y + i2.z * xi4.z + i2.w * xi4.w);
      acc3 += r3.x * xr4.x + r3.y * xr4.y + r3.z * xr4.z + r3.w * xr4.w - (i3.x * xi4.x + i3.y * xi4.y + i3.z * xi4.z + i3.w * xi4.w);
    }
    {
      const int tok = tok0 + sc * 16 + tt;
      u32x2 ur = *(const u32x2*)(us + (sc * 16 + tt) * 64 + wv * 16 + cq * 4);
      float y0 = acc0 + d0 * bflo(ur.x), y1 = acc1 + d1 * bfhi(ur.x), y2 = acc2 + d2 * bflo(ur.y), y3 = acc3 + d3 * bfhi(ur.y);
      u32x2 o; o.x = pack2(geluf_(y0), geluf_(y1)); o.y = pack2(geluf_(y2), geluf_(y3));
      *(u32x2*)(YD + (size_t)tok * 256 + g * 16 + cq * 4) = o;
    }
    __syncthreads();
  }
}

__device__ __forceinline__ void lds_barrier() {
  asm volatile("s_waitcnt lgkmcnt(0)" ::: "memory");
  __builtin_amdgcn_s_barrier();
  asm volatile("" ::: "memory");
}
__device__ __forceinline__ void scan_item(const Params& p, int item, unsigned char* smem) {
  const int tid = TIDX, lane = tid & 63, wv = tid >> 6;
  const int b = item >> 4, h = (item >> 2) & 3, q = item & 3;
  const int rl = lane >> 4, cl = lane & 15;
  const int rloc = wv * 4 + rl;
  const size_t tokb = (size_t)b * SEQ;
  const int chan0 = h * 64;
  const u16* SR = (const u16*)(p.ws + OFF_SR); const u16* SK = (const u16*)(p.ws + OFF_SK);
  const u16* SV = (const u16*)(p.ws + OFF_SV); const u16* SKK = (const u16*)(p.ws + OFF_SKK);
  const u16* SA = (const u16*)(p.ws + OFF_SA); const float* SW = (const float*)(p.ws + OFF_SW);
  float* O = (float*)(p.ws + OFF_O);
  constexpr int BUFF = 6432;
  float* lbase = (float*)smem;
  float* pp = lbase + 2 * BUFF + wv * 1024;
  const int st = tid >> 4, cg4 = tid & 15;
  struct Stg { u32x2 r, k, kk, a, kk1; f32x4 w; u16 v; };
  auto gload = [&](Stg& g, int c) {
    const size_t o = (tokb + (size_t)c * 16 + st) * 256 + chan0;
    g.r = *(const u32x2*)(SR + o + cg4 * 4); g.k = *(const u32x2*)(SK + o + cg4 * 4);
    g.kk = *(const u32x2*)(SKK + o + cg4 * 4); g.a = *(const u32x2*)(SA + o + cg4 * 4);
    g.w = *(const f32x4*)(SW + o + cg4 * 4);
    g.v = SV[o + q * 16 + cg4];
    int t1 = c * 16 + st + 1; if (t1 >= SEQ) t1 = SEQ - 1;
    g.kk1 = *(const u32x2*)(SKK + (tokb + (size_t)t1) * 256 + chan0 + cg4 * 4);
  };
  auto lwrite = [&](const Stg& g, int buf) {
    float* bp = lbase + buf * BUFF;
    const int o = st * 64 + cg4 * 4;
    f32x4 kk = {bflo(g.kk.x), bfhi(g.kk.x), bflo(g.kk.y), bfhi(g.kk.y)};
    f32x4 a = {bflo(g.a.x), bfhi(g.a.x), bflo(g.a.y), bfhi(g.a.y)};
    f32x4 k = {bflo(g.k.x), bfhi(g.k.x), bflo(g.k.y), bfhi(g.k.y)};
    f32x4 r = {bflo(g.r.x), bfhi(g.r.x), bflo(g.r.y), bfhi(g.r.y)};
    *(f32x4*)(bp + o) = kk;
    *(f32x4*)(bp + 1024 + o) = kk * a;
    *(f32x4*)(bp + 2048 + o) = k;
    *(f32x4*)(bp + 3072 + o) = g.w;
    *(f32x4*)(bp + 4096 + o) = r;
    bp[5120 + st * 16 + cg4] = bf2f(g.v);
    const f32x4 kn = {bflo(g.kk1.x), bfhi(g.kk1.x), bflo(g.kk1.y), bfhi(g.kk1.y)};
    *(f32x4*)(bp + 5376 + o) = g.w * kn;
    const f32x4 bb = kk * a;
    const float c1 = row_sum16(k.x * kn.x + k.y * kn.y + k.z * kn.z + k.w * kn.w);
    const float c2 = row_sum16(bb.x * kn.x + bb.y * kn.y + bb.z * kn.z + bb.w * kn.w);
    if (cg4 == 0) *(f32x2*)(bp + 6400 + st * 2) = f32x2{c1, c2};
  };
  constexpr int NCH = SEQ / 16;
  Stg R0, R1, R2, R3;
  gload(R0, 0); gload(R1, 1); gload(R2, 2); gload(R3, 3);
  __syncthreads();
  lwrite(R0, 0);
  __syncthreads();
  __builtin_amdgcn_s_setprio(3);
  float S0 = 0.f, S1 = 0.f, S2 = 0.f, S3 = 0.f;
  const int rrow = lane & 3, rstep = lane >> 2;
  struct Pair { f32x4 kkA, bbA, kA, wA, rA, mA, bbB, kB, wB, rB; f32x2 cA; float vA, vB; };
  auto chunk = [&](int c) {
    const float* bp = lbase + (c & 1) * BUFF;
    auto ldpair = [&](Pair& o, int s) {
      o.kkA = *(const f32x4*)(bp + s * 64 + cl * 4);
      o.mA = *(const f32x4*)(bp + 5376 + s * 64 + cl * 4);
      o.bbA = *(const f32x4*)(bp + 1024 + s * 64 + cl * 4);
      o.kA = *(const f32x4*)(bp + 2048 + s * 64 + cl * 4);
      o.wA = *(const f32x4*)(bp + 3072 + s * 64 + cl * 4);
      o.rA = *(const f32x4*)(bp + 4096 + s * 64 + cl * 4);
      o.vA = bp[5120 + s * 16 + rloc];
      o.cA = *(const f32x2*)(bp + 6400 + s * 2);
      o.bbB = *(const f32x4*)(bp + 1024 + (s + 1) * 64 + cl * 4);
      o.kB = *(const f32x4*)(bp + 2048 + (s + 1) * 64 + cl * 4);
      o.wB = *(const f32x4*)(bp + 3072 + (s + 1) * 64 + cl * 4);
      o.rB = *(const f32x4*)(bp + 4096 + (s + 1) * 64 + cl * 4);
      o.vB = bp[5120 + (s + 1) * 16 + rloc];
    };
    auto pairstep = [&](const Pair& o, int s) {
      const float pa = __builtin_fmaf(S3, o.kkA.w, __builtin_fmaf(S2, o.kkA.z, __builtin_fmaf(S1, o.kkA.y, S0 * o.kkA.x)));
      const float pd = __builtin_fmaf(S3, o.mA.w, __builtin_fmaf(S2, o.mA.z, __builtin_fmaf(S1, o.mA.y, S0 * o.mA.x)));
      const float saA = row_sum16(pa);
      const float dd = row_sum16(pd);
      const float saB = __builtin_fmaf(-saA, o.cA.y, __builtin_fmaf(o.vA, o.cA.x, dd));
      S0 = __builtin_fmaf(S0, o.wA.x, __builtin_fmaf(o.vA, o.kA.x, -(saA * o.bbA.x)));
      S1 = __builtin_fmaf(S1, o.wA.y, __builtin_fmaf(o.vA, o.kA.y, -(saA * o.bbA.y)));
      S2 = __builtin_fmaf(S2, o.wA.z, __builtin_fmaf(o.vA, o.kA.z, -(saA * o.bbA.z)));
      S3 = __builtin_fmaf(S3, o.wA.w, __builtin_fmaf(o.vA, o.kA.w, -(saA * o.bbA.w)));
      pp[(s * 4 + rl) * 16 + cl] = __builtin_fmaf(S3, o.rA.w, __builtin_fmaf(S2, o.rA.z, __builtin_fmaf(S1, o.rA.y, S0 * o.rA.x)));
      S0 = __builtin_fmaf(S0, o.wB.x, __builtin_fmaf(o.vB, o.kB.x, -(saB * o.bbB.x)));
      S1 = __builtin_fmaf(S1, o.wB.y, __builtin_fmaf(o.vB, o.kB.y, -(saB * o.bbB.y)));
      S2 = __builtin_fmaf(S2, o.wB.z, __builtin_fmaf(o.vB, o.kB.z, -(saB * o.bbB.z)));
      S3 = __builtin_fmaf(S3, o.wB.w, __builtin_fmaf(o.vB, o.kB.w, -(saB * o.bbB.w)));
      pp[((s + 1) * 4 + rl) * 16 + cl] = __builtin_fmaf(S3, o.rB.w, __builtin_fmaf(S2, o.rB.z, __builtin_fmaf(S1, o.rB.y, S0 * o.rB.x)));
    };
    Pair p0, p1;
    ldpair(p0, 0);
#pragma unroll
    for (int j = 0; j < 4; ++j) {
      ldpair(p1, 4 * j + 2);
      __builtin_amdgcn_sched_barrier(0);
      pairstep(p0, 4 * j);
      __builtin_amdgcn_sched_barrier(0);
      if (j < 3) ldpair(p0, 4 * j + 4);
      __builtin_amdgcn_sched_barrier(0);
      pairstep(p1, 4 * j + 2);
      __builtin_amdgcn_sched_barrier(0);
    }
    asm volatile("" ::: "memory");
    {
      const float* q0 = pp + (rstep * 4 + rrow) * 16;
      f32x4 a0 = *(const f32x4*)(q0), a1 = *(const f32x4*)(q0 + 4), a2 = *(const f32x4*)(q0 + 8), a3 = *(const f32x4*)(q0 + 12);
      f32x4 sm4 = (a0 + a1) + (a2 + a3);
      O[(tokb + (size_t)c * 16 + rstep) * 256 + chan0 + q * 16 + wv * 4 + rrow] = (sm4.x + sm4.y) + (sm4.z + sm4.w);
    }
    asm volatile("" ::: "memory");
  };
#pragma unroll 1
  for (int g = 0; g < NCH / 4; ++g) {
    const int c0 = g * 4;
    if (c0 + 4 < NCH) gload(R0, c0 + 4);
    chunk(c0);
    lwrite(R1, (c0 + 1) & 1);
    lds_barrier();
    if (c0 + 5 < NCH) gload(R1, c0 + 5);
    chunk(c0 + 1);
    lwrite(R2, (c0 + 2) & 1);
    lds_barrier();
    if (c0 + 6 < NCH) gload(R2, c0 + 6);
    chunk(c0 + 2);
    lwrite(R3, (c0 + 3) & 1);
    lds_barrier();
    if (c0 + 7 < NCH) gload(R3, c0 + 7);
    chunk(c0 + 3);
    if (c0 + 4 < NCH) lwrite(R0, (c0 + 4) & 1);
    lds_barrier();
  }
  __builtin_amdgcn_s_setprio(0);
}

__device__ __forceinline__ void rwkv_post_item(const Params& p, int l, int item) {
  const int j = TIDX;
  const float* O = (const float*)(p.ws + OFF_O);
  const u16* SR = (const u16*)(p.ws + OFF_SR); const u16* SK = (const u16*)(p.ws + OFF_SK);
  const u16* SV = (const u16*)(p.ws + OFF_SV); const u16* G = (const u16*)(p.ws + OFF_G);
  u16* OG = (u16*)(p.ws + OFF_OG);
  const float lw = p.in[18][l * 256 + j], lb = p.in[19][l * 256 + j], rk = p.in[17][l * 256 + j];
  const int tok0 = item * 8;
  float ov[8]; u16 rr[8], rkk[8], rv[8], rg[8];
#pragma unroll
  for (int t = 0; t < 8; ++t) {
    const size_t o = (size_t)(tok0 + t) * 256 + j;
    ov[t] = O[o]; rr[t] = SR[o]; rkk[t] = SK[o]; rv[t] = SV[o]; rg[t] = G[o];
  }
#pragma unroll
  for (int t = 0; t < 8; ++t) {
    const size_t o = (size_t)(tok0 + t) * 256 + j;
    float mean = wave_sum(ov[t]) * (1.f / 64.f);
    float d = ov[t] - mean;
    float var = wave_sum(d * d) * (1.f / 64.f);
    float on = d * rsqrtf(var + 64e-5f) * lw + lb;
    float bonus = wave_sum(bf2f(rr[t]) * bf2f(rkk[t]) * rk);
    OG[o] = f2bf((on + bonus * bf2f(rv[t])) * bf2f(rg[t]));
  }
}

#define XB_TMO      128
#define XB_XCNT(j)  (256  + 64 * (j))
#define XB_XSUB(j)  (1280 + 64 * (j))
#define XB_XGEN(j)  (2304 + 64 * (j))
#define XB_TOP      3328
#define XB_TOPGEN   3392
#define XCD_BAR_WORDS 3456
#define XB_SPIN_CAP (1u << 22)
#define LAS __attribute__((address_space(3)))
__device__ __forceinline__ unsigned xb_ld(unsigned* p) { return __hip_atomic_load(p, __ATOMIC_RELAXED, __HIP_MEMORY_SCOPE_AGENT); }
__device__ __forceinline__ unsigned xb_add(unsigned* p, unsigned v) { return __hip_atomic_fetch_add(p, v, __ATOMIC_RELAXED, __HIP_MEMORY_SCOPE_AGENT); }
__device__ __forceinline__ unsigned xb_xcc_id() { return (unsigned)__builtin_amdgcn_s_getreg((3 << 11) | 20) & 0xFu; }
#define XB_SPIN(cond, bar) do { unsigned _sp = 0; while (cond) { __builtin_amdgcn_s_sleep(1); \
    if ((++_sp & 255u) == 0u) { if (xb_ld(&(bar)[XB_TMO])) break; if (_sp > XB_SPIN_CAP) { atomicAdd(&(bar)[XB_TMO], 1u); break; } } } } while (0)
struct XcdBarrier { unsigned* bar; unsigned x; volatile LAS unsigned* st; };
__device__ __forceinline__ XcdBarrier xcd_barrier_post(unsigned* bar, volatile LAS unsigned* st) {
  XcdBarrier b; b.bar = bar; b.x = xb_xcc_id(); b.st = st;
  if (threadIdx.x == 0) st[2] = xb_add(&bar[XB_XCNT(b.x)], 1u);
  return b;
}
__device__ __forceinline__ void xcd_barrier_complete(unsigned* bar, unsigned x, unsigned& nloc, unsigned& nx) {
  const unsigned G = gridDim.x * gridDim.y * gridDim.z;
  unsigned sum, cnt, mine, sp = 0u;
  for (;;) {
    sum = 0u; cnt = 0u; mine = 0u;
#pragma unroll
    for (unsigned j = 0; j < 16; ++j) { const unsigned c = xb_ld(&bar[XB_XCNT(j)]); sum += c; cnt += (c > 0u) ? 1u : 0u; mine = (j == x) ? c : mine; }
    if (sum == G) break;
    __builtin_amdgcn_s_sleep(1);
    if ((++sp & 255u) == 0u) { if (xb_ld(&bar[XB_TMO])) break; if (sp > XB_SPIN_CAP) { atomicAdd(&bar[XB_TMO], 1u); break; } }
  }
  nloc = mine > 0u ? mine : 1u; nx = cnt > 0u ? cnt : 1u;
}
__device__ __forceinline__ void xcd_barrier(const XcdBarrier& b) {
  asm volatile("s_waitcnt vmcnt(0)" ::: "memory");
  __syncthreads();
  if (threadIdx.x == 0) {
    unsigned* bar = b.bar;
    __builtin_amdgcn_s_waitcnt(0);
    unsigned nloc = b.st[0], nx = b.st[1];
    if (nloc == 0u) { xcd_barrier_complete(bar, b.x, nloc, nx); b.st[0] = nloc; b.st[1] = nx; }
    const unsigned old = xb_add(&bar[XB_XSUB(b.x)], 1u);
    const unsigned gen = old / nloc;
    if (old + 1u == (gen + 1u) * nloc) {
      __builtin_amdgcn_fence(__ATOMIC_RELEASE, "agent");
      asm volatile("s_waitcnt vmcnt(0)" ::: "memory");
      const unsigned og = xb_add(&bar[XB_TOP], 1u);
      const unsigned tg = og / nx;
      if (og + 1u == (tg + 1u) * nx) xb_add(&bar[XB_TOPGEN], 1u);
      else XB_SPIN(xb_ld(&bar[XB_TOPGEN]) == tg, bar);
      __builtin_amdgcn_fence(__ATOMIC_ACQUIRE, "agent");
      xb_add(&bar[XB_XGEN(b.x)], 1u);
      asm volatile("s_waitcnt vmcnt(0)" ::: "memory");
    } else {
      XB_SPIN(xb_ld(&bar[XB_XGEN(b.x)]) == gen, bar);
      __builtin_amdgcn_fence(__ATOMIC_ACQUIRE, "agent");
      asm volatile("s_waitcnt vmcnt(0)" ::: "memory");
    }
  }
  __syncthreads();
}

__device__ __forceinline__ int xcd_virtual_id(const XcdBarrier& b) {
  if (threadIdx.x == 0) {
    unsigned base = 0u;
#pragma unroll
    for (unsigned j = 0; j < 16; ++j) { const unsigned c = xb_ld(&b.bar[XB_XCNT(j)]); base += (j < b.x) ? c : 0u; }
    b.st[3] = base + b.st[2];
  }
  __syncthreads();
  const int vb = __builtin_amdgcn_readfirstlane((int)b.st[3]);
  __syncthreads();
  return vb;
}

__device__ __forceinline__ void sub_barrier(unsigned* cnt, unsigned target) {
  asm volatile("s_waitcnt vmcnt(0)" ::: "memory");
  __syncthreads();
  if (threadIdx.x == 0) {
    __builtin_amdgcn_fence(__ATOMIC_RELEASE, "agent");
    asm volatile("s_waitcnt vmcnt(0)" ::: "memory");
    xb_add(cnt, 1u);
    unsigned sp = 0;
    while (xb_ld(cnt) < target) { __builtin_amdgcn_s_sleep(2); if (++sp > (1u << 24)) break; }
    __builtin_amdgcn_fence(__ATOMIC_ACQUIRE, "agent");
    asm volatile("s_waitcnt vmcnt(0)" ::: "memory");
  }
  __syncthreads();
}

#define N_PHASES 22
#ifndef PROBE_CONV_REPS
#define PROBE_CONV_REPS 1
#endif
#ifndef PROBE_PREP_REPS
#define PROBE_PREP_REPS 1
#endif
#ifndef PROBE_POST_REPS
#define PROBE_POST_REPS 1
#endif
#ifndef PROBE_SCAN_REPS
#define PROBE_SCAN_REPS 1
#endif
#ifndef PROBE_FFN1_REPS
#define PROBE_FFN1_REPS 1
#endif
#ifndef PH_MASK
#define PH_MASK 0xFFFFF
#endif
#define PHON(s) (PH_MASK & (1 << (s)))
#define PHASE_BEGIN(k) if (ph_hi > (k)) { if ((k) > 1) xcd_barrier(xb);
#define PHASE_END }

template <int L>
__device__ __forceinline__ void run_layer(const Params& p, int vbr, int ph_hi, unsigned char* smem_all, const XcdBarrier& xb) {
  unsigned char* smem = smem_all + SUBB * 73728;
  const int vb = vbr * 2 + SUBB;
  constexpr int l = L;
  constexpr int base = 1 + 10 * L;
  const float* modl = (const float*)(p.ws + OFF_MOD) + (size_t)l * 4 * 6144;
  PHASE_BEGIN(base + 0)
    for (int rep = 0; rep < PROBE_CONV_REPS; ++rep) {
      if (rep) xcd_barrier(xb);
      phase_convert(p, l, smem);
      phase_norm(l == 0 ? p.in[0] : p.out, p.in[4] + l * 1024, modl, 0, 1024, (u16*)(p.ws + OFF_H));
    }
  PHASE_END
  PHASE_BEGIN(base + 1)
    phase_gemm<0>(p, l, vb, smem);
  PHASE_END
  PHASE_BEGIN(base + 2)
    for (int rep = 0; rep < PROBE_PREP_REPS; ++rep) {
      if (rep) xcd_barrier(xb);
      for (int item = VBLK; item < 512; item += VGRID) rwkv_prep_item(p, l, item, smem);
    }
  PHASE_END
  PHASE_BEGIN(base + 3)
    if ((int)blockIdx.x < 64) {
      if (SUBB == 0) scan_item(p, blockIdx.x, smem);
      else { __syncthreads(); __syncthreads(); for (int c = 0; c < SEQ / 16; ++c) lds_barrier(); }
    }
    else {
      const int nb = VGRID - 128, bi = VBLK - 128;
      for (int item = bi; item < 512; item += nb) sg_item(p, l, item, smem);
      for (int item = (bi + 64) % nb; item < 1024; item += nb) s5a_item(p, l, item, smem);
      for (int item = bi; item < 2048; item += nb) conv_item(p, l, item);
      sub_barrier((unsigned*)(p.ws + OFF_BAR) + 3520 + 64 * (2 * l), gridDim.x - 64);
      for (int item = bi; item < 1024; item += nb) s5b_item(p, l, item, smem);
      sub_barrier((unsigned*)(p.ws + OFF_BAR) + 3520 + 64 * (2 * l + 1), gridDim.x - 64);
      for (int item = (int)blockIdx.x - 64; item < 512; item += (int)gridDim.x - 64) merge_tile8<0>(p, item, smem_all);
    }
  PHASE_END
  PHASE_BEGIN(base + 4)
    for (int rep = 0; rep < PROBE_POST_REPS; ++rep) { if (rep) xcd_barrier(xb); for (int item = VBLK; item < 2048; item += VGRID) rwkv_post_item(p, l, item); }
  PHASE_END
  PHASE_BEGIN(base + 5)
    for (int item = vbr; item < 512; item += (int)gridDim.x) {
      int it2 = item;
      if (gridDim.x == 256) { const int r = item >> 8, w = vbr & 31; it2 = ((r * 4 + (w >> 3)) << 6) | ((vbr >> 5) * 8 + (w & 7)); }
      merge_tile8<1>(p, it2, smem_all);
    }
  PHASE_END
  PHASE_BEGIN(base + 6)
    phase_gemm_8w<1>(p, l, vbr, smem_all);
  PHASE_END
  PHASE_BEGIN(base + 7)
    if (PHON(7)) phase_norm(p.out, p.in[38] + l * 1024, modl, 3072, 4096, (u16*)(p.ws + OFF_H));
  PHASE_END
  PHASE_BEGIN(base + 8)
    phase_gemm_8w<2>(p, l, vbr, smem_all);
  PHASE_END
#ifdef PROBE_DUP_FFN1
  PHASE_BEGIN(base + 8)
    phase_gemm_8w<2>(p, l, vbr, smem_all);
  PHASE_END
#endif
  PHASE_BEGIN(base + 9)
    phase_gemm_8w<3>(p, l, vbr, smem_all);
  PHASE_END
}

__global__ void __launch_bounds__(512, 2) mega_fwd(Params p, int ph_lo, int ph_hi) {
  __shared__ __attribute__((aligned(16))) unsigned char smem[2 * 73728 + 16];
  cg::grid_group grid = cg::this_grid();
  if (ph_hi < 0) grid.sync();
  volatile LAS unsigned* st = (volatile LAS unsigned*)(smem + 2 * 73728);
  if (threadIdx.x == 0) { st[0] = 0u; st[1] = 0u; st[2] = 0u; st[3] = 0u; }
  __syncthreads();
  const XcdBarrier xb = xcd_barrier_post((unsigned*)(p.ws + OFF_BAR), st);
  if (ph_hi > 0) phase_mod(p, smem + SUBB * 73728);
  xcd_barrier(xb);
  const int vb = xcd_virtual_id(xb);
  run_layer<0>(p, vb, ph_hi, smem, xb);
  run_layer<1>(p, vb, ph_hi, smem, xb);
  PHASE_BEGIN(21)
    if (PHON(11)) phase_final(p.out, p.in[41]);
  PHASE_END
}

extern "C" void kernel_launch(void* const* d_in, const int* in_sizes, int n_in, void* d_out, int out_size, void* d_ws,
                              size_t ws_size, hipStream_t stream) {
  static int grid_blocks = 0;
  if (!grid_blocks) {
    int dev = 0, cus = 0, per_cu = 0;
    hipGetDevice(&dev);
    hipDeviceGetAttribute(&cus, hipDeviceAttributeMultiprocessorCount, dev);
    hipOccupancyMaxActiveBlocksPerMultiprocessor(&per_cu, mega_fwd, 512, 0);
    if (per_cu > 1) per_cu = 1;
    if (per_cu < 1) per_cu = 1;
    grid_blocks = cus * per_cu;
    if (ws_size < WS_END) fprintf(stderr, "workspace too small: %zu < %zu\n", ws_size, (size_t)WS_END);
  }
  Params p{};
  for (int i = 0; i < 42; ++i) p.in[i] = (const float*)d_in[i];
  p.out = (float*)d_out;
  p.ws = (unsigned char*)d_ws;
  hipMemsetAsync((unsigned char*)d_ws + OFF_BAR, 0, 16384, stream);
  int lo = 0, hi = N_PHASES;
  void* args[] = {&p, &lo, &hi};
  hipError_t e = hipLaunchCooperativeKernel((void*)mega_fwd, dim3(grid_blocks), dim3(512), args, 0, stream);
  if (e != hipSuccess) fprintf(stderr, "cooperative launch failed: %s (grid %d)\n", hipGetErrorString(e), grid_blocks);
}
```

```cpp
#include <hip/hip_runtime.h>
#include <hip/hip_cooperative_groups.h>
#include <cstdio>
namespace cg = cooperative_groups;

typedef unsigned short u16;
using bf16x8 = __attribute__((ext_vector_type(8))) short;
using f32x4 = __attribute__((ext_vector_type(4))) float;
using u32x4 = __attribute__((ext_vector_type(4))) unsigned int;
using u32x2 = __attribute__((ext_vector_type(2))) unsigned int;
using f32x2 = __attribute__((ext_vector_type(2))) float;

#define T_TOK 16384
#define SEQ 4096
#define DM 1024
#define NTHR 256
#define TIDX ((int)(threadIdx.x & 255))
#define SUBB ((int)(threadIdx.x >> 8))
#define VBLK ((int)(blockIdx.x * 2 + (threadIdx.x >> 8)))
#define VGRID ((int)(gridDim.x * 2))

static constexpr size_t SZ_WIN = (size_t)6528 * 1024 * 2;
static constexpr size_t OFF_WIN = 0;
static constexpr size_t OFF_RO = OFF_WIN + SZ_WIN;
static constexpr size_t OFF_SO = OFF_RO + 1024 * 256 * 2;
static constexpr size_t OFF_CO = OFF_SO + 1024 * 256 * 2;
static constexpr size_t OFF_GLU = OFF_CO + 1024 * 256 * 2;
static constexpr size_t OFF_WO = OFF_GLU + 2048 * 256 * 2;
static constexpr size_t OFF_W1 = OFF_WO + 1024 * 1024 * 2;
static constexpr size_t OFF_W2 = OFF_W1 + (size_t)4096 * 1024 * 2;
static constexpr size_t OFF_H = OFF_W2 + (size_t)4096 * 1024 * 2;
static constexpr size_t SZ_T256B = (size_t)T_TOK * 256 * 2;
static constexpr size_t OFF_VF = OFF_H + (size_t)T_TOK * 1024 * 2;
static constexpr size_t OFF_PD = OFF_VF + SZ_T256B;
static constexpr size_t OFF_G = OFF_PD + SZ_T256B;
static constexpr size_t OFF_UB = OFF_G + SZ_T256B;
static constexpr size_t OFF_CB = OFF_UB + SZ_T256B;
static constexpr size_t OFF_SR = OFF_CB + SZ_T256B;
static constexpr size_t OFF_SK = OFF_SR + SZ_T256B;
static constexpr size_t OFF_SV = OFF_SK + SZ_T256B;
static constexpr size_t OFF_SKK = OFF_SV + SZ_T256B;
static constexpr size_t OFF_SA = OFF_SKK + SZ_T256B;
static constexpr size_t OFF_SW = OFF_SA + SZ_T256B;
static constexpr size_t OFF_PABC = OFF_SW + 2 * SZ_T256B;
static constexpr size_t OFF_YD = OFF_PABC;
static constexpr size_t OFF_OG = OFF_YD + SZ_T256B;
static constexpr size_t OFF_MRG = OFF_OG + SZ_T256B;
static constexpr size_t OFF_F = OFF_UB;
static constexpr size_t OFF_SMALL = OFF_PABC + (size_t)T_TOK * 2176 * 2;
static constexpr size_t OFF_MOD = OFF_SMALL;
static constexpr size_t OFF_S5AB = OFF_MOD + 2 * 4 * 6144 * 4;
static constexpr size_t OFF_S5BB = OFF_S5AB + 2 * 16 * 64 * 2 * 4;
static constexpr size_t OFF_S5E = OFF_S5BB + 2 * 16 * 64 * 32 * 4;
static constexpr size_t OFF_BAR = OFF_S5E + (size_t)4 * 64 * 16 * 64 * 2 * 4;
static constexpr size_t OFF_SGW = OFF_BAR + 16384;
static constexpr size_t OFF_O = OFF_SGW + 4 * 128 * 128 * 2;
static constexpr size_t OFF_LW2 = OFF_O + 2 * SZ_T256B;
static constexpr size_t OFF_LA2 = OFF_LW2 + 256 * 32 * 2;
static constexpr size_t OFF_LG2 = OFF_LA2 + 256 * 32 * 2;
static constexpr size_t OFF_LV2 = OFF_LG2 + 256 * 64 * 2;
static constexpr size_t OFF_LV1 = OFF_LV2 + 256 * 32 * 2;
static constexpr size_t WS_END = OFF_LV1 + 32 * 256 * 2;
static_assert(OFF_F + (size_t)T_TOK * 4096 * 2 <= OFF_SMALL, "F overlaps small region");
static_assert(OFF_MRG + (size_t)T_TOK * 1024 * 2 <= OFF_SMALL, "MRG overlaps");

struct Params {
  const float* in[42];
  float* out;
  unsigned char* ws;
};

__device__ __forceinline__ u16 f2bf(float f) {
  unsigned u = __float_as_uint(f);
  u += 0x7fffu + ((u >> 16) & 1u);
  return (u16)(u >> 16);
}
__device__ __forceinline__ float bf2f(u16 h) { return __uint_as_float(((unsigned)h) << 16); }
__device__ __forceinline__ float bflo(unsigned u) { return __uint_as_float(u << 16); }
__device__ __forceinline__ float bfhi(unsigned u) { return __uint_as_float(u & 0xffff0000u); }
__device__ __forceinline__ unsigned pack2(float a, float b) { return (unsigned)f2bf(a) | ((unsigned)f2bf(b) << 16); }
__device__ __forceinline__ float sigmoidf_(float x) { return 1.f / (1.f + __expf(-x)); }
__device__ __forceinline__ float tanhf_(float y) { return 1.f - 2.f / (1.f + __expf(2.f * y)); }
__device__ __forceinline__ float geluf_(float x) {
  float y = 0.7978845608028654f * (x + 0.044715f * x * x * x);
  return 0.5f * x * (1.f + tanhf_(y));
}
__device__ __forceinline__ float wave_sum(float v) {
#pragma unroll
  for (int o = 32; o > 0; o >>= 1) v += __shfl_xor(v, o, 64);
  return v;
}
template <int CTRL>
__device__ __forceinline__ float dppf(float x) {
  return __int_as_float(__builtin_amdgcn_update_dpp(__float_as_int(x), __float_as_int(x), CTRL, 0xF, 0xF, true));
}
__device__ __forceinline__ float row_sum16(float x) {
  x += dppf<0x128>(x);
  x += dppf<0x124>(x);
  x += dppf<0x122>(x);
  x += dppf<0x121>(x);
  return x;
}

__device__ __forceinline__ void phase_mod(const Params& p, unsigned char* smem) {
  const int tid = TIDX;
  float* cact = (float*)smem;
  float* red = cact + 4096;
  float* mod = (float*)(p.ws + OFF_MOD);
  for (int i = tid; i < 4096; i += NTHR) { float c = p.in[1][i]; cact[i] = c / (1.f + __expf(-c)); }
  __syncthreads();
  for (int item = VBLK; item < 192; item += VGRID) {
    int l = item / 96, nb = item % 96;
    int cl = tid & 63, kq = tid >> 6;
    int col = nb * 64 + cl;
    const float* W = p.in[2] + (size_t)l * 1024 * 6144;
    float a0 = 0, a1 = 0, a2 = 0, a3 = 0;
    for (int k = kq * 256; k < kq * 256 + 256; ++k) {
      float w = W[(size_t)k * 6144 + col];
      a0 += cact[k] * w; a1 += cact[1024 + k] * w; a2 += cact[2048 + k] * w; a3 += cact[3072 + k] * w;
    }
    red[(kq * 4 + 0) * 64 + cl] = a0; red[(kq * 4 + 1) * 64 + cl] = a1;
    red[(kq * 4 + 2) * 64 + cl] = a2; red[(kq * 4 + 3) * 64 + cl] = a3;
    __syncthreads();
    {
      int b = tid >> 6;
      float s = red[(0 * 4 + b) * 64 + cl] + red[(1 * 4 + b) * 64 + cl] + red[(2 * 4 + b) * 64 + cl] + red[(3 * 4 + b) * 64 + cl];
      mod[((size_t)l * 4 + b) * 6144 + col] = s + p.in[3][l * 6144 + col];
    }
    __syncthreads();
  }
  float* s5ab = (float*)(p.ws + OFF_S5AB);
  float* s5bb = (float*)(p.ws + OFF_S5BB);
  for (int idx = VBLK * NTHR + tid; idx < 2048; idx += VGRID * NTHR) {
    int l = idx >> 10, g = (idx >> 6) & 15, n = idx & 63;
    double lre = fmin((double)p.in[28][idx], -1e-4);
    double lim = (double)p.in[29][idx];
    double dt = exp((double)p.in[35][l * 16 + g]);
    double mag = exp(lre * dt);
    double abr = mag * cos(lim * dt), abi = mag * sin(lim * dt);
    double den = lre * lre + lim * lim;
    double qr = ((abr - 1.0) * lre + abi * lim) / den;
    double qi = (abi * lre - (abr - 1.0) * lim) / den;
    s5ab[idx * 2 + 0] = (float)abr; s5ab[idx * 2 + 1] = (float)abi;
    for (int c = 0; c < 16; ++c) {
      double br = p.in[30][(size_t)idx * 16 + c], bi = p.in[31][(size_t)idx * 16 + c];
      s5bb[(size_t)idx * 32 + c] = (float)(qr * br - qi * bi);
      s5bb[(size_t)idx * 32 + 16 + c] = (float)(qr * bi + qi * br);
    }
  }
}

__device__ __forceinline__ void convert_tile(const float* __restrict__ src, int K, int N, u16* __restrict__ dst, int tk, int tn, u16* sm) {
  const int tid = TIDX;
  int r = tid >> 4, c4 = (tid & 15) * 4;
#pragma unroll
  for (int i = 0; i < 4; ++i) {
    int kk = r + 16 * i;
    float4 v = *(const float4*)(src + (size_t)(tk * 64 + kk) * N + tn * 64 + c4);
    sm[(c4 + 0) * 72 + kk] = f2bf(v.x);
    sm[(c4 + 1) * 72 + kk] = f2bf(v.y);
    sm[(c4 + 2) * 72 + kk] = f2bf(v.z);
    sm[(c4 + 3) * 72 + kk] = f2bf(v.w);
  }
  __syncthreads();
#pragma unroll
  for (int j = 0; j < 2; ++j) {
    int n = (tid >> 3) + 32 * j, ch = tid & 7;
    u32x4 v = *(const u32x4*)(sm + n * 72 + ch * 8);
    *(u32x4*)(dst + (size_t)(tn * 64 + n) * K + tk * 64 + ch * 8) = v;
  }
  __syncthreads();
}

__device__ __forceinline__ void phase_convert(const Params& p, int l, unsigned char* smem) {
  u16* sm = (u16*)smem;
  const int total = 1632 + 192 + 128 + 256 + 1024 + 1024;
  for (int item = VBLK; item < total + 16 + 192; item += VGRID) {
    int t = item;
    if (t >= total + 16) {
      const int e = (t - total - 16) * 256 + TIDX;
      if (e < 8192) { const int n = e >> 5, k = e & 31; ((u16*)(p.ws + OFF_LW2))[e] = f2bf(p.in[8][(size_t)l * 8192 + k * 256 + n]); }
      else if (e < 16384) { const int q = e - 8192, n = q >> 5, k = q & 31; ((u16*)(p.ws + OFF_LA2))[q] = f2bf(p.in[10][(size_t)l * 8192 + k * 256 + n]); }
      else if (e < 32768) { const int q = e - 16384, n = q >> 6, k = q & 63; ((u16*)(p.ws + OFF_LG2))[q] = f2bf(p.in[11][(size_t)l * 16384 + k * 256 + n]); }
      else if (e < 40960) { const int q = e - 32768, n = q >> 5, k = q & 31; ((u16*)(p.ws + OFF_LV2))[q] = (l > 0) ? f2bf(p.in[14][k * 256 + n]) : (u16)0; }
      else { const int q = e - 40960, n = q >> 8, k = q & 255; ((u16*)(p.ws + OFF_LV1))[q] = (l > 0) ? f2bf(p.in[13][k * 32 + n]) : (u16)0; }
      continue;
    }
    if (t >= total) {
      const int idx = t - total, g = idx >> 2, rq = idx & 3;
      const int tr = rq * 32 + (TIDX >> 3), s0 = (TIDX & 7) * 16;
      const float* src = p.in[23] + (((size_t)l * 4 + g) * 128 + tr) * 128 + s0;
      u16* dst = (u16*)(p.ws + OFF_SGW) + ((size_t)g * 128 + tr) * 128 + s0;
      unsigned pk[8];
#pragma unroll
      for (int e = 0; e < 4; ++e) {
        f32x4 v = *(const f32x4*)(src + e * 4);
        const int sb = s0 + e * 4;
        pk[e * 2 + 0] = pack2(sb + 0 <= tr ? v.x : 0.f, sb + 1 <= tr ? v.y : 0.f);
        pk[e * 2 + 1] = pack2(sb + 2 <= tr ? v.z : 0.f, sb + 3 <= tr ? v.w : 0.f);
      }
      *(u32x4*)(dst) = u32x4{pk[0], pk[1], pk[2], pk[3]};
      *(u32x4*)(dst + 8) = u32x4{pk[4], pk[5], pk[6], pk[7]};
      continue;
    }
    const float* src; int K, N; size_t off;
    if (t < 1632) { src = p.in[5] + (size_t)l * 1024 * 6528; K = 1024; N = 6528; off = OFF_WIN; }
    else if ((t -= 1632) < 64) { src = p.in[20] + (size_t)l * 256 * 1024; K = 256; N = 1024; off = OFF_RO; }
    else if ((t -= 64) < 64) { src = p.in[25] + (size_t)l * 256 * 1024; K = 256; N = 1024; off = OFF_SO; }
    else if ((t -= 64) < 64) { src = p.in[27] + (size_t)l * 256 * 1024; K = 256; N = 1024; off = OFF_CO; }
    else if ((t -= 64) < 128) { src = p.in[36] + (size_t)l * 256 * 2048; K = 256; N = 2048; off = OFF_GLU; }
    else if ((t -= 128) < 256) { src = p.in[37] + (size_t)l * 1024 * 1024; K = 1024; N = 1024; off = OFF_WO; }
    else if ((t -= 256) < 1024) { src = p.in[39] + (size_t)l * 1024 * 4096; K = 1024; N = 4096; off = OFF_W1; }
    else { t -= 1024; src = p.in[40] + (size_t)l * 4096 * 1024; K = 4096; N = 1024; off = OFF_W2; }
    int ntn = N / 64;
    convert_tile(src, K, N, (u16*)(p.ws + off), t / ntn, t % ntn, sm);
  }
}

__device__ __forceinline__ void phase_norm(const float* __restrict__ X, const float* __restrict__ g, const float* __restrict__ modl,
                           int sh_off, int sc_off, u16* __restrict__ H) {
  const int lane = TIDX & 63, wv = TIDX >> 6;
  for (int item = VBLK; item < T_TOK / 4; item += VGRID) {
    int row = item * 4 + wv;
    int b = row >> 12;
    const float* xr = X + (size_t)row * 1024;
    float4 v[4];
    float ss = 0;
#pragma unroll
    for (int i = 0; i < 4; ++i) {
      v[i] = *(const float4*)(xr + lane * 4 + 256 * i);
      ss += v[i].x * v[i].x + v[i].y * v[i].y + v[i].z * v[i].z + v[i].w * v[i].w;
    }
    ss = wave_sum(ss);
    float rstd = rsqrtf(ss * (1.f / 1024.f) + 1e-6f);
    const float* sh = modl + (size_t)b * 6144 + sh_off;
    const float* sc = modl + (size_t)b * 6144 + sc_off;
#pragma unroll
    for (int i = 0; i < 4; ++i) {
      int c = lane * 4 + 256 * i;
      float4 gg = *(const float4*)(g + c);
      float4 s1 = *(const float4*)(sc + c);
      float4 s0 = *(const float4*)(sh + c);
      float h0 = v[i].x * rstd * gg.x * (1.f + s1.x) + s0.x;
      float h1 = v[i].y * rstd * gg.y * (1.f + s1.y) + s0.y;
      float h2 = v[i].z * rstd * gg.z * (1.f + s1.z) + s0.z;
      float h3 = v[i].w * rstd * gg.w * (1.f + s1.w) + s0.w;
      u32x2 o; o.x = pack2(h0, h1); o.y = pack2(h2, h3);
      *(u32x2*)(H + (size_t)row * 1024 + c) = o;
    }
  }
}

__device__ __forceinline__ void phase_final(float* __restrict__ X, const float* __restrict__ g) {
  const int lane = TIDX & 63, wv = TIDX >> 6;
  for (int item = VBLK; item < T_TOK / 4; item += VGRID) {
    int row = item * 4 + wv;
    float* xr = X + (size_t)row * 1024;
    float4 v[4];
    float ss = 0;
#pragma unroll
    for (int i = 0; i < 4; ++i) {
      v[i] = *(const float4*)(xr + lane * 4 + 256 * i);
      ss += v[i].x * v[i].x + v[i].y * v[i].y + v[i].z * v[i].z + v[i].w * v[i].w;
    }
    ss = wave_sum(ss);
    float rstd = rsqrtf(ss * (1.f / 1024.f) + 1e-6f);
#pragma unroll
    for (int i = 0; i < 4; ++i) {
      int c = lane * 4 + 256 * i;
      float4 gg = *(const float4*)(g + c);
      float4 o;
      o.x = v[i].x * rstd * gg.x; o.y = v[i].y * rstd * gg.y; o.z = v[i].z * rstd * gg.z; o.w = v[i].w * rstd * gg.w;
      *(float4*)(xr + c) = o;
    }
  }
}

template <int NF, bool LEAN = false>
__device__ __forceinline__ void gemm_mainloop(const u16* __restrict__ A, int lda, const u16* __restrict__ B, int ldb,
                                              int K, f32x4 (&acc)[4][NF], u16* smem) {
  constexpr int BN = 32 * NF;
  constexpr int NB = BN / 32;
  u16* sA = smem;
  u16* sB = smem + 2 * 128 * 64;
  int tz = 0;
  if (LEAN) asm volatile("" : "+v"(tz));
  const int tid = TIDX + tz, lane = tid & 63, wv = tid >> 6;
  const int wm = wv >> 1, wn = wv & 1;
  const int lrow = tid >> 3;
  const int lchs = (tid & 7) ^ ((lrow >> 1) & 7);
  const u16* Ap = A + (size_t)lrow * lda + lchs * 8;
  const u16* Bp = B + (size_t)lrow * ldb + lchs * 8;
  const int nk = K >> 6;
  auto stage = [&](int kt, int buf) {
    const int ko = kt << 6;
#pragma unroll
    for (int i = 0; i < 4; ++i)
      __builtin_amdgcn_global_load_lds((const unsigned*)(Ap + (size_t)(32 * i) * lda + ko),
                                       (__attribute__((address_space(3))) unsigned*)(sA + buf * (128 * 64) + (tid + 256 * i) * 8), 16, 0, 0);
#pragma unroll
    for (int i = 0; i < NB; ++i)
      __builtin_amdgcn_global_load_lds((const unsigned*)(Bp + (size_t)(32 * i) * ldb + ko),
                                       (__attribute__((address_space(3))) unsigned*)(sB + buf * (BN * 64) + (tid + 256 * i) * 8), 16, 0, 0);
  };
  __syncthreads();
  stage(0, 0);
  const int fr = lane & 15, fq = lane >> 4;
  const int sw = (fr >> 1) & 7;
  for (int kt = 0; kt < nk; ++kt) {
    const int cur = kt & 1;
    asm volatile("s_waitcnt vmcnt(0)" ::: "memory");
    __syncthreads();
    if (kt + 1 < nk) stage(kt + 1, cur ^ 1);
    const u16* cA = sA + cur * (128 * 64) + (wm * 64 + fr) * 64;
    const u16* cB = sB + cur * (BN * 64) + (wn * 16 * NF + fr) * 64;
#pragma unroll
    for (int ks = 0; ks < 2; ++ks) {
      if (LEAN) __builtin_amdgcn_sched_barrier(0);
      const int pc = ((fq + 4 * ks) ^ sw) << 3;
      bf16x8 fa[4], fb[NF];
#pragma unroll
      for (int i = 0; i < 4; ++i) fa[i] = *(const bf16x8*)(cA + i * 16 * 64 + pc);
#pragma unroll
      for (int j = 0; j < NF; ++j) fb[j] = *(const bf16x8*)(cB + j * 16 * 64 + pc);
#pragma unroll
      for (int i = 0; i < 4; ++i)
#pragma unroll
        for (int j = 0; j < NF; ++j)
          acc[i][j] = __builtin_amdgcn_mfma_f32_16x16x32_bf16(fb[j], fa[i], acc[i][j], 0, 0, 0);
    }
  }
}

template <int NF>
__device__ __forceinline__ void zero_acc(f32x4 (&acc)[4][NF]) {
#pragma unroll
  for (int i = 0; i < 4; ++i)
#pragma unroll
    for (int j = 0; j < NF; ++j) acc[i][j] = f32x4{0.f, 0.f, 0.f, 0.f};
}

__device__ __forceinline__ void gemm_mainloop_8w(const u16* __restrict__ A, int lda, const u16* __restrict__ B, int ldb,
                                                 int K, f32x4 (&acc)[8][4], u16* smem) {
  constexpr int STG = 32768;
  const int tid = threadIdx.x, lane = tid & 63, wv = tid >> 6;
  const int wm = wv >> 2, wn = wv & 3;
  const int lrow = tid >> 3;
  const int lchs = (tid & 7) ^ ((lrow >> 1) & 7);
  const u16* Ap = A + (size_t)lrow * lda + lchs * 8;
  const u16* Bp = B + (size_t)lrow * ldb + lchs * 8;
  const int nk = K >> 6;
  auto stage = [&](int kt, int buf) {
    const int ko = kt << 6;
    u16* sa = smem + buf * STG;
#pragma unroll
    for (int i = 0; i < 4; ++i)
      __builtin_amdgcn_global_load_lds((const unsigned*)(Ap + (size_t)(64 * i) * lda + ko),
                                       (__attribute__((address_space(3))) unsigned*)(sa + (tid + 512 * i) * 8), 16, 0, 0);
#pragma unroll
    for (int i = 0; i < 4; ++i)
      __builtin_amdgcn_global_load_lds((const unsigned*)(Bp + (size_t)(64 * i) * ldb + ko),
                                       (__attribute__((address_space(3))) unsigned*)(sa + 16384 + (tid + 512 * i) * 8), 16, 0, 0);
  };
  __syncthreads();
  stage(0, 0);
  const int fr = lane & 15, fq = lane >> 4;
  const int sw = (fr >> 1) & 7;
  for (int kt = 0; kt < nk; ++kt) {
    const int cur = kt & 1;
    asm volatile("s_waitcnt vmcnt(0)" ::: "memory");
    __syncthreads();
    if (kt + 1 < nk) stage(kt + 1, cur ^ 1);
    const u16* cA = smem + cur * STG + (wm * 128 + fr) * 64;
    const u16* cB = smem + cur * STG + 16384 + (wn * 64 + fr) * 64;
#pragma unroll
    for (int ks = 0; ks < 2; ++ks) {
      const int pc = ((fq + 4 * ks) ^ sw) << 3;
      bf16x8 fa[8], fb[4];
#pragma unroll
      for (int i = 0; i < 8; ++i) fa[i] = *(const bf16x8*)(cA + i * 16 * 64 + pc);
#pragma unroll
      for (int j = 0; j < 4; ++j) fb[j] = *(const bf16x8*)(cB + j * 16 * 64 + pc);
#pragma unroll
      for (int i = 0; i < 8; ++i)
#pragma unroll
        for (int j = 0; j < 4; ++j)
          acc[i][j] = __builtin_amdgcn_mfma_f32_16x16x32_bf16(fb[j], fa[i], acc[i][j], 0, 0, 0);
    }
  }
}

template <int EPI>
__device__ __forceinline__ void phase_gemm_8w(const Params& p, int l, int vb, unsigned char* smem_raw) {
  u16* smem = (u16*)smem_raw;
  const int lane = threadIdx.x & 63, wv = threadIdx.x >> 6;
  const int wm = wv >> 2, wn = wv & 3;
  const int fr = lane & 15, fq = lane >> 4;
  const u16* A; const u16* B; int lda, ldb, K, ntiles_n;
  if (EPI == 1) { A = (const u16*)(p.ws + OFF_MRG); lda = 1024; B = (const u16*)(p.ws + OFF_WO); ldb = 1024; K = 1024; ntiles_n = 4; }
  if (EPI == 2) { A = (const u16*)(p.ws + OFF_H); lda = 1024; B = (const u16*)(p.ws + OFF_W1); ldb = 1024; K = 1024; ntiles_n = 16; }
  if (EPI == 3) { A = (const u16*)(p.ws + OFF_F); lda = 4096; B = (const u16*)(p.ws + OFF_W2); ldb = 4096; K = 4096; ntiles_n = 4; }
  const float* modl = (const float*)(p.ws + OFF_MOD) + (size_t)l * 4 * 6144;
  const int total = 64 * ntiles_n;
  const int G = gridDim.x;
  const bool swz = (G == 256);
  for (int item = vb; item < total; item += G) {
    int mt = item & 63, nt = item >> 6;
    if (swz) { const int r = item >> 8, w = vb & 31; mt = (vb >> 5) * 8 + (w & 7); nt = r * 4 + (w >> 3); }
    const int m0 = mt * 256, n0 = nt * 256;
    f32x4 acc[8][4];
#pragma unroll
    for (int i = 0; i < 8; ++i)
#pragma unroll
      for (int j = 0; j < 4; ++j) acc[i][j] = f32x4{0.f, 0.f, 0.f, 0.f};
    gemm_mainloop_8w(A + (size_t)m0 * lda, lda, B + (size_t)n0 * ldb, ldb, K, acc, smem);
#pragma unroll
    for (int i = 0; i < 8; ++i) {
      const int m = m0 + wm * 128 + i * 16 + fr;
#pragma unroll
      for (int j = 0; j < 4; ++j) {
        const int n = n0 + wn * 64 + j * 16 + fq * 4;
        f32x4 v = acc[i][j];
        if (EPI == 1 || EPI == 3) {
          const int b = m >> 12;
          const float* gt = modl + (size_t)b * 6144 + (EPI == 1 ? 2048 : 5120) + n;
          const float* xin = ((EPI == 1 && l == 0) ? p.in[0] : p.out) + (size_t)m * 1024 + n;
          f32x4 x = *(const f32x4*)xin;
          f32x4 gg = *(const f32x4*)gt;
          *(f32x4*)(p.out + (size_t)m * 1024 + n) = x + gg * v;
        } else {
          float r0 = fmaxf(v[0], 0.f), r1 = fmaxf(v[1], 0.f), r2 = fmaxf(v[2], 0.f), r3 = fmaxf(v[3], 0.f);
          *(u32x2*)((u16*)(p.ws + OFF_F) + (size_t)m * 4096 + n) = u32x2{pack2(r0 * r0, r1 * r1), pack2(r2 * r2, r3 * r3)};
        }
      }
    }
  }
}

template <int EPI>
__device__ __forceinline__ void phase_gemm(const Params& p, int l, int vb, unsigned char* smem_raw) {
  u16* smem = (u16*)smem_raw;
  const int lane = TIDX & 63, wv = TIDX >> 6;
  const int wm = wv >> 1, wn = wv & 1;
  const int fr = lane & 15, fq = lane >> 4;
  const u16* A; const u16* B; int lda, ldb, K, ntiles_n;
  if (EPI == 0) { A = (const u16*)(p.ws + OFF_H); lda = 1024; B = (const u16*)(p.ws + OFF_WIN); ldb = 1024; K = 1024; ntiles_n = 19; }
  if (EPI == 1) { A = (const u16*)(p.ws + OFF_MRG); lda = 1024; B = (const u16*)(p.ws + OFF_WO); ldb = 1024; K = 1024; ntiles_n = 8; }
  if (EPI == 2) { A = (const u16*)(p.ws + OFF_H); lda = 1024; B = (const u16*)(p.ws + OFF_W1); ldb = 1024; K = 1024; ntiles_n = 32; }
  if (EPI == 3) { A = (const u16*)(p.ws + OFF_F); lda = 4096; B = (const u16*)(p.ws + OFF_W2); ldb = 4096; K = 4096; ntiles_n = 8; }
  const float* modl = (const float*)(p.ws + OFF_MOD) + (size_t)l * 4 * 6144;
  const int G = VGRID;
  const bool swz = (G == 512);
  const int total = swz ? 128 * ((ntiles_n + 3) & ~3) : 128 * ntiles_n;
  for (int item = vb; item < total; item += G) {
    int mt = item & 127, nt = item >> 7;
    if (swz) { const int r = item >> 9, w = vb & 63; mt = (vb >> 6) * 16 + (w & 15); nt = r * 4 + (w >> 4); if (nt >= ntiles_n) continue; }
    const int m0 = mt * 128, n0 = nt * 128;
    f32x4 acc[4][4];
    zero_acc<4>(acc);
    gemm_mainloop<4>(A + (size_t)m0 * lda, lda, B + (size_t)n0 * ldb, ldb, K, acc, smem);
#pragma unroll
    for (int i = 0; i < 4; ++i) {
      const int m = m0 + wm * 64 + i * 16 + fr;
#pragma unroll
      for (int j = 0; j < 4; ++j) {
        const int n = n0 + wn * 64 + j * 16 + fq * 4;
        f32x4 v = acc[i][j];
        if (EPI == 0) {
          u32x2 o; o.x = pack2(v[0], v[1]); o.y = pack2(v[2], v[3]);
          if (n < 2176) *(u32x2*)((u16*)(p.ws + OFF_PABC) + (size_t)m * 2176 + n) = o;
          else *(u32x2*)((u16*)(p.ws + OFF_PD) + (size_t)m * 256 + (n - 2176)) = o;
        } else if (EPI == 1 || EPI == 3) {
          const int b = m >> 12;
          const float* gt = modl + (size_t)b * 6144 + (EPI == 1 ? 2048 : 5120) + n;
          const float* xin = ((EPI == 1 && l == 0) ? p.in[0] : p.out) + (size_t)m * 1024 + n;
          float4 x = *(const float4*)xin;
          float4 gg = *(const float4*)gt;
          float4 o;
          o.x = x.x + gg.x * v[0]; o.y = x.y + gg.y * v[1]; o.z = x.z + gg.z * v[2]; o.w = x.w + gg.w * v[3];
          *(float4*)(p.out + (size_t)m * 1024 + n) = o;
        } else {
          float r0 = fmaxf(v[0], 0.f), r1 = fmaxf(v[1], 0.f), r2 = fmaxf(v[2], 0.f), r3 = fmaxf(v[3], 0.f);
          u32x2 o; o.x = pack2(r0 * r0, r1 * r1); o.y = pack2(r2 * r2, r3 * r3);
          *(u32x2*)((u16*)(p.ws + OFF_F) + (size_t)m * 4096 + n) = o;
        }
      }
    }
  }
}

template <int MODE>
__device__ __forceinline__ void merge_tile(const Params& p, int item, unsigned char* smem_raw) {
  u16* smem = (u16*)smem_raw;
  const int lane = TIDX & 63, wv = TIDX >> 6;
  const int wm = wv >> 1, wn = wv & 1;
  const int fr = lane & 15, fq = lane >> 4;
  const u16* H = (const u16*)(p.ws + OFF_H);
  const u16* WIN = (const u16*)(p.ws + OFF_WIN);
  const int mt = item & 127, nt = item >> 7;
  const int m0 = mt * 128, n0 = nt * 128;
  f32x4 bacc[4][4];
  u32x2 gpk[4][4];
  u16* MRG = (u16*)(p.ws + OFF_MRG);
#pragma unroll 1
  for (int br = (MODE == 0 ? 1 : 0); br < (MODE == 0 ? 4 : 1); ++br) {
    zero_acc<4>(bacc);
    gemm_mainloop<4, true>(H + (size_t)m0 * 1024, 1024, WIN + (size_t)(2432 + br * 1024 + n0) * 1024, 1024, 1024, bacc, smem);
#pragma unroll
    for (int i = 0; i < 4; ++i)
#pragma unroll
      for (int j = 0; j < 4; ++j)
        gpk[i][j] = u32x2{pack2(sigmoidf_(bacc[i][j][0]), sigmoidf_(bacc[i][j][1])), pack2(sigmoidf_(bacc[i][j][2]), sigmoidf_(bacc[i][j][3]))};
    const u16* Ab; const u16* Wb;
    if (br == 0) { Ab = (const u16*)(p.ws + OFF_OG); Wb = (const u16*)(p.ws + OFF_RO); }
    else if (br == 1) { Ab = (const u16*)(p.ws + OFF_UB); Wb = (const u16*)(p.ws + OFF_SO); }
    else if (br == 2) { Ab = (const u16*)(p.ws + OFF_CB); Wb = (const u16*)(p.ws + OFF_CO); }
    else { Ab = (const u16*)(p.ws + OFF_YD); Wb = (const u16*)(p.ws + OFF_GLU); }
    if (MODE == 0 && br == 3) {
      zero_acc<4>(bacc);
      gemm_mainloop<4, true>(Ab + (size_t)m0 * 256, 256, Wb + (size_t)(1024 + n0) * 256, 256, 256, bacc, smem);
#pragma unroll
      for (int i = 0; i < 4; ++i)
#pragma unroll
        for (int j = 0; j < 4; ++j) {
          const float g0 = bflo(gpk[i][j].x) * sigmoidf_(bacc[i][j][0]), g1 = bfhi(gpk[i][j].x) * sigmoidf_(bacc[i][j][1]);
          const float g2 = bflo(gpk[i][j].y) * sigmoidf_(bacc[i][j][2]), g3 = bfhi(gpk[i][j].y) * sigmoidf_(bacc[i][j][3]);
          gpk[i][j] = u32x2{pack2(g0, g1), pack2(g2, g3)};
        }
    }
    zero_acc<4>(bacc);
    gemm_mainloop<4, true>(Ab + (size_t)m0 * 256, 256, Wb + (size_t)n0 * 256, 256, 256, bacc, smem);
#pragma unroll
    for (int i = 0; i < 4; ++i)
#pragma unroll
      for (int j = 0; j < 4; ++j) {
        u32x2* mp = (u32x2*)(MRG + (size_t)(m0 + wm * 64 + i * 16 + fr) * 1024 + n0 + wn * 64 + j * 16 + fq * 4);
        u32x2 cm = u32x2{0u, 0u};
        if (MODE == 1 || br > 1) cm = *mp;
        const float v0 = bflo(cm.x) + bflo(gpk[i][j].x) * bacc[i][j][0];
        const float v1 = bfhi(cm.x) + bfhi(gpk[i][j].x) * bacc[i][j][1];
        const float v2 = bflo(cm.y) + bflo(gpk[i][j].y) * bacc[i][j][2];
        const float v3 = bfhi(cm.y) + bfhi(gpk[i][j].y) * bacc[i][j][3];
        *mp = u32x2{pack2(v0, v1), pack2(v2, v3)};
      }
  }
}

__device__ __forceinline__ void gemm_mainloop_8n(const u16* __restrict__ A, int lda, const u16* __restrict__ B, int ldb,
                                                 int K, f32x4 (&acc)[4][4], u16* smem) {
  constexpr int STG = 24576;
  int tz = 0;
  asm volatile("" : "+v"(tz));
  const int tid = threadIdx.x + tz, lane = tid & 63, wv = tid >> 6;
  const int wm = wv >> 1, wn = wv & 1;
  const int lrow = tid >> 3;
  const int lchs = (tid & 7) ^ ((lrow >> 1) & 7);
  const u16* Ap = A + (size_t)lrow * lda + lchs * 8;
  const u16* Bp = B + (size_t)lrow * ldb + lchs * 8;
  const int nk = K >> 6;
  auto stage = [&](int kt, int buf) {
    const int ko = kt << 6;
    u16* sa = smem + buf * STG;
#pragma unroll
    for (int i = 0; i < 4; ++i)
      __builtin_amdgcn_global_load_lds((const unsigned*)(Ap + (size_t)(64 * i) * lda + ko),
                                       (__attribute__((address_space(3))) unsigned*)(sa + (tid + 512 * i) * 8), 16, 0, 0);
#pragma unroll
    for (int i = 0; i < 2; ++i)
      __builtin_amdgcn_global_load_lds((const unsigned*)(Bp + (size_t)(64 * i) * ldb + ko),
                                       (__attribute__((address_space(3))) unsigned*)(sa + 16384 + (tid + 512 * i) * 8), 16, 0, 0);
  };
  __syncthreads();
  stage(0, 0);
  stage(nk > 1 ? 1 : 0, 1);
  const int fr = lane & 15, fq = lane >> 4;
  const int sw = (fr >> 1) & 7;
  int cur = 0;
  for (int kt = 0; kt < nk; ++kt) {
    asm volatile("s_waitcnt vmcnt(6)" ::: "memory");
    __builtin_amdgcn_s_barrier();
    asm volatile("" ::: "memory");
    {
      int nx = cur + 2; if (nx >= 3) nx -= 3;
      int ktn = kt + 2; if (ktn >= nk) ktn = nk - 1;
      stage(ktn, nx);
    }
    const u16* cA = smem + cur * STG + (wm * 64 + fr) * 64;
    const u16* cB = smem + cur * STG + 16384 + (wn * 64 + fr) * 64;
#pragma unroll
    for (int ks = 0; ks < 2; ++ks) {
      const int pc = ((fq + 4 * ks) ^ sw) << 3;
      bf16x8 fa[4], fb[4];
#pragma unroll
      for (int i = 0; i < 4; ++i) fa[i] = *(const bf16x8*)(cA + i * 16 * 64 + pc);
#pragma unroll
      for (int j = 0; j < 4; ++j) fb[j] = *(const bf16x8*)(cB + j * 16 * 64 + pc);
#pragma unroll
      for (int i = 0; i < 4; ++i)
#pragma unroll
        for (int j = 0; j < 4; ++j)
          acc[i][j] = __builtin_amdgcn_mfma_f32_16x16x32_bf16(fb[j], fa[i], acc[i][j], 0, 0, 0);
    }
    cur = cur + 1; if (cur >= 3) cur = 0;
  }
  asm volatile("s_waitcnt vmcnt(0)" ::: "memory");
}

template <int MODE>
__device__ __forceinline__ void merge_tile8(const Params& p, int item, unsigned char* smem_raw) {
  u16* smem = (u16*)smem_raw;
  const int lane = threadIdx.x & 63, wv = threadIdx.x >> 6;
  const int wm = wv >> 1, wn = wv & 1;
  const int fr = lane & 15, fq = lane >> 4;
  const u16* H = (const u16*)(p.ws + OFF_H);
  const u16* WIN = (const u16*)(p.ws + OFF_WIN);
  const int mt = item & 63, nt = item >> 6;
  const int m0 = mt * 256, n0 = nt * 128;
  f32x4 bacc[4][4];
  u32x2 gpk[4][4];
  u16* MRG = (u16*)(p.ws + OFF_MRG);
#pragma unroll 1
  for (int br = (MODE == 0 ? 1 : 0); br < (MODE == 0 ? 4 : 1); ++br) {
    zero_acc<4>(bacc);
    gemm_mainloop_8n(H + (size_t)m0 * 1024, 1024, WIN + (size_t)(2432 + br * 1024 + n0) * 1024, 1024, 1024, bacc, smem);
#pragma unroll
    for (int i = 0; i < 4; ++i)
#pragma unroll
      for (int j = 0; j < 4; ++j)
        gpk[i][j] = u32x2{pack2(sigmoidf_(bacc[i][j][0]), sigmoidf_(bacc[i][j][1])), pack2(sigmoidf_(bacc[i][j][2]), sigmoidf_(bacc[i][j][3]))};
    const u16* Ab; const u16* Wb;
    if (br == 0) { Ab = (const u16*)(p.ws + OFF_OG); Wb = (const u16*)(p.ws + OFF_RO); }
    else if (br == 1) { Ab = (const u16*)(p.ws + OFF_UB); Wb = (const u16*)(p.ws + OFF_SO); }
    else if (br == 2) { Ab = (const u16*)(p.ws + OFF_CB); Wb = (const u16*)(p.ws + OFF_CO); }
    else { Ab = (const u16*)(p.ws + OFF_YD); Wb = (const u16*)(p.ws + OFF_GLU); }
    if (MODE == 0 && br == 3) {
      zero_acc<4>(bacc);
      gemm_mainloop_8n(Ab + (size_t)m0 * 256, 256, Wb + (size_t)(1024 + n0) * 256, 256, 256, bacc, smem);
#pragma unroll
      for (int i = 0; i < 4; ++i)
#pragma unroll
        for (int j = 0; j < 4; ++j) {
          const float g0 = bflo(gpk[i][j].x) * sigmoidf_(bacc[i][j][0]), g1 = bfhi(gpk[i][j].x) * sigmoidf_(bacc[i][j][1]);
          const float g2 = bflo(gpk[i][j].y) * sigmoidf_(bacc[i][j][2]), g3 = bfhi(gpk[i][j].y) * sigmoidf_(bacc[i][j][3]);
          gpk[i][j] = u32x2{pack2(g0, g1), pack2(g2, g3)};
        }
    }
    zero_acc<4>(bacc);
    gemm_mainloop_8n(Ab + (size_t)m0 * 256, 256, Wb + (size_t)n0 * 256, 256, 256, bacc, smem);
#pragma unroll
    for (int i = 0; i < 4; ++i)
#pragma unroll
      for (int j = 0; j < 4; ++j) {
        u32x2* mp = (u32x2*)(MRG + (size_t)(m0 + wm * 64 + i * 16 + fr) * 1024 + n0 + wn * 64 + j * 16 + fq * 4);
        u32x2 cm = u32x2{0u, 0u};
        if (MODE == 1 || br > 1) cm = *mp;
        const float v0 = bflo(cm.x) + bflo(gpk[i][j].x) * bacc[i][j][0];
        const float v1 = bfhi(cm.x) + bfhi(gpk[i][j].x) * bacc[i][j][1];
        const float v2 = bflo(cm.y) + bflo(gpk[i][j].y) * bacc[i][j][2];
        const float v3 = bfhi(cm.y) + bfhi(gpk[i][j].y) * bacc[i][j][3];
        *mp = u32x2{pack2(v0, v1), pack2(v2, v3)};
      }
  }
}

__device__ __forceinline__ float shifted(const u16* __restrict__ P, int tok, int col, float mu) {
  float pv = bf2f(P[(size_t)tok * 2176 + col]);
  float pr = (tok & (SEQ - 1)) ? bf2f(P[(size_t)(tok - 1) * 2176 + col]) : 0.f;
  return pv + (pr - pv) * mu;
}

__device__ __forceinline__ void rwkv_prep_item(const Params& p, int l, int item, unsigned char* smem) {
  const int tid = TIDX, lane = tid & 63, wv = tid >> 6;
  const int fr = lane & 15, fq = lane >> 4;
  u16* sl = (u16*)smem;
  u16* sv = sl + 32 * 168;
  constexpr int SLS = 168, SVS = 264;
  const u16* P = (const u16*)(p.ws + OFF_PABC);
  const float* mu = p.in[6] + l * 896;
  const int tok0 = item * 32;
  for (int idx = tid; idx < 32 * 128; idx += NTHR) {
    const int t = idx >> 7, ci = idx & 127;
    float v = shifted(P, tok0 + t, 768 + ci, mu[768 + ci]);
    if (ci < 32) v = tanhf_(v);
    else if (ci >= 64) v = sigmoidf_(v);
    sl[t * SLS + ci] = f2bf(v);
  }
  if (l > 0) {
    const int t = tid >> 3, c0 = (tid & 7) * 32;
    const int tok = tok0 + t;
    const bool hasp = (tok & (SEQ - 1)) != 0;
#pragma unroll
    for (int q = 0; q < 4; ++q) {
      const int c = c0 + q * 8;
      const u32x4 cur = *(const u32x4*)(P + (size_t)tok * 2176 + 512 + c);
      u32x4 prv = u32x4{0u, 0u, 0u, 0u};
      if (hasp) prv = *(const u32x4*)(P + (size_t)(tok - 1) * 2176 + 512 + c);
      const f32x4 m0 = *(const f32x4*)(mu + 512 + c), m1 = *(const f32x4*)(mu + 512 + c + 4);
      float o[8];
      o[0] = bflo(cur.x) + (bflo(prv.x) - bflo(cur.x)) * m0.x; o[1] = bfhi(cur.x) + (bfhi(prv.x) - bfhi(cur.x)) * m0.y;
      o[2] = bflo(cur.y) + (bflo(prv.y) - bflo(cur.y)) * m0.z; o[3] = bfhi(cur.y) + (bfhi(prv.y) - bfhi(cur.y)) * m0.w;
      o[4] = bflo(cur.z) + (bflo(prv.z) - bflo(cur.z)) * m1.x; o[5] = bfhi(cur.z) + (bfhi(prv.z) - bfhi(cur.z)) * m1.y;
      o[6] = bflo(cur.w) + (bflo(prv.w) - bflo(cur.w)) * m1.z; o[7] = bfhi(cur.w) + (bfhi(prv.w) - bfhi(cur.w)) * m1.w;
      *(u32x4*)(sv + t * SVS + c) = u32x4{pack2(o[0], o[1]), pack2(o[2], o[3]), pack2(o[4], o[5]), pack2(o[6], o[7])};
    }
  }
  __syncthreads();
  if (l > 0) {
    const int mf = wv >> 1, nf = wv & 1;
    const u16* v1t = (const u16*)(p.ws + OFF_LV1);
    f32x4 acc = f32x4{0.f, 0.f, 0.f, 0.f};
#pragma unroll
    for (int ks = 0; ks < 8; ++ks) {
      const bf16x8 fa = *(const bf16x8*)(sv + (mf * 16 + fr) * SVS + ks * 32 + fq * 8);
      const bf16x8 fb = *(const bf16x8*)(v1t + (size_t)(nf * 16 + fr) * 256 + ks * 32 + fq * 8);
      acc = __builtin_amdgcn_mfma_f32_16x16x32_bf16(fb, fa, acc, 0, 0, 0);
    }
    *(u32x2*)(sl + (mf * 16 + fr) * SLS + 128 + nf * 16 + fq * 4) = u32x2{pack2(acc[0], acc[1]), pack2(acc[2], acc[3])};
    __syncthreads();
  }
  const u16* w2t = (const u16*)(p.ws + OFF_LW2); const u16* a2t = (const u16*)(p.ws + OFF_LA2);
  const u16* g2t = (const u16*)(p.ws + OFF_LG2); const u16* v2t = (const u16*)(p.ws + OFF_LV2);
  u16* SR = (u16*)(p.ws + OFF_SR); u16* SK = (u16*)(p.ws + OFF_SK); u16* SV = (u16*)(p.ws + OFF_SV);
  u16* SKK = (u16*)(p.ws + OFF_SKK); u16* SA = (u16*)(p.ws + OFF_SA); float* SW = (float*)(p.ws + OFF_SW);
  u16* G = (u16*)(p.ws + OFF_G); u16* VF = (u16*)(p.ws + OFF_VF);
#pragma unroll 1
  for (int mf = 0; mf < 2; ++mf) {
    const u16* arow = sl + (mf * 16 + fr) * SLS + fq * 8;
    const bf16x8 aw = *(const bf16x8*)(arow), aa = *(const bf16x8*)(arow + 32);
    const bf16x8 ag0 = *(const bf16x8*)(arow + 64), ag1 = *(const bf16x8*)(arow + 96), av = *(const bf16x8*)(arow + 128);
    f32x4 cw[4], ca[4], cg[4], cv[4];
#pragma unroll
    for (int nf = 0; nf < 4; ++nf) {
      const int n = wv * 64 + nf * 16 + fr;
      const f32x4 z = f32x4{0.f, 0.f, 0.f, 0.f};
      cw[nf] = __builtin_amdgcn_mfma_f32_16x16x32_bf16(*(const bf16x8*)(w2t + n * 32 + fq * 8), aw, z, 0, 0, 0);
      ca[nf] = __builtin_amdgcn_mfma_f32_16x16x32_bf16(*(const bf16x8*)(a2t + n * 32 + fq * 8), aa, z, 0, 0, 0);
      cg[nf] = __builtin_amdgcn_mfma_f32_16x16x32_bf16(*(const bf16x8*)(g2t + n * 64 + fq * 8), ag0, z, 0, 0, 0);
      cg[nf] = __builtin_amdgcn_mfma_f32_16x16x32_bf16(*(const bf16x8*)(g2t + n * 64 + 32 + fq * 8), ag1, cg[nf], 0, 0, 0);
      cv[nf] = z;
      if (l > 0) cv[nf] = __builtin_amdgcn_mfma_f32_16x16x32_bf16(*(const bf16x8*)(v2t + n * 32 + fq * 8), av, z, 0, 0, 0);
    }
    const int tok = tok0 + mf * 16 + fr;
    const bool hasp = (tok & (SEQ - 1)) != 0;
    float kkv[4][4], kmv[4][4], av4[4][4];
    float ss = 0.f;
#pragma unroll
    for (int nf = 0; nf < 4; ++nf) {
      const int c = wv * 64 + nf * 16 + fq * 4;
      const size_t o = (size_t)tok * 256 + c;
      const u16* pc = P + (size_t)tok * 2176 + c;
      const u32x2 r_c = *(const u32x2*)(pc), k_c = *(const u32x2*)(pc + 256), v_c = *(const u32x2*)(pc + 512);
      u32x2 r_p = u32x2{0u, 0u}, k_p = u32x2{0u, 0u}, v_p = u32x2{0u, 0u};
      if (hasp) { r_p = *(const u32x2*)(pc - 2176); k_p = *(const u32x2*)(pc - 2176 + 256); v_p = *(const u32x2*)(pc - 2176 + 512); }
      const f32x4 mur = *(const f32x4*)(mu + c), muk = *(const f32x4*)(mu + 256 + c), muv = *(const f32x4*)(mu + 512 + c);
      const f32x4 w0 = *(const f32x4*)(p.in[7] + l * 256 + c), a0 = *(const f32x4*)(p.in[9] + l * 256 + c);
      const f32x4 kkc = *(const f32x4*)(p.in[15] + l * 256 + c), kac = *(const f32x4*)(p.in[16] + l * 256 + c);
      f32x4 v0 = f32x4{0.f, 0.f, 0.f, 0.f};
      if (l > 0) v0 = *(const f32x4*)(p.in[12] + c);
      u32x2 vfraw = u32x2{0u, 0u};
      if (l > 0) vfraw = *(const u32x2*)(VF + o);
      float rr[4], kk_[4], vv[4], dec[4], gg[4];
#pragma unroll
      for (int e = 0; e < 4; ++e) {
        const unsigned rc = e < 2 ? r_c.x : r_c.y, rp = e < 2 ? r_p.x : r_p.y;
        const unsigned kc = e < 2 ? k_c.x : k_c.y, kp = e < 2 ? k_p.x : k_p.y;
        const unsigned vc = e < 2 ? v_c.x : v_c.y, vp = e < 2 ? v_p.x : v_p.y;
        const unsigned vfr = e < 2 ? vfraw.x : vfraw.y;
        const float rcf = (e & 1) ? bfhi(rc) : bflo(rc), rpf = (e & 1) ? bfhi(rp) : bflo(rp);
        const float kcf = (e & 1) ? bfhi(kc) : bflo(kc), kpf = (e & 1) ? bfhi(kp) : bflo(kp);
        const float vcf = (e & 1) ? bfhi(vc) : bflo(vc), vpf = (e & 1) ? bfhi(vp) : bflo(vp);
        const float r = rcf + (rpf - rcf) * mur[e];
        const float k = kcf + (kpf - kcf) * muk[e];
        float v = vcf + (vpf - vcf) * muv[e];
        const float wl = w0[e] + cw[nf][e];
        const float z = -wl;
        const float sp = (z > 15.f) ? z : __logf(1.f + __expf(z));
        dec[e] = __expf(-__expf(-sp - 0.5f));
        const float a = sigmoidf_(a0[e] + ca[nf][e]);
        gg[e] = cg[nf][e];
        if (l > 0) { const float vf = (e & 1) ? bfhi(vfr) : bflo(vfr); v = v + (vf - v) * sigmoidf_(v0[e] + cv[nf][e]); }
        const float kk = k * kkc[e];
        ss += kk * kk;
        rr[e] = r; vv[e] = v; kk_[e] = kk; kkv[nf][e] = kk;
        kmv[nf][e] = k * (1.f + (a - 1.f) * kac[e]); av4[nf][e] = a;
      }
      *(u32x2*)(SR + o) = u32x2{pack2(rr[0], rr[1]), pack2(rr[2], rr[3])};
      *(u32x2*)(SV + o) = u32x2{pack2(vv[0], vv[1]), pack2(vv[2], vv[3])};
      if (l == 0) *(u32x2*)(VF + o) = u32x2{pack2(vv[0], vv[1]), pack2(vv[2], vv[3])};
      *(u32x2*)(G + o) = u32x2{pack2(gg[0], gg[1]), pack2(gg[2], gg[3])};
      *(f32x4*)(SW + o) = f32x4{dec[0], dec[1], dec[2], dec[3]};
    }
    ss += __shfl_xor(ss, 16, 64);
    ss += __shfl_xor(ss, 32, 64);
    const float inv = 1.f / fmaxf(sqrtf(ss), 1e-12f);
#pragma unroll
    for (int nf = 0; nf < 4; ++nf) {
      const size_t o = (size_t)tok * 256 + wv * 64 + nf * 16 + fq * 4;
      *(u32x2*)(SKK + o) = u32x2{pack2(kkv[nf][0] * inv, kkv[nf][1] * inv), pack2(kkv[nf][2] * inv, kkv[nf][3] * inv)};
      *(u32x2*)(SK + o) = u32x2{pack2(kmv[nf][0], kmv[nf][1]), pack2(kmv[nf][2], kmv[nf][3])};
      *(u32x2*)(SA + o) = u32x2{pack2(av4[nf][0], av4[nf][1]), pack2(av4[nf][2], av4[nf][3])};
    }
  }
  __syncthreads();
}

__device__ __forceinline__ void sg_item(const Params& p, int l, int item, unsigned char* smem) {
  const int tid = TIDX, lane = tid & 63, wv = tid >> 6;
  u16* vsT = (u16*)smem;
  float* smu = (float*)(smem + 16384);
  float* srs = smu + 128;
  const u16* P = (const u16*)(p.ws + OFF_PABC);
  const int g = item & 3, chn = item >> 2;
  const int tok0 = chn * 128;
  {
    const int t = tid >> 1, hf = tid & 1;
    const u16* src = P + (size_t)(tok0 + t) * 2176 + 896 + 256 + hf * 128;
    float sm = 0.f, ss = 0.f;
#pragma unroll 4
    for (int i = 0; i < 16; ++i) {
      u32x4 raw = *(const u32x4*)(src + i * 8);
      float z;
      z = geluf_(bflo(raw.x)); sm += z; ss += z * z;  z = geluf_(bfhi(raw.x)); sm += z; ss += z * z;
      z = geluf_(bflo(raw.y)); sm += z; ss += z * z;  z = geluf_(bfhi(raw.y)); sm += z; ss += z * z;
      z = geluf_(bflo(raw.z)); sm += z; ss += z * z;  z = geluf_(bfhi(raw.z)); sm += z; ss += z * z;
      z = geluf_(bflo(raw.w)); sm += z; ss += z * z;  z = geluf_(bfhi(raw.w)); sm += z; ss += z * z;
    }
    sm += __shfl_xor(sm, 1, 64); ss += __shfl_xor(ss, 1, 64);
    const float mean = sm * (1.f / 256.f);
    const float var = fmaxf(ss * (1.f / 256.f) - mean * mean, 0.f);
    if (hf == 0) { smu[t] = mean; srs[t] = rsqrtf(var + 1e-5f); }
  }
  __syncthreads();
  {
    const int c = tid & 63, tb = tid >> 6;
    const float lw = p.in[21][l * 256 + g * 64 + c], lb = p.in[22][l * 256 + g * 64 + c];
#pragma unroll
    for (int j = 0; j < 4; ++j) {
      u16 raw[8];
#pragma unroll
      for (int e = 0; e < 8; ++e) raw[e] = P[(size_t)(tok0 + tb * 32 + j * 8 + e) * 2176 + 896 + 256 + g * 64 + c];
      float vv[8];
#pragma unroll
      for (int e = 0; e < 8; ++e) {
        const int t = tb * 32 + j * 8 + e;
        vv[e] = (geluf_(bf2f(raw[e])) - smu[t]) * srs[t] * lw + lb;
      }
      const int phys = (tb * 4 + j) ^ (c & 15);
      *(u32x4*)(vsT + c * 128 + phys * 8) = u32x4{pack2(vv[0], vv[1]), pack2(vv[2], vv[3]), pack2(vv[4], vv[5]), pack2(vv[6], vv[7])};
    }
  }
  __syncthreads();
  {
    const int fr = lane & 15, fq = lane >> 4;
    const u16* Wm = (const u16*)(p.ws + OFF_SGW) + (size_t)g * 128 * 128;
    f32x4 acc[2][4];
#pragma unroll
    for (int i = 0; i < 2; ++i)
#pragma unroll
      for (int j = 0; j < 4; ++j) acc[i][j] = f32x4{0.f, 0.f, 0.f, 0.f};
    for (int ks = 0; ks <= wv; ++ks) {
      bf16x8 fa[2], fb[4];
#pragma unroll
      for (int i = 0; i < 2; ++i) fa[i] = *(const bf16x8*)(Wm + (size_t)(32 * wv + 16 * i + fr) * 128 + ks * 32 + fq * 8);
#pragma unroll
      for (int j = 0; j < 4; ++j) fb[j] = *(const bf16x8*)(vsT + (j * 16 + fr) * 128 + (((ks * 4 + fq) ^ fr) << 3));
#pragma unroll
      for (int i = 0; i < 2; ++i)
#pragma unroll
        for (int j = 0; j < 4; ++j) acc[i][j] = __builtin_amdgcn_mfma_f32_16x16x32_bf16(fb[j], fa[i], acc[i][j], 0, 0, 0);
    }
    const float* bs = p.in[24] + ((size_t)l * 4 + g) * 128;
    u16* UB = (u16*)(p.ws + OFF_UB);
#pragma unroll
    for (int i = 0; i < 2; ++i) {
      const int t = 32 * wv + 16 * i + fr;
      const float bsv = bs[t];
#pragma unroll
      for (int j = 0; j < 4; ++j) {
        const int cc = j * 16 + fq * 4;
        u32x2 ur = *(const u32x2*)(P + (size_t)(tok0 + t) * 2176 + 896 + g * 64 + cc);
        float o0 = geluf_(bflo(ur.x)) * (acc[i][j][0] + bsv), o1 = geluf_(bfhi(ur.x)) * (acc[i][j][1] + bsv);
        float o2 = geluf_(bflo(ur.y)) * (acc[i][j][2] + bsv), o3 = geluf_(bfhi(ur.y)) * (acc[i][j][3] + bsv);
        *(u32x2*)(UB + (size_t)(tok0 + t) * 256 + g * 64 + cc) = u32x2{pack2(o0, o1), pack2(o2, o3)};
      }
    }
  }
  __syncthreads();
}

__device__ __forceinline__ void conv_item(const Params& p, int l, int item) {
  const int j = TIDX;
  const u16* P = (const u16*)(p.ws + OFF_PABC);
  u16* CB = (u16*)(p.ws + OFF_CB);
  const float c0 = p.in[26][(l * 3 + 0) * 256 + j], c1 = p.in[26][(l * 3 + 1) * 256 + j], c2 = p.in[26][(l * 3 + 2) * 256 + j];
  const int tok0 = item * 8;
  u16 rc[10], rx[10], rb[8];
  const bool first = (tok0 & (SEQ - 1)) == 0;
#pragma unroll
  for (int t = 0; t < 10; ++t) {
    const int tok = (first && t < 2) ? tok0 : tok0 + t - 2;
    const u16* q = P + (size_t)tok * 2176 + 1408;
    rc[t] = q[256 + j]; rx[t] = q[512 + j];
    if (t >= 2) rb[t - 2] = q[j];
  }
  float z[10];
#pragma unroll
  for (int t = 0; t < 10; ++t) z[t] = bf2f(rc[t]) * bf2f(rx[t]);
  if (first) { z[0] = 0.f; z[1] = 0.f; }
#pragma unroll
  for (int t = 0; t < 8; ++t) {
    float y = c0 * z[t] + c1 * z[t + 1] + c2 * z[t + 2];
    CB[(size_t)(tok0 + t) * 256 + j] = f2bf(bf2f(rb[t]) * y);
  }
}

__device__ __forceinline__ void s5_load_u(const u16* us, int t, int wv, float (&u)[16]) {
  const u32x4* q = (const u32x4*)(us + t * 64 + wv * 16);
  u32x4 a = q[0], b = q[1];
  u[0] = bflo(a.x); u[1] = bfhi(a.x); u[2] = bflo(a.y); u[3] = bfhi(a.y);
  u[4] = bflo(a.z); u[5] = bfhi(a.z); u[6] = bflo(a.w); u[7] = bfhi(a.w);
  u[8] = bflo(b.x); u[9] = bfhi(b.x); u[10] = bflo(b.y); u[11] = bfhi(b.y);
  u[12] = bflo(b.z); u[13] = bfhi(b.z); u[14] = bflo(b.w); u[15] = bfhi(b.w);
}
__device__ __forceinline__ void s5_stage_u(const u16* __restrict__ PD, int tok0, int gq, u16* us) {
#pragma unroll
  for (int i = 0; i < 2; ++i) {
    const int ch = TIDX + 256 * i;
    const int t = ch >> 3, part = ch & 7;
    *(u32x4*)(us + t * 64 + part * 8) = *(const u32x4*)(PD + (size_t)(tok0 + t) * 256 + gq * 64 + part * 8);
  }
}

__device__ __forceinline__ void s5a_item(const Params& p, int l, int item, unsigned char* smem) {
  const int lane = TIDX & 63, wv = TIDX >> 6;
  const int gq = item & 3, bc = item >> 2;
  const int g = gq * 4 + wv;
  const int tok0 = bc * 64;
  const u16* PD = (const u16*)(p.ws + OFF_PD);
  const float* ab = (const float*)(p.ws + OFF_S5AB) + ((size_t)(l * 16 + g) * 64 + lane) * 2;
  const float* bb = (const float*)(p.ws + OFF_S5BB) + ((size_t)(l * 16 + g) * 64 + lane) * 32;
  float bbr[16], bbi[16];
#pragma unroll
  for (int c = 0; c < 16; ++c) { bbr[c] = bb[c]; bbi[c] = bb[16 + c]; }
  const float abr = ab[0], abi = ab[1];
  float xr = 0.f, xi = 0.f;
  u16* us = (u16*)smem;
  s5_stage_u(PD, tok0, gq, us);
  __syncthreads();
#pragma unroll 4
  for (int t = 0; t < 64; ++t) {
    float u[16];
    s5_load_u(us, t, wv, u);
    float bur = 0.f, bui = 0.f;
#pragma unroll
    for (int c = 0; c < 16; ++c) { bur += bbr[c] * u[c]; bui += bbi[c] * u[c]; }
    float nr = abr * xr - abi * xi + bur;
    float ni = abr * xi + abi * xr + bui;
    xr = nr; xi = ni;
  }
  float2* E = (float2*)(p.ws + OFF_S5E);
  E[((size_t)bc * 16 + g) * 64 + lane] = make_float2(xr, xi);
  __syncthreads();
}

__device__ __forceinline__ void s5b_item(const Params& p, int l, int item, unsigned char* smem) {
  const int lane = TIDX & 63, wv = TIDX >> 6;
  const int gq = item & 3, bc = item >> 2;
  const int b = bc >> 6, ch = bc & 63;
  const int g = gq * 4 + wv;
  const int tok0 = bc * 64;
  u16* us = (u16*)(smem + 65536);
  s5_stage_u((const u16*)(p.ws + OFF_PD), tok0, gq, us);
  float* base = (float*)smem + wv * 4096;
  float* csr = base, *csi = base + 1024, *xsr = base + 2048, *xsi = base + 3072;
  const u16* PD = (const u16*)(p.ws + OFF_PD);
  const float* ab = (const float*)(p.ws + OFF_S5AB) + ((size_t)(l * 16 + g) * 64 + lane) * 2;
  const float* bb = (const float*)(p.ws + OFF_S5BB) + ((size_t)(l * 16 + g) * 64 + lane) * 32;
  const float* cre = p.in[32] + ((size_t)(l * 16 + g) * 16) * 64;
  const float* cim = p.in[33] + ((size_t)(l * 16 + g) * 16) * 64;
  for (int c = 0; c < 16; ++c) {
    csr[(lane >> 2) * 64 + c * 4 + (lane & 3)] = cre[c * 64 + lane];
    csi[(lane >> 2) * 64 + c * 4 + (lane & 3)] = cim[c * 64 + lane];
  }
  float bbr[16], bbi[16];
#pragma unroll
  for (int c = 0; c < 16; ++c) { bbr[c] = bb[c]; bbi[c] = bb[16 + c]; }
  const float abr = ab[0], abi = ab[1];
  float pr = abr, pi = abi;
#pragma unroll
  for (int s = 0; s < 6; ++s) { float nr = pr * pr - pi * pi, ni = 2.f * pr * pi; pr = nr; pi = ni; }
  float xr = 0.f, xi = 0.f;
  const float2* E = (const float2*)(p.ws + OFF_S5E);
  {
    const f32x2* Ev = (const f32x2*)E + ((size_t)(b * 64) * 16 + g) * 64 + lane;
    int c = 0;
    for (; c + 8 <= ch; c += 8) {
      f32x2 e[8];
#pragma unroll
      for (int k = 0; k < 8; ++k) e[k] = Ev[(size_t)(c + k) * 1024];
#pragma unroll
      for (int k = 0; k < 8; ++k) {
        const float nr = pr * xr - pi * xi + e[k].x;
        const float ni = pr * xi + pi * xr + e[k].y;
        xr = nr; xi = ni;
      }
    }
    for (; c < ch; ++c) {
      const f32x2 e = Ev[(size_t)c * 1024];
      const float nr = pr * xr - pi * xi + e.x;
      const float ni = pr * xi + pi * xr + e.y;
      xr = nr; xi = ni;
    }
  }
  const int tt = lane & 15, cq = lane >> 4;
  const float* dvec = p.in[34] + l * 256 + g * 16 + cq * 4;
  const float d0 = dvec[0], d1 = dvec[1], d2 = dvec[2], d3 = dvec[3];
  u16* YD = (u16*)(p.ws + OFF_YD);
  const int n4w = lane >> 2, e4 = lane & 3;
  __syncthreads();
#pragma unroll 1
  for (int sc = 0; sc < 4; ++sc) {
    for (int t = 0; t < 16; ++t) {
      float u[16];
      s5_load_u(us, sc * 16 + t, wv, u);
      float bur = 0.f, bui = 0.f;
#pragma unroll
      for (int c = 0; c < 16; ++c) { bur += bbr[c] * u[c]; bui += bbi[c] * u[c]; }
      float nr = abr * xr - abi * xi + bur;
      float ni = abr * xi + abi * xr + bui;
      xr = nr; xi = ni;
      int a = n4w * 64 + ((t ^ (n4w & 7)) << 2) + e4;
      xsr[a] = xr; xsi[a] = xi;
    }
    __syncthreads();
    float acc0 = 0.f, acc1 = 0.f, acc2 = 0.f, acc3 = 0.f;
#pragma unroll 2
    for (int n4 = 0; n4 < 16; ++n4) {
      int xa = n4 * 64 + ((tt ^ (n4 & 7)) << 2);
      float4 xr4 = *(const float4*)(xsr + xa);
      float4 xi4 = *(const float4*)(xsi + xa);
      const float* cr = csr + n4 * 64 + cq * 16;
      const float* ci = csi + n4 * 64 + cq * 16;
      float4 r0 = *(const float4*)(cr), r1 = *(const float4*)(cr + 4), r2 = *(const float4*)(cr + 8), r3 = *(const float4*)(cr + 12);
      float4 i0 = *(const float4*)(ci), i1 = *(const float4*)(ci + 4), i2 = *(const float4*)(ci + 8), i3 = *(const float4*)(ci + 12);
      acc0 += r0.x * xr4.x + r0.y * xr4.y + r0.z * xr4.z + r0.w * xr4.w - (i0.x * xi4.x + i0.y * xi4.y + i0.z * xi4.z + i0.w * xi4.w);
      acc1 += r1.x * xr4.x + r1.y * xr4.y + r1.z * xr4.z + r1.w * xr4.w - (i1.x * xi4.x + i1.y * xi4.y + i1.z * xi4.z + i1.w * xi4.w);
      acc2 += r2.x * xr4.x + r2.y * xr4.y + r2.z * xr4.z + r2.w * xr4.w - (i2.x * xi4.x + i2.y * xi4.y + i2.z * xi4.z + i2.w * xi4.w);
      acc3 += r3.x * xr4.x + r3.y * xr4.y + r3.z * xr4.z + r3.w * xr4.w - (i3.x * xi4.x + i3.y * xi4.y + i3.z * xi4.z + i3.w * xi4.w);
    }
    {
      const int tok = tok0 + sc * 16 + tt;
      u32x2 ur = *(const u32x2*)(us + (sc * 16 + tt) * 64 + wv * 16 + cq * 4);
      float y0 = acc0 + d0 * bflo(ur.x), y1 = acc1 + d1 * bfhi(ur.x), y2 = acc2 + d2 * bflo(ur.y), y3 = acc3 + d3 * bfhi(ur.y);
      u32x2 o; o.x = pack2(geluf_(y0), geluf_(y1)); o.y = pack2(geluf_(y2), geluf_(y3));
      *(u32x2*)(YD + (size_t)tok * 256 + g * 16 + cq * 4) = o;
    }
    __syncthreads();
  }
}

__device__ __forceinline__ void lds_barrier() {
  asm volatile("s_waitcnt lgkmcnt(0)" ::: "memory");
  __builtin_amdgcn_s_barrier();
  asm volatile("" ::: "memory");
}
__device__ __forceinline__ void scan_item(const Params& p, int item, unsigned char* smem) {
  const int tid = TIDX, lane = tid & 63, wv = tid >> 6;
  const int b = item >> 4, h = (item >> 2) & 3, q = item & 3;
  const int rl = lane >> 4, cl = lane & 15;
  const int rloc = wv * 4 + rl;
  const size_t tokb = (size_t)b * SEQ;
  const int chan0 = h * 64;
  const u16* SR = (const u16*)(p.ws + OFF_SR); const u16* SK = (const u16*)(p.ws + OFF_SK);
  const u16* SV = (const u16*)(p.ws + OFF_SV); const u16* SKK = (const u16*)(p.ws + OFF_SKK);
  const u16* SA = (const u16*)(p.ws + OFF_SA); const float* SW = (const float*)(p.ws + OFF_SW);
  float* O = (float*)(p.ws + OFF_O);
  constexpr int BUFF = 6432;
  float* lbase = (float*)smem;
  float* pp = lbase + 2 * BUFF + wv * 1024;
  const int st = tid >> 4, cg4 = tid & 15;
  struct Stg { u32x2 r, k, kk, a, kk1; f32x4 w; u16 v; };
  auto gload = [&](Stg& g, int c) {
    const size_t o = (tokb + (size_t)c * 16 + st) * 256 + chan0;
    g.r = *(const u32x2*)(SR + o + cg4 * 4); g.k = *(const u32x2*)(SK + o + cg4 * 4);
    g.kk = *(const u32x2*)(SKK + o + cg4 * 4); g.a = *(const u32x2*)(SA + o + cg4 * 4);
    g.w = *(const f32x4*)(SW + o + cg4 * 4);
    g.v = SV[o + q * 16 + cg4];
    int t1 = c * 16 + st + 1; if (t1 >= SEQ) t1 = SEQ - 1;
    g.kk1 = *(const u32x2*)(SKK + (tokb + (size_t)t1) * 256 + chan0 + cg4 * 4);
  };
  auto lwrite = [&](const Stg& g, int buf) {
    float* bp = lbase + buf * BUFF;
    const int o = st * 64 + cg4 * 4;
    f32x4 kk = {bflo(g.kk.x), bfhi(g.kk.x), bflo(g.kk.y), bfhi(g.kk.y)};
    f32x4 a = {bflo(g.a.x), bfhi(g.a.x), bflo(g.a.y), bfhi(g.a.y)};
    f32x4 k = {bflo(g.k.x), bfhi(g.k.x), bflo(g.k.y), bfhi(g.k.y)};
    f32x4 r = {bflo(g.r.x), bfhi(g.r.x), bflo(g.r.y), bfhi(g.r.y)};
    *(f32x4*)(bp + o) = kk;
    *(f32x4*)(bp + 1024 + o) = kk * a;
    *(f32x4*)(bp + 2048 + o) = k;
    *(f32x4*)(bp + 3072 + o) = g.w;
    *(f32x4*)(bp + 4096 + o) = r;
    bp[5120 + st * 16 + cg4] = bf2f(g.v);
    const f32x4 kn = {bflo(g.kk1.x), bfhi(g.kk1.x), bflo(g.kk1.y), bfhi(g.kk1.y)};
    *(f32x4*)(bp + 5376 + o) = g.w * kn;
    const f32x4 bb = kk * a;
    const float c1 = row_sum16(k.x * kn.x + k.y * kn.y + k.z * kn.z + k.w * kn.w);
    const float c2 = row_sum16(bb.x * kn.x + bb.y * kn.y + bb.z * kn.z + bb.w * kn.w);
    if (cg4 == 0) *(f32x2*)(bp + 6400 + st * 2) = f32x2{c1, c2};
  };
  constexpr int NCH = SEQ / 16;
  Stg R0, R1, R2, R3;
  gload(R0, 0); gload(R1, 1); gload(R2, 2); gload(R3, 3);
  __syncthreads();
  lwrite(R0, 0);
  __syncthreads();
  __builtin_amdgcn_s_setprio(3);
  float S0 = 0.f, S1 = 0.f, S2 = 0.f, S3 = 0.f;
  const int rrow = lane & 3, rstep = lane >> 2;
  struct Pair { f32x4 kkA, bbA, kA, wA, rA, mA, bbB, kB, wB, rB; f32x2 cA; float vA, vB; };
  auto chunk = [&](int c) {
    const float* bp = lbase + (c & 1) * BUFF;
    auto ldpair = [&](Pair& o, int s) {
      o.kkA = *(const f32x4*)(bp + s * 64 + cl * 4);
      o.mA = *(const f32x4*)(bp + 5376 + s * 64 + cl * 4);
      o.bbA = *(const f32x4*)(bp + 1024 + s * 64 + cl * 4);
      o.kA = *(const f32x4*)(bp + 2048 + s * 64 + cl * 4);
      o.wA = *(const f32x4*)(bp + 3072 + s * 64 + cl * 4);
      o.rA = *(const f32x4*)(bp + 4096 + s * 64 + cl * 4);
      o.vA = bp[5120 + s * 16 + rloc];
      o.cA = *(const f32x2*)(bp + 6400 + s * 2);
      o.bbB = *(const f32x4*)(bp + 1024 + (s + 1) * 64 + cl * 4);
      o.kB = *(const f32x4*)(bp + 2048 + (s + 1) * 64 + cl * 4);
      o.wB = *(const f32x4*)(bp + 3072 + (s + 1) * 64 + cl * 4);
      o.rB = *(const f32x4*)(bp + 4096 + (s + 1) * 64 + cl * 4);
      o.vB = bp[5120 + (s + 1) * 16 + rloc];
    };
    auto pairstep = [&](const Pair& o, int s) {
      const float pa = __builtin_fmaf(S3, o.kkA.w, __builtin_fmaf(S2, o.kkA.z, __builtin_fmaf(S1, o.kkA.y, S0 * o.kkA.x)));
      const float pd = __builtin_fmaf(S3, o.mA.w, __builtin_fmaf(S2, o.mA.z, __builtin_fmaf(S1, o.mA.y, S0 * o.mA.x)));
      const float saA = row_sum16(pa);
      const float dd = row_sum16(pd);
      const float saB = __builtin_fmaf(-saA, o.cA.y, __builtin_fmaf(o.vA, o.cA.x, dd));
      S0 = __builtin_fmaf(S0, o.wA.x, __builtin_fmaf(o.vA, o.kA.x, -(saA * o.bbA.x)));
      S1 = __builtin_fmaf(S1, o.wA.y, __builtin_fmaf(o.vA, o.kA.y, -(saA * o.bbA.y)));
      S2 = __builtin_fmaf(S2, o.wA.z, __builtin_fmaf(o.vA, o.kA.z, -(saA * o.bbA.z)));
      S3 = __builtin_fmaf(S3, o.wA.w, __builtin_fmaf(o.vA, o.kA.w, -(saA * o.bbA.w)));
      pp[(s * 4 + rl) * 16 + cl] = __builtin_fmaf(S3, o.rA.w, __builtin_fmaf(S2, o.rA.z, __builtin_fmaf(S1, o.rA.y, S0 * o.rA.x)));
      S0 = __builtin_fmaf(S0, o.wB.x, __builtin_fmaf(o.vB, o.kB.x, -(saB * o.bbB.x)));
      S1 = __builtin_fmaf(S1, o.wB.y, __builtin_fmaf(o.vB, o.kB.y, -(saB * o.bbB.y)));
      S2 = __builtin_fmaf(S2, o.wB.z, __builtin_fmaf(o.vB, o.kB.z, -(saB * o.bbB.z)));
      S3 = __builtin_fmaf(S3, o.wB.w, __builtin_fmaf(o.vB, o.kB.w, -(saB * o.bbB.w)));
      pp[((s + 1) * 4 + rl) * 16 + cl] = __builtin_fmaf(S3, o.rB.w, __builtin_fmaf(S2, o.rB.z, __builtin_fmaf(S1, o.rB.y, S0 * o.rB.x)));
    };
    Pair p0, p1;
    ldpair(p0, 0);
#pragma unroll
    for (int j = 0; j < 4; ++j) {
      ldpair(p1, 4 * j + 2);
      __builtin_amdgcn_sched_barrier(0);
      pairstep(p0, 4 * j);
      __builtin_amdgcn_sched_barrier(0);
      if (j < 3) ldpair(p0, 4 * j + 4);
      __builtin_amdgcn_sched_barrier(0);
      pairstep(p1, 4 * j + 2);
      __builtin_amdgcn_sched_barrier(0);
    }
    asm volatile("" ::: "memory");
    {
      const float* q0 = pp + (rstep * 4 + rrow) * 16;
      f32x4 a0 = *(const f32x4*)(q0), a1 = *(const f32x4*)(q0 + 4), a2 = *(const f32x4*)(q0 + 8), a3 = *(const f32x4*)(q0 + 12);
      f32x4 sm4 = (a0 + a1) + (a2 + a3);
      O[(tokb + (size_t)c * 16 + rstep) * 256 + chan0 + q * 16 + wv * 4 + rrow] = (sm4.x + sm4.y) + (sm4.z + sm4.w);
    }
    asm volatile("" ::: "memory");
  };
#pragma unroll 1
  for (int g = 0; g < NCH / 4; ++g) {
    const int c0 = g * 4;
    if (c0 + 4 < NCH) gload(R0, c0 + 4);
    chunk(c0);
    lwrite(R1, (c0 + 1) & 1);
    lds_barrier();
    if (c0 + 5 < NCH) gload(R1, c0 + 5);
    chunk(c0 + 1);
    lwrite(R2, (c0 + 2) & 1);
    lds_barrier();
    if (c0 + 6 < NCH) gload(R2, c0 + 6);
    chunk(c0 + 2);
    lwrite(R3, (c0 + 3) & 1);
    lds_barrier();
    if (c0 + 7 < NCH) gload(R3, c0 + 7);
    chunk(c0 + 3);
    if (c0 + 4 < NCH) lwrite(R0, (c0 + 4) & 1);
    lds_barrier();
  }
  __builtin_amdgcn_s_setprio(0);
}

__device__ __forceinline__ void rwkv_post_item(const Params& p, int l, int item) {
  const int j = TIDX;
  const float* O = (const float*)(p.ws + OFF_O);
  const u16* SR = (const u16*)(p.ws + OFF_SR); const u16* SK = (const u16*)(p.ws + OFF_SK);
  const u16* SV = (const u16*)(p.ws + OFF_SV); const u16* G = (const u16*)(p.ws + OFF_G);
  u16* OG = (u16*)(p.ws + OFF_OG);
  const float lw = p.in[18][l * 256 + j], lb = p.in[19][l * 256 + j], rk = p.in[17][l * 256 + j];
  const int tok0 = item * 8;
  float ov[8]; u16 rr[8], rkk[8], rv[8], rg[8];
#pragma unroll
  for (int t = 0; t < 8; ++t) {
    const size_t o = (size_t)(tok0 + t) * 256 + j;
    ov[t] = O[o]; rr[t] = SR[o]; rkk[t] = SK[o]; rv[t] = SV[o]; rg[t] = G[o];
  }
#pragma unroll
  for (int t = 0; t < 8; ++t) {
    const size_t o = (size_t)(tok0 + t) * 256 + j;
    float mean = wave_sum(ov[t]) * (1.f / 64.f);
    float d = ov[t] - mean;
    float var = wave_sum(d * d) * (1.f / 64.f);
    float on = d * rsqrtf(var + 64e-5f) * lw + lb;
    float bonus = wave_sum(bf2f(rr[t]) * bf2f(rkk[t]) * rk);
    OG[o] = f2bf((on + bonus * bf2f(rv[t])) * bf2f(rg[t]));
  }
}

#define XB_TMO      128
#define XB_XCNT(j)  (256  + 64 * (j))
#define XB_XSUB(j)  (1280 + 64 * (j))
#define XB_XGEN(j)  (2304 + 64 * (j))
#define XB_TOP      3328
#define XB_TOPGEN   3392
#define XCD_BAR_WORDS 3456
#define XB_SPIN_CAP (1u << 22)
#define LAS __attribute__((address_space(3)))
__device__ __forceinline__ unsigned xb_ld(unsigned* p) { return __hip_atomic_load(p, __ATOMIC_RELAXED, __HIP_MEMORY_SCOPE_AGENT); }
__device__ __forceinline__ unsigned xb_add(unsigned* p, unsigned v) { return __hip_atomic_fetch_add(p, v, __ATOMIC_RELAXED, __HIP_MEMORY_SCOPE_AGENT); }
__device__ __forceinline__ unsigned xb_xcc_id() { return (unsigned)__builtin_amdgcn_s_getreg((3 << 11) | 20) & 0xFu; }
#define XB_SPIN(cond, bar) do { unsigned _sp = 0; while (cond) { __builtin_amdgcn_s_sleep(1); \
    if ((++_sp & 255u) == 0u) { if (xb_ld(&(bar)[XB_TMO])) break; if (_sp > XB_SPIN_CAP) { atomicAdd(&(bar)[XB_TMO], 1u); break; } } } } while (0)
struct XcdBarrier { unsigned* bar; unsigned x; volatile LAS unsigned* st; };
__device__ __forceinline__ XcdBarrier xcd_barrier_post(unsigned* bar, volatile LAS unsigned* st) {
  XcdBarrier b; b.bar = bar; b.x = xb_xcc_id(); b.st = st;
  if (threadIdx.x == 0) st[2] = xb_add(&bar[XB_XCNT(b.x)], 1u);
  return b;
}
__device__ __forceinline__ void xcd_barrier_complete(unsigned* bar, unsigned x, unsigned& nloc, unsigned& nx) {
  const unsigned G = gridDim.x * gridDim.y * gridDim.z;
  unsigned sum, cnt, mine, sp = 0u;
  for (;;) {
    sum = 0u; cnt = 0u; mine = 0u;
#pragma unroll
    for (unsigned j = 0; j < 16; ++j) { const unsigned c = xb_ld(&bar[XB_XCNT(j)]); sum += c; cnt += (c > 0u) ? 1u : 0u; mine = (j == x) ? c : mine; }
    if (sum == G) break;
    __builtin_amdgcn_s_sleep(1);
    if ((++sp & 255u) == 0u) { if (xb_ld(&bar[XB_TMO])) break; if (sp > XB_SPIN_CAP) { atomicAdd(&bar[XB_TMO], 1u); break; } }
  }
  nloc = mine > 0u ? mine : 1u; nx = cnt > 0u ? cnt : 1u;
}
__device__ __forceinline__ void xcd_barrier(const XcdBarrier& b) {
  asm volatile("s_waitcnt vmcnt(0)" ::: "memory");
  __syncthreads();
  if (threadIdx.x == 0) {
    unsigned* bar = b.bar;
    __builtin_amdgcn_s_waitcnt(0);
    unsigned nloc = b.st[0], nx = b.st[1];
    if (nloc == 0u) { xcd_barrier_complete(bar, b.x, nloc, nx); b.st[0] = nloc; b.st[1] = nx; }
    const unsigned old = xb_add(&bar[XB_XSUB(b.x)], 1u);
    const unsigned gen = old / nloc;
    if (old + 1u == (gen + 1u) * nloc) {
      __builtin_amdgcn_fence(__ATOMIC_RELEASE, "agent");
      asm volatile("s_waitcnt vmcnt(0)" ::: "memory");
      const unsigned og = xb_add(&bar[XB_TOP], 1u);
      const unsigned tg = og / nx;
      if (og + 1u == (tg + 1u) * nx) xb_add(&bar[XB_TOPGEN], 1u);
      else XB_SPIN(xb_ld(&bar[XB_TOPGEN]) == tg, bar);
      __builtin_amdgcn_fence(__ATOMIC_ACQUIRE, "agent");
      xb_add(&bar[XB_XGEN(b.x)], 1u);
      asm volatile("s_waitcnt vmcnt(0)" ::: "memory");
    } else {
      XB_SPIN(xb_ld(&bar[XB_XGEN(b.x)]) == gen, bar);
      __builtin_amdgcn_fence(__ATOMIC_ACQUIRE, "agent");
      asm volatile("s_waitcnt vmcnt(0)" ::: "memory");
    }
  }
  __syncthreads();
}

__device__ __forceinline__ int xcd_virtual_id(const XcdBarrier& b) {
  if (threadIdx.x == 0) {
    unsigned base = 0u;
#pragma unroll
    for (unsigned j = 0; j < 16; ++j) { const unsigned c = xb_ld(&b.bar[XB_XCNT(j)]); base += (j < b.x) ? c : 0u; }
    b.st[3] = base + b.st[2];
  }
  __syncthreads();
  const int vb = __builtin_amdgcn_readfirstlane((int)b.st[3]);
  __syncthreads();
  return vb;
}

__device__ __forceinline__ void sub_barrier(unsigned* cnt, unsigned target) {
  asm volatile("s_waitcnt vmcnt(0)" ::: "memory");
  __syncthreads();
  if (threadIdx.x == 0) {
    __builtin_amdgcn_fence(__ATOMIC_RELEASE, "agent");
    asm volatile("s_waitcnt vmcnt(0)" ::: "memory");
    xb_add(cnt, 1u);
    unsigned sp = 0;
    while (xb_ld(cnt) < target) { __builtin_amdgcn_s_sleep(2); if (++sp > (1u << 24)) break; }
    __builtin_amdgcn_fence(__ATOMIC_ACQUIRE, "agent");
    asm volatile("s_waitcnt vmcnt(0)" ::: "memory");
  }
  __syncthreads();
}

#define N_PHASES 22
#ifndef PROBE_CONV_REPS
#define PROBE_CONV_REPS 1
#endif
#ifndef PROBE_PREP_REPS
#define PROBE_PREP_REPS 1
#endif
#ifndef PROBE_POST_REPS
#define PROBE_POST_REPS 1
#endif
#ifndef PROBE_SCAN_REPS
#define PROBE_SCAN_REPS 1
#endif
#ifndef PROBE_FFN1_REPS
#define PROBE_FFN1_REPS 1
#endif
#ifndef PH_MASK
#define PH_MASK 0xFFFFF
#endif
#define PHON(s) (PH_MASK & (1 << (s)))
#define PHASE_BEGIN(k) if (ph_hi > (k)) { if ((k) > 1) xcd_barrier(xb);
#define PHASE_END }

template <int L>
__device__ __forceinline__ void run_layer(const Params& p, int vbr, int ph_hi, unsigned char* smem_all, const XcdBarrier& xb) {
  unsigned char* smem = smem_all + SUBB * 73728;
  const int vb = vbr * 2 + SUBB;
  constexpr int l = L;
  constexpr int base = 1 + 10 * L;
  const float* modl = (const float*)(p.ws + OFF_MOD) + (size_t)l * 4 * 6144;
  PHASE_BEGIN(base + 0)
    for (int rep = 0; rep < PROBE_CONV_REPS; ++rep) {
      if (rep) xcd_barrier(xb);
      phase_convert(p, l, smem);
      phase_norm(l == 0 ? p.in[0] : p.out, p.in[4] + l * 1024, modl, 0, 1024, (u16*)(p.ws + OFF_H));
    }
  PHASE_END
  PHASE_BEGIN(base + 1)
    phase_gemm<0>(p, l, vb, smem);
  PHASE_END
  PHASE_BEGIN(base + 2)
    for (int rep = 0; rep < PROBE_PREP_REPS; ++rep) {
      if (rep) xcd_barrier(xb);
      for (int item = VBLK; item < 512; item += VGRID) rwkv_prep_item(p, l, item, smem);
    }
  PHASE_END
  PHASE_BEGIN(base + 3)
    if ((int)blockIdx.x < 64) {
      if (SUBB == 0) scan_item(p, blockIdx.x, smem);
      else { __syncthreads(); __syncthreads(); for (int c = 0; c < SEQ / 16; ++c) lds_barrier(); }
    }
    else {
      const int nb = VGRID - 128, bi = VBLK - 128;
      for (int item = bi; item < 512; item += nb) sg_item(p, l, item, smem);
      for (int item = (bi + 64) % nb; item < 1024; item += nb) s5a_item(p, l, item, smem);
      for (int item = bi; item < 2048; item += nb) conv_item(p, l, item);
      sub_barrier((unsigned*)(p.ws + OFF_BAR) + 3520 + 64 * (2 * l), gridDim.x - 64);
      for (int item = bi; item < 1024; item += nb) s5b_item(p, l, item, smem);
      sub_barrier((unsigned*)(p.ws + OFF_BAR) + 3520 + 64 * (2 * l + 1), gridDim.x - 64);
      for (int item = (int)blockIdx.x - 64; item < 512; item += (int)gridDim.x - 64) merge_tile8<0>(p, item, smem_all);
    }
  PHASE_END
  PHASE_BEGIN(base + 4)
    for (int rep = 0; rep < PROBE_POST_REPS; ++rep) { if (rep) xcd_barrier(xb); for (int item = VBLK; item < 2048; item += VGRID) rwkv_post_item(p, l, item); }
  PHASE_END
  PHASE_BEGIN(base + 5)
    for (int item = vbr; item < 512; item += (int)gridDim.x) {
      int it2 = item;
      if (gridDim.x == 256) { const int r = item >> 8, w = vbr & 31; it2 = ((r * 4 + (w >> 3)) << 6) | ((vbr >> 5) * 8 + (w & 7)); }
      merge_tile8<1>(p, it2, smem_all);
    }
  PHASE_END
  PHASE_BEGIN(base + 6)
    phase_gemm_8w<1>(p, l, vbr, smem_all);
  PHASE_END
  PHASE_BEGIN(base + 7)
    if (PHON(7)) phase_norm(p.out, p.in[38] + l * 1024, modl, 3072, 4096, (u16*)(p.ws + OFF_H));
  PHASE_END
  PHASE_BEGIN(base + 8)
    phase_gemm_8w<2>(p, l, vbr, smem_all);
  PHASE_END
#ifdef PROBE_DUP_FFN1
  PHASE_BEGIN(base + 8)
    phase_gemm_8w<2>(p, l, vbr, smem_all);
  PHASE_END
#endif
  PHASE_BEGIN(base + 9)
    phase_gemm_8w<3>(p, l, vbr, smem_all);
  PHASE_END
}

__global__ void __launch_bounds__(512, 2) mega_fwd(Params p, int ph_lo, int ph_hi) {
  __shared__ __attribute__((aligned(16))) unsigned char smem[2 * 73728 + 16];
  cg::grid_group grid = cg::this_grid();
  if (ph_hi < 0) grid.sync();
  volatile LAS unsigned* st = (volatile LAS unsigned*)(smem + 2 * 73728);
  if (threadIdx.x == 0) { st[0] = 0u; st[1] = 0u; st[2] = 0u; st[3] = 0u; }
  __syncthreads();
  const XcdBarrier xb = xcd_barrier_post((unsigned*)(p.ws + OFF_BAR), st);
  if (ph_hi > 0) phase_mod(p, smem + SUBB * 73728);
  xcd_barrier(xb);
  const int vb = xcd_virtual_id(xb);
  run_layer<0>(p, vb, ph_hi, smem, xb);
  run_layer<1>(p, vb, ph_hi, smem, xb);
  PHASE_BEGIN(21)
    if (PHON(11)) phase_final(p.out, p.in[41]);
  PHASE_END
}

extern "C" void kernel_launch(void* const* d_in, const int* in_sizes, int n_in, void* d_out, int out_size, void* d_ws,
                              size_t ws_size, hipStream_t stream) {
  static int grid_blocks = 0;
  if (!grid_blocks) {
    int dev = 0, cus = 0, per_cu = 0;
    hipGetDevice(&dev);
    hipDeviceGetAttribute(&cus, hipDeviceAttributeMultiprocessorCount, dev);
    hipOccupancyMaxActiveBlocksPerMultiprocessor(&per_cu, mega_fwd, 512, 0);
    if (per_cu > 1) per_cu = 1;
    if (per_cu < 1) per_cu = 1;
    grid_blocks = cus * per_cu;
    if (ws_size < WS_END) fprintf(stderr, "workspace too small: %zu < %zu\n", ws_size, (size_t)WS_END);
  }
  Params p{};
  for (int i = 0; i < 42; ++i) p.in[i] = (const float*)d_in[i];
  p.out = (float*)d_out;
  p.ws = (unsigned char*)d_ws;
  hipMemsetAsync((unsigned char*)d_ws + OFF_BAR, 0, 16384, stream);
  int lo = 0, hi = N_PHASES;
  void* args[] = {&p, &lo, &hi};
  hipError_t e = hipLaunchCooperativeKernel((void*)mega_fwd, dim3(grid_blocks), dim3(512), args, 0, stream);
  if (e != hipSuccess) fprintf(stderr, "cooperative launch failed: %s (grid %d)\n", hipGetErrorString(e), grid_blocks);
}
```

```cpp
#include <hip/hip_runtime.h>
#include <hip/hip_cooperative_groups.h>
#include <cstdio>
namespace cg = cooperative_groups;

typedef unsigned short u16;
using bf16x8 = __attribute__((ext_vector_type(8))) short;
using f32x4 = __attribute__((ext_vector_type(4))) float;
using u32x4 = __attribute__((ext_vector_type(4))) unsigned int;
using u32x2 = __attribute__((ext_vector_type(2))) unsigned int;
using f32x2 = __attribute__((ext_vector_type(2))) float;

#define T_TOK 16384
#define SEQ 4096
#define DM 1024
#define NTHR 256
#define TIDX ((int)(threadIdx.x & 255))
#define SUBB ((int)(threadIdx.x >> 8))
#define VBLK ((int)(blockIdx.x * 2 + (threadIdx.x >> 8)))
#define VGRID ((int)(gridDim.x * 2))

static constexpr size_t SZ_WIN = (size_t)6528 * 1024 * 2;
static constexpr size_t OFF_WIN = 0;
static constexpr size_t OFF_RO = OFF_WIN + SZ_WIN;
static constexpr size_t OFF_SO = OFF_RO + 1024 * 256 * 2;
static constexpr size_t OFF_CO = OFF_SO + 1024 * 256 * 2;
static constexpr size_t OFF_GLU = OFF_CO + 1024 * 256 * 2;
static constexpr size_t OFF_WO = OFF_GLU + 2048 * 256 * 2;
static constexpr size_t OFF_W1 = OFF_WO + 1024 * 1024 * 2;
static constexpr size_t OFF_W2 = OFF_W1 + (size_t)4096 * 1024 * 2;
static constexpr size_t OFF_H = OFF_W2 + (size_t)4096 * 1024 * 2;
static constexpr size_t SZ_T256B = (size_t)T_TOK * 256 * 2;
static constexpr size_t OFF_VF = OFF_H + (size_t)T_TOK * 1024 * 2;
static constexpr size_t OFF_PD = OFF_VF + SZ_T256B;
static constexpr size_t OFF_G = OFF_PD + SZ_T256B;
static constexpr size_t OFF_UB = OFF_G + SZ_T256B;
static constexpr size_t OFF_CB = OFF_UB + SZ_T256B;
static constexpr size_t OFF_SR = OFF_CB + SZ_T256B;
static constexpr size_t OFF_SK = OFF_SR + SZ_T256B;
static constexpr size_t OFF_SV = OFF_SK + SZ_T256B;
static constexpr size_t OFF_SKK = OFF_SV + SZ_T256B;
static constexpr size_t OFF_SA = OFF_SKK + SZ_T256B;
static constexpr size_t OFF_SW = OFF_SA + SZ_T256B;
static constexpr size_t OFF_PABC = OFF_SW + 2 * SZ_T256B;
static constexpr size_t OFF_YD = OFF_PABC;
static constexpr size_t OFF_OG = OFF_YD + SZ_T256B;
static constexpr size_t OFF_MRG = OFF_OG + SZ_T256B;
static constexpr size_t OFF_F = OFF_UB;
static constexpr size_t OFF_SMALL = OFF_PABC + (size_t)T_TOK * 2176 * 2;
static constexpr size_t OFF_MOD = OFF_SMALL;
static constexpr size_t OFF_S5AB = OFF_MOD + 2 * 4 * 6144 * 4;
static constexpr size_t OFF_S5BB = OFF_S5AB + 2 * 16 * 64 * 2 * 4;
static constexpr size_t OFF_S5E = OFF_S5BB + 2 * 16 * 64 * 32 * 4;
static constexpr size_t OFF_BAR = OFF_S5E + (size_t)4 * 64 * 16 * 64 * 2 * 4;
static constexpr size_t OFF_SGW = OFF_BAR + 16384;
static constexpr size_t OFF_O = OFF_SGW + 4 * 128 * 128 * 2;
static constexpr size_t OFF_LW2 = OFF_O + 2 * SZ_T256B;
static constexpr size_t OFF_LA2 = OFF_LW2 + 256 * 32 * 2;
static constexpr size_t OFF_LG2 = OFF_LA2 + 256 * 32 * 2;
static constexpr size_t OFF_LV2 = OFF_LG2 + 256 * 64 * 2;
static constexpr size_t OFF_LV1 = OFF_LV2 + 256 * 32 * 2;
static constexpr size_t WS_END = OFF_LV1 + 32 * 256 * 2;
static_assert(OFF_F + (size_t)T_TOK * 4096 * 2 <= OFF_SMALL, "F overlaps small region");
static_assert(OFF_MRG + (size_t)T_TOK * 1024 * 2 <= OFF_SMALL, "MRG overlaps");

struct Params {
  const float* in[42];
  float* out;
  unsigned char* ws;
};

__device__ __forceinline__ u16 f2bf(float f) {
  unsigned u = __float_as_uint(f);
  u += 0x7fffu + ((u >> 16) & 1u);
  return (u16)(u >> 16);
}
__device__ __forceinline__ float bf2f(u16 h) { return __uint_as_float(((unsigned)h) << 16); }
__device__ __forceinline__ float bflo(unsigned u) { return __uint_as_float(u << 16); }
__device__ __forceinline__ float bfhi(unsigned u) { return __uint_as_float(u & 0xffff0000u); }
__device__ __forceinline__ unsigned pack2(float a, float b) { return (unsigned)f2bf(a) | ((unsigned)f2bf(b) << 16); }
__device__ __forceinline__ float sigmoidf_(float x) { return 1.f / (1.f + __expf(-x)); }
__device__ __forceinline__ float tanhf_(float y) { return 1.f - 2.f / (1.f + __expf(2.f * y)); }
__device__ __forceinline__ float geluf_(float x) {
  float y = 0.7978845608028654f * (x + 0.044715f * x * x * x);
  return 0.5f * x * (1.f + tanhf_(y));
}
__device__ __forceinline__ float wave_sum(float v) {
#pragma unroll
  for (int o = 32; o > 0; o >>= 1) v += __shfl_xor(v, o, 64);
  return v;
}
template <int CTRL>
__device__ __forceinline__ float dppf(float x) {
  return __int_as_float(__builtin_amdgcn_update_dpp(__float_as_int(x), __float_as_int(x), CTRL, 0xF, 0xF, true));
}
__device__ __forceinline__ float row_sum16(float x) {
  x += dppf<0x128>(x);
  x += dppf<0x124>(x);
  x += dppf<0x122>(x);
  x += dppf<0x121>(x);
  return x;
}

__device__ __forceinline__ void phase_mod(const Params& p, unsigned char* smem) {
  const int tid = TIDX;
  float* cact = (float*)smem;
  float* red = cact + 4096;
  float* mod = (float*)(p.ws + OFF_MOD);
  for (int i = tid; i < 4096; i += NTHR) { float c = p.in[1][i]; cact[i] = c / (1.f + __expf(-c)); }
  __syncthreads();
  for (int item = VBLK; item < 192; item += VGRID) {
    int l = item / 96, nb = item % 96;
    int cl = tid & 63, kq = tid >> 6;
    int col = nb * 64 + cl;
    const float* W = p.in[2] + (size_t)l * 1024 * 6144;
    float a0 = 0, a1 = 0, a2 = 0, a3 = 0;
    for (int k = kq * 256; k < kq * 256 + 256; ++k) {
      float w = W[(size_t)k * 6144 + col];
      a0 += cact[k] * w; a1 += cact[1024 + k] * w; a2 += cact[2048 + k] * w; a3 += cact[3072 + k] * w;
    }
    red[(kq * 4 + 0) * 64 + cl] = a0; red[(kq * 4 + 1) * 64 + cl] = a1;
    red[(kq * 4 + 2) * 64 + cl] = a2; red[(kq * 4 + 3) * 64 + cl] = a3;
    __syncthreads();
    {
      int b = tid >> 6;
      float s = red[(0 * 4 + b) * 64 + cl] + red[(1 * 4 + b) * 64 + cl] + red[(2 * 4 + b) * 64 + cl] + red[(3 * 4 + b) * 64 + cl];
      mod[((size_t)l * 4 + b) * 6144 + col] = s + p.in[3][l * 6144 + col];
    }
    __syncthreads();
  }
  float* s5ab = (float*)(p.ws + OFF_S5AB);
  float* s5bb = (float*)(p.ws + OFF_S5BB);
  for (int idx = VBLK * NTHR + tid; idx < 2048; idx += VGRID * NTHR) {
    int l = idx >> 10, g = (idx >> 6) & 15, n = idx & 63;
    double lre = fmin((double)p.in[28][idx], -1e-4);
    double lim = (double)p.in[29][idx];
    double dt = exp((double)p.in[35][l * 16 + g]);
    double mag = exp(lre * dt);
    double abr = mag * cos(lim * dt), abi = mag * sin(lim * dt);
    double den = lre * lre + lim * lim;
    double qr = ((abr - 1.0) * lre + abi * lim) / den;
    double qi = (abi * lre - (abr - 1.0) * lim) / den;
    s5ab[idx * 2 + 0] = (float)abr; s5ab[idx * 2 + 1] = (float)abi;
    for (int c = 0; c < 16; ++c) {
      double br = p.in[30][(size_t)idx * 16 + c], bi = p.in[31][(size_t)idx * 16 + c];
      s5bb[(size_t)idx * 32 + c] = (float)(qr * br - qi * bi);
      s5bb[(size_t)idx * 32 + 16 + c] = (float)(qr * bi + qi * br);
    }
  }
}

__device__ __forceinline__ void convert_tile(const float* __restrict__ src, int K, int N, u16* __restrict__ dst, int tk, int tn, u16* sm) {
  const int tid = TIDX;
  int r = tid >> 4, c4 = (tid & 15) * 4;
#pragma unroll
  for (int i = 0; i < 4; ++i) {
    int kk = r + 16 * i;
    float4 v = *(const float4*)(src + (size_t)(tk * 64 + kk) * N + tn * 64 + c4);
    sm[(c4 + 0) * 72 + kk] = f2bf(v.x);
    sm[(c4 + 1) * 72 + kk] = f2bf(v.y);
    sm[(c4 + 2) * 72 + kk] = f2bf(v.z);
    sm[(c4 + 3) * 72 + kk] = f2bf(v.w);
  }
  __syncthreads();
#pragma unroll
  for (int j = 0; j < 2; ++j) {
    int n = (tid >> 3) + 32 * j, ch = tid & 7;
    u32x4 v = *(const u32x4*)(sm + n * 72 + ch * 8);
    *(u32x4*)(dst + (size_t)(tn * 64 + n) * K + tk * 64 + ch * 8) = v;
  }
  __syncthreads();
}

__device__ __forceinline__ void phase_convert(const Params& p, int l, unsigned char* smem) {
  u16* sm = (u16*)smem;
  const int total = 1632 + 192 + 128 + 256 + 1024 + 1024;
  for (int item = VBLK; item < total + 16 + 192; item += VGRID) {
    int t = item;
    if (t >= total + 16) {
      const int e = (t - total - 16) * 256 + TIDX;
      if (e < 8192) { const int n = e >> 5, k = e & 31; ((u16*)(p.ws + OFF_LW2))[e] = f2bf(p.in[8][(size_t)l * 8192 + k * 256 + n]); }
      else if (e < 16384) { const int q = e - 8192, n = q >> 5, k = q & 31; ((u16*)(p.ws + OFF_LA2))[q] = f2bf(p.in[10][(size_t)l * 8192 + k * 256 + n]); }
      else if (e < 32768) { const int q = e - 16384, n = q >> 6, k = q & 63; ((u16*)(p.ws + OFF_LG2))[q] = f2bf(p.in[11][(size_t)l * 16384 + k * 256 + n]); }
      else if (e < 40960) { const int q = e - 32768, n = q >> 5, k = q & 31; ((u16*)(p.ws + OFF_LV2))[q] = (l > 0) ? f2bf(p.in[14][k * 256 + n]) : (u16)0; }
      else { const int q = e - 40960, n = q >> 8, k = q & 255; ((u16*)(p.ws + OFF_LV1))[q] = (l > 0) ? f2bf(p.in[13][k * 32 + n]) : (u16)0; }
      continue;
    }
    if (t >= total) {
      const int idx = t - total, g = idx >> 2, rq = idx & 3;
      const int tr = rq * 32 + (TIDX >> 3), s0 = (TIDX & 7) * 16;
      const float* src = p.in[23] + (((size_t)l * 4 + g) * 128 + tr) * 128 + s0;
      u16* dst = (u16*)(p.ws + OFF_SGW) + ((size_t)g * 128 + tr) * 128 + s0;
      unsigned pk[8];
#pragma unroll
      for (int e = 0; e < 4; ++e) {
        f32x4 v = *(const f32x4*)(src + e * 4);
        const int sb = s0 + e * 4;
        pk[e * 2 + 0] = pack2(sb + 0 <= tr ? v.x : 0.f, sb + 1 <= tr ? v.y : 0.f);
        pk[e * 2 + 1] = pack2(sb + 2 <= tr ? v.z : 0.f, sb + 3 <= tr ? v.w : 0.f);
      }
      *(u32x4*)(dst) = u32x4{pk[0], pk[1], pk[2], pk[3]};
      *(u32x4*)(dst + 8) = u32x4{pk[4], pk[5], pk[6], pk[7]};
      continue;
    }
    const float* src; int K, N; size_t off;
    if (t < 1632) { src = p.in[5] + (size_t)l * 1024 * 6528; K = 1024; N = 6528; off = OFF_WIN; }
    else if ((t -= 1632) < 64) { src = p.in[20] + (size_t)l * 256 * 1024; K = 256; N = 1024; off = OFF_RO; }
    else if ((t -= 64) < 64) { src = p.in[25] + (size_t)l * 256 * 1024; K = 256; N = 1024; off = OFF_SO; }
    else if ((t -= 64) < 64) { src = p.in[27] + (size_t)l * 256 * 1024; K = 256; N = 1024; off = OFF_CO; }
    else if ((t -= 64) < 128) { src = p.in[36] + (size_t)l * 256 * 2048; K = 256; N = 2048; off = OFF_GLU; }
    else if ((t -= 128) < 256) { src = p.in[37] + (size_t)l * 1024 * 1024; K = 1024; N = 1024; off = OFF_WO; }
    else if ((t -= 256) < 1024) { src = p.in[39] + (size_t)l * 1024 * 4096; K = 1024; N = 4096; off = OFF_W1; }
    else { t -= 1024; src = p.in[40] + (size_t)l * 4096 * 1024; K = 4096; N = 1024; off = OFF_W2; }
    int ntn = N / 64;
    convert_tile(src, K, N, (u16*)(p.ws + off), t / ntn, t % ntn, sm);
  }
}

__device__ __forceinline__ void phase_norm(const float* __restrict__ X, const float* __restrict__ g, const float* __restrict__ modl,
                           int sh_off, int sc_off, u16* __restrict__ H) {
  const int lane = TIDX & 63, wv = TIDX >> 6;
  for (int item = VBLK; item < T_TOK / 4; item += VGRID) {
    int row = item * 4 + wv;
    int b = row >> 12;
    const float* xr = X + (size_t)row * 1024;
    float4 v[4];
    float ss = 0;
#pragma unroll
    for (int i = 0; i < 4; ++i) {
      v[i] = *(const float4*)(xr + lane * 4 + 256 * i);
      ss += v[i].x * v[i].x + v[i].y * v[i].y + v[i].z * v[i].z + v[i].w * v[i].w;
    }
    ss = wave_sum(ss);
    float rstd = rsqrtf(ss * (1.f / 1024.f) + 1e-6f);
    const float* sh = modl + (size_t)b * 6144 + sh_off;
    const float* sc = modl + (size_t)b * 6144 + sc_off;
#pragma unroll
    for (int i = 0; i < 4; ++i) {
      int c = lane * 4 + 256 * i;
      float4 gg = *(const float4*)(g + c);
      float4 s1 = *(const float4*)(sc + c);
      float4 s0 = *(const float4*)(sh + c);
      float h0 = v[i].x * rstd * gg.x * (1.f + s1.x) + s0.x;
      float h1 = v[i].y * rstd * gg.y * (1.f + s1.y) + s0.y;
      float h2 = v[i].z * rstd * gg.z * (1.f + s1.z) + s0.z;
      float h3 = v[i].w * rstd * gg.w * (1.f + s1.w) + s0.w;
      u32x2 o; o.x = pack2(h0, h1); o.y = pack2(h2, h3);
      *(u32x2*)(H + (size_t)row * 1024 + c) = o;
    }
  }
}

__device__ __forceinline__ void phase_final(float* __restrict__ X, const float* __restrict__ g) {
  const int lane = TIDX & 63, wv = TIDX >> 6;
  for (int item = VBLK; item < T_TOK / 4; item += VGRID) {
    int row = item * 4 + wv;
    float* xr = X + (size_t)row * 1024;
    float4 v[4];
    float ss = 0;
#pragma unroll
    for (int i = 0; i < 4; ++i) {
      v[i] = *(const float4*)(xr + lane * 4 + 256 * i);
      ss += v[i].x * v[i].x + v[i].y * v[i].y + v[i].z * v[i].z + v[i].w * v[i].w;
    }
    ss = wave_sum(ss);
    float rstd = rsqrtf(ss * (1.f / 1024.f) + 1e-6f);
#pragma unroll
    for (int i = 0; i < 4; ++i) {
      int c = lane * 4 + 256 * i;
      float4 gg = *(const float4*)(g + c);
      float4 o;
      o.x = v[i].x * rstd * gg.x; o.y = v[i].y * rstd * gg.y; o.z = v[i].z * rstd * gg.z; o.w = v[i].w * rstd * gg.w;
      *(float4*)(xr + c) = o;
    }
  }
}

template <int NF, bool LEAN = false>
__device__ __forceinline__ void gemm_mainloop(const u16* __restrict__ A, int lda, const u16* __restrict__ B, int ldb,
                                              int K, f32x4 (&acc)[4][NF], u16* smem) {
  constexpr int BN = 32 * NF;
  constexpr int NB = BN / 32;
  u16* sA = smem;
  u16* sB = smem + 2 * 128 * 64;
  int tz = 0;
  if (LEAN) asm volatile("" : "+v"(tz));
  const int tid = TIDX + tz, lane = tid & 63, wv = tid >> 6;
  const int wm = wv >> 1, wn = wv & 1;
  const int lrow = tid >> 3;
  const int lchs = (tid & 7) ^ ((lrow >> 1) & 7);
  const u16* Ap = A + (size_t)lrow * lda + lchs * 8;
  const u16* Bp = B + (size_t)lrow * ldb + lchs * 8;
  const int nk = K >> 6;
  auto stage = [&](int kt, int buf) {
    const int ko = kt << 6;
#pragma unroll
    for (int i = 0; i < 4; ++i)
      __builtin_amdgcn_global_load_lds((const unsigned*)(Ap + (size_t)(32 * i) * lda + ko),
                                       (__attribute__((address_space(3))) unsigned*)(sA + buf * (128 * 64) + (tid + 256 * i) * 8), 16, 0, 0);
#pragma unroll
    for (int i = 0; i < NB; ++i)
      __builtin_amdgcn_global_load_lds((const unsigned*)(Bp + (size_t)(32 * i) * ldb + ko),
                                       (__attribute__((address_space(3))) unsigned*)(sB + buf * (BN * 64) + (tid + 256 * i) * 8), 16, 0, 0);
  };
  __syncthreads();
  stage(0, 0);
  const int fr = lane & 15, fq = lane >> 4;
  const int sw = (fr >> 1) & 7;
  for (int kt = 0; kt < nk; ++kt) {
    const int cur = kt & 1;
    asm volatile("s_waitcnt vmcnt(0)" ::: "memory");
    __syncthreads();
    if (kt + 1 < nk) stage(kt + 1, cur ^ 1);
    const u16* cA = sA + cur * (128 * 64) + (wm * 64 + fr) * 64;
    const u16* cB = sB + cur * (BN * 64) + (wn * 16 * NF + fr) * 64;
#pragma unroll
    for (int ks = 0; ks < 2; ++ks) {
      if (LEAN) __builtin_amdgcn_sched_barrier(0);
      const int pc = ((fq + 4 * ks) ^ sw) << 3;
      bf16x8 fa[4], fb[NF];
#pragma unroll
      for (int i = 0; i < 4; ++i) fa[i] = *(const bf16x8*)(cA + i * 16 * 64 + pc);
#pragma unroll
      for (int j = 0; j < NF; ++j) fb[j] = *(const bf16x8*)(cB + j * 16 * 64 + pc);
#pragma unroll
      for (int i = 0; i < 4; ++i)
#pragma unroll
        for (int j = 0; j < NF; ++j)
          acc[i][j] = __builtin_amdgcn_mfma_f32_16x16x32_bf16(fb[j], fa[i], acc[i][j], 0, 0, 0);
    }
  }
}

template <int NF>
__device__ __forceinline__ void zero_acc(f32x4 (&acc)[4][NF]) {
#pragma unroll
  for (int i = 0; i < 4; ++i)
#pragma unroll
    for (int j = 0; j < NF; ++j) acc[i][j] = f32x4{0.f, 0.f, 0.f, 0.f};
}

__device__ __forceinline__ void gemm_mainloop_8w(const u16* __restrict__ A, int lda, const u16* __restrict__ B, int ldb,
                                                 int K, f32x4 (&acc)[8][4], u16* smem) {
  constexpr int STG = 32768;
  const int tid = threadIdx.x, lane = tid & 63, wv = tid >> 6;
  const int wm = wv >> 2, wn = wv & 3;
  const int lrow = tid >> 3;
  const int lchs = (tid & 7) ^ ((lrow >> 1) & 7);
  const u16* Ap = A + (size_t)lrow * lda + lchs * 8;
  const u16* Bp = B + (size_t)lrow * ldb + lchs * 8;
  const int nk = K >> 6;
  auto stage = [&](int kt, int buf) {
    const int ko = kt << 6;
    u16* sa = smem + buf * STG;
#pragma unroll
    for (int i = 0; i < 4; ++i)
      __builtin_amdgcn_global_load_lds((const unsigned*)(Ap + (size_t)(64 * i) * lda + ko),
                                       (__attribute__((address_space(3))) unsigned*)(sa + (tid + 512 * i) * 8), 16, 0, 0);
#pragma unroll
    for (int i = 0; i < 4; ++i)
      __builtin_amdgcn_global_load_lds((const unsigned*)(Bp + (size_t)(64 * i) * ldb + ko),
                                       (__attribute__((address_space(3))) unsigned*)(sa + 16384 + (tid + 512 * i) * 8), 16, 0, 0);
  };
  __syncthreads();
  stage(0, 0);
  const int fr = lane & 15, fq = lane >> 4;
  const int sw = (fr >> 1) & 7;
  for (int kt = 0; kt < nk; ++kt) {
    const int cur = kt & 1;
    asm volatile("s_waitcnt vmcnt(0)" ::: "memory");
    __syncthreads();
    if (kt + 1 < nk) stage(kt + 1, cur ^ 1);
    const u16* cA = smem + cur * STG + (wm * 128 + fr) * 64;
    const u16* cB = smem + cur * STG + 16384 + (wn * 64 + fr) * 64;
#pragma unroll
    for (int ks = 0; ks < 2; ++ks) {
      const int pc = ((fq + 4 * ks) ^ sw) << 3;
      bf16x8 fa[8], fb[4];
#pragma unroll
      for (int i = 0; i < 8; ++i) fa[i] = *(const bf16x8*)(cA + i * 16 * 64 + pc);
#pragma unroll
      for (int j = 0; j < 4; ++j) fb[j] = *(const bf16x8*)(cB + j * 16 * 64 + pc);
#pragma unroll
      for (int i = 0; i < 8; ++i)
#pragma unroll
        for (int j = 0; j < 4; ++j)
          acc[i][j] = __builtin_amdgcn_mfma_f32_16x16x32_bf16(fb[j], fa[i], acc[i][j], 0, 0, 0);
    }
  }
}

template <int EPI>
__device__ __forceinline__ void phase_gemm_8w(const Params& p, int l, int vb, unsigned char* smem_raw) {
  u16* smem = (u16*)smem_raw;
  const int lane = threadIdx.x & 63, wv = threadIdx.x >> 6;
  const int wm = wv >> 2, wn = wv & 3;
  const int fr = lane & 15, fq = lane >> 4;
  const u16* A; const u16* B; int lda, ldb, K, ntiles_n;
  if (EPI == 0) { A = (const u16*)(p.ws + OFF_H); lda = 1024; B = (const u16*)(p.ws + OFF_WIN); ldb = 1024; K = 1024; ntiles_n = 8; }
  if (EPI == 1) { A = (const u16*)(p.ws + OFF_MRG); lda = 1024; B = (const u16*)(p.ws + OFF_WO); ldb = 1024; K = 1024; ntiles_n = 4; }
  if (EPI == 2) { A = (const u16*)(p.ws + OFF_H); lda = 1024; B = (const u16*)(p.ws + OFF_W1); ldb = 1024; K = 1024; ntiles_n = 16; }
  if (EPI == 3) { A = (const u16*)(p.ws + OFF_F); lda = 4096; B = (const u16*)(p.ws + OFF_W2); ldb = 4096; K = 4096; ntiles_n = 4; }
  const float* modl = (const float*)(p.ws + OFF_MOD) + (size_t)l * 4 * 6144;
  const int total = 64 * ntiles_n;
  const int G = gridDim.x;
  const bool swz = (G == 256);
  for (int item = vb; item < total; item += G) {
    int mt = item & 63, nt = item >> 6;
    if (swz) { const int r = item >> 8, w = vb & 31; mt = (vb >> 5) * 8 + (w & 7); nt = r * 4 + (w >> 3); }
    const int m0 = mt * 256, n0 = nt * 256;
    f32x4 acc[8][4];
#pragma unroll
    for (int i = 0; i < 8; ++i)
#pragma unroll
      for (int j = 0; j < 4; ++j) acc[i][j] = f32x4{0.f, 0.f, 0.f, 0.f};
    gemm_mainloop_8w(A + (size_t)m0 * lda, lda, B + (size_t)n0 * ldb, ldb, K, acc, smem);
#pragma unroll
    for (int i = 0; i < 8; ++i) {
      const int m = m0 + wm * 128 + i * 16 + fr;
#pragma unroll
      for (int j = 0; j < 4; ++j) {
        const int n = n0 + wn * 64 + j * 16 + fq * 4;
        f32x4 v = acc[i][j];
        if (EPI == 0) {
          *(u32x2*)((u16*)(p.ws + OFF_PABC) + (size_t)m * 2176 + n) = u32x2{pack2(v[0], v[1]), pack2(v[2], v[3])};
        } else if (EPI == 1 || EPI == 3) {
          const int b = m >> 12;
          const float* gt = modl + (size_t)b * 6144 + (EPI == 1 ? 2048 : 5120) + n;
          const float* xin = ((EPI == 1 && l == 0) ? p.in[0] : p.out) + (size_t)m * 1024 + n;
          f32x4 x = *(const f32x4*)xin;
          f32x4 gg = *(const f32x4*)gt;
          *(f32x4*)(p.out + (size_t)m * 1024 + n) = x + gg * v;
        } else {
          float r0 = fmaxf(v[0], 0.f), r1 = fmaxf(v[1], 0.f), r2 = fmaxf(v[2], 0.f), r3 = fmaxf(v[3], 0.f);
          *(u32x2*)((u16*)(p.ws + OFF_F) + (size_t)m * 4096 + n) = u32x2{pack2(r0 * r0, r1 * r1), pack2(r2 * r2, r3 * r3)};
        }
      }
    }
  }
}

template <int EPI>
__device__ __forceinline__ void phase_gemm(const Params& p, int l, int vb, unsigned char* smem_raw) {
  u16* smem = (u16*)smem_raw;
  const int lane = TIDX & 63, wv = TIDX >> 6;
  const int wm = wv >> 1, wn = wv & 1;
  const int fr = lane & 15, fq = lane >> 4;
  const u16* A; const u16* B; int lda, ldb, K, ntiles_n;
  if (EPI == 0) { A = (const u16*)(p.ws + OFF_H); lda = 1024; B = (const u16*)(p.ws + OFF_WIN); ldb = 1024; K = 1024; ntiles_n = 19; }
  if (EPI == 1) { A = (const u16*)(p.ws + OFF_MRG); lda = 1024; B = (const u16*)(p.ws + OFF_WO); ldb = 1024; K = 1024; ntiles_n = 8; }
  if (EPI == 2) { A = (const u16*)(p.ws + OFF_H); lda = 1024; B = (const u16*)(p.ws + OFF_W1); ldb = 1024; K = 1024; ntiles_n = 32; }
  if (EPI == 3) { A = (const u16*)(p.ws + OFF_F); lda = 4096; B = (const u16*)(p.ws + OFF_W2); ldb = 4096; K = 4096; ntiles_n = 8; }
  const float* modl = (const float*)(p.ws + OFF_MOD) + (size_t)l * 4 * 6144;
  const int G = VGRID;
  const bool swz = (G == 512);
  const int total = swz ? 128 * ((ntiles_n + 3) & ~3) : 128 * ntiles_n;
  for (int item = vb; item < total; item += G) {
    int mt = item & 127, nt = item >> 7;
    if (swz) { const int r = item >> 9, w = vb & 63; mt = (vb >> 6) * 16 + (w & 15); nt = r * 4 + (w >> 4); if (nt >= ntiles_n) continue; }
    const int m0 = mt * 128, n0 = nt * 128;
    f32x4 acc[4][4];
    zero_acc<4>(acc);
    gemm_mainloop<4>(A + (size_t)m0 * lda, lda, B + (size_t)n0 * ldb, ldb, K, acc, smem);
#pragma unroll
    for (int i = 0; i < 4; ++i) {
      const int m = m0 + wm * 64 + i * 16 + fr;
#pragma unroll
      for (int j = 0; j < 4; ++j) {
        const int n = n0 + wn * 64 + j * 16 + fq * 4;
        f32x4 v = acc[i][j];
        if (EPI == 0) {
          u32x2 o; o.x = pack2(v[0], v[1]); o.y = pack2(v[2], v[3]);
          if (n < 2176) *(u32x2*)((u16*)(p.ws + OFF_PABC) + (size_t)m * 2176 + n) = o;
          else *(u32x2*)((u16*)(p.ws + OFF_PD) + (size_t)m * 256 + (n - 2176)) = o;
        } else if (EPI == 1 || EPI == 3) {
          const int b = m >> 12;
          const float* gt = modl + (size_t)b * 6144 + (EPI == 1 ? 2048 : 5120) + n;
          const float* xin = ((EPI == 1 && l == 0) ? p.in[0] : p.out) + (size_t)m * 1024 + n;
          float4 x = *(const float4*)xin;
          float4 gg = *(const float4*)gt;
          float4 o;
          o.x = x.x + gg.x * v[0]; o.y = x.y + gg.y * v[1]; o.z = x.z + gg.z * v[2]; o.w = x.w + gg.w * v[3];
          *(float4*)(p.out + (size_t)m * 1024 + n) = o;
        } else {
          float r0 = fmaxf(v[0], 0.f), r1 = fmaxf(v[1], 0.f), r2 = fmaxf(v[2], 0.f), r3 = fmaxf(v[3], 0.f);
          u32x2 o; o.x = pack2(r0 * r0, r1 * r1); o.y = pack2(r2 * r2, r3 * r3);
          *(u32x2*)((u16*)(p.ws + OFF_F) + (size_t)m * 4096 + n) = o;
        }
      }
    }
  }
}

template <int MODE>
__device__ __forceinline__ void merge_tile(const Params& p, int item, unsigned char* smem_raw) {
  u16* smem = (u16*)smem_raw;
  const int lane = TIDX & 63, wv = TIDX >> 6;
  const int wm = wv >> 1, wn = wv & 1;
  const int fr = lane & 15, fq = lane >> 4;
  const u16* H = (const u16*)(p.ws + OFF_H);
  const u16* WIN = (const u16*)(p.ws + OFF_WIN);
  const int mt = item & 127, nt = item >> 7;
  const int m0 = mt * 128, n0 = nt * 128;
  f32x4 bacc[4][4];
  u32x2 gpk[4][4];
  u16* MRG = (u16*)(p.ws + OFF_MRG);
#pragma unroll 1
  for (int br = (MODE == 0 ? 1 : 0); br < (MODE == 0 ? 4 : 1); ++br) {
    zero_acc<4>(bacc);
    gemm_mainloop<4, true>(H + (size_t)m0 * 1024, 1024, WIN + (size_t)(2432 + br * 1024 + n0) * 1024, 1024, 1024, bacc, smem);
#pragma unroll
    for (int i = 0; i < 4; ++i)
#pragma unroll
      for (int j = 0; j < 4; ++j)
        gpk[i][j] = u32x2{pack2(sigmoidf_(bacc[i][j][0]), sigmoidf_(bacc[i][j][1])), pack2(sigmoidf_(bacc[i][j][2]), sigmoidf_(bacc[i][j][3]))};
    const u16* Ab; const u16* Wb;
    if (br == 0) { Ab = (const u16*)(p.ws + OFF_OG); Wb = (const u16*)(p.ws + OFF_RO); }
    else if (br == 1) { Ab = (const u16*)(p.ws + OFF_UB); Wb = (const u16*)(p.ws + OFF_SO); }
    else if (br == 2) { Ab = (const u16*)(p.ws + OFF_CB); Wb = (const u16*)(p.ws + OFF_CO); }
    else { Ab = (const u16*)(p.ws + OFF_YD); Wb = (const u16*)(p.ws + OFF_GLU); }
    if (MODE == 0 && br == 3) {
      zero_acc<4>(bacc);
      gemm_mainloop<4, true>(Ab + (size_t)m0 * 256, 256, Wb + (size_t)(1024 + n0) * 256, 256, 256, bacc, smem);
#pragma unroll
      for (int i = 0; i < 4; ++i)
#pragma unroll
        for (int j = 0; j < 4; ++j) {
          const float g0 = bflo(gpk[i][j].x) * sigmoidf_(bacc[i][j][0]), g1 = bfhi(gpk[i][j].x) * sigmoidf_(bacc[i][j][1]);
          const float g2 = bflo(gpk[i][j].y) * sigmoidf_(bacc[i][j][2]), g3 = bfhi(gpk[i][j].y) * sigmoidf_(bacc[i][j][3]);
          gpk[i][j] = u32x2{pack2(g0, g1), pack2(g2, g3)};
        }
    }
    zero_acc<4>(bacc);
    gemm_mainloop<4, true>(Ab + (size_t)m0 * 256, 256, Wb + (size_t)n0 * 256, 256, 256, bacc, smem);
#pragma unroll
    for (int i = 0; i < 4; ++i)
#pragma unroll
      for (int j = 0; j < 4; ++j) {
        u32x2* mp = (u32x2*)(MRG + (size_t)(m0 + wm * 64 + i * 16 + fr) * 1024 + n0 + wn * 64 + j * 16 + fq * 4);
        u32x2 cm = u32x2{0u, 0u};
        if (MODE == 1 || br > 1) cm = *mp;
        const float v0 = bflo(cm.x) + bflo(gpk[i][j].x) * bacc[i][j][0];
        const float v1 = bfhi(cm.x) + bfhi(gpk[i][j].x) * bacc[i][j][1];
        const float v2 = bflo(cm.y) + bflo(gpk[i][j].y) * bacc[i][j][2];
        const float v3 = bfhi(cm.y) + bfhi(gpk[i][j].y) * bacc[i][j][3];
        *mp = u32x2{pack2(v0, v1), pack2(v2, v3)};
      }
  }
}

__device__ __forceinline__ void gemm_mainloop_8n(const u16* __restrict__ A, int lda, const u16* __restrict__ B, int ldb,
                                                 int K, f32x4 (&acc)[4][4], u16* smem) {
  constexpr int STG = 24576;
  int tz = 0;
  asm volatile("" : "+v"(tz));
  const int tid = threadIdx.x + tz, lane = tid & 63, wv = tid >> 6;
  const int wm = wv >> 1, wn = wv & 1;
  const int lrow = tid >> 3;
  const int lchs = (tid & 7) ^ ((lrow >> 1) & 7);
  const u16* Ap = A + (size_t)lrow * lda + lchs * 8;
  const u16* Bp = B + (size_t)lrow * ldb + lchs * 8;
  const int nk = K >> 6;
  auto stage = [&](int kt, int buf) {
    const int ko = kt << 6;
    u16* sa = smem + buf * STG;
#pragma unroll
    for (int i = 0; i < 4; ++i)
      __builtin_amdgcn_global_load_lds((const unsigned*)(Ap + (size_t)(64 * i) * lda + ko),
                                       (__attribute__((address_space(3))) unsigned*)(sa + (tid + 512 * i) * 8), 16, 0, 0);
#pragma unroll
    for (int i = 0; i < 2; ++i)
      __builtin_amdgcn_global_load_lds((const unsigned*)(Bp + (size_t)(64 * i) * ldb + ko),
                                       (__attribute__((address_space(3))) unsigned*)(sa + 16384 + (tid + 512 * i) * 8), 16, 0, 0);
  };
  __syncthreads();
  stage(0, 0);
  stage(nk > 1 ? 1 : 0, 1);
  const int fr = lane & 15, fq = lane >> 4;
  const int sw = (fr >> 1) & 7;
  int cur = 0;
  for (int kt = 0; kt < nk; ++kt) {
    asm volatile("s_waitcnt vmcnt(6)" ::: "memory");
    __builtin_amdgcn_s_barrier();
    asm volatile("" ::: "memory");
    {
      int nx = cur + 2; if (nx >= 3) nx -= 3;
      int ktn = kt + 2; if (ktn >= nk) ktn = nk - 1;
      stage(ktn, nx);
    }
    const u16* cA = smem + cur * STG + (wm * 64 + fr) * 64;
    const u16* cB = smem + cur * STG + 16384 + (wn * 64 + fr) * 64;
#pragma unroll
    for (int ks = 0; ks < 2; ++ks) {
      const int pc = ((fq + 4 * ks) ^ sw) << 3;
      bf16x8 fa[4], fb[4];
#pragma unroll
      for (int i = 0; i < 4; ++i) fa[i] = *(const bf16x8*)(cA + i * 16 * 64 + pc);
#pragma unroll
      for (int j = 0; j < 4; ++j) fb[j] = *(const bf16x8*)(cB + j * 16 * 64 + pc);
#pragma unroll
      for (int i = 0; i < 4; ++i)
#pragma unroll
        for (int j = 0; j < 4; ++j)
          acc[i][j] = __builtin_amdgcn_mfma_f32_16x16x32_bf16(fb[j], fa[i], acc[i][j], 0, 0, 0);
    }
    cur = cur + 1; if (cur >= 3) cur = 0;
  }
  asm volatile("s_waitcnt vmcnt(0)" ::: "memory");
}

template <int MODE>
__device__ __forceinline__ void merge_tile8(const Params& p, int item, unsigned char* smem_raw) {
  u16* smem = (u16*)smem_raw;
  const int lane = threadIdx.x & 63, wv = threadIdx.x >> 6;
  const int wm = wv >> 1, wn = wv & 1;
  const int fr = lane & 15, fq = lane >> 4;
  const u16* H = (const u16*)(p.ws + OFF_H);
  const u16* WIN = (const u16*)(p.ws + OFF_WIN);
  const int mt = item & 63, nt = item >> 6;
  const int m0 = mt * 256, n0 = nt * 128;
  f32x4 bacc[4][4];
  u32x2 gpk[4][4];
  u16* MRG = (u16*)(p.ws + OFF_MRG);
#pragma unroll 1
  for (int br = (MODE == 0 ? 1 : 0); br < (MODE == 0 ? 4 : 1); ++br) {
    zero_acc<4>(bacc);
    gemm_mainloop_8n(H + (size_t)m0 * 1024, 1024, WIN + (size_t)(2432 + br * 1024 + n0) * 1024, 1024, 1024, bacc, smem);
#pragma unroll
    for (int i = 0; i < 4; ++i)
#pragma unroll
      for (int j = 0; j < 4; ++j)
        gpk[i][j] = u32x2{pack2(sigmoidf_(bacc[i][j][0]), sigmoidf_(bacc[i][j][1])), pack2(sigmoidf_(bacc[i][j][2]), sigmoidf_(bacc[i][j][3]))};
    const u16* Ab; const u16* Wb;
    if (br == 0) { Ab = (const u16*)(p.ws + OFF_OG); Wb = (const u16*)(p.ws + OFF_RO); }
    else if (br == 1) { Ab = (const u16*)(p.ws + OFF_UB); Wb = (const u16*)(p.ws + OFF_SO); }
    else if (br == 2) { Ab = (const u16*)(p.ws + OFF_CB); Wb = (const u16*)(p.ws + OFF_CO); }
    else { Ab = (const u16*)(p.ws + OFF_YD); Wb = (const u16*)(p.ws + OFF_GLU); }
    if (MODE == 0 && br == 3) {
      zero_acc<4>(bacc);
      gemm_mainloop_8n(Ab + (size_t)m0 * 256, 256, Wb + (size_t)(1024 + n0) * 256, 256, 256, bacc, smem);
#pragma unroll
      for (int i = 0; i < 4; ++i)
#pragma unroll
        for (int j = 0; j < 4; ++j) {
          const float g0 = bflo(gpk[i][j].x) * sigmoidf_(bacc[i][j][0]), g1 = bfhi(gpk[i][j].x) * sigmoidf_(bacc[i][j][1]);
          const float g2 = bflo(gpk[i][j].y) * sigmoidf_(bacc[i][j][2]), g3 = bfhi(gpk[i][j].y) * sigmoidf_(bacc[i][j][3]);
          gpk[i][j] = u32x2{pack2(g0, g1), pack2(g2, g3)};
        }
    }
    zero_acc<4>(bacc);
    gemm_mainloop_8n(Ab + (size_t)m0 * 256, 256, Wb + (size_t)n0 * 256, 256, 256, bacc, smem);
#pragma unroll
    for (int i = 0; i < 4; ++i)
#pragma unroll
      for (int j = 0; j < 4; ++j) {
        u32x2* mp = (u32x2*)(MRG + (size_t)(m0 + wm * 64 + i * 16 + fr) * 1024 + n0 + wn * 64 + j * 16 + fq * 4);
        u32x2 cm = u32x2{0u, 0u};
        if (MODE == 1 || br > 1) cm = *mp;
        const float v0 = bflo(cm.x) + bflo(gpk[i][j].x) * bacc[i][j][0];
        const float v1 = bfhi(cm.x) + bfhi(gpk[i][j].x) * bacc[i][j][1];
        const float v2 = bflo(cm.y) + bflo(gpk[i][j].y) * bacc[i][j][2];
        const float v3 = bfhi(cm.y) + bfhi(gpk[i][j].y) * bacc[i][j][3];
        *mp = u32x2{pack2(v0, v1), pack2(v2, v3)};
      }
  }
}

__device__ __forceinline__ void phase_pproj_tail(const Params& p, int vb, unsigned char* smem_raw) {
  u16* smem = (u16*)smem_raw;
  const int lane = threadIdx.x & 63, wv = threadIdx.x >> 6;
  const int wm = wv >> 1, wn = wv & 1;
  const int fr = lane & 15, fq = lane >> 4;
  const u16* A = (const u16*)(p.ws + OFF_H);
  const u16* B = (const u16*)(p.ws + OFF_WIN);
  const int G = gridDim.x;
  const int total = (G == 256) ? 256 : 192;
  for (int item = vb; item < total; item += G) {
    int mt = item & 63, nt = item >> 6;
    if (G == 256) { const int w = vb & 31; mt = (vb >> 5) * 8 + (w & 7); nt = w >> 3; if (nt >= 3) continue; }
    const int m0 = mt * 256, n0 = 2048 + nt * 128;
    f32x4 acc[4][4];
    zero_acc<4>(acc);
    gemm_mainloop_8n(A + (size_t)m0 * 1024, 1024, B + (size_t)n0 * 1024, 1024, 1024, acc, smem);
#pragma unroll
    for (int i = 0; i < 4; ++i) {
      const int m = m0 + wm * 64 + i * 16 + fr;
#pragma unroll
      for (int j = 0; j < 4; ++j) {
        const int n = n0 + wn * 64 + j * 16 + fq * 4;
        const f32x4 v = acc[i][j];
        const u32x2 o = u32x2{pack2(v[0], v[1]), pack2(v[2], v[3])};
        if (n < 2176) *(u32x2*)((u16*)(p.ws + OFF_PABC) + (size_t)m * 2176 + n) = o;
        else *(u32x2*)((u16*)(p.ws + OFF_PD) + (size_t)m * 256 + (n - 2176)) = o;
      }
    }
  }
}

__device__ __forceinline__ float shifted(const u16* __restrict__ P, int tok, int col, float mu) {
  float pv = bf2f(P[(size_t)tok * 2176 + col]);
  float pr = (tok & (SEQ - 1)) ? bf2f(P[(size_t)(tok - 1) * 2176 + col]) : 0.f;
  return pv + (pr - pv) * mu;
}

__device__ __forceinline__ void rwkv_prep_item(const Params& p, int l, int item, unsigned char* smem) {
  const int tid = TIDX, lane = tid & 63, wv = tid >> 6;
  const int fr = lane & 15, fq = lane >> 4;
  u16* sl = (u16*)smem;
  u16* sv = sl + 32 * 168;
  constexpr int SLS = 168, SVS = 264;
  const u16* P = (const u16*)(p.ws + OFF_PABC);
  const float* mu = p.in[6] + l * 896;
  const int tok0 = item * 32;
  for (int idx = tid; idx < 32 * 128; idx += NTHR) {
    const int t = idx >> 7, ci = idx & 127;
    float v = shifted(P, tok0 + t, 768 + ci, mu[768 + ci]);
    if (ci < 32) v = tanhf_(v);
    else if (ci >= 64) v = sigmoidf_(v);
    sl[t * SLS + ci] = f2bf(v);
  }
  if (l > 0) {
    const int t = tid >> 3, c0 = (tid & 7) * 32;
    const int tok = tok0 + t;
    const bool hasp = (tok & (SEQ - 1)) != 0;
#pragma unroll
    for (int q = 0; q < 4; ++q) {
      const int c = c0 + q * 8;
      const u32x4 cur = *(const u32x4*)(P + (size_t)tok * 2176 + 512 + c);
      u32x4 prv = u32x4{0u, 0u, 0u, 0u};
      if (hasp) prv = *(const u32x4*)(P + (size_t)(tok - 1) * 2176 + 512 + c);
      const f32x4 m0 = *(const f32x4*)(mu + 512 + c), m1 = *(const f32x4*)(mu + 512 + c + 4);
      float o[8];
      o[0] = bflo(cur.x) + (bflo(prv.x) - bflo(cur.x)) * m0.x; o[1] = bfhi(cur.x) + (bfhi(prv.x) - bfhi(cur.x)) * m0.y;
      o[2] = bflo(cur.y) + (bflo(prv.y) - bflo(cur.y)) * m0.z; o[3] = bfhi(cur.y) + (bfhi(prv.y) - bfhi(cur.y)) * m0.w;
      o[4] = bflo(cur.z) + (bflo(prv.z) - bflo(cur.z)) * m1.x; o[5] = bfhi(cur.z) + (bfhi(prv.z) - bfhi(cur.z)) * m1.y;
      o[6] = bflo(cur.w) + (bflo(prv.w) - bflo(cur.w)) * m1.z; o[7] = bfhi(cur.w) + (bfhi(prv.w) - bfhi(cur.w)) * m1.w;
      *(u32x4*)(sv + t * SVS + c) = u32x4{pack2(o[0], o[1]), pack2(o[2], o[3]), pack2(o[4], o[5]), pack2(o[6], o[7])};
    }
  }
  __syncthreads();
  if (l > 0) {
    const int mf = wv >> 1, nf = wv & 1;
    const u16* v1t = (const u16*)(p.ws + OFF_LV1);
    f32x4 acc = f32x4{0.f, 0.f, 0.f, 0.f};
#pragma unroll
    for (int ks = 0; ks < 8; ++ks) {
      const bf16x8 fa = *(const bf16x8*)(sv + (mf * 16 + fr) * SVS + ks * 32 + fq * 8);
      const bf16x8 fb = *(const bf16x8*)(v1t + (size_t)(nf * 16 + fr) * 256 + ks * 32 + fq * 8);
      acc = __builtin_amdgcn_mfma_f32_16x16x32_bf16(fb, fa, acc, 0, 0, 0);
    }
    *(u32x2*)(sl + (mf * 16 + fr) * SLS + 128 + nf * 16 + fq * 4) = u32x2{pack2(acc[0], acc[1]), pack2(acc[2], acc[3])};
    __syncthreads();
  }
  const u16* w2t = (const u16*)(p.ws + OFF_LW2); const u16* a2t = (const u16*)(p.ws + OFF_LA2);
  const u16* g2t = (const u16*)(p.ws + OFF_LG2); const u16* v2t = (const u16*)(p.ws + OFF_LV2);
  u16* SR = (u16*)(p.ws + OFF_SR); u16* SK = (u16*)(p.ws + OFF_SK); u16* SV = (u16*)(p.ws + OFF_SV);
  u16* SKK = (u16*)(p.ws + OFF_SKK); u16* SA = (u16*)(p.ws + OFF_SA); float* SW = (float*)(p.ws + OFF_SW);
  u16* G = (u16*)(p.ws + OFF_G); u16* VF = (u16*)(p.ws + OFF_VF);
#pragma unroll 1
  for (int mf = 0; mf < 2; ++mf) {
    const u16* arow = sl + (mf * 16 + fr) * SLS + fq * 8;
    const bf16x8 aw = *(const bf16x8*)(arow), aa = *(const bf16x8*)(arow + 32);
    const bf16x8 ag0 = *(const bf16x8*)(arow + 64), ag1 = *(const bf16x8*)(arow + 96), av = *(const bf16x8*)(arow + 128);
    f32x4 cw[4], ca[4], cg[4], cv[4];
#pragma unroll
    for (int nf = 0; nf < 4; ++nf) {
      const int n = wv * 64 + nf * 16 + fr;
      const f32x4 z = f32x4{0.f, 0.f, 0.f, 0.f};
      cw[nf] = __builtin_amdgcn_mfma_f32_16x16x32_bf16(*(const bf16x8*)(w2t + n * 32 + fq * 8), aw, z, 0, 0, 0);
      ca[nf] = __builtin_amdgcn_mfma_f32_16x16x32_bf16(*(const bf16x8*)(a2t + n * 32 + fq * 8), aa, z, 0, 0, 0);
      cg[nf] = __builtin_amdgcn_mfma_f32_16x16x32_bf16(*(const bf16x8*)(g2t + n * 64 + fq * 8), ag0, z, 0, 0, 0);
      cg[nf] = __builtin_amdgcn_mfma_f32_16x16x32_bf16(*(const bf16x8*)(g2t + n * 64 + 32 + fq * 8), ag1, cg[nf], 0, 0, 0);
      cv[nf] = z;
      if (l > 0) cv[nf] = __builtin_amdgcn_mfma_f32_16x16x32_bf16(*(const bf16x8*)(v2t + n * 32 + fq * 8), av, z, 0, 0, 0);
    }
    const int tok = tok0 + mf * 16 + fr;
    const bool hasp = (tok & (SEQ - 1)) != 0;
    float kkv[4][4], kmv[4][4], av4[4][4];
    float ss = 0.f;
#pragma unroll
    for (int nf = 0; nf < 4; ++nf) {
      const int c = wv * 64 + nf * 16 + fq * 4;
      const size_t o = (size_t)tok * 256 + c;
      const u16* pc = P + (size_t)tok * 2176 + c;
      const u32x2 r_c = *(const u32x2*)(pc), k_c = *(const u32x2*)(pc + 256), v_c = *(const u32x2*)(pc + 512);
      u32x2 r_p = u32x2{0u, 0u}, k_p = u32x2{0u, 0u}, v_p = u32x2{0u, 0u};
      if (hasp) { r_p = *(const u32x2*)(pc - 2176); k_p = *(const u32x2*)(pc - 2176 + 256); v_p = *(const u32x2*)(pc - 2176 + 512); }
      const f32x4 mur = *(const f32x4*)(mu + c), muk = *(const f32x4*)(mu + 256 + c), muv = *(const f32x4*)(mu + 512 + c);
      const f32x4 w0 = *(const f32x4*)(p.in[7] + l * 256 + c), a0 = *(const f32x4*)(p.in[9] + l * 256 + c);
      const f32x4 kkc = *(const f32x4*)(p.in[15] + l * 256 + c), kac = *(const f32x4*)(p.in[16] + l * 256 + c);
      f32x4 v0 = f32x4{0.f, 0.f, 0.f, 0.f};
      if (l > 0) v0 = *(const f32x4*)(p.in[12] + c);
      u32x2 vfraw = u32x2{0u, 0u};
      if (l > 0) vfraw = *(const u32x2*)(VF + o);
      float rr[4], kk_[4], vv[4], dec[4], gg[4];
#pragma unroll
      for (int e = 0; e < 4; ++e) {
        const unsigned rc = e < 2 ? r_c.x : r_c.y, rp = e < 2 ? r_p.x : r_p.y;
        const unsigned kc = e < 2 ? k_c.x : k_c.y, kp = e < 2 ? k_p.x : k_p.y;
        const unsigned vc = e < 2 ? v_c.x : v_c.y, vp = e < 2 ? v_p.x : v_p.y;
        const unsigned vfr = e < 2 ? vfraw.x : vfraw.y;
        const float rcf = (e & 1) ? bfhi(rc) : bflo(rc), rpf = (e & 1) ? bfhi(rp) : bflo(rp);
        const float kcf = (e & 1) ? bfhi(kc) : bflo(kc), kpf = (e & 1) ? bfhi(kp) : bflo(kp);
        const float vcf = (e & 1) ? bfhi(vc) : bflo(vc), vpf = (e & 1) ? bfhi(vp) : bflo(vp);
        const float r = rcf + (rpf - rcf) * mur[e];
        const float k = kcf + (kpf - kcf) * muk[e];
        float v = vcf + (vpf - vcf) * muv[e];
        const float wl = w0[e] + cw[nf][e];
        const float z = -wl;
        const float sp = (z > 15.f) ? z : __logf(1.f + __expf(z));
        dec[e] = __expf(-__expf(-sp - 0.5f));
        const float a = sigmoidf_(a0[e] + ca[nf][e]);
        gg[e] = cg[nf][e];
        if (l > 0) { const float vf = (e & 1) ? bfhi(vfr) : bflo(vfr); v = v + (vf - v) * sigmoidf_(v0[e] + cv[nf][e]); }
        const float kk = k * kkc[e];
        ss += kk * kk;
        rr[e] = r; vv[e] = v; kk_[e] = kk; kkv[nf][e] = kk;
        kmv[nf][e] = k * (1.f + (a - 1.f) * kac[e]); av4[nf][e] = a;
      }
      *(u32x2*)(SR + o) = u32x2{pack2(rr[0], rr[1]), pack2(rr[2], rr[3])};
      *(u32x2*)(SV + o) = u32x2{pack2(vv[0], vv[1]), pack2(vv[2], vv[3])};
      if (l == 0) *(u32x2*)(VF + o) = u32x2{pack2(vv[0], vv[1]), pack2(vv[2], vv[3])};
      *(u32x2*)(G + o) = u32x2{pack2(gg[0], gg[1]), pack2(gg[2], gg[3])};
      *(f32x4*)(SW + o) = f32x4{dec[0], dec[1], dec[2], dec[3]};
    }
    ss += __shfl_xor(ss, 16, 64);
    ss += __shfl_xor(ss, 32, 64);
    const float inv = 1.f / fmaxf(sqrtf(ss), 1e-12f);
#pragma unroll
    for (int nf = 0; nf < 4; ++nf) {
      const size_t o = (size_t)tok * 256 + wv * 64 + nf * 16 + fq * 4;
      *(u32x2*)(SKK + o) = u32x2{pack2(kkv[nf][0] * inv, kkv[nf][1] * inv), pack2(kkv[nf][2] * inv, kkv[nf][3] * inv)};
      *(u32x2*)(SK + o) = u32x2{pack2(kmv[nf][0], kmv[nf][1]), pack2(kmv[nf][2], kmv[nf][3])};
      *(u32x2*)(SA + o) = u32x2{pack2(av4[nf][0], av4[nf][1]), pack2(av4[nf][2], av4[nf][3])};
    }
  }
  __syncthreads();
}

__device__ __forceinline__ void sg_item(const Params& p, int l, int item, unsigned char* smem) {
  const int tid = TIDX, lane = tid & 63, wv = tid >> 6;
  u16* vsT = (u16*)smem;
  float* smu = (float*)(smem + 16384);
  float* srs = smu + 128;
  const u16* P = (const u16*)(p.ws + OFF_PABC);
  const int g = item & 3, chn = item >> 2;
  const int tok0 = chn * 128;
  {
    const int t = tid >> 1, hf = tid & 1;
    const u16* src = P + (size_t)(tok0 + t) * 2176 + 896 + 256 + hf * 128;
    float sm = 0.f, ss = 0.f;
#pragma unroll 4
    for (int i = 0; i < 16; ++i) {
      u32x4 raw = *(const u32x4*)(src + i * 8);
      float z;
      z = geluf_(bflo(raw.x)); sm += z; ss += z * z;  z = geluf_(bfhi(raw.x)); sm += z; ss += z * z;
      z = geluf_(bflo(raw.y)); sm += z; ss += z * z;  z = geluf_(bfhi(raw.y)); sm += z; ss += z * z;
      z = geluf_(bflo(raw.z)); sm += z; ss += z * z;  z = geluf_(bfhi(raw.z)); sm += z; ss += z * z;
      z = geluf_(bflo(raw.w)); sm += z; ss += z * z;  z = geluf_(bfhi(raw.w)); sm += z; ss += z * z;
    }
    sm += __shfl_xor(sm, 1, 64); ss += __shfl_xor(ss, 1, 64);
    const float mean = sm * (1.f / 256.f);
    const float var = fmaxf(ss * (1.f / 256.f) - mean * mean, 0.f);
    if (hf == 0) { smu[t] = mean; srs[t] = rsqrtf(var + 1e-5f); }
  }
  __syncthreads();
  {
    const int c = tid & 63, tb = tid >> 6;
    const float lw = p.in[21][l * 256 + g * 64 + c], lb = p.in[22][l * 256 + g * 64 + c];
#pragma unroll
    for (int j = 0; j < 4; ++j) {
      u16 raw[8];
#pragma unroll
      for (int e = 0; e < 8; ++e) raw[e] = P[(size_t)(tok0 + tb * 32 + j * 8 + e) * 2176 + 896 + 256 + g * 64 + c];
      float vv[8];
#pragma unroll
      for (int e = 0; e < 8; ++e) {
        const int t = tb * 32 + j * 8 + e;
        vv[e] = (geluf_(bf2f(raw[e])) - smu[t]) * srs[t] * lw + lb;
      }
      const int phys = (tb * 4 + j) ^ (c & 15);
      *(u32x4*)(vsT + c * 128 + phys * 8) = u32x4{pack2(vv[0], vv[1]), pack2(vv[2], vv[3]), pack2(vv[4], vv[5]), pack2(vv[6], vv[7])};
    }
  }
  __syncthreads();
  {
    const int fr = lane & 15, fq = lane >> 4;
    const u16* Wm = (const u16*)(p.ws + OFF_SGW) + (size_t)g * 128 * 128;
    f32x4 acc[2][4];
#pragma unroll
    for (int i = 0; i < 2; ++i)
#pragma unroll
      for (int j = 0; j < 4; ++j) acc[i][j] = f32x4{0.f, 0.f, 0.f, 0.f};
    for (int ks = 0; ks <= wv; ++ks) {
      bf16x8 fa[2], fb[4];
#pragma unroll
      for (int i = 0; i < 2; ++i) fa[i] = *(const bf16x8*)(Wm + (size_t)(32 * wv + 16 * i + fr) * 128 + ks * 32 + fq * 8);
#pragma unroll
      for (int j = 0; j < 4; ++j) fb[j] = *(const bf16x8*)(vsT + (j * 16 + fr) * 128 + (((ks * 4 + fq) ^ fr) << 3));
#pragma unroll
      for (int i = 0; i < 2; ++i)
#pragma unroll
        for (int j = 0; j < 4; ++j) acc[i][j] = __builtin_amdgcn_mfma_f32_16x16x32_bf16(fb[j], fa[i], acc[i][j], 0, 0, 0);
    }
    const float* bs = p.in[24] + ((size_t)l * 4 + g) * 128;
    u16* UB = (u16*)(p.ws + OFF_UB);
#pragma unroll
    for (int i = 0; i < 2; ++i) {
      const int t = 32 * wv + 16 * i + fr;
      const float bsv = bs[t];
#pragma unroll
      for (int j = 0; j < 4; ++j) {
        const int cc = j * 16 + fq * 4;
        u32x2 ur = *(const u32x2*)(P + (size_t)(tok0 + t) * 2176 + 896 + g * 64 + cc);
        float o0 = geluf_(bflo(ur.x)) * (acc[i][j][0] + bsv), o1 = geluf_(bfhi(ur.x)) * (acc[i][j][1] + bsv);
        float o2 = geluf_(bflo(ur.y)) * (acc[i][j][2] + bsv), o3 = geluf_(bfhi(ur.y)) * (acc[i][j][3] + bsv);
        *(u32x2*)(UB + (size_t)(tok0 + t) * 256 + g * 64 + cc) = u32x2{pack2(o0, o1), pack2(o2, o3)};
      }
    }
  }
  __syncthreads();
}

__device__ __forceinline__ void conv_item(const Params& p, int l, int item) {
  const int j = TIDX;
  const u16* P = (const u16*)(p.ws + OFF_PABC);
  u16* CB = (u16*)(p.ws + OFF_CB);
  const float c0 = p.in[26][(l * 3 + 0) * 256 + j], c1 = p.in[26][(l * 3 + 1) * 256 + j], c2 = p.in[26][(l * 3 + 2) * 256 + j];
  const int tok0 = item * 8;
  u16 rc[10], rx[10], rb[8];
  const bool first = (tok0 & (SEQ - 1)) == 0;
#pragma unroll
  for (int t = 0; t < 10; ++t) {
    const int tok = (first && t < 2) ? tok0 : tok0 + t - 2;
    const u16* q = P + (size_t)tok * 2176 + 1408;
    rc[t] = q[256 + j]; rx[t] = q[512 + j];
    if (t >= 2) rb[t - 2] = q[j];
  }
  float z[10];
#pragma unroll
  for (int t = 0; t < 10; ++t) z[t] = bf2f(rc[t]) * bf2f(rx[t]);
  if (first) { z[0] = 0.f; z[1] = 0.f; }
#pragma unroll
  for (int t = 0; t < 8; ++t) {
    float y = c0 * z[t] + c1 * z[t + 1] + c2 * z[t + 2];
    CB[(size_t)(tok0 + t) * 256 + j] = f2bf(bf2f(rb[t]) * y);
  }
}

__device__ __forceinline__ void s5_load_u(const u16* us, int t, int wv, float (&u)[16]) {
  const u32x4* q = (const u32x4*)(us + t * 64 + wv * 16);
  u32x4 a = q[0], b = q[1];
  u[0] = bflo(a.x); u[1] = bfhi(a.x); u[2] = bflo(a.y); u[3] = bfhi(a.y);
  u[4] = bflo(a.z); u[5] = bfhi(a.z); u[6] = bflo(a.w); u[7] = bfhi(a.w);
  u[8] = bflo(b.x); u[9] = bfhi(b.x); u[10] = bflo(b.y); u[11] = bfhi(b.y);
  u[12] = bflo(b.z); u[13] = bfhi(b.z); u[14] = bflo(b.w); u[15] = bfhi(b.w);
}
__device__ __forceinline__ void s5_stage_u(const u16* __restrict__ PD, int tok0, int gq, u16* us) {
#pragma unroll
  for (int i = 0; i < 2; ++i) {
    const int ch = TIDX + 256 * i;
    const int t = ch >> 3, part = ch & 7;
    *(u32x4*)(us + t * 64 + part * 8) = *(const u32x4*)(PD + (size_t)(tok0 + t) * 256 + gq * 64 + part * 8);
  }
}

__device__ __forceinline__ void s5a_item(const Params& p, int l, int item, unsigned char* smem) {
  const int lane = TIDX & 63, wv = TIDX >> 6;
  const int gq = item & 3, bc = item >> 2;
  const int g = gq * 4 + wv;
  const int tok0 = bc * 64;
  const u16* PD = (const u16*)(p.ws + OFF_PD);
  const float* ab = (const float*)(p.ws + OFF_S5AB) + ((size_t)(l * 16 + g) * 64 + lane) * 2;
  const float* bb = (const float*)(p.ws + OFF_S5BB) + ((size_t)(l * 16 + g) * 64 + lane) * 32;
  float bbr[16], bbi[16];
#pragma unroll
  for (int c = 0; c < 16; ++c) { bbr[c] = bb[c]; bbi[c] = bb[16 + c]; }
  const float abr = ab[0], abi = ab[1];
  float xr = 0.f, xi = 0.f;
  u16* us = (u16*)smem;
  s5_stage_u(PD, tok0, gq, us);
  __syncthreads();
#pragma unroll 4
  for (int t = 0; t < 64; ++t) {
    float u[16];
    s5_load_u(us, t, wv, u);
    float bur = 0.f, bui = 0.f;
#pragma unroll
    for (int c = 0; c < 16; ++c) { bur += bbr[c] * u[c]; bui += bbi[c] * u[c]; }
    float nr = abr * xr - abi * xi + bur;
    float ni = abr * xi + abi * xr + bui;
    xr = nr; xi = ni;
  }
  float2* E = (float2*)(p.ws + OFF_S5E);
  E[((size_t)bc * 16 + g) * 64 + lane] = make_float2(xr, xi);
  __syncthreads();
}

__device__ __forceinline__ void s5b_item(const Params& p, int l, int item, unsigned char* smem) {
  const int lane = TIDX & 63, wv = TIDX >> 6;
  const int gq = item & 3, bc = item >> 2;
  const int b = bc >> 6, ch = bc & 63;
  const int g = gq * 4 + wv;
  const int tok0 = bc * 64;
  u16* us = (u16*)(smem + 65536);
  s5_stage_u((const u16*)(p.ws + OFF_PD), tok0, gq, us);
  float* base = (float*)smem + wv * 4096;
  float* csr = base, *csi = base + 1024, *xsr = base + 2048, *xsi = base + 3072;
  const u16* PD = (const u16*)(p.ws + OFF_PD);
  const float* ab = (const float*)(p.ws + OFF_S5AB) + ((size_t)(l * 16 + g) * 64 + lane) * 2;
  const float* bb = (const float*)(p.ws + OFF_S5BB) + ((size_t)(l * 16 + g) * 64 + lane) * 32;
  const float* cre = p.in[32] + ((size_t)(l * 16 + g) * 16) * 64;
  const float* cim = p.in[33] + ((size_t)(l * 16 + g) * 16) * 64;
  for (int c = 0; c < 16; ++c) {
    csr[(lane >> 2) * 64 + c * 4 + (lane & 3)] = cre[c * 64 + lane];
    csi[(lane >> 2) * 64 + c * 4 + (lane & 3)] = cim[c * 64 + lane];
  }
  float bbr[16], bbi[16];
#pragma unroll
  for (int c = 0; c < 16; ++c) { bbr[c] = bb[c]; bbi[c] = bb[16 + c]; }
  const float abr = ab[0], abi = ab[1];
  float pr = abr, pi = abi;
#pragma unroll
  for (int s = 0; s < 6; ++s) { float nr = pr * pr - pi * pi, ni = 2.f * pr * pi; pr = nr; pi = ni; }
  float xr = 0.f, xi = 0.f;
  const float2* E = (const float2*)(p.ws + OFF_S5E);
  {
    const f32x2* Ev = (const f32x2*)E + ((size_t)(b * 64) * 16 + g) * 64 + lane;
    int c = 0;
    for (; c + 8 <= ch; c += 8) {
      f32x2 e[8];
#pragma unroll
      for (int k = 0; k < 8; ++k) e[k] = Ev[(size_t)(c + k) * 1024];
#pragma unroll
      for (int k = 0; k < 8; ++k) {
        const float nr = pr * xr - pi * xi + e[k].x;
        const float ni = pr * xi + pi * xr + e[k].y;
        xr = nr; xi = ni;
      }
    }
    for (; c < ch; ++c) {
      const f32x2 e = Ev[(size_t)c * 1024];
      const float nr = pr * xr - pi * xi + e.x;
      const float ni = pr * xi + pi * xr + e.y;
      xr = nr; xi = ni;
    }
  }
  const int tt = lane & 15, cq = lane >> 4;
  const float* dvec = p.in[34] + l * 256 + g * 16 + cq * 4;
  const float d0 = dvec[0], d1 = dvec[1], d2 = dvec[2], d3 = dvec[3];
  u16* YD = (u16*)(p.ws + OFF_YD);
  const int n4w = lane >> 2, e4 = lane & 3;
  __syncthreads();
#pragma unroll 1
  for (int sc = 0; sc < 4; ++sc) {
    for (int t = 0; t < 16; ++t) {
      float u[16];
      s5_load_u(us, sc * 16 + t, wv, u);
      float bur = 0.f, bui = 0.f;
#pragma unroll
      for (int c = 0; c < 16; ++c) { bur += bbr[c] * u[c]; bui += bbi[c] * u[c]; }
      float nr = abr * xr - abi * xi + bur;
      float ni = abr * xi + abi * xr + bui;
      xr = nr; xi = ni;
      int a = n4w * 64 + ((t ^ (n4w & 7)) << 2) + e4;
      xsr[a] = xr; xsi[a] = xi;
    }
    __syncthreads();
    float acc0 = 0.f, acc1 = 0.f, acc2 = 0.f, acc3 = 0.f;
#pragma unroll 2
    for (int n4 = 0; n4 < 16; ++n4) {
      int xa = n4 * 64 + ((tt ^ (n4 & 7)) << 2);
      float4 xr4 = *(const float4*)(xsr + xa);
      float4 xi4 = *(const float4*)(xsi + xa);
      const float* cr = csr + n4 * 64 + cq * 16;
      const float* ci = csi + n4 * 64 + cq * 16;
      float4 r0 = *(const float4*)(cr), r1 = *(const float4*)(cr + 4), r2 = *(const float4*)(cr + 8), r3 = *(const float4*)(cr + 12);
      float4 i0 = *(const float4*)(ci), i1 = *(const float4*)(ci + 4), i2 = *(const float4*)(ci + 8), i3 = *(const float4*)(ci + 12);
      acc0 += r0.x * xr4.x + r0.y * xr4.y + r0.z * xr4.z + r0.w * xr4.w - (i0.x * xi4.x + i0.y * xi4.y + i0.z * xi4.z + i0.w * xi4.w);
      acc1 += r1.x * xr4.x + r1.y * xr4.y + r1.z * xr4.z + r1.w * xr4.w - (i1.x * xi4.x + i1.y * xi4.y + i1.z * xi4.z + i1.w * xi4.w);
      acc2 += r2.x * xr4.x + r2.y * xr4.y + r2.z * xr4.z + r2.w * xr4.w - (i2.x * xi4.x + i2.y * xi4.y + i2.z * xi4.z + i2.w * xi4.w);
      acc3 += r3.x * xr4.x + r3.y * xr4.y + r3.z * xr4.z + r3.w * xr4.w - (i3.x * xi4.x + i3.y * xi4.y + i3.z * xi4.z + i3.w * xi4.w);
    }
    {
      const int tok = tok0 + sc * 16 + tt;
      u32x2 ur = *(const u32x2*)(us + (sc * 16 + tt) * 64 + wv * 16 + cq * 4);
      float y0 = acc0 + d0 * bflo(ur.x), y1 = acc1 + d1 * bfhi(ur.x), y2 = acc2 + d2 * bflo(ur.y), y3 = acc3 + d3 * bfhi(ur.y);
      u32x2 o; o.x = pack2(geluf_(y0), geluf_(y1)); o.y = pack2(geluf_(y2), geluf_(y3));
      *(u32x2*)(YD + (size_t)tok * 256 + g * 16 + cq * 4) = o;
    }
    __syncthreads();
  }
}

__device__ __forceinline__ void lds_barrier() {
  asm volatile("s_waitcnt lgkmcnt(0)" ::: "memory");
  __builtin_amdgcn_s_barrier();
  asm volatile("" ::: "memory");
}
__device__ __forceinline__ void scan_item(const Params& p, int item, unsigned char* smem) {
  const int tid = TIDX, lane = tid & 63, wv = tid >> 6;
  const int b = item >> 4, h = (item >> 2) & 3, q = item & 3;
  const int rl = lane >> 4, cl = lane & 15;
  const int rloc = wv * 4 + rl;
  const size_t tokb = (size_t)b * SEQ;
  const int chan0 = h * 64;
  const u16* SR = (const u16*)(p.ws + OFF_SR); const u16* SK = (const u16*)(p.ws + OFF_SK);
  const u16* SV = (const u16*)(p.ws + OFF_SV); const u16* SKK = (const u16*)(p.ws + OFF_SKK);
  const u16* SA = (const u16*)(p.ws + OFF_SA); const float* SW = (const float*)(p.ws + OFF_SW);
  float* O = (float*)(p.ws + OFF_O);
  constexpr int BUFF = 6432;
  float* lbase = (float*)smem;
  float* pp = lbase + 2 * BUFF + wv * 1024;
  const int st = tid >> 4, cg4 = tid & 15;
  struct Stg { u32x2 r, k, kk, a, kk1; f32x4 w; u16 v; };
  auto gload = [&](Stg& g, int c) {
    const size_t o = (tokb + (size_t)c * 16 + st) * 256 + chan0;
    g.r = *(const u32x2*)(SR + o + cg4 * 4); g.k = *(const u32x2*)(SK + o + cg4 * 4);
    g.kk = *(const u32x2*)(SKK + o + cg4 * 4); g.a = *(const u32x2*)(SA + o + cg4 * 4);
    g.w = *(const f32x4*)(SW + o + cg4 * 4);
    g.v = SV[o + q * 16 + cg4];
    int t1 = c * 16 + st + 1; if (t1 >= SEQ) t1 = SEQ - 1;
    g.kk1 = *(const u32x2*)(SKK + (tokb + (size_t)t1) * 256 + chan0 + cg4 * 4);
  };
  auto lwrite = [&](const Stg& g, int buf) {
    float* bp = lbase + buf * BUFF;
    const int o = st * 64 + cg4 * 4;
    f32x4 kk = {bflo(g.kk.x), bfhi(g.kk.x), bflo(g.kk.y), bfhi(g.kk.y)};
    f32x4 a = {bflo(g.a.x), bfhi(g.a.x), bflo(g.a.y), bfhi(g.a.y)};
    f32x4 k = {bflo(g.k.x), bfhi(g.k.x), bflo(g.k.y), bfhi(g.k.y)};
    f32x4 r = {bflo(g.r.x), bfhi(g.r.x), bflo(g.r.y), bfhi(g.r.y)};
    *(f32x4*)(bp + o) = kk;
    *(f32x4*)(bp + 1024 + o) = kk * a;
    *(f32x4*)(bp + 2048 + o) = k;
    *(f32x4*)(bp + 3072 + o) = g.w;
    *(f32x4*)(bp + 4096 + o) = r;
    bp[5120 + st * 16 + cg4] = bf2f(g.v);
    const f32x4 kn = {bflo(g.kk1.x), bfhi(g.kk1.x), bflo(g.kk1.y), bfhi(g.kk1.y)};
    *(f32x4*)(bp + 5376 + o) = g.w * kn;
    const f32x4 bb = kk * a;
    const float c1 = row_sum16(k.x * kn.x + k.y * kn.y + k.z * kn.z + k.w * kn.w);
    const float c2 = row_sum16(bb.x * kn.x + bb.y * kn.y + bb.z * kn.z + bb.w * kn.w);
    if (cg4 == 0) *(f32x2*)(bp + 6400 + st * 2) = f32x2{c1, c2};
  };
  constexpr int NCH = SEQ / 16;
  Stg R0, R1, R2, R3;
  gload(R0, 0); gload(R1, 1); gload(R2, 2); gload(R3, 3);
  __syncthreads();
  lwrite(R0, 0);
  __syncthreads();
  __builtin_amdgcn_s_setprio(3);
  float S0 = 0.f, S1 = 0.f, S2 = 0.f, S3 = 0.f;
  const int rrow = lane & 3, rstep = lane >> 2;
  struct Pair { f32x4 kkA, bbA, kA, wA, rA, mA, bbB, kB, wB, rB; f32x2 cA; float vA, vB; };
  auto chunk = [&](int c) {
    const float* bp = lbase + (c & 1) * BUFF;
    auto ldpair = [&](Pair& o, int s) {
      o.kkA = *(const f32x4*)(bp + s * 64 + cl * 4);
      o.mA = *(const f32x4*)(bp + 5376 + s * 64 + cl * 4);
      o.bbA = *(const f32x4*)(bp + 1024 + s * 64 + cl * 4);
      o.kA = *(const f32x4*)(bp + 2048 + s * 64 + cl * 4);
      o.wA = *(const f32x4*)(bp + 3072 + s * 64 + cl * 4);
      o.rA = *(const f32x4*)(bp + 4096 + s * 64 + cl * 4);
      o.vA = bp[5120 + s * 16 + rloc];
      o.cA = *(const f32x2*)(bp + 6400 + s * 2);
      o.bbB = *(const f32x4*)(bp + 1024 + (s + 1) * 64 + cl * 4);
      o.kB = *(const f32x4*)(bp + 2048 + (s + 1) * 64 + cl * 4);
      o.wB = *(const f32x4*)(bp + 3072 + (s + 1) * 64 + cl * 4);
      o.rB = *(const f32x4*)(bp + 4096 + (s + 1) * 64 + cl * 4);
      o.vB = bp[5120 + (s + 1) * 16 + rloc];
    };
    auto pairstep = [&](const Pair& o, int s) {
      const float pa = __builtin_fmaf(S3, o.kkA.w, __builtin_fmaf(S2, o.kkA.z, __builtin_fmaf(S1, o.kkA.y, S0 * o.kkA.x)));
      const float pd = __builtin_fmaf(S3, o.mA.w, __builtin_fmaf(S2, o.mA.z, __builtin_fmaf(S1, o.mA.y, S0 * o.mA.x)));
      const float saA = row_sum16(pa);
      const float dd = row_sum16(pd);
      const float saB = __builtin_fmaf(-saA, o.cA.y, __builtin_fmaf(o.vA, o.cA.x, dd));
      S0 = __builtin_fmaf(S0, o.wA.x, __builtin_fmaf(o.vA, o.kA.x, -(saA * o.bbA.x)));
      S1 = __builtin_fmaf(S1, o.wA.y, __builtin_fmaf(o.vA, o.kA.y, -(saA * o.bbA.y)));
      S2 = __builtin_fmaf(S2, o.wA.z, __builtin_fmaf(o.vA, o.kA.z, -(saA * o.bbA.z)));
      S3 = __builtin_fmaf(S3, o.wA.w, __builtin_fmaf(o.vA, o.kA.w, -(saA * o.bbA.w)));
      pp[(s * 4 + rl) * 16 + cl] = __builtin_fmaf(S3, o.rA.w, __builtin_fmaf(S2, o.rA.z, __builtin_fmaf(S1, o.rA.y, S0 * o.rA.x)));
      S0 = __builtin_fmaf(S0, o.wB.x, __builtin_fmaf(o.vB, o.kB.x, -(saB * o.bbB.x)));
      S1 = __builtin_fmaf(S1, o.wB.y, __builtin_fmaf(o.vB, o.kB.y, -(saB * o.bbB.y)));
      S2 = __builtin_fmaf(S2, o.wB.z, __builtin_fmaf(o.vB, o.kB.z, -(saB * o.bbB.z)));
      S3 = __builtin_fmaf(S3, o.wB.w, __builtin_fmaf(o.vB, o.kB.w, -(saB * o.bbB.w)));
      pp[((s + 1) * 4 + rl) * 16 + cl] = __builtin_fmaf(S3, o.rB.w, __builtin_fmaf(S2, o.rB.z, __builtin_fmaf(S1, o.rB.y, S0 * o.rB.x)));
    };
    Pair p0, p1;
    ldpair(p0, 0);
#pragma unroll
    for (int j = 0; j < 4; ++j) {
      ldpair(p1, 4 * j + 2);
      __builtin_amdgcn_sched_barrier(0);
      pairstep(p0, 4 * j);
      __builtin_amdgcn_sched_barrier(0);
      if (j < 3) ldpair(p0, 4 * j + 4);
      __builtin_amdgcn_sched_barrier(0);
      pairstep(p1, 4 * j + 2);
      __builtin_amdgcn_sched_barrier(0);
    }
    asm volatile("" ::: "memory");
    {
      const float* q0 = pp + (rstep * 4 + rrow) * 16;
      f32x4 a0 = *(const f32x4*)(q0), a1 = *(const f32x4*)(q0 + 4), a2 = *(const f32x4*)(q0 + 8), a3 = *(const f32x4*)(q0 + 12);
      f32x4 sm4 = (a0 + a1) + (a2 + a3);
      O[(tokb + (size_t)c * 16 + rstep) * 256 + chan0 + q * 16 + wv * 4 + rrow] = (sm4.x + sm4.y) + (sm4.z + sm4.w);
    }
    asm volatile("" ::: "memory");
  };
#pragma unroll 1
  for (int g = 0; g < NCH / 4; ++g) {
    const int c0 = g * 4;
    if (c0 + 4 < NCH) gload(R0, c0 + 4);
    chunk(c0);
    lwrite(R1, (c0 + 1) & 1);
    lds_barrier();
    if (c0 + 5 < NCH) gload(R1, c0 + 5);
    chunk(c0 + 1);
    lwrite(R2, (c0 + 2) & 1);
    lds_barrier();
    if (c0 + 6 < NCH) gload(R2, c0 + 6);
    chunk(c0 + 2);
    lwrite(R3, (c0 + 3) & 1);
    lds_barrier();
    if (c0 + 7 < NCH) gload(R3, c0 + 7);
    chunk(c0 + 3);
    if (c0 + 4 < NCH) lwrite(R0, (c0 + 4) & 1);
    lds_barrier();
  }
  __builtin_amdgcn_s_setprio(0);
}

__device__ __forceinline__ void rwkv_post_item(const Params& p, int l, int item) {
  const int j = TIDX;
  const float* O = (const float*)(p.ws + OFF_O);
  const u16* SR = (const u16*)(p.ws + OFF_SR); const u16* SK = (const u16*)(p.ws + OFF_SK);
  const u16* SV = (const u16*)(p.ws + OFF_SV); const u16* G = (const u16*)(p.ws + OFF_G);
  u16* OG = (u16*)(p.ws + OFF_OG);
  const float lw = p.in[18][l * 256 + j], lb = p.in[19][l * 256 + j], rk = p.in[17][l * 256 + j];
  const int tok0 = item * 8;
  float ov[8]; u16 rr[8], rkk[8], rv[8], rg[8];
#pragma unroll
  for (int t = 0; t < 8; ++t) {
    const size_t o = (size_t)(tok0 + t) * 256 + j;
    ov[t] = O[o]; rr[t] = SR[o]; rkk[t] = SK[o]; rv[t] = SV[o]; rg[t] = G[o];
  }
#pragma unroll
  for (int t = 0; t < 8; ++t) {
    const size_t o = (size_t)(tok0 + t) * 256 + j;
    float mean = wave_sum(ov[t]) * (1.f / 64.f);
    float d = ov[t] - mean;
    float var = wave_sum(d * d) * (1.f / 64.f);
    float on = d * rsqrtf(var + 64e-5f) * lw + lb;
    float bonus = wave_sum(bf2f(rr[t]) * bf2f(rkk[t]) * rk);
    OG[o] = f2bf((on + bonus * bf2f(rv[t])) * bf2f(rg[t]));
  }
}

#define XB_TMO      128
#define XB_XCNT(j)  (256  + 64 * (j))
#define XB_XSUB(j)  (1280 + 64 * (j))
#define XB_XGEN(j)  (2304 + 64 * (j))
#define XB_TOP      3328
#define XB_TOPGEN   3392
#define XCD_BAR_WORDS 3456
#define XB_SPIN_CAP (1u << 22)
#define LAS __attribute__((address_space(3)))
__device__ __forceinline__ unsigned xb_ld(unsigned* p) { return __hip_atomic_load(p, __ATOMIC_RELAXED, __HIP_MEMORY_SCOPE_AGENT); }
__device__ __forceinline__ unsigned xb_add(unsigned* p, unsigned v) { return __hip_atomic_fetch_add(p, v, __ATOMIC_RELAXED, __HIP_MEMORY_SCOPE_AGENT); }
__device__ __forceinline__ unsigned xb_xcc_id() { return (unsigned)__builtin_amdgcn_s_getreg((3 << 11) | 20) & 0xFu; }
#define XB_SPIN(cond, bar) do { unsigned _sp = 0; while (cond) { __builtin_amdgcn_s_sleep(1); \
    if ((++_sp & 255u) == 0u) { if (xb_ld(&(bar)[XB_TMO])) break; if (_sp > XB_SPIN_CAP) { atomicAdd(&(bar)[XB_TMO], 1u); break; } } } } while (0)
struct XcdBarrier { unsigned* bar; unsigned x; volatile LAS unsigned* st; };
__device__ __forceinline__ XcdBarrier xcd_barrier_post(unsigned* bar, volatile LAS unsigned* st) {
  XcdBarrier b; b.bar = bar; b.x = xb_xcc_id(); b.st = st;
  if (threadIdx.x == 0) st[2] = xb_add(&bar[XB_XCNT(b.x)], 1u);
  return b;
}
__device__ __forceinline__ void xcd_barrier_complete(unsigned* bar, unsigned x, unsigned& nloc, unsigned& nx) {
  const unsigned G = gridDim.x * gridDim.y * gridDim.z;
  unsigned sum, cnt, mine, sp = 0u;
  for (;;) {
    sum = 0u; cnt = 0u; mine = 0u;
#pragma unroll
    for (unsigned j = 0; j < 16; ++j) { const unsigned c = xb_ld(&bar[XB_XCNT(j)]); sum += c; cnt += (c > 0u) ? 1u : 0u; mine = (j == x) ? c : mine; }
    if (sum == G) break;
    __builtin_amdgcn_s_sleep(1);
    if ((++sp & 255u) == 0u) { if (xb_ld(&bar[XB_TMO])) break; if (sp > XB_SPIN_CAP) { atomicAdd(&bar[XB_TMO], 1u); break; } }
  }
  nloc = mine > 0u ? mine : 1u; nx = cnt > 0u ? cnt : 1u;
}
__device__ __forceinline__ void xcd_barrier(const XcdBarrier& b) {
  asm volatile("s_waitcnt vmcnt(0)" ::: "memory");
  __syncthreads();
  if (threadIdx.x == 0) {
    unsigned* bar = b.bar;
    __builtin_amdgcn_s_waitcnt(0);
    unsigned nloc = b.st[0], nx = b.st[1];
    if (nloc == 0u) { xcd_barrier_complete(bar, b.x, nloc, nx); b.st[0] = nloc; b.st[1] = nx; }
    const unsigned old = xb_add(&bar[XB_XSUB(b.x)], 1u);
    const unsigned gen = old / nloc;
    if (old + 1u == (gen + 1u) * nloc) {
      __builtin_amdgcn_fence(__ATOMIC_RELEASE, "agent");
      asm volatile("s_waitcnt vmcnt(0)" ::: "memory");
      const unsigned og = xb_add(&bar[XB_TOP], 1u);
      const unsigned tg = og / nx;
      if (og + 1u == (tg + 1u) * nx) xb_add(&bar[XB_TOPGEN], 1u);
      else XB_SPIN(xb_ld(&bar[XB_TOPGEN]) == tg, bar);
      __builtin_amdgcn_fence(__ATOMIC_ACQUIRE, "agent");
      xb_add(&bar[XB_XGEN(b.x)], 1u);
      asm volatile("s_waitcnt vmcnt(0)" ::: "memory");
    } else {
      XB_SPIN(xb_ld(&bar[XB_XGEN(b.x)]) == gen, bar);
      __builtin_amdgcn_fence(__ATOMIC_ACQUIRE, "agent");
      asm volatile("s_waitcnt vmcnt(0)" ::: "memory");
    }
  }
  __syncthreads();
}

__device__ __forceinline__ int xcd_virtual_id(const XcdBarrier& b) {
  if (threadIdx.x == 0) {
    unsigned base = 0u;
#pragma unroll
    for (unsigned j = 0; j < 16; ++j) { const unsigned c = xb_ld(&b.bar[XB_XCNT(j)]); base += (j < b.x) ? c : 0u; }
    b.st[3] = base + b.st[2];
  }
  __syncthreads();
  const int vb = __builtin_amdgcn_readfirstlane((int)b.st[3]);
  __syncthreads();
  return vb;
}

__device__ __forceinline__ void sub_barrier(unsigned* cnt, unsigned target) {
  asm volatile("s_waitcnt vmcnt(0)" ::: "memory");
  __syncthreads();
  if (threadIdx.x == 0) {
    __builtin_amdgcn_fence(__ATOMIC_RELEASE, "agent");
    asm volatile("s_waitcnt vmcnt(0)" ::: "memory");
    xb_add(cnt, 1u);
    unsigned sp = 0;
    while (xb_ld(cnt) < target) { __builtin_amdgcn_s_sleep(2); if (++sp > (1u << 24)) break; }
    __builtin_amdgcn_fence(__ATOMIC_ACQUIRE, "agent");
    asm volatile("s_waitcnt vmcnt(0)" ::: "memory");
  }
  __syncthreads();
}

#define N_PHASES 22
#ifndef PROBE_CONV_REPS
#define PROBE_CONV_REPS 1
#endif
#ifndef PROBE_PREP_REPS
#define PROBE_PREP_REPS 1
#endif
#ifndef PROBE_POST_REPS
#define PROBE_POST_REPS 1
#endif
#ifndef PROBE_SCAN_REPS
#define PROBE_SCAN_REPS 1
#endif
#ifndef PROBE_FFN1_REPS
#define PROBE_FFN1_REPS 1
#endif
#ifndef PH_MASK
#define PH_MASK 0xFFFFF
#endif
#define PHON(s) (PH_MASK & (1 << (s)))
#define PHASE_BEGIN(k) if (ph_hi > (k)) { if ((k) > 1) xcd_barrier(xb);
#define PHASE_END }

template <int L>
__device__ __forceinline__ void run_layer(const Params& p, int vbr, int ph_hi, unsigned char* smem_all, const XcdBarrier& xb) {
  unsigned char* smem = smem_all + SUBB * 73728;
  const int vb = vbr * 2 + SUBB;
  constexpr int l = L;
  constexpr int base = 1 + 10 * L;
  const float* modl = (const float*)(p.ws + OFF_MOD) + (size_t)l * 4 * 6144;
  PHASE_BEGIN(base + 0)
    for (int rep = 0; rep < PROBE_CONV_REPS; ++rep) {
      if (rep) xcd_barrier(xb);
      phase_convert(p, l, smem);
      phase_norm(l == 0 ? p.in[0] : p.out, p.in[4] + l * 1024, modl, 0, 1024, (u16*)(p.ws + OFF_H));
    }
  PHASE_END
  PHASE_BEGIN(base + 1)
    phase_pproj_tail(p, vbr, smem_all);
    phase_gemm_8w<0>(p, l, vbr, smem_all);
  PHASE_END
  PHASE_BEGIN(base + 2)
    for (int rep = 0; rep < PROBE_PREP_REPS; ++rep) {
      if (rep) xcd_barrier(xb);
      for (int item = VBLK; item < 512; item += VGRID) rwkv_prep_item(p, l, item, smem);
    }
  PHASE_END
  PHASE_BEGIN(base + 3)
    if ((int)blockIdx.x < 64) {
      if (SUBB == 0) scan_item(p, blockIdx.x, smem);
      else { __syncthreads(); __syncthreads(); for (int c = 0; c < SEQ / 16; ++c) lds_barrier(); }
    }
    else {
      const int nb = VGRID - 128, bi = VBLK - 128;
      for (int item = bi; item < 512; item += nb) sg_item(p, l, item, smem);
      for (int item = (bi + 64) % nb; item < 1024; item += nb) s5a_item(p, l, item, smem);
      for (int item = bi; item < 2048; item += nb) conv_item(p, l, item);
      sub_barrier((unsigned*)(p.ws + OFF_BAR) + 3520 + 64 * (2 * l), gridDim.x - 64);
      for (int item = bi; item < 1024; item += nb) s5b_item(p, l, item, smem);
      sub_barrier((unsigned*)(p.ws + OFF_BAR) + 3520 + 64 * (2 * l + 1), gridDim.x - 64);
      for (int item = (int)blockIdx.x - 64; item < 512; item += (int)gridDim.x - 64) merge_tile8<0>(p, item, smem_all);
    }
  PHASE_END
  PHASE_BEGIN(base + 4)
    for (int rep = 0; rep < PROBE_POST_REPS; ++rep) { if (rep) xcd_barrier(xb); for (int item = VBLK; item < 2048; item += VGRID) rwkv_post_item(p, l, item); }
  PHASE_END
  PHASE_BEGIN(base + 5)
    for (int item = vbr; item < 512; item += (int)gridDim.x) {
      int it2 = item;
      if (gridDim.x == 256) { const int r = item >> 8, w = vbr & 31; it2 = ((r * 4 + (w >> 3)) << 6) | ((vbr >> 5) * 8 + (w & 7)); }
      merge_tile8<1>(p, it2, smem_all);
    }
  PHASE_END
  PHASE_BEGIN(base + 6)
    phase_gemm_8w<1>(p, l, vbr, smem_all);
  PHASE_END
  PHASE_BEGIN(base + 7)
    if (PHON(7)) phase_norm(p.out, p.in[38] + l * 1024, modl, 3072, 4096, (u16*)(p.ws + OFF_H));
  PHASE_END
  PHASE_BEGIN(base + 8)
    phase_gemm_8w<2>(p, l, vbr, smem_all);
  PHASE_END
#ifdef PROBE_DUP_FFN1
  PHASE_BEGIN(base + 8)
    phase_gemm_8w<2>(p, l, vbr, smem_all);
  PHASE_END
#endif
  PHASE_BEGIN(base + 9)
    phase_gemm_8w<3>(p, l, vbr, smem_all);
  PHASE_END
}

__global__ void __launch_bounds__(512, 2) mega_fwd(Params p, int ph_lo, int ph_hi) {
  __shared__ __attribute__((aligned(16))) unsigned char smem[2 * 73728 + 16];
  cg::grid_group grid = cg::this_grid();
  if (ph_hi < 0) grid.sync();
  volatile LAS unsigned* st = (volatile LAS unsigned*)(smem + 2 * 73728);
  if (threadIdx.x == 0) { st[0] = 0u; st[1] = 0u; st[2] = 0u; st[3] = 0u; }
  __syncthreads();
  const XcdBarrier xb = xcd_barrier_post((unsigned*)(p.ws + OFF_BAR), st);
  if (ph_hi > 0) phase_mod(p, smem + SUBB * 73728);
  xcd_barrier(xb);
  const int vb = xcd_virtual_id(xb);
  run_layer<0>(p, vb, ph_hi, smem, xb);
  run_layer<1>(p, vb, ph_hi, smem, xb);
  PHASE_BEGIN(21)
    if (PHON(11)) phase_final(p.out, p.in[41]);
  PHASE_END
}

extern "C" void kernel_launch(void* const* d_in, const int* in_sizes, int n_in, void* d_out, int out_size, void* d_ws,
                              size_t ws_size, hipStream_t stream) {
  static int grid_blocks = 0;
  if (!grid_blocks) {
    int dev = 0, cus = 0, per_cu = 0;
    hipGetDevice(&dev);
    hipDeviceGetAttribute(&cus, hipDeviceAttributeMultiprocessorCount, dev);
    hipOccupancyMaxActiveBlocksPerMultiprocessor(&per_cu, mega_fwd, 512, 0);
    if (per_cu > 1) per_cu = 1;
    if (per_cu < 1) per_cu = 1;
    grid_blocks = cus * per_cu;
    if (ws_size < WS_END) fprintf(stderr, "workspace too small: %zu < %zu\n", ws_size, (size_t)WS_END);
  }
  Params p{};
  for (int i = 0; i < 42; ++i) p.in[i] = (const float*)d_in[i];
  p.out = (float*)d_out;
  p.ws = (unsigned char*)d_ws;
  hipMemsetAsync((unsigned char*)d_ws + OFF_BAR, 0, 16384, stream);
  int lo = 0, hi = N_PHASES;
  void* args[] = {&p, &lo, &hi};
  hipError_t e = hipLaunchCooperativeKernel((void*)mega_fwd, dim3(grid_blocks), dim3(512), args, 0, stream);
  if (e != hipSuccess) fprintf(stderr, "cooperative launch failed: %s (grid %d)\n", hipGetErrorString(e), grid_blocks);
}
```

```cpp
#include <hip/hip_runtime.h>
#include <hip/hip_cooperative_groups.h>
#include <cstdio>
namespace cg = cooperative_groups;

typedef unsigned short u16;
using bf16x8 = __attribute__((ext_vector_type(8))) short;
using f32x4 = __attribute__((ext_vector_type(4))) float;
using u32x4 = __attribute__((ext_vector_type(4))) unsigned int;
using u32x2 = __attribute__((ext_vector_type(2))) unsigned int;
using f32x2 = __attribute__((ext_vector_type(2))) float;

#define T_TOK 16384
#define SEQ 4096
#define DM 1024
#define NTHR 256
#define TIDX ((int)(threadIdx.x & 255))
#define SUBB ((int)(threadIdx.x >> 8))
#define VBLK ((int)(blockIdx.x * 2 + (threadIdx.x >> 8)))
#define VGRID ((int)(gridDim.x * 2))

static constexpr size_t SZ_WIN = (size_t)6528 * 1024 * 2;
static constexpr size_t OFF_WIN = 0;
static constexpr size_t OFF_RO = OFF_WIN + SZ_WIN;
static constexpr size_t OFF_SO = OFF_RO + 1024 * 256 * 2;
static constexpr size_t OFF_CO = OFF_SO + 1024 * 256 * 2;
static constexpr size_t OFF_GLU = OFF_CO + 1024 * 256 * 2;
static constexpr size_t OFF_WO = OFF_GLU + 2048 * 256 * 2;
static constexpr size_t OFF_W1 = OFF_WO + 1024 * 1024 * 2;
static constexpr size_t OFF_W2 = OFF_W1 + (size_t)4096 * 1024 * 2;
static constexpr size_t OFF_H = OFF_W2 + (size_t)4096 * 1024 * 2;
static constexpr size_t SZ_T256B = (size_t)T_TOK * 256 * 2;
static constexpr size_t OFF_VF = OFF_H + (size_t)T_TOK * 1024 * 2;
static constexpr size_t OFF_PD = OFF_VF + SZ_T256B;
static constexpr size_t OFF_G = OFF_PD + SZ_T256B;
static constexpr size_t OFF_UB = OFF_G + SZ_T256B;
static constexpr size_t OFF_CB = OFF_UB + SZ_T256B;
static constexpr size_t OFF_SR = OFF_CB + SZ_T256B;
static constexpr size_t OFF_SK = OFF_SR + SZ_T256B;
static constexpr size_t OFF_SV = OFF_SK + SZ_T256B;
static constexpr size_t OFF_SKK = OFF_SV + SZ_T256B;
static constexpr size_t OFF_SA = OFF_SKK + SZ_T256B;
static constexpr size_t OFF_SW = OFF_SA + SZ_T256B;
static constexpr size_t OFF_PABC = OFF_SW + 2 * SZ_T256B;
static constexpr size_t OFF_YD = OFF_PABC;
static constexpr size_t OFF_OG = OFF_YD + SZ_T256B;
static constexpr size_t OFF_MRG = OFF_OG + SZ_T256B;
static constexpr size_t OFF_F = OFF_UB;
static constexpr size_t OFF_SMALL = OFF_PABC + (size_t)T_TOK * 2176 * 2;
static constexpr size_t OFF_MOD = OFF_SMALL;
static constexpr size_t OFF_S5AB = OFF_MOD + 2 * 4 * 6144 * 4;
static constexpr size_t OFF_S5BB = OFF_S5AB + 2 * 16 * 64 * 2 * 4;
static constexpr size_t OFF_S5E = OFF_S5BB + 2 * 16 * 64 * 32 * 4;
static constexpr size_t OFF_BAR = OFF_S5E + (size_t)4 * 64 * 16 * 64 * 2 * 4;
static constexpr size_t OFF_SGW = OFF_BAR + 16384;
static constexpr size_t OFF_O = OFF_SGW + 4 * 128 * 128 * 2;
static constexpr size_t OFF_LW2 = OFF_O + 2 * SZ_T256B;
static constexpr size_t OFF_LA2 = OFF_LW2 + 256 * 32 * 2;
static constexpr size_t OFF_LG2 = OFF_LA2 + 256 * 32 * 2;
static constexpr size_t OFF_LV2 = OFF_LG2 + 256 * 64 * 2;
static constexpr size_t OFF_LV1 = OFF_LV2 + 256 * 32 * 2;
static constexpr size_t OFF_SGST = OFF_LV1 + 32 * 256 * 2;
static constexpr size_t WS_END = OFF_SGST + (size_t)T_TOK * 2 * 4;
static_assert(OFF_F + (size_t)T_TOK * 4096 * 2 <= OFF_SMALL, "F overlaps small region");
static_assert(OFF_MRG + (size_t)T_TOK * 1024 * 2 <= OFF_SMALL, "MRG overlaps");

struct Params {
  const float* in[42];
  float* out;
  unsigned char* ws;
};

__device__ __forceinline__ u16 f2bf(float f) {
  unsigned u = __float_as_uint(f);
  u += 0x7fffu + ((u >> 16) & 1u);
  return (u16)(u >> 16);
}
__device__ __forceinline__ float bf2f(u16 h) { return __uint_as_float(((unsigned)h) << 16); }
__device__ __forceinline__ float bflo(unsigned u) { return __uint_as_float(u << 16); }
__device__ __forceinline__ float bfhi(unsigned u) { return __uint_as_float(u & 0xffff0000u); }
__device__ __forceinline__ unsigned pack2(float a, float b) { return (unsigned)f2bf(a) | ((unsigned)f2bf(b) << 16); }
__device__ __forceinline__ float sigmoidf_(float x) { return 1.f / (1.f + __expf(-x)); }
__device__ __forceinline__ float tanhf_(float y) { return 1.f - 2.f / (1.f + __expf(2.f * y)); }
__device__ __forceinline__ float geluf_(float x) {
  float y = 0.7978845608028654f * (x + 0.044715f * x * x * x);
  return 0.5f * x * (1.f + tanhf_(y));
}
__device__ __forceinline__ float wave_sum(float v) {
#pragma unroll
  for (int o = 32; o > 0; o >>= 1) v += __shfl_xor(v, o, 64);
  return v;
}
template <int CTRL>
__device__ __forceinline__ float dppf(float x) {
  return __int_as_float(__builtin_amdgcn_update_dpp(__float_as_int(x), __float_as_int(x), CTRL, 0xF, 0xF, true));
}
__device__ __forceinline__ float row_sum16(float x) {
  x += dppf<0x128>(x);
  x += dppf<0x124>(x);
  x += dppf<0x122>(x);
  x += dppf<0x121>(x);
  return x;
}

__device__ __forceinline__ void phase_mod(const Params& p, unsigned char* smem) {
  const int tid = TIDX;
  float* cact = (float*)smem;
  float* red = cact + 4096;
  float* mod = (float*)(p.ws + OFF_MOD);
  for (int i = tid; i < 4096; i += NTHR) { float c = p.in[1][i]; cact[i] = c / (1.f + __expf(-c)); }
  __syncthreads();
  for (int item = VBLK; item < 192; item += VGRID) {
    int l = item / 96, nb = item % 96;
    int cl = tid & 63, kq = tid >> 6;
    int col = nb * 64 + cl;
    const float* W = p.in[2] + (size_t)l * 1024 * 6144;
    float a0 = 0, a1 = 0, a2 = 0, a3 = 0;
    for (int k = kq * 256; k < kq * 256 + 256; ++k) {
      float w = W[(size_t)k * 6144 + col];
      a0 += cact[k] * w; a1 += cact[1024 + k] * w; a2 += cact[2048 + k] * w; a3 += cact[3072 + k] * w;
    }
    red[(kq * 4 + 0) * 64 + cl] = a0; red[(kq * 4 + 1) * 64 + cl] = a1;
    red[(kq * 4 + 2) * 64 + cl] = a2; red[(kq * 4 + 3) * 64 + cl] = a3;
    __syncthreads();
    {
      int b = tid >> 6;
      float s = red[(0 * 4 + b) * 64 + cl] + red[(1 * 4 + b) * 64 + cl] + red[(2 * 4 + b) * 64 + cl] + red[(3 * 4 + b) * 64 + cl];
      mod[((size_t)l * 4 + b) * 6144 + col] = s + p.in[3][l * 6144 + col];
    }
    __syncthreads();
  }
  float* s5ab = (float*)(p.ws + OFF_S5AB);
  float* s5bb = (float*)(p.ws + OFF_S5BB);
  for (int idx = VBLK * NTHR + tid; idx < 2048; idx += VGRID * NTHR) {
    int l = idx >> 10, g = (idx >> 6) & 15, n = idx & 63;
    double lre = fmin((double)p.in[28][idx], -1e-4);
    double lim = (double)p.in[29][idx];
    double dt = exp((double)p.in[35][l * 16 + g]);
    double mag = exp(lre * dt);
    double abr = mag * cos(lim * dt), abi = mag * sin(lim * dt);
    double den = lre * lre + lim * lim;
    double qr = ((abr - 1.0) * lre + abi * lim) / den;
    double qi = (abi * lre - (abr - 1.0) * lim) / den;
    s5ab[idx * 2 + 0] = (float)abr; s5ab[idx * 2 + 1] = (float)abi;
    for (int c = 0; c < 16; ++c) {
      double br = p.in[30][(size_t)idx * 16 + c], bi = p.in[31][(size_t)idx * 16 + c];
      s5bb[(size_t)idx * 32 + c] = (float)(qr * br - qi * bi);
      s5bb[(size_t)idx * 32 + 16 + c] = (float)(qr * bi + qi * br);
    }
  }
}

__device__ __forceinline__ void convert_tile(const float* __restrict__ src, int K, int N, u16* __restrict__ dst, int tk, int tn, u16* sm) {
  const int tid = TIDX;
  int r = tid >> 4, c4 = (tid & 15) * 4;
#pragma unroll
  for (int i = 0; i < 4; ++i) {
    int kk = r + 16 * i;
    float4 v = *(const float4*)(src + (size_t)(tk * 64 + kk) * N + tn * 64 + c4);
    sm[(c4 + 0) * 72 + kk] = f2bf(v.x);
    sm[(c4 + 1) * 72 + kk] = f2bf(v.y);
    sm[(c4 + 2) * 72 + kk] = f2bf(v.z);
    sm[(c4 + 3) * 72 + kk] = f2bf(v.w);
  }
  __syncthreads();
#pragma unroll
  for (int j = 0; j < 2; ++j) {
    int n = (tid >> 3) + 32 * j, ch = tid & 7;
    u32x4 v = *(const u32x4*)(sm + n * 72 + ch * 8);
    *(u32x4*)(dst + (size_t)(tn * 64 + n) * K + tk * 64 + ch * 8) = v;
  }
  __syncthreads();
}

__device__ __forceinline__ void phase_convert(const Params& p, int l, unsigned char* smem) {
  u16* sm = (u16*)smem;
  const int total = 1632 + 192 + 128 + 256 + 1024 + 1024;
  for (int item = VBLK; item < total + 16 + 192; item += VGRID) {
    int t = item;
    if (t >= total + 16) {
      const int e = (t - total - 16) * 256 + TIDX;
      if (e < 8192) { const int n = e >> 5, k = e & 31; ((u16*)(p.ws + OFF_LW2))[e] = f2bf(p.in[8][(size_t)l * 8192 + k * 256 + n]); }
      else if (e < 16384) { const int q = e - 8192, n = q >> 5, k = q & 31; ((u16*)(p.ws + OFF_LA2))[q] = f2bf(p.in[10][(size_t)l * 8192 + k * 256 + n]); }
      else if (e < 32768) { const int q = e - 16384, n = q >> 6, k = q & 63; ((u16*)(p.ws + OFF_LG2))[q] = f2bf(p.in[11][(size_t)l * 16384 + k * 256 + n]); }
      else if (e < 40960) { const int q = e - 32768, n = q >> 5, k = q & 31; ((u16*)(p.ws + OFF_LV2))[q] = (l > 0) ? f2bf(p.in[14][k * 256 + n]) : (u16)0; }
      else { const int q = e - 40960, n = q >> 8, k = q & 255; ((u16*)(p.ws + OFF_LV1))[q] = (l > 0) ? f2bf(p.in[13][k * 32 + n]) : (u16)0; }
      continue;
    }
    if (t >= total) {
      const int idx = t - total, g = idx >> 2, rq = idx & 3;
      const int tr = rq * 32 + (TIDX >> 3), s0 = (TIDX & 7) * 16;
      const float* src = p.in[23] + (((size_t)l * 4 + g) * 128 + tr) * 128 + s0;
      u16* dst = (u16*)(p.ws + OFF_SGW) + ((size_t)g * 128 + tr) * 128 + s0;
      unsigned pk[8];
#pragma unroll
      for (int e = 0; e < 4; ++e) {
        f32x4 v = *(const f32x4*)(src + e * 4);
        const int sb = s0 + e * 4;
        pk[e * 2 + 0] = pack2(sb + 0 <= tr ? v.x : 0.f, sb + 1 <= tr ? v.y : 0.f);
        pk[e * 2 + 1] = pack2(sb + 2 <= tr ? v.z : 0.f, sb + 3 <= tr ? v.w : 0.f);
      }
      *(u32x4*)(dst) = u32x4{pk[0], pk[1], pk[2], pk[3]};
      *(u32x4*)(dst + 8) = u32x4{pk[4], pk[5], pk[6], pk[7]};
      continue;
    }
    const float* src; int K, N; size_t off;
    if (t < 1632) { src = p.in[5] + (size_t)l * 1024 * 6528; K = 1024; N = 6528; off = OFF_WIN; }
    else if ((t -= 1632) < 64) { src = p.in[20] + (size_t)l * 256 * 1024; K = 256; N = 1024; off = OFF_RO; }
    else if ((t -= 64) < 64) { src = p.in[25] + (size_t)l * 256 * 1024; K = 256; N = 1024; off = OFF_SO; }
    else if ((t -= 64) < 64) { src = p.in[27] + (size_t)l * 256 * 1024; K = 256; N = 1024; off = OFF_CO; }
    else if ((t -= 64) < 128) { src = p.in[36] + (size_t)l * 256 * 2048; K = 256; N = 2048; off = OFF_GLU; }
    else if ((t -= 128) < 256) { src = p.in[37] + (size_t)l * 1024 * 1024; K = 1024; N = 1024; off = OFF_WO; }
    else if ((t -= 256) < 1024) { src = p.in[39] + (size_t)l * 1024 * 4096; K = 1024; N = 4096; off = OFF_W1; }
    else { t -= 1024; src = p.in[40] + (size_t)l * 4096 * 1024; K = 4096; N = 1024; off = OFF_W2; }
    int ntn = N / 64;
    convert_tile(src, K, N, (u16*)(p.ws + off), t / ntn, t % ntn, sm);
  }
}

__device__ __forceinline__ void phase_norm(const float* __restrict__ X, const float* __restrict__ g, const float* __restrict__ modl,
                           int sh_off, int sc_off, u16* __restrict__ H) {
  const int lane = TIDX & 63, wv = TIDX >> 6;
  for (int item = VBLK; item < T_TOK / 4; item += VGRID) {
    int row = item * 4 + wv;
    int b = row >> 12;
    const float* xr = X + (size_t)row * 1024;
    float4 v[4];
    float ss = 0;
#pragma unroll
    for (int i = 0; i < 4; ++i) {
      v[i] = *(const float4*)(xr + lane * 4 + 256 * i);
      ss += v[i].x * v[i].x + v[i].y * v[i].y + v[i].z * v[i].z + v[i].w * v[i].w;
    }
    ss = wave_sum(ss);
    float rstd = rsqrtf(ss * (1.f / 1024.f) + 1e-6f);
    const float* sh = modl + (size_t)b * 6144 + sh_off;
    const float* sc = modl + (size_t)b * 6144 + sc_off;
#pragma unroll
    for (int i = 0; i < 4; ++i) {
      int c = lane * 4 + 256 * i;
      float4 gg = *(const float4*)(g + c);
      float4 s1 = *(const float4*)(sc + c);
      float4 s0 = *(const float4*)(sh + c);
      float h0 = v[i].x * rstd * gg.x * (1.f + s1.x) + s0.x;
      float h1 = v[i].y * rstd * gg.y * (1.f + s1.y) + s0.y;
      float h2 = v[i].z * rstd * gg.z * (1.f + s1.z) + s0.z;
      float h3 = v[i].w * rstd * gg.w * (1.f + s1.w) + s0.w;
      u32x2 o; o.x = pack2(h0, h1); o.y = pack2(h2, h3);
      *(u32x2*)(H + (size_t)row * 1024 + c) = o;
    }
  }
}

__device__ __forceinline__ void phase_final(float* __restrict__ X, const float* __restrict__ g) {
  const int lane = TIDX & 63, wv = TIDX >> 6;
  for (int item = VBLK; item < T_TOK / 4; item += VGRID) {
    int row = item * 4 + wv;
    float* xr = X + (size_t)row * 1024;
    float4 v[4];
    float ss = 0;
#pragma unroll
    for (int i = 0; i < 4; ++i) {
      v[i] = *(const float4*)(xr + lane * 4 + 256 * i);
      ss += v[i].x * v[i].x + v[i].y * v[i].y + v[i].z * v[i].z + v[i].w * v[i].w;
    }
    ss = wave_sum(ss);
    float rstd = rsqrtf(ss * (1.f / 1024.f) + 1e-6f);
#pragma unroll
    for (int i = 0; i < 4; ++i) {
      int c = lane * 4 + 256 * i;
      float4 gg = *(const float4*)(g + c);
      float4 o;
      o.x = v[i].x * rstd * gg.x; o.y = v[i].y * rstd * gg.y; o.z = v[i].z * rstd * gg.z; o.w = v[i].w * rstd * gg.w;
      *(float4*)(xr + c) = o;
    }
  }
}

template <int NF, bool LEAN = false>
__device__ __forceinline__ void gemm_mainloop(const u16* __restrict__ A, int lda, const u16* __restrict__ B, int ldb,
                                              int K, f32x4 (&acc)[4][NF], u16* smem) {
  constexpr int BN = 32 * NF;
  constexpr int NB = BN / 32;
  u16* sA = smem;
  u16* sB = smem + 2 * 128 * 64;
  int tz = 0;
  if (LEAN) asm volatile("" : "+v"(tz));
  const int tid = TIDX + tz, lane = tid & 63, wv = tid >> 6;
  const int wm = wv >> 1, wn = wv & 1;
  const int lrow = tid >> 3;
  const int lchs = (tid & 7) ^ ((lrow >> 1) & 7);
  const u16* Ap = A + (size_t)lrow * lda + lchs * 8;
  const u16* Bp = B + (size_t)lrow * ldb + lchs * 8;
  const int nk = K >> 6;
  auto stage = [&](int kt, int buf) {
    const int ko = kt << 6;
#pragma unroll
    for (int i = 0; i < 4; ++i)
      __builtin_amdgcn_global_load_lds((const unsigned*)(Ap + (size_t)(32 * i) * lda + ko),
                                       (__attribute__((address_space(3))) unsigned*)(sA + buf * (128 * 64) + (tid + 256 * i) * 8), 16, 0, 0);
#pragma unroll
    for (int i = 0; i < NB; ++i)
      __builtin_amdgcn_global_load_lds((const unsigned*)(Bp + (size_t)(32 * i) * ldb + ko),
                                       (__attribute__((address_space(3))) unsigned*)(sB + buf * (BN * 64) + (tid + 256 * i) * 8), 16, 0, 0);
  };
  __syncthreads();
  stage(0, 0);
  const int fr = lane & 15, fq = lane >> 4;
  const int sw = (fr >> 1) & 7;
  for (int kt = 0; kt < nk; ++kt) {
    const int cur = kt & 1;
    asm volatile("s_waitcnt vmcnt(0)" ::: "memory");
    __syncthreads();
    if (kt + 1 < nk) stage(kt + 1, cur ^ 1);
    const u16* cA = sA + cur * (128 * 64) + (wm * 64 + fr) * 64;
    const u16* cB = sB + cur * (BN * 64) + (wn * 16 * NF + fr) * 64;
#pragma unroll
    for (int ks = 0; ks < 2; ++ks) {
      if (LEAN) __builtin_amdgcn_sched_barrier(0);
      const int pc = ((fq + 4 * ks) ^ sw) << 3;
      bf16x8 fa[4], fb[NF];
#pragma unroll
      for (int i = 0; i < 4; ++i) fa[i] = *(const bf16x8*)(cA + i * 16 * 64 + pc);
#pragma unroll
      for (int j = 0; j < NF; ++j) fb[j] = *(const bf16x8*)(cB + j * 16 * 64 + pc);
#pragma unroll
      for (int i = 0; i < 4; ++i)
#pragma unroll
        for (int j = 0; j < NF; ++j)
          acc[i][j] = __builtin_amdgcn_mfma_f32_16x16x32_bf16(fb[j], fa[i], acc[i][j], 0, 0, 0);
    }
  }
}

template <int NF>
__device__ __forceinline__ void zero_acc(f32x4 (&acc)[4][NF]) {
#pragma unroll
  for (int i = 0; i < 4; ++i)
#pragma unroll
    for (int j = 0; j < NF; ++j) acc[i][j] = f32x4{0.f, 0.f, 0.f, 0.f};
}

__device__ __forceinline__ void gemm_mainloop_8w(const u16* __restrict__ A, int lda, const u16* __restrict__ B, int ldb,
                                                 int K, f32x4 (&acc)[8][4], u16* smem) {
  constexpr int STG = 32768;
  const int tid = threadIdx.x, lane = tid & 63, wv = tid >> 6;
  const int wm = wv >> 2, wn = wv & 3;
  const int lrow = tid >> 3;
  const int lchs = (tid & 7) ^ ((lrow >> 1) & 7);
  const u16* Ap = A + (size_t)lrow * lda + lchs * 8;
  const u16* Bp = B + (size_t)lrow * ldb + lchs * 8;
  const int nk = K >> 6;
  auto stage = [&](int kt, int buf) {
    const int ko = kt << 6;
    u16* sa = smem + buf * STG;
#pragma unroll
    for (int i = 0; i < 4; ++i)
      __builtin_amdgcn_global_load_lds((const unsigned*)(Ap + (size_t)(64 * i) * lda + ko),
                                       (__attribute__((address_space(3))) unsigned*)(sa + (tid + 512 * i) * 8), 16, 0, 0);
#pragma unroll
    for (int i = 0; i < 4; ++i)
      __builtin_amdgcn_global_load_lds((const unsigned*)(Bp + (size_t)(64 * i) * ldb + ko),
                                       (__attribute__((address_space(3))) unsigned*)(sa + 16384 + (tid + 512 * i) * 8), 16, 0, 0);
  };
  __syncthreads();
  stage(0, 0);
  const int fr = lane & 15, fq = lane >> 4;
  const int sw = (fr >> 1) & 7;
  for (int kt = 0; kt < nk; ++kt) {
    const int cur = kt & 1;
    asm volatile("s_waitcnt vmcnt(0)" ::: "memory");
    __syncthreads();
    if (kt + 1 < nk) stage(kt + 1, cur ^ 1);
    const u16* cA = smem + cur * STG + (wm * 128 + fr) * 64;
    const u16* cB = smem + cur * STG + 16384 + (wn * 64 + fr) * 64;
#pragma unroll
    for (int ks = 0; ks < 2; ++ks) {
      const int pc = ((fq + 4 * ks) ^ sw) << 3;
      bf16x8 fa[8], fb[4];
#pragma unroll
      for (int i = 0; i < 8; ++i) fa[i] = *(const bf16x8*)(cA + i * 16 * 64 + pc);
#pragma unroll
      for (int j = 0; j < 4; ++j) fb[j] = *(const bf16x8*)(cB + j * 16 * 64 + pc);
#pragma unroll
      for (int i = 0; i < 8; ++i)
#pragma unroll
        for (int j = 0; j < 4; ++j)
          acc[i][j] = __builtin_amdgcn_mfma_f32_16x16x32_bf16(fb[j], fa[i], acc[i][j], 0, 0, 0);
    }
  }
}

template <int EPI>
__device__ __forceinline__ void phase_gemm_8w(const Params& p, int l, int vb, unsigned char* smem_raw) {
  u16* smem = (u16*)smem_raw;
  const int lane = threadIdx.x & 63, wv = threadIdx.x >> 6;
  const int wm = wv >> 2, wn = wv & 3;
  const int fr = lane & 15, fq = lane >> 4;
  const u16* A; const u16* B; int lda, ldb, K, ntiles_n;
  if (EPI == 0) { A = (const u16*)(p.ws + OFF_H); lda = 1024; B = (const u16*)(p.ws + OFF_WIN); ldb = 1024; K = 1024; ntiles_n = 8; }
  if (EPI == 1) { A = (const u16*)(p.ws + OFF_MRG); lda = 1024; B = (const u16*)(p.ws + OFF_WO); ldb = 1024; K = 1024; ntiles_n = 4; }
  if (EPI == 2) { A = (const u16*)(p.ws + OFF_H); lda = 1024; B = (const u16*)(p.ws + OFF_W1); ldb = 1024; K = 1024; ntiles_n = 16; }
  if (EPI == 3) { A = (const u16*)(p.ws + OFF_F); lda = 4096; B = (const u16*)(p.ws + OFF_W2); ldb = 4096; K = 4096; ntiles_n = 4; }
  const float* modl = (const float*)(p.ws + OFF_MOD) + (size_t)l * 4 * 6144;
  const int total = 64 * ntiles_n;
  const int G = gridDim.x;
  const bool swz = (G == 256);
  for (int item = vb; item < total; item += G) {
    int mt = item & 63, nt = item >> 6;
    if (swz) { const int r = item >> 8, w = vb & 31; mt = (vb >> 5) * 8 + (w & 7); nt = r * 4 + (w >> 3); }
    const int m0 = mt * 256, n0 = nt * 256;
    f32x4 acc[8][4];
#pragma unroll
    for (int i = 0; i < 8; ++i)
#pragma unroll
      for (int j = 0; j < 4; ++j) acc[i][j] = f32x4{0.f, 0.f, 0.f, 0.f};
    gemm_mainloop_8w(A + (size_t)m0 * lda, lda, B + (size_t)n0 * ldb, ldb, K, acc, smem);
#pragma unroll
    for (int i = 0; i < 8; ++i) {
      const int m = m0 + wm * 128 + i * 16 + fr;
#pragma unroll
      for (int j = 0; j < 4; ++j) {
        const int n = n0 + wn * 64 + j * 16 + fq * 4;
        f32x4 v = acc[i][j];
        if (EPI == 0) {
          *(u32x2*)((u16*)(p.ws + OFF_PABC) + (size_t)m * 2176 + n) = u32x2{pack2(v[0], v[1]), pack2(v[2], v[3])};
        } else if (EPI == 1 || EPI == 3) {
          const int b = m >> 12;
          const float* gt = modl + (size_t)b * 6144 + (EPI == 1 ? 2048 : 5120) + n;
          const float* xin = ((EPI == 1 && l == 0) ? p.in[0] : p.out) + (size_t)m * 1024 + n;
          f32x4 x = *(const f32x4*)xin;
          f32x4 gg = *(const f32x4*)gt;
          *(f32x4*)(p.out + (size_t)m * 1024 + n) = x + gg * v;
        } else {
          float r0 = fmaxf(v[0], 0.f), r1 = fmaxf(v[1], 0.f), r2 = fmaxf(v[2], 0.f), r3 = fmaxf(v[3], 0.f);
          *(u32x2*)((u16*)(p.ws + OFF_F) + (size_t)m * 4096 + n) = u32x2{pack2(r0 * r0, r1 * r1), pack2(r2 * r2, r3 * r3)};
        }
      }
    }
  }
}

template <int EPI>
__device__ __forceinline__ void phase_gemm(const Params& p, int l, int vb, unsigned char* smem_raw) {
  u16* smem = (u16*)smem_raw;
  const int lane = TIDX & 63, wv = TIDX >> 6;
  const int wm = wv >> 1, wn = wv & 1;
  const int fr = lane & 15, fq = lane >> 4;
  const u16* A; const u16* B; int lda, ldb, K, ntiles_n;
  if (EPI == 0) { A = (const u16*)(p.ws + OFF_H); lda = 1024; B = (const u16*)(p.ws + OFF_WIN); ldb = 1024; K = 1024; ntiles_n = 19; }
  if (EPI == 1) { A = (const u16*)(p.ws + OFF_MRG); lda = 1024; B = (const u16*)(p.ws + OFF_WO); ldb = 1024; K = 1024; ntiles_n = 8; }
  if (EPI == 2) { A = (const u16*)(p.ws + OFF_H); lda = 1024; B = (const u16*)(p.ws + OFF_W1); ldb = 1024; K = 1024; ntiles_n = 32; }
  if (EPI == 3) { A = (const u16*)(p.ws + OFF_F); lda = 4096; B = (const u16*)(p.ws + OFF_W2); ldb = 4096; K = 4096; ntiles_n = 8; }
  const float* modl = (const float*)(p.ws + OFF_MOD) + (size_t)l * 4 * 6144;
  const int G = VGRID;
  const bool swz = (G == 512);
  const int total = swz ? 128 * ((ntiles_n + 3) & ~3) : 128 * ntiles_n;
  for (int item = vb; item < total; item += G) {
    int mt = item & 127, nt = item >> 7;
    if (swz) { const int r = item >> 9, w = vb & 63; mt = (vb >> 6) * 16 + (w & 15); nt = r * 4 + (w >> 4); if (nt >= ntiles_n) continue; }
    const int m0 = mt * 128, n0 = nt * 128;
    f32x4 acc[4][4];
    zero_acc<4>(acc);
    gemm_mainloop<4>(A + (size_t)m0 * lda, lda, B + (size_t)n0 * ldb, ldb, K, acc, smem);
#pragma unroll
    for (int i = 0; i < 4; ++i) {
      const int m = m0 + wm * 64 + i * 16 + fr;
#pragma unroll
      for (int j = 0; j < 4; ++j) {
        const int n = n0 + wn * 64 + j * 16 + fq * 4;
        f32x4 v = acc[i][j];
        if (EPI == 0) {
          u32x2 o; o.x = pack2(v[0], v[1]); o.y = pack2(v[2], v[3]);
          if (n < 2176) *(u32x2*)((u16*)(p.ws + OFF_PABC) + (size_t)m * 2176 + n) = o;
          else *(u32x2*)((u16*)(p.ws + OFF_PD) + (size_t)m * 256 + (n - 2176)) = o;
        } else if (EPI == 1 || EPI == 3) {
          const int b = m >> 12;
          const float* gt = modl + (size_t)b * 6144 + (EPI == 1 ? 2048 : 5120) + n;
          const float* xin = ((EPI == 1 && l == 0) ? p.in[0] : p.out) + (size_t)m * 1024 + n;
          float4 x = *(const float4*)xin;
          float4 gg = *(const float4*)gt;
          float4 o;
          o.x = x.x + gg.x * v[0]; o.y = x.y + gg.y * v[1]; o.z = x.z + gg.z * v[2]; o.w = x.w + gg.w * v[3];
          *(float4*)(p.out + (size_t)m * 1024 + n) = o;
        } else {
          float r0 = fmaxf(v[0], 0.f), r1 = fmaxf(v[1], 0.f), r2 = fmaxf(v[2], 0.f), r3 = fmaxf(v[3], 0.f);
          u32x2 o; o.x = pack2(r0 * r0, r1 * r1); o.y = pack2(r2 * r2, r3 * r3);
          *(u32x2*)((u16*)(p.ws + OFF_F) + (size_t)m * 4096 + n) = o;
        }
      }
    }
  }
}

template <int MODE>
__device__ __forceinline__ void merge_tile(const Params& p, int item, unsigned char* smem_raw) {
  u16* smem = (u16*)smem_raw;
  const int lane = TIDX & 63, wv = TIDX >> 6;
  const int wm = wv >> 1, wn = wv & 1;
  const int fr = lane & 15, fq = lane >> 4;
  const u16* H = (const u16*)(p.ws + OFF_H);
  const u16* WIN = (const u16*)(p.ws + OFF_WIN);
  const int mt = item & 127, nt = item >> 7;
  const int m0 = mt * 128, n0 = nt * 128;
  f32x4 bacc[4][4];
  u32x2 gpk[4][4];
  u16* MRG = (u16*)(p.ws + OFF_MRG);
#pragma unroll 1
  for (int br = (MODE == 0 ? 1 : 0); br < (MODE == 0 ? 4 : 1); ++br) {
    zero_acc<4>(bacc);
    gemm_mainloop<4, true>(H + (size_t)m0 * 1024, 1024, WIN + (size_t)(2432 + br * 1024 + n0) * 1024, 1024, 1024, bacc, smem);
#pragma unroll
    for (int i = 0; i < 4; ++i)
#pragma unroll
      for (int j = 0; j < 4; ++j)
        gpk[i][j] = u32x2{pack2(sigmoidf_(bacc[i][j][0]), sigmoidf_(bacc[i][j][1])), pack2(sigmoidf_(bacc[i][j][2]), sigmoidf_(bacc[i][j][3]))};
    const u16* Ab; const u16* Wb;
    if (br == 0) { Ab = (const u16*)(p.ws + OFF_OG); Wb = (const u16*)(p.ws + OFF_RO); }
    else if (br == 1) { Ab = (const u16*)(p.ws + OFF_UB); Wb = (const u16*)(p.ws + OFF_SO); }
    else if (br == 2) { Ab = (const u16*)(p.ws + OFF_CB); Wb = (const u16*)(p.ws + OFF_CO); }
    else { Ab = (const u16*)(p.ws + OFF_YD); Wb = (const u16*)(p.ws + OFF_GLU); }
    if (MODE == 0 && br == 3) {
      zero_acc<4>(bacc);
      gemm_mainloop<4, true>(Ab + (size_t)m0 * 256, 256, Wb + (size_t)(1024 + n0) * 256, 256, 256, bacc, smem);
#pragma unroll
      for (int i = 0; i < 4; ++i)
#pragma unroll
        for (int j = 0; j < 4; ++j) {
          const float g0 = bflo(gpk[i][j].x) * sigmoidf_(bacc[i][j][0]), g1 = bfhi(gpk[i][j].x) * sigmoidf_(bacc[i][j][1]);
          const float g2 = bflo(gpk[i][j].y) * sigmoidf_(bacc[i][j][2]), g3 = bfhi(gpk[i][j].y) * sigmoidf_(bacc[i][j][3]);
          gpk[i][j] = u32x2{pack2(g0, g1), pack2(g2, g3)};
        }
    }
    zero_acc<4>(bacc);
    gemm_mainloop<4, true>(Ab + (size_t)m0 * 256, 256, Wb + (size_t)n0 * 256, 256, 256, bacc, smem);
#pragma unroll
    for (int i = 0; i < 4; ++i)
#pragma unroll
      for (int j = 0; j < 4; ++j) {
        u32x2* mp = (u32x2*)(MRG + (size_t)(m0 + wm * 64 + i * 16 + fr) * 1024 + n0 + wn * 64 + j * 16 + fq * 4);
        u32x2 cm = u32x2{0u, 0u};
        if (MODE == 1 || br > 1) cm = *mp;
        const float v0 = bflo(cm.x) + bflo(gpk[i][j].x) * bacc[i][j][0];
        const float v1 = bfhi(cm.x) + bfhi(gpk[i][j].x) * bacc[i][j][1];
        const float v2 = bflo(cm.y) + bflo(gpk[i][j].y) * bacc[i][j][2];
        const float v3 = bfhi(cm.y) + bfhi(gpk[i][j].y) * bacc[i][j][3];
        *mp = u32x2{pack2(v0, v1), pack2(v2, v3)};
      }
  }
}

__device__ __forceinline__ void gemm_mainloop_8n(const u16* __restrict__ A, int lda, const u16* __restrict__ B, int ldb,
                                                 int K, f32x4 (&acc)[4][4], u16* smem) {
  constexpr int STG = 24576;
  int tz = 0;
  asm volatile("" : "+v"(tz));
  const int tid = threadIdx.x + tz, lane = tid & 63, wv = tid >> 6;
  const int wm = wv >> 1, wn = wv & 1;
  const int lrow = tid >> 3;
  const int lchs = (tid & 7) ^ ((lrow >> 1) & 7);
  const u16* Ap = A + (size_t)lrow * lda + lchs * 8;
  const u16* Bp = B + (size_t)lrow * ldb + lchs * 8;
  const int nk = K >> 6;
  auto stage = [&](int kt, int buf) {
    const int ko = kt << 6;
    u16* sa = smem + buf * STG;
#pragma unroll
    for (int i = 0; i < 4; ++i)
      __builtin_amdgcn_global_load_lds((const unsigned*)(Ap + (size_t)(64 * i) * lda + ko),
                                       (__attribute__((address_space(3))) unsigned*)(sa + (tid + 512 * i) * 8), 16, 0, 0);
#pragma unroll
    for (int i = 0; i < 2; ++i)
      __builtin_amdgcn_global_load_lds((const unsigned*)(Bp + (size_t)(64 * i) * ldb + ko),
                                       (__attribute__((address_space(3))) unsigned*)(sa + 16384 + (tid + 512 * i) * 8), 16, 0, 0);
  };
  __syncthreads();
  stage(0, 0);
  stage(nk > 1 ? 1 : 0, 1);
  const int fr = lane & 15, fq = lane >> 4;
  const int sw = (fr >> 1) & 7;
  int cur = 0;
  for (int kt = 0; kt < nk; ++kt) {
    asm volatile("s_waitcnt vmcnt(6)" ::: "memory");
    __builtin_amdgcn_s_barrier();
    asm volatile("" ::: "memory");
    {
      int nx = cur + 2; if (nx >= 3) nx -= 3;
      int ktn = kt + 2; if (ktn >= nk) ktn = nk - 1;
      stage(ktn, nx);
    }
    const u16* cA = smem + cur * STG + (wm * 64 + fr) * 64;
    const u16* cB = smem + cur * STG + 16384 + (wn * 64 + fr) * 64;
#pragma unroll
    for (int ks = 0; ks < 2; ++ks) {
      const int pc = ((fq + 4 * ks) ^ sw) << 3;
      bf16x8 fa[4], fb[4];
#pragma unroll
      for (int i = 0; i < 4; ++i) fa[i] = *(const bf16x8*)(cA + i * 16 * 64 + pc);
#pragma unroll
      for (int j = 0; j < 4; ++j) fb[j] = *(const bf16x8*)(cB + j * 16 * 64 + pc);
#pragma unroll
      for (int i = 0; i < 4; ++i)
#pragma unroll
        for (int j = 0; j < 4; ++j)
          acc[i][j] = __builtin_amdgcn_mfma_f32_16x16x32_bf16(fb[j], fa[i], acc[i][j], 0, 0, 0);
    }
    cur = cur + 1; if (cur >= 3) cur = 0;
  }
  asm volatile("s_waitcnt vmcnt(0)" ::: "memory");
}

template <int MODE>
__device__ __forceinline__ void merge_tile8(const Params& p, int item, unsigned char* smem_raw) {
  u16* smem = (u16*)smem_raw;
  const int lane = threadIdx.x & 63, wv = threadIdx.x >> 6;
  const int wm = wv >> 1, wn = wv & 1;
  const int fr = lane & 15, fq = lane >> 4;
  const u16* H = (const u16*)(p.ws + OFF_H);
  const u16* WIN = (const u16*)(p.ws + OFF_WIN);
  const int mt = item & 63, nt = item >> 6;
  const int m0 = mt * 256, n0 = nt * 128;
  f32x4 bacc[4][4];
  u32x2 gpk[4][4];
  u16* MRG = (u16*)(p.ws + OFF_MRG);
#pragma unroll 1
  for (int br = (MODE == 0 ? 1 : 0); br < (MODE == 0 ? 4 : 1); ++br) {
    zero_acc<4>(bacc);
    gemm_mainloop_8n(H + (size_t)m0 * 1024, 1024, WIN + (size_t)(2432 + br * 1024 + n0) * 1024, 1024, 1024, bacc, smem);
#pragma unroll
    for (int i = 0; i < 4; ++i)
#pragma unroll
      for (int j = 0; j < 4; ++j)
        gpk[i][j] = u32x2{pack2(sigmoidf_(bacc[i][j][0]), sigmoidf_(bacc[i][j][1])), pack2(sigmoidf_(bacc[i][j][2]), sigmoidf_(bacc[i][j][3]))};
    const u16* Ab; const u16* Wb;
    if (br == 0) { Ab = (const u16*)(p.ws + OFF_OG); Wb = (const u16*)(p.ws + OFF_RO); }
    else if (br == 1) { Ab = (const u16*)(p.ws + OFF_UB); Wb = (const u16*)(p.ws + OFF_SO); }
    else if (br == 2) { Ab = (const u16*)(p.ws + OFF_CB); Wb = (const u16*)(p.ws + OFF_CO); }
    else { Ab = (const u16*)(p.ws + OFF_YD); Wb = (const u16*)(p.ws + OFF_GLU); }
    if (MODE == 0 && br == 3) {
      zero_acc<4>(bacc);
      gemm_mainloop_8n(Ab + (size_t)m0 * 256, 256, Wb + (size_t)(1024 + n0) * 256, 256, 256, bacc, smem);
#pragma unroll
      for (int i = 0; i < 4; ++i)
#pragma unroll
        for (int j = 0; j < 4; ++j) {
          const float g0 = bflo(gpk[i][j].x) * sigmoidf_(bacc[i][j][0]), g1 = bfhi(gpk[i][j].x) * sigmoidf_(bacc[i][j][1]);
          const float g2 = bflo(gpk[i][j].y) * sigmoidf_(bacc[i][j][2]), g3 = bfhi(gpk[i][j].y) * sigmoidf_(bacc[i][j][3]);
          gpk[i][j] = u32x2{pack2(g0, g1), pack2(g2, g3)};
        }
    }
    zero_acc<4>(bacc);
    gemm_mainloop_8n(Ab + (size_t)m0 * 256, 256, Wb + (size_t)n0 * 256, 256, 256, bacc, smem);
#pragma unroll
    for (int i = 0; i < 4; ++i)
#pragma unroll
      for (int j = 0; j < 4; ++j) {
        u32x2* mp = (u32x2*)(MRG + (size_t)(m0 + wm * 64 + i * 16 + fr) * 1024 + n0 + wn * 64 + j * 16 + fq * 4);
        u32x2 cm = u32x2{0u, 0u};
        if (MODE == 1 || br > 1) cm = *mp;
        const float v0 = bflo(cm.x) + bflo(gpk[i][j].x) * bacc[i][j][0];
        const float v1 = bfhi(cm.x) + bfhi(gpk[i][j].x) * bacc[i][j][1];
        const float v2 = bflo(cm.y) + bflo(gpk[i][j].y) * bacc[i][j][2];
        const float v3 = bfhi(cm.y) + bfhi(gpk[i][j].y) * bacc[i][j][3];
        *mp = u32x2{pack2(v0, v1), pack2(v2, v3)};
      }
  }
}

__device__ __forceinline__ void phase_pproj_tail(const Params& p, int vb, unsigned char* smem_raw) {
  u16* smem = (u16*)smem_raw;
  const int lane = threadIdx.x & 63, wv = threadIdx.x >> 6;
  const int wm = wv >> 1, wn = wv & 1;
  const int fr = lane & 15, fq = lane >> 4;
  const u16* A = (const u16*)(p.ws + OFF_H);
  const u16* B = (const u16*)(p.ws + OFF_WIN);
  const int G = gridDim.x;
  const int total = (G == 256) ? 256 : 192;
  for (int item = vb; item < total; item += G) {
    int mt = item & 63, nt = item >> 6;
    if (G == 256) { const int w = vb & 31; mt = (vb >> 5) * 8 + (w & 7); nt = w >> 3; if (nt >= 3) continue; }
    const int m0 = mt * 256, n0 = 2048 + nt * 128;
    f32x4 acc[4][4];
    zero_acc<4>(acc);
    gemm_mainloop_8n(A + (size_t)m0 * 1024, 1024, B + (size_t)n0 * 1024, 1024, 1024, acc, smem);
#pragma unroll
    for (int i = 0; i < 4; ++i) {
      const int m = m0 + wm * 64 + i * 16 + fr;
#pragma unroll
      for (int j = 0; j < 4; ++j) {
        const int n = n0 + wn * 64 + j * 16 + fq * 4;
        const f32x4 v = acc[i][j];
        const u32x2 o = u32x2{pack2(v[0], v[1]), pack2(v[2], v[3])};
        if (n < 2176) *(u32x2*)((u16*)(p.ws + OFF_PABC) + (size_t)m * 2176 + n) = o;
        else *(u32x2*)((u16*)(p.ws + OFF_PD) + (size_t)m * 256 + (n - 2176)) = o;
      }
    }
  }
}

__device__ __forceinline__ float shifted(const u16* __restrict__ P, int tok, int col, float mu) {
  float pv = bf2f(P[(size_t)tok * 2176 + col]);
  float pr = (tok & (SEQ - 1)) ? bf2f(P[(size_t)(tok - 1) * 2176 + col]) : 0.f;
  return pv + (pr - pv) * mu;
}

__device__ __forceinline__ void rwkv_prep_item(const Params& p, int l, int item, unsigned char* smem) {
  const int tid = TIDX, lane = tid & 63, wv = tid >> 6;
  const int fr = lane & 15, fq = lane >> 4;
  u16* sl = (u16*)smem;
  u16* sv = sl + 32 * 168;
  constexpr int SLS = 168, SVS = 264;
  const u16* P = (const u16*)(p.ws + OFF_PABC);
  const float* mu = p.in[6] + l * 896;
  const int tok0 = item * 32;
  {
    const int t = tid >> 3, c0 = (tid & 7) * 32;
    const u16* src = P + (size_t)(tok0 + t) * 2176 + 896 + 256 + c0;
    float sm = 0.f, ss = 0.f;
#pragma unroll
    for (int q = 0; q < 4; ++q) {
      const u32x4 raw = *(const u32x4*)(src + q * 8);
      float z;
      z = geluf_(bflo(raw.x)); sm += z; ss += z * z;  z = geluf_(bfhi(raw.x)); sm += z; ss += z * z;
      z = geluf_(bflo(raw.y)); sm += z; ss += z * z;  z = geluf_(bfhi(raw.y)); sm += z; ss += z * z;
      z = geluf_(bflo(raw.z)); sm += z; ss += z * z;  z = geluf_(bfhi(raw.z)); sm += z; ss += z * z;
      z = geluf_(bflo(raw.w)); sm += z; ss += z * z;  z = geluf_(bfhi(raw.w)); sm += z; ss += z * z;
    }
    sm += __shfl_xor(sm, 1, 64); ss += __shfl_xor(ss, 1, 64);
    sm += __shfl_xor(sm, 2, 64); ss += __shfl_xor(ss, 2, 64);
    sm += __shfl_xor(sm, 4, 64); ss += __shfl_xor(ss, 4, 64);
    const float mean = sm * (1.f / 256.f);
    const float var = fmaxf(ss * (1.f / 256.f) - mean * mean, 0.f);
    if ((tid & 7) == 0) *(f32x2*)((float*)(p.ws + OFF_SGST) + (size_t)(tok0 + t) * 2) = f32x2{mean, rsqrtf(var + 1e-5f)};
  }
  for (int idx = tid; idx < 32 * 128; idx += NTHR) {
    const int t = idx >> 7, ci = idx & 127;
    float v = shifted(P, tok0 + t, 768 + ci, mu[768 + ci]);
    if (ci < 32) v = tanhf_(v);
    else if (ci >= 64) v = sigmoidf_(v);
    sl[t * SLS + ci] = f2bf(v);
  }
  if (l > 0) {
    const int t = tid >> 3, c0 = (tid & 7) * 32;
    const int tok = tok0 + t;
    const bool hasp = (tok & (SEQ - 1)) != 0;
#pragma unroll
    for (int q = 0; q < 4; ++q) {
      const int c = c0 + q * 8;
      const u32x4 cur = *(const u32x4*)(P + (size_t)tok * 2176 + 512 + c);
      u32x4 prv = u32x4{0u, 0u, 0u, 0u};
      if (hasp) prv = *(const u32x4*)(P + (size_t)(tok - 1) * 2176 + 512 + c);
      const f32x4 m0 = *(const f32x4*)(mu + 512 + c), m1 = *(const f32x4*)(mu + 512 + c + 4);
      float o[8];
      o[0] = bflo(cur.x) + (bflo(prv.x) - bflo(cur.x)) * m0.x; o[1] = bfhi(cur.x) + (bfhi(prv.x) - bfhi(cur.x)) * m0.y;
      o[2] = bflo(cur.y) + (bflo(prv.y) - bflo(cur.y)) * m0.z; o[3] = bfhi(cur.y) + (bfhi(prv.y) - bfhi(cur.y)) * m0.w;
      o[4] = bflo(cur.z) + (bflo(prv.z) - bflo(cur.z)) * m1.x; o[5] = bfhi(cur.z) + (bfhi(prv.z) - bfhi(cur.z)) * m1.y;
      o[6] = bflo(cur.w) + (bflo(prv.w) - bflo(cur.w)) * m1.z; o[7] = bfhi(cur.w) + (bfhi(prv.w) - bfhi(cur.w)) * m1.w;
      *(u32x4*)(sv + t * SVS + c) = u32x4{pack2(o[0], o[1]), pack2(o[2], o[3]), pack2(o[4], o[5]), pack2(o[6], o[7])};
    }
  }
  __syncthreads();
  if (l > 0) {
    const int mf = wv >> 1, nf = wv & 1;
    const u16* v1t = (const u16*)(p.ws + OFF_LV1);
    f32x4 acc = f32x4{0.f, 0.f, 0.f, 0.f};
#pragma unroll
    for (int ks = 0; ks < 8; ++ks) {
      const bf16x8 fa = *(const bf16x8*)(sv + (mf * 16 + fr) * SVS + ks * 32 + fq * 8);
      const bf16x8 fb = *(const bf16x8*)(v1t + (size_t)(nf * 16 + fr) * 256 + ks * 32 + fq * 8);
      acc = __builtin_amdgcn_mfma_f32_16x16x32_bf16(fb, fa, acc, 0, 0, 0);
    }
    *(u32x2*)(sl + (mf * 16 + fr) * SLS + 128 + nf * 16 + fq * 4) = u32x2{pack2(acc[0], acc[1]), pack2(acc[2], acc[3])};
    __syncthreads();
  }
  const u16* w2t = (const u16*)(p.ws + OFF_LW2); const u16* a2t = (const u16*)(p.ws + OFF_LA2);
  const u16* g2t = (const u16*)(p.ws + OFF_LG2); const u16* v2t = (const u16*)(p.ws + OFF_LV2);
  u16* SR = (u16*)(p.ws + OFF_SR); u16* SK = (u16*)(p.ws + OFF_SK); u16* SV = (u16*)(p.ws + OFF_SV);
  u16* SKK = (u16*)(p.ws + OFF_SKK); u16* SA = (u16*)(p.ws + OFF_SA); float* SW = (float*)(p.ws + OFF_SW);
  u16* G = (u16*)(p.ws + OFF_G); u16* VF = (u16*)(p.ws + OFF_VF);
#pragma unroll 1
  for (int mf = 0; mf < 2; ++mf) {
    const u16* arow = sl + (mf * 16 + fr) * SLS + fq * 8;
    const bf16x8 aw = *(const bf16x8*)(arow), aa = *(const bf16x8*)(arow + 32);
    const bf16x8 ag0 = *(const bf16x8*)(arow + 64), ag1 = *(const bf16x8*)(arow + 96), av = *(const bf16x8*)(arow + 128);
    f32x4 cw[4], ca[4], cg[4], cv[4];
#pragma unroll
    for (int nf = 0; nf < 4; ++nf) {
      const int n = wv * 64 + nf * 16 + fr;
      const f32x4 z = f32x4{0.f, 0.f, 0.f, 0.f};
      cw[nf] = __builtin_amdgcn_mfma_f32_16x16x32_bf16(*(const bf16x8*)(w2t + n * 32 + fq * 8), aw, z, 0, 0, 0);
      ca[nf] = __builtin_amdgcn_mfma_f32_16x16x32_bf16(*(const bf16x8*)(a2t + n * 32 + fq * 8), aa, z, 0, 0, 0);
      cg[nf] = __builtin_amdgcn_mfma_f32_16x16x32_bf16(*(const bf16x8*)(g2t + n * 64 + fq * 8), ag0, z, 0, 0, 0);
      cg[nf] = __builtin_amdgcn_mfma_f32_16x16x32_bf16(*(const bf16x8*)(g2t + n * 64 + 32 + fq * 8), ag1, cg[nf], 0, 0, 0);
      cv[nf] = z;
      if (l > 0) cv[nf] = __builtin_amdgcn_mfma_f32_16x16x32_bf16(*(const bf16x8*)(v2t + n * 32 + fq * 8), av, z, 0, 0, 0);
    }
    const int tok = tok0 + mf * 16 + fr;
    const bool hasp = (tok & (SEQ - 1)) != 0;
    float kkv[4][4], kmv[4][4], av4[4][4];
    float ss = 0.f;
#pragma unroll
    for (int nf = 0; nf < 4; ++nf) {
      const int c = wv * 64 + nf * 16 + fq * 4;
      const size_t o = (size_t)tok * 256 + c;
      const u16* pc = P + (size_t)tok * 2176 + c;
      const u32x2 r_c = *(const u32x2*)(pc), k_c = *(const u32x2*)(pc + 256), v_c = *(const u32x2*)(pc + 512);
      u32x2 r_p = u32x2{0u, 0u}, k_p = u32x2{0u, 0u}, v_p = u32x2{0u, 0u};
      if (hasp) { r_p = *(const u32x2*)(pc - 2176); k_p = *(const u32x2*)(pc - 2176 + 256); v_p = *(const u32x2*)(pc - 2176 + 512); }
      const f32x4 mur = *(const f32x4*)(mu + c), muk = *(const f32x4*)(mu + 256 + c), muv = *(const f32x4*)(mu + 512 + c);
      const f32x4 w0 = *(const f32x4*)(p.in[7] + l * 256 + c), a0 = *(const f32x4*)(p.in[9] + l * 256 + c);
      const f32x4 kkc = *(const f32x4*)(p.in[15] + l * 256 + c), kac = *(const f32x4*)(p.in[16] + l * 256 + c);
      f32x4 v0 = f32x4{0.f, 0.f, 0.f, 0.f};
      if (l > 0) v0 = *(const f32x4*)(p.in[12] + c);
      u32x2 vfraw = u32x2{0u, 0u};
      if (l > 0) vfraw = *(const u32x2*)(VF + o);
      float rr[4], kk_[4], vv[4], dec[4], gg[4];
#pragma unroll
      for (int e = 0; e < 4; ++e) {
        const unsigned rc = e < 2 ? r_c.x : r_c.y, rp = e < 2 ? r_p.x : r_p.y;
        const unsigned kc = e < 2 ? k_c.x : k_c.y, kp = e < 2 ? k_p.x : k_p.y;
        const unsigned vc = e < 2 ? v_c.x : v_c.y, vp = e < 2 ? v_p.x : v_p.y;
        const unsigned vfr = e < 2 ? vfraw.x : vfraw.y;
        const float rcf = (e & 1) ? bfhi(rc) : bflo(rc), rpf = (e & 1) ? bfhi(rp) : bflo(rp);
        const float kcf = (e & 1) ? bfhi(kc) : bflo(kc), kpf = (e & 1) ? bfhi(kp) : bflo(kp);
        const float vcf = (e & 1) ? bfhi(vc) : bflo(vc), vpf = (e & 1) ? bfhi(vp) : bflo(vp);
        const float r = rcf + (rpf - rcf) * mur[e];
        const float k = kcf + (kpf - kcf) * muk[e];
        float v = vcf + (vpf - vcf) * muv[e];
        const float wl = w0[e] + cw[nf][e];
        const float z = -wl;
        const float sp = (z > 15.f) ? z : __logf(1.f + __expf(z));
        dec[e] = __expf(-__expf(-sp - 0.5f));
        const float a = sigmoidf_(a0[e] + ca[nf][e]);
        gg[e] = cg[nf][e];
        if (l > 0) { const float vf = (e & 1) ? bfhi(vfr) : bflo(vfr); v = v + (vf - v) * sigmoidf_(v0[e] + cv[nf][e]); }
        const float kk = k * kkc[e];
        ss += kk * kk;
        rr[e] = r; vv[e] = v; kk_[e] = kk; kkv[nf][e] = kk;
        kmv[nf][e] = k * (1.f + (a - 1.f) * kac[e]); av4[nf][e] = a;
      }
      *(u32x2*)(SR + o) = u32x2{pack2(rr[0], rr[1]), pack2(rr[2], rr[3])};
      *(u32x2*)(SV + o) = u32x2{pack2(vv[0], vv[1]), pack2(vv[2], vv[3])};
      if (l == 0) *(u32x2*)(VF + o) = u32x2{pack2(vv[0], vv[1]), pack2(vv[2], vv[3])};
      *(u32x2*)(G + o) = u32x2{pack2(gg[0], gg[1]), pack2(gg[2], gg[3])};
      *(f32x4*)(SW + o) = f32x4{dec[0], dec[1], dec[2], dec[3]};
    }
    ss += __shfl_xor(ss, 16, 64);
    ss += __shfl_xor(ss, 32, 64);
    const float inv = 1.f / fmaxf(sqrtf(ss), 1e-12f);
#pragma unroll
    for (int nf = 0; nf < 4; ++nf) {
      const size_t o = (size_t)tok * 256 + wv * 64 + nf * 16 + fq * 4;
      *(u32x2*)(SKK + o) = u32x2{pack2(kkv[nf][0] * inv, kkv[nf][1] * inv), pack2(kkv[nf][2] * inv, kkv[nf][3] * inv)};
      *(u32x2*)(SK + o) = u32x2{pack2(kmv[nf][0], kmv[nf][1]), pack2(kmv[nf][2], kmv[nf][3])};
      *(u32x2*)(SA + o) = u32x2{pack2(av4[nf][0], av4[nf][1]), pack2(av4[nf][2], av4[nf][3])};
    }
  }
  __syncthreads();
}

__device__ __forceinline__ void sg_item(const Params& p, int l, int item, unsigned char* smem) {
  const int tid = TIDX, lane = tid & 63, wv = tid >> 6;
  u16* vsT = (u16*)smem;
  float* smu = (float*)(smem + 16384);
  float* srs = smu + 128;
  const u16* P = (const u16*)(p.ws + OFF_PABC);
  const int g = item & 3, chn = item >> 2;
  const int tok0 = chn * 128;
  if (tid < 128) {
    const f32x2 ms = *(const f32x2*)((const float*)(p.ws + OFF_SGST) + (size_t)(tok0 + tid) * 2);
    smu[tid] = ms.x; srs[tid] = ms.y;
  }
  __syncthreads();
  {
    const int c = tid & 63, tb = tid >> 6;
    const float lw = p.in[21][l * 256 + g * 64 + c], lb = p.in[22][l * 256 + g * 64 + c];
#pragma unroll
    for (int j = 0; j < 4; ++j) {
      u16 raw[8];
#pragma unroll
      for (int e = 0; e < 8; ++e) raw[e] = P[(size_t)(tok0 + tb * 32 + j * 8 + e) * 2176 + 896 + 256 + g * 64 + c];
      float vv[8];
#pragma unroll
      for (int e = 0; e < 8; ++e) {
        const int t = tb * 32 + j * 8 + e;
        vv[e] = (geluf_(bf2f(raw[e])) - smu[t]) * srs[t] * lw + lb;
      }
      const int phys = (tb * 4 + j) ^ (c & 15);
      *(u32x4*)(vsT + c * 128 + phys * 8) = u32x4{pack2(vv[0], vv[1]), pack2(vv[2], vv[3]), pack2(vv[4], vv[5]), pack2(vv[6], vv[7])};
    }
  }
  __syncthreads();
  {
    const int fr = lane & 15, fq = lane >> 4;
    const u16* Wm = (const u16*)(p.ws + OFF_SGW) + (size_t)g * 128 * 128;
    f32x4 acc[2][4];
#pragma unroll
    for (int i = 0; i < 2; ++i)
#pragma unroll
      for (int j = 0; j < 4; ++j) acc[i][j] = f32x4{0.f, 0.f, 0.f, 0.f};
    for (int ks = 0; ks <= wv; ++ks) {
      bf16x8 fa[2], fb[4];
#pragma unroll
      for (int i = 0; i < 2; ++i) fa[i] = *(const bf16x8*)(Wm + (size_t)(32 * wv + 16 * i + fr) * 128 + ks * 32 + fq * 8);
#pragma unroll
      for (int j = 0; j < 4; ++j) fb[j] = *(const bf16x8*)(vsT + (j * 16 + fr) * 128 + (((ks * 4 + fq) ^ fr) << 3));
#pragma unroll
      for (int i = 0; i < 2; ++i)
#pragma unroll
        for (int j = 0; j < 4; ++j) acc[i][j] = __builtin_amdgcn_mfma_f32_16x16x32_bf16(fb[j], fa[i], acc[i][j], 0, 0, 0);
    }
    const float* bs = p.in[24] + ((size_t)l * 4 + g) * 128;
    u16* UB = (u16*)(p.ws + OFF_UB);
#pragma unroll
    for (int i = 0; i < 2; ++i) {
      const int t = 32 * wv + 16 * i + fr;
      const float bsv = bs[t];
#pragma unroll
      for (int j = 0; j < 4; ++j) {
        const int cc = j * 16 + fq * 4;
        u32x2 ur = *(const u32x2*)(P + (size_t)(tok0 + t) * 2176 + 896 + g * 64 + cc);
        float o0 = geluf_(bflo(ur.x)) * (acc[i][j][0] + bsv), o1 = geluf_(bfhi(ur.x)) * (acc[i][j][1] + bsv);
        float o2 = geluf_(bflo(ur.y)) * (acc[i][j][2] + bsv), o3 = geluf_(bfhi(ur.y)) * (acc[i][j][3] + bsv);
        *(u32x2*)(UB + (size_t)(tok0 + t) * 256 + g * 64 + cc) = u32x2{pack2(o0, o1), pack2(o2, o3)};
      }
    }
  }
  __syncthreads();
}

__device__ __forceinline__ void conv_item(const Params& p, int l, int item) {
  const int j = TIDX;
  const u16* P = (const u16*)(p.ws + OFF_PABC);
  u16* CB = (u16*)(p.ws + OFF_CB);
  const float c0 = p.in[26][(l * 3 + 0) * 256 + j], c1 = p.in[26][(l * 3 + 1) * 256 + j], c2 = p.in[26][(l * 3 + 2) * 256 + j];
  const int tok0 = item * 8;
  u16 rc[10], rx[10], rb[8];
  const bool first = (tok0 & (SEQ - 1)) == 0;
#pragma unroll
  for (int t = 0; t < 10; ++t) {
    const int tok = (first && t < 2) ? tok0 : tok0 + t - 2;
    const u16* q = P + (size_t)tok * 2176 + 1408;
    rc[t] = q[256 + j]; rx[t] = q[512 + j];
    if (t >= 2) rb[t - 2] = q[j];
  }
  float z[10];
#pragma unroll
  for (int t = 0; t < 10; ++t) z[t] = bf2f(rc[t]) * bf2f(rx[t]);
  if (first) { z[0] = 0.f; z[1] = 0.f; }
#pragma unroll
  for (int t = 0; t < 8; ++t) {
    float y = c0 * z[t] + c1 * z[t + 1] + c2 * z[t + 2];
    CB[(size_t)(tok0 + t) * 256 + j] = f2bf(bf2f(rb[t]) * y);
  }
}

__device__ __forceinline__ void s5_load_u(const u16* us, int t, int wv, float (&u)[16]) {
  const u32x4* q = (const u32x4*)(us + t * 64 + wv * 16);
  u32x4 a = q[0], b = q[1];
  u[0] = bflo(a.x); u[1] = bfhi(a.x); u[2] = bflo(a.y); u[3] = bfhi(a.y);
  u[4] = bflo(a.z); u[5] = bfhi(a.z); u[6] = bflo(a.w); u[7] = bfhi(a.w);
  u[8] = bflo(b.x); u[9] = bfhi(b.x); u[10] = bflo(b.y); u[11] = bfhi(b.y);
  u[12] = bflo(b.z); u[13] = bfhi(b.z); u[14] = bflo(b.w); u[15] = bfhi(b.w);
}
__device__ __forceinline__ void s5_stage_u(const u16* __restrict__ PD, int tok0, int gq, u16* us) {
#pragma unroll
  for (int i = 0; i < 2; ++i) {
    const int ch = TIDX + 256 * i;
    const int t = ch >> 3, part = ch & 7;
    *(u32x4*)(us + t * 64 + part * 8) = *(const u32x4*)(PD + (size_t)(tok0 + t) * 256 + gq * 64 + part * 8);
  }
}

__device__ __forceinline__ void s5a_item(const Params& p, int l, int item, unsigned char* smem) {
  const int lane = TIDX & 63, wv = TIDX >> 6;
  const int gq = item & 3, bc = item >> 2;
  const int g = gq * 4 + wv;
  const int tok0 = bc * 64;
  const u16* PD = (const u16*)(p.ws + OFF_PD);
  const float* ab = (const float*)(p.ws + OFF_S5AB) + ((size_t)(l * 16 + g) * 64 + lane) * 2;
  const float* bb = (const float*)(p.ws + OFF_S5BB) + ((size_t)(l * 16 + g) * 64 + lane) * 32;
  float bbr[16], bbi[16];
#pragma unroll
  for (int c = 0; c < 16; ++c) { bbr[c] = bb[c]; bbi[c] = bb[16 + c]; }
  const float abr = ab[0], abi = ab[1];
  float xr = 0.f, xi = 0.f;
  u16* us = (u16*)smem;
  s5_stage_u(PD, tok0, gq, us);
  __syncthreads();
#pragma unroll 4
  for (int t = 0; t < 64; ++t) {
    float u[16];
    s5_load_u(us, t, wv, u);
    float bur = 0.f, bui = 0.f;
#pragma unroll
    for (int c = 0; c < 16; ++c) { bur += bbr[c] * u[c]; bui += bbi[c] * u[c]; }
    float nr = abr * xr - abi * xi + bur;
    float ni = abr * xi + abi * xr + bui;
    xr = nr; xi = ni;
  }
  float2* E = (float2*)(p.ws + OFF_S5E);
  E[((size_t)bc * 16 + g) * 64 + lane] = make_float2(xr, xi);
  __syncthreads();
}

__device__ __forceinline__ void s5b_item(const Params& p, int l, int item, unsigned char* smem) {
  const int lane = TIDX & 63, wv = TIDX >> 6;
  const int gq = item & 3, bc = item >> 2;
  const int b = bc >> 6, ch = bc & 63;
  const int g = gq * 4 + wv;
  const int tok0 = bc * 64;
  u16* us = (u16*)(smem + 65536);
  s5_stage_u((const u16*)(p.ws + OFF_PD), tok0, gq, us);
  float* base = (float*)smem + wv * 4096;
  float* csr = base, *csi = base + 1024, *xsr = base + 2048, *xsi = base + 3072;
  const u16* PD = (const u16*)(p.ws + OFF_PD);
  const float* ab = (const float*)(p.ws + OFF_S5AB) + ((size_t)(l * 16 + g) * 64 + lane) * 2;
  const float* bb = (const float*)(p.ws + OFF_S5BB) + ((size_t)(l * 16 + g) * 64 + lane) * 32;
  const float* cre = p.in[32] + ((size_t)(l * 16 + g) * 16) * 64;
  const float* cim = p.in[33] + ((size_t)(l * 16 + g) * 16) * 64;
  for (int c = 0; c < 16; ++c) {
    csr[(lane >> 2) * 64 + c * 4 + (lane & 3)] = cre[c * 64 + lane];
    csi[(lane >> 2) * 64 + c * 4 + (lane & 3)] = cim[c * 64 + lane];
  }
  float bbr[16], bbi[16];
#pragma unroll
  for (int c = 0; c < 16; ++c) { bbr[c] = bb[c]; bbi[c] = bb[16 + c]; }
  const float abr = ab[0], abi = ab[1];
  float pr = abr, pi = abi;
#pragma unroll
  for (int s = 0; s < 6; ++s) { float nr = pr * pr - pi * pi, ni = 2.f * pr * pi; pr = nr; pi = ni; }
  float xr = 0.f, xi = 0.f;
  const float2* E = (const float2*)(p.ws + OFF_S5E);
  {
    const f32x2* Ev = (const f32x2*)E + ((size_t)(b * 64) * 16 + g) * 64 + lane;
    int c = 0;
    for (; c + 8 <= ch; c += 8) {
      f32x2 e[8];
#pragma unroll
      for (int k = 0; k < 8; ++k) e[k] = Ev[(size_t)(c + k) * 1024];
#pragma unroll
      for (int k = 0; k < 8; ++k) {
        const float nr = pr * xr - pi * xi + e[k].x;
        const float ni = pr * xi + pi * xr + e[k].y;
        xr = nr; xi = ni;
      }
    }
    for (; c < ch; ++c) {
      const f32x2 e = Ev[(size_t)c * 1024];
      const float nr = pr * xr - pi * xi + e.x;
      const float ni = pr * xi + pi * xr + e.y;
      xr = nr; xi = ni;
    }
  }
  const int tt = lane & 15, cq = lane >> 4;
  const float* dvec = p.in[34] + l * 256 + g * 16 + cq * 4;
  const float d0 = dvec[0], d1 = dvec[1], d2 = dvec[2], d3 = dvec[3];
  u16* YD = (u16*)(p.ws + OFF_YD);
  const int n4w = lane >> 2, e4 = lane & 3;
  __syncthreads();
#pragma unroll 1
  for (int sc = 0; sc < 4; ++sc) {
    for (int t = 0; t < 16; ++t) {
      float u[16];
      s5_load_u(us, sc * 16 + t, wv, u);
      float bur = 0.f, bui = 0.f;
#pragma unroll
      for (int c = 0; c < 16; ++c) { bur += bbr[c] * u[c]; bui += bbi[c] * u[c]; }
      float nr = abr * xr - abi * xi + bur;
      float ni = abr * xi + abi * xr + bui;
      xr = nr; xi = ni;
      int a = n4w * 64 + ((t ^ (n4w & 7)) << 2) + e4;
      xsr[a] = xr; xsi[a] = xi;
    }
    __syncthreads();
    float acc0 = 0.f, acc1 = 0.f, acc2 = 0.f, acc3 = 0.f;
#pragma unroll 2
    for (int n4 = 0; n4 < 16; ++n4) {
      int xa = n4 * 64 + ((tt ^ (n4 & 7)) << 2);
      float4 xr4 = *(const float4*)(xsr + xa);
      float4 xi4 = *(const float4*)(xsi + xa);
      const float* cr = csr + n4 * 64 + cq * 16;
      const float* ci = csi + n4 * 64 + cq * 16;
      float4 r0 = *(const float4*)(cr), r1 = *(const float4*)(cr + 4), r2 = *(const float4*)(cr + 8), r3 = *(const float4*)(cr + 12);
      float4 i0 = *(const float4*)(ci), i1 = *(const float4*)(ci + 4), i2 = *(const float4*)(ci + 8), i3 = *(const float4*)(ci + 12);
      acc0 += r0.x * xr4.x + r0.y * xr4.y + r0.z * xr4.z + r0.w * xr4.w - (i0.x * xi4.x + i0.y * xi4.y + i0.z * xi4.z + i0.w * xi4.w);
      acc1 += r1.x * xr4.x + r1.y * xr4.y + r1.z * xr4.z + r1.w * xr4.w - (i1.x * xi4.x + i1.y * xi4.y + i1.z * xi4.z + i1.w * xi4.w);
      acc2 += r2.x * xr4.x + r2.y * xr4.y + r2.z * xr4.z + r2.w * xr4.w - (i2.x * xi4.x + i2.y * xi4.y + i2.z * xi4.z + i2.w * xi4.w);
      acc3 += r3.x * xr4.x + r3.y * xr4.y + r3.z * xr4.z + r3.w * xr4.w - (i3.x * xi4.x + i3.y * xi4.y + i3.z * xi4.z + i3.w * xi4.w);
    }
    {
      const int tok = tok0 + sc * 16 + tt;
      u32x2 ur = *(const u32x2*)(us + (sc * 16 + tt) * 64 + wv * 16 + cq * 4);
      float y0 = acc0 + d0 * bflo(ur.x), y1 = acc1 + d1 * bfhi(ur.x), y2 = acc2 + d2 * bflo(ur.y), y3 = acc3 + d3 * bfhi(ur.y);
      u32x2 o; o.x = pack2(geluf_(y0), geluf_(y1)); o.y = pack2(geluf_(y2), geluf_(y3));
      *(u32x2*)(YD + (size_t)tok * 256 + g * 16 + cq * 4) = o;
    }
    __syncthreads();
  }
}

__device__ __forceinline__ void lds_barrier() {
  asm volatile("s_waitcnt lgkmcnt(0)" ::: "memory");
  __builtin_amdgcn_s_barrier();
  asm volatile("" ::: "memory");
}
__device__ __forceinline__ void scan_item(const Params& p, int item, unsigned char* smem) {
  const int tid = TIDX, lane = tid & 63, wv = tid >> 6;
  const int b = item >> 4, h = (item >> 2) & 3, q = item & 3;
  const int rl = lane >> 4, cl = lane & 15;
  const int rloc = wv * 4 + rl;
  const size_t tokb = (size_t)b * SEQ;
  const int chan0 = h * 64;
  const u16* SR = (const u16*)(p.ws + OFF_SR); const u16* SK = (const u16*)(p.ws + OFF_SK);
  const u16* SV = (const u16*)(p.ws + OFF_SV); const u16* SKK = (const u16*)(p.ws + OFF_SKK);
  const u16* SA = (const u16*)(p.ws + OFF_SA); const float* SW = (const float*)(p.ws + OFF_SW);
  float* O = (float*)(p.ws + OFF_O);
  constexpr int BUFF = 6432;
  float* lbase = (float*)smem;
  float* pp = lbase + 2 * BUFF + wv * 1024;
  const int st = tid >> 4, cg4 = tid & 15;
  struct Stg { u32x2 r, k, kk, a, kk1; f32x4 w; u16 v; };
  auto gload = [&](Stg& g, int c) {
    const size_t o = (tokb + (size_t)c * 16 + st) * 256 + chan0;
    g.r = *(const u32x2*)(SR + o + cg4 * 4); g.k = *(const u32x2*)(SK + o + cg4 * 4);
    g.kk = *(const u32x2*)(SKK + o + cg4 * 4); g.a = *(const u32x2*)(SA + o + cg4 * 4);
    g.w = *(const f32x4*)(SW + o + cg4 * 4);
    g.v = SV[o + q * 16 + cg4];
    int t1 = c * 16 + st + 1; if (t1 >= SEQ) t1 = SEQ - 1;
    g.kk1 = *(const u32x2*)(SKK + (tokb + (size_t)t1) * 256 + chan0 + cg4 * 4);
  };
  auto lwrite = [&](const Stg& g, int buf) {
    float* bp = lbase + buf * BUFF;
    const int o = st * 64 + cg4 * 4;
    f32x4 kk = {bflo(g.kk.x), bfhi(g.kk.x), bflo(g.kk.y), bfhi(g.kk.y)};
    f32x4 a = {bflo(g.a.x), bfhi(g.a.x), bflo(g.a.y), bfhi(g.a.y)};
    f32x4 k = {bflo(g.k.x), bfhi(g.k.x), bflo(g.k.y), bfhi(g.k.y)};
    f32x4 r = {bflo(g.r.x), bfhi(g.r.x), bflo(g.r.y), bfhi(g.r.y)};
    *(f32x4*)(bp + o) = kk;
    *(f32x4*)(bp + 1024 + o) = kk * a;
    *(f32x4*)(bp + 2048 + o) = k;
    *(f32x4*)(bp + 3072 + o) = g.w;
    *(f32x4*)(bp + 4096 + o) = r;
    bp[5120 + st * 16 + cg4] = bf2f(g.v);
    const f32x4 kn = {bflo(g.kk1.x), bfhi(g.kk1.x), bflo(g.kk1.y), bfhi(g.kk1.y)};
    *(f32x4*)(bp + 5376 + o) = g.w * kn;
    const f32x4 bb = kk * a;
    const float c1 = row_sum16(k.x * kn.x + k.y * kn.y + k.z * kn.z + k.w * kn.w);
    const float c2 = row_sum16(bb.x * kn.x + bb.y * kn.y + bb.z * kn.z + bb.w * kn.w);
    if (cg4 == 0) *(f32x2*)(bp + 6400 + st * 2) = f32x2{c1, c2};
  };
  constexpr int NCH = SEQ / 16;
  Stg R0, R1, R2, R3;
  gload(R0, 0); gload(R1, 1); gload(R2, 2); gload(R3, 3);
  __syncthreads();
  lwrite(R0, 0);
  __syncthreads();
  __builtin_amdgcn_s_setprio(3);
  float S0 = 0.f, S1 = 0.f, S2 = 0.f, S3 = 0.f;
  const int rrow = lane & 3, rstep = lane >> 2;
  struct Pair { f32x4 kkA, bbA, kA, wA, rA, mA, bbB, kB, wB, rB; f32x2 cA; float vA, vB; };
  auto chunk = [&](int c) {
    const float* bp = lbase + (c & 1) * BUFF;
    auto ldpair = [&](Pair& o, int s) {
      o.kkA = *(const f32x4*)(bp + s * 64 + cl * 4);
      o.mA = *(const f32x4*)(bp + 5376 + s * 64 + cl * 4);
      o.bbA = *(const f32x4*)(bp + 1024 + s * 64 + cl * 4);
      o.kA = *(const f32x4*)(bp + 2048 + s * 64 + cl * 4);
      o.wA = *(const f32x4*)(bp + 3072 + s * 64 + cl * 4);
      o.rA = *(const f32x4*)(bp + 4096 + s * 64 + cl * 4);
      o.vA = bp[5120 + s * 16 + rloc];
      o.cA = *(const f32x2*)(bp + 6400 + s * 2);
      o.bbB = *(const f32x4*)(bp + 1024 + (s + 1) * 64 + cl * 4);
      o.kB = *(const f32x4*)(bp + 2048 + (s + 1) * 64 + cl * 4);
      o.wB = *(const f32x4*)(bp + 3072 + (s + 1) * 64 + cl * 4);
      o.rB = *(const f32x4*)(bp + 4096 + (s + 1) * 64 + cl * 4);
      o.vB = bp[5120 + (s + 1) * 16 + rloc];
    };
    auto pairstep = [&](const Pair& o, int s) {
      const float pa = __builtin_fmaf(S3, o.kkA.w, __builtin_fmaf(S2, o.kkA.z, __builtin_fmaf(S1, o.kkA.y, S0 * o.kkA.x)));
      const float pd = __builtin_fmaf(S3, o.mA.w, __builtin_fmaf(S2, o.mA.z, __builtin_fmaf(S1, o.mA.y, S0 * o.mA.x)));
      const float saA = row_sum16(pa);
      const float dd = row_sum16(pd);
      const float saB = __builtin_fmaf(-saA, o.cA.y, __builtin_fmaf(o.vA, o.cA.x, dd));
      S0 = __builtin_fmaf(S0, o.wA.x, __builtin_fmaf(o.vA, o.kA.x, -(saA * o.bbA.x)));
      S1 = __builtin_fmaf(S1, o.wA.y, __builtin_fmaf(o.vA, o.kA.y, -(saA * o.bbA.y)));
      S2 = __builtin_fmaf(S2, o.wA.z, __builtin_fmaf(o.vA, o.kA.z, -(saA * o.bbA.z)));
      S3 = __builtin_fmaf(S3, o.wA.w, __builtin_fmaf(o.vA, o.kA.w, -(saA * o.bbA.w)));
      pp[(s * 4 + rl) * 16 + cl] = __builtin_fmaf(S3, o.rA.w, __builtin_fmaf(S2, o.rA.z, __builtin_fmaf(S1, o.rA.y, S0 * o.rA.x)));
      S0 = __builtin_fmaf(S0, o.wB.x, __builtin_fmaf(o.vB, o.kB.x, -(saB * o.bbB.x)));
      S1 = __builtin_fmaf(S1, o.wB.y, __builtin_fmaf(o.vB, o.kB.y, -(saB * o.bbB.y)));
      S2 = __builtin_fmaf(S2, o.wB.z, __builtin_fmaf(o.vB, o.kB.z, -(saB * o.bbB.z)));
      S3 = __builtin_fmaf(S3, o.wB.w, __builtin_fmaf(o.vB, o.kB.w, -(saB * o.bbB.w)));
      pp[((s + 1) * 4 + rl) * 16 + cl] = __builtin_fmaf(S3, o.rB.w, __builtin_fmaf(S2, o.rB.z, __builtin_fmaf(S1, o.rB.y, S0 * o.rB.x)));
    };
    Pair p0, p1;
    ldpair(p0, 0);
#pragma unroll
    for (int j = 0; j < 4; ++j) {
      ldpair(p1, 4 * j + 2);
      __builtin_amdgcn_sched_barrier(0);
      pairstep(p0, 4 * j);
      __builtin_amdgcn_sched_barrier(0);
      if (j < 3) ldpair(p0, 4 * j + 4);
      __builtin_amdgcn_sched_barrier(0);
      pairstep(p1, 4 * j + 2);
      __builtin_amdgcn_sched_barrier(0);
    }
    asm volatile("" ::: "memory");
    {
      const float* q0 = pp + (rstep * 4 + rrow) * 16;
      f32x4 a0 = *(const f32x4*)(q0), a1 = *(const f32x4*)(q0 + 4), a2 = *(const f32x4*)(q0 + 8), a3 = *(const f32x4*)(q0 + 12);
      f32x4 sm4 = (a0 + a1) + (a2 + a3);
      O[(tokb + (size_t)c * 16 + rstep) * 256 + chan0 + q * 16 + wv * 4 + rrow] = (sm4.x + sm4.y) + (sm4.z + sm4.w);
    }
    asm volatile("" ::: "memory");
  };
#pragma unroll 1
  for (int g = 0; g < NCH / 4; ++g) {
    const int c0 = g * 4;
    if (c0 + 4 < NCH) gload(R0, c0 + 4);
    chunk(c0);
    lwrite(R1, (c0 + 1) & 1);
    lds_barrier();
    if (c0 + 5 < NCH) gload(R1, c0 + 5);
    chunk(c0 + 1);
    lwrite(R2, (c0 + 2) & 1);
    lds_barrier();
    if (c0 + 6 < NCH) gload(R2, c0 + 6);
    chunk(c0 + 2);
    lwrite(R3, (c0 + 3) & 1);
    lds_barrier();
    if (c0 + 7 < NCH) gload(R3, c0 + 7);
    chunk(c0 + 3);
    if (c0 + 4 < NCH) lwrite(R0, (c0 + 4) & 1);
    lds_barrier();
  }
  __builtin_amdgcn_s_setprio(0);
}

__device__ __forceinline__ void rwkv_post_item(const Params& p, int l, int item) {
  const int j = TIDX;
  const float* O = (const float*)(p.ws + OFF_O);
  const u16* SR = (const u16*)(p.ws + OFF_SR); const u16* SK = (const u16*)(p.ws + OFF_SK);
  const u16* SV = (const u16*)(p.ws + OFF_SV); const u16* G = (const u16*)(p.ws + OFF_G);
  u16* OG = (u16*)(p.ws + OFF_OG);
  const float lw = p.in[18][l * 256 + j], lb = p.in[19][l * 256 + j], rk = p.in[17][l * 256 + j];
  const int tok0 = item * 8;
  float ov[8]; u16 rr[8], rkk[8], rv[8], rg[8];
#pragma unroll
  for (int t = 0; t < 8; ++t) {
    const size_t o = (size_t)(tok0 + t) * 256 + j;
    ov[t] = O[o]; rr[t] = SR[o]; rkk[t] = SK[o]; rv[t] = SV[o]; rg[t] = G[o];
  }
#pragma unroll
  for (int t = 0; t < 8; ++t) {
    const size_t o = (size_t)(tok0 + t) * 256 + j;
    float mean = wave_sum(ov[t]) * (1.f / 64.f);
    float d = ov[t] - mean;
    float var = wave_sum(d * d) * (1.f / 64.f);
    float on = d * rsqrtf(var + 64e-5f) * lw + lb;
    float bonus = wave_sum(bf2f(rr[t]) * bf2f(rkk[t]) * rk);
    OG[o] = f2bf((on + bonus * bf2f(rv[t])) * bf2f(rg[t]));
  }
}

#define XB_TMO      128
#define XB_XCNT(j)  (256  + 64 * (j))
#define XB_XSUB(j)  (1280 + 64 * (j))
#define XB_XGEN(j)  (2304 + 64 * (j))
#define XB_TOP      3328
#define XB_TOPGEN   3392
#define XCD_BAR_WORDS 3456
#define XB_SPIN_CAP (1u << 22)
#define LAS __attribute__((address_space(3)))
__device__ __forceinline__ unsigned xb_ld(unsigned* p) { return __hip_atomic_load(p, __ATOMIC_RELAXED, __HIP_MEMORY_SCOPE_AGENT); }
__device__ __forceinline__ unsigned xb_add(unsigned* p, unsigned v) { return __hip_atomic_fetch_add(p, v, __ATOMIC_RELAXED, __HIP_MEMORY_SCOPE_AGENT); }
__device__ __forceinline__ unsigned xb_xcc_id() { return (unsigned)__builtin_amdgcn_s_getreg((3 << 11) | 20) & 0xFu; }
#define XB_SPIN(cond, bar) do { unsigned _sp = 0; while (cond) { __builtin_amdgcn_s_sleep(1); \
    if ((++_sp & 255u) == 0u) { if (xb_ld(&(bar)[XB_TMO])) break; if (_sp > XB_SPIN_CAP) { atomicAdd(&(bar)[XB_TMO], 1u); break; } } } } while (0)
struct XcdBarrier { unsigned* bar; unsigned x; volatile LAS unsigned* st; };
__device__ __forceinline__ XcdBarrier xcd_barrier_post(unsigned* bar, volatile LAS unsigned* st) {
  XcdBarrier b; b.bar = bar; b.x = xb_xcc_id(); b.st = st;
  if (threadIdx.x == 0) st[2] = xb_add(&bar[XB_XCNT(b.x)], 1u);
  return b;
}
__device__ __forceinline__ void xcd_barrier_complete(unsigned* bar, unsigned x, unsigned& nloc, unsigned& nx) {
  const unsigned G = gridDim.x * gridDim.y * gridDim.z;
  unsigned sum, cnt, mine, sp = 0u;
  for (;;) {
    sum = 0u; cnt = 0u; mine = 0u;
#pragma unroll
    for (unsigned j = 0; j < 16; ++j) { const unsigned c = xb_ld(&bar[XB_XCNT(j)]); sum += c; cnt += (c > 0u) ? 1u : 0u; mine = (j == x) ? c : mine; }
    if (sum == G) break;
    __builtin_amdgcn_s_sleep(1);
    if ((++sp & 255u) == 0u) { if (xb_ld(&bar[XB_TMO])) break; if (sp > XB_SPIN_CAP) { atomicAdd(&bar[XB_TMO], 1u); break; } }
  }
  nloc = mine > 0u ? mine : 1u; nx = cnt > 0u ? cnt : 1u;
}
__device__ __forceinline__ void xcd_barrier(const XcdBarrier& b) {
  asm volatile("s_waitcnt vmcnt(0)" ::: "memory");
  __syncthreads();
  if (threadIdx.x == 0) {
    unsigned* bar = b.bar;
    __builtin_amdgcn_s_waitcnt(0);
    unsigned nloc = b.st[0], nx = b.st[1];
    if (nloc == 0u) { xcd_barrier_complete(bar, b.x, nloc, nx); b.st[0] = nloc; b.st[1] = nx; }
    const unsigned old = xb_add(&bar[XB_XSUB(b.x)], 1u);
    const unsigned gen = old / nloc;
    if (old + 1u == (gen + 1u) * nloc) {
      __builtin_amdgcn_fence(__ATOMIC_RELEASE, "agent");
      asm volatile("s_waitcnt vmcnt(0)" ::: "memory");
      const unsigned og = xb_add(&bar[XB_TOP], 1u);
      const unsigned tg = og / nx;
      if (og + 1u == (tg + 1u) * nx) xb_add(&bar[XB_TOPGEN], 1u);
      else XB_SPIN(xb_ld(&bar[XB_TOPGEN]) == tg, bar);
      __builtin_amdgcn_fence(__ATOMIC_ACQUIRE, "agent");
      xb_add(&bar[XB_XGEN(b.x)], 1u);
      asm volatile("s_waitcnt vmcnt(0)" ::: "memory");
    } else {
      XB_SPIN(xb_ld(&bar[XB_XGEN(b.x)]) == gen, bar);
      __builtin_amdgcn_fence(__ATOMIC_ACQUIRE, "agent");
      asm volatile("s_waitcnt vmcnt(0)" ::: "memory");
    }
  }
  __syncthreads();
}

__device__ __forceinline__ int xcd_virtual_id(const XcdBarrier& b) {
  if (threadIdx.x == 0) {
    unsigned base = 0u;
#pragma unroll
    for (unsigned j = 0; j < 16; ++j) { const unsigned c = xb_ld(&b.bar[XB_XCNT(j)]); base += (j < b.x) ? c : 0u; }
    b.st[3] = base + b.st[2];
  }
  __syncthreads();
  const int vb = __builtin_amdgcn_readfirstlane((int)b.st[3]);
  __syncthreads();
  return vb;
}

__device__ __forceinline__ void sub_barrier(unsigned* cnt, unsigned target) {
  asm volatile("s_waitcnt vmcnt(0)" ::: "memory");
  __syncthreads();
  if (threadIdx.x == 0) {
    __builtin_amdgcn_fence(__ATOMIC_RELEASE, "agent");
    asm volatile("s_waitcnt vmcnt(0)" ::: "memory");
    xb_add(cnt, 1u);
    unsigned sp = 0;
    while (xb_ld(cnt) < target) { __builtin_amdgcn_s_sleep(2); if (++sp > (1u << 24)) break; }
    __builtin_amdgcn_fence(__ATOMIC_ACQUIRE, "agent");
    asm volatile("s_waitcnt vmcnt(0)" ::: "memory");
  }
  __syncthreads();
}

#define N_PHASES 22
#ifndef PROBE_CONV_REPS
#define PROBE_CONV_REPS 1
#endif
#ifndef PROBE_PREP_REPS
#define PROBE_PREP_REPS 1
#endif
#ifndef PROBE_POST_REPS
#define PROBE_POST_REPS 1
#endif
#ifndef PROBE_SCAN_REPS
#define PROBE_SCAN_REPS 1
#endif
#ifndef PROBE_FFN1_REPS
#define PROBE_FFN1_REPS 1
#endif
#ifndef PH_MASK
#define PH_MASK 0xFFFFF
#endif
#define PHON(s) (PH_MASK & (1 << (s)))
#define PHASE_BEGIN(k) if (ph_hi > (k)) { if ((k) > 1) xcd_barrier(xb);
#define PHASE_END }

template <int L>
__device__ __forceinline__ void run_layer(const Params& p, int vbr, int ph_hi, unsigned char* smem_all, const XcdBarrier& xb) {
  unsigned char* smem = smem_all + SUBB * 73728;
  const int vb = vbr * 2 + SUBB;
  constexpr int l = L;
  constexpr int base = 1 + 10 * L;
  const float* modl = (const float*)(p.ws + OFF_MOD) + (size_t)l * 4 * 6144;
  PHASE_BEGIN(base + 0)
    for (int rep = 0; rep < PROBE_CONV_REPS; ++rep) {
      if (rep) xcd_barrier(xb);
      phase_convert(p, l, smem);
      phase_norm(l == 0 ? p.in[0] : p.out, p.in[4] + l * 1024, modl, 0, 1024, (u16*)(p.ws + OFF_H));
    }
  PHASE_END
  PHASE_BEGIN(base + 1)
    phase_pproj_tail(p, vbr, smem_all);
    phase_gemm_8w<0>(p, l, vbr, smem_all);
  PHASE_END
  PHASE_BEGIN(base + 2)
    for (int rep = 0; rep < PROBE_PREP_REPS; ++rep) {
      if (rep) xcd_barrier(xb);
      for (int item = VBLK; item < 512; item += VGRID) rwkv_prep_item(p, l, item, smem);
    }
  PHASE_END
  PHASE_BEGIN(base + 3)
    if ((int)blockIdx.x < 64) {
      if (SUBB == 0) scan_item(p, blockIdx.x, smem);
      else { __syncthreads(); __syncthreads(); for (int c = 0; c < SEQ / 16; ++c) lds_barrier(); }
    }
    else {
      const int nb = VGRID - 128, bi = VBLK - 128;
      for (int item = bi; item < 512; item += nb) sg_item(p, l, item, smem);
      for (int item = (bi + 64) % nb; item < 1024; item += nb) s5a_item(p, l, item, smem);
      for (int item = bi; item < 2048; item += nb) conv_item(p, l, item);
      sub_barrier((unsigned*)(p.ws + OFF_BAR) + 3520 + 64 * (2 * l), gridDim.x - 64);
      for (int item = bi; item < 1024; item += nb) s5b_item(p, l, item, smem);
      sub_barrier((unsigned*)(p.ws + OFF_BAR) + 3520 + 64 * (2 * l + 1), gridDim.x - 64);
      for (int item = (int)blockIdx.x - 64; item < 512; item += (int)gridDim.x - 64) merge_tile8<0>(p, item, smem_all);
    }
  PHASE_END
  PHASE_BEGIN(base + 4)
    for (int rep = 0; rep < PROBE_POST_REPS; ++rep) { if (rep) xcd_barrier(xb); for (int item = VBLK; item < 2048; item += VGRID) rwkv_post_item(p, l, item); }
  PHASE_END
  PHASE_BEGIN(base + 5)
    for (int item = vbr; item < 512; item += (int)gridDim.x) {
      int it2 = item;
      if (gridDim.x == 256) { const int r = item >> 8, w = vbr & 31; it2 = ((r * 4 + (w >> 3)) << 6) | ((vbr >> 5) * 8 + (w & 7)); }
      merge_tile8<1>(p, it2, smem_all);
    }
  PHASE_END
  PHASE_BEGIN(base + 6)
    phase_gemm_8w<1>(p, l, vbr, smem_all);
  PHASE_END
  PHASE_BEGIN(base + 7)
    if (PHON(7)) phase_norm(p.out, p.in[38] + l * 1024, modl, 3072, 4096, (u16*)(p.ws + OFF_H));
  PHASE_END
  PHASE_BEGIN(base + 8)
    phase_gemm_8w<2>(p, l, vbr, smem_all);
  PHASE_END
#ifdef PROBE_DUP_FFN1
  PHASE_BEGIN(base + 8)
    phase_gemm_8w<2>(p, l, vbr, smem_all);
  PHASE_END
#endif
  PHASE_BEGIN(base + 9)
    phase_gemm_8w<3>(p, l, vbr, smem_all);
  PHASE_END
}

__global__ void __launch_bounds__(512, 2) mega_fwd(Params p, int ph_lo, int ph_hi) {
  __shared__ __attribute__((aligned(16))) unsigned char smem[2 * 73728 + 16];
  cg::grid_group grid = cg::this_grid();
  if (ph_hi < 0) grid.sync();
  volatile LAS unsigned* st = (volatile LAS unsigned*)(smem + 2 * 73728);
  if (threadIdx.x == 0) { st[0] = 0u; st[1] = 0u; st[2] = 0u; st[3] = 0u; }
  __syncthreads();
  const XcdBarrier xb = xcd_barrier_post((unsigned*)(p.ws + OFF_BAR), st);
  if (ph_hi > 0) phase_mod(p, smem + SUBB * 73728);
  xcd_barrier(xb);
  const int vb = xcd_virtual_id(xb);
  run_layer<0>(p, vb, ph_hi, smem, xb);
  run_layer<1>(p, vb, ph_hi, smem, xb);
  PHASE_BEGIN(21)
    if (PHON(11)) phase_final(p.out, p.in[41]);
  PHASE_END
}

extern "C" void kernel_launch(void* const* d_in, const int* in_sizes, int n_in, void* d_out, int out_size, void* d_ws,
                              size_t ws_size, hipStream_t stream) {
  static int grid_blocks = 0;
  if (!grid_blocks) {
    int dev = 0, cus = 0, per_cu = 0;
    hipGetDevice(&dev);
    hipDeviceGetAttribute(&cus, hipDeviceAttributeMultiprocessorCount, dev);
    hipOccupancyMaxActiveBlocksPerMultiprocessor(&per_cu, mega_fwd, 512, 0);
    if (per_cu > 1) per_cu = 1;
    if (per_cu < 1) per_cu = 1;
    grid_blocks = cus * per_cu;
    if (ws_size < WS_END) fprintf(stderr, "workspace too small: %zu < %zu\n", ws_size, (size_t)WS_END);
  }
  Params p{};
  for (int i = 0; i < 42; ++i) p.in[i] = (const float*)d_in[i];
  p.out = (float*)d_out;
  p.ws = (unsigned char*)d_ws;
  hipMemsetAsync((unsigned char*)d_ws + OFF_BAR, 0, 16384, stream);
  int lo = 0, hi = N_PHASES;
  void* args[] = {&p, &lo, &hi};
  hipError_t e = hipLaunchCooperativeKernel((void*)mega_fwd, dim3(grid_blocks), dim3(512), args, 0, stream);
  if (e != hipSuccess) fprintf(stderr, "cooperative launch failed: %s (grid %d)\n", hipGetErrorString(e), grid_blocks);
}
```

```cpp
#include <hip/hip_runtime.h>
#include <hip/hip_cooperative_groups.h>
#include <cstdio>
namespace cg = cooperative_groups;

typedef unsigned short u16;
using bf16x8 = __attribute__((ext_vector_type(8))) short;
using f32x4 = __attribute__((ext_vector_type(4))) float;
using u32x4 = __attribute__((ext_vector_type(4))) unsigned int;
using u32x2 = __attribute__((ext_vector_type(2))) unsigned int;
using f32x2 = __attribute__((ext_vector_type(2))) float;

#define T_TOK 16384
#define SEQ 4096
#define DM 1024
#define NTHR 256
#define TIDX ((int)(threadIdx.x & 255))
#define SUBB ((int)(threadIdx.x >> 8))
#define VBLK ((int)(blockIdx.x * 2 + (threadIdx.x >> 8)))
#define VGRID ((int)(gridDim.x * 2))

static constexpr size_t SZ_WIN = (size_t)6528 * 1024 * 2;
static constexpr size_t OFF_WIN = 0;
static constexpr size_t OFF_RO = OFF_WIN + SZ_WIN;
static constexpr size_t OFF_SO = OFF_RO + 1024 * 256 * 2;
static constexpr size_t OFF_CO = OFF_SO + 1024 * 256 * 2;
static constexpr size_t OFF_GLU = OFF_CO + 1024 * 256 * 2;
static constexpr size_t OFF_WO = OFF_GLU + 2048 * 256 * 2;
static constexpr size_t OFF_W1 = OFF_WO + 1024 * 1024 * 2;
static constexpr size_t OFF_W2 = OFF_W1 + (size_t)4096 * 1024 * 2;
static constexpr size_t OFF_H = OFF_W2 + (size_t)4096 * 1024 * 2;
static constexpr size_t SZ_T256B = (size_t)T_TOK * 256 * 2;
static constexpr size_t OFF_VF = OFF_H + (size_t)T_TOK * 1024 * 2;
static constexpr size_t OFF_PD = OFF_VF + SZ_T256B;
static constexpr size_t OFF_G = OFF_PD + SZ_T256B;
static constexpr size_t OFF_UB = OFF_G + SZ_T256B;
static constexpr size_t OFF_CB = OFF_UB + SZ_T256B;
static constexpr size_t OFF_SR = OFF_CB + SZ_T256B;
static constexpr size_t OFF_SK = OFF_SR + SZ_T256B;
static constexpr size_t OFF_SV = OFF_SK + SZ_T256B;
static constexpr size_t OFF_SKK = OFF_SV + SZ_T256B;
static constexpr size_t OFF_SA = OFF_SKK + SZ_T256B;
static constexpr size_t OFF_SW = OFF_SA + SZ_T256B;
static constexpr size_t OFF_PABC = OFF_SW + 2 * SZ_T256B;
static constexpr size_t OFF_YD = OFF_PABC;
static constexpr size_t OFF_OG = OFF_YD + SZ_T256B;
static constexpr size_t OFF_MRG = OFF_OG + SZ_T256B;
static constexpr size_t OFF_F = OFF_UB;
static constexpr size_t OFF_SMALL = OFF_PABC + (size_t)T_TOK * 2176 * 2;
static constexpr size_t OFF_MOD = OFF_SMALL;
static constexpr size_t OFF_S5AB = OFF_MOD + 2 * 4 * 6144 * 4;
static constexpr size_t OFF_S5BB = OFF_S5AB + 2 * 16 * 64 * 2 * 4;
static constexpr size_t OFF_S5E = OFF_S5BB + 2 * 16 * 64 * 32 * 4;
static constexpr size_t OFF_BAR = OFF_S5E + (size_t)4 * 64 * 16 * 64 * 2 * 4;
static constexpr size_t OFF_SGW = OFF_BAR + 16384;
static constexpr size_t OFF_O = OFF_SGW + 4 * 128 * 128 * 2;
static constexpr size_t OFF_LW2 = OFF_O + 2 * SZ_T256B;
static constexpr size_t OFF_LA2 = OFF_LW2 + 256 * 32 * 2;
static constexpr size_t OFF_LG2 = OFF_LA2 + 256 * 32 * 2;
static constexpr size_t OFF_LV2 = OFF_LG2 + 256 * 64 * 2;
static constexpr size_t OFF_LV1 = OFF_LV2 + 256 * 32 * 2;
static constexpr size_t OFF_SGST = OFF_LV1 + 32 * 256 * 2;
static constexpr size_t WS_END = OFF_SGST + (size_t)T_TOK * 2 * 4;
static_assert(OFF_F + (size_t)T_TOK * 4096 * 2 <= OFF_SMALL, "F overlaps small region");
static_assert(OFF_MRG + (size_t)T_TOK * 1024 * 2 <= OFF_SMALL, "MRG overlaps");

struct Params {
  const float* in[42];
  float* out;
  unsigned char* ws;
};

__device__ __forceinline__ u16 f2bf(float f) {
  unsigned u = __float_as_uint(f);
  u += 0x7fffu + ((u >> 16) & 1u);
  return (u16)(u >> 16);
}
__device__ __forceinline__ float bf2f(u16 h) { return __uint_as_float(((unsigned)h) << 16); }
__device__ __forceinline__ float bflo(unsigned u) { return __uint_as_float(u << 16); }
__device__ __forceinline__ float bfhi(unsigned u) { return __uint_as_float(u & 0xffff0000u); }
__device__ __forceinline__ unsigned pack2(float a, float b) { return (unsigned)f2bf(a) | ((unsigned)f2bf(b) << 16); }
__device__ __forceinline__ float sigmoidf_(float x) { return 1.f / (1.f + __expf(-x)); }
__device__ __forceinline__ float tanhf_(float y) { return 1.f - 2.f / (1.f + __expf(2.f * y)); }
__device__ __forceinline__ float geluf_(float x) {
  float y = 0.7978845608028654f * (x + 0.044715f * x * x * x);
  return 0.5f * x * (1.f + tanhf_(y));
}
__device__ __forceinline__ float wave_sum(float v) {
#pragma unroll
  for (int o = 32; o > 0; o >>= 1) v += __shfl_xor(v, o, 64);
  return v;
}
template <int CTRL>
__device__ __forceinline__ float dppf(float x) {
  return __int_as_float(__builtin_amdgcn_update_dpp(__float_as_int(x), __float_as_int(x), CTRL, 0xF, 0xF, true));
}
__device__ __forceinline__ float row_sum16(float x) {
  x += dppf<0x128>(x);
  x += dppf<0x124>(x);
  x += dppf<0x122>(x);
  x += dppf<0x121>(x);
  return x;
}

__device__ __forceinline__ void phase_mod(const Params& p, unsigned char* smem) {
  const int tid = TIDX;
  float* cact = (float*)smem;
  float* red = cact + 4096;
  float* mod = (float*)(p.ws + OFF_MOD);
  for (int i = tid; i < 4096; i += NTHR) { float c = p.in[1][i]; cact[i] = c / (1.f + __expf(-c)); }
  __syncthreads();
  for (int item = VBLK; item < 192; item += VGRID) {
    int l = item / 96, nb = item % 96;
    int cl = tid & 63, kq = tid >> 6;
    int col = nb * 64 + cl;
    const float* W = p.in[2] + (size_t)l * 1024 * 6144;
    float a0 = 0, a1 = 0, a2 = 0, a3 = 0;
    for (int k = kq * 256; k < kq * 256 + 256; ++k) {
      float w = W[(size_t)k * 6144 + col];
      a0 += cact[k] * w; a1 += cact[1024 + k] * w; a2 += cact[2048 + k] * w; a3 += cact[3072 + k] * w;
    }
    red[(kq * 4 + 0) * 64 + cl] = a0; red[(kq * 4 + 1) * 64 + cl] = a1;
    red[(kq * 4 + 2) * 64 + cl] = a2; red[(kq * 4 + 3) * 64 + cl] = a3;
    __syncthreads();
    {
      int b = tid >> 6;
      float s = red[(0 * 4 + b) * 64 + cl] + red[(1 * 4 + b) * 64 + cl] + red[(2 * 4 + b) * 64 + cl] + red[(3 * 4 + b) * 64 + cl];
      mod[((size_t)l * 4 + b) * 6144 + col] = s + p.in[3][l * 6144 + col];
    }
    __syncthreads();
  }
  float* s5ab = (float*)(p.ws + OFF_S5AB);
  float* s5bb = (float*)(p.ws + OFF_S5BB);
  for (int idx = VBLK * NTHR + tid; idx < 2048; idx += VGRID * NTHR) {
    int l = idx >> 10, g = (idx >> 6) & 15, n = idx & 63;
    double lre = fmin((double)p.in[28][idx], -1e-4);
    double lim = (double)p.in[29][idx];
    double dt = exp((double)p.in[35][l * 16 + g]);
    double mag = exp(lre * dt);
    double abr = mag * cos(lim * dt), abi = mag * sin(lim * dt);
    double den = lre * lre + lim * lim;
    double qr = ((abr - 1.0) * lre + abi * lim) / den;
    double qi = (abi * lre - (abr - 1.0) * lim) / den;
    s5ab[idx * 2 + 0] = (float)abr; s5ab[idx * 2 + 1] = (float)abi;
    for (int c = 0; c < 16; ++c) {
      double br = p.in[30][(size_t)idx * 16 + c], bi = p.in[31][(size_t)idx * 16 + c];
      s5bb[(size_t)idx * 32 + c] = (float)(qr * br - qi * bi);
      s5bb[(size_t)idx * 32 + 16 + c] = (float)(qr * bi + qi * br);
    }
  }
}

__device__ __forceinline__ void convert_tile(const float* __restrict__ src, int K, int N, u16* __restrict__ dst, int tk, int tn, u16* sm) {
  const int tid = TIDX;
  int r = tid >> 4, c4 = (tid & 15) * 4;
#pragma unroll
  for (int i = 0; i < 4; ++i) {
    int kk = r + 16 * i;
    float4 v = *(const float4*)(src + (size_t)(tk * 64 + kk) * N + tn * 64 + c4);
    sm[(c4 + 0) * 72 + kk] = f2bf(v.x);
    sm[(c4 + 1) * 72 + kk] = f2bf(v.y);
    sm[(c4 + 2) * 72 + kk] = f2bf(v.z);
    sm[(c4 + 3) * 72 + kk] = f2bf(v.w);
  }
  __syncthreads();
#pragma unroll
  for (int j = 0; j < 2; ++j) {
    int n = (tid >> 3) + 32 * j, ch = tid & 7;
    u32x4 v = *(const u32x4*)(sm + n * 72 + ch * 8);
    *(u32x4*)(dst + (size_t)(tn * 64 + n) * K + tk * 64 + ch * 8) = v;
  }
  __syncthreads();
}

__device__ __forceinline__ void phase_convert(const Params& p, int l, unsigned char* smem) {
  u16* sm = (u16*)smem;
  const int total = 1632 + 192 + 128 + 256 + 1024 + 1024;
  for (int item = VBLK; item < total + 16 + 192; item += VGRID) {
    int t = item;
    if (t >= total + 16) {
      const int e = (t - total - 16) * 256 + TIDX;
      if (e < 8192) { const int n = e >> 5, k = e & 31; ((u16*)(p.ws + OFF_LW2))[e] = f2bf(p.in[8][(size_t)l * 8192 + k * 256 + n]); }
      else if (e < 16384) { const int q = e - 8192, n = q >> 5, k = q & 31; ((u16*)(p.ws + OFF_LA2))[q] = f2bf(p.in[10][(size_t)l * 8192 + k * 256 + n]); }
      else if (e < 32768) { const int q = e - 16384, n = q >> 6, k = q & 63; ((u16*)(p.ws + OFF_LG2))[q] = f2bf(p.in[11][(size_t)l * 16384 + k * 256 + n]); }
      else if (e < 40960) { const int q = e - 32768, n = q >> 5, k = q & 31; ((u16*)(p.ws + OFF_LV2))[q] = (l > 0) ? f2bf(p.in[14][k * 256 + n]) : (u16)0; }
      else { const int q = e - 40960, n = q >> 8, k = q & 255; ((u16*)(p.ws + OFF_LV1))[q] = (l > 0) ? f2bf(p.in[13][k * 32 + n]) : (u16)0; }
      continue;
    }
    if (t >= total) {
      const int idx = t - total, g = idx >> 2, rq = idx & 3;
      const int tr = rq * 32 + (TIDX >> 3), s0 = (TIDX & 7) * 16;
      const float* src = p.in[23] + (((size_t)l * 4 + g) * 128 + tr) * 128 + s0;
      u16* dst = (u16*)(p.ws + OFF_SGW) + ((size_t)g * 128 + tr) * 128 + s0;
      unsigned pk[8];
#pragma unroll
      for (int e = 0; e < 4; ++e) {
        f32x4 v = *(const f32x4*)(src + e * 4);
        const int sb = s0 + e * 4;
        pk[e * 2 + 0] = pack2(sb + 0 <= tr ? v.x : 0.f, sb + 1 <= tr ? v.y : 0.f);
        pk[e * 2 + 1] = pack2(sb + 2 <= tr ? v.z : 0.f, sb + 3 <= tr ? v.w : 0.f);
      }
      *(u32x4*)(dst) = u32x4{pk[0], pk[1], pk[2], pk[3]};
      *(u32x4*)(dst + 8) = u32x4{pk[4], pk[5], pk[6], pk[7]};
      continue;
    }
    const float* src; int K, N; size_t off;
    if (t < 1632) { src = p.in[5] + (size_t)l * 1024 * 6528; K = 1024; N = 6528; off = OFF_WIN; }
    else if ((t -= 1632) < 64) { src = p.in[20] + (size_t)l * 256 * 1024; K = 256; N = 1024; off = OFF_RO; }
    else if ((t -= 64) < 64) { src = p.in[25] + (size_t)l * 256 * 1024; K = 256; N = 1024; off = OFF_SO; }
    else if ((t -= 64) < 64) { src = p.in[27] + (size_t)l * 256 * 1024; K = 256; N = 1024; off = OFF_CO; }
    else if ((t -= 64) < 128) { src = p.in[36] + (size_t)l * 256 * 2048; K = 256; N = 2048; off = OFF_GLU; }
    else if ((t -= 128) < 256) { src = p.in[37] + (size_t)l * 1024 * 1024; K = 1024; N = 1024; off = OFF_WO; }
    else if ((t -= 256) < 1024) { src = p.in[39] + (size_t)l * 1024 * 4096; K = 1024; N = 4096; off = OFF_W1; }
    else { t -= 1024; src = p.in[40] + (size_t)l * 4096 * 1024; K = 4096; N = 1024; off = OFF_W2; }
    int ntn = N / 64;
    convert_tile(src, K, N, (u16*)(p.ws + off), t / ntn, t % ntn, sm);
  }
}

__device__ __forceinline__ void phase_norm(const float* __restrict__ X, const float* __restrict__ g, const float* __restrict__ modl,
                           int sh_off, int sc_off, u16* __restrict__ H) {
  const int lane = TIDX & 63, wv = TIDX >> 6;
  for (int item = VBLK; item < T_TOK / 4; item += VGRID) {
    int row = item * 4 + wv;
    int b = row >> 12;
    const float* xr = X + (size_t)row * 1024;
    float4 v[4];
    float ss = 0;
#pragma unroll
    for (int i = 0; i < 4; ++i) {
      v[i] = *(const float4*)(xr + lane * 4 + 256 * i);
      ss += v[i].x * v[i].x + v[i].y * v[i].y + v[i].z * v[i].z + v[i].w * v[i].w;
    }
    ss = wave_sum(ss);
    float rstd = rsqrtf(ss * (1.f / 1024.f) + 1e-6f);
    const float* sh = modl + (size_t)b * 6144 + sh_off;
    const float* sc = modl + (size_t)b * 6144 + sc_off;
#pragma unroll
    for (int i = 0; i < 4; ++i) {
      int c = lane * 4 + 256 * i;
      float4 gg = *(const float4*)(g + c);
      float4 s1 = *(const float4*)(sc + c);
      float4 s0 = *(const float4*)(sh + c);
      float h0 = v[i].x * rstd * gg.x * (1.f + s1.x) + s0.x;
      float h1 = v[i].y * rstd * gg.y * (1.f + s1.y) + s0.y;
      float h2 = v[i].z * rstd * gg.z * (1.f + s1.z) + s0.z;
      float h3 = v[i].w * rstd * gg.w * (1.f + s1.w) + s0.w;
      u32x2 o; o.x = pack2(h0, h1); o.y = pack2(h2, h3);
      *(u32x2*)(H + (size_t)row * 1024 + c) = o;
    }
  }
}

__device__ __forceinline__ void phase_final(float* __restrict__ X, const float* __restrict__ g) {
  const int lane = TIDX & 63, wv = TIDX >> 6;
  for (int item = VBLK; item < T_TOK / 4; item += VGRID) {
    int row = item * 4 + wv;
    float* xr = X + (size_t)row * 1024;
    float4 v[4];
    float ss = 0;
#pragma unroll
    for (int i = 0; i < 4; ++i) {
      v[i] = *(const float4*)(xr + lane * 4 + 256 * i);
      ss += v[i].x * v[i].x + v[i].y * v[i].y + v[i].z * v[i].z + v[i].w * v[i].w;
    }
    ss = wave_sum(ss);
    float rstd = rsqrtf(ss * (1.f / 1024.f) + 1e-6f);
#pragma unroll
    for (int i = 0; i < 4; ++i) {
      int c = lane * 4 + 256 * i;
      float4 gg = *(const float4*)(g + c);
      float4 o;
      o.x = v[i].x * rstd * gg.x; o.y = v[i].y * rstd * gg.y; o.z = v[i].z * rstd * gg.z; o.w = v[i].w * rstd * gg.w;
      *(float4*)(xr + c) = o;
    }
  }
}

template <int NF, bool LEAN = false>
__device__ __forceinline__ void gemm_mainloop(const u16* __restrict__ A, int lda, const u16* __restrict__ B, int ldb,
                                              int K, f32x4 (&acc)[4][NF], u16* smem) {
  constexpr int BN = 32 * NF;
  constexpr int NB = BN / 32;
  u16* sA = smem;
  u16* sB = smem + 2 * 128 * 64;
  int tz = 0;
  if (LEAN) asm volatile("" : "+v"(tz));
  const int tid = TIDX + tz, lane = tid & 63, wv = tid >> 6;
  const int wm = wv >> 1, wn = wv & 1;
  const int lrow = tid >> 3;
  const int lchs = (tid & 7) ^ ((lrow >> 1) & 7);
  const u16* Ap = A + (size_t)lrow * lda + lchs * 8;
  const u16* Bp = B + (size_t)lrow * ldb + lchs * 8;
  const int nk = K >> 6;
  auto stage = [&](int kt, int buf) {
    const int ko = kt << 6;
#pragma unroll
    for (int i = 0; i < 4; ++i)
      __builtin_amdgcn_global_load_lds((const unsigned*)(Ap + (size_t)(32 * i) * lda + ko),
                                       (__attribute__((address_space(3))) unsigned*)(sA + buf * (128 * 64) + (tid + 256 * i) * 8), 16, 0, 0);
#pragma unroll
    for (int i = 0; i < NB; ++i)
      __builtin_amdgcn_global_load_lds((const unsigned*)(Bp + (size_t)(32 * i) * ldb + ko),
                                       (__attribute__((address_space(3))) unsigned*)(sB + buf * (BN * 64) + (tid + 256 * i) * 8), 16, 0, 0);
  };
  __syncthreads();
  stage(0, 0);
  const int fr = lane & 15, fq = lane >> 4;
  const int sw = (fr >> 1) & 7;
  for (int kt = 0; kt < nk; ++kt) {
    const int cur = kt & 1;
    asm volatile("s_waitcnt vmcnt(0)" ::: "memory");
    __syncthreads();
    if (kt + 1 < nk) stage(kt + 1, cur ^ 1);
    const u16* cA = sA + cur * (128 * 64) + (wm * 64 + fr) * 64;
    const u16* cB = sB + cur * (BN * 64) + (wn * 16 * NF + fr) * 64;
#pragma unroll
    for (int ks = 0; ks < 2; ++ks) {
      if (LEAN) __builtin_amdgcn_sched_barrier(0);
      const int pc = ((fq + 4 * ks) ^ sw) << 3;
      bf16x8 fa[4], fb[NF];
#pragma unroll
      for (int i = 0; i < 4; ++i) fa[i] = *(const bf16x8*)(cA + i * 16 * 64 + pc);
#pragma unroll
      for (int j = 0; j < NF; ++j) fb[j] = *(const bf16x8*)(cB + j * 16 * 64 + pc);
#pragma unroll
      for (int i = 0; i < 4; ++i)
#pragma unroll
        for (int j = 0; j < NF; ++j)
          acc[i][j] = __builtin_amdgcn_mfma_f32_16x16x32_bf16(fb[j], fa[i], acc[i][j], 0, 0, 0);
    }
  }
}

template <int NF>
__device__ __forceinline__ void zero_acc(f32x4 (&acc)[4][NF]) {
#pragma unroll
  for (int i = 0; i < 4; ++i)
#pragma unroll
    for (int j = 0; j < NF; ++j) acc[i][j] = f32x4{0.f, 0.f, 0.f, 0.f};
}

__device__ __forceinline__ void gemm_mainloop_8w(const u16* __restrict__ A, int lda, const u16* __restrict__ B, int ldb,
                                                 int K, f32x4 (&acc)[8][4], u16* smem) {
  constexpr int STG = 32768;
  const int tid = threadIdx.x, lane = tid & 63, wv = tid >> 6;
  const int wm = wv >> 2, wn = wv & 3;
  const int lrow = tid >> 3;
  const int lchs = (tid & 7) ^ ((lrow >> 1) & 7);
  const u16* Ap = A + (size_t)lrow * lda + lchs * 8;
  const u16* Bp = B + (size_t)lrow * ldb + lchs * 8;
  const int nk = K >> 6;
  auto stage = [&](int kt, int buf) {
    const int ko = kt << 6;
    u16* sa = smem + buf * STG;
#pragma unroll
    for (int i = 0; i < 4; ++i)
      __builtin_amdgcn_global_load_lds((const unsigned*)(Ap + (size_t)(64 * i) * lda + ko),
                                       (__attribute__((address_space(3))) unsigned*)(sa + (tid + 512 * i) * 8), 16, 0, 0);
#pragma unroll
    for (int i = 0; i < 4; ++i)
      __builtin_amdgcn_global_load_lds((const unsigned*)(Bp + (size_t)(64 * i) * ldb + ko),
                                       (__attribute__((address_space(3))) unsigned*)(sa + 16384 + (tid + 512 * i) * 8), 16, 0, 0);
  };
  __syncthreads();
  stage(0, 0);
  const int fr = lane & 15, fq = lane >> 4;
  const int sw = (fr >> 1) & 7;
  for (int kt = 0; kt < nk; ++kt) {
    const int cur = kt & 1;
    asm volatile("s_waitcnt vmcnt(0)" ::: "memory");
    __syncthreads();
    if (kt + 1 < nk) stage(kt + 1, cur ^ 1);
    const u16* cA = smem + cur * STG + (wm * 128 + fr) * 64;
    const u16* cB = smem + cur * STG + 16384 + (wn * 64 + fr) * 64;
#pragma unroll
    for (int ks = 0; ks < 2; ++ks) {
      const int pc = ((fq + 4 * ks) ^ sw) << 3;
      bf16x8 fa[8], fb[4];
#pragma unroll
      for (int i = 0; i < 8; ++i) fa[i] = *(const bf16x8*)(cA + i * 16 * 64 + pc);
#pragma unroll
      for (int j = 0; j < 4; ++j) fb[j] = *(const bf16x8*)(cB + j * 16 * 64 + pc);
#pragma unroll
      for (int i = 0; i < 8; ++i)
#pragma unroll
        for (int j = 0; j < 4; ++j)
          acc[i][j] = __builtin_amdgcn_mfma_f32_16x16x32_bf16(fb[j], fa[i], acc[i][j], 0, 0, 0);
    }
  }
}

template <int EPI>
__device__ __forceinline__ void phase_gemm_8w(const Params& p, int l, int vb, unsigned char* smem_raw) {
  u16* smem = (u16*)smem_raw;
  const int lane = threadIdx.x & 63, wv = threadIdx.x >> 6;
  const int wm = wv >> 2, wn = wv & 3;
  const int fr = lane & 15, fq = lane >> 4;
  const u16* A; const u16* B; int lda, ldb, K, ntiles_n;
  if (EPI == 0) { A = (const u16*)(p.ws + OFF_H); lda = 1024; B = (const u16*)(p.ws + OFF_WIN); ldb = 1024; K = 1024; ntiles_n = 8; }
  if (EPI == 1) { A = (const u16*)(p.ws + OFF_MRG); lda = 1024; B = (const u16*)(p.ws + OFF_WO); ldb = 1024; K = 1024; ntiles_n = 4; }
  if (EPI == 2) { A = (const u16*)(p.ws + OFF_H); lda = 1024; B = (const u16*)(p.ws + OFF_W1); ldb = 1024; K = 1024; ntiles_n = 16; }
  if (EPI == 3) { A = (const u16*)(p.ws + OFF_F); lda = 4096; B = (const u16*)(p.ws + OFF_W2); ldb = 4096; K = 4096; ntiles_n = 4; }
  const float* modl = (const float*)(p.ws + OFF_MOD) + (size_t)l * 4 * 6144;
  const int total = 64 * ntiles_n;
  const int G = gridDim.x;
  const bool swz = (G == 256);
  for (int item = vb; item < total; item += G) {
    int mt = item & 63, nt = item >> 6;
    if (swz) { const int r = item >> 8, w = vb & 31; mt = (vb >> 5) * 8 + (w & 7); nt = r * 4 + (w >> 3); }
    const int m0 = mt * 256, n0 = nt * 256;
    f32x4 acc[8][4];
#pragma unroll
    for (int i = 0; i < 8; ++i)
#pragma unroll
      for (int j = 0; j < 4; ++j) acc[i][j] = f32x4{0.f, 0.f, 0.f, 0.f};
    gemm_mainloop_8w(A + (size_t)m0 * lda, lda, B + (size_t)n0 * ldb, ldb, K, acc, smem);
#pragma unroll
    for (int i = 0; i < 8; ++i) {
      const int m = m0 + wm * 128 + i * 16 + fr;
#pragma unroll
      for (int j = 0; j < 4; ++j) {
        const int n = n0 + wn * 64 + j * 16 + fq * 4;
        f32x4 v = acc[i][j];
        if (EPI == 0) {
          *(u32x2*)((u16*)(p.ws + OFF_PABC) + (size_t)m * 2176 + n) = u32x2{pack2(v[0], v[1]), pack2(v[2], v[3])};
        } else if (EPI == 1 || EPI == 3) {
          const int b = m >> 12;
          const float* gt = modl + (size_t)b * 6144 + (EPI == 1 ? 2048 : 5120) + n;
          const float* xin = ((EPI == 1 && l == 0) ? p.in[0] : p.out) + (size_t)m * 1024 + n;
          f32x4 x = *(const f32x4*)xin;
          f32x4 gg = *(const f32x4*)gt;
          *(f32x4*)(p.out + (size_t)m * 1024 + n) = x + gg * v;
        } else {
          float r0 = fmaxf(v[0], 0.f), r1 = fmaxf(v[1], 0.f), r2 = fmaxf(v[2], 0.f), r3 = fmaxf(v[3], 0.f);
          *(u32x2*)((u16*)(p.ws + OFF_F) + (size_t)m * 4096 + n) = u32x2{pack2(r0 * r0, r1 * r1), pack2(r2 * r2, r3 * r3)};
        }
      }
    }
  }
}

template <int EPI>
__device__ __forceinline__ void phase_gemm(const Params& p, int l, int vb, unsigned char* smem_raw) {
  u16* smem = (u16*)smem_raw;
  const int lane = TIDX & 63, wv = TIDX >> 6;
  const int wm = wv >> 1, wn = wv & 1;
  const int fr = lane & 15, fq = lane >> 4;
  const u16* A; const u16* B; int lda, ldb, K, ntiles_n;
  if (EPI == 0) { A = (const u16*)(p.ws + OFF_H); lda = 1024; B = (const u16*)(p.ws + OFF_WIN); ldb = 1024; K = 1024; ntiles_n = 19; }
  if (EPI == 1) { A = (const u16*)(p.ws + OFF_MRG); lda = 1024; B = (const u16*)(p.ws + OFF_WO); ldb = 1024; K = 1024; ntiles_n = 8; }
  if (EPI == 2) { A = (const u16*)(p.ws + OFF_H); lda = 1024; B = (const u16*)(p.ws + OFF_W1); ldb = 1024; K = 1024; ntiles_n = 32; }
  if (EPI == 3) { A = (const u16*)(p.ws + OFF_F); lda = 4096; B = (const u16*)(p.ws + OFF_W2); ldb = 4096; K = 4096; ntiles_n = 8; }
  const float* modl = (const float*)(p.ws + OFF_MOD) + (size_t)l * 4 * 6144;
  const int G = VGRID;
  const bool swz = (G == 512);
  const int total = swz ? 128 * ((ntiles_n + 3) & ~3) : 128 * ntiles_n;
  for (int item = vb; item < total; item += G) {
    int mt = item & 127, nt = item >> 7;
    if (swz) { const int r = item >> 9, w = vb & 63; mt = (vb >> 6) * 16 + (w & 15); nt = r * 4 + (w >> 4); if (nt >= ntiles_n) continue; }
    const int m0 = mt * 128, n0 = nt * 128;
    f32x4 acc[4][4];
    zero_acc<4>(acc);
    gemm_mainloop<4>(A + (size_t)m0 * lda, lda, B + (size_t)n0 * ldb, ldb, K, acc, smem);
#pragma unroll
    for (int i = 0; i < 4; ++i) {
      const int m = m0 + wm * 64 + i * 16 + fr;
#pragma unroll
      for (int j = 0; j < 4; ++j) {
        const int n = n0 + wn * 64 + j * 16 + fq * 4;
        f32x4 v = acc[i][j];
        if (EPI == 0) {
          u32x2 o; o.x = pack2(v[0], v[1]); o.y = pack2(v[2], v[3]);
          if (n < 2176) *(u32x2*)((u16*)(p.ws + OFF_PABC) + (size_t)m * 2176 + n) = o;
          else *(u32x2*)((u16*)(p.ws + OFF_PD) + (size_t)m * 256 + (n - 2176)) = o;
        } else if (EPI == 1 || EPI == 3) {
          const int b = m >> 12;
          const float* gt = modl + (size_t)b * 6144 + (EPI == 1 ? 2048 : 5120) + n;
          const float* xin = ((EPI == 1 && l == 0) ? p.in[0] : p.out) + (size_t)m * 1024 + n;
          float4 x = *(const float4*)xin;
          float4 gg = *(const float4*)gt;
          float4 o;
          o.x = x.x + gg.x * v[0]; o.y = x.y + gg.y * v[1]; o.z = x.z + gg.z * v[2]; o.w = x.w + gg.w * v[3];
          *(float4*)(p.out + (size_t)m * 1024 + n) = o;
        } else {
          float r0 = fmaxf(v[0], 0.f), r1 = fmaxf(v[1], 0.f), r2 = fmaxf(v[2], 0.f), r3 = fmaxf(v[3], 0.f);
          u32x2 o; o.x = pack2(r0 * r0, r1 * r1); o.y = pack2(r2 * r2, r3 * r3);
          *(u32x2*)((u16*)(p.ws + OFF_F) + (size_t)m * 4096 + n) = o;
        }
      }
    }
  }
}

template <int MODE>
__device__ __forceinline__ void merge_tile(const Params& p, int item, unsigned char* smem_raw) {
  u16* smem = (u16*)smem_raw;
  const int lane = TIDX & 63, wv = TIDX >> 6;
  const int wm = wv >> 1, wn = wv & 1;
  const int fr = lane & 15, fq = lane >> 4;
  const u16* H = (const u16*)(p.ws + OFF_H);
  const u16* WIN = (const u16*)(p.ws + OFF_WIN);
  const int mt = item & 127, nt = item >> 7;
  const int m0 = mt * 128, n0 = nt * 128;
  f32x4 bacc[4][4];
  u32x2 gpk[4][4];
  u16* MRG = (u16*)(p.ws + OFF_MRG);
#pragma unroll 1
  for (int br = (MODE == 0 ? 1 : 0); br < (MODE == 0 ? 4 : 1); ++br) {
    zero_acc<4>(bacc);
    gemm_mainloop<4, true>(H + (size_t)m0 * 1024, 1024, WIN + (size_t)(2432 + br * 1024 + n0) * 1024, 1024, 1024, bacc, smem);
#pragma unroll
    for (int i = 0; i < 4; ++i)
#pragma unroll
      for (int j = 0; j < 4; ++j)
        gpk[i][j] = u32x2{pack2(sigmoidf_(bacc[i][j][0]), sigmoidf_(bacc[i][j][1])), pack2(sigmoidf_(bacc[i][j][2]), sigmoidf_(bacc[i][j][3]))};
    const u16* Ab; const u16* Wb;
    if (br == 0) { Ab = (const u16*)(p.ws + OFF_OG); Wb = (const u16*)(p.ws + OFF_RO); }
    else if (br == 1) { Ab = (const u16*)(p.ws + OFF_UB); Wb = (const u16*)(p.ws + OFF_SO); }
    else if (br == 2) { Ab = (const u16*)(p.ws + OFF_CB); Wb = (const u16*)(p.ws + OFF_CO); }
    else { Ab = (const u16*)(p.ws + OFF_YD); Wb = (const u16*)(p.ws + OFF_GLU); }
    if (MODE == 0 && br == 3) {
      zero_acc<4>(bacc);
      gemm_mainloop<4, true>(Ab + (size_t)m0 * 256, 256, Wb + (size_t)(1024 + n0) * 256, 256, 256, bacc, smem);
#pragma unroll
      for (int i = 0; i < 4; ++i)
#pragma unroll
        for (int j = 0; j < 4; ++j) {
          const float g0 = bflo(gpk[i][j].x) * sigmoidf_(bacc[i][j][0]), g1 = bfhi(gpk[i][j].x) * sigmoidf_(bacc[i][j][1]);
          const float g2 = bflo(gpk[i][j].y) * sigmoidf_(bacc[i][j][2]), g3 = bfhi(gpk[i][j].y) * sigmoidf_(bacc[i][j][3]);
          gpk[i][j] = u32x2{pack2(g0, g1), pack2(g2, g3)};
        }
    }
    zero_acc<4>(bacc);
    gemm_mainloop<4, true>(Ab + (size_t)m0 * 256, 256, Wb + (size_t)n0 * 256, 256, 256, bacc, smem);
#pragma unroll
    for (int i = 0; i < 4; ++i)
#pragma unroll
      for (int j = 0; j < 4; ++j) {
        u32x2* mp = (u32x2*)(MRG + (size_t)(m0 + wm * 64 + i * 16 + fr) * 1024 + n0 + wn * 64 + j * 16 + fq * 4);
        u32x2 cm = u32x2{0u, 0u};
        if (MODE == 1 || br > 1) cm = *mp;
        const float v0 = bflo(cm.x) + bflo(gpk[i][j].x) * bacc[i][j][0];
        const float v1 = bfhi(cm.x) + bfhi(gpk[i][j].x) * bacc[i][j][1];
        const float v2 = bflo(cm.y) + bflo(gpk[i][j].y) * bacc[i][j][2];
        const float v3 = bfhi(cm.y) + bfhi(gpk[i][j].y) * bacc[i][j][3];
        *mp = u32x2{pack2(v0, v1), pack2(v2, v3)};
      }
  }
}

__device__ __forceinline__ void gemm_mainloop_8n(const u16* __restrict__ A, int lda, const u16* __restrict__ B, int ldb,
                                                 int K, f32x4 (&acc)[4][4], u16* smem) {
  constexpr int STG = 24576;
  int tz = 0;
  asm volatile("" : "+v"(tz));
  const int tid = threadIdx.x + tz, lane = tid & 63, wv = tid >> 6;
  const int wm = wv >> 1, wn = wv & 1;
  const int lrow = tid >> 3;
  const int lchs = (tid & 7) ^ ((lrow >> 1) & 7);
  const u16* Ap = A + (size_t)lrow * lda + lchs * 8;
  const u16* Bp = B + (size_t)lrow * ldb + lchs * 8;
  const int nk = K >> 6;
  auto stage = [&](int kt, int buf) {
    const int ko = kt << 6;
    u16* sa = smem + buf * STG;
#pragma unroll
    for (int i = 0; i < 4; ++i)
      __builtin_amdgcn_global_load_lds((const unsigned*)(Ap + (size_t)(64 * i) * lda + ko),
                                       (__attribute__((address_space(3))) unsigned*)(sa + (tid + 512 * i) * 8), 16, 0, 0);
#pragma unroll
    for (int i = 0; i < 2; ++i)
      __builtin_amdgcn_global_load_lds((const unsigned*)(Bp + (size_t)(64 * i) * ldb + ko),
                                       (__attribute__((address_space(3))) unsigned*)(sa + 16384 + (tid + 512 * i) * 8), 16, 0, 0);
  };
  __syncthreads();
  stage(0, 0);
  stage(nk > 1 ? 1 : 0, 1);
  const int fr = lane & 15, fq = lane >> 4;
  const int sw = (fr >> 1) & 7;
  int cur = 0;
  for (int kt = 0; kt < nk; ++kt) {
    asm volatile("s_waitcnt vmcnt(6)" ::: "memory");
    __builtin_amdgcn_s_barrier();
    asm volatile("" ::: "memory");
    {
      int nx = cur + 2; if (nx >= 3) nx -= 3;
      int ktn = kt + 2; if (ktn >= nk) ktn = nk - 1;
      stage(ktn, nx);
    }
    const u16* cA = smem + cur * STG + (wm * 64 + fr) * 64;
    const u16* cB = smem + cur * STG + 16384 + (wn * 64 + fr) * 64;
#pragma unroll
    for (int ks = 0; ks < 2; ++ks) {
      const int pc = ((fq + 4 * ks) ^ sw) << 3;
      bf16x8 fa[4], fb[4];
#pragma unroll
      for (int i = 0; i < 4; ++i) fa[i] = *(const bf16x8*)(cA + i * 16 * 64 + pc);
#pragma unroll
      for (int j = 0; j < 4; ++j) fb[j] = *(const bf16x8*)(cB + j * 16 * 64 + pc);
#pragma unroll
      for (int i = 0; i < 4; ++i)
#pragma unroll
        for (int j = 0; j < 4; ++j)
          acc[i][j] = __builtin_amdgcn_mfma_f32_16x16x32_bf16(fb[j], fa[i], acc[i][j], 0, 0, 0);
    }
    cur = cur + 1; if (cur >= 3) cur = 0;
  }
  asm volatile("s_waitcnt vmcnt(0)" ::: "memory");
}

template <int MODE>
__device__ __forceinline__ void merge_tile8(const Params& p, int item, unsigned char* smem_raw) {
  u16* smem = (u16*)smem_raw;
  const int lane = threadIdx.x & 63, wv = threadIdx.x >> 6;
  const int wm = wv >> 1, wn = wv & 1;
  const int fr = lane & 15, fq = lane >> 4;
  const u16* H = (const u16*)(p.ws + OFF_H);
  const u16* WIN = (const u16*)(p.ws + OFF_WIN);
  const int mt = item & 63, nt = item >> 6;
  const int m0 = mt * 256, n0 = nt * 128;
  f32x4 bacc[4][4];
  u32x2 gpk[4][4];
  u16* MRG = (u16*)(p.ws + OFF_MRG);
#pragma unroll 1
  for (int br = (MODE == 0 ? 1 : 0); br < (MODE == 0 ? 4 : 1); ++br) {
    zero_acc<4>(bacc);
    gemm_mainloop_8n(H + (size_t)m0 * 1024, 1024, WIN + (size_t)(2432 + br * 1024 + n0) * 1024, 1024, 1024, bacc, smem);
#pragma unroll
    for (int i = 0; i < 4; ++i)
#pragma unroll
      for (int j = 0; j < 4; ++j)
        gpk[i][j] = u32x2{pack2(sigmoidf_(bacc[i][j][0]), sigmoidf_(bacc[i][j][1])), pack2(sigmoidf_(bacc[i][j][2]), sigmoidf_(bacc[i][j][3]))};
    const u16* Ab; const u16* Wb;
    if (br == 0) { Ab = (const u16*)(p.ws + OFF_OG); Wb = (const u16*)(p.ws + OFF_RO); }
    else if (br == 1) { Ab = (const u16*)(p.ws + OFF_UB); Wb = (const u16*)(p.ws + OFF_SO); }
    else if (br == 2) { Ab = (const u16*)(p.ws + OFF_CB); Wb = (const u16*)(p.ws + OFF_CO); }
    else { Ab = (const u16*)(p.ws + OFF_YD); Wb = (const u16*)(p.ws + OFF_GLU); }
    if (MODE == 0 && br == 3) {
      zero_acc<4>(bacc);
      gemm_mainloop_8n(Ab + (size_t)m0 * 256, 256, Wb + (size_t)(1024 + n0) * 256, 256, 256, bacc, smem);
#pragma unroll
      for (int i = 0; i < 4; ++i)
#pragma unroll
        for (int j = 0; j < 4; ++j) {
          const float g0 = bflo(gpk[i][j].x) * sigmoidf_(bacc[i][j][0]), g1 = bfhi(gpk[i][j].x) * sigmoidf_(bacc[i][j][1]);
          const float g2 = bflo(gpk[i][j].y) * sigmoidf_(bacc[i][j][2]), g3 = bfhi(gpk[i][j].y) * sigmoidf_(bacc[i][j][3]);
          gpk[i][j] = u32x2{pack2(g0, g1), pack2(g2, g3)};
        }
    }
    zero_acc<4>(bacc);
    gemm_mainloop_8n(Ab + (size_t)m0 * 256, 256, Wb + (size_t)n0 * 256, 256, 256, bacc, smem);
#pragma unroll
    for (int i = 0; i < 4; ++i)
#pragma unroll
      for (int j = 0; j < 4; ++j) {
        u32x2* mp = (u32x2*)(MRG + (size_t)(m0 + wm * 64 + i * 16 + fr) * 1024 + n0 + wn * 64 + j * 16 + fq * 4);
        u32x2 cm = u32x2{0u, 0u};
        if (MODE == 1 || br > 1) cm = *mp;
        const float v0 = bflo(cm.x) + bflo(gpk[i][j].x) * bacc[i][j][0];
        const float v1 = bfhi(cm.x) + bfhi(gpk[i][j].x) * bacc[i][j][1];
        const float v2 = bflo(cm.y) + bflo(gpk[i][j].y) * bacc[i][j][2];
        const float v3 = bfhi(cm.y) + bfhi(gpk[i][j].y) * bacc[i][j][3];
        *mp = u32x2{pack2(v0, v1), pack2(v2, v3)};
      }
  }
}

__device__ __forceinline__ void phase_pproj_tail(const Params& p, int vb, unsigned char* smem_raw) {
  u16* smem = (u16*)smem_raw;
  const int lane = threadIdx.x & 63, wv = threadIdx.x >> 6;
  const int wm = wv >> 1, wn = wv & 1;
  const int fr = lane & 15, fq = lane >> 4;
  const u16* A = (const u16*)(p.ws + OFF_H);
  const u16* B = (const u16*)(p.ws + OFF_WIN);
  const int G = gridDim.x;
  const int total = (G == 256) ? 256 : 192;
  for (int item = vb; item < total; item += G) {
    int mt = item & 63, nt = item >> 6;
    if (G == 256) { const int w = vb & 31; mt = (vb >> 5) * 8 + (w & 7); nt = w >> 3; if (nt >= 3) continue; }
    const int m0 = mt * 256, n0 = 2048 + nt * 128;
    f32x4 acc[4][4];
    zero_acc<4>(acc);
    gemm_mainloop_8n(A + (size_t)m0 * 1024, 1024, B + (size_t)n0 * 1024, 1024, 1024, acc, smem);
#pragma unroll
    for (int i = 0; i < 4; ++i) {
      const int m = m0 + wm * 64 + i * 16 + fr;
#pragma unroll
      for (int j = 0; j < 4; ++j) {
        const int n = n0 + wn * 64 + j * 16 + fq * 4;
        const f32x4 v = acc[i][j];
        const u32x2 o = u32x2{pack2(v[0], v[1]), pack2(v[2], v[3])};
        if (n < 2176) *(u32x2*)((u16*)(p.ws + OFF_PABC) + (size_t)m * 2176 + n) = o;
        else *(u32x2*)((u16*)(p.ws + OFF_PD) + (size_t)m * 256 + (n - 2176)) = o;
      }
    }
  }
}

__device__ __forceinline__ float shifted(const u16* __restrict__ P, int tok, int col, float mu) {
  float pv = bf2f(P[(size_t)tok * 2176 + col]);
  float pr = (tok & (SEQ - 1)) ? bf2f(P[(size_t)(tok - 1) * 2176 + col]) : 0.f;
  return pv + (pr - pv) * mu;
}

__device__ __forceinline__ void rwkv_prep_item(const Params& p, int l, int item, unsigned char* smem) {
  const int tid = TIDX, lane = tid & 63, wv = tid >> 6;
  const int fr = lane & 15, fq = lane >> 4;
  u16* sl = (u16*)smem;
  u16* sv = sl + 32 * 168;
  constexpr int SLS = 168, SVS = 264;
  const u16* P = (const u16*)(p.ws + OFF_PABC);
  const float* mu = p.in[6] + l * 896;
  const int tok0 = item * 32;
  {
    const int t = tid >> 3, c0 = (tid & 7) * 32;
    const u16* src = P + (size_t)(tok0 + t) * 2176 + 896 + 256 + c0;
    float sm = 0.f, ss = 0.f;
#pragma unroll
    for (int q = 0; q < 4; ++q) {
      const u32x4 raw = *(const u32x4*)(src + q * 8);
      float z;
      z = geluf_(bflo(raw.x)); sm += z; ss += z * z;  z = geluf_(bfhi(raw.x)); sm += z; ss += z * z;
      z = geluf_(bflo(raw.y)); sm += z; ss += z * z;  z = geluf_(bfhi(raw.y)); sm += z; ss += z * z;
      z = geluf_(bflo(raw.z)); sm += z; ss += z * z;  z = geluf_(bfhi(raw.z)); sm += z; ss += z * z;
      z = geluf_(bflo(raw.w)); sm += z; ss += z * z;  z = geluf_(bfhi(raw.w)); sm += z; ss += z * z;
    }
    sm += __shfl_xor(sm, 1, 64); ss += __shfl_xor(ss, 1, 64);
    sm += __shfl_xor(sm, 2, 64); ss += __shfl_xor(ss, 2, 64);
    sm += __shfl_xor(sm, 4, 64); ss += __shfl_xor(ss, 4, 64);
    const float mean = sm * (1.f / 256.f);
    const float var = fmaxf(ss * (1.f / 256.f) - mean * mean, 0.f);
    if ((tid & 7) == 0) *(f32x2*)((float*)(p.ws + OFF_SGST) + (size_t)(tok0 + t) * 2) = f32x2{mean, rsqrtf(var + 1e-5f)};
  }
  for (int idx = tid; idx < 32 * 128; idx += NTHR) {
    const int t = idx >> 7, ci = idx & 127;
    float v = shifted(P, tok0 + t, 768 + ci, mu[768 + ci]);
    if (ci < 32) v = tanhf_(v);
    else if (ci >= 64) v = sigmoidf_(v);
    sl[t * SLS + ci] = f2bf(v);
  }
  if (l > 0) {
    const int t = tid >> 3, c0 = (tid & 7) * 32;
    const int tok = tok0 + t;
    const bool hasp = (tok & (SEQ - 1)) != 0;
#pragma unroll
    for (int q = 0; q < 4; ++q) {
      const int c = c0 + q * 8;
      const u32x4 cur = *(const u32x4*)(P + (size_t)tok * 2176 + 512 + c);
      u32x4 prv = u32x4{0u, 0u, 0u, 0u};
      if (hasp) prv = *(const u32x4*)(P + (size_t)(tok - 1) * 2176 + 512 + c);
      const f32x4 m0 = *(const f32x4*)(mu + 512 + c), m1 = *(const f32x4*)(mu + 512 + c + 4);
      float o[8];
      o[0] = bflo(cur.x) + (bflo(prv.x) - bflo(cur.x)) * m0.x; o[1] = bfhi(cur.x) + (bfhi(prv.x) - bfhi(cur.x)) * m0.y;
      o[2] = bflo(cur.y) + (bflo(prv.y) - bflo(cur.y)) * m0.z; o[3] = bfhi(cur.y) + (bfhi(prv.y) - bfhi(cur.y)) * m0.w;
      o[4] = bflo(cur.z) + (bflo(prv.z) - bflo(cur.z)) * m1.x; o[5] = bfhi(cur.z) + (bfhi(prv.z) - bfhi(cur.z)) * m1.y;
      o[6] = bflo(cur.w) + (bflo(prv.w) - bflo(cur.w)) * m1.z; o[7] = bfhi(cur.w) + (bfhi(prv.w) - bfhi(cur.w)) * m1.w;
      *(u32x4*)(sv + t * SVS + c) = u32x4{pack2(o[0], o[1]), pack2(o[2], o[3]), pack2(o[4], o[5]), pack2(o[6], o[7])};
    }
  }
  __syncthreads();
  if (l > 0) {
    const int mf = wv >> 1, nf = wv & 1;
    const u16* v1t = (const u16*)(p.ws + OFF_LV1);
    f32x4 acc = f32x4{0.f, 0.f, 0.f, 0.f};
#pragma unroll
    for (int ks = 0; ks < 8; ++ks) {
      const bf16x8 fa = *(const bf16x8*)(sv + (mf * 16 + fr) * SVS + ks * 32 + fq * 8);
      const bf16x8 fb = *(const bf16x8*)(v1t + (size_t)(nf * 16 + fr) * 256 + ks * 32 + fq * 8);
      acc = __builtin_amdgcn_mfma_f32_16x16x32_bf16(fb, fa, acc, 0, 0, 0);
    }
    *(u32x2*)(sl + (mf * 16 + fr) * SLS + 128 + nf * 16 + fq * 4) = u32x2{pack2(acc[0], acc[1]), pack2(acc[2], acc[3])};
    __syncthreads();
  }
  const u16* w2t = (const u16*)(p.ws + OFF_LW2); const u16* a2t = (const u16*)(p.ws + OFF_LA2);
  const u16* g2t = (const u16*)(p.ws + OFF_LG2); const u16* v2t = (const u16*)(p.ws + OFF_LV2);
  u16* SR = (u16*)(p.ws + OFF_SR); u16* SK = (u16*)(p.ws + OFF_SK); u16* SV = (u16*)(p.ws + OFF_SV);
  u16* SKK = (u16*)(p.ws + OFF_SKK); u16* SA = (u16*)(p.ws + OFF_SA); float* SW = (float*)(p.ws + OFF_SW);
  u16* G = (u16*)(p.ws + OFF_G); u16* VF = (u16*)(p.ws + OFF_VF);
#pragma unroll 1
  for (int mf = 0; mf < 2; ++mf) {
    const u16* arow = sl + (mf * 16 + fr) * SLS + fq * 8;
    const bf16x8 aw = *(const bf16x8*)(arow), aa = *(const bf16x8*)(arow + 32);
    const bf16x8 ag0 = *(const bf16x8*)(arow + 64), ag1 = *(const bf16x8*)(arow + 96), av = *(const bf16x8*)(arow + 128);
    f32x4 cw[4], ca[4], cg[4], cv[4];
#pragma unroll
    for (int nf = 0; nf < 4; ++nf) {
      const int n = wv * 64 + nf * 16 + fr;
      const f32x4 z = f32x4{0.f, 0.f, 0.f, 0.f};
      cw[nf] = __builtin_amdgcn_mfma_f32_16x16x32_bf16(*(const bf16x8*)(w2t + n * 32 + fq * 8), aw, z, 0, 0, 0);
      ca[nf] = __builtin_amdgcn_mfma_f32_16x16x32_bf16(*(const bf16x8*)(a2t + n * 32 + fq * 8), aa, z, 0, 0, 0);
      cg[nf] = __builtin_amdgcn_mfma_f32_16x16x32_bf16(*(const bf16x8*)(g2t + n * 64 + fq * 8), ag0, z, 0, 0, 0);
      cg[nf] = __builtin_amdgcn_mfma_f32_16x16x32_bf16(*(const bf16x8*)(g2t + n * 64 + 32 + fq * 8), ag1, cg[nf], 0, 0, 0);
      cv[nf] = z;
      if (l > 0) cv[nf] = __builtin_amdgcn_mfma_f32_16x16x32_bf16(*(const bf16x8*)(v2t + n * 32 + fq * 8), av, z, 0, 0, 0);
    }
    const int tok = tok0 + mf * 16 + fr;
    const bool hasp = (tok & (SEQ - 1)) != 0;
    float kkv[4][4], kmv[4][4], av4[4][4];
    float ss = 0.f;
#pragma unroll
    for (int nf = 0; nf < 4; ++nf) {
      const int c = wv * 64 + nf * 16 + fq * 4;
      const size_t o = (size_t)tok * 256 + c;
      const u16* pc = P + (size_t)tok * 2176 + c;
      const u32x2 r_c = *(const u32x2*)(pc), k_c = *(const u32x2*)(pc + 256), v_c = *(const u32x2*)(pc + 512);
      u32x2 r_p = u32x2{0u, 0u}, k_p = u32x2{0u, 0u}, v_p = u32x2{0u, 0u};
      if (hasp) { r_p = *(const u32x2*)(pc - 2176); k_p = *(const u32x2*)(pc - 2176 + 256); v_p = *(const u32x2*)(pc - 2176 + 512); }
      const f32x4 mur = *(const f32x4*)(mu + c), muk = *(const f32x4*)(mu + 256 + c), muv = *(const f32x4*)(mu + 512 + c);
      const f32x4 w0 = *(const f32x4*)(p.in[7] + l * 256 + c), a0 = *(const f32x4*)(p.in[9] + l * 256 + c);
      const f32x4 kkc = *(const f32x4*)(p.in[15] + l * 256 + c), kac = *(const f32x4*)(p.in[16] + l * 256 + c);
      f32x4 v0 = f32x4{0.f, 0.f, 0.f, 0.f};
      if (l > 0) v0 = *(const f32x4*)(p.in[12] + c);
      u32x2 vfraw = u32x2{0u, 0u};
      if (l > 0) vfraw = *(const u32x2*)(VF + o);
      float rr[4], kk_[4], vv[4], dec[4], gg[4];
#pragma unroll
      for (int e = 0; e < 4; ++e) {
        const unsigned rc = e < 2 ? r_c.x : r_c.y, rp = e < 2 ? r_p.x : r_p.y;
        const unsigned kc = e < 2 ? k_c.x : k_c.y, kp = e < 2 ? k_p.x : k_p.y;
        const unsigned vc = e < 2 ? v_c.x : v_c.y, vp = e < 2 ? v_p.x : v_p.y;
        const unsigned vfr = e < 2 ? vfraw.x : vfraw.y;
        const float rcf = (e & 1) ? bfhi(rc) : bflo(rc), rpf = (e & 1) ? bfhi(rp) : bflo(rp);
        const float kcf = (e & 1) ? bfhi(kc) : bflo(kc), kpf = (e & 1) ? bfhi(kp) : bflo(kp);
        const float vcf = (e & 1) ? bfhi(vc) : bflo(vc), vpf = (e & 1) ? bfhi(vp) : bflo(vp);
        const float r = rcf + (rpf - rcf) * mur[e];
        const float k = kcf + (kpf - kcf) * muk[e];
        float v = vcf + (vpf - vcf) * muv[e];
        const float wl = w0[e] + cw[nf][e];
        const float z = -wl;
        const float sp = (z > 15.f) ? z : __logf(1.f + __expf(z));
        dec[e] = __expf(-__expf(-sp - 0.5f));
        const float a = sigmoidf_(a0[e] + ca[nf][e]);
        gg[e] = cg[nf][e];
        if (l > 0) { const float vf = (e & 1) ? bfhi(vfr) : bflo(vfr); v = v + (vf - v) * sigmoidf_(v0[e] + cv[nf][e]); }
        const float kk = k * kkc[e];
        ss += kk * kk;
        rr[e] = r; vv[e] = v; kk_[e] = kk; kkv[nf][e] = kk;
        kmv[nf][e] = k * (1.f + (a - 1.f) * kac[e]); av4[nf][e] = a;
      }
      *(u32x2*)(SR + o) = u32x2{pack2(rr[0], rr[1]), pack2(rr[2], rr[3])};
      *(u32x2*)(SV + o) = u32x2{pack2(vv[0], vv[1]), pack2(vv[2], vv[3])};
      if (l == 0) *(u32x2*)(VF + o) = u32x2{pack2(vv[0], vv[1]), pack2(vv[2], vv[3])};
      *(u32x2*)(G + o) = u32x2{pack2(gg[0], gg[1]), pack2(gg[2], gg[3])};
      *(f32x4*)(SW + o) = f32x4{dec[0], dec[1], dec[2], dec[3]};
    }
    ss += __shfl_xor(ss, 16, 64);
    ss += __shfl_xor(ss, 32, 64);
    const float inv = 1.f / fmaxf(sqrtf(ss), 1e-12f);
#pragma unroll
    for (int nf = 0; nf < 4; ++nf) {
      const size_t o = (size_t)tok * 256 + wv * 64 + nf * 16 + fq * 4;
      *(u32x2*)(SKK + o) = u32x2{pack2(kkv[nf][0] * inv, kkv[nf][1] * inv), pack2(kkv[nf][2] * inv, kkv[nf][3] * inv)};
      *(u32x2*)(SK + o) = u32x2{pack2(kmv[nf][0], kmv[nf][1]), pack2(kmv[nf][2], kmv[nf][3])};
      *(u32x2*)(SA + o) = u32x2{pack2(av4[nf][0], av4[nf][1]), pack2(av4[nf][2], av4[nf][3])};
    }
  }
  __syncthreads();
}

__device__ __forceinline__ void sg_item(const Params& p, int l, int item, unsigned char* smem) {
  const int tid = TIDX, lane = tid & 63, wv = tid >> 6;
  u16* vsT = (u16*)smem;
  float* smu = (float*)(smem + 16384);
  float* srs = smu + 128;
  const u16* P = (const u16*)(p.ws + OFF_PABC);
  const int g = item & 3, chn = item >> 2;
  const int tok0 = chn * 128;
  if (tid < 128) {
    const f32x2 ms = *(const f32x2*)((const float*)(p.ws + OFF_SGST) + (size_t)(tok0 + tid) * 2);
    smu[tid] = ms.x; srs[tid] = ms.y;
  }
  __syncthreads();
  {
    const int c = tid & 63, tb = tid >> 6;
    const float lw = p.in[21][l * 256 + g * 64 + c], lb = p.in[22][l * 256 + g * 64 + c];
#pragma unroll
    for (int j = 0; j < 4; ++j) {
      u16 raw[8];
#pragma unroll
      for (int e = 0; e < 8; ++e) raw[e] = P[(size_t)(tok0 + tb * 32 + j * 8 + e) * 2176 + 896 + 256 + g * 64 + c];
      float vv[8];
#pragma unroll
      for (int e = 0; e < 8; ++e) {
        const int t = tb * 32 + j * 8 + e;
        vv[e] = (geluf_(bf2f(raw[e])) - smu[t]) * srs[t] * lw + lb;
      }
      const int phys = (tb * 4 + j) ^ (c & 15);
      *(u32x4*)(vsT + c * 128 + phys * 8) = u32x4{pack2(vv[0], vv[1]), pack2(vv[2], vv[3]), pack2(vv[4], vv[5]), pack2(vv[6], vv[7])};
    }
  }
  __syncthreads();
  {
    const int fr = lane & 15, fq = lane >> 4;
    const u16* Wm = (const u16*)(p.ws + OFF_SGW) + (size_t)g * 128 * 128;
    f32x4 acc[2][4];
#pragma unroll
    for (int i = 0; i < 2; ++i)
#pragma unroll
      for (int j = 0; j < 4; ++j) acc[i][j] = f32x4{0.f, 0.f, 0.f, 0.f};
    for (int ks = 0; ks <= wv; ++ks) {
      bf16x8 fa[2], fb[4];
#pragma unroll
      for (int i = 0; i < 2; ++i) fa[i] = *(const bf16x8*)(Wm + (size_t)(32 * wv + 16 * i + fr) * 128 + ks * 32 + fq * 8);
#pragma unroll
      for (int j = 0; j < 4; ++j) fb[j] = *(const bf16x8*)(vsT + (j * 16 + fr) * 128 + (((ks * 4 + fq) ^ fr) << 3));
#pragma unroll
      for (int i = 0; i < 2; ++i)
#pragma unroll
        for (int j = 0; j < 4; ++j) acc[i][j] = __builtin_amdgcn_mfma_f32_16x16x32_bf16(fb[j], fa[i], acc[i][j], 0, 0, 0);
    }
    const float* bs = p.in[24] + ((size_t)l * 4 + g) * 128;
    u16* UB = (u16*)(p.ws + OFF_UB);
#pragma unroll
    for (int i = 0; i < 2; ++i) {
      const int t = 32 * wv + 16 * i + fr;
      const float bsv = bs[t];
#pragma unroll
      for (int j = 0; j < 4; ++j) {
        const int cc = j * 16 + fq * 4;
        u32x2 ur = *(const u32x2*)(P + (size_t)(tok0 + t) * 2176 + 896 + g * 64 + cc);
        float o0 = geluf_(bflo(ur.x)) * (acc[i][j][0] + bsv), o1 = geluf_(bfhi(ur.x)) * (acc[i][j][1] + bsv);
        float o2 = geluf_(bflo(ur.y)) * (acc[i][j][2] + bsv), o3 = geluf_(bfhi(ur.y)) * (acc[i][j][3] + bsv);
        *(u32x2*)(UB + (size_t)(tok0 + t) * 256 + g * 64 + cc) = u32x2{pack2(o0, o1), pack2(o2, o3)};
      }
    }
  }
  __syncthreads();
}

__device__ __forceinline__ void conv_item(const Params& p, int l, int item) {
  const int j = TIDX;
  const u16* P = (const u16*)(p.ws + OFF_PABC);
  u16* CB = (u16*)(p.ws + OFF_CB);
  const float c0 = p.in[26][(l * 3 + 0) * 256 + j], c1 = p.in[26][(l * 3 + 1) * 256 + j], c2 = p.in[26][(l * 3 + 2) * 256 + j];
  const int tok0 = item * 8;
  u16 rc[10], rx[10], rb[8];
  const bool first = (tok0 & (SEQ - 1)) == 0;
#pragma unroll
  for (int t = 0; t < 10; ++t) {
    const int tok = (first && t < 2) ? tok0 : tok0 + t - 2;
    const u16* q = P + (size_t)tok * 2176 + 1408;
    rc[t] = q[256 + j]; rx[t] = q[512 + j];
    if (t >= 2) rb[t - 2] = q[j];
  }
  float z[10];
#pragma unroll
  for (int t = 0; t < 10; ++t) z[t] = bf2f(rc[t]) * bf2f(rx[t]);
  if (first) { z[0] = 0.f; z[1] = 0.f; }
#pragma unroll
  for (int t = 0; t < 8; ++t) {
    float y = c0 * z[t] + c1 * z[t + 1] + c2 * z[t + 2];
    CB[(size_t)(tok0 + t) * 256 + j] = f2bf(bf2f(rb[t]) * y);
  }
}

__device__ __forceinline__ void s5_load_u(const u16* us, int t, int wv, float (&u)[16]) {
  const u32x4* q = (const u32x4*)(us + t * 64 + wv * 16);
  u32x4 a = q[0], b = q[1];
  u[0] = bflo(a.x); u[1] = bfhi(a.x); u[2] = bflo(a.y); u[3] = bfhi(a.y);
  u[4] = bflo(a.z); u[5] = bfhi(a.z); u[6] = bflo(a.w); u[7] = bfhi(a.w);
  u[8] = bflo(b.x); u[9] = bfhi(b.x); u[10] = bflo(b.y); u[11] = bfhi(b.y);
  u[12] = bflo(b.z); u[13] = bfhi(b.z); u[14] = bflo(b.w); u[15] = bfhi(b.w);
}
__device__ __forceinline__ void s5_stage_u(const u16* __restrict__ PD, int tok0, int gq, u16* us) {
#pragma unroll
  for (int i = 0; i < 2; ++i) {
    const int ch = TIDX + 256 * i;
    const int t = ch >> 3, part = ch & 7;
    *(u32x4*)(us + t * 64 + part * 8) = *(const u32x4*)(PD + (size_t)(tok0 + t) * 256 + gq * 64 + part * 8);
  }
}

__device__ __forceinline__ void s5a_item(const Params& p, int l, int item, unsigned char* smem) {
  const int lane = TIDX & 63, wv = TIDX >> 6;
  const int gq = item & 3, bc = item >> 2;
  const int g = gq * 4 + wv;
  const int tok0 = bc * 64;
  const u16* PD = (const u16*)(p.ws + OFF_PD);
  const float* ab = (const float*)(p.ws + OFF_S5AB) + ((size_t)(l * 16 + g) * 64 + lane) * 2;
  const float* bb = (const float*)(p.ws + OFF_S5BB) + ((size_t)(l * 16 + g) * 64 + lane) * 32;
  float bbr[16], bbi[16];
#pragma unroll
  for (int c = 0; c < 16; ++c) { bbr[c] = bb[c]; bbi[c] = bb[16 + c]; }
  const float abr = ab[0], abi = ab[1];
  float xr = 0.f, xi = 0.f;
  u16* us = (u16*)smem;
  s5_stage_u(PD, tok0, gq, us);
  __syncthreads();
#pragma unroll 4
  for (int t = 0; t < 64; ++t) {
    float u[16];
    s5_load_u(us, t, wv, u);
    float bur = 0.f, bui = 0.f;
#pragma unroll
    for (int c = 0; c < 16; ++c) { bur += bbr[c] * u[c]; bui += bbi[c] * u[c]; }
    float nr = abr * xr - abi * xi + bur;
    float ni = abr * xi + abi * xr + bui;
    xr = nr; xi = ni;
  }
  float2* E = (float2*)(p.ws + OFF_S5E);
  E[((size_t)bc * 16 + g) * 64 + lane] = make_float2(xr, xi);
  __syncthreads();
}

__device__ __forceinline__ void s5b_item(const Params& p, int l, int item, unsigned char* smem) {
  const int lane = TIDX & 63, wv = TIDX >> 6;
  const int gq = item & 3, bc = item >> 2;
  const int b = bc >> 6, ch = bc & 63;
  const int g = gq * 4 + wv;
  const int tok0 = bc * 64;
  u16* us = (u16*)(smem + 65536);
  s5_stage_u((const u16*)(p.ws + OFF_PD), tok0, gq, us);
  float* base = (float*)smem + wv * 4096;
  float* csr = base, *csi = base + 1024, *xsr = base + 2048, *xsi = base + 3072;
  const u16* PD = (const u16*)(p.ws + OFF_PD);
  const float* ab = (const float*)(p.ws + OFF_S5AB) + ((size_t)(l * 16 + g) * 64 + lane) * 2;
  const float* bb = (const float*)(p.ws + OFF_S5BB) + ((size_t)(l * 16 + g) * 64 + lane) * 32;
  const float* cre = p.in[32] + ((size_t)(l * 16 + g) * 16) * 64;
  const float* cim = p.in[33] + ((size_t)(l * 16 + g) * 16) * 64;
  for (int c = 0; c < 16; ++c) {
    csr[(lane >> 2) * 64 + c * 4 + (lane & 3)] = cre[c * 64 + lane];
    csi[(lane >> 2) * 64 + c * 4 + (lane & 3)] = cim[c * 64 + lane];
  }
  float bbr[16], bbi[16];
#pragma unroll
  for (int c = 0; c < 16; ++c) { bbr[c] = bb[c]; bbi[c] = bb[16 + c]; }
  const float abr = ab[0], abi = ab[1];
  float pr = abr, pi = abi;
#pragma unroll
  for (int s = 0; s < 6; ++s) { float nr = pr * pr - pi * pi, ni = 2.f * pr * pi; pr = nr; pi = ni; }
  float xr = 0.f, xi = 0.f;
  const float2* E = (const float2*)(p.ws + OFF_S5E);
  {
    const f32x2* Ev = (const f32x2*)E + ((size_t)(b * 64) * 16 + g) * 64 + lane;
    int c = 0;
    for (; c + 8 <= ch; c += 8) {
      f32x2 e[8];
#pragma unroll
      for (int k = 0; k < 8; ++k) e[k] = Ev[(size_t)(c + k) * 1024];
#pragma unroll
      for (int k = 0; k < 8; ++k) {
        const float nr = pr * xr - pi * xi + e[k].x;
        const float ni = pr * xi + pi * xr + e[k].y;
        xr = nr; xi = ni;
      }
    }
    for (; c < ch; ++c) {
      const f32x2 e = Ev[(size_t)c * 1024];
      const float nr = pr * xr - pi * xi + e.x;
      const float ni = pr * xi + pi * xr + e.y;
      xr = nr; xi = ni;
    }
  }
  const int tt = lane & 15, cq = lane >> 4;
  const float* dvec = p.in[34] + l * 256 + g * 16 + cq * 4;
  const float d0 = dvec[0], d1 = dvec[1], d2 = dvec[2], d3 = dvec[3];
  u16* YD = (u16*)(p.ws + OFF_YD);
  const int n4w = lane >> 2, e4 = lane & 3;
  __syncthreads();
#pragma unroll 1
  for (int sc = 0; sc < 4; ++sc) {
    for (int t = 0; t < 16; ++t) {
      float u[16];
      s5_load_u(us, sc * 16 + t, wv, u);
      float bur = 0.f, bui = 0.f;
#pragma unroll
      for (int c = 0; c < 16; ++c) { bur += bbr[c] * u[c]; bui += bbi[c] * u[c]; }
      float nr = abr * xr - abi * xi + bur;
      float ni = abr * xi + abi * xr + bui;
      xr = nr; xi = ni;
      int a = n4w * 64 + ((t ^ (n4w & 7)) << 2) + e4;
      xsr[a] = xr; xsi[a] = xi;
    }
    __syncthreads();
    float acc0 = 0.f, acc1 = 0.f, acc2 = 0.f, acc3 = 0.f;
#pragma unroll 2
    for (int n4 = 0; n4 < 16; ++n4) {
      int xa = n4 * 64 + ((tt ^ (n4 & 7)) << 2);
      float4 xr4 = *(const float4*)(xsr + xa);
      float4 xi4 = *(const float4*)(xsi + xa);
      const float* cr = csr + n4 * 64 + cq * 16;
      const float* ci = csi + n4 * 64 + cq * 16;
      float4 r0 = *(const float4*)(cr), r1 = *(const float4*)(cr + 4), r2 = *(const float4*)(cr + 8), r3 = *(const float4*)(cr + 12);
      float4 i0 = *(const float4*)(ci), i1 = *(const float4*)(ci + 4), i2 = *(const float4*)(ci + 8), i3 = *(const float4*)(ci + 12);
      acc0 += r0.x * xr4.x + r0.y * xr4.y + r0.z * xr4.z + r0.w * xr4.w - (i0.x * xi4.x + i0.y * xi4.y + i0.z * xi4.z + i0.w * xi4.w);
      acc1 += r1.x * xr4.x + r1.y * xr4.y + r1.z * xr4.z + r1.w * xr4.w - (i1.x * xi4.x + i1.y * xi4.y + i1.z * xi4.z + i1.w * xi4.w);
      acc2 += r2.x * xr4.x + r2.y * xr4.y + r2.z * xr4.z + r2.w * xr4.w - (i2.x * xi4.x + i2.y * xi4.y + i2.z * xi4.z + i2.w * xi4.w);
      acc3 += r3.x * xr4.x + r3.y * xr4.y + r3.z * xr4.z + r3.w * xr4.w - (i3.x * xi4.x + i3.y * xi4.y + i3.z * xi4.z + i3.w * xi4.w);
    }
    {
      const int tok = tok0 + sc * 16 + tt;
      u32x2 ur = *(const u32x2*)(us + (sc * 16 + tt) * 64 + wv * 16 + cq * 4);
      float y0 = acc0 + d0 * bflo(ur.x), y1 = acc1 + d1 * bfhi(ur.x), y2 = acc2 + d2 * bflo(ur.y), y3 = acc3 + d3 * bfhi(ur.y);
      u32x2 o; o.x = pack2(geluf_(y0), geluf_(y1)); o.y = pack2(geluf_(y2), geluf_(y3));
      *(u32x2*)(YD + (size_t)tok * 256 + g * 16 + cq * 4) = o;
    }
    __syncthreads();
  }
}

__device__ __forceinline__ void lds_barrier() {
  asm volatile("s_waitcnt lgkmcnt(0)" ::: "memory");
  __builtin_amdgcn_s_barrier();
  asm volatile("" ::: "memory");
}
__device__ __forceinline__ void scan_item(const Params& p, int item, unsigned char* smem) {
  const int tid = TIDX, lane = tid & 63, wv = tid >> 6;
  const int b = item >> 4, h = (item >> 2) & 3, q = item & 3;
  const int rl = lane >> 4, cl = lane & 15;
  const int rloc = wv * 4 + rl;
  const size_t tokb = (size_t)b * SEQ;
  const int chan0 = h * 64;
  const u16* SR = (const u16*)(p.ws + OFF_SR); const u16* SK = (const u16*)(p.ws + OFF_SK);
  const u16* SV = (const u16*)(p.ws + OFF_SV); const u16* SKK = (const u16*)(p.ws + OFF_SKK);
  const u16* SA = (const u16*)(p.ws + OFF_SA); const float* SW = (const float*)(p.ws + OFF_SW);
  float* O = (float*)(p.ws + OFF_O);
  constexpr int BUFF = 6432;
  float* lbase = (float*)smem;
  float* pp = lbase + 2 * BUFF + wv * 1024;
  const int st = tid >> 4, cg4 = tid & 15;
  struct Stg { u32x2 r, k, kk, a, kk1; f32x4 w; u16 v; };
  auto gload = [&](Stg& g, int c) {
    const size_t o = (tokb + (size_t)c * 16 + st) * 256 + chan0;
    g.r = *(const u32x2*)(SR + o + cg4 * 4); g.k = *(const u32x2*)(SK + o + cg4 * 4);
    g.kk = *(const u32x2*)(SKK + o + cg4 * 4); g.a = *(const u32x2*)(SA + o + cg4 * 4);
    g.w = *(const f32x4*)(SW + o + cg4 * 4);
    g.v = SV[o + q * 16 + cg4];
    int t1 = c * 16 + st + 1; if (t1 >= SEQ) t1 = SEQ - 1;
    g.kk1 = *(const u32x2*)(SKK + (tokb + (size_t)t1) * 256 + chan0 + cg4 * 4);
  };
  auto lwrite = [&](const Stg& g, int buf) {
    float* bp = lbase + buf * BUFF;
    const int o = st * 64 + cg4 * 4;
    f32x4 kk = {bflo(g.kk.x), bfhi(g.kk.x), bflo(g.kk.y), bfhi(g.kk.y)};
    f32x4 a = {bflo(g.a.x), bfhi(g.a.x), bflo(g.a.y), bfhi(g.a.y)};
    f32x4 k = {bflo(g.k.x), bfhi(g.k.x), bflo(g.k.y), bfhi(g.k.y)};
    f32x4 r = {bflo(g.r.x), bfhi(g.r.x), bflo(g.r.y), bfhi(g.r.y)};
    *(f32x4*)(bp + o) = kk;
    *(f32x4*)(bp + 1024 + o) = kk * a;
    *(f32x4*)(bp + 2048 + o) = k;
    *(f32x4*)(bp + 3072 + o) = g.w;
    *(f32x4*)(bp + 4096 + o) = r;
    bp[5120 + st * 16 + cg4] = bf2f(g.v);
    const f32x4 kn = {bflo(g.kk1.x), bfhi(g.kk1.x), bflo(g.kk1.y), bfhi(g.kk1.y)};
    *(f32x4*)(bp + 5376 + o) = g.w * kn;
    const f32x4 bb = kk * a;
    const float c1 = row_sum16(k.x * kn.x + k.y * kn.y + k.z * kn.z + k.w * kn.w);
    const float c2 = row_sum16(bb.x * kn.x + bb.y * kn.y + bb.z * kn.z + bb.w * kn.w);
    if (cg4 == 0) *(f32x2*)(bp + 6400 + st * 2) = f32x2{c1, c2};
  };
  constexpr int NCH = SEQ / 16;
  Stg R0, R1, R2, R3;
  gload(R0, 0); gload(R1, 1); gload(R2, 2); gload(R3, 3);
  __syncthreads();
  lwrite(R0, 0);
  __syncthreads();
  __builtin_amdgcn_s_setprio(3);
  float S0 = 0.f, S1 = 0.f, S2 = 0.f, S3 = 0.f;
  const int rrow = lane & 3, rstep = lane >> 2;
  struct Pair { f32x4 kkA, bbA, kA, wA, rA, mA, bbB, kB, wB, rB; f32x2 cA; float vA, vB; };
  auto chunk = [&](int c) {
    const float* bp = lbase + (c & 1) * BUFF;
    auto ldpair = [&](Pair& o, int s) {
      o.kkA = *(const f32x4*)(bp + s * 64 + cl * 4);
      o.mA = *(const f32x4*)(bp + 5376 + s * 64 + cl * 4);
      o.bbA = *(const f32x4*)(bp + 1024 + s * 64 + cl * 4);
      o.kA = *(const f32x4*)(bp + 2048 + s * 64 + cl * 4);
      o.wA = *(const f32x4*)(bp + 3072 + s * 64 + cl * 4);
      o.rA = *(const f32x4*)(bp + 4096 + s * 64 + cl * 4);
      o.vA = bp[5120 + s * 16 + rloc];
      o.cA = *(const f32x2*)(bp + 6400 + s * 2);
      o.bbB = *(const f32x4*)(bp + 1024 + (s + 1) * 64 + cl * 4);
      o.kB = *(const f32x4*)(bp + 2048 + (s + 1) * 64 + cl * 4);
      o.wB = *(const f32x4*)(bp + 3072 + (s + 1) * 64 + cl * 4);
      o.rB = *(const f32x4*)(bp + 4096 + (s + 1) * 64 + cl * 4);
      o.vB = bp[5120 + (s + 1) * 16 + rloc];
    };
    auto pairstep = [&](const Pair& o, int s) {
      const float pa = __builtin_fmaf(S3, o.kkA.w, __builtin_fmaf(S2, o.kkA.z, __builtin_fmaf(S1, o.kkA.y, S0 * o.kkA.x)));
      const float pd = __builtin_fmaf(S3, o.mA.w, __builtin_fmaf(S2, o.mA.z, __builtin_fmaf(S1, o.mA.y, S0 * o.mA.x)));
      const float saA = row_sum16(pa);
      const float dd = row_sum16(pd);
      const float saB = __builtin_fmaf(-saA, o.cA.y, __builtin_fmaf(o.vA, o.cA.x, dd));
      S0 = __builtin_fmaf(S0, o.wA.x, __builtin_fmaf(o.vA, o.kA.x, -(saA * o.bbA.x)));
      S1 = __builtin_fmaf(S1, o.wA.y, __builtin_fmaf(o.vA, o.kA.y, -(saA * o.bbA.y)));
      S2 = __builtin_fmaf(S2, o.wA.z, __builtin_fmaf(o.vA, o.kA.z, -(saA * o.bbA.z)));
      S3 = __builtin_fmaf(S3, o.wA.w, __builtin_fmaf(o.vA, o.kA.w, -(saA * o.bbA.w)));
      pp[(s * 4 + rl) * 16 + cl] = __builtin_fmaf(S3, o.rA.w, __builtin_fmaf(S2, o.rA.z, __builtin_fmaf(S1, o.rA.y, S0 * o.rA.x)));
      S0 = __builtin_fmaf(S0, o.wB.x, __builtin_fmaf(o.vB, o.kB.x, -(saB * o.bbB.x)));
      S1 = __builtin_fmaf(S1, o.wB.y, __builtin_fmaf(o.vB, o.kB.y, -(saB * o.bbB.y)));
      S2 = __builtin_fmaf(S2, o.wB.z, __builtin_fmaf(o.vB, o.kB.z, -(saB * o.bbB.z)));
      S3 = __builtin_fmaf(S3, o.wB.w, __builtin_fmaf(o.vB, o.kB.w, -(saB * o.bbB.w)));
      pp[((s + 1) * 4 + rl) * 16 + cl] = __builtin_fmaf(S3, o.rB.w, __builtin_fmaf(S2, o.rB.z, __builtin_fmaf(S1, o.rB.y, S0 * o.rB.x)));
    };
    Pair p0, p1;
    ldpair(p0, 0);
#pragma unroll
    for (int j = 0; j < 4; ++j) {
      ldpair(p1, 4 * j + 2);
      __builtin_amdgcn_sched_barrier(0);
      pairstep(p0, 4 * j);
      __builtin_amdgcn_sched_barrier(0);
      if (j < 3) ldpair(p0, 4 * j + 4);
      __builtin_amdgcn_sched_barrier(0);
      pairstep(p1, 4 * j + 2);
      __builtin_amdgcn_sched_barrier(0);
    }
    asm volatile("" ::: "memory");
    {
      const float* q0 = pp + (rstep * 4 + rrow) * 16;
      f32x4 a0 = *(const f32x4*)(q0), a1 = *(const f32x4*)(q0 + 4), a2 = *(const f32x4*)(q0 + 8), a3 = *(const f32x4*)(q0 + 12);
      f32x4 sm4 = (a0 + a1) + (a2 + a3);
      O[(tokb + (size_t)c * 16 + rstep) * 256 + chan0 + q * 16 + wv * 4 + rrow] = (sm4.x + sm4.y) + (sm4.z + sm4.w);
    }
    asm volatile("" ::: "memory");
  };
#pragma unroll 1
  for (int g = 0; g < NCH / 4; ++g) {
    const int c0 = g * 4;
    if (c0 + 4 < NCH) gload(R0, c0 + 4);
    chunk(c0);
    lwrite(R1, (c0 + 1) & 1);
    lds_barrier();
    if (c0 + 5 < NCH) gload(R1, c0 + 5);
    chunk(c0 + 1);
    lwrite(R2, (c0 + 2) & 1);
    lds_barrier();
    if (c0 + 6 < NCH) gload(R2, c0 + 6);
    chunk(c0 + 2);
    lwrite(R3, (c0 + 3) & 1);
    lds_barrier();
    if (c0 + 7 < NCH) gload(R3, c0 + 7);
    chunk(c0 + 3);
    if (c0 + 4 < NCH) lwrite(R0, (c0 + 4) & 1);
    lds_barrier();
  }
  __builtin_amdgcn_s_setprio(0);
}

__device__ __forceinline__ void rwkv_post_item(const Params& p, int l, int item) {
  const int j = TIDX;
  const float* O = (const float*)(p.ws + OFF_O);
  const u16* SR = (const u16*)(p.ws + OFF_SR); const u16* SK = (const u16*)(p.ws + OFF_SK);
  const u16* SV = (const u16*)(p.ws + OFF_SV); const u16* G = (const u16*)(p.ws + OFF_G);
  u16* OG = (u16*)(p.ws + OFF_OG);
  const float lw = p.in[18][l * 256 + j], lb = p.in[19][l * 256 + j], rk = p.in[17][l * 256 + j];
  const int tok0 = item * 8;
  float ov[8]; u16 rr[8], rkk[8], rv[8], rg[8];
#pragma unroll
  for (int t = 0; t < 8; ++t) {
    const size_t o = (size_t)(tok0 + t) * 256 + j;
    ov[t] = O[o]; rr[t] = SR[o]; rkk[t] = SK[o]; rv[t] = SV[o]; rg[t] = G[o];
  }
#pragma unroll
  for (int t = 0; t < 8; ++t) {
    const size_t o = (size_t)(tok0 + t) * 256 + j;
    float mean = wave_sum(ov[t]) * (1.f / 64.f);
    float d = ov[t] - mean;
    float var = wave_sum(d * d) * (1.f / 64.f);
    float on = d * rsqrtf(var + 64e-5f) * lw + lb;
    float bonus = wave_sum(bf2f(rr[t]) * bf2f(rkk[t]) * rk);
    OG[o] = f2bf((on + bonus * bf2f(rv[t])) * bf2f(rg[t]));
  }
}

#define XB_TMO      128
#define XB_XCNT(j)  (256  + 64 * (j))
#define XB_XSUB(j)  (1280 + 64 * (j))
#define XB_XGEN(j)  (2304 + 64 * (j))
#define XB_TOP      3328
#define XB_TOPGEN   3392
#define XCD_BAR_WORDS 3456
#define XB_SPIN_CAP (1u << 22)
#define LAS __attribute__((address_space(3)))
__device__ __forceinline__ unsigned xb_ld(unsigned* p) { return __hip_atomic_load(p, __ATOMIC_RELAXED, __HIP_MEMORY_SCOPE_AGENT); }
__device__ __forceinline__ unsigned xb_add(unsigned* p, unsigned v) { return __hip_atomic_fetch_add(p, v, __ATOMIC_RELAXED, __HIP_MEMORY_SCOPE_AGENT); }
__device__ __forceinline__ unsigned xb_xcc_id() { return (unsigned)__builtin_amdgcn_s_getreg((3 << 11) | 20) & 0xFu; }
#define XB_SPIN(cond, bar) do { unsigned _sp = 0; while (cond) { __builtin_amdgcn_s_sleep(1); \
    if ((++_sp & 255u) == 0u) { if (xb_ld(&(bar)[XB_TMO])) break; if (_sp > XB_SPIN_CAP) { atomicAdd(&(bar)[XB_TMO], 1u); break; } } } } while (0)
struct XcdBarrier { unsigned* bar; unsigned x; volatile LAS unsigned* st; };
__device__ __forceinline__ XcdBarrier xcd_barrier_post(unsigned* bar, volatile LAS unsigned* st) {
  XcdBarrier b; b.bar = bar; b.x = xb_xcc_id(); b.st = st;
  if (threadIdx.x == 0) st[2] = xb_add(&bar[XB_XCNT(b.x)], 1u);
  return b;
}
__device__ __forceinline__ void xcd_barrier_complete(unsigned* bar, unsigned x, unsigned& nloc, unsigned& nx) {
  const unsigned G = gridDim.x * gridDim.y * gridDim.z;
  unsigned sum, cnt, mine, sp = 0u;
  for (;;) {
    sum = 0u; cnt = 0u; mine = 0u;
#pragma unroll
    for (unsigned j = 0; j < 16; ++j) { const unsigned c = xb_ld(&bar[XB_XCNT(j)]); sum += c; cnt += (c > 0u) ? 1u : 0u; mine = (j == x) ? c : mine; }
    if (sum == G) break;
    __builtin_amdgcn_s_sleep(1);
    if ((++sp & 255u) == 0u) { if (xb_ld(&bar[XB_TMO])) break; if (sp > XB_SPIN_CAP) { atomicAdd(&bar[XB_TMO], 1u); break; } }
  }
  nloc = mine > 0u ? mine : 1u; nx = cnt > 0u ? cnt : 1u;
}
__device__ __forceinline__ void xcd_barrier(const XcdBarrier& b) {
  asm volatile("s_waitcnt vmcnt(0)" ::: "memory");
  __syncthreads();
  if (threadIdx.x == 0) {
    unsigned* bar = b.bar;
    __builtin_amdgcn_s_waitcnt(0);
    unsigned nloc = b.st[0], nx = b.st[1];
    if (nloc == 0u) { xcd_barrier_complete(bar, b.x, nloc, nx); b.st[0] = nloc; b.st[1] = nx; }
    const unsigned old = xb_add(&bar[XB_XSUB(b.x)], 1u);
    const unsigned gen = old / nloc;
    if (old + 1u == (gen + 1u) * nloc) {
      __builtin_amdgcn_fence(__ATOMIC_RELEASE, "agent");
      asm volatile("s_waitcnt vmcnt(0)" ::: "memory");
      const unsigned og = xb_add(&bar[XB_TOP], 1u);
      const unsigned tg = og / nx;
      if (og + 1u == (tg + 1u) * nx) xb_add(&bar[XB_TOPGEN], 1u);
      else XB_SPIN(xb_ld(&bar[XB_TOPGEN]) == tg, bar);
      __builtin_amdgcn_fence(__ATOMIC_ACQUIRE, "agent");
      xb_add(&bar[XB_XGEN(b.x)], 1u);
      asm volatile("s_waitcnt vmcnt(0)" ::: "memory");
    } else {
      XB_SPIN(xb_ld(&bar[XB_XGEN(b.x)]) == gen, bar);
      __builtin_amdgcn_fence(__ATOMIC_ACQUIRE, "agent");
      asm volatile("s_waitcnt vmcnt(0)" ::: "memory");
    }
  }
  __syncthreads();
}

__device__ __forceinline__ int xcd_virtual_id(const XcdBarrier& b) {
  if (threadIdx.x == 0) {
    unsigned base = 0u;
#pragma unroll
    for (unsigned j = 0; j < 16; ++j) { const unsigned c = xb_ld(&b.bar[XB_XCNT(j)]); base += (j < b.x) ? c : 0u; }
    b.st[3] = base + b.st[2];
  }
  __syncthreads();
  const int vb = __builtin_amdgcn_readfirstlane((int)b.st[3]);
  __syncthreads();
  return vb;
}

__device__ __forceinline__ void sub_barrier(unsigned* cnt, unsigned target) {
  asm volatile("s_waitcnt vmcnt(0)" ::: "memory");
  __syncthreads();
  if (threadIdx.x == 0) {
    __builtin_amdgcn_fence(__ATOMIC_RELEASE, "agent");
    asm volatile("s_waitcnt vmcnt(0)" ::: "memory");
    xb_add(cnt, 1u);
    unsigned sp = 0;
    while (xb_ld(cnt) < target) { __builtin_amdgcn_s_sleep(2); if (++sp > (1u << 24)) break; }
    __builtin_amdgcn_fence(__ATOMIC_ACQUIRE, "agent");
    asm volatile("s_waitcnt vmcnt(0)" ::: "memory");
  }
  __syncthreads();
}

#define N_PHASES 22
#ifndef PROBE_CONV_REPS
#define PROBE_CONV_REPS 1
#endif
#ifndef PROBE_PREP_REPS
#define PROBE_PREP_REPS 1
#endif
#ifndef PROBE_POST_REPS
#define PROBE_POST_REPS 1
#endif
#ifndef PROBE_SCAN_REPS
#define PROBE_SCAN_REPS 1
#endif
#ifndef PROBE_FFN1_REPS
#define PROBE_FFN1_REPS 1
#endif
#ifndef PH_MASK
#define PH_MASK 0xFFFFF
#endif
#define PHON(s) (PH_MASK & (1 << (s)))
#define PHASE_BEGIN(k) if (ph_hi > (k)) { if ((k) > 1) xcd_barrier(xb);
#define PHASE_END }

template <int L>
__device__ __forceinline__ void run_layer(const Params& p, int vbr, int ph_hi, unsigned char* smem_all, const XcdBarrier& xb) {
  unsigned char* smem = smem_all + SUBB * 73728;
  const int vb = vbr * 2 + SUBB;
  constexpr int l = L;
  constexpr int base = 1 + 10 * L;
  const float* modl = (const float*)(p.ws + OFF_MOD) + (size_t)l * 4 * 6144;
  PHASE_BEGIN(base + 0)
    for (int rep = 0; rep < PROBE_CONV_REPS; ++rep) {
      if (rep) xcd_barrier(xb);
      phase_convert(p, l, smem);
      phase_norm(l == 0 ? p.in[0] : p.out, p.in[4] + l * 1024, modl, 0, 1024, (u16*)(p.ws + OFF_H));
    }
  PHASE_END
  PHASE_BEGIN(base + 1)
    phase_pproj_tail(p, vbr, smem_all);
    phase_gemm_8w<0>(p, l, vbr, smem_all);
  PHASE_END
  PHASE_BEGIN(base + 2)
    for (int rep = 0; rep < PROBE_PREP_REPS; ++rep) {
      if (rep) xcd_barrier(xb);
      for (int item = VBLK; item < 512; item += VGRID) rwkv_prep_item(p, l, item, smem);
    }
  PHASE_END
  PHASE_BEGIN(base + 3)
    if ((int)blockIdx.x < 64) {
      if (SUBB == 0) scan_item(p, blockIdx.x, smem);
      else { __syncthreads(); __syncthreads(); for (int c = 0; c < SEQ / 16; ++c) lds_barrier(); }
    }
    else {
      const int nb = VGRID - 128, bi = VBLK - 128;
      for (int item = bi; item < 512; item += nb) sg_item(p, l, item, smem);
      for (int item = (bi + 2 * (nb / 3)) % nb; item < 1024; item += nb) s5a_item(p, l, item, smem);
      for (int item = (bi + 2 * (nb / 3)) % nb; item < 2048; item += nb) conv_item(p, l, item);
      sub_barrier((unsigned*)(p.ws + OFF_BAR) + 3520 + 64 * (2 * l), gridDim.x - 64);
      for (int item = bi; item < 1024; item += nb) s5b_item(p, l, item, smem);
      sub_barrier((unsigned*)(p.ws + OFF_BAR) + 3520 + 64 * (2 * l + 1), gridDim.x - 64);
      for (int item = (int)blockIdx.x - 64; item < 512; item += (int)gridDim.x - 64) merge_tile8<0>(p, item, smem_all);
    }
  PHASE_END
  PHASE_BEGIN(base + 4)
    for (int rep = 0; rep < PROBE_POST_REPS; ++rep) { if (rep) xcd_barrier(xb); for (int item = VBLK; item < 2048; item += VGRID) rwkv_post_item(p, l, item); }
  PHASE_END
  PHASE_BEGIN(base + 5)
    for (int item = vbr; item < 512; item += (int)gridDim.x) {
      int it2 = item;
      if (gridDim.x == 256) { const int r = item >> 8, w = vbr & 31; it2 = ((r * 4 + (w >> 3)) << 6) | ((vbr >> 5) * 8 + (w & 7)); }
      merge_tile8<1>(p, it2, smem_all);
    }
  PHASE_END
  PHASE_BEGIN(base + 6)
    phase_gemm_8w<1>(p, l, vbr, smem_all);
  PHASE_END
  PHASE_BEGIN(base + 7)
    if (PHON(7)) phase_norm(p.out, p.in[38] + l * 1024, modl, 3072, 4096, (u16*)(p.ws + OFF_H));
  PHASE_END
  PHASE_BEGIN(base + 8)
    phase_gemm_8w<2>(p, l, vbr, smem_all);
  PHASE_END
#ifdef PROBE_DUP_FFN1
  PHASE_BEGIN(base + 8)
    phase_gemm_8w<2>(p, l, vbr, smem_all);
  PHASE_END
#endif
  PHASE_BEGIN(base + 9)
    phase_gemm_8w<3>(p, l, vbr, smem_all);
  PHASE_END
}

__global__ void __launch_bounds__(512, 2) mega_fwd(Params p, int ph_lo, int ph_hi) {
  __shared__ __attribute__((aligned(16))) unsigned char smem[2 * 73728 + 16];
  cg::grid_group grid = cg::this_grid();
  if (ph_hi < 0) grid.sync();
  volatile LAS unsigned* st = (volatile LAS unsigned*)(smem + 2 * 73728);
  if (threadIdx.x == 0) { st[0] = 0u; st[1] = 0u; st[2] = 0u; st[3] = 0u; }
  __syncthreads();
  const XcdBarrier xb = xcd_barrier_post((unsigned*)(p.ws + OFF_BAR), st);
  if (ph_hi > 0) phase_mod(p, smem + SUBB * 73728);
  xcd_barrier(xb);
  const int vb = xcd_virtual_id(xb);
  run_layer<0>(p, vb, ph_hi, smem, xb);
  run_layer<1>(p, vb, ph_hi, smem, xb);
  PHASE_BEGIN(21)
    if (PHON(11)) phase_final(p.out, p.in[41]);
  PHASE_END
}

extern "C" void kernel_launch(void* const* d_in, const int* in_sizes, int n_in, void* d_out, int out_size, void* d_ws,
                              size_t ws_size, hipStream_t stream) {
  static int grid_blocks = 0;
  if (!grid_blocks) {
    int dev = 0, cus = 0, per_cu = 0;
    hipGetDevice(&dev);
    hipDeviceGetAttribute(&cus, hipDeviceAttributeMultiprocessorCount, dev);
    hipOccupancyMaxActiveBlocksPerMultiprocessor(&per_cu, mega_fwd, 512, 0);
    if (per_cu > 1) per_cu = 1;
    if (per_cu < 1) per_cu = 1;
    grid_blocks = cus * per_cu;
    if (ws_size < WS_END) fprintf(stderr, "workspace too small: %zu < %zu\n", ws_size, (size_t)WS_END);
  }
  Params p{};
  for (int i = 0; i < 42; ++i) p.in[i] = (const float*)d_in[i];
  p.out = (float*)d_out;
  p.ws = (unsigned char*)d_ws;
  hipMemsetAsync((unsigned char*)d_ws + OFF_BAR, 0, 16384, stream);
  int lo = 0, hi = N_PHASES;
  void* args[] = {&p, &lo, &hi};
  hipError_t e = hipLaunchCooperativeKernel((void*)mega_fwd, dim3(grid_blocks), dim3(512), args, 0, stream);
  if (e != hipSuccess) fprintf(stderr, "cooperative launch failed: %s (grid %d)\n", hipGetErrorString(e), grid_blocks);
}
```

```cpp
#include <hip/hip_runtime.h>
#include <hip/hip_cooperative_groups.h>
#include <cstdio>
namespace cg = cooperative_groups;

typedef unsigned short u16;
using bf16x8 = __attribute__((ext_vector_type(8))) short;
using f32x4 = __attribute__((ext_vector_type(4))) float;
using u32x4 = __attribute__((ext_vector_type(4))) unsigned int;
using u32x2 = __attribute__((ext_vector_type(2))) unsigned int;
using f32x2 = __attribute__((ext_vector_type(2))) float;

#define T_TOK 16384
#define SEQ 4096
#define DM 1024
#define NTHR 256
#define TIDX ((int)(threadIdx.x & 255))
#define SUBB ((int)(threadIdx.x >> 8))
#define VBLK ((int)(blockIdx.x * 2 + (threadIdx.x >> 8)))
#define VGRID ((int)(gridDim.x * 2))

static constexpr size_t SZ_WIN = (size_t)6528 * 1024 * 2;
static constexpr size_t OFF_WIN = 0;
static constexpr size_t OFF_RO = OFF_WIN + SZ_WIN;
static constexpr size_t OFF_SO = OFF_RO + 1024 * 256 * 2;
static constexpr size_t OFF_CO = OFF_SO + 1024 * 256 * 2;
static constexpr size_t OFF_GLU = OFF_CO + 1024 * 256 * 2;
static constexpr size_t OFF_WO = OFF_GLU + 2048 * 256 * 2;
static constexpr size_t OFF_W1 = OFF_WO + 1024 * 1024 * 2;
static constexpr size_t OFF_W2 = OFF_W1 + (size_t)4096 * 1024 * 2;
static constexpr size_t OFF_H = OFF_W2 + (size_t)4096 * 1024 * 2;
static constexpr size_t SZ_T256B = (size_t)T_TOK * 256 * 2;
static constexpr size_t OFF_VF = OFF_H + (size_t)T_TOK * 1024 * 2;
static constexpr size_t OFF_PD = OFF_VF + SZ_T256B;
static constexpr size_t OFF_G = OFF_PD + SZ_T256B;
static constexpr size_t OFF_UB = OFF_G + SZ_T256B;
static constexpr size_t OFF_CB = OFF_UB + SZ_T256B;
static constexpr size_t OFF_SR = OFF_CB + SZ_T256B;
static constexpr size_t OFF_SK = OFF_SR + SZ_T256B;
static constexpr size_t OFF_SV = OFF_SK + SZ_T256B;
static constexpr size_t OFF_SKK = OFF_SV + SZ_T256B;
static constexpr size_t OFF_SA = OFF_SKK + SZ_T256B;
static constexpr size_t OFF_SW = OFF_SA + SZ_T256B;
static constexpr size_t OFF_PABC = OFF_SW + 2 * SZ_T256B;
static constexpr size_t OFF_YD = OFF_PABC;
static constexpr size_t OFF_OG = OFF_YD + SZ_T256B;
static constexpr size_t OFF_MRG = OFF_OG + SZ_T256B;
static constexpr size_t OFF_F = OFF_UB;
static constexpr size_t OFF_SMALL = OFF_PABC + (size_t)T_TOK * 2176 * 2;
static constexpr size_t OFF_MOD = OFF_SMALL;
static constexpr size_t OFF_S5AB = OFF_MOD + 2 * 4 * 6144 * 4;
static constexpr size_t OFF_S5BB = OFF_S5AB + 2 * 16 * 64 * 2 * 4;
static constexpr size_t OFF_S5E = OFF_S5BB + 2 * 16 * 64 * 32 * 4;
static constexpr size_t OFF_BAR = OFF_S5E + (size_t)4 * 64 * 16 * 64 * 2 * 4;
static constexpr size_t OFF_SGW = OFF_BAR + 16384;
static constexpr size_t OFF_O = OFF_SGW + 4 * 128 * 128 * 2;
static constexpr size_t OFF_LW2 = OFF_O + 2 * SZ_T256B;
static constexpr size_t OFF_LA2 = OFF_LW2 + 256 * 32 * 2;
static constexpr size_t OFF_LG2 = OFF_LA2 + 256 * 32 * 2;
static constexpr size_t OFF_LV2 = OFF_LG2 + 256 * 64 * 2;
static constexpr size_t OFF_LV1 = OFF_LV2 + 256 * 32 * 2;
static constexpr size_t OFF_SGST = OFF_LV1 + 32 * 256 * 2;
static constexpr size_t WS_END = OFF_SGST + (size_t)T_TOK * 2 * 4;
static_assert(OFF_F + (size_t)T_TOK * 4096 * 2 <= OFF_SMALL, "F overlaps small region");
static_assert(OFF_MRG + (size_t)T_TOK * 1024 * 2 <= OFF_SMALL, "MRG overlaps");

struct Params {
  const float* in[42];
  float* out;
  unsigned char* ws;
};

__device__ __forceinline__ u16 f2bf(float f) {
  unsigned u = __float_as_uint(f);
  u += 0x7fffu + ((u >> 16) & 1u);
  return (u16)(u >> 16);
}
__device__ __forceinline__ float bf2f(u16 h) { return __uint_as_float(((unsigned)h) << 16); }
__device__ __forceinline__ float bflo(unsigned u) { return __uint_as_float(u << 16); }
__device__ __forceinline__ float bfhi(unsigned u) { return __uint_as_float(u & 0xffff0000u); }
__device__ __forceinline__ unsigned pack2(float a, float b) { return (unsigned)f2bf(a) | ((unsigned)f2bf(b) << 16); }
__device__ __forceinline__ float sigmoidf_(float x) { return 1.f / (1.f + __expf(-x)); }
__device__ __forceinline__ float tanhf_(float y) { return 1.f - 2.f / (1.f + __expf(2.f * y)); }
__device__ __forceinline__ float geluf_(float x) {
  float y = 0.7978845608028654f * (x + 0.044715f * x * x * x);
  return 0.5f * x * (1.f + tanhf_(y));
}
__device__ __forceinline__ float wave_sum(float v) {
#pragma unroll
  for (int o = 32; o > 0; o >>= 1) v += __shfl_xor(v, o, 64);
  return v;
}
template <int CTRL>
__device__ __forceinline__ float dppf(float x) {
  return __int_as_float(__builtin_amdgcn_update_dpp(__float_as_int(x), __float_as_int(x), CTRL, 0xF, 0xF, true));
}
__device__ __forceinline__ float row_sum16(float x) {
  x += dppf<0x128>(x);
  x += dppf<0x124>(x);
  x += dppf<0x122>(x);
  x += dppf<0x121>(x);
  return x;
}

__device__ __forceinline__ void phase_mod(const Params& p, unsigned char* smem) {
  const int tid = TIDX;
  float* cact = (float*)smem;
  float* red = cact + 4096;
  float* mod = (float*)(p.ws + OFF_MOD);
  for (int i = tid; i < 4096; i += NTHR) { float c = p.in[1][i]; cact[i] = c / (1.f + __expf(-c)); }
  __syncthreads();
  for (int item = VBLK; item < 192; item += VGRID) {
    int l = item / 96, nb = item % 96;
    int cl = tid & 63, kq = tid >> 6;
    int col = nb * 64 + cl;
    const float* W = p.in[2] + (size_t)l * 1024 * 6144;
    float a0 = 0, a1 = 0, a2 = 0, a3 = 0;
    for (int k = kq * 256; k < kq * 256 + 256; ++k) {
      float w = W[(size_t)k * 6144 + col];
      a0 += cact[k] * w; a1 += cact[1024 + k] * w; a2 += cact[2048 + k] * w; a3 += cact[3072 + k] * w;
    }
    red[(kq * 4 + 0) * 64 + cl] = a0; red[(kq * 4 + 1) * 64 + cl] = a1;
    red[(kq * 4 + 2) * 64 + cl] = a2; red[(kq * 4 + 3) * 64 + cl] = a3;
    __syncthreads();
    {
      int b = tid >> 6;
      float s = red[(0 * 4 + b) * 64 + cl] + red[(1 * 4 + b) * 64 + cl] + red[(2 * 4 + b) * 64 + cl] + red[(3 * 4 + b) * 64 + cl];
      mod[((size_t)l * 4 + b) * 6144 + col] = s + p.in[3][l * 6144 + col];
    }
    __syncthreads();
  }
  float* s5ab = (float*)(p.ws + OFF_S5AB);
  float* s5bb = (float*)(p.ws + OFF_S5BB);
  for (int idx = VBLK * NTHR + tid; idx < 2048; idx += VGRID * NTHR) {
    int l = idx >> 10, g = (idx >> 6) & 15, n = idx & 63;
    double lre = fmin((double)p.in[28][idx], -1e-4);
    double lim = (double)p.in[29][idx];
    double dt = exp((double)p.in[35][l * 16 + g]);
    double mag = exp(lre * dt);
    double abr = mag * cos(lim * dt), abi = mag * sin(lim * dt);
    double den = lre * lre + lim * lim;
    double qr = ((abr - 1.0) * lre + abi * lim) / den;
    double qi = (abi * lre - (abr - 1.0) * lim) / den;
    s5ab[idx * 2 + 0] = (float)abr; s5ab[idx * 2 + 1] = (float)abi;
    for (int c = 0; c < 16; ++c) {
      double br = p.in[30][(size_t)idx * 16 + c], bi = p.in[31][(size_t)idx * 16 + c];
      s5bb[(size_t)idx * 32 + c] = (float)(qr * br - qi * bi);
      s5bb[(size_t)idx * 32 + 16 + c] = (float)(qr * bi + qi * br);
    }
  }
}

__device__ __forceinline__ void convert_tile(const float* __restrict__ src, int K, int N, u16* __restrict__ dst, int tk, int tn, u16* sm) {
  const int tid = TIDX;
  int r = tid >> 4, c4 = (tid & 15) * 4;
#pragma unroll
  for (int i = 0; i < 4; ++i) {
    int kk = r + 16 * i;
    float4 v = *(const float4*)(src + (size_t)(tk * 64 + kk) * N + tn * 64 + c4);
    sm[(c4 + 0) * 72 + kk] = f2bf(v.x);
    sm[(c4 + 1) * 72 + kk] = f2bf(v.y);
    sm[(c4 + 2) * 72 + kk] = f2bf(v.z);
    sm[(c4 + 3) * 72 + kk] = f2bf(v.w);
  }
  __syncthreads();
#pragma unroll
  for (int j = 0; j < 2; ++j) {
    int n = (tid >> 3) + 32 * j, ch = tid & 7;
    u32x4 v = *(const u32x4*)(sm + n * 72 + ch * 8);
    *(u32x4*)(dst + (size_t)(tn * 64 + n) * K + tk * 64 + ch * 8) = v;
  }
  __syncthreads();
}

__device__ __forceinline__ void phase_convert(const Params& p, int l, unsigned char* smem) {
  u16* sm = (u16*)smem;
  const int total = 1632 + 192 + 128 + 256 + 1024 + 1024;
  for (int item = VBLK; item < total + 16 + 192; item += VGRID) {
    int t = item;
    if (t >= total + 16) {
      const int e = (t - total - 16) * 256 + TIDX;
      if (e < 8192) { const int n = e >> 5, k = e & 31; ((u16*)(p.ws + OFF_LW2))[e] = f2bf(p.in[8][(size_t)l * 8192 + k * 256 + n]); }
      else if (e < 16384) { const int q = e - 8192, n = q >> 5, k = q & 31; ((u16*)(p.ws + OFF_LA2))[q] = f2bf(p.in[10][(size_t)l * 8192 + k * 256 + n]); }
      else if (e < 32768) { const int q = e - 16384, n = q >> 6, k = q & 63; ((u16*)(p.ws + OFF_LG2))[q] = f2bf(p.in[11][(size_t)l * 16384 + k * 256 + n]); }
      else if (e < 40960) { const int q = e - 32768, n = q >> 5, k = q & 31; ((u16*)(p.ws + OFF_LV2))[q] = (l > 0) ? f2bf(p.in[14][k * 256 + n]) : (u16)0; }
      else { const int q = e - 40960, n = q >> 8, k = q & 255; ((u16*)(p.ws + OFF_LV1))[q] = (l > 0) ? f2bf(p.in[13][k * 32 + n]) : (u16)0; }
      continue;
    }
    if (t >= total) {
      const int idx = t - total, g = idx >> 2, rq = idx & 3;
      const int tr = rq * 32 + (TIDX >> 3), s0 = (TIDX & 7) * 16;
      const float* src = p.in[23] + (((size_t)l * 4 + g) * 128 + tr) * 128 + s0;
      u16* dst = (u16*)(p.ws + OFF_SGW) + ((size_t)g * 128 + tr) * 128 + s0;
      unsigned pk[8];
#pragma unroll
      for (int e = 0; e < 4; ++e) {
        f32x4 v = *(const f32x4*)(src + e * 4);
        const int sb = s0 + e * 4;
        pk[e * 2 + 0] = pack2(sb + 0 <= tr ? v.x : 0.f, sb + 1 <= tr ? v.y : 0.f);
        pk[e * 2 + 1] = pack2(sb + 2 <= tr ? v.z : 0.f, sb + 3 <= tr ? v.w : 0.f);
      }
      *(u32x4*)(dst) = u32x4{pk[0], pk[1], pk[2], pk[3]};
      *(u32x4*)(dst + 8) = u32x4{pk[4], pk[5], pk[6], pk[7]};
      continue;
    }
    const float* src; int K, N; size_t off;
    if (t < 1632) { src = p.in[5] + (size_t)l * 1024 * 6528; K = 1024; N = 6528; off = OFF_WIN; }
    else if ((t -= 1632) < 64) { src = p.in[20] + (size_t)l * 256 * 1024; K = 256; N = 1024; off = OFF_RO; }
    else if ((t -= 64) < 64) { src = p.in[25] + (size_t)l * 256 * 1024; K = 256; N = 1024; off = OFF_SO; }
    else if ((t -= 64) < 64) { src = p.in[27] + (size_t)l * 256 * 1024; K = 256; N = 1024; off = OFF_CO; }
    else if ((t -= 64) < 128) { src = p.in[36] + (size_t)l * 256 * 2048; K = 256; N = 2048; off = OFF_GLU; }
    else if ((t -= 128) < 256) { src = p.in[37] + (size_t)l * 1024 * 1024; K = 1024; N = 1024; off = OFF_WO; }
    else if ((t -= 256) < 1024) { src = p.in[39] + (size_t)l * 1024 * 4096; K = 1024; N = 4096; off = OFF_W1; }
    else { t -= 1024; src = p.in[40] + (size_t)l * 4096 * 1024; K = 4096; N = 1024; off = OFF_W2; }
    int ntn = N / 64;
    convert_tile(src, K, N, (u16*)(p.ws + off), t / ntn, t % ntn, sm);
  }
}

__device__ __forceinline__ void phase_norm(const float* __restrict__ X, const float* __restrict__ g, const float* __restrict__ modl,
                           int sh_off, int sc_off, u16* __restrict__ H) {
  const int lane = TIDX & 63, wv = TIDX >> 6;
  for (int item = VBLK; item < T_TOK / 4; item += VGRID) {
    int row = item * 4 + wv;
    int b = row >> 12;
    const float* xr = X + (size_t)row * 1024;
    float4 v[4];
    float ss = 0;
#pragma unroll
    for (int i = 0; i < 4; ++i) {
      v[i] = *(const float4*)(xr + lane * 4 + 256 * i);
      ss += v[i].x * v[i].x + v[i].y * v[i].y + v[i].z * v[i].z + v[i].w * v[i].w;
    }
    ss = wave_sum(ss);
    float rstd = rsqrtf(ss * (1.f / 1024.f) + 1e-6f);
    const float* sh = modl + (size_t)b * 6144 + sh_off;
    const float* sc = modl + (size_t)b * 6144 + sc_off;
#pragma unroll
    for (int i = 0; i < 4; ++i) {
      int c = lane * 4 + 256 * i;
      float4 gg = *(const float4*)(g + c);
      float4 s1 = *(const float4*)(sc + c);
      float4 s0 = *(const float4*)(sh + c);
      float h0 = v[i].x * rstd * gg.x * (1.f + s1.x) + s0.x;
      float h1 = v[i].y * rstd * gg.y * (1.f + s1.y) + s0.y;
      float h2 = v[i].z * rstd * gg.z * (1.f + s1.z) + s0.z;
      float h3 = v[i].w * rstd * gg.w * (1.f + s1.w) + s0.w;
      u32x2 o; o.x = pack2(h0, h1); o.y = pack2(h2, h3);
      *(u32x2*)(H + (size_t)row * 1024 + c) = o;
    }
  }
}

__device__ __forceinline__ void phase_final(float* __restrict__ X, const float* __restrict__ g) {
  const int lane = TIDX & 63, wv = TIDX >> 6;
  for (int item = VBLK; item < T_TOK / 4; item += VGRID) {
    int row = item * 4 + wv;
    float* xr = X + (size_t)row * 1024;
    float4 v[4];
    float ss = 0;
#pragma unroll
    for (int i = 0; i < 4; ++i) {
      v[i] = *(const float4*)(xr + lane * 4 + 256 * i);
      ss += v[i].x * v[i].x + v[i].y * v[i].y + v[i].z * v[i].z + v[i].w * v[i].w;
    }
    ss = wave_sum(ss);
    float rstd = rsqrtf(ss * (1.f / 1024.f) + 1e-6f);
#pragma unroll
    for (int i = 0; i < 4; ++i) {
      int c = lane * 4 + 256 * i;
      float4 gg = *(const float4*)(g + c);
      float4 o;
      o.x = v[i].x * rstd * gg.x; o.y = v[i].y * rstd * gg.y; o.z = v[i].z * rstd * gg.z; o.w = v[i].w * rstd * gg.w;
      *(float4*)(xr + c) = o;
    }
  }
}

template <int NF, bool LEAN = false>
__device__ __forceinline__ void gemm_mainloop(const u16* __restrict__ A, int lda, const u16* __restrict__ B, int ldb,
                                              int K, f32x4 (&acc)[4][NF], u16* smem) {
  constexpr int BN = 32 * NF;
  constexpr int NB = BN / 32;
  u16* sA = smem;
  u16* sB = smem + 2 * 128 * 64;
  int tz = 0;
  if (LEAN) asm volatile("" : "+v"(tz));
  const int tid = TIDX + tz, lane = tid & 63, wv = tid >> 6;
  const int wm = wv >> 1, wn = wv & 1;
  const int lrow = tid >> 3;
  const int lchs = (tid & 7) ^ ((lrow >> 1) & 7);
  const u16* Ap = A + (size_t)lrow * lda + lchs * 8;
  const u16* Bp = B + (size_t)lrow * ldb + lchs * 8;
  const int nk = K >> 6;
  auto stage = [&](int kt, int buf) {
    const int ko = kt << 6;
#pragma unroll
    for (int i = 0; i < 4; ++i)
      __builtin_amdgcn_global_load_lds((const unsigned*)(Ap + (size_t)(32 * i) * lda + ko),
                                       (__attribute__((address_space(3))) unsigned*)(sA + buf * (128 * 64) + (tid + 256 * i) * 8), 16, 0, 0);
#pragma unroll
    for (int i = 0; i < NB; ++i)
      __builtin_amdgcn_global_load_lds((const unsigned*)(Bp + (size_t)(32 * i) * ldb + ko),
                                       (__attribute__((address_space(3))) unsigned*)(sB + buf * (BN * 64) + (tid + 256 * i) * 8), 16, 0, 0);
  };
  __syncthreads();
  stage(0, 0);
  const int fr = lane & 15, fq = lane >> 4;
  const int sw = (fr >> 1) & 7;
  for (int kt = 0; kt < nk; ++kt) {
    const int cur = kt & 1;
    asm volatile("s_waitcnt vmcnt(0)" ::: "memory");
    __syncthreads();
    if (kt + 1 < nk) stage(kt + 1, cur ^ 1);
    const u16* cA = sA + cur * (128 * 64) + (wm * 64 + fr) * 64;
    const u16* cB = sB + cur * (BN * 64) + (wn * 16 * NF + fr) * 64;
#pragma unroll
    for (int ks = 0; ks < 2; ++ks) {
      if (LEAN) __builtin_amdgcn_sched_barrier(0);
      const int pc = ((fq + 4 * ks) ^ sw) << 3;
      bf16x8 fa[4], fb[NF];
#pragma unroll
      for (int i = 0; i < 4; ++i) fa[i] = *(const bf16x8*)(cA + i * 16 * 64 + pc);
#pragma unroll
      for (int j = 0; j < NF; ++j) fb[j] = *(const bf16x8*)(cB + j * 16 * 64 + pc);
#pragma unroll
      for (int i = 0; i < 4; ++i)
#pragma unroll
        for (int j = 0; j < NF; ++j)
          acc[i][j] = __builtin_amdgcn_mfma_f32_16x16x32_bf16(fb[j], fa[i], acc[i][j], 0, 0, 0);
    }
  }
}

template <int NF>
__device__ __forceinline__ void zero_acc(f32x4 (&acc)[4][NF]) {
#pragma unroll
  for (int i = 0; i < 4; ++i)
#pragma unroll
    for (int j = 0; j < NF; ++j) acc[i][j] = f32x4{0.f, 0.f, 0.f, 0.f};
}

template <bool PERM>
__device__ __forceinline__ void gemm_mainloop_8w(const u16* __restrict__ A, int lda, const u16* __restrict__ B, int ldb,
                                                 int K, f32x4 (&acc)[8][4], u16* smem) {
  constexpr int STG = 32768;
  const int tid = threadIdx.x, lane = tid & 63, wv = tid >> 6;
  const int wm = wv >> 2, wn = wv & 3;
  const int lrow = tid >> 3;
  const int lchs = (tid & 7) ^ ((lrow >> 1) & 7);
  const u16* Ap = A + (size_t)lrow * lda + lchs * 8;
  const int rho = lrow & 31, pi = rho & 15;
  const int brow = PERM ? ((lrow & ~31) + 8 * (pi >> 2) + 4 * (rho >> 4) + (pi & 3)) : lrow;
  const u16* Bp = B + (size_t)brow * ldb + lchs * 8;
  const int nk = K >> 6;
  auto stage = [&](int kt, int buf) {
    const int ko = kt << 6;
    u16* sa = smem + buf * STG;
#pragma unroll
    for (int i = 0; i < 4; ++i)
      __builtin_amdgcn_global_load_lds((const unsigned*)(Ap + (size_t)(64 * i) * lda + ko),
                                       (__attribute__((address_space(3))) unsigned*)(sa + (tid + 512 * i) * 8), 16, 0, 0);
#pragma unroll
    for (int i = 0; i < 4; ++i)
      __builtin_amdgcn_global_load_lds((const unsigned*)(Bp + (size_t)(64 * i) * ldb + ko),
                                       (__attribute__((address_space(3))) unsigned*)(sa + 16384 + (tid + 512 * i) * 8), 16, 0, 0);
  };
  __syncthreads();
  stage(0, 0);
  const int fr = lane & 15, fq = lane >> 4;
  const int sw = (fr >> 1) & 7;
  for (int kt = 0; kt < nk; ++kt) {
    const int cur = kt & 1;
    asm volatile("s_waitcnt vmcnt(0)" ::: "memory");
    __syncthreads();
    if (kt + 1 < nk) stage(kt + 1, cur ^ 1);
    const u16* cA = smem + cur * STG + (wm * 128 + fr) * 64;
    const u16* cB = smem + cur * STG + 16384 + (wn * 64 + fr) * 64;
#pragma unroll
    for (int ks = 0; ks < 2; ++ks) {
      const int pc = ((fq + 4 * ks) ^ sw) << 3;
      bf16x8 fa[8], fb[4];
#pragma unroll
      for (int i = 0; i < 8; ++i) fa[i] = *(const bf16x8*)(cA + i * 16 * 64 + pc);
#pragma unroll
      for (int j = 0; j < 4; ++j) fb[j] = *(const bf16x8*)(cB + j * 16 * 64 + pc);
#pragma unroll
      for (int i = 0; i < 8; ++i)
#pragma unroll
        for (int j = 0; j < 4; ++j)
          acc[i][j] = __builtin_amdgcn_mfma_f32_16x16x32_bf16(fb[j], fa[i], acc[i][j], 0, 0, 0);
    }
  }
}

template <int EPI>
__device__ __forceinline__ void phase_gemm_8w(const Params& p, int l, int vb, unsigned char* smem_raw) {
  u16* smem = (u16*)smem_raw;
  const int lane = threadIdx.x & 63, wv = threadIdx.x >> 6;
  const int wm = wv >> 2, wn = wv & 3;
  const int fr = lane & 15, fq = lane >> 4;
  const u16* A; const u16* B; int lda, ldb, K, ntiles_n;
  if (EPI == 0) { A = (const u16*)(p.ws + OFF_H); lda = 1024; B = (const u16*)(p.ws + OFF_WIN); ldb = 1024; K = 1024; ntiles_n = 8; }
  if (EPI == 1) { A = (const u16*)(p.ws + OFF_MRG); lda = 1024; B = (const u16*)(p.ws + OFF_WO); ldb = 1024; K = 1024; ntiles_n = 4; }
  if (EPI == 2) { A = (const u16*)(p.ws + OFF_H); lda = 1024; B = (const u16*)(p.ws + OFF_W1); ldb = 1024; K = 1024; ntiles_n = 16; }
  if (EPI == 3) { A = (const u16*)(p.ws + OFF_F); lda = 4096; B = (const u16*)(p.ws + OFF_W2); ldb = 4096; K = 4096; ntiles_n = 4; }
  const float* modl = (const float*)(p.ws + OFF_MOD) + (size_t)l * 4 * 6144;
  const int total = 64 * ntiles_n;
  const int G = gridDim.x;
  const bool swz = (G == 256);
  for (int item = vb; item < total; item += G) {
    int mt = item & 63, nt = item >> 6;
    if (swz) { const int r = item >> 8, w = vb & 31; mt = (vb >> 5) * 8 + (w & 7); nt = r * 4 + (w >> 3); }
    const int m0 = mt * 256, n0 = nt * 256;
    f32x4 acc[8][4];
#pragma unroll
    for (int i = 0; i < 8; ++i)
#pragma unroll
      for (int j = 0; j < 4; ++j) acc[i][j] = f32x4{0.f, 0.f, 0.f, 0.f};
    gemm_mainloop_8w<(EPI == 0 || EPI == 2)>(A + (size_t)m0 * lda, lda, B + (size_t)n0 * ldb, ldb, K, acc, smem);
    if (EPI == 0 || EPI == 2) {
      constexpr int LDO = (EPI == 0) ? 2176 : 4096;
      u16* obase = (u16*)(p.ws + (EPI == 0 ? OFF_PABC : OFF_F)) + (size_t)(m0 + wm * 128 + fr) * LDO + n0 + wn * 64 + 8 * fq;
#pragma unroll
      for (int i = 0; i < 8; ++i) {
#pragma unroll
        for (int g2 = 0; g2 < 2; ++g2) {
          f32x4 a = acc[i][2 * g2], b = acc[i][2 * g2 + 1];
          if (EPI == 2) {
            a = __builtin_elementwise_max(a, f32x4{0.f, 0.f, 0.f, 0.f}); b = __builtin_elementwise_max(b, f32x4{0.f, 0.f, 0.f, 0.f});
            a = a * a; b = b * b;
          }
          const u32x4 o = u32x4{pack2(a[0], a[1]), pack2(a[2], a[3]), pack2(b[0], b[1]), pack2(b[2], b[3])};
          *(u32x4*)(obase + (size_t)(i * 16) * LDO + 32 * g2) = o;
        }
      }
    } else {
#pragma unroll
    for (int i = 0; i < 8; ++i) {
      const int m = m0 + wm * 128 + i * 16 + fr;
#pragma unroll
      for (int j = 0; j < 4; ++j) {
        const int n = n0 + wn * 64 + j * 16 + fq * 4;
        f32x4 v = acc[i][j];
        if (EPI == 0) {
          *(u32x2*)((u16*)(p.ws + OFF_PABC) + (size_t)m * 2176 + n) = u32x2{pack2(v[0], v[1]), pack2(v[2], v[3])};
        } else if (EPI == 1 || EPI == 3) {
          const int b = m >> 12;
          const float* gt = modl + (size_t)b * 6144 + (EPI == 1 ? 2048 : 5120) + n;
          const float* xin = ((EPI == 1 && l == 0) ? p.in[0] : p.out) + (size_t)m * 1024 + n;
          f32x4 x = *(const f32x4*)xin;
          f32x4 gg = *(const f32x4*)gt;
          *(f32x4*)(p.out + (size_t)m * 1024 + n) = x + gg * v;
        } else {
          float r0 = fmaxf(v[0], 0.f), r1 = fmaxf(v[1], 0.f), r2 = fmaxf(v[2], 0.f), r3 = fmaxf(v[3], 0.f);
          *(u32x2*)((u16*)(p.ws + OFF_F) + (size_t)m * 4096 + n) = u32x2{pack2(r0 * r0, r1 * r1), pack2(r2 * r2, r3 * r3)};
        }
      }
    }
    }
  }
}

template <int EPI>
__device__ __forceinline__ void phase_gemm(const Params& p, int l, int vb, unsigned char* smem_raw) {
  u16* smem = (u16*)smem_raw;
  const int lane = TIDX & 63, wv = TIDX >> 6;
  const int wm = wv >> 1, wn = wv & 1;
  const int fr = lane & 15, fq = lane >> 4;
  const u16* A; const u16* B; int lda, ldb, K, ntiles_n;
  if (EPI == 0) { A = (const u16*)(p.ws + OFF_H); lda = 1024; B = (const u16*)(p.ws + OFF_WIN); ldb = 1024; K = 1024; ntiles_n = 19; }
  if (EPI == 1) { A = (const u16*)(p.ws + OFF_MRG); lda = 1024; B = (const u16*)(p.ws + OFF_WO); ldb = 1024; K = 1024; ntiles_n = 8; }
  if (EPI == 2) { A = (const u16*)(p.ws + OFF_H); lda = 1024; B = (const u16*)(p.ws + OFF_W1); ldb = 1024; K = 1024; ntiles_n = 32; }
  if (EPI == 3) { A = (const u16*)(p.ws + OFF_F); lda = 4096; B = (const u16*)(p.ws + OFF_W2); ldb = 4096; K = 4096; ntiles_n = 8; }
  const float* modl = (const float*)(p.ws + OFF_MOD) + (size_t)l * 4 * 6144;
  const int G = VGRID;
  const bool swz = (G == 512);
  const int total = swz ? 128 * ((ntiles_n + 3) & ~3) : 128 * ntiles_n;
  for (int item = vb; item < total; item += G) {
    int mt = item & 127, nt = item >> 7;
    if (swz) { const int r = item >> 9, w = vb & 63; mt = (vb >> 6) * 16 + (w & 15); nt = r * 4 + (w >> 4); if (nt >= ntiles_n) continue; }
    const int m0 = mt * 128, n0 = nt * 128;
    f32x4 acc[4][4];
    zero_acc<4>(acc);
    gemm_mainloop<4>(A + (size_t)m0 * lda, lda, B + (size_t)n0 * ldb, ldb, K, acc, smem);
#pragma unroll
    for (int i = 0; i < 4; ++i) {
      const int m = m0 + wm * 64 + i * 16 + fr;
#pragma unroll
      for (int j = 0; j < 4; ++j) {
        const int n = n0 + wn * 64 + j * 16 + fq * 4;
        f32x4 v = acc[i][j];
        if (EPI == 0) {
          u32x2 o; o.x = pack2(v[0], v[1]); o.y = pack2(v[2], v[3]);
          if (n < 2176) *(u32x2*)((u16*)(p.ws + OFF_PABC) + (size_t)m * 2176 + n) = o;
          else *(u32x2*)((u16*)(p.ws + OFF_PD) + (size_t)m * 256 + (n - 2176)) = o;
        } else if (EPI == 1 || EPI == 3) {
          const int b = m >> 12;
          const float* gt = modl + (size_t)b * 6144 + (EPI == 1 ? 2048 : 5120) + n;
          const float* xin = ((EPI == 1 && l == 0) ? p.in[0] : p.out) + (size_t)m * 1024 + n;
          float4 x = *(const float4*)xin;
          float4 gg = *(const float4*)gt;
          float4 o;
          o.x = x.x + gg.x * v[0]; o.y = x.y + gg.y * v[1]; o.z = x.z + gg.z * v[2]; o.w = x.w + gg.w * v[3];
          *(float4*)(p.out + (size_t)m * 1024 + n) = o;
        } else {
          float r0 = fmaxf(v[0], 0.f), r1 = fmaxf(v[1], 0.f), r2 = fmaxf(v[2], 0.f), r3 = fmaxf(v[3], 0.f);
          u32x2 o; o.x = pack2(r0 * r0, r1 * r1); o.y = pack2(r2 * r2, r3 * r3);
          *(u32x2*)((u16*)(p.ws + OFF_F) + (size_t)m * 4096 + n) = o;
        }
      }
    }
  }
}

template <int MODE>
__device__ __forceinline__ void merge_tile(const Params& p, int item, unsigned char* smem_raw) {
  u16* smem = (u16*)smem_raw;
  const int lane = TIDX & 63, wv = TIDX >> 6;
  const int wm = wv >> 1, wn = wv & 1;
  const int fr = lane & 15, fq = lane >> 4;
  const u16* H = (const u16*)(p.ws + OFF_H);
  const u16* WIN = (const u16*)(p.ws + OFF_WIN);
  const int mt = item & 127, nt = item >> 7;
  const int m0 = mt * 128, n0 = nt * 128;
  f32x4 bacc[4][4];
  u32x2 gpk[4][4];
  u16* MRG = (u16*)(p.ws + OFF_MRG);
#pragma unroll 1
  for (int br = (MODE == 0 ? 1 : 0); br < (MODE == 0 ? 4 : 1); ++br) {
    zero_acc<4>(bacc);
    gemm_mainloop<4, true>(H + (size_t)m0 * 1024, 1024, WIN + (size_t)(2432 + br * 1024 + n0) * 1024, 1024, 1024, bacc, smem);
#pragma unroll
    for (int i = 0; i < 4; ++i)
#pragma unroll
      for (int j = 0; j < 4; ++j)
        gpk[i][j] = u32x2{pack2(sigmoidf_(bacc[i][j][0]), sigmoidf_(bacc[i][j][1])), pack2(sigmoidf_(bacc[i][j][2]), sigmoidf_(bacc[i][j][3]))};
    const u16* Ab; const u16* Wb;
    if (br == 0) { Ab = (const u16*)(p.ws + OFF_OG); Wb = (const u16*)(p.ws + OFF_RO); }
    else if (br == 1) { Ab = (const u16*)(p.ws + OFF_UB); Wb = (const u16*)(p.ws + OFF_SO); }
    else if (br == 2) { Ab = (const u16*)(p.ws + OFF_CB); Wb = (const u16*)(p.ws + OFF_CO); }
    else { Ab = (const u16*)(p.ws + OFF_YD); Wb = (const u16*)(p.ws + OFF_GLU); }
    if (MODE == 0 && br == 3) {
      zero_acc<4>(bacc);
      gemm_mainloop<4, true>(Ab + (size_t)m0 * 256, 256, Wb + (size_t)(1024 + n0) * 256, 256, 256, bacc, smem);
#pragma unroll
      for (int i = 0; i < 4; ++i)
#pragma unroll
        for (int j = 0; j < 4; ++j) {
          const float g0 = bflo(gpk[i][j].x) * sigmoidf_(bacc[i][j][0]), g1 = bfhi(gpk[i][j].x) * sigmoidf_(bacc[i][j][1]);
          const float g2 = bflo(gpk[i][j].y) * sigmoidf_(bacc[i][j][2]), g3 = bfhi(gpk[i][j].y) * sigmoidf_(bacc[i][j][3]);
          gpk[i][j] = u32x2{pack2(g0, g1), pack2(g2, g3)};
        }
    }
    zero_acc<4>(bacc);
    gemm_mainloop<4, true>(Ab + (size_t)m0 * 256, 256, Wb + (size_t)n0 * 256, 256, 256, bacc, smem);
#pragma unroll
    for (int i = 0; i < 4; ++i)
#pragma unroll
      for (int j = 0; j < 4; ++j) {
        u32x2* mp = (u32x2*)(MRG + (size_t)(m0 + wm * 64 + i * 16 + fr) * 1024 + n0 + wn * 64 + j * 16 + fq * 4);
        u32x2 cm = u32x2{0u, 0u};
        if (MODE == 1 || br > 1) cm = *mp;
        const float v0 = bflo(cm.x) + bflo(gpk[i][j].x) * bacc[i][j][0];
        const float v1 = bfhi(cm.x) + bfhi(gpk[i][j].x) * bacc[i][j][1];
        const float v2 = bflo(cm.y) + bflo(gpk[i][j].y) * bacc[i][j][2];
        const float v3 = bfhi(cm.y) + bfhi(gpk[i][j].y) * bacc[i][j][3];
        *mp = u32x2{pack2(v0, v1), pack2(v2, v3)};
      }
  }
}

__device__ __forceinline__ void gemm_mainloop_8n(const u16* __restrict__ A, int lda, const u16* __restrict__ B, int ldb,
                                                 int K, f32x4 (&acc)[4][4], u16* smem) {
  constexpr int STG = 24576;
  int tz = 0;
  asm volatile("" : "+v"(tz));
  const int tid = threadIdx.x + tz, lane = tid & 63, wv = tid >> 6;
  const int wm = wv >> 1, wn = wv & 1;
  const int lrow = tid >> 3;
  const int lchs = (tid & 7) ^ ((lrow >> 1) & 7);
  const u16* Ap = A + (size_t)lrow * lda + lchs * 8;
  const u16* Bp = B + (size_t)lrow * ldb + lchs * 8;
  const int nk = K >> 6;
  auto stage = [&](int kt, int buf) {
    const int ko = kt << 6;
    u16* sa = smem + buf * STG;
#pragma unroll
    for (int i = 0; i < 4; ++i)
      __builtin_amdgcn_global_load_lds((const unsigned*)(Ap + (size_t)(64 * i) * lda + ko),
                                       (__attribute__((address_space(3))) unsigned*)(sa + (tid + 512 * i) * 8), 16, 0, 0);
#pragma unroll
    for (int i = 0; i < 2; ++i)
      __builtin_amdgcn_global_load_lds((const unsigned*)(Bp + (size_t)(64 * i) * ldb + ko),
                                       (__attribute__((address_space(3))) unsigned*)(sa + 16384 + (tid + 512 * i) * 8), 16, 0, 0);
  };
  __syncthreads();
  stage(0, 0);
  stage(nk > 1 ? 1 : 0, 1);
  const int fr = lane & 15, fq = lane >> 4;
  const int sw = (fr >> 1) & 7;
  int cur = 0;
  for (int kt = 0; kt < nk; ++kt) {
    asm volatile("s_waitcnt vmcnt(6)" ::: "memory");
    __builtin_amdgcn_s_barrier();
    asm volatile("" ::: "memory");
    {
      int nx = cur + 2; if (nx >= 3) nx -= 3;
      int ktn = kt + 2; if (ktn >= nk) ktn = nk - 1;
      stage(ktn, nx);
    }
    const u16* cA = smem + cur * STG + (wm * 64 + fr) * 64;
    const u16* cB = smem + cur * STG + 16384 + (wn * 64 + fr) * 64;
#pragma unroll
    for (int ks = 0; ks < 2; ++ks) {
      const int pc = ((fq + 4 * ks) ^ sw) << 3;
      bf16x8 fa[4], fb[4];
#pragma unroll
      for (int i = 0; i < 4; ++i) fa[i] = *(const bf16x8*)(cA + i * 16 * 64 + pc);
#pragma unroll
      for (int j = 0; j < 4; ++j) fb[j] = *(const bf16x8*)(cB + j * 16 * 64 + pc);
#pragma unroll
      for (int i = 0; i < 4; ++i)
#pragma unroll
        for (int j = 0; j < 4; ++j)
          acc[i][j] = __builtin_amdgcn_mfma_f32_16x16x32_bf16(fb[j], fa[i], acc[i][j], 0, 0, 0);
    }
    cur = cur + 1; if (cur >= 3) cur = 0;
  }
  asm volatile("s_waitcnt vmcnt(0)" ::: "memory");
}

template <int MODE>
__device__ __forceinline__ void merge_tile8(const Params& p, int item, unsigned char* smem_raw) {
  u16* smem = (u16*)smem_raw;
  const int lane = threadIdx.x & 63, wv = threadIdx.x >> 6;
  const int wm = wv >> 1, wn = wv & 1;
  const int fr = lane & 15, fq = lane >> 4;
  const u16* H = (const u16*)(p.ws + OFF_H);
  const u16* WIN = (const u16*)(p.ws + OFF_WIN);
  const int mt = item & 63, nt = item >> 6;
  const int m0 = mt * 256, n0 = nt * 128;
  f32x4 bacc[4][4];
  u32x2 gpk[4][4];
  u16* MRG = (u16*)(p.ws + OFF_MRG);
#pragma unroll 1
  for (int br = (MODE == 0 ? 1 : 0); br < (MODE == 0 ? 4 : 1); ++br) {
    zero_acc<4>(bacc);
    gemm_mainloop_8n(H + (size_t)m0 * 1024, 1024, WIN + (size_t)(2432 + br * 1024 + n0) * 1024, 1024, 1024, bacc, smem);
#pragma unroll
    for (int i = 0; i < 4; ++i)
#pragma unroll
      for (int j = 0; j < 4; ++j)
        gpk[i][j] = u32x2{pack2(sigmoidf_(bacc[i][j][0]), sigmoidf_(bacc[i][j][1])), pack2(sigmoidf_(bacc[i][j][2]), sigmoidf_(bacc[i][j][3]))};
    const u16* Ab; const u16* Wb;
    if (br == 0) { Ab = (const u16*)(p.ws + OFF_OG); Wb = (const u16*)(p.ws + OFF_RO); }
    else if (br == 1) { Ab = (const u16*)(p.ws + OFF_UB); Wb = (const u16*)(p.ws + OFF_SO); }
    else if (br == 2) { Ab = (const u16*)(p.ws + OFF_CB); Wb = (const u16*)(p.ws + OFF_CO); }
    else { Ab = (const u16*)(p.ws + OFF_YD); Wb = (const u16*)(p.ws + OFF_GLU); }
    if (MODE == 0 && br == 3) {
      zero_acc<4>(bacc);
      gemm_mainloop_8n(Ab + (size_t)m0 * 256, 256, Wb + (size_t)(1024 + n0) * 256, 256, 256, bacc, smem);
#pragma unroll
      for (int i = 0; i < 4; ++i)
#pragma unroll
        for (int j = 0; j < 4; ++j) {
          const float g0 = bflo(gpk[i][j].x) * sigmoidf_(bacc[i][j][0]), g1 = bfhi(gpk[i][j].x) * sigmoidf_(bacc[i][j][1]);
          const float g2 = bflo(gpk[i][j].y) * sigmoidf_(bacc[i][j][2]), g3 = bfhi(gpk[i][j].y) * sigmoidf_(bacc[i][j][3]);
          gpk[i][j] = u32x2{pack2(g0, g1), pack2(g2, g3)};
        }
    }
    zero_acc<4>(bacc);
    gemm_mainloop_8n(Ab + (size_t)m0 * 256, 256, Wb + (size_t)n0 * 256, 256, 256, bacc, smem);
#pragma unroll
    for (int i = 0; i < 4; ++i)
#pragma unroll
      for (int j = 0; j < 4; ++j) {
        u32x2* mp = (u32x2*)(MRG + (size_t)(m0 + wm * 64 + i * 16 + fr) * 1024 + n0 + wn * 64 + j * 16 + fq * 4);
        u32x2 cm = u32x2{0u, 0u};
        if (MODE == 1 || br > 1) cm = *mp;
        const float v0 = bflo(cm.x) + bflo(gpk[i][j].x) * bacc[i][j][0];
        const float v1 = bfhi(cm.x) + bfhi(gpk[i][j].x) * bacc[i][j][1];
        const float v2 = bflo(cm.y) + bflo(gpk[i][j].y) * bacc[i][j][2];
        const float v3 = bfhi(cm.y) + bfhi(gpk[i][j].y) * bacc[i][j][3];
        *mp = u32x2{pack2(v0, v1), pack2(v2, v3)};
      }
  }
}

__device__ __forceinline__ void phase_pproj_tail(const Params& p, int vb, unsigned char* smem_raw) {
  u16* smem = (u16*)smem_raw;
  const int lane = threadIdx.x & 63, wv = threadIdx.x >> 6;
  const int wm = wv >> 1, wn = wv & 1;
  const int fr = lane & 15, fq = lane >> 4;
  const u16* A = (const u16*)(p.ws + OFF_H);
  const u16* B = (const u16*)(p.ws + OFF_WIN);
  const int G = gridDim.x;
  const int total = (G == 256) ? 256 : 192;
  for (int item = vb; item < total; item += G) {
    int mt = item & 63, nt = item >> 6;
    if (G == 256) { const int w = vb & 31; mt = (vb >> 5) * 8 + (w & 7); nt = w >> 3; if (nt >= 3) continue; }
    const int m0 = mt * 256, n0 = 2048 + nt * 128;
    f32x4 acc[4][4];
    zero_acc<4>(acc);
    gemm_mainloop_8n(A + (size_t)m0 * 1024, 1024, B + (size_t)n0 * 1024, 1024, 1024, acc, smem);
#pragma unroll
    for (int i = 0; i < 4; ++i) {
      const int m = m0 + wm * 64 + i * 16 + fr;
#pragma unroll
      for (int j = 0; j < 4; ++j) {
        const int n = n0 + wn * 64 + j * 16 + fq * 4;
        const f32x4 v = acc[i][j];
        const u32x2 o = u32x2{pack2(v[0], v[1]), pack2(v[2], v[3])};
        if (n < 2176) *(u32x2*)((u16*)(p.ws + OFF_PABC) + (size_t)m * 2176 + n) = o;
        else *(u32x2*)((u16*)(p.ws + OFF_PD) + (size_t)m * 256 + (n - 2176)) = o;
      }
    }
  }
}

__device__ __forceinline__ float shifted(const u16* __restrict__ P, int tok, int col, float mu) {
  float pv = bf2f(P[(size_t)tok * 2176 + col]);
  float pr = (tok & (SEQ - 1)) ? bf2f(P[(size_t)(tok - 1) * 2176 + col]) : 0.f;
  return pv + (pr - pv) * mu;
}

__device__ __forceinline__ void rwkv_prep_item(const Params& p, int l, int item, unsigned char* smem) {
  const int tid = TIDX, lane = tid & 63, wv = tid >> 6;
  const int fr = lane & 15, fq = lane >> 4;
  u16* sl = (u16*)smem;
  u16* sv = sl + 32 * 168;
  constexpr int SLS = 168, SVS = 264;
  const u16* P = (const u16*)(p.ws + OFF_PABC);
  const float* mu = p.in[6] + l * 896;
  const int tok0 = item * 32;
  {
    const int t = tid >> 3, c0 = (tid & 7) * 32;
    const u16* src = P + (size_t)(tok0 + t) * 2176 + 896 + 256 + c0;
    float sm = 0.f, ss = 0.f;
#pragma unroll
    for (int q = 0; q < 4; ++q) {
      const u32x4 raw = *(const u32x4*)(src + q * 8);
      float z;
      z = geluf_(bflo(raw.x)); sm += z; ss += z * z;  z = geluf_(bfhi(raw.x)); sm += z; ss += z * z;
      z = geluf_(bflo(raw.y)); sm += z; ss += z * z;  z = geluf_(bfhi(raw.y)); sm += z; ss += z * z;
      z = geluf_(bflo(raw.z)); sm += z; ss += z * z;  z = geluf_(bfhi(raw.z)); sm += z; ss += z * z;
      z = geluf_(bflo(raw.w)); sm += z; ss += z * z;  z = geluf_(bfhi(raw.w)); sm += z; ss += z * z;
    }
    sm += __shfl_xor(sm, 1, 64); ss += __shfl_xor(ss, 1, 64);
    sm += __shfl_xor(sm, 2, 64); ss += __shfl_xor(ss, 2, 64);
    sm += __shfl_xor(sm, 4, 64); ss += __shfl_xor(ss, 4, 64);
    const float mean = sm * (1.f / 256.f);
    const float var = fmaxf(ss * (1.f / 256.f) - mean * mean, 0.f);
    if ((tid & 7) == 0) *(f32x2*)((float*)(p.ws + OFF_SGST) + (size_t)(tok0 + t) * 2) = f32x2{mean, rsqrtf(var + 1e-5f)};
  }
  for (int idx = tid; idx < 32 * 128; idx += NTHR) {
    const int t = idx >> 7, ci = idx & 127;
    float v = shifted(P, tok0 + t, 768 + ci, mu[768 + ci]);
    if (ci < 32) v = tanhf_(v);
    else if (ci >= 64) v = sigmoidf_(v);
    sl[t * SLS + ci] = f2bf(v);
  }
  if (l > 0) {
    const int t = tid >> 3, c0 = (tid & 7) * 32;
    const int tok = tok0 + t;
    const bool hasp = (tok & (SEQ - 1)) != 0;
#pragma unroll
    for (int q = 0; q < 4; ++q) {
      const int c = c0 + q * 8;
      const u32x4 cur = *(const u32x4*)(P + (size_t)tok * 2176 + 512 + c);
      u32x4 prv = u32x4{0u, 0u, 0u, 0u};
      if (hasp) prv = *(const u32x4*)(P + (size_t)(tok - 1) * 2176 + 512 + c);
      const f32x4 m0 = *(const f32x4*)(mu + 512 + c), m1 = *(const f32x4*)(mu + 512 + c + 4);
      float o[8];
      o[0] = bflo(cur.x) + (bflo(prv.x) - bflo(cur.x)) * m0.x; o[1] = bfhi(cur.x) + (bfhi(prv.x) - bfhi(cur.x)) * m0.y;
      o[2] = bflo(cur.y) + (bflo(prv.y) - bflo(cur.y)) * m0.z; o[3] = bfhi(cur.y) + (bfhi(prv.y) - bfhi(cur.y)) * m0.w;
      o[4] = bflo(cur.z) + (bflo(prv.z) - bflo(cur.z)) * m1.x; o[5] = bfhi(cur.z) + (bfhi(prv.z) - bfhi(cur.z)) * m1.y;
      o[6] = bflo(cur.w) + (bflo(prv.w) - bflo(cur.w)) * m1.z; o[7] = bfhi(cur.w) + (bfhi(prv.w) - bfhi(cur.w)) * m1.w;
      *(u32x4*)(sv + t * SVS + c) = u32x4{pack2(o[0], o[1]), pack2(o[2], o[3]), pack2(o[4], o[5]), pack2(o[6], o[7])};
    }
  }
  __syncthreads();
  if (l > 0) {
    const int mf = wv >> 1, nf = wv & 1;
    const u16* v1t = (const u16*)(p.ws + OFF_LV1);
    f32x4 acc = f32x4{0.f, 0.f, 0.f, 0.f};
#pragma unroll
    for (int ks = 0; ks < 8; ++ks) {
      const bf16x8 fa = *(const bf16x8*)(sv + (mf * 16 + fr) * SVS + ks * 32 + fq * 8);
      const bf16x8 fb = *(const bf16x8*)(v1t + (size_t)(nf * 16 + fr) * 256 + ks * 32 + fq * 8);
      acc = __builtin_amdgcn_mfma_f32_16x16x32_bf16(fb, fa, acc, 0, 0, 0);
    }
    *(u32x2*)(sl + (mf * 16 + fr) * SLS + 128 + nf * 16 + fq * 4) = u32x2{pack2(acc[0], acc[1]), pack2(acc[2], acc[3])};
    __syncthreads();
  }
  const u16* w2t = (const u16*)(p.ws + OFF_LW2); const u16* a2t = (const u16*)(p.ws + OFF_LA2);
  const u16* g2t = (const u16*)(p.ws + OFF_LG2); const u16* v2t = (const u16*)(p.ws + OFF_LV2);
  u16* SR = (u16*)(p.ws + OFF_SR); u16* SK = (u16*)(p.ws + OFF_SK); u16* SV = (u16*)(p.ws + OFF_SV);
  u16* SKK = (u16*)(p.ws + OFF_SKK); u16* SA = (u16*)(p.ws + OFF_SA); float* SW = (float*)(p.ws + OFF_SW);
  u16* G = (u16*)(p.ws + OFF_G); u16* VF = (u16*)(p.ws + OFF_VF);
#pragma unroll 1
  for (int mf = 0; mf < 2; ++mf) {
    const u16* arow = sl + (mf * 16 + fr) * SLS + fq * 8;
    const bf16x8 aw = *(const bf16x8*)(arow), aa = *(const bf16x8*)(arow + 32);
    const bf16x8 ag0 = *(const bf16x8*)(arow + 64), ag1 = *(const bf16x8*)(arow + 96), av = *(const bf16x8*)(arow + 128);
    f32x4 cw[4], ca[4], cg[4], cv[4];
#pragma unroll
    for (int nf = 0; nf < 4; ++nf) {
      const int n = wv * 64 + nf * 16 + fr;
      const f32x4 z = f32x4{0.f, 0.f, 0.f, 0.f};
      cw[nf] = __builtin_amdgcn_mfma_f32_16x16x32_bf16(*(const bf16x8*)(w2t + n * 32 + fq * 8), aw, z, 0, 0, 0);
      ca[nf] = __builtin_amdgcn_mfma_f32_16x16x32_bf16(*(const bf16x8*)(a2t + n * 32 + fq * 8), aa, z, 0, 0, 0);
      cg[nf] = __builtin_amdgcn_mfma_f32_16x16x32_bf16(*(const bf16x8*)(g2t + n * 64 + fq * 8), ag0, z, 0, 0, 0);
      cg[nf] = __builtin_amdgcn_mfma_f32_16x16x32_bf16(*(const bf16x8*)(g2t + n * 64 + 32 + fq * 8), ag1, cg[nf], 0, 0, 0);
      cv[nf] = z;
      if (l > 0) cv[nf] = __builtin_amdgcn_mfma_f32_16x16x32_bf16(*(const bf16x8*)(v2t + n * 32 + fq * 8), av, z, 0, 0, 0);
    }
    const int tok = tok0 + mf * 16 + fr;
    const bool hasp = (tok & (SEQ - 1)) != 0;
    float kkv[4][4], kmv[4][4], av4[4][4];
    float ss = 0.f;
#pragma unroll
    for (int nf = 0; nf < 4; ++nf) {
      const int c = wv * 64 + nf * 16 + fq * 4;
      const size_t o = (size_t)tok * 256 + c;
      const u16* pc = P + (size_t)tok * 2176 + c;
      const u32x2 r_c = *(const u32x2*)(pc), k_c = *(const u32x2*)(pc + 256), v_c = *(const u32x2*)(pc + 512);
      u32x2 r_p = u32x2{0u, 0u}, k_p = u32x2{0u, 0u}, v_p = u32x2{0u, 0u};
      if (hasp) { r_p = *(const u32x2*)(pc - 2176); k_p = *(const u32x2*)(pc - 2176 + 256); v_p = *(const u32x2*)(pc - 2176 + 512); }
      const f32x4 mur = *(const f32x4*)(mu + c), muk = *(const f32x4*)(mu + 256 + c), muv = *(const f32x4*)(mu + 512 + c);
      const f32x4 w0 = *(const f32x4*)(p.in[7] + l * 256 + c), a0 = *(const f32x4*)(p.in[9] + l * 256 + c);
      const f32x4 kkc = *(const f32x4*)(p.in[15] + l * 256 + c), kac = *(const f32x4*)(p.in[16] + l * 256 + c);
      f32x4 v0 = f32x4{0.f, 0.f, 0.f, 0.f};
      if (l > 0) v0 = *(const f32x4*)(p.in[12] + c);
      u32x2 vfraw = u32x2{0u, 0u};
      if (l > 0) vfraw = *(const u32x2*)(VF + o);
      float rr[4], kk_[4], vv[4], dec[4], gg[4];
#pragma unroll
      for (int e = 0; e < 4; ++e) {
        const unsigned rc = e < 2 ? r_c.x : r_c.y, rp = e < 2 ? r_p.x : r_p.y;
        const unsigned kc = e < 2 ? k_c.x : k_c.y, kp = e < 2 ? k_p.x : k_p.y;
        const unsigned vc = e < 2 ? v_c.x : v_c.y, vp = e < 2 ? v_p.x : v_p.y;
        const unsigned vfr = e < 2 ? vfraw.x : vfraw.y;
        const float rcf = (e & 1) ? bfhi(rc) : bflo(rc), rpf = (e & 1) ? bfhi(rp) : bflo(rp);
        const float kcf = (e & 1) ? bfhi(kc) : bflo(kc), kpf = (e & 1) ? bfhi(kp) : bflo(kp);
        const float vcf = (e & 1) ? bfhi(vc) : bflo(vc), vpf = (e & 1) ? bfhi(vp) : bflo(vp);
        const float r = rcf + (rpf - rcf) * mur[e];
        const float k = kcf + (kpf - kcf) * muk[e];
        float v = vcf + (vpf - vcf) * muv[e];
        const float wl = w0[e] + cw[nf][e];
        const float z = -wl;
        const float sp = (z > 15.f) ? z : __logf(1.f + __expf(z));
        dec[e] = __expf(-__expf(-sp - 0.5f));
        const float a = sigmoidf_(a0[e] + ca[nf][e]);
        gg[e] = cg[nf][e];
        if (l > 0) { const float vf = (e & 1) ? bfhi(vfr) : bflo(vfr); v = v + (vf - v) * sigmoidf_(v0[e] + cv[nf][e]); }
        const float kk = k * kkc[e];
        ss += kk * kk;
        rr[e] = r; vv[e] = v; kk_[e] = kk; kkv[nf][e] = kk;
        kmv[nf][e] = k * (1.f + (a - 1.f) * kac[e]); av4[nf][e] = a;
      }
      *(u32x2*)(SR + o) = u32x2{pack2(rr[0], rr[1]), pack2(rr[2], rr[3])};
      *(u32x2*)(SV + o) = u32x2{pack2(vv[0], vv[1]), pack2(vv[2], vv[3])};
      if (l == 0) *(u32x2*)(VF + o) = u32x2{pack2(vv[0], vv[1]), pack2(vv[2], vv[3])};
      *(u32x2*)(G + o) = u32x2{pack2(gg[0], gg[1]), pack2(gg[2], gg[3])};
      *(f32x4*)(SW + o) = f32x4{dec[0], dec[1], dec[2], dec[3]};
    }
    ss += __shfl_xor(ss, 16, 64);
    ss += __shfl_xor(ss, 32, 64);
    const float inv = 1.f / fmaxf(sqrtf(ss), 1e-12f);
#pragma unroll
    for (int nf = 0; nf < 4; ++nf) {
      const size_t o = (size_t)tok * 256 + wv * 64 + nf * 16 + fq * 4;
      *(u32x2*)(SKK + o) = u32x2{pack2(kkv[nf][0] * inv, kkv[nf][1] * inv), pack2(kkv[nf][2] * inv, kkv[nf][3] * inv)};
      *(u32x2*)(SK + o) = u32x2{pack2(kmv[nf][0], kmv[nf][1]), pack2(kmv[nf][2], kmv[nf][3])};
      *(u32x2*)(SA + o) = u32x2{pack2(av4[nf][0], av4[nf][1]), pack2(av4[nf][2], av4[nf][3])};
    }
  }
  __syncthreads();
}

__device__ __forceinline__ void sg_item(const Params& p, int l, int item, unsigned char* smem) {
  const int tid = TIDX, lane = tid & 63, wv = tid >> 6;
  u16* vsT = (u16*)smem;
  float* smu = (float*)(smem + 16384);
  float* srs = smu + 128;
  const u16* P = (const u16*)(p.ws + OFF_PABC);
  const int g = item & 3, chn = item >> 2;
  const int tok0 = chn * 128;
  if (tid < 128) {
    const f32x2 ms = *(const f32x2*)((const float*)(p.ws + OFF_SGST) + (size_t)(tok0 + tid) * 2);
    smu[tid] = ms.x; srs[tid] = ms.y;
  }
  __syncthreads();
  {
    const int c = tid & 63, tb = tid >> 6;
    const float lw = p.in[21][l * 256 + g * 64 + c], lb = p.in[22][l * 256 + g * 64 + c];
#pragma unroll
    for (int j = 0; j < 4; ++j) {
      u16 raw[8];
#pragma unroll
      for (int e = 0; e < 8; ++e) raw[e] = P[(size_t)(tok0 + tb * 32 + j * 8 + e) * 2176 + 896 + 256 + g * 64 + c];
      float vv[8];
#pragma unroll
      for (int e = 0; e < 8; ++e) {
        const int t = tb * 32 + j * 8 + e;
        vv[e] = (geluf_(bf2f(raw[e])) - smu[t]) * srs[t] * lw + lb;
      }
      const int phys = (tb * 4 + j) ^ (c & 15);
      *(u32x4*)(vsT + c * 128 + phys * 8) = u32x4{pack2(vv[0], vv[1]), pack2(vv[2], vv[3]), pack2(vv[4], vv[5]), pack2(vv[6], vv[7])};
    }
  }
  __syncthreads();
  {
    const int fr = lane & 15, fq = lane >> 4;
    const u16* Wm = (const u16*)(p.ws + OFF_SGW) + (size_t)g * 128 * 128;
    f32x4 acc[2][4];
#pragma unroll
    for (int i = 0; i < 2; ++i)
#pragma unroll
      for (int j = 0; j < 4; ++j) acc[i][j] = f32x4{0.f, 0.f, 0.f, 0.f};
    for (int ks = 0; ks <= wv; ++ks) {
      bf16x8 fa[2], fb[4];
#pragma unroll
      for (int i = 0; i < 2; ++i) fa[i] = *(const bf16x8*)(Wm + (size_t)(32 * wv + 16 * i + fr) * 128 + ks * 32 + fq * 8);
#pragma unroll
      for (int j = 0; j < 4; ++j) fb[j] = *(const bf16x8*)(vsT + (j * 16 + fr) * 128 + (((ks * 4 + fq) ^ fr) << 3));
#pragma unroll
      for (int i = 0; i < 2; ++i)
#pragma unroll
        for (int j = 0; j < 4; ++j) acc[i][j] = __builtin_amdgcn_mfma_f32_16x16x32_bf16(fb[j], fa[i], acc[i][j], 0, 0, 0);
    }
    const float* bs = p.in[24] + ((size_t)l * 4 + g) * 128;
    u16* UB = (u16*)(p.ws + OFF_UB);
#pragma unroll
    for (int i = 0; i < 2; ++i) {
      const int t = 32 * wv + 16 * i + fr;
      const float bsv = bs[t];
#pragma unroll
      for (int j = 0; j < 4; ++j) {
        const int cc = j * 16 + fq * 4;
        u32x2 ur = *(const u32x2*)(P + (size_t)(tok0 + t) * 2176 + 896 + g * 64 + cc);
        float o0 = geluf_(bflo(ur.x)) * (acc[i][j][0] + bsv), o1 = geluf_(bfhi(ur.x)) * (acc[i][j][1] + bsv);
        float o2 = geluf_(bflo(ur.y)) * (acc[i][j][2] + bsv), o3 = geluf_(bfhi(ur.y)) * (acc[i][j][3] + bsv);
        *(u32x2*)(UB + (size_t)(tok0 + t) * 256 + g * 64 + cc) = u32x2{pack2(o0, o1), pack2(o2, o3)};
      }
    }
  }
  __syncthreads();
}

__device__ __forceinline__ void conv_item(const Params& p, int l, int item) {
  const int j = TIDX;
  const u16* P = (const u16*)(p.ws + OFF_PABC);
  u16* CB = (u16*)(p.ws + OFF_CB);
  const float c0 = p.in[26][(l * 3 + 0) * 256 + j], c1 = p.in[26][(l * 3 + 1) * 256 + j], c2 = p.in[26][(l * 3 + 2) * 256 + j];
  const int tok0 = item * 8;
  u16 rc[10], rx[10], rb[8];
  const bool first = (tok0 & (SEQ - 1)) == 0;
#pragma unroll
  for (int t = 0; t < 10; ++t) {
    const int tok = (first && t < 2) ? tok0 : tok0 + t - 2;
    const u16* q = P + (size_t)tok * 2176 + 1408;
    rc[t] = q[256 + j]; rx[t] = q[512 + j];
    if (t >= 2) rb[t - 2] = q[j];
  }
  float z[10];
#pragma unroll
  for (int t = 0; t < 10; ++t) z[t] = bf2f(rc[t]) * bf2f(rx[t]);
  if (first) { z[0] = 0.f; z[1] = 0.f; }
#pragma unroll
  for (int t = 0; t < 8; ++t) {
    float y = c0 * z[t] + c1 * z[t + 1] + c2 * z[t + 2];
    CB[(size_t)(tok0 + t) * 256 + j] = f2bf(bf2f(rb[t]) * y);
  }
}

__device__ __forceinline__ void s5_load_u(const u16* us, int t, int wv, float (&u)[16]) {
  const u32x4* q = (const u32x4*)(us + t * 64 + wv * 16);
  u32x4 a = q[0], b = q[1];
  u[0] = bflo(a.x); u[1] = bfhi(a.x); u[2] = bflo(a.y); u[3] = bfhi(a.y);
  u[4] = bflo(a.z); u[5] = bfhi(a.z); u[6] = bflo(a.w); u[7] = bfhi(a.w);
  u[8] = bflo(b.x); u[9] = bfhi(b.x); u[10] = bflo(b.y); u[11] = bfhi(b.y);
  u[12] = bflo(b.z); u[13] = bfhi(b.z); u[14] = bflo(b.w); u[15] = bfhi(b.w);
}
__device__ __forceinline__ void s5_stage_u(const u16* __restrict__ PD, int tok0, int gq, u16* us) {
#pragma unroll
  for (int i = 0; i < 2; ++i) {
    const int ch = TIDX + 256 * i;
    const int t = ch >> 3, part = ch & 7;
    *(u32x4*)(us + t * 64 + part * 8) = *(const u32x4*)(PD + (size_t)(tok0 + t) * 256 + gq * 64 + part * 8);
  }
}

__device__ __forceinline__ void s5a_item(const Params& p, int l, int item, unsigned char* smem) {
  const int lane = TIDX & 63, wv = TIDX >> 6;
  const int gq = item & 3, bc = item >> 2;
  const int g = gq * 4 + wv;
  const int tok0 = bc * 64;
  const u16* PD = (const u16*)(p.ws + OFF_PD);
  const float* ab = (const float*)(p.ws + OFF_S5AB) + ((size_t)(l * 16 + g) * 64 + lane) * 2;
  const float* bb = (const float*)(p.ws + OFF_S5BB) + ((size_t)(l * 16 + g) * 64 + lane) * 32;
  float bbr[16], bbi[16];
#pragma unroll
  for (int c = 0; c < 16; ++c) { bbr[c] = bb[c]; bbi[c] = bb[16 + c]; }
  const float abr = ab[0], abi = ab[1];
  float xr = 0.f, xi = 0.f;
  u16* us = (u16*)smem;
  s5_stage_u(PD, tok0, gq, us);
  __syncthreads();
#pragma unroll 4
  for (int t = 0; t < 64; ++t) {
    float u[16];
    s5_load_u(us, t, wv, u);
    float bur = 0.f, bui = 0.f;
#pragma unroll
    for (int c = 0; c < 16; ++c) { bur += bbr[c] * u[c]; bui += bbi[c] * u[c]; }
    float nr = abr * xr - abi * xi + bur;
    float ni = abr * xi + abi * xr + bui;
    xr = nr; xi = ni;
  }
  float2* E = (float2*)(p.ws + OFF_S5E);
  E[((size_t)bc * 16 + g) * 64 + lane] = make_float2(xr, xi);
  __syncthreads();
}

__device__ __forceinline__ void s5b_item(const Params& p, int l, int item, unsigned char* smem) {
  const int lane = TIDX & 63, wv = TIDX >> 6;
  const int gq = item & 3, bc = item >> 2;
  const int b = bc >> 6, ch = bc & 63;
  const int g = gq * 4 + wv;
  const int tok0 = bc * 64;
  u16* us = (u16*)(smem + 65536);
  s5_stage_u((const u16*)(p.ws + OFF_PD), tok0, gq, us);
  float* base = (float*)smem + wv * 4096;
  float* csr = base, *csi = base + 1024, *xsr = base + 2048, *xsi = base + 3072;
  const u16* PD = (const u16*)(p.ws + OFF_PD);
  const float* ab = (const float*)(p.ws + OFF_S5AB) + ((size_t)(l * 16 + g) * 64 + lane) * 2;
  const float* bb = (const float*)(p.ws + OFF_S5BB) + ((size_t)(l * 16 + g) * 64 + lane) * 32;
  const float* cre = p.in[32] + ((size_t)(l * 16 + g) * 16) * 64;
  const float* cim = p.in[33] + ((size_t)(l * 16 + g) * 16) * 64;
  for (int c = 0; c < 16; ++c) {
    csr[(lane >> 2) * 64 + c * 4 + (lane & 3)] = cre[c * 64 + lane];
    csi[(lane >> 2) * 64 + c * 4 + (lane & 3)] = cim[c * 64 + lane];
  }
  float bbr[16], bbi[16];
#pragma unroll
  for (int c = 0; c < 16; ++c) { bbr[c] = bb[c]; bbi[c] = bb[16 + c]; }
  const float abr = ab[0], abi = ab[1];
  float pr = abr, pi = abi;
#pragma unroll
  for (int s = 0; s < 6; ++s) { float nr = pr * pr - pi * pi, ni = 2.f * pr * pi; pr = nr; pi = ni; }
  float xr = 0.f, xi = 0.f;
  const float2* E = (const float2*)(p.ws + OFF_S5E);
  {
    const f32x2* Ev = (const f32x2*)E + ((size_t)(b * 64) * 16 + g) * 64 + lane;
    int c = 0;
    for (; c + 8 <= ch; c += 8) {
      f32x2 e[8];
#pragma unroll
      for (int k = 0; k < 8; ++k) e[k] = Ev[(size_t)(c + k) * 1024];
#pragma unroll
      for (int k = 0; k < 8; ++k) {
        const float nr = pr * xr - pi * xi + e[k].x;
        const float ni = pr * xi + pi * xr + e[k].y;
        xr = nr; xi = ni;
      }
    }
    for (; c < ch; ++c) {
      const f32x2 e = Ev[(size_t)c * 1024];
      const float nr = pr * xr - pi * xi + e.x;
      const float ni = pr * xi + pi * xr + e.y;
      xr = nr; xi = ni;
    }
  }
  const int tt = lane & 15, cq = lane >> 4;
  const float* dvec = p.in[34] + l * 256 + g * 16 + cq * 4;
  const float d0 = dvec[0], d1 = dvec[1], d2 = dvec[2], d3 = dvec[3];
  u16* YD = (u16*)(p.ws + OFF_YD);
  const int n4w = lane >> 2, e4 = lane & 3;
  __syncthreads();
#pragma unroll 1
  for (int sc = 0; sc < 4; ++sc) {
    for (int t = 0; t < 16; ++t) {
      float u[16];
      s5_load_u(us, sc * 16 + t, wv, u);
      float bur = 0.f, bui = 0.f;
#pragma unroll
      for (int c = 0; c < 16; ++c) { bur += bbr[c] * u[c]; bui += bbi[c] * u[c]; }
      float nr = abr * xr - abi * xi + bur;
      float ni = abr * xi + abi * xr + bui;
      xr = nr; xi = ni;
      int a = n4w * 64 + ((t ^ (n4w & 7)) << 2) + e4;
      xsr[a] = xr; xsi[a] = xi;
    }
    __syncthreads();
    float acc0 = 0.f, acc1 = 0.f, acc2 = 0.f, acc3 = 0.f;
#pragma unroll 2
    for (int n4 = 0; n4 < 16; ++n4) {
      int xa = n4 * 64 + ((tt ^ (n4 & 7)) << 2);
      float4 xr4 = *(const float4*)(xsr + xa);
      float4 xi4 = *(const float4*)(xsi + xa);
      const float* cr = csr + n4 * 64 + cq * 16;
      const float* ci = csi + n4 * 64 + cq * 16;
      float4 r0 = *(const float4*)(cr), r1 = *(const float4*)(cr + 4), r2 = *(const float4*)(cr + 8), r3 = *(const float4*)(cr + 12);
      float4 i0 = *(const float4*)(ci), i1 = *(const float4*)(ci + 4), i2 = *(const float4*)(ci + 8), i3 = *(const float4*)(ci + 12);
      acc0 += r0.x * xr4.x + r0.y * xr4.y + r0.z * xr4.z + r0.w * xr4.w - (i0.x * xi4.x + i0.y * xi4.y + i0.z * xi4.z + i0.w * xi4.w);
      acc1 += r1.x * xr4.x + r1.y * xr4.y + r1.z * xr4.z + r1.w * xr4.w - (i1.x * xi4.x + i1.y * xi4.y + i1.z * xi4.z + i1.w * xi4.w);
      acc2 += r2.x * xr4.x + r2.y * xr4.y + r2.z * xr4.z + r2.w * xr4.w - (i2.x * xi4.x + i2.y * xi4.y + i2.z * xi4.z + i2.w * xi4.w);
      acc3 += r3.x * xr4.x + r3.y * xr4.y + r3.z * xr4.z + r3.w * xr4.w - (i3.x * xi4.x + i3.y * xi4.y + i3.z * xi4.z + i3.w * xi4.w);
    }
    {
      const int tok = tok0 + sc * 16 + tt;
      u32x2 ur = *(const u32x2*)(us + (sc * 16 + tt) * 64 + wv * 16 + cq * 4);
      float y0 = acc0 + d0 * bflo(ur.x), y1 = acc1 + d1 * bfhi(ur.x), y2 = acc2 + d2 * bflo(ur.y), y3 = acc3 + d3 * bfhi(ur.y);
      u32x2 o; o.x = pack2(geluf_(y0), geluf_(y1)); o.y = pack2(geluf_(y2), geluf_(y3));
      *(u32x2*)(YD + (size_t)tok * 256 + g * 16 + cq * 4) = o;
    }
    __syncthreads();
  }
}

__device__ __forceinline__ void lds_barrier() {
  asm volatile("s_waitcnt lgkmcnt(0)" ::: "memory");
  __builtin_amdgcn_s_barrier();
  asm volatile("" ::: "memory");
}
__device__ __forceinline__ void scan_item(const Params& p, int item, unsigned char* smem) {
  const int tid = TIDX, lane = tid & 63, wv = tid >> 6;
  const int b = item >> 4, h = (item >> 2) & 3, q = item & 3;
  const int rl = lane >> 4, cl = lane & 15;
  const int rloc = wv * 4 + rl;
  const size_t tokb = (size_t)b * SEQ;
  const int chan0 = h * 64;
  const u16* SR = (const u16*)(p.ws + OFF_SR); const u16* SK = (const u16*)(p.ws + OFF_SK);
  const u16* SV = (const u16*)(p.ws + OFF_SV); const u16* SKK = (const u16*)(p.ws + OFF_SKK);
  const u16* SA = (const u16*)(p.ws + OFF_SA); const float* SW = (const float*)(p.ws + OFF_SW);
  float* O = (float*)(p.ws + OFF_O);
  constexpr int BUFF = 6432;
  float* lbase = (float*)smem;
  float* pp = lbase + 2 * BUFF + wv * 1024;
  const int st = tid >> 4, cg4 = tid & 15;
  struct Stg { u32x2 r, k, kk, a, kk1; f32x4 w; u16 v; };
  auto gload = [&](Stg& g, int c) {
    const size_t o = (tokb + (size_t)c * 16 + st) * 256 + chan0;
    g.r = *(const u32x2*)(SR + o + cg4 * 4); g.k = *(const u32x2*)(SK + o + cg4 * 4);
    g.kk = *(const u32x2*)(SKK + o + cg4 * 4); g.a = *(const u32x2*)(SA + o + cg4 * 4);
    g.w = *(const f32x4*)(SW + o + cg4 * 4);
    g.v = SV[o + q * 16 + cg4];
    int t1 = c * 16 + st + 1; if (t1 >= SEQ) t1 = SEQ - 1;
    g.kk1 = *(const u32x2*)(SKK + (tokb + (size_t)t1) * 256 + chan0 + cg4 * 4);
  };
  auto lwrite = [&](const Stg& g, int buf) {
    float* bp = lbase + buf * BUFF;
    const int o = st * 64 + cg4 * 4;
    f32x4 kk = {bflo(g.kk.x), bfhi(g.kk.x), bflo(g.kk.y), bfhi(g.kk.y)};
    f32x4 a = {bflo(g.a.x), bfhi(g.a.x), bflo(g.a.y), bfhi(g.a.y)};
    f32x4 k = {bflo(g.k.x), bfhi(g.k.x), bflo(g.k.y), bfhi(g.k.y)};
    f32x4 r = {bflo(g.r.x), bfhi(g.r.x), bflo(g.r.y), bfhi(g.r.y)};
    *(f32x4*)(bp + o) = kk;
    *(f32x4*)(bp + 1024 + o) = kk * a;
    *(f32x4*)(bp + 2048 + o) = k;
    *(f32x4*)(bp + 3072 + o) = g.w;
    *(f32x4*)(bp + 4096 + o) = r;
    bp[5120 + st * 16 + cg4] = bf2f(g.v);
    const f32x4 kn = {bflo(g.kk1.x), bfhi(g.kk1.x), bflo(g.kk1.y), bfhi(g.kk1.y)};
    *(f32x4*)(bp + 5376 + o) = g.w * kn;
    const f32x4 bb = kk * a;
    const float c1 = row_sum16(k.x * kn.x + k.y * kn.y + k.z * kn.z + k.w * kn.w);
    const float c2 = row_sum16(bb.x * kn.x + bb.y * kn.y + bb.z * kn.z + bb.w * kn.w);
    if (cg4 == 0) *(f32x2*)(bp + 6400 + st * 2) = f32x2{c1, c2};
  };
  constexpr int NCH = SEQ / 16;
  Stg R0, R1, R2, R3;
  gload(R0, 0); gload(R1, 1); gload(R2, 2); gload(R3, 3);
  __syncthreads();
  lwrite(R0, 0);
  __syncthreads();
  __builtin_amdgcn_s_setprio(3);
  float S0 = 0.f, S1 = 0.f, S2 = 0.f, S3 = 0.f;
  const int rrow = lane & 3, rstep = lane >> 2;
  struct Pair { f32x4 kkA, bbA, kA, wA, rA, mA, bbB, kB, wB, rB; f32x2 cA; float vA, vB; };
  auto chunk = [&](int c) {
    const float* bp = lbase + (c & 1) * BUFF;
    auto ldpair = [&](Pair& o, int s) {
      o.kkA = *(const f32x4*)(bp + s * 64 + cl * 4);
      o.mA = *(const f32x4*)(bp + 5376 + s * 64 + cl * 4);
      o.bbA = *(const f32x4*)(bp + 1024 + s * 64 + cl * 4);
      o.kA = *(const f32x4*)(bp + 2048 + s * 64 + cl * 4);
      o.wA = *(const f32x4*)(bp + 3072 + s * 64 + cl * 4);
      o.rA = *(const f32x4*)(bp + 4096 + s * 64 + cl * 4);
      o.vA = bp[5120 + s * 16 + rloc];
      o.cA = *(const f32x2*)(bp + 6400 + s * 2);
      o.bbB = *(const f32x4*)(bp + 1024 + (s + 1) * 64 + cl * 4);
      o.kB = *(const f32x4*)(bp + 2048 + (s + 1) * 64 + cl * 4);
      o.wB = *(const f32x4*)(bp + 3072 + (s + 1) * 64 + cl * 4);
      o.rB = *(const f32x4*)(bp + 4096 + (s + 1) * 64 + cl * 4);
      o.vB = bp[5120 + (s + 1) * 16 + rloc];
    };
    auto pairstep = [&](const Pair& o, int s) {
      const float pa = __builtin_fmaf(S3, o.kkA.w, __builtin_fmaf(S2, o.kkA.z, __builtin_fmaf(S1, o.kkA.y, S0 * o.kkA.x)));
      const float pd = __builtin_fmaf(S3, o.mA.w, __builtin_fmaf(S2, o.mA.z, __builtin_fmaf(S1, o.mA.y, S0 * o.mA.x)));
      const float saA = row_sum16(pa);
      const float dd = row_sum16(pd);
      const float saB = __builtin_fmaf(-saA, o.cA.y, __builtin_fmaf(o.vA, o.cA.x, dd));
      S0 = __builtin_fmaf(S0, o.wA.x, __builtin_fmaf(o.vA, o.kA.x, -(saA * o.bbA.x)));
      S1 = __builtin_fmaf(S1, o.wA.y, __builtin_fmaf(o.vA, o.kA.y, -(saA * o.bbA.y)));
      S2 = __builtin_fmaf(S2, o.wA.z, __builtin_fmaf(o.vA, o.kA.z, -(saA * o.bbA.z)));
      S3 = __builtin_fmaf(S3, o.wA.w, __builtin_fmaf(o.vA, o.kA.w, -(saA * o.bbA.w)));
      pp[(s * 4 + rl) * 16 + cl] = __builtin_fmaf(S3, o.rA.w, __builtin_fmaf(S2, o.rA.z, __builtin_fmaf(S1, o.rA.y, S0 * o.rA.x)));
      S0 = __builtin_fmaf(S0, o.wB.x, __builtin_fmaf(o.vB, o.kB.x, -(saB * o.bbB.x)));
      S1 = __builtin_fmaf(S1, o.wB.y, __builtin_fmaf(o.vB, o.kB.y, -(saB * o.bbB.y)));
      S2 = __builtin_fmaf(S2, o.wB.z, __builtin_fmaf(o.vB, o.kB.z, -(saB * o.bbB.z)));
      S3 = __builtin_fmaf(S3, o.wB.w, __builtin_fmaf(o.vB, o.kB.w, -(saB * o.bbB.w)));
      pp[((s + 1) * 4 + rl) * 16 + cl] = __builtin_fmaf(S3, o.rB.w, __builtin_fmaf(S2, o.rB.z, __builtin_fmaf(S1, o.rB.y, S0 * o.rB.x)));
    };
    Pair p0, p1;
    ldpair(p0, 0);
#pragma unroll
    for (int j = 0; j < 4; ++j) {
      ldpair(p1, 4 * j + 2);
      __builtin_amdgcn_sched_barrier(0);
      pairstep(p0, 4 * j);
      __builtin_amdgcn_sched_barrier(0);
      if (j < 3) ldpair(p0, 4 * j + 4);
      __builtin_amdgcn_sched_barrier(0);
      pairstep(p1, 4 * j + 2);
      __builtin_amdgcn_sched_barrier(0);
    }
    asm volatile("" ::: "memory");
    {
      const float* q0 = pp + (rstep * 4 + rrow) * 16;
      f32x4 a0 = *(const f32x4*)(q0), a1 = *(const f32x4*)(q0 + 4), a2 = *(const f32x4*)(q0 + 8), a3 = *(const f32x4*)(q0 + 12);
      f32x4 sm4 = (a0 + a1) + (a2 + a3);
      O[(tokb + (size_t)c * 16 + rstep) * 256 + chan0 + q * 16 + wv * 4 + rrow] = (sm4.x + sm4.y) + (sm4.z + sm4.w);
    }
    asm volatile("" ::: "memory");
  };
#pragma unroll 1
  for (int g = 0; g < NCH / 4; ++g) {
    const int c0 = g * 4;
    if (c0 + 4 < NCH) gload(R0, c0 + 4);
    chunk(c0);
    lwrite(R1, (c0 + 1) & 1);
    lds_barrier();
    if (c0 + 5 < NCH) gload(R1, c0 + 5);
    chunk(c0 + 1);
    lwrite(R2, (c0 + 2) & 1);
    lds_barrier();
    if (c0 + 6 < NCH) gload(R2, c0 + 6);
    chunk(c0 + 2);
    lwrite(R3, (c0 + 3) & 1);
    lds_barrier();
    if (c0 + 7 < NCH) gload(R3, c0 + 7);
    chunk(c0 + 3);
    if (c0 + 4 < NCH) lwrite(R0, (c0 + 4) & 1);
    lds_barrier();
  }
  __builtin_amdgcn_s_setprio(0);
}

__device__ __forceinline__ void rwkv_post_item(const Params& p, int l, int item) {
  const int j = TIDX;
  const float* O = (const float*)(p.ws + OFF_O);
  const u16* SR = (const u16*)(p.ws + OFF_SR); const u16* SK = (const u16*)(p.ws + OFF_SK);
  const u16* SV = (const u16*)(p.ws + OFF_SV); const u16* G = (const u16*)(p.ws + OFF_G);
  u16* OG = (u16*)(p.ws + OFF_OG);
  const float lw = p.in[18][l * 256 + j], lb = p.in[19][l * 256 + j], rk = p.in[17][l * 256 + j];
  const int tok0 = item * 8;
  float ov[8]; u16 rr[8], rkk[8], rv[8], rg[8];
#pragma unroll
  for (int t = 0; t < 8; ++t) {
    const size_t o = (size_t)(tok0 + t) * 256 + j;
    ov[t] = O[o]; rr[t] = SR[o]; rkk[t] = SK[o]; rv[t] = SV[o]; rg[t] = G[o];
  }
#pragma unroll
  for (int t = 0; t < 8; ++t) {
    const size_t o = (size_t)(tok0 + t) * 256 + j;
    float mean = wave_sum(ov[t]) * (1.f / 64.f);
    float d = ov[t] - mean;
    float var = wave_sum(d * d) * (1.f / 64.f);
    float on = d * rsqrtf(var + 64e-5f) * lw + lb;
    float bonus = wave_sum(bf2f(rr[t]) * bf2f(rkk[t]) * rk);
    OG[o] = f2bf((on + bonus * bf2f(rv[t])) * bf2f(rg[t]));
  }
}

#define XB_TMO      128
#define XB_XCNT(j)  (256  + 64 * (j))
#define XB_XSUB(j)  (1280 + 64 * (j))
#define XB_XGEN(j)  (2304 + 64 * (j))
#define XB_TOP      3328
#define XB_TOPGEN   3392
#define XCD_BAR_WORDS 3456
#define XB_SPIN_CAP (1u << 22)
#define LAS __attribute__((address_space(3)))
__device__ __forceinline__ unsigned xb_ld(unsigned* p) { return __hip_atomic_load(p, __ATOMIC_RELAXED, __HIP_MEMORY_SCOPE_AGENT); }
__device__ __forceinline__ unsigned xb_add(unsigned* p, unsigned v) { return __hip_atomic_fetch_add(p, v, __ATOMIC_RELAXED, __HIP_MEMORY_SCOPE_AGENT); }
__device__ __forceinline__ unsigned xb_xcc_id() { return (unsigned)__builtin_amdgcn_s_getreg((3 << 11) | 20) & 0xFu; }
#define XB_SPIN(cond, bar) do { unsigned _sp = 0; while (cond) { __builtin_amdgcn_s_sleep(1); \
    if ((++_sp & 255u) == 0u) { if (xb_ld(&(bar)[XB_TMO])) break; if (_sp > XB_SPIN_CAP) { atomicAdd(&(bar)[XB_TMO], 1u); break; } } } } while (0)
struct XcdBarrier { unsigned* bar; unsigned x; volatile LAS unsigned* st; };
__device__ __forceinline__ XcdBarrier xcd_barrier_post(unsigned* bar, volatile LAS unsigned* st) {
  XcdBarrier b; b.bar = bar; b.x = xb_xcc_id(); b.st = st;
  if (threadIdx.x == 0) st[2] = xb_add(&bar[XB_XCNT(b.x)], 1u);
  return b;
}
__device__ __forceinline__ void xcd_barrier_complete(unsigned* bar, unsigned x, unsigned& nloc, unsigned& nx) {
  const unsigned G = gridDim.x * gridDim.y * gridDim.z;
  unsigned sum, cnt, mine, sp = 0u;
  for (;;) {
    sum = 0u; cnt = 0u; mine = 0u;
#pragma unroll
    for (unsigned j = 0; j < 16; ++j) { const unsigned c = xb_ld(&bar[XB_XCNT(j)]); sum += c; cnt += (c > 0u) ? 1u : 0u; mine = (j == x) ? c : mine; }
    if (sum == G) break;
    __builtin_amdgcn_s_sleep(1);
    if ((++sp & 255u) == 0u) { if (xb_ld(&bar[XB_TMO])) break; if (sp > XB_SPIN_CAP) { atomicAdd(&bar[XB_TMO], 1u); break; } }
  }
  nloc = mine > 0u ? mine : 1u; nx = cnt > 0u ? cnt : 1u;
}
__device__ __forceinline__ void xcd_barrier(const XcdBarrier& b) {
  asm volatile("s_waitcnt vmcnt(0)" ::: "memory");
  __syncthreads();
  if (threadIdx.x == 0) {
    unsigned* bar = b.bar;
    __builtin_amdgcn_s_waitcnt(0);
    unsigned nloc = b.st[0], nx = b.st[1];
    if (nloc == 0u) { xcd_barrier_complete(bar, b.x, nloc, nx); b.st[0] = nloc; b.st[1] = nx; }
    const unsigned old = xb_add(&bar[XB_XSUB(b.x)], 1u);
    const unsigned gen = old / nloc;
    if (old + 1u == (gen + 1u) * nloc) {
      __builtin_amdgcn_fence(__ATOMIC_RELEASE, "agent");
      asm volatile("s_waitcnt vmcnt(0)" ::: "memory");
      const unsigned og = xb_add(&bar[XB_TOP], 1u);
      const unsigned tg = og / nx;
      if (og + 1u == (tg + 1u) * nx) xb_add(&bar[XB_TOPGEN], 1u);
      else XB_SPIN(xb_ld(&bar[XB_TOPGEN]) == tg, bar);
      __builtin_amdgcn_fence(__ATOMIC_ACQUIRE, "agent");
      xb_add(&bar[XB_XGEN(b.x)], 1u);
      asm volatile("s_waitcnt vmcnt(0)" ::: "memory");
    } else {
      XB_SPIN(xb_ld(&bar[XB_XGEN(b.x)]) == gen, bar);
      __builtin_amdgcn_fence(__ATOMIC_ACQUIRE, "agent");
      asm volatile("s_waitcnt vmcnt(0)" ::: "memory");
    }
  }
  __syncthreads();
}

__device__ __forceinline__ int xcd_virtual_id(const XcdBarrier& b) {
  if (threadIdx.x == 0) {
    unsigned base = 0u;
#pragma unroll
    for (unsigned j = 0; j < 16; ++j) { const unsigned c = xb_ld(&b.bar[XB_XCNT(j)]); base += (j < b.x) ? c : 0u; }
    b.st[3] = base + b.st[2];
  }
  __syncthreads();
  const int vb = __builtin_amdgcn_readfirstlane((int)b.st[3]);
  __syncthreads();
  return vb;
}

__device__ __forceinline__ void sub_barrier(unsigned* cnt, unsigned target) {
  asm volatile("s_waitcnt vmcnt(0)" ::: "memory");
  __syncthreads();
  if (threadIdx.x == 0) {
    __builtin_amdgcn_fence(__ATOMIC_RELEASE, "agent");
    asm volatile("s_waitcnt vmcnt(0)" ::: "memory");
    xb_add(cnt, 1u);
    unsigned sp = 0;
    while (xb_ld(cnt) < target) { __builtin_amdgcn_s_sleep(2); if (++sp > (1u << 24)) break; }
    __builtin_amdgcn_fence(__ATOMIC_ACQUIRE, "agent");
    asm volatile("s_waitcnt vmcnt(0)" ::: "memory");
  }
  __syncthreads();
}

#define N_PHASES 22
#ifndef PROBE_CONV_REPS
#define PROBE_CONV_REPS 1
#endif
#ifndef PROBE_PREP_REPS
#define PROBE_PREP_REPS 1
#endif
#ifndef PROBE_POST_REPS
#define PROBE_POST_REPS 1
#endif
#ifndef PROBE_SCAN_REPS
#define PROBE_SCAN_REPS 1
#endif
#ifndef PROBE_FFN1_REPS
#define PROBE_FFN1_REPS 1
#endif
#ifndef PH_MASK
#define PH_MASK 0xFFFFF
#endif
#define PHON(s) (PH_MASK & (1 << (s)))
#define PHASE_BEGIN(k) if (ph_hi > (k)) { if ((k) > 1) xcd_barrier(xb);
#define PHASE_END }

template <int L>
__device__ __forceinline__ void run_layer(const Params& p, int vbr, int ph_hi, unsigned char* smem_all, const XcdBarrier& xb) {
  unsigned char* smem = smem_all + SUBB * 73728;
  const int vb = vbr * 2 + SUBB;
  constexpr int l = L;
  constexpr int base = 1 + 10 * L;
  const float* modl = (const float*)(p.ws + OFF_MOD) + (size_t)l * 4 * 6144;
  PHASE_BEGIN(base + 0)
    for (int rep = 0; rep < PROBE_CONV_REPS; ++rep) {
      if (rep) xcd_barrier(xb);
      phase_convert(p, l, smem);
      phase_norm(l == 0 ? p.in[0] : p.out, p.in[4] + l * 1024, modl, 0, 1024, (u16*)(p.ws + OFF_H));
    }
  PHASE_END
  PHASE_BEGIN(base + 1)
    phase_pproj_tail(p, vbr, smem_all);
    phase_gemm_8w<0>(p, l, vbr, smem_all);
  PHASE_END
  PHASE_BEGIN(base + 2)
    for (int rep = 0; rep < PROBE_PREP_REPS; ++rep) {
      if (rep) xcd_barrier(xb);
      for (int item = VBLK; item < 512; item += VGRID) rwkv_prep_item(p, l, item, smem);
    }
  PHASE_END
  PHASE_BEGIN(base + 3)
    if ((int)blockIdx.x < 64) {
      if (SUBB == 0) scan_item(p, blockIdx.x, smem);
      else { __syncthreads(); __syncthreads(); for (int c = 0; c < SEQ / 16; ++c) lds_barrier(); }
    }
    else {
      const int nb = VGRID - 128, bi = VBLK - 128;
      for (int item = bi; item < 512; item += nb) sg_item(p, l, item, smem);
      for (int item = (bi + 2 * (nb / 3)) % nb; item < 1024; item += nb) s5a_item(p, l, item, smem);
      for (int item = (bi + 2 * (nb / 3)) % nb; item < 2048; item += nb) conv_item(p, l, item);
      sub_barrier((unsigned*)(p.ws + OFF_BAR) + 3520 + 64 * (2 * l), gridDim.x - 64);
      for (int item = bi; item < 1024; item += nb) s5b_item(p, l, item, smem);
      sub_barrier((unsigned*)(p.ws + OFF_BAR) + 3520 + 64 * (2 * l + 1), gridDim.x - 64);
      for (int item = (int)blockIdx.x - 64; item < 512; item += (int)gridDim.x - 64) merge_tile8<0>(p, item, smem_all);
    }
  PHASE_END
  PHASE_BEGIN(base + 4)
    for (int rep = 0; rep < PROBE_POST_REPS; ++rep) { if (rep) xcd_barrier(xb); for (int item = VBLK; item < 2048; item += VGRID) rwkv_post_item(p, l, item); }
  PHASE_END
  PHASE_BEGIN(base + 5)
    for (int item = vbr; item < 512; item += (int)gridDim.x) {
      int it2 = item;
      if (gridDim.x == 256) { const int r = item >> 8, w = vbr & 31; it2 = ((r * 4 + (w >> 3)) << 6) | ((vbr >> 5) * 8 + (w & 7)); }
      merge_tile8<1>(p, it2, smem_all);
    }
  PHASE_END
  PHASE_BEGIN(base + 6)
    phase_gemm_8w<1>(p, l, vbr, smem_all);
  PHASE_END
  PHASE_BEGIN(base + 7)
    if (PHON(7)) phase_norm(p.out, p.in[38] + l * 1024, modl, 3072, 4096, (u16*)(p.ws + OFF_H));
  PHASE_END
  PHASE_BEGIN(base + 8)
    phase_gemm_8w<2>(p, l, vbr, smem_all);
  PHASE_END
#ifdef PROBE_DUP_FFN1
  PHASE_BEGIN(base + 8)
    phase_gemm_8w<2>(p, l, vbr, smem_all);
  PHASE_END
#endif
  PHASE_BEGIN(base + 9)
    phase_gemm_8w<3>(p, l, vbr, smem_all);
  PHASE_END
}

__global__ void __launch_bounds__(512, 2) mega_fwd(Params p, int ph_lo, int ph_hi) {
  __shared__ __attribute__((aligned(16))) unsigned char smem[2 * 73728 + 16];
  cg::grid_group grid = cg::this_grid();
  if (ph_hi < 0) grid.sync();
  volatile LAS unsigned* st = (volatile LAS unsigned*)(smem + 2 * 73728);
  if (threadIdx.x == 0) { st[0] = 0u; st[1] = 0u; st[2] = 0u; st[3] = 0u; }
  __syncthreads();
  const XcdBarrier xb = xcd_barrier_post((unsigned*)(p.ws + OFF_BAR), st);
  if (ph_hi > 0) phase_mod(p, smem + SUBB * 73728);
  xcd_barrier(xb);
  const int vb = xcd_virtual_id(xb);
  run_layer<0>(p, vb, ph_hi, smem, xb);
  run_layer<1>(p, vb, ph_hi, smem, xb);
  PHASE_BEGIN(21)
    if (PHON(11)) phase_final(p.out, p.in[41]);
  PHASE_END
}

extern "C" void kernel_launch(void* const* d_in, const int* in_sizes, int n_in, void* d_out, int out_size, void* d_ws,
                              size_t ws_size, hipStream_t stream) {
  static int grid_blocks = 0;
  if (!grid_blocks) {
    int dev = 0, cus = 0, per_cu = 0;
    hipGetDevice(&dev);
    hipDeviceGetAttribute(&cus, hipDeviceAttributeMultiprocessorCount, dev);
    hipOccupancyMaxActiveBlocksPerMultiprocessor(&per_cu, mega_fwd, 512, 0);
    if (per_cu > 1) per_cu = 1;
    if (per_cu < 1) per_cu = 1;
    grid_blocks = cus * per_cu;
    if (ws_size < WS_END) fprintf(stderr, "workspace too small: %zu < %zu\n", ws_size, (size_t)WS_END);
  }
  Params p{};
  for (int i = 0; i < 42; ++i) p.in[i] = (const float*)d_in[i];
  p.out = (float*)d_out;
  p.ws = (unsigned char*)d_ws;
  hipMemsetAsync((unsigned char*)d_ws + OFF_BAR, 0, 16384, stream);
  int lo = 0, hi = N_PHASES;
  void* args[] = {&p, &lo, &hi};
  hipError_t e = hipLaunchCooperativeKernel((void*)mega_fwd, dim3(grid_blocks), dim3(512), args, 0, stream);
  if (e != hipSuccess) fprintf(stderr, "cooperative launch failed: %s (grid %d)\n", hipGetErrorString(e), grid_blocks);
}
```

```cpp
#include <hip/hip_runtime.h>
#include <hip/hip_cooperative_groups.h>
#include <cstdio>
namespace cg = cooperative_groups;

typedef unsigned short u16;
using bf16x8 = __attribute__((ext_vector_type(8))) short;
using f32x4 = __attribute__((ext_vector_type(4))) float;
using u32x4 = __attribute__((ext_vector_type(4))) unsigned int;
using u32x2 = __attribute__((ext_vector_type(2))) unsigned int;
using f32x2 = __attribute__((ext_vector_type(2))) float;

#define T_TOK 16384
#define SEQ 4096
#define DM 1024
#define NTHR 256
#define TIDX ((int)(threadIdx.x & 255))
#define SUBB ((int)(threadIdx.x >> 8))
#define VBLK ((int)(blockIdx.x * 2 + (threadIdx.x >> 8)))
#define VGRID ((int)(gridDim.x * 2))

static constexpr size_t SZ_WIN = (size_t)6528 * 1024 * 2;
static constexpr size_t OFF_WIN = 0;
static constexpr size_t OFF_RO = OFF_WIN + SZ_WIN;
static constexpr size_t OFF_SO = OFF_RO + 1024 * 256 * 2;
static constexpr size_t OFF_CO = OFF_SO + 1024 * 256 * 2;
static constexpr size_t OFF_GLU = OFF_CO + 1024 * 256 * 2;
static constexpr size_t OFF_WO = OFF_GLU + 2048 * 256 * 2;
static constexpr size_t OFF_W1 = OFF_WO + 1024 * 1024 * 2;
static constexpr size_t OFF_W2 = OFF_W1 + (size_t)4096 * 1024 * 2;
static constexpr size_t OFF_H = OFF_W2 + (size_t)4096 * 1024 * 2;
static constexpr size_t SZ_T256B = (size_t)T_TOK * 256 * 2;
static constexpr size_t OFF_VF = OFF_H + (size_t)T_TOK * 1024 * 2;
static constexpr size_t OFF_PD = OFF_VF + SZ_T256B;
static constexpr size_t OFF_G = OFF_PD + SZ_T256B;
static constexpr size_t OFF_UB = OFF_G + SZ_T256B;
static constexpr size_t OFF_CB = OFF_UB + SZ_T256B;
static constexpr size_t OFF_SR = OFF_CB + SZ_T256B;
static constexpr size_t OFF_SK = OFF_SR + SZ_T256B;
static constexpr size_t OFF_SV = OFF_SK + SZ_T256B;
static constexpr size_t OFF_SKK = OFF_SV + SZ_T256B;
static constexpr size_t OFF_SA = OFF_SKK + SZ_T256B;
static constexpr size_t OFF_SW = OFF_SA + SZ_T256B;
static constexpr size_t OFF_PABC = OFF_SW + 2 * SZ_T256B;
static constexpr size_t OFF_YD = OFF_PABC;
static constexpr size_t OFF_OG = OFF_YD + SZ_T256B;
static constexpr size_t OFF_MRG = OFF_OG + SZ_T256B;
static constexpr size_t OFF_F = OFF_UB;
static constexpr size_t OFF_SMALL = OFF_PABC + (size_t)T_TOK * 2176 * 2;
static constexpr size_t OFF_MOD = OFF_SMALL;
static constexpr size_t OFF_S5AB = OFF_MOD + 2 * 4 * 6144 * 4;
static constexpr size_t OFF_S5BB = OFF_S5AB + 2 * 16 * 64 * 2 * 4;
static constexpr size_t OFF_S5E = OFF_S5BB + 2 * 16 * 64 * 32 * 4;
static constexpr size_t OFF_BAR = OFF_S5E + (size_t)4 * 64 * 16 * 64 * 2 * 4;
static constexpr size_t OFF_SGW = OFF_BAR + 16384;
static constexpr size_t OFF_O = OFF_SGW + 4 * 128 * 128 * 2;
static constexpr size_t OFF_LW2 = OFF_O + 2 * SZ_T256B;
static constexpr size_t OFF_LA2 = OFF_LW2 + 256 * 32 * 2;
static constexpr size_t OFF_LG2 = OFF_LA2 + 256 * 32 * 2;
static constexpr size_t OFF_LV2 = OFF_LG2 + 256 * 64 * 2;
static constexpr size_t OFF_LV1 = OFF_LV2 + 256 * 32 * 2;
static constexpr size_t OFF_SGST = OFF_LV1 + 32 * 256 * 2;
static constexpr size_t WS_END = OFF_SGST + (size_t)T_TOK * 2 * 4;
static_assert(OFF_F + (size_t)T_TOK * 4096 * 2 <= OFF_SMALL, "F overlaps small region");
static_assert(OFF_MRG + (size_t)T_TOK * 1024 * 2 <= OFF_SMALL, "MRG overlaps");

struct Params {
  const float* in[42];
  float* out;
  unsigned char* ws;
};

__device__ __forceinline__ u16 f2bf(float f) {
  unsigned u = __float_as_uint(f);
  u += 0x7fffu + ((u >> 16) & 1u);
  return (u16)(u >> 16);
}
__device__ __forceinline__ float bf2f(u16 h) { return __uint_as_float(((unsigned)h) << 16); }
__device__ __forceinline__ float bflo(unsigned u) { return __uint_as_float(u << 16); }
__device__ __forceinline__ float bfhi(unsigned u) { return __uint_as_float(u & 0xffff0000u); }
__device__ __forceinline__ unsigned pack2(float a, float b) { return (unsigned)f2bf(a) | ((unsigned)f2bf(b) << 16); }
__device__ __forceinline__ float sigmoidf_(float x) { return 1.f / (1.f + __expf(-x)); }
__device__ __forceinline__ float tanhf_(float y) { return 1.f - 2.f / (1.f + __expf(2.f * y)); }
__device__ __forceinline__ float geluf_(float x) {
  float y = 0.7978845608028654f * (x + 0.044715f * x * x * x);
  return 0.5f * x * (1.f + tanhf_(y));
}
__device__ __forceinline__ float wave_sum(float v) {
#pragma unroll
  for (int o = 32; o > 0; o >>= 1) v += __shfl_xor(v, o, 64);
  return v;
}
template <int CTRL>
__device__ __forceinline__ float dppf(float x) {
  return __int_as_float(__builtin_amdgcn_update_dpp(__float_as_int(x), __float_as_int(x), CTRL, 0xF, 0xF, true));
}
__device__ __forceinline__ float row_sum16(float x) {
  x += dppf<0x128>(x);
  x += dppf<0x124>(x);
  x += dppf<0x122>(x);
  x += dppf<0x121>(x);
  return x;
}

__device__ __forceinline__ void phase_mod(const Params& p, unsigned char* smem) {
  const int tid = TIDX;
  float* cact = (float*)smem;
  float* red = cact + 4096;
  float* mod = (float*)(p.ws + OFF_MOD);
  for (int i = tid; i < 4096; i += NTHR) { float c = p.in[1][i]; cact[i] = c / (1.f + __expf(-c)); }
  __syncthreads();
  for (int item = VBLK; item < 192; item += VGRID) {
    int l = item / 96, nb = item % 96;
    int cl = tid & 63, kq = tid >> 6;
    int col = nb * 64 + cl;
    const float* W = p.in[2] + (size_t)l * 1024 * 6144;
    float a0 = 0, a1 = 0, a2 = 0, a3 = 0;
    for (int k = kq * 256; k < kq * 256 + 256; ++k) {
      float w = W[(size_t)k * 6144 + col];
      a0 += cact[k] * w; a1 += cact[1024 + k] * w; a2 += cact[2048 + k] * w; a3 += cact[3072 + k] * w;
    }
    red[(kq * 4 + 0) * 64 + cl] = a0; red[(kq * 4 + 1) * 64 + cl] = a1;
    red[(kq * 4 + 2) * 64 + cl] = a2; red[(kq * 4 + 3) * 64 + cl] = a3;
    __syncthreads();
    {
      int b = tid >> 6;
      float s = red[(0 * 4 + b) * 64 + cl] + red[(1 * 4 + b) * 64 + cl] + red[(2 * 4 + b) * 64 + cl] + red[(3 * 4 + b) * 64 + cl];
      mod[((size_t)l * 4 + b) * 6144 + col] = s + p.in[3][l * 6144 + col];
    }
    __syncthreads();
  }
  float* s5ab = (float*)(p.ws + OFF_S5AB);
  float* s5bb = (float*)(p.ws + OFF_S5BB);
  for (int idx = VBLK * NTHR + tid; idx < 2048; idx += VGRID * NTHR) {
    int l = idx >> 10, g = (idx >> 6) & 15, n = idx & 63;
    double lre = fmin((double)p.in[28][idx], -1e-4);
    double lim = (double)p.in[29][idx];
    double dt = exp((double)p.in[35][l * 16 + g]);
    double mag = exp(lre * dt);
    double abr = mag * cos(lim * dt), abi = mag * sin(lim * dt);
    double den = lre * lre + lim * lim;
    double qr = ((abr - 1.0) * lre + abi * lim) / den;
    double qi = (abi * lre - (abr - 1.0) * lim) / den;
    s5ab[idx * 2 + 0] = (float)abr; s5ab[idx * 2 + 1] = (float)abi;
    for (int c = 0; c < 16; ++c) {
      double br = p.in[30][(size_t)idx * 16 + c], bi = p.in[31][(size_t)idx * 16 + c];
      s5bb[(size_t)idx * 32 + c] = (float)(qr * br - qi * bi);
      s5bb[(size_t)idx * 32 + 16 + c] = (float)(qr * bi + qi * br);
    }
  }
}

__device__ __forceinline__ void convert_tile(const float* __restrict__ src, int K, int N, u16* __restrict__ dst, int tk, int tn, u16* sm) {
  const int tid = TIDX;
  int r = tid >> 4, c4 = (tid & 15) * 4;
#pragma unroll
  for (int i = 0; i < 4; ++i) {
    int kk = r + 16 * i;
    float4 v = *(const float4*)(src + (size_t)(tk * 64 + kk) * N + tn * 64 + c4);
    sm[(c4 + 0) * 72 + kk] = f2bf(v.x);
    sm[(c4 + 1) * 72 + kk] = f2bf(v.y);
    sm[(c4 + 2) * 72 + kk] = f2bf(v.z);
    sm[(c4 + 3) * 72 + kk] = f2bf(v.w);
  }
  __syncthreads();
#pragma unroll
  for (int j = 0; j < 2; ++j) {
    int n = (tid >> 3) + 32 * j, ch = tid & 7;
    u32x4 v = *(const u32x4*)(sm + n * 72 + ch * 8);
    *(u32x4*)(dst + (size_t)(tn * 64 + n) * K + tk * 64 + ch * 8) = v;
  }
  __syncthreads();
}

__device__ __forceinline__ void phase_convert(const Params& p, int l, unsigned char* smem) {
  u16* sm = (u16*)smem;
  const int total = 1632 + 192 + 128 + 256 + 1024 + 1024;
  for (int item = VBLK; item < total + 16 + 192; item += VGRID) {
    int t = item;
    if (t >= total + 16) {
      const int e = (t - total - 16) * 256 + TIDX;
      if (e < 8192) { const int n = e >> 5, k = e & 31; ((u16*)(p.ws + OFF_LW2))[e] = f2bf(p.in[8][(size_t)l * 8192 + k * 256 + n]); }
      else if (e < 16384) { const int q = e - 8192, n = q >> 5, k = q & 31; ((u16*)(p.ws + OFF_LA2))[q] = f2bf(p.in[10][(size_t)l * 8192 + k * 256 + n]); }
      else if (e < 32768) { const int q = e - 16384, n = q >> 6, k = q & 63; ((u16*)(p.ws + OFF_LG2))[q] = f2bf(p.in[11][(size_t)l * 16384 + k * 256 + n]); }
      else if (e < 40960) { const int q = e - 32768, n = q >> 5, k = q & 31; ((u16*)(p.ws + OFF_LV2))[q] = (l > 0) ? f2bf(p.in[14][k * 256 + n]) : (u16)0; }
      else { const int q = e - 40960, n = q >> 8, k = q & 255; ((u16*)(p.ws + OFF_LV1))[q] = (l > 0) ? f2bf(p.in[13][k * 32 + n]) : (u16)0; }
      continue;
    }
    if (t >= total) {
      const int idx = t - total, g = idx >> 2, rq = idx & 3;
      const int tr = rq * 32 + (TIDX >> 3), s0 = (TIDX & 7) * 16;
      const float* src = p.in[23] + (((size_t)l * 4 + g) * 128 + tr) * 128 + s0;
      u16* dst = (u16*)(p.ws + OFF_SGW) + ((size_t)g * 128 + tr) * 128 + s0;
      unsigned pk[8];
#pragma unroll
      for (int e = 0; e < 4; ++e) {
        f32x4 v = *(const f32x4*)(src + e * 4);
        const int sb = s0 + e * 4;
        pk[e * 2 + 0] = pack2(sb + 0 <= tr ? v.x : 0.f, sb + 1 <= tr ? v.y : 0.f);
        pk[e * 2 + 1] = pack2(sb + 2 <= tr ? v.z : 0.f, sb + 3 <= tr ? v.w : 0.f);
      }
      *(u32x4*)(dst) = u32x4{pk[0], pk[1], pk[2], pk[3]};
      *(u32x4*)(dst + 8) = u32x4{pk[4], pk[5], pk[6], pk[7]};
      continue;
    }
    const float* src; int K, N; size_t off;
    if (t < 1632) { src = p.in[5] + (size_t)l * 1024 * 6528; K = 1024; N = 6528; off = OFF_WIN; }
    else if ((t -= 1632) < 64) { src = p.in[20] + (size_t)l * 256 * 1024; K = 256; N = 1024; off = OFF_RO; }
    else if ((t -= 64) < 64) { src = p.in[25] + (size_t)l * 256 * 1024; K = 256; N = 1024; off = OFF_SO; }
    else if ((t -= 64) < 64) { src = p.in[27] + (size_t)l * 256 * 1024; K = 256; N = 1024; off = OFF_CO; }
    else if ((t -= 64) < 128) { src = p.in[36] + (size_t)l * 256 * 2048; K = 256; N = 2048; off = OFF_GLU; }
    else if ((t -= 128) < 256) { src = p.in[37] + (size_t)l * 1024 * 1024; K = 1024; N = 1024; off = OFF_WO; }
    else if ((t -= 256) < 1024) { src = p.in[39] + (size_t)l * 1024 * 4096; K = 1024; N = 4096; off = OFF_W1; }
    else { t -= 1024; src = p.in[40] + (size_t)l * 4096 * 1024; K = 4096; N = 1024; off = OFF_W2; }
    int ntn = N / 64;
    convert_tile(src, K, N, (u16*)(p.ws + off), t / ntn, t % ntn, sm);
  }
}

__device__ __forceinline__ void phase_norm(const float* __restrict__ X, const float* __restrict__ g, const float* __restrict__ modl,
                           int sh_off, int sc_off, u16* __restrict__ H) {
  const int lane = TIDX & 63, wv = TIDX >> 6;
  for (int item = VBLK; item < T_TOK / 4; item += VGRID) {
    int row = item * 4 + wv;
    int b = row >> 12;
    const float* xr = X + (size_t)row * 1024;
    float4 v[4];
    float ss = 0;
#pragma unroll
    for (int i = 0; i < 4; ++i) {
      v[i] = *(const float4*)(xr + lane * 4 + 256 * i);
      ss += v[i].x * v[i].x + v[i].y * v[i].y + v[i].z * v[i].z + v[i].w * v[i].w;
    }
    ss = wave_sum(ss);
    float rstd = rsqrtf(ss * (1.f / 1024.f) + 1e-6f);
    const float* sh = modl + (size_t)b * 6144 + sh_off;
    const float* sc = modl + (size_t)b * 6144 + sc_off;
#pragma unroll
    for (int i = 0; i < 4; ++i) {
      int c = lane * 4 + 256 * i;
      float4 gg = *(const float4*)(g + c);
      float4 s1 = *(const float4*)(sc + c);
      float4 s0 = *(const float4*)(sh + c);
      float h0 = v[i].x * rstd * gg.x * (1.f + s1.x) + s0.x;
      float h1 = v[i].y * rstd * gg.y * (1.f + s1.y) + s0.y;
      float h2 = v[i].z * rstd * gg.z * (1.f + s1.z) + s0.z;
      float h3 = v[i].w * rstd * gg.w * (1.f + s1.w) + s0.w;
      u32x2 o; o.x = pack2(h0, h1); o.y = pack2(h2, h3);
      *(u32x2*)(H + (size_t)row * 1024 + c) = o;
    }
  }
}

__device__ __forceinline__ void phase_final(float* __restrict__ X, const float* __restrict__ g) {
  const int lane = TIDX & 63, wv = TIDX >> 6;
  for (int item = VBLK; item < T_TOK / 4; item += VGRID) {
    int row = item * 4 + wv;
    float* xr = X + (size_t)row * 1024;
    float4 v[4];
    float ss = 0;
#pragma unroll
    for (int i = 0; i < 4; ++i) {
      v[i] = *(const float4*)(xr + lane * 4 + 256 * i);
      ss += v[i].x * v[i].x + v[i].y * v[i].y + v[i].z * v[i].z + v[i].w * v[i].w;
    }
    ss = wave_sum(ss);
    float rstd = rsqrtf(ss * (1.f / 1024.f) + 1e-6f);
#pragma unroll
    for (int i = 0; i < 4; ++i) {
      int c = lane * 4 + 256 * i;
      float4 gg = *(const float4*)(g + c);
      float4 o;
      o.x = v[i].x * rstd * gg.x; o.y = v[i].y * rstd * gg.y; o.z = v[i].z * rstd * gg.z; o.w = v[i].w * rstd * gg.w;
      *(float4*)(xr + c) = o;
    }
  }
}

template <int NF, bool LEAN = false>
__device__ __forceinline__ void gemm_mainloop(const u16* __restrict__ A, int lda, const u16* __restrict__ B, int ldb,
                                              int K, f32x4 (&acc)[4][NF], u16* smem) {
  constexpr int BN = 32 * NF;
  constexpr int NB = BN / 32;
  u16* sA = smem;
  u16* sB = smem + 2 * 128 * 64;
  int tz = 0;
  if (LEAN) asm volatile("" : "+v"(tz));
  const int tid = TIDX + tz, lane = tid & 63, wv = tid >> 6;
  const int wm = wv >> 1, wn = wv & 1;
  const int lrow = tid >> 3;
  const int lchs = (tid & 7) ^ ((lrow >> 1) & 7);
  const u16* Ap = A + (size_t)lrow * lda + lchs * 8;
  const u16* Bp = B + (size_t)lrow * ldb + lchs * 8;
  const int nk = K >> 6;
  auto stage = [&](int kt, int buf) {
    const int ko = kt << 6;
#pragma unroll
    for (int i = 0; i < 4; ++i)
      __builtin_amdgcn_global_load_lds((const unsigned*)(Ap + (size_t)(32 * i) * lda + ko),
                                       (__attribute__((address_space(3))) unsigned*)(sA + buf * (128 * 64) + (tid + 256 * i) * 8), 16, 0, 0);
#pragma unroll
    for (int i = 0; i < NB; ++i)
      __builtin_amdgcn_global_load_lds((const unsigned*)(Bp + (size_t)(32 * i) * ldb + ko),
                                       (__attribute__((address_space(3))) unsigned*)(sB + buf * (BN * 64) + (tid + 256 * i) * 8), 16, 0, 0);
  };
  __syncthreads();
  stage(0, 0);
  const int fr = lane & 15, fq = lane >> 4;
  const int sw = (fr >> 1) & 7;
  for (int kt = 0; kt < nk; ++kt) {
    const int cur = kt & 1;
    asm volatile("s_waitcnt vmcnt(0)" ::: "memory");
    __syncthreads();
    if (kt + 1 < nk) stage(kt + 1, cur ^ 1);
    const u16* cA = sA + cur * (128 * 64) + (wm * 64 + fr) * 64;
    const u16* cB = sB + cur * (BN * 64) + (wn * 16 * NF + fr) * 64;
#pragma unroll
    for (int ks = 0; ks < 2; ++ks) {
      if (LEAN) __builtin_amdgcn_sched_barrier(0);
      const int pc = ((fq + 4 * ks) ^ sw) << 3;
      bf16x8 fa[4], fb[NF];
#pragma unroll
      for (int i = 0; i < 4; ++i) fa[i] = *(const bf16x8*)(cA + i * 16 * 64 + pc);
#pragma unroll
      for (int j = 0; j < NF; ++j) fb[j] = *(const bf16x8*)(cB + j * 16 * 64 + pc);
#pragma unroll
      for (int i = 0; i < 4; ++i)
#pragma unroll
        for (int j = 0; j < NF; ++j)
          acc[i][j] = __builtin_amdgcn_mfma_f32_16x16x32_bf16(fb[j], fa[i], acc[i][j], 0, 0, 0);
    }
  }
}

template <int NF>
__device__ __forceinline__ void zero_acc(f32x4 (&acc)[4][NF]) {
#pragma unroll
  for (int i = 0; i < 4; ++i)
#pragma unroll
    for (int j = 0; j < NF; ++j) acc[i][j] = f32x4{0.f, 0.f, 0.f, 0.f};
}

template <bool PERM>
__device__ __forceinline__ void gemm_mainloop_8w(const u16* __restrict__ A, int lda, const u16* __restrict__ B, int ldb,
                                                 int K, f32x4 (&acc)[8][4], u16* smem) {
  constexpr int STG = 32768;
  const int tid = threadIdx.x, lane = tid & 63, wv = tid >> 6;
  const int wm = wv >> 2, wn = wv & 3;
  const int lrow = tid >> 3;
  const int lchs = (tid & 7) ^ ((lrow >> 1) & 7);
  const u16* Ap = A + (size_t)lrow * lda + lchs * 8;
  const int rho = lrow & 31, pi = rho & 15;
  const int brow = PERM ? ((lrow & ~31) + 8 * (pi >> 2) + 4 * (rho >> 4) + (pi & 3)) : lrow;
  const u16* Bp = B + (size_t)brow * ldb + lchs * 8;
  const int nk = K >> 6;
  auto stage = [&](int kt, int buf) {
    const int ko = kt << 6;
    u16* sa = smem + buf * STG;
#pragma unroll
    for (int i = 0; i < 4; ++i)
      __builtin_amdgcn_global_load_lds((const unsigned*)(Ap + (size_t)(64 * i) * lda + ko),
                                       (__attribute__((address_space(3))) unsigned*)(sa + (tid + 512 * i) * 8), 16, 0, 0);
#pragma unroll
    for (int i = 0; i < 4; ++i)
      __builtin_amdgcn_global_load_lds((const unsigned*)(Bp + (size_t)(64 * i) * ldb + ko),
                                       (__attribute__((address_space(3))) unsigned*)(sa + 16384 + (tid + 512 * i) * 8), 16, 0, 0);
  };
  __syncthreads();
  stage(0, 0);
  const int fr = lane & 15, fq = lane >> 4;
  const int sw = (fr >> 1) & 7;
  for (int kt = 0; kt < nk; ++kt) {
    const int cur = kt & 1;
    asm volatile("s_waitcnt vmcnt(0)" ::: "memory");
    __syncthreads();
    if (kt + 1 < nk) stage(kt + 1, cur ^ 1);
    const u16* cA = smem + cur * STG + (wm * 128 + fr) * 64;
    const u16* cB = smem + cur * STG + 16384 + (wn * 64 + fr) * 64;
#pragma unroll
    for (int ks = 0; ks < 2; ++ks) {
      const int pc = ((fq + 4 * ks) ^ sw) << 3;
      bf16x8 fa[8], fb[4];
#pragma unroll
      for (int i = 0; i < 8; ++i) fa[i] = *(const bf16x8*)(cA + i * 16 * 64 + pc);
#pragma unroll
      for (int j = 0; j < 4; ++j) fb[j] = *(const bf16x8*)(cB + j * 16 * 64 + pc);
#pragma unroll
      for (int i = 0; i < 8; ++i)
#pragma unroll
        for (int j = 0; j < 4; ++j)
          acc[i][j] = __builtin_amdgcn_mfma_f32_16x16x32_bf16(fb[j], fa[i], acc[i][j], 0, 0, 0);
    }
  }
}

template <int EPI>
__device__ __forceinline__ void phase_gemm_8w(const Params& p, int l, int vb, unsigned char* smem_raw) {
  u16* smem = (u16*)smem_raw;
  const int lane = threadIdx.x & 63, wv = threadIdx.x >> 6;
  const int wm = wv >> 2, wn = wv & 3;
  const int fr = lane & 15, fq = lane >> 4;
  const u16* A; const u16* B; int lda, ldb, K, ntiles_n;
  if (EPI == 0) { A = (const u16*)(p.ws + OFF_H); lda = 1024; B = (const u16*)(p.ws + OFF_WIN); ldb = 1024; K = 1024; ntiles_n = 8; }
  if (EPI == 1) { A = (const u16*)(p.ws + OFF_MRG); lda = 1024; B = (const u16*)(p.ws + OFF_WO); ldb = 1024; K = 1024; ntiles_n = 4; }
  if (EPI == 2) { A = (const u16*)(p.ws + OFF_H); lda = 1024; B = (const u16*)(p.ws + OFF_W1); ldb = 1024; K = 1024; ntiles_n = 16; }
  if (EPI == 3) { A = (const u16*)(p.ws + OFF_F); lda = 4096; B = (const u16*)(p.ws + OFF_W2); ldb = 4096; K = 4096; ntiles_n = 4; }
  const float* modl = (const float*)(p.ws + OFF_MOD) + (size_t)l * 4 * 6144;
  const int total = 64 * ntiles_n;
  const int G = gridDim.x;
  const bool swz = (G == 256);
  for (int item = vb; item < total; item += G) {
    int mt = item & 63, nt = item >> 6;
    if (swz) { const int r = item >> 8, w = vb & 31; mt = (vb >> 5) * 8 + (w & 7); nt = r * 4 + (w >> 3); }
    const int m0 = mt * 256, n0 = nt * 256;
    f32x4 acc[8][4];
#pragma unroll
    for (int i = 0; i < 8; ++i)
#pragma unroll
      for (int j = 0; j < 4; ++j) acc[i][j] = f32x4{0.f, 0.f, 0.f, 0.f};
    gemm_mainloop_8w<(EPI == 0 || EPI == 2)>(A + (size_t)m0 * lda, lda, B + (size_t)n0 * ldb, ldb, K, acc, smem);
    if (EPI == 0 || EPI == 2) {
      constexpr int LDO = (EPI == 0) ? 2176 : 4096;
      u16* obase = (u16*)(p.ws + (EPI == 0 ? OFF_PABC : OFF_F)) + (size_t)(m0 + wm * 128 + fr) * LDO + n0 + wn * 64 + 8 * fq;
#pragma unroll
      for (int i = 0; i < 8; ++i) {
#pragma unroll
        for (int g2 = 0; g2 < 2; ++g2) {
          f32x4 a = acc[i][2 * g2], b = acc[i][2 * g2 + 1];
          if (EPI == 2) {
            a = __builtin_elementwise_max(a, f32x4{0.f, 0.f, 0.f, 0.f}); b = __builtin_elementwise_max(b, f32x4{0.f, 0.f, 0.f, 0.f});
            a = a * a; b = b * b;
          }
          const u32x4 o = u32x4{pack2(a[0], a[1]), pack2(a[2], a[3]), pack2(b[0], b[1]), pack2(b[2], b[3])};
          *(u32x4*)(obase + (size_t)(i * 16) * LDO + 32 * g2) = o;
        }
      }
    } else {
#pragma unroll
    for (int i = 0; i < 8; ++i) {
      const int m = m0 + wm * 128 + i * 16 + fr;
#pragma unroll
      for (int j = 0; j < 4; ++j) {
        const int n = n0 + wn * 64 + j * 16 + fq * 4;
        f32x4 v = acc[i][j];
        if (EPI == 0) {
          *(u32x2*)((u16*)(p.ws + OFF_PABC) + (size_t)m * 2176 + n) = u32x2{pack2(v[0], v[1]), pack2(v[2], v[3])};
        } else if (EPI == 1 || EPI == 3) {
          const int b = m >> 12;
          const float* gt = modl + (size_t)b * 6144 + (EPI == 1 ? 2048 : 5120) + n;
          const float* xin = ((EPI == 1 && l == 0) ? p.in[0] : p.out) + (size_t)m * 1024 + n;
          f32x4 x = *(const f32x4*)xin;
          f32x4 gg = *(const f32x4*)gt;
          *(f32x4*)(p.out + (size_t)m * 1024 + n) = x + gg * v;
        } else {
          float r0 = fmaxf(v[0], 0.f), r1 = fmaxf(v[1], 0.f), r2 = fmaxf(v[2], 0.f), r3 = fmaxf(v[3], 0.f);
          *(u32x2*)((u16*)(p.ws + OFF_F) + (size_t)m * 4096 + n) = u32x2{pack2(r0 * r0, r1 * r1), pack2(r2 * r2, r3 * r3)};
        }
      }
    }
    }
  }
}

template <int EPI>
__device__ __forceinline__ void phase_gemm(const Params& p, int l, int vb, unsigned char* smem_raw) {
  u16* smem = (u16*)smem_raw;
  const int lane = TIDX & 63, wv = TIDX >> 6;
  const int wm = wv >> 1, wn = wv & 1;
  const int fr = lane & 15, fq = lane >> 4;
  const u16* A; const u16* B; int lda, ldb, K, ntiles_n;
  if (EPI == 0) { A = (const u16*)(p.ws + OFF_H); lda = 1024; B = (const u16*)(p.ws + OFF_WIN); ldb = 1024; K = 1024; ntiles_n = 19; }
  if (EPI == 1) { A = (const u16*)(p.ws + OFF_MRG); lda = 1024; B = (const u16*)(p.ws + OFF_WO); ldb = 1024; K = 1024; ntiles_n = 8; }
  if (EPI == 2) { A = (const u16*)(p.ws + OFF_H); lda = 1024; B = (const u16*)(p.ws + OFF_W1); ldb = 1024; K = 1024; ntiles_n = 32; }
  if (EPI == 3) { A = (const u16*)(p.ws + OFF_F); lda = 4096; B = (const u16*)(p.ws + OFF_W2); ldb = 4096; K = 4096; ntiles_n = 8; }
  const float* modl = (const float*)(p.ws + OFF_MOD) + (size_t)l * 4 * 6144;
  const int G = VGRID;
  const bool swz = (G == 512);
  const int total = swz ? 128 * ((ntiles_n + 3) & ~3) : 128 * ntiles_n;
  for (int item = vb; item < total; item += G) {
    int mt = item & 127, nt = item >> 7;
    if (swz) { const int r = item >> 9, w = vb & 63; mt = (vb >> 6) * 16 + (w & 15); nt = r * 4 + (w >> 4); if (nt >= ntiles_n) continue; }
    const int m0 = mt * 128, n0 = nt * 128;
    f32x4 acc[4][4];
    zero_acc<4>(acc);
    gemm_mainloop<4>(A + (size_t)m0 * lda, lda, B + (size_t)n0 * ldb, ldb, K, acc, smem);
#pragma unroll
    for (int i = 0; i < 4; ++i) {
      const int m = m0 + wm * 64 + i * 16 + fr;
#pragma unroll
      for (int j = 0; j < 4; ++j) {
        const int n = n0 + wn * 64 + j * 16 + fq * 4;
        f32x4 v = acc[i][j];
        if (EPI == 0) {
          u32x2 o; o.x = pack2(v[0], v[1]); o.y = pack2(v[2], v[3]);
          if (n < 2176) *(u32x2*)((u16*)(p.ws + OFF_PABC) + (size_t)m * 2176 + n) = o;
          else *(u32x2*)((u16*)(p.ws + OFF_PD) + (size_t)m * 256 + (n - 2176)) = o;
        } else if (EPI == 1 || EPI == 3) {
          const int b = m >> 12;
          const float* gt = modl + (size_t)b * 6144 + (EPI == 1 ? 2048 : 5120) + n;
          const float* xin = ((EPI == 1 && l == 0) ? p.in[0] : p.out) + (size_t)m * 1024 + n;
          float4 x = *(const float4*)xin;
          float4 gg = *(const float4*)gt;
          float4 o;
          o.x = x.x + gg.x * v[0]; o.y = x.y + gg.y * v[1]; o.z = x.z + gg.z * v[2]; o.w = x.w + gg.w * v[3];
          *(float4*)(p.out + (size_t)m * 1024 + n) = o;
        } else {
          float r0 = fmaxf(v[0], 0.f), r1 = fmaxf(v[1], 0.f), r2 = fmaxf(v[2], 0.f), r3 = fmaxf(v[3], 0.f);
          u32x2 o; o.x = pack2(r0 * r0, r1 * r1); o.y = pack2(r2 * r2, r3 * r3);
          *(u32x2*)((u16*)(p.ws + OFF_F) + (size_t)m * 4096 + n) = o;
        }
      }
    }
  }
}

template <int MODE>
__device__ __forceinline__ void merge_tile(const Params& p, int item, unsigned char* smem_raw) {
  u16* smem = (u16*)smem_raw;
  const int lane = TIDX & 63, wv = TIDX >> 6;
  const int wm = wv >> 1, wn = wv & 1;
  const int fr = lane & 15, fq = lane >> 4;
  const u16* H = (const u16*)(p.ws + OFF_H);
  const u16* WIN = (const u16*)(p.ws + OFF_WIN);
  const int mt = item & 127, nt = item >> 7;
  const int m0 = mt * 128, n0 = nt * 128;
  f32x4 bacc[4][4];
  u32x2 gpk[4][4];
  u16* MRG = (u16*)(p.ws + OFF_MRG);
#pragma unroll 1
  for (int br = (MODE == 0 ? 1 : 0); br < (MODE == 0 ? 4 : 1); ++br) {
    zero_acc<4>(bacc);
    gemm_mainloop<4, true>(H + (size_t)m0 * 1024, 1024, WIN + (size_t)(2432 + br * 1024 + n0) * 1024, 1024, 1024, bacc, smem);
#pragma unroll
    for (int i = 0; i < 4; ++i)
#pragma unroll
      for (int j = 0; j < 4; ++j)
        gpk[i][j] = u32x2{pack2(sigmoidf_(bacc[i][j][0]), sigmoidf_(bacc[i][j][1])), pack2(sigmoidf_(bacc[i][j][2]), sigmoidf_(bacc[i][j][3]))};
    const u16* Ab; const u16* Wb;
    if (br == 0) { Ab = (const u16*)(p.ws + OFF_OG); Wb = (const u16*)(p.ws + OFF_RO); }
    else if (br == 1) { Ab = (const u16*)(p.ws + OFF_UB); Wb = (const u16*)(p.ws + OFF_SO); }
    else if (br == 2) { Ab = (const u16*)(p.ws + OFF_CB); Wb = (const u16*)(p.ws + OFF_CO); }
    else { Ab = (const u16*)(p.ws + OFF_YD); Wb = (const u16*)(p.ws + OFF_GLU); }
    if (MODE == 0 && br == 3) {
      zero_acc<4>(bacc);
      gemm_mainloop<4, true>(Ab + (size_t)m0 * 256, 256, Wb + (size_t)(1024 + n0) * 256, 256, 256, bacc, smem);
#pragma unroll
      for (int i = 0; i < 4; ++i)
#pragma unroll
        for (int j = 0; j < 4; ++j) {
          const float g0 = bflo(gpk[i][j].x) * sigmoidf_(bacc[i][j][0]), g1 = bfhi(gpk[i][j].x) * sigmoidf_(bacc[i][j][1]);
          const float g2 = bflo(gpk[i][j].y) * sigmoidf_(bacc[i][j][2]), g3 = bfhi(gpk[i][j].y) * sigmoidf_(bacc[i][j][3]);
          gpk[i][j] = u32x2{pack2(g0, g1), pack2(g2, g3)};
        }
    }
    zero_acc<4>(bacc);
    gemm_mainloop<4, true>(Ab + (size_t)m0 * 256, 256, Wb + (size_t)n0 * 256, 256, 256, bacc, smem);
#pragma unroll
    for (int i = 0; i < 4; ++i)
#pragma unroll
      for (int j = 0; j < 4; ++j) {
        u32x2* mp = (u32x2*)(MRG + (size_t)(m0 + wm * 64 + i * 16 + fr) * 1024 + n0 + wn * 64 + j * 16 + fq * 4);
        u32x2 cm = u32x2{0u, 0u};
        if (MODE == 1 || br > 1) cm = *mp;
        const float v0 = bflo(cm.x) + bflo(gpk[i][j].x) * bacc[i][j][0];
        const float v1 = bfhi(cm.x) + bfhi(gpk[i][j].x) * bacc[i][j][1];
        const float v2 = bflo(cm.y) + bflo(gpk[i][j].y) * bacc[i][j][2];
        const float v3 = bfhi(cm.y) + bfhi(gpk[i][j].y) * bacc[i][j][3];
        *mp = u32x2{pack2(v0, v1), pack2(v2, v3)};
      }
  }
}

__device__ __forceinline__ void gemm_mainloop_8n(const u16* __restrict__ A, int lda, const u16* __restrict__ B, int ldb,
                                                 int K, f32x4 (&acc)[4][4], u16* smem) {
  constexpr int STG = 24576;
  int tz = 0;
  asm volatile("" : "+v"(tz));
  const int tid = threadIdx.x + tz, lane = tid & 63, wv = tid >> 6;
  const int wm = wv >> 1, wn = wv & 1;
  const int lrow = tid >> 3;
  const int lchs = (tid & 7) ^ ((lrow >> 1) & 7);
  const u16* Ap = A + (size_t)lrow * lda + lchs * 8;
  const int rho = lrow & 31, pi = rho & 15;
  const u16* Bp = B + (size_t)((lrow & ~31) + 8 * (pi >> 2) + 4 * (rho >> 4) + (pi & 3)) * ldb + lchs * 8;
  const int nk = K >> 6;
  auto stage = [&](int kt, int buf) {
    const int ko = kt << 6;
    u16* sa = smem + buf * STG;
#pragma unroll
    for (int i = 0; i < 4; ++i)
      __builtin_amdgcn_global_load_lds((const unsigned*)(Ap + (size_t)(64 * i) * lda + ko),
                                       (__attribute__((address_space(3))) unsigned*)(sa + (tid + 512 * i) * 8), 16, 0, 0);
#pragma unroll
    for (int i = 0; i < 2; ++i)
      __builtin_amdgcn_global_load_lds((const unsigned*)(Bp + (size_t)(64 * i) * ldb + ko),
                                       (__attribute__((address_space(3))) unsigned*)(sa + 16384 + (tid + 512 * i) * 8), 16, 0, 0);
  };
  __syncthreads();
  stage(0, 0);
  stage(nk > 1 ? 1 : 0, 1);
  const int fr = lane & 15, fq = lane >> 4;
  const int sw = (fr >> 1) & 7;
  int cur = 0;
  for (int kt = 0; kt < nk; ++kt) {
    asm volatile("s_waitcnt vmcnt(6)" ::: "memory");
    __builtin_amdgcn_s_barrier();
    asm volatile("" ::: "memory");
    {
      int nx = cur + 2; if (nx >= 3) nx -= 3;
      int ktn = kt + 2; if (ktn >= nk) ktn = nk - 1;
      stage(ktn, nx);
    }
    const u16* cA = smem + cur * STG + (wm * 64 + fr) * 64;
    const u16* cB = smem + cur * STG + 16384 + (wn * 64 + fr) * 64;
#pragma unroll
    for (int ks = 0; ks < 2; ++ks) {
      const int pc = ((fq + 4 * ks) ^ sw) << 3;
      bf16x8 fa[4], fb[4];
#pragma unroll
      for (int i = 0; i < 4; ++i) fa[i] = *(const bf16x8*)(cA + i * 16 * 64 + pc);
#pragma unroll
      for (int j = 0; j < 4; ++j) fb[j] = *(const bf16x8*)(cB + j * 16 * 64 + pc);
#pragma unroll
      for (int i = 0; i < 4; ++i)
#pragma unroll
        for (int j = 0; j < 4; ++j)
          acc[i][j] = __builtin_amdgcn_mfma_f32_16x16x32_bf16(fb[j], fa[i], acc[i][j], 0, 0, 0);
    }
    cur = cur + 1; if (cur >= 3) cur = 0;
  }
  asm volatile("s_waitcnt vmcnt(0)" ::: "memory");
}

template <int MODE>
__device__ __forceinline__ void merge_tile8(const Params& p, int item, unsigned char* smem_raw) {
  u16* smem = (u16*)smem_raw;
  const int lane = threadIdx.x & 63, wv = threadIdx.x >> 6;
  const int wm = wv >> 1, wn = wv & 1;
  const int fr = lane & 15, fq = lane >> 4;
  const u16* H = (const u16*)(p.ws + OFF_H);
  const u16* WIN = (const u16*)(p.ws + OFF_WIN);
  const int mt = item & 63, nt = item >> 6;
  const int m0 = mt * 256, n0 = nt * 128;
  f32x4 bacc[4][4];
  u32x2 gpk[4][4];
  u16* MRG = (u16*)(p.ws + OFF_MRG);
#pragma unroll 1
  for (int br = (MODE == 0 ? 1 : 0); br < (MODE == 0 ? 4 : 1); ++br) {
    zero_acc<4>(bacc);
    gemm_mainloop_8n(H + (size_t)m0 * 1024, 1024, WIN + (size_t)(2432 + br * 1024 + n0) * 1024, 1024, 1024, bacc, smem);
#pragma unroll
    for (int i = 0; i < 4; ++i)
#pragma unroll
      for (int j = 0; j < 4; ++j)
        gpk[i][j] = u32x2{pack2(sigmoidf_(bacc[i][j][0]), sigmoidf_(bacc[i][j][1])), pack2(sigmoidf_(bacc[i][j][2]), sigmoidf_(bacc[i][j][3]))};
    const u16* Ab; const u16* Wb;
    if (br == 0) { Ab = (const u16*)(p.ws + OFF_OG); Wb = (const u16*)(p.ws + OFF_RO); }
    else if (br == 1) { Ab = (const u16*)(p.ws + OFF_UB); Wb = (const u16*)(p.ws + OFF_SO); }
    else if (br == 2) { Ab = (const u16*)(p.ws + OFF_CB); Wb = (const u16*)(p.ws + OFF_CO); }
    else { Ab = (const u16*)(p.ws + OFF_YD); Wb = (const u16*)(p.ws + OFF_GLU); }
    if (MODE == 0 && br == 3) {
      zero_acc<4>(bacc);
      gemm_mainloop_8n(Ab + (size_t)m0 * 256, 256, Wb + (size_t)(1024 + n0) * 256, 256, 256, bacc, smem);
#pragma unroll
      for (int i = 0; i < 4; ++i)
#pragma unroll
        for (int j = 0; j < 4; ++j) {
          const float g0 = bflo(gpk[i][j].x) * sigmoidf_(bacc[i][j][0]), g1 = bfhi(gpk[i][j].x) * sigmoidf_(bacc[i][j][1]);
          const float g2 = bflo(gpk[i][j].y) * sigmoidf_(bacc[i][j][2]), g3 = bfhi(gpk[i][j].y) * sigmoidf_(bacc[i][j][3]);
          gpk[i][j] = u32x2{pack2(g0, g1), pack2(g2, g3)};
        }
    }
    zero_acc<4>(bacc);
    gemm_mainloop_8n(Ab + (size_t)m0 * 256, 256, Wb + (size_t)n0 * 256, 256, 256, bacc, smem);
#pragma unroll
    for (int i = 0; i < 4; ++i)
#pragma unroll
      for (int g2 = 0; g2 < 2; ++g2) {
        u32x4* mp = (u32x4*)(MRG + (size_t)(m0 + wm * 64 + i * 16 + fr) * 1024 + n0 + wn * 64 + 32 * g2 + 8 * fq);
        u32x4 cm = u32x4{0u, 0u, 0u, 0u};
        if (MODE == 1 || br > 1) cm = *mp;
        const int ja = 2 * g2, jb = 2 * g2 + 1;
        const float v0 = bflo(cm.x) + bflo(gpk[i][ja].x) * bacc[i][ja][0];
        const float v1 = bfhi(cm.x) + bfhi(gpk[i][ja].x) * bacc[i][ja][1];
        const float v2 = bflo(cm.y) + bflo(gpk[i][ja].y) * bacc[i][ja][2];
        const float v3 = bfhi(cm.y) + bfhi(gpk[i][ja].y) * bacc[i][ja][3];
        const float v4 = bflo(cm.z) + bflo(gpk[i][jb].x) * bacc[i][jb][0];
        const float v5 = bfhi(cm.z) + bfhi(gpk[i][jb].x) * bacc[i][jb][1];
        const float v6 = bflo(cm.w) + bflo(gpk[i][jb].y) * bacc[i][jb][2];
        const float v7 = bfhi(cm.w) + bfhi(gpk[i][jb].y) * bacc[i][jb][3];
        *mp = u32x4{pack2(v0, v1), pack2(v2, v3), pack2(v4, v5), pack2(v6, v7)};
      }
  }
}

__device__ __forceinline__ void phase_pproj_tail(const Params& p, int vb, unsigned char* smem_raw) {
  u16* smem = (u16*)smem_raw;
  const int lane = threadIdx.x & 63, wv = threadIdx.x >> 6;
  const int wm = wv >> 1, wn = wv & 1;
  const int fr = lane & 15, fq = lane >> 4;
  const u16* A = (const u16*)(p.ws + OFF_H);
  const u16* B = (const u16*)(p.ws + OFF_WIN);
  const int G = gridDim.x;
  const int total = (G == 256) ? 256 : 192;
  for (int item = vb; item < total; item += G) {
    int mt = item & 63, nt = item >> 6;
    if (G == 256) { const int w = vb & 31; mt = (vb >> 5) * 8 + (w & 7); nt = w >> 3; if (nt >= 3) continue; }
    const int m0 = mt * 256, n0 = 2048 + nt * 128;
    f32x4 acc[4][4];
    zero_acc<4>(acc);
    gemm_mainloop_8n(A + (size_t)m0 * 1024, 1024, B + (size_t)n0 * 1024, 1024, 1024, acc, smem);
#pragma unroll
    for (int i = 0; i < 4; ++i) {
      const int m = m0 + wm * 64 + i * 16 + fr;
#pragma unroll
      for (int g2 = 0; g2 < 2; ++g2) {
        const int n = n0 + wn * 64 + 32 * g2 + 8 * fq;
        const f32x4 va = acc[i][2 * g2], vb2 = acc[i][2 * g2 + 1];
        const u32x4 o = u32x4{pack2(va[0], va[1]), pack2(va[2], va[3]), pack2(vb2[0], vb2[1]), pack2(vb2[2], vb2[3])};
        if (n < 2176) *(u32x4*)((u16*)(p.ws + OFF_PABC) + (size_t)m * 2176 + n) = o;
        else *(u32x4*)((u16*)(p.ws + OFF_PD) + (size_t)m * 256 + (n - 2176)) = o;
      }
    }
  }
}

__device__ __forceinline__ float shifted(const u16* __restrict__ P, int tok, int col, float mu) {
  float pv = bf2f(P[(size_t)tok * 2176 + col]);
  float pr = (tok & (SEQ - 1)) ? bf2f(P[(size_t)(tok - 1) * 2176 + col]) : 0.f;
  return pv + (pr - pv) * mu;
}

__device__ __forceinline__ void rwkv_prep_item(const Params& p, int l, int item, unsigned char* smem) {
  const int tid = TIDX, lane = tid & 63, wv = tid >> 6;
  const int fr = lane & 15, fq = lane >> 4;
  u16* sl = (u16*)smem;
  u16* sv = sl + 32 * 168;
  constexpr int SLS = 168, SVS = 264;
  const u16* P = (const u16*)(p.ws + OFF_PABC);
  const float* mu = p.in[6] + l * 896;
  const int tok0 = item * 32;
  {
    const int t = tid >> 3, c0 = (tid & 7) * 32;
    const u16* src = P + (size_t)(tok0 + t) * 2176 + 896 + 256 + c0;
    float sm = 0.f, ss = 0.f;
#pragma unroll
    for (int q = 0; q < 4; ++q) {
      const u32x4 raw = *(const u32x4*)(src + q * 8);
      float z;
      z = geluf_(bflo(raw.x)); sm += z; ss += z * z;  z = geluf_(bfhi(raw.x)); sm += z; ss += z * z;
      z = geluf_(bflo(raw.y)); sm += z; ss += z * z;  z = geluf_(bfhi(raw.y)); sm += z; ss += z * z;
      z = geluf_(bflo(raw.z)); sm += z; ss += z * z;  z = geluf_(bfhi(raw.z)); sm += z; ss += z * z;
      z = geluf_(bflo(raw.w)); sm += z; ss += z * z;  z = geluf_(bfhi(raw.w)); sm += z; ss += z * z;
    }
    sm += __shfl_xor(sm, 1, 64); ss += __shfl_xor(ss, 1, 64);
    sm += __shfl_xor(sm, 2, 64); ss += __shfl_xor(ss, 2, 64);
    sm += __shfl_xor(sm, 4, 64); ss += __shfl_xor(ss, 4, 64);
    const float mean = sm * (1.f / 256.f);
    const float var = fmaxf(ss * (1.f / 256.f) - mean * mean, 0.f);
    if ((tid & 7) == 0) *(f32x2*)((float*)(p.ws + OFF_SGST) + (size_t)(tok0 + t) * 2) = f32x2{mean, rsqrtf(var + 1e-5f)};
  }
  for (int idx = tid; idx < 32 * 128; idx += NTHR) {
    const int t = idx >> 7, ci = idx & 127;
    float v = shifted(P, tok0 + t, 768 + ci, mu[768 + ci]);
    if (ci < 32) v = tanhf_(v);
    else if (ci >= 64) v = sigmoidf_(v);
    sl[t * SLS + ci] = f2bf(v);
  }
  if (l > 0) {
    const int t = tid >> 3, c0 = (tid & 7) * 32;
    const int tok = tok0 + t;
    const bool hasp = (tok & (SEQ - 1)) != 0;
#pragma unroll
    for (int q = 0; q < 4; ++q) {
      const int c = c0 + q * 8;
      const u32x4 cur = *(const u32x4*)(P + (size_t)tok * 2176 + 512 + c);
      u32x4 prv = u32x4{0u, 0u, 0u, 0u};
      if (hasp) prv = *(const u32x4*)(P + (size_t)(tok - 1) * 2176 + 512 + c);
      const f32x4 m0 = *(const f32x4*)(mu + 512 + c), m1 = *(const f32x4*)(mu + 512 + c + 4);
      float o[8];
      o[0] = bflo(cur.x) + (bflo(prv.x) - bflo(cur.x)) * m0.x; o[1] = bfhi(cur.x) + (bfhi(prv.x) - bfhi(cur.x)) * m0.y;
      o[2] = bflo(cur.y) + (bflo(prv.y) - bflo(cur.y)) * m0.z; o[3] = bfhi(cur.y) + (bfhi(prv.y) - bfhi(cur.y)) * m0.w;
      o[4] = bflo(cur.z) + (bflo(prv.z) - bflo(cur.z)) * m1.x; o[5] = bfhi(cur.z) + (bfhi(prv.z) - bfhi(cur.z)) * m1.y;
      o[6] = bflo(cur.w) + (bflo(prv.w) - bflo(cur.w)) * m1.z; o[7] = bfhi(cur.w) + (bfhi(prv.w) - bfhi(cur.w)) * m1.w;
      *(u32x4*)(sv + t * SVS + c) = u32x4{pack2(o[0], o[1]), pack2(o[2], o[3]), pack2(o[4], o[5]), pack2(o[6], o[7])};
    }
  }
  __syncthreads();
  if (l > 0) {
    const int mf = wv >> 1, nf = wv & 1;
    const u16* v1t = (const u16*)(p.ws + OFF_LV1);
    f32x4 acc = f32x4{0.f, 0.f, 0.f, 0.f};
#pragma unroll
    for (int ks = 0; ks < 8; ++ks) {
      const bf16x8 fa = *(const bf16x8*)(sv + (mf * 16 + fr) * SVS + ks * 32 + fq * 8);
      const bf16x8 fb = *(const bf16x8*)(v1t + (size_t)(nf * 16 + fr) * 256 + ks * 32 + fq * 8);
      acc = __builtin_amdgcn_mfma_f32_16x16x32_bf16(fb, fa, acc, 0, 0, 0);
    }
    *(u32x2*)(sl + (mf * 16 + fr) * SLS + 128 + nf * 16 + fq * 4) = u32x2{pack2(acc[0], acc[1]), pack2(acc[2], acc[3])};
    __syncthreads();
  }
  const u16* w2t = (const u16*)(p.ws + OFF_LW2); const u16* a2t = (const u16*)(p.ws + OFF_LA2);
  const u16* g2t = (const u16*)(p.ws + OFF_LG2); const u16* v2t = (const u16*)(p.ws + OFF_LV2);
  u16* SR = (u16*)(p.ws + OFF_SR); u16* SK = (u16*)(p.ws + OFF_SK); u16* SV = (u16*)(p.ws + OFF_SV);
  u16* SKK = (u16*)(p.ws + OFF_SKK); u16* SA = (u16*)(p.ws + OFF_SA); float* SW = (float*)(p.ws + OFF_SW);
  u16* G = (u16*)(p.ws + OFF_G); u16* VF = (u16*)(p.ws + OFF_VF);
#pragma unroll 1
  for (int mf = 0; mf < 2; ++mf) {
    const u16* arow = sl + (mf * 16 + fr) * SLS + fq * 8;
    const bf16x8 aw = *(const bf16x8*)(arow), aa = *(const bf16x8*)(arow + 32);
    const bf16x8 ag0 = *(const bf16x8*)(arow + 64), ag1 = *(const bf16x8*)(arow + 96), av = *(const bf16x8*)(arow + 128);
    f32x4 cw[4], ca[4], cg[4], cv[4];
#pragma unroll
    for (int nf = 0; nf < 4; ++nf) {
      const int n = wv * 64 + nf * 16 + fr;
      const f32x4 z = f32x4{0.f, 0.f, 0.f, 0.f};
      cw[nf] = __builtin_amdgcn_mfma_f32_16x16x32_bf16(*(const bf16x8*)(w2t + n * 32 + fq * 8), aw, z, 0, 0, 0);
      ca[nf] = __builtin_amdgcn_mfma_f32_16x16x32_bf16(*(const bf16x8*)(a2t + n * 32 + fq * 8), aa, z, 0, 0, 0);
      cg[nf] = __builtin_amdgcn_mfma_f32_16x16x32_bf16(*(const bf16x8*)(g2t + n * 64 + fq * 8), ag0, z, 0, 0, 0);
      cg[nf] = __builtin_amdgcn_mfma_f32_16x16x32_bf16(*(const bf16x8*)(g2t + n * 64 + 32 + fq * 8), ag1, cg[nf], 0, 0, 0);
      cv[nf] = z;
      if (l > 0) cv[nf] = __builtin_amdgcn_mfma_f32_16x16x32_bf16(*(const bf16x8*)(v2t + n * 32 + fq * 8), av, z, 0, 0, 0);
    }
    const int tok = tok0 + mf * 16 + fr;
    const bool hasp = (tok & (SEQ - 1)) != 0;
    float kkv[4][4], kmv[4][4], av4[4][4];
    float ss = 0.f;
#pragma unroll
    for (int nf = 0; nf < 4; ++nf) {
      const int c = wv * 64 + nf * 16 + fq * 4;
      const size_t o = (size_t)tok * 256 + c;
      const u16* pc = P + (size_t)tok * 2176 + c;
      const u32x2 r_c = *(const u32x2*)(pc), k_c = *(const u32x2*)(pc + 256), v_c = *(const u32x2*)(pc + 512);
      u32x2 r_p = u32x2{0u, 0u}, k_p = u32x2{0u, 0u}, v_p = u32x2{0u, 0u};
      if (hasp) { r_p = *(const u32x2*)(pc - 2176); k_p = *(const u32x2*)(pc - 2176 + 256); v_p = *(const u32x2*)(pc - 2176 + 512); }
      const f32x4 mur = *(const f32x4*)(mu + c), muk = *(const f32x4*)(mu + 256 + c), muv = *(const f32x4*)(mu + 512 + c);
      const f32x4 w0 = *(const f32x4*)(p.in[7] + l * 256 + c), a0 = *(const f32x4*)(p.in[9] + l * 256 + c);
      const f32x4 kkc = *(const f32x4*)(p.in[15] + l * 256 + c), kac = *(const f32x4*)(p.in[16] + l * 256 + c);
      f32x4 v0 = f32x4{0.f, 0.f, 0.f, 0.f};
      if (l > 0) v0 = *(const f32x4*)(p.in[12] + c);
      u32x2 vfraw = u32x2{0u, 0u};
      if (l > 0) vfraw = *(const u32x2*)(VF + o);
      float rr[4], kk_[4], vv[4], dec[4], gg[4];
#pragma unroll
      for (int e = 0; e < 4; ++e) {
        const unsigned rc = e < 2 ? r_c.x : r_c.y, rp = e < 2 ? r_p.x : r_p.y;
        const unsigned kc = e < 2 ? k_c.x : k_c.y, kp = e < 2 ? k_p.x : k_p.y;
        const unsigned vc = e < 2 ? v_c.x : v_c.y, vp = e < 2 ? v_p.x : v_p.y;
        const unsigned vfr = e < 2 ? vfraw.x : vfraw.y;
        const float rcf = (e & 1) ? bfhi(rc) : bflo(rc), rpf = (e & 1) ? bfhi(rp) : bflo(rp);
        const float kcf = (e & 1) ? bfhi(kc) : bflo(kc), kpf = (e & 1) ? bfhi(kp) : bflo(kp);
        const float vcf = (e & 1) ? bfhi(vc) : bflo(vc), vpf = (e & 1) ? bfhi(vp) : bflo(vp);
        const float r = rcf + (rpf - rcf) * mur[e];
        const float k = kcf + (kpf - kcf) * muk[e];
        float v = vcf + (vpf - vcf) * muv[e];
        const float wl = w0[e] + cw[nf][e];
        const float z = -wl;
        const float sp = (z > 15.f) ? z : __logf(1.f + __expf(z));
        dec[e] = __expf(-__expf(-sp - 0.5f));
        const float a = sigmoidf_(a0[e] + ca[nf][e]);
        gg[e] = cg[nf][e];
        if (l > 0) { const float vf = (e & 1) ? bfhi(vfr) : bflo(vfr); v = v + (vf - v) * sigmoidf_(v0[e] + cv[nf][e]); }
        const float kk = k * kkc[e];
        ss += kk * kk;
        rr[e] = r; vv[e] = v; kk_[e] = kk; kkv[nf][e] = kk;
        kmv[nf][e] = k * (1.f + (a - 1.f) * kac[e]); av4[nf][e] = a;
      }
      *(u32x2*)(SR + o) = u32x2{pack2(rr[0], rr[1]), pack2(rr[2], rr[3])};
      *(u32x2*)(SV + o) = u32x2{pack2(vv[0], vv[1]), pack2(vv[2], vv[3])};
      if (l == 0) *(u32x2*)(VF + o) = u32x2{pack2(vv[0], vv[1]), pack2(vv[2], vv[3])};
      *(u32x2*)(G + o) = u32x2{pack2(gg[0], gg[1]), pack2(gg[2], gg[3])};
      *(f32x4*)(SW + o) = f32x4{dec[0], dec[1], dec[2], dec[3]};
    }
    ss += __shfl_xor(ss, 16, 64);
    ss += __shfl_xor(ss, 32, 64);
    const float inv = 1.f / fmaxf(sqrtf(ss), 1e-12f);
#pragma unroll
    for (int nf = 0; nf < 4; ++nf) {
      const size_t o = (size_t)tok * 256 + wv * 64 + nf * 16 + fq * 4;
      *(u32x2*)(SKK + o) = u32x2{pack2(kkv[nf][0] * inv, kkv[nf][1] * inv), pack2(kkv[nf][2] * inv, kkv[nf][3] * inv)};
      *(u32x2*)(SK + o) = u32x2{pack2(kmv[nf][0], kmv[nf][1]), pack2(kmv[nf][2], kmv[nf][3])};
      *(u32x2*)(SA + o) = u32x2{pack2(av4[nf][0], av4[nf][1]), pack2(av4[nf][2], av4[nf][3])};
    }
  }
  __syncthreads();
}

__device__ __forceinline__ void sg_item(const Params& p, int l, int item, unsigned char* smem) {
  const int tid = TIDX, lane = tid & 63, wv = tid >> 6;
  u16* vsT = (u16*)smem;
  float* smu = (float*)(smem + 16384);
  float* srs = smu + 128;
  const u16* P = (const u16*)(p.ws + OFF_PABC);
  const int g = item & 3, chn = item >> 2;
  const int tok0 = chn * 128;
  if (tid < 128) {
    const f32x2 ms = *(const f32x2*)((const float*)(p.ws + OFF_SGST) + (size_t)(tok0 + tid) * 2);
    smu[tid] = ms.x; srs[tid] = ms.y;
  }
  __syncthreads();
  {
    const int c = tid & 63, tb = tid >> 6;
    const float lw = p.in[21][l * 256 + g * 64 + c], lb = p.in[22][l * 256 + g * 64 + c];
#pragma unroll
    for (int j = 0; j < 4; ++j) {
      u16 raw[8];
#pragma unroll
      for (int e = 0; e < 8; ++e) raw[e] = P[(size_t)(tok0 + tb * 32 + j * 8 + e) * 2176 + 896 + 256 + g * 64 + c];
      float vv[8];
#pragma unroll
      for (int e = 0; e < 8; ++e) {
        const int t = tb * 32 + j * 8 + e;
        vv[e] = (geluf_(bf2f(raw[e])) - smu[t]) * srs[t] * lw + lb;
      }
      const int phys = (tb * 4 + j) ^ (c & 15);
      *(u32x4*)(vsT + c * 128 + phys * 8) = u32x4{pack2(vv[0], vv[1]), pack2(vv[2], vv[3]), pack2(vv[4], vv[5]), pack2(vv[6], vv[7])};
    }
  }
  __syncthreads();
  {
    const int fr = lane & 15, fq = lane >> 4;
    const u16* Wm = (const u16*)(p.ws + OFF_SGW) + (size_t)g * 128 * 128;
    f32x4 acc[2][4];
#pragma unroll
    for (int i = 0; i < 2; ++i)
#pragma unroll
      for (int j = 0; j < 4; ++j) acc[i][j] = f32x4{0.f, 0.f, 0.f, 0.f};
    for (int ks = 0; ks <= wv; ++ks) {
      bf16x8 fa[2], fb[4];
#pragma unroll
      for (int i = 0; i < 2; ++i) fa[i] = *(const bf16x8*)(Wm + (size_t)(32 * wv + 16 * i + fr) * 128 + ks * 32 + fq * 8);
#pragma unroll
      for (int j = 0; j < 4; ++j) fb[j] = *(const bf16x8*)(vsT + (j * 16 + fr) * 128 + (((ks * 4 + fq) ^ fr) << 3));
#pragma unroll
      for (int i = 0; i < 2; ++i)
#pragma unroll
        for (int j = 0; j < 4; ++j) acc[i][j] = __builtin_amdgcn_mfma_f32_16x16x32_bf16(fb[j], fa[i], acc[i][j], 0, 0, 0);
    }
    const float* bs = p.in[24] + ((size_t)l * 4 + g) * 128;
    u16* UB = (u16*)(p.ws + OFF_UB);
#pragma unroll
    for (int i = 0; i < 2; ++i) {
      const int t = 32 * wv + 16 * i + fr;
      const float bsv = bs[t];
#pragma unroll
      for (int j = 0; j < 4; ++j) {
        const int cc = j * 16 + fq * 4;
        u32x2 ur = *(const u32x2*)(P + (size_t)(tok0 + t) * 2176 + 896 + g * 64 + cc);
        float o0 = geluf_(bflo(ur.x)) * (acc[i][j][0] + bsv), o1 = geluf_(bfhi(ur.x)) * (acc[i][j][1] + bsv);
        float o2 = geluf_(bflo(ur.y)) * (acc[i][j][2] + bsv), o3 = geluf_(bfhi(ur.y)) * (acc[i][j][3] + bsv);
        *(u32x2*)(UB + (size_t)(tok0 + t) * 256 + g * 64 + cc) = u32x2{pack2(o0, o1), pack2(o2, o3)};
      }
    }
  }
  __syncthreads();
}

__device__ __forceinline__ void conv_item(const Params& p, int l, int item) {
  const int j = TIDX;
  const u16* P = (const u16*)(p.ws + OFF_PABC);
  u16* CB = (u16*)(p.ws + OFF_CB);
  const float c0 = p.in[26][(l * 3 + 0) * 256 + j], c1 = p.in[26][(l * 3 + 1) * 256 + j], c2 = p.in[26][(l * 3 + 2) * 256 + j];
  const int tok0 = item * 8;
  u16 rc[10], rx[10], rb[8];
  const bool first = (tok0 & (SEQ - 1)) == 0;
#pragma unroll
  for (int t = 0; t < 10; ++t) {
    const int tok = (first && t < 2) ? tok0 : tok0 + t - 2;
    const u16* q = P + (size_t)tok * 2176 + 1408;
    rc[t] = q[256 + j]; rx[t] = q[512 + j];
    if (t >= 2) rb[t - 2] = q[j];
  }
  float z[10];
#pragma unroll
  for (int t = 0; t < 10; ++t) z[t] = bf2f(rc[t]) * bf2f(rx[t]);
  if (first) { z[0] = 0.f; z[1] = 0.f; }
#pragma unroll
  for (int t = 0; t < 8; ++t) {
    float y = c0 * z[t] + c1 * z[t + 1] + c2 * z[t + 2];
    CB[(size_t)(tok0 + t) * 256 + j] = f2bf(bf2f(rb[t]) * y);
  }
}

__device__ __forceinline__ void s5_load_u(const u16* us, int t, int wv, float (&u)[16]) {
  const u32x4* q = (const u32x4*)(us + t * 64 + wv * 16);
  u32x4 a = q[0], b = q[1];
  u[0] = bflo(a.x); u[1] = bfhi(a.x); u[2] = bflo(a.y); u[3] = bfhi(a.y);
  u[4] = bflo(a.z); u[5] = bfhi(a.z); u[6] = bflo(a.w); u[7] = bfhi(a.w);
  u[8] = bflo(b.x); u[9] = bfhi(b.x); u[10] = bflo(b.y); u[11] = bfhi(b.y);
  u[12] = bflo(b.z); u[13] = bfhi(b.z); u[14] = bflo(b.w); u[15] = bfhi(b.w);
}
__device__ __forceinline__ void s5_stage_u(const u16* __restrict__ PD, int tok0, int gq, u16* us) {
#pragma unroll
  for (int i = 0; i < 2; ++i) {
    const int ch = TIDX + 256 * i;
    const int t = ch >> 3, part = ch & 7;
    *(u32x4*)(us + t * 64 + part * 8) = *(const u32x4*)(PD + (size_t)(tok0 + t) * 256 + gq * 64 + part * 8);
  }
}

__device__ __forceinline__ void s5a_item(const Params& p, int l, int item, unsigned char* smem) {
  const int lane = TIDX & 63, wv = TIDX >> 6;
  const int gq = item & 3, bc = item >> 2;
  const int g = gq * 4 + wv;
  const int tok0 = bc * 64;
  const u16* PD = (const u16*)(p.ws + OFF_PD);
  const float* ab = (const float*)(p.ws + OFF_S5AB) + ((size_t)(l * 16 + g) * 64 + lane) * 2;
  const float* bb = (const float*)(p.ws + OFF_S5BB) + ((size_t)(l * 16 + g) * 64 + lane) * 32;
  float bbr[16], bbi[16];
#pragma unroll
  for (int c = 0; c < 16; ++c) { bbr[c] = bb[c]; bbi[c] = bb[16 + c]; }
  const float abr = ab[0], abi = ab[1];
  float xr = 0.f, xi = 0.f;
  u16* us = (u16*)smem;
  s5_stage_u(PD, tok0, gq, us);
  __syncthreads();
#pragma unroll 4
  for (int t = 0; t < 64; ++t) {
    float u[16];
    s5_load_u(us, t, wv, u);
    float bur = 0.f, bui = 0.f;
#pragma unroll
    for (int c = 0; c < 16; ++c) { bur += bbr[c] * u[c]; bui += bbi[c] * u[c]; }
    float nr = abr * xr - abi * xi + bur;
    float ni = abr * xi + abi * xr + bui;
    xr = nr; xi = ni;
  }
  float2* E = (float2*)(p.ws + OFF_S5E);
  E[((size_t)bc * 16 + g) * 64 + lane] = make_float2(xr, xi);
  __syncthreads();
}

__device__ __forceinline__ void s5b_item(const Params& p, int l, int item, unsigned char* smem) {
  const int lane = TIDX & 63, wv = TIDX >> 6;
  const int gq = item & 3, bc = item >> 2;
  const int b = bc >> 6, ch = bc & 63;
  const int g = gq * 4 + wv;
  const int tok0 = bc * 64;
  u16* us = (u16*)(smem + 65536);
  s5_stage_u((const u16*)(p.ws + OFF_PD), tok0, gq, us);
  float* base = (float*)smem + wv * 4096;
  float* csr = base, *csi = base + 1024, *xsr = base + 2048, *xsi = base + 3072;
  const u16* PD = (const u16*)(p.ws + OFF_PD);
  const float* ab = (const float*)(p.ws + OFF_S5AB) + ((size_t)(l * 16 + g) * 64 + lane) * 2;
  const float* bb = (const float*)(p.ws + OFF_S5BB) + ((size_t)(l * 16 + g) * 64 + lane) * 32;
  const float* cre = p.in[32] + ((size_t)(l * 16 + g) * 16) * 64;
  const float* cim = p.in[33] + ((size_t)(l * 16 + g) * 16) * 64;
  for (int c = 0; c < 16; ++c) {
    csr[(lane >> 2) * 64 + c * 4 + (lane & 3)] = cre[c * 64 + lane];
    csi[(lane >> 2) * 64 + c * 4 + (lane & 3)] = cim[c * 64 + lane];
  }
  float bbr[16], bbi[16];
#pragma unroll
  for (int c = 0; c < 16; ++c) { bbr[c] = bb[c]; bbi[c] = bb[16 + c]; }
  const float abr = ab[0], abi = ab[1];
  float pr = abr, pi = abi;
#pragma unroll
  for (int s = 0; s < 6; ++s) { float nr = pr * pr - pi * pi, ni = 2.f * pr * pi; pr = nr; pi = ni; }
  float xr = 0.f, xi = 0.f;
  const float2* E = (const float2*)(p.ws + OFF_S5E);
  {
    const f32x2* Ev = (const f32x2*)E + ((size_t)(b * 64) * 16 + g) * 64 + lane;
    int c = 0;
    for (; c + 8 <= ch; c += 8) {
      f32x2 e[8];
#pragma unroll
      for (int k = 0; k < 8; ++k) e[k] = Ev[(size_t)(c + k) * 1024];
#pragma unroll
      for (int k = 0; k < 8; ++k) {
        const float nr = pr * xr - pi * xi + e[k].x;
        const float ni = pr * xi + pi * xr + e[k].y;
        xr = nr; xi = ni;
      }
    }
    for (; c < ch; ++c) {
      const f32x2 e = Ev[(size_t)c * 1024];
      const float nr = pr * xr - pi * xi + e.x;
      const float ni = pr * xi + pi * xr + e.y;
      xr = nr; xi = ni;
    }
  }
  const int tt = lane & 15, cq = lane >> 4;
  const float* dvec = p.in[34] + l * 256 + g * 16 + cq * 4;
  const float d0 = dvec[0], d1 = dvec[1], d2 = dvec[2], d3 = dvec[3];
  u16* YD = (u16*)(p.ws + OFF_YD);
  const int n4w = lane >> 2, e4 = lane & 3;
  __syncthreads();
#pragma unroll 1
  for (int sc = 0; sc < 4; ++sc) {
    for (int t = 0; t < 16; ++t) {
      float u[16];
      s5_load_u(us, sc * 16 + t, wv, u);
      float bur = 0.f, bui = 0.f;
#pragma unroll
      for (int c = 0; c < 16; ++c) { bur += bbr[c] * u[c]; bui += bbi[c] * u[c]; }
      float nr = abr * xr - abi * xi + bur;
      float ni = abr * xi + abi * xr + bui;
      xr = nr; xi = ni;
      int a = n4w * 64 + ((t ^ (n4w & 7)) << 2) + e4;
      xsr[a] = xr; xsi[a] = xi;
    }
    __syncthreads();
    float acc0 = 0.f, acc1 = 0.f, acc2 = 0.f, acc3 = 0.f;
#pragma unroll 2
    for (int n4 = 0; n4 < 16; ++n4) {
      int xa = n4 * 64 + ((tt ^ (n4 & 7)) << 2);
      float4 xr4 = *(const float4*)(xsr + xa);
      float4 xi4 = *(const float4*)(xsi + xa);
      const float* cr = csr + n4 * 64 + cq * 16;
      const float* ci = csi + n4 * 64 + cq * 16;
      float4 r0 = *(const float4*)(cr), r1 = *(const float4*)(cr + 4), r2 = *(const float4*)(cr + 8), r3 = *(const float4*)(cr + 12);
      float4 i0 = *(const float4*)(ci), i1 = *(const float4*)(ci + 4), i2 = *(const float4*)(ci + 8), i3 = *(const float4*)(ci + 12);
      acc0 += r0.x * xr4.x + r0.y * xr4.y + r0.z * xr4.z + r0.w * xr4.w - (i0.x * xi4.x + i0.y * xi4.y + i0.z * xi4.z + i0.w * xi4.w);
      acc1 += r1.x * xr4.x + r1.y * xr4.y + r1.z * xr4.z + r1.w * xr4.w - (i1.x * xi4.x + i1.y * xi4.y + i1.z * xi4.z + i1.w * xi4.w);
      acc2 += r2.x * xr4.x + r2.y * xr4.y + r2.z * xr4.z + r2.w * xr4.w - (i2.x * xi4.x + i2.y * xi4.y + i2.z * xi4.z + i2.w * xi4.w);
      acc3 += r3.x * xr4.x + r3.y * xr4.y + r3.z * xr4.z + r3.w * xr4.w - (i3.x * xi4.x + i3.y * xi4.y + i3.z * xi4.z + i3.w * xi4.w);
    }
    {
      const int tok = tok0 + sc * 16 + tt;
      u32x2 ur = *(const u32x2*)(us + (sc * 16 + tt) * 64 + wv * 16 + cq * 4);
      float y0 = acc0 + d0 * bflo(ur.x), y1 = acc1 + d1 * bfhi(ur.x), y2 = acc2 + d2 * bflo(ur.y), y3 = acc3 + d3 * bfhi(ur.y);
      u32x2 o; o.x = pack2(geluf_(y0), geluf_(y1)); o.y = pack2(geluf_(y2), geluf_(y3));
      *(u32x2*)(YD + (size_t)tok * 256 + g * 16 + cq * 4) = o;
    }
    __syncthreads();
  }
}

__device__ __forceinline__ void lds_barrier() {
  asm volatile("s_waitcnt lgkmcnt(0)" ::: "memory");
  __builtin_amdgcn_s_barrier();
  asm volatile("" ::: "memory");
}
__device__ __forceinline__ void scan_item(const Params& p, int item, unsigned char* smem) {
  const int tid = TIDX, lane = tid & 63, wv = tid >> 6;
  const int b = item >> 4, h = (item >> 2) & 3, q = item & 3;
  const int rl = lane >> 4, cl = lane & 15;
  const int rloc = wv * 4 + rl;
  const size_t tokb = (size_t)b * SEQ;
  const int chan0 = h * 64;
  const u16* SR = (const u16*)(p.ws + OFF_SR); const u16* SK = (const u16*)(p.ws + OFF_SK);
  const u16* SV = (const u16*)(p.ws + OFF_SV); const u16* SKK = (const u16*)(p.ws + OFF_SKK);
  const u16* SA = (const u16*)(p.ws + OFF_SA); const float* SW = (const float*)(p.ws + OFF_SW);
  float* O = (float*)(p.ws + OFF_O);
  constexpr int BUFF = 6432;
  float* lbase = (float*)smem;
  float* pp = lbase + 2 * BUFF + wv * 1024;
  const int st = tid >> 4, cg4 = tid & 15;
  struct Stg { u32x2 r, k, kk, a, kk1; f32x4 w; u16 v; };
  auto gload = [&](Stg& g, int c) {
    const size_t o = (tokb + (size_t)c * 16 + st) * 256 + chan0;
    g.r = *(const u32x2*)(SR + o + cg4 * 4); g.k = *(const u32x2*)(SK + o + cg4 * 4);
    g.kk = *(const u32x2*)(SKK + o + cg4 * 4); g.a = *(const u32x2*)(SA + o + cg4 * 4);
    g.w = *(const f32x4*)(SW + o + cg4 * 4);
    g.v = SV[o + q * 16 + cg4];
    int t1 = c * 16 + st + 1; if (t1 >= SEQ) t1 = SEQ - 1;
    g.kk1 = *(const u32x2*)(SKK + (tokb + (size_t)t1) * 256 + chan0 + cg4 * 4);
  };
  auto lwrite = [&](const Stg& g, int buf) {
    float* bp = lbase + buf * BUFF;
    const int o = st * 64 + cg4 * 4;
    f32x4 kk = {bflo(g.kk.x), bfhi(g.kk.x), bflo(g.kk.y), bfhi(g.kk.y)};
    f32x4 a = {bflo(g.a.x), bfhi(g.a.x), bflo(g.a.y), bfhi(g.a.y)};
    f32x4 k = {bflo(g.k.x), bfhi(g.k.x), bflo(g.k.y), bfhi(g.k.y)};
    f32x4 r = {bflo(g.r.x), bfhi(g.r.x), bflo(g.r.y), bfhi(g.r.y)};
    *(f32x4*)(bp + o) = kk;
    *(f32x4*)(bp + 1024 + o) = kk * a;
    *(f32x4*)(bp + 2048 + o) = k;
    *(f32x4*)(bp + 3072 + o) = g.w;
    *(f32x4*)(bp + 4096 + o) = r;
    bp[5120 + st * 16 + cg4] = bf2f(g.v);
    const f32x4 kn = {bflo(g.kk1.x), bfhi(g.kk1.x), bflo(g.kk1.y), bfhi(g.kk1.y)};
    *(f32x4*)(bp + 5376 + o) = g.w * kn;
    const f32x4 bb = kk * a;
    const float c1 = row_sum16(k.x * kn.x + k.y * kn.y + k.z * kn.z + k.w * kn.w);
    const float c2 = row_sum16(bb.x * kn.x + bb.y * kn.y + bb.z * kn.z + bb.w * kn.w);
    if (cg4 == 0) *(f32x2*)(bp + 6400 + st * 2) = f32x2{c1, c2};
  };
  constexpr int NCH = SEQ / 16;
  Stg R0, R1, R2, R3;
  gload(R0, 0); gload(R1, 1); gload(R2, 2); gload(R3, 3);
  __syncthreads();
  lwrite(R0, 0);
  __syncthreads();
  __builtin_amdgcn_s_setprio(3);
  float S0 = 0.f, S1 = 0.f, S2 = 0.f, S3 = 0.f;
  const int rrow = lane & 3, rstep = lane >> 2;
  struct Pair { f32x4 kkA, bbA, kA, wA, rA, mA, bbB, kB, wB, rB; f32x2 cA; float vA, vB; };
  auto chunk = [&](int c) {
    const float* bp = lbase + (c & 1) * BUFF;
    auto ldpair = [&](Pair& o, int s) {
      o.kkA = *(const f32x4*)(bp + s * 64 + cl * 4);
      o.mA = *(const f32x4*)(bp + 5376 + s * 64 + cl * 4);
      o.bbA = *(const f32x4*)(bp + 1024 + s * 64 + cl * 4);
      o.kA = *(const f32x4*)(bp + 2048 + s * 64 + cl * 4);
      o.wA = *(const f32x4*)(bp + 3072 + s * 64 + cl * 4);
      o.rA = *(const f32x4*)(bp + 4096 + s * 64 + cl * 4);
      o.vA = bp[5120 + s * 16 + rloc];
      o.cA = *(const f32x2*)(bp + 6400 + s * 2);
      o.bbB = *(const f32x4*)(bp + 1024 + (s + 1) * 64 + cl * 4);
      o.kB = *(const f32x4*)(bp + 2048 + (s + 1) * 64 + cl * 4);
      o.wB = *(const f32x4*)(bp + 3072 + (s + 1) * 64 + cl * 4);
      o.rB = *(const f32x4*)(bp + 4096 + (s + 1) * 64 + cl * 4);
      o.vB = bp[5120 + (s + 1) * 16 + rloc];
    };
    auto pairstep = [&](const Pair& o, int s) {
      const float pa = __builtin_fmaf(S3, o.kkA.w, __builtin_fmaf(S2, o.kkA.z, __builtin_fmaf(S1, o.kkA.y, S0 * o.kkA.x)));
      const float pd = __builtin_fmaf(S3, o.mA.w, __builtin_fmaf(S2, o.mA.z, __builtin_fmaf(S1, o.mA.y, S0 * o.mA.x)));
      const float saA = row_sum16(pa);
      const float dd = row_sum16(pd);
      const float saB = __builtin_fmaf(-saA, o.cA.y, __builtin_fmaf(o.vA, o.cA.x, dd));
      S0 = __builtin_fmaf(S0, o.wA.x, __builtin_fmaf(o.vA, o.kA.x, -(saA * o.bbA.x)));
      S1 = __builtin_fmaf(S1, o.wA.y, __builtin_fmaf(o.vA, o.kA.y, -(saA * o.bbA.y)));
      S2 = __builtin_fmaf(S2, o.wA.z, __builtin_fmaf(o.vA, o.kA.z, -(saA * o.bbA.z)));
      S3 = __builtin_fmaf(S3, o.wA.w, __builtin_fmaf(o.vA, o.kA.w, -(saA * o.bbA.w)));
      pp[(s * 4 + rl) * 16 + cl] = __builtin_fmaf(S3, o.rA.w, __builtin_fmaf(S2, o.rA.z, __builtin_fmaf(S1, o.rA.y, S0 * o.rA.x)));
      S0 = __builtin_fmaf(S0, o.wB.x, __builtin_fmaf(o.vB, o.kB.x, -(saB * o.bbB.x)));
      S1 = __builtin_fmaf(S1, o.wB.y, __builtin_fmaf(o.vB, o.kB.y, -(saB * o.bbB.y)));
      S2 = __builtin_fmaf(S2, o.wB.z, __builtin_fmaf(o.vB, o.kB.z, -(saB * o.bbB.z)));
      S3 = __builtin_fmaf(S3, o.wB.w, __builtin_fmaf(o.vB, o.kB.w, -(saB * o.bbB.w)));
      pp[((s + 1) * 4 + rl) * 16 + cl] = __builtin_fmaf(S3, o.rB.w, __builtin_fmaf(S2, o.rB.z, __builtin_fmaf(S1, o.rB.y, S0 * o.rB.x)));
    };
    Pair p0, p1;
    ldpair(p0, 0);
#pragma unroll
    for (int j = 0; j < 4; ++j) {
      ldpair(p1, 4 * j + 2);
      __builtin_amdgcn_sched_barrier(0);
      pairstep(p0, 4 * j);
      __builtin_amdgcn_sched_barrier(0);
      if (j < 3) ldpair(p0, 4 * j + 4);
      __builtin_amdgcn_sched_barrier(0);
      pairstep(p1, 4 * j + 2);
      __builtin_amdgcn_sched_barrier(0);
    }
    asm volatile("" ::: "memory");
    {
      const float* q0 = pp + (rstep * 4 + rrow) * 16;
      f32x4 a0 = *(const f32x4*)(q0), a1 = *(const f32x4*)(q0 + 4), a2 = *(const f32x4*)(q0 + 8), a3 = *(const f32x4*)(q0 + 12);
      f32x4 sm4 = (a0 + a1) + (a2 + a3);
      O[(tokb + (size_t)c * 16 + rstep) * 256 + chan0 + q * 16 + wv * 4 + rrow] = (sm4.x + sm4.y) + (sm4.z + sm4.w);
    }
    asm volatile("" ::: "memory");
  };
#pragma unroll 1
  for (int g = 0; g < NCH / 4; ++g) {
    const int c0 = g * 4;
    if (c0 + 4 < NCH) gload(R0, c0 + 4);
    chunk(c0);
    lwrite(R1, (c0 + 1) & 1);
    lds_barrier();
    if (c0 + 5 < NCH) gload(R1, c0 + 5);
    chunk(c0 + 1);
    lwrite(R2, (c0 + 2) & 1);
    lds_barrier();
    if (c0 + 6 < NCH) gload(R2, c0 + 6);
    chunk(c0 + 2);
    lwrite(R3, (c0 + 3) & 1);
    lds_barrier();
    if (c0 + 7 < NCH) gload(R3, c0 + 7);
    chunk(c0 + 3);
    if (c0 + 4 < NCH) lwrite(R0, (c0 + 4) & 1);
    lds_barrier();
  }
  __builtin_amdgcn_s_setprio(0);
}

__device__ __forceinline__ void rwkv_post_item(const Params& p, int l, int item) {
  const int j = TIDX;
  const float* O = (const float*)(p.ws + OFF_O);
  const u16* SR = (const u16*)(p.ws + OFF_SR); const u16* SK = (const u16*)(p.ws + OFF_SK);
  const u16* SV = (const u16*)(p.ws + OFF_SV); const u16* G = (const u16*)(p.ws + OFF_G);
  u16* OG = (u16*)(p.ws + OFF_OG);
  const float lw = p.in[18][l * 256 + j], lb = p.in[19][l * 256 + j], rk = p.in[17][l * 256 + j];
  const int tok0 = item * 8;
  float ov[8]; u16 rr[8], rkk[8], rv[8], rg[8];
#pragma unroll
  for (int t = 0; t < 8; ++t) {
    const size_t o = (size_t)(tok0 + t) * 256 + j;
    ov[t] = O[o]; rr[t] = SR[o]; rkk[t] = SK[o]; rv[t] = SV[o]; rg[t] = G[o];
  }
#pragma unroll
  for (int t = 0; t < 8; ++t) {
    const size_t o = (size_t)(tok0 + t) * 256 + j;
    float mean = wave_sum(ov[t]) * (1.f / 64.f);
    float d = ov[t] - mean;
    float var = wave_sum(d * d) * (1.f / 64.f);
    float on = d * rsqrtf(var + 64e-5f) * lw + lb;
    float bonus = wave_sum(bf2f(rr[t]) * bf2f(rkk[t]) * rk);
    OG[o] = f2bf((on + bonus * bf2f(rv[t])) * bf2f(rg[t]));
  }
}

#define XB_TMO      128
#define XB_XCNT(j)  (256  + 64 * (j))
#define XB_XSUB(j)  (1280 + 64 * (j))
#define XB_XGEN(j)  (2304 + 64 * (j))
#define XB_TOP      3328
#define XB_TOPGEN   3392
#define XCD_BAR_WORDS 3456
#define XB_SPIN_CAP (1u << 22)
#define LAS __attribute__((address_space(3)))
__device__ __forceinline__ unsigned xb_ld(unsigned* p) { return __hip_atomic_load(p, __ATOMIC_RELAXED, __HIP_MEMORY_SCOPE_AGENT); }
__device__ __forceinline__ unsigned xb_add(unsigned* p, unsigned v) { return __hip_atomic_fetch_add(p, v, __ATOMIC_RELAXED, __HIP_MEMORY_SCOPE_AGENT); }
__device__ __forceinline__ unsigned xb_xcc_id() { return (unsigned)__builtin_amdgcn_s_getreg((3 << 11) | 20) & 0xFu; }
#define XB_SPIN(cond, bar) do { unsigned _sp = 0; while (cond) { __builtin_amdgcn_s_sleep(1); \
    if ((++_sp & 255u) == 0u) { if (xb_ld(&(bar)[XB_TMO])) break; if (_sp > XB_SPIN_CAP) { atomicAdd(&(bar)[XB_TMO], 1u); break; } } } } while (0)
struct XcdBarrier { unsigned* bar; unsigned x; volatile LAS unsigned* st; };
__device__ __forceinline__ XcdBarrier xcd_barrier_post(unsigned* bar, volatile LAS unsigned* st) {
  XcdBarrier b; b.bar = bar; b.x = xb_xcc_id(); b.st = st;
  if (threadIdx.x == 0) st[2] = xb_add(&bar[XB_XCNT(b.x)], 1u);
  return b;
}
__device__ __forceinline__ void xcd_barrier_complete(unsigned* bar, unsigned x, unsigned& nloc, unsigned& nx) {
  const unsigned G = gridDim.x * gridDim.y * gridDim.z;
  unsigned sum, cnt, mine, sp = 0u;
  for (;;) {
    sum = 0u; cnt = 0u; mine = 0u;
#pragma unroll
    for (unsigned j = 0; j < 16; ++j) { const unsigned c = xb_ld(&bar[XB_XCNT(j)]); sum += c; cnt += (c > 0u) ? 1u : 0u; mine = (j == x) ? c : mine; }
    if (sum == G) break;
    __builtin_amdgcn_s_sleep(1);
    if ((++sp & 255u) == 0u) { if (xb_ld(&bar[XB_TMO])) break; if (sp > XB_SPIN_CAP) { atomicAdd(&bar[XB_TMO], 1u); break; } }
  }
  nloc = mine > 0u ? mine : 1u; nx = cnt > 0u ? cnt : 1u;
}
__device__ __forceinline__ void xcd_barrier(const XcdBarrier& b) {
  asm volatile("s_waitcnt vmcnt(0)" ::: "memory");
  __syncthreads();
  if (threadIdx.x == 0) {
    unsigned* bar = b.bar;
    __builtin_amdgcn_s_waitcnt(0);
    unsigned nloc = b.st[0], nx = b.st[1];
    if (nloc == 0u) { xcd_barrier_complete(bar, b.x, nloc, nx); b.st[0] = nloc; b.st[1] = nx; }
    const unsigned old = xb_add(&bar[XB_XSUB(b.x)], 1u);
    const unsigned gen = old / nloc;
    if (old + 1u == (gen + 1u) * nloc) {
      __builtin_amdgcn_fence(__ATOMIC_RELEASE, "agent");
      asm volatile("s_waitcnt vmcnt(0)" ::: "memory");
      const unsigned og = xb_add(&bar[XB_TOP], 1u);
      const unsigned tg = og / nx;
      if (og + 1u == (tg + 1u) * nx) xb_add(&bar[XB_TOPGEN], 1u);
      else XB_SPIN(xb_ld(&bar[XB_TOPGEN]) == tg, bar);
      __builtin_amdgcn_fence(__ATOMIC_ACQUIRE, "agent");
      xb_add(&bar[XB_XGEN(b.x)], 1u);
      asm volatile("s_waitcnt vmcnt(0)" ::: "memory");
    } else {
      XB_SPIN(xb_ld(&bar[XB_XGEN(b.x)]) == gen, bar);
      __builtin_amdgcn_fence(__ATOMIC_ACQUIRE, "agent");
      asm volatile("s_waitcnt vmcnt(0)" ::: "memory");
    }
  }
  __syncthreads();
}

__device__ __forceinline__ int xcd_virtual_id(const XcdBarrier& b) {
  if (threadIdx.x == 0) {
    unsigned base = 0u;
#pragma unroll
    for (unsigned j = 0; j < 16; ++j) { const unsigned c = xb_ld(&b.bar[XB_XCNT(j)]); base += (j < b.x) ? c : 0u; }
    b.st[3] = base + b.st[2];
  }
  __syncthreads();
  const int vb = __builtin_amdgcn_readfirstlane((int)b.st[3]);
  __syncthreads();
  return vb;
}

__device__ __forceinline__ void sub_barrier(unsigned* cnt, unsigned target) {
  asm volatile("s_waitcnt vmcnt(0)" ::: "memory");
  __syncthreads();
  if (threadIdx.x == 0) {
    __builtin_amdgcn_fence(__ATOMIC_RELEASE, "agent");
    asm volatile("s_waitcnt vmcnt(0)" ::: "memory");
    xb_add(cnt, 1u);
    unsigned sp = 0;
    while (xb_ld(cnt) < target) { __builtin_amdgcn_s_sleep(2); if (++sp > (1u << 24)) break; }
    __builtin_amdgcn_fence(__ATOMIC_ACQUIRE, "agent");
    asm volatile("s_waitcnt vmcnt(0)" ::: "memory");
  }
  __syncthreads();
}

#define N_PHASES 22
#ifndef PROBE_CONV_REPS
#define PROBE_CONV_REPS 1
#endif
#ifndef PROBE_PREP_REPS
#define PROBE_PREP_REPS 1
#endif
#ifndef PROBE_POST_REPS
#define PROBE_POST_REPS 1
#endif
#ifndef PROBE_SCAN_REPS
#define PROBE_SCAN_REPS 1
#endif
#ifndef PROBE_FFN1_REPS
#define PROBE_FFN1_REPS 1
#endif
#ifndef PH_MASK
#define PH_MASK 0xFFFFF
#endif
#define PHON(s) (PH_MASK & (1 << (s)))
#define PHASE_BEGIN(k) if (ph_hi > (k)) { if ((k) > 1) xcd_barrier(xb);
#define PHASE_END }

template <int L>
__device__ __forceinline__ void run_layer(const Params& p, int vbr, int ph_hi, unsigned char* smem_all, const XcdBarrier& xb) {
  unsigned char* smem = smem_all + SUBB * 73728;
  const int vb = vbr * 2 + SUBB;
  constexpr int l = L;
  constexpr int base = 1 + 10 * L;
  const float* modl = (const float*)(p.ws + OFF_MOD) + (size_t)l * 4 * 6144;
  PHASE_BEGIN(base + 0)
    for (int rep = 0; rep < PROBE_CONV_REPS; ++rep) {
      if (rep) xcd_barrier(xb);
      phase_convert(p, l, smem);
      phase_norm(l == 0 ? p.in[0] : p.out, p.in[4] + l * 1024, modl, 0, 1024, (u16*)(p.ws + OFF_H));
    }
  PHASE_END
  PHASE_BEGIN(base + 1)
    phase_pproj_tail(p, vbr, smem_all);
    phase_gemm_8w<0>(p, l, vbr, smem_all);
  PHASE_END
  PHASE_BEGIN(base + 2)
    for (int rep = 0; rep < PROBE_PREP_REPS; ++rep) {
      if (rep) xcd_barrier(xb);
      for (int item = VBLK; item < 512; item += VGRID) rwkv_prep_item(p, l, item, smem);
    }
  PHASE_END
  PHASE_BEGIN(base + 3)
    if ((int)blockIdx.x < 64) {
      if (SUBB == 0) scan_item(p, blockIdx.x, smem);
      else { __syncthreads(); __syncthreads(); for (int c = 0; c < SEQ / 16; ++c) lds_barrier(); }
    }
    else {
      const int nb = VGRID - 128, bi = VBLK - 128;
      for (int item = bi; item < 512; item += nb) sg_item(p, l, item, smem);
      for (int item = (bi + 2 * (nb / 3)) % nb; item < 1024; item += nb) s5a_item(p, l, item, smem);
      for (int item = (bi + 2 * (nb / 3)) % nb; item < 2048; item += nb) conv_item(p, l, item);
      sub_barrier((unsigned*)(p.ws + OFF_BAR) + 3520 + 64 * (2 * l), gridDim.x - 64);
      for (int item = bi; item < 1024; item += nb) s5b_item(p, l, item, smem);
      sub_barrier((unsigned*)(p.ws + OFF_BAR) + 3520 + 64 * (2 * l + 1), gridDim.x - 64);
      for (int item = (int)blockIdx.x - 64; item < 512; item += (int)gridDim.x - 64) merge_tile8<0>(p, item, smem_all);
    }
  PHASE_END
  PHASE_BEGIN(base + 4)
    for (int rep = 0; rep < PROBE_POST_REPS; ++rep) { if (rep) xcd_barrier(xb); for (int item = VBLK; item < 2048; item += VGRID) rwkv_post_item(p, l, item); }
  PHASE_END
  PHASE_BEGIN(base + 5)
    for (int item = vbr; item < 512; item += (int)gridDim.x) {
      int it2 = item;
      if (gridDim.x == 256) { const int r = item >> 8, w = vbr & 31; it2 = ((r * 4 + (w >> 3)) << 6) | ((vbr >> 5) * 8 + (w & 7)); }
      merge_tile8<1>(p, it2, smem_all);
    }
  PHASE_END
  PHASE_BEGIN(base + 6)
    phase_gemm_8w<1>(p, l, vbr, smem_all);
  PHASE_END
  PHASE_BEGIN(base + 7)
    if (PHON(7)) phase_norm(p.out, p.in[38] + l * 1024, modl, 3072, 4096, (u16*)(p.ws + OFF_H));
  PHASE_END
  PHASE_BEGIN(base + 8)
    phase_gemm_8w<2>(p, l, vbr, smem_all);
  PHASE_END
#ifdef PROBE_DUP_FFN1
  PHASE_BEGIN(base + 8)
    phase_gemm_8w<2>(p, l, vbr, smem_all);
  PHASE_END
#endif
  PHASE_BEGIN(base + 9)
    phase_gemm_8w<3>(p, l, vbr, smem_all);
  PHASE_END
}

__global__ void __launch_bounds__(512, 2) mega_fwd(Params p, int ph_lo, int ph_hi) {
  __shared__ __attribute__((aligned(16))) unsigned char smem[2 * 73728 + 16];
  cg::grid_group grid = cg::this_grid();
  if (ph_hi < 0) grid.sync();
  volatile LAS unsigned* st = (volatile LAS unsigned*)(smem + 2 * 73728);
  if (threadIdx.x == 0) { st[0] = 0u; st[1] = 0u; st[2] = 0u; st[3] = 0u; }
  __syncthreads();
  const XcdBarrier xb = xcd_barrier_post((unsigned*)(p.ws + OFF_BAR), st);
  if (ph_hi > 0) phase_mod(p, smem + SUBB * 73728);
  xcd_barrier(xb);
  const int vb = xcd_virtual_id(xb);
  run_layer<0>(p, vb, ph_hi, smem, xb);
  run_layer<1>(p, vb, ph_hi, smem, xb);
  PHASE_BEGIN(21)
    if (PHON(11)) phase_final(p.out, p.in[41]);
  PHASE_END
}

extern "C" void kernel_launch(void* const* d_in, const int* in_sizes, int n_in, void* d_out, int out_size, void* d_ws,
                              size_t ws_size, hipStream_t stream) {
  static int grid_blocks = 0;
  if (!grid_blocks) {
    int dev = 0, cus = 0, per_cu = 0;
    hipGetDevice(&dev);
    hipDeviceGetAttribute(&cus, hipDeviceAttributeMultiprocessorCount, dev);
    hipOccupancyMaxActiveBlocksPerMultiprocessor(&per_cu, mega_fwd, 512, 0);
    if (per_cu > 1) per_cu = 1;
    if (per_cu < 1) per_cu = 1;
    grid_blocks = cus * per_cu;
    if (ws_size < WS_END) fprintf(stderr, "workspace too small: %zu < %zu\n", ws_size, (size_t)WS_END);
  }
  Params p{};
  for (int i = 0; i < 42; ++i) p.in[i] = (const float*)d_in[i];
  p.out = (float*)d_out;
  p.ws = (unsigned char*)d_ws;
  hipMemsetAsync((unsigned char*)d_ws + OFF_BAR, 0, 16384, stream);
  int lo = 0, hi = N_PHASES;
  void* args[] = {&p, &lo, &hi};
  hipError_t e = hipLaunchCooperativeKernel((void*)mega_fwd, dim3(grid_blocks), dim3(512), args, 0, stream);
  if (e != hipSuccess) fprintf(stderr, "cooperative launch failed: %s (grid %d)\n", hipGetErrorString(e), grid_blocks);
}
```

```cpp
#include <hip/hip_runtime.h>
#include <hip/hip_cooperative_groups.h>
#include <cstdio>
namespace cg = cooperative_groups;

typedef unsigned short u16;
using bf16x8 = __attribute__((ext_vector_type(8))) short;
using f32x4 = __attribute__((ext_vector_type(4))) float;
using u32x4 = __attribute__((ext_vector_type(4))) unsigned int;
using u32x2 = __attribute__((ext_vector_type(2))) unsigned int;
using f32x2 = __attribute__((ext_vector_type(2))) float;

#define T_TOK 16384
#define SEQ 4096
#define DM 1024
#define NTHR 256
#define TIDX ((int)(threadIdx.x & 255))
#define SUBB ((int)(threadIdx.x >> 8))
#define VBLK ((int)(blockIdx.x * 2 + (threadIdx.x >> 8)))
#define VGRID ((int)(gridDim.x * 2))

static constexpr size_t SZ_WIN = (size_t)6528 * 1024 * 2;
static constexpr size_t OFF_WIN = 0;
static constexpr size_t OFF_RO = OFF_WIN + SZ_WIN;
static constexpr size_t OFF_SO = OFF_RO + 1024 * 256 * 2;
static constexpr size_t OFF_CO = OFF_SO + 1024 * 256 * 2;
static constexpr size_t OFF_GLU = OFF_CO + 1024 * 256 * 2;
static constexpr size_t OFF_WO = OFF_GLU + 2048 * 256 * 2;
static constexpr size_t OFF_W1 = OFF_WO + 1024 * 1024 * 2;
static constexpr size_t OFF_W2 = OFF_W1 + (size_t)4096 * 1024 * 2;
static constexpr size_t OFF_H = OFF_W2 + (size_t)4096 * 1024 * 2;
static constexpr size_t SZ_T256B = (size_t)T_TOK * 256 * 2;
static constexpr size_t OFF_VF = OFF_H + (size_t)T_TOK * 1024 * 2;
static constexpr size_t OFF_PD = OFF_VF + SZ_T256B;
static constexpr size_t OFF_G = OFF_PD + SZ_T256B;
static constexpr size_t OFF_UB = OFF_G + SZ_T256B;
static constexpr size_t OFF_CB = OFF_UB + SZ_T256B;
static constexpr size_t OFF_SR = OFF_CB + SZ_T256B;
static constexpr size_t OFF_SK = OFF_SR + SZ_T256B;
static constexpr size_t OFF_SV = OFF_SK + SZ_T256B;
static constexpr size_t OFF_SKK = OFF_SV + SZ_T256B;
static constexpr size_t OFF_SA = OFF_SKK + SZ_T256B;
static constexpr size_t OFF_SW = OFF_SA + SZ_T256B;
static constexpr size_t OFF_PABC = OFF_SW + 2 * SZ_T256B;
static constexpr size_t OFF_YD = OFF_PABC;
static constexpr size_t OFF_OG = OFF_YD + SZ_T256B;
static constexpr size_t OFF_MRG = OFF_OG + SZ_T256B;
static constexpr size_t OFF_F = OFF_UB;
static constexpr size_t OFF_SMALL = OFF_PABC + (size_t)T_TOK * 2176 * 2;
static constexpr size_t OFF_MOD = OFF_SMALL;
static constexpr size_t OFF_S5AB = OFF_MOD + 2 * 4 * 6144 * 4;
static constexpr size_t OFF_S5BB = OFF_S5AB + 2 * 16 * 64 * 2 * 4;
static constexpr size_t OFF_S5E = OFF_S5BB + 2 * 16 * 64 * 32 * 4;
static constexpr size_t OFF_BAR = OFF_S5E + (size_t)4 * 64 * 16 * 64 * 2 * 4;
static constexpr size_t OFF_SGW = OFF_BAR + 16384;
static constexpr size_t OFF_O = OFF_SGW + 4 * 128 * 128 * 2;
static constexpr size_t OFF_LW2 = OFF_O + 2 * SZ_T256B;
static constexpr size_t OFF_LA2 = OFF_LW2 + 256 * 32 * 2;
static constexpr size_t OFF_LG2 = OFF_LA2 + 256 * 32 * 2;
static constexpr size_t OFF_LV2 = OFF_LG2 + 256 * 64 * 2;
static constexpr size_t OFF_LV1 = OFF_LV2 + 256 * 32 * 2;
static constexpr size_t OFF_SGST = OFF_LV1 + 32 * 256 * 2;
static constexpr size_t WS_END = OFF_SGST + (size_t)T_TOK * 2 * 4;
static_assert(OFF_F + (size_t)T_TOK * 4096 * 2 <= OFF_SMALL, "F overlaps small region");
static_assert(OFF_MRG + (size_t)T_TOK * 1024 * 2 <= OFF_SMALL, "MRG overlaps");

struct Params {
  const float* in[42];
  float* out;
  unsigned char* ws;
};

__device__ __forceinline__ u16 f2bf(float f) {
  unsigned u = __float_as_uint(f);
  u += 0x7fffu + ((u >> 16) & 1u);
  return (u16)(u >> 16);
}
__device__ __forceinline__ float bf2f(u16 h) { return __uint_as_float(((unsigned)h) << 16); }
__device__ __forceinline__ float bflo(unsigned u) { return __uint_as_float(u << 16); }
__device__ __forceinline__ float bfhi(unsigned u) { return __uint_as_float(u & 0xffff0000u); }
__device__ __forceinline__ unsigned pack2(float a, float b) { return (unsigned)f2bf(a) | ((unsigned)f2bf(b) << 16); }
__device__ __forceinline__ float sigmoidf_(float x) { return 1.f / (1.f + __expf(-x)); }
__device__ __forceinline__ float tanhf_(float y) { return 1.f - 2.f / (1.f + __expf(2.f * y)); }
__device__ __forceinline__ float geluf_(float x) {
  float y = 0.7978845608028654f * (x + 0.044715f * x * x * x);
  return 0.5f * x * (1.f + tanhf_(y));
}
__device__ __forceinline__ float wave_sum(float v) {
#pragma unroll
  for (int o = 32; o > 0; o >>= 1) v += __shfl_xor(v, o, 64);
  return v;
}
template <int CTRL>
__device__ __forceinline__ float dppf(float x) {
  return __int_as_float(__builtin_amdgcn_update_dpp(__float_as_int(x), __float_as_int(x), CTRL, 0xF, 0xF, true));
}
__device__ __forceinline__ float row_sum16(float x) {
  x += dppf<0x128>(x);
  x += dppf<0x124>(x);
  x += dppf<0x122>(x);
  x += dppf<0x121>(x);
  return x;
}

__device__ __forceinline__ void phase_mod(const Params& p, unsigned char* smem) {
  const int tid = TIDX;
  float* cact = (float*)smem;
  float* red = cact + 4096;
  float* mod = (float*)(p.ws + OFF_MOD);
  for (int i = tid; i < 4096; i += NTHR) { float c = p.in[1][i]; cact[i] = c / (1.f + __expf(-c)); }
  __syncthreads();
  for (int item = VBLK; item < 192; item += VGRID) {
    int l = item / 96, nb = item % 96;
    int cl = tid & 63, kq = tid >> 6;
    int col = nb * 64 + cl;
    const float* W = p.in[2] + (size_t)l * 1024 * 6144;
    float a0 = 0, a1 = 0, a2 = 0, a3 = 0;
    for (int k = kq * 256; k < kq * 256 + 256; ++k) {
      float w = W[(size_t)k * 6144 + col];
      a0 += cact[k] * w; a1 += cact[1024 + k] * w; a2 += cact[2048 + k] * w; a3 += cact[3072 + k] * w;
    }
    red[(kq * 4 + 0) * 64 + cl] = a0; red[(kq * 4 + 1) * 64 + cl] = a1;
    red[(kq * 4 + 2) * 64 + cl] = a2; red[(kq * 4 + 3) * 64 + cl] = a3;
    __syncthreads();
    {
      int b = tid >> 6;
      float s = red[(0 * 4 + b) * 64 + cl] + red[(1 * 4 + b) * 64 + cl] + red[(2 * 4 + b) * 64 + cl] + red[(3 * 4 + b) * 64 + cl];
      mod[((size_t)l * 4 + b) * 6144 + col] = s + p.in[3][l * 6144 + col];
    }
    __syncthreads();
  }
  float* s5ab = (float*)(p.ws + OFF_S5AB);
  float* s5bb = (float*)(p.ws + OFF_S5BB);
  for (int idx = VBLK * NTHR + tid; idx < 2048; idx += VGRID * NTHR) {
    int l = idx >> 10, g = (idx >> 6) & 15, n = idx & 63;
    double lre = fmin((double)p.in[28][idx], -1e-4);
    double lim = (double)p.in[29][idx];
    double dt = exp((double)p.in[35][l * 16 + g]);
    double mag = exp(lre * dt);
    double abr = mag * cos(lim * dt), abi = mag * sin(lim * dt);
    double den = lre * lre + lim * lim;
    double qr = ((abr - 1.0) * lre + abi * lim) / den;
    double qi = (abi * lre - (abr - 1.0) * lim) / den;
    s5ab[idx * 2 + 0] = (float)abr; s5ab[idx * 2 + 1] = (float)abi;
    for (int c = 0; c < 16; ++c) {
      double br = p.in[30][(size_t)idx * 16 + c], bi = p.in[31][(size_t)idx * 16 + c];
      s5bb[(size_t)idx * 32 + c] = (float)(qr * br - qi * bi);
      s5bb[(size_t)idx * 32 + 16 + c] = (float)(qr * bi + qi * br);
    }
  }
}

__device__ __forceinline__ void convert_tile(const float* __restrict__ src, int K, int N, u16* __restrict__ dst, int tk, int tn, u16* sm) {
  const int tid = TIDX;
  int r = tid >> 4, c4 = (tid & 15) * 4;
#pragma unroll
  for (int i = 0; i < 4; ++i) {
    int kk = r + 16 * i;
    float4 v = *(const float4*)(src + (size_t)(tk * 64 + kk) * N + tn * 64 + c4);
    sm[(c4 + 0) * 72 + kk] = f2bf(v.x);
    sm[(c4 + 1) * 72 + kk] = f2bf(v.y);
    sm[(c4 + 2) * 72 + kk] = f2bf(v.z);
    sm[(c4 + 3) * 72 + kk] = f2bf(v.w);
  }
  __syncthreads();
#pragma unroll
  for (int j = 0; j < 2; ++j) {
    int n = (tid >> 3) + 32 * j, ch = tid & 7;
    u32x4 v = *(const u32x4*)(sm + n * 72 + ch * 8);
    *(u32x4*)(dst + (size_t)(tn * 64 + n) * K + tk * 64 + ch * 8) = v;
  }
  __syncthreads();
}

__device__ __forceinline__ void phase_convert(const Params& p, int l, unsigned char* smem) {
  u16* sm = (u16*)smem;
  const int total = 1632 + 192 + 128 + 256 + 1024 + 1024;
  for (int item = VBLK; item < total + 16 + 192; item += VGRID) {
    int t = item;
    if (t >= total + 16) {
      const int e = (t - total - 16) * 256 + TIDX;
      if (e < 8192) { const int n = e >> 5, k = e & 31; ((u16*)(p.ws + OFF_LW2))[e] = f2bf(p.in[8][(size_t)l * 8192 + k * 256 + n]); }
      else if (e < 16384) { const int q = e - 8192, n = q >> 5, k = q & 31; ((u16*)(p.ws + OFF_LA2))[q] = f2bf(p.in[10][(size_t)l * 8192 + k * 256 + n]); }
      else if (e < 32768) { const int q = e - 16384, n = q >> 6, k = q & 63; ((u16*)(p.ws + OFF_LG2))[q] = f2bf(p.in[11][(size_t)l * 16384 + k * 256 + n]); }
      else if (e < 40960) { const int q = e - 32768, n = q >> 5, k = q & 31; ((u16*)(p.ws + OFF_LV2))[q] = (l > 0) ? f2bf(p.in[14][k * 256 + n]) : (u16)0; }
      else { const int q = e - 40960, n = q >> 8, k = q & 255; ((u16*)(p.ws + OFF_LV1))[q] = (l > 0) ? f2bf(p.in[13][k * 32 + n]) : (u16)0; }
      continue;
    }
    if (t >= total) {
      const int idx = t - total, g = idx >> 2, rq = idx & 3;
      const int tr = rq * 32 + (TIDX >> 3), s0 = (TIDX & 7) * 16;
      const float* src = p.in[23] + (((size_t)l * 4 + g) * 128 + tr) * 128 + s0;
      u16* dst = (u16*)(p.ws + OFF_SGW) + ((size_t)g * 128 + tr) * 128 + s0;
      unsigned pk[8];
#pragma unroll
      for (int e = 0; e < 4; ++e) {
        f32x4 v = *(const f32x4*)(src + e * 4);
        const int sb = s0 + e * 4;
        pk[e * 2 + 0] = pack2(sb + 0 <= tr ? v.x : 0.f, sb + 1 <= tr ? v.y : 0.f);
        pk[e * 2 + 1] = pack2(sb + 2 <= tr ? v.z : 0.f, sb + 3 <= tr ? v.w : 0.f);
      }
      *(u32x4*)(dst) = u32x4{pk[0], pk[1], pk[2], pk[3]};
      *(u32x4*)(dst + 8) = u32x4{pk[4], pk[5], pk[6], pk[7]};
      continue;
    }
    const float* src; int K, N; size_t off;
    if (t < 1632) { src = p.in[5] + (size_t)l * 1024 * 6528; K = 1024; N = 6528; off = OFF_WIN; }
    else if ((t -= 1632) < 64) { src = p.in[20] + (size_t)l * 256 * 1024; K = 256; N = 1024; off = OFF_RO; }
    else if ((t -= 64) < 64) { src = p.in[25] + (size_t)l * 256 * 1024; K = 256; N = 1024; off = OFF_SO; }
    else if ((t -= 64) < 64) { src = p.in[27] + (size_t)l * 256 * 1024; K = 256; N = 1024; off = OFF_CO; }
    else if ((t -= 64) < 128) { src = p.in[36] + (size_t)l * 256 * 2048; K = 256; N = 2048; off = OFF_GLU; }
    else if ((t -= 128) < 256) { src = p.in[37] + (size_t)l * 1024 * 1024; K = 1024; N = 1024; off = OFF_WO; }
    else if ((t -= 256) < 1024) { src = p.in[39] + (size_t)l * 1024 * 4096; K = 1024; N = 4096; off = OFF_W1; }
    else { t -= 1024; src = p.in[40] + (size_t)l * 4096 * 1024; K = 4096; N = 1024; off = OFF_W2; }
    int ntn = N / 64;
    convert_tile(src, K, N, (u16*)(p.ws + off), t / ntn, t % ntn, sm);
  }
}

__device__ __forceinline__ void phase_norm(const float* __restrict__ X, const float* __restrict__ g, const float* __restrict__ modl,
                           int sh_off, int sc_off, u16* __restrict__ H) {
  const int lane = TIDX & 63, wv = TIDX >> 6;
  for (int item = VBLK; item < T_TOK / 4; item += VGRID) {
    int row = item * 4 + wv;
    int b = row >> 12;
    const float* xr = X + (size_t)row * 1024;
    float4 v[4];
    float ss = 0;
#pragma unroll
    for (int i = 0; i < 4; ++i) {
      v[i] = *(const float4*)(xr + lane * 4 + 256 * i);
      ss += v[i].x * v[i].x + v[i].y * v[i].y + v[i].z * v[i].z + v[i].w * v[i].w;
    }
    ss = wave_sum(ss);
    float rstd = rsqrtf(ss * (1.f / 1024.f) + 1e-6f);
    const float* sh = modl + (size_t)b * 6144 + sh_off;
    const float* sc = modl + (size_t)b * 6144 + sc_off;
#pragma unroll
    for (int i = 0; i < 4; ++i) {
      int c = lane * 4 + 256 * i;
      float4 gg = *(const float4*)(g + c);
      float4 s1 = *(const float4*)(sc + c);
      float4 s0 = *(const float4*)(sh + c);
      float h0 = v[i].x * rstd * gg.x * (1.f + s1.x) + s0.x;
      float h1 = v[i].y * rstd * gg.y * (1.f + s1.y) + s0.y;
      float h2 = v[i].z * rstd * gg.z * (1.f + s1.z) + s0.z;
      float h3 = v[i].w * rstd * gg.w * (1.f + s1.w) + s0.w;
      u32x2 o; o.x = pack2(h0, h1); o.y = pack2(h2, h3);
      *(u32x2*)(H + (size_t)row * 1024 + c) = o;
    }
  }
}

__device__ __forceinline__ void phase_final(float* __restrict__ X, const float* __restrict__ g) {
  const int lane = TIDX & 63, wv = TIDX >> 6;
  for (int item = VBLK; item < T_TOK / 4; item += VGRID) {
    int row = item * 4 + wv;
    float* xr = X + (size_t)row * 1024;
    float4 v[4];
    float ss = 0;
#pragma unroll
    for (int i = 0; i < 4; ++i) {
      v[i] = *(const float4*)(xr + lane * 4 + 256 * i);
      ss += v[i].x * v[i].x + v[i].y * v[i].y + v[i].z * v[i].z + v[i].w * v[i].w;
    }
    ss = wave_sum(ss);
    float rstd = rsqrtf(ss * (1.f / 1024.f) + 1e-6f);
#pragma unroll
    for (int i = 0; i < 4; ++i) {
      int c = lane * 4 + 256 * i;
      float4 gg = *(const float4*)(g + c);
      float4 o;
      o.x = v[i].x * rstd * gg.x; o.y = v[i].y * rstd * gg.y; o.z = v[i].z * rstd * gg.z; o.w = v[i].w * rstd * gg.w;
      *(float4*)(xr + c) = o;
    }
  }
}

template <int NF, bool LEAN = false>
__device__ __forceinline__ void gemm_mainloop(const u16* __restrict__ A, int lda, const u16* __restrict__ B, int ldb,
                                              int K, f32x4 (&acc)[4][NF], u16* smem) {
  constexpr int BN = 32 * NF;
  constexpr int NB = BN / 32;
  u16* sA = smem;
  u16* sB = smem + 2 * 128 * 64;
  int tz = 0;
  if (LEAN) asm volatile("" : "+v"(tz));
  const int tid = TIDX + tz, lane = tid & 63, wv = tid >> 6;
  const int wm = wv >> 1, wn = wv & 1;
  const int lrow = tid >> 3;
  const int lchs = (tid & 7) ^ ((lrow >> 1) & 7);
  const u16* Ap = A + (size_t)lrow * lda + lchs * 8;
  const u16* Bp = B + (size_t)lrow * ldb + lchs * 8;
  const int nk = K >> 6;
  auto stage = [&](int kt, int buf) {
    const int ko = kt << 6;
#pragma unroll
    for (int i = 0; i < 4; ++i)
      __builtin_amdgcn_global_load_lds((const unsigned*)(Ap + (size_t)(32 * i) * lda + ko),
                                       (__attribute__((address_space(3))) unsigned*)(sA + buf * (128 * 64) + (tid + 256 * i) * 8), 16, 0, 0);
#pragma unroll
    for (int i = 0; i < NB; ++i)
      __builtin_amdgcn_global_load_lds((const unsigned*)(Bp + (size_t)(32 * i) * ldb + ko),
                                       (__attribute__((address_space(3))) unsigned*)(sB + buf * (BN * 64) + (tid + 256 * i) * 8), 16, 0, 0);
  };
  __syncthreads();
  stage(0, 0);
  const int fr = lane & 15, fq = lane >> 4;
  const int sw = (fr >> 1) & 7;
  for (int kt = 0; kt < nk; ++kt) {
    const int cur = kt & 1;
    asm volatile("s_waitcnt vmcnt(0)" ::: "memory");
    __syncthreads();
    if (kt + 1 < nk) stage(kt + 1, cur ^ 1);
    const u16* cA = sA + cur * (128 * 64) + (wm * 64 + fr) * 64;
    const u16* cB = sB + cur * (BN * 64) + (wn * 16 * NF + fr) * 64;
#pragma unroll
    for (int ks = 0; ks < 2; ++ks) {
      if (LEAN) __builtin_amdgcn_sched_barrier(0);
      const int pc = ((fq + 4 * ks) ^ sw) << 3;
      bf16x8 fa[4], fb[NF];
#pragma unroll
      for (int i = 0; i < 4; ++i) fa[i] = *(const bf16x8*)(cA + i * 16 * 64 + pc);
#pragma unroll
      for (int j = 0; j < NF; ++j) fb[j] = *(const bf16x8*)(cB + j * 16 * 64 + pc);
#pragma unroll
      for (int i = 0; i < 4; ++i)
#pragma unroll
        for (int j = 0; j < NF; ++j)
          acc[i][j] = __builtin_amdgcn_mfma_f32_16x16x32_bf16(fb[j], fa[i], acc[i][j], 0, 0, 0);
    }
  }
}

template <int NF>
__device__ __forceinline__ void zero_acc(f32x4 (&acc)[4][NF]) {
#pragma unroll
  for (int i = 0; i < 4; ++i)
#pragma unroll
    for (int j = 0; j < NF; ++j) acc[i][j] = f32x4{0.f, 0.f, 0.f, 0.f};
}

template <bool PERM>
__device__ __forceinline__ void gemm_mainloop_8w(const u16* __restrict__ A, int lda, const u16* __restrict__ B, int ldb,
                                                 int K, f32x4 (&acc)[8][4], u16* smem) {
  constexpr int STG = 32768;
  const int tid = threadIdx.x, lane = tid & 63, wv = tid >> 6;
  const int wm = wv >> 2, wn = wv & 3;
  const int lrow = tid >> 3;
  const int lchs = (tid & 7) ^ ((lrow >> 1) & 7);
  const u16* Ap = A + (size_t)lrow * lda + lchs * 8;
  const int rho = lrow & 31, pi = rho & 15;
  const int brow = PERM ? ((lrow & ~31) + 8 * (pi >> 2) + 4 * (rho >> 4) + (pi & 3)) : lrow;
  const u16* Bp = B + (size_t)brow * ldb + lchs * 8;
  const int nk = K >> 6;
  auto stage = [&](int kt, int buf) {
    const int ko = kt << 6;
    u16* sa = smem + buf * STG;
#pragma unroll
    for (int i = 0; i < 4; ++i)
      __builtin_amdgcn_global_load_lds((const unsigned*)(Ap + (size_t)(64 * i) * lda + ko),
                                       (__attribute__((address_space(3))) unsigned*)(sa + (tid + 512 * i) * 8), 16, 0, 0);
#pragma unroll
    for (int i = 0; i < 4; ++i)
      __builtin_amdgcn_global_load_lds((const unsigned*)(Bp + (size_t)(64 * i) * ldb + ko),
                                       (__attribute__((address_space(3))) unsigned*)(sa + 16384 + (tid + 512 * i) * 8), 16, 0, 0);
  };
  __syncthreads();
  stage(0, 0);
  const int fr = lane & 15, fq = lane >> 4;
  const int sw = (fr >> 1) & 7;
  for (int kt = 0; kt < nk; ++kt) {
    const int cur = kt & 1;
    asm volatile("s_waitcnt vmcnt(0)" ::: "memory");
    __syncthreads();
    if (kt + 1 < nk) stage(kt + 1, cur ^ 1);
    const u16* cA = smem + cur * STG + (wm * 128 + fr) * 64;
    const u16* cB = smem + cur * STG + 16384 + (wn * 64 + fr) * 64;
#pragma unroll
    for (int ks = 0; ks < 2; ++ks) {
      const int pc = ((fq + 4 * ks) ^ sw) << 3;
      bf16x8 fa[8], fb[4];
#pragma unroll
      for (int i = 0; i < 8; ++i) fa[i] = *(const bf16x8*)(cA + i * 16 * 64 + pc);
#pragma unroll
      for (int j = 0; j < 4; ++j) fb[j] = *(const bf16x8*)(cB + j * 16 * 64 + pc);
#pragma unroll
      for (int i = 0; i < 8; ++i)
#pragma unroll
        for (int j = 0; j < 4; ++j)
          acc[i][j] = __builtin_amdgcn_mfma_f32_16x16x32_bf16(fb[j], fa[i], acc[i][j], 0, 0, 0);
    }
  }
}

template <int EPI>
__device__ __forceinline__ void phase_gemm_8w(const Params& p, int l, int vb, unsigned char* smem_raw) {
  u16* smem = (u16*)smem_raw;
  const int lane = threadIdx.x & 63, wv = threadIdx.x >> 6;
  const int wm = wv >> 2, wn = wv & 3;
  const int fr = lane & 15, fq = lane >> 4;
  const u16* A; const u16* B; int lda, ldb, K, ntiles_n;
  if (EPI == 0) { A = (const u16*)(p.ws + OFF_H); lda = 1024; B = (const u16*)(p.ws + OFF_WIN); ldb = 1024; K = 1024; ntiles_n = 8; }
  if (EPI == 1) { A = (const u16*)(p.ws + OFF_MRG); lda = 1024; B = (const u16*)(p.ws + OFF_WO); ldb = 1024; K = 1024; ntiles_n = 4; }
  if (EPI == 2) { A = (const u16*)(p.ws + OFF_H); lda = 1024; B = (const u16*)(p.ws + OFF_W1); ldb = 1024; K = 1024; ntiles_n = 16; }
  if (EPI == 3) { A = (const u16*)(p.ws + OFF_F); lda = 4096; B = (const u16*)(p.ws + OFF_W2); ldb = 4096; K = 4096; ntiles_n = 4; }
  const float* modl = (const float*)(p.ws + OFF_MOD) + (size_t)l * 4 * 6144;
  const int total = 64 * ntiles_n;
  const int G = gridDim.x;
  const bool swz = (G == 256);
  for (int item = vb; item < total; item += G) {
    int mt = item & 63, nt = item >> 6;
    if (swz) { const int r = item >> 8, w = vb & 31; mt = (vb >> 5) * 8 + (w & 7); nt = r * 4 + (w >> 3); }
    const int m0 = mt * 256, n0 = nt * 256;
    f32x4 acc[8][4];
#pragma unroll
    for (int i = 0; i < 8; ++i)
#pragma unroll
      for (int j = 0; j < 4; ++j) acc[i][j] = f32x4{0.f, 0.f, 0.f, 0.f};
    gemm_mainloop_8w<(EPI == 0 || EPI == 2)>(A + (size_t)m0 * lda, lda, B + (size_t)n0 * ldb, ldb, K, acc, smem);
    if (EPI == 0 || EPI == 2) {
      constexpr int LDO = (EPI == 0) ? 2176 : 4096;
      u16* obase = (u16*)(p.ws + (EPI == 0 ? OFF_PABC : OFF_F)) + (size_t)(m0 + wm * 128 + fr) * LDO + n0 + wn * 64 + 8 * fq;
#pragma unroll
      for (int i = 0; i < 8; ++i) {
#pragma unroll
        for (int g2 = 0; g2 < 2; ++g2) {
          f32x4 a = acc[i][2 * g2], b = acc[i][2 * g2 + 1];
          if (EPI == 2) {
            a = __builtin_elementwise_max(a, f32x4{0.f, 0.f, 0.f, 0.f}); b = __builtin_elementwise_max(b, f32x4{0.f, 0.f, 0.f, 0.f});
            a = a * a; b = b * b;
          }
          const u32x4 o = u32x4{pack2(a[0], a[1]), pack2(a[2], a[3]), pack2(b[0], b[1]), pack2(b[2], b[3])};
          *(u32x4*)(obase + (size_t)(i * 16) * LDO + 32 * g2) = o;
        }
      }
    } else {
#pragma unroll
    for (int i = 0; i < 8; ++i) {
      const int m = m0 + wm * 128 + i * 16 + fr;
#pragma unroll
      for (int j = 0; j < 4; ++j) {
        const int n = n0 + wn * 64 + j * 16 + fq * 4;
        f32x4 v = acc[i][j];
        if (EPI == 0) {
          *(u32x2*)((u16*)(p.ws + OFF_PABC) + (size_t)m * 2176 + n) = u32x2{pack2(v[0], v[1]), pack2(v[2], v[3])};
        } else if (EPI == 1 || EPI == 3) {
          const int b = m >> 12;
          const float* gt = modl + (size_t)b * 6144 + (EPI == 1 ? 2048 : 5120) + n;
          const float* xin = ((EPI == 1 && l == 0) ? p.in[0] : p.out) + (size_t)m * 1024 + n;
          f32x4 x = *(const f32x4*)xin;
          f32x4 gg = *(const f32x4*)gt;
          *(f32x4*)(p.out + (size_t)m * 1024 + n) = x + gg * v;
        } else {
          float r0 = fmaxf(v[0], 0.f), r1 = fmaxf(v[1], 0.f), r2 = fmaxf(v[2], 0.f), r3 = fmaxf(v[3], 0.f);
          *(u32x2*)((u16*)(p.ws + OFF_F) + (size_t)m * 4096 + n) = u32x2{pack2(r0 * r0, r1 * r1), pack2(r2 * r2, r3 * r3)};
        }
      }
    }
    }
  }
}

template <int EPI>
__device__ __forceinline__ void phase_gemm(const Params& p, int l, int vb, unsigned char* smem_raw) {
  u16* smem = (u16*)smem_raw;
  const int lane = TIDX & 63, wv = TIDX >> 6;
  const int wm = wv >> 1, wn = wv & 1;
  const int fr = lane & 15, fq = lane >> 4;
  const u16* A; const u16* B; int lda, ldb, K, ntiles_n;
  if (EPI == 0) { A = (const u16*)(p.ws + OFF_H); lda = 1024; B = (const u16*)(p.ws + OFF_WIN); ldb = 1024; K = 1024; ntiles_n = 19; }
  if (EPI == 1) { A = (const u16*)(p.ws + OFF_MRG); lda = 1024; B = (const u16*)(p.ws + OFF_WO); ldb = 1024; K = 1024; ntiles_n = 8; }
  if (EPI == 2) { A = (const u16*)(p.ws + OFF_H); lda = 1024; B = (const u16*)(p.ws + OFF_W1); ldb = 1024; K = 1024; ntiles_n = 32; }
  if (EPI == 3) { A = (const u16*)(p.ws + OFF_F); lda = 4096; B = (const u16*)(p.ws + OFF_W2); ldb = 4096; K = 4096; ntiles_n = 8; }
  const float* modl = (const float*)(p.ws + OFF_MOD) + (size_t)l * 4 * 6144;
  const int G = VGRID;
  const bool swz = (G == 512);
  const int total = swz ? 128 * ((ntiles_n + 3) & ~3) : 128 * ntiles_n;
  for (int item = vb; item < total; item += G) {
    int mt = item & 127, nt = item >> 7;
    if (swz) { const int r = item >> 9, w = vb & 63; mt = (vb >> 6) * 16 + (w & 15); nt = r * 4 + (w >> 4); if (nt >= ntiles_n) continue; }
    const int m0 = mt * 128, n0 = nt * 128;
    f32x4 acc[4][4];
    zero_acc<4>(acc);
    gemm_mainloop<4>(A + (size_t)m0 * lda, lda, B + (size_t)n0 * ldb, ldb, K, acc, smem);
#pragma unroll
    for (int i = 0; i < 4; ++i) {
      const int m = m0 + wm * 64 + i * 16 + fr;
#pragma unroll
      for (int j = 0; j < 4; ++j) {
        const int n = n0 + wn * 64 + j * 16 + fq * 4;
        f32x4 v = acc[i][j];
        if (EPI == 0) {
          u32x2 o; o.x = pack2(v[0], v[1]); o.y = pack2(v[2], v[3]);
          if (n < 2176) *(u32x2*)((u16*)(p.ws + OFF_PABC) + (size_t)m * 2176 + n) = o;
          else *(u32x2*)((u16*)(p.ws + OFF_PD) + (size_t)m * 256 + (n - 2176)) = o;
        } else if (EPI == 1 || EPI == 3) {
          const int b = m >> 12;
          const float* gt = modl + (size_t)b * 6144 + (EPI == 1 ? 2048 : 5120) + n;
          const float* xin = ((EPI == 1 && l == 0) ? p.in[0] : p.out) + (size_t)m * 1024 + n;
          float4 x = *(const float4*)xin;
          float4 gg = *(const float4*)gt;
          float4 o;
          o.x = x.x + gg.x * v[0]; o.y = x.y + gg.y * v[1]; o.z = x.z + gg.z * v[2]; o.w = x.w + gg.w * v[3];
          *(float4*)(p.out + (size_t)m * 1024 + n) = o;
        } else {
          float r0 = fmaxf(v[0], 0.f), r1 = fmaxf(v[1], 0.f), r2 = fmaxf(v[2], 0.f), r3 = fmaxf(v[3], 0.f);
          u32x2 o; o.x = pack2(r0 * r0, r1 * r1); o.y = pack2(r2 * r2, r3 * r3);
          *(u32x2*)((u16*)(p.ws + OFF_F) + (size_t)m * 4096 + n) = o;
        }
      }
    }
  }
}

template <int MODE>
__device__ __forceinline__ void merge_tile(const Params& p, int item, unsigned char* smem_raw) {
  u16* smem = (u16*)smem_raw;
  const int lane = TIDX & 63, wv = TIDX >> 6;
  const int wm = wv >> 1, wn = wv & 1;
  const int fr = lane & 15, fq = lane >> 4;
  const u16* H = (const u16*)(p.ws + OFF_H);
  const u16* WIN = (const u16*)(p.ws + OFF_WIN);
  const int mt = item & 127, nt = item >> 7;
  const int m0 = mt * 128, n0 = nt * 128;
  f32x4 bacc[4][4];
  u32x2 gpk[4][4];
  u16* MRG = (u16*)(p.ws + OFF_MRG);
#pragma unroll 1
  for (int br = (MODE == 0 ? 1 : 0); br < (MODE == 0 ? 4 : 1); ++br) {
    zero_acc<4>(bacc);
    gemm_mainloop<4, true>(H + (size_t)m0 * 1024, 1024, WIN + (size_t)(2432 + br * 1024 + n0) * 1024, 1024, 1024, bacc, smem);
#pragma unroll
    for (int i = 0; i < 4; ++i)
#pragma unroll
      for (int j = 0; j < 4; ++j)
        gpk[i][j] = u32x2{pack2(sigmoidf_(bacc[i][j][0]), sigmoidf_(bacc[i][j][1])), pack2(sigmoidf_(bacc[i][j][2]), sigmoidf_(bacc[i][j][3]))};
    const u16* Ab; const u16* Wb;
    if (br == 0) { Ab = (const u16*)(p.ws + OFF_OG); Wb = (const u16*)(p.ws + OFF_RO); }
    else if (br == 1) { Ab = (const u16*)(p.ws + OFF_UB); Wb = (const u16*)(p.ws + OFF_SO); }
    else if (br == 2) { Ab = (const u16*)(p.ws + OFF_CB); Wb = (const u16*)(p.ws + OFF_CO); }
    else { Ab = (const u16*)(p.ws + OFF_YD); Wb = (const u16*)(p.ws + OFF_GLU); }
    if (MODE == 0 && br == 3) {
      zero_acc<4>(bacc);
      gemm_mainloop<4, true>(Ab + (size_t)m0 * 256, 256, Wb + (size_t)(1024 + n0) * 256, 256, 256, bacc, smem);
#pragma unroll
      for (int i = 0; i < 4; ++i)
#pragma unroll
        for (int j = 0; j < 4; ++j) {
          const float g0 = bflo(gpk[i][j].x) * sigmoidf_(bacc[i][j][0]), g1 = bfhi(gpk[i][j].x) * sigmoidf_(bacc[i][j][1]);
          const float g2 = bflo(gpk[i][j].y) * sigmoidf_(bacc[i][j][2]), g3 = bfhi(gpk[i][j].y) * sigmoidf_(bacc[i][j][3]);
          gpk[i][j] = u32x2{pack2(g0, g1), pack2(g2, g3)};
        }
    }
    zero_acc<4>(bacc);
    gemm_mainloop<4, true>(Ab + (size_t)m0 * 256, 256, Wb + (size_t)n0 * 256, 256, 256, bacc, smem);
#pragma unroll
    for (int i = 0; i < 4; ++i)
#pragma unroll
      for (int j = 0; j < 4; ++j) {
        u32x2* mp = (u32x2*)(MRG + (size_t)(m0 + wm * 64 + i * 16 + fr) * 1024 + n0 + wn * 64 + j * 16 + fq * 4);
        u32x2 cm = u32x2{0u, 0u};
        if (MODE == 1 || br > 1) cm = *mp;
        const float v0 = bflo(cm.x) + bflo(gpk[i][j].x) * bacc[i][j][0];
        const float v1 = bfhi(cm.x) + bfhi(gpk[i][j].x) * bacc[i][j][1];
        const float v2 = bflo(cm.y) + bflo(gpk[i][j].y) * bacc[i][j][2];
        const float v3 = bfhi(cm.y) + bfhi(gpk[i][j].y) * bacc[i][j][3];
        *mp = u32x2{pack2(v0, v1), pack2(v2, v3)};
      }
  }
}

__device__ __forceinline__ void gemm_mainloop_8n(const u16* __restrict__ A, int lda, const u16* __restrict__ B, int ldb,
                                                 int K, f32x4 (&acc)[4][4], u16* smem) {
  constexpr int STG = 24576;
  int tz = 0;
  asm volatile("" : "+v"(tz));
  const int tid = threadIdx.x + tz, lane = tid & 63, wv = tid >> 6;
  const int wm = wv >> 1, wn = wv & 1;
  const int lrow = tid >> 3;
  const int lchs = (tid & 7) ^ ((lrow >> 1) & 7);
  const u16* Ap = A + (size_t)lrow * lda + lchs * 8;
  const int rho = lrow & 31, pi = rho & 15;
  const u16* Bp = B + (size_t)((lrow & ~31) + 8 * (pi >> 2) + 4 * (rho >> 4) + (pi & 3)) * ldb + lchs * 8;
  const int nk = K >> 6;
  auto stage = [&](int kt, int buf) {
    const int ko = kt << 6;
    u16* sa = smem + buf * STG;
#pragma unroll
    for (int i = 0; i < 4; ++i)
      __builtin_amdgcn_global_load_lds((const unsigned*)(Ap + (size_t)(64 * i) * lda + ko),
                                       (__attribute__((address_space(3))) unsigned*)(sa + (tid + 512 * i) * 8), 16, 0, 0);
#pragma unroll
    for (int i = 0; i < 2; ++i)
      __builtin_amdgcn_global_load_lds((const unsigned*)(Bp + (size_t)(64 * i) * ldb + ko),
                                       (__attribute__((address_space(3))) unsigned*)(sa + 16384 + (tid + 512 * i) * 8), 16, 0, 0);
  };
  __syncthreads();
  stage(0, 0);
  stage(nk > 1 ? 1 : 0, 1);
  const int fr = lane & 15, fq = lane >> 4;
  const int sw = (fr >> 1) & 7;
  int cur = 0;
  for (int kt = 0; kt < nk; ++kt) {
    asm volatile("s_waitcnt vmcnt(6)" ::: "memory");
    __builtin_amdgcn_s_barrier();
    asm volatile("" ::: "memory");
    {
      int nx = cur + 2; if (nx >= 3) nx -= 3;
      int ktn = kt + 2; if (ktn >= nk) ktn = nk - 1;
      stage(ktn, nx);
    }
    const u16* cA = smem + cur * STG + (wm * 64 + fr) * 64;
    const u16* cB = smem + cur * STG + 16384 + (wn * 64 + fr) * 64;
#pragma unroll
    for (int ks = 0; ks < 2; ++ks) {
      const int pc = ((fq + 4 * ks) ^ sw) << 3;
      bf16x8 fa[4], fb[4];
#pragma unroll
      for (int i = 0; i < 4; ++i) fa[i] = *(const bf16x8*)(cA + i * 16 * 64 + pc);
#pragma unroll
      for (int j = 0; j < 4; ++j) fb[j] = *(const bf16x8*)(cB + j * 16 * 64 + pc);
#pragma unroll
      for (int i = 0; i < 4; ++i)
#pragma unroll
        for (int j = 0; j < 4; ++j)
          acc[i][j] = __builtin_amdgcn_mfma_f32_16x16x32_bf16(fb[j], fa[i], acc[i][j], 0, 0, 0);
    }
    cur = cur + 1; if (cur >= 3) cur = 0;
  }
  asm volatile("s_waitcnt vmcnt(0)" ::: "memory");
}

template <int MODE>
__device__ __forceinline__ void merge_tile8(const Params& p, int item, unsigned char* smem_raw) {
  u16* smem = (u16*)smem_raw;
  const int lane = threadIdx.x & 63, wv = threadIdx.x >> 6;
  const int wm = wv >> 1, wn = wv & 1;
  const int fr = lane & 15, fq = lane >> 4;
  const u16* H = (const u16*)(p.ws + OFF_H);
  const u16* WIN = (const u16*)(p.ws + OFF_WIN);
  const int mt = item & 63, nt = item >> 6;
  const int m0 = mt * 256, n0 = nt * 128;
  f32x4 bacc[4][4];
  u32x2 gpk[4][4];
  u16* MRG = (u16*)(p.ws + OFF_MRG);
#pragma unroll 1
  for (int br = (MODE == 0 ? 1 : 0); br < (MODE == 0 ? 4 : 1); ++br) {
    zero_acc<4>(bacc);
    gemm_mainloop_8n(H + (size_t)m0 * 1024, 1024, WIN + (size_t)(2432 + br * 1024 + n0) * 1024, 1024, 1024, bacc, smem);
#pragma unroll
    for (int i = 0; i < 4; ++i)
#pragma unroll
      for (int j = 0; j < 4; ++j)
        gpk[i][j] = u32x2{pack2(sigmoidf_(bacc[i][j][0]), sigmoidf_(bacc[i][j][1])), pack2(sigmoidf_(bacc[i][j][2]), sigmoidf_(bacc[i][j][3]))};
    const u16* Ab; const u16* Wb;
    if (br == 0) { Ab = (const u16*)(p.ws + OFF_OG); Wb = (const u16*)(p.ws + OFF_RO); }
    else if (br == 1) { Ab = (const u16*)(p.ws + OFF_UB); Wb = (const u16*)(p.ws + OFF_SO); }
    else if (br == 2) { Ab = (const u16*)(p.ws + OFF_CB); Wb = (const u16*)(p.ws + OFF_CO); }
    else { Ab = (const u16*)(p.ws + OFF_YD); Wb = (const u16*)(p.ws + OFF_GLU); }
    if (MODE == 0 && br == 3) {
      zero_acc<4>(bacc);
      gemm_mainloop_8n(Ab + (size_t)m0 * 256, 256, Wb + (size_t)(1024 + n0) * 256, 256, 256, bacc, smem);
#pragma unroll
      for (int i = 0; i < 4; ++i)
#pragma unroll
        for (int j = 0; j < 4; ++j) {
          const float g0 = bflo(gpk[i][j].x) * sigmoidf_(bacc[i][j][0]), g1 = bfhi(gpk[i][j].x) * sigmoidf_(bacc[i][j][1]);
          const float g2 = bflo(gpk[i][j].y) * sigmoidf_(bacc[i][j][2]), g3 = bfhi(gpk[i][j].y) * sigmoidf_(bacc[i][j][3]);
          gpk[i][j] = u32x2{pack2(g0, g1), pack2(g2, g3)};
        }
    }
    zero_acc<4>(bacc);
    gemm_mainloop_8n(Ab + (size_t)m0 * 256, 256, Wb + (size_t)n0 * 256, 256, 256, bacc, smem);
#pragma unroll
    for (int i = 0; i < 4; ++i)
#pragma unroll
      for (int g2 = 0; g2 < 2; ++g2) {
        u32x4* mp = (u32x4*)(MRG + (size_t)(m0 + wm * 64 + i * 16 + fr) * 1024 + n0 + wn * 64 + 32 * g2 + 8 * fq);
        u32x4 cm = u32x4{0u, 0u, 0u, 0u};
        if (MODE == 1 || br > 1) cm = *mp;
        const int ja = 2 * g2, jb = 2 * g2 + 1;
        const float v0 = bflo(cm.x) + bflo(gpk[i][ja].x) * bacc[i][ja][0];
        const float v1 = bfhi(cm.x) + bfhi(gpk[i][ja].x) * bacc[i][ja][1];
        const float v2 = bflo(cm.y) + bflo(gpk[i][ja].y) * bacc[i][ja][2];
        const float v3 = bfhi(cm.y) + bfhi(gpk[i][ja].y) * bacc[i][ja][3];
        const float v4 = bflo(cm.z) + bflo(gpk[i][jb].x) * bacc[i][jb][0];
        const float v5 = bfhi(cm.z) + bfhi(gpk[i][jb].x) * bacc[i][jb][1];
        const float v6 = bflo(cm.w) + bflo(gpk[i][jb].y) * bacc[i][jb][2];
        const float v7 = bfhi(cm.w) + bfhi(gpk[i][jb].y) * bacc[i][jb][3];
        *mp = u32x4{pack2(v0, v1), pack2(v2, v3), pack2(v4, v5), pack2(v6, v7)};
      }
  }
}

__device__ __forceinline__ void phase_pproj_tail(const Params& p, int vb, unsigned char* smem_raw) {
  u16* smem = (u16*)smem_raw;
  const int lane = threadIdx.x & 63, wv = threadIdx.x >> 6;
  const int wm = wv >> 1, wn = wv & 1;
  const int fr = lane & 15, fq = lane >> 4;
  const u16* A = (const u16*)(p.ws + OFF_H);
  const u16* B = (const u16*)(p.ws + OFF_WIN);
  const int G = gridDim.x;
  const int total = (G == 256) ? 256 : 192;
  for (int item = vb; item < total; item += G) {
    int mt = item & 63, nt = item >> 6;
    if (G == 256) { const int w = vb & 31; mt = (vb >> 5) * 8 + (w & 7); nt = w >> 3; if (nt >= 3) continue; }
    const int m0 = mt * 256, n0 = 2048 + nt * 128;
    f32x4 acc[4][4];
    zero_acc<4>(acc);
    gemm_mainloop_8n(A + (size_t)m0 * 1024, 1024, B + (size_t)n0 * 1024, 1024, 1024, acc, smem);
#pragma unroll
    for (int i = 0; i < 4; ++i) {
      const int m = m0 + wm * 64 + i * 16 + fr;
#pragma unroll
      for (int g2 = 0; g2 < 2; ++g2) {
        const int n = n0 + wn * 64 + 32 * g2 + 8 * fq;
        const f32x4 va = acc[i][2 * g2], vb2 = acc[i][2 * g2 + 1];
        const u32x4 o = u32x4{pack2(va[0], va[1]), pack2(va[2], va[3]), pack2(vb2[0], vb2[1]), pack2(vb2[2], vb2[3])};
        if (n < 2176) *(u32x4*)((u16*)(p.ws + OFF_PABC) + (size_t)m * 2176 + n) = o;
        else *(u32x4*)((u16*)(p.ws + OFF_PD) + (size_t)m * 256 + (n - 2176)) = o;
      }
    }
  }
}

__device__ __forceinline__ float shifted(const u16* __restrict__ P, int tok, int col, float mu) {
  float pv = bf2f(P[(size_t)tok * 2176 + col]);
  float pr = (tok & (SEQ - 1)) ? bf2f(P[(size_t)(tok - 1) * 2176 + col]) : 0.f;
  return pv + (pr - pv) * mu;
}

__device__ __forceinline__ void rwkv_prep_item(const Params& p, int l, int item, unsigned char* smem) {
  const int tid = TIDX, lane = tid & 63, wv = tid >> 6;
  const int fr = lane & 15, fq = lane >> 4;
  u16* sl = (u16*)smem;
  u16* sv = sl + 32 * 168;
  constexpr int SLS = 168, SVS = 264;
  const u16* P = (const u16*)(p.ws + OFF_PABC);
  const float* mu = p.in[6] + l * 896;
  const int tok0 = item * 32;
  {
    const int t = tid >> 3, c0 = (tid & 7) * 32;
    const u16* src = P + (size_t)(tok0 + t) * 2176 + 896 + 256 + c0;
    float sm = 0.f, ss = 0.f;
#pragma unroll
    for (int q = 0; q < 4; ++q) {
      const u32x4 raw = *(const u32x4*)(src + q * 8);
      float z;
      z = geluf_(bflo(raw.x)); sm += z; ss += z * z;  z = geluf_(bfhi(raw.x)); sm += z; ss += z * z;
      z = geluf_(bflo(raw.y)); sm += z; ss += z * z;  z = geluf_(bfhi(raw.y)); sm += z; ss += z * z;
      z = geluf_(bflo(raw.z)); sm += z; ss += z * z;  z = geluf_(bfhi(raw.z)); sm += z; ss += z * z;
      z = geluf_(bflo(raw.w)); sm += z; ss += z * z;  z = geluf_(bfhi(raw.w)); sm += z; ss += z * z;
    }
    sm += __shfl_xor(sm, 1, 64); ss += __shfl_xor(ss, 1, 64);
    sm += __shfl_xor(sm, 2, 64); ss += __shfl_xor(ss, 2, 64);
    sm += __shfl_xor(sm, 4, 64); ss += __shfl_xor(ss, 4, 64);
    const float mean = sm * (1.f / 256.f);
    const float var = fmaxf(ss * (1.f / 256.f) - mean * mean, 0.f);
    if ((tid & 7) == 0) *(f32x2*)((float*)(p.ws + OFF_SGST) + (size_t)(tok0 + t) * 2) = f32x2{mean, rsqrtf(var + 1e-5f)};
  }
  for (int idx = tid; idx < 32 * 128; idx += NTHR) {
    const int t = idx >> 7, ci = idx & 127;
    float v = shifted(P, tok0 + t, 768 + ci, mu[768 + ci]);
    if (ci < 32) v = tanhf_(v);
    else if (ci >= 64) v = sigmoidf_(v);
    sl[t * SLS + ci] = f2bf(v);
  }
  if (l > 0) {
    const int t = tid >> 3, c0 = (tid & 7) * 32;
    const int tok = tok0 + t;
    const bool hasp = (tok & (SEQ - 1)) != 0;
#pragma unroll
    for (int q = 0; q < 4; ++q) {
      const int c = c0 + q * 8;
      const u32x4 cur = *(const u32x4*)(P + (size_t)tok * 2176 + 512 + c);
      u32x4 prv = u32x4{0u, 0u, 0u, 0u};
      if (hasp) prv = *(const u32x4*)(P + (size_t)(tok - 1) * 2176 + 512 + c);
      const f32x4 m0 = *(const f32x4*)(mu + 512 + c), m1 = *(const f32x4*)(mu + 512 + c + 4);
      float o[8];
      o[0] = bflo(cur.x) + (bflo(prv.x) - bflo(cur.x)) * m0.x; o[1] = bfhi(cur.x) + (bfhi(prv.x) - bfhi(cur.x)) * m0.y;
      o[2] = bflo(cur.y) + (bflo(prv.y) - bflo(cur.y)) * m0.z; o[3] = bfhi(cur.y) + (bfhi(prv.y) - bfhi(cur.y)) * m0.w;
      o[4] = bflo(cur.z) + (bflo(prv.z) - bflo(cur.z)) * m1.x; o[5] = bfhi(cur.z) + (bfhi(prv.z) - bfhi(cur.z)) * m1.y;
      o[6] = bflo(cur.w) + (bflo(prv.w) - bflo(cur.w)) * m1.z; o[7] = bfhi(cur.w) + (bfhi(prv.w) - bfhi(cur.w)) * m1.w;
      *(u32x4*)(sv + t * SVS + c) = u32x4{pack2(o[0], o[1]), pack2(o[2], o[3]), pack2(o[4], o[5]), pack2(o[6], o[7])};
    }
  }
  __syncthreads();
  if (l > 0) {
    const int mf = wv >> 1, nf = wv & 1;
    const u16* v1t = (const u16*)(p.ws + OFF_LV1);
    f32x4 acc = f32x4{0.f, 0.f, 0.f, 0.f};
#pragma unroll
    for (int ks = 0; ks < 8; ++ks) {
      const bf16x8 fa = *(const bf16x8*)(sv + (mf * 16 + fr) * SVS + ks * 32 + fq * 8);
      const bf16x8 fb = *(const bf16x8*)(v1t + (size_t)(nf * 16 + fr) * 256 + ks * 32 + fq * 8);
      acc = __builtin_amdgcn_mfma_f32_16x16x32_bf16(fb, fa, acc, 0, 0, 0);
    }
    *(u32x2*)(sl + (mf * 16 + fr) * SLS + 128 + nf * 16 + fq * 4) = u32x2{pack2(acc[0], acc[1]), pack2(acc[2], acc[3])};
    __syncthreads();
  }
  const u16* w2t = (const u16*)(p.ws + OFF_LW2); const u16* a2t = (const u16*)(p.ws + OFF_LA2);
  const u16* g2t = (const u16*)(p.ws + OFF_LG2); const u16* v2t = (const u16*)(p.ws + OFF_LV2);
  u16* SR = (u16*)(p.ws + OFF_SR); u16* SK = (u16*)(p.ws + OFF_SK); u16* SV = (u16*)(p.ws + OFF_SV);
  u16* SKK = (u16*)(p.ws + OFF_SKK); u16* SA = (u16*)(p.ws + OFF_SA); float* SW = (float*)(p.ws + OFF_SW);
  u16* G = (u16*)(p.ws + OFF_G); u16* VF = (u16*)(p.ws + OFF_VF);
#pragma unroll 1
  for (int mf = 0; mf < 2; ++mf) {
    const u16* arow = sl + (mf * 16 + fr) * SLS + fq * 8;
    const bf16x8 aw = *(const bf16x8*)(arow), aa = *(const bf16x8*)(arow + 32);
    const bf16x8 ag0 = *(const bf16x8*)(arow + 64), ag1 = *(const bf16x8*)(arow + 96), av = *(const bf16x8*)(arow + 128);
    f32x4 cw[4], ca[4], cg[4], cv[4];
#pragma unroll
    for (int nf = 0; nf < 4; ++nf) {
      const int n = wv * 64 + (nf >> 1) * 32 + 8 * (fr >> 2) + 4 * (nf & 1) + (fr & 3);
      const f32x4 z = f32x4{0.f, 0.f, 0.f, 0.f};
      cw[nf] = __builtin_amdgcn_mfma_f32_16x16x32_bf16(*(const bf16x8*)(w2t + n * 32 + fq * 8), aw, z, 0, 0, 0);
      ca[nf] = __builtin_amdgcn_mfma_f32_16x16x32_bf16(*(const bf16x8*)(a2t + n * 32 + fq * 8), aa, z, 0, 0, 0);
      cg[nf] = __builtin_amdgcn_mfma_f32_16x16x32_bf16(*(const bf16x8*)(g2t + n * 64 + fq * 8), ag0, z, 0, 0, 0);
      cg[nf] = __builtin_amdgcn_mfma_f32_16x16x32_bf16(*(const bf16x8*)(g2t + n * 64 + 32 + fq * 8), ag1, cg[nf], 0, 0, 0);
      cv[nf] = z;
      if (l > 0) cv[nf] = __builtin_amdgcn_mfma_f32_16x16x32_bf16(*(const bf16x8*)(v2t + n * 32 + fq * 8), av, z, 0, 0, 0);
    }
    const int tok = tok0 + mf * 16 + fr;
    const bool hasp = (tok & (SEQ - 1)) != 0;
    float kkv[4][4], kmv[4][4], av4[4][4];
    float ss = 0.f;
#pragma unroll
    for (int g2 = 0; g2 < 2; ++g2) {
    u32x2 pr[2], pv[2], pg[2];
#pragma unroll
    for (int hh = 0; hh < 2; ++hh) {
      const int nf = 2 * g2 + hh;
      const int c = wv * 64 + 32 * g2 + 8 * fq + 4 * hh;
      const size_t o = (size_t)tok * 256 + c;
      const u16* pc = P + (size_t)tok * 2176 + c;
      const u32x2 r_c = *(const u32x2*)(pc), k_c = *(const u32x2*)(pc + 256), v_c = *(const u32x2*)(pc + 512);
      u32x2 r_p = u32x2{0u, 0u}, k_p = u32x2{0u, 0u}, v_p = u32x2{0u, 0u};
      if (hasp) { r_p = *(const u32x2*)(pc - 2176); k_p = *(const u32x2*)(pc - 2176 + 256); v_p = *(const u32x2*)(pc - 2176 + 512); }
      const f32x4 mur = *(const f32x4*)(mu + c), muk = *(const f32x4*)(mu + 256 + c), muv = *(const f32x4*)(mu + 512 + c);
      const f32x4 w0 = *(const f32x4*)(p.in[7] + l * 256 + c), a0 = *(const f32x4*)(p.in[9] + l * 256 + c);
      const f32x4 kkc = *(const f32x4*)(p.in[15] + l * 256 + c), kac = *(const f32x4*)(p.in[16] + l * 256 + c);
      f32x4 v0 = f32x4{0.f, 0.f, 0.f, 0.f};
      if (l > 0) v0 = *(const f32x4*)(p.in[12] + c);
      u32x2 vfraw = u32x2{0u, 0u};
      if (l > 0) vfraw = *(const u32x2*)(VF + o);
      float rr[4], kk_[4], vv[4], dec[4], gg[4];
#pragma unroll
      for (int e = 0; e < 4; ++e) {
        const unsigned rc = e < 2 ? r_c.x : r_c.y, rp = e < 2 ? r_p.x : r_p.y;
        const unsigned kc = e < 2 ? k_c.x : k_c.y, kp = e < 2 ? k_p.x : k_p.y;
        const unsigned vc = e < 2 ? v_c.x : v_c.y, vp = e < 2 ? v_p.x : v_p.y;
        const unsigned vfr = e < 2 ? vfraw.x : vfraw.y;
        const float rcf = (e & 1) ? bfhi(rc) : bflo(rc), rpf = (e & 1) ? bfhi(rp) : bflo(rp);
        const float kcf = (e & 1) ? bfhi(kc) : bflo(kc), kpf = (e & 1) ? bfhi(kp) : bflo(kp);
        const float vcf = (e & 1) ? bfhi(vc) : bflo(vc), vpf = (e & 1) ? bfhi(vp) : bflo(vp);
        const float r = rcf + (rpf - rcf) * mur[e];
        const float k = kcf + (kpf - kcf) * muk[e];
        float v = vcf + (vpf - vcf) * muv[e];
        const float wl = w0[e] + cw[nf][e];
        const float z = -wl;
        const float sp = (z > 15.f) ? z : __logf(1.f + __expf(z));
        dec[e] = __expf(-__expf(-sp - 0.5f));
        const float a = sigmoidf_(a0[e] + ca[nf][e]);
        gg[e] = cg[nf][e];
        if (l > 0) { const float vf = (e & 1) ? bfhi(vfr) : bflo(vfr); v = v + (vf - v) * sigmoidf_(v0[e] + cv[nf][e]); }
        const float kk = k * kkc[e];
        ss += kk * kk;
        rr[e] = r; vv[e] = v; kk_[e] = kk; kkv[nf][e] = kk;
        kmv[nf][e] = k * (1.f + (a - 1.f) * kac[e]); av4[nf][e] = a;
      }
      pr[hh] = u32x2{pack2(rr[0], rr[1]), pack2(rr[2], rr[3])};
      pv[hh] = u32x2{pack2(vv[0], vv[1]), pack2(vv[2], vv[3])};
      pg[hh] = u32x2{pack2(gg[0], gg[1]), pack2(gg[2], gg[3])};
      *(f32x4*)(SW + o) = f32x4{dec[0], dec[1], dec[2], dec[3]};
    }
      {
        const size_t o8 = (size_t)tok * 256 + wv * 64 + 32 * g2 + 8 * fq;
        *(u32x4*)(SR + o8) = u32x4{pr[0].x, pr[0].y, pr[1].x, pr[1].y};
        *(u32x4*)(SV + o8) = u32x4{pv[0].x, pv[0].y, pv[1].x, pv[1].y};
        if (l == 0) *(u32x4*)(VF + o8) = u32x4{pv[0].x, pv[0].y, pv[1].x, pv[1].y};
        *(u32x4*)(G + o8) = u32x4{pg[0].x, pg[0].y, pg[1].x, pg[1].y};
      }
    }
    ss += __shfl_xor(ss, 16, 64);
    ss += __shfl_xor(ss, 32, 64);
    const float inv = 1.f / fmaxf(sqrtf(ss), 1e-12f);
#pragma unroll
    for (int g2 = 0; g2 < 2; ++g2) {
      const size_t o8 = (size_t)tok * 256 + wv * 64 + 32 * g2 + 8 * fq;
      const int na = 2 * g2, nb2 = 2 * g2 + 1;
      *(u32x4*)(SKK + o8) = u32x4{pack2(kkv[na][0] * inv, kkv[na][1] * inv), pack2(kkv[na][2] * inv, kkv[na][3] * inv),
                                  pack2(kkv[nb2][0] * inv, kkv[nb2][1] * inv), pack2(kkv[nb2][2] * inv, kkv[nb2][3] * inv)};
      *(u32x4*)(SK + o8) = u32x4{pack2(kmv[na][0], kmv[na][1]), pack2(kmv[na][2], kmv[na][3]), pack2(kmv[nb2][0], kmv[nb2][1]), pack2(kmv[nb2][2], kmv[nb2][3])};
      *(u32x4*)(SA + o8) = u32x4{pack2(av4[na][0], av4[na][1]), pack2(av4[na][2], av4[na][3]), pack2(av4[nb2][0], av4[nb2][1]), pack2(av4[nb2][2], av4[nb2][3])};
    }
  }
  __syncthreads();
}

__device__ __forceinline__ void sg_item(const Params& p, int l, int item, unsigned char* smem) {
  const int tid = TIDX, lane = tid & 63, wv = tid >> 6;
  u16* vsT = (u16*)smem;
  float* smu = (float*)(smem + 16384);
  float* srs = smu + 128;
  const u16* P = (const u16*)(p.ws + OFF_PABC);
  const int g = item & 3, chn = item >> 2;
  const int tok0 = chn * 128;
  if (tid < 128) {
    const f32x2 ms = *(const f32x2*)((const float*)(p.ws + OFF_SGST) + (size_t)(tok0 + tid) * 2);
    smu[tid] = ms.x; srs[tid] = ms.y;
  }
  __syncthreads();
  {
    const int c = tid & 63, tb = tid >> 6;
    const float lw = p.in[21][l * 256 + g * 64 + c], lb = p.in[22][l * 256 + g * 64 + c];
#pragma unroll
    for (int j = 0; j < 4; ++j) {
      u16 raw[8];
#pragma unroll
      for (int e = 0; e < 8; ++e) raw[e] = P[(size_t)(tok0 + tb * 32 + j * 8 + e) * 2176 + 896 + 256 + g * 64 + c];
      float vv[8];
#pragma unroll
      for (int e = 0; e < 8; ++e) {
        const int t = tb * 32 + j * 8 + e;
        vv[e] = (geluf_(bf2f(raw[e])) - smu[t]) * srs[t] * lw + lb;
      }
      const int phys = (tb * 4 + j) ^ (c & 15);
      *(u32x4*)(vsT + c * 128 + phys * 8) = u32x4{pack2(vv[0], vv[1]), pack2(vv[2], vv[3]), pack2(vv[4], vv[5]), pack2(vv[6], vv[7])};
    }
  }
  __syncthreads();
  {
    const int fr = lane & 15, fq = lane >> 4;
    const u16* Wm = (const u16*)(p.ws + OFF_SGW) + (size_t)g * 128 * 128;
    f32x4 acc[2][4];
#pragma unroll
    for (int i = 0; i < 2; ++i)
#pragma unroll
      for (int j = 0; j < 4; ++j) acc[i][j] = f32x4{0.f, 0.f, 0.f, 0.f};
    for (int ks = 0; ks <= wv; ++ks) {
      bf16x8 fa[2], fb[4];
#pragma unroll
      for (int i = 0; i < 2; ++i) fa[i] = *(const bf16x8*)(Wm + (size_t)(32 * wv + 16 * i + fr) * 128 + ks * 32 + fq * 8);
#pragma unroll
      for (int j = 0; j < 4; ++j) fb[j] = *(const bf16x8*)(vsT + (j * 16 + fr) * 128 + (((ks * 4 + fq) ^ fr) << 3));
#pragma unroll
      for (int i = 0; i < 2; ++i)
#pragma unroll
        for (int j = 0; j < 4; ++j) acc[i][j] = __builtin_amdgcn_mfma_f32_16x16x32_bf16(fb[j], fa[i], acc[i][j], 0, 0, 0);
    }
    const float* bs = p.in[24] + ((size_t)l * 4 + g) * 128;
    u16* UB = (u16*)(p.ws + OFF_UB);
#pragma unroll
    for (int i = 0; i < 2; ++i) {
      const int t = 32 * wv + 16 * i + fr;
      const float bsv = bs[t];
#pragma unroll
      for (int j = 0; j < 4; ++j) {
        const int cc = j * 16 + fq * 4;
        u32x2 ur = *(const u32x2*)(P + (size_t)(tok0 + t) * 2176 + 896 + g * 64 + cc);
        float o0 = geluf_(bflo(ur.x)) * (acc[i][j][0] + bsv), o1 = geluf_(bfhi(ur.x)) * (acc[i][j][1] + bsv);
        float o2 = geluf_(bflo(ur.y)) * (acc[i][j][2] + bsv), o3 = geluf_(bfhi(ur.y)) * (acc[i][j][3] + bsv);
        *(u32x2*)(UB + (size_t)(tok0 + t) * 256 + g * 64 + cc) = u32x2{pack2(o0, o1), pack2(o2, o3)};
      }
    }
  }
  __syncthreads();
}

__device__ __forceinline__ void conv_item(const Params& p, int l, int item) {
  const int j = TIDX;
  const u16* P = (const u16*)(p.ws + OFF_PABC);
  u16* CB = (u16*)(p.ws + OFF_CB);
  const float c0 = p.in[26][(l * 3 + 0) * 256 + j], c1 = p.in[26][(l * 3 + 1) * 256 + j], c2 = p.in[26][(l * 3 + 2) * 256 + j];
  const int tok0 = item * 8;
  u16 rc[10], rx[10], rb[8];
  const bool first = (tok0 & (SEQ - 1)) == 0;
#pragma unroll
  for (int t = 0; t < 10; ++t) {
    const int tok = (first && t < 2) ? tok0 : tok0 + t - 2;
    const u16* q = P + (size_t)tok * 2176 + 1408;
    rc[t] = q[256 + j]; rx[t] = q[512 + j];
    if (t >= 2) rb[t - 2] = q[j];
  }
  float z[10];
#pragma unroll
  for (int t = 0; t < 10; ++t) z[t] = bf2f(rc[t]) * bf2f(rx[t]);
  if (first) { z[0] = 0.f; z[1] = 0.f; }
#pragma unroll
  for (int t = 0; t < 8; ++t) {
    float y = c0 * z[t] + c1 * z[t + 1] + c2 * z[t + 2];
    CB[(size_t)(tok0 + t) * 256 + j] = f2bf(bf2f(rb[t]) * y);
  }
}

__device__ __forceinline__ void s5_load_u(const u16* us, int t, int wv, float (&u)[16]) {
  const u32x4* q = (const u32x4*)(us + t * 64 + wv * 16);
  u32x4 a = q[0], b = q[1];
  u[0] = bflo(a.x); u[1] = bfhi(a.x); u[2] = bflo(a.y); u[3] = bfhi(a.y);
  u[4] = bflo(a.z); u[5] = bfhi(a.z); u[6] = bflo(a.w); u[7] = bfhi(a.w);
  u[8] = bflo(b.x); u[9] = bfhi(b.x); u[10] = bflo(b.y); u[11] = bfhi(b.y);
  u[12] = bflo(b.z); u[13] = bfhi(b.z); u[14] = bflo(b.w); u[15] = bfhi(b.w);
}
__device__ __forceinline__ void s5_stage_u(const u16* __restrict__ PD, int tok0, int gq, u16* us) {
#pragma unroll
  for (int i = 0; i < 2; ++i) {
    const int ch = TIDX + 256 * i;
    const int t = ch >> 3, part = ch & 7;
    *(u32x4*)(us + t * 64 + part * 8) = *(const u32x4*)(PD + (size_t)(tok0 + t) * 256 + gq * 64 + part * 8);
  }
}

__device__ __forceinline__ void s5a_item(const Params& p, int l, int item, unsigned char* smem) {
  const int lane = TIDX & 63, wv = TIDX >> 6;
  const int gq = item & 3, bc = item >> 2;
  const int g = gq * 4 + wv;
  const int tok0 = bc * 64;
  const u16* PD = (const u16*)(p.ws + OFF_PD);
  const float* ab = (const float*)(p.ws + OFF_S5AB) + ((size_t)(l * 16 + g) * 64 + lane) * 2;
  const float* bb = (const float*)(p.ws + OFF_S5BB) + ((size_t)(l * 16 + g) * 64 + lane) * 32;
  float bbr[16], bbi[16];
#pragma unroll
  for (int c = 0; c < 16; ++c) { bbr[c] = bb[c]; bbi[c] = bb[16 + c]; }
  const float abr = ab[0], abi = ab[1];
  float xr = 0.f, xi = 0.f;
  u16* us = (u16*)smem;
  s5_stage_u(PD, tok0, gq, us);
  __syncthreads();
#pragma unroll 4
  for (int t = 0; t < 64; ++t) {
    float u[16];
    s5_load_u(us, t, wv, u);
    float bur = 0.f, bui = 0.f;
#pragma unroll
    for (int c = 0; c < 16; ++c) { bur += bbr[c] * u[c]; bui += bbi[c] * u[c]; }
    float nr = abr * xr - abi * xi + bur;
    float ni = abr * xi + abi * xr + bui;
    xr = nr; xi = ni;
  }
  float2* E = (float2*)(p.ws + OFF_S5E);
  E[((size_t)bc * 16 + g) * 64 + lane] = make_float2(xr, xi);
  __syncthreads();
}

__device__ __forceinline__ void s5b_item(const Params& p, int l, int item, unsigned char* smem) {
  const int lane = TIDX & 63, wv = TIDX >> 6;
  const int gq = item & 3, bc = item >> 2;
  const int b = bc >> 6, ch = bc & 63;
  const int g = gq * 4 + wv;
  const int tok0 = bc * 64;
  u16* us = (u16*)(smem + 65536);
  s5_stage_u((const u16*)(p.ws + OFF_PD), tok0, gq, us);
  float* base = (float*)smem + wv * 4096;
  float* csr = base, *csi = base + 1024, *xsr = base + 2048, *xsi = base + 3072;
  const u16* PD = (const u16*)(p.ws + OFF_PD);
  const float* ab = (const float*)(p.ws + OFF_S5AB) + ((size_t)(l * 16 + g) * 64 + lane) * 2;
  const float* bb = (const float*)(p.ws + OFF_S5BB) + ((size_t)(l * 16 + g) * 64 + lane) * 32;
  const float* cre = p.in[32] + ((size_t)(l * 16 + g) * 16) * 64;
  const float* cim = p.in[33] + ((size_t)(l * 16 + g) * 16) * 64;
  for (int c = 0; c < 16; ++c) {
    csr[(lane >> 2) * 64 + c * 4 + (lane & 3)] = cre[c * 64 + lane];
    csi[(lane >> 2) * 64 + c * 4 + (lane & 3)] = cim[c * 64 + lane];
  }
  float bbr[16], bbi[16];
#pragma unroll
  for (int c = 0; c < 16; ++c) { bbr[c] = bb[c]; bbi[c] = bb[16 + c]; }
  const float abr = ab[0], abi = ab[1];
  float pr = abr, pi = abi;
#pragma unroll
  for (int s = 0; s < 6; ++s) { float nr = pr * pr - pi * pi, ni = 2.f * pr * pi; pr = nr; pi = ni; }
  float xr = 0.f, xi = 0.f;
  const float2* E = (const float2*)(p.ws + OFF_S5E);
  {
    const f32x2* Ev = (const f32x2*)E + ((size_t)(b * 64) * 16 + g) * 64 + lane;
    int c = 0;
    for (; c + 8 <= ch; c += 8) {
      f32x2 e[8];
#pragma unroll
      for (int k = 0; k < 8; ++k) e[k] = Ev[(size_t)(c + k) * 1024];
#pragma unroll
      for (int k = 0; k < 8; ++k) {
        const float nr = pr * xr - pi * xi + e[k].x;
        const float ni = pr * xi + pi * xr + e[k].y;
        xr = nr; xi = ni;
      }
    }
    for (; c < ch; ++c) {
      const f32x2 e = Ev[(size_t)c * 1024];
      const float nr = pr * xr - pi * xi + e.x;
      const float ni = pr * xi + pi * xr + e.y;
      xr = nr; xi = ni;
    }
  }
  const int tt = lane & 15, cq = lane >> 4;
  const float* dvec = p.in[34] + l * 256 + g * 16 + cq * 4;
  const float d0 = dvec[0], d1 = dvec[1], d2 = dvec[2], d3 = dvec[3];
  u16* YD = (u16*)(p.ws + OFF_YD);
  const int n4w = lane >> 2, e4 = lane & 3;
  __syncthreads();
#pragma unroll 1
  for (int sc = 0; sc < 4; ++sc) {
    for (int t = 0; t < 16; ++t) {
      float u[16];
      s5_load_u(us, sc * 16 + t, wv, u);
      float bur = 0.f, bui = 0.f;
#pragma unroll
      for (int c = 0; c < 16; ++c) { bur += bbr[c] * u[c]; bui += bbi[c] * u[c]; }
      float nr = abr * xr - abi * xi + bur;
      float ni = abr * xi + abi * xr + bui;
      xr = nr; xi = ni;
      int a = n4w * 64 + ((t ^ (n4w & 7)) << 2) + e4;
      xsr[a] = xr; xsi[a] = xi;
    }
    __syncthreads();
    float acc0 = 0.f, acc1 = 0.f, acc2 = 0.f, acc3 = 0.f;
#pragma unroll 2
    for (int n4 = 0; n4 < 16; ++n4) {
      int xa = n4 * 64 + ((tt ^ (n4 & 7)) << 2);
      float4 xr4 = *(const float4*)(xsr + xa);
      float4 xi4 = *(const float4*)(xsi + xa);
      const float* cr = csr + n4 * 64 + cq * 16;
      const float* ci = csi + n4 * 64 + cq * 16;
      float4 r0 = *(const float4*)(cr), r1 = *(const float4*)(cr + 4), r2 = *(const float4*)(cr + 8), r3 = *(const float4*)(cr + 12);
      float4 i0 = *(const float4*)(ci), i1 = *(const float4*)(ci + 4), i2 = *(const float4*)(ci + 8), i3 = *(const float4*)(ci + 12);
      acc0 += r0.x * xr4.x + r0.y * xr4.y + r0.z * xr4.z + r0.w * xr4.w - (i0.x * xi4.x + i0.y * xi4.y + i0.z * xi4.z + i0.w * xi4.w);
      acc1 += r1.x * xr4.x + r1.y * xr4.y + r1.z * xr4.z + r1.w * xr4.w - (i1.x * xi4.x + i1.y * xi4.y + i1.z * xi4.z + i1.w * xi4.w);
      acc2 += r2.x * xr4.x + r2.y * xr4.y + r2.z * xr4.z + r2.w * xr4.w - (i2.x * xi4.x + i2.y * xi4.y + i2.z * xi4.z + i2.w * xi4.w);
      acc3 += r3.x * xr4.x + r3.y * xr4.y + r3.z * xr4.z + r3.w * xr4.w - (i3.x * xi4.x + i3.y * xi4.y + i3.z * xi4.z + i3.w * xi4.w);
    }
    {
      const int tok = tok0 + sc * 16 + tt;
      u32x2 ur = *(const u32x2*)(us + (sc * 16 + tt) * 64 + wv * 16 + cq * 4);
      float y0 = acc0 + d0 * bflo(ur.x), y1 = acc1 + d1 * bfhi(ur.x), y2 = acc2 + d2 * bflo(ur.y), y3 = acc3 + d3 * bfhi(ur.y);
      u32x2 o; o.x = pack2(geluf_(y0), geluf_(y1)); o.y = pack2(geluf_(y2), geluf_(y3));
      *(u32x2*)(YD + (size_t)tok * 256 + g * 16 + cq * 4) = o;
    }
    __syncthreads();
  }
}

__device__ __forceinline__ void lds_barrier() {
  asm volatile("s_waitcnt lgkmcnt(0)" ::: "memory");
  __builtin_amdgcn_s_barrier();
  asm volatile("" ::: "memory");
}
__device__ __forceinline__ void scan_item(const Params& p, int item, unsigned char* smem) {
  const int tid = TIDX, lane = tid & 63, wv = tid >> 6;
  const int b = item >> 4, h = (item >> 2) & 3, q = item & 3;
  const int rl = lane >> 4, cl = lane & 15;
  const int rloc = wv * 4 + rl;
  const size_t tokb = (size_t)b * SEQ;
  const int chan0 = h * 64;
  const u16* SR = (const u16*)(p.ws + OFF_SR); const u16* SK = (const u16*)(p.ws + OFF_SK);
  const u16* SV = (const u16*)(p.ws + OFF_SV); const u16* SKK = (const u16*)(p.ws + OFF_SKK);
  const u16* SA = (const u16*)(p.ws + OFF_SA); const float* SW = (const float*)(p.ws + OFF_SW);
  float* O = (float*)(p.ws + OFF_O);
  constexpr int BUFF = 6432;
  float* lbase = (float*)smem;
  float* pp = lbase + 2 * BUFF + wv * 1024;
  const int st = tid >> 4, cg4 = tid & 15;
  struct Stg { u32x2 r, k, kk, a, kk1; f32x4 w; u16 v; };
  auto gload = [&](Stg& g, int c) {
    const size_t o = (tokb + (size_t)c * 16 + st) * 256 + chan0;
    g.r = *(const u32x2*)(SR + o + cg4 * 4); g.k = *(const u32x2*)(SK + o + cg4 * 4);
    g.kk = *(const u32x2*)(SKK + o + cg4 * 4); g.a = *(const u32x2*)(SA + o + cg4 * 4);
    g.w = *(const f32x4*)(SW + o + cg4 * 4);
    g.v = SV[o + q * 16 + cg4];
    int t1 = c * 16 + st + 1; if (t1 >= SEQ) t1 = SEQ - 1;
    g.kk1 = *(const u32x2*)(SKK + (tokb + (size_t)t1) * 256 + chan0 + cg4 * 4);
  };
  auto lwrite = [&](const Stg& g, int buf) {
    float* bp = lbase + buf * BUFF;
    const int o = st * 64 + cg4 * 4;
    f32x4 kk = {bflo(g.kk.x), bfhi(g.kk.x), bflo(g.kk.y), bfhi(g.kk.y)};
    f32x4 a = {bflo(g.a.x), bfhi(g.a.x), bflo(g.a.y), bfhi(g.a.y)};
    f32x4 k = {bflo(g.k.x), bfhi(g.k.x), bflo(g.k.y), bfhi(g.k.y)};
    f32x4 r = {bflo(g.r.x), bfhi(g.r.x), bflo(g.r.y), bfhi(g.r.y)};
    *(f32x4*)(bp + o) = kk;
    *(f32x4*)(bp + 1024 + o) = kk * a;
    *(f32x4*)(bp + 2048 + o) = k;
    *(f32x4*)(bp + 3072 + o) = g.w;
    *(f32x4*)(bp + 4096 + o) = r;
    bp[5120 + st * 16 + cg4] = bf2f(g.v);
    const f32x4 kn = {bflo(g.kk1.x), bfhi(g.kk1.x), bflo(g.kk1.y), bfhi(g.kk1.y)};
    *(f32x4*)(bp + 5376 + o) = g.w * kn;
    const f32x4 bb = kk * a;
    const float c1 = row_sum16(k.x * kn.x + k.y * kn.y + k.z * kn.z + k.w * kn.w);
    const float c2 = row_sum16(bb.x * kn.x + bb.y * kn.y + bb.z * kn.z + bb.w * kn.w);
    if (cg4 == 0) *(f32x2*)(bp + 6400 + st * 2) = f32x2{c1, c2};
  };
  constexpr int NCH = SEQ / 16;
  Stg R0, R1, R2, R3;
  gload(R0, 0); gload(R1, 1); gload(R2, 2); gload(R3, 3);
  __syncthreads();
  lwrite(R0, 0);
  __syncthreads();
  __builtin_amdgcn_s_setprio(3);
  float S0 = 0.f, S1 = 0.f, S2 = 0.f, S3 = 0.f;
  const int rrow = lane & 3, rstep = lane >> 2;
  struct Pair { f32x4 kkA, bbA, kA, wA, rA, mA, bbB, kB, wB, rB; f32x2 cA; float vA, vB; };
  auto chunk = [&](int c) {
    const float* bp = lbase + (c & 1) * BUFF;
    auto ldpair = [&](Pair& o, int s) {
      o.kkA = *(const f32x4*)(bp + s * 64 + cl * 4);
      o.mA = *(const f32x4*)(bp + 5376 + s * 64 + cl * 4);
      o.bbA = *(const f32x4*)(bp + 1024 + s * 64 + cl * 4);
      o.kA = *(const f32x4*)(bp + 2048 + s * 64 + cl * 4);
      o.wA = *(const f32x4*)(bp + 3072 + s * 64 + cl * 4);
      o.rA = *(const f32x4*)(bp + 4096 + s * 64 + cl * 4);
      o.vA = bp[5120 + s * 16 + rloc];
      o.cA = *(const f32x2*)(bp + 6400 + s * 2);
      o.bbB = *(const f32x4*)(bp + 1024 + (s + 1) * 64 + cl * 4);
      o.kB = *(const f32x4*)(bp + 2048 + (s + 1) * 64 + cl * 4);
      o.wB = *(const f32x4*)(bp + 3072 + (s + 1) * 64 + cl * 4);
      o.rB = *(const f32x4*)(bp + 4096 + (s + 1) * 64 + cl * 4);
      o.vB = bp[5120 + (s + 1) * 16 + rloc];
    };
    auto pairstep = [&](const Pair& o, int s) {
      const float pa = __builtin_fmaf(S3, o.kkA.w, __builtin_fmaf(S2, o.kkA.z, __builtin_fmaf(S1, o.kkA.y, S0 * o.kkA.x)));
      const float pd = __builtin_fmaf(S3, o.mA.w, __builtin_fmaf(S2, o.mA.z, __builtin_fmaf(S1, o.mA.y, S0 * o.mA.x)));
      const float saA = row_sum16(pa);
      const float dd = row_sum16(pd);
      const float saB = __builtin_fmaf(-saA, o.cA.y, __builtin_fmaf(o.vA, o.cA.x, dd));
      S0 = __builtin_fmaf(S0, o.wA.x, __builtin_fmaf(o.vA, o.kA.x, -(saA * o.bbA.x)));
      S1 = __builtin_fmaf(S1, o.wA.y, __builtin_fmaf(o.vA, o.kA.y, -(saA * o.bbA.y)));
      S2 = __builtin_fmaf(S2, o.wA.z, __builtin_fmaf(o.vA, o.kA.z, -(saA * o.bbA.z)));
      S3 = __builtin_fmaf(S3, o.wA.w, __builtin_fmaf(o.vA, o.kA.w, -(saA * o.bbA.w)));
      pp[(s * 4 + rl) * 16 + cl] = __builtin_fmaf(S3, o.rA.w, __builtin_fmaf(S2, o.rA.z, __builtin_fmaf(S1, o.rA.y, S0 * o.rA.x)));
      S0 = __builtin_fmaf(S0, o.wB.x, __builtin_fmaf(o.vB, o.kB.x, -(saB * o.bbB.x)));
      S1 = __builtin_fmaf(S1, o.wB.y, __builtin_fmaf(o.vB, o.kB.y, -(saB * o.bbB.y)));
      S2 = __builtin_fmaf(S2, o.wB.z, __builtin_fmaf(o.vB, o.kB.z, -(saB * o.bbB.z)));
      S3 = __builtin_fmaf(S3, o.wB.w, __builtin_fmaf(o.vB, o.kB.w, -(saB * o.bbB.w)));
      pp[((s + 1) * 4 + rl) * 16 + cl] = __builtin_fmaf(S3, o.rB.w, __builtin_fmaf(S2, o.rB.z, __builtin_fmaf(S1, o.rB.y, S0 * o.rB.x)));
    };
    Pair p0, p1;
    ldpair(p0, 0);
#pragma unroll
    for (int j = 0; j < 4; ++j) {
      ldpair(p1, 4 * j + 2);
      __builtin_amdgcn_sched_barrier(0);
      pairstep(p0, 4 * j);
      __builtin_amdgcn_sched_barrier(0);
      if (j < 3) ldpair(p0, 4 * j + 4);
      __builtin_amdgcn_sched_barrier(0);
      pairstep(p1, 4 * j + 2);
      __builtin_amdgcn_sched_barrier(0);
    }
    asm volatile("" ::: "memory");
    {
      const float* q0 = pp + (rstep * 4 + rrow) * 16;
      f32x4 a0 = *(const f32x4*)(q0), a1 = *(const f32x4*)(q0 + 4), a2 = *(const f32x4*)(q0 + 8), a3 = *(const f32x4*)(q0 + 12);
      f32x4 sm4 = (a0 + a1) + (a2 + a3);
      O[(tokb + (size_t)c * 16 + rstep) * 256 + chan0 + q * 16 + wv * 4 + rrow] = (sm4.x + sm4.y) + (sm4.z + sm4.w);
    }
    asm volatile("" ::: "memory");
  };
#pragma unroll 1
  for (int g = 0; g < NCH / 4; ++g) {
    const int c0 = g * 4;
    if (c0 + 4 < NCH) gload(R0, c0 + 4);
    chunk(c0);
    lwrite(R1, (c0 + 1) & 1);
    lds_barrier();
    if (c0 + 5 < NCH) gload(R1, c0 + 5);
    chunk(c0 + 1);
    lwrite(R2, (c0 + 2) & 1);
    lds_barrier();
    if (c0 + 6 < NCH) gload(R2, c0 + 6);
    chunk(c0 + 2);
    lwrite(R3, (c0 + 3) & 1);
    lds_barrier();
    if (c0 + 7 < NCH) gload(R3, c0 + 7);
    chunk(c0 + 3);
    if (c0 + 4 < NCH) lwrite(R0, (c0 + 4) & 1);
    lds_barrier();
  }
  __builtin_amdgcn_s_setprio(0);
}

__device__ __forceinline__ void rwkv_post_item(const Params& p, int l, int item) {
  const int j = TIDX;
  const float* O = (const float*)(p.ws + OFF_O);
  const u16* SR = (const u16*)(p.ws + OFF_SR); const u16* SK = (const u16*)(p.ws + OFF_SK);
  const u16* SV = (const u16*)(p.ws + OFF_SV); const u16* G = (const u16*)(p.ws + OFF_G);
  u16* OG = (u16*)(p.ws + OFF_OG);
  const float lw = p.in[18][l * 256 + j], lb = p.in[19][l * 256 + j], rk = p.in[17][l * 256 + j];
  const int tok0 = item * 8;
  float ov[8]; u16 rr[8], rkk[8], rv[8], rg[8];
#pragma unroll
  for (int t = 0; t < 8; ++t) {
    const size_t o = (size_t)(tok0 + t) * 256 + j;
    ov[t] = O[o]; rr[t] = SR[o]; rkk[t] = SK[o]; rv[t] = SV[o]; rg[t] = G[o];
  }
#pragma unroll
  for (int t = 0; t < 8; ++t) {
    const size_t o = (size_t)(tok0 + t) * 256 + j;
    float mean = wave_sum(ov[t]) * (1.f / 64.f);
    float d = ov[t] - mean;
    float var = wave_sum(d * d) * (1.f / 64.f);
    float on = d * rsqrtf(var + 64e-5f) * lw + lb;
    float bonus = wave_sum(bf2f(rr[t]) * bf2f(rkk[t]) * rk);
    OG[o] = f2bf((on + bonus * bf2f(rv[t])) * bf2f(rg[t]));
  }
}

#define XB_TMO      128
#define XB_XCNT(j)  (256  + 64 * (j))
#define XB_XSUB(j)  (1280 + 64 * (j))
#define XB_XGEN(j)  (2304 + 64 * (j))
#define XB_TOP      3328
#define XB_TOPGEN   3392
#define XCD_BAR_WORDS 3456
#define XB_SPIN_CAP (1u << 22)
#define LAS __attribute__((address_space(3)))
__device__ __forceinline__ unsigned xb_ld(unsigned* p) { return __hip_atomic_load(p, __ATOMIC_RELAXED, __HIP_MEMORY_SCOPE_AGENT); }
__device__ __forceinline__ unsigned xb_add(unsigned* p, unsigned v) { return __hip_atomic_fetch_add(p, v, __ATOMIC_RELAXED, __HIP_MEMORY_SCOPE_AGENT); }
__device__ __forceinline__ unsigned xb_xcc_id() { return (unsigned)__builtin_amdgcn_s_getreg((3 << 11) | 20) & 0xFu; }
#define XB_SPIN(cond, bar) do { unsigned _sp = 0; while (cond) { __builtin_amdgcn_s_sleep(1); \
    if ((++_sp & 255u) == 0u) { if (xb_ld(&(bar)[XB_TMO])) break; if (_sp > XB_SPIN_CAP) { atomicAdd(&(bar)[XB_TMO], 1u); break; } } } } while (0)
struct XcdBarrier { unsigned* bar; unsigned x; volatile LAS unsigned* st; };
__device__ __forceinline__ XcdBarrier xcd_barrier_post(unsigned* bar, volatile LAS unsigned* st) {
  XcdBarrier b; b.bar = bar; b.x = xb_xcc_id(); b.st = st;
  if (threadIdx.x == 0) st[2] = xb_add(&bar[XB_XCNT(b.x)], 1u);
  return b;
}
__device__ __forceinline__ void xcd_barrier_complete(unsigned* bar, unsigned x, unsigned& nloc, unsigned& nx) {
  const unsigned G = gridDim.x * gridDim.y * gridDim.z;
  unsigned sum, cnt, mine, sp = 0u;
  for (;;) {
    sum = 0u; cnt = 0u; mine = 0u;
#pragma unroll
    for (unsigned j = 0; j < 16; ++j) { const unsigned c = xb_ld(&bar[XB_XCNT(j)]); sum += c; cnt += (c > 0u) ? 1u : 0u; mine = (j == x) ? c : mine; }
    if (sum == G) break;
    __builtin_amdgcn_s_sleep(1);
    if ((++sp & 255u) == 0u) { if (xb_ld(&bar[XB_TMO])) break; if (sp > XB_SPIN_CAP) { atomicAdd(&bar[XB_TMO], 1u); break; } }
  }
  nloc = mine > 0u ? mine : 1u; nx = cnt > 0u ? cnt : 1u;
}
__device__ __forceinline__ void xcd_barrier(const XcdBarrier& b) {
  asm volatile("s_waitcnt vmcnt(0)" ::: "memory");
  __syncthreads();
  if (threadIdx.x == 0) {
    unsigned* bar = b.bar;
    __builtin_amdgcn_s_waitcnt(0);
    unsigned nloc = b.st[0], nx = b.st[1];
    if (nloc == 0u) { xcd_barrier_complete(bar, b.x, nloc, nx); b.st[0] = nloc; b.st[1] = nx; }
    const unsigned old = xb_add(&bar[XB_XSUB(b.x)], 1u);
    const unsigned gen = old / nloc;
    if (old + 1u == (gen + 1u) * nloc) {
      __builtin_amdgcn_fence(__ATOMIC_RELEASE, "agent");
      asm volatile("s_waitcnt vmcnt(0)" ::: "memory");
      const unsigned og = xb_add(&bar[XB_TOP], 1u);
      const unsigned tg = og / nx;
      if (og + 1u == (tg + 1u) * nx) xb_add(&bar[XB_TOPGEN], 1u);
      else XB_SPIN(xb_ld(&bar[XB_TOPGEN]) == tg, bar);
      __builtin_amdgcn_fence(__ATOMIC_ACQUIRE, "agent");
      xb_add(&bar[XB_XGEN(b.x)], 1u);
      asm volatile("s_waitcnt vmcnt(0)" ::: "memory");
    } else {
      XB_SPIN(xb_ld(&bar[XB_XGEN(b.x)]) == gen, bar);
      __builtin_amdgcn_fence(__ATOMIC_ACQUIRE, "agent");
      asm volatile("s_waitcnt vmcnt(0)" ::: "memory");
    }
  }
  __syncthreads();
}

__device__ __forceinline__ int xcd_virtual_id(const XcdBarrier& b) {
  if (threadIdx.x == 0) {
    unsigned base = 0u;
#pragma unroll
    for (unsigned j = 0; j < 16; ++j) { const unsigned c = xb_ld(&b.bar[XB_XCNT(j)]); base += (j < b.x) ? c : 0u; }
    b.st[3] = base + b.st[2];
  }
  __syncthreads();
  const int vb = __builtin_amdgcn_readfirstlane((int)b.st[3]);
  __syncthreads();
  return vb;
}

__device__ __forceinline__ void sub_barrier(unsigned* cnt, unsigned target) {
  asm volatile("s_waitcnt vmcnt(0)" ::: "memory");
  __syncthreads();
  if (threadIdx.x == 0) {
    __builtin_amdgcn_fence(__ATOMIC_RELEASE, "agent");
    asm volatile("s_waitcnt vmcnt(0)" ::: "memory");
    xb_add(cnt, 1u);
    unsigned sp = 0;
    while (xb_ld(cnt) < target) { __builtin_amdgcn_s_sleep(2); if (++sp > (1u << 24)) break; }
    __builtin_amdgcn_fence(__ATOMIC_ACQUIRE, "agent");
    asm volatile("s_waitcnt vmcnt(0)" ::: "memory");
  }
  __syncthreads();
}

#define N_PHASES 22
#ifndef PROBE_CONV_REPS
#define PROBE_CONV_REPS 1
#endif
#ifndef PROBE_PREP_REPS
#define PROBE_PREP_REPS 1
#endif
#ifndef PROBE_POST_REPS
#define PROBE_POST_REPS 1
#endif
#ifndef PROBE_SCAN_REPS
#define PROBE_SCAN_REPS 1
#endif
#ifndef PROBE_FFN1_REPS
#define PROBE_FFN1_REPS 1
#endif
#ifndef PH_MASK
#define PH_MASK 0xFFFFF
#endif
#define PHON(s) (PH_MASK & (1 << (s)))
#define PHASE_BEGIN(k) if (ph_hi > (k)) { if ((k) > 1) xcd_barrier(xb);
#define PHASE_END }

template <int L>
__device__ __forceinline__ void run_layer(const Params& p, int vbr, int ph_hi, unsigned char* smem_all, const XcdBarrier& xb) {
  unsigned char* smem = smem_all + SUBB * 73728;
  const int vb = vbr * 2 + SUBB;
  constexpr int l = L;
  constexpr int base = 1 + 10 * L;
  const float* modl = (const float*)(p.ws + OFF_MOD) + (size_t)l * 4 * 6144;
  PHASE_BEGIN(base + 0)
    for (int rep = 0; rep < PROBE_CONV_REPS; ++rep) {
      if (rep) xcd_barrier(xb);
      phase_convert(p, l, smem);
      phase_norm(l == 0 ? p.in[0] : p.out, p.in[4] + l * 1024, modl, 0, 1024, (u16*)(p.ws + OFF_H));
    }
  PHASE_END
  PHASE_BEGIN(base + 1)
    phase_pproj_tail(p, vbr, smem_all);
    phase_gemm_8w<0>(p, l, vbr, smem_all);
  PHASE_END
  PHASE_BEGIN(base + 2)
    for (int rep = 0; rep < PROBE_PREP_REPS; ++rep) {
      if (rep) xcd_barrier(xb);
      for (int item = VBLK; item < 512; item += VGRID) rwkv_prep_item(p, l, item, smem);
    }
  PHASE_END
  PHASE_BEGIN(base + 3)
    if ((int)blockIdx.x < 64) {
      if (SUBB == 0) scan_item(p, blockIdx.x, smem);
      else { __syncthreads(); __syncthreads(); for (int c = 0; c < SEQ / 16; ++c) lds_barrier(); }
    }
    else {
      const int nb = VGRID - 128, bi = VBLK - 128;
      for (int item = bi; item < 512; item += nb) sg_item(p, l, item, smem);
      for (int item = (bi + 2 * (nb / 3)) % nb; item < 1024; item += nb) s5a_item(p, l, item, smem);
      for (int item = (bi + 2 * (nb / 3)) % nb; item < 2048; item += nb) conv_item(p, l, item);
      sub_barrier((unsigned*)(p.ws + OFF_BAR) + 3520 + 64 * (2 * l), gridDim.x - 64);
      for (int item = bi; item < 1024; item += nb) s5b_item(p, l, item, smem);
      sub_barrier((unsigned*)(p.ws + OFF_BAR) + 3520 + 64 * (2 * l + 1), gridDim.x - 64);
      for (int item = (int)blockIdx.x - 64; item < 512; item += (int)gridDim.x - 64) merge_tile8<0>(p, item, smem_all);
    }
  PHASE_END
  PHASE_BEGIN(base + 4)
    for (int rep = 0; rep < PROBE_POST_REPS; ++rep) { if (rep) xcd_barrier(xb); for (int item = VBLK; item < 2048; item += VGRID) rwkv_post_item(p, l, item); }
  PHASE_END
  PHASE_BEGIN(base + 5)
    for (int item = vbr; item < 512; item += (int)gridDim.x) {
      int it2 = item;
      if (gridDim.x == 256) { const int r = item >> 8, w = vbr & 31; it2 = ((r * 4 + (w >> 3)) << 6) | ((vbr >> 5) * 8 + (w & 7)); }
      merge_tile8<1>(p, it2, smem_all);
    }
  PHASE_END
  PHASE_BEGIN(base + 6)
    phase_gemm_8w<1>(p, l, vbr, smem_all);
  PHASE_END
  PHASE_BEGIN(base + 7)
    if (PHON(7)) phase_norm(p.out, p.in[38] + l * 1024, modl, 3072, 4096, (u16*)(p.ws + OFF_H));
  PHASE_END
  PHASE_BEGIN(base + 8)
    phase_gemm_8w<2>(p, l, vbr, smem_all);
  PHASE_END
#ifdef PROBE_DUP_FFN1
  PHASE_BEGIN(base + 8)
    phase_gemm_8w<2>(p, l, vbr, smem_all);
  PHASE_END
#endif
  PHASE_BEGIN(base + 9)
    phase_gemm_8w<3>(p, l, vbr, smem_all);
  PHASE_END
}

__global__ void __launch_bounds__(512, 2) mega_fwd(Params p, int ph_lo, int ph_hi) {
  __shared__ __attribute__((aligned(16))) unsigned char smem[2 * 73728 + 16];
  cg::grid_group grid = cg::this_grid();
  if (ph_hi < 0) grid.sync();
  volatile LAS unsigned* st = (volatile LAS unsigned*)(smem + 2 * 73728);
  if (threadIdx.x == 0) { st[0] = 0u; st[1] = 0u; st[2] = 0u; st[3] = 0u; }
  __syncthreads();
  const XcdBarrier xb = xcd_barrier_post((unsigned*)(p.ws + OFF_BAR), st);
  if (ph_hi > 0) phase_mod(p, smem + SUBB * 73728);
  xcd_barrier(xb);
  const int vb = xcd_virtual_id(xb);
  run_layer<0>(p, vb, ph_hi, smem, xb);
  run_layer<1>(p, vb, ph_hi, smem, xb);
  PHASE_BEGIN(21)
    if (PHON(11)) phase_final(p.out, p.in[41]);
  PHASE_END
}

extern "C" void kernel_launch(void* const* d_in, const int* in_sizes, int n_in, void* d_out, int out_size, void* d_ws,
                              size_t ws_size, hipStream_t stream) {
  static int grid_blocks = 0;
  if (!grid_blocks) {
    int dev = 0, cus = 0, per_cu = 0;
    hipGetDevice(&dev);
    hipDeviceGetAttribute(&cus, hipDeviceAttributeMultiprocessorCount, dev);
    hipOccupancyMaxActiveBlocksPerMultiprocessor(&per_cu, mega_fwd, 512, 0);
    if (per_cu > 1) per_cu = 1;
    if (per_cu < 1) per_cu = 1;
    grid_blocks = cus * per_cu;
    if (ws_size < WS_END) fprintf(stderr, "workspace too small: %zu < %zu\n", ws_size, (size_t)WS_END);
  }
  Params p{};
  for (int i = 0; i < 42; ++i) p.in[i] = (const float*)d_in[i];
  p.out = (float*)d_out;
  p.ws = (unsigned char*)d_ws;
  hipMemsetAsync((unsigned char*)d_ws + OFF_BAR, 0, 16384, stream);
  int lo = 0, hi = N_PHASES;
  void* args[] = {&p, &lo, &hi};
  hipError_t e = hipLaunchCooperativeKernel((void*)mega_fwd, dim3(grid_blocks), dim3(512), args, 0, stream);
  if (e != hipSuccess) fprintf(stderr, "cooperative launch failed: %s (grid %d)\n", hipGetErrorString(e), grid_blocks);
}
```

```cpp
#include <hip/hip_runtime.h>
#include <hip/hip_cooperative_groups.h>
#include <cstdio>
namespace cg = cooperative_groups;

typedef unsigned short u16;
using bf16x8 = __attribute__((ext_vector_type(8))) short;
using f32x4 = __attribute__((ext_vector_type(4))) float;
using u32x4 = __attribute__((ext_vector_type(4))) unsigned int;
using u32x2 = __attribute__((ext_vector_type(2))) unsigned int;
using f32x2 = __attribute__((ext_vector_type(2))) float;

#define T_TOK 16384
#define SEQ 4096
#define DM 1024
#define NTHR 256
#define TIDX ((int)(threadIdx.x & 255))
#define SUBB ((int)(threadIdx.x >> 8))
#define VBLK ((int)(blockIdx.x * 2 + (threadIdx.x >> 8)))
#define VGRID ((int)(gridDim.x * 2))

static constexpr size_t SZ_WIN = (size_t)6528 * 1024 * 2;
static constexpr size_t OFF_WIN = 0;
static constexpr size_t OFF_RO = OFF_WIN + SZ_WIN;
static constexpr size_t OFF_SO = OFF_RO + 1024 * 256 * 2;
static constexpr size_t OFF_CO = OFF_SO + 1024 * 256 * 2;
static constexpr size_t OFF_GLU = OFF_CO + 1024 * 256 * 2;
static constexpr size_t OFF_WO = OFF_GLU + 2048 * 256 * 2;
static constexpr size_t OFF_W1 = OFF_WO + 1024 * 1024 * 2;
static constexpr size_t OFF_W2 = OFF_W1 + (size_t)4096 * 1024 * 2;
static constexpr size_t OFF_H = OFF_W2 + (size_t)4096 * 1024 * 2;
static constexpr size_t SZ_T256B = (size_t)T_TOK * 256 * 2;
static constexpr size_t OFF_VF = OFF_H + (size_t)T_TOK * 1024 * 2;
static constexpr size_t OFF_PD = OFF_VF + SZ_T256B;
static constexpr size_t OFF_G = OFF_PD + SZ_T256B;
static constexpr size_t OFF_UB = OFF_G + SZ_T256B;
static constexpr size_t OFF_CB = OFF_UB + SZ_T256B;
static constexpr size_t OFF_SR = OFF_CB + SZ_T256B;
static constexpr size_t OFF_SK = OFF_SR + SZ_T256B;
static constexpr size_t OFF_SV = OFF_SK + SZ_T256B;
static constexpr size_t OFF_SKK = OFF_SV + SZ_T256B;
static constexpr size_t OFF_SA = OFF_SKK + SZ_T256B;
static constexpr size_t OFF_SW = OFF_SA + SZ_T256B;
static constexpr size_t OFF_PABC = OFF_SW + 2 * SZ_T256B;
static constexpr size_t OFF_YD = OFF_PABC;
static constexpr size_t OFF_OG = OFF_YD + SZ_T256B;
static constexpr size_t OFF_MRG = OFF_OG + SZ_T256B;
static constexpr size_t OFF_F = OFF_UB;
static constexpr size_t OFF_SMALL = OFF_PABC + (size_t)T_TOK * 2176 * 2;
static constexpr size_t OFF_MOD = OFF_SMALL;
static constexpr size_t OFF_S5AB = OFF_MOD + 2 * 4 * 6144 * 4;
static constexpr size_t OFF_S5BB = OFF_S5AB + 2 * 16 * 64 * 2 * 4;
static constexpr size_t OFF_S5E = OFF_S5BB + 2 * 16 * 64 * 32 * 4;
static constexpr size_t OFF_BAR = OFF_S5E + (size_t)4 * 64 * 16 * 64 * 2 * 4;
static constexpr size_t OFF_SGW = OFF_BAR + 16384;
static constexpr size_t OFF_O = OFF_SGW + 4 * 128 * 128 * 2;
static constexpr size_t OFF_LW2 = OFF_O + 2 * SZ_T256B;
static constexpr size_t OFF_LA2 = OFF_LW2 + 256 * 32 * 2;
static constexpr size_t OFF_LG2 = OFF_LA2 + 256 * 32 * 2;
static constexpr size_t OFF_LV2 = OFF_LG2 + 256 * 64 * 2;
static constexpr size_t OFF_LV1 = OFF_LV2 + 256 * 32 * 2;
static constexpr size_t OFF_SGST = OFF_LV1 + 32 * 256 * 2;
static constexpr size_t WS_END = OFF_SGST + (size_t)T_TOK * 2 * 4;
static_assert(OFF_F + (size_t)T_TOK * 4096 * 2 <= OFF_SMALL, "F overlaps small region");
static_assert(OFF_MRG + (size_t)T_TOK * 1024 * 2 <= OFF_SMALL, "MRG overlaps");

struct Params {
  const float* in[42];
  float* out;
  unsigned char* ws;
};

__device__ __forceinline__ u16 f2bf(float f) {
  unsigned u = __float_as_uint(f);
  u += 0x7fffu + ((u >> 16) & 1u);
  return (u16)(u >> 16);
}
__device__ __forceinline__ float bf2f(u16 h) { return __uint_as_float(((unsigned)h) << 16); }
__device__ __forceinline__ float bflo(unsigned u) { return __uint_as_float(u << 16); }
__device__ __forceinline__ float bfhi(unsigned u) { return __uint_as_float(u & 0xffff0000u); }
__device__ __forceinline__ unsigned pack2(float a, float b) { return (unsigned)f2bf(a) | ((unsigned)f2bf(b) << 16); }
__device__ __forceinline__ float sigmoidf_(float x) { return 1.f / (1.f + __expf(-x)); }
__device__ __forceinline__ float tanhf_(float y) { return 1.f - 2.f / (1.f + __expf(2.f * y)); }
__device__ __forceinline__ float geluf_(float x) {
  float y = 0.7978845608028654f * (x + 0.044715f * x * x * x);
  return 0.5f * x * (1.f + tanhf_(y));
}
__device__ __forceinline__ float wave_sum(float v) {
#pragma unroll
  for (int o = 32; o > 0; o >>= 1) v += __shfl_xor(v, o, 64);
  return v;
}
template <int CTRL>
__device__ __forceinline__ float dppf(float x) {
  return __int_as_float(__builtin_amdgcn_update_dpp(__float_as_int(x), __float_as_int(x), CTRL, 0xF, 0xF, true));
}
__device__ __forceinline__ float row_sum16(float x) {
  x += dppf<0x128>(x);
  x += dppf<0x124>(x);
  x += dppf<0x122>(x);
  x += dppf<0x121>(x);
  return x;
}

__device__ __forceinline__ void phase_mod(const Params& p, unsigned char* smem) {
  const int tid = TIDX;
  float* cact = (float*)smem;
  float* red = cact + 4096;
  float* mod = (float*)(p.ws + OFF_MOD);
  for (int i = tid; i < 4096; i += NTHR) { float c = p.in[1][i]; cact[i] = c / (1.f + __expf(-c)); }
  __syncthreads();
  for (int item = VBLK; item < 192; item += VGRID) {
    int l = item / 96, nb = item % 96;
    int cl = tid & 63, kq = tid >> 6;
    int col = nb * 64 + cl;
    const float* W = p.in[2] + (size_t)l * 1024 * 6144;
    float a0 = 0, a1 = 0, a2 = 0, a3 = 0;
    for (int k = kq * 256; k < kq * 256 + 256; ++k) {
      float w = W[(size_t)k * 6144 + col];
      a0 += cact[k] * w; a1 += cact[1024 + k] * w; a2 += cact[2048 + k] * w; a3 += cact[3072 + k] * w;
    }
    red[(kq * 4 + 0) * 64 + cl] = a0; red[(kq * 4 + 1) * 64 + cl] = a1;
    red[(kq * 4 + 2) * 64 + cl] = a2; red[(kq * 4 + 3) * 64 + cl] = a3;
    __syncthreads();
    {
      int b = tid >> 6;
      float s = red[(0 * 4 + b) * 64 + cl] + red[(1 * 4 + b) * 64 + cl] + red[(2 * 4 + b) * 64 + cl] + red[(3 * 4 + b) * 64 + cl];
      mod[((size_t)l * 4 + b) * 6144 + col] = s + p.in[3][l * 6144 + col];
    }
    __syncthreads();
  }
  float* s5ab = (float*)(p.ws + OFF_S5AB);
  float* s5bb = (float*)(p.ws + OFF_S5BB);
  for (int idx = VBLK * NTHR + tid; idx < 2048; idx += VGRID * NTHR) {
    int l = idx >> 10, g = (idx >> 6) & 15, n = idx & 63;
    double lre = fmin((double)p.in[28][idx], -1e-4);
    double lim = (double)p.in[29][idx];
    double dt = exp((double)p.in[35][l * 16 + g]);
    double mag = exp(lre * dt);
    double abr = mag * cos(lim * dt), abi = mag * sin(lim * dt);
    double den = lre * lre + lim * lim;
    double qr = ((abr - 1.0) * lre + abi * lim) / den;
    double qi = (abi * lre - (abr - 1.0) * lim) / den;
    s5ab[idx * 2 + 0] = (float)abr; s5ab[idx * 2 + 1] = (float)abi;
    for (int c = 0; c < 16; ++c) {
      double br = p.in[30][(size_t)idx * 16 + c], bi = p.in[31][(size_t)idx * 16 + c];
      s5bb[(size_t)idx * 32 + c] = (float)(qr * br - qi * bi);
      s5bb[(size_t)idx * 32 + 16 + c] = (float)(qr * bi + qi * br);
    }
  }
}

__device__ __forceinline__ void convert_tile(const float* __restrict__ src, int K, int N, u16* __restrict__ dst, int tk, int tn, u16* sm) {
  const int tid = TIDX;
  int r = tid >> 4, c4 = (tid & 15) * 4;
#pragma unroll
  for (int i = 0; i < 4; ++i) {
    int kk = r + 16 * i;
    float4 v = *(const float4*)(src + (size_t)(tk * 64 + kk) * N + tn * 64 + c4);
    sm[(c4 + 0) * 72 + kk] = f2bf(v.x);
    sm[(c4 + 1) * 72 + kk] = f2bf(v.y);
    sm[(c4 + 2) * 72 + kk] = f2bf(v.z);
    sm[(c4 + 3) * 72 + kk] = f2bf(v.w);
  }
  __syncthreads();
#pragma unroll
  for (int j = 0; j < 2; ++j) {
    int n = (tid >> 3) + 32 * j, ch = tid & 7;
    u32x4 v = *(const u32x4*)(sm + n * 72 + ch * 8);
    *(u32x4*)(dst + (size_t)(tn * 64 + n) * K + tk * 64 + ch * 8) = v;
  }
  __syncthreads();
}

__device__ __forceinline__ void phase_convert(const Params& p, int l, unsigned char* smem) {
  u16* sm = (u16*)smem;
  const int total = 1632 + 192 + 128 + 256 + 1024 + 1024;
  for (int item = VBLK; item < total + 16 + 192; item += VGRID) {
    int t = item;
    if (t >= total + 16) {
      const int e = (t - total - 16) * 256 + TIDX;
      if (e < 8192) { const int n = e >> 5, k = e & 31; ((u16*)(p.ws + OFF_LW2))[e] = f2bf(p.in[8][(size_t)l * 8192 + k * 256 + n]); }
      else if (e < 16384) { const int q = e - 8192, n = q >> 5, k = q & 31; ((u16*)(p.ws + OFF_LA2))[q] = f2bf(p.in[10][(size_t)l * 8192 + k * 256 + n]); }
      else if (e < 32768) { const int q = e - 16384, n = q >> 6, k = q & 63; ((u16*)(p.ws + OFF_LG2))[q] = f2bf(p.in[11][(size_t)l * 16384 + k * 256 + n]); }
      else if (e < 40960) { const int q = e - 32768, n = q >> 5, k = q & 31; ((u16*)(p.ws + OFF_LV2))[q] = (l > 0) ? f2bf(p.in[14][k * 256 + n]) : (u16)0; }
      else { const int q = e - 40960, n = q >> 8, k = q & 255; ((u16*)(p.ws + OFF_LV1))[q] = (l > 0) ? f2bf(p.in[13][k * 32 + n]) : (u16)0; }
      continue;
    }
    if (t >= total) {
      const int idx = t - total, g = idx >> 2, rq = idx & 3;
      const int tr = rq * 32 + (TIDX >> 3), s0 = (TIDX & 7) * 16;
      const float* src = p.in[23] + (((size_t)l * 4 + g) * 128 + tr) * 128 + s0;
      u16* dst = (u16*)(p.ws + OFF_SGW) + ((size_t)g * 128 + tr) * 128 + s0;
      unsigned pk[8];
#pragma unroll
      for (int e = 0; e < 4; ++e) {
        f32x4 v = *(const f32x4*)(src + e * 4);
        const int sb = s0 + e * 4;
        pk[e * 2 + 0] = pack2(sb + 0 <= tr ? v.x : 0.f, sb + 1 <= tr ? v.y : 0.f);
        pk[e * 2 + 1] = pack2(sb + 2 <= tr ? v.z : 0.f, sb + 3 <= tr ? v.w : 0.f);
      }
      *(u32x4*)(dst) = u32x4{pk[0], pk[1], pk[2], pk[3]};
      *(u32x4*)(dst + 8) = u32x4{pk[4], pk[5], pk[6], pk[7]};
      continue;
    }
    const float* src; int K, N; size_t off;
    if (t < 1632) { src = p.in[5] + (size_t)l * 1024 * 6528; K = 1024; N = 6528; off = OFF_WIN; }
    else if ((t -= 1632) < 64) { src = p.in[20] + (size_t)l * 256 * 1024; K = 256; N = 1024; off = OFF_RO; }
    else if ((t -= 64) < 64) { src = p.in[25] + (size_t)l * 256 * 1024; K = 256; N = 1024; off = OFF_SO; }
    else if ((t -= 64) < 64) { src = p.in[27] + (size_t)l * 256 * 1024; K = 256; N = 1024; off = OFF_CO; }
    else if ((t -= 64) < 128) { src = p.in[36] + (size_t)l * 256 * 2048; K = 256; N = 2048; off = OFF_GLU; }
    else if ((t -= 128) < 256) { src = p.in[37] + (size_t)l * 1024 * 1024; K = 1024; N = 1024; off = OFF_WO; }
    else if ((t -= 256) < 1024) { src = p.in[39] + (size_t)l * 1024 * 4096; K = 1024; N = 4096; off = OFF_W1; }
    else { t -= 1024; src = p.in[40] + (size_t)l * 4096 * 1024; K = 4096; N = 1024; off = OFF_W2; }
    int ntn = N / 64;
    convert_tile(src, K, N, (u16*)(p.ws + off), t / ntn, t % ntn, sm);
  }
}

__device__ __forceinline__ void phase_norm(const float* __restrict__ X, const float* __restrict__ g, const float* __restrict__ modl,
                           int sh_off, int sc_off, u16* __restrict__ H) {
  const int lane = TIDX & 63, wv = TIDX >> 6;
  for (int item = VBLK; item < T_TOK / 4; item += VGRID) {
    int row = item * 4 + wv;
    int b = row >> 12;
    const float* xr = X + (size_t)row * 1024;
    float4 v[4];
    float ss = 0;
#pragma unroll
    for (int i = 0; i < 4; ++i) {
      v[i] = *(const float4*)(xr + lane * 4 + 256 * i);
      ss += v[i].x * v[i].x + v[i].y * v[i].y + v[i].z * v[i].z + v[i].w * v[i].w;
    }
    ss = wave_sum(ss);
    float rstd = rsqrtf(ss * (1.f / 1024.f) + 1e-6f);
    const float* sh = modl + (size_t)b * 6144 + sh_off;
    const float* sc = modl + (size_t)b * 6144 + sc_off;
#pragma unroll
    for (int i = 0; i < 4; ++i) {
      int c = lane * 4 + 256 * i;
      float4 gg = *(const float4*)(g + c);
      float4 s1 = *(const float4*)(sc + c);
      float4 s0 = *(const float4*)(sh + c);
      float h0 = v[i].x * rstd * gg.x * (1.f + s1.x) + s0.x;
      float h1 = v[i].y * rstd * gg.y * (1.f + s1.y) + s0.y;
      float h2 = v[i].z * rstd * gg.z * (1.f + s1.z) + s0.z;
      float h3 = v[i].w * rstd * gg.w * (1.f + s1.w) + s0.w;
      u32x2 o; o.x = pack2(h0, h1); o.y = pack2(h2, h3);
      *(u32x2*)(H + (size_t)row * 1024 + c) = o;
    }
  }
}

__device__ __forceinline__ void phase_final(float* __restrict__ X, const float* __restrict__ g) {
  const int lane = TIDX & 63, wv = TIDX >> 6;
  for (int item = VBLK; item < T_TOK / 4; item += VGRID) {
    int row = item * 4 + wv;
    float* xr = X + (size_t)row * 1024;
    float4 v[4];
    float ss = 0;
#pragma unroll
    for (int i = 0; i < 4; ++i) {
      v[i] = *(const float4*)(xr + lane * 4 + 256 * i);
      ss += v[i].x * v[i].x + v[i].y * v[i].y + v[i].z * v[i].z + v[i].w * v[i].w;
    }
    ss = wave_sum(ss);
    float rstd = rsqrtf(ss * (1.f / 1024.f) + 1e-6f);
#pragma unroll
    for (int i = 0; i < 4; ++i) {
      int c = lane * 4 + 256 * i;
      float4 gg = *(const float4*)(g + c);
      float4 o;
      o.x = v[i].x * rstd * gg.x; o.y = v[i].y * rstd * gg.y; o.z = v[i].z * rstd * gg.z; o.w = v[i].w * rstd * gg.w;
      *(float4*)(xr + c) = o;
    }
  }
}

template <int NF, bool LEAN = false>
__device__ __forceinline__ void gemm_mainloop(const u16* __restrict__ A, int lda, const u16* __restrict__ B, int ldb,
                                              int K, f32x4 (&acc)[4][NF], u16* smem) {
  constexpr int BN = 32 * NF;
  constexpr int NB = BN / 32;
  u16* sA = smem;
  u16* sB = smem + 2 * 128 * 64;
  int tz = 0;
  if (LEAN) asm volatile("" : "+v"(tz));
  const int tid = TIDX + tz, lane = tid & 63, wv = tid >> 6;
  const int wm = wv >> 1, wn = wv & 1;
  const int lrow = tid >> 3;
  const int lchs = (tid & 7) ^ ((lrow >> 1) & 7);
  const u16* Ap = A + (size_t)lrow * lda + lchs * 8;
  const u16* Bp = B + (size_t)lrow * ldb + lchs * 8;
  const int nk = K >> 6;
  auto stage = [&](int kt, int buf) {
    const int ko = kt << 6;
#pragma unroll
    for (int i = 0; i < 4; ++i)
      __builtin_amdgcn_global_load_lds((const unsigned*)(Ap + (size_t)(32 * i) * lda + ko),
                                       (__attribute__((address_space(3))) unsigned*)(sA + buf * (128 * 64) + (tid + 256 * i) * 8), 16, 0, 0);
#pragma unroll
    for (int i = 0; i < NB; ++i)
      __builtin_amdgcn_global_load_lds((const unsigned*)(Bp + (size_t)(32 * i) * ldb + ko),
                                       (__attribute__((address_space(3))) unsigned*)(sB + buf * (BN * 64) + (tid + 256 * i) * 8), 16, 0, 0);
  };
  __syncthreads();
  stage(0, 0);
  const int fr = lane & 15, fq = lane >> 4;
  const int sw = (fr >> 1) & 7;
  for (int kt = 0; kt < nk; ++kt) {
    const int cur = kt & 1;
    asm volatile("s_waitcnt vmcnt(0)" ::: "memory");
    __syncthreads();
    if (kt + 1 < nk) stage(kt + 1, cur ^ 1);
    const u16* cA = sA + cur * (128 * 64) + (wm * 64 + fr) * 64;
    const u16* cB = sB + cur * (BN * 64) + (wn * 16 * NF + fr) * 64;
#pragma unroll
    for (int ks = 0; ks < 2; ++ks) {
      if (LEAN) __builtin_amdgcn_sched_barrier(0);
      const int pc = ((fq + 4 * ks) ^ sw) << 3;
      bf16x8 fa[4], fb[NF];
#pragma unroll
      for (int i = 0; i < 4; ++i) fa[i] = *(const bf16x8*)(cA + i * 16 * 64 + pc);
#pragma unroll
      for (int j = 0; j < NF; ++j) fb[j] = *(const bf16x8*)(cB + j * 16 * 64 + pc);
#pragma unroll
      for (int i = 0; i < 4; ++i)
#pragma unroll
        for (int j = 0; j < NF; ++j)
          acc[i][j] = __builtin_amdgcn_mfma_f32_16x16x32_bf16(fb[j], fa[i], acc[i][j], 0, 0, 0);
    }
  }
}

template <int NF>
__device__ __forceinline__ void zero_acc(f32x4 (&acc)[4][NF]) {
#pragma unroll
  for (int i = 0; i < 4; ++i)
#pragma unroll
    for (int j = 0; j < NF; ++j) acc[i][j] = f32x4{0.f, 0.f, 0.f, 0.f};
}

template <bool PERM>
__device__ __forceinline__ void gemm_mainloop_8w(const u16* __restrict__ A, int lda, const u16* __restrict__ B, int ldb,
                                                 int K, f32x4 (&acc)[8][4], u16* smem) {
  constexpr int STG = 32768;
  const int tid = threadIdx.x, lane = tid & 63, wv = tid >> 6;
  const int wm = wv >> 2, wn = wv & 3;
  const int lrow = tid >> 3;
  const int lchs = (tid & 7) ^ ((lrow >> 1) & 7);
  const u16* Ap = A + (size_t)lrow * lda + lchs * 8;
  const int rho = lrow & 31, pi = rho & 15;
  const int brow = PERM ? ((lrow & ~31) + 8 * (pi >> 2) + 4 * (rho >> 4) + (pi & 3)) : lrow;
  const u16* Bp = B + (size_t)brow * ldb + lchs * 8;
  const int nk = K >> 6;
  auto stage = [&](int kt, int buf) {
    const int ko = kt << 6;
    u16* sa = smem + buf * STG;
#pragma unroll
    for (int i = 0; i < 4; ++i)
      __builtin_amdgcn_global_load_lds((const unsigned*)(Ap + (size_t)(64 * i) * lda + ko),
                                       (__attribute__((address_space(3))) unsigned*)(sa + (tid + 512 * i) * 8), 16, 0, 0);
#pragma unroll
    for (int i = 0; i < 4; ++i)
      __builtin_amdgcn_global_load_lds((const unsigned*)(Bp + (size_t)(64 * i) * ldb + ko),
                                       (__attribute__((address_space(3))) unsigned*)(sa + 16384 + (tid + 512 * i) * 8), 16, 0, 0);
  };
  __syncthreads();
  stage(0, 0);
  const int fr = lane & 15, fq = lane >> 4;
  const int sw = (fr >> 1) & 7;
  for (int kt = 0; kt < nk; ++kt) {
    const int cur = kt & 1;
    asm volatile("s_waitcnt vmcnt(0)" ::: "memory");
    __syncthreads();
    if (kt + 1 < nk) stage(kt + 1, cur ^ 1);
    const u16* cA = smem + cur * STG + (wm * 128 + fr) * 64;
    const u16* cB = smem + cur * STG + 16384 + (wn * 64 + fr) * 64;
#pragma unroll
    for (int ks = 0; ks < 2; ++ks) {
      const int pc = ((fq + 4 * ks) ^ sw) << 3;
      bf16x8 fa[8], fb[4];
#pragma unroll
      for (int i = 0; i < 8; ++i) fa[i] = *(const bf16x8*)(cA + i * 16 * 64 + pc);
#pragma unroll
      for (int j = 0; j < 4; ++j) fb[j] = *(const bf16x8*)(cB + j * 16 * 64 + pc);
#pragma unroll
      for (int i = 0; i < 8; ++i)
#pragma unroll
        for (int j = 0; j < 4; ++j)
          acc[i][j] = __builtin_amdgcn_mfma_f32_16x16x32_bf16(fb[j], fa[i], acc[i][j], 0, 0, 0);
    }
  }
}

template <int EPI>
__device__ __forceinline__ void phase_gemm_8w(const Params& p, int l, int vb, unsigned char* smem_raw) {
  u16* smem = (u16*)smem_raw;
  const int lane = threadIdx.x & 63, wv = threadIdx.x >> 6;
  const int wm = wv >> 2, wn = wv & 3;
  const int fr = lane & 15, fq = lane >> 4;
  const u16* A; const u16* B; int lda, ldb, K, ntiles_n;
  if (EPI == 0) { A = (const u16*)(p.ws + OFF_H); lda = 1024; B = (const u16*)(p.ws + OFF_WIN); ldb = 1024; K = 1024; ntiles_n = 8; }
  if (EPI == 1) { A = (const u16*)(p.ws + OFF_MRG); lda = 1024; B = (const u16*)(p.ws + OFF_WO); ldb = 1024; K = 1024; ntiles_n = 4; }
  if (EPI == 2) { A = (const u16*)(p.ws + OFF_H); lda = 1024; B = (const u16*)(p.ws + OFF_W1); ldb = 1024; K = 1024; ntiles_n = 16; }
  if (EPI == 3) { A = (const u16*)(p.ws + OFF_F); lda = 4096; B = (const u16*)(p.ws + OFF_W2); ldb = 4096; K = 4096; ntiles_n = 4; }
  const float* modl = (const float*)(p.ws + OFF_MOD) + (size_t)l * 4 * 6144;
  const int total = 64 * ntiles_n;
  const int G = gridDim.x;
  const bool swz = (G == 256);
  for (int item = vb; item < total; item += G) {
    int mt = item & 63, nt = item >> 6;
    if (swz) { const int r = item >> 8, w = vb & 31; mt = (vb >> 5) * 8 + (w & 7); nt = r * 4 + (w >> 3); }
    const int m0 = mt * 256, n0 = nt * 256;
    f32x4 acc[8][4];
#pragma unroll
    for (int i = 0; i < 8; ++i)
#pragma unroll
      for (int j = 0; j < 4; ++j) acc[i][j] = f32x4{0.f, 0.f, 0.f, 0.f};
    gemm_mainloop_8w<(EPI == 0 || EPI == 2)>(A + (size_t)m0 * lda, lda, B + (size_t)n0 * ldb, ldb, K, acc, smem);
    if (EPI == 0 || EPI == 2) {
      constexpr int LDO = (EPI == 0) ? 2176 : 4096;
      u16* obase = (u16*)(p.ws + (EPI == 0 ? OFF_PABC : OFF_F)) + (size_t)(m0 + wm * 128 + fr) * LDO + n0 + wn * 64 + 8 * fq;
#pragma unroll
      for (int i = 0; i < 8; ++i) {
#pragma unroll
        for (int g2 = 0; g2 < 2; ++g2) {
          f32x4 a = acc[i][2 * g2], b = acc[i][2 * g2 + 1];
          if (EPI == 2) {
            a = __builtin_elementwise_max(a, f32x4{0.f, 0.f, 0.f, 0.f}); b = __builtin_elementwise_max(b, f32x4{0.f, 0.f, 0.f, 0.f});
            a = a * a; b = b * b;
          }
          const u32x4 o = u32x4{pack2(a[0], a[1]), pack2(a[2], a[3]), pack2(b[0], b[1]), pack2(b[2], b[3])};
          *(u32x4*)(obase + (size_t)(i * 16) * LDO + 32 * g2) = o;
        }
      }
    } else {
#pragma unroll
    for (int i = 0; i < 8; ++i) {
      const int m = m0 + wm * 128 + i * 16 + fr;
#pragma unroll
      for (int j = 0; j < 4; ++j) {
        const int n = n0 + wn * 64 + j * 16 + fq * 4;
        f32x4 v = acc[i][j];
        if (EPI == 0) {
          *(u32x2*)((u16*)(p.ws + OFF_PABC) + (size_t)m * 2176 + n) = u32x2{pack2(v[0], v[1]), pack2(v[2], v[3])};
        } else if (EPI == 1 || EPI == 3) {
          const int b = m >> 12;
          const float* gt = modl + (size_t)b * 6144 + (EPI == 1 ? 2048 : 5120) + n;
          const float* xin = ((EPI == 1 && l == 0) ? p.in[0] : p.out) + (size_t)m * 1024 + n;
          f32x4 x = *(const f32x4*)xin;
          f32x4 gg = *(const f32x4*)gt;
          *(f32x4*)(p.out + (size_t)m * 1024 + n) = x + gg * v;
        } else {
          float r0 = fmaxf(v[0], 0.f), r1 = fmaxf(v[1], 0.f), r2 = fmaxf(v[2], 0.f), r3 = fmaxf(v[3], 0.f);
          *(u32x2*)((u16*)(p.ws + OFF_F) + (size_t)m * 4096 + n) = u32x2{pack2(r0 * r0, r1 * r1), pack2(r2 * r2, r3 * r3)};
        }
      }
    }
    }
  }
}

template <int EPI>
__device__ __forceinline__ void phase_gemm(const Params& p, int l, int vb, unsigned char* smem_raw) {
  u16* smem = (u16*)smem_raw;
  const int lane = TIDX & 63, wv = TIDX >> 6;
  const int wm = wv >> 1, wn = wv & 1;
  const int fr = lane & 15, fq = lane >> 4;
  const u16* A; const u16* B; int lda, ldb, K, ntiles_n;
  if (EPI == 0) { A = (const u16*)(p.ws + OFF_H); lda = 1024; B = (const u16*)(p.ws + OFF_WIN); ldb = 1024; K = 1024; ntiles_n = 19; }
  if (EPI == 1) { A = (const u16*)(p.ws + OFF_MRG); lda = 1024; B = (const u16*)(p.ws + OFF_WO); ldb = 1024; K = 1024; ntiles_n = 8; }
  if (EPI == 2) { A = (const u16*)(p.ws + OFF_H); lda = 1024; B = (const u16*)(p.ws + OFF_W1); ldb = 1024; K = 1024; ntiles_n = 32; }
  if (EPI == 3) { A = (const u16*)(p.ws + OFF_F); lda = 4096; B = (const u16*)(p.ws + OFF_W2); ldb = 4096; K = 4096; ntiles_n = 8; }
  const float* modl = (const float*)(p.ws + OFF_MOD) + (size_t)l * 4 * 6144;
  const int G = VGRID;
  const bool swz = (G == 512);
  const int total = swz ? 128 * ((ntiles_n + 3) & ~3) : 128 * ntiles_n;
  for (int item = vb; item < total; item += G) {
    int mt = item & 127, nt = item >> 7;
    if (swz) { const int r = item >> 9, w = vb & 63; mt = (vb >> 6) * 16 + (w & 15); nt = r * 4 + (w >> 4); if (nt >= ntiles_n) continue; }
    const int m0 = mt * 128, n0 = nt * 128;
    f32x4 acc[4][4];
    zero_acc<4>(acc);
    gemm_mainloop<4>(A + (size_t)m0 * lda, lda, B + (size_t)n0 * ldb, ldb, K, acc, smem);
#pragma unroll
    for (int i = 0; i < 4; ++i) {
      const int m = m0 + wm * 64 + i * 16 + fr;
#pragma unroll
      for (int j = 0; j < 4; ++j) {
        const int n = n0 + wn * 64 + j * 16 + fq * 4;
        f32x4 v = acc[i][j];
        if (EPI == 0) {
          u32x2 o; o.x = pack2(v[0], v[1]); o.y = pack2(v[2], v[3]);
          if (n < 2176) *(u32x2*)((u16*)(p.ws + OFF_PABC) + (size_t)m * 2176 + n) = o;
          else *(u32x2*)((u16*)(p.ws + OFF_PD) + (size_t)m * 256 + (n - 2176)) = o;
        } else if (EPI == 1 || EPI == 3) {
          const int b = m >> 12;
          const float* gt = modl + (size_t)b * 6144 + (EPI == 1 ? 2048 : 5120) + n;
          const float* xin = ((EPI == 1 && l == 0) ? p.in[0] : p.out) + (size_t)m * 1024 + n;
          float4 x = *(const float4*)xin;
          float4 gg = *(const float4*)gt;
          float4 o;
          o.x = x.x + gg.x * v[0]; o.y = x.y + gg.y * v[1]; o.z = x.z + gg.z * v[2]; o.w = x.w + gg.w * v[3];
          *(float4*)(p.out + (size_t)m * 1024 + n) = o;
        } else {
          float r0 = fmaxf(v[0], 0.f), r1 = fmaxf(v[1], 0.f), r2 = fmaxf(v[2], 0.f), r3 = fmaxf(v[3], 0.f);
          u32x2 o; o.x = pack2(r0 * r0, r1 * r1); o.y = pack2(r2 * r2, r3 * r3);
          *(u32x2*)((u16*)(p.ws + OFF_F) + (size_t)m * 4096 + n) = o;
        }
      }
    }
  }
}

template <int MODE>
__device__ __forceinline__ void merge_tile(const Params& p, int item, unsigned char* smem_raw) {
  u16* smem = (u16*)smem_raw;
  const int lane = TIDX & 63, wv = TIDX >> 6;
  const int wm = wv >> 1, wn = wv & 1;
  const int fr = lane & 15, fq = lane >> 4;
  const u16* H = (const u16*)(p.ws + OFF_H);
  const u16* WIN = (const u16*)(p.ws + OFF_WIN);
  const int mt = item & 127, nt = item >> 7;
  const int m0 = mt * 128, n0 = nt * 128;
  f32x4 bacc[4][4];
  u32x2 gpk[4][4];
  u16* MRG = (u16*)(p.ws + OFF_MRG);
#pragma unroll 1
  for (int br = (MODE == 0 ? 1 : 0); br < (MODE == 0 ? 4 : 1); ++br) {
    zero_acc<4>(bacc);
    gemm_mainloop<4, true>(H + (size_t)m0 * 1024, 1024, WIN + (size_t)(2432 + br * 1024 + n0) * 1024, 1024, 1024, bacc, smem);
#pragma unroll
    for (int i = 0; i < 4; ++i)
#pragma unroll
      for (int j = 0; j < 4; ++j)
        gpk[i][j] = u32x2{pack2(sigmoidf_(bacc[i][j][0]), sigmoidf_(bacc[i][j][1])), pack2(sigmoidf_(bacc[i][j][2]), sigmoidf_(bacc[i][j][3]))};
    const u16* Ab; const u16* Wb;
    if (br == 0) { Ab = (const u16*)(p.ws + OFF_OG); Wb = (const u16*)(p.ws + OFF_RO); }
    else if (br == 1) { Ab = (const u16*)(p.ws + OFF_UB); Wb = (const u16*)(p.ws + OFF_SO); }
    else if (br == 2) { Ab = (const u16*)(p.ws + OFF_CB); Wb = (const u16*)(p.ws + OFF_CO); }
    else { Ab = (const u16*)(p.ws + OFF_YD); Wb = (const u16*)(p.ws + OFF_GLU); }
    if (MODE == 0 && br == 3) {
      zero_acc<4>(bacc);
      gemm_mainloop<4, true>(Ab + (size_t)m0 * 256, 256, Wb + (size_t)(1024 + n0) * 256, 256, 256, bacc, smem);
#pragma unroll
      for (int i = 0; i < 4; ++i)
#pragma unroll
        for (int j = 0; j < 4; ++j) {
          const float g0 = bflo(gpk[i][j].x) * sigmoidf_(bacc[i][j][0]), g1 = bfhi(gpk[i][j].x) * sigmoidf_(bacc[i][j][1]);
          const float g2 = bflo(gpk[i][j].y) * sigmoidf_(bacc[i][j][2]), g3 = bfhi(gpk[i][j].y) * sigmoidf_(bacc[i][j][3]);
          gpk[i][j] = u32x2{pack2(g0, g1), pack2(g2, g3)};
        }
    }
    zero_acc<4>(bacc);
    gemm_mainloop<4, true>(Ab + (size_t)m0 * 256, 256, Wb + (size_t)n0 * 256, 256, 256, bacc, smem);
#pragma unroll
    for (int i = 0; i < 4; ++i)
#pragma unroll
      for (int j = 0; j < 4; ++j) {
        u32x2* mp = (u32x2*)(MRG + (size_t)(m0 + wm * 64 + i * 16 + fr) * 1024 + n0 + wn * 64 + j * 16 + fq * 4);
        u32x2 cm = u32x2{0u, 0u};
        if (MODE == 1 || br > 1) cm = *mp;
        const float v0 = bflo(cm.x) + bflo(gpk[i][j].x) * bacc[i][j][0];
        const float v1 = bfhi(cm.x) + bfhi(gpk[i][j].x) * bacc[i][j][1];
        const float v2 = bflo(cm.y) + bflo(gpk[i][j].y) * bacc[i][j][2];
        const float v3 = bfhi(cm.y) + bfhi(gpk[i][j].y) * bacc[i][j][3];
        *mp = u32x2{pack2(v0, v1), pack2(v2, v3)};
      }
  }
}

__device__ __forceinline__ void gemm_mainloop_8n(const u16* __restrict__ A, int lda, const u16* __restrict__ B, int ldb,
                                                 int K, f32x4 (&acc)[4][4], u16* smem) {
  constexpr int STG = 24576;
  int tz = 0;
  asm volatile("" : "+v"(tz));
  const int tid = threadIdx.x + tz, lane = tid & 63, wv = tid >> 6;
  const int wm = wv >> 1, wn = wv & 1;
  const int lrow = tid >> 3;
  const int lchs = (tid & 7) ^ ((lrow >> 1) & 7);
  const u16* Ap = A + (size_t)lrow * lda + lchs * 8;
  const int rho = lrow & 31, pi = rho & 15;
  const u16* Bp = B + (size_t)((lrow & ~31) + 8 * (pi >> 2) + 4 * (rho >> 4) + (pi & 3)) * ldb + lchs * 8;
  const int nk = K >> 6;
  auto stage = [&](int kt, int buf) {
    const int ko = kt << 6;
    u16* sa = smem + buf * STG;
#pragma unroll
    for (int i = 0; i < 4; ++i)
      __builtin_amdgcn_global_load_lds((const unsigned*)(Ap + (size_t)(64 * i) * lda + ko),
                                       (__attribute__((address_space(3))) unsigned*)(sa + (tid + 512 * i) * 8), 16, 0, 0);
#pragma unroll
    for (int i = 0; i < 2; ++i)
      __builtin_amdgcn_global_load_lds((const unsigned*)(Bp + (size_t)(64 * i) * ldb + ko),
                                       (__attribute__((address_space(3))) unsigned*)(sa + 16384 + (tid + 512 * i) * 8), 16, 0, 0);
  };
  __syncthreads();
  stage(0, 0);
  stage(nk > 1 ? 1 : 0, 1);
  const int fr = lane & 15, fq = lane >> 4;
  const int sw = (fr >> 1) & 7;
  int cur = 0;
  for (int kt = 0; kt < nk; ++kt) {
    asm volatile("s_waitcnt vmcnt(6)" ::: "memory");
    __builtin_amdgcn_s_barrier();
    asm volatile("" ::: "memory");
    {
      int nx = cur + 2; if (nx >= 3) nx -= 3;
      int ktn = kt + 2; if (ktn >= nk) ktn = nk - 1;
      stage(ktn, nx);
    }
    const u16* cA = smem + cur * STG + (wm * 64 + fr) * 64;
    const u16* cB = smem + cur * STG + 16384 + (wn * 64 + fr) * 64;
#pragma unroll
    for (int ks = 0; ks < 2; ++ks) {
      const int pc = ((fq + 4 * ks) ^ sw) << 3;
      bf16x8 fa[4], fb[4];
#pragma unroll
      for (int i = 0; i < 4; ++i) fa[i] = *(const bf16x8*)(cA + i * 16 * 64 + pc);
#pragma unroll
      for (int j = 0; j < 4; ++j) fb[j] = *(const bf16x8*)(cB + j * 16 * 64 + pc);
#pragma unroll
      for (int i = 0; i < 4; ++i)
#pragma unroll
        for (int j = 0; j < 4; ++j)
          acc[i][j] = __builtin_amdgcn_mfma_f32_16x16x32_bf16(fb[j], fa[i], acc[i][j], 0, 0, 0);
    }
    cur = cur + 1; if (cur >= 3) cur = 0;
  }
  asm volatile("s_waitcnt vmcnt(0)" ::: "memory");
}

template <int MODE>
__device__ __forceinline__ void merge_tile8(const Params& p, int item, unsigned char* smem_raw) {
  u16* smem = (u16*)smem_raw;
  const int lane = threadIdx.x & 63, wv = threadIdx.x >> 6;
  const int wm = wv >> 1, wn = wv & 1;
  const int fr = lane & 15, fq = lane >> 4;
  const u16* H = (const u16*)(p.ws + OFF_H);
  const u16* WIN = (const u16*)(p.ws + OFF_WIN);
  const int mt = item & 63, nt = item >> 6;
  const int m0 = mt * 256, n0 = nt * 128;
  f32x4 bacc[4][4];
  u32x2 gpk[4][4];
  u16* MRG = (u16*)(p.ws + OFF_MRG);
#pragma unroll 1
  for (int br = (MODE == 0 ? 1 : 0); br < (MODE == 0 ? 4 : 1); ++br) {
    zero_acc<4>(bacc);
    gemm_mainloop_8n(H + (size_t)m0 * 1024, 1024, WIN + (size_t)(2432 + br * 1024 + n0) * 1024, 1024, 1024, bacc, smem);
#pragma unroll
    for (int i = 0; i < 4; ++i)
#pragma unroll
      for (int j = 0; j < 4; ++j)
        gpk[i][j] = u32x2{pack2(sigmoidf_(bacc[i][j][0]), sigmoidf_(bacc[i][j][1])), pack2(sigmoidf_(bacc[i][j][2]), sigmoidf_(bacc[i][j][3]))};
    const u16* Ab; const u16* Wb;
    if (br == 0) { Ab = (const u16*)(p.ws + OFF_OG); Wb = (const u16*)(p.ws + OFF_RO); }
    else if (br == 1) { Ab = (const u16*)(p.ws + OFF_UB); Wb = (const u16*)(p.ws + OFF_SO); }
    else if (br == 2) { Ab = (const u16*)(p.ws + OFF_CB); Wb = (const u16*)(p.ws + OFF_CO); }
    else { Ab = (const u16*)(p.ws + OFF_YD); Wb = (const u16*)(p.ws + OFF_GLU); }
    if (MODE == 0 && br == 3) {
      zero_acc<4>(bacc);
      gemm_mainloop_8n(Ab + (size_t)m0 * 256, 256, Wb + (size_t)(1024 + n0) * 256, 256, 256, bacc, smem);
#pragma unroll
      for (int i = 0; i < 4; ++i)
#pragma unroll
        for (int j = 0; j < 4; ++j) {
          const float g0 = bflo(gpk[i][j].x) * sigmoidf_(bacc[i][j][0]), g1 = bfhi(gpk[i][j].x) * sigmoidf_(bacc[i][j][1]);
          const float g2 = bflo(gpk[i][j].y) * sigmoidf_(bacc[i][j][2]), g3 = bfhi(gpk[i][j].y) * sigmoidf_(bacc[i][j][3]);
          gpk[i][j] = u32x2{pack2(g0, g1), pack2(g2, g3)};
        }
    }
    zero_acc<4>(bacc);
    gemm_mainloop_8n(Ab + (size_t)m0 * 256, 256, Wb + (size_t)n0 * 256, 256, 256, bacc, smem);
#pragma unroll
    for (int i = 0; i < 4; ++i)
#pragma unroll
      for (int g2 = 0; g2 < 2; ++g2) {
        u32x4* mp = (u32x4*)(MRG + (size_t)(m0 + wm * 64 + i * 16 + fr) * 1024 + n0 + wn * 64 + 32 * g2 + 8 * fq);
        u32x4 cm = u32x4{0u, 0u, 0u, 0u};
        if (MODE == 1 || br > 1) cm = *mp;
        const int ja = 2 * g2, jb = 2 * g2 + 1;
        const float v0 = bflo(cm.x) + bflo(gpk[i][ja].x) * bacc[i][ja][0];
        const float v1 = bfhi(cm.x) + bfhi(gpk[i][ja].x) * bacc[i][ja][1];
        const float v2 = bflo(cm.y) + bflo(gpk[i][ja].y) * bacc[i][ja][2];
        const float v3 = bfhi(cm.y) + bfhi(gpk[i][ja].y) * bacc[i][ja][3];
        const float v4 = bflo(cm.z) + bflo(gpk[i][jb].x) * bacc[i][jb][0];
        const float v5 = bfhi(cm.z) + bfhi(gpk[i][jb].x) * bacc[i][jb][1];
        const float v6 = bflo(cm.w) + bflo(gpk[i][jb].y) * bacc[i][jb][2];
        const float v7 = bfhi(cm.w) + bfhi(gpk[i][jb].y) * bacc[i][jb][3];
        *mp = u32x4{pack2(v0, v1), pack2(v2, v3), pack2(v4, v5), pack2(v6, v7)};
      }
  }
}

__device__ __forceinline__ void phase_pproj_tail(const Params& p, int vb, unsigned char* smem_raw) {
  u16* smem = (u16*)smem_raw;
  const int lane = threadIdx.x & 63, wv = threadIdx.x >> 6;
  const int wm = wv >> 1, wn = wv & 1;
  const int fr = lane & 15, fq = lane >> 4;
  const u16* A = (const u16*)(p.ws + OFF_H);
  const u16* B = (const u16*)(p.ws + OFF_WIN);
  const int G = gridDim.x;
  const int total = (G == 256) ? 256 : 192;
  for (int item = vb; item < total; item += G) {
    int mt = item & 63, nt = item >> 6;
    if (G == 256) { const int w = vb & 31; mt = (vb >> 5) * 8 + (w & 7); nt = w >> 3; if (nt >= 3) continue; }
    const int m0 = mt * 256, n0 = 2048 + nt * 128;
    f32x4 acc[4][4];
    zero_acc<4>(acc);
    gemm_mainloop_8n(A + (size_t)m0 * 1024, 1024, B + (size_t)n0 * 1024, 1024, 1024, acc, smem);
#pragma unroll
    for (int i = 0; i < 4; ++i) {
      const int m = m0 + wm * 64 + i * 16 + fr;
#pragma unroll
      for (int g2 = 0; g2 < 2; ++g2) {
        const int n = n0 + wn * 64 + 32 * g2 + 8 * fq;
        const f32x4 va = acc[i][2 * g2], vb2 = acc[i][2 * g2 + 1];
        const u32x4 o = u32x4{pack2(va[0], va[1]), pack2(va[2], va[3]), pack2(vb2[0], vb2[1]), pack2(vb2[2], vb2[3])};
        if (n < 2176) *(u32x4*)((u16*)(p.ws + OFF_PABC) + (size_t)m * 2176 + n) = o;
        else *(u32x4*)((u16*)(p.ws + OFF_PD) + (size_t)m * 256 + (n - 2176)) = o;
      }
    }
  }
}

__device__ __forceinline__ float shifted(const u16* __restrict__ P, int tok, int col, float mu) {
  float pv = bf2f(P[(size_t)tok * 2176 + col]);
  float pr = (tok & (SEQ - 1)) ? bf2f(P[(size_t)(tok - 1) * 2176 + col]) : 0.f;
  return pv + (pr - pv) * mu;
}

__device__ __forceinline__ void rwkv_prep_item(const Params& p, int l, int item, unsigned char* smem) {
  const int tid = TIDX, lane = tid & 63, wv = tid >> 6;
  const int fr = lane & 15, fq = lane >> 4;
  u16* sl = (u16*)smem;
  u16* sv = sl + 32 * 168;
  constexpr int SLS = 168, SVS = 264;
  const u16* P = (const u16*)(p.ws + OFF_PABC);
  const float* mu = p.in[6] + l * 896;
  const int tok0 = item * 32;
  {
    const int t = tid >> 3, c0 = (tid & 7) * 32;
    const u16* src = P + (size_t)(tok0 + t) * 2176 + 896 + 256 + c0;
    float sm = 0.f, ss = 0.f;
#pragma unroll
    for (int q = 0; q < 4; ++q) {
      const u32x4 raw = *(const u32x4*)(src + q * 8);
      float z;
      z = geluf_(bflo(raw.x)); sm += z; ss += z * z;  z = geluf_(bfhi(raw.x)); sm += z; ss += z * z;
      z = geluf_(bflo(raw.y)); sm += z; ss += z * z;  z = geluf_(bfhi(raw.y)); sm += z; ss += z * z;
      z = geluf_(bflo(raw.z)); sm += z; ss += z * z;  z = geluf_(bfhi(raw.z)); sm += z; ss += z * z;
      z = geluf_(bflo(raw.w)); sm += z; ss += z * z;  z = geluf_(bfhi(raw.w)); sm += z; ss += z * z;
    }
    sm += __shfl_xor(sm, 1, 64); ss += __shfl_xor(ss, 1, 64);
    sm += __shfl_xor(sm, 2, 64); ss += __shfl_xor(ss, 2, 64);
    sm += __shfl_xor(sm, 4, 64); ss += __shfl_xor(ss, 4, 64);
    const float mean = sm * (1.f / 256.f);
    const float var = fmaxf(ss * (1.f / 256.f) - mean * mean, 0.f);
    if ((tid & 7) == 0) *(f32x2*)((float*)(p.ws + OFF_SGST) + (size_t)(tok0 + t) * 2) = f32x2{mean, rsqrtf(var + 1e-5f)};
  }
  for (int idx = tid; idx < 32 * 128; idx += NTHR) {
    const int t = idx >> 7, ci = idx & 127;
    float v = shifted(P, tok0 + t, 768 + ci, mu[768 + ci]);
    if (ci < 32) v = tanhf_(v);
    else if (ci >= 64) v = sigmoidf_(v);
    sl[t * SLS + ci] = f2bf(v);
  }
  if (l > 0) {
    const int t = tid >> 3, c0 = (tid & 7) * 32;
    const int tok = tok0 + t;
    const bool hasp = (tok & (SEQ - 1)) != 0;
#pragma unroll
    for (int q = 0; q < 4; ++q) {
      const int c = c0 + q * 8;
      const u32x4 cur = *(const u32x4*)(P + (size_t)tok * 2176 + 512 + c);
      u32x4 prv = u32x4{0u, 0u, 0u, 0u};
      if (hasp) prv = *(const u32x4*)(P + (size_t)(tok - 1) * 2176 + 512 + c);
      const f32x4 m0 = *(const f32x4*)(mu + 512 + c), m1 = *(const f32x4*)(mu + 512 + c + 4);
      float o[8];
      o[0] = bflo(cur.x) + (bflo(prv.x) - bflo(cur.x)) * m0.x; o[1] = bfhi(cur.x) + (bfhi(prv.x) - bfhi(cur.x)) * m0.y;
      o[2] = bflo(cur.y) + (bflo(prv.y) - bflo(cur.y)) * m0.z; o[3] = bfhi(cur.y) + (bfhi(prv.y) - bfhi(cur.y)) * m0.w;
      o[4] = bflo(cur.z) + (bflo(prv.z) - bflo(cur.z)) * m1.x; o[5] = bfhi(cur.z) + (bfhi(prv.z) - bfhi(cur.z)) * m1.y;
      o[6] = bflo(cur.w) + (bflo(prv.w) - bflo(cur.w)) * m1.z; o[7] = bfhi(cur.w) + (bfhi(prv.w) - bfhi(cur.w)) * m1.w;
      *(u32x4*)(sv + t * SVS + c) = u32x4{pack2(o[0], o[1]), pack2(o[2], o[3]), pack2(o[4], o[5]), pack2(o[6], o[7])};
    }
  }
  __syncthreads();
  if (l > 0) {
    const int mf = wv >> 1, nf = wv & 1;
    const u16* v1t = (const u16*)(p.ws + OFF_LV1);
    f32x4 acc = f32x4{0.f, 0.f, 0.f, 0.f};
#pragma unroll
    for (int ks = 0; ks < 8; ++ks) {
      const bf16x8 fa = *(const bf16x8*)(sv + (mf * 16 + fr) * SVS + ks * 32 + fq * 8);
      const bf16x8 fb = *(const bf16x8*)(v1t + (size_t)(nf * 16 + fr) * 256 + ks * 32 + fq * 8);
      acc = __builtin_amdgcn_mfma_f32_16x16x32_bf16(fb, fa, acc, 0, 0, 0);
    }
    *(u32x2*)(sl + (mf * 16 + fr) * SLS + 128 + nf * 16 + fq * 4) = u32x2{pack2(acc[0], acc[1]), pack2(acc[2], acc[3])};
    __syncthreads();
  }
  const u16* w2t = (const u16*)(p.ws + OFF_LW2); const u16* a2t = (const u16*)(p.ws + OFF_LA2);
  const u16* g2t = (const u16*)(p.ws + OFF_LG2); const u16* v2t = (const u16*)(p.ws + OFF_LV2);
  u16* SR = (u16*)(p.ws + OFF_SR); u16* SK = (u16*)(p.ws + OFF_SK); u16* SV = (u16*)(p.ws + OFF_SV);
  u16* SKK = (u16*)(p.ws + OFF_SKK); u16* SA = (u16*)(p.ws + OFF_SA); float* SW = (float*)(p.ws + OFF_SW);
  u16* G = (u16*)(p.ws + OFF_G); u16* VF = (u16*)(p.ws + OFF_VF);
#pragma unroll 1
  for (int mf = 0; mf < 2; ++mf) {
    const u16* arow = sl + (mf * 16 + fr) * SLS + fq * 8;
    const bf16x8 aw = *(const bf16x8*)(arow), aa = *(const bf16x8*)(arow + 32);
    const bf16x8 ag0 = *(const bf16x8*)(arow + 64), ag1 = *(const bf16x8*)(arow + 96), av = *(const bf16x8*)(arow + 128);
    f32x4 cw[4], ca[4], cg[4], cv[4];
#pragma unroll
    for (int nf = 0; nf < 4; ++nf) {
      const int n = wv * 64 + (nf >> 1) * 32 + 8 * (fr >> 2) + 4 * (nf & 1) + (fr & 3);
      const f32x4 z = f32x4{0.f, 0.f, 0.f, 0.f};
      cw[nf] = __builtin_amdgcn_mfma_f32_16x16x32_bf16(*(const bf16x8*)(w2t + n * 32 + fq * 8), aw, z, 0, 0, 0);
      ca[nf] = __builtin_amdgcn_mfma_f32_16x16x32_bf16(*(const bf16x8*)(a2t + n * 32 + fq * 8), aa, z, 0, 0, 0);
      cg[nf] = __builtin_amdgcn_mfma_f32_16x16x32_bf16(*(const bf16x8*)(g2t + n * 64 + fq * 8), ag0, z, 0, 0, 0);
      cg[nf] = __builtin_amdgcn_mfma_f32_16x16x32_bf16(*(const bf16x8*)(g2t + n * 64 + 32 + fq * 8), ag1, cg[nf], 0, 0, 0);
      cv[nf] = z;
      if (l > 0) cv[nf] = __builtin_amdgcn_mfma_f32_16x16x32_bf16(*(const bf16x8*)(v2t + n * 32 + fq * 8), av, z, 0, 0, 0);
    }
    const int tok = tok0 + mf * 16 + fr;
    const bool hasp = (tok & (SEQ - 1)) != 0;
    float kkv[4][4], kmv[4][4], av4[4][4];
    float ss = 0.f;
#pragma unroll
    for (int g2 = 0; g2 < 2; ++g2) {
    u32x2 pr[2], pv[2], pg[2];
    const int c8 = wv * 64 + 32 * g2 + 8 * fq;
    const u16* pc8 = P + (size_t)tok * 2176 + c8;
    const u32x4 r_c8 = *(const u32x4*)(pc8), k_c8 = *(const u32x4*)(pc8 + 256), v_c8 = *(const u32x4*)(pc8 + 512);
    u32x4 r_p8 = u32x4{0u, 0u, 0u, 0u}, k_p8 = r_p8, v_p8 = r_p8, vf8 = r_p8;
    if (hasp) { r_p8 = *(const u32x4*)(pc8 - 2176); k_p8 = *(const u32x4*)(pc8 - 2176 + 256); v_p8 = *(const u32x4*)(pc8 - 2176 + 512); }
    if (l > 0) vf8 = *(const u32x4*)(VF + (size_t)tok * 256 + c8);
#pragma unroll
    for (int hh = 0; hh < 2; ++hh) {
      const int nf = 2 * g2 + hh;
      const int c = wv * 64 + 32 * g2 + 8 * fq + 4 * hh;
      const size_t o = (size_t)tok * 256 + c;
      const u32x2 r_c = hh ? u32x2{r_c8.z, r_c8.w} : u32x2{r_c8.x, r_c8.y}, k_c = hh ? u32x2{k_c8.z, k_c8.w} : u32x2{k_c8.x, k_c8.y};
      const u32x2 v_c = hh ? u32x2{v_c8.z, v_c8.w} : u32x2{v_c8.x, v_c8.y};
      const u32x2 r_p = hh ? u32x2{r_p8.z, r_p8.w} : u32x2{r_p8.x, r_p8.y}, k_p = hh ? u32x2{k_p8.z, k_p8.w} : u32x2{k_p8.x, k_p8.y};
      const u32x2 v_p = hh ? u32x2{v_p8.z, v_p8.w} : u32x2{v_p8.x, v_p8.y};
      const f32x4 mur = *(const f32x4*)(mu + c), muk = *(const f32x4*)(mu + 256 + c), muv = *(const f32x4*)(mu + 512 + c);
      const f32x4 w0 = *(const f32x4*)(p.in[7] + l * 256 + c), a0 = *(const f32x4*)(p.in[9] + l * 256 + c);
      const f32x4 kkc = *(const f32x4*)(p.in[15] + l * 256 + c), kac = *(const f32x4*)(p.in[16] + l * 256 + c);
      f32x4 v0 = f32x4{0.f, 0.f, 0.f, 0.f};
      if (l > 0) v0 = *(const f32x4*)(p.in[12] + c);
      const u32x2 vfraw = hh ? u32x2{vf8.z, vf8.w} : u32x2{vf8.x, vf8.y};
      float rr[4], kk_[4], vv[4], dec[4], gg[4];
#pragma unroll
      for (int e = 0; e < 4; ++e) {
        const unsigned rc = e < 2 ? r_c.x : r_c.y, rp = e < 2 ? r_p.x : r_p.y;
        const unsigned kc = e < 2 ? k_c.x : k_c.y, kp = e < 2 ? k_p.x : k_p.y;
        const unsigned vc = e < 2 ? v_c.x : v_c.y, vp = e < 2 ? v_p.x : v_p.y;
        const unsigned vfr = e < 2 ? vfraw.x : vfraw.y;
        const float rcf = (e & 1) ? bfhi(rc) : bflo(rc), rpf = (e & 1) ? bfhi(rp) : bflo(rp);
        const float kcf = (e & 1) ? bfhi(kc) : bflo(kc), kpf = (e & 1) ? bfhi(kp) : bflo(kp);
        const float vcf = (e & 1) ? bfhi(vc) : bflo(vc), vpf = (e & 1) ? bfhi(vp) : bflo(vp);
        const float r = rcf + (rpf - rcf) * mur[e];
        const float k = kcf + (kpf - kcf) * muk[e];
        float v = vcf + (vpf - vcf) * muv[e];
        const float wl = w0[e] + cw[nf][e];
        const float z = -wl;
        const float sp = (z > 15.f) ? z : __logf(1.f + __expf(z));
        dec[e] = __expf(-__expf(-sp - 0.5f));
        const float a = sigmoidf_(a0[e] + ca[nf][e]);
        gg[e] = cg[nf][e];
        if (l > 0) { const float vf = (e & 1) ? bfhi(vfr) : bflo(vfr); v = v + (vf - v) * sigmoidf_(v0[e] + cv[nf][e]); }
        const float kk = k * kkc[e];
        ss += kk * kk;
        rr[e] = r; vv[e] = v; kk_[e] = kk; kkv[nf][e] = kk;
        kmv[nf][e] = k * (1.f + (a - 1.f) * kac[e]); av4[nf][e] = a;
      }
      pr[hh] = u32x2{pack2(rr[0], rr[1]), pack2(rr[2], rr[3])};
      pv[hh] = u32x2{pack2(vv[0], vv[1]), pack2(vv[2], vv[3])};
      pg[hh] = u32x2{pack2(gg[0], gg[1]), pack2(gg[2], gg[3])};
      *(f32x4*)(SW + o) = f32x4{dec[0], dec[1], dec[2], dec[3]};
    }
      {
        const size_t o8 = (size_t)tok * 256 + wv * 64 + 32 * g2 + 8 * fq;
        *(u32x4*)(SR + o8) = u32x4{pr[0].x, pr[0].y, pr[1].x, pr[1].y};
        *(u32x4*)(SV + o8) = u32x4{pv[0].x, pv[0].y, pv[1].x, pv[1].y};
        if (l == 0) *(u32x4*)(VF + o8) = u32x4{pv[0].x, pv[0].y, pv[1].x, pv[1].y};
        *(u32x4*)(G + o8) = u32x4{pg[0].x, pg[0].y, pg[1].x, pg[1].y};
      }
    }
    ss += __shfl_xor(ss, 16, 64);
    ss += __shfl_xor(ss, 32, 64);
    const float inv = 1.f / fmaxf(sqrtf(ss), 1e-12f);
#pragma unroll
    for (int g2 = 0; g2 < 2; ++g2) {
      const size_t o8 = (size_t)tok * 256 + wv * 64 + 32 * g2 + 8 * fq;
      const int na = 2 * g2, nb2 = 2 * g2 + 1;
      *(u32x4*)(SKK + o8) = u32x4{pack2(kkv[na][0] * inv, kkv[na][1] * inv), pack2(kkv[na][2] * inv, kkv[na][3] * inv),
                                  pack2(kkv[nb2][0] * inv, kkv[nb2][1] * inv), pack2(kkv[nb2][2] * inv, kkv[nb2][3] * inv)};
      *(u32x4*)(SK + o8) = u32x4{pack2(kmv[na][0], kmv[na][1]), pack2(kmv[na][2], kmv[na][3]), pack2(kmv[nb2][0], kmv[nb2][1]), pack2(kmv[nb2][2], kmv[nb2][3])};
      *(u32x4*)(SA + o8) = u32x4{pack2(av4[na][0], av4[na][1]), pack2(av4[na][2], av4[na][3]), pack2(av4[nb2][0], av4[nb2][1]), pack2(av4[nb2][2], av4[nb2][3])};
    }
  }
  __syncthreads();
}

__device__ __forceinline__ void sg_item(const Params& p, int l, int item, unsigned char* smem) {
  const int tid = TIDX, lane = tid & 63, wv = tid >> 6;
  u16* vsT = (u16*)smem;
  float* smu = (float*)(smem + 16384);
  float* srs = smu + 128;
  const u16* P = (const u16*)(p.ws + OFF_PABC);
  const int g = item & 3, chn = item >> 2;
  const int tok0 = chn * 128;
  if (tid < 128) {
    const f32x2 ms = *(const f32x2*)((const float*)(p.ws + OFF_SGST) + (size_t)(tok0 + tid) * 2);
    smu[tid] = ms.x; srs[tid] = ms.y;
  }
  __syncthreads();
  {
    const int c = tid & 63, tb = tid >> 6;
    const float lw = p.in[21][l * 256 + g * 64 + c], lb = p.in[22][l * 256 + g * 64 + c];
#pragma unroll
    for (int j = 0; j < 4; ++j) {
      u16 raw[8];
#pragma unroll
      for (int e = 0; e < 8; ++e) raw[e] = P[(size_t)(tok0 + tb * 32 + j * 8 + e) * 2176 + 896 + 256 + g * 64 + c];
      float vv[8];
#pragma unroll
      for (int e = 0; e < 8; ++e) {
        const int t = tb * 32 + j * 8 + e;
        vv[e] = (geluf_(bf2f(raw[e])) - smu[t]) * srs[t] * lw + lb;
      }
      const int phys = (tb * 4 + j) ^ (c & 15);
      *(u32x4*)(vsT + c * 128 + phys * 8) = u32x4{pack2(vv[0], vv[1]), pack2(vv[2], vv[3]), pack2(vv[4], vv[5]), pack2(vv[6], vv[7])};
    }
  }
  __syncthreads();
  {
    const int fr = lane & 15, fq = lane >> 4;
    const u16* Wm = (const u16*)(p.ws + OFF_SGW) + (size_t)g * 128 * 128;
    f32x4 acc[2][4];
#pragma unroll
    for (int i = 0; i < 2; ++i)
#pragma unroll
      for (int j = 0; j < 4; ++j) acc[i][j] = f32x4{0.f, 0.f, 0.f, 0.f};
    for (int ks = 0; ks <= wv; ++ks) {
      bf16x8 fa[2], fb[4];
#pragma unroll
      for (int i = 0; i < 2; ++i) fa[i] = *(const bf16x8*)(Wm + (size_t)(32 * wv + 16 * i + fr) * 128 + ks * 32 + fq * 8);
#pragma unroll
      for (int j = 0; j < 4; ++j) fb[j] = *(const bf16x8*)(vsT + (j * 16 + fr) * 128 + (((ks * 4 + fq) ^ fr) << 3));
#pragma unroll
      for (int i = 0; i < 2; ++i)
#pragma unroll
        for (int j = 0; j < 4; ++j) acc[i][j] = __builtin_amdgcn_mfma_f32_16x16x32_bf16(fb[j], fa[i], acc[i][j], 0, 0, 0);
    }
    const float* bs = p.in[24] + ((size_t)l * 4 + g) * 128;
    u16* UB = (u16*)(p.ws + OFF_UB);
#pragma unroll
    for (int i = 0; i < 2; ++i) {
      const int t = 32 * wv + 16 * i + fr;
      const float bsv = bs[t];
#pragma unroll
      for (int j = 0; j < 4; ++j) {
        const int cc = j * 16 + fq * 4;
        u32x2 ur = *(const u32x2*)(P + (size_t)(tok0 + t) * 2176 + 896 + g * 64 + cc);
        float o0 = geluf_(bflo(ur.x)) * (acc[i][j][0] + bsv), o1 = geluf_(bfhi(ur.x)) * (acc[i][j][1] + bsv);
        float o2 = geluf_(bflo(ur.y)) * (acc[i][j][2] + bsv), o3 = geluf_(bfhi(ur.y)) * (acc[i][j][3] + bsv);
        *(u32x2*)(UB + (size_t)(tok0 + t) * 256 + g * 64 + cc) = u32x2{pack2(o0, o1), pack2(o2, o3)};
      }
    }
  }
  __syncthreads();
}

__device__ __forceinline__ void conv_item(const Params& p, int l, int item) {
  const int j = TIDX;
  const u16* P = (const u16*)(p.ws + OFF_PABC);
  u16* CB = (u16*)(p.ws + OFF_CB);
  const float c0 = p.in[26][(l * 3 + 0) * 256 + j], c1 = p.in[26][(l * 3 + 1) * 256 + j], c2 = p.in[26][(l * 3 + 2) * 256 + j];
  const int tok0 = item * 8;
  u16 rc[10], rx[10], rb[8];
  const bool first = (tok0 & (SEQ - 1)) == 0;
#pragma unroll
  for (int t = 0; t < 10; ++t) {
    const int tok = (first && t < 2) ? tok0 : tok0 + t - 2;
    const u16* q = P + (size_t)tok * 2176 + 1408;
    rc[t] = q[256 + j]; rx[t] = q[512 + j];
    if (t >= 2) rb[t - 2] = q[j];
  }
  float z[10];
#pragma unroll
  for (int t = 0; t < 10; ++t) z[t] = bf2f(rc[t]) * bf2f(rx[t]);
  if (first) { z[0] = 0.f; z[1] = 0.f; }
#pragma unroll
  for (int t = 0; t < 8; ++t) {
    float y = c0 * z[t] + c1 * z[t + 1] + c2 * z[t + 2];
    CB[(size_t)(tok0 + t) * 256 + j] = f2bf(bf2f(rb[t]) * y);
  }
}

__device__ __forceinline__ void s5_load_u(const u16* us, int t, int wv, float (&u)[16]) {
  const u32x4* q = (const u32x4*)(us + t * 64 + wv * 16);
  u32x4 a = q[0], b = q[1];
  u[0] = bflo(a.x); u[1] = bfhi(a.x); u[2] = bflo(a.y); u[3] = bfhi(a.y);
  u[4] = bflo(a.z); u[5] = bfhi(a.z); u[6] = bflo(a.w); u[7] = bfhi(a.w);
  u[8] = bflo(b.x); u[9] = bfhi(b.x); u[10] = bflo(b.y); u[11] = bfhi(b.y);
  u[12] = bflo(b.z); u[13] = bfhi(b.z); u[14] = bflo(b.w); u[15] = bfhi(b.w);
}
__device__ __forceinline__ void s5_stage_u(const u16* __restrict__ PD, int tok0, int gq, u16* us) {
#pragma unroll
  for (int i = 0; i < 2; ++i) {
    const int ch = TIDX + 256 * i;
    const int t = ch >> 3, part = ch & 7;
    *(u32x4*)(us + t * 64 + part * 8) = *(const u32x4*)(PD + (size_t)(tok0 + t) * 256 + gq * 64 + part * 8);
  }
}

__device__ __forceinline__ void s5a_item(const Params& p, int l, int item, unsigned char* smem) {
  const int lane = TIDX & 63, wv = TIDX >> 6;
  const int gq = item & 3, bc = item >> 2;
  const int g = gq * 4 + wv;
  const int tok0 = bc * 64;
  const u16* PD = (const u16*)(p.ws + OFF_PD);
  const float* ab = (const float*)(p.ws + OFF_S5AB) + ((size_t)(l * 16 + g) * 64 + lane) * 2;
  const float* bb = (const float*)(p.ws + OFF_S5BB) + ((size_t)(l * 16 + g) * 64 + lane) * 32;
  float bbr[16], bbi[16];
#pragma unroll
  for (int c = 0; c < 16; ++c) { bbr[c] = bb[c]; bbi[c] = bb[16 + c]; }
  const float abr = ab[0], abi = ab[1];
  float xr = 0.f, xi = 0.f;
  u16* us = (u16*)smem;
  s5_stage_u(PD, tok0, gq, us);
  __syncthreads();
#pragma unroll 4
  for (int t = 0; t < 64; ++t) {
    float u[16];
    s5_load_u(us, t, wv, u);
    float bur = 0.f, bui = 0.f;
#pragma unroll
    for (int c = 0; c < 16; ++c) { bur += bbr[c] * u[c]; bui += bbi[c] * u[c]; }
    float nr = abr * xr - abi * xi + bur;
    float ni = abr * xi + abi * xr + bui;
    xr = nr; xi = ni;
  }
  float2* E = (float2*)(p.ws + OFF_S5E);
  E[((size_t)bc * 16 + g) * 64 + lane] = make_float2(xr, xi);
  __syncthreads();
}

__device__ __forceinline__ void s5b_item(const Params& p, int l, int item, unsigned char* smem) {
  const int lane = TIDX & 63, wv = TIDX >> 6;
  const int gq = item & 3, bc = item >> 2;
  const int b = bc >> 6, ch = bc & 63;
  const int g = gq * 4 + wv;
  const int tok0 = bc * 64;
  u16* us = (u16*)(smem + 65536);
  s5_stage_u((const u16*)(p.ws + OFF_PD), tok0, gq, us);
  float* base = (float*)smem + wv * 4096;
  float* csr = base, *csi = base + 1024, *xsr = base + 2048, *xsi = base + 3072;
  const u16* PD = (const u16*)(p.ws + OFF_PD);
  const float* ab = (const float*)(p.ws + OFF_S5AB) + ((size_t)(l * 16 + g) * 64 + lane) * 2;
  const float* bb = (const float*)(p.ws + OFF_S5BB) + ((size_t)(l * 16 + g) * 64 + lane) * 32;
  const float* cre = p.in[32] + ((size_t)(l * 16 + g) * 16) * 64;
  const float* cim = p.in[33] + ((size_t)(l * 16 + g) * 16) * 64;
  for (int c = 0; c < 16; ++c) {
    csr[(lane >> 2) * 64 + c * 4 + (lane & 3)] = cre[c * 64 + lane];
    csi[(lane >> 2) * 64 + c * 4 + (lane & 3)] = cim[c * 64 + lane];
  }
  float bbr[16], bbi[16];
#pragma unroll
  for (int c = 0; c < 16; ++c) { bbr[c] = bb[c]; bbi[c] = bb[16 + c]; }
  const float abr = ab[0], abi = ab[1];
  float pr = abr, pi = abi;
#pragma unroll
  for (int s = 0; s < 6; ++s) { float nr = pr * pr - pi * pi, ni = 2.f * pr * pi; pr = nr; pi = ni; }
  float xr = 0.f, xi = 0.f;
  const float2* E = (const float2*)(p.ws + OFF_S5E);
  {
    const f32x2* Ev = (const f32x2*)E + ((size_t)(b * 64) * 16 + g) * 64 + lane;
    int c = 0;
    for (; c + 8 <= ch; c += 8) {
      f32x2 e[8];
#pragma unroll
      for (int k = 0; k < 8; ++k) e[k] = Ev[(size_t)(c + k) * 1024];
#pragma unroll
      for (int k = 0; k < 8; ++k) {
        const float nr = pr * xr - pi * xi + e[k].x;
        const float ni = pr * xi + pi * xr + e[k].y;
        xr = nr; xi = ni;
      }
    }
    for (; c < ch; ++c) {
      const f32x2 e = Ev[(size_t)c * 1024];
      const float nr = pr * xr - pi * xi + e.x;
      const float ni = pr * xi + pi * xr + e.y;
      xr = nr; xi = ni;
    }
  }
  const int tt = lane & 15, cq = lane >> 4;
  const float* dvec = p.in[34] + l * 256 + g * 16 + cq * 4;
  const float d0 = dvec[0], d1 = dvec[1], d2 = dvec[2], d3 = dvec[3];
  u16* YD = (u16*)(p.ws + OFF_YD);
  const int n4w = lane >> 2, e4 = lane & 3;
  __syncthreads();
#pragma unroll 1
  for (int sc = 0; sc < 4; ++sc) {
    for (int t = 0; t < 16; ++t) {
      float u[16];
      s5_load_u(us, sc * 16 + t, wv, u);
      float bur = 0.f, bui = 0.f;
#pragma unroll
      for (int c = 0; c < 16; ++c) { bur += bbr[c] * u[c]; bui += bbi[c] * u[c]; }
      float nr = abr * xr - abi * xi + bur;
      float ni = abr * xi + abi * xr + bui;
      xr = nr; xi = ni;
      int a = n4w * 64 + ((t ^ (n4w & 7)) << 2) + e4;
      xsr[a] = xr; xsi[a] = xi;
    }
    __syncthreads();
    float acc0 = 0.f, acc1 = 0.f, acc2 = 0.f, acc3 = 0.f;
#pragma unroll 2
    for (int n4 = 0; n4 < 16; ++n4) {
      int xa = n4 * 64 + ((tt ^ (n4 & 7)) << 2);
      float4 xr4 = *(const float4*)(xsr + xa);
      float4 xi4 = *(const float4*)(xsi + xa);
      const float* cr = csr + n4 * 64 + cq * 16;
      const float* ci = csi + n4 * 64 + cq * 16;
      float4 r0 = *(const float4*)(cr), r1 = *(const float4*)(cr + 4), r2 = *(const float4*)(cr + 8), r3 = *(const float4*)(cr + 12);
      float4 i0 = *(const float4*)(ci), i1 = *(const float4*)(ci + 4), i2 = *(const float4*)(ci + 8), i3 = *(const float4*)(ci + 12);
      acc0 += r0.x * xr4.x + r0.y * xr4.y + r0.z * xr4.z + r0.w * xr4.w - (i0.x * xi4.x + i0.y * xi4.y + i0.z * xi4.z + i0.w * xi4.w);
      acc1 += r1.x * xr4.x + r1.y * xr4.y + r1.z * xr4.z + r1.w * xr4.w - (i1.x * xi4.x + i1.y * xi4.y + i1.z * xi4.z + i1.w * xi4.w);
      acc2 += r2.x * xr4.x + r2.y * xr4.y + r2.z * xr4.z + r2.w * xr4.w - (i2.x * xi4.x + i2.y * xi4.y + i2.z * xi4.z + i2.w * xi4.w);
      acc3 += r3.x * xr4.x + r3.y * xr4.y + r3.z * xr4.z + r3.w * xr4.w - (i3.x * xi4.x + i3.y * xi4.y + i3.z * xi4.z + i3.w * xi4.w);
    }
    {
      const int tok = tok0 + sc * 16 + tt;
      u32x2 ur = *(const u32x2*)(us + (sc * 16 + tt) * 64 + wv * 16 + cq * 4);
      float y0 = acc0 + d0 * bflo(ur.x), y1 = acc1 + d1 * bfhi(ur.x), y2 = acc2 + d2 * bflo(ur.y), y3 = acc3 + d3 * bfhi(ur.y);
      u32x2 o; o.x = pack2(geluf_(y0), geluf_(y1)); o.y = pack2(geluf_(y2), geluf_(y3));
      *(u32x2*)(YD + (size_t)tok * 256 + g * 16 + cq * 4) = o;
    }
    __syncthreads();
  }
}

__device__ __forceinline__ void lds_barrier() {
  asm volatile("s_waitcnt lgkmcnt(0)" ::: "memory");
  __builtin_amdgcn_s_barrier();
  asm volatile("" ::: "memory");
}
__device__ __forceinline__ void scan_item(const Params& p, int item, unsigned char* smem) {
  const int tid = TIDX, lane = tid & 63, wv = tid >> 6;
  const int b = item >> 4, h = (item >> 2) & 3, q = item & 3;
  const int rl = lane >> 4, cl = lane & 15;
  const int rloc = wv * 4 + rl;
  const size_t tokb = (size_t)b * SEQ;
  const int chan0 = h * 64;
  const u16* SR = (const u16*)(p.ws + OFF_SR); const u16* SK = (const u16*)(p.ws + OFF_SK);
  const u16* SV = (const u16*)(p.ws + OFF_SV); const u16* SKK = (const u16*)(p.ws + OFF_SKK);
  const u16* SA = (const u16*)(p.ws + OFF_SA); const float* SW = (const float*)(p.ws + OFF_SW);
  float* O = (float*)(p.ws + OFF_O);
  constexpr int BUFF = 6432;
  float* lbase = (float*)smem;
  float* pp = lbase + 2 * BUFF + wv * 1024;
  const int st = tid >> 4, cg4 = tid & 15;
  struct Stg { u32x2 r, k, kk, a, kk1; f32x4 w; u16 v; };
  auto gload = [&](Stg& g, int c) {
    const size_t o = (tokb + (size_t)c * 16 + st) * 256 + chan0;
    g.r = *(const u32x2*)(SR + o + cg4 * 4); g.k = *(const u32x2*)(SK + o + cg4 * 4);
    g.kk = *(const u32x2*)(SKK + o + cg4 * 4); g.a = *(const u32x2*)(SA + o + cg4 * 4);
    g.w = *(const f32x4*)(SW + o + cg4 * 4);
    g.v = SV[o + q * 16 + cg4];
    int t1 = c * 16 + st + 1; if (t1 >= SEQ) t1 = SEQ - 1;
    g.kk1 = *(const u32x2*)(SKK + (tokb + (size_t)t1) * 256 + chan0 + cg4 * 4);
  };
  auto lwrite = [&](const Stg& g, int buf) {
    float* bp = lbase + buf * BUFF;
    const int o = st * 64 + cg4 * 4;
    f32x4 kk = {bflo(g.kk.x), bfhi(g.kk.x), bflo(g.kk.y), bfhi(g.kk.y)};
    f32x4 a = {bflo(g.a.x), bfhi(g.a.x), bflo(g.a.y), bfhi(g.a.y)};
    f32x4 k = {bflo(g.k.x), bfhi(g.k.x), bflo(g.k.y), bfhi(g.k.y)};
    f32x4 r = {bflo(g.r.x), bfhi(g.r.x), bflo(g.r.y), bfhi(g.r.y)};
    *(f32x4*)(bp + o) = kk;
    *(f32x4*)(bp + 1024 + o) = kk * a;
    *(f32x4*)(bp + 2048 + o) = k;
    *(f32x4*)(bp + 3072 + o) = g.w;
    *(f32x4*)(bp + 4096 + o) = r;
    bp[5120 + st * 16 + cg4] = bf2f(g.v);
    const f32x4 kn = {bflo(g.kk1.x), bfhi(g.kk1.x), bflo(g.kk1.y), bfhi(g.kk1.y)};
    *(f32x4*)(bp + 5376 + o) = g.w * kn;
    const f32x4 bb = kk * a;
    const float c1 = row_sum16(k.x * kn.x + k.y * kn.y + k.z * kn.z + k.w * kn.w);
    const float c2 = row_sum16(bb.x * kn.x + bb.y * kn.y + bb.z * kn.z + bb.w * kn.w);
    if (cg4 == 0) *(f32x2*)(bp + 6400 + st * 2) = f32x2{c1, c2};
  };
  constexpr int NCH = SEQ / 16;
  Stg R0, R1, R2, R3;
  gload(R0, 0); gload(R1, 1); gload(R2, 2); gload(R3, 3);
  __syncthreads();
  lwrite(R0, 0);
  __syncthreads();
  __builtin_amdgcn_s_setprio(3);
  float S0 = 0.f, S1 = 0.f, S2 = 0.f, S3 = 0.f;
  const int rrow = lane & 3, rstep = lane >> 2;
  struct Pair { f32x4 kkA, bbA, kA, wA, rA, mA, bbB, kB, wB, rB; f32x2 cA; float vA, vB; };
  auto chunk = [&](int c) {
    const float* bp = lbase + (c & 1) * BUFF;
    auto ldpair = [&](Pair& o, int s) {
      o.kkA = *(const f32x4*)(bp + s * 64 + cl * 4);
      o.mA = *(const f32x4*)(bp + 5376 + s * 64 + cl * 4);
      o.bbA = *(const f32x4*)(bp + 1024 + s * 64 + cl * 4);
      o.kA = *(const f32x4*)(bp + 2048 + s * 64 + cl * 4);
      o.wA = *(const f32x4*)(bp + 3072 + s * 64 + cl * 4);
      o.rA = *(const f32x4*)(bp + 4096 + s * 64 + cl * 4);
      o.vA = bp[5120 + s * 16 + rloc];
      o.cA = *(const f32x2*)(bp + 6400 + s * 2);
      o.bbB = *(const f32x4*)(bp + 1024 + (s + 1) * 64 + cl * 4);
      o.kB = *(const f32x4*)(bp + 2048 + (s + 1) * 64 + cl * 4);
      o.wB = *(const f32x4*)(bp + 3072 + (s + 1) * 64 + cl * 4);
      o.rB = *(const f32x4*)(bp + 4096 + (s + 1) * 64 + cl * 4);
      o.vB = bp[5120 + (s + 1) * 16 + rloc];
    };
    auto pairstep = [&](const Pair& o, int s) {
      const float pa = __builtin_fmaf(S3, o.kkA.w, __builtin_fmaf(S2, o.kkA.z, __builtin_fmaf(S1, o.kkA.y, S0 * o.kkA.x)));
      const float pd = __builtin_fmaf(S3, o.mA.w, __builtin_fmaf(S2, o.mA.z, __builtin_fmaf(S1, o.mA.y, S0 * o.mA.x)));
      const float saA = row_sum16(pa);
      const float dd = row_sum16(pd);
      const float saB = __builtin_fmaf(-saA, o.cA.y, __builtin_fmaf(o.vA, o.cA.x, dd));
      S0 = __builtin_fmaf(S0, o.wA.x, __builtin_fmaf(o.vA, o.kA.x, -(saA * o.bbA.x)));
      S1 = __builtin_fmaf(S1, o.wA.y, __builtin_fmaf(o.vA, o.kA.y, -(saA * o.bbA.y)));
      S2 = __builtin_fmaf(S2, o.wA.z, __builtin_fmaf(o.vA, o.kA.z, -(saA * o.bbA.z)));
      S3 = __builtin_fmaf(S3, o.wA.w, __builtin_fmaf(o.vA, o.kA.w, -(saA * o.bbA.w)));
      pp[(s * 4 + rl) * 16 + cl] = __builtin_fmaf(S3, o.rA.w, __builtin_fmaf(S2, o.rA.z, __builtin_fmaf(S1, o.rA.y, S0 * o.rA.x)));
      S0 = __builtin_fmaf(S0, o.wB.x, __builtin_fmaf(o.vB, o.kB.x, -(saB * o.bbB.x)));
      S1 = __builtin_fmaf(S1, o.wB.y, __builtin_fmaf(o.vB, o.kB.y, -(saB * o.bbB.y)));
      S2 = __builtin_fmaf(S2, o.wB.z, __builtin_fmaf(o.vB, o.kB.z, -(saB * o.bbB.z)));
      S3 = __builtin_fmaf(S3, o.wB.w, __builtin_fmaf(o.vB, o.kB.w, -(saB * o.bbB.w)));
      pp[((s + 1) * 4 + rl) * 16 + cl] = __builtin_fmaf(S3, o.rB.w, __builtin_fmaf(S2, o.rB.z, __builtin_fmaf(S1, o.rB.y, S0 * o.rB.x)));
    };
    Pair p0, p1;
    ldpair(p0, 0);
#pragma unroll
    for (int j = 0; j < 4; ++j) {
      ldpair(p1, 4 * j + 2);
      __builtin_amdgcn_sched_barrier(0);
      pairstep(p0, 4 * j);
      __builtin_amdgcn_sched_barrier(0);
      if (j < 3) ldpair(p0, 4 * j + 4);
      __builtin_amdgcn_sched_barrier(0);
      pairstep(p1, 4 * j + 2);
      __builtin_amdgcn_sched_barrier(0);
    }
    asm volatile("" ::: "memory");
    {
      const float* q0 = pp + (rstep * 4 + rrow) * 16;
      f32x4 a0 = *(const f32x4*)(q0), a1 = *(const f32x4*)(q0 + 4), a2 = *(const f32x4*)(q0 + 8), a3 = *(const f32x4*)(q0 + 12);
      f32x4 sm4 = (a0 + a1) + (a2 + a3);
      O[(tokb + (size_t)c * 16 + rstep) * 256 + chan0 + q * 16 + wv * 4 + rrow] = (sm4.x + sm4.y) + (sm4.z + sm4.w);
    }
    asm volatile("" ::: "memory");
  };
#pragma unroll 1
  for (int g = 0; g < NCH / 4; ++g) {
    const int c0 = g * 4;
    if (c0 + 4 < NCH) gload(R0, c0 + 4);
    chunk(c0);
    lwrite(R1, (c0 + 1) & 1);
    lds_barrier();
    if (c0 + 5 < NCH) gload(R1, c0 + 5);
    chunk(c0 + 1);
    lwrite(R2, (c0 + 2) & 1);
    lds_barrier();
    if (c0 + 6 < NCH) gload(R2, c0 + 6);
    chunk(c0 + 2);
    lwrite(R3, (c0 + 3) & 1);
    lds_barrier();
    if (c0 + 7 < NCH) gload(R3, c0 + 7);
    chunk(c0 + 3);
    if (c0 + 4 < NCH) lwrite(R0, (c0 + 4) & 1);
    lds_barrier();
  }
  __builtin_amdgcn_s_setprio(0);
}

__device__ __forceinline__ void rwkv_post_item(const Params& p, int l, int item) {
  const int j = TIDX;
  const float* O = (const float*)(p.ws + OFF_O);
  const u16* SR = (const u16*)(p.ws + OFF_SR); const u16* SK = (const u16*)(p.ws + OFF_SK);
  const u16* SV = (const u16*)(p.ws + OFF_SV); const u16* G = (const u16*)(p.ws + OFF_G);
  u16* OG = (u16*)(p.ws + OFF_OG);
  const float lw = p.in[18][l * 256 + j], lb = p.in[19][l * 256 + j], rk = p.in[17][l * 256 + j];
  const int tok0 = item * 8;
  float ov[8]; u16 rr[8], rkk[8], rv[8], rg[8];
#pragma unroll
  for (int t = 0; t < 8; ++t) {
    const size_t o = (size_t)(tok0 + t) * 256 + j;
    ov[t] = O[o]; rr[t] = SR[o]; rkk[t] = SK[o]; rv[t] = SV[o]; rg[t] = G[o];
  }
#pragma unroll
  for (int t = 0; t < 8; ++t) {
    const size_t o = (size_t)(tok0 + t) * 256 + j;
    float mean = wave_sum(ov[t]) * (1.f / 64.f);
    float d = ov[t] - mean;
    float var = wave_sum(d * d) * (1.f / 64.f);
    float on = d * rsqrtf(var + 64e-5f) * lw + lb;
    float bonus = wave_sum(bf2f(rr[t]) * bf2f(rkk[t]) * rk);
    OG[o] = f2bf((on + bonus * bf2f(rv[t])) * bf2f(rg[t]));
  }
}

#define XB_TMO      128
#define XB_XCNT(j)  (256  + 64 * (j))
#define XB_XSUB(j)  (1280 + 64 * (j))
#define XB_XGEN(j)  (2304 + 64 * (j))
#define XB_TOP      3328
#define XB_TOPGEN   3392
#define XCD_BAR_WORDS 3456
#define XB_SPIN_CAP (1u << 22)
#define LAS __attribute__((address_space(3)))
__device__ __forceinline__ unsigned xb_ld(unsigned* p) { return __hip_atomic_load(p, __ATOMIC_RELAXED, __HIP_MEMORY_SCOPE_AGENT); }
__device__ __forceinline__ unsigned xb_add(unsigned* p, unsigned v) { return __hip_atomic_fetch_add(p, v, __ATOMIC_RELAXED, __HIP_MEMORY_SCOPE_AGENT); }
__device__ __forceinline__ unsigned xb_xcc_id() { return (unsigned)__builtin_amdgcn_s_getreg((3 << 11) | 20) & 0xFu; }
#define XB_SPIN(cond, bar) do { unsigned _sp = 0; while (cond) { __builtin_amdgcn_s_sleep(1); \
    if ((++_sp & 255u) == 0u) { if (xb_ld(&(bar)[XB_TMO])) break; if (_sp > XB_SPIN_CAP) { atomicAdd(&(bar)[XB_TMO], 1u); break; } } } } while (0)
struct XcdBarrier { unsigned* bar; unsigned x; volatile LAS unsigned* st; };
__device__ __forceinline__ XcdBarrier xcd_barrier_post(unsigned* bar, volatile LAS unsigned* st) {
  XcdBarrier b; b.bar = bar; b.x = xb_xcc_id(); b.st = st;
  if (threadIdx.x == 0) st[2] = xb_add(&bar[XB_XCNT(b.x)], 1u);
  return b;
}
__device__ __forceinline__ void xcd_barrier_complete(unsigned* bar, unsigned x, unsigned& nloc, unsigned& nx) {
  const unsigned G = gridDim.x * gridDim.y * gridDim.z;
  unsigned sum, cnt, mine, sp = 0u;
  for (;;) {
    sum = 0u; cnt = 0u; mine = 0u;
#pragma unroll
    for (unsigned j = 0; j < 16; ++j) { const unsigned c = xb_ld(&bar[XB_XCNT(j)]); sum += c; cnt += (c > 0u) ? 1u : 0u; mine = (j == x) ? c : mine; }
    if (sum == G) break;
    __builtin_amdgcn_s_sleep(1);
    if ((++sp & 255u) == 0u) { if (xb_ld(&bar[XB_TMO])) break; if (sp > XB_SPIN_CAP) { atomicAdd(&bar[XB_TMO], 1u); break; } }
  }
  nloc = mine > 0u ? mine : 1u; nx = cnt > 0u ? cnt : 1u;
}
__device__ __forceinline__ void xcd_barrier(const XcdBarrier& b) {
  asm volatile("s_waitcnt vmcnt(0)" ::: "memory");
  __syncthreads();
  if (threadIdx.x == 0) {
    unsigned* bar = b.bar;
    __builtin_amdgcn_s_waitcnt(0);
    unsigned nloc = b.st[0], nx = b.st[1];
    if (nloc == 0u) { xcd_barrier_complete(bar, b.x, nloc, nx); b.st[0] = nloc; b.st[1] = nx; }
    const unsigned old = xb_add(&bar[XB_XSUB(b.x)], 1u);
    const unsigned gen = old / nloc;
    if (old + 1u == (gen + 1u) * nloc) {
      __builtin_amdgcn_fence(__ATOMIC_RELEASE, "agent");
      asm volatile("s_waitcnt vmcnt(0)" ::: "memory");
      const unsigned og = xb_add(&bar[XB_TOP], 1u);
      const unsigned tg = og / nx;
      if (og + 1u == (tg + 1u) * nx) xb_add(&bar[XB_TOPGEN], 1u);
      else XB_SPIN(xb_ld(&bar[XB_TOPGEN]) == tg, bar);
      __builtin_amdgcn_fence(__ATOMIC_ACQUIRE, "agent");
      xb_add(&bar[XB_XGEN(b.x)], 1u);
      asm volatile("s_waitcnt vmcnt(0)" ::: "memory");
    } else {
      XB_SPIN(xb_ld(&bar[XB_XGEN(b.x)]) == gen, bar);
      __builtin_amdgcn_fence(__ATOMIC_ACQUIRE, "agent");
      asm volatile("s_waitcnt vmcnt(0)" ::: "memory");
    }
  }
  __syncthreads();
}

__device__ __forceinline__ int xcd_virtual_id(const XcdBarrier& b) {
  if (threadIdx.x == 0) {
    unsigned base = 0u;
#pragma unroll
    for (unsigned j = 0; j < 16; ++j) { const unsigned c = xb_ld(&b.bar[XB_XCNT(j)]); base += (j < b.x) ? c : 0u; }
    b.st[3] = base + b.st[2];
  }
  __syncthreads();
  const int vb = __builtin_amdgcn_readfirstlane((int)b.st[3]);
  __syncthreads();
  return vb;
}

__device__ __forceinline__ void sub_barrier(unsigned* cnt, unsigned target) {
  asm volatile("s_waitcnt vmcnt(0)" ::: "memory");
  __syncthreads();
  if (threadIdx.x == 0) {
    __builtin_amdgcn_fence(__ATOMIC_RELEASE, "agent");
    asm volatile("s_waitcnt vmcnt(0)" ::: "memory");
    xb_add(cnt, 1u);
    unsigned sp = 0;
    while (xb_ld(cnt) < target) { __builtin_amdgcn_s_sleep(2); if (++sp > (1u << 24)) break; }
    __builtin_amdgcn_fence(__ATOMIC_ACQUIRE, "agent");
    asm volatile("s_waitcnt vmcnt(0)" ::: "memory");
  }
  __syncthreads();
}

#define N_PHASES 22
#ifndef PROBE_CONV_REPS
#define PROBE_CONV_REPS 1
#endif
#ifndef PROBE_PREP_REPS
#define PROBE_PREP_REPS 1
#endif
#ifndef PROBE_POST_REPS
#define PROBE_POST_REPS 1
#endif
#ifndef PROBE_SCAN_REPS
#define PROBE_SCAN_REPS 1
#endif
#ifndef PROBE_FFN1_REPS
#define PROBE_FFN1_REPS 1
#endif
#ifndef PH_MASK
#define PH_MASK 0xFFFFF
#endif
#define PHON(s) (PH_MASK & (1 << (s)))
#define PHASE_BEGIN(k) if (ph_hi > (k)) { if ((k) > 1) xcd_barrier(xb);
#define PHASE_END }

template <int L>
__device__ __forceinline__ void run_layer(const Params& p, int vbr, int ph_hi, unsigned char* smem_all, const XcdBarrier& xb) {
  unsigned char* smem = smem_all + SUBB * 73728;
  const int vb = vbr * 2 + SUBB;
  constexpr int l = L;
  constexpr int base = 1 + 10 * L;
  const float* modl = (const float*)(p.ws + OFF_MOD) + (size_t)l * 4 * 6144;
  PHASE_BEGIN(base + 0)
    for (int rep = 0; rep < PROBE_CONV_REPS; ++rep) {
      if (rep) xcd_barrier(xb);
      phase_convert(p, l, smem);
      phase_norm(l == 0 ? p.in[0] : p.out, p.in[4] + l * 1024, modl, 0, 1024, (u16*)(p.ws + OFF_H));
    }
  PHASE_END
  PHASE_BEGIN(base + 1)
    phase_pproj_tail(p, vbr, smem_all);
    phase_gemm_8w<0>(p, l, vbr, smem_all);
  PHASE_END
  PHASE_BEGIN(base + 2)
    for (int rep = 0; rep < PROBE_PREP_REPS; ++rep) {
      if (rep) xcd_barrier(xb);
      for (int item = VBLK; item < 512; item += VGRID) rwkv_prep_item(p, l, item, smem);
    }
  PHASE_END
  PHASE_BEGIN(base + 3)
    if ((int)blockIdx.x < 64) {
      if (SUBB == 0) scan_item(p, blockIdx.x, smem);
      else { __syncthreads(); __syncthreads(); for (int c = 0; c < SEQ / 16; ++c) lds_barrier(); }
    }
    else {
      const int nb = VGRID - 128, bi = VBLK - 128;
      for (int item = bi; item < 512; item += nb) sg_item(p, l, item, smem);
      for (int item = (bi + 2 * (nb / 3)) % nb; item < 1024; item += nb) s5a_item(p, l, item, smem);
      for (int item = (bi + 2 * (nb / 3)) % nb; item < 2048; item += nb) conv_item(p, l, item);
      sub_barrier((unsigned*)(p.ws + OFF_BAR) + 3520 + 64 * (2 * l), gridDim.x - 64);
      for (int item = bi; item < 1024; item += nb) s5b_item(p, l, item, smem);
      sub_barrier((unsigned*)(p.ws + OFF_BAR) + 3520 + 64 * (2 * l + 1), gridDim.x - 64);
      for (int item = (int)blockIdx.x - 64; item < 512; item += (int)gridDim.x - 64) merge_tile8<0>(p, item, smem_all);
    }
  PHASE_END
  PHASE_BEGIN(base + 4)
    for (int rep = 0; rep < PROBE_POST_REPS; ++rep) { if (rep) xcd_barrier(xb); for (int item = VBLK; item < 2048; item += VGRID) rwkv_post_item(p, l, item); }
  PHASE_END
  PHASE_BEGIN(base + 5)
    for (int item = vbr; item < 512; item += (int)gridDim.x) {
      int it2 = item;
      if (gridDim.x == 256) { const int r = item >> 8, w = vbr & 31; it2 = ((r * 4 + (w >> 3)) << 6) | ((vbr >> 5) * 8 + (w & 7)); }
      merge_tile8<1>(p, it2, smem_all);
    }
  PHASE_END
  PHASE_BEGIN(base + 6)
    phase_gemm_8w<1>(p, l, vbr, smem_all);
  PHASE_END
  PHASE_BEGIN(base + 7)
    if (PHON(7)) phase_norm(p.out, p.in[38] + l * 1024, modl, 3072, 4096, (u16*)(p.ws + OFF_H));
  PHASE_END
  PHASE_BEGIN(base + 8)
    phase_gemm_8w<2>(p, l, vbr, smem_all);
  PHASE_END
#ifdef PROBE_DUP_FFN1
  PHASE_BEGIN(base + 8)
    phase_gemm_8w<2>(p, l, vbr, smem_all);
  PHASE_END
#endif
  PHASE_BEGIN(base + 9)
    phase_gemm_8w<3>(p, l, vbr, smem_all);
  PHASE_END
}

__global__ void __launch_bounds__(512, 2) mega_fwd(Params p, int ph_lo, int ph_hi) {
  __shared__ __attribute__((aligned(16))) unsigned char smem[2 * 73728 + 16];
  cg::grid_group grid = cg::this_grid();
  if (ph_hi < 0) grid.sync();
  volatile LAS unsigned* st = (volatile LAS unsigned*)(smem + 2 * 73728);
  if (threadIdx.x == 0) { st[0] = 0u; st[1] = 0u; st[2] = 0u; st[3] = 0u; }
  __syncthreads();
  const XcdBarrier xb = xcd_barrier_post((unsigned*)(p.ws + OFF_BAR), st);
  if (ph_hi > 0) phase_mod(p, smem + SUBB * 73728);
  xcd_barrier(xb);
  const int vb = xcd_virtual_id(xb);
  run_layer<0>(p, vb, ph_hi, smem, xb);
  run_layer<1>(p, vb, ph_hi, smem, xb);
  PHASE_BEGIN(21)
    if (PHON(11)) phase_final(p.out, p.in[41]);
  PHASE_END
}

extern "C" void kernel_launch(void* const* d_in, const int* in_sizes, int n_in, void* d_out, int out_size, void* d_ws,
                              size_t ws_size, hipStream_t stream) {
  static int grid_blocks = 0;
  if (!grid_blocks) {
    int dev = 0, cus = 0, per_cu = 0;
    hipGetDevice(&dev);
    hipDeviceGetAttribute(&cus, hipDeviceAttributeMultiprocessorCount, dev);
    hipOccupancyMaxActiveBlocksPerMultiprocessor(&per_cu, mega_fwd, 512, 0);
    if (per_cu > 1) per_cu = 1;
    if (per_cu < 1) per_cu = 1;
    grid_blocks = cus * per_cu;
    if (ws_size < WS_END) fprintf(stderr, "workspace too small: %zu < %zu\n", ws_size, (size_t)WS_END);
  }
  Params p{};
  for (int i = 0; i < 42; ++i) p.in[i] = (const float*)d_in[i];
  p.out = (float*)d_out;
  p.ws = (unsigned char*)d_ws;
  hipMemsetAsync((unsigned char*)d_ws + OFF_BAR, 0, 16384, stream);
  int lo = 0, hi = N_PHASES;
  void* args[] = {&p, &lo, &hi};
  hipError_t e = hipLaunchCooperativeKernel((void*)mega_fwd, dim3(grid_blocks), dim3(512), args, 0, stream);
  if (e != hipSuccess) fprintf(stderr, "cooperative launch failed: %s (grid %d)\n", hipGetErrorString(e), grid_blocks);
}
```

```cpp
#include <hip/hip_runtime.h>
#include <hip/hip_cooperative_groups.h>
#include <cstdio>
namespace cg = cooperative_groups;

typedef unsigned short u16;
using bf16x8 = __attribute__((ext_vector_type(8))) short;
using f32x4 = __attribute__((ext_vector_type(4))) float;
using u32x4 = __attribute__((ext_vector_type(4))) unsigned int;
using u32x2 = __attribute__((ext_vector_type(2))) unsigned int;
using f32x2 = __attribute__((ext_vector_type(2))) float;

#define T_TOK 16384
#define SEQ 4096
#define DM 1024
#define NTHR 256
#define TIDX ((int)(threadIdx.x & 255))
#define SUBB ((int)(threadIdx.x >> 8))
#define VBLK ((int)(blockIdx.x * 2 + (threadIdx.x >> 8)))
#define VGRID ((int)(gridDim.x * 2))

static constexpr size_t SZ_WIN = (size_t)6528 * 1024 * 2;
static constexpr size_t OFF_WIN = 0;
static constexpr size_t OFF_RO = OFF_WIN + SZ_WIN;
static constexpr size_t OFF_SO = OFF_RO + 1024 * 256 * 2;
static constexpr size_t OFF_CO = OFF_SO + 1024 * 256 * 2;
static constexpr size_t OFF_GLU = OFF_CO + 1024 * 256 * 2;
static constexpr size_t OFF_WO = OFF_GLU + 2048 * 256 * 2;
static constexpr size_t OFF_W1 = OFF_WO + 1024 * 1024 * 2;
static constexpr size_t OFF_W2 = OFF_W1 + (size_t)4096 * 1024 * 2;
static constexpr size_t OFF_H = OFF_W2 + (size_t)4096 * 1024 * 2;
static constexpr size_t SZ_T256B = (size_t)T_TOK * 256 * 2;
static constexpr size_t OFF_VF = OFF_H + (size_t)T_TOK * 1024 * 2;
static constexpr size_t OFF_PD = OFF_VF + SZ_T256B;
static constexpr size_t OFF_G = OFF_PD + SZ_T256B;
static constexpr size_t OFF_UB = OFF_G + SZ_T256B;
static constexpr size_t OFF_CB = OFF_UB + SZ_T256B;
static constexpr size_t OFF_SR = OFF_CB + SZ_T256B;
static constexpr size_t OFF_SK = OFF_SR + SZ_T256B;
static constexpr size_t OFF_SV = OFF_SK + SZ_T256B;
static constexpr size_t OFF_SKK = OFF_SV + SZ_T256B;
static constexpr size_t OFF_SA = OFF_SKK + SZ_T256B;
static constexpr size_t OFF_SW = OFF_SA + SZ_T256B;
static constexpr size_t OFF_PABC = OFF_SW + 2 * SZ_T256B;
static constexpr size_t OFF_YD = OFF_PABC;
static constexpr size_t OFF_OG = OFF_YD + SZ_T256B;
static constexpr size_t OFF_MRG = OFF_OG + SZ_T256B;
static constexpr size_t OFF_F = OFF_UB;
static constexpr size_t OFF_SMALL = OFF_PABC + (size_t)T_TOK * 2176 * 2;
static constexpr size_t OFF_MOD = OFF_SMALL;
static constexpr size_t OFF_S5AB = OFF_MOD + 2 * 4 * 6144 * 4;
static constexpr size_t OFF_S5BB = OFF_S5AB + 2 * 16 * 64 * 2 * 4;
static constexpr size_t OFF_S5E = OFF_S5BB + 2 * 16 * 64 * 32 * 4;
static constexpr size_t OFF_BAR = OFF_S5E + (size_t)4 * 64 * 16 * 64 * 2 * 4;
static constexpr size_t OFF_SGW = OFF_BAR + 16384;
static constexpr size_t OFF_O = OFF_SGW + 4 * 128 * 128 * 2;
static constexpr size_t OFF_LW2 = OFF_O + 2 * SZ_T256B;
static constexpr size_t OFF_LA2 = OFF_LW2 + 256 * 32 * 2;
static constexpr size_t OFF_LG2 = OFF_LA2 + 256 * 32 * 2;
static constexpr size_t OFF_LV2 = OFF_LG2 + 256 * 64 * 2;
static constexpr size_t OFF_LV1 = OFF_LV2 + 256 * 32 * 2;
static constexpr size_t OFF_SGST = OFF_LV1 + 32 * 256 * 2;
static constexpr size_t WS_END = OFF_SGST + (size_t)T_TOK * 2 * 4;
static_assert(OFF_F + (size_t)T_TOK * 4096 * 2 <= OFF_SMALL, "F overlaps small region");
static_assert(OFF_MRG + (size_t)T_TOK * 1024 * 2 <= OFF_SMALL, "MRG overlaps");

struct Params {
  const float* in[42];
  float* out;
  unsigned char* ws;
};

__device__ __forceinline__ u16 f2bf(float f) {
  unsigned u = __float_as_uint(f);
  u += 0x7fffu + ((u >> 16) & 1u);
  return (u16)(u >> 16);
}
__device__ __forceinline__ float bf2f(u16 h) { return __uint_as_float(((unsigned)h) << 16); }
__device__ __forceinline__ float bflo(unsigned u) { return __uint_as_float(u << 16); }
__device__ __forceinline__ float bfhi(unsigned u) { return __uint_as_float(u & 0xffff0000u); }
__device__ __forceinline__ unsigned pack2(float a, float b) { return (unsigned)f2bf(a) | ((unsigned)f2bf(b) << 16); }
__device__ __forceinline__ float sigmoidf_(float x) { return 1.f / (1.f + __expf(-x)); }
__device__ __forceinline__ float tanhf_(float y) { return 1.f - 2.f / (1.f + __expf(2.f * y)); }
__device__ __forceinline__ float geluf_(float x) {
  float y = 0.7978845608028654f * (x + 0.044715f * x * x * x);
  return 0.5f * x * (1.f + tanhf_(y));
}
__device__ __forceinline__ float wave_sum(float v) {
#pragma unroll
  for (int o = 32; o > 0; o >>= 1) v += __shfl_xor(v, o, 64);
  return v;
}
template <int CTRL>
__device__ __forceinline__ float dppf(float x) {
  return __int_as_float(__builtin_amdgcn_update_dpp(__float_as_int(x), __float_as_int(x), CTRL, 0xF, 0xF, true));
}
__device__ __forceinline__ float row_sum16(float x) {
  x += dppf<0x128>(x);
  x += dppf<0x124>(x);
  x += dppf<0x122>(x);
  x += dppf<0x121>(x);
  return x;
}

__device__ __forceinline__ void phase_mod(const Params& p, unsigned char* smem) {
  const int tid = TIDX;
  float* cact = (float*)smem;
  float* red = cact + 4096;
  float* mod = (float*)(p.ws + OFF_MOD);
  for (int i = tid; i < 4096; i += NTHR) { float c = p.in[1][i]; cact[i] = c / (1.f + __expf(-c)); }
  __syncthreads();
  for (int item = VBLK; item < 192; item += VGRID) {
    int l = item / 96, nb = item % 96;
    int cl = tid & 63, kq = tid >> 6;
    int col = nb * 64 + cl;
    const float* W = p.in[2] + (size_t)l * 1024 * 6144;
    float a0 = 0, a1 = 0, a2 = 0, a3 = 0;
    for (int k = kq * 256; k < kq * 256 + 256; ++k) {
      float w = W[(size_t)k * 6144 + col];
      a0 += cact[k] * w; a1 += cact[1024 + k] * w; a2 += cact[2048 + k] * w; a3 += cact[3072 + k] * w;
    }
    red[(kq * 4 + 0) * 64 + cl] = a0; red[(kq * 4 + 1) * 64 + cl] = a1;
    red[(kq * 4 + 2) * 64 + cl] = a2; red[(kq * 4 + 3) * 64 + cl] = a3;
    __syncthreads();
    {
      int b = tid >> 6;
      float s = red[(0 * 4 + b) * 64 + cl] + red[(1 * 4 + b) * 64 + cl] + red[(2 * 4 + b) * 64 + cl] + red[(3 * 4 + b) * 64 + cl];
      mod[((size_t)l * 4 + b) * 6144 + col] = s + p.in[3][l * 6144 + col];
    }
    __syncthreads();
  }
  float* s5ab = (float*)(p.ws + OFF_S5AB);
  float* s5bb = (float*)(p.ws + OFF_S5BB);
  for (int idx = VBLK * NTHR + tid; idx < 2048; idx += VGRID * NTHR) {
    int l = idx >> 10, g = (idx >> 6) & 15, n = idx & 63;
    double lre = fmin((double)p.in[28][idx], -1e-4);
    double lim = (double)p.in[29][idx];
    double dt = exp((double)p.in[35][l * 16 + g]);
    double mag = exp(lre * dt);
    double abr = mag * cos(lim * dt), abi = mag * sin(lim * dt);
    double den = lre * lre + lim * lim;
    double qr = ((abr - 1.0) * lre + abi * lim) / den;
    double qi = (abi * lre - (abr - 1.0) * lim) / den;
    s5ab[idx * 2 + 0] = (float)abr; s5ab[idx * 2 + 1] = (float)abi;
    for (int c = 0; c < 16; ++c) {
      double br = p.in[30][(size_t)idx * 16 + c], bi = p.in[31][(size_t)idx * 16 + c];
      s5bb[(size_t)idx * 32 + c] = (float)(qr * br - qi * bi);
      s5bb[(size_t)idx * 32 + 16 + c] = (float)(qr * bi + qi * br);
    }
  }
}

__device__ __forceinline__ void convert_tile(const float* __restrict__ src, int K, int N, u16* __restrict__ dst, int tk, int tn, u16* sm) {
  const int tid = TIDX;
  int r = tid >> 4, c4 = (tid & 15) * 4;
#pragma unroll
  for (int i = 0; i < 4; ++i) {
    int kk = r + 16 * i;
    float4 v = *(const float4*)(src + (size_t)(tk * 64 + kk) * N + tn * 64 + c4);
    sm[(c4 + 0) * 72 + kk] = f2bf(v.x);
    sm[(c4 + 1) * 72 + kk] = f2bf(v.y);
    sm[(c4 + 2) * 72 + kk] = f2bf(v.z);
    sm[(c4 + 3) * 72 + kk] = f2bf(v.w);
  }
  __syncthreads();
#pragma unroll
  for (int j = 0; j < 2; ++j) {
    int n = (tid >> 3) + 32 * j, ch = tid & 7;
    u32x4 v = *(const u32x4*)(sm + n * 72 + ch * 8);
    *(u32x4*)(dst + (size_t)(tn * 64 + n) * K + tk * 64 + ch * 8) = v;
  }
  __syncthreads();
}

__device__ __forceinline__ void phase_convert(const Params& p, int l, unsigned char* smem) {
  u16* sm = (u16*)smem;
  const int total = 1632 + 192 + 128 + 256 + 1024 + 1024;
  for (int item = VBLK; item < total + 16 + 192; item += VGRID) {
    int t = item;
    if (t >= total + 16) {
      const int e = (t - total - 16) * 256 + TIDX;
      if (e < 8192) { const int n = e >> 5, k = e & 31; ((u16*)(p.ws + OFF_LW2))[e] = f2bf(p.in[8][(size_t)l * 8192 + k * 256 + n]); }
      else if (e < 16384) { const int q = e - 8192, n = q >> 5, k = q & 31; ((u16*)(p.ws + OFF_LA2))[q] = f2bf(p.in[10][(size_t)l * 8192 + k * 256 + n]); }
      else if (e < 32768) { const int q = e - 16384, n = q >> 6, k = q & 63; ((u16*)(p.ws + OFF_LG2))[q] = f2bf(p.in[11][(size_t)l * 16384 + k * 256 + n]); }
      else if (e < 40960) { const int q = e - 32768, n = q >> 5, k = q & 31; ((u16*)(p.ws + OFF_LV2))[q] = (l > 0) ? f2bf(p.in[14][k * 256 + n]) : (u16)0; }
      else { const int q = e - 40960, n = q >> 8, k = q & 255; ((u16*)(p.ws + OFF_LV1))[q] = (l > 0) ? f2bf(p.in[13][k * 32 + n]) : (u16)0; }
      continue;
    }
    if (t >= total) {
      const int idx = t - total, g = idx >> 2, rq = idx & 3;
      const int tr = rq * 32 + (TIDX >> 3), s0 = (TIDX & 7) * 16;
      const float* src = p.in[23] + (((size_t)l * 4 + g) * 128 + tr) * 128 + s0;
      u16* dst = (u16*)(p.ws + OFF_SGW) + ((size_t)g * 128 + tr) * 128 + s0;
      unsigned pk[8];
#pragma unroll
      for (int e = 0; e < 4; ++e) {
        f32x4 v = *(const f32x4*)(src + e * 4);
        const int sb = s0 + e * 4;
        pk[e * 2 + 0] = pack2(sb + 0 <= tr ? v.x : 0.f, sb + 1 <= tr ? v.y : 0.f);
        pk[e * 2 + 1] = pack2(sb + 2 <= tr ? v.z : 0.f, sb + 3 <= tr ? v.w : 0.f);
      }
      *(u32x4*)(dst) = u32x4{pk[0], pk[1], pk[2], pk[3]};
      *(u32x4*)(dst + 8) = u32x4{pk[4], pk[5], pk[6], pk[7]};
      continue;
    }
    const float* src; int K, N; size_t off;
    if (t < 1632) { src = p.in[5] + (size_t)l * 1024 * 6528; K = 1024; N = 6528; off = OFF_WIN; }
    else if ((t -= 1632) < 64) { src = p.in[20] + (size_t)l * 256 * 1024; K = 256; N = 1024; off = OFF_RO; }
    else if ((t -= 64) < 64) { src = p.in[25] + (size_t)l * 256 * 1024; K = 256; N = 1024; off = OFF_SO; }
    else if ((t -= 64) < 64) { src = p.in[27] + (size_t)l * 256 * 1024; K = 256; N = 1024; off = OFF_CO; }
    else if ((t -= 64) < 128) { src = p.in[36] + (size_t)l * 256 * 2048; K = 256; N = 2048; off = OFF_GLU; }
    else if ((t -= 128) < 256) { src = p.in[37] + (size_t)l * 1024 * 1024; K = 1024; N = 1024; off = OFF_WO; }
    else if ((t -= 256) < 1024) { src = p.in[39] + (size_t)l * 1024 * 4096; K = 1024; N = 4096; off = OFF_W1; }
    else { t -= 1024; src = p.in[40] + (size_t)l * 4096 * 1024; K = 4096; N = 1024; off = OFF_W2; }
    int ntn = N / 64;
    convert_tile(src, K, N, (u16*)(p.ws + off), t / ntn, t % ntn, sm);
  }
}

__device__ __forceinline__ void phase_norm(const float* __restrict__ X, const float* __restrict__ g, const float* __restrict__ modl,
                           int sh_off, int sc_off, u16* __restrict__ H) {
  const int lane = TIDX & 63, wv = TIDX >> 6;
  for (int item = VBLK; item < T_TOK / 4; item += VGRID) {
    int row = item * 4 + wv;
    int b = row >> 12;
    const float* xr = X + (size_t)row * 1024;
    float4 v[4];
    float ss = 0;
#pragma unroll
    for (int i = 0; i < 4; ++i) {
      v[i] = *(const float4*)(xr + lane * 4 + 256 * i);
      ss += v[i].x * v[i].x + v[i].y * v[i].y + v[i].z * v[i].z + v[i].w * v[i].w;
    }
    ss = wave_sum(ss);
    float rstd = rsqrtf(ss * (1.f / 1024.f) + 1e-6f);
    const float* sh = modl + (size_t)b * 6144 + sh_off;
    const float* sc = modl + (size_t)b * 6144 + sc_off;
#pragma unroll
    for (int i = 0; i < 4; ++i) {
      int c = lane * 4 + 256 * i;
      float4 gg = *(const float4*)(g + c);
      float4 s1 = *(const float4*)(sc + c);
      float4 s0 = *(const float4*)(sh + c);
      float h0 = v[i].x * rstd * gg.x * (1.f + s1.x) + s0.x;
      float h1 = v[i].y * rstd * gg.y * (1.f + s1.y) + s0.y;
      float h2 = v[i].z * rstd * gg.z * (1.f + s1.z) + s0.z;
      float h3 = v[i].w * rstd * gg.w * (1.f + s1.w) + s0.w;
      u32x2 o; o.x = pack2(h0, h1); o.y = pack2(h2, h3);
      *(u32x2*)(H + (size_t)row * 1024 + c) = o;
    }
  }
}

__device__ __forceinline__ void phase_final(float* __restrict__ X, const float* __restrict__ g) {
  const int lane = TIDX & 63, wv = TIDX >> 6;
  for (int item = VBLK; item < T_TOK / 4; item += VGRID) {
    int row = item * 4 + wv;
    float* xr = X + (size_t)row * 1024;
    float4 v[4];
    float ss = 0;
#pragma unroll
    for (int i = 0; i < 4; ++i) {
      v[i] = *(const float4*)(xr + lane * 4 + 256 * i);
      ss += v[i].x * v[i].x + v[i].y * v[i].y + v[i].z * v[i].z + v[i].w * v[i].w;
    }
    ss = wave_sum(ss);
    float rstd = rsqrtf(ss * (1.f / 1024.f) + 1e-6f);
#pragma unroll
    for (int i = 0; i < 4; ++i) {
      int c = lane * 4 + 256 * i;
      float4 gg = *(const float4*)(g + c);
      float4 o;
      o.x = v[i].x * rstd * gg.x; o.y = v[i].y * rstd * gg.y; o.z = v[i].z * rstd * gg.z; o.w = v[i].w * rstd * gg.w;
      *(float4*)(xr + c) = o;
    }
  }
}

template <int NF, bool LEAN = false>
__device__ __forceinline__ void gemm_mainloop(const u16* __restrict__ A, int lda, const u16* __restrict__ B, int ldb,
                                              int K, f32x4 (&acc)[4][NF], u16* smem) {
  constexpr int BN = 32 * NF;
  constexpr int NB = BN / 32;
  u16* sA = smem;
  u16* sB = smem + 2 * 128 * 64;
  int tz = 0;
  if (LEAN) asm volatile("" : "+v"(tz));
  const int tid = TIDX + tz, lane = tid & 63, wv = tid >> 6;
  const int wm = wv >> 1, wn = wv & 1;
  const int lrow = tid >> 3;
  const int lchs = (tid & 7) ^ ((lrow >> 1) & 7);
  const u16* Ap = A + (size_t)lrow * lda + lchs * 8;
  const u16* Bp = B + (size_t)lrow * ldb + lchs * 8;
  const int nk = K >> 6;
  auto stage = [&](int kt, int buf) {
    const int ko = kt << 6;
#pragma unroll
    for (int i = 0; i < 4; ++i)
      __builtin_amdgcn_global_load_lds((const unsigned*)(Ap + (size_t)(32 * i) * lda + ko),
                                       (__attribute__((address_space(3))) unsigned*)(sA + buf * (128 * 64) + (tid + 256 * i) * 8), 16, 0, 0);
#pragma unroll
    for (int i = 0; i < NB; ++i)
      __builtin_amdgcn_global_load_lds((const unsigned*)(Bp + (size_t)(32 * i) * ldb + ko),
                                       (__attribute__((address_space(3))) unsigned*)(sB + buf * (BN * 64) + (tid + 256 * i) * 8), 16, 0, 0);
  };
  __syncthreads();
  stage(0, 0);
  const int fr = lane & 15, fq = lane >> 4;
  const int sw = (fr >> 1) & 7;
  for (int kt = 0; kt < nk; ++kt) {
    const int cur = kt & 1;
    asm volatile("s_waitcnt vmcnt(0)" ::: "memory");
    __syncthreads();
    if (kt + 1 < nk) stage(kt + 1, cur ^ 1);
    const u16* cA = sA + cur * (128 * 64) + (wm * 64 + fr) * 64;
    const u16* cB = sB + cur * (BN * 64) + (wn * 16 * NF + fr) * 64;
#pragma unroll
    for (int ks = 0; ks < 2; ++ks) {
      if (LEAN) __builtin_amdgcn_sched_barrier(0);
      const int pc = ((fq + 4 * ks) ^ sw) << 3;
      bf16x8 fa[4], fb[NF];
#pragma unroll
      for (int i = 0; i < 4; ++i) fa[i] = *(const bf16x8*)(cA + i * 16 * 64 + pc);
#pragma unroll
      for (int j = 0; j < NF; ++j) fb[j] = *(const bf16x8*)(cB + j * 16 * 64 + pc);
#pragma unroll
      for (int i = 0; i < 4; ++i)
#pragma unroll
        for (int j = 0; j < NF; ++j)
          acc[i][j] = __builtin_amdgcn_mfma_f32_16x16x32_bf16(fb[j], fa[i], acc[i][j], 0, 0, 0);
    }
  }
}

template <int NF>
__device__ __forceinline__ void zero_acc(f32x4 (&acc)[4][NF]) {
#pragma unroll
  for (int i = 0; i < 4; ++i)
#pragma unroll
    for (int j = 0; j < NF; ++j) acc[i][j] = f32x4{0.f, 0.f, 0.f, 0.f};
}

template <bool PERM>
__device__ __forceinline__ void gemm_mainloop_8w(const u16* __restrict__ A, int lda, const u16* __restrict__ B, int ldb,
                                                 int K, f32x4 (&acc)[8][4], u16* smem) {
  constexpr int STG = 32768;
  const int tid = threadIdx.x, lane = tid & 63, wv = tid >> 6;
  const int wm = wv >> 2, wn = wv & 3;
  const int lrow = tid >> 3;
  const int lchs = (tid & 7) ^ ((lrow >> 1) & 7);
  const u16* Ap = A + (size_t)lrow * lda + lchs * 8;
  const int rho = lrow & 31, pi = rho & 15;
  const int brow = PERM ? ((lrow & ~31) + 8 * (pi >> 2) + 4 * (rho >> 4) + (pi & 3)) : lrow;
  const u16* Bp = B + (size_t)brow * ldb + lchs * 8;
  const int nk = K >> 6;
  auto stage = [&](int kt, int buf) {
    const int ko = kt << 6;
    u16* sa = smem + buf * STG;
#pragma unroll
    for (int i = 0; i < 4; ++i)
      __builtin_amdgcn_global_load_lds((const unsigned*)(Ap + (size_t)(64 * i) * lda + ko),
                                       (__attribute__((address_space(3))) unsigned*)(sa + (tid + 512 * i) * 8), 16, 0, 0);
#pragma unroll
    for (int i = 0; i < 4; ++i)
      __builtin_amdgcn_global_load_lds((const unsigned*)(Bp + (size_t)(64 * i) * ldb + ko),
                                       (__attribute__((address_space(3))) unsigned*)(sa + 16384 + (tid + 512 * i) * 8), 16, 0, 0);
  };
  __syncthreads();
  stage(0, 0);
  const int fr = lane & 15, fq = lane >> 4;
  const int sw = (fr >> 1) & 7;
  for (int kt = 0; kt < nk; ++kt) {
    const int cur = kt & 1;
    asm volatile("s_waitcnt vmcnt(0)" ::: "memory");
    __syncthreads();
    if (kt + 1 < nk) stage(kt + 1, cur ^ 1);
    const u16* cA = smem + cur * STG + (wm * 128 + fr) * 64;
    const u16* cB = smem + cur * STG + 16384 + (wn * 64 + fr) * 64;
#pragma unroll
    for (int ks = 0; ks < 2; ++ks) {
      const int pc = ((fq + 4 * ks) ^ sw) << 3;
      bf16x8 fa[8], fb[4];
#pragma unroll
      for (int i = 0; i < 8; ++i) fa[i] = *(const bf16x8*)(cA + i * 16 * 64 + pc);
#pragma unroll
      for (int j = 0; j < 4; ++j) fb[j] = *(const bf16x8*)(cB + j * 16 * 64 + pc);
#pragma unroll
      for (int i = 0; i < 8; ++i)
#pragma unroll
        for (int j = 0; j < 4; ++j)
          acc[i][j] = __builtin_amdgcn_mfma_f32_16x16x32_bf16(fb[j], fa[i], acc[i][j], 0, 0, 0);
    }
  }
}

template <int EPI>
__device__ __forceinline__ void phase_gemm_8w(const Params& p, int l, int vb, unsigned char* smem_raw) {
  u16* smem = (u16*)smem_raw;
  const int lane = threadIdx.x & 63, wv = threadIdx.x >> 6;
  const int wm = wv >> 2, wn = wv & 3;
  const int fr = lane & 15, fq = lane >> 4;
  const u16* A; const u16* B; int lda, ldb, K, ntiles_n;
  if (EPI == 0) { A = (const u16*)(p.ws + OFF_H); lda = 1024; B = (const u16*)(p.ws + OFF_WIN); ldb = 1024; K = 1024; ntiles_n = 8; }
  if (EPI == 1) { A = (const u16*)(p.ws + OFF_MRG); lda = 1024; B = (const u16*)(p.ws + OFF_WO); ldb = 1024; K = 1024; ntiles_n = 4; }
  if (EPI == 2) { A = (const u16*)(p.ws + OFF_H); lda = 1024; B = (const u16*)(p.ws + OFF_W1); ldb = 1024; K = 1024; ntiles_n = 16; }
  if (EPI == 3) { A = (const u16*)(p.ws + OFF_F); lda = 4096; B = (const u16*)(p.ws + OFF_W2); ldb = 4096; K = 4096; ntiles_n = 4; }
  const float* modl = (const float*)(p.ws + OFF_MOD) + (size_t)l * 4 * 6144;
  const int total = 64 * ntiles_n;
  const int G = gridDim.x;
  const bool swz = (G == 256);
  for (int item = vb; item < total; item += G) {
    int mt = item & 63, nt = item >> 6;
    if (swz) { const int r = item >> 8, w = vb & 31; mt = (vb >> 5) * 8 + (w & 7); nt = r * 4 + (w >> 3); }
    const int m0 = mt * 256, n0 = nt * 256;
    f32x4 acc[8][4];
#pragma unroll
    for (int i = 0; i < 8; ++i)
#pragma unroll
      for (int j = 0; j < 4; ++j) acc[i][j] = f32x4{0.f, 0.f, 0.f, 0.f};
    gemm_mainloop_8w<(EPI == 0 || EPI == 2)>(A + (size_t)m0 * lda, lda, B + (size_t)n0 * ldb, ldb, K, acc, smem);
    if (EPI == 0 || EPI == 2) {
      constexpr int LDO = (EPI == 0) ? 2176 : 4096;
      u16* obase = (u16*)(p.ws + (EPI == 0 ? OFF_PABC : OFF_F)) + (size_t)(m0 + wm * 128 + fr) * LDO + n0 + wn * 64 + 8 * fq;
#pragma unroll
      for (int i = 0; i < 8; ++i) {
#pragma unroll
        for (int g2 = 0; g2 < 2; ++g2) {
          f32x4 a = acc[i][2 * g2], b = acc[i][2 * g2 + 1];
          if (EPI == 2) {
            a = __builtin_elementwise_max(a, f32x4{0.f, 0.f, 0.f, 0.f}); b = __builtin_elementwise_max(b, f32x4{0.f, 0.f, 0.f, 0.f});
            a = a * a; b = b * b;
          }
          const u32x4 o = u32x4{pack2(a[0], a[1]), pack2(a[2], a[3]), pack2(b[0], b[1]), pack2(b[2], b[3])};
          *(u32x4*)(obase + (size_t)(i * 16) * LDO + 32 * g2) = o;
        }
      }
    } else {
#pragma unroll
    for (int i = 0; i < 8; ++i) {
      const int m = m0 + wm * 128 + i * 16 + fr;
#pragma unroll
      for (int j = 0; j < 4; ++j) {
        const int n = n0 + wn * 64 + j * 16 + fq * 4;
        f32x4 v = acc[i][j];
        if (EPI == 0) {
          *(u32x2*)((u16*)(p.ws + OFF_PABC) + (size_t)m * 2176 + n) = u32x2{pack2(v[0], v[1]), pack2(v[2], v[3])};
        } else if (EPI == 1 || EPI == 3) {
          const int b = m >> 12;
          const float* gt = modl + (size_t)b * 6144 + (EPI == 1 ? 2048 : 5120) + n;
          const float* xin = ((EPI == 1 && l == 0) ? p.in[0] : p.out) + (size_t)m * 1024 + n;
          f32x4 x = *(const f32x4*)xin;
          f32x4 gg = *(const f32x4*)gt;
          *(f32x4*)(p.out + (size_t)m * 1024 + n) = x + gg * v;
        } else {
          float r0 = fmaxf(v[0], 0.f), r1 = fmaxf(v[1], 0.f), r2 = fmaxf(v[2], 0.f), r3 = fmaxf(v[3], 0.f);
          *(u32x2*)((u16*)(p.ws + OFF_F) + (size_t)m * 4096 + n) = u32x2{pack2(r0 * r0, r1 * r1), pack2(r2 * r2, r3 * r3)};
        }
      }
    }
    }
  }
}

template <int EPI>
__device__ __forceinline__ void phase_gemm(const Params& p, int l, int vb, unsigned char* smem_raw) {
  u16* smem = (u16*)smem_raw;
  const int lane = TIDX & 63, wv = TIDX >> 6;
  const int wm = wv >> 1, wn = wv & 1;
  const int fr = lane & 15, fq = lane >> 4;
  const u16* A; const u16* B; int lda, ldb, K, ntiles_n;
  if (EPI == 0) { A = (const u16*)(p.ws + OFF_H); lda = 1024; B = (const u16*)(p.ws + OFF_WIN); ldb = 1024; K = 1024; ntiles_n = 19; }
  if (EPI == 1) { A = (const u16*)(p.ws + OFF_MRG); lda = 1024; B = (const u16*)(p.ws + OFF_WO); ldb = 1024; K = 1024; ntiles_n = 8; }
  if (EPI == 2) { A = (const u16*)(p.ws + OFF_H); lda = 1024; B = (const u16*)(p.ws + OFF_W1); ldb = 1024; K = 1024; ntiles_n = 32; }
  if (EPI == 3) { A = (const u16*)(p.ws + OFF_F); lda = 4096; B = (const u16*)(p.ws + OFF_W2); ldb = 4096; K = 4096; ntiles_n = 8; }
  const float* modl = (const float*)(p.ws + OFF_MOD) + (size_t)l * 4 * 6144;
  const int G = VGRID;
  const bool swz = (G == 512);
  const int total = swz ? 128 * ((ntiles_n + 3) & ~3) : 128 * ntiles_n;
  for (int item = vb; item < total; item += G) {
    int mt = item & 127, nt = item >> 7;
    if (swz) { const int r = item >> 9, w = vb & 63; mt = (vb >> 6) * 16 + (w & 15); nt = r * 4 + (w >> 4); if (nt >= ntiles_n) continue; }
    const int m0 = mt * 128, n0 = nt * 128;
    f32x4 acc[4][4];
    zero_acc<4>(acc);
    gemm_mainloop<4>(A + (size_t)m0 * lda, lda, B + (size_t)n0 * ldb, ldb, K, acc, smem);
#pragma unroll
    for (int i = 0; i < 4; ++i) {
      const int m = m0 + wm * 64 + i * 16 + fr;
#pragma unroll
      for (int j = 0; j < 4; ++j) {
        const int n = n0 + wn * 64 + j * 16 + fq * 4;
        f32x4 v = acc[i][j];
        if (EPI == 0) {
          u32x2 o; o.x = pack2(v[0], v[1]); o.y = pack2(v[2], v[3]);
          if (n < 2176) *(u32x2*)((u16*)(p.ws + OFF_PABC) + (size_t)m * 2176 + n) = o;
          else *(u32x2*)((u16*)(p.ws + OFF_PD) + (size_t)m * 256 + (n - 2176)) = o;
        } else if (EPI == 1 || EPI == 3) {
          const int b = m >> 12;
          const float* gt = modl + (size_t)b * 6144 + (EPI == 1 ? 2048 : 5120) + n;
          const float* xin = ((EPI == 1 && l == 0) ? p.in[0] : p.out) + (size_t)m * 1024 + n;
          float4 x = *(const float4*)xin;
          float4 gg = *(const float4*)gt;
          float4 o;
          o.x = x.x + gg.x * v[0]; o.y = x.y + gg.y * v[1]; o.z = x.z + gg.z * v[2]; o.w = x.w + gg.w * v[3];
          *(float4*)(p.out + (size_t)m * 1024 + n) = o;
        } else {
          float r0 = fmaxf(v[0], 0.f), r1 = fmaxf(v[1], 0.f), r2 = fmaxf(v[2], 0.f), r3 = fmaxf(v[3], 0.f);
          u32x2 o; o.x = pack2(r0 * r0, r1 * r1); o.y = pack2(r2 * r2, r3 * r3);
          *(u32x2*)((u16*)(p.ws + OFF_F) + (size_t)m * 4096 + n) = o;
        }
      }
    }
  }
}

template <int MODE>
__device__ __forceinline__ void merge_tile(const Params& p, int item, unsigned char* smem_raw) {
  u16* smem = (u16*)smem_raw;
  const int lane = TIDX & 63, wv = TIDX >> 6;
  const int wm = wv >> 1, wn = wv & 1;
  const int fr = lane & 15, fq = lane >> 4;
  const u16* H = (const u16*)(p.ws + OFF_H);
  const u16* WIN = (const u16*)(p.ws + OFF_WIN);
  const int mt = item & 127, nt = item >> 7;
  const int m0 = mt * 128, n0 = nt * 128;
  f32x4 bacc[4][4];
  u32x2 gpk[4][4];
  u16* MRG = (u16*)(p.ws + OFF_MRG);
#pragma unroll 1
  for (int br = (MODE == 0 ? 1 : 0); br < (MODE == 0 ? 4 : 1); ++br) {
    zero_acc<4>(bacc);
    gemm_mainloop<4, true>(H + (size_t)m0 * 1024, 1024, WIN + (size_t)(2432 + br * 1024 + n0) * 1024, 1024, 1024, bacc, smem);
#pragma unroll
    for (int i = 0; i < 4; ++i)
#pragma unroll
      for (int j = 0; j < 4; ++j)
        gpk[i][j] = u32x2{pack2(sigmoidf_(bacc[i][j][0]), sigmoidf_(bacc[i][j][1])), pack2(sigmoidf_(bacc[i][j][2]), sigmoidf_(bacc[i][j][3]))};
    const u16* Ab; const u16* Wb;
    if (br == 0) { Ab = (const u16*)(p.ws + OFF_OG); Wb = (const u16*)(p.ws + OFF_RO); }
    else if (br == 1) { Ab = (const u16*)(p.ws + OFF_UB); Wb = (const u16*)(p.ws + OFF_SO); }
    else if (br == 2) { Ab = (const u16*)(p.ws + OFF_CB); Wb = (const u16*)(p.ws + OFF_CO); }
    else { Ab = (const u16*)(p.ws + OFF_YD); Wb = (const u16*)(p.ws + OFF_GLU); }
    if (MODE == 0 && br == 3) {
      zero_acc<4>(bacc);
      gemm_mainloop<4, true>(Ab + (size_t)m0 * 256, 256, Wb + (size_t)(1024 + n0) * 256, 256, 256, bacc, smem);
#pragma unroll
      for (int i = 0; i < 4; ++i)
#pragma unroll
        for (int j = 0; j < 4; ++j) {
          const float g0 = bflo(gpk[i][j].x) * sigmoidf_(bacc[i][j][0]), g1 = bfhi(gpk[i][j].x) * sigmoidf_(bacc[i][j][1]);
          const float g2 = bflo(gpk[i][j].y) * sigmoidf_(bacc[i][j][2]), g3 = bfhi(gpk[i][j].y) * sigmoidf_(bacc[i][j][3]);
          gpk[i][j] = u32x2{pack2(g0, g1), pack2(g2, g3)};
        }
    }
    zero_acc<4>(bacc);
    gemm_mainloop<4, true>(Ab + (size_t)m0 * 256, 256, Wb + (size_t)n0 * 256, 256, 256, bacc, smem);
#pragma unroll
    for (int i = 0; i < 4; ++i)
#pragma unroll
      for (int j = 0; j < 4; ++j) {
        u32x2* mp = (u32x2*)(MRG + (size_t)(m0 + wm * 64 + i * 16 + fr) * 1024 + n0 + wn * 64 + j * 16 + fq * 4);
        u32x2 cm = u32x2{0u, 0u};
        if (MODE == 1 || br > 1) cm = *mp;
        const float v0 = bflo(cm.x) + bflo(gpk[i][j].x) * bacc[i][j][0];
        const float v1 = bfhi(cm.x) + bfhi(gpk[i][j].x) * bacc[i][j][1];
        const float v2 = bflo(cm.y) + bflo(gpk[i][j].y) * bacc[i][j][2];
        const float v3 = bfhi(cm.y) + bfhi(gpk[i][j].y) * bacc[i][j][3];
        *mp = u32x2{pack2(v0, v1), pack2(v2, v3)};
      }
  }
}

__device__ __forceinline__ void gemm_mainloop_8n(const u16* __restrict__ A, int lda, const u16* __restrict__ B, int ldb,
                                                 int K, f32x4 (&acc)[4][4], u16* smem) {
  constexpr int STG = 24576;
  int tz = 0;
  asm volatile("" : "+v"(tz));
  const int tid = threadIdx.x + tz, lane = tid & 63, wv = tid >> 6;
  const int wm = wv >> 1, wn = wv & 1;
  const int lrow = tid >> 3;
  const int lchs = (tid & 7) ^ ((lrow >> 1) & 7);
  const u16* Ap = A + (size_t)lrow * lda + lchs * 8;
  const int rho = lrow & 31, pi = rho & 15;
  const u16* Bp = B + (size_t)((lrow & ~31) + 8 * (pi >> 2) + 4 * (rho >> 4) + (pi & 3)) * ldb + lchs * 8;
  const int nk = K >> 6;
  auto stage = [&](int kt, int buf) {
    const int ko = kt << 6;
    u16* sa = smem + buf * STG;
#pragma unroll
    for (int i = 0; i < 4; ++i)
      __builtin_amdgcn_global_load_lds((const unsigned*)(Ap + (size_t)(64 * i) * lda + ko),
                                       (__attribute__((address_space(3))) unsigned*)(sa + (tid + 512 * i) * 8), 16, 0, 0);
#pragma unroll
    for (int i = 0; i < 2; ++i)
      __builtin_amdgcn_global_load_lds((const unsigned*)(Bp + (size_t)(64 * i) * ldb + ko),
                                       (__attribute__((address_space(3))) unsigned*)(sa + 16384 + (tid + 512 * i) * 8), 16, 0, 0);
  };
  __syncthreads();
  stage(0, 0);
  stage(nk > 1 ? 1 : 0, 1);
  const int fr = lane & 15, fq = lane >> 4;
  const int sw = (fr >> 1) & 7;
  int cur = 0;
  for (int kt = 0; kt < nk; ++kt) {
    asm volatile("s_waitcnt vmcnt(6)" ::: "memory");
    __builtin_amdgcn_s_barrier();
    asm volatile("" ::: "memory");
    {
      int nx = cur + 2; if (nx >= 3) nx -= 3;
      int ktn = kt + 2; if (ktn >= nk) ktn = nk - 1;
      stage(ktn, nx);
    }
    const u16* cA = smem + cur * STG + (wm * 64 + fr) * 64;
    const u16* cB = smem + cur * STG + 16384 + (wn * 64 + fr) * 64;
#pragma unroll
    for (int ks = 0; ks < 2; ++ks) {
      const int pc = ((fq + 4 * ks) ^ sw) << 3;
      bf16x8 fa[4], fb[4];
#pragma unroll
      for (int i = 0; i < 4; ++i) fa[i] = *(const bf16x8*)(cA + i * 16 * 64 + pc);
#pragma unroll
      for (int j = 0; j < 4; ++j) fb[j] = *(const bf16x8*)(cB + j * 16 * 64 + pc);
#pragma unroll
      for (int i = 0; i < 4; ++i)
#pragma unroll
        for (int j = 0; j < 4; ++j)
          acc[i][j] = __builtin_amdgcn_mfma_f32_16x16x32_bf16(fb[j], fa[i], acc[i][j], 0, 0, 0);
    }
    cur = cur + 1; if (cur >= 3) cur = 0;
  }
  asm volatile("s_waitcnt vmcnt(0)" ::: "memory");
}

template <int MODE>
__device__ __forceinline__ void merge_tile8(const Params& p, int item, unsigned char* smem_raw) {
  u16* smem = (u16*)smem_raw;
  const int lane = threadIdx.x & 63, wv = threadIdx.x >> 6;
  const int wm = wv >> 1, wn = wv & 1;
  const int fr = lane & 15, fq = lane >> 4;
  const u16* H = (const u16*)(p.ws + OFF_H);
  const u16* WIN = (const u16*)(p.ws + OFF_WIN);
  const int mt = item & 63, nt = item >> 6;
  const int m0 = mt * 256, n0 = nt * 128;
  f32x4 bacc[4][4];
  u32x2 gpk[4][4];
  u16* MRG = (u16*)(p.ws + OFF_MRG);
#pragma unroll 1
  for (int br = (MODE == 0 ? 1 : 0); br < (MODE == 0 ? 4 : 1); ++br) {
    zero_acc<4>(bacc);
    gemm_mainloop_8n(H + (size_t)m0 * 1024, 1024, WIN + (size_t)(2432 + br * 1024 + n0) * 1024, 1024, 1024, bacc, smem);
#pragma unroll
    for (int i = 0; i < 4; ++i)
#pragma unroll
      for (int j = 0; j < 4; ++j)
        gpk[i][j] = u32x2{pack2(sigmoidf_(bacc[i][j][0]), sigmoidf_(bacc[i][j][1])), pack2(sigmoidf_(bacc[i][j][2]), sigmoidf_(bacc[i][j][3]))};
    const u16* Ab; const u16* Wb;
    if (br == 0) { Ab = (const u16*)(p.ws + OFF_OG); Wb = (const u16*)(p.ws + OFF_RO); }
    else if (br == 1) { Ab = (const u16*)(p.ws + OFF_UB); Wb = (const u16*)(p.ws + OFF_SO); }
    else if (br == 2) { Ab = (const u16*)(p.ws + OFF_CB); Wb = (const u16*)(p.ws + OFF_CO); }
    else { Ab = (const u16*)(p.ws + OFF_YD); Wb = (const u16*)(p.ws + OFF_GLU); }
    if (MODE == 0 && br == 3) {
      zero_acc<4>(bacc);
      gemm_mainloop_8n(Ab + (size_t)m0 * 256, 256, Wb + (size_t)(1024 + n0) * 256, 256, 256, bacc, smem);
#pragma unroll
      for (int i = 0; i < 4; ++i)
#pragma unroll
        for (int j = 0; j < 4; ++j) {
          const float g0 = bflo(gpk[i][j].x) * sigmoidf_(bacc[i][j][0]), g1 = bfhi(gpk[i][j].x) * sigmoidf_(bacc[i][j][1]);
          const float g2 = bflo(gpk[i][j].y) * sigmoidf_(bacc[i][j][2]), g3 = bfhi(gpk[i][j].y) * sigmoidf_(bacc[i][j][3]);
          gpk[i][j] = u32x2{pack2(g0, g1), pack2(g2, g3)};
        }
    }
    zero_acc<4>(bacc);
    gemm_mainloop_8n(Ab + (size_t)m0 * 256, 256, Wb + (size_t)n0 * 256, 256, 256, bacc, smem);
#pragma unroll
    for (int i = 0; i < 4; ++i)
#pragma unroll
      for (int g2 = 0; g2 < 2; ++g2) {
        u32x4* mp = (u32x4*)(MRG + (size_t)(m0 + wm * 64 + i * 16 + fr) * 1024 + n0 + wn * 64 + 32 * g2 + 8 * fq);
        u32x4 cm = u32x4{0u, 0u, 0u, 0u};
        if (MODE == 1 || br > 1) cm = *mp;
        const int ja = 2 * g2, jb = 2 * g2 + 1;
        const float v0 = bflo(cm.x) + bflo(gpk[i][ja].x) * bacc[i][ja][0];
        const float v1 = bfhi(cm.x) + bfhi(gpk[i][ja].x) * bacc[i][ja][1];
        const float v2 = bflo(cm.y) + bflo(gpk[i][ja].y) * bacc[i][ja][2];
        const float v3 = bfhi(cm.y) + bfhi(gpk[i][ja].y) * bacc[i][ja][3];
        const float v4 = bflo(cm.z) + bflo(gpk[i][jb].x) * bacc[i][jb][0];
        const float v5 = bfhi(cm.z) + bfhi(gpk[i][jb].x) * bacc[i][jb][1];
        const float v6 = bflo(cm.w) + bflo(gpk[i][jb].y) * bacc[i][jb][2];
        const float v7 = bfhi(cm.w) + bfhi(gpk[i][jb].y) * bacc[i][jb][3];
        *mp = u32x4{pack2(v0, v1), pack2(v2, v3), pack2(v4, v5), pack2(v6, v7)};
      }
  }
}

__device__ __forceinline__ void phase_pproj_tail(const Params& p, int vb, unsigned char* smem_raw) {
  u16* smem = (u16*)smem_raw;
  const int lane = threadIdx.x & 63, wv = threadIdx.x >> 6;
  const int wm = wv >> 1, wn = wv & 1;
  const int fr = lane & 15, fq = lane >> 4;
  const u16* A = (const u16*)(p.ws + OFF_H);
  const u16* B = (const u16*)(p.ws + OFF_WIN);
  const int G = gridDim.x;
  const int total = (G == 256) ? 256 : 192;
  for (int item = vb; item < total; item += G) {
    int mt = item & 63, nt = item >> 6;
    if (G == 256) { const int w = vb & 31; mt = (vb >> 5) * 8 + (w & 7); nt = w >> 3; if (nt >= 3) continue; }
    const int m0 = mt * 256, n0 = 2048 + nt * 128;
    f32x4 acc[4][4];
    zero_acc<4>(acc);
    gemm_mainloop_8n(A + (size_t)m0 * 1024, 1024, B + (size_t)n0 * 1024, 1024, 1024, acc, smem);
#pragma unroll
    for (int i = 0; i < 4; ++i) {
      const int m = m0 + wm * 64 + i * 16 + fr;
#pragma unroll
      for (int g2 = 0; g2 < 2; ++g2) {
        const int n = n0 + wn * 64 + 32 * g2 + 8 * fq;
        const f32x4 va = acc[i][2 * g2], vb2 = acc[i][2 * g2 + 1];
        const u32x4 o = u32x4{pack2(va[0], va[1]), pack2(va[2], va[3]), pack2(vb2[0], vb2[1]), pack2(vb2[2], vb2[3])};
        if (n < 2176) *(u32x4*)((u16*)(p.ws + OFF_PABC) + (size_t)m * 2176 + n) = o;
        else *(u32x4*)((u16*)(p.ws + OFF_PD) + (size_t)m * 256 + (n - 2176)) = o;
      }
    }
  }
}

__device__ __forceinline__ float shifted(const u16* __restrict__ P, int tok, int col, float mu) {
  float pv = bf2f(P[(size_t)tok * 2176 + col]);
  float pr = (tok & (SEQ - 1)) ? bf2f(P[(size_t)(tok - 1) * 2176 + col]) : 0.f;
  return pv + (pr - pv) * mu;
}

__device__ __forceinline__ void rwkv_prep_item(const Params& p, int l, int item, unsigned char* smem) {
  const int tid = TIDX, lane = tid & 63, wv = tid >> 6;
  const int fr = lane & 15, fq = lane >> 4;
  u16* sl = (u16*)smem;
  u16* sv = sl + 32 * 168;
  constexpr int SLS = 168, SVS = 264;
  const u16* P = (const u16*)(p.ws + OFF_PABC);
  const float* mu = p.in[6] + l * 896;
  const int tok0 = item * 32;
  {
    const int t = tid >> 3, c0 = (tid & 7) * 32;
    const u16* src = P + (size_t)(tok0 + t) * 2176 + 896 + 256 + c0;
    float sm = 0.f, ss = 0.f;
#pragma unroll
    for (int q = 0; q < 4; ++q) {
      const u32x4 raw = *(const u32x4*)(src + q * 8);
      float z;
      z = geluf_(bflo(raw.x)); sm += z; ss += z * z;  z = geluf_(bfhi(raw.x)); sm += z; ss += z * z;
      z = geluf_(bflo(raw.y)); sm += z; ss += z * z;  z = geluf_(bfhi(raw.y)); sm += z; ss += z * z;
      z = geluf_(bflo(raw.z)); sm += z; ss += z * z;  z = geluf_(bfhi(raw.z)); sm += z; ss += z * z;
      z = geluf_(bflo(raw.w)); sm += z; ss += z * z;  z = geluf_(bfhi(raw.w)); sm += z; ss += z * z;
    }
    sm += __shfl_xor(sm, 1, 64); ss += __shfl_xor(ss, 1, 64);
    sm += __shfl_xor(sm, 2, 64); ss += __shfl_xor(ss, 2, 64);
    sm += __shfl_xor(sm, 4, 64); ss += __shfl_xor(ss, 4, 64);
    const float mean = sm * (1.f / 256.f);
    const float var = fmaxf(ss * (1.f / 256.f) - mean * mean, 0.f);
    if ((tid & 7) == 0) *(f32x2*)((float*)(p.ws + OFF_SGST) + (size_t)(tok0 + t) * 2) = f32x2{mean, rsqrtf(var + 1e-5f)};
  }
  for (int idx = tid; idx < 32 * 128; idx += NTHR) {
    const int t = idx >> 7, ci = idx & 127;
    float v = shifted(P, tok0 + t, 768 + ci, mu[768 + ci]);
    if (ci < 32) v = tanhf_(v);
    else if (ci >= 64) v = sigmoidf_(v);
    sl[t * SLS + ci] = f2bf(v);
  }
  if (l > 0) {
    const int t = tid >> 3, c0 = (tid & 7) * 32;
    const int tok = tok0 + t;
    const bool hasp = (tok & (SEQ - 1)) != 0;
#pragma unroll
    for (int q = 0; q < 4; ++q) {
      const int c = c0 + q * 8;
      const u32x4 cur = *(const u32x4*)(P + (size_t)tok * 2176 + 512 + c);
      u32x4 prv = u32x4{0u, 0u, 0u, 0u};
      if (hasp) prv = *(const u32x4*)(P + (size_t)(tok - 1) * 2176 + 512 + c);
      const f32x4 m0 = *(const f32x4*)(mu + 512 + c), m1 = *(const f32x4*)(mu + 512 + c + 4);
      float o[8];
      o[0] = bflo(cur.x) + (bflo(prv.x) - bflo(cur.x)) * m0.x; o[1] = bfhi(cur.x) + (bfhi(prv.x) - bfhi(cur.x)) * m0.y;
      o[2] = bflo(cur.y) + (bflo(prv.y) - bflo(cur.y)) * m0.z; o[3] = bfhi(cur.y) + (bfhi(prv.y) - bfhi(cur.y)) * m0.w;
      o[4] = bflo(cur.z) + (bflo(prv.z) - bflo(cur.z)) * m1.x; o[5] = bfhi(cur.z) + (bfhi(prv.z) - bfhi(cur.z)) * m1.y;
      o[6] = bflo(cur.w) + (bflo(prv.w) - bflo(cur.w)) * m1.z; o[7] = bfhi(cur.w) + (bfhi(prv.w) - bfhi(cur.w)) * m1.w;
      *(u32x4*)(sv + t * SVS + c) = u32x4{pack2(o[0], o[1]), pack2(o[2], o[3]), pack2(o[4], o[5]), pack2(o[6], o[7])};
    }
  }
  __syncthreads();
  if (l > 0) {
    const int mf = wv >> 1, nf = wv & 1;
    const u16* v1t = (const u16*)(p.ws + OFF_LV1);
    f32x4 acc = f32x4{0.f, 0.f, 0.f, 0.f};
#pragma unroll
    for (int ks = 0; ks < 8; ++ks) {
      const bf16x8 fa = *(const bf16x8*)(sv + (mf * 16 + fr) * SVS + ks * 32 + fq * 8);
      const bf16x8 fb = *(const bf16x8*)(v1t + (size_t)(nf * 16 + fr) * 256 + ks * 32 + fq * 8);
      acc = __builtin_amdgcn_mfma_f32_16x16x32_bf16(fb, fa, acc, 0, 0, 0);
    }
    *(u32x2*)(sl + (mf * 16 + fr) * SLS + 128 + nf * 16 + fq * 4) = u32x2{pack2(acc[0], acc[1]), pack2(acc[2], acc[3])};
    __syncthreads();
  }
  const u16* w2t = (const u16*)(p.ws + OFF_LW2); const u16* a2t = (const u16*)(p.ws + OFF_LA2);
  const u16* g2t = (const u16*)(p.ws + OFF_LG2); const u16* v2t = (const u16*)(p.ws + OFF_LV2);
  u16* SR = (u16*)(p.ws + OFF_SR); u16* SK = (u16*)(p.ws + OFF_SK); u16* SV = (u16*)(p.ws + OFF_SV);
  u16* SKK = (u16*)(p.ws + OFF_SKK); u16* SA = (u16*)(p.ws + OFF_SA); float* SW = (float*)(p.ws + OFF_SW);
  u16* G = (u16*)(p.ws + OFF_G); u16* VF = (u16*)(p.ws + OFF_VF);
#pragma unroll 1
  for (int mf = 0; mf < 2; ++mf) {
    const u16* arow = sl + (mf * 16 + fr) * SLS + fq * 8;
    const bf16x8 aw = *(const bf16x8*)(arow), aa = *(const bf16x8*)(arow + 32);
    const bf16x8 ag0 = *(const bf16x8*)(arow + 64), ag1 = *(const bf16x8*)(arow + 96), av = *(const bf16x8*)(arow + 128);
    f32x4 cw[4], ca[4], cg[4], cv[4];
#pragma unroll
    for (int nf = 0; nf < 4; ++nf) {
      const int n = wv * 64 + (nf >> 1) * 32 + 8 * (fr >> 2) + 4 * (nf & 1) + (fr & 3);
      const f32x4 z = f32x4{0.f, 0.f, 0.f, 0.f};
      cw[nf] = __builtin_amdgcn_mfma_f32_16x16x32_bf16(*(const bf16x8*)(w2t + n * 32 + fq * 8), aw, z, 0, 0, 0);
      ca[nf] = __builtin_amdgcn_mfma_f32_16x16x32_bf16(*(const bf16x8*)(a2t + n * 32 + fq * 8), aa, z, 0, 0, 0);
      cg[nf] = __builtin_amdgcn_mfma_f32_16x16x32_bf16(*(const bf16x8*)(g2t + n * 64 + fq * 8), ag0, z, 0, 0, 0);
      cg[nf] = __builtin_amdgcn_mfma_f32_16x16x32_bf16(*(const bf16x8*)(g2t + n * 64 + 32 + fq * 8), ag1, cg[nf], 0, 0, 0);
      cv[nf] = z;
      if (l > 0) cv[nf] = __builtin_amdgcn_mfma_f32_16x16x32_bf16(*(const bf16x8*)(v2t + n * 32 + fq * 8), av, z, 0, 0, 0);
    }
    const int tok = tok0 + mf * 16 + fr;
    const bool hasp = (tok & (SEQ - 1)) != 0;
    float kkv[4][4], kmv[4][4], av4[4][4];
    float ss = 0.f;
#pragma unroll
    for (int g2 = 0; g2 < 2; ++g2) {
    u32x2 pr[2], pv[2], pg[2];
    const int c8 = wv * 64 + 32 * g2 + 8 * fq;
    const u16* pc8 = P + (size_t)tok * 2176 + c8;
    const u32x4 r_c8 = *(const u32x4*)(pc8), k_c8 = *(const u32x4*)(pc8 + 256), v_c8 = *(const u32x4*)(pc8 + 512);
    u32x4 r_p8 = u32x4{0u, 0u, 0u, 0u}, k_p8 = r_p8, v_p8 = r_p8, vf8 = r_p8;
    if (hasp) { r_p8 = *(const u32x4*)(pc8 - 2176); k_p8 = *(const u32x4*)(pc8 - 2176 + 256); v_p8 = *(const u32x4*)(pc8 - 2176 + 512); }
    if (l > 0) vf8 = *(const u32x4*)(VF + (size_t)tok * 256 + c8);
#pragma unroll
    for (int hh = 0; hh < 2; ++hh) {
      const int nf = 2 * g2 + hh;
      const int c = wv * 64 + 32 * g2 + 8 * fq + 4 * hh;
      const size_t o = (size_t)tok * 256 + c;
      const u32x2 r_c = hh ? u32x2{r_c8.z, r_c8.w} : u32x2{r_c8.x, r_c8.y}, k_c = hh ? u32x2{k_c8.z, k_c8.w} : u32x2{k_c8.x, k_c8.y};
      const u32x2 v_c = hh ? u32x2{v_c8.z, v_c8.w} : u32x2{v_c8.x, v_c8.y};
      const u32x2 r_p = hh ? u32x2{r_p8.z, r_p8.w} : u32x2{r_p8.x, r_p8.y}, k_p = hh ? u32x2{k_p8.z, k_p8.w} : u32x2{k_p8.x, k_p8.y};
      const u32x2 v_p = hh ? u32x2{v_p8.z, v_p8.w} : u32x2{v_p8.x, v_p8.y};
      const f32x4 mur = *(const f32x4*)(mu + c), muk = *(const f32x4*)(mu + 256 + c), muv = *(const f32x4*)(mu + 512 + c);
      const f32x4 w0 = *(const f32x4*)(p.in[7] + l * 256 + c), a0 = *(const f32x4*)(p.in[9] + l * 256 + c);
      const f32x4 kkc = *(const f32x4*)(p.in[15] + l * 256 + c), kac = *(const f32x4*)(p.in[16] + l * 256 + c);
      f32x4 v0 = f32x4{0.f, 0.f, 0.f, 0.f};
      if (l > 0) v0 = *(const f32x4*)(p.in[12] + c);
      const u32x2 vfraw = hh ? u32x2{vf8.z, vf8.w} : u32x2{vf8.x, vf8.y};
      float rr[4], kk_[4], vv[4], dec[4], gg[4];
#pragma unroll
      for (int e = 0; e < 4; ++e) {
        const unsigned rc = e < 2 ? r_c.x : r_c.y, rp = e < 2 ? r_p.x : r_p.y;
        const unsigned kc = e < 2 ? k_c.x : k_c.y, kp = e < 2 ? k_p.x : k_p.y;
        const unsigned vc = e < 2 ? v_c.x : v_c.y, vp = e < 2 ? v_p.x : v_p.y;
        const unsigned vfr = e < 2 ? vfraw.x : vfraw.y;
        const float rcf = (e & 1) ? bfhi(rc) : bflo(rc), rpf = (e & 1) ? bfhi(rp) : bflo(rp);
        const float kcf = (e & 1) ? bfhi(kc) : bflo(kc), kpf = (e & 1) ? bfhi(kp) : bflo(kp);
        const float vcf = (e & 1) ? bfhi(vc) : bflo(vc), vpf = (e & 1) ? bfhi(vp) : bflo(vp);
        const float r = rcf + (rpf - rcf) * mur[e];
        const float k = kcf + (kpf - kcf) * muk[e];
        float v = vcf + (vpf - vcf) * muv[e];
        const float wl = w0[e] + cw[nf][e];
        const float z = -wl;
        const float sp = (z > 15.f) ? z : __logf(1.f + __expf(z));
        dec[e] = __expf(-__expf(-sp - 0.5f));
        const float a = sigmoidf_(a0[e] + ca[nf][e]);
        gg[e] = cg[nf][e];
        if (l > 0) { const float vf = (e & 1) ? bfhi(vfr) : bflo(vfr); v = v + (vf - v) * sigmoidf_(v0[e] + cv[nf][e]); }
        const float kk = k * kkc[e];
        ss += kk * kk;
        rr[e] = r; vv[e] = v; kk_[e] = kk; kkv[nf][e] = kk;
        kmv[nf][e] = k * (1.f + (a - 1.f) * kac[e]); av4[nf][e] = a;
      }
      pr[hh] = u32x2{pack2(rr[0], rr[1]), pack2(rr[2], rr[3])};
      pv[hh] = u32x2{pack2(vv[0], vv[1]), pack2(vv[2], vv[3])};
      pg[hh] = u32x2{pack2(gg[0], gg[1]), pack2(gg[2], gg[3])};
      *(f32x4*)(SW + o) = f32x4{dec[0], dec[1], dec[2], dec[3]};
    }
      {
        const size_t o8 = (size_t)tok * 256 + wv * 64 + 32 * g2 + 8 * fq;
        *(u32x4*)(SR + o8) = u32x4{pr[0].x, pr[0].y, pr[1].x, pr[1].y};
        *(u32x4*)(SV + o8) = u32x4{pv[0].x, pv[0].y, pv[1].x, pv[1].y};
        if (l == 0) *(u32x4*)(VF + o8) = u32x4{pv[0].x, pv[0].y, pv[1].x, pv[1].y};
        *(u32x4*)(G + o8) = u32x4{pg[0].x, pg[0].y, pg[1].x, pg[1].y};
      }
    }
    ss += __shfl_xor(ss, 16, 64);
    ss += __shfl_xor(ss, 32, 64);
    const float inv = 1.f / fmaxf(sqrtf(ss), 1e-12f);
#pragma unroll
    for (int g2 = 0; g2 < 2; ++g2) {
      const size_t o8 = (size_t)tok * 256 + wv * 64 + 32 * g2 + 8 * fq;
      const int na = 2 * g2, nb2 = 2 * g2 + 1;
      *(u32x4*)(SKK + o8) = u32x4{pack2(kkv[na][0] * inv, kkv[na][1] * inv), pack2(kkv[na][2] * inv, kkv[na][3] * inv),
                                  pack2(kkv[nb2][0] * inv, kkv[nb2][1] * inv), pack2(kkv[nb2][2] * inv, kkv[nb2][3] * inv)};
      *(u32x4*)(SK + o8) = u32x4{pack2(kmv[na][0], kmv[na][1]), pack2(kmv[na][2], kmv[na][3]), pack2(kmv[nb2][0], kmv[nb2][1]), pack2(kmv[nb2][2], kmv[nb2][3])};
      *(u32x4*)(SA + o8) = u32x4{pack2(av4[na][0], av4[na][1]), pack2(av4[na][2], av4[na][3]), pack2(av4[nb2][0], av4[nb2][1]), pack2(av4[nb2][2], av4[nb2][3])};
    }
  }
  __syncthreads();
}

__device__ __forceinline__ void sg_item(const Params& p, int l, int item, unsigned char* smem) {
  const int tid = TIDX, lane = tid & 63, wv = tid >> 6;
  u16* vsT = (u16*)smem;
  float* smu = (float*)(smem + 16384);
  float* srs = smu + 128;
  const u16* P = (const u16*)(p.ws + OFF_PABC);
  const int g = item & 3, chn = item >> 2;
  const int tok0 = chn * 128;
  if (tid < 128) {
    const f32x2 ms = *(const f32x2*)((const float*)(p.ws + OFF_SGST) + (size_t)(tok0 + tid) * 2);
    smu[tid] = ms.x; srs[tid] = ms.y;
  }
  __syncthreads();
  {
    const int c = tid & 63, tb = tid >> 6;
    const float lw = p.in[21][l * 256 + g * 64 + c], lb = p.in[22][l * 256 + g * 64 + c];
#pragma unroll
    for (int j = 0; j < 4; ++j) {
      u16 raw[8];
#pragma unroll
      for (int e = 0; e < 8; ++e) raw[e] = P[(size_t)(tok0 + tb * 32 + j * 8 + e) * 2176 + 896 + 256 + g * 64 + c];
      float vv[8];
#pragma unroll
      for (int e = 0; e < 8; ++e) {
        const int t = tb * 32 + j * 8 + e;
        vv[e] = (geluf_(bf2f(raw[e])) - smu[t]) * srs[t] * lw + lb;
      }
      const int phys = (tb * 4 + j) ^ (c & 15);
      *(u32x4*)(vsT + c * 128 + phys * 8) = u32x4{pack2(vv[0], vv[1]), pack2(vv[2], vv[3]), pack2(vv[4], vv[5]), pack2(vv[6], vv[7])};
    }
  }
  __syncthreads();
  {
    const int fr = lane & 15, fq = lane >> 4;
    const u16* Wm = (const u16*)(p.ws + OFF_SGW) + (size_t)g * 128 * 128;
    f32x4 acc[2][4];
#pragma unroll
    for (int i = 0; i < 2; ++i)
#pragma unroll
      for (int j = 0; j < 4; ++j) acc[i][j] = f32x4{0.f, 0.f, 0.f, 0.f};
    for (int ks = 0; ks <= wv; ++ks) {
      bf16x8 fa[2], fb[4];
#pragma unroll
      for (int i = 0; i < 2; ++i) fa[i] = *(const bf16x8*)(Wm + (size_t)(32 * wv + 16 * i + fr) * 128 + ks * 32 + fq * 8);
#pragma unroll
      for (int j = 0; j < 4; ++j) fb[j] = *(const bf16x8*)(vsT + (j * 16 + fr) * 128 + (((ks * 4 + fq) ^ fr) << 3));
#pragma unroll
      for (int i = 0; i < 2; ++i)
#pragma unroll
        for (int j = 0; j < 4; ++j) acc[i][j] = __builtin_amdgcn_mfma_f32_16x16x32_bf16(fb[j], fa[i], acc[i][j], 0, 0, 0);
    }
    const float* bs = p.in[24] + ((size_t)l * 4 + g) * 128;
    u16* UB = (u16*)(p.ws + OFF_UB);
#pragma unroll
    for (int i = 0; i < 2; ++i) {
      const int t = 32 * wv + 16 * i + fr;
      const float bsv = bs[t];
#pragma unroll
      for (int j = 0; j < 4; ++j) {
        const int cc = j * 16 + fq * 4;
        u32x2 ur = *(const u32x2*)(P + (size_t)(tok0 + t) * 2176 + 896 + g * 64 + cc);
        float o0 = geluf_(bflo(ur.x)) * (acc[i][j][0] + bsv), o1 = geluf_(bfhi(ur.x)) * (acc[i][j][1] + bsv);
        float o2 = geluf_(bflo(ur.y)) * (acc[i][j][2] + bsv), o3 = geluf_(bfhi(ur.y)) * (acc[i][j][3] + bsv);
        *(u32x2*)(UB + (size_t)(tok0 + t) * 256 + g * 64 + cc) = u32x2{pack2(o0, o1), pack2(o2, o3)};
      }
    }
  }
  __syncthreads();
}

__device__ __forceinline__ void conv_item(const Params& p, int l, int item) {
  const int j = TIDX;
  const u16* P = (const u16*)(p.ws + OFF_PABC);
  u16* CB = (u16*)(p.ws + OFF_CB);
  const float c0 = p.in[26][(l * 3 + 0) * 256 + j], c1 = p.in[26][(l * 3 + 1) * 256 + j], c2 = p.in[26][(l * 3 + 2) * 256 + j];
  const int tok0 = item * 8;
  u16 rc[10], rx[10], rb[8];
  const bool first = (tok0 & (SEQ - 1)) == 0;
#pragma unroll
  for (int t = 0; t < 10; ++t) {
    const int tok = (first && t < 2) ? tok0 : tok0 + t - 2;
    const u16* q = P + (size_t)tok * 2176 + 1408;
    rc[t] = q[256 + j]; rx[t] = q[512 + j];
    if (t >= 2) rb[t - 2] = q[j];
  }
  float z[10];
#pragma unroll
  for (int t = 0; t < 10; ++t) z[t] = bf2f(rc[t]) * bf2f(rx[t]);
  if (first) { z[0] = 0.f; z[1] = 0.f; }
#pragma unroll
  for (int t = 0; t < 8; ++t) {
    float y = c0 * z[t] + c1 * z[t + 1] + c2 * z[t + 2];
    CB[(size_t)(tok0 + t) * 256 + j] = f2bf(bf2f(rb[t]) * y);
  }
}

__device__ __forceinline__ void s5_load_u(const u16* us, int t, int wv, float (&u)[16]) {
  const u32x4* q = (const u32x4*)(us + t * 64 + wv * 16);
  u32x4 a = q[0], b = q[1];
  u[0] = bflo(a.x); u[1] = bfhi(a.x); u[2] = bflo(a.y); u[3] = bfhi(a.y);
  u[4] = bflo(a.z); u[5] = bfhi(a.z); u[6] = bflo(a.w); u[7] = bfhi(a.w);
  u[8] = bflo(b.x); u[9] = bfhi(b.x); u[10] = bflo(b.y); u[11] = bfhi(b.y);
  u[12] = bflo(b.z); u[13] = bfhi(b.z); u[14] = bflo(b.w); u[15] = bfhi(b.w);
}
__device__ __forceinline__ void s5_stage_u(const u16* __restrict__ PD, int tok0, int gq, u16* us) {
#pragma unroll
  for (int i = 0; i < 2; ++i) {
    const int ch = TIDX + 256 * i;
    const int t = ch >> 3, part = ch & 7;
    *(u32x4*)(us + t * 64 + part * 8) = *(const u32x4*)(PD + (size_t)(tok0 + t) * 256 + gq * 64 + part * 8);
  }
}

__device__ __forceinline__ void s5a_item(const Params& p, int l, int item, unsigned char* smem) {
  const int lane = TIDX & 63, wv = TIDX >> 6;
  const int gq = item & 3, bc = item >> 2;
  const int g = gq * 4 + wv;
  const int tok0 = bc * 64;
  const u16* PD = (const u16*)(p.ws + OFF_PD);
  const float* ab = (const float*)(p.ws + OFF_S5AB) + ((size_t)(l * 16 + g) * 64 + lane) * 2;
  const float* bb = (const float*)(p.ws + OFF_S5BB) + ((size_t)(l * 16 + g) * 64 + lane) * 32;
  float bbr[16], bbi[16];
#pragma unroll
  for (int c = 0; c < 16; ++c) { bbr[c] = bb[c]; bbi[c] = bb[16 + c]; }
  const float abr = ab[0], abi = ab[1];
  float xr = 0.f, xi = 0.f;
  u16* us = (u16*)smem;
  s5_stage_u(PD, tok0, gq, us);
  __syncthreads();
#pragma unroll 4
  for (int t = 0; t < 64; ++t) {
    float u[16];
    s5_load_u(us, t, wv, u);
    float bur = 0.f, bui = 0.f;
#pragma unroll
    for (int c = 0; c < 16; ++c) { bur += bbr[c] * u[c]; bui += bbi[c] * u[c]; }
    float nr = abr * xr - abi * xi + bur;
    float ni = abr * xi + abi * xr + bui;
    xr = nr; xi = ni;
  }
  float2* E = (float2*)(p.ws + OFF_S5E);
  E[((size_t)bc * 16 + g) * 64 + lane] = make_float2(xr, xi);
  __syncthreads();
}

__device__ __forceinline__ void s5b_item(const Params& p, int l, int item, unsigned char* smem) {
  const int lane = TIDX & 63, wv = TIDX >> 6;
  const int gq = item & 3, bc = item >> 2;
  const int b = bc >> 6, ch = bc & 63;
  const int g = gq * 4 + wv;
  const int tok0 = bc * 64;
  u16* us = (u16*)(smem + 65536);
  s5_stage_u((const u16*)(p.ws + OFF_PD), tok0, gq, us);
  float* base = (float*)smem + wv * 4096;
  float* csr = base, *csi = base + 1024, *xsr = base + 2048, *xsi = base + 3072;
  const u16* PD = (const u16*)(p.ws + OFF_PD);
  const float* ab = (const float*)(p.ws + OFF_S5AB) + ((size_t)(l * 16 + g) * 64 + lane) * 2;
  const float* bb = (const float*)(p.ws + OFF_S5BB) + ((size_t)(l * 16 + g) * 64 + lane) * 32;
  const float* cre = p.in[32] + ((size_t)(l * 16 + g) * 16) * 64;
  const float* cim = p.in[33] + ((size_t)(l * 16 + g) * 16) * 64;
  for (int c = 0; c < 16; ++c) {
    csr[(lane >> 2) * 64 + c * 4 + (lane & 3)] = cre[c * 64 + lane];
    csi[(lane >> 2) * 64 + c * 4 + (lane & 3)] = cim[c * 64 + lane];
  }
  float bbr[16], bbi[16];
#pragma unroll
  for (int c = 0; c < 16; ++c) { bbr[c] = bb[c]; bbi[c] = bb[16 + c]; }
  const float abr = ab[0], abi = ab[1];
  float pr = abr, pi = abi;
#pragma unroll
  for (int s = 0; s < 6; ++s) { float nr = pr * pr - pi * pi, ni = 2.f * pr * pi; pr = nr; pi = ni; }
  float xr = 0.f, xi = 0.f;
  const float2* E = (const float2*)(p.ws + OFF_S5E);
  {
    const f32x2* Ev = (const f32x2*)E + ((size_t)(b * 64) * 16 + g) * 64 + lane;
    int c = 0;
    for (; c + 8 <= ch; c += 8) {
      f32x2 e[8];
#pragma unroll
      for (int k = 0; k < 8; ++k) e[k] = Ev[(size_t)(c + k) * 1024];
#pragma unroll
      for (int k = 0; k < 8; ++k) {
        const float nr = pr * xr - pi * xi + e[k].x;
        const float ni = pr * xi + pi * xr + e[k].y;
        xr = nr; xi = ni;
      }
    }
    for (; c < ch; ++c) {
      const f32x2 e = Ev[(size_t)c * 1024];
      const float nr = pr * xr - pi * xi + e.x;
      const float ni = pr * xi + pi * xr + e.y;
      xr = nr; xi = ni;
    }
  }
  const int tt = lane & 15, cq = lane >> 4;
  const float* dvec = p.in[34] + l * 256 + g * 16 + cq * 4;
  const float d0 = dvec[0], d1 = dvec[1], d2 = dvec[2], d3 = dvec[3];
  u16* YD = (u16*)(p.ws + OFF_YD);
  const int n4w = lane >> 2, e4 = lane & 3;
  __syncthreads();
#pragma unroll 1
  for (int sc = 0; sc < 4; ++sc) {
    for (int t = 0; t < 16; ++t) {
      float u[16];
      s5_load_u(us, sc * 16 + t, wv, u);
      float bur = 0.f, bui = 0.f;
#pragma unroll
      for (int c = 0; c < 16; ++c) { bur += bbr[c] * u[c]; bui += bbi[c] * u[c]; }
      float nr = abr * xr - abi * xi + bur;
      float ni = abr * xi + abi * xr + bui;
      xr = nr; xi = ni;
      int a = n4w * 64 + ((t ^ (n4w & 7)) << 2) + e4;
      xsr[a] = xr; xsi[a] = xi;
    }
    __syncthreads();
    float acc0 = 0.f, acc1 = 0.f, acc2 = 0.f, acc3 = 0.f;
#pragma unroll 2
    for (int n4 = 0; n4 < 16; ++n4) {
      int xa = n4 * 64 + ((tt ^ (n4 & 7)) << 2);
      float4 xr4 = *(const float4*)(xsr + xa);
      float4 xi4 = *(const float4*)(xsi + xa);
      const float* cr = csr + n4 * 64 + cq * 16;
      const float* ci = csi + n4 * 64 + cq * 16;
      float4 r0 = *(const float4*)(cr), r1 = *(const float4*)(cr + 4), r2 = *(const float4*)(cr + 8), r3 = *(const float4*)(cr + 12);
      float4 i0 = *(const float4*)(ci), i1 = *(const float4*)(ci + 4), i2 = *(const float4*)(ci + 8), i3 = *(const float4*)(ci + 12);
      acc0 += r0.x * xr4.x + r0.y * xr4.y + r0.z * xr4.z + r0.w * xr4.w - (i0.x * xi4.x + i0.y * xi4.y + i0.z * xi4.z + i0.w * xi4.w);
      acc1 += r1.x * xr4.x + r1.y * xr4.y + r1.z * xr4.z + r1.w * xr4.w - (i1.x * xi4.x + i1.y * xi4.y + i1.z * xi4.z + i1.w * xi4.w);
      acc2 += r2.x * xr4.x + r2.y * xr4.y + r2.z * xr4.z + r2.w * xr4.w - (i2.x * xi4.x + i2.y * xi4.y + i2.z * xi4.z + i2.w * xi4.w);
      acc3 += r3.x * xr4.x + r3.y * xr4.y + r3.z * xr4.z + r3.w * xr4.w - (i3.x * xi4.x + i3.y * xi4.y + i3.z * xi4.z + i3.w * xi4.w);
    }
    {
      const int tok = tok0 + sc * 16 + tt;
      u32x2 ur = *(const u32x2*)(us + (sc * 16 + tt) * 64 + wv * 16 + cq * 4);
      float y0 = acc0 + d0 * bflo(ur.x), y1 = acc1 + d1 * bfhi(ur.x), y2 = acc2 + d2 * bflo(ur.y), y3 = acc3 + d3 * bfhi(ur.y);
      u32x2 o; o.x = pack2(geluf_(y0), geluf_(y1)); o.y = pack2(geluf_(y2), geluf_(y3));
      *(u32x2*)(YD + (size_t)tok * 256 + g * 16 + cq * 4) = o;
    }
    __syncthreads();
  }
}

__device__ __forceinline__ void lds_barrier() {
  asm volatile("s_waitcnt lgkmcnt(0)" ::: "memory");
  __builtin_amdgcn_s_barrier();
  asm volatile("" ::: "memory");
}
__device__ __forceinline__ void scan_item(const Params& p, int item, unsigned char* smem) {
  const int tid = TIDX, lane = tid & 63, wv = tid >> 6;
  const int b = item >> 4, h = (item >> 2) & 3, q = item & 3;
  const int rl = lane >> 4, cl = lane & 15;
  const int rloc = wv * 4 + rl;
  const size_t tokb = (size_t)b * SEQ;
  const int chan0 = h * 64;
  const u16* SR = (const u16*)(p.ws + OFF_SR); const u16* SK = (const u16*)(p.ws + OFF_SK);
  const u16* SV = (const u16*)(p.ws + OFF_SV); const u16* SKK = (const u16*)(p.ws + OFF_SKK);
  const u16* SA = (const u16*)(p.ws + OFF_SA); const float* SW = (const float*)(p.ws + OFF_SW);
  float* O = (float*)(p.ws + OFF_O);
  constexpr int BUFF = 6432;
  float* lbase = (float*)smem;
  float* pp = lbase + 2 * BUFF + wv * 1024;
  const int st = tid >> 4, cg4 = tid & 15;
  struct Stg { u32x2 r, k, kk, a, kk1; f32x4 w; u16 v; };
  auto gload = [&](Stg& g, int c) {
    const size_t o = (tokb + (size_t)c * 16 + st) * 256 + chan0;
    g.r = *(const u32x2*)(SR + o + cg4 * 4); g.k = *(const u32x2*)(SK + o + cg4 * 4);
    g.kk = *(const u32x2*)(SKK + o + cg4 * 4); g.a = *(const u32x2*)(SA + o + cg4 * 4);
    g.w = *(const f32x4*)(SW + o + cg4 * 4);
    g.v = SV[o + q * 16 + cg4];
    int t1 = c * 16 + st + 1; if (t1 >= SEQ) t1 = SEQ - 1;
    g.kk1 = *(const u32x2*)(SKK + (tokb + (size_t)t1) * 256 + chan0 + cg4 * 4);
  };
  auto lwrite = [&](const Stg& g, int buf) {
    float* bp = lbase + buf * BUFF;
    const int o = st * 64 + cg4 * 4;
    f32x4 kk = {bflo(g.kk.x), bfhi(g.kk.x), bflo(g.kk.y), bfhi(g.kk.y)};
    f32x4 a = {bflo(g.a.x), bfhi(g.a.x), bflo(g.a.y), bfhi(g.a.y)};
    f32x4 k = {bflo(g.k.x), bfhi(g.k.x), bflo(g.k.y), bfhi(g.k.y)};
    f32x4 r = {bflo(g.r.x), bfhi(g.r.x), bflo(g.r.y), bfhi(g.r.y)};
    *(f32x4*)(bp + o) = kk;
    *(f32x4*)(bp + 1024 + o) = kk * a;
    *(f32x4*)(bp + 2048 + o) = k;
    *(f32x4*)(bp + 3072 + o) = g.w;
    *(f32x4*)(bp + 4096 + o) = r;
    bp[5120 + st * 16 + cg4] = bf2f(g.v);
    const f32x4 kn = {bflo(g.kk1.x), bfhi(g.kk1.x), bflo(g.kk1.y), bfhi(g.kk1.y)};
    *(f32x4*)(bp + 5376 + o) = g.w * kn;
    const f32x4 bb = kk * a;
    const float c1 = row_sum16(k.x * kn.x + k.y * kn.y + k.z * kn.z + k.w * kn.w);
    const float c2 = row_sum16(bb.x * kn.x + bb.y * kn.y + bb.z * kn.z + bb.w * kn.w);
    if (cg4 == 0) *(f32x2*)(bp + 6400 + st * 2) = f32x2{c1, c2};
  };
  constexpr int NCH = SEQ / 16;
  Stg R0, R1, R2, R3;
  gload(R0, 0); gload(R1, 1); gload(R2, 2); gload(R3, 3);
  __syncthreads();
  lwrite(R0, 0);
  __syncthreads();
  __builtin_amdgcn_s_setprio(3);
  float S0 = 0.f, S1 = 0.f, S2 = 0.f, S3 = 0.f;
  const int rrow = lane & 3, rstep = lane >> 2;
  struct Pair { f32x4 kkA, bbA, kA, wA, rA, mA, bbB, kB, wB, rB; f32x2 cA; float vA, vB; };
  auto chunk = [&](int c) {
    const float* bp = lbase + (c & 1) * BUFF;
    auto ldpair = [&](Pair& o, int s) {
      o.kkA = *(const f32x4*)(bp + s * 64 + cl * 4);
      o.mA = *(const f32x4*)(bp + 5376 + s * 64 + cl * 4);
      o.bbA = *(const f32x4*)(bp + 1024 + s * 64 + cl * 4);
      o.kA = *(const f32x4*)(bp + 2048 + s * 64 + cl * 4);
      o.wA = *(const f32x4*)(bp + 3072 + s * 64 + cl * 4);
      o.rA = *(const f32x4*)(bp + 4096 + s * 64 + cl * 4);
      o.vA = bp[5120 + s * 16 + rloc];
      o.cA = *(const f32x2*)(bp + 6400 + s * 2);
      o.bbB = *(const f32x4*)(bp + 1024 + (s + 1) * 64 + cl * 4);
      o.kB = *(const f32x4*)(bp + 2048 + (s + 1) * 64 + cl * 4);
      o.wB = *(const f32x4*)(bp + 3072 + (s + 1) * 64 + cl * 4);
      o.rB = *(const f32x4*)(bp + 4096 + (s + 1) * 64 + cl * 4);
      o.vB = bp[5120 + (s + 1) * 16 + rloc];
    };
    auto pairstep = [&](const Pair& o, int s) {
      const float pa = __builtin_fmaf(S3, o.kkA.w, __builtin_fmaf(S2, o.kkA.z, __builtin_fmaf(S1, o.kkA.y, S0 * o.kkA.x)));
      const float pd = __builtin_fmaf(S3, o.mA.w, __builtin_fmaf(S2, o.mA.z, __builtin_fmaf(S1, o.mA.y, S0 * o.mA.x)));
      const float saA = row_sum16(pa);
      const float dd = row_sum16(pd);
      const float saB = __builtin_fmaf(-saA, o.cA.y, __builtin_fmaf(o.vA, o.cA.x, dd));
      S0 = __builtin_fmaf(S0, o.wA.x, __builtin_fmaf(o.vA, o.kA.x, -(saA * o.bbA.x)));
      S1 = __builtin_fmaf(S1, o.wA.y, __builtin_fmaf(o.vA, o.kA.y, -(saA * o.bbA.y)));
      S2 = __builtin_fmaf(S2, o.wA.z, __builtin_fmaf(o.vA, o.kA.z, -(saA * o.bbA.z)));
      S3 = __builtin_fmaf(S3, o.wA.w, __builtin_fmaf(o.vA, o.kA.w, -(saA * o.bbA.w)));
      pp[(s * 4 + rl) * 16 + cl] = __builtin_fmaf(S3, o.rA.w, __builtin_fmaf(S2, o.rA.z, __builtin_fmaf(S1, o.rA.y, S0 * o.rA.x)));
      S0 = __builtin_fmaf(S0, o.wB.x, __builtin_fmaf(o.vB, o.kB.x, -(saB * o.bbB.x)));
      S1 = __builtin_fmaf(S1, o.wB.y, __builtin_fmaf(o.vB, o.kB.y, -(saB * o.bbB.y)));
      S2 = __builtin_fmaf(S2, o.wB.z, __builtin_fmaf(o.vB, o.kB.z, -(saB * o.bbB.z)));
      S3 = __builtin_fmaf(S3, o.wB.w, __builtin_fmaf(o.vB, o.kB.w, -(saB * o.bbB.w)));
      pp[((s + 1) * 4 + rl) * 16 + cl] = __builtin_fmaf(S3, o.rB.w, __builtin_fmaf(S2, o.rB.z, __builtin_fmaf(S1, o.rB.y, S0 * o.rB.x)));
    };
    Pair p0, p1;
    ldpair(p0, 0);
#pragma unroll
    for (int j = 0; j < 4; ++j) {
      ldpair(p1, 4 * j + 2);
      __builtin_amdgcn_sched_barrier(0);
      pairstep(p0, 4 * j);
      __builtin_amdgcn_sched_barrier(0);
      if (j < 3) ldpair(p0, 4 * j + 4);
      __builtin_amdgcn_sched_barrier(0);
      pairstep(p1, 4 * j + 2);
      __builtin_amdgcn_sched_barrier(0);
    }
    asm volatile("" ::: "memory");
    {
      const float* q0 = pp + (rstep * 4 + rrow) * 16;
      f32x4 a0 = *(const f32x4*)(q0), a1 = *(const f32x4*)(q0 + 4), a2 = *(const f32x4*)(q0 + 8), a3 = *(const f32x4*)(q0 + 12);
      f32x4 sm4 = (a0 + a1) + (a2 + a3);
      O[(tokb + (size_t)c * 16 + rstep) * 256 + chan0 + q * 16 + wv * 4 + rrow] = (sm4.x + sm4.y) + (sm4.z + sm4.w);
    }
    asm volatile("" ::: "memory");
  };
#pragma unroll 1
  for (int g = 0; g < NCH / 4; ++g) {
    const int c0 = g * 4;
    if (c0 + 4 < NCH) gload(R0, c0 + 4);
    chunk(c0);
    lwrite(R1, (c0 + 1) & 1);
    lds_barrier();
    if (c0 + 5 < NCH) gload(R1, c0 + 5);
    chunk(c0 + 1);
    lwrite(R2, (c0 + 2) & 1);
    lds_barrier();
    if (c0 + 6 < NCH) gload(R2, c0 + 6);
    chunk(c0 + 2);
    lwrite(R3, (c0 + 3) & 1);
    lds_barrier();
    if (c0 + 7 < NCH) gload(R3, c0 + 7);
    chunk(c0 + 3);
    if (c0 + 4 < NCH) lwrite(R0, (c0 + 4) & 1);
    lds_barrier();
  }
  __builtin_amdgcn_s_setprio(0);
}

__device__ __forceinline__ void rwkv_post_item(const Params& p, int l, int item) {
  const int tid = TIDX, lane = tid & 63, wv = tid >> 6;
  const int tg = lane >> 4, cl = lane & 15;
  const int c = wv * 64 + cl * 4;
  const float* O = (const float*)(p.ws + OFF_O);
  const u16* SR = (const u16*)(p.ws + OFF_SR); const u16* SK = (const u16*)(p.ws + OFF_SK);
  const u16* SV = (const u16*)(p.ws + OFF_SV); const u16* G = (const u16*)(p.ws + OFF_G);
  u16* OG = (u16*)(p.ws + OFF_OG);
  const f32x4 lw = *(const f32x4*)(p.in[18] + l * 256 + c), lb = *(const f32x4*)(p.in[19] + l * 256 + c);
  const f32x4 rk = *(const f32x4*)(p.in[17] + l * 256 + c);
  const int tok0 = item * 8;
  f32x4 ov[2]; u32x2 rr[2], kk[2], vv[2], gg[2];
#pragma unroll
  for (int k = 0; k < 2; ++k) {
    const size_t o = (size_t)(tok0 + tg + 4 * k) * 256 + c;
    ov[k] = *(const f32x4*)(O + o);
    rr[k] = *(const u32x2*)(SR + o); kk[k] = *(const u32x2*)(SK + o); vv[k] = *(const u32x2*)(SV + o); gg[k] = *(const u32x2*)(G + o);
  }
#pragma unroll
  for (int k = 0; k < 2; ++k) {
    const size_t o = (size_t)(tok0 + tg + 4 * k) * 256 + c;
    const f32x4 x = ov[k];
    const float mean = row_sum16((x.x + x.y) + (x.z + x.w)) * (1.f / 64.f);
    const f32x4 d = x - mean;
    const float var = row_sum16((d.x * d.x + d.y * d.y) + (d.z * d.z + d.w * d.w)) * (1.f / 64.f);
    const float rs = rsqrtf(var + 64e-5f);
    const f32x4 on = d * rs * lw + lb;
    const f32x4 r = {bflo(rr[k].x), bfhi(rr[k].x), bflo(rr[k].y), bfhi(rr[k].y)};
    const f32x4 kf = {bflo(kk[k].x), bfhi(kk[k].x), bflo(kk[k].y), bfhi(kk[k].y)};
    const f32x4 v = {bflo(vv[k].x), bfhi(vv[k].x), bflo(vv[k].y), bfhi(vv[k].y)};
    const f32x4 g = {bflo(gg[k].x), bfhi(gg[k].x), bflo(gg[k].y), bfhi(gg[k].y)};
    const f32x4 rkk = r * kf * rk;
    const float bonus = row_sum16((rkk.x + rkk.y) + (rkk.z + rkk.w));
    const f32x4 res = (on + v * bonus) * g;
    *(u32x2*)(OG + o) = u32x2{pack2(res.x, res.y), pack2(res.z, res.w)};
  }
}

#define XB_TMO      128
#define XB_XCNT(j)  (256  + 64 * (j))
#define XB_XSUB(j)  (1280 + 64 * (j))
#define XB_XGEN(j)  (2304 + 64 * (j))
#define XB_TOP      3328
#define XB_TOPGEN   3392
#define XCD_BAR_WORDS 3456
#define XB_SPIN_CAP (1u << 22)
#define LAS __attribute__((address_space(3)))
__device__ __forceinline__ unsigned xb_ld(unsigned* p) { return __hip_atomic_load(p, __ATOMIC_RELAXED, __HIP_MEMORY_SCOPE_AGENT); }
__device__ __forceinline__ unsigned xb_add(unsigned* p, unsigned v) { return __hip_atomic_fetch_add(p, v, __ATOMIC_RELAXED, __HIP_MEMORY_SCOPE_AGENT); }
__device__ __forceinline__ unsigned xb_xcc_id() { return (unsigned)__builtin_amdgcn_s_getreg((3 << 11) | 20) & 0xFu; }
#define XB_SPIN(cond, bar) do { unsigned _sp = 0; while (cond) { __builtin_amdgcn_s_sleep(1); \
    if ((++_sp & 255u) == 0u) { if (xb_ld(&(bar)[XB_TMO])) break; if (_sp > XB_SPIN_CAP) { atomicAdd(&(bar)[XB_TMO], 1u); break; } } } } while (0)
struct XcdBarrier { unsigned* bar; unsigned x; volatile LAS unsigned* st; };
__device__ __forceinline__ XcdBarrier xcd_barrier_post(unsigned* bar, volatile LAS unsigned* st) {
  XcdBarrier b; b.bar = bar; b.x = xb_xcc_id(); b.st = st;
  if (threadIdx.x == 0) st[2] = xb_add(&bar[XB_XCNT(b.x)], 1u);
  return b;
}
__device__ __forceinline__ void xcd_barrier_complete(unsigned* bar, unsigned x, unsigned& nloc, unsigned& nx) {
  const unsigned G = gridDim.x * gridDim.y * gridDim.z;
  unsigned sum, cnt, mine, sp = 0u;
  for (;;) {
    sum = 0u; cnt = 0u; mine = 0u;
#pragma unroll
    for (unsigned j = 0; j < 16; ++j) { const unsigned c = xb_ld(&bar[XB_XCNT(j)]); sum += c; cnt += (c > 0u) ? 1u : 0u; mine = (j == x) ? c : mine; }
    if (sum == G) break;
    __builtin_amdgcn_s_sleep(1);
    if ((++sp & 255u) == 0u) { if (xb_ld(&bar[XB_TMO])) break; if (sp > XB_SPIN_CAP) { atomicAdd(&bar[XB_TMO], 1u); break; } }
  }
  nloc = mine > 0u ? mine : 1u; nx = cnt > 0u ? cnt : 1u;
}
__device__ __forceinline__ void xcd_barrier(const XcdBarrier& b) {
  asm volatile("s_waitcnt vmcnt(0)" ::: "memory");
  __syncthreads();
  if (threadIdx.x == 0) {
    unsigned* bar = b.bar;
    __builtin_amdgcn_s_waitcnt(0);
    unsigned nloc = b.st[0], nx = b.st[1];
    if (nloc == 0u) { xcd_barrier_complete(bar, b.x, nloc, nx); b.st[0] = nloc; b.st[1] = nx; }
    const unsigned old = xb_add(&bar[XB_XSUB(b.x)], 1u);
    const unsigned gen = old / nloc;
    if (old + 1u == (gen + 1u) * nloc) {
      __builtin_amdgcn_fence(__ATOMIC_RELEASE, "agent");
      asm volatile("s_waitcnt vmcnt(0)" ::: "memory");
      const unsigned og = xb_add(&bar[XB_TOP], 1u);
      const unsigned tg = og / nx;
      if (og + 1u == (tg + 1u) * nx) xb_add(&bar[XB_TOPGEN], 1u);
      else XB_SPIN(xb_ld(&bar[XB_TOPGEN]) == tg, bar);
      __builtin_amdgcn_fence(__ATOMIC_ACQUIRE, "agent");
      xb_add(&bar[XB_XGEN(b.x)], 1u);
      asm volatile("s_waitcnt vmcnt(0)" ::: "memory");
    } else {
      XB_SPIN(xb_ld(&bar[XB_XGEN(b.x)]) == gen, bar);
      __builtin_amdgcn_fence(__ATOMIC_ACQUIRE, "agent");
      asm volatile("s_waitcnt vmcnt(0)" ::: "memory");
    }
  }
  __syncthreads();
}

__device__ __forceinline__ int xcd_virtual_id(const XcdBarrier& b) {
  if (threadIdx.x == 0) {
    unsigned base = 0u;
#pragma unroll
    for (unsigned j = 0; j < 16; ++j) { const unsigned c = xb_ld(&b.bar[XB_XCNT(j)]); base += (j < b.x) ? c : 0u; }
    b.st[3] = base + b.st[2];
  }
  __syncthreads();
  const int vb = __builtin_amdgcn_readfirstlane((int)b.st[3]);
  __syncthreads();
  return vb;
}

__device__ __forceinline__ void sub_barrier(unsigned* cnt, unsigned target) {
  asm volatile("s_waitcnt vmcnt(0)" ::: "memory");
  __syncthreads();
  if (threadIdx.x == 0) {
    __builtin_amdgcn_fence(__ATOMIC_RELEASE, "agent");
    asm volatile("s_waitcnt vmcnt(0)" ::: "memory");
    xb_add(cnt, 1u);
    unsigned sp = 0;
    while (xb_ld(cnt) < target) { __builtin_amdgcn_s_sleep(2); if (++sp > (1u << 24)) break; }
    __builtin_amdgcn_fence(__ATOMIC_ACQUIRE, "agent");
    asm volatile("s_waitcnt vmcnt(0)" ::: "memory");
  }
  __syncthreads();
}

#define N_PHASES 22
#ifndef PROBE_CONV_REPS
#define PROBE_CONV_REPS 1
#endif
#ifndef PROBE_PREP_REPS
#define PROBE_PREP_REPS 1
#endif
#ifndef PROBE_POST_REPS
#define PROBE_POST_REPS 1
#endif
#ifndef PROBE_SCAN_REPS
#define PROBE_SCAN_REPS 1
#endif
#ifndef PROBE_FFN1_REPS
#define PROBE_FFN1_REPS 1
#endif
#ifndef PH_MASK
#define PH_MASK 0xFFFFF
#endif
#define PHON(s) (PH_MASK & (1 << (s)))
#define PHASE_BEGIN(k) if (ph_hi > (k)) { if ((k) > 1) xcd_barrier(xb);
#define PHASE_END }

template <int L>
__device__ __forceinline__ void run_layer(const Params& p, int vbr, int ph_hi, unsigned char* smem_all, const XcdBarrier& xb) {
  unsigned char* smem = smem_all + SUBB * 73728;
  const int vb = vbr * 2 + SUBB;
  constexpr int l = L;
  constexpr int base = 1 + 10 * L;
  const float* modl = (const float*)(p.ws + OFF_MOD) + (size_t)l * 4 * 6144;
  PHASE_BEGIN(base + 0)
    for (int rep = 0; rep < PROBE_CONV_REPS; ++rep) {
      if (rep) xcd_barrier(xb);
      phase_convert(p, l, smem);
      phase_norm(l == 0 ? p.in[0] : p.out, p.in[4] + l * 1024, modl, 0, 1024, (u16*)(p.ws + OFF_H));
    }
  PHASE_END
  PHASE_BEGIN(base + 1)
    phase_pproj_tail(p, vbr, smem_all);
    phase_gemm_8w<0>(p, l, vbr, smem_all);
  PHASE_END
  PHASE_BEGIN(base + 2)
    for (int rep = 0; rep < PROBE_PREP_REPS; ++rep) {
      if (rep) xcd_barrier(xb);
      for (int item = VBLK; item < 512; item += VGRID) rwkv_prep_item(p, l, item, smem);
    }
  PHASE_END
  PHASE_BEGIN(base + 3)
    if ((int)blockIdx.x < 64) {
      if (SUBB == 0) scan_item(p, blockIdx.x, smem);
      else { __syncthreads(); __syncthreads(); for (int c = 0; c < SEQ / 16; ++c) lds_barrier(); }
    }
    else {
      const int nb = VGRID - 128, bi = VBLK - 128;
      for (int item = bi; item < 512; item += nb) sg_item(p, l, item, smem);
      for (int item = (bi + 2 * (nb / 3)) % nb; item < 1024; item += nb) s5a_item(p, l, item, smem);
      for (int item = (bi + 2 * (nb / 3)) % nb; item < 2048; item += nb) conv_item(p, l, item);
      sub_barrier((unsigned*)(p.ws + OFF_BAR) + 3520 + 64 * (2 * l), gridDim.x - 64);
      for (int item = bi; item < 1024; item += nb) s5b_item(p, l, item, smem);
      sub_barrier((unsigned*)(p.ws + OFF_BAR) + 3520 + 64 * (2 * l + 1), gridDim.x - 64);
      for (int item = (int)blockIdx.x - 64; item < 512; item += (int)gridDim.x - 64) merge_tile8<0>(p, item, smem_all);
    }
  PHASE_END
  PHASE_BEGIN(base + 4)
    for (int rep = 0; rep < PROBE_POST_REPS; ++rep) { if (rep) xcd_barrier(xb); for (int item = VBLK; item < 2048; item += VGRID) rwkv_post_item(p, l, item); }
  PHASE_END
  PHASE_BEGIN(base + 5)
    for (int item = vbr; item < 512; item += (int)gridDim.x) {
      int it2 = item;
      if (gridDim.x == 256) { const int r = item >> 8, w = vbr & 31; it2 = ((r * 4 + (w >> 3)) << 6) | ((vbr >> 5) * 8 + (w & 7)); }
      merge_tile8<1>(p, it2, smem_all);
    }
  PHASE_END
  PHASE_BEGIN(base + 6)
    phase_gemm_8w<1>(p, l, vbr, smem_all);
  PHASE_END
  PHASE_BEGIN(base + 7)
    if (PHON(7)) phase_norm(p.out, p.in[38] + l * 1024, modl, 3072, 4096, (u16*)(p.ws + OFF_H));
  PHASE_END
  PHASE_BEGIN(base + 8)
    phase_gemm_8w<2>(p, l, vbr, smem_all);
  PHASE_END
#ifdef PROBE_DUP_FFN1
  PHASE_BEGIN(base + 8)
    phase_gemm_8w<2>(p, l, vbr, smem_all);
  PHASE_END
#endif
  PHASE_BEGIN(base + 9)
    phase_gemm_8w<3>(p, l, vbr, smem_all);
  PHASE_END
}

__global__ void __launch_bounds__(512, 2) mega_fwd(Params p, int ph_lo, int ph_hi) {
  __shared__ __attribute__((aligned(16))) unsigned char smem[2 * 73728 + 16];
  cg::grid_group grid = cg::this_grid();
  if (ph_hi < 0) grid.sync();
  volatile LAS unsigned* st = (volatile LAS unsigned*)(smem + 2 * 73728);
  if (threadIdx.x == 0) { st[0] = 0u; st[1] = 0u; st[2] = 0u; st[3] = 0u; }
  __syncthreads();
  const XcdBarrier xb = xcd_barrier_post((unsigned*)(p.ws + OFF_BAR), st);
  if (ph_hi > 0) phase_mod(p, smem + SUBB * 73728);
  xcd_barrier(xb);
  const int vb = xcd_virtual_id(xb);
  run_layer<0>(p, vb, ph_hi, smem, xb);
  run_layer<1>(p, vb, ph_hi, smem, xb);
  PHASE_BEGIN(21)
    if (PHON(11)) phase_final(p.out, p.in[41]);
  PHASE_END
}

extern "C" void kernel_launch(void* const* d_in, const int* in_sizes, int n_in, void* d_out, int out_size, void* d_ws,
                              size_t ws_size, hipStream_t stream) {
  static int grid_blocks = 0;
  if (!grid_blocks) {
    int dev = 0, cus = 0, per_cu = 0;
    hipGetDevice(&dev);
    hipDeviceGetAttribute(&cus, hipDeviceAttributeMultiprocessorCount, dev);
    hipOccupancyMaxActiveBlocksPerMultiprocessor(&per_cu, mega_fwd, 512, 0);
    if (per_cu > 1) per_cu = 1;
    if (per_cu < 1) per_cu = 1;
    grid_blocks = cus * per_cu;
    if (ws_size < WS_END) fprintf(stderr, "workspace too small: %zu < %zu\n", ws_size, (size_t)WS_END);
  }
  Params p{};
  for (int i = 0; i < 42; ++i) p.in[i] = (const float*)d_in[i];
  p.out = (float*)d_out;
  p.ws = (unsigned char*)d_ws;
  hipMemsetAsync((unsigned char*)d_ws + OFF_BAR, 0, 16384, stream);
  int lo = 0, hi = N_PHASES;
  void* args[] = {&p, &lo, &hi};
  hipError_t e = hipLaunchCooperativeKernel((void*)mega_fwd, dim3(grid_blocks), dim3(512), args, 0, stream);
  if (e != hipSuccess) fprintf(stderr, "cooperative launch failed: %s (grid %d)\n", hipGetErrorString(e), grid_blocks);
}
```
